# Optimizing an MI355X kernel written in HIP

```python
import jax, jax.numpy as jnp
from jax import lax
import numpy as np

D_MODEL = 1024
BATCH = 2
SEQ = 16384
DEPTH = 4

N_BRANCH = 4
HEAD_DIM = 64
BRANCH_WIDTH = D_MODEL // N_BRANCH
N_HEADS = BRANCH_WIDTH // HEAD_DIM
NORM_EPS = 1e-6
RW_DECAY_LORA = 64
RW_AAA_LORA = 64
RW_GATE_LORA = 128
RW_DECAY_SCALE = 0.606531
RW_LN_EPS = 64e-5
SB_BLOCK = 128
RET_CHUNK = 128
RET_GN_EPS = 1e-5
ROPE_BASE = 10000.0
CONV_WIDTH = 31
CONV_LN_EPS = 1e-5
D_FF = 2816
N_EXPERTS = 8
TOP_K = 2
D_FF_EXPERT = 1408
MOE_BLOCK = 256

RW_IN = 3 * BRANCH_WIDTH + RW_DECAY_LORA + RW_AAA_LORA + RW_GATE_LORA
SB_IN = 3 * BRANCH_WIDTH
RET_IN = 4 * BRANCH_WIDTH
CONV_IN = 2 * BRANCH_WIDTH
N_IN = RW_IN + SB_IN + RET_IN + CONV_IN
MIX_SPLITS = [RW_IN, RW_IN + SB_IN, RW_IN + SB_IN + RET_IN]
RW_SPLITS = [BRANCH_WIDTH, 2 * BRANCH_WIDTH, 3 * BRANCH_WIDTH,
             3 * BRANCH_WIDTH + RW_DECAY_LORA, 3 * BRANCH_WIDTH + RW_DECAY_LORA + RW_AAA_LORA]

kernel_name = "hybrid_rwkv7_stickbreak_retnet_conformer_moe"


def _rmsnorm(x, gain, eps=NORM_EPS):
    x32 = x.astype(jnp.float32)
    y = x32 * lax.rsqrt(jnp.mean(x32 * x32, axis=-1, keepdims=True) + eps)
    return (y * gain).astype(x.dtype)


def _layernorm(x, gain, bias, eps):
    x32 = x.astype(jnp.float32)
    xc = x32 - jnp.mean(x32, axis=-1, keepdims=True)
    var = jnp.mean(xc * xc, axis=-1, keepdims=True)
    return (xc * lax.rsqrt(var + eps) * gain + bias).astype(x.dtype)


def _token_shift(x):
    return jnp.pad(x, ((0, 0), (1, 0), (0, 0)))[:, :-1]


def _split_heads(t):
    return t.reshape(t.shape[0], t.shape[1], N_HEADS, HEAD_DIM)


def _rwkv7_mixer(p, mu, w0, w2, a0, a2, g2, k_k, k_a, r_k, ln_w, ln_b):
    B, S, _ = p.shape
    p = p + (_token_shift(p) - p) * mu
    r, k, v, pw, pa, pg = jnp.split(p, RW_SPLITS, axis=-1)
    w = jnp.exp(-RW_DECAY_SCALE * jax.nn.sigmoid((w0 + jnp.tanh(pw) @ w2).astype(jnp.float32)))
    a = jax.nn.sigmoid(a0 + pa @ a2)
    g = jax.nn.sigmoid(pg) @ g2
    r, k, v, w, a = (_split_heads(t) for t in (r, k, v, w, a))
    kk32 = (k * k_k.reshape(N_HEADS, HEAD_DIM)).astype(jnp.float32)
    kk = kk32 / jnp.maximum(jnp.sqrt(jnp.sum(kk32 * kk32, axis=-1, keepdims=True)), 1e-12)
    k = k * (1.0 + (a - 1.0) * k_a.reshape(N_HEADS, HEAD_DIM))

    def step(state, inp):
        r_t, w_t, k_t, v_t, kk_t, a_t = inp
        sa = jnp.einsum('bhvk,bhk->bhv', state, -kk_t)
        state = (state * w_t[:, :, None, :] + sa[..., None] * (kk_t * a_t)[:, :, None, :]
                 + v_t[..., None] * k_t[:, :, None, :])
        return state, jnp.einsum('bhvk,bhk->bhv', state, r_t)

    seq_first = lambda t: jnp.moveaxis(t.astype(jnp.float32), 1, 0)
    state0 = jnp.zeros((B, N_HEADS, HEAD_DIM, HEAD_DIM), jnp.float32)
    _, y = lax.scan(step, state0, tuple(seq_first(t) for t in (r, w, k, v, kk, a)))
    y = jnp.moveaxis(y, 0, 1)
    y = _layernorm(y, ln_w.reshape(N_HEADS, HEAD_DIM), ln_b.reshape(N_HEADS, HEAD_DIM), RW_LN_EPS)
    y = y + jnp.sum(r * k * r_k, axis=-1, keepdims=True) * v
    return (y.reshape(B, S, BRANCH_WIDTH) * g).astype(p.dtype)


def _stick_breaking_mixer(p, q_norm, k_norm):
    B, S, _ = p.shape
    nb = S // SB_BLOCK
    blocks = lambda t: _split_heads(t).reshape(B, nb, SB_BLOCK, N_HEADS, HEAD_DIM).transpose(0, 3, 1, 2, 4)
    q, k, v = (blocks(t) for t in jnp.split(p, 3, axis=-1))
    q = _rmsnorm(q, q_norm) * (HEAD_DIM ** -0.5)
    k = _rmsnorm(k, k_norm)
    idx = jnp.arange(SB_BLOCK)
    rev_incl = (idx[:, None] >= idx[None, :]).astype(jnp.float32)
    diag_mask = idx[None, :] < idx[:, None]
    acc = jnp.zeros((B, N_HEADS, nb, SB_BLOCK), jnp.float32)
    o = jnp.zeros((B, N_HEADS, nb, SB_BLOCK, HEAD_DIM), jnp.float32)
    for d in range(nb):
        n = nb - d
        z = jnp.einsum('bhnqd,bhnkd->bhnqk', q[:, :, d:], k[:, :, :n]).astype(jnp.float32)
        ls = jax.nn.log_sigmoid(-z)
        if d == 0:
            ls = jnp.where(diag_mask, ls, 0.0)
        cum = jnp.einsum('bhnqk,kj->bhnqj', ls, rev_incl)
        log_a = z + cum + acc[:, :, d:, :, None]
        if d == 0:
            log_a = jnp.where(diag_mask, log_a, -jnp.inf)
        attn = jnp.exp(log_a)
        o = o.at[:, :, d:].add(jnp.einsum('bhnqk,bhnkd->bhnqd', attn.astype(v.dtype), v[:, :, :n]).astype(jnp.float32))
        acc = acc.at[:, :, d:].add(cum[..., 0])
    return o.transpose(0, 2, 3, 1, 4).reshape(B, S, BRANCH_WIDTH).astype(p.dtype)


def _rotary(t):
    S = t.shape[1]
    inv_freq = ROPE_BASE ** (-jnp.arange(0, HEAD_DIM, 2, dtype=jnp.float32) / HEAD_DIM)
    ang = jnp.arange(S, dtype=jnp.float32)[:, None] * inv_freq[None, :]
    cos = jnp.cos(ang)[None, :, None, :].astype(t.dtype)
    sin = jnp.sin(ang)[None, :, None, :].astype(t.dtype)
    t1, t2 = jnp.split(t, 2, axis=-1)
    return jnp.concatenate([t1 * cos - t2 * sin, t1 * sin + t2 * cos], axis=-1)


def _retention_mixer(p, gn_w):
    B, S, _ = p.shape
    dt = p.dtype
    q, k, v, gt = jnp.split(p, 4, axis=-1)
    q = _rotary(_split_heads(q))
    k = _rotary(_split_heads(k)) * (HEAD_DIM ** -0.5)
    v = _split_heads(v)
    nc = S // RET_CHUNK
    chunk = lambda t: t.reshape(B, nc, RET_CHUNK, N_HEADS, HEAD_DIM).transpose(0, 3, 1, 2, 4)
    qc, kc, vc = chunk(q), chunk(k), chunk(v)
    log_gamma = jnp.log(1.0 - 2.0 ** (-5.0 - jnp.arange(N_HEADS, dtype=jnp.float32)))
    idx = jnp.arange(RET_CHUNK, dtype=jnp.float32)
    rel = idx[:, None] - idx[None, :]
    intra_decay = jnp.where(rel >= 0, jnp.exp(jnp.maximum(rel, 0.0) * log_gamma[:, None, None]), 0.0)
    k_decay = jnp.exp((RET_CHUNK - 1 - idx)[None, :] * log_gamma[:, None])
    q_decay = jnp.exp((idx + 1.0)[None, :] * log_gamma[:, None])
    chunk_decay = jnp.exp(RET_CHUNK * log_gamma)
    scores = jnp.einsum('bhcqd,bhckd->bhcqk', qc, kc) * intra_decay[None, :, None].astype(dt)
    intra = jnp.einsum('bhcqk,bhckd->bhcqd', scores, vc)
    kv = jnp.einsum('bhckd,bhcke->cbhde', kc * k_decay[None, :, None, :, None].astype(dt), vc)

    def step(state, kv_c):
        return chunk_decay[None, :, None, None] * state + kv_c, state

    _, state_prev = lax.scan(step, jnp.zeros(kv.shape[1:], jnp.float32), kv.astype(jnp.float32))
    inter = jnp.einsum('bhcqd,cbhde->bhcqe', qc * q_decay[None, :, None, :, None].astype(dt),
                       state_prev.astype(dt))
    o = (intra + inter).transpose(0, 2, 3, 1, 4).reshape(B, S, N_HEADS, HEAD_DIM)
    o = _layernorm(o, gn_w.reshape(N_HEADS, HEAD_DIM), 0.0, RET_GN_EPS)
    return o.reshape(B, S, BRANCH_WIDTH) * jax.nn.silu(gt)


def _conformer_conv_mixer(p, dw, db, ln_w, ln_b):
    u_a, u_b = jnp.split(p, 2, axis=-1)
    u = u_a * jax.nn.sigmoid(u_b)
    u = lax.conv_general_dilated(u, dw[:, None, :].astype(u.dtype), window_strides=(1,),
                                 padding=[(CONV_WIDTH - 1, 0)],
                                 dimension_numbers=('NWC', 'WIO', 'NWC'),
                                 feature_group_count=BRANCH_WIDTH) + db
    return jax.nn.silu(_layernorm(u, ln_w, ln_b, CONV_LN_EPS))


def _swiglu(h, w1, w3, w2):
    return (jax.nn.silu(h @ w1) * (h @ w3)) @ w2


def _moe_ffn(h, router, w1, w3, w2):
    B, S, D = h.shape
    T = B * S
    xt = h.reshape(T, D)
    logits = (xt @ router).astype(jnp.float32)
    top_logit, top_idx = lax.top_k(logits, TOP_K)
    gates = jax.nn.softmax(top_logit, axis=-1)
    n_assign = T * TOP_K
    expert = top_idx.reshape(-1)
    token = jnp.arange(n_assign) // TOP_K
    order = jnp.argsort(expert)
    expert_s, token_s, weight_s = expert[order], token[order], gates.reshape(-1)[order]
    x_s = xt[token_s]
    counts = jnp.bincount(expert, length=N_EXPERTS)
    n_blk = n_assign // MOE_BLOCK
    seg_start = jnp.sort(jnp.concatenate([jnp.arange(n_blk) * MOE_BLOCK, jnp.cumsum(counts)[:-1]]))
    seg_end = jnp.concatenate([seg_start[1:], jnp.array([n_assign], seg_start.dtype)])
    seg_blk = jnp.minimum(seg_start // MOE_BLOCK, n_blk - 1)
    seg_exp = expert_s[jnp.minimum(seg_start, n_assign - 1)]

    def segment(args):
        start, end, blk, e = args
        rows = blk * MOE_BLOCK + jnp.arange(MOE_BLOCK)
        xb = lax.dynamic_slice_in_dim(x_s, blk * MOE_BLOCK, MOE_BLOCK, axis=0)
        yb = _swiglu(xb, w1[e], w3[e], w2[e])
        return jnp.where(((rows >= start) & (rows < end))[:, None], yb, 0.0)

    y_seg = lax.map(segment, (seg_start, seg_end, seg_blk, seg_exp))
    y_s = jax.ops.segment_sum(y_seg, seg_blk, num_segments=n_blk).reshape(n_assign, D)
    out = jax.ops.segment_sum(y_s * weight_s[:, None].astype(y_s.dtype), token_s, num_segments=T)
    return out.reshape(B, S, D)


def setup_inputs(seed: int = 0) -> dict:
    key = jax.random.key(seed)
    ks = iter(jax.random.split(key, 40))
    nrm = lambda shape, scale: scale * jax.random.normal(next(ks), shape, jnp.float32)
    L, C = DEPTH, BRANCH_WIDTH
    nd, nm = (DEPTH + 1) // 2, DEPTH // 2
    return {
        "x": nrm((BATCH, SEQ, D_MODEL), 1.0),
        "norm_mix": 1.0 + nrm((L, D_MODEL), 0.1),
        "w_in": nrm((L, D_MODEL, N_IN), D_MODEL ** -0.5),
        "rw_mu": jax.random.uniform(next(ks), (L, RW_IN), jnp.float32),
        "rw_w0": -1.5 + nrm((L, C), 0.5),
        "rw_w2": nrm((L, RW_DECAY_LORA, C), 0.5 * RW_DECAY_LORA ** -0.5),
        "rw_a0": nrm((L, C), 0.5),
        "rw_a2": nrm((L, RW_AAA_LORA, C), RW_AAA_LORA ** -0.5),
        "rw_g2": nrm((L, RW_GATE_LORA, C), RW_GATE_LORA ** -0.5),
        "rw_k_k": 0.85 + nrm((L, C), 0.1),
        "rw_k_a": 1.0 + nrm((L, C), 0.1),
        "rw_r_k": nrm((L, N_HEADS, HEAD_DIM), 0.1),
        "rw_ln_w": 1.0 + nrm((L, C), 0.1),
        "rw_ln_b": nrm((L, C), 0.01),
        "sb_q_norm": 1.0 + nrm((L, HEAD_DIM), 0.1),
        "sb_k_norm": 1.0 + nrm((L, HEAD_DIM), 0.1),
        "ret_gn": 1.0 + nrm((L, C), 0.1),
        "conv_dw": nrm((L, CONV_WIDTH, C), CONV_WIDTH ** -0.5),
        "conv_b": nrm((L, C), 0.01),
        "conv_ln_w": 1.0 + nrm((L, C), 0.1),
        "conv_ln_b": nrm((L, C), 0.01),
        "w_gate": nrm((L, N_BRANCH, D_MODEL, D_MODEL), D_MODEL ** -0.5),
        "w_branch": nrm((L, N_BRANCH, C, D_MODEL), C ** -0.5),
        "w_out": nrm((L, D_MODEL, D_MODEL), 0.5 * D_MODEL ** -0.5),
        "norm_ffn": 1.0 + nrm((L, D_MODEL), 0.1),
        "ffn_w1": nrm((nd, D_MODEL, D_FF), D_MODEL ** -0.5),
        "ffn_w3": nrm((nd, D_MODEL, D_FF), D_MODEL ** -0.5),
        "ffn_w2": nrm((nd, D_FF, D_MODEL), 0.5 * D_FF ** -0.5),
        "router": nrm((nm, D_MODEL, N_EXPERTS), D_MODEL ** -0.5),
        "moe_w1": nrm((nm, N_EXPERTS, D_MODEL, D_FF_EXPERT), D_MODEL ** -0.5),
        "moe_w3": nrm((nm, N_EXPERTS, D_MODEL, D_FF_EXPERT), D_MODEL ** -0.5),
        "moe_w2": nrm((nm, N_EXPERTS, D_FF_EXPERT, D_MODEL), 0.5 * D_FF_EXPERT ** -0.5),
    }


def reference(x, norm_mix, w_in, rw_mu, rw_w0, rw_w2, rw_a0, rw_a2, rw_g2, rw_k_k, rw_k_a, rw_r_k,
              rw_ln_w, rw_ln_b, sb_q_norm, sb_k_norm, ret_gn, conv_dw, conv_b, conv_ln_w, conv_ln_b,
              w_gate, w_branch, w_out, norm_ffn, ffn_w1, ffn_w3, ffn_w2, router, moe_w1, moe_w3, moe_w2):
    for l in range(DEPTH):
        h = _rmsnorm(x, norm_mix[l])
        p_rw, p_sb, p_ret, p_conv = jnp.split(h @ w_in[l], MIX_SPLITS, axis=-1)
        branches = (
            _rwkv7_mixer(p_rw, rw_mu[l], rw_w0[l], rw_w2[l], rw_a0[l], rw_a2[l], rw_g2[l],
                         rw_k_k[l], rw_k_a[l], rw_r_k[l], rw_ln_w[l], rw_ln_b[l]),
            _stick_breaking_mixer(p_sb, sb_q_norm[l], sb_k_norm[l]),
            _retention_mixer(p_ret, ret_gn[l]),
            _conformer_conv_mixer(p_conv, conv_dw[l], conv_b[l], conv_ln_w[l], conv_ln_b[l]),
        )
        merged = jax.nn.sigmoid(h @ w_gate[l, 0]) * (branches[0] @ w_branch[l, 0])
        for i in range(1, N_BRANCH):
            merged = merged + jax.nn.sigmoid(h @ w_gate[l, i]) * (branches[i] @ w_branch[l, i])
        x = x + merged @ w_out[l]
        h = _rmsnorm(x, norm_ffn[l])
        if l % 2 == 0:
            x = x + _swiglu(h, ffn_w1[l // 2], ffn_w3[l // 2], ffn_w2[l // 2])
        else:
            x = x + _moe_ffn(h, router[l // 2], moe_w1[l // 2], moe_w3[l // 2], moe_w2[l // 2])
    return x
```

```cpp
#include <hip/hip_runtime.h>
#include <cstdio>
#include <cstdint>

#define GAS __attribute__((address_space(1)))
#define LAS __attribute__((address_space(3)))
typedef unsigned short bf16;
typedef unsigned u32x4 __attribute__((ext_vector_type(4)));
typedef unsigned u32x2 __attribute__((ext_vector_type(2)));
typedef float f32x4 __attribute__((ext_vector_type(4)));
typedef float f32x2 __attribute__((ext_vector_type(2)));
typedef short bf16x8 __attribute__((ext_vector_type(8)));
typedef float f32x16 __attribute__((ext_vector_type(16)));
typedef short s16x4 __attribute__((ext_vector_type(4)));

constexpr int SEQ = 16384, NBATCH = 2, T = NBATCH * SEQ, D = 1024, NIN = 3328, DFF = 2816, DFE = 1408, NEXP = 8, NLAYER = 4;
constexpr int MPAD = 2 * T + NEXP * 256;
constexpr int NWAVES = 8, NTHR = 512;
constexpr float LOG2E = 1.4426950408889634f;
constexpr int MM_LP = 72;

typedef __bf16 bf16x2_t __attribute__((ext_vector_type(2)));
__device__ __forceinline__ unsigned cvt_pk_bf16(float lo, float hi) { const f32x2 v = {lo, hi}; const bf16x2_t b = __builtin_convertvector(v, bf16x2_t); return __builtin_bit_cast(unsigned, b); }
__device__ __forceinline__ float bflo(unsigned u) { return __builtin_bit_cast(float, u << 16); }
__device__ __forceinline__ float bfhi(unsigned u) { return __builtin_bit_cast(float, u & 0xffff0000u); }
__device__ __forceinline__ float bf2f(bf16 u) { return __builtin_bit_cast(float, (unsigned)u << 16); }
__device__ __forceinline__ bf16 f2bf(float f) { return (bf16)(cvt_pk_bf16(f, 0.f) & 0xffffu); }
__device__ __forceinline__ float sigm(float x) { return __builtin_amdgcn_rcpf(1.f + __builtin_amdgcn_exp2f(-x * LOG2E)); }
__device__ __forceinline__ float shx(float v, int o, int lane) { return __builtin_bit_cast(float, __builtin_amdgcn_ds_bpermute((lane ^ o) << 2, __builtin_bit_cast(int, v))); }
__device__ __forceinline__ float dpp_add(float v, const int ctrl_id) {
    const int x = __builtin_bit_cast(int, v);
    int y;
    if (ctrl_id == 0) y = __builtin_amdgcn_update_dpp(0, x, 0xB1, 0xF, 0xF, true);
    else if (ctrl_id == 1) y = __builtin_amdgcn_update_dpp(0, x, 0x4E, 0xF, 0xF, true);
    else if (ctrl_id == 2) y = __builtin_amdgcn_update_dpp(0, x, 0x141, 0xF, 0xF, true);
    else y = __builtin_amdgcn_update_dpp(0, x, 0x140, 0xF, 0xF, true);
    return v + __builtin_bit_cast(float, y);
}
__device__ __forceinline__ float wave_sum(float v, int lane) {
    (void)lane;
    v = dpp_add(v, 0); v = dpp_add(v, 1); v = dpp_add(v, 2); v = dpp_add(v, 3);
    const int x = __builtin_bit_cast(int, v);
    const float s0 = __builtin_bit_cast(float, __builtin_amdgcn_readlane(x, 0)), s1 = __builtin_bit_cast(float, __builtin_amdgcn_readlane(x, 16)),
                s2 = __builtin_bit_cast(float, __builtin_amdgcn_readlane(x, 32)), s3 = __builtin_bit_cast(float, __builtin_amdgcn_readlane(x, 48));
    return (s0 + s1) + (s2 + s3);
}
__device__ __forceinline__ void unpack8(const u32x4 v, float* f) {
    f[0] = bflo(v.x); f[1] = bfhi(v.x); f[2] = bflo(v.y); f[3] = bfhi(v.y); f[4] = bflo(v.z); f[5] = bfhi(v.z); f[6] = bflo(v.w); f[7] = bfhi(v.w);
}
__device__ __forceinline__ u32x4 pack8(const float* f) {
    u32x4 w; w.x = cvt_pk_bf16(f[0], f[1]); w.y = cvt_pk_bf16(f[2], f[3]); w.z = cvt_pk_bf16(f[4], f[5]); w.w = cvt_pk_bf16(f[6], f[7]); return w;
}


#ifndef PROBE2
#define PROBE2 0
#endif
#ifndef GMASK
#define GMASK 15
#endif
#ifndef RWDBG
#define RWDBG 0
#endif
namespace pg8 {
typedef unsigned short bf16_t;
constexpr int BM = 256, BK = 64, HALF = 128, HTB = HALF * BK * 2, NXCD = 8, WGM = 8;
__host__ __device__ __forceinline__ int lds_byte(int r, int c) { const int st = (r >> 4) * 2 + (c >> 5), rr = r & 15, cc = c & 31, ob = rr * 64 + cc * 2; return st * 1024 + (ob ^ (((ob >> 9) & 1) << 5)); }
__host__ __device__ __forceinline__ void stage_rc(int b, int& R, int& C) { const int st = b / 1024, sb = b % 1024, swz = sb ^ (((sb >> 9) & 1) << 5); R = (st >> 1) * 16 + swz / 64; C = (st & 1) * 32 + (swz % 64) / 2; }
__host__ __device__ __forceinline__ int perm32(int rho) { const int n = rho >> 4, i = rho & 15; return 8 * (i >> 2) + 4 * n + (i & 3); }

struct Unit { int pm, pn, aoff; };
struct Gemm { const bf16_t* A; const bf16_t* Bt; int lda, K; };

struct StaticOrder {
    int nM, nN, nwg, G, c, ashift, amul;
    __device__ void init(int M, int N, int G_, int c_, int ashift_ = 0, int amul_ = 0) { nM = M / BM; nN = N / BM; nwg = nM * nN; G = G_; c = c_; ashift = ashift_; amul = amul_; }
    __device__ bool next(int i, Unit& u) const {
        const long L = (long)i * G + c; if (L >= nwg) return false;
        int wgid = (int)L; { const int q = nwg / NXCD, r = nwg % NXCD, xcd = wgid % NXCD, off = wgid / NXCD; wgid = (xcd < r ? xcd * (q + 1) : r * (q + 1) + (xcd - r) * q) + off; }
        const int nig = WGM * nN, gid = wgid / nig, fm = gid * WGM, gsz = (nM - fm) < WGM ? (nM - fm) : WGM;
        u.pm = fm + ((wgid % nig) % gsz); u.pn = (wgid % nig) / gsz; u.aoff = (u.pn >> ashift) * amul; return true;
    }
};
struct MoeOrder {
    const int* texp; int ntiles, ncol, G, c;
    __device__ bool next(int i, Unit& u) const {
        const long L = (long)i * G + c; if (L >= (long)ntiles * ncol) return false;
        const int pm = (int)(L / ncol), pl = (int)(L % ncol);
        u.pm = pm; u.pn = texp[pm] * ncol + pl; u.aoff = 0; return true;
    }
};

template <class Epi, class Sched, bool ALIGN_EPI>
__device__ __forceinline__ void gemm_phase(LAS unsigned char* lds, const int tid_in, const Gemm g, const Sched& S, const Epi& E) {
    const int tid = tid_in, wid = __builtin_amdgcn_readfirstlane(tid >> 6), lane = tid & 63, wr = wid >> 2, wc = wid & 3, fr = lane & 15, fq = lane >> 4;
    const int K = g.K, nt = K / BK, lda = g.lda;
    unsigned voffA[2], voffB[2];
#pragma unroll
    for (int i = 0; i < 2; ++i) { int R, C; stage_rc(tid * 16 + i * 8192, R, C); const int Rb = (R & ~31) + perm32(R & 31);
        voffA[i] = (unsigned)(R * lda + C) * 2u; voffB[i] = (unsigned)(Rb * K + C) * 2u; }
    const size_t kstep = (size_t)(BK * 2);
    const size_t hstepA = (size_t)HALF * lda * 2, tstepA = 2 * hstepA, hstepB = (size_t)HALF * K * 2, tstepB = 2 * hstepB;
    const unsigned ldsw = (unsigned)wid * 1024u;
    const int aoff = lds_byte(wr * 64 + fr, fq * 8), boff = lds_byte(wc * 32 + fr, fq * 8);
#define PG8_SA(b, h) (((b) * 2 + (h)) * HTB)
#define PG8_SB(b, h) ((4 + (b) * 2 + (h)) * HTB)
#define PG8_STAGE(bufoff, gbase, voff) do { _Pragma("unroll") for (int _i = 0; _i < 2; ++_i) \
        __builtin_amdgcn_global_load_lds((const unsigned*)((const char*)(gbase) + (voff)[_i]), (LAS unsigned*)(lds + (bufoff) + ldsw + _i * 8192), 16, 0, 0); } while (0)
#define PG8_LDA(dst, b, h) do { _Pragma("unroll") for (int m = 0; m < 4; ++m) _Pragma("unroll") for (int k = 0; k < 2; ++k) dst[m][k] = *(const LAS bf16x8*)(lds + PG8_SA(b, h) + aoff + m * 2048 + k * 1024); } while (0)
#define PG8_LDB(dst, b, h) do { _Pragma("unroll") for (int n = 0; n < 2; ++n) _Pragma("unroll") for (int k = 0; k < 2; ++k) dst[n][k] = *(const LAS bf16x8*)(lds + PG8_SB(b, h) + boff + n * 2048 + k * 1024); } while (0)
#define PG8_MMA(ai, bj, At, Bt) do { __builtin_amdgcn_s_setprio(1); _Pragma("unroll") for (int m = 0; m < 4; ++m) _Pragma("unroll") for (int n = 0; n < 2; ++n) _Pragma("unroll") for (int k = 0; k < 2; ++k) \
        acc[ai][bj][m][n] = __builtin_amdgcn_mfma_f32_16x16x32_bf16(Bt[n][k], At[m][k], acc[ai][bj][m][n], 0, 0, 0); __builtin_amdgcn_s_setprio(0); } while (0)
#define PG8_WAIT_V(n) asm volatile("s_waitcnt vmcnt(" #n ")" ::: "memory")
#define PG8_WAIT_L(n) asm volatile("s_waitcnt lgkmcnt(" #n ")" ::: "memory")
#define PG8_BAR __builtin_amdgcn_s_barrier()
#define PG8_SCHED __builtin_amdgcn_sched_barrier(0)
    Unit cur, nxt; int ui = 0;
    if (!S.next(0, cur)) return;
    f32x4 acc[2][2][4][2];
#pragma unroll
    for (int a = 0; a < 2; ++a)
#pragma unroll
        for (int b = 0; b < 2; ++b)
#pragma unroll
            for (int m = 0; m < 4; ++m)
#pragma unroll
                for (int n = 0; n < 2; ++n) acc[a][b][m][n] = (f32x4){0.f, 0.f, 0.f, 0.f};
    bf16x8 At[4][2], B0[2][2], B1[2][2];
    const char* cA = (const char*)g.A + (size_t)cur.pm * tstepA + cur.aoff; const char* cB = (const char*)g.Bt + (size_t)cur.pn * tstepB;
    PG8_STAGE(PG8_SB(0, 0), cB, voffB); PG8_STAGE(PG8_SB(0, 1), cB + hstepB, voffB); PG8_STAGE(PG8_SA(0, 0), cA, voffA); PG8_STAGE(PG8_SA(0, 1), cA + hstepA, voffA);
    if (wr == 1) PG8_BAR;
    PG8_WAIT_V(2); PG8_BAR;
    PG8_STAGE(PG8_SB(1, 0), cB + kstep, voffB); PG8_STAGE(PG8_SA(1, 0), cA + kstep, voffA); PG8_STAGE(PG8_SB(1, 1), cB + hstepB + kstep, voffB);
    PG8_WAIT_V(6); PG8_BAR;
    for (;;) {
        const bool has_next = S.next(ui + 1, nxt);
        const char* nA = has_next ? (const char*)g.A + (size_t)nxt.pm * tstepA + nxt.aoff : cA; const char* nB = has_next ? (const char*)g.Bt + (size_t)nxt.pn * tstepB : cB;
#pragma unroll 1
        for (int t = 0; t < nt; t += 2) {
            const bool last = (t == nt - 2);
            const char* a1 = cA + (size_t)(t + 1) * kstep;
            const char* a2 = last ? nA : cA + (size_t)(t + 2) * kstep; const char* b2 = last ? nB : cB + (size_t)(t + 2) * kstep;
            const char* a3 = a2 + kstep; const char* b3 = b2 + kstep;
            PG8_LDB(B0, 0, 0); PG8_LDB(B1, 0, 1); PG8_SCHED; PG8_LDA(At, 0, 0); PG8_STAGE(PG8_SA(1, 1), a1 + hstepA, voffA);
            PG8_WAIT_V(8); PG8_WAIT_L(0); PG8_BAR; PG8_MMA(0, 0, At, B0); PG8_MMA(0, 1, At, B1); PG8_BAR; PG8_SCHED;
            PG8_LDA(At, 0, 1); PG8_STAGE(PG8_SB(0, 0), b2, voffB); PG8_STAGE(PG8_SB(0, 1), b2 + hstepB, voffB); PG8_STAGE(PG8_SA(0, 0), a2, voffA);
            PG8_WAIT_V(8); PG8_WAIT_L(0); PG8_BAR; PG8_MMA(1, 0, At, B0); PG8_MMA(1, 1, At, B1); PG8_BAR; PG8_SCHED;
            PG8_LDB(B0, 1, 0); PG8_LDB(B1, 1, 1); PG8_SCHED; PG8_LDA(At, 1, 0); PG8_STAGE(PG8_SA(0, 1), a2 + hstepA, voffA);
            PG8_WAIT_V(8); PG8_WAIT_L(0); PG8_BAR; PG8_MMA(0, 0, At, B0); PG8_MMA(0, 1, At, B1); PG8_BAR; PG8_SCHED;
            PG8_LDA(At, 1, 1); PG8_STAGE(PG8_SB(1, 0), b3, voffB); PG8_STAGE(PG8_SB(1, 1), b3 + hstepB, voffB); PG8_STAGE(PG8_SA(1, 0), a3, voffA);
            PG8_WAIT_V(8); PG8_WAIT_L(0); PG8_BAR; PG8_MMA(1, 0, At, B0); PG8_MMA(1, 1, At, B1); PG8_BAR; PG8_SCHED;
        }
        if constexpr (ALIGN_EPI) { if (wr == 0) PG8_BAR; }
        E(acc, cur, wr, wc, fr, fq);
        if (!has_next) break;
#pragma unroll
        for (int a = 0; a < 2; ++a)
#pragma unroll
            for (int b = 0; b < 2; ++b)
#pragma unroll
                for (int m = 0; m < 4; ++m)
#pragma unroll
                    for (int n = 0; n < 2; ++n) acc[a][b][m][n] = (f32x4){0.f, 0.f, 0.f, 0.f};
        cur = nxt; cA = nA; cB = nB; ++ui;
        if constexpr (ALIGN_EPI) { if (wr == 1) PG8_BAR; }
    }
    PG8_WAIT_V(0);
    if constexpr (!ALIGN_EPI) { if (wr == 0) PG8_BAR; }
    PG8_BAR;
#undef PG8_SA
#undef PG8_SB
#undef PG8_STAGE
#undef PG8_LDA
#undef PG8_LDB
#undef PG8_MMA
#undef PG8_WAIT_V
#undef PG8_WAIT_L
#undef PG8_BAR
#undef PG8_SCHED
}

typedef f32x4 Acc[2][2][4][2];

struct EpiRoute {
    bf16_t *d0, *d1, *d2, *d3;
    __device__ __forceinline__ void operator()(const Acc& acc, const Unit& u, int wr, int wc, int fr, int fq) const {
        const int pn = u.pn; bf16_t* base; int ld, ct;
        if (pn < 4) { base = d0; ld = 1024; ct = pn; } else if (pn < 7) { base = d1; ld = 768; ct = pn - 4; } else if (pn < 11) { base = d2; ld = 1024; ct = pn - 7; } else { base = d3; ld = 512; ct = pn - 11; }
        const int row0 = u.pm * BM + wr * 64 + fr, col0 = ct * 256 + wc * 32 + 8 * fq;
#pragma unroll
        for (int ai = 0; ai < 2; ++ai)
#pragma unroll
            for (int m = 0; m < 4; ++m) { bf16_t* rowp = base + (size_t)(row0 + ai * HALF + m * 16) * ld + col0;
#pragma unroll
                for (int bj = 0; bj < 2; ++bj) { const f32x4 v0 = acc[ai][bj][m][0], v1 = acc[ai][bj][m][1]; u32x4 w;
                    w.x = cvt_pk_bf16(v0[0], v0[1]); w.y = cvt_pk_bf16(v0[2], v0[3]); w.z = cvt_pk_bf16(v1[0], v1[1]); w.w = cvt_pk_bf16(v1[2], v1[3]);
                    *(u32x4*)(rowp + bj * HALF) = w; } }
    }
};
struct EpiBf16 {
    bf16_t* O; int ld, pnmask;
    __device__ __forceinline__ void operator()(const Acc& acc, const Unit& u, int wr, int wc, int fr, int fq) const {
        const int row0 = u.pm * BM + wr * 64 + fr, col0 = (u.pn & pnmask) * 256 + wc * 32 + 8 * fq;
#pragma unroll
        for (int ai = 0; ai < 2; ++ai)
#pragma unroll
            for (int m = 0; m < 4; ++m) { bf16_t* rowp = O + (size_t)(row0 + ai * HALF + m * 16) * ld + col0;
#pragma unroll
                for (int bj = 0; bj < 2; ++bj) { const f32x4 v0 = acc[ai][bj][m][0], v1 = acc[ai][bj][m][1]; u32x4 w;
                    w.x = cvt_pk_bf16(v0[0], v0[1]); w.y = cvt_pk_bf16(v0[2], v0[3]); w.z = cvt_pk_bf16(v1[0], v1[1]); w.w = cvt_pk_bf16(v1[2], v1[3]);
                    *(u32x4*)(rowp + bj * HALF) = w; } }
    }
};
struct EpiLora {
    float* wdec; bf16_t* ag; const float* w0; const float* a0;
    __device__ __forceinline__ void operator()(const Acc& acc, const Unit& u, int wr, int wc, int fr, int fq) const {
        const int row0 = u.pm * BM + wr * 64 + fr, cl0 = wc * 32 + 8 * fq, pn = u.pn;
#pragma unroll
        for (int ai = 0; ai < 2; ++ai)
#pragma unroll
            for (int m = 0; m < 4; ++m) { const size_t row = (size_t)(row0 + ai * HALF + m * 16);
#pragma unroll
                for (int bj = 0; bj < 2; ++bj) { const int col = bj * HALF + cl0; float v[8];
#pragma unroll
                    for (int n = 0; n < 2; ++n)
#pragma unroll
                        for (int e = 0; e < 4; ++e) v[4 * n + e] = acc[ai][bj][m][n][e];
                    if (pn == 0) {
                        *(f32x4*)(wdec + row * 256 + col) = (f32x4){v[0], v[1], v[2], v[3]}; *(f32x4*)(wdec + row * 256 + col + 4) = (f32x4){v[4], v[5], v[6], v[7]};
                    } else if (pn == 1) {
                        *(u32x4*)(ag + row * 512 + col) = pack8(v);
                    } else { *(u32x4*)(ag + row * 512 + 256 + col) = pack8(v); }
                } }
    }
};
struct EpiGateMerge {
    const bf16_t* ball; bf16_t* merged;
    __device__ __forceinline__ void operator()(const Acc& acc, const Unit& u, int wr, int wc, int fr, int fq) const {
        const int row0 = u.pm * BM + wr * 64 + fr, o0 = 64 * u.pn + 16 * wc + 4 * fq;
#pragma unroll
        for (int ai = 0; ai < 2; ++ai)
#pragma unroll
            for (int m = 0; m < 4; ++m) { const size_t row = (size_t)(row0 + ai * HALF + m * 16); float s[4] = {0.f, 0.f, 0.f, 0.f};
#pragma unroll
                for (int bj = 0; bj < 2; ++bj)
#pragma unroll
                    for (int n = 0; n < 2; ++n) { const int gi = 2 * bj + n; if (!((GMASK >> gi) & 1)) continue; const u32x2 b = *(const u32x2*)(ball + row * 4096 + 1024 * gi + o0);
                        const f32x4 a = acc[ai][bj][m][n];
                        s[0] += sigm(a[0]) * bflo(b.x); s[1] += sigm(a[1]) * bfhi(b.x); s[2] += sigm(a[2]) * bflo(b.y); s[3] += sigm(a[3]) * bfhi(b.y); }
                u32x2 w; w.x = cvt_pk_bf16(s[0], s[1]); w.y = cvt_pk_bf16(s[2], s[3]);
                *(u32x2*)(merged + row * 1024 + o0) = w; }
    }
};
struct EpiResidual {
    float* out;
    __device__ __forceinline__ void operator()(const Acc& acc, const Unit& u, int wr, int wc, int fr, int fq) const {
        const int row0 = u.pm * BM + wr * 64 + fr, col0 = u.pn * 256 + wc * 32 + 8 * fq;
#pragma unroll
        for (int ai = 0; ai < 2; ++ai)
#pragma unroll
            for (int m = 0; m < 4; ++m) { float* rowp = out + (size_t)(row0 + ai * HALF + m * 16) * 1024 + col0;
#pragma unroll
                for (int bj = 0; bj < 2; ++bj)
#pragma unroll
                    for (int n = 0; n < 2; ++n) { f32x4* p = (f32x4*)(rowp + bj * HALF + 4 * n); f32x4 v = *p; v = v + acc[ai][bj][m][n]; *p = v; } }
    }
};
struct EpiSwiglu {
    bf16_t* hid; int ldh, ncol;
    __device__ __forceinline__ void operator()(const Acc& acc, const Unit& u, int wr, int wc, int fr, int fq) const {
        const int row0 = u.pm * BM + wr * 64 + fr, col0 = (u.pn % ncol) * 128 + wc * 32 + 8 * fq;
#pragma unroll
        for (int ai = 0; ai < 2; ++ai)
#pragma unroll
            for (int m = 0; m < 4; ++m) { float v[8];
#pragma unroll
                for (int n = 0; n < 2; ++n)
#pragma unroll
                    for (int e = 0; e < 4; ++e) { const float a = acc[ai][0][m][n][e], b = acc[ai][1][m][n][e]; v[4 * n + e] = a * sigm(a) * b; }
                *(u32x4*)(hid + (size_t)(row0 + ai * HALF + m * 16) * ldh + col0) = pack8(v); }
    }
};
struct EpiMoeOut {
    float* out; const int* rowtok; const float* rowgate; const int* segend;
    __device__ __forceinline__ void operator()(const Acc& acc, const Unit& u, int wr, int wc, int fr, int fq) const {
        const int row0 = u.pm * BM + wr * 64 + fr, col0 = (u.pn & 3) * 256 + wc * 32 + 8 * fq, lim = segend[u.pm];
#pragma unroll
        for (int ai = 0; ai < 2; ++ai)
#pragma unroll
            for (int m = 0; m < 4; ++m) { const int row = row0 + ai * HALF + m * 16;
                if (row < lim) { const int tok = rowtok[row]; const float gt = rowgate[row]; float* rowp = out + (size_t)tok * 1024 + col0;
#pragma unroll
                    for (int bj = 0; bj < 2; ++bj)
#pragma unroll
                        for (int n = 0; n < 2; ++n)
#pragma unroll
                            for (int e = 0; e < 4; ++e) __hip_atomic_fetch_add(rowp + bj * HALF + 4 * n + e, gt * acc[ai][bj][m][n][e], __ATOMIC_RELAXED, __HIP_MEMORY_SCOPE_AGENT);
                } }
    }
};
}

#define XB_TMO      128
#define XB_XCNT(j)  (256  + 64 * (j))
#define XB_XSUB(j)  (1280 + 64 * (j))
#define XB_XGEN(j)  (2304 + 64 * (j))
#define XB_TOP      3328
#define XB_TOPGEN   3392
#define XCD_BAR_WORDS 3456
#define XB_SPIN_CAP (1u << 18)
__device__ __forceinline__ unsigned xb_ld(unsigned* p)              { return __hip_atomic_load(p, __ATOMIC_RELAXED, __HIP_MEMORY_SCOPE_AGENT); }
__device__ __forceinline__ unsigned xb_add(unsigned* p, unsigned v) { return __hip_atomic_fetch_add(p, v, __ATOMIC_RELAXED, __HIP_MEMORY_SCOPE_AGENT); }
__device__ __forceinline__ unsigned xb_xcc_id() { return (unsigned)__builtin_amdgcn_s_getreg((3 << 11) | 20) & 0xFu; }
#define XB_SPIN(cond, bar) do { unsigned _sp = 0; while (cond) { __builtin_amdgcn_s_sleep(1); \
    if ((++_sp & 255u) == 0u) { if (xb_ld(&(bar)[XB_TMO])) break; if (_sp > XB_SPIN_CAP) { atomicAdd(&(bar)[XB_TMO], 1u); break; } } } } while (0)
struct XcdBarrier { unsigned* bar; unsigned x; volatile LAS unsigned* st; };
__device__ __forceinline__ XcdBarrier xcd_barrier_post(unsigned* bar, volatile LAS unsigned* st) {
    XcdBarrier b; b.bar = bar; b.x = xb_xcc_id(); b.st = st;
    if (threadIdx.x == 0) (void)xb_add(&bar[XB_XCNT(b.x)], 1u);
    return b;
}
__device__ __forceinline__ void xcd_barrier_complete(unsigned* bar, unsigned x, unsigned& nloc, unsigned& nx) {
    const unsigned G = gridDim.x * gridDim.y * gridDim.z;
    unsigned sum, cnt, mine, sp = 0u;
    for (;;) {
        sum = 0u; cnt = 0u; mine = 0u;
#pragma unroll
        for (unsigned j = 0; j < 16; ++j) { const unsigned c = xb_ld(&bar[XB_XCNT(j)]); sum += c; cnt += (c > 0u) ? 1u : 0u; mine = (j == x) ? c : mine; }
        if (sum == G) break;
        __builtin_amdgcn_s_sleep(1);
        if ((++sp & 255u) == 0u) { if (xb_ld(&bar[XB_TMO])) break; if (sp > XB_SPIN_CAP) { atomicAdd(&bar[XB_TMO], 1u); break; } }
    }
    nloc = mine > 0u ? mine : 1u; nx = cnt > 0u ? cnt : 1u;
}
__device__ __forceinline__ void xcd_barrier(const XcdBarrier& b, const int tid) {
    asm volatile("s_waitcnt vmcnt(0)" ::: "memory");
    __syncthreads();
    if (tid == 0) {
        unsigned* bar = b.bar;
        __builtin_amdgcn_s_waitcnt(0);
        unsigned nloc = b.st[0], nx = b.st[1];
        if (nloc == 0u) { xcd_barrier_complete(bar, b.x, nloc, nx); b.st[0] = nloc; b.st[1] = nx; }
        const unsigned old = xb_add(&bar[XB_XSUB(b.x)], 1u);
        const unsigned gen = old / nloc;
        if (old + 1u == (gen + 1u) * nloc) {
            __builtin_amdgcn_fence(__ATOMIC_RELEASE, "agent");
            asm volatile("s_waitcnt vmcnt(0)" ::: "memory");
            const unsigned og = xb_add(&bar[XB_TOP], 1u);
            const unsigned tg = og / nx;
            if (og + 1u == (tg + 1u) * nx) xb_add(&bar[XB_TOPGEN], 1u);
            else XB_SPIN(xb_ld(&bar[XB_TOPGEN]) == tg, bar);
            __builtin_amdgcn_fence(__ATOMIC_ACQUIRE, "agent");
            xb_add(&bar[XB_XGEN(b.x)], 1u);
            asm volatile("s_waitcnt vmcnt(0)" ::: "memory");
        } else {
            XB_SPIN(xb_ld(&bar[XB_XGEN(b.x)]) == gen, bar);
            __builtin_amdgcn_fence(__ATOMIC_ACQUIRE, "agent");
            asm volatile("s_waitcnt vmcnt(0)" ::: "memory");
        }
    }
    __syncthreads();
}

constexpr size_t MiB = 1u << 20;
constexpr size_t WS_CTL = 0, CTL_ZERO_BYTES = 1 * MiB;
constexpr int CW_BAR = 4096;
constexpr int CW_MOE = 16384;
constexpr size_t WS_EIDX = 1 * MiB, WS_GATE = WS_EIDX + 256 * 1024, WS_ROWTOK = WS_EIDX + 512 * 1024, WS_ROWGATE = 2 * MiB, WS_TEXP = 2 * MiB + 512 * 1024, WS_SEGEND = WS_TEXP + 4096, WS_NT = WS_TEXP + 8192;
constexpr size_t WS_SLOTOF = 2 * MiB + 768 * 1024;
constexpr size_t WS_BON = 3 * MiB, WS_COS = 4 * MiB, WS_SIN = 6 * MiB;
constexpr size_t WS_WIN = 8 * MiB, WS_WLORA = 15 * MiB, WS_WB = 16 * MiB, WS_WG = 18 * MiB, WS_WOUT = 26 * MiB, WS_W13 = 28 * MiB, WS_W2D = 40 * MiB, WS_W2M = 72 * MiB;
constexpr size_t WS_H = 104 * MiB, WS_Y = 168 * MiB, WS_BIG = 232 * MiB;
constexpr size_t WS_RW = WS_BIG, WS_WDEC = WS_BIG, WS_AG = WS_BIG + 32 * MiB, WS_SB = WS_BIG + 64 * MiB, WS_RET = WS_BIG + 112 * MiB, WS_CV = WS_BIG + 176 * MiB, WS_Y0 = WS_CV;
constexpr size_t WS_RKVS = WS_BIG + 208 * MiB, WS_ALORA = WS_BIG + 256 * MiB, WS_RHAT = WS_ALORA, WS_KV = WS_BIG + 272 * MiB, WS_SST = WS_WDEC  , WS_PQ = WS_BIG + 304 * MiB  , WS_END = WS_BIG + 368 * MiB;
constexpr size_t WS_BALL = WS_BIG, WS_MERGED = WS_BIG + 256 * MiB, WS_HID = WS_BIG, WS_XS = WS_BIG, WS_YS = WS_XS, WS_HIDM = WS_BIG + 132 * MiB;
static_assert(WS_HIDM + (size_t)MPAD * DFE * 2 <= WS_END && WS_MERGED + (size_t)T * D * 2 <= WS_END && WS_W2M + (size_t)NEXP * D * DFE * 2 <= WS_H, "ws map");
static_assert(WS_W13 + (size_t)NEXP * 2 * DFE * D * 2 <= WS_W2M && WS_W13 + (size_t)2 * DFF * D * 2 <= WS_W2D, "ws map weights");

constexpr int LDS_BYTES = 147456, RING_BYTES = 131072, MISC_OFF = RING_BYTES + 320;

struct Args { const float* in[32]; float* out; unsigned char* ws; int ph_lo, ph_hi; };
#define CAS __attribute__((address_space(4)))
struct Ctx {
    LAS unsigned char* lds; unsigned char* ws; float* out; const float* const CAS* in;
    int tid, lane, wave, G, bid;
};
__device__ __forceinline__ const CAS Args* ka_ptr() { const CAS Args* p = (const CAS Args*)__builtin_amdgcn_kernarg_segment_ptr(); asm volatile("" : "+s"(p)); return p; }
extern __shared__ __attribute__((aligned(16))) unsigned char lds_raw[];
__device__ __forceinline__ Ctx make_ctx(int wv) {
    const CAS Args* ka = ka_ptr();
    Ctx C; C.lds = (LAS unsigned char*)lds_raw; C.ws = ka->ws; C.out = ka->out; C.in = ka->in;
    int g_ = gridDim.x, b_ = blockIdx.x, w_ = wv; asm volatile("" : "+s"(g_), "+s"(b_), "+s"(w_));
    int ln_; asm volatile("v_mbcnt_lo_u32_b32 %0, -1, 0\n\tv_mbcnt_hi_u32_b32 %0, -1, %0" : "=v"(ln_));
    C.lane = ln_; C.wave = w_; C.tid = w_ * 64 + ln_; C.G = g_; C.bid = b_;
    return C;
}
enum { I_X = 0, I_NORM_MIX, I_W_IN, I_RW_MU, I_RW_W0, I_RW_W2, I_RW_A0, I_RW_A2, I_RW_G2, I_RW_KK, I_RW_KA, I_RW_RK, I_RW_LNW, I_RW_LNB, I_SB_QN, I_SB_KN, I_RET_GN,
       I_CONV_DW, I_CONV_B, I_CONV_LNW, I_CONV_LNB, I_W_GATE, I_W_BRANCH, I_W_OUT, I_NORM_FFN, I_FFN_W1, I_FFN_W3, I_FFN_W2, I_ROUTER, I_MOE_W1, I_MOE_W3, I_MOE_W2 };

__device__ __forceinline__ void ph_prologue_(const Ctx& C) {
    const size_t gid = (size_t)C.bid * NTHR + C.tid, gsz = (size_t)C.G * NTHR;
    float* cs = (float*)(C.ws + WS_COS); float* sn = (float*)(C.ws + WS_SIN);
    for (size_t i = gid; i < (size_t)SEQ * 32; i += gsz) {
        const int pos = (int)(i >> 5), j = (int)(i & 31);
        const float inv = (float)pow(10000.0, -(double)(2 * j) / 64.0);
        const float ang = (float)pos * inv;
        cs[i] = (float)cos((double)ang); sn[i] = (float)sin((double)ang);
    }
}

__device__ __forceinline__ int dest_row(int mode, int roff, int which, int n) {
    if (mode == 0) return roff + n;
    if (mode == 1) { const int pn = n >> 6, oc = n & 63; return 256 * pn + 128 * (roff >> 1) + 32 * (oc >> 4) + 8 * ((oc >> 2) & 3) + 4 * (roff & 1) + (oc & 3); }
    return roff + 256 * (n >> 7) + 128 * which + (n & 127);
}
__device__ __forceinline__ void xpose_item(const float* W, int K, int N, bf16* WT, int mode, int roff, int which, LAS float* scr, int item, int lane) {
    const int nblk = N / 32, kb = item / nblk, nb = item % nblk, k0 = 64 * kb, n0 = 32 * nb;
#pragma unroll
    for (int i = 0; i < 8; ++i) { const int kk = (lane >> 3) + 8 * i, c4 = (lane & 7) * 4; const f32x4 v = *(const f32x4*)(W + (size_t)(k0 + kk) * N + n0 + c4);
        scr[kk * 33 + c4] = v.x; scr[kk * 33 + c4 + 1] = v.y; scr[kk * 33 + c4 + 2] = v.z; scr[kk * 33 + c4 + 3] = v.w; }
    asm volatile("s_waitcnt lgkmcnt(0)" ::: "memory");
    const int c = lane & 7;
#pragma unroll
    for (int j = 0; j < 4; ++j) { const int n = (lane >> 3) + 8 * j; const LAS float* s = scr + (8 * c) * 33 + n;
        u32x4 o; o.x = cvt_pk_bf16(s[0 * 33], s[1 * 33]); o.y = cvt_pk_bf16(s[2 * 33], s[3 * 33]); o.z = cvt_pk_bf16(s[4 * 33], s[5 * 33]); o.w = cvt_pk_bf16(s[6 * 33], s[7 * 33]);
        *(u32x4*)(WT + (size_t)dest_row(mode, roff, which, n0 + n) * K + k0 + 8 * c) = o; }
    asm volatile("s_waitcnt lgkmcnt(0)" ::: "memory");
}
__device__ __forceinline__ void ph_weights_(const Ctx& C, int l, int part, int first_wg, int nwg) {
    LAS float* scr = (LAS float*)(C.lds + C.wave * 16384);
    const int gw = (C.bid - first_wg) * NWAVES + C.wave, NGW = nwg * NWAVES, lane = C.lane;
    unsigned char* ws = C.ws;
    const bool moe = (l & 1);
    const int l2 = l >> 1;
    constexpr int IT_IN = (D / 64) * (NIN / 32), IT_B = (256 / 64) * (D / 32), IT_G = (D / 64) * (D / 32), IT_O = IT_G;
    constexpr int IT_F1 = (D / 64) * (DFF / 32), IT_F2 = (DFF / 64) * (D / 32), IT_M1 = (D / 64) * (DFE / 32), IT_M2 = (DFE / 64) * (D / 32);
    const int n_fixed = IT_IN + 4 * IT_B + 4 * IT_G + IT_O;
    if (part == 1) {
        if (C.bid < first_wg) return;
        const int n1 = moe ? NEXP * IT_M2 : (2 * IT_F1 + IT_F2);
        for (int it = gw; it < n1; it += NGW) {
            int r = it;
            if (!moe) {
                if (r < IT_F1) { xpose_item(C.in[I_FFN_W1] + (size_t)l2 * D * DFF, D, DFF, (bf16*)(ws + WS_W13), 2, 0, 0, scr, r, lane); continue; } r -= IT_F1;
                if (r < IT_F1) { xpose_item(C.in[I_FFN_W3] + (size_t)l2 * D * DFF, D, DFF, (bf16*)(ws + WS_W13), 2, 0, 1, scr, r, lane); continue; } r -= IT_F1;
                xpose_item(C.in[I_FFN_W2] + (size_t)l2 * DFF * D, DFF, D, (bf16*)(ws + WS_W2D), 0, 0, 0, scr, r, lane);
            } else { const int e = r / IT_M2; r -= e * IT_M2;
                xpose_item(C.in[I_MOE_W2] + ((size_t)l2 * NEXP + e) * DFE * D, DFE, D, (bf16*)(ws + WS_W2M), 0, e * D, 0, scr, r, lane); }
        }
        return;
    }
    const int n_ffn = moe ? (NEXP * 2 * IT_M1) : 0;
    for (int it = gw; it < n_fixed + n_ffn; it += NGW) {
        int r = it;
        if (r < IT_IN) { xpose_item(C.in[I_W_IN] + (size_t)l * D * NIN, D, NIN, (bf16*)(ws + WS_WIN), 0, 0, 0, scr, r, lane); continue; } r -= IT_IN;
        if (r < 4 * IT_B) { const int i = r / IT_B; xpose_item(C.in[I_W_BRANCH] + ((size_t)l * 4 + i) * 256 * D, 256, D, (bf16*)(ws + WS_WB), 0, 1024 * i, 0, scr, r % IT_B, lane); continue; } r -= 4 * IT_B;
        if (r < 4 * IT_G) { const int i = r / IT_G; xpose_item(C.in[I_W_GATE] + ((size_t)l * 4 + i) * D * D, D, D, (bf16*)(ws + WS_WG), 1, i, 0, scr, r % IT_G, lane); continue; } r -= 4 * IT_G;
        if (r < IT_O) { xpose_item(C.in[I_W_OUT] + (size_t)l * D * D, D, D, (bf16*)(ws + WS_WOUT), 0, 0, 0, scr, r, lane); continue; } r -= IT_O;
        { const int per = 2 * IT_M1, e = r / per; r -= e * per;
          if (r < IT_M1) { xpose_item(C.in[I_MOE_W1] + ((size_t)l2 * NEXP + e) * D * DFE, D, DFE, (bf16*)(ws + WS_W13), 2, e * 2 * DFE, 0, scr, r, lane); continue; } r -= IT_M1;
          xpose_item(C.in[I_MOE_W3] + ((size_t)l2 * NEXP + e) * D * DFE, D, DFE, (bf16*)(ws + WS_W13), 2, e * 2 * DFE, 1, scr, r, lane); }
    }
    bf16* WL = (bf16*)(ws + WS_WLORA);
    const float* w2 = C.in[I_RW_W2] + (size_t)l * 64 * 256; const float* a2 = C.in[I_RW_A2] + (size_t)l * 64 * 256; const float* g2 = C.in[I_RW_G2] + (size_t)l * 128 * 256;
    for (int i = C.bid * NTHR + C.tid; i < 768 * 256; i += C.G * NTHR) {
        const int n = i >> 8, k = i & 255; float v = 0.f;
        if (n < 256) { if (k < 64) v = w2[k * 256 + n]; }
        else if (n < 512) { if (k >= 64 && k < 128) v = a2[(k - 64) * 256 + (n - 256)]; }
        else { if (k >= 128) v = g2[(k - 128) * 256 + (n - 512)]; }
        WL[i] = f2bf(v);
    }
}

__device__ __forceinline__ void ph_norm_(const Ctx& C, const float* gain, bool route, const float* router, int moe_idx, bool combine = false, const float* src = nullptr) {
    const int gw = C.bid * NWAVES + C.wave, NGW = C.G * NWAVES, lane = C.lane;
    bf16* H = (bf16*)(C.ws + WS_H);
    f32x4 g[4];
#pragma unroll
    for (int j = 0; j < 4; ++j) g[j] = *((const f32x4*)gain + lane + 64 * j);
    LAS unsigned* lcnt = (LAS unsigned*)(C.lds);
    if (route) { if (C.tid < 8) lcnt[C.tid] = 0u; __syncthreads(); }
    int* eidx = (int*)(C.ws + WS_EIDX); float* gate = (float*)(C.ws + WS_GATE);
    constexpr int NR = 2;
    for (int mb = gw; mb < T; mb += NR * NGW) {
        f32x4 vv[NR][4]; u32x2 ya[NR][4], yb[NR][4]; float g0v[NR], g1v[NR];
#pragma unroll
        for (int r = 0; r < NR; ++r) { const int m = mb + r * NGW; if (m < T) { const f32x4* xr = (const f32x4*)((src ? src : C.out) + (size_t)m * D) + lane;
#pragma unroll
            for (int j = 0; j < 4; ++j) vv[r][j] = xr[64 * j];
            if (src) { f32x4* xo = (f32x4*)(C.out + (size_t)m * D) + lane;
#pragma unroll
                for (int j = 0; j < 4; ++j) xo[64 * j] = vv[r][j]; }
            if (combine) { const int* slotof = (const int*)(C.ws + WS_SLOTOF); const float* gt = (const float*)(C.ws + WS_GATE); const bf16* YS = (const bf16*)(C.ws + WS_YS);
                const int s0 = slotof[2 * m], s1 = slotof[2 * m + 1]; g0v[r] = gt[2 * m]; g1v[r] = gt[2 * m + 1];
                const u32x2* y0 = (const u32x2*)(YS + (size_t)s0 * D) + lane; const u32x2* y1 = (const u32x2*)(YS + (size_t)s1 * D) + lane;
#pragma unroll
                for (int j = 0; j < 4; ++j) { ya[r][j] = y0[64 * j]; yb[r][j] = y1[64 * j]; } } } }
#pragma unroll
        for (int r = 0; r < NR; ++r) { const int m = mb + r * NGW; if (m < T) {
        f32x4* xr = (f32x4*)(C.out + (size_t)m * D) + lane;
        f32x4 v[4]; float s = 0.f;
#pragma unroll
        for (int j = 0; j < 4; ++j) v[j] = vv[r][j];
        if (combine) {
            const float g0 = g0v[r], g1 = g1v[r];
#pragma unroll
            for (int j = 0; j < 4; ++j) { const u32x2 a = ya[r][j], b = yb[r][j];
                v[j].x += g0 * bflo(a.x) + g1 * bflo(b.x); v[j].y += g0 * bfhi(a.x) + g1 * bfhi(b.x); v[j].z += g0 * bflo(a.y) + g1 * bflo(b.y); v[j].w += g0 * bfhi(a.y) + g1 * bfhi(b.y);
                xr[64 * j] = v[j]; }
        }
#pragma unroll
        for (int j = 0; j < 4; ++j) s += (v[j].x * v[j].x + v[j].y * v[j].y) + (v[j].z * v[j].z + v[j].w * v[j].w);
        const float rs = 1.0f / sqrtf(wave_sum(s, C.lane) * (1.f / D) + 1e-6f);
        unsigned long long* o8 = (unsigned long long*)(H + (size_t)m * D) + lane;
#pragma unroll
        for (int j = 0; j < 4; ++j) { v[j] = v[j] * rs * g[j]; o8[64 * j] = (unsigned long long)cvt_pk_bf16(v[j].x, v[j].y) | ((unsigned long long)cvt_pk_bf16(v[j].z, v[j].w) << 32); }
        if (route) {
            float lg[8];
#pragma unroll
            for (int e = 0; e < 8; ++e) lg[e] = 0.f;
#pragma unroll
            for (int j = 0; j < 4; ++j)
#pragma unroll
                for (int q = 0; q < 4; ++q) { const int k = 4 * (lane + 64 * j) + q; const f32x4 r0 = *(const f32x4*)(router + (size_t)k * 8), r1 = *(const f32x4*)(router + (size_t)k * 8 + 4); const float hv = v[j][q];
                    lg[0] += hv * r0.x; lg[1] += hv * r0.y; lg[2] += hv * r0.z; lg[3] += hv * r0.w; lg[4] += hv * r1.x; lg[5] += hv * r1.y; lg[6] += hv * r1.z; lg[7] += hv * r1.w; }
#pragma unroll
            for (int e = 0; e < 8; ++e) lg[e] = wave_sum(lg[e], C.lane);
            int e0 = 0; float b0 = lg[0];
#pragma unroll
            for (int e = 1; e < 8; ++e) if (lg[e] > b0) { b0 = lg[e]; e0 = e; }
            int e1 = -1; float b1 = -3.0e38f;
#pragma unroll
            for (int e = 0; e < 8; ++e) if (e != e0 && lg[e] > b1) { b1 = lg[e]; e1 = e; }
            const float p1 = __expf(b1 - b0), inv = 1.f / (1.f + p1);
            if (lane == 0) { eidx[2 * m] = e0; eidx[2 * m + 1] = e1; gate[2 * m] = inv; gate[2 * m + 1] = p1 * inv; atomicAdd((unsigned*)&lcnt[e0], 1u); atomicAdd((unsigned*)&lcnt[e1], 1u); }
        }
        } }
    }
    if (route) { __syncthreads(); if (C.tid < 8) { unsigned* cw = (unsigned*)(C.ws + WS_CTL) + CW_MOE + moe_idx * 64; atomicAdd(&cw[C.tid], lcnt[C.tid]); } }
}

__device__ __forceinline__ void ph_rw_prep_(const Ctx& C, int l) {
    const bf16* RW = (const bf16*)(C.ws + WS_RW); bf16* RKVS = (bf16*)(C.ws + WS_RKVS); bf16* AL = (bf16*)(C.ws + WS_ALORA);
    const float* mu = C.in[I_RW_MU] + (size_t)l * 1024;
    const size_t gid = (size_t)C.bid * NTHR + C.tid, gsz = (size_t)C.G * NTHR;
    constexpr int NI = 4;
    for (size_t it0 = gid; it0 < (size_t)T * 128; it0 += NI * gsz) {
        u32x4 cuv[NI], pvv[NI];
#pragma unroll
        for (int r = 0; r < NI; ++r) { const size_t it = it0 + r * gsz; cuv[r] = (u32x4){0u, 0u, 0u, 0u}; pvv[r] = cuv[r];
            if (it < (size_t)T * 128) { const int m = (int)(it >> 7), c8 = (int)(it & 127) * 8, t = m & (SEQ - 1);
                cuv[r] = *(const u32x4*)(RW + (size_t)m * 1024 + c8); if (t) pvv[r] = *(const u32x4*)(RW + (size_t)(m - 1) * 1024 + c8); } }
#pragma unroll
        for (int r = 0; r < NI; ++r) { const size_t it = it0 + r * gsz; if (it < (size_t)T * 128) {
        const int m = (int)(it >> 7), c8 = (int)(it & 127) * 8;
        float a[8], b[8]; unpack8(cuv[r], a); unpack8(pvv[r], b);
        const f32x4 m0 = *(const f32x4*)(mu + c8), m1 = *(const f32x4*)(mu + c8 + 4);
        const float mm[8] = {m0.x, m0.y, m0.z, m0.w, m1.x, m1.y, m1.z, m1.w};
#pragma unroll
        for (int e = 0; e < 8; ++e) a[e] = a[e] + (b[e] - a[e]) * mm[e];
        if (c8 < 768) { *(u32x4*)(RKVS + (size_t)m * 768 + c8) = pack8(a); }
        else {
            if (c8 < 832) {
#pragma unroll
                for (int e = 0; e < 8; ++e) a[e] = 1.f - 2.f * __builtin_amdgcn_rcpf(1.f + __builtin_amdgcn_exp2f(2.f * LOG2E * a[e]));
            } else if (c8 >= 896) {
#pragma unroll
                for (int e = 0; e < 8; ++e) a[e] = sigm(a[e]);
            }
            *(u32x4*)(AL + (size_t)m * 256 + (c8 - 768)) = pack8(a);
        } } }
    }
}

__device__ __forceinline__ void ph_sb_prep_(const Ctx& C, int l) {
    bf16* SB = (bf16*)(C.ws + WS_SB);
    const int gw = C.bid * NWAVES + C.wave, NGW = C.G * NWAVES, lane = C.lane;
    const bool isk = lane >= 32; const int d0 = (lane & 7) * 8;
    const float* gn = (isk ? C.in[I_SB_KN] : C.in[I_SB_QN]) + (size_t)l * 64 + d0;
    float gg[8];
#pragma unroll
    for (int e = 0; e < 8; ++e) gg[e] = gn[e] * (isk ? 1.f : 0.125f * LOG2E);
    constexpr int NR = 4;
    for (int mb = gw; mb < T; mb += NR * NGW) {
        u32x4 uu[NR];
#pragma unroll
        for (int r = 0; r < NR; ++r) { const int m = mb + r * NGW; uu[r] = (u32x4){0u, 0u, 0u, 0u}; if (m < T) uu[r] = *(const u32x4*)(SB + (size_t)m * 768 + lane * 8); }
#pragma unroll
        for (int r = 0; r < NR; ++r) { const int m = mb + r * NGW; if (m < T) {
            bf16* p = SB + (size_t)m * 768 + lane * 8;
            float a[8]; unpack8(uu[r], a);
            float ss = 0.f;
#pragma unroll
            for (int e = 0; e < 8; ++e) ss += a[e] * a[e];
            ss += shx(ss, 1, lane); ss += shx(ss, 2, lane); ss += shx(ss, 4, lane);
            const float rs = 1.0f / sqrtf(ss * (1.f / 64.f) + 1e-6f);
#pragma unroll
            for (int e = 0; e < 8; ++e) a[e] = a[e] * rs * gg[e];
            *(u32x4*)p = pack8(a); } }
    }
}

__device__ __forceinline__ void ph_conv_(const Ctx& C, int l) {
    const bf16* CV = (const bf16*)(C.ws + WS_CV); bf16* Y = (bf16*)(C.ws + WS_Y);
    LAS float* U = (LAS float*)(C.lds); LAS float* OC = (LAS float*)(C.lds + 65536);
    const int tid = C.tid, c = tid & 255, half = tid >> 8;
    const float* dw = C.in[I_CONV_DW] + (size_t)l * 31 * 256; const float db = C.in[I_CONV_B][l * 256 + c];
    float dwr[31];
#pragma unroll
    for (int j = 0; j < 31; ++j) dwr[j] = dw[j * 256 + c];
    const float* lnw = C.in[I_CONV_LNW] + (size_t)l * 256; const float* lnb = C.in[I_CONV_LNB] + (size_t)l * 256;
    for (int u = C.bid; u < T / 32; u += C.G) {
        const int m0 = u * 32, t0 = m0 & (SEQ - 1);
        for (int it = tid; it < 62 * 32; it += NTHR) {
            const int r = it >> 5, c8 = (it & 31) * 8, tt = t0 - 30 + r; float a[8], b[8];
            if (tt >= 0) { const size_t mm = (size_t)(m0 - 30 + r); unpack8(*(const u32x4*)(CV + mm * 512 + c8), a); unpack8(*(const u32x4*)(CV + mm * 512 + 256 + c8), b);
#pragma unroll
                for (int e = 0; e < 8; ++e) a[e] = a[e] * sigm(b[e]); }
            else {
#pragma unroll
                for (int e = 0; e < 8; ++e) a[e] = 0.f; }
#pragma unroll
            for (int e = 0; e < 8; ++e) U[r * 256 + c8 + e] = a[e];
        }
        __syncthreads();
        { float win[46];
#pragma unroll
          for (int i = 0; i < 46; ++i) win[i] = U[(half * 16 + i) * 256 + c];
#pragma unroll
          for (int tt = 0; tt < 16; ++tt) { float acc = db;
#pragma unroll
              for (int j = 0; j < 31; ++j) acc += dwr[j] * win[tt + j];
              OC[(half * 16 + tt) * 256 + c] = acc; } }
        __syncthreads();
#pragma unroll 1
        for (int q = 0; q < 4; ++q) { const int tl = C.wave * 4 + q; float v[4]; float s = 0.f;
#pragma unroll
            for (int i = 0; i < 4; ++i) { v[i] = OC[tl * 256 + C.lane + 64 * i]; s += v[i]; }
            const float mean = wave_sum(s, C.lane) * (1.f / 256.f); float s2 = 0.f;
#pragma unroll
            for (int i = 0; i < 4; ++i) { v[i] -= mean; s2 += v[i] * v[i]; }
            const float rstd = 1.0f / sqrtf(wave_sum(s2, C.lane) * (1.f / 256.f) + 1e-5f);
#pragma unroll
            for (int i = 0; i < 4; ++i) { const int cc = C.lane + 64 * i; const float y = v[i] * rstd * lnw[cc] + lnb[cc]; Y[(size_t)(m0 + tl) * 1024 + 768 + cc] = f2bf(y * sigm(y)); } }
        __syncthreads();
    }
}

__device__ __forceinline__ float ret_log2gamma(int h) { return log2f(1.0f - exp2f(-5.0f - (float)h)); }
__device__ __forceinline__ void ret_load_rot(const Ctx& C, const bf16* RET, int m0, int coff, float scale, LAS float* dst) {
    const int s = C.tid >> 3, d0 = (C.tid & 7) * 4;
    const float* cs = (const float*)(C.ws + WS_COS); const float* sn = (const float*)(C.ws + WS_SIN);
    const int pos = (m0 + s) & (SEQ - 1);
    const u32x2 a = *(const u32x2*)(RET + (size_t)(m0 + s) * 1024 + coff + d0), b = *(const u32x2*)(RET + (size_t)(m0 + s) * 1024 + coff + 32 + d0);
    const float x1[4] = {bflo(a.x), bfhi(a.x), bflo(a.y), bfhi(a.y)}, x2[4] = {bflo(b.x), bfhi(b.x), bflo(b.y), bfhi(b.y)};
    const f32x4 cv = *(const f32x4*)(cs + (size_t)pos * 32 + d0), sv = *(const f32x4*)(sn + (size_t)pos * 32 + d0);
#pragma unroll
    for (int e = 0; e < 4; ++e) { dst[s * 65 + d0 + e] = (x1[e] * cv[e] - x2[e] * sv[e]) * scale; dst[s * 65 + 32 + d0 + e] = (x1[e] * sv[e] + x2[e] * cv[e]) * scale; }
}
__device__ __forceinline__ void ph_ret_kv_(const Ctx& C) {
    const bf16* RET = (const bf16*)(C.ws + WS_RET); float* KV = (float*)(C.ws + WS_KV);
    LAS float* KD = (LAS float*)(C.lds); LAS float* VV = (LAS float*)(C.lds + 32768);
    const int tid = C.tid;
    for (int u = C.bid; u < 2048; u += C.G) {
        const int bh = u >> 8, ch = u & 255, b = bh >> 2, h = bh & 3, m0 = b * SEQ + ch * 64;
        const float lg = ret_log2gamma(h);
        ret_load_rot(C, RET, m0, 256 + h * 64, 0.125f, KD);
        { const int s = tid >> 3, e0 = (tid & 7) * 8; float a[8]; unpack8(*(const u32x4*)(RET + (size_t)(m0 + s) * 1024 + 512 + h * 64 + e0), a);
          const float dec = exp2f(lg * (float)(63 - s));
#pragma unroll
          for (int e = 0; e < 8; ++e) VV[s * 64 + e0 + e] = a[e] * dec; }
        __syncthreads();
        const int d = tid >> 3, e0 = (tid & 7) * 8; float acc[8];
#pragma unroll
        for (int e = 0; e < 8; ++e) acc[e] = 0.f;
#pragma unroll 4
        for (int s = 0; s < 64; ++s) { const float kd = KD[s * 65 + d]; const f32x4 v0 = *(const LAS f32x4*)(VV + s * 64 + e0), v1 = *(const LAS f32x4*)(VV + s * 64 + e0 + 4);
            acc[0] += kd * v0.x; acc[1] += kd * v0.y; acc[2] += kd * v0.z; acc[3] += kd * v0.w; acc[4] += kd * v1.x; acc[5] += kd * v1.y; acc[6] += kd * v1.z; acc[7] += kd * v1.w; }
        float* o = KV + (size_t)u * 4096 + d * 64 + e0;
        *(f32x4*)o = (f32x4){acc[0], acc[1], acc[2], acc[3]}; *(f32x4*)(o + 4) = (f32x4){acc[4], acc[5], acc[6], acc[7]};
        __syncthreads();
    }
}
__device__ __forceinline__ void ph_ret_scan_(const Ctx& C) {
    float* KV = (float*)(C.ws + WS_KV);
    const int wg0 = (C.G >= 256) ? 128 : 0, nw = C.G - wg0;
    for (int i = (C.bid - wg0) * NTHR + C.tid; i < 8 * 4096 && C.bid >= wg0; i += nw * NTHR) {
        const int bh = i >> 12, el = i & 4095, h = bh & 3;
        const float cd = exp2f(ret_log2gamma(h) * 64.f);
        float* p = KV + (size_t)bh * 256 * 4096 + el; float S = 0.f;
#pragma unroll 1
        for (int c = 0; c < 256; c += 32) { float kv[32];
#pragma unroll
            for (int q = 0; q < 32; ++q) kv[q] = p[(size_t)(c + q) * 4096];
#pragma unroll
            for (int q = 0; q < 32; ++q) { p[(size_t)(c + q) * 4096] = S; S = S * cd + kv[q]; } }
    }
}
__device__ __forceinline__ void ph_ret_out_(const Ctx& C, int l, int first_wg, int nwg) {
    const bf16* RET = (const bf16*)(C.ws + WS_RET); const float* KV = (const float*)(C.ws + WS_KV); bf16* Y = (bf16*)(C.ws + WS_Y);
    LAS float* Q = (LAS float*)(C.lds); LAS float* Kk = (LAS float*)(C.lds + 16640); LAS float* VV = (LAS float*)(C.lds + 33280); LAS float* SS = (LAS float*)(C.lds + 49664); LAS float* SC = (LAS float*)(C.lds + 66048);
    const int tid = C.tid; const float* gn = C.in[I_RET_GN] + (size_t)l * 256;
    for (int u = C.bid - first_wg; u < 2048; u += nwg) {
        const int bh = u >> 8, ch = u & 255, b = bh >> 2, h = bh & 3, m0 = b * SEQ + ch * 64;
        const float lg = ret_log2gamma(h);
        ret_load_rot(C, RET, m0, h * 64, 1.0f, Q);
        ret_load_rot(C, RET, m0, 256 + h * 64, 0.125f, Kk);
        { const int s = tid >> 3, e0 = (tid & 7) * 8; float a[8]; unpack8(*(const u32x4*)(RET + (size_t)(m0 + s) * 1024 + 512 + h * 64 + e0), a);
#pragma unroll
          for (int e = 0; e < 8; ++e) VV[s * 64 + e0 + e] = a[e];
          const float* sp = KV + (size_t)u * 4096 + s * 64 + e0; const f32x4 s0 = *(const f32x4*)sp, s1 = *(const f32x4*)(sp + 4);
          *(LAS f32x4*)(SS + s * 64 + e0) = s0; *(LAS f32x4*)(SS + s * 64 + e0 + 4) = s1; }
        __syncthreads();
        const int t = tid >> 3, g8 = tid & 7;
        { float sc[8];
#pragma unroll
          for (int i = 0; i < 8; ++i) sc[i] = 0.f;
#pragma unroll 4
          for (int d = 0; d < 64; ++d) { const float qv = Q[t * 65 + d];
#pragma unroll
              for (int i = 0; i < 8; ++i) sc[i] += qv * Kk[(g8 * 8 + i) * 65 + d]; }
#pragma unroll
          for (int i = 0; i < 8; ++i) { const int s = g8 * 8 + i; SC[t * 65 + s] = (s <= t) ? sc[i] * exp2f(lg * (float)(t - s)) : 0.f; } }
        __syncthreads();
        { const int e0 = g8 * 8; float o[8], o2[8];
#pragma unroll
          for (int e = 0; e < 8; ++e) { o[e] = 0.f; o2[e] = 0.f; }
#pragma unroll 4
          for (int s = 0; s < 64; ++s) { const float p = SC[t * 65 + s]; const f32x4 v0 = *(const LAS f32x4*)(VV + s * 64 + e0), v1 = *(const LAS f32x4*)(VV + s * 64 + e0 + 4);
              o[0] += p * v0.x; o[1] += p * v0.y; o[2] += p * v0.z; o[3] += p * v0.w; o[4] += p * v1.x; o[5] += p * v1.y; o[6] += p * v1.z; o[7] += p * v1.w; }
#pragma unroll 4
          for (int d = 0; d < 64; ++d) { const float qv = Q[t * 65 + d]; const f32x4 v0 = *(const LAS f32x4*)(SS + d * 64 + e0), v1 = *(const LAS f32x4*)(SS + d * 64 + e0 + 4);
              o2[0] += qv * v0.x; o2[1] += qv * v0.y; o2[2] += qv * v0.z; o2[3] += qv * v0.w; o2[4] += qv * v1.x; o2[5] += qv * v1.y; o2[6] += qv * v1.z; o2[7] += qv * v1.w; }
          const float qd = exp2f(lg * (float)(t + 1)); float s1 = 0.f;
#pragma unroll
          for (int e = 0; e < 8; ++e) { o[e] += qd * o2[e]; s1 += o[e]; }
          s1 += shx(s1, 1, C.lane); s1 += shx(s1, 2, C.lane); s1 += shx(s1, 4, C.lane);
          const float mean = s1 * (1.f / 64.f); float s2 = 0.f;
#pragma unroll
          for (int e = 0; e < 8; ++e) { o[e] -= mean; s2 += o[e] * o[e]; }
          s2 += shx(s2, 1, C.lane); s2 += shx(s2, 2, C.lane); s2 += shx(s2, 4, C.lane);
          const float rstd = 1.0f / sqrtf(s2 * (1.f / 64.f) + 1e-5f);
          float gtv[8]; unpack8(*(const u32x4*)(RET + (size_t)(m0 + t) * 1024 + 768 + h * 64 + e0), gtv);
#pragma unroll
          for (int e = 0; e < 8; ++e) o[e] = o[e] * rstd * gn[h * 64 + e0 + e] * (gtv[e] * sigm(gtv[e]));
          *(u32x4*)(Y + (size_t)(m0 + t) * 1024 + 512 + h * 64 + e0) = pack8(o); }
        __syncthreads();
    }
}

constexpr int RWC = 64, RW_NCH = SEQ / RWC, RW_NU = 8 * RW_NCH;
__device__ __forceinline__ void ph_rw_local_(const Ctx& C, int l) {
    const bf16* RKVS = (const bf16*)(C.ws + WS_RKVS); const float* WDEC = (const float*)(C.ws + WS_WDEC); const bf16* AG = (const bf16*)(C.ws + WS_AG);
    bf16* Y0 = (bf16*)(C.ws + WS_Y0); bf16* RH = (bf16*)(C.ws + WS_RHAT); float* PQ = (float*)(C.ws + WS_PQ); float* BON = (float*)(C.ws + WS_BON);
    const int lane = C.lane;
    LAS float* base = (LAS float*)(C.lds + C.wave * 12288);
    for (int it = C.bid; it < RW_NU / 8; it += C.G) {
        const int u = it * 8 + C.wave, bh = u >> 8, ch = u & 255, b = bh >> 2, h = bh & 3, m0 = b * SEQ + ch * RWC, hc = h * 64 + lane;
        const float kkw = C.in[I_RW_KK][l * 256 + hc], kaw = C.in[I_RW_KA][l * 256 + hc], rkw = C.in[I_RW_RK][l * 256 + hc], w0l = C.in[I_RW_W0][l * 256 + hc], a0l = C.in[I_RW_A0][l * 256 + hc];
        f32x2 sL[32], sI[32];
        { int ln = lane; asm volatile("" : "+v"(ln));
#pragma unroll
          for (int k = 0; k < 32; ++k) { sL[k] = (f32x2){0.f, 0.f}; sI[k].x = (2 * k == ln) ? 1.f : 0.f; sI[k].y = (2 * k + 1 == ln) ? 1.f : 0.f; } }
#pragma unroll 1
        for (int sb = 0; sb < RWC / 8; ++sb) {
            asm volatile("" ::: "memory");
#pragma unroll
            for (int i = 0; i < 8; ++i) { const size_t m = (size_t)(m0 + sb * 8 + i);
                const float r = bf2f(RKVS[m * 768 + hc]), k = bf2f(RKVS[m * 768 + 256 + hc]), v = bf2f(RKVS[m * 768 + 512 + hc]);
                const float w = __builtin_amdgcn_exp2f(-0.606531f * LOG2E * sigm(WDEC[m * 256 + hc] + w0l)), a = sigm(bf2f(AG[m * 512 + hc]) + a0l);
                const float kr = k * kkw; const float nn = sqrtf(wave_sum(kr * kr, C.lane)); const float kk = kr / fmaxf(nn, 1e-12f);
                const float kp = k * (1.f + (a - 1.f) * kaw);
                const float bon = wave_sum(r * kp * rkw, C.lane);
                if (lane == 0) BON[m * 4 + h] = bon;
                base[0 * 512 + i * 64 + lane] = w; base[1 * 512 + i * 64 + lane] = kk; base[2 * 512 + i * 64 + lane] = kk * a; base[3 * 512 + i * 64 + lane] = kp; base[4 * 512 + i * 64 + lane] = r; base[5 * 512 + i * 64 + lane] = v; }
            asm volatile("" ::: "memory");
#pragma unroll 1
            for (int i = 0; i < 8; ++i) {
                const LAS f32x4* wv = (const LAS f32x4*)(base + 0 * 512 + i * 64); const LAS f32x4* kkv = (const LAS f32x4*)(base + 1 * 512 + i * 64); const LAS f32x4* kav = (const LAS f32x4*)(base + 2 * 512 + i * 64);
                const LAS f32x4* kpv = (const LAS f32x4*)(base + 3 * 512 + i * 64); const LAS f32x4* rv = (const LAS f32x4*)(base + 4 * 512 + i * 64);
                const float vv = base[5 * 512 + i * 64 + lane];
                f32x4 kq[2][4];
#pragma unroll
                for (int t = 0; t < 4; ++t) kq[0][t] = kkv[t];
                f32x2 dL0 = (f32x2){0.f, 0.f}, dL1 = dL0, dI0 = dL0, dI1 = dL0;
                f32x4 ga[2][4];
#pragma unroll
                for (int g = 0; g < 4; ++g) {
                    __builtin_amdgcn_sched_barrier(0);
                    if (g + 1 < 4) {
#pragma unroll
                        for (int t = 0; t < 4; ++t) kq[(g + 1) & 1][t] = kkv[4 * (g + 1) + t]; }
                    else { ga[0][0] = wv[0]; ga[0][1] = kav[0]; ga[0][2] = kpv[0]; ga[0][3] = rv[0]; }
                    __builtin_amdgcn_sched_barrier(0);
#pragma unroll
                    for (int t = 0; t < 4; ++t) { const int k4 = 4 * g + t; const f32x4 q4 = kq[g & 1][t];
                        dL0 += sL[2 * k4] * q4.xy; dL1 += sL[2 * k4 + 1] * q4.zw; dI0 += sI[2 * k4] * q4.xy; dI1 += sI[2 * k4 + 1] * q4.zw; }
                }
                const float saL = -((dL0.x + dL0.y) + (dL1.x + dL1.y)), saI = -((dI0.x + dI0.y) + (dI1.x + dI1.y));
                const f32x2 saLv = (f32x2){saL, saL}, saIv = (f32x2){saI, saI}, vvv = (f32x2){vv, vv};
                f32x2 yL0 = (f32x2){0.f, 0.f}, yL1 = yL0, yI0 = yL0, yI1 = yL0;
#pragma unroll
                for (int k4 = 0; k4 < 16; ++k4) {
                    __builtin_amdgcn_sched_barrier(0);
                    if (k4 + 1 < 16) { ga[(k4 + 1) & 1][0] = wv[k4 + 1]; ga[(k4 + 1) & 1][1] = kav[k4 + 1]; ga[(k4 + 1) & 1][2] = kpv[k4 + 1]; ga[(k4 + 1) & 1][3] = rv[k4 + 1]; }
                    __builtin_amdgcn_sched_barrier(0);
                    const f32x4 wq = ga[k4 & 1][0], aq = ga[k4 & 1][1], pq = ga[k4 & 1][2], rq = ga[k4 & 1][3];
                    sL[2 * k4]     = sL[2 * k4]     * wq.xy + saLv * aq.xy + vvv * pq.xy; yL0 += sL[2 * k4]     * rq.xy;
                    sL[2 * k4 + 1] = sL[2 * k4 + 1] * wq.zw + saLv * aq.zw + vvv * pq.zw; yL1 += sL[2 * k4 + 1] * rq.zw;
                    sI[2 * k4]     = sI[2 * k4]     * wq.xy + saIv * aq.xy;                  yI0 += sI[2 * k4]     * rq.xy;
                    sI[2 * k4 + 1] = sI[2 * k4 + 1] * wq.zw + saIv * aq.zw;                  yI1 += sI[2 * k4 + 1] * rq.zw;
                }
                __builtin_amdgcn_sched_barrier(0);
                const size_t m = (size_t)(m0 + sb * 8 + i);
                Y0[m * 256 + hc] = f2bf((yL0.x + yL0.y) + (yL1.x + yL1.y));
                RH[m * 256 + hc] = f2bf((yI0.x + yI0.y) + (yI1.x + yI1.y));
            }
        }
        float* oq = PQ + (size_t)u * 4096 + lane * 64; float* opt = PQ + ((size_t)RW_NU + u) * 4096 + lane;
#pragma unroll
        for (int k4 = 0; k4 < 16; ++k4) { *(f32x4*)(oq + 4 * k4) = (f32x4){sL[2 * k4].x, sL[2 * k4].y, sL[2 * k4 + 1].x, sL[2 * k4 + 1].y};
            opt[(4 * k4) * 64] = sI[2 * k4].x; opt[(4 * k4 + 1) * 64] = sI[2 * k4].y; opt[(4 * k4 + 2) * 64] = sI[2 * k4 + 1].x; opt[(4 * k4 + 3) * 64] = sI[2 * k4 + 1].y; }
    }
}
__device__ __forceinline__ void ph_rw_scan_(const Ctx& C, int wg) {
    const float* Qg = (const float*)(C.ws + WS_PQ); const float* Pg = Qg + (size_t)RW_NU * 4096; float* SST = (float*)(C.ws + WS_SST);
    LAS bf16* PT = (LAS bf16*)(C.lds);
    LAS bf16* SLb = PT + 2 * 64 * MM_LP;
    LAS float* QL = (LAS float*)(C.lds + (2 * 64 * MM_LP + 2 * 16 * MM_LP) * 2);
    LAS float* SO = QL + 2 * 16 * 64;
    const int lane = C.lane, wave = C.wave, bh = wg >> 2, rq = wg & 3, ct = wave & 3, li = lane & 15, lq = lane >> 4;
    const bool mm = wave < 4;
    const size_t ubase = (size_t)bh * RW_NCH;
    const int lt = C.tid & 255;
    const int qrow = lt >> 4, qc4 = (lt & 15) * 4;
    constexpr int PD = 6;
    f32x4 pr[PD][4], qr[PD];
#define SC_P_PIECE(i) (lt + 256 * (i))
#define SC_PUT_P(buf, sx_) do { LAS bf16* d_ = PT + (buf) * (64 * MM_LP); _Pragma("unroll") for (int i_ = 0; i_ < 4; ++i_) { const int idx_ = SC_P_PIECE(i_), r_ = (idx_ * 4) >> 6, k_ = (idx_ * 4) & 63; u32x2 w_; \
        w_.x = cvt_pk_bf16(pr[sx_][i_].x, pr[sx_][i_].y); w_.y = cvt_pk_bf16(pr[sx_][i_].z, pr[sx_][i_].w); *(LAS u32x2*)(d_ + r_ * MM_LP + k_) = w_; } } while (0)
#define SC_LOAD(sx_, cc) do { const f32x4* p4_ = (const f32x4*)(Pg + (ubase + (cc)) * 4096); _Pragma("unroll") for (int i_ = 0; i_ < 4; ++i_) pr[sx_][i_] = p4_[SC_P_PIECE(i_)]; \
        qr[sx_] = *(const f32x4*)(Qg + (ubase + (cc)) * 4096 + (rq * 16 + qrow) * 64 + qc4); } while (0)
    if (mm) {
#pragma unroll
        for (int r = 0; r < 4; ++r) SLb[(4 * lq + r) * MM_LP + ct * 16 + li] = (bf16)0;
    } else {
        *(f32x4*)(SST + ubase * 4096 + (rq * 16 + qrow) * 64 + qc4) = (f32x4){0.f, 0.f, 0.f, 0.f};
        SC_LOAD(0, 0); SC_PUT_P(0, 0); *(LAS f32x4*)(QL + qrow * 64 + qc4) = qr[0];
#pragma unroll
        for (int x = 0; x < PD; ++x) SC_LOAD(x, 1 + x);
    }
    __syncthreads();
#pragma unroll 1
    for (int c2 = 0; c2 < RW_NCH; c2 += PD) {
#pragma unroll
        for (int x = 0; x < PD; ++x) {
            const int c = c2 + x;
            if (c < RW_NCH) {
            if (mm) {
                const LAS bf16* Pc = PT + (c & 1) * (64 * MM_LP); const LAS bf16* Sc = SLb + (c & 1) * (16 * MM_LP); const LAS float* Qc = QL + (c & 1) * (16 * 64);
                LAS bf16* Sn = SLb + ((c + 1) & 1) * (16 * MM_LP); LAS float* So = SO + ((c + 1) & 1) * (16 * 64);
                bf16x8 af[2], bfr[2];
#pragma unroll
                for (int ks = 0; ks < 2; ++ks) { af[ks] = *(const LAS bf16x8*)(Sc + li * MM_LP + 32 * ks + 8 * lq); bfr[ks] = *(const LAS bf16x8*)(Pc + (16 * ct + li) * MM_LP + 32 * ks + 8 * lq); }
                f32x4 acc;
#pragma unroll
                for (int r = 0; r < 4; ++r) acc[r] = Qc[(4 * lq + r) * 64 + ct * 16 + li];
#pragma unroll
                for (int ks = 0; ks < 2; ++ks) acc = __builtin_amdgcn_mfma_f32_16x16x32_bf16(af[ks], bfr[ks], acc, 0, 0, 0);
                if (c + 1 < RW_NCH) {
#pragma unroll
                    for (int r = 0; r < 4; ++r) { Sn[(4 * lq + r) * MM_LP + ct * 16 + li] = f2bf(acc[r]); So[(4 * lq + r) * 64 + ct * 16 + li] = acc[r]; } }
            } else {
                if (c > 0) *(f32x4*)(SST + (ubase + c) * 4096 + (rq * 16 + qrow) * 64 + qc4) = *(const LAS f32x4*)(SO + (c & 1) * (16 * 64) + qrow * 64 + qc4);
                if (c + 1 < RW_NCH) { SC_PUT_P((c + 1) & 1, x); *(LAS f32x4*)(QL + ((c + 1) & 1) * (16 * 64) + qrow * 64 + qc4) = qr[x]; }
                if (c + 1 + PD < RW_NCH) SC_LOAD(x, c + 1 + PD);
            }
            __syncthreads();
#ifdef SCAN_2BAR
            __syncthreads();
#endif
            }
        }
    }
#undef SC_PUT_P
#undef SC_LOAD
#undef SC_P_PIECE
}
__device__ __forceinline__ void ph_rw_out_(const Ctx& C, int l) {
    const bf16* RKVS = (const bf16*)(C.ws + WS_RKVS); const bf16* AG = (const bf16*)(C.ws + WS_AG); const bf16* Y0 = (const bf16*)(C.ws + WS_Y0); const bf16* RH = (const bf16*)(C.ws + WS_RHAT);
    const float* SST = (const float*)(C.ws + WS_SST); const float* BON = (const float*)(C.ws + WS_BON); bf16* Y = (bf16*)(C.ws + WS_Y);
    LAS float* RL = (LAS float*)(C.lds);
    const int lane = C.lane, wave = C.wave;
    for (int u = C.bid; u < RW_NU; u += C.G) {
        const int bh = u >> 8, ch = u & 255, b = bh >> 2, h = bh & 3, m0 = b * SEQ + ch * RWC, hc = h * 64 + lane;
        { const int t = C.tid >> 3, d0 = (C.tid & 7) * 8; float a[8];
          unpack8(*(const u32x4*)(RH + (size_t)(m0 + t) * 256 + h * 64 + d0), a);
#pragma unroll
          for (int e = 0; e < 8; ++e) RL[t * 64 + d0 + e] = a[e]; }
        float s[64];
        { const f32x4* sp = (const f32x4*)(SST + (size_t)u * 4096 + lane * 64);
#pragma unroll
          for (int k4 = 0; k4 < 16; ++k4) { const f32x4 v = sp[k4]; s[4 * k4] = v.x; s[4 * k4 + 1] = v.y; s[4 * k4 + 2] = v.z; s[4 * k4 + 3] = v.w; } }
        const float lnw = C.in[I_RW_LNW][l * 256 + hc], lnb = C.in[I_RW_LNB][l * 256 + hc];
        __syncthreads();
#pragma unroll 2
        for (int q = 0; q < 8; ++q) { const int t = wave * 8 + q; const size_t m = (size_t)(m0 + t);
            const LAS f32x4* rv = (const LAS f32x4*)(RL + t * 64);
            float y0 = 0.f, y1 = 0.f, y2 = 0.f, y3 = 0.f;
#pragma unroll
            for (int k4 = 0; k4 < 16; ++k4) { const f32x4 rq = rv[k4]; y0 += s[4 * k4] * rq.x; y1 += s[4 * k4 + 1] * rq.y; y2 += s[4 * k4 + 2] * rq.z; y3 += s[4 * k4 + 3] * rq.w; }
#ifndef RWDBG
#define RWDBG 0
#endif
            float y = ((RWDBG & 1) ? 0.f : (y0 + y1) + (y2 + y3)) + ((RWDBG & 2) ? 0.f : bf2f(Y0[m * 256 + hc]));
            const float mean = wave_sum(y, C.lane) * (1.f / 64.f); y -= mean;
            const float rstd = 1.0f / sqrtf(wave_sum(y * y, C.lane) * (1.f / 64.f) + 64e-5f);
            y = y * rstd * lnw + lnb;
            if (!(RWDBG & 4)) y += BON[m * 4 + h] * bf2f(RKVS[m * 768 + 512 + hc]);
            y *= bf2f(AG[m * 512 + 256 + hc]);
            if (RWDBG & 120) { y = 0.f; if (RWDBG & 8) y += ((const float*)(C.ws + WS_WDEC))[m * 256 + hc]; if (RWDBG & 16) y += bf2f(AG[m * 512 + hc]);
                if (RWDBG & 32) y += bf2f(RKVS[m * 768 + hc]) + bf2f(RKVS[m * 768 + 256 + hc]) + bf2f(RKVS[m * 768 + 512 + hc]); if (RWDBG & 64) y += BON[m * 4 + h]; }
            Y[m * 1024 + hc] = f2bf(y); }
        __syncthreads();
    }
}

constexpr int SB_VLD = 40;
__device__ __forceinline__ void ph_sb_attn_(const Ctx& C, int first_wg, int nwg) {
    const bf16* SB = (const bf16*)(C.ws + WS_SB); bf16* Y = (bf16*)(C.ws + WS_Y);
    const int lane = C.lane, j = lane & 31, hi = lane >> 5;
    LAS bf16* VT = (LAS bf16*)(C.lds + C.wave * (64 * SB_VLD * 2));
    for (int it = C.bid - first_wg; it < 512; it += nwg) {
        const int bh = it >> 6, b = bh >> 2, h = bh & 3, t0 = (it & 63) * 256 + C.wave * 32; const size_t mb = (size_t)b * SEQ;
        bf16x8 qf[4];
#pragma unroll
        for (int ks = 0; ks < 4; ++ks) qf[ks] = *(const bf16x8*)(SB + (mb + t0 + j) * 768 + h * 64 + 16 * ks + 8 * hi);
        f32x16 o0, o1;
#pragma unroll
        for (int i = 0; i < 16; ++i) { o0[i] = 0.f; o1[i] = 0.f; }
        float acc = 0.f;
#pragma unroll 1
        for (int kt = t0; kt >= 0; kt -= 32) {
            bf16x8 kf[4];
#pragma unroll
            for (int ks = 0; ks < 4; ++ks) kf[ks] = *(const bf16x8*)(SB + (mb + kt + j) * 768 + 256 + h * 64 + 16 * ks + 8 * hi);
            u32x4 vv[4];
#pragma unroll
            for (int i = 0; i < 4; ++i) { const int c = lane + 64 * i; vv[i] = *(const u32x4*)(SB + (mb + kt + (c >> 3)) * 768 + 512 + h * 64 + (c & 7) * 8); }
            f32x16 sc;
#pragma unroll
            for (int i = 0; i < 16; ++i) sc[i] = 0.f;
#pragma unroll
            for (int ks = 0; ks < 4; ++ks) sc = __builtin_amdgcn_mfma_f32_32x32x16_bf16(kf[ks], qf[ks], sc, 0, 0, 0);
#pragma unroll
            for (int i = 0; i < 4; ++i) { const int c = lane + 64 * i, key = c >> 3, d8 = (c & 7) * 8; const unsigned w[4] = {vv[i].x, vv[i].y, vv[i].z, vv[i].w};
#pragma unroll
                for (int e = 0; e < 4; ++e) { VT[(d8 + 2 * e) * SB_VLD + key] = (bf16)(w[e] & 0xffffu); VT[(d8 + 2 * e + 1) * SB_VLD + key] = (bf16)(w[e] >> 16); } }
            const bool diag = (kt == t0);
            float ls[16], g[4], og[4];
#pragma unroll
            for (int r = 0; r < 4; ++r) { g[r] = 0.f;
#pragma unroll
                for (int e = 0; e < 4; ++e) { const float z = sc[4 * r + e]; const bool valid = !diag || (8 * r + 4 * hi + e) < j;
                    const float l = (z > 40.f) ? -z : -__builtin_amdgcn_logf(1.f + __builtin_amdgcn_exp2f(z));
                    ls[4 * r + e] = valid ? l : 0.f; g[r] += ls[4 * r + e]; } }
#pragma unroll
            for (int r = 0; r < 4; ++r) og[r] = shx(g[r], 32, lane);
            float pw[16]; float run = acc;
#pragma unroll
            for (int r = 3; r >= 0; --r) { float cum = run + (hi == 0 ? og[r] : 0.f);
#pragma unroll
                for (int e = 3; e >= 0; --e) { cum += ls[4 * r + e]; const bool valid = !diag || (8 * r + 4 * hi + e) < j;
                    pw[4 * r + e] = valid ? __builtin_amdgcn_exp2f(sc[4 * r + e] + cum) : 0.f; }
                run += g[r] + og[r]; }
            acc = run;
            asm volatile("" ::: "memory");
#pragma unroll
            for (int ks = 0; ks < 2; ++ks) {
                u32x4 pk; pk.x = cvt_pk_bf16(pw[8 * ks], pw[8 * ks + 1]); pk.y = cvt_pk_bf16(pw[8 * ks + 2], pw[8 * ks + 3]); pk.z = cvt_pk_bf16(pw[8 * ks + 4], pw[8 * ks + 5]); pk.w = cvt_pk_bf16(pw[8 * ks + 6], pw[8 * ks + 7]);
                const bf16x8 pb = __builtin_bit_cast(bf16x8, pk);
                const s16x4 a0l = *(const LAS s16x4*)(VT + j * SB_VLD + 16 * ks + 4 * hi), a0h = *(const LAS s16x4*)(VT + j * SB_VLD + 16 * ks + 8 + 4 * hi);
                const s16x4 a1l = *(const LAS s16x4*)(VT + (32 + j) * SB_VLD + 16 * ks + 4 * hi), a1h = *(const LAS s16x4*)(VT + (32 + j) * SB_VLD + 16 * ks + 8 + 4 * hi);
                const bf16x8 va0 = __builtin_shufflevector(a0l, a0h, 0, 1, 2, 3, 4, 5, 6, 7), va1 = __builtin_shufflevector(a1l, a1h, 0, 1, 2, 3, 4, 5, 6, 7);
                o0 = __builtin_amdgcn_mfma_f32_32x32x16_bf16(va0, pb, o0, 0, 0, 0);
                o1 = __builtin_amdgcn_mfma_f32_32x32x16_bf16(va1, pb, o1, 0, 0, 0);
            }
            asm volatile("" ::: "memory");
            if (__builtin_amdgcn_ballot_w64(acc > -140.f) == 0ull) break;
        }
        bf16* yp = Y + (mb + t0 + j) * 1024 + 256 + h * 64 + 4 * hi;
#pragma unroll
        for (int r = 0; r < 4; ++r) { u32x2 w0, w1; w0.x = cvt_pk_bf16(o0[4 * r], o0[4 * r + 1]); w0.y = cvt_pk_bf16(o0[4 * r + 2], o0[4 * r + 3]); w1.x = cvt_pk_bf16(o1[4 * r], o1[4 * r + 1]); w1.y = cvt_pk_bf16(o1[4 * r + 2], o1[4 * r + 3]);
            *(u32x2*)(yp + 8 * r) = w0; *(u32x2*)(yp + 32 + 8 * r) = w1; }
    }
}


__device__ __forceinline__ f32x16 mm_tile(const LAS bf16* X, const LAS bf16* Y, int ti, int tj, int lane) {
    const int j = lane & 31, hi = lane >> 5; f32x16 acc;
#pragma unroll
    for (int i = 0; i < 16; ++i) acc[i] = 0.f;
#pragma unroll
    for (int ks = 0; ks < 4; ++ks) { const bf16x8 a = *(const LAS bf16x8*)(X + (32 * ti + j) * MM_LP + 16 * ks + 8 * hi), b = *(const LAS bf16x8*)(Y + (32 * tj + j) * MM_LP + 16 * ks + 8 * hi);
        acc = __builtin_amdgcn_mfma_f32_32x32x16_bf16(a, b, acc, 0, 0, 0); }
    return acc;
}
__device__ __forceinline__ void ln_pair_stats(const f32x16& x, LAS float* XCH, int tr, int tt, int lane, float eps, float& mean, float& rstd) {
    const int j = lane & 31, hi = lane >> 5; float s1 = 0.f, s2 = 0.f;
#pragma unroll
    for (int i = 0; i < 16; ++i) { s1 += x[i]; s2 += x[i] * x[i]; }
    s1 += shx(s1, 32, lane); s2 += shx(s2, 32, lane);
    if (hi == 0) { XCH[(tr * 64 + 32 * tt + j) * 2] = s1; XCH[(tr * 64 + 32 * tt + j) * 2 + 1] = s2; }
    __syncthreads();
    const float a1 = XCH[(32 * tt + j) * 2] + XCH[(64 + 32 * tt + j) * 2], a2 = XCH[(32 * tt + j) * 2 + 1] + XCH[(64 + 32 * tt + j) * 2 + 1];
    mean = a1 * (1.f / 64.f); const float var = fmaxf(a2 * (1.f / 64.f) - mean * mean, 0.f); rstd = 1.0f / sqrtf(var + eps);
}
__device__ __forceinline__ void rot_store(const Ctx& C, const bf16* src  , int pos, int d0, float scale, LAS bf16* dstrow) {
    const float* cs = (const float*)(C.ws + WS_COS) + (size_t)pos * 32 + d0; const float* sn = (const float*)(C.ws + WS_SIN) + (size_t)pos * 32 + d0;
    float x1[8], x2[8]; unpack8(*(const u32x4*)(src + d0), x1); unpack8(*(const u32x4*)(src + 32 + d0), x2);
    const f32x4 c0 = *(const f32x4*)cs, c1 = *(const f32x4*)(cs + 4), s0 = *(const f32x4*)sn, s1 = *(const f32x4*)(sn + 4);
    const float cc[8] = {c0.x, c0.y, c0.z, c0.w, c1.x, c1.y, c1.z, c1.w}, ss[8] = {s0.x, s0.y, s0.z, s0.w, s1.x, s1.y, s1.z, s1.w};
    float o1[8], o2[8];
#pragma unroll
    for (int e = 0; e < 8; ++e) { o1[e] = (x1[e] * cc[e] - x2[e] * ss[e]) * scale; o2[e] = (x1[e] * ss[e] + x2[e] * cc[e]) * scale; }
    *(LAS u32x4*)(dstrow + d0) = pack8(o1); *(LAS u32x4*)(dstrow + 32 + d0) = pack8(o2);
}

__device__ __forceinline__ void ph_ret_kv2_(const Ctx& C) {
    const bf16* RET = (const bf16*)(C.ws + WS_RET); float* KV = (float*)(C.ws + WS_KV);
    const int half = C.wave >> 2, w4 = C.wave & 3, th = C.tid & 255, lane = C.lane;
    LAS bf16* KT = (LAS bf16*)(C.lds + half * 36864);
    LAS bf16* VT = KT + 64 * MM_LP;
    LAS bf16* KR = VT + 64 * MM_LP;
    for (int it = C.bid; it < 1024; it += C.G) {
        const int u = it * 2 + half, bh = u >> 8, ch = u & 255, b = bh >> 2, h = bh & 3, m0 = b * SEQ + ch * 64;
        const float lg = ret_log2gamma(h);
        { const int srow = th >> 2, dq = th & 3; const size_t m = (size_t)(m0 + srow);
          rot_store(C, RET + m * 1024 + 256 + h * 64, (int)(m & (SEQ - 1)), dq * 8, 0.125f * exp2f(lg * (float)(63 - srow)), KR + srow * MM_LP);
          float a[8];
#pragma unroll
          for (int q = 0; q < 2; ++q) { const int e0 = dq * 16 + q * 8; unpack8(*(const u32x4*)(RET + m * 1024 + 512 + h * 64 + e0), a);
#pragma unroll
              for (int e = 0; e < 8; ++e) VT[(e0 + e) * MM_LP + srow] = f2bf(a[e]); } }
        __syncthreads();
        { const int d = th >> 2, s0 = (th & 3) * 16;
#pragma unroll
          for (int i = 0; i < 16; ++i) KT[d * MM_LP + s0 + i] = KR[(s0 + i) * MM_LP + d]; }
        __syncthreads();
        { const int ti = w4 >> 1, tj = w4 & 1, j = lane & 31, hi = lane >> 5;
          const f32x16 acc = mm_tile(VT, KT, ti, tj, lane);
          float* o = KV + (size_t)u * 4096 + (size_t)(32 * ti + 4 * hi) * 64 + 32 * tj + j;
#pragma unroll
          for (int r = 0; r < 4; ++r)
#pragma unroll
              for (int e = 0; e < 4; ++e) o[(8 * r + e) * 64] = acc[4 * r + e]; }
        __syncthreads();
    }
}
__device__ __forceinline__ void ph_ret_out2_(const Ctx& C, int l, int first_wg, int nwg) {
    const bf16* RET = (const bf16*)(C.ws + WS_RET); const float* KV = (const float*)(C.ws + WS_KV); bf16* Y = (bf16*)(C.ws + WS_Y);
    const int half = C.wave >> 2, w4 = C.wave & 3, th = C.tid & 255, lane = C.lane, j = lane & 31, hi = lane >> 5, te = w4 >> 1, tt = w4 & 1;
    LAS bf16* QL = (LAS bf16*)(C.lds + half * 40960);
    LAS bf16* KL = QL + 64 * MM_LP;
    LAS bf16* VT = KL + 64 * MM_LP;
    LAS bf16* ST = VT + 64 * MM_LP;
    LAS float* XCH = (LAS float*)(C.lds + half * 40960 + 4 * 64 * MM_LP * 2);
    const float* gn = C.in[I_RET_GN] + (size_t)l * 256;
    for (int it = C.bid - first_wg; it < 1024; it += nwg) {
        const int u = it * 2 + half, bh = u >> 8, ch = u & 255, b = bh >> 2, h = bh & 3, m0 = b * SEQ + ch * 64;
        const float lg = ret_log2gamma(h);
        { const int srow = th >> 2, dq = th & 3; const size_t m = (size_t)(m0 + srow); const int pos = (int)(m & (SEQ - 1));
          rot_store(C, RET + m * 1024 + h * 64, pos, dq * 8, 1.0f, QL + srow * MM_LP);
          rot_store(C, RET + m * 1024 + 256 + h * 64, pos, dq * 8, 0.125f, KL + srow * MM_LP);
          float a[8];
#pragma unroll
          for (int q = 0; q < 2; ++q) { const int e0 = dq * 16 + q * 8; unpack8(*(const u32x4*)(RET + m * 1024 + 512 + h * 64 + e0), a);
#pragma unroll
              for (int e = 0; e < 8; ++e) VT[(e0 + e) * MM_LP + srow] = f2bf(a[e]); }
          const float* sp = KV + (size_t)u * 4096 + srow * 64 + dq * 16;
          float sv[16];
#pragma unroll
          for (int q = 0; q < 4; ++q) { const f32x4 v4 = *(const f32x4*)(sp + 4 * q); sv[4 * q] = v4.x; sv[4 * q + 1] = v4.y; sv[4 * q + 2] = v4.z; sv[4 * q + 3] = v4.w; }
          *(LAS u32x4*)(ST + srow * MM_LP + dq * 16) = pack8(sv); *(LAS u32x4*)(ST + srow * MM_LP + dq * 16 + 8) = pack8(sv + 8); }
        __syncthreads();
        f32x16 acc = mm_tile(ST, QL, te, tt, lane);
        { const float qd = exp2f(lg * (float)(32 * tt + j + 1));
#pragma unroll
          for (int i = 0; i < 16; ++i) acc[i] *= qd; }
#pragma unroll
        for (int st = 0; st < 2; ++st) {
            if (st > tt) continue;
            const f32x16 sc = mm_tile(KL, QL, st, tt, lane);
            float pw[16];
#pragma unroll
            for (int r = 0; r < 4; ++r)
#pragma unroll
                for (int e = 0; e < 4; ++e) { const int sk = 32 * st + 8 * r + 4 * hi + e, tq = 32 * tt + j;
                    pw[4 * r + e] = (sk <= tq) ? sc[4 * r + e] * exp2f(lg * (float)(tq - sk)) : 0.f; }
#pragma unroll
            for (int ks = 0; ks < 2; ++ks) {
                u32x4 pk; pk.x = cvt_pk_bf16(pw[8 * ks], pw[8 * ks + 1]); pk.y = cvt_pk_bf16(pw[8 * ks + 2], pw[8 * ks + 3]); pk.z = cvt_pk_bf16(pw[8 * ks + 4], pw[8 * ks + 5]); pk.w = cvt_pk_bf16(pw[8 * ks + 6], pw[8 * ks + 7]);
                const bf16x8 pb = __builtin_bit_cast(bf16x8, pk);
                const LAS bf16* vr = VT + (32 * te + j) * MM_LP + 32 * st + 16 * ks + 4 * hi;
                const s16x4 al = *(const LAS s16x4*)vr, ah = *(const LAS s16x4*)(vr + 8);
                const bf16x8 va = __builtin_shufflevector(al, ah, 0, 1, 2, 3, 4, 5, 6, 7);
                acc = __builtin_amdgcn_mfma_f32_32x32x16_bf16(va, pb, acc, 0, 0, 0);
            }
        }
        float mean, rstd; ln_pair_stats(acc, XCH, te, tt, lane, 1e-5f, mean, rstd);
        { const size_t m = (size_t)(m0 + 32 * tt + j); const bf16* gp = RET + m * 1024 + 768 + h * 64 + 32 * te + 4 * hi; bf16* yp = Y + m * 1024 + 512 + h * 64 + 32 * te + 4 * hi;
          const float* gw = gn + h * 64 + 32 * te + 4 * hi;
#pragma unroll
          for (int r = 0; r < 4; ++r) { const u32x2 gt2 = *(const u32x2*)(gp + 8 * r); const float gtv[4] = {bflo(gt2.x), bfhi(gt2.x), bflo(gt2.y), bfhi(gt2.y)}; const f32x4 gwv = *(const f32x4*)(gw + 8 * r);
              float o[4];
#pragma unroll
              for (int e = 0; e < 4; ++e) o[e] = (acc[4 * r + e] - mean) * rstd * gwv[e] * (gtv[e] * sigm(gtv[e]));
              u32x2 w; w.x = cvt_pk_bf16(o[0], o[1]); w.y = cvt_pk_bf16(o[2], o[3]); *(u32x2*)(yp + 8 * r) = w; } }
        __syncthreads();
    }
}
__device__ __forceinline__ void ph_rw_out2_(const Ctx& C, int l) {
    const bf16* RKVS = (const bf16*)(C.ws + WS_RKVS); const bf16* AG = (const bf16*)(C.ws + WS_AG); const bf16* Y0 = (const bf16*)(C.ws + WS_Y0); const bf16* RH = (const bf16*)(C.ws + WS_RHAT);
    const float* SST = (const float*)(C.ws + WS_SST); const float* BON = (const float*)(C.ws + WS_BON); bf16* Y = (bf16*)(C.ws + WS_Y);
    const int half = C.wave >> 2, w4 = C.wave & 3, th = C.tid & 255, lane = C.lane, j = lane & 31, hi = lane >> 5, tv = w4 >> 1, tt = w4 & 1;
    LAS bf16* SL = (LAS bf16*)(C.lds + half * 20480);
    LAS bf16* RL = SL + 64 * MM_LP;
    LAS float* XCH = (LAS float*)(C.lds + half * 20480 + 2 * 64 * MM_LP * 2);
    for (int it = C.bid; it < RW_NU / 2; it += C.G) {
        const int u = it * 2 + half, bh = u >> 8, ch = u & 255, b = bh >> 2, h = bh & 3, m0 = b * SEQ + ch * RWC;
        { const int row = th >> 2, q4 = th & 3;
          const float* sp = SST + (size_t)u * 4096 + row * 64 + q4 * 16; float sv[16];
#pragma unroll
          for (int q = 0; q < 4; ++q) { const f32x4 v4 = *(const f32x4*)(sp + 4 * q); sv[4 * q] = v4.x; sv[4 * q + 1] = v4.y; sv[4 * q + 2] = v4.z; sv[4 * q + 3] = v4.w; }
          *(LAS u32x4*)(SL + row * MM_LP + q4 * 16) = pack8(sv); *(LAS u32x4*)(SL + row * MM_LP + q4 * 16 + 8) = pack8(sv + 8);
          const u32x4* rp = (const u32x4*)(RH + (size_t)(m0 + row) * 256 + h * 64 + q4 * 16);
          *(LAS u32x4*)(RL + row * MM_LP + q4 * 16) = rp[0]; *(LAS u32x4*)(RL + row * MM_LP + q4 * 16 + 8) = rp[1]; }
        __syncthreads();
        f32x16 acc = mm_tile(SL, RL, tv, tt, lane);
        const size_t m = (size_t)(m0 + 32 * tt + j); const int vb = h * 64 + 32 * tv + 4 * hi;
#pragma unroll
        for (int r = 0; r < 4; ++r) { const u32x2 y2 = *(const u32x2*)(Y0 + m * 256 + vb + 8 * r); acc[4 * r] += bflo(y2.x); acc[4 * r + 1] += bfhi(y2.x); acc[4 * r + 2] += bflo(y2.y); acc[4 * r + 3] += bfhi(y2.y); }
        float mean, rstd; ln_pair_stats(acc, XCH, tv, tt, lane, 64e-5f, mean, rstd);
        const float bon = BON[m * 4 + h];
#pragma unroll
        for (int r = 0; r < 4; ++r) { const int vc = vb + 8 * r;
            const f32x4 lw = *(const f32x4*)(C.in[I_RW_LNW] + (size_t)l * 256 + vc), lb = *(const f32x4*)(C.in[I_RW_LNB] + (size_t)l * 256 + vc);
            const u32x2 v2 = *(const u32x2*)(RKVS + m * 768 + 512 + vc), g2 = *(const u32x2*)(AG + m * 512 + 256 + vc);
            const float vv[4] = {bflo(v2.x), bfhi(v2.x), bflo(v2.y), bfhi(v2.y)}, gg[4] = {bflo(g2.x), bfhi(g2.x), bflo(g2.y), bfhi(g2.y)};
            float o[4];
#pragma unroll
            for (int e = 0; e < 4; ++e) o[e] = ((acc[4 * r + e] - mean) * rstd * lw[e] + lb[e] + bon * vv[e]) * gg[e];
            u32x2 w; w.x = cvt_pk_bf16(o[0], o[1]); w.y = cvt_pk_bf16(o[2], o[3]); *(u32x2*)(Y + m * 1024 + vc) = w; }
        __syncthreads();
    }
}

__device__ __forceinline__ void ph_moe_scatter_(const Ctx& C, int moe_idx) {
    unsigned* cw = (unsigned*)(C.ws + WS_CTL) + CW_MOE + moe_idx * 64;
    const int* eidx = (const int*)(C.ws + WS_EIDX); const float* gate = (const float*)(C.ws + WS_GATE);
    int* rowtok = (int*)(C.ws + WS_ROWTOK); float* rowgate = (float*)(C.ws + WS_ROWGATE); int* texp = (int*)(C.ws + WS_TEXP); int* segend = (int*)(C.ws + WS_SEGEND); int* ntp = (int*)(C.ws + WS_NT);
    const bf16* H = (const bf16*)(C.ws + WS_H); bf16* XS = (bf16*)(C.ws + WS_XS);
    LAS unsigned* lcnt = (LAS unsigned*)(C.lds); LAS unsigned* lbase = lcnt + 8; LAS int* sl = (LAS int*)(C.lds + 256);
    int cnt[8], segb[8]; int tot = 0;
#pragma unroll
    for (int e = 0; e < 8; ++e) { cnt[e] = (int)__hip_atomic_load(&cw[e], __ATOMIC_RELAXED, __HIP_MEMORY_SCOPE_AGENT); segb[e] = tot; tot += (cnt[e] + 255) & ~255; }
    if (C.bid == 0) {
        if (C.tid < 8) { const int e = C.tid; int sb = 0, ce = 0;
#pragma unroll
            for (int q = 0; q < 8; ++q) if (q == e) { sb = segb[q]; ce = cnt[q]; }
            for (int pm = sb >> 8; pm < ((sb + ((ce + 255) & ~255)) >> 8); ++pm) { texp[pm] = e; segend[pm] = sb + ce; } }
        if (C.tid == 0) *ntp = tot >> 8;
    }
    for (int blk = C.bid; blk < T / 256; blk += C.G) {
        __syncthreads();
        if (C.tid < 8) lcnt[C.tid] = 0u;
        __syncthreads();
        const int a = blk * 512 + C.tid, e = eidx[a];
        const unsigned rank = atomicAdd((unsigned*)&lcnt[e], 1u);
        __syncthreads();
        if (C.tid < 8) lbase[C.tid] = atomicAdd(&cw[16 + C.tid], lcnt[C.tid]);
        __syncthreads();
        int sb = 0;
#pragma unroll
        for (int q = 0; q < 8; ++q) if (q == e) sb = segb[q];
        const int slot = sb + (int)lbase[e] + (int)rank;
        rowtok[slot] = a >> 1; rowgate[slot] = gate[a]; sl[C.tid] = slot; ((int*)(C.ws + WS_SLOTOF))[a] = slot;
        __syncthreads();
        for (int i = C.wave; i < 512; i += NWAVES) { const int s2 = sl[i]; const u32x4* src = (const u32x4*)(H + (size_t)(blk * 256 + (i >> 1)) * D); u32x4* dst = (u32x4*)(XS + (size_t)s2 * D);
            dst[C.lane] = src[C.lane]; dst[C.lane + 64] = src[C.lane + 64]; }
    }
}

__device__ __forceinline__ void grid_barrier(int wv) {
    const Ctx C = make_ctx(wv);
    XcdBarrier b; b.bar = (unsigned*)(C.ws + WS_CTL) + CW_BAR; b.x = xb_xcc_id(); b.st = (volatile LAS unsigned*)(C.lds + MISC_OFF) + 8;
    xcd_barrier(b, C.tid);
}
__device__ __forceinline__ void P_prologue(int wv) { const Ctx C = make_ctx(wv); ph_prologue_(C); }
__device__ __forceinline__ void P_weights_norm(int wv, int l) { const Ctx C = make_ctx(wv); ph_weights_(C, l, 0, 0, C.G); __syncthreads(); ph_norm_(C, C.in[I_NORM_MIX] + (size_t)l * D, false, nullptr, 0,  (l > 0) && ((l - 1) & 1), l == 0 ? C.in[I_X] : nullptr); }
__device__ __forceinline__ void P_gemm_in(int wv) { const Ctx C = make_ctx(wv); using namespace pg8; unsigned char* ws = C.ws;
    Gemm g{(const bf16*)(ws + WS_H), (const bf16*)(ws + WS_WIN), D, D}; StaticOrder S; S.init(T, NIN, C.G, C.bid);
    EpiRoute E{(bf16*)(ws + WS_RW), (bf16*)(ws + WS_SB), (bf16*)(ws + WS_RET), (bf16*)(ws + WS_CV)};
    gemm_phase<EpiRoute, StaticOrder, true>(C.lds, C.tid, g, S, E); }
#define REP2(bit, stmt) do { stmt; if constexpr ((PROBE2 >> (bit)) & 1) { __syncthreads(); stmt; } } while (0)
__device__ __forceinline__ void P_mix1(int wv, int l) { REP2(2, { const Ctx C = make_ctx(wv); ph_rw_prep_(C, l); }); { const Ctx C = make_ctx(wv); ph_sb_prep_(C, l); } REP2(3, { const Ctx C = make_ctx(wv); ph_conv_(C, l); }); REP2(4, { const Ctx C = make_ctx(wv); ph_ret_kv2_(C); }); }
__device__ __forceinline__ void P_mix2(int wv, int l) { { const Ctx C = make_ctx(wv); using namespace pg8; unsigned char* ws = C.ws;
    Gemm g{(const bf16*)(ws + WS_ALORA), (const bf16*)(ws + WS_WLORA), 256, 256}; StaticOrder S; S.init(T, 768, C.G, C.bid);
    EpiLora E{(float*)(ws + WS_WDEC), (bf16*)(ws + WS_AG), C.in[I_RW_W0] + (size_t)l * 256, C.in[I_RW_A0] + (size_t)l * 256};
    gemm_phase<EpiLora, StaticOrder, false>(C.lds, C.tid, g, S, E); }
    { const Ctx C = make_ctx(wv); ph_ret_scan_(C); } }
#ifndef MIX3_SEL
#define MIX3_SEL 3
#endif
__device__ __forceinline__ void P_mix3(int wv, int l) { REP2(0, { const Ctx C = make_ctx(wv); ph_rw_local_(C, l); }); }
__device__ __forceinline__ void P_mix4(int wv, int l) { const Ctx C = make_ctx(wv);
    if (C.G >= 64) { if (C.bid < 32) { REP2(6, ph_rw_scan_(C, C.bid)); } else { REP2(7, ph_sb_attn_(C, 32, C.G - 32)); __syncthreads(); REP2(1, ph_ret_out2_(C, l, 32, C.G - 32)); __syncthreads(); ph_weights_(C, l, 1, 32, C.G - 32); } }
    else { for (int w = C.bid; w < 32; w += C.G) { ph_rw_scan_(C, w); __syncthreads(); } ph_sb_attn_(C, 0, C.G); __syncthreads(); ph_ret_out2_(C, l, 0, C.G); __syncthreads(); ph_weights_(C, l, 1, 0, C.G); } }
__device__ __forceinline__ void P_mix5(int wv, int l) { REP2(5, { const Ctx C = make_ctx(wv); ph_rw_out2_(C, l); }); }
__device__ __forceinline__ void P_gemm_branch(int wv) { const Ctx C = make_ctx(wv); using namespace pg8; unsigned char* ws = C.ws;
    Gemm g{(const bf16*)(ws + WS_Y), (const bf16*)(ws + WS_WB), D, 256}; StaticOrder S; S.init(T, 4096, C.G, C.bid, 2, 512);
    EpiBf16 E{(bf16*)(ws + WS_BALL), 4096, 0xffff};
    gemm_phase<EpiBf16, StaticOrder, false>(C.lds, C.tid, g, S, E); }
__device__ __forceinline__ void P_gemm_gate(int wv) { const Ctx C = make_ctx(wv); using namespace pg8; unsigned char* ws = C.ws;
    Gemm g{(const bf16*)(ws + WS_H), (const bf16*)(ws + WS_WG), D, D}; StaticOrder S; S.init(T, 4096, C.G, C.bid);
    EpiGateMerge E{(const bf16*)(ws + WS_BALL), (bf16*)(ws + WS_MERGED)};
    gemm_phase<EpiGateMerge, StaticOrder, true>(C.lds, C.tid, g, S, E); }
__device__ __forceinline__ void P_gemm_out(int wv) { const Ctx C = make_ctx(wv); using namespace pg8; unsigned char* ws = C.ws;
    Gemm g{(const bf16*)(ws + WS_MERGED), (const bf16*)(ws + WS_WOUT), D, D}; StaticOrder S; S.init(T, D, C.G, C.bid);
    EpiResidual E{C.out};
    gemm_phase<EpiResidual, StaticOrder, false>(C.lds, C.tid, g, S, E); }
__device__ __forceinline__ void P_norm_ffn(int wv, int l) { const Ctx C = make_ctx(wv); ph_norm_(C, C.in[I_NORM_FFN] + (size_t)l * D, (l & 1) != 0, C.in[I_ROUTER] + (size_t)(l >> 1) * D * NEXP, l >> 1); }
__device__ __forceinline__ void P_ffn_up(int wv) { const Ctx C = make_ctx(wv); using namespace pg8; unsigned char* ws = C.ws;
    Gemm g{(const bf16*)(ws + WS_H), (const bf16*)(ws + WS_W13), D, D}; StaticOrder S; S.init(T, 2 * DFF, C.G, C.bid);
    EpiSwiglu E{(bf16*)(ws + WS_HID), DFF, 1 << 20};
    gemm_phase<EpiSwiglu, StaticOrder, true>(C.lds, C.tid, g, S, E); }
__device__ __forceinline__ void P_ffn_down(int wv) { const Ctx C = make_ctx(wv); using namespace pg8; unsigned char* ws = C.ws;
    Gemm g{(const bf16*)(ws + WS_HID), (const bf16*)(ws + WS_W2D), DFF, DFF}; StaticOrder S; S.init(T, D, C.G, C.bid);
    EpiResidual E{C.out};
    gemm_phase<EpiResidual, StaticOrder, false>(C.lds, C.tid, g, S, E); }
__device__ __forceinline__ void P_moe_scatter(int wv, int l2) { const Ctx C = make_ctx(wv); ph_moe_scatter_(C, l2); }
__device__ __forceinline__ void P_moe_up(int wv) { const Ctx C = make_ctx(wv); using namespace pg8; unsigned char* ws = C.ws;
    Gemm g{(const bf16*)(ws + WS_XS), (const bf16*)(ws + WS_W13), D, D};
    MoeOrder S{(const int*)(ws + WS_TEXP), *(const int*)(ws + WS_NT), 2 * DFE / 256, C.G, C.bid};
    EpiSwiglu E{(bf16*)(ws + WS_HIDM), DFE, 2 * DFE / 256};
    gemm_phase<EpiSwiglu, MoeOrder, true>(C.lds, C.tid, g, S, E); }
__device__ __forceinline__ void P_moe_down(int wv) { const Ctx C = make_ctx(wv); using namespace pg8; unsigned char* ws = C.ws;
    Gemm g{(const bf16*)(ws + WS_HIDM), (const bf16*)(ws + WS_W2M), DFE, DFE};
    MoeOrder S{(const int*)(ws + WS_TEXP), *(const int*)(ws + WS_NT), D / 256, C.G, C.bid};
    EpiBf16 E{(bf16*)(ws + WS_YS), D, 3};
    gemm_phase<EpiBf16, MoeOrder, false>(C.lds, C.tid, g, S, E); }
__device__ __forceinline__ void P_moe_combine(int wv) { const Ctx C = make_ctx(wv);
    const int gw = C.bid * NWAVES + C.wave, NGW = C.G * NWAVES, lane = C.lane;
    const int* slotof = (const int*)(C.ws + WS_SLOTOF); const float* gate = (const float*)(C.ws + WS_GATE); const bf16* YS = (const bf16*)(C.ws + WS_YS);
    for (int m = gw; m < T; m += NGW) {
        const int s0 = slotof[2 * m], s1 = slotof[2 * m + 1]; const float g0 = gate[2 * m], g1 = gate[2 * m + 1];
        f32x4* xr = (f32x4*)(C.out + (size_t)m * D) + lane;
        const u32x2* y0 = (const u32x2*)(YS + (size_t)s0 * D) + lane; const u32x2* y1 = (const u32x2*)(YS + (size_t)s1 * D) + lane;
#pragma unroll
        for (int j = 0; j < 4; ++j) { f32x4 v = xr[64 * j]; const u32x2 a = y0[64 * j], b = y1[64 * j];
            v.x += g0 * bflo(a.x) + g1 * bflo(b.x); v.y += g0 * bfhi(a.x) + g1 * bfhi(b.x); v.z += g0 * bflo(a.y) + g1 * bflo(b.y); v.w += g0 * bfhi(a.y) + g1 * bfhi(b.y);
            xr[64 * j] = v; }
    }
}

#ifndef PROBE_MASK
#define PROBE_MASK 0u
#endif
#ifndef PH_MASK
#define PH_MASK 0xffffffffu
#endif
__global__ void __launch_bounds__(NTHR, 2) hybrid_fwd(Args args) {
    (void)args;
    const int wv = __builtin_amdgcn_readfirstlane(threadIdx.x >> 6);
    { LAS unsigned char* lds = (LAS unsigned char*)lds_raw;
      for (int u = threadIdx.x; u < (LDS_BYTES - RING_BYTES) / 4; u += NTHR) ((LAS unsigned*)(lds + RING_BYTES))[u] = 0u; }
    __syncthreads();
    { const CAS Args* ka = ka_ptr();
      if (ka->ph_hi - ka->ph_lo > 1) { (void)xcd_barrier_post((unsigned*)(ka->ws + WS_CTL) + CW_BAR, (volatile LAS unsigned*)((LAS unsigned char*)lds_raw + MISC_OFF) + 8); } }
    int gp = 0;
#define PHASE(k, call) { const CAS Args* ka_ = ka_ptr(); const int lo_ = ka_->ph_lo, hi_ = ka_->ph_hi; if (lo_ <= gp && gp < hi_) { if constexpr ((PH_MASK >> (k)) & 1u) { call; if constexpr ((PROBE_MASK >> (k)) & 1u) { __syncthreads(); call; } } if (hi_ - lo_ > 1 && gp + 1 < hi_) grid_barrier(wv); } ++gp; }
    PHASE(0, P_prologue(wv))
#pragma unroll 1
    for (int l = 0; l < NLAYER; ++l) {
        PHASE(1, P_weights_norm(wv, l))
        PHASE(2, P_gemm_in(wv))
        PHASE(3, P_mix1(wv, l))
        PHASE(4, P_mix2(wv, l))
        PHASE(5, P_mix3(wv, l))
        PHASE(6, P_mix4(wv, l))
        PHASE(7, P_mix5(wv, l))
        PHASE(8, P_gemm_branch(wv))
        PHASE(9, P_gemm_gate(wv))
        PHASE(10, P_gemm_out(wv))
        PHASE(11, P_norm_ffn(wv, l))
        if (!(l & 1)) {
            PHASE(12, P_ffn_up(wv))
            PHASE(13, P_ffn_down(wv))
            gp += 2;
        } else {
            PHASE(14, P_moe_scatter(wv, l >> 1))
            PHASE(15, P_moe_up(wv))
            PHASE(16, P_moe_down(wv))
            if (l == NLAYER - 1) { PHASE(17, P_moe_combine(wv)) } else { ++gp; }
        }
    }
#undef PHASE
}
constexpr int N_PHASES = 1 + NLAYER * 15;

#ifndef MK_MULTI
#define MK_MULTI 0
#endif
extern "C" void kernel_launch(void* const* d_in, const int* in_sizes, int n_in, void* d_out, int out_size, void* d_ws, size_t ws_size, hipStream_t stream) {
    static int grid = 0;
    if (grid == 0) {
        if (n_in != 32 || in_sizes[0] != T * D || out_size != T * D || ws_size < WS_END) { fprintf(stderr, "kernel_launch: unexpected problem shape / workspace (%d inputs, ws %zu)\n", n_in, ws_size); grid = -1; return; }
        int dev = 0, cus = 0, per_cu = 0;
        if (hipGetDevice(&dev) != hipSuccess || hipDeviceGetAttribute(&cus, hipDeviceAttributeMultiprocessorCount, dev) != hipSuccess) { grid = -1; return; }
        if (hipFuncSetAttribute((const void*)hybrid_fwd, hipFuncAttributeMaxDynamicSharedMemorySize, LDS_BYTES) != hipSuccess) { fprintf(stderr, "kernel_launch: hipFuncSetAttribute failed\n"); grid = -1; return; }
        if (hipOccupancyMaxActiveBlocksPerMultiprocessor(&per_cu, (const void*)hybrid_fwd, NTHR, LDS_BYTES) != hipSuccess || per_cu < 1) { fprintf(stderr, "kernel_launch: occupancy query says %d\n", per_cu); }
        (void)hipGetLastError();
        grid = cus;
    }
    if (grid < 0) return;
    (void)hipMemsetAsync((char*)d_ws + WS_CTL, 0, CTL_ZERO_BYTES, stream);
#ifdef DBG_ZERO_WS
    (void)hipMemsetAsync((char*)d_ws + CTL_ZERO_BYTES, 0, WS_END - CTL_ZERO_BYTES, stream);
#endif
    Args a{};
    for (int i = 0; i < 32; ++i) a.in[i] = (const float*)d_in[i];
    a.out = (float*)d_out; a.ws = (unsigned char*)d_ws;
#if MK_MULTI
    for (int p = 0; p < N_PHASES; ++p) { a.ph_lo = p; a.ph_hi = p + 1; hipLaunchKernelGGL(hybrid_fwd, dim3(grid), dim3(NTHR), LDS_BYTES, stream, a); }
#else
    a.ph_lo = 0; a.ph_hi = N_PHASES; hipLaunchKernelGGL(hybrid_fwd, dim3(grid), dim3(NTHR), LDS_BYTES, stream, a);
#endif
}
```

```cpp
#include <hip/hip_runtime.h>
#include <cstdio>
#include <cstdint>

#define GAS __attribute__((address_space(1)))
#define LAS __attribute__((address_space(3)))
typedef unsigned short bf16;
typedef unsigned u32x4 __attribute__((ext_vector_type(4)));
typedef unsigned u32x2 __attribute__((ext_vector_type(2)));
typedef float f32x4 __attribute__((ext_vector_type(4)));
typedef float f32x2 __attribute__((ext_vector_type(2)));
typedef short bf16x8 __attribute__((ext_vector_type(8)));
typedef float f32x16 __attribute__((ext_vector_type(16)));
typedef short s16x4 __attribute__((ext_vector_type(4)));

constexpr int SEQ = 16384, NBATCH = 2, T = NBATCH * SEQ, D = 1024, NIN = 3328, DFF = 2816, DFE = 1408, NEXP = 8, NLAYER = 4;
constexpr int MPAD = 2 * T + NEXP * 256;
constexpr int NWAVES = 8, NTHR = 512;
constexpr float LOG2E = 1.4426950408889634f;
constexpr int MM_LP = 72;

typedef __bf16 bf16x2_t __attribute__((ext_vector_type(2)));
__device__ __forceinline__ unsigned cvt_pk_bf16(float lo, float hi) { const f32x2 v = {lo, hi}; const bf16x2_t b = __builtin_convertvector(v, bf16x2_t); return __builtin_bit_cast(unsigned, b); }
__device__ __forceinline__ float bflo(unsigned u) { return __builtin_bit_cast(float, u << 16); }
__device__ __forceinline__ float bfhi(unsigned u) { return __builtin_bit_cast(float, u & 0xffff0000u); }
__device__ __forceinline__ float bf2f(bf16 u) { return __builtin_bit_cast(float, (unsigned)u << 16); }
__device__ __forceinline__ bf16 f2bf(float f) { return (bf16)(cvt_pk_bf16(f, 0.f) & 0xffffu); }
__device__ __forceinline__ float sigm(float x) { return __builtin_amdgcn_rcpf(1.f + __builtin_amdgcn_exp2f(-x * LOG2E)); }
__device__ __forceinline__ float shx(float v, int o, int lane) { return __builtin_bit_cast(float, __builtin_amdgcn_ds_bpermute((lane ^ o) << 2, __builtin_bit_cast(int, v))); }
__device__ __forceinline__ float dpp_add(float v, const int ctrl_id) {
    const int x = __builtin_bit_cast(int, v);
    int y;
    if (ctrl_id == 0) y = __builtin_amdgcn_update_dpp(0, x, 0xB1, 0xF, 0xF, true);
    else if (ctrl_id == 1) y = __builtin_amdgcn_update_dpp(0, x, 0x4E, 0xF, 0xF, true);
    else if (ctrl_id == 2) y = __builtin_amdgcn_update_dpp(0, x, 0x141, 0xF, 0xF, true);
    else y = __builtin_amdgcn_update_dpp(0, x, 0x140, 0xF, 0xF, true);
    return v + __builtin_bit_cast(float, y);
}
__device__ __forceinline__ float wave_sum(float v, int lane) {
    (void)lane;
    v = dpp_add(v, 0); v = dpp_add(v, 1); v = dpp_add(v, 2); v = dpp_add(v, 3);
    const int x = __builtin_bit_cast(int, v);
    const float s0 = __builtin_bit_cast(float, __builtin_amdgcn_readlane(x, 0)), s1 = __builtin_bit_cast(float, __builtin_amdgcn_readlane(x, 16)),
                s2 = __builtin_bit_cast(float, __builtin_amdgcn_readlane(x, 32)), s3 = __builtin_bit_cast(float, __builtin_amdgcn_readlane(x, 48));
    return (s0 + s1) + (s2 + s3);
}
__device__ __forceinline__ void unpack8(const u32x4 v, float* f) {
    f[0] = bflo(v.x); f[1] = bfhi(v.x); f[2] = bflo(v.y); f[3] = bfhi(v.y); f[4] = bflo(v.z); f[5] = bfhi(v.z); f[6] = bflo(v.w); f[7] = bfhi(v.w);
}
__device__ __forceinline__ unsigned pk4_fp8(float a, float b, float c, float d) { int w = __builtin_amdgcn_cvt_pk_fp8_f32(a, b, 0, false); w = __builtin_amdgcn_cvt_pk_fp8_f32(c, d, w, true); return (unsigned)w; }
__device__ __forceinline__ u32x4 pack8(const float* f) {
    u32x4 w; w.x = cvt_pk_bf16(f[0], f[1]); w.y = cvt_pk_bf16(f[2], f[3]); w.z = cvt_pk_bf16(f[4], f[5]); w.w = cvt_pk_bf16(f[6], f[7]); return w;
}


#ifndef PROBE2
#define PROBE2 0
#endif
#ifndef GMASK
#define GMASK 15
#endif
#ifndef RWDBG
#define RWDBG 0
#endif
typedef int i32x8 __attribute__((ext_vector_type(8)));
constexpr float F8_MUL_X = 16.f, F8_MUL_W = 256.f, F8_DESCALE = 1.0f / (16.f * 256.f);
namespace pg8 {
typedef unsigned short bf16_t;
constexpr int BM = 256, BK = 64, HALF = 128, HTB = HALF * BK * 2, NXCD = 8, WGM = 8;
__host__ __device__ __forceinline__ int lds_byte(int r, int c) { const int st = (r >> 4) * 2 + (c >> 5), rr = r & 15, cc = c & 31, ob = rr * 64 + cc * 2; return st * 1024 + (ob ^ (((ob >> 9) & 1) << 5)); }
__host__ __device__ __forceinline__ void stage_rc(int b, int& R, int& C) { const int st = b / 1024, sb = b % 1024, swz = sb ^ (((sb >> 9) & 1) << 5); R = (st >> 1) * 16 + swz / 64; C = (st & 1) * 32 + (swz % 64) / 2; }
__host__ __device__ __forceinline__ int perm32(int rho) { const int n = rho >> 4, i = rho & 15; return 8 * (i >> 2) + 4 * n + (i & 3); }

struct Unit { int pm, pn, aoff; };
struct Gemm { const bf16_t* A; const bf16_t* Bt; int lda, K; };

struct StaticOrder {
    int nM, nN, nwg, G, c, ashift, amul;
    __device__ void init(int M, int N, int G_, int c_, int ashift_ = 0, int amul_ = 0) { nM = M / BM; nN = N / BM; nwg = nM * nN; G = G_; c = c_; ashift = ashift_; amul = amul_; }
    __device__ bool next(int i, Unit& u) const {
        const long L = (long)i * G + c; if (L >= nwg) return false;
        int wgid = (int)L; { const int q = nwg / NXCD, r = nwg % NXCD, xcd = wgid % NXCD, off = wgid / NXCD; wgid = (xcd < r ? xcd * (q + 1) : r * (q + 1) + (xcd - r) * q) + off; }
        const int nig = WGM * nN, gid = wgid / nig, fm = gid * WGM, gsz = (nM - fm) < WGM ? (nM - fm) : WGM;
        u.pm = fm + ((wgid % nig) % gsz); u.pn = (wgid % nig) / gsz; u.aoff = (u.pn >> ashift) * amul; return true;
    }
};
struct MoeOrder {
    const int* texp; int ntiles, ncol, G, c;
    __device__ bool next(int i, Unit& u) const {
        const int L = i * G + c; if (L >= ntiles * ncol) return false;
        const int pm = L / ncol, pl = L % ncol;
        u.pm = pm; u.pn = texp[pm] * ncol + pl; u.aoff = 0; return true;
    }
};

template <class Epi, class Sched, bool ALIGN_EPI>
__device__ __forceinline__ void gemm_phase(LAS unsigned char* lds, const int tid_in, const Gemm g, const Sched& S, const Epi& E) {
    const int tid = tid_in, wid = __builtin_amdgcn_readfirstlane(tid >> 6), lane = tid & 63, wr = wid >> 2, wc = wid & 3, fr = lane & 15, fq = lane >> 4;
    const int K = g.K, nt = K / BK, lda = g.lda;
    unsigned voffA[2], voffB[2];
#pragma unroll
    for (int i = 0; i < 2; ++i) { int R, C; stage_rc(tid * 16 + i * 8192, R, C); const int Rb = (R & ~31) + perm32(R & 31);
        voffA[i] = (unsigned)(R * lda + C) * 2u; voffB[i] = (unsigned)(Rb * K + C) * 2u; }
    const size_t kstep = (size_t)(BK * 2);
    const size_t hstepA = (size_t)HALF * lda * 2, tstepA = 2 * hstepA, hstepB = (size_t)HALF * K * 2, tstepB = 2 * hstepB;
    const unsigned ldsw = (unsigned)wid * 1024u;
    const int aoff = lds_byte(wr * 64 + fr, fq * 8), boff = lds_byte(wc * 32 + fr, fq * 8);
#define PG8_SA(b, h) (((b) * 2 + (h)) * HTB)
#define PG8_SB(b, h) ((4 + (b) * 2 + (h)) * HTB)
#define PG8_STAGE(bufoff, gbase, voff) do { _Pragma("unroll") for (int _i = 0; _i < 2; ++_i) \
        __builtin_amdgcn_global_load_lds((const unsigned*)((const char*)(gbase) + (voff)[_i]), (LAS unsigned*)(lds + (bufoff) + ldsw + _i * 8192), 16, 0, 0); } while (0)
#define PG8_LDA(dst, b, h) do { _Pragma("unroll") for (int m = 0; m < 4; ++m) _Pragma("unroll") for (int k = 0; k < 2; ++k) dst[m][k] = *(const LAS bf16x8*)(lds + PG8_SA(b, h) + aoff + m * 2048 + k * 1024); } while (0)
#define PG8_LDB(dst, b, h) do { _Pragma("unroll") for (int n = 0; n < 2; ++n) _Pragma("unroll") for (int k = 0; k < 2; ++k) dst[n][k] = *(const LAS bf16x8*)(lds + PG8_SB(b, h) + boff + n * 2048 + k * 1024); } while (0)
#define PG8_MMA(ai, bj, At, Bt) do { __builtin_amdgcn_s_setprio(1); _Pragma("unroll") for (int m = 0; m < 4; ++m) _Pragma("unroll") for (int n = 0; n < 2; ++n) _Pragma("unroll") for (int k = 0; k < 2; ++k) \
        acc[ai][bj][m][n] = __builtin_amdgcn_mfma_f32_16x16x32_bf16(Bt[n][k], At[m][k], acc[ai][bj][m][n], 0, 0, 0); __builtin_amdgcn_s_setprio(0); } while (0)
#define PG8_WAIT_V(n) asm volatile("s_waitcnt vmcnt(" #n ")" ::: "memory")
#define PG8_WAIT_L(n) asm volatile("s_waitcnt lgkmcnt(" #n ")" ::: "memory")
#define PG8_BAR __builtin_amdgcn_s_barrier()
#define PG8_SCHED __builtin_amdgcn_sched_barrier(0)
    Unit cur, nxt; int ui = 0;
    if (!S.next(0, cur)) return;
    f32x4 acc[2][2][4][2];
#pragma unroll
    for (int a = 0; a < 2; ++a)
#pragma unroll
        for (int b = 0; b < 2; ++b)
#pragma unroll
            for (int m = 0; m < 4; ++m)
#pragma unroll
                for (int n = 0; n < 2; ++n) acc[a][b][m][n] = (f32x4){0.f, 0.f, 0.f, 0.f};
    bf16x8 At[4][2], B0[2][2], B1[2][2];
    const char* cA = (const char*)g.A + (size_t)cur.pm * tstepA + cur.aoff; const char* cB = (const char*)g.Bt + (size_t)cur.pn * tstepB;
    PG8_STAGE(PG8_SB(0, 0), cB, voffB); PG8_STAGE(PG8_SB(0, 1), cB + hstepB, voffB); PG8_STAGE(PG8_SA(0, 0), cA, voffA); PG8_STAGE(PG8_SA(0, 1), cA + hstepA, voffA);
    if (wr == 1) PG8_BAR;
    PG8_WAIT_V(2); PG8_BAR;
    PG8_STAGE(PG8_SB(1, 0), cB + kstep, voffB); PG8_STAGE(PG8_SA(1, 0), cA + kstep, voffA); PG8_STAGE(PG8_SB(1, 1), cB + hstepB + kstep, voffB);
    PG8_WAIT_V(6); PG8_BAR;
    for (;;) {
        const bool has_next = S.next(ui + 1, nxt);
        const char* nA = has_next ? (const char*)g.A + (size_t)nxt.pm * tstepA + nxt.aoff : cA; const char* nB = has_next ? (const char*)g.Bt + (size_t)nxt.pn * tstepB : cB;
#pragma unroll 1
        for (int t = 0; t < nt; t += 2) {
            const bool last = (t == nt - 2);
            const char* a1 = cA + (size_t)(t + 1) * kstep;
            const char* a2 = last ? nA : cA + (size_t)(t + 2) * kstep; const char* b2 = last ? nB : cB + (size_t)(t + 2) * kstep;
            const char* a3 = a2 + kstep; const char* b3 = b2 + kstep;
            PG8_LDB(B0, 0, 0); PG8_LDB(B1, 0, 1); PG8_SCHED; PG8_LDA(At, 0, 0); PG8_STAGE(PG8_SA(1, 1), a1 + hstepA, voffA);
            PG8_WAIT_V(8); PG8_WAIT_L(0); PG8_BAR; PG8_MMA(0, 0, At, B0); PG8_MMA(0, 1, At, B1); PG8_BAR; PG8_SCHED;
            PG8_LDA(At, 0, 1); PG8_STAGE(PG8_SB(0, 0), b2, voffB); PG8_STAGE(PG8_SB(0, 1), b2 + hstepB, voffB); PG8_STAGE(PG8_SA(0, 0), a2, voffA);
            PG8_WAIT_V(8); PG8_WAIT_L(0); PG8_BAR; PG8_MMA(1, 0, At, B0); PG8_MMA(1, 1, At, B1); PG8_BAR; PG8_SCHED;
            PG8_LDB(B0, 1, 0); PG8_LDB(B1, 1, 1); PG8_SCHED; PG8_LDA(At, 1, 0); PG8_STAGE(PG8_SA(0, 1), a2 + hstepA, voffA);
            PG8_WAIT_V(8); PG8_WAIT_L(0); PG8_BAR; PG8_MMA(0, 0, At, B0); PG8_MMA(0, 1, At, B1); PG8_BAR; PG8_SCHED;
            PG8_LDA(At, 1, 1); PG8_STAGE(PG8_SB(1, 0), b3, voffB); PG8_STAGE(PG8_SB(1, 1), b3 + hstepB, voffB); PG8_STAGE(PG8_SA(1, 0), a3, voffA);
            PG8_WAIT_V(8); PG8_WAIT_L(0); PG8_BAR; PG8_MMA(1, 0, At, B0); PG8_MMA(1, 1, At, B1); PG8_BAR; PG8_SCHED;
        }
        if constexpr (ALIGN_EPI) { if (wr == 0) PG8_BAR; }
        { int fr_ = fr, fq_ = fq; asm volatile("" : "+v"(fr_), "+v"(fq_)); E(acc, cur, wr, wc, fr_, fq_); }
        if (!has_next) break;
#pragma unroll
        for (int a = 0; a < 2; ++a)
#pragma unroll
            for (int b = 0; b < 2; ++b)
#pragma unroll
                for (int m = 0; m < 4; ++m)
#pragma unroll
                    for (int n = 0; n < 2; ++n) acc[a][b][m][n] = (f32x4){0.f, 0.f, 0.f, 0.f};
        cur = nxt; cA = nA; cB = nB; ++ui;
        if constexpr (ALIGN_EPI) { if (wr == 1) PG8_BAR; }
    }
    PG8_WAIT_V(0);
    if constexpr (!ALIGN_EPI) { if (wr == 0) PG8_BAR; }
    PG8_BAR;
#undef PG8_SA
#undef PG8_SB
#undef PG8_STAGE
#undef PG8_LDA
#undef PG8_LDB
#undef PG8_MMA
#undef PG8_WAIT_V
#undef PG8_WAIT_L
#undef PG8_BAR
#undef PG8_SCHED
}

template <class Epi, class Sched, bool ALIGN_EPI>
__device__ __forceinline__ void gemm_phase8(LAS unsigned char* lds, const int tid_in, const Gemm g, const Sched& S, const Epi& E) {
    const int tid = tid_in, wid = __builtin_amdgcn_readfirstlane(tid >> 6), lane = tid & 63, wr = wid >> 2, wc = wid & 3, fr = lane & 15, fq = lane >> 4;
    const int K = g.K, nt = K / 128, lda = g.lda;
    unsigned voffA, voffB;
    { int R, C; stage_rc(tid * 16, R, C); const int Rb = (R & ~31) + perm32(R & 31); voffA = (unsigned)(R * lda + C * 2); voffB = (unsigned)(Rb * K + C * 2); }
    const unsigned pstepA = 64u * (unsigned)lda, pstepB = 64u * (unsigned)K;
    const unsigned kstep = (unsigned)(BK * 2);
    const unsigned hstepA = (unsigned)HALF * (unsigned)lda, tstepA = 2 * hstepA, hstepB = (unsigned)HALF * (unsigned)K, tstepB = 2 * hstepB;
    const __amdgpu_buffer_rsrc_t rsA = __builtin_amdgcn_make_buffer_rsrc((void*)g.A, 0, 0x7fffffff, 0x00020000), rsB = __builtin_amdgcn_make_buffer_rsrc((void*)g.Bt, 0, 0x7fffffff, 0x00020000);
    const unsigned ldsw = (unsigned)wid * 1024u;
    const int aoff0 = lds_byte(wr * 64 + fr, fq * 16), aoff1 = aoff0 + 16, boff0 = lds_byte(wc * 32 + fr, fq * 16), boff1 = boff0 + 16;
#define PG8_SA(b, h) (((b) * 2 + (h)) * HTB)
#define PG8_SB(b, h) ((4 + (b) * 2 + (h)) * HTB)
#define PG8_STAGE(bufoff, goff, voff, pstep) do { _Pragma("unroll") for (int _i = 0; _i < 2; ++_i) \
        __builtin_amdgcn_raw_ptr_buffer_load_lds(PG8_RS_##voff, (LAS unsigned*)(lds + (bufoff) + ldsw + _i * 8192), 16, (int)(voff), (int)((goff) + _i * (pstep)), 0, 0); } while (0)
#define PG8_RS_voffA rsA
#define PG8_RS_voffB rsB
#define PG8_LDA(dst, b, h) do { _Pragma("unroll") for (int m = 0; m < 4; ++m) { dst[m][0] = *(const LAS u32x4*)(lds + PG8_SA(b, h) + aoff0 + m * 2048); dst[m][1] = *(const LAS u32x4*)(lds + PG8_SA(b, h) + aoff1 + m * 2048); } } while (0)
#define PG8_LDB(dst, b, h) do { _Pragma("unroll") for (int n = 0; n < 2; ++n) { dst[n][0] = *(const LAS u32x4*)(lds + PG8_SB(b, h) + boff0 + n * 2048); dst[n][1] = *(const LAS u32x4*)(lds + PG8_SB(b, h) + boff1 + n * 2048); } } while (0)
#define PG8_J8(x) __builtin_bit_cast(i32x8, __builtin_shufflevector((x)[0], (x)[1], 0, 1, 2, 3, 4, 5, 6, 7))
#define PG8_MMA(ai, bj, At, Bt) do { __builtin_amdgcn_s_setprio(1); _Pragma("unroll") for (int m = 0; m < 4; ++m) _Pragma("unroll") for (int n = 0; n < 2; ++n) \
        acc[ai][bj][m][n] = __builtin_amdgcn_mfma_scale_f32_16x16x128_f8f6f4(PG8_J8(Bt[n]), PG8_J8(At[m]), acc[ai][bj][m][n], 0, 0, 0, 0, 0, 0);        __builtin_amdgcn_s_setprio(0); } while (0)
#define PG8_WAIT_V(n) asm volatile("s_waitcnt vmcnt(" #n ")" ::: "memory")
#define PG8_WAIT_L(n) asm volatile("s_waitcnt lgkmcnt(" #n ")" ::: "memory")
#define PG8_BAR __builtin_amdgcn_s_barrier()
#define PG8_SCHED __builtin_amdgcn_sched_barrier(0)
    Unit cur, nxt; int ui = 0;
    if (!S.next(0, cur)) return;
    f32x4 acc[2][2][4][2];
#pragma unroll
    for (int a = 0; a < 2; ++a)
#pragma unroll
        for (int b = 0; b < 2; ++b)
#pragma unroll
            for (int m = 0; m < 4; ++m)
#pragma unroll
                for (int n = 0; n < 2; ++n) acc[a][b][m][n] = (f32x4){0.f, 0.f, 0.f, 0.f};
    u32x4 At[4][2], B0[2][2], B1[2][2];
    unsigned cA = (unsigned)cur.pm * tstepA + (unsigned)cur.aoff, cB = (unsigned)cur.pn * tstepB;
    PG8_STAGE(PG8_SB(0, 0), cB, voffB, pstepB); PG8_STAGE(PG8_SB(0, 1), cB + hstepB, voffB, pstepB); PG8_STAGE(PG8_SA(0, 0), cA, voffA, pstepA); PG8_STAGE(PG8_SA(0, 1), cA + hstepA, voffA, pstepA);
    if (wr == 1) PG8_BAR;
    PG8_WAIT_V(2); PG8_BAR;
    PG8_STAGE(PG8_SB(1, 0), cB + kstep, voffB, pstepB); PG8_STAGE(PG8_SA(1, 0), cA + kstep, voffA, pstepA); PG8_STAGE(PG8_SB(1, 1), cB + hstepB + kstep, voffB, pstepB);
    PG8_WAIT_V(6); PG8_BAR;
    for (;;) {
        const bool has_next = S.next(ui + 1, nxt);
        const unsigned nA = has_next ? (unsigned)nxt.pm * tstepA + (unsigned)nxt.aoff : cA, nB = has_next ? (unsigned)nxt.pn * tstepB : cB;
#pragma unroll 1
        for (int t = 0; t < nt; t += 2) {
            const bool last = (t == nt - 2);
            const unsigned a1 = cA + (unsigned)(t + 1) * kstep;
            const unsigned a2 = last ? nA : cA + (unsigned)(t + 2) * kstep, b2 = last ? nB : cB + (unsigned)(t + 2) * kstep;
            const unsigned a3 = a2 + kstep, b3 = b2 + kstep;
            PG8_LDB(B0, 0, 0); PG8_LDB(B1, 0, 1); PG8_SCHED; PG8_LDA(At, 0, 0); PG8_STAGE(PG8_SA(1, 1), a1 + hstepA, voffA, pstepA);
            PG8_WAIT_V(8); PG8_WAIT_L(0); PG8_BAR; PG8_MMA(0, 0, At, B0); PG8_MMA(0, 1, At, B1); PG8_BAR; PG8_SCHED;
            PG8_LDA(At, 0, 1); PG8_STAGE(PG8_SB(0, 0), b2, voffB, pstepB); PG8_STAGE(PG8_SB(0, 1), b2 + hstepB, voffB, pstepB); PG8_STAGE(PG8_SA(0, 0), a2, voffA, pstepA);
            PG8_WAIT_V(8); PG8_WAIT_L(0); PG8_BAR; PG8_MMA(1, 0, At, B0); PG8_MMA(1, 1, At, B1); PG8_BAR; PG8_SCHED;
            PG8_LDB(B0, 1, 0); PG8_LDB(B1, 1, 1); PG8_SCHED; PG8_LDA(At, 1, 0); PG8_STAGE(PG8_SA(0, 1), a2 + hstepA, voffA, pstepA);
            PG8_WAIT_V(8); PG8_WAIT_L(0); PG8_BAR; PG8_MMA(0, 0, At, B0); PG8_MMA(0, 1, At, B1); PG8_BAR; PG8_SCHED;
            PG8_LDA(At, 1, 1); PG8_STAGE(PG8_SB(1, 0), b3, voffB, pstepB); PG8_STAGE(PG8_SB(1, 1), b3 + hstepB, voffB, pstepB); PG8_STAGE(PG8_SA(1, 0), a3, voffA, pstepA);
            PG8_WAIT_V(8); PG8_WAIT_L(0); PG8_BAR; PG8_MMA(1, 0, At, B0); PG8_MMA(1, 1, At, B1); PG8_BAR; PG8_SCHED;
        }
        if constexpr (ALIGN_EPI) { if (wr == 0) PG8_BAR; }
        { int fr_ = fr, fq_ = fq; asm volatile("" : "+v"(fr_), "+v"(fq_)); E(acc, cur, wr, wc, fr_, fq_); }
        if (!has_next) break;
#pragma unroll
        for (int a = 0; a < 2; ++a)
#pragma unroll
            for (int b = 0; b < 2; ++b)
#pragma unroll
                for (int m = 0; m < 4; ++m)
#pragma unroll
                    for (int n = 0; n < 2; ++n) acc[a][b][m][n] = (f32x4){0.f, 0.f, 0.f, 0.f};
        cur = nxt; cA = nA; cB = nB; ++ui;
        if constexpr (ALIGN_EPI) { if (wr == 1) PG8_BAR; }
    }
    PG8_WAIT_V(0);
    if constexpr (!ALIGN_EPI) { if (wr == 0) PG8_BAR; }
    PG8_BAR;
#undef PG8_SA
#undef PG8_SB
#undef PG8_STAGE
#undef PG8_RS_voffA
#undef PG8_RS_voffB
#undef PG8_LDA
#undef PG8_LDB
#undef PG8_MMA
#undef PG8_J8
#undef PG8_WAIT_V
#undef PG8_WAIT_L
#undef PG8_BAR
#undef PG8_SCHED
}

typedef f32x4 Acc[2][2][4][2];

struct EpiRoute {
    bf16_t *d0, *d1, *d2, *d3;
    __device__ __forceinline__ void operator()(const Acc& acc, const Unit& u, int wr, int wc, int fr, int fq) const {
        const int pn = u.pn; bf16_t* base; int ld, ct;
        if (pn < 4) { base = d0; ld = 1024; ct = pn; } else if (pn < 7) { base = d1; ld = 768; ct = pn - 4; } else if (pn < 11) { base = d2; ld = 1024; ct = pn - 7; } else { base = d3; ld = 512; ct = pn - 11; }
        const int row0 = u.pm * BM + wr * 64 + fr, col0 = ct * 256 + wc * 32 + 8 * fq;
#pragma unroll
        for (int ai = 0; ai < 2; ++ai)
#pragma unroll
            for (int m = 0; m < 4; ++m) { bf16_t* rowp = base + (size_t)(row0 + ai * HALF + m * 16) * ld + col0;
#pragma unroll
                for (int bj = 0; bj < 2; ++bj) { const f32x4 v0 = acc[ai][bj][m][0], v1 = acc[ai][bj][m][1]; u32x4 w;
                    w.x = cvt_pk_bf16(v0[0], v0[1]); w.y = cvt_pk_bf16(v0[2], v0[3]); w.z = cvt_pk_bf16(v1[0], v1[1]); w.w = cvt_pk_bf16(v1[2], v1[3]);
                    *(u32x4*)(rowp + bj * HALF) = w; } }
    }
};
struct EpiBf16 {
    bf16_t* O; int ld, pnmask;
    __device__ __forceinline__ void operator()(const Acc& acc, const Unit& u, int wr, int wc, int fr, int fq) const {
        const int row0 = u.pm * BM + wr * 64 + fr, col0 = (u.pn & pnmask) * 256 + wc * 32 + 8 * fq;
#pragma unroll
        for (int ai = 0; ai < 2; ++ai)
#pragma unroll
            for (int m = 0; m < 4; ++m) { bf16_t* rowp = O + (size_t)(row0 + ai * HALF + m * 16) * ld + col0;
#pragma unroll
                for (int bj = 0; bj < 2; ++bj) { const f32x4 v0 = acc[ai][bj][m][0], v1 = acc[ai][bj][m][1]; u32x4 w;
                    w.x = cvt_pk_bf16(v0[0], v0[1]); w.y = cvt_pk_bf16(v0[2], v0[3]); w.z = cvt_pk_bf16(v1[0], v1[1]); w.w = cvt_pk_bf16(v1[2], v1[3]);
                    *(u32x4*)(rowp + bj * HALF) = w; } }
    }
};
struct EpiLora {
    float* wdec; bf16_t* ag; const float* w0; const float* a0;
    __device__ __forceinline__ void operator()(const Acc& acc, const Unit& u, int wr, int wc, int fr, int fq) const {
        const int row0 = u.pm * BM + wr * 64 + fr, cl0 = wc * 32 + 8 * fq, pn = u.pn;
#pragma unroll
        for (int ai = 0; ai < 2; ++ai)
#pragma unroll
            for (int m = 0; m < 4; ++m) { const size_t row = (size_t)(row0 + ai * HALF + m * 16);
#pragma unroll
                for (int bj = 0; bj < 2; ++bj) { const int col = bj * HALF + cl0; float v[8];
#pragma unroll
                    for (int n = 0; n < 2; ++n)
#pragma unroll
                        for (int e = 0; e < 4; ++e) v[4 * n + e] = acc[ai][bj][m][n][e];
                    if (pn == 0) {
                        *(f32x4*)(wdec + row * 256 + col) = (f32x4){v[0], v[1], v[2], v[3]}; *(f32x4*)(wdec + row * 256 + col + 4) = (f32x4){v[4], v[5], v[6], v[7]};
                    } else if (pn == 1) {
                        *(u32x4*)(ag + row * 512 + col) = pack8(v);
                    } else { *(u32x4*)(ag + row * 512 + 256 + col) = pack8(v); }
                } }
    }
};
struct EpiGateMerge {
    const bf16_t* ball; bf16_t* merged;
    __device__ __forceinline__ void operator()(const Acc& acc, const Unit& u, int wr, int wc, int fr, int fq) const {
        const int row0 = u.pm * BM + wr * 64 + fr, o0 = 64 * u.pn + 16 * wc + 4 * fq;
#pragma unroll
        for (int ai = 0; ai < 2; ++ai)
#pragma unroll
            for (int m = 0; m < 4; ++m) { const size_t row = (size_t)(row0 + ai * HALF + m * 16); float s[4] = {0.f, 0.f, 0.f, 0.f};
#pragma unroll
                for (int bj = 0; bj < 2; ++bj)
#pragma unroll
                    for (int n = 0; n < 2; ++n) { const int gi = 2 * bj + n; if (!((GMASK >> gi) & 1)) continue; const u32x2 b = *(const u32x2*)(ball + row * 4096 + 1024 * gi + o0);
                        const f32x4 a = acc[ai][bj][m][n] * F8_DESCALE;
                        s[0] += sigm(a[0]) * bflo(b.x); s[1] += sigm(a[1]) * bfhi(b.x); s[2] += sigm(a[2]) * bflo(b.y); s[3] += sigm(a[3]) * bfhi(b.y); }
                u32x2 w; w.x = cvt_pk_bf16(s[0], s[1]); w.y = cvt_pk_bf16(s[2], s[3]);
                *(u32x2*)(merged + row * 1024 + o0) = w; }
    }
};
struct EpiResidual {
    float* out;
    __device__ __forceinline__ void operator()(const Acc& acc, const Unit& u, int wr, int wc, int fr, int fq) const {
        const int row0 = u.pm * BM + wr * 64 + fr, col0 = u.pn * 256 + wc * 32 + 8 * fq;
#pragma unroll
        for (int ai = 0; ai < 2; ++ai)
#pragma unroll
            for (int m = 0; m < 4; ++m) { float* rowp = out + (size_t)(row0 + ai * HALF + m * 16) * 1024 + col0;
#pragma unroll
                for (int bj = 0; bj < 2; ++bj)
#pragma unroll
                    for (int n = 0; n < 2; ++n) { f32x4* p = (f32x4*)(rowp + bj * HALF + 4 * n); f32x4 v = *p; v = v + acc[ai][bj][m][n]; *p = v; } }
    }
};
struct EpiSwiglu {
    bf16_t* hid; int ldh, ncol;
    __device__ __forceinline__ void operator()(const Acc& acc, const Unit& u, int wr, int wc, int fr, int fq) const {
        const int row0 = u.pm * BM + wr * 64 + fr, col0 = (u.pn % ncol) * 128 + wc * 32 + 8 * fq;
#pragma unroll
        for (int ai = 0; ai < 2; ++ai)
#pragma unroll
            for (int m = 0; m < 4; ++m) { float v[8];
#pragma unroll
                for (int n = 0; n < 2; ++n)
#pragma unroll
                    for (int e = 0; e < 4; ++e) { const float a = acc[ai][0][m][n][e] * F8_DESCALE, b = acc[ai][1][m][n][e] * F8_DESCALE; v[4 * n + e] = a * sigm(a) * b; }
                *(u32x4*)(hid + (size_t)(row0 + ai * HALF + m * 16) * ldh + col0) = pack8(v); }
    }
};
struct EpiMoeOut {
    float* out; const int* rowtok; const float* rowgate; const int* segend;
    __device__ __forceinline__ void operator()(const Acc& acc, const Unit& u, int wr, int wc, int fr, int fq) const {
        const int row0 = u.pm * BM + wr * 64 + fr, col0 = (u.pn & 3) * 256 + wc * 32 + 8 * fq, lim = segend[u.pm];
#pragma unroll
        for (int ai = 0; ai < 2; ++ai)
#pragma unroll
            for (int m = 0; m < 4; ++m) { const int row = row0 + ai * HALF + m * 16;
                if (row < lim) { const int tok = rowtok[row]; const float gt = rowgate[row]; float* rowp = out + (size_t)tok * 1024 + col0;
#pragma unroll
                    for (int bj = 0; bj < 2; ++bj)
#pragma unroll
                        for (int n = 0; n < 2; ++n)
#pragma unroll
                            for (int e = 0; e < 4; ++e) __hip_atomic_fetch_add(rowp + bj * HALF + 4 * n + e, gt * acc[ai][bj][m][n][e], __ATOMIC_RELAXED, __HIP_MEMORY_SCOPE_AGENT);
                } }
    }
};
}

#define XB_TMO      128
#define XB_XCNT(j)  (256  + 64 * (j))
#define XB_XSUB(j)  (1280 + 64 * (j))
#define XB_XGEN(j)  (2304 + 64 * (j))
#define XB_TOP      3328
#define XB_TOPGEN   3392
#define XCD_BAR_WORDS 3456
#define XB_SPIN_CAP (1u << 18)
__device__ __forceinline__ unsigned xb_ld(unsigned* p)              { return __hip_atomic_load(p, __ATOMIC_RELAXED, __HIP_MEMORY_SCOPE_AGENT); }
__device__ __forceinline__ unsigned xb_add(unsigned* p, unsigned v) { return __hip_atomic_fetch_add(p, v, __ATOMIC_RELAXED, __HIP_MEMORY_SCOPE_AGENT); }
__device__ __forceinline__ unsigned xb_xcc_id() { return (unsigned)__builtin_amdgcn_s_getreg((3 << 11) | 20) & 0xFu; }
#define XB_SPIN(cond, bar) do { unsigned _sp = 0; while (cond) { __builtin_amdgcn_s_sleep(1); \
    if ((++_sp & 255u) == 0u) { if (xb_ld(&(bar)[XB_TMO])) break; if (_sp > XB_SPIN_CAP) { atomicAdd(&(bar)[XB_TMO], 1u); break; } } } } while (0)
struct XcdBarrier { unsigned* bar; unsigned x; volatile LAS unsigned* st; };
__device__ __forceinline__ XcdBarrier xcd_barrier_post(unsigned* bar, volatile LAS unsigned* st) {
    XcdBarrier b; b.bar = bar; b.x = xb_xcc_id(); b.st = st;
    if (threadIdx.x == 0) (void)xb_add(&bar[XB_XCNT(b.x)], 1u);
    return b;
}
__device__ __forceinline__ void xcd_barrier_complete(unsigned* bar, unsigned x, unsigned& nloc, unsigned& nx) {
    const unsigned G = gridDim.x * gridDim.y * gridDim.z;
    unsigned sum, cnt, mine, sp = 0u;
    for (;;) {
        sum = 0u; cnt = 0u; mine = 0u;
#pragma unroll
        for (unsigned j = 0; j < 16; ++j) { const unsigned c = xb_ld(&bar[XB_XCNT(j)]); sum += c; cnt += (c > 0u) ? 1u : 0u; mine = (j == x) ? c : mine; }
        if (sum == G) break;
        __builtin_amdgcn_s_sleep(1);
        if ((++sp & 255u) == 0u) { if (xb_ld(&bar[XB_TMO])) break; if (sp > XB_SPIN_CAP) { atomicAdd(&bar[XB_TMO], 1u); break; } }
    }
    nloc = mine > 0u ? mine : 1u; nx = cnt > 0u ? cnt : 1u;
}
__device__ __forceinline__ void xcd_barrier(const XcdBarrier& b, const int tid) {
    asm volatile("s_waitcnt vmcnt(0)" ::: "memory");
    __syncthreads();
    if (tid == 0) {
        unsigned* bar = b.bar;
        __builtin_amdgcn_s_waitcnt(0);
        unsigned nloc = b.st[0], nx = b.st[1];
        if (nloc == 0u) { xcd_barrier_complete(bar, b.x, nloc, nx); b.st[0] = nloc; b.st[1] = nx; }
        const unsigned old = xb_add(&bar[XB_XSUB(b.x)], 1u);
        const unsigned gen = old / nloc;
        if (old + 1u == (gen + 1u) * nloc) {
            __builtin_amdgcn_fence(__ATOMIC_RELEASE, "agent");
            asm volatile("s_waitcnt vmcnt(0)" ::: "memory");
            const unsigned og = xb_add(&bar[XB_TOP], 1u);
            const unsigned tg = og / nx;
            if (og + 1u == (tg + 1u) * nx) xb_add(&bar[XB_TOPGEN], 1u);
            else XB_SPIN(xb_ld(&bar[XB_TOPGEN]) == tg, bar);
            __builtin_amdgcn_fence(__ATOMIC_ACQUIRE, "agent");
            xb_add(&bar[XB_XGEN(b.x)], 1u);
            asm volatile("s_waitcnt vmcnt(0)" ::: "memory");
        } else {
            XB_SPIN(xb_ld(&bar[XB_XGEN(b.x)]) == gen, bar);
            __builtin_amdgcn_fence(__ATOMIC_ACQUIRE, "agent");
            asm volatile("s_waitcnt vmcnt(0)" ::: "memory");
        }
    }
    __syncthreads();
}

constexpr size_t MiB = 1u << 20;
constexpr size_t WS_CTL = 0, CTL_ZERO_BYTES = 1 * MiB;
constexpr int CW_BAR = 4096;
constexpr int CW_MOE = 16384;
constexpr size_t WS_EIDX = 1 * MiB, WS_GATE = WS_EIDX + 256 * 1024, WS_ROWTOK = WS_EIDX + 512 * 1024, WS_ROWGATE = 2 * MiB, WS_TEXP = 2 * MiB + 512 * 1024, WS_SEGEND = WS_TEXP + 4096, WS_NT = WS_TEXP + 8192;
constexpr size_t WS_SLOTOF = 2 * MiB + 768 * 1024;
constexpr size_t WS_BON = 3 * MiB, WS_COS = 4 * MiB, WS_SIN = 6 * MiB;
constexpr size_t WS_WIN = 8 * MiB, WS_WLORA = 15 * MiB, WS_WB = 16 * MiB, WS_WG = 18 * MiB, WS_WOUT = 26 * MiB, WS_W13 = 28 * MiB  , WS_W2D = 50 * MiB, WS_W2M = 50 * MiB, WS_H8 = 72 * MiB  ;
constexpr size_t WS_H = 104 * MiB, WS_Y = 168 * MiB, WS_BIG = 232 * MiB;
constexpr size_t WS_RW = WS_BIG, WS_WDEC = WS_BIG, WS_AG = WS_BIG + 32 * MiB, WS_SB = WS_BIG + 64 * MiB, WS_RET = WS_BIG + 112 * MiB, WS_CV = WS_BIG + 176 * MiB, WS_Y0 = WS_CV;
constexpr size_t WS_RKVS = WS_BIG + 208 * MiB, WS_ALORA = WS_BIG + 256 * MiB, WS_RHAT = WS_ALORA, WS_KV = WS_BIG + 272 * MiB, WS_SST = WS_WDEC  , WS_PQ = WS_BIG + 304 * MiB  , WS_END = WS_BIG + 368 * MiB;
constexpr size_t WS_BALL = WS_BIG, WS_MERGED = WS_BIG + 256 * MiB, WS_HID = WS_BIG, WS_XS = WS_BIG, WS_YS = WS_XS, WS_HIDM = WS_BIG + 132 * MiB;
static_assert(WS_HIDM + (size_t)MPAD * DFE * 2 <= WS_END && WS_MERGED + (size_t)T * D * 2 <= WS_END && WS_W2M + (size_t)NEXP * D * DFE * 2 <= WS_H8, "ws map");
static_assert(WS_W13 + (size_t)NEXP * 2 * DFE * D <= WS_W2M && WS_W13 + (size_t)2 * DFF * D <= WS_W2D && WS_W2M + (size_t)NEXP * D * DFE * 2 <= WS_H8 && WS_H8 + (size_t)T * D <= WS_H, "ws map weights");

constexpr int LDS_BYTES = 147456, RING_BYTES = 131072, MISC_OFF = RING_BYTES + 320;

struct Args { const float* in[32]; float* out; unsigned char* ws; int ph_lo, ph_hi; };
#define CAS __attribute__((address_space(4)))
struct Ctx {
    LAS unsigned char* lds; unsigned char* ws; float* out; const float* const CAS* in;
    int tid, lane, wave, G, bid;
};
__device__ __forceinline__ const CAS Args* ka_ptr() { const CAS Args* p = (const CAS Args*)__builtin_amdgcn_kernarg_segment_ptr(); asm volatile("" : "+s"(p)); return p; }
extern __shared__ __attribute__((aligned(16))) unsigned char lds_raw[];
__device__ __forceinline__ Ctx make_ctx(int wv) {
    const CAS Args* ka = ka_ptr();
    Ctx C; C.lds = (LAS unsigned char*)lds_raw; C.ws = ka->ws; C.out = ka->out; C.in = ka->in;
    int g_ = gridDim.x, b_ = blockIdx.x, w_ = wv; asm volatile("" : "+s"(g_), "+s"(b_), "+s"(w_));
    int ln_; asm volatile("v_mbcnt_lo_u32_b32 %0, -1, 0\n\tv_mbcnt_hi_u32_b32 %0, -1, %0" : "=v"(ln_));
    C.lane = ln_; C.wave = w_; C.tid = w_ * 64 + ln_; C.G = g_; C.bid = b_;
    return C;
}
enum { I_X = 0, I_NORM_MIX, I_W_IN, I_RW_MU, I_RW_W0, I_RW_W2, I_RW_A0, I_RW_A2, I_RW_G2, I_RW_KK, I_RW_KA, I_RW_RK, I_RW_LNW, I_RW_LNB, I_SB_QN, I_SB_KN, I_RET_GN,
       I_CONV_DW, I_CONV_B, I_CONV_LNW, I_CONV_LNB, I_W_GATE, I_W_BRANCH, I_W_OUT, I_NORM_FFN, I_FFN_W1, I_FFN_W3, I_FFN_W2, I_ROUTER, I_MOE_W1, I_MOE_W3, I_MOE_W2 };

__device__ __forceinline__ void ph_prologue_(const Ctx& C) {
    const size_t gid = (size_t)C.bid * NTHR + C.tid, gsz = (size_t)C.G * NTHR;
    float* cs = (float*)(C.ws + WS_COS); float* sn = (float*)(C.ws + WS_SIN);
    for (size_t i = gid; i < (size_t)SEQ * 32; i += gsz) {
        const int pos = (int)(i >> 5), j = (int)(i & 31);
        const float inv = (float)pow(10000.0, -(double)(2 * j) / 64.0);
        const float ang = (float)pos * inv;
        cs[i] = (float)cos((double)ang); sn[i] = (float)sin((double)ang);
    }
}

__device__ __forceinline__ int dest_row(int mode, int roff, int which, int n) {
    if (mode == 0) return roff + n;
    if (mode == 1) { const int pn = n >> 6, oc = n & 63; return 256 * pn + 128 * (roff >> 1) + 32 * (oc >> 4) + 8 * ((oc >> 2) & 3) + 4 * (roff & 1) + (oc & 3); }
    return roff + 256 * (n >> 7) + 128 * which + (n & 127);
}
__device__ __forceinline__ void xpose_item(const float* W, int K, int N, bf16* WT, int mode, int roff, int which, LAS float* scr, int item, int lane) {
    const int nblk = N / 32, kb = item / nblk, nb = item % nblk, k0 = 64 * kb, n0 = 32 * nb;
#pragma unroll
    for (int i = 0; i < 8; ++i) { const int kk = (lane >> 3) + 8 * i, c4 = (lane & 7) * 4; const f32x4 v = *(const f32x4*)(W + (size_t)(k0 + kk) * N + n0 + c4);
        scr[kk * 33 + c4] = v.x; scr[kk * 33 + c4 + 1] = v.y; scr[kk * 33 + c4 + 2] = v.z; scr[kk * 33 + c4 + 3] = v.w; }
    asm volatile("s_waitcnt lgkmcnt(0)" ::: "memory");
    const int c = lane & 7;
#pragma unroll
    for (int j = 0; j < 4; ++j) { const int n = (lane >> 3) + 8 * j; const LAS float* s = scr + (8 * c) * 33 + n;
        u32x4 o; o.x = cvt_pk_bf16(s[0 * 33], s[1 * 33]); o.y = cvt_pk_bf16(s[2 * 33], s[3 * 33]); o.z = cvt_pk_bf16(s[4 * 33], s[5 * 33]); o.w = cvt_pk_bf16(s[6 * 33], s[7 * 33]);
        *(u32x4*)(WT + (size_t)dest_row(mode, roff, which, n0 + n) * K + k0 + 8 * c) = o; }
    asm volatile("s_waitcnt lgkmcnt(0)" ::: "memory");
}
__device__ __forceinline__ void xpose_item8(const float* W, int K, int N, unsigned char* WT, int mode, int roff, int which, LAS float* scr, int item, int lane) {
    const int nblk = N / 32, kb = item / nblk, nb = item % nblk, k0 = 64 * kb, n0 = 32 * nb;
#pragma unroll
    for (int i = 0; i < 8; ++i) { const int kk = (lane >> 3) + 8 * i, c4 = (lane & 7) * 4; const f32x4 v = *(const f32x4*)(W + (size_t)(k0 + kk) * N + n0 + c4);
        scr[kk * 33 + c4] = v.x; scr[kk * 33 + c4 + 1] = v.y; scr[kk * 33 + c4 + 2] = v.z; scr[kk * 33 + c4 + 3] = v.w; }
    asm volatile("s_waitcnt lgkmcnt(0)" ::: "memory");
    const int c = lane & 3;
#pragma unroll
    for (int j = 0; j < 2; ++j) { const int n = (lane >> 2) + 16 * j; const LAS float* sp = scr + (16 * c) * 33 + n;
        u32x4 o;
        o.x = pk4_fp8(sp[0 * 33] * F8_MUL_W, sp[1 * 33] * F8_MUL_W, sp[2 * 33] * F8_MUL_W, sp[3 * 33] * F8_MUL_W);
        o.y = pk4_fp8(sp[4 * 33] * F8_MUL_W, sp[5 * 33] * F8_MUL_W, sp[6 * 33] * F8_MUL_W, sp[7 * 33] * F8_MUL_W);
        o.z = pk4_fp8(sp[8 * 33] * F8_MUL_W, sp[9 * 33] * F8_MUL_W, sp[10 * 33] * F8_MUL_W, sp[11 * 33] * F8_MUL_W);
        o.w = pk4_fp8(sp[12 * 33] * F8_MUL_W, sp[13 * 33] * F8_MUL_W, sp[14 * 33] * F8_MUL_W, sp[15 * 33] * F8_MUL_W);
        *(u32x4*)(WT + (size_t)dest_row(mode, roff, which, n0 + n) * K + k0 + 16 * c) = o; }
    asm volatile("s_waitcnt lgkmcnt(0)" ::: "memory");
}
__device__ __forceinline__ void ph_weights_(const Ctx& C, int l, int part, int first_wg, int nwg) {
    LAS float* scr = (LAS float*)(C.lds + C.wave * 16384);
    const int gw = (C.bid - first_wg) * NWAVES + C.wave, NGW = nwg * NWAVES, lane = C.lane;
    unsigned char* ws = C.ws;
    const bool moe = (l & 1);
    const int l2 = l >> 1;
    constexpr int IT_IN = (D / 64) * (NIN / 32), IT_B = (256 / 64) * (D / 32), IT_G = (D / 64) * (D / 32), IT_O = IT_G;
    constexpr int IT_F1 = (D / 64) * (DFF / 32), IT_F2 = (DFF / 64) * (D / 32), IT_M1 = (D / 64) * (DFE / 32), IT_M2 = (DFE / 64) * (D / 32);
    const int n_fixed = IT_IN + 4 * IT_B + 4 * IT_G + IT_O;
    if (part == 1) {
        if (C.bid < first_wg) return;
        const int n1 = moe ? NEXP * IT_M2 : (2 * IT_F1 + IT_F2);
        for (int it = gw; it < n1; it += NGW) {
            int r = it;
            if (!moe) {
                if (r < IT_F1) { xpose_item8(C.in[I_FFN_W1] + (size_t)l2 * D * DFF, D, DFF, ws + WS_W13, 2, 0, 0, scr, r, lane); continue; } r -= IT_F1;
                if (r < IT_F1) { xpose_item8(C.in[I_FFN_W3] + (size_t)l2 * D * DFF, D, DFF, ws + WS_W13, 2, 0, 1, scr, r, lane); continue; } r -= IT_F1;
                xpose_item(C.in[I_FFN_W2] + (size_t)l2 * DFF * D, DFF, D, (bf16*)(ws + WS_W2D), 0, 0, 0, scr, r, lane);
            } else { const int e = r / IT_M2; r -= e * IT_M2;
                xpose_item(C.in[I_MOE_W2] + ((size_t)l2 * NEXP + e) * DFE * D, DFE, D, (bf16*)(ws + WS_W2M), 0, e * D, 0, scr, r, lane); }
        }
        return;
    }
    const int n_ffn = moe ? (NEXP * 2 * IT_M1) : 0;
    for (int it = gw; it < n_fixed + n_ffn; it += NGW) {
        int r = it;
        if (r < IT_IN) { xpose_item(C.in[I_W_IN] + (size_t)l * D * NIN, D, NIN, (bf16*)(ws + WS_WIN), 0, 0, 0, scr, r, lane); continue; } r -= IT_IN;
        if (r < 4 * IT_B) { const int i = r / IT_B; xpose_item(C.in[I_W_BRANCH] + ((size_t)l * 4 + i) * 256 * D, 256, D, (bf16*)(ws + WS_WB), 0, 1024 * i, 0, scr, r % IT_B, lane); continue; } r -= 4 * IT_B;
        if (r < 4 * IT_G) { const int i = r / IT_G; xpose_item8(C.in[I_W_GATE] + ((size_t)l * 4 + i) * D * D, D, D, ws + WS_WG, 1, i, 0, scr, r % IT_G, lane); continue; } r -= 4 * IT_G;
        if (r < IT_O) { xpose_item(C.in[I_W_OUT] + (size_t)l * D * D, D, D, (bf16*)(ws + WS_WOUT), 0, 0, 0, scr, r, lane); continue; } r -= IT_O;
        { const int per = 2 * IT_M1, e = r / per; r -= e * per;
          if (r < IT_M1) { xpose_item8(C.in[I_MOE_W1] + ((size_t)l2 * NEXP + e) * D * DFE, D, DFE, ws + WS_W13, 2, e * 2 * DFE, 0, scr, r, lane); continue; } r -= IT_M1;
          xpose_item8(C.in[I_MOE_W3] + ((size_t)l2 * NEXP + e) * D * DFE, D, DFE, ws + WS_W13, 2, e * 2 * DFE, 1, scr, r, lane); }
    }
    bf16* WL = (bf16*)(ws + WS_WLORA);
    const float* w2 = C.in[I_RW_W2] + (size_t)l * 64 * 256; const float* a2 = C.in[I_RW_A2] + (size_t)l * 64 * 256; const float* g2 = C.in[I_RW_G2] + (size_t)l * 128 * 256;
    for (int i = C.bid * NTHR + C.tid; i < 768 * 256; i += C.G * NTHR) {
        const int n = i >> 8, k = i & 255; float v = 0.f;
        if (n < 256) { if (k < 64) v = w2[k * 256 + n]; }
        else if (n < 512) { if (k >= 64 && k < 128) v = a2[(k - 64) * 256 + (n - 256)]; }
        else { if (k >= 128) v = g2[(k - 128) * 256 + (n - 512)]; }
        WL[i] = f2bf(v);
    }
}

__device__ __forceinline__ void ph_norm_(const Ctx& C, const float* gain, bool route, const float* router, int moe_idx, bool combine = false, const float* src = nullptr, bool want_bf16 = true) {
    const int gw = C.bid * NWAVES + C.wave, NGW = C.G * NWAVES, lane = C.lane;
    bf16* H = (bf16*)(C.ws + WS_H);
    f32x4 g[4];
#pragma unroll
    for (int j = 0; j < 4; ++j) g[j] = *((const f32x4*)gain + lane + 64 * j);
    LAS unsigned* lcnt = (LAS unsigned*)(C.lds);
    if (route) { if (C.tid < 8) lcnt[C.tid] = 0u; __syncthreads(); }
    int* eidx = (int*)(C.ws + WS_EIDX); float* gate = (float*)(C.ws + WS_GATE);
    constexpr int NR = 2;
    for (int mb = gw; mb < T; mb += NR * NGW) {
        f32x4 vv[NR][4]; u32x2 ya[NR][4], yb[NR][4]; float g0v[NR], g1v[NR];
#pragma unroll
        for (int r = 0; r < NR; ++r) { const int m = mb + r * NGW; if (m < T) { const f32x4* xr = (const f32x4*)((src ? src : C.out) + (size_t)m * D) + lane;
#pragma unroll
            for (int j = 0; j < 4; ++j) vv[r][j] = xr[64 * j];
            if (src) { f32x4* xo = (f32x4*)(C.out + (size_t)m * D) + lane;
#pragma unroll
                for (int j = 0; j < 4; ++j) xo[64 * j] = vv[r][j]; }
            if (combine) { const int* slotof = (const int*)(C.ws + WS_SLOTOF); const float* gt = (const float*)(C.ws + WS_GATE); const bf16* YS = (const bf16*)(C.ws + WS_YS);
                const int s0 = slotof[2 * m], s1 = slotof[2 * m + 1]; g0v[r] = gt[2 * m]; g1v[r] = gt[2 * m + 1];
                const u32x2* y0 = (const u32x2*)(YS + (size_t)s0 * D) + lane; const u32x2* y1 = (const u32x2*)(YS + (size_t)s1 * D) + lane;
#pragma unroll
                for (int j = 0; j < 4; ++j) { ya[r][j] = y0[64 * j]; yb[r][j] = y1[64 * j]; } } } }
#pragma unroll
        for (int r = 0; r < NR; ++r) { const int m = mb + r * NGW; if (m < T) {
        f32x4* xr = (f32x4*)(C.out + (size_t)m * D) + lane;
        f32x4 v[4]; float s = 0.f;
#pragma unroll
        for (int j = 0; j < 4; ++j) v[j] = vv[r][j];
        if (combine) {
            const float g0 = g0v[r], g1 = g1v[r];
#pragma unroll
            for (int j = 0; j < 4; ++j) { const u32x2 a = ya[r][j], b = yb[r][j];
                v[j].x += g0 * bflo(a.x) + g1 * bflo(b.x); v[j].y += g0 * bfhi(a.x) + g1 * bfhi(b.x); v[j].z += g0 * bflo(a.y) + g1 * bflo(b.y); v[j].w += g0 * bfhi(a.y) + g1 * bfhi(b.y);
                xr[64 * j] = v[j]; }
        }
#pragma unroll
        for (int j = 0; j < 4; ++j) s += (v[j].x * v[j].x + v[j].y * v[j].y) + (v[j].z * v[j].z + v[j].w * v[j].w);
        const float rs = 1.0f / sqrtf(wave_sum(s, C.lane) * (1.f / D) + 1e-6f);
        unsigned long long* o8 = (unsigned long long*)(H + (size_t)m * D) + lane;
#pragma unroll
        for (int j = 0; j < 4; ++j) { v[j] = v[j] * rs * g[j]; if (want_bf16) o8[64 * j] = (unsigned long long)cvt_pk_bf16(v[j].x, v[j].y) | ((unsigned long long)cvt_pk_bf16(v[j].z, v[j].w) << 32);
            ((unsigned*)(C.ws + WS_H8 + (size_t)m * D))[lane + 64 * j] = pk4_fp8(v[j].x * F8_MUL_X, v[j].y * F8_MUL_X, v[j].z * F8_MUL_X, v[j].w * F8_MUL_X); }
        if (route) {
            float lg[8];
#pragma unroll
            for (int e = 0; e < 8; ++e) lg[e] = 0.f;
#pragma unroll
            for (int j = 0; j < 4; ++j)
#pragma unroll
                for (int q = 0; q < 4; ++q) { const int k = 4 * (lane + 64 * j) + q; const f32x4 r0 = *(const f32x4*)(router + (size_t)k * 8), r1 = *(const f32x4*)(router + (size_t)k * 8 + 4); const float hv = v[j][q];
                    lg[0] += hv * r0.x; lg[1] += hv * r0.y; lg[2] += hv * r0.z; lg[3] += hv * r0.w; lg[4] += hv * r1.x; lg[5] += hv * r1.y; lg[6] += hv * r1.z; lg[7] += hv * r1.w; }
#pragma unroll
            for (int e = 0; e < 8; ++e) lg[e] = wave_sum(lg[e], C.lane);
            int e0 = 0; float b0 = lg[0];
#pragma unroll
            for (int e = 1; e < 8; ++e) if (lg[e] > b0) { b0 = lg[e]; e0 = e; }
            int e1 = -1; float b1 = -3.0e38f;
#pragma unroll
            for (int e = 0; e < 8; ++e) if (e != e0 && lg[e] > b1) { b1 = lg[e]; e1 = e; }
            const float p1 = __expf(b1 - b0), inv = 1.f / (1.f + p1);
            if (lane == 0) { eidx[2 * m] = e0; eidx[2 * m + 1] = e1; gate[2 * m] = inv; gate[2 * m + 1] = p1 * inv; atomicAdd((unsigned*)&lcnt[e0], 1u); atomicAdd((unsigned*)&lcnt[e1], 1u); }
        }
        } }
    }
    if (route) { __syncthreads(); if (C.tid < 8) { unsigned* cw = (unsigned*)(C.ws + WS_CTL) + CW_MOE + moe_idx * 64; atomicAdd(&cw[C.tid], lcnt[C.tid]); } }
}

__device__ __forceinline__ void ph_rw_prep_(const Ctx& C, int l) {
    const bf16* RW = (const bf16*)(C.ws + WS_RW); bf16* RKVS = (bf16*)(C.ws + WS_RKVS); bf16* AL = (bf16*)(C.ws + WS_ALORA);
    const float* mu = C.in[I_RW_MU] + (size_t)l * 1024;
    const size_t gid = (size_t)C.bid * NTHR + C.tid, gsz = (size_t)C.G * NTHR;
    constexpr int NI = 4;
    for (size_t it0 = gid; it0 < (size_t)T * 128; it0 += NI * gsz) {
        u32x4 cuv[NI], pvv[NI];
#pragma unroll
        for (int r = 0; r < NI; ++r) { const size_t it = it0 + r * gsz; cuv[r] = (u32x4){0u, 0u, 0u, 0u}; pvv[r] = cuv[r];
            if (it < (size_t)T * 128) { const int m = (int)(it >> 7), c8 = (int)(it & 127) * 8, t = m & (SEQ - 1);
                cuv[r] = *(const u32x4*)(RW + (size_t)m * 1024 + c8); if (t) pvv[r] = *(const u32x4*)(RW + (size_t)(m - 1) * 1024 + c8); } }
#pragma unroll
        for (int r = 0; r < NI; ++r) { const size_t it = it0 + r * gsz; if (it < (size_t)T * 128) {
        const int m = (int)(it >> 7), c8 = (int)(it & 127) * 8;
        float a[8], b[8]; unpack8(cuv[r], a); unpack8(pvv[r], b);
        const f32x4 m0 = *(const f32x4*)(mu + c8), m1 = *(const f32x4*)(mu + c8 + 4);
        const float mm[8] = {m0.x, m0.y, m0.z, m0.w, m1.x, m1.y, m1.z, m1.w};
#pragma unroll
        for (int e = 0; e < 8; ++e) a[e] = a[e] + (b[e] - a[e]) * mm[e];
        if (c8 < 768) { *(u32x4*)(RKVS + (size_t)m * 768 + c8) = pack8(a); }
        else {
            if (c8 < 832) {
#pragma unroll
                for (int e = 0; e < 8; ++e) a[e] = 1.f - 2.f * __builtin_amdgcn_rcpf(1.f + __builtin_amdgcn_exp2f(2.f * LOG2E * a[e]));
            } else if (c8 >= 896) {
#pragma unroll
                for (int e = 0; e < 8; ++e) a[e] = sigm(a[e]);
            }
            *(u32x4*)(AL + (size_t)m * 256 + (c8 - 768)) = pack8(a);
        } } }
    }
}

__device__ __forceinline__ void ph_sb_prep_(const Ctx& C, int l) {
    bf16* SB = (bf16*)(C.ws + WS_SB);
    const int gw = C.bid * NWAVES + C.wave, NGW = C.G * NWAVES, lane = C.lane;
    const bool isk = lane >= 32; const int d0 = (lane & 7) * 8;
    const float* gn = (isk ? C.in[I_SB_KN] : C.in[I_SB_QN]) + (size_t)l * 64 + d0;
    float gg[8];
#pragma unroll
    for (int e = 0; e < 8; ++e) gg[e] = gn[e] * (isk ? 1.f : 0.125f * LOG2E);
    constexpr int NR = 4;
    for (int mb = gw; mb < T; mb += NR * NGW) {
        u32x4 uu[NR];
#pragma unroll
        for (int r = 0; r < NR; ++r) { const int m = mb + r * NGW; uu[r] = (u32x4){0u, 0u, 0u, 0u}; if (m < T) uu[r] = *(const u32x4*)(SB + (size_t)m * 768 + lane * 8); }
#pragma unroll
        for (int r = 0; r < NR; ++r) { const int m = mb + r * NGW; if (m < T) {
            bf16* p = SB + (size_t)m * 768 + lane * 8;
            float a[8]; unpack8(uu[r], a);
            float ss = 0.f;
#pragma unroll
            for (int e = 0; e < 8; ++e) ss += a[e] * a[e];
            ss += shx(ss, 1, lane); ss += shx(ss, 2, lane); ss += shx(ss, 4, lane);
            const float rs = 1.0f / sqrtf(ss * (1.f / 64.f) + 1e-6f);
#pragma unroll
            for (int e = 0; e < 8; ++e) a[e] = a[e] * rs * gg[e];
            *(u32x4*)p = pack8(a); } }
    }
}

__device__ __forceinline__ void ph_conv_(const Ctx& C, int l) {
    const bf16* CV = (const bf16*)(C.ws + WS_CV); bf16* Y = (bf16*)(C.ws + WS_Y);
    LAS float* U = (LAS float*)(C.lds); LAS float* OC = (LAS float*)(C.lds + 65536);
    const int tid = C.tid, c = tid & 255, half = tid >> 8;
    const float* dw = C.in[I_CONV_DW] + (size_t)l * 31 * 256; const float db = C.in[I_CONV_B][l * 256 + c];
    float dwr[31];
#pragma unroll
    for (int j = 0; j < 31; ++j) dwr[j] = dw[j * 256 + c];
    const float* lnw = C.in[I_CONV_LNW] + (size_t)l * 256; const float* lnb = C.in[I_CONV_LNB] + (size_t)l * 256;
    for (int u = C.bid; u < T / 32; u += C.G) {
        const int m0 = u * 32, t0 = m0 & (SEQ - 1);
        for (int it = tid; it < 62 * 32; it += NTHR) {
            const int r = it >> 5, c8 = (it & 31) * 8, tt = t0 - 30 + r; float a[8], b[8];
            if (tt >= 0) { const size_t mm = (size_t)(m0 - 30 + r); unpack8(*(const u32x4*)(CV + mm * 512 + c8), a); unpack8(*(const u32x4*)(CV + mm * 512 + 256 + c8), b);
#pragma unroll
                for (int e = 0; e < 8; ++e) a[e] = a[e] * sigm(b[e]); }
            else {
#pragma unroll
                for (int e = 0; e < 8; ++e) a[e] = 0.f; }
#pragma unroll
            for (int e = 0; e < 8; ++e) U[r * 256 + c8 + e] = a[e];
        }
        __syncthreads();
        { float win[46];
#pragma unroll
          for (int i = 0; i < 46; ++i) win[i] = U[(half * 16 + i) * 256 + c];
#pragma unroll
          for (int tt = 0; tt < 16; ++tt) { float acc = db;
#pragma unroll
              for (int j = 0; j < 31; ++j) acc += dwr[j] * win[tt + j];
              OC[(half * 16 + tt) * 256 + c] = acc; } }
        __syncthreads();
#pragma unroll 1
        for (int q = 0; q < 4; ++q) { const int tl = C.wave * 4 + q; float v[4]; float s = 0.f;
#pragma unroll
            for (int i = 0; i < 4; ++i) { v[i] = OC[tl * 256 + C.lane + 64 * i]; s += v[i]; }
            const float mean = wave_sum(s, C.lane) * (1.f / 256.f); float s2 = 0.f;
#pragma unroll
            for (int i = 0; i < 4; ++i) { v[i] -= mean; s2 += v[i] * v[i]; }
            const float rstd = 1.0f / sqrtf(wave_sum(s2, C.lane) * (1.f / 256.f) + 1e-5f);
#pragma unroll
            for (int i = 0; i < 4; ++i) { const int cc = C.lane + 64 * i; const float y = v[i] * rstd * lnw[cc] + lnb[cc]; Y[(size_t)(m0 + tl) * 1024 + 768 + cc] = f2bf(y * sigm(y)); } }
        __syncthreads();
    }
}

__device__ __forceinline__ float ret_log2gamma(int h) { return log2f(1.0f - exp2f(-5.0f - (float)h)); }
__device__ __forceinline__ void ret_load_rot(const Ctx& C, const bf16* RET, int m0, int coff, float scale, LAS float* dst) {
    const int s = C.tid >> 3, d0 = (C.tid & 7) * 4;
    const float* cs = (const float*)(C.ws + WS_COS); const float* sn = (const float*)(C.ws + WS_SIN);
    const int pos = (m0 + s) & (SEQ - 1);
    const u32x2 a = *(const u32x2*)(RET + (size_t)(m0 + s) * 1024 + coff + d0), b = *(const u32x2*)(RET + (size_t)(m0 + s) * 1024 + coff + 32 + d0);
    const float x1[4] = {bflo(a.x), bfhi(a.x), bflo(a.y), bfhi(a.y)}, x2[4] = {bflo(b.x), bfhi(b.x), bflo(b.y), bfhi(b.y)};
    const f32x4 cv = *(const f32x4*)(cs + (size_t)pos * 32 + d0), sv = *(const f32x4*)(sn + (size_t)pos * 32 + d0);
#pragma unroll
    for (int e = 0; e < 4; ++e) { dst[s * 65 + d0 + e] = (x1[e] * cv[e] - x2[e] * sv[e]) * scale; dst[s * 65 + 32 + d0 + e] = (x1[e] * sv[e] + x2[e] * cv[e]) * scale; }
}
__device__ __forceinline__ void ph_ret_kv_(const Ctx& C) {
    const bf16* RET = (const bf16*)(C.ws + WS_RET); float* KV = (float*)(C.ws + WS_KV);
    LAS float* KD = (LAS float*)(C.lds); LAS float* VV = (LAS float*)(C.lds + 32768);
    const int tid = C.tid;
    for (int u = C.bid; u < 2048; u += C.G) {
        const int bh = u >> 8, ch = u & 255, b = bh >> 2, h = bh & 3, m0 = b * SEQ + ch * 64;
        const float lg = ret_log2gamma(h);
        ret_load_rot(C, RET, m0, 256 + h * 64, 0.125f, KD);
        { const int s = tid >> 3, e0 = (tid & 7) * 8; float a[8]; unpack8(*(const u32x4*)(RET + (size_t)(m0 + s) * 1024 + 512 + h * 64 + e0), a);
          const float dec = exp2f(lg * (float)(63 - s));
#pragma unroll
          for (int e = 0; e < 8; ++e) VV[s * 64 + e0 + e] = a[e] * dec; }
        __syncthreads();
        const int d = tid >> 3, e0 = (tid & 7) * 8; float acc[8];
#pragma unroll
        for (int e = 0; e < 8; ++e) acc[e] = 0.f;
#pragma unroll 4
        for (int s = 0; s < 64; ++s) { const float kd = KD[s * 65 + d]; const f32x4 v0 = *(const LAS f32x4*)(VV + s * 64 + e0), v1 = *(const LAS f32x4*)(VV + s * 64 + e0 + 4);
            acc[0] += kd * v0.x; acc[1] += kd * v0.y; acc[2] += kd * v0.z; acc[3] += kd * v0.w; acc[4] += kd * v1.x; acc[5] += kd * v1.y; acc[6] += kd * v1.z; acc[7] += kd * v1.w; }
        float* o = KV + (size_t)u * 4096 + d * 64 + e0;
        *(f32x4*)o = (f32x4){acc[0], acc[1], acc[2], acc[3]}; *(f32x4*)(o + 4) = (f32x4){acc[4], acc[5], acc[6], acc[7]};
        __syncthreads();
    }
}
__device__ __forceinline__ void ph_ret_scan_(const Ctx& C) {
    float* KV = (float*)(C.ws + WS_KV);
    const int wg0 = (C.G >= 256) ? 128 : 0, nw = C.G - wg0;
    for (int i = (C.bid - wg0) * NTHR + C.tid; i < 8 * 4096 && C.bid >= wg0; i += nw * NTHR) {
        const int bh = i >> 12, el = i & 4095, h = bh & 3;
        const float cd = exp2f(ret_log2gamma(h) * 64.f);
        float* p = KV + (size_t)bh * 256 * 4096 + el; float S = 0.f;
#pragma unroll 1
        for (int c = 0; c < 256; c += 32) { float kv[32];
#pragma unroll
            for (int q = 0; q < 32; ++q) kv[q] = p[(size_t)(c + q) * 4096];
#pragma unroll
            for (int q = 0; q < 32; ++q) { p[(size_t)(c + q) * 4096] = S; S = S * cd + kv[q]; } }
    }
}
__device__ __forceinline__ void ph_ret_out_(const Ctx& C, int l, int first_wg, int nwg) {
    const bf16* RET = (const bf16*)(C.ws + WS_RET); const float* KV = (const float*)(C.ws + WS_KV); bf16* Y = (bf16*)(C.ws + WS_Y);
    LAS float* Q = (LAS float*)(C.lds); LAS float* Kk = (LAS float*)(C.lds + 16640); LAS float* VV = (LAS float*)(C.lds + 33280); LAS float* SS = (LAS float*)(C.lds + 49664); LAS float* SC = (LAS float*)(C.lds + 66048);
    const int tid = C.tid; const float* gn = C.in[I_RET_GN] + (size_t)l * 256;
    for (int u = C.bid - first_wg; u < 2048; u += nwg) {
        const int bh = u >> 8, ch = u & 255, b = bh >> 2, h = bh & 3, m0 = b * SEQ + ch * 64;
        const float lg = ret_log2gamma(h);
        ret_load_rot(C, RET, m0, h * 64, 1.0f, Q);
        ret_load_rot(C, RET, m0, 256 + h * 64, 0.125f, Kk);
        { const int s = tid >> 3, e0 = (tid & 7) * 8; float a[8]; unpack8(*(const u32x4*)(RET + (size_t)(m0 + s) * 1024 + 512 + h * 64 + e0), a);
#pragma unroll
          for (int e = 0; e < 8; ++e) VV[s * 64 + e0 + e] = a[e];
          const float* sp = KV + (size_t)u * 4096 + s * 64 + e0; const f32x4 s0 = *(const f32x4*)sp, s1 = *(const f32x4*)(sp + 4);
          *(LAS f32x4*)(SS + s * 64 + e0) = s0; *(LAS f32x4*)(SS + s * 64 + e0 + 4) = s1; }
        __syncthreads();
        const int t = tid >> 3, g8 = tid & 7;
        { float sc[8];
#pragma unroll
          for (int i = 0; i < 8; ++i) sc[i] = 0.f;
#pragma unroll 4
          for (int d = 0; d < 64; ++d) { const float qv = Q[t * 65 + d];
#pragma unroll
              for (int i = 0; i < 8; ++i) sc[i] += qv * Kk[(g8 * 8 + i) * 65 + d]; }
#pragma unroll
          for (int i = 0; i < 8; ++i) { const int s = g8 * 8 + i; SC[t * 65 + s] = (s <= t) ? sc[i] * exp2f(lg * (float)(t - s)) : 0.f; } }
        __syncthreads();
        { const int e0 = g8 * 8; float o[8], o2[8];
#pragma unroll
          for (int e = 0; e < 8; ++e) { o[e] = 0.f; o2[e] = 0.f; }
#pragma unroll 4
          for (int s = 0; s < 64; ++s) { const float p = SC[t * 65 + s]; const f32x4 v0 = *(const LAS f32x4*)(VV + s * 64 + e0), v1 = *(const LAS f32x4*)(VV + s * 64 + e0 + 4);
              o[0] += p * v0.x; o[1] += p * v0.y; o[2] += p * v0.z; o[3] += p * v0.w; o[4] += p * v1.x; o[5] += p * v1.y; o[6] += p * v1.z; o[7] += p * v1.w; }
#pragma unroll 4
          for (int d = 0; d < 64; ++d) { const float qv = Q[t * 65 + d]; const f32x4 v0 = *(const LAS f32x4*)(SS + d * 64 + e0), v1 = *(const LAS f32x4*)(SS + d * 64 + e0 + 4);
              o2[0] += qv * v0.x; o2[1] += qv * v0.y; o2[2] += qv * v0.z; o2[3] += qv * v0.w; o2[4] += qv * v1.x; o2[5] += qv * v1.y; o2[6] += qv * v1.z; o2[7] += qv * v1.w; }
          const float qd = exp2f(lg * (float)(t + 1)); float s1 = 0.f;
#pragma unroll
          for (int e = 0; e < 8; ++e) { o[e] += qd * o2[e]; s1 += o[e]; }
          s1 += shx(s1, 1, C.lane); s1 += shx(s1, 2, C.lane); s1 += shx(s1, 4, C.lane);
          const float mean = s1 * (1.f / 64.f); float s2 = 0.f;
#pragma unroll
          for (int e = 0; e < 8; ++e) { o[e] -= mean; s2 += o[e] * o[e]; }
          s2 += shx(s2, 1, C.lane); s2 += shx(s2, 2, C.lane); s2 += shx(s2, 4, C.lane);
          const float rstd = 1.0f / sqrtf(s2 * (1.f / 64.f) + 1e-5f);
          float gtv[8]; unpack8(*(const u32x4*)(RET + (size_t)(m0 + t) * 1024 + 768 + h * 64 + e0), gtv);
#pragma unroll
          for (int e = 0; e < 8; ++e) o[e] = o[e] * rstd * gn[h * 64 + e0 + e] * (gtv[e] * sigm(gtv[e]));
          *(u32x4*)(Y + (size_t)(m0 + t) * 1024 + 512 + h * 64 + e0) = pack8(o); }
        __syncthreads();
    }
}

constexpr int RWC = 64, RW_NCH = SEQ / RWC, RW_NU = 8 * RW_NCH;
__device__ __forceinline__ void ph_rw_local_(const Ctx& C, int l) {
    const bf16* RKVS = (const bf16*)(C.ws + WS_RKVS); const float* WDEC = (const float*)(C.ws + WS_WDEC); const bf16* AG = (const bf16*)(C.ws + WS_AG);
    bf16* Y0 = (bf16*)(C.ws + WS_Y0); bf16* RH = (bf16*)(C.ws + WS_RHAT); float* PQ = (float*)(C.ws + WS_PQ); float* BON = (float*)(C.ws + WS_BON);
    const int lane = C.lane;
    LAS float* base = (LAS float*)(C.lds + C.wave * 12288);
    for (int it = C.bid; it < RW_NU / 8; it += C.G) {
        const int u = it * 8 + C.wave, bh = u >> 8, ch = u & 255, b = bh >> 2, h = bh & 3, m0 = b * SEQ + ch * RWC, hc = h * 64 + lane;
        const float kkw = C.in[I_RW_KK][l * 256 + hc], kaw = C.in[I_RW_KA][l * 256 + hc], rkw = C.in[I_RW_RK][l * 256 + hc], w0l = C.in[I_RW_W0][l * 256 + hc], a0l = C.in[I_RW_A0][l * 256 + hc];
        f32x2 sL[32], sI[32];
        { int ln = lane; asm volatile("" : "+v"(ln));
#pragma unroll
          for (int k = 0; k < 32; ++k) { sL[k] = (f32x2){0.f, 0.f}; sI[k].x = (2 * k == ln) ? 1.f : 0.f; sI[k].y = (2 * k + 1 == ln) ? 1.f : 0.f; } }
#pragma unroll 1
        for (int sb = 0; sb < RWC / 8; ++sb) {
            asm volatile("" ::: "memory");
#pragma unroll
            for (int i = 0; i < 8; ++i) { const size_t m = (size_t)(m0 + sb * 8 + i);
                const float r = bf2f(RKVS[m * 768 + hc]), k = bf2f(RKVS[m * 768 + 256 + hc]), v = bf2f(RKVS[m * 768 + 512 + hc]);
                const float w = __builtin_amdgcn_exp2f(-0.606531f * LOG2E * sigm(WDEC[m * 256 + hc] + w0l)), a = sigm(bf2f(AG[m * 512 + hc]) + a0l);
                const float kr = k * kkw; const float nn = sqrtf(wave_sum(kr * kr, C.lane)); const float kk = kr / fmaxf(nn, 1e-12f);
                const float kp = k * (1.f + (a - 1.f) * kaw);
                const float bon = wave_sum(r * kp * rkw, C.lane);
                if (lane == 0) BON[m * 4 + h] = bon;
                base[0 * 512 + i * 64 + lane] = w; base[1 * 512 + i * 64 + lane] = kk; base[2 * 512 + i * 64 + lane] = kk * a; base[3 * 512 + i * 64 + lane] = kp; base[4 * 512 + i * 64 + lane] = r; base[5 * 512 + i * 64 + lane] = v; }
            asm volatile("" ::: "memory");
#pragma unroll 1
            for (int i = 0; i < 8; ++i) {
                const LAS f32x4* wv = (const LAS f32x4*)(base + 0 * 512 + i * 64); const LAS f32x4* kkv = (const LAS f32x4*)(base + 1 * 512 + i * 64); const LAS f32x4* kav = (const LAS f32x4*)(base + 2 * 512 + i * 64);
                const LAS f32x4* kpv = (const LAS f32x4*)(base + 3 * 512 + i * 64); const LAS f32x4* rv = (const LAS f32x4*)(base + 4 * 512 + i * 64);
                const float vv = base[5 * 512 + i * 64 + lane];
                f32x4 kq[2][4];
#pragma unroll
                for (int t = 0; t < 4; ++t) kq[0][t] = kkv[t];
                f32x2 dL0 = (f32x2){0.f, 0.f}, dL1 = dL0, dI0 = dL0, dI1 = dL0;
                f32x4 ga[2][4];
#pragma unroll
                for (int g = 0; g < 4; ++g) {
                    __builtin_amdgcn_sched_barrier(0);
                    if (g + 1 < 4) {
#pragma unroll
                        for (int t = 0; t < 4; ++t) kq[(g + 1) & 1][t] = kkv[4 * (g + 1) + t]; }
                    else { ga[0][0] = wv[0]; ga[0][1] = kav[0]; ga[0][2] = kpv[0]; ga[0][3] = rv[0]; }
                    __builtin_amdgcn_sched_barrier(0);
#pragma unroll
                    for (int t = 0; t < 4; ++t) { const int k4 = 4 * g + t; const f32x4 q4 = kq[g & 1][t];
                        dL0 += sL[2 * k4] * q4.xy; dL1 += sL[2 * k4 + 1] * q4.zw; dI0 += sI[2 * k4] * q4.xy; dI1 += sI[2 * k4 + 1] * q4.zw; }
                }
                const float saL = -((dL0.x + dL0.y) + (dL1.x + dL1.y)), saI = -((dI0.x + dI0.y) + (dI1.x + dI1.y));
                const f32x2 saLv = (f32x2){saL, saL}, saIv = (f32x2){saI, saI}, vvv = (f32x2){vv, vv};
                f32x2 yL0 = (f32x2){0.f, 0.f}, yL1 = yL0, yI0 = yL0, yI1 = yL0;
#pragma unroll
                for (int k4 = 0; k4 < 16; ++k4) {
                    __builtin_amdgcn_sched_barrier(0);
                    if (k4 + 1 < 16) { ga[(k4 + 1) & 1][0] = wv[k4 + 1]; ga[(k4 + 1) & 1][1] = kav[k4 + 1]; ga[(k4 + 1) & 1][2] = kpv[k4 + 1]; ga[(k4 + 1) & 1][3] = rv[k4 + 1]; }
                    __builtin_amdgcn_sched_barrier(0);
                    const f32x4 wq = ga[k4 & 1][0], aq = ga[k4 & 1][1], pq = ga[k4 & 1][2], rq = ga[k4 & 1][3];
                    sL[2 * k4]     = sL[2 * k4]     * wq.xy + saLv * aq.xy + vvv * pq.xy; yL0 += sL[2 * k4]     * rq.xy;
                    sL[2 * k4 + 1] = sL[2 * k4 + 1] * wq.zw + saLv * aq.zw + vvv * pq.zw; yL1 += sL[2 * k4 + 1] * rq.zw;
                    sI[2 * k4]     = sI[2 * k4]     * wq.xy + saIv * aq.xy;                  yI0 += sI[2 * k4]     * rq.xy;
                    sI[2 * k4 + 1] = sI[2 * k4 + 1] * wq.zw + saIv * aq.zw;                  yI1 += sI[2 * k4 + 1] * rq.zw;
                }
                __builtin_amdgcn_sched_barrier(0);
                const size_t m = (size_t)(m0 + sb * 8 + i);
                Y0[m * 256 + hc] = f2bf((yL0.x + yL0.y) + (yL1.x + yL1.y));
                RH[m * 256 + hc] = f2bf((yI0.x + yI0.y) + (yI1.x + yI1.y));
            }
        }
        float* oq = PQ + (size_t)u * 4096 + lane * 64; float* opt = PQ + ((size_t)RW_NU + u) * 4096 + lane;
#pragma unroll
        for (int k4 = 0; k4 < 16; ++k4) { *(f32x4*)(oq + 4 * k4) = (f32x4){sL[2 * k4].x, sL[2 * k4].y, sL[2 * k4 + 1].x, sL[2 * k4 + 1].y};
            opt[(4 * k4) * 64] = sI[2 * k4].x; opt[(4 * k4 + 1) * 64] = sI[2 * k4].y; opt[(4 * k4 + 2) * 64] = sI[2 * k4 + 1].x; opt[(4 * k4 + 3) * 64] = sI[2 * k4 + 1].y; }
    }
}
__device__ __forceinline__ void ph_rw_scan_(const Ctx& C, int wg) {
    const float* Qg = (const float*)(C.ws + WS_PQ); const float* Pg = Qg + (size_t)RW_NU * 4096; float* SST = (float*)(C.ws + WS_SST);
    LAS bf16* PT = (LAS bf16*)(C.lds);
    LAS bf16* SLb = PT + 2 * 64 * MM_LP;
    LAS float* QL = (LAS float*)(C.lds + (2 * 64 * MM_LP + 2 * 16 * MM_LP) * 2);
    LAS float* SO = QL + 2 * 16 * 64;
    const int lane = C.lane, wave = C.wave, bh = wg >> 2, rq = wg & 3, ct = wave & 3, li = lane & 15, lq = lane >> 4;
    const bool mm = wave < 4;
    const size_t ubase = (size_t)bh * RW_NCH;
    const int lt = C.tid & 255;
    const int qrow = lt >> 4, qc4 = (lt & 15) * 4;
    constexpr int PD = 6;
    f32x4 pr[PD][4], qr[PD];
#define SC_P_PIECE(i) (lt + 256 * (i))
#define SC_PUT_P(buf, sx_) do { LAS bf16* d_ = PT + (buf) * (64 * MM_LP); _Pragma("unroll") for (int i_ = 0; i_ < 4; ++i_) { const int idx_ = SC_P_PIECE(i_), r_ = (idx_ * 4) >> 6, k_ = (idx_ * 4) & 63; u32x2 w_; \
        w_.x = cvt_pk_bf16(pr[sx_][i_].x, pr[sx_][i_].y); w_.y = cvt_pk_bf16(pr[sx_][i_].z, pr[sx_][i_].w); *(LAS u32x2*)(d_ + r_ * MM_LP + k_) = w_; } } while (0)
#define SC_LOAD(sx_, cc) do { const f32x4* p4_ = (const f32x4*)(Pg + (ubase + (cc)) * 4096); _Pragma("unroll") for (int i_ = 0; i_ < 4; ++i_) pr[sx_][i_] = p4_[SC_P_PIECE(i_)]; \
        qr[sx_] = *(const f32x4*)(Qg + (ubase + (cc)) * 4096 + (rq * 16 + qrow) * 64 + qc4); } while (0)
    if (mm) {
#pragma unroll
        for (int r = 0; r < 4; ++r) SLb[(4 * lq + r) * MM_LP + ct * 16 + li] = (bf16)0;
    } else {
        { float z0; asm volatile("v_mov_b32 %0, 0" : "=v"(z0));
          *(f32x4*)(SST + ubase * 4096 + (rq * 16 + qrow) * 64 + qc4) = (f32x4){z0, z0, z0, z0}; }
        SC_LOAD(0, 0); SC_PUT_P(0, 0); *(LAS f32x4*)(QL + qrow * 64 + qc4) = qr[0];
#pragma unroll
        for (int x = 0; x < PD; ++x) SC_LOAD(x, 1 + x);
    }
    __syncthreads();
#pragma unroll 1
    for (int c2 = 0; c2 < RW_NCH; c2 += PD) {
#pragma unroll
        for (int x = 0; x < PD; ++x) {
            const int c = c2 + x;
            if (c < RW_NCH) {
            if (mm) {
                const LAS bf16* Pc = PT + (c & 1) * (64 * MM_LP); const LAS bf16* Sc = SLb + (c & 1) * (16 * MM_LP); const LAS float* Qc = QL + (c & 1) * (16 * 64);
                LAS bf16* Sn = SLb + ((c + 1) & 1) * (16 * MM_LP); LAS float* So = SO + ((c + 1) & 1) * (16 * 64);
                bf16x8 af[2], bfr[2];
#pragma unroll
                for (int ks = 0; ks < 2; ++ks) { af[ks] = *(const LAS bf16x8*)(Sc + li * MM_LP + 32 * ks + 8 * lq); bfr[ks] = *(const LAS bf16x8*)(Pc + (16 * ct + li) * MM_LP + 32 * ks + 8 * lq); }
                f32x4 acc;
#pragma unroll
                for (int r = 0; r < 4; ++r) acc[r] = Qc[(4 * lq + r) * 64 + ct * 16 + li];
#pragma unroll
                for (int ks = 0; ks < 2; ++ks) acc = __builtin_amdgcn_mfma_f32_16x16x32_bf16(af[ks], bfr[ks], acc, 0, 0, 0);
                if (c + 1 < RW_NCH) {
#pragma unroll
                    for (int r = 0; r < 4; ++r) { Sn[(4 * lq + r) * MM_LP + ct * 16 + li] = f2bf(acc[r]); So[(4 * lq + r) * 64 + ct * 16 + li] = acc[r]; } }
            } else {
                if (c > 0) *(f32x4*)(SST + (ubase + c) * 4096 + (rq * 16 + qrow) * 64 + qc4) = *(const LAS f32x4*)(SO + (c & 1) * (16 * 64) + qrow * 64 + qc4);
                if (c + 1 < RW_NCH) { SC_PUT_P((c + 1) & 1, x); *(LAS f32x4*)(QL + ((c + 1) & 1) * (16 * 64) + qrow * 64 + qc4) = qr[x]; }
                if (c + 1 + PD < RW_NCH) SC_LOAD(x, c + 1 + PD);
            }
            __syncthreads();
#ifdef SCAN_2BAR
            __syncthreads();
#endif
            }
        }
    }
#undef SC_PUT_P
#undef SC_LOAD
#undef SC_P_PIECE
}
__device__ __forceinline__ void ph_rw_out_(const Ctx& C, int l) {
    const bf16* RKVS = (const bf16*)(C.ws + WS_RKVS); const bf16* AG = (const bf16*)(C.ws + WS_AG); const bf16* Y0 = (const bf16*)(C.ws + WS_Y0); const bf16* RH = (const bf16*)(C.ws + WS_RHAT);
    const float* SST = (const float*)(C.ws + WS_SST); const float* BON = (const float*)(C.ws + WS_BON); bf16* Y = (bf16*)(C.ws + WS_Y);
    LAS float* RL = (LAS float*)(C.lds);
    const int lane = C.lane, wave = C.wave;
    for (int u = C.bid; u < RW_NU; u += C.G) {
        const int bh = u >> 8, ch = u & 255, b = bh >> 2, h = bh & 3, m0 = b * SEQ + ch * RWC, hc = h * 64 + lane;
        { const int t = C.tid >> 3, d0 = (C.tid & 7) * 8; float a[8];
          unpack8(*(const u32x4*)(RH + (size_t)(m0 + t) * 256 + h * 64 + d0), a);
#pragma unroll
          for (int e = 0; e < 8; ++e) RL[t * 64 + d0 + e] = a[e]; }
        float s[64];
        { const f32x4* sp = (const f32x4*)(SST + (size_t)u * 4096 + lane * 64);
#pragma unroll
          for (int k4 = 0; k4 < 16; ++k4) { const f32x4 v = sp[k4]; s[4 * k4] = v.x; s[4 * k4 + 1] = v.y; s[4 * k4 + 2] = v.z; s[4 * k4 + 3] = v.w; } }
        const float lnw = C.in[I_RW_LNW][l * 256 + hc], lnb = C.in[I_RW_LNB][l * 256 + hc];
        __syncthreads();
#pragma unroll 2
        for (int q = 0; q < 8; ++q) { const int t = wave * 8 + q; const size_t m = (size_t)(m0 + t);
            const LAS f32x4* rv = (const LAS f32x4*)(RL + t * 64);
            float y0 = 0.f, y1 = 0.f, y2 = 0.f, y3 = 0.f;
#pragma unroll
            for (int k4 = 0; k4 < 16; ++k4) { const f32x4 rq = rv[k4]; y0 += s[4 * k4] * rq.x; y1 += s[4 * k4 + 1] * rq.y; y2 += s[4 * k4 + 2] * rq.z; y3 += s[4 * k4 + 3] * rq.w; }
#ifndef RWDBG
#define RWDBG 0
#endif
            float y = ((RWDBG & 1) ? 0.f : (y0 + y1) + (y2 + y3)) + ((RWDBG & 2) ? 0.f : bf2f(Y0[m * 256 + hc]));
            const float mean = wave_sum(y, C.lane) * (1.f / 64.f); y -= mean;
            const float rstd = 1.0f / sqrtf(wave_sum(y * y, C.lane) * (1.f / 64.f) + 64e-5f);
            y = y * rstd * lnw + lnb;
            if (!(RWDBG & 4)) y += BON[m * 4 + h] * bf2f(RKVS[m * 768 + 512 + hc]);
            y *= bf2f(AG[m * 512 + 256 + hc]);
            if (RWDBG & 120) { y = 0.f; if (RWDBG & 8) y += ((const float*)(C.ws + WS_WDEC))[m * 256 + hc]; if (RWDBG & 16) y += bf2f(AG[m * 512 + hc]);
                if (RWDBG & 32) y += bf2f(RKVS[m * 768 + hc]) + bf2f(RKVS[m * 768 + 256 + hc]) + bf2f(RKVS[m * 768 + 512 + hc]); if (RWDBG & 64) y += BON[m * 4 + h]; }
            Y[m * 1024 + hc] = f2bf(y); }
        __syncthreads();
    }
}

constexpr int SB_VLD = 40;
__device__ __forceinline__ void ph_sb_attn_(const Ctx& C, int first_wg, int nwg) {
    const bf16* SB = (const bf16*)(C.ws + WS_SB); bf16* Y = (bf16*)(C.ws + WS_Y);
    const int lane = C.lane, j = lane & 31, hi = lane >> 5;
    LAS bf16* VT = (LAS bf16*)(C.lds + C.wave * (64 * SB_VLD * 2));
    for (int it = C.bid - first_wg; it < 512; it += nwg) {
        const int bh = it >> 6, b = bh >> 2, h = bh & 3, t0 = (it & 63) * 256 + C.wave * 32; const size_t mb = (size_t)b * SEQ;
        bf16x8 qf[4];
#pragma unroll
        for (int ks = 0; ks < 4; ++ks) qf[ks] = *(const bf16x8*)(SB + (mb + t0 + j) * 768 + h * 64 + 16 * ks + 8 * hi);
        f32x16 o0, o1;
#pragma unroll
        for (int i = 0; i < 16; ++i) { o0[i] = 0.f; o1[i] = 0.f; }
        float acc = 0.f;
#pragma unroll 1
        for (int kt = t0; kt >= 0; kt -= 32) {
            bf16x8 kf[4];
#pragma unroll
            for (int ks = 0; ks < 4; ++ks) kf[ks] = *(const bf16x8*)(SB + (mb + kt + j) * 768 + 256 + h * 64 + 16 * ks + 8 * hi);
            u32x4 vv[4];
#pragma unroll
            for (int i = 0; i < 4; ++i) { const int c = lane + 64 * i; vv[i] = *(const u32x4*)(SB + (mb + kt + (c >> 3)) * 768 + 512 + h * 64 + (c & 7) * 8); }
            f32x16 sc;
#pragma unroll
            for (int i = 0; i < 16; ++i) sc[i] = 0.f;
#pragma unroll
            for (int ks = 0; ks < 4; ++ks) sc = __builtin_amdgcn_mfma_f32_32x32x16_bf16(kf[ks], qf[ks], sc, 0, 0, 0);
#pragma unroll
            for (int i = 0; i < 4; ++i) { const int c = lane + 64 * i, key = c >> 3, d8 = (c & 7) * 8; const unsigned w[4] = {vv[i].x, vv[i].y, vv[i].z, vv[i].w};
#pragma unroll
                for (int e = 0; e < 4; ++e) { VT[(d8 + 2 * e) * SB_VLD + key] = (bf16)(w[e] & 0xffffu); VT[(d8 + 2 * e + 1) * SB_VLD + key] = (bf16)(w[e] >> 16); } }
            const bool diag = (kt == t0);
            float ls[16], g[4], og[4];
#pragma unroll
            for (int r = 0; r < 4; ++r) { g[r] = 0.f;
#pragma unroll
                for (int e = 0; e < 4; ++e) { const float z = sc[4 * r + e]; const bool valid = !diag || (8 * r + 4 * hi + e) < j;
                    const float l = (z > 40.f) ? -z : -__builtin_amdgcn_logf(1.f + __builtin_amdgcn_exp2f(z));
                    ls[4 * r + e] = valid ? l : 0.f; g[r] += ls[4 * r + e]; } }
#pragma unroll
            for (int r = 0; r < 4; ++r) og[r] = shx(g[r], 32, lane);
            float pw[16]; float run = acc;
#pragma unroll
            for (int r = 3; r >= 0; --r) { float cum = run + (hi == 0 ? og[r] : 0.f);
#pragma unroll
                for (int e = 3; e >= 0; --e) { cum += ls[4 * r + e]; const bool valid = !diag || (8 * r + 4 * hi + e) < j;
                    pw[4 * r + e] = valid ? __builtin_amdgcn_exp2f(sc[4 * r + e] + cum) : 0.f; }
                run += g[r] + og[r]; }
            acc = run;
            asm volatile("" ::: "memory");
#pragma unroll
            for (int ks = 0; ks < 2; ++ks) {
                u32x4 pk; pk.x = cvt_pk_bf16(pw[8 * ks], pw[8 * ks + 1]); pk.y = cvt_pk_bf16(pw[8 * ks + 2], pw[8 * ks + 3]); pk.z = cvt_pk_bf16(pw[8 * ks + 4], pw[8 * ks + 5]); pk.w = cvt_pk_bf16(pw[8 * ks + 6], pw[8 * ks + 7]);
                const bf16x8 pb = __builtin_bit_cast(bf16x8, pk);
                const s16x4 a0l = *(const LAS s16x4*)(VT + j * SB_VLD + 16 * ks + 4 * hi), a0h = *(const LAS s16x4*)(VT + j * SB_VLD + 16 * ks + 8 + 4 * hi);
                const s16x4 a1l = *(const LAS s16x4*)(VT + (32 + j) * SB_VLD + 16 * ks + 4 * hi), a1h = *(const LAS s16x4*)(VT + (32 + j) * SB_VLD + 16 * ks + 8 + 4 * hi);
                const bf16x8 va0 = __builtin_shufflevector(a0l, a0h, 0, 1, 2, 3, 4, 5, 6, 7), va1 = __builtin_shufflevector(a1l, a1h, 0, 1, 2, 3, 4, 5, 6, 7);
                o0 = __builtin_amdgcn_mfma_f32_32x32x16_bf16(va0, pb, o0, 0, 0, 0);
                o1 = __builtin_amdgcn_mfma_f32_32x32x16_bf16(va1, pb, o1, 0, 0, 0);
            }
            asm volatile("" ::: "memory");
            if (__builtin_amdgcn_ballot_w64(acc > -140.f) == 0ull) break;
        }
        bf16* yp = Y + (mb + t0 + j) * 1024 + 256 + h * 64 + 4 * hi;
#pragma unroll
        for (int r = 0; r < 4; ++r) { u32x2 w0, w1; w0.x = cvt_pk_bf16(o0[4 * r], o0[4 * r + 1]); w0.y = cvt_pk_bf16(o0[4 * r + 2], o0[4 * r + 3]); w1.x = cvt_pk_bf16(o1[4 * r], o1[4 * r + 1]); w1.y = cvt_pk_bf16(o1[4 * r + 2], o1[4 * r + 3]);
            *(u32x2*)(yp + 8 * r) = w0; *(u32x2*)(yp + 32 + 8 * r) = w1; }
    }
}


__device__ __forceinline__ f32x16 mm_tile(const LAS bf16* X, const LAS bf16* Y, int ti, int tj, int lane) {
    const int j = lane & 31, hi = lane >> 5; f32x16 acc;
#pragma unroll
    for (int i = 0; i < 16; ++i) acc[i] = 0.f;
#pragma unroll
    for (int ks = 0; ks < 4; ++ks) { const bf16x8 a = *(const LAS bf16x8*)(X + (32 * ti + j) * MM_LP + 16 * ks + 8 * hi), b = *(const LAS bf16x8*)(Y + (32 * tj + j) * MM_LP + 16 * ks + 8 * hi);
        acc = __builtin_amdgcn_mfma_f32_32x32x16_bf16(a, b, acc, 0, 0, 0); }
    return acc;
}
__device__ __forceinline__ void ln_pair_stats(const f32x16& x, LAS float* XCH, int tr, int tt, int lane, float eps, float& mean, float& rstd) {
    const int j = lane & 31, hi = lane >> 5; float s1 = 0.f, s2 = 0.f;
#pragma unroll
    for (int i = 0; i < 16; ++i) { s1 += x[i]; s2 += x[i] * x[i]; }
    s1 += shx(s1, 32, lane); s2 += shx(s2, 32, lane);
    if (hi == 0) { XCH[(tr * 64 + 32 * tt + j) * 2] = s1; XCH[(tr * 64 + 32 * tt + j) * 2 + 1] = s2; }
    __syncthreads();
    const float a1 = XCH[(32 * tt + j) * 2] + XCH[(64 + 32 * tt + j) * 2], a2 = XCH[(32 * tt + j) * 2 + 1] + XCH[(64 + 32 * tt + j) * 2 + 1];
    mean = a1 * (1.f / 64.f); const float var = fmaxf(a2 * (1.f / 64.f) - mean * mean, 0.f); rstd = 1.0f / sqrtf(var + eps);
}
__device__ __forceinline__ void rot_store(const Ctx& C, const bf16* src  , int pos, int d0, float scale, LAS bf16* dstrow) {
    const float* cs = (const float*)(C.ws + WS_COS) + (size_t)pos * 32 + d0; const float* sn = (const float*)(C.ws + WS_SIN) + (size_t)pos * 32 + d0;
    float x1[8], x2[8]; unpack8(*(const u32x4*)(src + d0), x1); unpack8(*(const u32x4*)(src + 32 + d0), x2);
    const f32x4 c0 = *(const f32x4*)cs, c1 = *(const f32x4*)(cs + 4), s0 = *(const f32x4*)sn, s1 = *(const f32x4*)(sn + 4);
    const float cc[8] = {c0.x, c0.y, c0.z, c0.w, c1.x, c1.y, c1.z, c1.w}, ss[8] = {s0.x, s0.y, s0.z, s0.w, s1.x, s1.y, s1.z, s1.w};
    float o1[8], o2[8];
#pragma unroll
    for (int e = 0; e < 8; ++e) { o1[e] = (x1[e] * cc[e] - x2[e] * ss[e]) * scale; o2[e] = (x1[e] * ss[e] + x2[e] * cc[e]) * scale; }
    *(LAS u32x4*)(dstrow + d0) = pack8(o1); *(LAS u32x4*)(dstrow + 32 + d0) = pack8(o2);
}

__device__ __forceinline__ void ph_ret_kv2_(const Ctx& C) {
    const bf16* RET = (const bf16*)(C.ws + WS_RET); float* KV = (float*)(C.ws + WS_KV);
    const int half = C.wave >> 2, w4 = C.wave & 3, th = C.tid & 255, lane = C.lane;
    LAS bf16* KT = (LAS bf16*)(C.lds + half * 36864);
    LAS bf16* VT = KT + 64 * MM_LP;
    LAS bf16* KR = VT + 64 * MM_LP;
    for (int it = C.bid; it < 1024; it += C.G) {
        const int u = it * 2 + half, bh = u >> 8, ch = u & 255, b = bh >> 2, h = bh & 3, m0 = b * SEQ + ch * 64;
        const float lg = ret_log2gamma(h);
        { const int srow = th >> 2, dq = th & 3; const size_t m = (size_t)(m0 + srow);
          rot_store(C, RET + m * 1024 + 256 + h * 64, (int)(m & (SEQ - 1)), dq * 8, 0.125f * exp2f(lg * (float)(63 - srow)), KR + srow * MM_LP);
          float a[8];
#pragma unroll
          for (int q = 0; q < 2; ++q) { const int e0 = dq * 16 + q * 8; unpack8(*(const u32x4*)(RET + m * 1024 + 512 + h * 64 + e0), a);
#pragma unroll
              for (int e = 0; e < 8; ++e) VT[(e0 + e) * MM_LP + srow] = f2bf(a[e]); } }
        __syncthreads();
        { const int d = th >> 2, s0 = (th & 3) * 16;
#pragma unroll
          for (int i = 0; i < 16; ++i) KT[d * MM_LP + s0 + i] = KR[(s0 + i) * MM_LP + d]; }
        __syncthreads();
        { const int ti = w4 >> 1, tj = w4 & 1, j = lane & 31, hi = lane >> 5;
          const f32x16 acc = mm_tile(VT, KT, ti, tj, lane);
          float* o = KV + (size_t)u * 4096 + (size_t)(32 * ti + 4 * hi) * 64 + 32 * tj + j;
#pragma unroll
          for (int r = 0; r < 4; ++r)
#pragma unroll
              for (int e = 0; e < 4; ++e) o[(8 * r + e) * 64] = acc[4 * r + e]; }
        __syncthreads();
    }
}
__device__ __forceinline__ void ph_ret_out2_(const Ctx& C, int l, int first_wg, int nwg) {
    const bf16* RET = (const bf16*)(C.ws + WS_RET); const float* KV = (const float*)(C.ws + WS_KV); bf16* Y = (bf16*)(C.ws + WS_Y);
    const int half = C.wave >> 2, w4 = C.wave & 3, th = C.tid & 255, lane = C.lane, j = lane & 31, hi = lane >> 5, te = w4 >> 1, tt = w4 & 1;
    LAS bf16* QL = (LAS bf16*)(C.lds + half * 40960);
    LAS bf16* KL = QL + 64 * MM_LP;
    LAS bf16* VT = KL + 64 * MM_LP;
    LAS bf16* ST = VT + 64 * MM_LP;
    LAS float* XCH = (LAS float*)(C.lds + half * 40960 + 4 * 64 * MM_LP * 2);
    const float* gn = C.in[I_RET_GN] + (size_t)l * 256;
    for (int it = C.bid - first_wg; it < 1024; it += nwg) {
        const int u = it * 2 + half, bh = u >> 8, ch = u & 255, b = bh >> 2, h = bh & 3, m0 = b * SEQ + ch * 64;
        const float lg = ret_log2gamma(h);
        { const int srow = th >> 2, dq = th & 3; const size_t m = (size_t)(m0 + srow); const int pos = (int)(m & (SEQ - 1));
          rot_store(C, RET + m * 1024 + h * 64, pos, dq * 8, 1.0f, QL + srow * MM_LP);
          rot_store(C, RET + m * 1024 + 256 + h * 64, pos, dq * 8, 0.125f, KL + srow * MM_LP);
          float a[8];
#pragma unroll
          for (int q = 0; q < 2; ++q) { const int e0 = dq * 16 + q * 8; unpack8(*(const u32x4*)(RET + m * 1024 + 512 + h * 64 + e0), a);
#pragma unroll
              for (int e = 0; e < 8; ++e) VT[(e0 + e) * MM_LP + srow] = f2bf(a[e]); }
          const float* sp = KV + (size_t)u * 4096 + srow * 64 + dq * 16;
          float sv[16];
#pragma unroll
          for (int q = 0; q < 4; ++q) { const f32x4 v4 = *(const f32x4*)(sp + 4 * q); sv[4 * q] = v4.x; sv[4 * q + 1] = v4.y; sv[4 * q + 2] = v4.z; sv[4 * q + 3] = v4.w; }
          *(LAS u32x4*)(ST + srow * MM_LP + dq * 16) = pack8(sv); *(LAS u32x4*)(ST + srow * MM_LP + dq * 16 + 8) = pack8(sv + 8); }
        __syncthreads();
        f32x16 acc = mm_tile(ST, QL, te, tt, lane);
        { const float qd = exp2f(lg * (float)(32 * tt + j + 1));
#pragma unroll
          for (int i = 0; i < 16; ++i) acc[i] *= qd; }
#pragma unroll
        for (int st = 0; st < 2; ++st) {
            if (st > tt) continue;
            const f32x16 sc = mm_tile(KL, QL, st, tt, lane);
            float pw[16];
#pragma unroll
            for (int r = 0; r < 4; ++r)
#pragma unroll
                for (int e = 0; e < 4; ++e) { const int sk = 32 * st + 8 * r + 4 * hi + e, tq = 32 * tt + j;
                    pw[4 * r + e] = (sk <= tq) ? sc[4 * r + e] * exp2f(lg * (float)(tq - sk)) : 0.f; }
#pragma unroll
            for (int ks = 0; ks < 2; ++ks) {
                u32x4 pk; pk.x = cvt_pk_bf16(pw[8 * ks], pw[8 * ks + 1]); pk.y = cvt_pk_bf16(pw[8 * ks + 2], pw[8 * ks + 3]); pk.z = cvt_pk_bf16(pw[8 * ks + 4], pw[8 * ks + 5]); pk.w = cvt_pk_bf16(pw[8 * ks + 6], pw[8 * ks + 7]);
                const bf16x8 pb = __builtin_bit_cast(bf16x8, pk);
                const LAS bf16* vr = VT + (32 * te + j) * MM_LP + 32 * st + 16 * ks + 4 * hi;
                const s16x4 al = *(const LAS s16x4*)vr, ah = *(const LAS s16x4*)(vr + 8);
                const bf16x8 va = __builtin_shufflevector(al, ah, 0, 1, 2, 3, 4, 5, 6, 7);
                acc = __builtin_amdgcn_mfma_f32_32x32x16_bf16(va, pb, acc, 0, 0, 0);
            }
        }
        float mean, rstd; ln_pair_stats(acc, XCH, te, tt, lane, 1e-5f, mean, rstd);
        { const size_t m = (size_t)(m0 + 32 * tt + j); const bf16* gp = RET + m * 1024 + 768 + h * 64 + 32 * te + 4 * hi; bf16* yp = Y + m * 1024 + 512 + h * 64 + 32 * te + 4 * hi;
          const float* gw = gn + h * 64 + 32 * te + 4 * hi;
#pragma unroll
          for (int r = 0; r < 4; ++r) { const u32x2 gt2 = *(const u32x2*)(gp + 8 * r); const float gtv[4] = {bflo(gt2.x), bfhi(gt2.x), bflo(gt2.y), bfhi(gt2.y)}; const f32x4 gwv = *(const f32x4*)(gw + 8 * r);
              float o[4];
#pragma unroll
              for (int e = 0; e < 4; ++e) o[e] = (acc[4 * r + e] - mean) * rstd * gwv[e] * (gtv[e] * sigm(gtv[e]));
              u32x2 w; w.x = cvt_pk_bf16(o[0], o[1]); w.y = cvt_pk_bf16(o[2], o[3]); *(u32x2*)(yp + 8 * r) = w; } }
        __syncthreads();
    }
}
__device__ __forceinline__ void ph_rw_out2_(const Ctx& C, int l) {
    const bf16* RKVS = (const bf16*)(C.ws + WS_RKVS); const bf16* AG = (const bf16*)(C.ws + WS_AG); const bf16* Y0 = (const bf16*)(C.ws + WS_Y0); const bf16* RH = (const bf16*)(C.ws + WS_RHAT);
    const float* SST = (const float*)(C.ws + WS_SST); const float* BON = (const float*)(C.ws + WS_BON); bf16* Y = (bf16*)(C.ws + WS_Y);
    const int half = C.wave >> 2, w4 = C.wave & 3, th = C.tid & 255, lane = C.lane, j = lane & 31, hi = lane >> 5, tv = w4 >> 1, tt = w4 & 1;
    LAS bf16* SL = (LAS bf16*)(C.lds + half * 20480);
    LAS bf16* RL = SL + 64 * MM_LP;
    LAS float* XCH = (LAS float*)(C.lds + half * 20480 + 2 * 64 * MM_LP * 2);
    for (int it = C.bid; it < RW_NU / 2; it += C.G) {
        const int u = it * 2 + half, bh = u >> 8, ch = u & 255, b = bh >> 2, h = bh & 3, m0 = b * SEQ + ch * RWC;
        { const int row = th >> 2, q4 = th & 3;
          const float* sp = SST + (size_t)u * 4096 + row * 64 + q4 * 16; float sv[16];
#pragma unroll
          for (int q = 0; q < 4; ++q) { const f32x4 v4 = *(const f32x4*)(sp + 4 * q); sv[4 * q] = v4.x; sv[4 * q + 1] = v4.y; sv[4 * q + 2] = v4.z; sv[4 * q + 3] = v4.w; }
          *(LAS u32x4*)(SL + row * MM_LP + q4 * 16) = pack8(sv); *(LAS u32x4*)(SL + row * MM_LP + q4 * 16 + 8) = pack8(sv + 8);
          const u32x4* rp = (const u32x4*)(RH + (size_t)(m0 + row) * 256 + h * 64 + q4 * 16);
          *(LAS u32x4*)(RL + row * MM_LP + q4 * 16) = rp[0]; *(LAS u32x4*)(RL + row * MM_LP + q4 * 16 + 8) = rp[1]; }
        __syncthreads();
        f32x16 acc = mm_tile(SL, RL, tv, tt, lane);
        const size_t m = (size_t)(m0 + 32 * tt + j); const int vb = h * 64 + 32 * tv + 4 * hi;
#pragma unroll
        for (int r = 0; r < 4; ++r) { const u32x2 y2 = *(const u32x2*)(Y0 + m * 256 + vb + 8 * r); acc[4 * r] += bflo(y2.x); acc[4 * r + 1] += bfhi(y2.x); acc[4 * r + 2] += bflo(y2.y); acc[4 * r + 3] += bfhi(y2.y); }
        float mean, rstd; ln_pair_stats(acc, XCH, tv, tt, lane, 64e-5f, mean, rstd);
        const float bon = BON[m * 4 + h];
#pragma unroll
        for (int r = 0; r < 4; ++r) { const int vc = vb + 8 * r;
            const f32x4 lw = *(const f32x4*)(C.in[I_RW_LNW] + (size_t)l * 256 + vc), lb = *(const f32x4*)(C.in[I_RW_LNB] + (size_t)l * 256 + vc);
            const u32x2 v2 = *(const u32x2*)(RKVS + m * 768 + 512 + vc), g2 = *(const u32x2*)(AG + m * 512 + 256 + vc);
            const float vv[4] = {bflo(v2.x), bfhi(v2.x), bflo(v2.y), bfhi(v2.y)}, gg[4] = {bflo(g2.x), bfhi(g2.x), bflo(g2.y), bfhi(g2.y)};
            float o[4];
#pragma unroll
            for (int e = 0; e < 4; ++e) o[e] = ((acc[4 * r + e] - mean) * rstd * lw[e] + lb[e] + bon * vv[e]) * gg[e];
            u32x2 w; w.x = cvt_pk_bf16(o[0], o[1]); w.y = cvt_pk_bf16(o[2], o[3]); *(u32x2*)(Y + m * 1024 + vc) = w; }
        __syncthreads();
    }
}

__device__ __forceinline__ void ph_moe_scatter_(const Ctx& C, int moe_idx) {
    unsigned* cw = (unsigned*)(C.ws + WS_CTL) + CW_MOE + moe_idx * 64;
    const int* eidx = (const int*)(C.ws + WS_EIDX); const float* gate = (const float*)(C.ws + WS_GATE);
    int* rowtok = (int*)(C.ws + WS_ROWTOK); float* rowgate = (float*)(C.ws + WS_ROWGATE); int* texp = (int*)(C.ws + WS_TEXP); int* segend = (int*)(C.ws + WS_SEGEND); int* ntp = (int*)(C.ws + WS_NT);
    const bf16* H = (const bf16*)(C.ws + WS_H); bf16* XS = (bf16*)(C.ws + WS_XS);
    LAS unsigned* lcnt = (LAS unsigned*)(C.lds); LAS unsigned* lbase = lcnt + 8; LAS int* sl = (LAS int*)(C.lds + 256);
    int cnt[8], segb[8]; int tot = 0;
#pragma unroll
    for (int e = 0; e < 8; ++e) { cnt[e] = (int)__hip_atomic_load(&cw[e], __ATOMIC_RELAXED, __HIP_MEMORY_SCOPE_AGENT); segb[e] = tot; tot += (cnt[e] + 255) & ~255; }
    if (C.bid == 0) {
        if (C.tid < 8) { const int e = C.tid; int sb = 0, ce = 0;
#pragma unroll
            for (int q = 0; q < 8; ++q) if (q == e) { sb = segb[q]; ce = cnt[q]; }
            for (int pm = sb >> 8; pm < ((sb + ((ce + 255) & ~255)) >> 8); ++pm) { texp[pm] = e; segend[pm] = sb + ce; } }
        if (C.tid == 0) *ntp = tot >> 8;
    }
    for (int blk = C.bid; blk < T / 256; blk += C.G) {
        __syncthreads();
        if (C.tid < 8) lcnt[C.tid] = 0u;
        __syncthreads();
        const int a = blk * 512 + C.tid, e = eidx[a];
        const unsigned rank = atomicAdd((unsigned*)&lcnt[e], 1u);
        __syncthreads();
        if (C.tid < 8) lbase[C.tid] = atomicAdd(&cw[16 + C.tid], lcnt[C.tid]);
        __syncthreads();
        int sb = 0;
#pragma unroll
        for (int q = 0; q < 8; ++q) if (q == e) sb = segb[q];
        const int slot = sb + (int)lbase[e] + (int)rank;
        rowtok[slot] = a >> 1; rowgate[slot] = gate[a]; sl[C.tid] = slot; ((int*)(C.ws + WS_SLOTOF))[a] = slot;
        __syncthreads();
        for (int i = C.wave; i < 512; i += NWAVES) { const int s2 = sl[i]; const u32x4* src = (const u32x4*)(C.ws + WS_H8 + (size_t)(blk * 256 + (i >> 1)) * D); u32x4* dst = (u32x4*)(C.ws + WS_XS + (size_t)s2 * D);
            dst[C.lane] = src[C.lane]; }
    }
}

__device__ __forceinline__ void grid_barrier(int wv) {
    const Ctx C = make_ctx(wv);
    XcdBarrier b; b.bar = (unsigned*)(C.ws + WS_CTL) + CW_BAR; b.x = xb_xcc_id(); b.st = (volatile LAS unsigned*)(C.lds + MISC_OFF) + 8;
    xcd_barrier(b, C.tid);
}
__device__ __forceinline__ void P_prologue(int wv) { const Ctx C = make_ctx(wv); ph_prologue_(C); }
__device__ __forceinline__ void P_weights_norm(int wv, int l) { const Ctx C = make_ctx(wv); ph_weights_(C, l, 0, 0, C.G); __syncthreads(); ph_norm_(C, C.in[I_NORM_MIX] + (size_t)l * D, false, nullptr, 0,  (l > 0) && ((l - 1) & 1), l == 0 ? C.in[I_X] : nullptr); }
__device__ __forceinline__ void P_gemm_in(int wv) { const Ctx C = make_ctx(wv); using namespace pg8; unsigned char* ws = C.ws;
    Gemm g{(const bf16*)(ws + WS_H), (const bf16*)(ws + WS_WIN), D, D}; StaticOrder S; S.init(T, NIN, C.G, C.bid);
    EpiRoute E{(bf16*)(ws + WS_RW), (bf16*)(ws + WS_SB), (bf16*)(ws + WS_RET), (bf16*)(ws + WS_CV)};
    gemm_phase<EpiRoute, StaticOrder, true>(C.lds, C.tid, g, S, E); }
#define REP2(bit, stmt) do { stmt; if constexpr ((PROBE2 >> (bit)) & 1) { __syncthreads(); stmt; } } while (0)
__device__ __forceinline__ void P_mix1(int wv, int l) { REP2(2, { const Ctx C = make_ctx(wv); ph_rw_prep_(C, l); }); { const Ctx C = make_ctx(wv); ph_sb_prep_(C, l); } REP2(3, { const Ctx C = make_ctx(wv); ph_conv_(C, l); }); REP2(4, { const Ctx C = make_ctx(wv); ph_ret_kv2_(C); }); }
__device__ __forceinline__ void P_mix2(int wv, int l) { { const Ctx C = make_ctx(wv); using namespace pg8; unsigned char* ws = C.ws;
    Gemm g{(const bf16*)(ws + WS_ALORA), (const bf16*)(ws + WS_WLORA), 256, 256}; StaticOrder S; S.init(T, 768, C.G, C.bid);
    EpiLora E{(float*)(ws + WS_WDEC), (bf16*)(ws + WS_AG), C.in[I_RW_W0] + (size_t)l * 256, C.in[I_RW_A0] + (size_t)l * 256};
    gemm_phase<EpiLora, StaticOrder, true>(C.lds, C.tid, g, S, E); }
    { const Ctx C = make_ctx(wv); ph_ret_scan_(C); } }
#ifndef MIX3_SEL
#define MIX3_SEL 3
#endif
__device__ __forceinline__ void P_mix3(int wv, int l) { REP2(0, { const Ctx C = make_ctx(wv); ph_rw_local_(C, l); }); }
__device__ __forceinline__ void P_mix4(int wv, int l) { const Ctx C = make_ctx(wv);
    if (C.G >= 64) { if (C.bid < 32) { REP2(6, ph_rw_scan_(C, C.bid)); } else { REP2(7, ph_sb_attn_(C, 32, C.G - 32)); __syncthreads(); REP2(1, ph_ret_out2_(C, l, 32, C.G - 32)); __syncthreads(); ph_weights_(C, l, 1, 32, C.G - 32); } }
    else { for (int w = C.bid; w < 32; w += C.G) { ph_rw_scan_(C, w); __syncthreads(); } ph_sb_attn_(C, 0, C.G); __syncthreads(); ph_ret_out2_(C, l, 0, C.G); __syncthreads(); ph_weights_(C, l, 1, 0, C.G); } }
__device__ __forceinline__ void P_mix5(int wv, int l) { REP2(5, { const Ctx C = make_ctx(wv); ph_rw_out2_(C, l); }); }
__device__ __forceinline__ void P_gemm_branch(int wv) { const Ctx C = make_ctx(wv); using namespace pg8; unsigned char* ws = C.ws;
    Gemm g{(const bf16*)(ws + WS_Y), (const bf16*)(ws + WS_WB), D, 256}; StaticOrder S; S.init(T, 4096, C.G, C.bid, 2, 512);
    EpiBf16 E{(bf16*)(ws + WS_BALL), 4096, 0xffff};
    gemm_phase<EpiBf16, StaticOrder, false>(C.lds, C.tid, g, S, E); }
__device__ __forceinline__ void P_gemm_gate(int wv) { const Ctx C = make_ctx(wv); using namespace pg8; unsigned char* ws = C.ws;
    Gemm g{(const bf16*)(ws + WS_H8), (const bf16*)(ws + WS_WG), D, D}; StaticOrder S; S.init(T, 4096, C.G, C.bid);
    EpiGateMerge E{(const bf16*)(ws + WS_BALL), (bf16*)(ws + WS_MERGED)};
    gemm_phase8<EpiGateMerge, StaticOrder, true>(C.lds, C.tid, g, S, E); }
__device__ __forceinline__ void P_gemm_out(int wv) { const Ctx C = make_ctx(wv); using namespace pg8; unsigned char* ws = C.ws;
    Gemm g{(const bf16*)(ws + WS_MERGED), (const bf16*)(ws + WS_WOUT), D, D}; StaticOrder S; S.init(T, D, C.G, C.bid);
    EpiResidual E{C.out};
    gemm_phase<EpiResidual, StaticOrder, false>(C.lds, C.tid, g, S, E); }
__device__ __forceinline__ void P_norm_ffn(int wv, int l) { const Ctx C = make_ctx(wv); ph_norm_(C, C.in[I_NORM_FFN] + (size_t)l * D, (l & 1) != 0, C.in[I_ROUTER] + (size_t)(l >> 1) * D * NEXP, l >> 1, false, nullptr,  false); }
__device__ __forceinline__ void P_ffn_up(int wv) { const Ctx C = make_ctx(wv); using namespace pg8; unsigned char* ws = C.ws;
    Gemm g{(const bf16*)(ws + WS_H8), (const bf16*)(ws + WS_W13), D, D}; StaticOrder S; S.init(T, 2 * DFF, C.G, C.bid);
    EpiSwiglu E{(bf16*)(ws + WS_HID), DFF, 1 << 20};
    gemm_phase8<EpiSwiglu, StaticOrder, true>(C.lds, C.tid, g, S, E); }
__device__ __forceinline__ void P_ffn_down(int wv) { const Ctx C = make_ctx(wv); using namespace pg8; unsigned char* ws = C.ws;
    Gemm g{(const bf16*)(ws + WS_HID), (const bf16*)(ws + WS_W2D), DFF, DFF}; StaticOrder S; S.init(T, D, C.G, C.bid);
    EpiResidual E{C.out};
    gemm_phase<EpiResidual, StaticOrder, false>(C.lds, C.tid, g, S, E); }
__device__ __forceinline__ void P_moe_scatter(int wv, int l2) { const Ctx C = make_ctx(wv); ph_moe_scatter_(C, l2); }
__device__ __forceinline__ void P_moe_up(int wv) { const Ctx C = make_ctx(wv); using namespace pg8; unsigned char* ws = C.ws;
    Gemm g{(const bf16*)(ws + WS_XS), (const bf16*)(ws + WS_W13), D, D};
    MoeOrder S{(const int*)(ws + WS_TEXP), __builtin_amdgcn_readfirstlane(*(const int*)(ws + WS_NT)), 2 * DFE / 256, C.G, C.bid};
    EpiSwiglu E{(bf16*)(ws + WS_HIDM), DFE, 2 * DFE / 256};
    gemm_phase8<EpiSwiglu, MoeOrder, true>(C.lds, C.tid, g, S, E); }
__device__ __forceinline__ void P_moe_down(int wv) { const Ctx C = make_ctx(wv); using namespace pg8; unsigned char* ws = C.ws;
    Gemm g{(const bf16*)(ws + WS_HIDM), (const bf16*)(ws + WS_W2M), DFE, DFE};
    MoeOrder S{(const int*)(ws + WS_TEXP), __builtin_amdgcn_readfirstlane(*(const int*)(ws + WS_NT)), D / 256, C.G, C.bid};
    EpiBf16 E{(bf16*)(ws + WS_YS), D, 3};
    gemm_phase<EpiBf16, MoeOrder, true>(C.lds, C.tid, g, S, E); }
__device__ __forceinline__ void P_moe_combine(int wv) { const Ctx C = make_ctx(wv);
    const int gw = C.bid * NWAVES + C.wave, NGW = C.G * NWAVES, lane = C.lane;
    const int* slotof = (const int*)(C.ws + WS_SLOTOF); const float* gate = (const float*)(C.ws + WS_GATE); const bf16* YS = (const bf16*)(C.ws + WS_YS);
    for (int m = gw; m < T; m += NGW) {
        const int s0 = slotof[2 * m], s1 = slotof[2 * m + 1]; const float g0 = gate[2 * m], g1 = gate[2 * m + 1];
        f32x4* xr = (f32x4*)(C.out + (size_t)m * D) + lane;
        const u32x2* y0 = (const u32x2*)(YS + (size_t)s0 * D) + lane; const u32x2* y1 = (const u32x2*)(YS + (size_t)s1 * D) + lane;
#pragma unroll
        for (int j = 0; j < 4; ++j) { f32x4 v = xr[64 * j]; const u32x2 a = y0[64 * j], b = y1[64 * j];
            v.x += g0 * bflo(a.x) + g1 * bflo(b.x); v.y += g0 * bfhi(a.x) + g1 * bfhi(b.x); v.z += g0 * bflo(a.y) + g1 * bflo(b.y); v.w += g0 * bfhi(a.y) + g1 * bfhi(b.y);
            xr[64 * j] = v; }
    }
}

#ifndef PROBE_MASK
#define PROBE_MASK 0u
#endif
#ifndef PH_MASK
#define PH_MASK 0xffffffffu
#endif
__global__ void __launch_bounds__(NTHR, 2) hybrid_fwd(Args args) {
    (void)args;
    const int wv = __builtin_amdgcn_readfirstlane(threadIdx.x >> 6);
    { LAS unsigned char* lds = (LAS unsigned char*)lds_raw;
      for (int u = threadIdx.x; u < (LDS_BYTES - RING_BYTES) / 4; u += NTHR) ((LAS unsigned*)(lds + RING_BYTES))[u] = 0u; }
    __syncthreads();
    { const CAS Args* ka = ka_ptr();
      if (ka->ph_hi - ka->ph_lo > 1) { (void)xcd_barrier_post((unsigned*)(ka->ws + WS_CTL) + CW_BAR, (volatile LAS unsigned*)((LAS unsigned char*)lds_raw + MISC_OFF) + 8); } }
    int gp = 0;
#define PHASE(k, call) { const CAS Args* ka_ = ka_ptr(); const int lo_ = ka_->ph_lo, hi_ = ka_->ph_hi; if (lo_ <= gp && gp < hi_) { if constexpr ((PH_MASK >> (k)) & 1u) { call; if constexpr ((PROBE_MASK >> (k)) & 1u) { __syncthreads(); call; } } if (hi_ - lo_ > 1 && gp + 1 < hi_) grid_barrier(wv); } ++gp; }
    PHASE(0, P_prologue(wv))
#pragma unroll 1
    for (int l = 0; l < NLAYER; ++l) {
        PHASE(1, P_weights_norm(wv, l))
        PHASE(2, P_gemm_in(wv))
        PHASE(3, P_mix1(wv, l))
        PHASE(4, P_mix2(wv, l))
        PHASE(5, P_mix3(wv, l))
        PHASE(6, P_mix4(wv, l))
        PHASE(7, P_mix5(wv, l))
        PHASE(8, P_gemm_branch(wv))
        PHASE(9, P_gemm_gate(wv))
        PHASE(10, P_gemm_out(wv))
        PHASE(11, P_norm_ffn(wv, l))
        if (!(l & 1)) {
            PHASE(12, P_ffn_up(wv))
            PHASE(13, P_ffn_down(wv))
            gp += 2;
        } else {
            PHASE(14, P_moe_scatter(wv, l >> 1))
            PHASE(15, P_moe_up(wv))
            PHASE(16, P_moe_down(wv))
            if (l == NLAYER - 1) { PHASE(17, P_moe_combine(wv)) } else { ++gp; }
        }
    }
#undef PHASE
}
constexpr int N_PHASES = 1 + NLAYER * 15;

#ifndef MK_MULTI
#define MK_MULTI 0
#endif
extern "C" void kernel_launch(void* const* d_in, const int* in_sizes, int n_in, void* d_out, int out_size, void* d_ws, size_t ws_size, hipStream_t stream) {
    static int grid = 0;
    if (grid == 0) {
        if (n_in != 32 || in_sizes[0] != T * D || out_size != T * D || ws_size < WS_END) { fprintf(stderr, "kernel_launch: unexpected problem shape / workspace (%d inputs, ws %zu)\n", n_in, ws_size); grid = -1; return; }
        int dev = 0, cus = 0, per_cu = 0;
        if (hipGetDevice(&dev) != hipSuccess || hipDeviceGetAttribute(&cus, hipDeviceAttributeMultiprocessorCount, dev) != hipSuccess) { grid = -1; return; }
        if (hipFuncSetAttribute((const void*)hybrid_fwd, hipFuncAttributeMaxDynamicSharedMemorySize, LDS_BYTES) != hipSuccess) { fprintf(stderr, "kernel_launch: hipFuncSetAttribute failed\n"); grid = -1; return; }
        if (hipOccupancyMaxActiveBlocksPerMultiprocessor(&per_cu, (const void*)hybrid_fwd, NTHR, LDS_BYTES) != hipSuccess || per_cu < 1) { fprintf(stderr, "kernel_launch: occupancy query says %d\n", per_cu); }
        (void)hipGetLastError();
        grid = cus;
    }
    if (grid < 0) return;
    (void)hipMemsetAsync((char*)d_ws + WS_CTL, 0, CTL_ZERO_BYTES, stream);
#ifdef DBG_ZERO_WS
    (void)hipMemsetAsync((char*)d_ws + CTL_ZERO_BYTES, 0, WS_END - CTL_ZERO_BYTES, stream);
#endif
    Args a{};
    for (int i = 0; i < 32; ++i) a.in[i] = (const float*)d_in[i];
    a.out = (float*)d_out; a.ws = (unsigned char*)d_ws;
#if MK_MULTI
    for (int p = 0; p < N_PHASES; ++p) { a.ph_lo = p; a.ph_hi = p + 1; hipLaunchKernelGGL(hybrid_fwd, dim3(grid), dim3(NTHR), LDS_BYTES, stream, a); }
#else
    a.ph_lo = 0; a.ph_hi = N_PHASES; hipLaunchKernelGGL(hybrid_fwd, dim3(grid), dim3(NTHR), LDS_BYTES, stream, a);
#endif
}
```

```cpp
#include <hip/hip_runtime.h>
#include <cstdio>
#include <cstdint>

#define GAS __attribute__((address_space(1)))
#define LAS __attribute__((address_space(3)))
typedef unsigned short bf16;
typedef unsigned u32x4 __attribute__((ext_vector_type(4)));
typedef unsigned u32x2 __attribute__((ext_vector_type(2)));
typedef float f32x4 __attribute__((ext_vector_type(4)));
typedef float f32x2 __attribute__((ext_vector_type(2)));
typedef short bf16x8 __attribute__((ext_vector_type(8)));
typedef float f32x16 __attribute__((ext_vector_type(16)));
typedef short s16x4 __attribute__((ext_vector_type(4)));

constexpr int SEQ = 16384, NBATCH = 2, T = NBATCH * SEQ, D = 1024, NIN = 3328, DFF = 2816, DFE = 1408, NEXP = 8, NLAYER = 4;
constexpr int MPAD = 2 * T + NEXP * 256;
constexpr int NWAVES = 8, NTHR = 512;
constexpr float LOG2E = 1.4426950408889634f;
constexpr int MM_LP = 72;

typedef __bf16 bf16x2_t __attribute__((ext_vector_type(2)));
__device__ __forceinline__ unsigned cvt_pk_bf16(float lo, float hi) { const f32x2 v = {lo, hi}; const bf16x2_t b = __builtin_convertvector(v, bf16x2_t); return __builtin_bit_cast(unsigned, b); }
__device__ __forceinline__ float bflo(unsigned u) { return __builtin_bit_cast(float, u << 16); }
__device__ __forceinline__ float bfhi(unsigned u) { return __builtin_bit_cast(float, u & 0xffff0000u); }
__device__ __forceinline__ float bf2f(bf16 u) { return __builtin_bit_cast(float, (unsigned)u << 16); }
__device__ __forceinline__ bf16 f2bf(float f) { return (bf16)(cvt_pk_bf16(f, 0.f) & 0xffffu); }
__device__ __forceinline__ float sigm(float x) { return __builtin_amdgcn_rcpf(1.f + __builtin_amdgcn_exp2f(-x * LOG2E)); }
__device__ __forceinline__ float shx(float v, int o, int lane) { return __builtin_bit_cast(float, __builtin_amdgcn_ds_bpermute((lane ^ o) << 2, __builtin_bit_cast(int, v))); }
__device__ __forceinline__ float dpp_add(float v, const int ctrl_id) {
    const int x = __builtin_bit_cast(int, v);
    int y;
    if (ctrl_id == 0) y = __builtin_amdgcn_update_dpp(0, x, 0xB1, 0xF, 0xF, true);
    else if (ctrl_id == 1) y = __builtin_amdgcn_update_dpp(0, x, 0x4E, 0xF, 0xF, true);
    else if (ctrl_id == 2) y = __builtin_amdgcn_update_dpp(0, x, 0x141, 0xF, 0xF, true);
    else y = __builtin_amdgcn_update_dpp(0, x, 0x140, 0xF, 0xF, true);
    return v + __builtin_bit_cast(float, y);
}
__device__ __forceinline__ float wave_sum(float v, int lane) {
    (void)lane;
    v = dpp_add(v, 0); v = dpp_add(v, 1); v = dpp_add(v, 2); v = dpp_add(v, 3);
    const int x = __builtin_bit_cast(int, v);
    const float s0 = __builtin_bit_cast(float, __builtin_amdgcn_readlane(x, 0)), s1 = __builtin_bit_cast(float, __builtin_amdgcn_readlane(x, 16)),
                s2 = __builtin_bit_cast(float, __builtin_amdgcn_readlane(x, 32)), s3 = __builtin_bit_cast(float, __builtin_amdgcn_readlane(x, 48));
    return (s0 + s1) + (s2 + s3);
}
__device__ __forceinline__ void unpack8(const u32x4 v, float* f) {
    f[0] = bflo(v.x); f[1] = bfhi(v.x); f[2] = bflo(v.y); f[3] = bfhi(v.y); f[4] = bflo(v.z); f[5] = bfhi(v.z); f[6] = bflo(v.w); f[7] = bfhi(v.w);
}
__device__ __forceinline__ unsigned pk4_fp8(float a, float b, float c, float d) {
    a = __builtin_amdgcn_fmed3f(a, -440.f, 440.f); b = __builtin_amdgcn_fmed3f(b, -440.f, 440.f); c = __builtin_amdgcn_fmed3f(c, -440.f, 440.f); d = __builtin_amdgcn_fmed3f(d, -440.f, 440.f);
    int w = __builtin_amdgcn_cvt_pk_fp8_f32(a, b, 0, false); w = __builtin_amdgcn_cvt_pk_fp8_f32(c, d, w, true); return (unsigned)w; }
__device__ __forceinline__ u32x4 pack8(const float* f) {
    u32x4 w; w.x = cvt_pk_bf16(f[0], f[1]); w.y = cvt_pk_bf16(f[2], f[3]); w.z = cvt_pk_bf16(f[4], f[5]); w.w = cvt_pk_bf16(f[6], f[7]); return w;
}


#ifndef PROBE2
#define PROBE2 0
#endif
#ifndef GMASK
#define GMASK 15
#endif
#ifndef RWDBG
#define RWDBG 0
#endif
typedef int i32x8 __attribute__((ext_vector_type(8)));
constexpr float F8_MUL_X = 16.f, F8_MUL_W = 256.f, F8_DESCALE = 1.0f / (16.f * 256.f), F8_MUL_H = 4.f, F8_DESCALE_DOWN = 1.0f / (4.f * 256.f);
constexpr int DFE_PAD = 1536;
namespace pg8 {
typedef unsigned short bf16_t;
constexpr int BM = 256, BK = 64, HALF = 128, HTB = HALF * BK * 2, NXCD = 8, WGM = 8;
__host__ __device__ __forceinline__ int lds_byte(int r, int c) { const int st = (r >> 4) * 2 + (c >> 5), rr = r & 15, cc = c & 31, ob = rr * 64 + cc * 2; return st * 1024 + (ob ^ (((ob >> 9) & 1) << 5)); }
__host__ __device__ __forceinline__ void stage_rc(int b, int& R, int& C) { const int st = b / 1024, sb = b % 1024, swz = sb ^ (((sb >> 9) & 1) << 5); R = (st >> 1) * 16 + swz / 64; C = (st & 1) * 32 + (swz % 64) / 2; }
__host__ __device__ __forceinline__ int perm32(int rho) { const int n = rho >> 4, i = rho & 15; return 8 * (i >> 2) + 4 * n + (i & 3); }

struct Unit { int pm, pn, aoff; };
struct Gemm { const bf16_t* A; const bf16_t* Bt; int lda, K; };

struct StaticOrder {
    int nM, nN, nwg, G, c, ashift, amul;
    __device__ void init(int M, int N, int G_, int c_, int ashift_ = 0, int amul_ = 0) { nM = M / BM; nN = N / BM; nwg = nM * nN; G = G_; c = c_; ashift = ashift_; amul = amul_; }
    __device__ bool next(int i, Unit& u) const {
        const long L = (long)i * G + c; if (L >= nwg) return false;
        int wgid = (int)L; { const int q = nwg / NXCD, r = nwg % NXCD, xcd = wgid % NXCD, off = wgid / NXCD; wgid = (xcd < r ? xcd * (q + 1) : r * (q + 1) + (xcd - r) * q) + off; }
        const int nig = WGM * nN, gid = wgid / nig, fm = gid * WGM, gsz = (nM - fm) < WGM ? (nM - fm) : WGM;
        u.pm = fm + ((wgid % nig) % gsz); u.pn = (wgid % nig) / gsz; u.aoff = (u.pn >> ashift) * amul; return true;
    }
};
struct MoeOrder {
    const int* texp; int ntiles, ncol, G, c;
    __device__ bool next(int i, Unit& u) const {
        const int L = i * G + c; if (L >= ntiles * ncol) return false;
        const int pm = L / ncol, pl = L % ncol;
        u.pm = pm; u.pn = texp[pm] * ncol + pl; u.aoff = 0; return true;
    }
};

template <class Epi, class Sched, bool ALIGN_EPI>
__device__ __forceinline__ void gemm_phase(LAS unsigned char* lds, const int tid_in, const Gemm g, const Sched& S, const Epi& E) {
    const int tid = tid_in, wid = __builtin_amdgcn_readfirstlane(tid >> 6), lane = tid & 63, wr = wid >> 2, wc = wid & 3, fr = lane & 15, fq = lane >> 4;
    const int K = g.K, nt = K / BK, lda = g.lda;
    unsigned voffA[2], voffB[2];
#pragma unroll
    for (int i = 0; i < 2; ++i) { int R, C; stage_rc(tid * 16 + i * 8192, R, C); const int Rb = (R & ~31) + perm32(R & 31);
        voffA[i] = (unsigned)(R * lda + C) * 2u; voffB[i] = (unsigned)(Rb * K + C) * 2u; }
    const size_t kstep = (size_t)(BK * 2);
    const size_t hstepA = (size_t)HALF * lda * 2, tstepA = 2 * hstepA, hstepB = (size_t)HALF * K * 2, tstepB = 2 * hstepB;
    const unsigned ldsw = (unsigned)wid * 1024u;
    const int aoff = lds_byte(wr * 64 + fr, fq * 8), boff = lds_byte(wc * 32 + fr, fq * 8);
#define PG8_SA(b, h) (((b) * 2 + (h)) * HTB)
#define PG8_SB(b, h) ((4 + (b) * 2 + (h)) * HTB)
#define PG8_STAGE(bufoff, gbase, voff) do { _Pragma("unroll") for (int _i = 0; _i < 2; ++_i) \
        __builtin_amdgcn_global_load_lds((const unsigned*)((const char*)(gbase) + (voff)[_i]), (LAS unsigned*)(lds + (bufoff) + ldsw + _i * 8192), 16, 0, 0); } while (0)
#define PG8_LDA(dst, b, h) do { _Pragma("unroll") for (int m = 0; m < 4; ++m) _Pragma("unroll") for (int k = 0; k < 2; ++k) dst[m][k] = *(const LAS bf16x8*)(lds + PG8_SA(b, h) + aoff + m * 2048 + k * 1024); } while (0)
#define PG8_LDB(dst, b, h) do { _Pragma("unroll") for (int n = 0; n < 2; ++n) _Pragma("unroll") for (int k = 0; k < 2; ++k) dst[n][k] = *(const LAS bf16x8*)(lds + PG8_SB(b, h) + boff + n * 2048 + k * 1024); } while (0)
#define PG8_MMA(ai, bj, At, Bt) do { __builtin_amdgcn_s_setprio(1); _Pragma("unroll") for (int m = 0; m < 4; ++m) _Pragma("unroll") for (int n = 0; n < 2; ++n) _Pragma("unroll") for (int k = 0; k < 2; ++k) \
        acc[ai][bj][m][n] = __builtin_amdgcn_mfma_f32_16x16x32_bf16(Bt[n][k], At[m][k], acc[ai][bj][m][n], 0, 0, 0); __builtin_amdgcn_s_setprio(0); } while (0)
#define PG8_WAIT_V(n) asm volatile("s_waitcnt vmcnt(" #n ")" ::: "memory")
#define PG8_WAIT_L(n) asm volatile("s_waitcnt lgkmcnt(" #n ")" ::: "memory")
#define PG8_BAR __builtin_amdgcn_s_barrier()
#define PG8_SCHED __builtin_amdgcn_sched_barrier(0)
    Unit cur, nxt; int ui = 0;
    if (!S.next(0, cur)) return;
    f32x4 acc[2][2][4][2];
#pragma unroll
    for (int a = 0; a < 2; ++a)
#pragma unroll
        for (int b = 0; b < 2; ++b)
#pragma unroll
            for (int m = 0; m < 4; ++m)
#pragma unroll
                for (int n = 0; n < 2; ++n) acc[a][b][m][n] = (f32x4){0.f, 0.f, 0.f, 0.f};
    bf16x8 At[4][2], B0[2][2], B1[2][2];
    const char* cA = (const char*)g.A + (size_t)cur.pm * tstepA + cur.aoff; const char* cB = (const char*)g.Bt + (size_t)cur.pn * tstepB;
    PG8_STAGE(PG8_SB(0, 0), cB, voffB); PG8_STAGE(PG8_SB(0, 1), cB + hstepB, voffB); PG8_STAGE(PG8_SA(0, 0), cA, voffA); PG8_STAGE(PG8_SA(0, 1), cA + hstepA, voffA);
    if (wr == 1) PG8_BAR;
    PG8_WAIT_V(2); PG8_BAR;
    PG8_STAGE(PG8_SB(1, 0), cB + kstep, voffB); PG8_STAGE(PG8_SA(1, 0), cA + kstep, voffA); PG8_STAGE(PG8_SB(1, 1), cB + hstepB + kstep, voffB);
    PG8_WAIT_V(6); PG8_BAR;
    for (;;) {
        const bool has_next = S.next(ui + 1, nxt);
        const char* nA = has_next ? (const char*)g.A + (size_t)nxt.pm * tstepA + nxt.aoff : cA; const char* nB = has_next ? (const char*)g.Bt + (size_t)nxt.pn * tstepB : cB;
#pragma unroll 1
        for (int t = 0; t < nt; t += 2) {
            const bool last = (t == nt - 2);
            const char* a1 = cA + (size_t)(t + 1) * kstep;
            const char* a2 = last ? nA : cA + (size_t)(t + 2) * kstep; const char* b2 = last ? nB : cB + (size_t)(t + 2) * kstep;
            const char* a3 = a2 + kstep; const char* b3 = b2 + kstep;
            PG8_LDB(B0, 0, 0); PG8_LDB(B1, 0, 1); PG8_SCHED; PG8_LDA(At, 0, 0); PG8_STAGE(PG8_SA(1, 1), a1 + hstepA, voffA);
            PG8_WAIT_V(8); PG8_WAIT_L(0); PG8_BAR; PG8_MMA(0, 0, At, B0); PG8_MMA(0, 1, At, B1); PG8_BAR; PG8_SCHED;
            PG8_LDA(At, 0, 1); PG8_STAGE(PG8_SB(0, 0), b2, voffB); PG8_STAGE(PG8_SB(0, 1), b2 + hstepB, voffB); PG8_STAGE(PG8_SA(0, 0), a2, voffA);
            PG8_WAIT_V(8); PG8_WAIT_L(0); PG8_BAR; PG8_MMA(1, 0, At, B0); PG8_MMA(1, 1, At, B1); PG8_BAR; PG8_SCHED;
            PG8_LDB(B0, 1, 0); PG8_LDB(B1, 1, 1); PG8_SCHED; PG8_LDA(At, 1, 0); PG8_STAGE(PG8_SA(0, 1), a2 + hstepA, voffA);
            PG8_WAIT_V(8); PG8_WAIT_L(0); PG8_BAR; PG8_MMA(0, 0, At, B0); PG8_MMA(0, 1, At, B1); PG8_BAR; PG8_SCHED;
            PG8_LDA(At, 1, 1); PG8_STAGE(PG8_SB(1, 0), b3, voffB); PG8_STAGE(PG8_SB(1, 1), b3 + hstepB, voffB); PG8_STAGE(PG8_SA(1, 0), a3, voffA);
            PG8_WAIT_V(8); PG8_WAIT_L(0); PG8_BAR; PG8_MMA(1, 0, At, B0); PG8_MMA(1, 1, At, B1); PG8_BAR; PG8_SCHED;
        }
        if constexpr (ALIGN_EPI) { if (wr == 0) PG8_BAR; }
        { int ln_; asm volatile("v_mbcnt_lo_u32_b32 %0, -1, 0\n\tv_mbcnt_hi_u32_b32 %0, -1, %0" : "=v"(ln_)); E(acc, cur, wr, wc, ln_ & 15, ln_ >> 4); }
        if (!has_next) break;
#pragma unroll
        for (int a = 0; a < 2; ++a)
#pragma unroll
            for (int b = 0; b < 2; ++b)
#pragma unroll
                for (int m = 0; m < 4; ++m)
#pragma unroll
                    for (int n = 0; n < 2; ++n) acc[a][b][m][n] = (f32x4){0.f, 0.f, 0.f, 0.f};
        cur = nxt; cA = nA; cB = nB; ++ui;
        if constexpr (ALIGN_EPI) { if (wr == 1) PG8_BAR; }
    }
    PG8_WAIT_V(0);
    if constexpr (!ALIGN_EPI) { if (wr == 0) PG8_BAR; }
    PG8_BAR;
#undef PG8_SA
#undef PG8_SB
#undef PG8_STAGE
#undef PG8_LDA
#undef PG8_LDB
#undef PG8_MMA
#undef PG8_WAIT_V
#undef PG8_WAIT_L
#undef PG8_BAR
#undef PG8_SCHED
}

template <class Epi, class Sched, bool ALIGN_EPI>
__device__ __forceinline__ void gemm_phase8(LAS unsigned char* lds, const int tid_in, const Gemm g, const Sched& S, const Epi& E) {
    const int tid = tid_in, wid = __builtin_amdgcn_readfirstlane(tid >> 6), lane = tid & 63, wr = wid >> 2, wc = wid & 3, fr = lane & 15, fq = lane >> 4;
    const int K = g.K, nt = K / 128, lda = g.lda;
    unsigned voffA, voffB;
    { int R, C; stage_rc(tid * 16, R, C); const int Rb = (R & ~31) + perm32(R & 31); voffA = (unsigned)(R * lda + C * 2); voffB = (unsigned)(Rb * K + C * 2); }
    const unsigned pstepA = 64u * (unsigned)lda, pstepB = 64u * (unsigned)K;
    const unsigned kstep = (unsigned)(BK * 2);
    const unsigned hstepA = (unsigned)HALF * (unsigned)lda, tstepA = 2 * hstepA, hstepB = (unsigned)HALF * (unsigned)K, tstepB = 2 * hstepB;
    const __amdgpu_buffer_rsrc_t rsA = __builtin_amdgcn_make_buffer_rsrc((void*)g.A, 0, 0x7fffffff, 0x00020000), rsB = __builtin_amdgcn_make_buffer_rsrc((void*)g.Bt, 0, 0x7fffffff, 0x00020000);
    const unsigned ldsw = (unsigned)wid * 1024u;
    const int aoff0 = lds_byte(wr * 64 + fr, fq * 16), aoff1 = aoff0 + 16, boff0 = lds_byte(wc * 32 + fr, fq * 16), boff1 = boff0 + 16;
#define PG8_SA(b, h) (((b) * 2 + (h)) * HTB)
#define PG8_SB(b, h) ((4 + (b) * 2 + (h)) * HTB)
#define PG8_STAGE(bufoff, goff, voff, pstep) do { _Pragma("unroll") for (int _i = 0; _i < 2; ++_i) \
        __builtin_amdgcn_raw_ptr_buffer_load_lds(PG8_RS_##voff, (LAS unsigned*)(lds + (bufoff) + ldsw + _i * 8192), 16, (int)(voff), (int)((goff) + _i * (pstep)), 0, 0); } while (0)
#define PG8_RS_voffA rsA
#define PG8_RS_voffB rsB
#define PG8_LDA(dst, b, h) do { _Pragma("unroll") for (int m = 0; m < 4; ++m) { dst[m][0] = *(const LAS u32x4*)(lds + PG8_SA(b, h) + aoff0 + m * 2048); dst[m][1] = *(const LAS u32x4*)(lds + PG8_SA(b, h) + aoff1 + m * 2048); } } while (0)
#define PG8_LDB(dst, b, h) do { _Pragma("unroll") for (int n = 0; n < 2; ++n) { dst[n][0] = *(const LAS u32x4*)(lds + PG8_SB(b, h) + boff0 + n * 2048); dst[n][1] = *(const LAS u32x4*)(lds + PG8_SB(b, h) + boff1 + n * 2048); } } while (0)
#define PG8_J8(x) __builtin_bit_cast(i32x8, __builtin_shufflevector((x)[0], (x)[1], 0, 1, 2, 3, 4, 5, 6, 7))
#define PG8_MMA(ai, bj, At, Bt) do { __builtin_amdgcn_s_setprio(1); _Pragma("unroll") for (int m = 0; m < 4; ++m) _Pragma("unroll") for (int n = 0; n < 2; ++n) \
        acc[ai][bj][m][n] = __builtin_amdgcn_mfma_scale_f32_16x16x128_f8f6f4(PG8_J8(Bt[n]), PG8_J8(At[m]), acc[ai][bj][m][n], 0, 0, 0, 0, 0, 0);        __builtin_amdgcn_s_setprio(0); } while (0)
#define PG8_WAIT_V(n) asm volatile("s_waitcnt vmcnt(" #n ")" ::: "memory")
#define PG8_WAIT_L(n) asm volatile("s_waitcnt lgkmcnt(" #n ")" ::: "memory")
#define PG8_BAR __builtin_amdgcn_s_barrier()
#define PG8_SCHED __builtin_amdgcn_sched_barrier(0)
    Unit cur, nxt; int ui = 0;
    if (!S.next(0, cur)) return;
    f32x4 acc[2][2][4][2];
#pragma unroll
    for (int a = 0; a < 2; ++a)
#pragma unroll
        for (int b = 0; b < 2; ++b)
#pragma unroll
            for (int m = 0; m < 4; ++m)
#pragma unroll
                for (int n = 0; n < 2; ++n) acc[a][b][m][n] = (f32x4){0.f, 0.f, 0.f, 0.f};
    u32x4 At[4][2], B0[2][2], B1[2][2];
    unsigned cA = (unsigned)cur.pm * tstepA + (unsigned)cur.aoff, cB = (unsigned)cur.pn * tstepB;
    PG8_STAGE(PG8_SB(0, 0), cB, voffB, pstepB); PG8_STAGE(PG8_SB(0, 1), cB + hstepB, voffB, pstepB); PG8_STAGE(PG8_SA(0, 0), cA, voffA, pstepA); PG8_STAGE(PG8_SA(0, 1), cA + hstepA, voffA, pstepA);
    if (wr == 1) PG8_BAR;
    PG8_WAIT_V(2); PG8_BAR;
    PG8_STAGE(PG8_SB(1, 0), cB + kstep, voffB, pstepB); PG8_STAGE(PG8_SA(1, 0), cA + kstep, voffA, pstepA); PG8_STAGE(PG8_SB(1, 1), cB + hstepB + kstep, voffB, pstepB);
    PG8_WAIT_V(6); PG8_BAR;
    for (;;) {
        const bool has_next = S.next(ui + 1, nxt);
        const unsigned nA = has_next ? (unsigned)nxt.pm * tstepA + (unsigned)nxt.aoff : cA, nB = has_next ? (unsigned)nxt.pn * tstepB : cB;
#pragma unroll 1
        for (int t = 0; t < nt; t += 2) {
            const bool last = (t == nt - 2);
            const unsigned a1 = cA + (unsigned)(t + 1) * kstep;
            const unsigned a2 = last ? nA : cA + (unsigned)(t + 2) * kstep, b2 = last ? nB : cB + (unsigned)(t + 2) * kstep;
            const unsigned a3 = a2 + kstep, b3 = b2 + kstep;
            PG8_LDB(B0, 0, 0); PG8_LDB(B1, 0, 1); PG8_SCHED; PG8_LDA(At, 0, 0); PG8_STAGE(PG8_SA(1, 1), a1 + hstepA, voffA, pstepA);
            PG8_WAIT_V(8); PG8_WAIT_L(0); PG8_BAR; PG8_MMA(0, 0, At, B0); PG8_MMA(0, 1, At, B1); PG8_BAR; PG8_SCHED;
            PG8_LDA(At, 0, 1); PG8_STAGE(PG8_SB(0, 0), b2, voffB, pstepB); PG8_STAGE(PG8_SB(0, 1), b2 + hstepB, voffB, pstepB); PG8_STAGE(PG8_SA(0, 0), a2, voffA, pstepA);
            PG8_WAIT_V(8); PG8_WAIT_L(0); PG8_BAR; PG8_MMA(1, 0, At, B0); PG8_MMA(1, 1, At, B1); PG8_BAR; PG8_SCHED;
            PG8_LDB(B0, 1, 0); PG8_LDB(B1, 1, 1); PG8_SCHED; PG8_LDA(At, 1, 0); PG8_STAGE(PG8_SA(0, 1), a2 + hstepA, voffA, pstepA);
            PG8_WAIT_V(8); PG8_WAIT_L(0); PG8_BAR; PG8_MMA(0, 0, At, B0); PG8_MMA(0, 1, At, B1); PG8_BAR; PG8_SCHED;
            PG8_LDA(At, 1, 1); PG8_STAGE(PG8_SB(1, 0), b3, voffB, pstepB); PG8_STAGE(PG8_SB(1, 1), b3 + hstepB, voffB, pstepB); PG8_STAGE(PG8_SA(1, 0), a3, voffA, pstepA);
            PG8_WAIT_V(8); PG8_WAIT_L(0); PG8_BAR; PG8_MMA(1, 0, At, B0); PG8_MMA(1, 1, At, B1); PG8_BAR; PG8_SCHED;
        }
        if constexpr (ALIGN_EPI) { if (wr == 0) PG8_BAR; }
        { int ln_; asm volatile("v_mbcnt_lo_u32_b32 %0, -1, 0\n\tv_mbcnt_hi_u32_b32 %0, -1, %0" : "=v"(ln_)); E(acc, cur, wr, wc, ln_ & 15, ln_ >> 4); }
        if (!has_next) break;
#pragma unroll
        for (int a = 0; a < 2; ++a)
#pragma unroll
            for (int b = 0; b < 2; ++b)
#pragma unroll
                for (int m = 0; m < 4; ++m)
#pragma unroll
                    for (int n = 0; n < 2; ++n) acc[a][b][m][n] = (f32x4){0.f, 0.f, 0.f, 0.f};
        cur = nxt; cA = nA; cB = nB; ++ui;
        if constexpr (ALIGN_EPI) { if (wr == 1) PG8_BAR; }
    }
    PG8_WAIT_V(0);
    if constexpr (!ALIGN_EPI) { if (wr == 0) PG8_BAR; }
    PG8_BAR;
#undef PG8_SA
#undef PG8_SB
#undef PG8_STAGE
#undef PG8_RS_voffA
#undef PG8_RS_voffB
#undef PG8_LDA
#undef PG8_LDB
#undef PG8_MMA
#undef PG8_J8
#undef PG8_WAIT_V
#undef PG8_WAIT_L
#undef PG8_BAR
#undef PG8_SCHED
}

typedef f32x4 Acc[2][2][4][2];

struct EpiRoute {
    bf16_t *d0, *d1, *d2, *d3;
    __device__ __forceinline__ void operator()(const Acc& acc, const Unit& u, int wr, int wc, int fr, int fq) const {
        const int pn = u.pn; bf16_t* base; int ld, ct;
        if (pn < 4) { base = d0; ld = 1024; ct = pn; } else if (pn < 7) { base = d1; ld = 768; ct = pn - 4; } else if (pn < 11) { base = d2; ld = 1024; ct = pn - 7; } else { base = d3; ld = 512; ct = pn - 11; }
        const int row0 = u.pm * BM + wr * 64 + fr, col0 = ct * 256 + wc * 32 + 8 * fq;
#pragma unroll
        for (int ai = 0; ai < 2; ++ai)
#pragma unroll
            for (int m = 0; m < 4; ++m) { bf16_t* rowp = base + (size_t)(row0 + ai * HALF + m * 16) * ld + col0;
#pragma unroll
                for (int bj = 0; bj < 2; ++bj) { const f32x4 v0 = acc[ai][bj][m][0], v1 = acc[ai][bj][m][1]; u32x4 w;
                    w.x = cvt_pk_bf16(v0[0], v0[1]); w.y = cvt_pk_bf16(v0[2], v0[3]); w.z = cvt_pk_bf16(v1[0], v1[1]); w.w = cvt_pk_bf16(v1[2], v1[3]);
                    *(u32x4*)(rowp + bj * HALF) = w; } }
    }
};
struct EpiBf16 {
    bf16_t* O; int ld, pnmask; float sc;
    __device__ __forceinline__ void operator()(const Acc& acc, const Unit& u, int wr, int wc, int fr, int fq) const {
        const int row0 = u.pm * BM + wr * 64 + fr, col0 = (u.pn & pnmask) * 256 + wc * 32 + 8 * fq;
#pragma unroll
        for (int ai = 0; ai < 2; ++ai)
#pragma unroll
            for (int m = 0; m < 4; ++m) { bf16_t* rowp = O + (size_t)(row0 + ai * HALF + m * 16) * ld + col0;
#pragma unroll
                for (int bj = 0; bj < 2; ++bj) { const f32x4 v0 = acc[ai][bj][m][0] * sc, v1 = acc[ai][bj][m][1] * sc; u32x4 w;
                    w.x = cvt_pk_bf16(v0[0], v0[1]); w.y = cvt_pk_bf16(v0[2], v0[3]); w.z = cvt_pk_bf16(v1[0], v1[1]); w.w = cvt_pk_bf16(v1[2], v1[3]);
                    *(u32x4*)(rowp + bj * HALF) = w; } }
    }
};
struct EpiLora {
    float* wdec; bf16_t* ag; const float* w0; const float* a0;
    __device__ __forceinline__ void operator()(const Acc& acc, const Unit& u, int wr, int wc, int fr, int fq) const {
        const int row0 = u.pm * BM + wr * 64 + fr, cl0 = wc * 32 + 8 * fq, pn = u.pn;
#pragma unroll
        for (int ai = 0; ai < 2; ++ai)
#pragma unroll
            for (int m = 0; m < 4; ++m) { const size_t row = (size_t)(row0 + ai * HALF + m * 16);
#pragma unroll
                for (int bj = 0; bj < 2; ++bj) { const int col = bj * HALF + cl0; float v[8];
#pragma unroll
                    for (int n = 0; n < 2; ++n)
#pragma unroll
                        for (int e = 0; e < 4; ++e) v[4 * n + e] = acc[ai][bj][m][n][e];
                    if (pn == 0) {
                        *(f32x4*)(wdec + row * 256 + col) = (f32x4){v[0], v[1], v[2], v[3]}; *(f32x4*)(wdec + row * 256 + col + 4) = (f32x4){v[4], v[5], v[6], v[7]};
                    } else if (pn == 1) {
                        *(u32x4*)(ag + row * 512 + col) = pack8(v);
                    } else { *(u32x4*)(ag + row * 512 + 256 + col) = pack8(v); }
                } }
    }
};
struct EpiGateMerge {
    const bf16_t* ball; bf16_t* merged;
    __device__ __forceinline__ void operator()(const Acc& acc, const Unit& u, int wr, int wc, int fr, int fq) const {
        const int row0 = u.pm * BM + wr * 64 + fr, o0 = 64 * u.pn + 16 * wc + 4 * fq;
#pragma unroll
        for (int ai = 0; ai < 2; ++ai)
#pragma unroll
            for (int m = 0; m < 4; ++m) { const size_t row = (size_t)(row0 + ai * HALF + m * 16); float s[4] = {0.f, 0.f, 0.f, 0.f};
#pragma unroll
                for (int bj = 0; bj < 2; ++bj)
#pragma unroll
                    for (int n = 0; n < 2; ++n) { const int gi = 2 * bj + n; if (!((GMASK >> gi) & 1)) continue; const u32x2 b = *(const u32x2*)(ball + row * 4096 + 1024 * gi + o0);
                        const f32x4 a = acc[ai][bj][m][n] * F8_DESCALE;
                        s[0] += sigm(a[0]) * bflo(b.x); s[1] += sigm(a[1]) * bfhi(b.x); s[2] += sigm(a[2]) * bflo(b.y); s[3] += sigm(a[3]) * bfhi(b.y); }
                u32x2 w; w.x = cvt_pk_bf16(s[0], s[1]); w.y = cvt_pk_bf16(s[2], s[3]);
                *(u32x2*)(merged + row * 1024 + o0) = w; }
    }
};
struct EpiResidual {
    float* out; float sc;
    __device__ __forceinline__ void operator()(const Acc& acc, const Unit& u, int wr, int wc, int fr, int fq) const {
        const int row0 = u.pm * BM + wr * 64 + fr, col0 = u.pn * 256 + wc * 32 + 8 * fq;
#pragma unroll
        for (int ai = 0; ai < 2; ++ai)
#pragma unroll
            for (int m = 0; m < 4; ++m) { float* rowp = out + (size_t)(row0 + ai * HALF + m * 16) * 1024 + col0;
#pragma unroll
                for (int bj = 0; bj < 2; ++bj)
#pragma unroll
                    for (int n = 0; n < 2; ++n) { f32x4* p = (f32x4*)(rowp + bj * HALF + 4 * n); f32x4 v = *p; v = v + acc[ai][bj][m][n] * sc; *p = v; } }
    }
};
struct EpiSwiglu {
    unsigned char* hid; int ldh, ncol; bool pad;
    __device__ __forceinline__ void operator()(const Acc& acc, const Unit& u, int wr, int wc, int fr, int fq) const {
        const int pl = u.pn % ncol; const int row0 = u.pm * BM + wr * 64 + fr, col0 = pl * 128 + wc * 32 + 8 * fq;
        const bool dopad = pad && (pl == ncol - 1);
#pragma unroll
        for (int ai = 0; ai < 2; ++ai)
#pragma unroll
            for (int m = 0; m < 4; ++m) { float v[8];
#pragma unroll
                for (int n = 0; n < 2; ++n)
#pragma unroll
                    for (int e = 0; e < 4; ++e) { const float a = acc[ai][0][m][n][e] * F8_DESCALE, b = acc[ai][1][m][n][e] * F8_DESCALE; v[4 * n + e] = a * sigm(a) * b * F8_MUL_H; }
                unsigned char* rp = hid + (size_t)(row0 + ai * HALF + m * 16) * ldh + col0;
                u32x2 w; w.x = pk4_fp8(v[0], v[1], v[2], v[3]); w.y = pk4_fp8(v[4], v[5], v[6], v[7]); *(u32x2*)rp = w;
                if (dopad) { unsigned z0; asm volatile("v_mov_b32 %0, 0" : "=v"(z0)); *(u32x2*)(rp + 128) = (u32x2){z0, z0}; } }
    }
};
struct EpiMoeOut {
    float* out; const int* rowtok; const float* rowgate; const int* segend;
    __device__ __forceinline__ void operator()(const Acc& acc, const Unit& u, int wr, int wc, int fr, int fq) const {
        const int row0 = u.pm * BM + wr * 64 + fr, col0 = (u.pn & 3) * 256 + wc * 32 + 8 * fq, lim = segend[u.pm];
#pragma unroll
        for (int ai = 0; ai < 2; ++ai)
#pragma unroll
            for (int m = 0; m < 4; ++m) { const int row = row0 + ai * HALF + m * 16;
                if (row < lim) { const int tok = rowtok[row]; const float gt = rowgate[row]; float* rowp = out + (size_t)tok * 1024 + col0;
#pragma unroll
                    for (int bj = 0; bj < 2; ++bj)
#pragma unroll
                        for (int n = 0; n < 2; ++n)
#pragma unroll
                            for (int e = 0; e < 4; ++e) __hip_atomic_fetch_add(rowp + bj * HALF + 4 * n + e, gt * acc[ai][bj][m][n][e], __ATOMIC_RELAXED, __HIP_MEMORY_SCOPE_AGENT);
                } }
    }
};
}

#define XB_TMO      128
#define XB_XCNT(j)  (256  + 64 * (j))
#define XB_XSUB(j)  (1280 + 64 * (j))
#define XB_XGEN(j)  (2304 + 64 * (j))
#define XB_TOP      3328
#define XB_TOPGEN   3392
#define XCD_BAR_WORDS 3456
#define XB_SPIN_CAP (1u << 18)
__device__ __forceinline__ unsigned xb_ld(unsigned* p)              { return __hip_atomic_load(p, __ATOMIC_RELAXED, __HIP_MEMORY_SCOPE_AGENT); }
__device__ __forceinline__ unsigned xb_add(unsigned* p, unsigned v) { return __hip_atomic_fetch_add(p, v, __ATOMIC_RELAXED, __HIP_MEMORY_SCOPE_AGENT); }
__device__ __forceinline__ unsigned xb_xcc_id() { return (unsigned)__builtin_amdgcn_s_getreg((3 << 11) | 20) & 0xFu; }
#define XB_SPIN(cond, bar) do { unsigned _sp = 0; while (cond) { __builtin_amdgcn_s_sleep(1); \
    if ((++_sp & 255u) == 0u) { if (xb_ld(&(bar)[XB_TMO])) break; if (_sp > XB_SPIN_CAP) { atomicAdd(&(bar)[XB_TMO], 1u); break; } } } } while (0)
struct XcdBarrier { unsigned* bar; unsigned x; volatile LAS unsigned* st; };
__device__ __forceinline__ XcdBarrier xcd_barrier_post(unsigned* bar, volatile LAS unsigned* st) {
    XcdBarrier b; b.bar = bar; b.x = xb_xcc_id(); b.st = st;
    if (threadIdx.x == 0) (void)xb_add(&bar[XB_XCNT(b.x)], 1u);
    return b;
}
__device__ __forceinline__ void xcd_barrier_complete(unsigned* bar, unsigned x, unsigned& nloc, unsigned& nx) {
    const unsigned G = gridDim.x * gridDim.y * gridDim.z;
    unsigned sum, cnt, mine, sp = 0u;
    for (;;) {
        sum = 0u; cnt = 0u; mine = 0u;
#pragma unroll
        for (unsigned j = 0; j < 16; ++j) { const unsigned c = xb_ld(&bar[XB_XCNT(j)]); sum += c; cnt += (c > 0u) ? 1u : 0u; mine = (j == x) ? c : mine; }
        if (sum == G) break;
        __builtin_amdgcn_s_sleep(1);
        if ((++sp & 255u) == 0u) { if (xb_ld(&bar[XB_TMO])) break; if (sp > XB_SPIN_CAP) { atomicAdd(&bar[XB_TMO], 1u); break; } }
    }
    nloc = mine > 0u ? mine : 1u; nx = cnt > 0u ? cnt : 1u;
}
__device__ __forceinline__ void xcd_barrier(const XcdBarrier& b, const int tid) {
    asm volatile("s_waitcnt vmcnt(0)" ::: "memory");
    __syncthreads();
    if (tid == 0) {
        unsigned* bar = b.bar;
        __builtin_amdgcn_s_waitcnt(0);
        unsigned nloc = b.st[0], nx = b.st[1];
        if (nloc == 0u) { xcd_barrier_complete(bar, b.x, nloc, nx); b.st[0] = nloc; b.st[1] = nx; }
        const unsigned old = xb_add(&bar[XB_XSUB(b.x)], 1u);
        const unsigned gen = old / nloc;
        if (old + 1u == (gen + 1u) * nloc) {
            __builtin_amdgcn_fence(__ATOMIC_RELEASE, "agent");
            asm volatile("s_waitcnt vmcnt(0)" ::: "memory");
            const unsigned og = xb_add(&bar[XB_TOP], 1u);
            const unsigned tg = og / nx;
            if (og + 1u == (tg + 1u) * nx) xb_add(&bar[XB_TOPGEN], 1u);
            else XB_SPIN(xb_ld(&bar[XB_TOPGEN]) == tg, bar);
            __builtin_amdgcn_fence(__ATOMIC_ACQUIRE, "agent");
            xb_add(&bar[XB_XGEN(b.x)], 1u);
            asm volatile("s_waitcnt vmcnt(0)" ::: "memory");
        } else {
            XB_SPIN(xb_ld(&bar[XB_XGEN(b.x)]) == gen, bar);
            __builtin_amdgcn_fence(__ATOMIC_ACQUIRE, "agent");
            asm volatile("s_waitcnt vmcnt(0)" ::: "memory");
        }
    }
    __syncthreads();
}

constexpr size_t MiB = 1u << 20;
constexpr size_t WS_CTL = 0, CTL_ZERO_BYTES = 1 * MiB;
constexpr int CW_BAR = 4096;
constexpr int CW_MOE = 16384;
constexpr size_t WS_EIDX = 1 * MiB, WS_GATE = WS_EIDX + 256 * 1024, WS_ROWTOK = WS_EIDX + 512 * 1024, WS_ROWGATE = 2 * MiB, WS_TEXP = 2 * MiB + 512 * 1024, WS_SEGEND = WS_TEXP + 4096, WS_NT = WS_TEXP + 8192;
constexpr size_t WS_SLOTOF = 2 * MiB + 768 * 1024;
constexpr size_t WS_BON = 3 * MiB, WS_COS = 4 * MiB, WS_SIN = 6 * MiB;
constexpr size_t WS_WIN = 8 * MiB, WS_WLORA = 15 * MiB, WS_WB = 16 * MiB, WS_WG = 18 * MiB, WS_WOUT = 26 * MiB, WS_W13 = 28 * MiB  , WS_W2D = 50 * MiB, WS_W2M = 50 * MiB, WS_H8 = 72 * MiB  ;
constexpr size_t WS_H = 104 * MiB, WS_Y = 168 * MiB, WS_BIG = 232 * MiB;
constexpr size_t WS_RW = WS_BIG, WS_WDEC = WS_BIG, WS_AG = WS_BIG + 32 * MiB, WS_SB = WS_BIG + 64 * MiB, WS_RET = WS_BIG + 112 * MiB, WS_CV = WS_BIG + 176 * MiB, WS_Y0 = WS_CV;
constexpr size_t WS_RKVS = WS_BIG + 208 * MiB, WS_ALORA = WS_BIG + 256 * MiB, WS_RHAT = WS_ALORA, WS_KV = WS_BIG + 272 * MiB, WS_SST = WS_WDEC  , WS_PQ = WS_BIG + 304 * MiB  , WS_END = WS_BIG + 368 * MiB;
constexpr size_t WS_BALL = WS_BIG, WS_MERGED = WS_BIG + 256 * MiB, WS_HID = WS_BIG, WS_XS = WS_BIG, WS_YS = WS_XS, WS_HIDM = WS_BIG + 132 * MiB;
static_assert(WS_HIDM + (size_t)MPAD * DFE * 2 <= WS_END && WS_MERGED + (size_t)T * D * 2 <= WS_END && WS_W2M + (size_t)NEXP * D * DFE * 2 <= WS_H8, "ws map");
static_assert(WS_W13 + (size_t)NEXP * 2 * DFE * D <= WS_W2M && WS_W13 + (size_t)2 * DFF * D <= WS_W2D && WS_W2M + (size_t)NEXP * D * DFE * 2 <= WS_H8 && WS_H8 + (size_t)T * D <= WS_H, "ws map weights");

constexpr int LDS_BYTES = 147456, RING_BYTES = 131072, MISC_OFF = RING_BYTES + 320;

struct Args { const float* in[32]; float* out; unsigned char* ws; int ph_lo, ph_hi; };
#define CAS __attribute__((address_space(4)))
struct Ctx {
    LAS unsigned char* lds; unsigned char* ws; float* out; const float* const CAS* in;
    int tid, lane, wave, G, bid;
};
__device__ __forceinline__ const CAS Args* ka_ptr() { const CAS Args* p = (const CAS Args*)__builtin_amdgcn_kernarg_segment_ptr(); asm volatile("" : "+s"(p)); return p; }
extern __shared__ __attribute__((aligned(16))) unsigned char lds_raw[];
__device__ __forceinline__ Ctx make_ctx(int wv) {
    const CAS Args* ka = ka_ptr();
    Ctx C; C.lds = (LAS unsigned char*)lds_raw; C.ws = ka->ws; C.out = ka->out; C.in = ka->in;
    int g_ = gridDim.x, b_ = blockIdx.x, w_ = wv; asm volatile("" : "+s"(g_), "+s"(b_), "+s"(w_));
    int ln_; asm volatile("v_mbcnt_lo_u32_b32 %0, -1, 0\n\tv_mbcnt_hi_u32_b32 %0, -1, %0" : "=v"(ln_));
    C.lane = ln_; C.wave = w_; C.tid = w_ * 64 + ln_; C.G = g_; C.bid = b_;
    return C;
}
enum { I_X = 0, I_NORM_MIX, I_W_IN, I_RW_MU, I_RW_W0, I_RW_W2, I_RW_A0, I_RW_A2, I_RW_G2, I_RW_KK, I_RW_KA, I_RW_RK, I_RW_LNW, I_RW_LNB, I_SB_QN, I_SB_KN, I_RET_GN,
       I_CONV_DW, I_CONV_B, I_CONV_LNW, I_CONV_LNB, I_W_GATE, I_W_BRANCH, I_W_OUT, I_NORM_FFN, I_FFN_W1, I_FFN_W3, I_FFN_W2, I_ROUTER, I_MOE_W1, I_MOE_W3, I_MOE_W2 };

__device__ __forceinline__ void ph_prologue_(const Ctx& C) {
    const size_t gid = (size_t)C.bid * NTHR + C.tid, gsz = (size_t)C.G * NTHR;
    float* cs = (float*)(C.ws + WS_COS); float* sn = (float*)(C.ws + WS_SIN);
    for (size_t i = gid; i < (size_t)SEQ * 32; i += gsz) {
        const int pos = (int)(i >> 5), j = (int)(i & 31);
        const float inv = (float)pow(10000.0, -(double)(2 * j) / 64.0);
        const float ang = (float)pos * inv;
        cs[i] = (float)cos((double)ang); sn[i] = (float)sin((double)ang);
    }
}

__device__ __forceinline__ int dest_row(int mode, int roff, int which, int n) {
    if (mode == 0) return roff + n;
    if (mode == 1) { const int pn = n >> 6, oc = n & 63; return 256 * pn + 128 * (roff >> 1) + 32 * (oc >> 4) + 8 * ((oc >> 2) & 3) + 4 * (roff & 1) + (oc & 3); }
    return roff + 256 * (n >> 7) + 128 * which + (n & 127);
}
__device__ __forceinline__ void xpose_item(const float* W, int K, int N, bf16* WT, int mode, int roff, int which, LAS float* scr, int item, int lane) {
    const int nblk = N / 32, kb = item / nblk, nb = item % nblk, k0 = 64 * kb, n0 = 32 * nb;
#pragma unroll
    for (int i = 0; i < 8; ++i) { const int kk = (lane >> 3) + 8 * i, c4 = (lane & 7) * 4; const f32x4 v = *(const f32x4*)(W + (size_t)(k0 + kk) * N + n0 + c4);
        scr[kk * 33 + c4] = v.x; scr[kk * 33 + c4 + 1] = v.y; scr[kk * 33 + c4 + 2] = v.z; scr[kk * 33 + c4 + 3] = v.w; }
    asm volatile("s_waitcnt lgkmcnt(0)" ::: "memory");
    const int c = lane & 7;
#pragma unroll
    for (int j = 0; j < 4; ++j) { const int n = (lane >> 3) + 8 * j; const LAS float* s = scr + (8 * c) * 33 + n;
        u32x4 o; o.x = cvt_pk_bf16(s[0 * 33], s[1 * 33]); o.y = cvt_pk_bf16(s[2 * 33], s[3 * 33]); o.z = cvt_pk_bf16(s[4 * 33], s[5 * 33]); o.w = cvt_pk_bf16(s[6 * 33], s[7 * 33]);
        *(u32x4*)(WT + (size_t)dest_row(mode, roff, which, n0 + n) * K + k0 + 8 * c) = o; }
    asm volatile("s_waitcnt lgkmcnt(0)" ::: "memory");
}
__device__ __forceinline__ void xpose_item8(const float* W, int K, int N, unsigned char* WT, int mode, int roff, int which, LAS float* scr, int item, int lane, int ldk = 0) {
    if (ldk == 0) ldk = K;
    const int nblk = N / 32, kb = item / nblk, nb = item % nblk, k0 = 64 * kb, n0 = 32 * nb;
#pragma unroll
    for (int i = 0; i < 8; ++i) { const int kk = (lane >> 3) + 8 * i, c4 = (lane & 7) * 4; const f32x4 v = *(const f32x4*)(W + (size_t)(k0 + kk) * N + n0 + c4);
        scr[kk * 33 + c4] = v.x; scr[kk * 33 + c4 + 1] = v.y; scr[kk * 33 + c4 + 2] = v.z; scr[kk * 33 + c4 + 3] = v.w; }
    asm volatile("s_waitcnt lgkmcnt(0)" ::: "memory");
    const int c = lane & 3;
#pragma unroll
    for (int j = 0; j < 2; ++j) { const int n = (lane >> 2) + 16 * j; const LAS float* sp = scr + (16 * c) * 33 + n;
        u32x4 o;
        o.x = pk4_fp8(sp[0 * 33] * F8_MUL_W, sp[1 * 33] * F8_MUL_W, sp[2 * 33] * F8_MUL_W, sp[3 * 33] * F8_MUL_W);
        o.y = pk4_fp8(sp[4 * 33] * F8_MUL_W, sp[5 * 33] * F8_MUL_W, sp[6 * 33] * F8_MUL_W, sp[7 * 33] * F8_MUL_W);
        o.z = pk4_fp8(sp[8 * 33] * F8_MUL_W, sp[9 * 33] * F8_MUL_W, sp[10 * 33] * F8_MUL_W, sp[11 * 33] * F8_MUL_W);
        o.w = pk4_fp8(sp[12 * 33] * F8_MUL_W, sp[13 * 33] * F8_MUL_W, sp[14 * 33] * F8_MUL_W, sp[15 * 33] * F8_MUL_W);
        *(u32x4*)(WT + (size_t)dest_row(mode, roff, which, n0 + n) * ldk + k0 + 16 * c) = o; }
    asm volatile("s_waitcnt lgkmcnt(0)" ::: "memory");
}
__device__ __forceinline__ void ph_weights_(const Ctx& C, int l, int part, int first_wg, int nwg) {
    LAS float* scr = (LAS float*)(C.lds + C.wave * 16384);
    const int gw = (C.bid - first_wg) * NWAVES + C.wave, NGW = nwg * NWAVES, lane = C.lane;
    unsigned char* ws = C.ws;
    const bool moe = (l & 1);
    const int l2 = l >> 1;
    constexpr int IT_IN = (D / 64) * (NIN / 32), IT_B = (256 / 64) * (D / 32), IT_G = (D / 64) * (D / 32), IT_O = IT_G;
    constexpr int IT_F1 = (D / 64) * (DFF / 32), IT_F2 = (DFF / 64) * (D / 32), IT_M1 = (D / 64) * (DFE / 32), IT_M2 = (DFE / 64) * (D / 32);
    const int n_fixed = IT_IN + 4 * IT_B + 4 * IT_G + IT_O;
    if (part == 1) {
        if (C.bid < first_wg) return;
        const int n1 = moe ? NEXP * IT_M2 : (2 * IT_F1 + IT_F2);
        for (int it = gw; it < n1; it += NGW) {
            int r = it;
            if (!moe) {
                if (r < IT_F1) { xpose_item8(C.in[I_FFN_W1] + (size_t)l2 * D * DFF, D, DFF, ws + WS_W13, 2, 0, 0, scr, r, lane); continue; } r -= IT_F1;
                if (r < IT_F1) { xpose_item8(C.in[I_FFN_W3] + (size_t)l2 * D * DFF, D, DFF, ws + WS_W13, 2, 0, 1, scr, r, lane); continue; } r -= IT_F1;
                xpose_item8(C.in[I_FFN_W2] + (size_t)l2 * DFF * D, DFF, D, ws + WS_W2D, 0, 0, 0, scr, r, lane);
            } else { const int e = r / IT_M2; r -= e * IT_M2;
                xpose_item8(C.in[I_MOE_W2] + ((size_t)l2 * NEXP + e) * DFE * D, DFE, D, ws + WS_W2M, 0, e * D, 0, scr, r, lane, DFE_PAD); }
        }
        if (moe) {
            for (int i = (C.bid - first_wg) * NTHR + C.tid; i < NEXP * D * ((DFE_PAD - DFE) / 16); i += nwg * NTHR) { const int row = i >> 3, c16 = i & 7;
                unsigned z0; asm volatile("v_mov_b32 %0, 0" : "=v"(z0)); *(u32x4*)(ws + WS_W2M + (size_t)row * DFE_PAD + DFE + 16 * c16) = (u32x4){z0, z0, z0, z0}; } }
        return;
    }
    const int n_ffn = moe ? (NEXP * 2 * IT_M1) : 0;
    for (int it = gw; it < n_fixed + n_ffn; it += NGW) {
        int r = it;
        if (r < IT_IN) { xpose_item(C.in[I_W_IN] + (size_t)l * D * NIN, D, NIN, (bf16*)(ws + WS_WIN), 0, 0, 0, scr, r, lane); continue; } r -= IT_IN;
        if (r < 4 * IT_B) { const int i = r / IT_B; xpose_item(C.in[I_W_BRANCH] + ((size_t)l * 4 + i) * 256 * D, 256, D, (bf16*)(ws + WS_WB), 0, 1024 * i, 0, scr, r % IT_B, lane); continue; } r -= 4 * IT_B;
        if (r < 4 * IT_G) { const int i = r / IT_G; xpose_item8(C.in[I_W_GATE] + ((size_t)l * 4 + i) * D * D, D, D, ws + WS_WG, 1, i, 0, scr, r % IT_G, lane); continue; } r -= 4 * IT_G;
        if (r < IT_O) { xpose_item(C.in[I_W_OUT] + (size_t)l * D * D, D, D, (bf16*)(ws + WS_WOUT), 0, 0, 0, scr, r, lane); continue; } r -= IT_O;
        { const int per = 2 * IT_M1, e = r / per; r -= e * per;
          if (r < IT_M1) { xpose_item8(C.in[I_MOE_W1] + ((size_t)l2 * NEXP + e) * D * DFE, D, DFE, ws + WS_W13, 2, e * 2 * DFE, 0, scr, r, lane); continue; } r -= IT_M1;
          xpose_item8(C.in[I_MOE_W3] + ((size_t)l2 * NEXP + e) * D * DFE, D, DFE, ws + WS_W13, 2, e * 2 * DFE, 1, scr, r, lane); }
    }
    bf16* WL = (bf16*)(ws + WS_WLORA);
    const float* w2 = C.in[I_RW_W2] + (size_t)l * 64 * 256; const float* a2 = C.in[I_RW_A2] + (size_t)l * 64 * 256; const float* g2 = C.in[I_RW_G2] + (size_t)l * 128 * 256;
    for (int i = C.bid * NTHR + C.tid; i < 768 * 256; i += C.G * NTHR) {
        const int n = i >> 8, k = i & 255; float v = 0.f;
        if (n < 256) { if (k < 64) v = w2[k * 256 + n]; }
        else if (n < 512) { if (k >= 64 && k < 128) v = a2[(k - 64) * 256 + (n - 256)]; }
        else { if (k >= 128) v = g2[(k - 128) * 256 + (n - 512)]; }
        WL[i] = f2bf(v);
    }
}

__device__ __forceinline__ void ph_norm_(const Ctx& C, const float* gain, bool route, const float* router, int moe_idx, bool combine = false, const float* src = nullptr, bool want_bf16 = true) {
    const int gw = C.bid * NWAVES + C.wave, NGW = C.G * NWAVES, lane = C.lane;
    bf16* H = (bf16*)(C.ws + WS_H);
    f32x4 g[4];
#pragma unroll
    for (int j = 0; j < 4; ++j) g[j] = *((const f32x4*)gain + lane + 64 * j);
    LAS unsigned* lcnt = (LAS unsigned*)(C.lds);
    if (route) { if (C.tid < 8) lcnt[C.tid] = 0u; __syncthreads(); }
    int* eidx = (int*)(C.ws + WS_EIDX); float* gate = (float*)(C.ws + WS_GATE);
    constexpr int NR = 2;
    for (int mb = gw; mb < T; mb += NR * NGW) {
        f32x4 vv[NR][4]; u32x2 ya[NR][4], yb[NR][4]; float g0v[NR], g1v[NR];
#pragma unroll
        for (int r = 0; r < NR; ++r) { const int m = mb + r * NGW; if (m < T) { const f32x4* xr = (const f32x4*)((src ? src : C.out) + (size_t)m * D) + lane;
#pragma unroll
            for (int j = 0; j < 4; ++j) vv[r][j] = xr[64 * j];
            if (src) { f32x4* xo = (f32x4*)(C.out + (size_t)m * D) + lane;
#pragma unroll
                for (int j = 0; j < 4; ++j) xo[64 * j] = vv[r][j]; }
            if (combine) { const int* slotof = (const int*)(C.ws + WS_SLOTOF); const float* gt = (const float*)(C.ws + WS_GATE); const bf16* YS = (const bf16*)(C.ws + WS_YS);
                const int s0 = slotof[2 * m], s1 = slotof[2 * m + 1]; g0v[r] = gt[2 * m]; g1v[r] = gt[2 * m + 1];
                const u32x2* y0 = (const u32x2*)(YS + (size_t)s0 * D) + lane; const u32x2* y1 = (const u32x2*)(YS + (size_t)s1 * D) + lane;
#pragma unroll
                for (int j = 0; j < 4; ++j) { ya[r][j] = y0[64 * j]; yb[r][j] = y1[64 * j]; } } } }
#pragma unroll
        for (int r = 0; r < NR; ++r) { const int m = mb + r * NGW; if (m < T) {
        f32x4* xr = (f32x4*)(C.out + (size_t)m * D) + lane;
        f32x4 v[4]; float s = 0.f;
#pragma unroll
        for (int j = 0; j < 4; ++j) v[j] = vv[r][j];
        if (combine) {
            const float g0 = g0v[r], g1 = g1v[r];
#pragma unroll
            for (int j = 0; j < 4; ++j) { const u32x2 a = ya[r][j], b = yb[r][j];
                v[j].x += g0 * bflo(a.x) + g1 * bflo(b.x); v[j].y += g0 * bfhi(a.x) + g1 * bfhi(b.x); v[j].z += g0 * bflo(a.y) + g1 * bflo(b.y); v[j].w += g0 * bfhi(a.y) + g1 * bfhi(b.y);
                xr[64 * j] = v[j]; }
        }
#pragma unroll
        for (int j = 0; j < 4; ++j) s += (v[j].x * v[j].x + v[j].y * v[j].y) + (v[j].z * v[j].z + v[j].w * v[j].w);
        const float rs = 1.0f / sqrtf(wave_sum(s, C.lane) * (1.f / D) + 1e-6f);
        unsigned long long* o8 = (unsigned long long*)(H + (size_t)m * D) + lane;
#pragma unroll
        for (int j = 0; j < 4; ++j) { v[j] = v[j] * rs * g[j]; if (want_bf16) o8[64 * j] = (unsigned long long)cvt_pk_bf16(v[j].x, v[j].y) | ((unsigned long long)cvt_pk_bf16(v[j].z, v[j].w) << 32);
            ((unsigned*)(C.ws + WS_H8 + (size_t)m * D))[lane + 64 * j] = pk4_fp8(v[j].x * F8_MUL_X, v[j].y * F8_MUL_X, v[j].z * F8_MUL_X, v[j].w * F8_MUL_X); }
        if (route) {
            float lg[8];
#pragma unroll
            for (int e = 0; e < 8; ++e) lg[e] = 0.f;
#pragma unroll
            for (int j = 0; j < 4; ++j)
#pragma unroll
                for (int q = 0; q < 4; ++q) { const int k = 4 * (lane + 64 * j) + q; const f32x4 r0 = *(const f32x4*)(router + (size_t)k * 8), r1 = *(const f32x4*)(router + (size_t)k * 8 + 4); const float hv = v[j][q];
                    lg[0] += hv * r0.x; lg[1] += hv * r0.y; lg[2] += hv * r0.z; lg[3] += hv * r0.w; lg[4] += hv * r1.x; lg[5] += hv * r1.y; lg[6] += hv * r1.z; lg[7] += hv * r1.w; }
#pragma unroll
            for (int e = 0; e < 8; ++e) lg[e] = wave_sum(lg[e], C.lane);
            int e0 = 0; float b0 = lg[0];
#pragma unroll
            for (int e = 1; e < 8; ++e) if (lg[e] > b0) { b0 = lg[e]; e0 = e; }
            int e1 = -1; float b1 = -3.0e38f;
#pragma unroll
            for (int e = 0; e < 8; ++e) if (e != e0 && lg[e] > b1) { b1 = lg[e]; e1 = e; }
            const float p1 = __expf(b1 - b0), inv = 1.f / (1.f + p1);
            if (lane == 0) { eidx[2 * m] = e0; eidx[2 * m + 1] = e1; gate[2 * m] = inv; gate[2 * m + 1] = p1 * inv; atomicAdd((unsigned*)&lcnt[e0], 1u); atomicAdd((unsigned*)&lcnt[e1], 1u); }
        }
        } }
    }
    if (route) { __syncthreads(); if (C.tid < 8) { unsigned* cw = (unsigned*)(C.ws + WS_CTL) + CW_MOE + moe_idx * 64; atomicAdd(&cw[C.tid], lcnt[C.tid]); } }
}

__device__ __forceinline__ void ph_rw_prep_(const Ctx& C, int l) {
    const bf16* RW = (const bf16*)(C.ws + WS_RW); bf16* RKVS = (bf16*)(C.ws + WS_RKVS); bf16* AL = (bf16*)(C.ws + WS_ALORA);
    const float* mu = C.in[I_RW_MU] + (size_t)l * 1024;
    const size_t gid = (size_t)C.bid * NTHR + C.tid, gsz = (size_t)C.G * NTHR;
    constexpr int NI = 4;
    for (size_t it0 = gid; it0 < (size_t)T * 128; it0 += NI * gsz) {
        u32x4 cuv[NI], pvv[NI];
#pragma unroll
        for (int r = 0; r < NI; ++r) { const size_t it = it0 + r * gsz; cuv[r] = (u32x4){0u, 0u, 0u, 0u}; pvv[r] = cuv[r];
            if (it < (size_t)T * 128) { const int m = (int)(it >> 7), c8 = (int)(it & 127) * 8, t = m & (SEQ - 1);
                cuv[r] = *(const u32x4*)(RW + (size_t)m * 1024 + c8); if (t) pvv[r] = *(const u32x4*)(RW + (size_t)(m - 1) * 1024 + c8); } }
#pragma unroll
        for (int r = 0; r < NI; ++r) { const size_t it = it0 + r * gsz; if (it < (size_t)T * 128) {
        const int m = (int)(it >> 7), c8 = (int)(it & 127) * 8;
        float a[8], b[8]; unpack8(cuv[r], a); unpack8(pvv[r], b);
        const f32x4 m0 = *(const f32x4*)(mu + c8), m1 = *(const f32x4*)(mu + c8 + 4);
        const float mm[8] = {m0.x, m0.y, m0.z, m0.w, m1.x, m1.y, m1.z, m1.w};
#pragma unroll
        for (int e = 0; e < 8; ++e) a[e] = a[e] + (b[e] - a[e]) * mm[e];
        if (c8 < 768) { *(u32x4*)(RKVS + (size_t)m * 768 + c8) = pack8(a); }
        else {
            if (c8 < 832) {
#pragma unroll
                for (int e = 0; e < 8; ++e) a[e] = 1.f - 2.f * __builtin_amdgcn_rcpf(1.f + __builtin_amdgcn_exp2f(2.f * LOG2E * a[e]));
            } else if (c8 >= 896) {
#pragma unroll
                for (int e = 0; e < 8; ++e) a[e] = sigm(a[e]);
            }
            *(u32x4*)(AL + (size_t)m * 256 + (c8 - 768)) = pack8(a);
        } } }
    }
}

__device__ __forceinline__ void ph_sb_prep_(const Ctx& C, int l) {
    bf16* SB = (bf16*)(C.ws + WS_SB);
    const int gw = C.bid * NWAVES + C.wave, NGW = C.G * NWAVES, lane = C.lane;
    const bool isk = lane >= 32; const int d0 = (lane & 7) * 8;
    const float* gn = (isk ? C.in[I_SB_KN] : C.in[I_SB_QN]) + (size_t)l * 64 + d0;
    float gg[8];
#pragma unroll
    for (int e = 0; e < 8; ++e) gg[e] = gn[e] * (isk ? 1.f : 0.125f * LOG2E);
    constexpr int NR = 4;
    for (int mb = gw; mb < T; mb += NR * NGW) {
        u32x4 uu[NR];
#pragma unroll
        for (int r = 0; r < NR; ++r) { const int m = mb + r * NGW; uu[r] = (u32x4){0u, 0u, 0u, 0u}; if (m < T) uu[r] = *(const u32x4*)(SB + (size_t)m * 768 + lane * 8); }
#pragma unroll
        for (int r = 0; r < NR; ++r) { const int m = mb + r * NGW; if (m < T) {
            bf16* p = SB + (size_t)m * 768 + lane * 8;
            float a[8]; unpack8(uu[r], a);
            float ss = 0.f;
#pragma unroll
            for (int e = 0; e < 8; ++e) ss += a[e] * a[e];
            ss += shx(ss, 1, lane); ss += shx(ss, 2, lane); ss += shx(ss, 4, lane);
            const float rs = 1.0f / sqrtf(ss * (1.f / 64.f) + 1e-6f);
#pragma unroll
            for (int e = 0; e < 8; ++e) a[e] = a[e] * rs * gg[e];
            *(u32x4*)p = pack8(a); } }
    }
}

__device__ __forceinline__ void ph_conv_(const Ctx& C, int l) {
    const bf16* CV = (const bf16*)(C.ws + WS_CV); bf16* Y = (bf16*)(C.ws + WS_Y);
    LAS float* U = (LAS float*)(C.lds); LAS float* OC = (LAS float*)(C.lds + 65536);
    const int tid = C.tid, c = tid & 255, half = tid >> 8;
    const float* dw = C.in[I_CONV_DW] + (size_t)l * 31 * 256; const float db = C.in[I_CONV_B][l * 256 + c];
    float dwr[31];
#pragma unroll
    for (int j = 0; j < 31; ++j) dwr[j] = dw[j * 256 + c];
    const float* lnw = C.in[I_CONV_LNW] + (size_t)l * 256; const float* lnb = C.in[I_CONV_LNB] + (size_t)l * 256;
    for (int u = C.bid; u < T / 32; u += C.G) {
        const int m0 = u * 32, t0 = m0 & (SEQ - 1);
        for (int it = tid; it < 62 * 32; it += NTHR) {
            const int r = it >> 5, c8 = (it & 31) * 8, tt = t0 - 30 + r; float a[8], b[8];
            if (tt >= 0) { const size_t mm = (size_t)(m0 - 30 + r); unpack8(*(const u32x4*)(CV + mm * 512 + c8), a); unpack8(*(const u32x4*)(CV + mm * 512 + 256 + c8), b);
#pragma unroll
                for (int e = 0; e < 8; ++e) a[e] = a[e] * sigm(b[e]); }
            else {
#pragma unroll
                for (int e = 0; e < 8; ++e) a[e] = 0.f; }
#pragma unroll
            for (int e = 0; e < 8; ++e) U[r * 256 + c8 + e] = a[e];
        }
        __syncthreads();
        { float win[46];
#pragma unroll
          for (int i = 0; i < 46; ++i) win[i] = U[(half * 16 + i) * 256 + c];
#pragma unroll
          for (int tt = 0; tt < 16; ++tt) { float acc = db;
#pragma unroll
              for (int j = 0; j < 31; ++j) acc += dwr[j] * win[tt + j];
              OC[(half * 16 + tt) * 256 + c] = acc; } }
        __syncthreads();
#pragma unroll 1
        for (int q = 0; q < 4; ++q) { const int tl = C.wave * 4 + q; float v[4]; float s = 0.f;
#pragma unroll
            for (int i = 0; i < 4; ++i) { v[i] = OC[tl * 256 + C.lane + 64 * i]; s += v[i]; }
            const float mean = wave_sum(s, C.lane) * (1.f / 256.f); float s2 = 0.f;
#pragma unroll
            for (int i = 0; i < 4; ++i) { v[i] -= mean; s2 += v[i] * v[i]; }
            const float rstd = 1.0f / sqrtf(wave_sum(s2, C.lane) * (1.f / 256.f) + 1e-5f);
#pragma unroll
            for (int i = 0; i < 4; ++i) { const int cc = C.lane + 64 * i; const float y = v[i] * rstd * lnw[cc] + lnb[cc]; Y[(size_t)(m0 + tl) * 1024 + 768 + cc] = f2bf(y * sigm(y)); } }
        __syncthreads();
    }
}

__device__ __forceinline__ float ret_log2gamma(int h) { return log2f(1.0f - exp2f(-5.0f - (float)h)); }
__device__ __forceinline__ void ret_load_rot(const Ctx& C, const bf16* RET, int m0, int coff, float scale, LAS float* dst) {
    const int s = C.tid >> 3, d0 = (C.tid & 7) * 4;
    const float* cs = (const float*)(C.ws + WS_COS); const float* sn = (const float*)(C.ws + WS_SIN);
    const int pos = (m0 + s) & (SEQ - 1);
    const u32x2 a = *(const u32x2*)(RET + (size_t)(m0 + s) * 1024 + coff + d0), b = *(const u32x2*)(RET + (size_t)(m0 + s) * 1024 + coff + 32 + d0);
    const float x1[4] = {bflo(a.x), bfhi(a.x), bflo(a.y), bfhi(a.y)}, x2[4] = {bflo(b.x), bfhi(b.x), bflo(b.y), bfhi(b.y)};
    const f32x4 cv = *(const f32x4*)(cs + (size_t)pos * 32 + d0), sv = *(const f32x4*)(sn + (size_t)pos * 32 + d0);
#pragma unroll
    for (int e = 0; e < 4; ++e) { dst[s * 65 + d0 + e] = (x1[e] * cv[e] - x2[e] * sv[e]) * scale; dst[s * 65 + 32 + d0 + e] = (x1[e] * sv[e] + x2[e] * cv[e]) * scale; }
}
__device__ __forceinline__ void ph_ret_kv_(const Ctx& C) {
    const bf16* RET = (const bf16*)(C.ws + WS_RET); float* KV = (float*)(C.ws + WS_KV);
    LAS float* KD = (LAS float*)(C.lds); LAS float* VV = (LAS float*)(C.lds + 32768);
    const int tid = C.tid;
    for (int u = C.bid; u < 2048; u += C.G) {
        const int bh = u >> 8, ch = u & 255, b = bh >> 2, h = bh & 3, m0 = b * SEQ + ch * 64;
        const float lg = ret_log2gamma(h);
        ret_load_rot(C, RET, m0, 256 + h * 64, 0.125f, KD);
        { const int s = tid >> 3, e0 = (tid & 7) * 8; float a[8]; unpack8(*(const u32x4*)(RET + (size_t)(m0 + s) * 1024 + 512 + h * 64 + e0), a);
          const float dec = exp2f(lg * (float)(63 - s));
#pragma unroll
          for (int e = 0; e < 8; ++e) VV[s * 64 + e0 + e] = a[e] * dec; }
        __syncthreads();
        const int d = tid >> 3, e0 = (tid & 7) * 8; float acc[8];
#pragma unroll
        for (int e = 0; e < 8; ++e) acc[e] = 0.f;
#pragma unroll 4
        for (int s = 0; s < 64; ++s) { const float kd = KD[s * 65 + d]; const f32x4 v0 = *(const LAS f32x4*)(VV + s * 64 + e0), v1 = *(const LAS f32x4*)(VV + s * 64 + e0 + 4);
            acc[0] += kd * v0.x; acc[1] += kd * v0.y; acc[2] += kd * v0.z; acc[3] += kd * v0.w; acc[4] += kd * v1.x; acc[5] += kd * v1.y; acc[6] += kd * v1.z; acc[7] += kd * v1.w; }
        float* o = KV + (size_t)u * 4096 + d * 64 + e0;
        *(f32x4*)o = (f32x4){acc[0], acc[1], acc[2], acc[3]}; *(f32x4*)(o + 4) = (f32x4){acc[4], acc[5], acc[6], acc[7]};
        __syncthreads();
    }
}
__device__ __forceinline__ void ph_ret_scan_(const Ctx& C) {
    float* KV = (float*)(C.ws + WS_KV);
    const int wg0 = (C.G >= 256) ? 128 : 0, nw = C.G - wg0;
    for (int i = (C.bid - wg0) * NTHR + C.tid; i < 8 * 4096 && C.bid >= wg0; i += nw * NTHR) {
        const int bh = i >> 12, el = i & 4095, h = bh & 3;
        const float cd = exp2f(ret_log2gamma(h) * 64.f);
        float* p = KV + (size_t)bh * 256 * 4096 + el; float S = 0.f;
#pragma unroll 1
        for (int c = 0; c < 256; c += 32) { float kv[32];
#pragma unroll
            for (int q = 0; q < 32; ++q) kv[q] = p[(size_t)(c + q) * 4096];
#pragma unroll
            for (int q = 0; q < 32; ++q) { p[(size_t)(c + q) * 4096] = S; S = S * cd + kv[q]; } }
    }
}
__device__ __forceinline__ void ph_ret_out_(const Ctx& C, int l, int first_wg, int nwg) {
    const bf16* RET = (const bf16*)(C.ws + WS_RET); const float* KV = (const float*)(C.ws + WS_KV); bf16* Y = (bf16*)(C.ws + WS_Y);
    LAS float* Q = (LAS float*)(C.lds); LAS float* Kk = (LAS float*)(C.lds + 16640); LAS float* VV = (LAS float*)(C.lds + 33280); LAS float* SS = (LAS float*)(C.lds + 49664); LAS float* SC = (LAS float*)(C.lds + 66048);
    const int tid = C.tid; const float* gn = C.in[I_RET_GN] + (size_t)l * 256;
    for (int u = C.bid - first_wg; u < 2048; u += nwg) {
        const int bh = u >> 8, ch = u & 255, b = bh >> 2, h = bh & 3, m0 = b * SEQ + ch * 64;
        const float lg = ret_log2gamma(h);
        ret_load_rot(C, RET, m0, h * 64, 1.0f, Q);
        ret_load_rot(C, RET, m0, 256 + h * 64, 0.125f, Kk);
        { const int s = tid >> 3, e0 = (tid & 7) * 8; float a[8]; unpack8(*(const u32x4*)(RET + (size_t)(m0 + s) * 1024 + 512 + h * 64 + e0), a);
#pragma unroll
          for (int e = 0; e < 8; ++e) VV[s * 64 + e0 + e] = a[e];
          const float* sp = KV + (size_t)u * 4096 + s * 64 + e0; const f32x4 s0 = *(const f32x4*)sp, s1 = *(const f32x4*)(sp + 4);
          *(LAS f32x4*)(SS + s * 64 + e0) = s0; *(LAS f32x4*)(SS + s * 64 + e0 + 4) = s1; }
        __syncthreads();
        const int t = tid >> 3, g8 = tid & 7;
        { float sc[8];
#pragma unroll
          for (int i = 0; i < 8; ++i) sc[i] = 0.f;
#pragma unroll 4
          for (int d = 0; d < 64; ++d) { const float qv = Q[t * 65 + d];
#pragma unroll
              for (int i = 0; i < 8; ++i) sc[i] += qv * Kk[(g8 * 8 + i) * 65 + d]; }
#pragma unroll
          for (int i = 0; i < 8; ++i) { const int s = g8 * 8 + i; SC[t * 65 + s] = (s <= t) ? sc[i] * exp2f(lg * (float)(t - s)) : 0.f; } }
        __syncthreads();
        { const int e0 = g8 * 8; float o[8], o2[8];
#pragma unroll
          for (int e = 0; e < 8; ++e) { o[e] = 0.f; o2[e] = 0.f; }
#pragma unroll 4
          for (int s = 0; s < 64; ++s) { const float p = SC[t * 65 + s]; const f32x4 v0 = *(const LAS f32x4*)(VV + s * 64 + e0), v1 = *(const LAS f32x4*)(VV + s * 64 + e0 + 4);
              o[0] += p * v0.x; o[1] += p * v0.y; o[2] += p * v0.z; o[3] += p * v0.w; o[4] += p * v1.x; o[5] += p * v1.y; o[6] += p * v1.z; o[7] += p * v1.w; }
#pragma unroll 4
          for (int d = 0; d < 64; ++d) { const float qv = Q[t * 65 + d]; const f32x4 v0 = *(const LAS f32x4*)(SS + d * 64 + e0), v1 = *(const LAS f32x4*)(SS + d * 64 + e0 + 4);
              o2[0] += qv * v0.x; o2[1] += qv * v0.y; o2[2] += qv * v0.z; o2[3] += qv * v0.w; o2[4] += qv * v1.x; o2[5] += qv * v1.y; o2[6] += qv * v1.z; o2[7] += qv * v1.w; }
          const float qd = exp2f(lg * (float)(t + 1)); float s1 = 0.f;
#pragma unroll
          for (int e = 0; e < 8; ++e) { o[e] += qd * o2[e]; s1 += o[e]; }
          s1 += shx(s1, 1, C.lane); s1 += shx(s1, 2, C.lane); s1 += shx(s1, 4, C.lane);
          const float mean = s1 * (1.f / 64.f); float s2 = 0.f;
#pragma unroll
          for (int e = 0; e < 8; ++e) { o[e] -= mean; s2 += o[e] * o[e]; }
          s2 += shx(s2, 1, C.lane); s2 += shx(s2, 2, C.lane); s2 += shx(s2, 4, C.lane);
          const float rstd = 1.0f / sqrtf(s2 * (1.f / 64.f) + 1e-5f);
          float gtv[8]; unpack8(*(const u32x4*)(RET + (size_t)(m0 + t) * 1024 + 768 + h * 64 + e0), gtv);
#pragma unroll
          for (int e = 0; e < 8; ++e) o[e] = o[e] * rstd * gn[h * 64 + e0 + e] * (gtv[e] * sigm(gtv[e]));
          *(u32x4*)(Y + (size_t)(m0 + t) * 1024 + 512 + h * 64 + e0) = pack8(o); }
        __syncthreads();
    }
}

constexpr int RWC = 64, RW_NCH = SEQ / RWC, RW_NU = 8 * RW_NCH;
__device__ __forceinline__ void ph_rw_local_(const Ctx& C, int l) {
    const bf16* RKVS = (const bf16*)(C.ws + WS_RKVS); const float* WDEC = (const float*)(C.ws + WS_WDEC); const bf16* AG = (const bf16*)(C.ws + WS_AG);
    bf16* Y0 = (bf16*)(C.ws + WS_Y0); bf16* RH = (bf16*)(C.ws + WS_RHAT); float* PQ = (float*)(C.ws + WS_PQ); float* BON = (float*)(C.ws + WS_BON);
    const int lane = C.lane;
    LAS float* base = (LAS float*)(C.lds + C.wave * 12288);
    for (int it = C.bid; it < RW_NU / 8; it += C.G) {
        const int u = it * 8 + C.wave, bh = u >> 8, ch = u & 255, b = bh >> 2, h = bh & 3, m0 = b * SEQ + ch * RWC, hc = h * 64 + lane;
        const float kkw = C.in[I_RW_KK][l * 256 + hc], kaw = C.in[I_RW_KA][l * 256 + hc], rkw = C.in[I_RW_RK][l * 256 + hc], w0l = C.in[I_RW_W0][l * 256 + hc], a0l = C.in[I_RW_A0][l * 256 + hc];
        f32x2 sL[32], sI[32];
        { int ln = lane; asm volatile("" : "+v"(ln));
#pragma unroll
          for (int k = 0; k < 32; ++k) { sL[k] = (f32x2){0.f, 0.f}; sI[k].x = (2 * k == ln) ? 1.f : 0.f; sI[k].y = (2 * k + 1 == ln) ? 1.f : 0.f; } }
#pragma unroll 1
        for (int sb = 0; sb < RWC / 8; ++sb) {
            asm volatile("" ::: "memory");
#pragma unroll
            for (int i = 0; i < 8; ++i) { const size_t m = (size_t)(m0 + sb * 8 + i);
                const float r = bf2f(RKVS[m * 768 + hc]), k = bf2f(RKVS[m * 768 + 256 + hc]), v = bf2f(RKVS[m * 768 + 512 + hc]);
                const float w = __builtin_amdgcn_exp2f(-0.606531f * LOG2E * sigm(WDEC[m * 256 + hc] + w0l)), a = sigm(bf2f(AG[m * 512 + hc]) + a0l);
                const float kr = k * kkw; const float nn = sqrtf(wave_sum(kr * kr, C.lane)); const float kk = kr / fmaxf(nn, 1e-12f);
                const float kp = k * (1.f + (a - 1.f) * kaw);
                const float bon = wave_sum(r * kp * rkw, C.lane);
                if (lane == 0) BON[m * 4 + h] = bon;
                base[0 * 512 + i * 64 + lane] = w; base[1 * 512 + i * 64 + lane] = kk; base[2 * 512 + i * 64 + lane] = kk * a; base[3 * 512 + i * 64 + lane] = kp; base[4 * 512 + i * 64 + lane] = r; base[5 * 512 + i * 64 + lane] = v; }
            asm volatile("" ::: "memory");
#pragma unroll 1
            for (int i = 0; i < 8; ++i) {
                const LAS f32x4* wv = (const LAS f32x4*)(base + 0 * 512 + i * 64); const LAS f32x4* kkv = (const LAS f32x4*)(base + 1 * 512 + i * 64); const LAS f32x4* kav = (const LAS f32x4*)(base + 2 * 512 + i * 64);
                const LAS f32x4* kpv = (const LAS f32x4*)(base + 3 * 512 + i * 64); const LAS f32x4* rv = (const LAS f32x4*)(base + 4 * 512 + i * 64);
                const float vv = base[5 * 512 + i * 64 + lane];
                f32x4 kq[2][4];
#pragma unroll
                for (int t = 0; t < 4; ++t) kq[0][t] = kkv[t];
                f32x2 dL0 = (f32x2){0.f, 0.f}, dL1 = dL0, dI0 = dL0, dI1 = dL0;
                f32x4 ga[2][4];
#pragma unroll
                for (int g = 0; g < 4; ++g) {
                    __builtin_amdgcn_sched_barrier(0);
                    if (g + 1 < 4) {
#pragma unroll
                        for (int t = 0; t < 4; ++t) kq[(g + 1) & 1][t] = kkv[4 * (g + 1) + t]; }
                    else { ga[0][0] = wv[0]; ga[0][1] = kav[0]; ga[0][2] = kpv[0]; ga[0][3] = rv[0]; }
                    __builtin_amdgcn_sched_barrier(0);
#pragma unroll
                    for (int t = 0; t < 4; ++t) { const int k4 = 4 * g + t; const f32x4 q4 = kq[g & 1][t];
                        dL0 += sL[2 * k4] * q4.xy; dL1 += sL[2 * k4 + 1] * q4.zw; dI0 += sI[2 * k4] * q4.xy; dI1 += sI[2 * k4 + 1] * q4.zw; }
                }
                const float saL = -((dL0.x + dL0.y) + (dL1.x + dL1.y)), saI = -((dI0.x + dI0.y) + (dI1.x + dI1.y));
                const f32x2 saLv = (f32x2){saL, saL}, saIv = (f32x2){saI, saI}, vvv = (f32x2){vv, vv};
                f32x2 yL0 = (f32x2){0.f, 0.f}, yL1 = yL0, yI0 = yL0, yI1 = yL0;
#pragma unroll
                for (int k4 = 0; k4 < 16; ++k4) {
                    __builtin_amdgcn_sched_barrier(0);
                    if (k4 + 1 < 16) { ga[(k4 + 1) & 1][0] = wv[k4 + 1]; ga[(k4 + 1) & 1][1] = kav[k4 + 1]; ga[(k4 + 1) & 1][2] = kpv[k4 + 1]; ga[(k4 + 1) & 1][3] = rv[k4 + 1]; }
                    __builtin_amdgcn_sched_barrier(0);
                    const f32x4 wq = ga[k4 & 1][0], aq = ga[k4 & 1][1], pq = ga[k4 & 1][2], rq = ga[k4 & 1][3];
                    sL[2 * k4]     = sL[2 * k4]     * wq.xy + saLv * aq.xy + vvv * pq.xy; yL0 += sL[2 * k4]     * rq.xy;
                    sL[2 * k4 + 1] = sL[2 * k4 + 1] * wq.zw + saLv * aq.zw + vvv * pq.zw; yL1 += sL[2 * k4 + 1] * rq.zw;
                    sI[2 * k4]     = sI[2 * k4]     * wq.xy + saIv * aq.xy;                  yI0 += sI[2 * k4]     * rq.xy;
                    sI[2 * k4 + 1] = sI[2 * k4 + 1] * wq.zw + saIv * aq.zw;                  yI1 += sI[2 * k4 + 1] * rq.zw;
                }
                __builtin_amdgcn_sched_barrier(0);
                const size_t m = (size_t)(m0 + sb * 8 + i);
                Y0[m * 256 + hc] = f2bf((yL0.x + yL0.y) + (yL1.x + yL1.y));
                RH[m * 256 + hc] = f2bf((yI0.x + yI0.y) + (yI1.x + yI1.y));
            }
        }
        float* oq = PQ + (size_t)u * 4096 + lane * 64; float* opt = PQ + ((size_t)RW_NU + u) * 4096 + lane;
#pragma unroll
        for (int k4 = 0; k4 < 16; ++k4) { *(f32x4*)(oq + 4 * k4) = (f32x4){sL[2 * k4].x, sL[2 * k4].y, sL[2 * k4 + 1].x, sL[2 * k4 + 1].y};
            opt[(4 * k4) * 64] = sI[2 * k4].x; opt[(4 * k4 + 1) * 64] = sI[2 * k4].y; opt[(4 * k4 + 2) * 64] = sI[2 * k4 + 1].x; opt[(4 * k4 + 3) * 64] = sI[2 * k4 + 1].y; }
    }
}
__device__ __forceinline__ void ph_rw_scan_(const Ctx& C, int wg) {
    const float* Qg = (const float*)(C.ws + WS_PQ); const float* Pg = Qg + (size_t)RW_NU * 4096; float* SST = (float*)(C.ws + WS_SST);
    LAS bf16* PT = (LAS bf16*)(C.lds);
    LAS bf16* SLb = PT + 2 * 64 * MM_LP;
    LAS float* QL = (LAS float*)(C.lds + (2 * 64 * MM_LP + 2 * 16 * MM_LP) * 2);
    LAS float* SO = QL + 2 * 16 * 64;
    const int lane = C.lane, wave = C.wave, bh = wg >> 2, rq = wg & 3, ct = wave & 3, li = lane & 15, lq = lane >> 4;
    const bool mm = wave < 4;
    const size_t ubase = (size_t)bh * RW_NCH;
    const int lt = C.tid & 255;
    const int qrow = lt >> 4, qc4 = (lt & 15) * 4;
    constexpr int PD = 6;
    f32x4 pr[PD][4], qr[PD];
#define SC_P_PIECE(i) (lt + 256 * (i))
#define SC_PUT_P(buf, sx_) do { LAS bf16* d_ = PT + (buf) * (64 * MM_LP); _Pragma("unroll") for (int i_ = 0; i_ < 4; ++i_) { const int idx_ = SC_P_PIECE(i_), r_ = (idx_ * 4) >> 6, k_ = (idx_ * 4) & 63; u32x2 w_; \
        w_.x = cvt_pk_bf16(pr[sx_][i_].x, pr[sx_][i_].y); w_.y = cvt_pk_bf16(pr[sx_][i_].z, pr[sx_][i_].w); *(LAS u32x2*)(d_ + r_ * MM_LP + k_) = w_; } } while (0)
#define SC_LOAD(sx_, cc) do { const f32x4* p4_ = (const f32x4*)(Pg + (ubase + (cc)) * 4096); _Pragma("unroll") for (int i_ = 0; i_ < 4; ++i_) pr[sx_][i_] = p4_[SC_P_PIECE(i_)]; \
        qr[sx_] = *(const f32x4*)(Qg + (ubase + (cc)) * 4096 + (rq * 16 + qrow) * 64 + qc4); } while (0)
    if (mm) {
#pragma unroll
        for (int r = 0; r < 4; ++r) SLb[(4 * lq + r) * MM_LP + ct * 16 + li] = (bf16)0;
    } else {
        { float z0; asm volatile("v_mov_b32 %0, 0" : "=v"(z0));
          *(f32x4*)(SST + ubase * 4096 + (rq * 16 + qrow) * 64 + qc4) = (f32x4){z0, z0, z0, z0}; }
        SC_LOAD(0, 0); SC_PUT_P(0, 0); *(LAS f32x4*)(QL + qrow * 64 + qc4) = qr[0];
#pragma unroll
        for (int x = 0; x < PD; ++x) SC_LOAD(x, 1 + x);
    }
    __syncthreads();
#pragma unroll 1
    for (int c2 = 0; c2 < RW_NCH; c2 += PD) {
#pragma unroll
        for (int x = 0; x < PD; ++x) {
            const int c = c2 + x;
            if (c < RW_NCH) {
            if (mm) {
                const LAS bf16* Pc = PT + (c & 1) * (64 * MM_LP); const LAS bf16* Sc = SLb + (c & 1) * (16 * MM_LP); const LAS float* Qc = QL + (c & 1) * (16 * 64);
                LAS bf16* Sn = SLb + ((c + 1) & 1) * (16 * MM_LP); LAS float* So = SO + ((c + 1) & 1) * (16 * 64);
                bf16x8 af[2], bfr[2];
#pragma unroll
                for (int ks = 0; ks < 2; ++ks) { af[ks] = *(const LAS bf16x8*)(Sc + li * MM_LP + 32 * ks + 8 * lq); bfr[ks] = *(const LAS bf16x8*)(Pc + (16 * ct + li) * MM_LP + 32 * ks + 8 * lq); }
                f32x4 acc;
#pragma unroll
                for (int r = 0; r < 4; ++r) acc[r] = Qc[(4 * lq + r) * 64 + ct * 16 + li];
#pragma unroll
                for (int ks = 0; ks < 2; ++ks) acc = __builtin_amdgcn_mfma_f32_16x16x32_bf16(af[ks], bfr[ks], acc, 0, 0, 0);
                if (c + 1 < RW_NCH) {
#pragma unroll
                    for (int r = 0; r < 4; ++r) { Sn[(4 * lq + r) * MM_LP + ct * 16 + li] = f2bf(acc[r]); So[(4 * lq + r) * 64 + ct * 16 + li] = acc[r]; } }
            } else {
                if (c > 0) *(f32x4*)(SST + (ubase + c) * 4096 + (rq * 16 + qrow) * 64 + qc4) = *(const LAS f32x4*)(SO + (c & 1) * (16 * 64) + qrow * 64 + qc4);
                if (c + 1 < RW_NCH) { SC_PUT_P((c + 1) & 1, x); *(LAS f32x4*)(QL + ((c + 1) & 1) * (16 * 64) + qrow * 64 + qc4) = qr[x]; }
                if (c + 1 + PD < RW_NCH) SC_LOAD(x, c + 1 + PD);
            }
            __syncthreads();
#ifdef SCAN_2BAR
            __syncthreads();
#endif
            }
        }
    }
#undef SC_PUT_P
#undef SC_LOAD
#undef SC_P_PIECE
}
__device__ __forceinline__ void ph_rw_out_(const Ctx& C, int l) {
    const bf16* RKVS = (const bf16*)(C.ws + WS_RKVS); const bf16* AG = (const bf16*)(C.ws + WS_AG); const bf16* Y0 = (const bf16*)(C.ws + WS_Y0); const bf16* RH = (const bf16*)(C.ws + WS_RHAT);
    const float* SST = (const float*)(C.ws + WS_SST); const float* BON = (const float*)(C.ws + WS_BON); bf16* Y = (bf16*)(C.ws + WS_Y);
    LAS float* RL = (LAS float*)(C.lds);
    const int lane = C.lane, wave = C.wave;
    for (int u = C.bid; u < RW_NU; u += C.G) {
        const int bh = u >> 8, ch = u & 255, b = bh >> 2, h = bh & 3, m0 = b * SEQ + ch * RWC, hc = h * 64 + lane;
        { const int t = C.tid >> 3, d0 = (C.tid & 7) * 8; float a[8];
          unpack8(*(const u32x4*)(RH + (size_t)(m0 + t) * 256 + h * 64 + d0), a);
#pragma unroll
          for (int e = 0; e < 8; ++e) RL[t * 64 + d0 + e] = a[e]; }
        float s[64];
        { const f32x4* sp = (const f32x4*)(SST + (size_t)u * 4096 + lane * 64);
#pragma unroll
          for (int k4 = 0; k4 < 16; ++k4) { const f32x4 v = sp[k4]; s[4 * k4] = v.x; s[4 * k4 + 1] = v.y; s[4 * k4 + 2] = v.z; s[4 * k4 + 3] = v.w; } }
        const float lnw = C.in[I_RW_LNW][l * 256 + hc], lnb = C.in[I_RW_LNB][l * 256 + hc];
        __syncthreads();
#pragma unroll 2
        for (int q = 0; q < 8; ++q) { const int t = wave * 8 + q; const size_t m = (size_t)(m0 + t);
            const LAS f32x4* rv = (const LAS f32x4*)(RL + t * 64);
            float y0 = 0.f, y1 = 0.f, y2 = 0.f, y3 = 0.f;
#pragma unroll
            for (int k4 = 0; k4 < 16; ++k4) { const f32x4 rq = rv[k4]; y0 += s[4 * k4] * rq.x; y1 += s[4 * k4 + 1] * rq.y; y2 += s[4 * k4 + 2] * rq.z; y3 += s[4 * k4 + 3] * rq.w; }
#ifndef RWDBG
#define RWDBG 0
#endif
            float y = ((RWDBG & 1) ? 0.f : (y0 + y1) + (y2 + y3)) + ((RWDBG & 2) ? 0.f : bf2f(Y0[m * 256 + hc]));
            const float mean = wave_sum(y, C.lane) * (1.f / 64.f); y -= mean;
            const float rstd = 1.0f / sqrtf(wave_sum(y * y, C.lane) * (1.f / 64.f) + 64e-5f);
            y = y * rstd * lnw + lnb;
            if (!(RWDBG & 4)) y += BON[m * 4 + h] * bf2f(RKVS[m * 768 + 512 + hc]);
            y *= bf2f(AG[m * 512 + 256 + hc]);
            if (RWDBG & 120) { y = 0.f; if (RWDBG & 8) y += ((const float*)(C.ws + WS_WDEC))[m * 256 + hc]; if (RWDBG & 16) y += bf2f(AG[m * 512 + hc]);
                if (RWDBG & 32) y += bf2f(RKVS[m * 768 + hc]) + bf2f(RKVS[m * 768 + 256 + hc]) + bf2f(RKVS[m * 768 + 512 + hc]); if (RWDBG & 64) y += BON[m * 4 + h]; }
            Y[m * 1024 + hc] = f2bf(y); }
        __syncthreads();
    }
}

constexpr int SB_VLD = 40;
__device__ __forceinline__ void ph_sb_attn_(const Ctx& C, int first_wg, int nwg) {
    const bf16* SB = (const bf16*)(C.ws + WS_SB); bf16* Y = (bf16*)(C.ws + WS_Y);
    const int lane = C.lane, j = lane & 31, hi = lane >> 5;
    LAS bf16* VT = (LAS bf16*)(C.lds + C.wave * (64 * SB_VLD * 2));
    for (int it = C.bid - first_wg; it < 512; it += nwg) {
        const int bh = it >> 6, b = bh >> 2, h = bh & 3, t0 = (it & 63) * 256 + C.wave * 32; const size_t mb = (size_t)b * SEQ;
        bf16x8 qf[4];
#pragma unroll
        for (int ks = 0; ks < 4; ++ks) qf[ks] = *(const bf16x8*)(SB + (mb + t0 + j) * 768 + h * 64 + 16 * ks + 8 * hi);
        f32x16 o0, o1;
#pragma unroll
        for (int i = 0; i < 16; ++i) { o0[i] = 0.f; o1[i] = 0.f; }
        float acc = 0.f;
#pragma unroll 1
        for (int kt = t0; kt >= 0; kt -= 32) {
            bf16x8 kf[4];
#pragma unroll
            for (int ks = 0; ks < 4; ++ks) kf[ks] = *(const bf16x8*)(SB + (mb + kt + j) * 768 + 256 + h * 64 + 16 * ks + 8 * hi);
            u32x4 vv[4];
#pragma unroll
            for (int i = 0; i < 4; ++i) { const int c = lane + 64 * i; vv[i] = *(const u32x4*)(SB + (mb + kt + (c >> 3)) * 768 + 512 + h * 64 + (c & 7) * 8); }
            f32x16 sc;
#pragma unroll
            for (int i = 0; i < 16; ++i) sc[i] = 0.f;
#pragma unroll
            for (int ks = 0; ks < 4; ++ks) sc = __builtin_amdgcn_mfma_f32_32x32x16_bf16(kf[ks], qf[ks], sc, 0, 0, 0);
#pragma unroll
            for (int i = 0; i < 4; ++i) { const int c = lane + 64 * i, key = c >> 3, d8 = (c & 7) * 8; const unsigned w[4] = {vv[i].x, vv[i].y, vv[i].z, vv[i].w};
#pragma unroll
                for (int e = 0; e < 4; ++e) { VT[(d8 + 2 * e) * SB_VLD + key] = (bf16)(w[e] & 0xffffu); VT[(d8 + 2 * e + 1) * SB_VLD + key] = (bf16)(w[e] >> 16); } }
            const bool diag = (kt == t0);
            float ls[16], g[4], og[4];
#pragma unroll
            for (int r = 0; r < 4; ++r) { g[r] = 0.f;
#pragma unroll
                for (int e = 0; e < 4; ++e) { const float z = sc[4 * r + e]; const bool valid = !diag || (8 * r + 4 * hi + e) < j;
                    const float l = (z > 40.f) ? -z : -__builtin_amdgcn_logf(1.f + __builtin_amdgcn_exp2f(z));
                    ls[4 * r + e] = valid ? l : 0.f; g[r] += ls[4 * r + e]; } }
#pragma unroll
            for (int r = 0; r < 4; ++r) og[r] = shx(g[r], 32, lane);
            float pw[16]; float run = acc;
#pragma unroll
            for (int r = 3; r >= 0; --r) { float cum = run + (hi == 0 ? og[r] : 0.f);
#pragma unroll
                for (int e = 3; e >= 0; --e) { cum += ls[4 * r + e]; const bool valid = !diag || (8 * r + 4 * hi + e) < j;
                    pw[4 * r + e] = valid ? __builtin_amdgcn_exp2f(sc[4 * r + e] + cum) : 0.f; }
                run += g[r] + og[r]; }
            acc = run;
            asm volatile("" ::: "memory");
#pragma unroll
            for (int ks = 0; ks < 2; ++ks) {
                u32x4 pk; pk.x = cvt_pk_bf16(pw[8 * ks], pw[8 * ks + 1]); pk.y = cvt_pk_bf16(pw[8 * ks + 2], pw[8 * ks + 3]); pk.z = cvt_pk_bf16(pw[8 * ks + 4], pw[8 * ks + 5]); pk.w = cvt_pk_bf16(pw[8 * ks + 6], pw[8 * ks + 7]);
                const bf16x8 pb = __builtin_bit_cast(bf16x8, pk);
                const s16x4 a0l = *(const LAS s16x4*)(VT + j * SB_VLD + 16 * ks + 4 * hi), a0h = *(const LAS s16x4*)(VT + j * SB_VLD + 16 * ks + 8 + 4 * hi);
                const s16x4 a1l = *(const LAS s16x4*)(VT + (32 + j) * SB_VLD + 16 * ks + 4 * hi), a1h = *(const LAS s16x4*)(VT + (32 + j) * SB_VLD + 16 * ks + 8 + 4 * hi);
                const bf16x8 va0 = __builtin_shufflevector(a0l, a0h, 0, 1, 2, 3, 4, 5, 6, 7), va1 = __builtin_shufflevector(a1l, a1h, 0, 1, 2, 3, 4, 5, 6, 7);
                o0 = __builtin_amdgcn_mfma_f32_32x32x16_bf16(va0, pb, o0, 0, 0, 0);
                o1 = __builtin_amdgcn_mfma_f32_32x32x16_bf16(va1, pb, o1, 0, 0, 0);
            }
            asm volatile("" ::: "memory");
            if (__builtin_amdgcn_ballot_w64(acc > -140.f) == 0ull) break;
        }
        bf16* yp = Y + (mb + t0 + j) * 1024 + 256 + h * 64 + 4 * hi;
#pragma unroll
        for (int r = 0; r < 4; ++r) { u32x2 w0, w1; w0.x = cvt_pk_bf16(o0[4 * r], o0[4 * r + 1]); w0.y = cvt_pk_bf16(o0[4 * r + 2], o0[4 * r + 3]); w1.x = cvt_pk_bf16(o1[4 * r], o1[4 * r + 1]); w1.y = cvt_pk_bf16(o1[4 * r + 2], o1[4 * r + 3]);
            *(u32x2*)(yp + 8 * r) = w0; *(u32x2*)(yp + 32 + 8 * r) = w1; }
    }
}


__device__ __forceinline__ f32x16 mm_tile(const LAS bf16* X, const LAS bf16* Y, int ti, int tj, int lane) {
    const int j = lane & 31, hi = lane >> 5; f32x16 acc;
#pragma unroll
    for (int i = 0; i < 16; ++i) acc[i] = 0.f;
#pragma unroll
    for (int ks = 0; ks < 4; ++ks) { const bf16x8 a = *(const LAS bf16x8*)(X + (32 * ti + j) * MM_LP + 16 * ks + 8 * hi), b = *(const LAS bf16x8*)(Y + (32 * tj + j) * MM_LP + 16 * ks + 8 * hi);
        acc = __builtin_amdgcn_mfma_f32_32x32x16_bf16(a, b, acc, 0, 0, 0); }
    return acc;
}
__device__ __forceinline__ void ln_pair_stats(const f32x16& x, LAS float* XCH, int tr, int tt, int lane, float eps, float& mean, float& rstd) {
    const int j = lane & 31, hi = lane >> 5; float s1 = 0.f, s2 = 0.f;
#pragma unroll
    for (int i = 0; i < 16; ++i) { s1 += x[i]; s2 += x[i] * x[i]; }
    s1 += shx(s1, 32, lane); s2 += shx(s2, 32, lane);
    if (hi == 0) { XCH[(tr * 64 + 32 * tt + j) * 2] = s1; XCH[(tr * 64 + 32 * tt + j) * 2 + 1] = s2; }
    __syncthreads();
    const float a1 = XCH[(32 * tt + j) * 2] + XCH[(64 + 32 * tt + j) * 2], a2 = XCH[(32 * tt + j) * 2 + 1] + XCH[(64 + 32 * tt + j) * 2 + 1];
    mean = a1 * (1.f / 64.f); const float var = fmaxf(a2 * (1.f / 64.f) - mean * mean, 0.f); rstd = 1.0f / sqrtf(var + eps);
}
__device__ __forceinline__ void rot_store(const Ctx& C, const bf16* src  , int pos, int d0, float scale, LAS bf16* dstrow) {
    const float* cs = (const float*)(C.ws + WS_COS) + (size_t)pos * 32 + d0; const float* sn = (const float*)(C.ws + WS_SIN) + (size_t)pos * 32 + d0;
    float x1[8], x2[8]; unpack8(*(const u32x4*)(src + d0), x1); unpack8(*(const u32x4*)(src + 32 + d0), x2);
    const f32x4 c0 = *(const f32x4*)cs, c1 = *(const f32x4*)(cs + 4), s0 = *(const f32x4*)sn, s1 = *(const f32x4*)(sn + 4);
    const float cc[8] = {c0.x, c0.y, c0.z, c0.w, c1.x, c1.y, c1.z, c1.w}, ss[8] = {s0.x, s0.y, s0.z, s0.w, s1.x, s1.y, s1.z, s1.w};
    float o1[8], o2[8];
#pragma unroll
    for (int e = 0; e < 8; ++e) { o1[e] = (x1[e] * cc[e] - x2[e] * ss[e]) * scale; o2[e] = (x1[e] * ss[e] + x2[e] * cc[e]) * scale; }
    *(LAS u32x4*)(dstrow + d0) = pack8(o1); *(LAS u32x4*)(dstrow + 32 + d0) = pack8(o2);
}

__device__ __forceinline__ void ph_ret_kv2_(const Ctx& C) {
    const bf16* RET = (const bf16*)(C.ws + WS_RET); float* KV = (float*)(C.ws + WS_KV);
    const int half = C.wave >> 2, w4 = C.wave & 3, th = C.tid & 255, lane = C.lane;
    LAS bf16* KT = (LAS bf16*)(C.lds + half * 36864);
    LAS bf16* VT = KT + 64 * MM_LP;
    LAS bf16* KR = VT + 64 * MM_LP;
    for (int it = C.bid; it < 1024; it += C.G) {
        const int u = it * 2 + half, bh = u >> 8, ch = u & 255, b = bh >> 2, h = bh & 3, m0 = b * SEQ + ch * 64;
        const float lg = ret_log2gamma(h);
        { const int srow = th >> 2, dq = th & 3; const size_t m = (size_t)(m0 + srow);
          rot_store(C, RET + m * 1024 + 256 + h * 64, (int)(m & (SEQ - 1)), dq * 8, 0.125f * exp2f(lg * (float)(63 - srow)), KR + srow * MM_LP);
          float a[8];
#pragma unroll
          for (int q = 0; q < 2; ++q) { const int e0 = dq * 16 + q * 8; unpack8(*(const u32x4*)(RET + m * 1024 + 512 + h * 64 + e0), a);
#pragma unroll
              for (int e = 0; e < 8; ++e) VT[(e0 + e) * MM_LP + srow] = f2bf(a[e]); } }
        __syncthreads();
        { const int d = th >> 2, s0 = (th & 3) * 16;
#pragma unroll
          for (int i = 0; i < 16; ++i) KT[d * MM_LP + s0 + i] = KR[(s0 + i) * MM_LP + d]; }
        __syncthreads();
        { const int ti = w4 >> 1, tj = w4 & 1, j = lane & 31, hi = lane >> 5;
          const f32x16 acc = mm_tile(VT, KT, ti, tj, lane);
          float* o = KV + (size_t)u * 4096 + (size_t)(32 * ti + 4 * hi) * 64 + 32 * tj + j;
#pragma unroll
          for (int r = 0; r < 4; ++r)
#pragma unroll
              for (int e = 0; e < 4; ++e) o[(8 * r + e) * 64] = acc[4 * r + e]; }
        __syncthreads();
    }
}
__device__ __forceinline__ void ph_ret_out2_(const Ctx& C, int l, int first_wg, int nwg) {
    const bf16* RET = (const bf16*)(C.ws + WS_RET); const float* KV = (const float*)(C.ws + WS_KV); bf16* Y = (bf16*)(C.ws + WS_Y);
    const int half = C.wave >> 2, w4 = C.wave & 3, th = C.tid & 255, lane = C.lane, j = lane & 31, hi = lane >> 5, te = w4 >> 1, tt = w4 & 1;
    LAS bf16* QL = (LAS bf16*)(C.lds + half * 40960);
    LAS bf16* KL = QL + 64 * MM_LP;
    LAS bf16* VT = KL + 64 * MM_LP;
    LAS bf16* ST = VT + 64 * MM_LP;
    LAS float* XCH = (LAS float*)(C.lds + half * 40960 + 4 * 64 * MM_LP * 2);
    const float* gn = C.in[I_RET_GN] + (size_t)l * 256;
    for (int it = C.bid - first_wg; it < 1024; it += nwg) {
        const int u = it * 2 + half, bh = u >> 8, ch = u & 255, b = bh >> 2, h = bh & 3, m0 = b * SEQ + ch * 64;
        const float lg = ret_log2gamma(h);
        { const int srow = th >> 2, dq = th & 3; const size_t m = (size_t)(m0 + srow); const int pos = (int)(m & (SEQ - 1));
          rot_store(C, RET + m * 1024 + h * 64, pos, dq * 8, 1.0f, QL + srow * MM_LP);
          rot_store(C, RET + m * 1024 + 256 + h * 64, pos, dq * 8, 0.125f, KL + srow * MM_LP);
          float a[8];
#pragma unroll
          for (int q = 0; q < 2; ++q) { const int e0 = dq * 16 + q * 8; unpack8(*(const u32x4*)(RET + m * 1024 + 512 + h * 64 + e0), a);
#pragma unroll
              for (int e = 0; e < 8; ++e) VT[(e0 + e) * MM_LP + srow] = f2bf(a[e]); }
          const float* sp = KV + (size_t)u * 4096 + srow * 64 + dq * 16;
          float sv[16];
#pragma unroll
          for (int q = 0; q < 4; ++q) { const f32x4 v4 = *(const f32x4*)(sp + 4 * q); sv[4 * q] = v4.x; sv[4 * q + 1] = v4.y; sv[4 * q + 2] = v4.z; sv[4 * q + 3] = v4.w; }
          *(LAS u32x4*)(ST + srow * MM_LP + dq * 16) = pack8(sv); *(LAS u32x4*)(ST + srow * MM_LP + dq * 16 + 8) = pack8(sv + 8); }
        __syncthreads();
        f32x16 acc = mm_tile(ST, QL, te, tt, lane);
        { const float qd = exp2f(lg * (float)(32 * tt + j + 1));
#pragma unroll
          for (int i = 0; i < 16; ++i) acc[i] *= qd; }
#pragma unroll
        for (int st = 0; st < 2; ++st) {
            if (st > tt) continue;
            const f32x16 sc = mm_tile(KL, QL, st, tt, lane);
            float pw[16];
#pragma unroll
            for (int r = 0; r < 4; ++r)
#pragma unroll
                for (int e = 0; e < 4; ++e) { const int sk = 32 * st + 8 * r + 4 * hi + e, tq = 32 * tt + j;
                    pw[4 * r + e] = (sk <= tq) ? sc[4 * r + e] * exp2f(lg * (float)(tq - sk)) : 0.f; }
#pragma unroll
            for (int ks = 0; ks < 2; ++ks) {
                u32x4 pk; pk.x = cvt_pk_bf16(pw[8 * ks], pw[8 * ks + 1]); pk.y = cvt_pk_bf16(pw[8 * ks + 2], pw[8 * ks + 3]); pk.z = cvt_pk_bf16(pw[8 * ks + 4], pw[8 * ks + 5]); pk.w = cvt_pk_bf16(pw[8 * ks + 6], pw[8 * ks + 7]);
                const bf16x8 pb = __builtin_bit_cast(bf16x8, pk);
                const LAS bf16* vr = VT + (32 * te + j) * MM_LP + 32 * st + 16 * ks + 4 * hi;
                const s16x4 al = *(const LAS s16x4*)vr, ah = *(const LAS s16x4*)(vr + 8);
                const bf16x8 va = __builtin_shufflevector(al, ah, 0, 1, 2, 3, 4, 5, 6, 7);
                acc = __builtin_amdgcn_mfma_f32_32x32x16_bf16(va, pb, acc, 0, 0, 0);
            }
        }
        float mean, rstd; ln_pair_stats(acc, XCH, te, tt, lane, 1e-5f, mean, rstd);
        { const size_t m = (size_t)(m0 + 32 * tt + j); const bf16* gp = RET + m * 1024 + 768 + h * 64 + 32 * te + 4 * hi; bf16* yp = Y + m * 1024 + 512 + h * 64 + 32 * te + 4 * hi;
          const float* gw = gn + h * 64 + 32 * te + 4 * hi;
#pragma unroll
          for (int r = 0; r < 4; ++r) { const u32x2 gt2 = *(const u32x2*)(gp + 8 * r); const float gtv[4] = {bflo(gt2.x), bfhi(gt2.x), bflo(gt2.y), bfhi(gt2.y)}; const f32x4 gwv = *(const f32x4*)(gw + 8 * r);
              float o[4];
#pragma unroll
              for (int e = 0; e < 4; ++e) o[e] = (acc[4 * r + e] - mean) * rstd * gwv[e] * (gtv[e] * sigm(gtv[e]));
              u32x2 w; w.x = cvt_pk_bf16(o[0], o[1]); w.y = cvt_pk_bf16(o[2], o[3]); *(u32x2*)(yp + 8 * r) = w; } }
        __syncthreads();
    }
}
__device__ __forceinline__ void ph_rw_out2_(const Ctx& C, int l) {
    const bf16* RKVS = (const bf16*)(C.ws + WS_RKVS); const bf16* AG = (const bf16*)(C.ws + WS_AG); const bf16* Y0 = (const bf16*)(C.ws + WS_Y0); const bf16* RH = (const bf16*)(C.ws + WS_RHAT);
    const float* SST = (const float*)(C.ws + WS_SST); const float* BON = (const float*)(C.ws + WS_BON); bf16* Y = (bf16*)(C.ws + WS_Y);
    const int half = C.wave >> 2, w4 = C.wave & 3, th = C.tid & 255, lane = C.lane, j = lane & 31, hi = lane >> 5, tv = w4 >> 1, tt = w4 & 1;
    LAS bf16* SL = (LAS bf16*)(C.lds + half * 20480);
    LAS bf16* RL = SL + 64 * MM_LP;
    LAS float* XCH = (LAS float*)(C.lds + half * 20480 + 2 * 64 * MM_LP * 2);
    for (int it = C.bid; it < RW_NU / 2; it += C.G) {
        const int u = it * 2 + half, bh = u >> 8, ch = u & 255, b = bh >> 2, h = bh & 3, m0 = b * SEQ + ch * RWC;
        { const int row = th >> 2, q4 = th & 3;
          const float* sp = SST + (size_t)u * 4096 + row * 64 + q4 * 16; float sv[16];
#pragma unroll
          for (int q = 0; q < 4; ++q) { const f32x4 v4 = *(const f32x4*)(sp + 4 * q); sv[4 * q] = v4.x; sv[4 * q + 1] = v4.y; sv[4 * q + 2] = v4.z; sv[4 * q + 3] = v4.w; }
          *(LAS u32x4*)(SL + row * MM_LP + q4 * 16) = pack8(sv); *(LAS u32x4*)(SL + row * MM_LP + q4 * 16 + 8) = pack8(sv + 8);
          const u32x4* rp = (const u32x4*)(RH + (size_t)(m0 + row) * 256 + h * 64 + q4 * 16);
          *(LAS u32x4*)(RL + row * MM_LP + q4 * 16) = rp[0]; *(LAS u32x4*)(RL + row * MM_LP + q4 * 16 + 8) = rp[1]; }
        __syncthreads();
        f32x16 acc = mm_tile(SL, RL, tv, tt, lane);
        const size_t m = (size_t)(m0 + 32 * tt + j); const int vb = h * 64 + 32 * tv + 4 * hi;
#pragma unroll
        for (int r = 0; r < 4; ++r) { const u32x2 y2 = *(const u32x2*)(Y0 + m * 256 + vb + 8 * r); acc[4 * r] += bflo(y2.x); acc[4 * r + 1] += bfhi(y2.x); acc[4 * r + 2] += bflo(y2.y); acc[4 * r + 3] += bfhi(y2.y); }
        float mean, rstd; ln_pair_stats(acc, XCH, tv, tt, lane, 64e-5f, mean, rstd);
        const float bon = BON[m * 4 + h];
#pragma unroll
        for (int r = 0; r < 4; ++r) { const int vc = vb + 8 * r;
            const f32x4 lw = *(const f32x4*)(C.in[I_RW_LNW] + (size_t)l * 256 + vc), lb = *(const f32x4*)(C.in[I_RW_LNB] + (size_t)l * 256 + vc);
            const u32x2 v2 = *(const u32x2*)(RKVS + m * 768 + 512 + vc), g2 = *(const u32x2*)(AG + m * 512 + 256 + vc);
            const float vv[4] = {bflo(v2.x), bfhi(v2.x), bflo(v2.y), bfhi(v2.y)}, gg[4] = {bflo(g2.x), bfhi(g2.x), bflo(g2.y), bfhi(g2.y)};
            float o[4];
#pragma unroll
            for (int e = 0; e < 4; ++e) o[e] = ((acc[4 * r + e] - mean) * rstd * lw[e] + lb[e] + bon * vv[e]) * gg[e];
            u32x2 w; w.x = cvt_pk_bf16(o[0], o[1]); w.y = cvt_pk_bf16(o[2], o[3]); *(u32x2*)(Y + m * 1024 + vc) = w; }
        __syncthreads();
    }
}

__device__ __forceinline__ void ph_moe_scatter_(const Ctx& C, int moe_idx) {
    unsigned* cw = (unsigned*)(C.ws + WS_CTL) + CW_MOE + moe_idx * 64;
    const int* eidx = (const int*)(C.ws + WS_EIDX); const float* gate = (const float*)(C.ws + WS_GATE);
    int* rowtok = (int*)(C.ws + WS_ROWTOK); float* rowgate = (float*)(C.ws + WS_ROWGATE); int* texp = (int*)(C.ws + WS_TEXP); int* segend = (int*)(C.ws + WS_SEGEND); int* ntp = (int*)(C.ws + WS_NT);
    const bf16* H = (const bf16*)(C.ws + WS_H); bf16* XS = (bf16*)(C.ws + WS_XS);
    LAS unsigned* lcnt = (LAS unsigned*)(C.lds); LAS unsigned* lbase = lcnt + 8; LAS int* sl = (LAS int*)(C.lds + 256);
    int cnt[8], segb[8]; int tot = 0;
#pragma unroll
    for (int e = 0; e < 8; ++e) { cnt[e] = (int)__hip_atomic_load(&cw[e], __ATOMIC_RELAXED, __HIP_MEMORY_SCOPE_AGENT); segb[e] = tot; tot += (cnt[e] + 255) & ~255; }
    if (C.bid == 0) {
        if (C.tid < 8) { const int e = C.tid; int sb = 0, ce = 0;
#pragma unroll
            for (int q = 0; q < 8; ++q) if (q == e) { sb = segb[q]; ce = cnt[q]; }
            for (int pm = sb >> 8; pm < ((sb + ((ce + 255) & ~255)) >> 8); ++pm) { texp[pm] = e; segend[pm] = sb + ce; } }
        if (C.tid == 0) *ntp = tot >> 8;
    }
    for (int blk = C.bid; blk < T / 256; blk += C.G) {
        __syncthreads();
        if (C.tid < 8) lcnt[C.tid] = 0u;
        __syncthreads();
        const int a = blk * 512 + C.tid, e = eidx[a];
        const unsigned rank = atomicAdd((unsigned*)&lcnt[e], 1u);
        __syncthreads();
        if (C.tid < 8) lbase[C.tid] = atomicAdd(&cw[16 + C.tid], lcnt[C.tid]);
        __syncthreads();
        int sb = 0;
#pragma unroll
        for (int q = 0; q < 8; ++q) if (q == e) sb = segb[q];
        const int slot = sb + (int)lbase[e] + (int)rank;
        rowtok[slot] = a >> 1; rowgate[slot] = gate[a]; sl[C.tid] = slot; ((int*)(C.ws + WS_SLOTOF))[a] = slot;
        __syncthreads();
        for (int i = C.wave; i < 512; i += NWAVES) { const int s2 = sl[i]; const u32x4* src = (const u32x4*)(C.ws + WS_H8 + (size_t)(blk * 256 + (i >> 1)) * D); u32x4* dst = (u32x4*)(C.ws + WS_XS + (size_t)s2 * D);
            dst[C.lane] = src[C.lane]; }
    }
}

__device__ __forceinline__ void grid_barrier(int wv) {
    const Ctx C = make_ctx(wv);
    XcdBarrier b; b.bar = (unsigned*)(C.ws + WS_CTL) + CW_BAR; b.x = xb_xcc_id(); b.st = (volatile LAS unsigned*)(C.lds + MISC_OFF) + 8;
    xcd_barrier(b, C.tid);
}
__device__ __forceinline__ void P_prologue(int wv) { const Ctx C = make_ctx(wv); ph_prologue_(C); }
__device__ __forceinline__ void P_weights_norm(int wv, int l) { const Ctx C = make_ctx(wv); ph_weights_(C, l, 0, 0, C.G); __syncthreads(); ph_norm_(C, C.in[I_NORM_MIX] + (size_t)l * D, false, nullptr, 0,  (l > 0) && ((l - 1) & 1), l == 0 ? C.in[I_X] : nullptr); }
__device__ __forceinline__ void P_gemm_in(int wv) { const Ctx C = make_ctx(wv); using namespace pg8; unsigned char* ws = C.ws;
    Gemm g{(const bf16*)(ws + WS_H), (const bf16*)(ws + WS_WIN), D, D}; StaticOrder S; S.init(T, NIN, C.G, C.bid);
    EpiRoute E{(bf16*)(ws + WS_RW), (bf16*)(ws + WS_SB), (bf16*)(ws + WS_RET), (bf16*)(ws + WS_CV)};
    gemm_phase<EpiRoute, StaticOrder, true>(C.lds, C.tid, g, S, E); }
#define REP2(bit, stmt) do { stmt; if constexpr ((PROBE2 >> (bit)) & 1) { __syncthreads(); stmt; } } while (0)
__device__ __forceinline__ void P_mix1(int wv, int l) { REP2(2, { const Ctx C = make_ctx(wv); ph_rw_prep_(C, l); }); { const Ctx C = make_ctx(wv); ph_sb_prep_(C, l); } REP2(3, { const Ctx C = make_ctx(wv); ph_conv_(C, l); }); REP2(4, { const Ctx C = make_ctx(wv); ph_ret_kv2_(C); }); }
__device__ __forceinline__ void P_mix2(int wv, int l) { { const Ctx C = make_ctx(wv); using namespace pg8; unsigned char* ws = C.ws;
    Gemm g{(const bf16*)(ws + WS_ALORA), (const bf16*)(ws + WS_WLORA), 256, 256}; StaticOrder S; S.init(T, 768, C.G, C.bid);
    EpiLora E{(float*)(ws + WS_WDEC), (bf16*)(ws + WS_AG), C.in[I_RW_W0] + (size_t)l * 256, C.in[I_RW_A0] + (size_t)l * 256};
    gemm_phase<EpiLora, StaticOrder, true>(C.lds, C.tid, g, S, E); }
    { const Ctx C = make_ctx(wv); ph_ret_scan_(C); } }
#ifndef MIX3_SEL
#define MIX3_SEL 3
#endif
__device__ __forceinline__ void P_mix3(int wv, int l) { REP2(0, { const Ctx C = make_ctx(wv); ph_rw_local_(C, l); }); }
__device__ __forceinline__ void P_mix4(int wv, int l) { const Ctx C = make_ctx(wv);
    if (C.G >= 64) { if (C.bid < 32) { REP2(6, ph_rw_scan_(C, C.bid)); } else { REP2(7, ph_sb_attn_(C, 32, C.G - 32)); __syncthreads(); REP2(1, ph_ret_out2_(C, l, 32, C.G - 32)); __syncthreads(); ph_weights_(C, l, 1, 32, C.G - 32); } }
    else { for (int w = C.bid; w < 32; w += C.G) { ph_rw_scan_(C, w); __syncthreads(); } ph_sb_attn_(C, 0, C.G); __syncthreads(); ph_ret_out2_(C, l, 0, C.G); __syncthreads(); ph_weights_(C, l, 1, 0, C.G); } }
__device__ __forceinline__ void P_mix5(int wv, int l) { REP2(5, { const Ctx C = make_ctx(wv); ph_rw_out2_(C, l); }); }
__device__ __forceinline__ void P_gemm_branch(int wv) { const Ctx C = make_ctx(wv); using namespace pg8; unsigned char* ws = C.ws;
    Gemm g{(const bf16*)(ws + WS_Y), (const bf16*)(ws + WS_WB), D, 256}; StaticOrder S; S.init(T, 4096, C.G, C.bid, 2, 512);
    EpiBf16 E{(bf16*)(ws + WS_BALL), 4096, 0xffff, 1.0f};
    gemm_phase<EpiBf16, StaticOrder, false>(C.lds, C.tid, g, S, E); }
__device__ __forceinline__ void P_gemm_gate(int wv) { const Ctx C = make_ctx(wv); using namespace pg8; unsigned char* ws = C.ws;
    Gemm g{(const bf16*)(ws + WS_H8), (const bf16*)(ws + WS_WG), D, D}; StaticOrder S; S.init(T, 4096, C.G, C.bid);
    EpiGateMerge E{(const bf16*)(ws + WS_BALL), (bf16*)(ws + WS_MERGED)};
    gemm_phase8<EpiGateMerge, StaticOrder, true>(C.lds, C.tid, g, S, E); }
__device__ __forceinline__ void P_gemm_out(int wv) { const Ctx C = make_ctx(wv); using namespace pg8; unsigned char* ws = C.ws;
    Gemm g{(const bf16*)(ws + WS_MERGED), (const bf16*)(ws + WS_WOUT), D, D}; StaticOrder S; S.init(T, D, C.G, C.bid);
    EpiResidual E{C.out, 1.0f};
    gemm_phase<EpiResidual, StaticOrder, false>(C.lds, C.tid, g, S, E); }
__device__ __forceinline__ void P_norm_ffn(int wv, int l) { const Ctx C = make_ctx(wv); ph_norm_(C, C.in[I_NORM_FFN] + (size_t)l * D, (l & 1) != 0, C.in[I_ROUTER] + (size_t)(l >> 1) * D * NEXP, l >> 1, false, nullptr,  false); }
__device__ __forceinline__ void P_ffn_up(int wv) { const Ctx C = make_ctx(wv); using namespace pg8; unsigned char* ws = C.ws;
    Gemm g{(const bf16*)(ws + WS_H8), (const bf16*)(ws + WS_W13), D, D}; StaticOrder S; S.init(T, 2 * DFF, C.G, C.bid);
    EpiSwiglu E{ws + WS_HID, DFF, 1 << 20, false};
    gemm_phase8<EpiSwiglu, StaticOrder, true>(C.lds, C.tid, g, S, E); }
__device__ __forceinline__ void P_ffn_down(int wv) { const Ctx C = make_ctx(wv); using namespace pg8; unsigned char* ws = C.ws;
    Gemm g{(const bf16*)(ws + WS_HID), (const bf16*)(ws + WS_W2D), DFF, DFF}; StaticOrder S; S.init(T, D, C.G, C.bid);
    EpiResidual E{C.out, F8_DESCALE_DOWN};
    gemm_phase8<EpiResidual, StaticOrder, false>(C.lds, C.tid, g, S, E); }
__device__ __forceinline__ void P_moe_scatter(int wv, int l2) { const Ctx C = make_ctx(wv); ph_moe_scatter_(C, l2); }
__device__ __forceinline__ void P_moe_up(int wv) { const Ctx C = make_ctx(wv); using namespace pg8; unsigned char* ws = C.ws;
    Gemm g{(const bf16*)(ws + WS_XS), (const bf16*)(ws + WS_W13), D, D};
    MoeOrder S{(const int*)(ws + WS_TEXP), __builtin_amdgcn_readfirstlane(*(const int*)(ws + WS_NT)), 2 * DFE / 256, C.G, C.bid};
    EpiSwiglu E{ws + WS_HIDM, DFE_PAD, 2 * DFE / 256, true};
    gemm_phase8<EpiSwiglu, MoeOrder, true>(C.lds, C.tid, g, S, E); }
__device__ __forceinline__ void P_moe_down(int wv) { const Ctx C = make_ctx(wv); using namespace pg8; unsigned char* ws = C.ws;
    Gemm g{(const bf16*)(ws + WS_HIDM), (const bf16*)(ws + WS_W2M), DFE_PAD, DFE_PAD};
    MoeOrder S{(const int*)(ws + WS_TEXP), __builtin_amdgcn_readfirstlane(*(const int*)(ws + WS_NT)), D / 256, C.G, C.bid};
    EpiBf16 E{(bf16*)(ws + WS_YS), D, 3, F8_DESCALE_DOWN};
    gemm_phase8<EpiBf16, MoeOrder, true>(C.lds, C.tid, g, S, E); }
__device__ __forceinline__ void P_moe_combine(int wv) { const Ctx C = make_ctx(wv);
    const int gw = C.bid * NWAVES + C.wave, NGW = C.G * NWAVES, lane = C.lane;
    const int* slotof = (const int*)(C.ws + WS_SLOTOF); const float* gate = (const float*)(C.ws + WS_GATE); const bf16* YS = (const bf16*)(C.ws + WS_YS);
    for (int m = gw; m < T; m += NGW) {
        const int s0 = slotof[2 * m], s1 = slotof[2 * m + 1]; const float g0 = gate[2 * m], g1 = gate[2 * m + 1];
        f32x4* xr = (f32x4*)(C.out + (size_t)m * D) + lane;
        const u32x2* y0 = (const u32x2*)(YS + (size_t)s0 * D) + lane; const u32x2* y1 = (const u32x2*)(YS + (size_t)s1 * D) + lane;
#pragma unroll
        for (int j = 0; j < 4; ++j) { f32x4 v = xr[64 * j]; const u32x2 a = y0[64 * j], b = y1[64 * j];
            v.x += g0 * bflo(a.x) + g1 * bflo(b.x); v.y += g0 * bfhi(a.x) + g1 * bfhi(b.x); v.z += g0 * bflo(a.y) + g1 * bflo(b.y); v.w += g0 * bfhi(a.y) + g1 * bfhi(b.y);
            xr[64 * j] = v; }
    }
}

#ifndef PROBE_MASK
#define PROBE_MASK 0u
#endif
#ifndef PH_MASK
#define PH_MASK 0xffffffffu
#endif
__global__ void __launch_bounds__(NTHR, 2) hybrid_fwd(Args args) {
    (void)args;
    const int wv = __builtin_amdgcn_readfirstlane(threadIdx.x >> 6);
    { LAS unsigned char* lds = (LAS unsigned char*)lds_raw;
      for (int u = threadIdx.x; u < (LDS_BYTES - RING_BYTES) / 4; u += NTHR) ((LAS unsigned*)(lds + RING_BYTES))[u] = 0u; }
    __syncthreads();
    { const CAS Args* ka = ka_ptr();
      if (ka->ph_hi - ka->ph_lo > 1) { (void)xcd_barrier_post((unsigned*)(ka->ws + WS_CTL) + CW_BAR, (volatile LAS unsigned*)((LAS unsigned char*)lds_raw + MISC_OFF) + 8); } }
    int gp = 0;
#define PHASE(k, call) { const CAS Args* ka_ = ka_ptr(); const int lo_ = ka_->ph_lo, hi_ = ka_->ph_hi; if (lo_ <= gp && gp < hi_) { if constexpr ((PH_MASK >> (k)) & 1u) { call; if constexpr ((PROBE_MASK >> (k)) & 1u) { __syncthreads(); call; } } if (hi_ - lo_ > 1 && gp + 1 < hi_) grid_barrier(wv); } ++gp; }
    PHASE(0, P_prologue(wv))
#pragma unroll 1
    for (int l = 0; l < NLAYER; ++l) {
        PHASE(1, P_weights_norm(wv, l))
        PHASE(2, P_gemm_in(wv))
        PHASE(3, P_mix1(wv, l))
        PHASE(4, P_mix2(wv, l))
        PHASE(5, P_mix3(wv, l))
        PHASE(6, P_mix4(wv, l))
        PHASE(7, P_mix5(wv, l))
        PHASE(8, P_gemm_branch(wv))
        PHASE(9, P_gemm_gate(wv))
        PHASE(10, P_gemm_out(wv))
        PHASE(11, P_norm_ffn(wv, l))
        if (!(l & 1)) {
            PHASE(12, P_ffn_up(wv))
            PHASE(13, P_ffn_down(wv))
            gp += 2;
        } else {
            PHASE(14, P_moe_scatter(wv, l >> 1))
            PHASE(15, P_moe_up(wv))
            PHASE(16, P_moe_down(wv))
            if (l == NLAYER - 1) { PHASE(17, P_moe_combine(wv)) } else { ++gp; }
        }
    }
#undef PHASE
}
constexpr int N_PHASES = 1 + NLAYER * 15;

#ifndef MK_MULTI
#define MK_MULTI 0
#endif
extern "C" void kernel_launch(void* const* d_in, const int* in_sizes, int n_in, void* d_out, int out_size, void* d_ws, size_t ws_size, hipStream_t stream) {
    static int grid = 0;
    if (grid == 0) {
        if (n_in != 32 || in_sizes[0] != T * D || out_size != T * D || ws_size < WS_END) { fprintf(stderr, "kernel_launch: unexpected problem shape / workspace (%d inputs, ws %zu)\n", n_in, ws_size); grid = -1; return; }
        int dev = 0, cus = 0, per_cu = 0;
        if (hipGetDevice(&dev) != hipSuccess || hipDeviceGetAttribute(&cus, hipDeviceAttributeMultiprocessorCount, dev) != hipSuccess) { grid = -1; return; }
        if (hipFuncSetAttribute((const void*)hybrid_fwd, hipFuncAttributeMaxDynamicSharedMemorySize, LDS_BYTES) != hipSuccess) { fprintf(stderr, "kernel_launch: hipFuncSetAttribute failed\n"); grid = -1; return; }
        if (hipOccupancyMaxActiveBlocksPerMultiprocessor(&per_cu, (const void*)hybrid_fwd, NTHR, LDS_BYTES) != hipSuccess || per_cu < 1) { fprintf(stderr, "kernel_launch: occupancy query says %d\n", per_cu); }
        (void)hipGetLastError();
        grid = cus;
    }
    if (grid < 0) return;
    (void)hipMemsetAsync((char*)d_ws + WS_CTL, 0, CTL_ZERO_BYTES, stream);
#ifdef DBG_ZERO_WS
    (void)hipMemsetAsync((char*)d_ws + CTL_ZERO_BYTES, 0, WS_END - CTL_ZERO_BYTES, stream);
#endif
    Args a{};
    for (int i = 0; i < 32; ++i) a.in[i] = (const float*)d_in[i];
    a.out = (float*)d_out; a.ws = (unsigned char*)d_ws;
#if MK_MULTI
    for (int p = 0; p < N_PHASES; ++p) { a.ph_lo = p; a.ph_hi = p + 1; hipLaunchKernelGGL(hybrid_fwd, dim3(grid), dim3(NTHR), LDS_BYTES, stream, a); }
#else
    a.ph_lo = 0; a.ph_hi = N_PHASES; hipLaunchKernelGGL(hybrid_fwd, dim3(grid), dim3(NTHR), LDS_BYTES, stream, a);
#endif
}
```

```cpp
#include <hip/hip_runtime.h>
#include <cstdio>
#include <cstdint>

#define GAS __attribute__((address_space(1)))
#define LAS __attribute__((address_space(3)))
typedef unsigned short bf16;
typedef unsigned u32x4 __attribute__((ext_vector_type(4)));
typedef unsigned u32x2 __attribute__((ext_vector_type(2)));
typedef float f32x4 __attribute__((ext_vector_type(4)));
typedef float f32x2 __attribute__((ext_vector_type(2)));
typedef short bf16x8 __attribute__((ext_vector_type(8)));
typedef float f32x16 __attribute__((ext_vector_type(16)));
typedef short s16x4 __attribute__((ext_vector_type(4)));

constexpr int SEQ = 16384, NBATCH = 2, T = NBATCH * SEQ, D = 1024, NIN = 3328, DFF = 2816, DFE = 1408, NEXP = 8, NLAYER = 4;
constexpr int MPAD = 2 * T + NEXP * 256;
constexpr int NWAVES = 8, NTHR = 512;
constexpr float LOG2E = 1.4426950408889634f;
constexpr int MM_LP = 72;

typedef __bf16 bf16x2_t __attribute__((ext_vector_type(2)));
__device__ __forceinline__ unsigned cvt_pk_bf16(float lo, float hi) { const f32x2 v = {lo, hi}; const bf16x2_t b = __builtin_convertvector(v, bf16x2_t); return __builtin_bit_cast(unsigned, b); }
__device__ __forceinline__ float bflo(unsigned u) { return __builtin_bit_cast(float, u << 16); }
__device__ __forceinline__ float bfhi(unsigned u) { return __builtin_bit_cast(float, u & 0xffff0000u); }
__device__ __forceinline__ float bf2f(bf16 u) { return __builtin_bit_cast(float, (unsigned)u << 16); }
__device__ __forceinline__ bf16 f2bf(float f) { return (bf16)(cvt_pk_bf16(f, 0.f) & 0xffffu); }
__device__ __forceinline__ float sigm(float x) { return __builtin_amdgcn_rcpf(1.f + __builtin_amdgcn_exp2f(-x * LOG2E)); }
__device__ __forceinline__ float shx(float v, int o, int lane) { return __builtin_bit_cast(float, __builtin_amdgcn_ds_bpermute((lane ^ o) << 2, __builtin_bit_cast(int, v))); }
__device__ __forceinline__ float dpp_add(float v, const int ctrl_id) {
    const int x = __builtin_bit_cast(int, v);
    int y;
    if (ctrl_id == 0) y = __builtin_amdgcn_update_dpp(0, x, 0xB1, 0xF, 0xF, true);
    else if (ctrl_id == 1) y = __builtin_amdgcn_update_dpp(0, x, 0x4E, 0xF, 0xF, true);
    else if (ctrl_id == 2) y = __builtin_amdgcn_update_dpp(0, x, 0x141, 0xF, 0xF, true);
    else y = __builtin_amdgcn_update_dpp(0, x, 0x140, 0xF, 0xF, true);
    return v + __builtin_bit_cast(float, y);
}
__device__ __forceinline__ float wave_sum(float v, int lane) {
    (void)lane;
    v = dpp_add(v, 0); v = dpp_add(v, 1); v = dpp_add(v, 2); v = dpp_add(v, 3);
    const int x = __builtin_bit_cast(int, v);
    const float s0 = __builtin_bit_cast(float, __builtin_amdgcn_readlane(x, 0)), s1 = __builtin_bit_cast(float, __builtin_amdgcn_readlane(x, 16)),
                s2 = __builtin_bit_cast(float, __builtin_amdgcn_readlane(x, 32)), s3 = __builtin_bit_cast(float, __builtin_amdgcn_readlane(x, 48));
    return (s0 + s1) + (s2 + s3);
}
__device__ __forceinline__ void unpack8(const u32x4 v, float* f) {
    f[0] = bflo(v.x); f[1] = bfhi(v.x); f[2] = bflo(v.y); f[3] = bfhi(v.y); f[4] = bflo(v.z); f[5] = bfhi(v.z); f[6] = bflo(v.w); f[7] = bfhi(v.w);
}
__device__ __forceinline__ unsigned pk4_fp8(float a, float b, float c, float d) {
    a = __builtin_amdgcn_fmed3f(a, -440.f, 440.f); b = __builtin_amdgcn_fmed3f(b, -440.f, 440.f); c = __builtin_amdgcn_fmed3f(c, -440.f, 440.f); d = __builtin_amdgcn_fmed3f(d, -440.f, 440.f);
    int w = __builtin_amdgcn_cvt_pk_fp8_f32(a, b, 0, false); w = __builtin_amdgcn_cvt_pk_fp8_f32(c, d, w, true); return (unsigned)w; }
__device__ __forceinline__ u32x4 pack8(const float* f) {
    u32x4 w; w.x = cvt_pk_bf16(f[0], f[1]); w.y = cvt_pk_bf16(f[2], f[3]); w.z = cvt_pk_bf16(f[4], f[5]); w.w = cvt_pk_bf16(f[6], f[7]); return w;
}


#ifndef PROBE2
#define PROBE2 0
#endif
#ifndef GMASK
#define GMASK 15
#endif
#ifndef RWDBG
#define RWDBG 0
#endif
typedef int i32x8 __attribute__((ext_vector_type(8)));
constexpr float F8_MUL_X = 16.f, F8_MUL_W = 256.f, F8_DESCALE = 1.0f / (16.f * 256.f), F8_MUL_H = 4.f, F8_DESCALE_DOWN = 1.0f / (4.f * 256.f);
constexpr int DFE_PAD = 1536;
namespace pg8 {
typedef unsigned short bf16_t;
constexpr int BM = 256, BK = 64, HALF = 128, HTB = HALF * BK * 2, NXCD = 8, WGM = 8;
__host__ __device__ __forceinline__ int lds_byte(int r, int c) { const int st = (r >> 4) * 2 + (c >> 5), rr = r & 15, cc = c & 31, ob = rr * 64 + cc * 2; return st * 1024 + (ob ^ (((ob >> 9) & 1) << 5)); }
__host__ __device__ __forceinline__ void stage_rc(int b, int& R, int& C) { const int st = b / 1024, sb = b % 1024, swz = sb ^ (((sb >> 9) & 1) << 5); R = (st >> 1) * 16 + swz / 64; C = (st & 1) * 32 + (swz % 64) / 2; }
__host__ __device__ __forceinline__ int perm32(int rho) { const int n = rho >> 4, i = rho & 15; return 8 * (i >> 2) + 4 * n + (i & 3); }

struct Unit { int pm, pn, aoff; };
struct Gemm { const bf16_t* A; const bf16_t* Bt; int lda, K; };

struct StaticOrder {
    int nM, nN, nwg, G, c, ashift, amul;
    __device__ void init(int M, int N, int G_, int c_, int ashift_ = 0, int amul_ = 0) { nM = M / BM; nN = N / BM; nwg = nM * nN; G = G_; c = c_; ashift = ashift_; amul = amul_; }
    __device__ bool next(int i, Unit& u) const {
        const long L = (long)i * G + c; if (L >= nwg) return false;
        int wgid = (int)L; { const int q = nwg / NXCD, r = nwg % NXCD, xcd = wgid % NXCD, off = wgid / NXCD; wgid = (xcd < r ? xcd * (q + 1) : r * (q + 1) + (xcd - r) * q) + off; }
        const int nig = WGM * nN, gid = wgid / nig, fm = gid * WGM, gsz = (nM - fm) < WGM ? (nM - fm) : WGM;
        u.pm = fm + ((wgid % nig) % gsz); u.pn = (wgid % nig) / gsz; u.aoff = (u.pn >> ashift) * amul; return true;
    }
};
struct MoeOrder {
    const int* texp; int ntiles, ncol, G, c;
    __device__ bool next(int i, Unit& u) const {
        const int L = i * G + c; if (L >= ntiles * ncol) return false;
        const int pm = L / ncol, pl = L % ncol;
        u.pm = pm; u.pn = texp[pm] * ncol + pl; u.aoff = 0; return true;
    }
};

template <class Epi, class Sched, bool ALIGN_EPI>
__device__ __forceinline__ void gemm_phase(LAS unsigned char* lds, const int tid_in, const Gemm g, const Sched& S, const Epi& E) {
    const int tid = tid_in, wid = __builtin_amdgcn_readfirstlane(tid >> 6), lane = tid & 63, wr = wid >> 2, wc = wid & 3, fr = lane & 15, fq = lane >> 4;
    const int K = g.K, nt = K / BK, lda = g.lda;
    unsigned voffA[2], voffB[2];
#pragma unroll
    for (int i = 0; i < 2; ++i) { int R, C; stage_rc(tid * 16 + i * 8192, R, C); const int Rb = (R & ~31) + perm32(R & 31);
        voffA[i] = (unsigned)(R * lda + C) * 2u; voffB[i] = (unsigned)(Rb * K + C) * 2u; }
    const size_t kstep = (size_t)(BK * 2);
    const size_t hstepA = (size_t)HALF * lda * 2, tstepA = 2 * hstepA, hstepB = (size_t)HALF * K * 2, tstepB = 2 * hstepB;
    const unsigned ldsw = (unsigned)wid * 1024u;
    const int aoff = lds_byte(wr * 64 + fr, fq * 8), boff = lds_byte(wc * 32 + fr, fq * 8);
#define PG8_SA(b, h) (((b) * 2 + (h)) * HTB)
#define PG8_SB(b, h) ((4 + (b) * 2 + (h)) * HTB)
#define PG8_STAGE(bufoff, gbase, voff) do { _Pragma("unroll") for (int _i = 0; _i < 2; ++_i) \
        __builtin_amdgcn_global_load_lds((const unsigned*)((const char*)(gbase) + (voff)[_i]), (LAS unsigned*)(lds + (bufoff) + ldsw + _i * 8192), 16, 0, 0); } while (0)
#define PG8_LDA(dst, b, h) do { _Pragma("unroll") for (int m = 0; m < 4; ++m) _Pragma("unroll") for (int k = 0; k < 2; ++k) dst[m][k] = *(const LAS bf16x8*)(lds + PG8_SA(b, h) + aoff + m * 2048 + k * 1024); } while (0)
#define PG8_LDB(dst, b, h) do { _Pragma("unroll") for (int n = 0; n < 2; ++n) _Pragma("unroll") for (int k = 0; k < 2; ++k) dst[n][k] = *(const LAS bf16x8*)(lds + PG8_SB(b, h) + boff + n * 2048 + k * 1024); } while (0)
#define PG8_MMA(ai, bj, At, Bt) do { __builtin_amdgcn_s_setprio(1); _Pragma("unroll") for (int m = 0; m < 4; ++m) _Pragma("unroll") for (int n = 0; n < 2; ++n) _Pragma("unroll") for (int k = 0; k < 2; ++k) \
        acc[ai][bj][m][n] = __builtin_amdgcn_mfma_f32_16x16x32_bf16(Bt[n][k], At[m][k], acc[ai][bj][m][n], 0, 0, 0); __builtin_amdgcn_s_setprio(0); } while (0)
#define PG8_WAIT_V(n) asm volatile("s_waitcnt vmcnt(" #n ")" ::: "memory")
#define PG8_WAIT_L(n) asm volatile("s_waitcnt lgkmcnt(" #n ")" ::: "memory")
#define PG8_BAR __builtin_amdgcn_s_barrier()
#define PG8_SCHED __builtin_amdgcn_sched_barrier(0)
    Unit cur, nxt; int ui = 0;
    if (!S.next(0, cur)) return;
    f32x4 acc[2][2][4][2];
#pragma unroll
    for (int a = 0; a < 2; ++a)
#pragma unroll
        for (int b = 0; b < 2; ++b)
#pragma unroll
            for (int m = 0; m < 4; ++m)
#pragma unroll
                for (int n = 0; n < 2; ++n) acc[a][b][m][n] = (f32x4){0.f, 0.f, 0.f, 0.f};
    bf16x8 At[4][2], B0[2][2], B1[2][2];
    const char* cA = (const char*)g.A + (size_t)cur.pm * tstepA + cur.aoff; const char* cB = (const char*)g.Bt + (size_t)cur.pn * tstepB;
    PG8_STAGE(PG8_SB(0, 0), cB, voffB); PG8_STAGE(PG8_SB(0, 1), cB + hstepB, voffB); PG8_STAGE(PG8_SA(0, 0), cA, voffA); PG8_STAGE(PG8_SA(0, 1), cA + hstepA, voffA);
    if (wr == 1) PG8_BAR;
    PG8_WAIT_V(2); PG8_BAR;
    PG8_STAGE(PG8_SB(1, 0), cB + kstep, voffB); PG8_STAGE(PG8_SA(1, 0), cA + kstep, voffA); PG8_STAGE(PG8_SB(1, 1), cB + hstepB + kstep, voffB);
    PG8_WAIT_V(6); PG8_BAR;
    for (;;) {
        const bool has_next = S.next(ui + 1, nxt);
        const char* nA = has_next ? (const char*)g.A + (size_t)nxt.pm * tstepA + nxt.aoff : cA; const char* nB = has_next ? (const char*)g.Bt + (size_t)nxt.pn * tstepB : cB;
#pragma unroll 1
        for (int t = 0; t < nt; t += 2) {
            const bool last = (t == nt - 2);
            const char* a1 = cA + (size_t)(t + 1) * kstep;
            const char* a2 = last ? nA : cA + (size_t)(t + 2) * kstep; const char* b2 = last ? nB : cB + (size_t)(t + 2) * kstep;
            const char* a3 = a2 + kstep; const char* b3 = b2 + kstep;
            PG8_LDB(B0, 0, 0); PG8_LDB(B1, 0, 1); PG8_SCHED; PG8_LDA(At, 0, 0); PG8_STAGE(PG8_SA(1, 1), a1 + hstepA, voffA);
            PG8_WAIT_V(8); PG8_WAIT_L(0); PG8_BAR; PG8_MMA(0, 0, At, B0); PG8_MMA(0, 1, At, B1); PG8_BAR; PG8_SCHED;
            PG8_LDA(At, 0, 1); PG8_STAGE(PG8_SB(0, 0), b2, voffB); PG8_STAGE(PG8_SB(0, 1), b2 + hstepB, voffB); PG8_STAGE(PG8_SA(0, 0), a2, voffA);
            PG8_WAIT_V(8); PG8_WAIT_L(0); PG8_BAR; PG8_MMA(1, 0, At, B0); PG8_MMA(1, 1, At, B1); PG8_BAR; PG8_SCHED;
            PG8_LDB(B0, 1, 0); PG8_LDB(B1, 1, 1); PG8_SCHED; PG8_LDA(At, 1, 0); PG8_STAGE(PG8_SA(0, 1), a2 + hstepA, voffA);
            PG8_WAIT_V(8); PG8_WAIT_L(0); PG8_BAR; PG8_MMA(0, 0, At, B0); PG8_MMA(0, 1, At, B1); PG8_BAR; PG8_SCHED;
            PG8_LDA(At, 1, 1); PG8_STAGE(PG8_SB(1, 0), b3, voffB); PG8_STAGE(PG8_SB(1, 1), b3 + hstepB, voffB); PG8_STAGE(PG8_SA(1, 0), a3, voffA);
            PG8_WAIT_V(8); PG8_WAIT_L(0); PG8_BAR; PG8_MMA(1, 0, At, B0); PG8_MMA(1, 1, At, B1); PG8_BAR; PG8_SCHED;
        }
        if constexpr (ALIGN_EPI) { if (wr == 0) PG8_BAR; }
        { int ln_; asm volatile("v_mbcnt_lo_u32_b32 %0, -1, 0\n\tv_mbcnt_hi_u32_b32 %0, -1, %0" : "=v"(ln_)); E(acc, cur, wr, wc, ln_ & 15, ln_ >> 4); }
        if (!has_next) break;
#pragma unroll
        for (int a = 0; a < 2; ++a)
#pragma unroll
            for (int b = 0; b < 2; ++b)
#pragma unroll
                for (int m = 0; m < 4; ++m)
#pragma unroll
                    for (int n = 0; n < 2; ++n) acc[a][b][m][n] = (f32x4){0.f, 0.f, 0.f, 0.f};
        cur = nxt; cA = nA; cB = nB; ++ui;
        if constexpr (ALIGN_EPI) { if (wr == 1) PG8_BAR; }
    }
    PG8_WAIT_V(0);
    if constexpr (!ALIGN_EPI) { if (wr == 0) PG8_BAR; }
    PG8_BAR;
#undef PG8_SA
#undef PG8_SB
#undef PG8_STAGE
#undef PG8_LDA
#undef PG8_LDB
#undef PG8_MMA
#undef PG8_WAIT_V
#undef PG8_WAIT_L
#undef PG8_BAR
#undef PG8_SCHED
}

template <class Epi, class Sched, bool ALIGN_EPI>
__device__ __forceinline__ void gemm_phase8(LAS unsigned char* lds, const int tid_in, const Gemm g, const Sched& S, const Epi& E) {
    const int tid = tid_in, wid = __builtin_amdgcn_readfirstlane(tid >> 6), lane = tid & 63, wr = wid >> 2, wc = wid & 3, fr = lane & 15, fq = lane >> 4;
    const int K = g.K, nt = K / 128, lda = g.lda;
    unsigned voffA, voffB;
    { int R, C; stage_rc(tid * 16, R, C); const int Rb = (R & ~31) + perm32(R & 31); voffA = (unsigned)(R * lda + C * 2); voffB = (unsigned)(Rb * K + C * 2); }
    const unsigned pstepA = 64u * (unsigned)lda, pstepB = 64u * (unsigned)K;
    const unsigned kstep = (unsigned)(BK * 2);
    const unsigned hstepA = (unsigned)HALF * (unsigned)lda, tstepA = 2 * hstepA, hstepB = (unsigned)HALF * (unsigned)K, tstepB = 2 * hstepB;
    const __amdgpu_buffer_rsrc_t rsA = __builtin_amdgcn_make_buffer_rsrc((void*)g.A, 0, 0x7fffffff, 0x00020000), rsB = __builtin_amdgcn_make_buffer_rsrc((void*)g.Bt, 0, 0x7fffffff, 0x00020000);
    const unsigned ldsw = (unsigned)wid * 1024u;
    const int aoff0 = lds_byte(wr * 64 + fr, fq * 16), aoff1 = aoff0 + 16, boff0 = lds_byte(wc * 32 + fr, fq * 16), boff1 = boff0 + 16;
#define PG8_SA(b, h) (((b) * 2 + (h)) * HTB)
#define PG8_SB(b, h) ((4 + (b) * 2 + (h)) * HTB)
#define PG8_STAGE(bufoff, goff, voff, pstep) do { _Pragma("unroll") for (int _i = 0; _i < 2; ++_i) \
        __builtin_amdgcn_raw_ptr_buffer_load_lds(PG8_RS_##voff, (LAS unsigned*)(lds + (bufoff) + ldsw + _i * 8192), 16, (int)(voff), (int)((goff) + _i * (pstep)), 0, 0); } while (0)
#define PG8_RS_voffA rsA
#define PG8_RS_voffB rsB
#define PG8_LDA(dst, b, h) do { _Pragma("unroll") for (int m = 0; m < 4; ++m) { dst[m][0] = *(const LAS u32x4*)(lds + PG8_SA(b, h) + aoff0 + m * 2048); dst[m][1] = *(const LAS u32x4*)(lds + PG8_SA(b, h) + aoff1 + m * 2048); } } while (0)
#define PG8_LDB(dst, b, h) do { _Pragma("unroll") for (int n = 0; n < 2; ++n) { dst[n][0] = *(const LAS u32x4*)(lds + PG8_SB(b, h) + boff0 + n * 2048); dst[n][1] = *(const LAS u32x4*)(lds + PG8_SB(b, h) + boff1 + n * 2048); } } while (0)
#define PG8_J8(x) __builtin_bit_cast(i32x8, __builtin_shufflevector((x)[0], (x)[1], 0, 1, 2, 3, 4, 5, 6, 7))
#define PG8_MMA(ai, bj, At, Bt) do { __builtin_amdgcn_s_setprio(1); _Pragma("unroll") for (int m = 0; m < 4; ++m) _Pragma("unroll") for (int n = 0; n < 2; ++n) \
        acc[ai][bj][m][n] = __builtin_amdgcn_mfma_scale_f32_16x16x128_f8f6f4(PG8_J8(Bt[n]), PG8_J8(At[m]), acc[ai][bj][m][n], 0, 0, 0, 0, 0, 0);        __builtin_amdgcn_s_setprio(0); } while (0)
#define PG8_WAIT_V(n) asm volatile("s_waitcnt vmcnt(" #n ")" ::: "memory")
#define PG8_WAIT_L(n) asm volatile("s_waitcnt lgkmcnt(" #n ")" ::: "memory")
#define PG8_BAR __builtin_amdgcn_s_barrier()
#define PG8_SCHED __builtin_amdgcn_sched_barrier(0)
    Unit cur, nxt; int ui = 0;
    if (!S.next(0, cur)) return;
    f32x4 acc[2][2][4][2];
#pragma unroll
    for (int a = 0; a < 2; ++a)
#pragma unroll
        for (int b = 0; b < 2; ++b)
#pragma unroll
            for (int m = 0; m < 4; ++m)
#pragma unroll
                for (int n = 0; n < 2; ++n) acc[a][b][m][n] = (f32x4){0.f, 0.f, 0.f, 0.f};
    u32x4 At[4][2], B0[2][2], B1[2][2];
    unsigned cA = (unsigned)cur.pm * tstepA + (unsigned)cur.aoff, cB = (unsigned)cur.pn * tstepB;
    PG8_STAGE(PG8_SB(0, 0), cB, voffB, pstepB); PG8_STAGE(PG8_SB(0, 1), cB + hstepB, voffB, pstepB); PG8_STAGE(PG8_SA(0, 0), cA, voffA, pstepA); PG8_STAGE(PG8_SA(0, 1), cA + hstepA, voffA, pstepA);
    if (wr == 1) PG8_BAR;
    PG8_WAIT_V(2); PG8_BAR;
    PG8_STAGE(PG8_SB(1, 0), cB + kstep, voffB, pstepB); PG8_STAGE(PG8_SA(1, 0), cA + kstep, voffA, pstepA); PG8_STAGE(PG8_SB(1, 1), cB + hstepB + kstep, voffB, pstepB);
    PG8_WAIT_V(6); PG8_BAR;
    for (;;) {
        const bool has_next = S.next(ui + 1, nxt);
        const unsigned nA = has_next ? (unsigned)nxt.pm * tstepA + (unsigned)nxt.aoff : cA, nB = has_next ? (unsigned)nxt.pn * tstepB : cB;
#pragma unroll 1
        for (int t = 0; t < nt; t += 2) {
            const bool last = (t == nt - 2);
            const unsigned a1 = cA + (unsigned)(t + 1) * kstep;
            const unsigned a2 = last ? nA : cA + (unsigned)(t + 2) * kstep, b2 = last ? nB : cB + (unsigned)(t + 2) * kstep;
            const unsigned a3 = a2 + kstep, b3 = b2 + kstep;
            PG8_LDB(B0, 0, 0); PG8_LDB(B1, 0, 1); PG8_SCHED; PG8_LDA(At, 0, 0); PG8_STAGE(PG8_SA(1, 1), a1 + hstepA, voffA, pstepA);
            PG8_WAIT_V(8); PG8_WAIT_L(0); PG8_BAR; PG8_MMA(0, 0, At, B0); PG8_MMA(0, 1, At, B1); PG8_BAR; PG8_SCHED;
            PG8_LDA(At, 0, 1); PG8_STAGE(PG8_SB(0, 0), b2, voffB, pstepB); PG8_STAGE(PG8_SB(0, 1), b2 + hstepB, voffB, pstepB); PG8_STAGE(PG8_SA(0, 0), a2, voffA, pstepA);
            PG8_WAIT_V(8); PG8_WAIT_L(0); PG8_BAR; PG8_MMA(1, 0, At, B0); PG8_MMA(1, 1, At, B1); PG8_BAR; PG8_SCHED;
            PG8_LDB(B0, 1, 0); PG8_LDB(B1, 1, 1); PG8_SCHED; PG8_LDA(At, 1, 0); PG8_STAGE(PG8_SA(0, 1), a2 + hstepA, voffA, pstepA);
            PG8_WAIT_V(8); PG8_WAIT_L(0); PG8_BAR; PG8_MMA(0, 0, At, B0); PG8_MMA(0, 1, At, B1); PG8_BAR; PG8_SCHED;
            PG8_LDA(At, 1, 1); PG8_STAGE(PG8_SB(1, 0), b3, voffB, pstepB); PG8_STAGE(PG8_SB(1, 1), b3 + hstepB, voffB, pstepB); PG8_STAGE(PG8_SA(1, 0), a3, voffA, pstepA);
            PG8_WAIT_V(8); PG8_WAIT_L(0); PG8_BAR; PG8_MMA(1, 0, At, B0); PG8_MMA(1, 1, At, B1); PG8_BAR; PG8_SCHED;
        }
        if constexpr (ALIGN_EPI) { if (wr == 0) PG8_BAR; }
        { int ln_; asm volatile("v_mbcnt_lo_u32_b32 %0, -1, 0\n\tv_mbcnt_hi_u32_b32 %0, -1, %0" : "=v"(ln_)); E(acc, cur, wr, wc, ln_ & 15, ln_ >> 4); }
        if (!has_next) break;
#pragma unroll
        for (int a = 0; a < 2; ++a)
#pragma unroll
            for (int b = 0; b < 2; ++b)
#pragma unroll
                for (int m = 0; m < 4; ++m)
#pragma unroll
                    for (int n = 0; n < 2; ++n) acc[a][b][m][n] = (f32x4){0.f, 0.f, 0.f, 0.f};
        cur = nxt; cA = nA; cB = nB; ++ui;
        if constexpr (ALIGN_EPI) { if (wr == 1) PG8_BAR; }
    }
    PG8_WAIT_V(0);
    if constexpr (!ALIGN_EPI) { if (wr == 0) PG8_BAR; }
    PG8_BAR;
#undef PG8_SA
#undef PG8_SB
#undef PG8_STAGE
#undef PG8_RS_voffA
#undef PG8_RS_voffB
#undef PG8_LDA
#undef PG8_LDB
#undef PG8_MMA
#undef PG8_J8
#undef PG8_WAIT_V
#undef PG8_WAIT_L
#undef PG8_BAR
#undef PG8_SCHED
}

typedef f32x4 Acc[2][2][4][2];

struct EpiRoute {
    bf16_t *d0, *d1, *d2, *d3;
    __device__ __forceinline__ void operator()(const Acc& acc, const Unit& u, int wr, int wc, int fr, int fq) const {
        const int pn = u.pn; bf16_t* base; int ld, ct;
        if (pn < 4) { base = d0; ld = 1024; ct = pn; } else if (pn < 7) { base = d1; ld = 768; ct = pn - 4; } else if (pn < 11) { base = d2; ld = 1024; ct = pn - 7; } else { base = d3; ld = 512; ct = pn - 11; }
        const int row0 = u.pm * BM + wr * 64 + fr, col0 = ct * 256 + wc * 32 + 8 * fq;
#pragma unroll
        for (int ai = 0; ai < 2; ++ai)
#pragma unroll
            for (int m = 0; m < 4; ++m) { bf16_t* rowp = base + (size_t)(row0 + ai * HALF + m * 16) * ld + col0;
#pragma unroll
                for (int bj = 0; bj < 2; ++bj) { const f32x4 v0 = acc[ai][bj][m][0], v1 = acc[ai][bj][m][1]; u32x4 w;
                    w.x = cvt_pk_bf16(v0[0], v0[1]); w.y = cvt_pk_bf16(v0[2], v0[3]); w.z = cvt_pk_bf16(v1[0], v1[1]); w.w = cvt_pk_bf16(v1[2], v1[3]);
                    *(u32x4*)(rowp + bj * HALF) = w; } }
    }
};
struct EpiBf16 {
    bf16_t* O; int ld, pnmask; float sc;
    __device__ __forceinline__ void operator()(const Acc& acc, const Unit& u, int wr, int wc, int fr, int fq) const {
        const int row0 = u.pm * BM + wr * 64 + fr, col0 = (u.pn & pnmask) * 256 + wc * 32 + 8 * fq;
#pragma unroll
        for (int ai = 0; ai < 2; ++ai)
#pragma unroll
            for (int m = 0; m < 4; ++m) { bf16_t* rowp = O + (size_t)(row0 + ai * HALF + m * 16) * ld + col0;
#pragma unroll
                for (int bj = 0; bj < 2; ++bj) { const f32x4 v0 = acc[ai][bj][m][0] * sc, v1 = acc[ai][bj][m][1] * sc; u32x4 w;
                    w.x = cvt_pk_bf16(v0[0], v0[1]); w.y = cvt_pk_bf16(v0[2], v0[3]); w.z = cvt_pk_bf16(v1[0], v1[1]); w.w = cvt_pk_bf16(v1[2], v1[3]);
                    *(u32x4*)(rowp + bj * HALF) = w; } }
    }
};
struct EpiLora {
    float* wdec; bf16_t* ag; const float* w0; const float* a0;
    __device__ __forceinline__ void operator()(const Acc& acc, const Unit& u, int wr, int wc, int fr, int fq) const {
        const int row0 = u.pm * BM + wr * 64 + fr, cl0 = wc * 32 + 8 * fq, pn = u.pn;
#pragma unroll
        for (int ai = 0; ai < 2; ++ai)
#pragma unroll
            for (int m = 0; m < 4; ++m) { const size_t row = (size_t)(row0 + ai * HALF + m * 16);
#pragma unroll
                for (int bj = 0; bj < 2; ++bj) { const int col = bj * HALF + cl0; float v[8];
#pragma unroll
                    for (int n = 0; n < 2; ++n)
#pragma unroll
                        for (int e = 0; e < 4; ++e) v[4 * n + e] = acc[ai][bj][m][n][e];
                    if (pn == 0) {
                        *(f32x4*)(wdec + row * 256 + col) = (f32x4){v[0], v[1], v[2], v[3]}; *(f32x4*)(wdec + row * 256 + col + 4) = (f32x4){v[4], v[5], v[6], v[7]};
                    } else if (pn == 1) {
                        *(u32x4*)(ag + row * 512 + col) = pack8(v);
                    } else { *(u32x4*)(ag + row * 512 + 256 + col) = pack8(v); }
                } }
    }
};
struct EpiGateMerge {
    const bf16_t* ball; bf16_t* merged;
    __device__ __forceinline__ void operator()(const Acc& acc, const Unit& u, int wr, int wc, int fr, int fq) const {
        const int row0 = u.pm * BM + wr * 64 + fr, o0 = 64 * u.pn + 16 * wc + 4 * fq;
#pragma unroll
        for (int ai = 0; ai < 2; ++ai)
#pragma unroll
            for (int m = 0; m < 4; ++m) { const size_t row = (size_t)(row0 + ai * HALF + m * 16); float s[4] = {0.f, 0.f, 0.f, 0.f};
#pragma unroll
                for (int bj = 0; bj < 2; ++bj)
#pragma unroll
                    for (int n = 0; n < 2; ++n) { const int gi = 2 * bj + n; if (!((GMASK >> gi) & 1)) continue; const u32x2 b = *(const u32x2*)(ball + row * 4096 + 1024 * gi + o0);
                        const f32x4 a = acc[ai][bj][m][n] * F8_DESCALE;
                        s[0] += sigm(a[0]) * bflo(b.x); s[1] += sigm(a[1]) * bfhi(b.x); s[2] += sigm(a[2]) * bflo(b.y); s[3] += sigm(a[3]) * bfhi(b.y); }
                u32x2 w; w.x = cvt_pk_bf16(s[0], s[1]); w.y = cvt_pk_bf16(s[2], s[3]);
                *(u32x2*)(merged + row * 1024 + o0) = w; }
    }
};
struct EpiResidual {
    float* out; float sc;
    __device__ __forceinline__ void operator()(const Acc& acc, const Unit& u, int wr, int wc, int fr, int fq) const {
        const int row0 = u.pm * BM + wr * 64 + fr, col0 = u.pn * 256 + wc * 32 + 8 * fq;
#pragma unroll
        for (int ai = 0; ai < 2; ++ai)
#pragma unroll
            for (int m = 0; m < 4; ++m) { float* rowp = out + (size_t)(row0 + ai * HALF + m * 16) * 1024 + col0;
#pragma unroll
                for (int bj = 0; bj < 2; ++bj)
#pragma unroll
                    for (int n = 0; n < 2; ++n) { f32x4* p = (f32x4*)(rowp + bj * HALF + 4 * n); f32x4 v = *p; v = v + acc[ai][bj][m][n] * sc; *p = v; } }
    }
};
struct EpiSwiglu {
    unsigned char* hid; int ldh, ncol; bool pad;
    __device__ __forceinline__ void operator()(const Acc& acc, const Unit& u, int wr, int wc, int fr, int fq) const {
        const int pl = u.pn % ncol; const int row0 = u.pm * BM + wr * 64 + fr, col0 = pl * 128 + wc * 32 + 8 * fq;
        const bool dopad = pad && (pl == ncol - 1);
#pragma unroll
        for (int ai = 0; ai < 2; ++ai)
#pragma unroll
            for (int m = 0; m < 4; ++m) { float v[8];
#pragma unroll
                for (int n = 0; n < 2; ++n)
#pragma unroll
                    for (int e = 0; e < 4; ++e) { const float a = acc[ai][0][m][n][e] * F8_DESCALE, b = acc[ai][1][m][n][e] * F8_DESCALE; v[4 * n + e] = a * sigm(a) * b * F8_MUL_H; }
                unsigned char* rp = hid + (size_t)(row0 + ai * HALF + m * 16) * ldh + col0;
                u32x2 w; w.x = pk4_fp8(v[0], v[1], v[2], v[3]); w.y = pk4_fp8(v[4], v[5], v[6], v[7]); *(u32x2*)rp = w;
                if (dopad) { unsigned z0; asm volatile("v_mov_b32 %0, 0" : "=v"(z0)); *(u32x2*)(rp + 128) = (u32x2){z0, z0}; } }
    }
};
struct EpiMoeOut {
    float* out; const int* rowtok; const float* rowgate; const int* segend;
    __device__ __forceinline__ void operator()(const Acc& acc, const Unit& u, int wr, int wc, int fr, int fq) const {
        const int row0 = u.pm * BM + wr * 64 + fr, col0 = (u.pn & 3) * 256 + wc * 32 + 8 * fq, lim = segend[u.pm];
#pragma unroll
        for (int ai = 0; ai < 2; ++ai)
#pragma unroll
            for (int m = 0; m < 4; ++m) { const int row = row0 + ai * HALF + m * 16;
                if (row < lim) { const int tok = rowtok[row]; const float gt = rowgate[row]; float* rowp = out + (size_t)tok * 1024 + col0;
#pragma unroll
                    for (int bj = 0; bj < 2; ++bj)
#pragma unroll
                        for (int n = 0; n < 2; ++n)
#pragma unroll
                            for (int e = 0; e < 4; ++e) __hip_atomic_fetch_add(rowp + bj * HALF + 4 * n + e, gt * acc[ai][bj][m][n][e], __ATOMIC_RELAXED, __HIP_MEMORY_SCOPE_AGENT);
                } }
    }
};
}

#define XB_TMO      128
#define XB_XCNT(j)  (256  + 64 * (j))
#define XB_XSUB(j)  (1280 + 64 * (j))
#define XB_XGEN(j)  (2304 + 64 * (j))
#define XB_TOP      3328
#define XB_TOPGEN   3392
#define XCD_BAR_WORDS 3456
#define XB_SPIN_CAP (1u << 18)
__device__ __forceinline__ unsigned xb_ld(unsigned* p)              { return __hip_atomic_load(p, __ATOMIC_RELAXED, __HIP_MEMORY_SCOPE_AGENT); }
__device__ __forceinline__ unsigned xb_add(unsigned* p, unsigned v) { return __hip_atomic_fetch_add(p, v, __ATOMIC_RELAXED, __HIP_MEMORY_SCOPE_AGENT); }
__device__ __forceinline__ unsigned xb_xcc_id() { return (unsigned)__builtin_amdgcn_s_getreg((3 << 11) | 20) & 0xFu; }
#define XB_SPIN(cond, bar) do { unsigned _sp = 0; while (cond) { __builtin_amdgcn_s_sleep(1); \
    if ((++_sp & 255u) == 0u) { if (xb_ld(&(bar)[XB_TMO])) break; if (_sp > XB_SPIN_CAP) { atomicAdd(&(bar)[XB_TMO], 1u); break; } } } } while (0)
struct XcdBarrier { unsigned* bar; unsigned x; volatile LAS unsigned* st; };
__device__ __forceinline__ XcdBarrier xcd_barrier_post(unsigned* bar, volatile LAS unsigned* st) {
    XcdBarrier b; b.bar = bar; b.x = xb_xcc_id(); b.st = st;
    if (threadIdx.x == 0) (void)xb_add(&bar[XB_XCNT(b.x)], 1u);
    return b;
}
__device__ __forceinline__ void xcd_barrier_complete(unsigned* bar, unsigned x, unsigned& nloc, unsigned& nx) {
    const unsigned G = gridDim.x * gridDim.y * gridDim.z;
    unsigned sum, cnt, mine, sp = 0u;
    for (;;) {
        sum = 0u; cnt = 0u; mine = 0u;
#pragma unroll
        for (unsigned j = 0; j < 16; ++j) { const unsigned c = xb_ld(&bar[XB_XCNT(j)]); sum += c; cnt += (c > 0u) ? 1u : 0u; mine = (j == x) ? c : mine; }
        if (sum == G) break;
        __builtin_amdgcn_s_sleep(1);
        if ((++sp & 255u) == 0u) { if (xb_ld(&bar[XB_TMO])) break; if (sp > XB_SPIN_CAP) { atomicAdd(&bar[XB_TMO], 1u); break; } }
    }
    nloc = mine > 0u ? mine : 1u; nx = cnt > 0u ? cnt : 1u;
}
__device__ __forceinline__ void xcd_barrier(const XcdBarrier& b, const int tid) {
    asm volatile("s_waitcnt vmcnt(0)" ::: "memory");
    __syncthreads();
    if (tid == 0) {
        unsigned* bar = b.bar;
        __builtin_amdgcn_s_waitcnt(0);
        unsigned nloc = b.st[0], nx = b.st[1];
        if (nloc == 0u) { xcd_barrier_complete(bar, b.x, nloc, nx); b.st[0] = nloc; b.st[1] = nx; }
        const unsigned old = xb_add(&bar[XB_XSUB(b.x)], 1u);
        const unsigned gen = old / nloc;
        if (old + 1u == (gen + 1u) * nloc) {
            __builtin_amdgcn_fence(__ATOMIC_RELEASE, "agent");
            asm volatile("s_waitcnt vmcnt(0)" ::: "memory");
            const unsigned og = xb_add(&bar[XB_TOP], 1u);
            const unsigned tg = og / nx;
            if (og + 1u == (tg + 1u) * nx) xb_add(&bar[XB_TOPGEN], 1u);
            else XB_SPIN(xb_ld(&bar[XB_TOPGEN]) == tg, bar);
            __builtin_amdgcn_fence(__ATOMIC_ACQUIRE, "agent");
            xb_add(&bar[XB_XGEN(b.x)], 1u);
            asm volatile("s_waitcnt vmcnt(0)" ::: "memory");
        } else {
            XB_SPIN(xb_ld(&bar[XB_XGEN(b.x)]) == gen, bar);
            __builtin_amdgcn_fence(__ATOMIC_ACQUIRE, "agent");
            asm volatile("s_waitcnt vmcnt(0)" ::: "memory");
        }
    }
    __syncthreads();
}

constexpr size_t MiB = 1u << 20;
constexpr size_t WS_CTL = 0, CTL_ZERO_BYTES = 1 * MiB;
constexpr int CW_BAR = 4096;
constexpr int CW_MOE = 16384;
constexpr size_t WS_EIDX = 1 * MiB, WS_GATE = WS_EIDX + 256 * 1024, WS_ROWTOK = WS_EIDX + 512 * 1024, WS_ROWGATE = 2 * MiB, WS_TEXP = 2 * MiB + 512 * 1024, WS_SEGEND = WS_TEXP + 4096, WS_NT = WS_TEXP + 8192;
constexpr size_t WS_SLOTOF = 2 * MiB + 768 * 1024;
constexpr size_t WS_BON = 3 * MiB, WS_COS = 4 * MiB, WS_SIN = 6 * MiB;
constexpr size_t WS_WIN = 8 * MiB, WS_WLORA = 15 * MiB, WS_WB = 16 * MiB, WS_WG = 18 * MiB, WS_WOUT = 26 * MiB, WS_W13 = 28 * MiB  , WS_W2D = 50 * MiB, WS_W2M = 50 * MiB, WS_H8 = 72 * MiB  ;
constexpr size_t WS_H = 104 * MiB, WS_Y = 168 * MiB, WS_BIG = 232 * MiB;
constexpr size_t WS_RW = WS_BIG, WS_WDEC = WS_BIG, WS_AG = WS_BIG + 32 * MiB, WS_SB = WS_BIG + 64 * MiB, WS_RET = WS_BIG + 112 * MiB, WS_CV = WS_BIG + 176 * MiB, WS_Y0 = WS_CV;
constexpr size_t WS_RKVS = WS_BIG + 208 * MiB, WS_ALORA = WS_BIG + 256 * MiB, WS_RHAT = WS_ALORA, WS_KV = WS_BIG + 272 * MiB, WS_SST = WS_WDEC  , WS_PQ = WS_BIG + 304 * MiB  , WS_END = WS_BIG + 368 * MiB;
constexpr size_t WS_BALL = WS_BIG, WS_MERGED = WS_BIG + 256 * MiB, WS_HID = WS_BIG, WS_XS = WS_BIG, WS_YS = WS_XS, WS_HIDM = WS_BIG + 132 * MiB;
static_assert(WS_HIDM + (size_t)MPAD * DFE * 2 <= WS_END && WS_MERGED + (size_t)T * D * 2 <= WS_END && WS_W2M + (size_t)NEXP * D * DFE * 2 <= WS_H8, "ws map");
static_assert(WS_W13 + (size_t)NEXP * 2 * DFE * D <= WS_W2M && WS_W13 + (size_t)2 * DFF * D <= WS_W2D && WS_W2M + (size_t)NEXP * D * DFE * 2 <= WS_H8 && WS_H8 + (size_t)T * D <= WS_H, "ws map weights");

constexpr int LDS_BYTES = 147456, RING_BYTES = 131072, MISC_OFF = RING_BYTES + 320;

struct Args { const float* in[32]; float* out; unsigned char* ws; int ph_lo, ph_hi; };
#define CAS __attribute__((address_space(4)))
struct Ctx {
    LAS unsigned char* lds; unsigned char* ws; float* out; const float* const CAS* in;
    int tid, lane, wave, G, bid;
};
__device__ __forceinline__ const CAS Args* ka_ptr() { const CAS Args* p = (const CAS Args*)__builtin_amdgcn_kernarg_segment_ptr(); asm volatile("" : "+s"(p)); return p; }
extern __shared__ __attribute__((aligned(16))) unsigned char lds_raw[];
__device__ __forceinline__ Ctx make_ctx(int wv) {
    const CAS Args* ka = ka_ptr();
    Ctx C; C.lds = (LAS unsigned char*)lds_raw; C.ws = ka->ws; C.out = ka->out; C.in = ka->in;
    int g_ = gridDim.x, b_ = blockIdx.x, w_ = wv; asm volatile("" : "+s"(g_), "+s"(b_), "+s"(w_));
    int ln_; asm volatile("v_mbcnt_lo_u32_b32 %0, -1, 0\n\tv_mbcnt_hi_u32_b32 %0, -1, %0" : "=v"(ln_));
    C.lane = ln_; C.wave = w_; C.tid = w_ * 64 + ln_; C.G = g_; C.bid = b_;
    return C;
}
enum { I_X = 0, I_NORM_MIX, I_W_IN, I_RW_MU, I_RW_W0, I_RW_W2, I_RW_A0, I_RW_A2, I_RW_G2, I_RW_KK, I_RW_KA, I_RW_RK, I_RW_LNW, I_RW_LNB, I_SB_QN, I_SB_KN, I_RET_GN,
       I_CONV_DW, I_CONV_B, I_CONV_LNW, I_CONV_LNB, I_W_GATE, I_W_BRANCH, I_W_OUT, I_NORM_FFN, I_FFN_W1, I_FFN_W3, I_FFN_W2, I_ROUTER, I_MOE_W1, I_MOE_W3, I_MOE_W2 };

__device__ __forceinline__ void ph_prologue_(const Ctx& C) {
    const size_t gid = (size_t)C.bid * NTHR + C.tid, gsz = (size_t)C.G * NTHR;
    float* cs = (float*)(C.ws + WS_COS); float* sn = (float*)(C.ws + WS_SIN);
    for (size_t i = gid; i < (size_t)SEQ * 32; i += gsz) {
        const int pos = (int)(i >> 5), j = (int)(i & 31);
        const float inv = (float)pow(10000.0, -(double)(2 * j) / 64.0);
        const float ang = (float)pos * inv;
        cs[i] = (float)cos((double)ang); sn[i] = (float)sin((double)ang);
    }
}

__device__ __forceinline__ int dest_row(int mode, int roff, int which, int n) {
    if (mode == 0) return roff + n;
    if (mode == 1) { const int pn = n >> 6, oc = n & 63; return 256 * pn + 128 * (roff >> 1) + 32 * (oc >> 4) + 8 * ((oc >> 2) & 3) + 4 * (roff & 1) + (oc & 3); }
    return roff + 256 * (n >> 7) + 128 * which + (n & 127);
}
__device__ __forceinline__ void xpose_item(const float* W, int K, int N, bf16* WT, int mode, int roff, int which, LAS float* scr, int item, int lane) {
    const int nblk = N / 32, kb = item / nblk, nb = item % nblk, k0 = 64 * kb, n0 = 32 * nb;
#pragma unroll
    for (int i = 0; i < 8; ++i) { const int kk = (lane >> 3) + 8 * i, c4 = (lane & 7) * 4; const f32x4 v = *(const f32x4*)(W + (size_t)(k0 + kk) * N + n0 + c4);
        scr[kk * 33 + c4] = v.x; scr[kk * 33 + c4 + 1] = v.y; scr[kk * 33 + c4 + 2] = v.z; scr[kk * 33 + c4 + 3] = v.w; }
    asm volatile("s_waitcnt lgkmcnt(0)" ::: "memory");
    const int c = lane & 7;
#pragma unroll
    for (int j = 0; j < 4; ++j) { const int n = (lane >> 3) + 8 * j; const LAS float* s = scr + (8 * c) * 33 + n;
        u32x4 o; o.x = cvt_pk_bf16(s[0 * 33], s[1 * 33]); o.y = cvt_pk_bf16(s[2 * 33], s[3 * 33]); o.z = cvt_pk_bf16(s[4 * 33], s[5 * 33]); o.w = cvt_pk_bf16(s[6 * 33], s[7 * 33]);
        *(u32x4*)(WT + (size_t)dest_row(mode, roff, which, n0 + n) * K + k0 + 8 * c) = o; }
    asm volatile("s_waitcnt lgkmcnt(0)" ::: "memory");
}
__device__ __forceinline__ void xpose_item8(const float* W, int K, int N, unsigned char* WT, int mode, int roff, int which, LAS float* scr, int item, int lane, int ldk = 0) {
    if (ldk == 0) ldk = K;
    const int nblk = N / 32, kb = item / nblk, nb = item % nblk, k0 = 64 * kb, n0 = 32 * nb;
#pragma unroll
    for (int i = 0; i < 8; ++i) { const int kk = (lane >> 3) + 8 * i, c4 = (lane & 7) * 4; const f32x4 v = *(const f32x4*)(W + (size_t)(k0 + kk) * N + n0 + c4);
        scr[kk * 33 + c4] = v.x; scr[kk * 33 + c4 + 1] = v.y; scr[kk * 33 + c4 + 2] = v.z; scr[kk * 33 + c4 + 3] = v.w; }
    asm volatile("s_waitcnt lgkmcnt(0)" ::: "memory");
    const int c = lane & 3;
#pragma unroll
    for (int j = 0; j < 2; ++j) { const int n = (lane >> 2) + 16 * j; const LAS float* sp = scr + (16 * c) * 33 + n;
        u32x4 o;
        o.x = pk4_fp8(sp[0 * 33] * F8_MUL_W, sp[1 * 33] * F8_MUL_W, sp[2 * 33] * F8_MUL_W, sp[3 * 33] * F8_MUL_W);
        o.y = pk4_fp8(sp[4 * 33] * F8_MUL_W, sp[5 * 33] * F8_MUL_W, sp[6 * 33] * F8_MUL_W, sp[7 * 33] * F8_MUL_W);
        o.z = pk4_fp8(sp[8 * 33] * F8_MUL_W, sp[9 * 33] * F8_MUL_W, sp[10 * 33] * F8_MUL_W, sp[11 * 33] * F8_MUL_W);
        o.w = pk4_fp8(sp[12 * 33] * F8_MUL_W, sp[13 * 33] * F8_MUL_W, sp[14 * 33] * F8_MUL_W, sp[15 * 33] * F8_MUL_W);
        *(u32x4*)(WT + (size_t)dest_row(mode, roff, which, n0 + n) * ldk + k0 + 16 * c) = o; }
    asm volatile("s_waitcnt lgkmcnt(0)" ::: "memory");
}
__device__ __forceinline__ void ph_weights_(const Ctx& C, int l, int part, int first_wg, int nwg) {
    LAS float* scr = (LAS float*)(C.lds + C.wave * 16384);
    const int gw = (C.bid - first_wg) * NWAVES + C.wave, NGW = nwg * NWAVES, lane = C.lane;
    unsigned char* ws = C.ws;
    const bool moe = (l & 1);
    const int l2 = l >> 1;
    constexpr int IT_IN = (D / 64) * (NIN / 32), IT_B = (256 / 64) * (D / 32), IT_G = (D / 64) * (D / 32), IT_O = IT_G;
    constexpr int IT_F1 = (D / 64) * (DFF / 32), IT_F2 = (DFF / 64) * (D / 32), IT_M1 = (D / 64) * (DFE / 32), IT_M2 = (DFE / 64) * (D / 32);
    const int n_fixed = IT_IN + 4 * IT_B + 4 * IT_G + IT_O;
    if (part == 1) {
        if (C.bid < first_wg) return;
        const int n1 = moe ? NEXP * IT_M2 : (2 * IT_F1 + IT_F2);
        for (int it = gw; it < n1; it += NGW) {
            int r = it;
            if (!moe) {
                if (r < IT_F1) { xpose_item8(C.in[I_FFN_W1] + (size_t)l2 * D * DFF, D, DFF, ws + WS_W13, 2, 0, 0, scr, r, lane); continue; } r -= IT_F1;
                if (r < IT_F1) { xpose_item8(C.in[I_FFN_W3] + (size_t)l2 * D * DFF, D, DFF, ws + WS_W13, 2, 0, 1, scr, r, lane); continue; } r -= IT_F1;
                xpose_item8(C.in[I_FFN_W2] + (size_t)l2 * DFF * D, DFF, D, ws + WS_W2D, 0, 0, 0, scr, r, lane);
            } else { const int e = r / IT_M2; r -= e * IT_M2;
                xpose_item8(C.in[I_MOE_W2] + ((size_t)l2 * NEXP + e) * DFE * D, DFE, D, ws + WS_W2M, 0, e * D, 0, scr, r, lane, DFE_PAD); }
        }
        if (moe) {
            for (int i = (C.bid - first_wg) * NTHR + C.tid; i < NEXP * D * ((DFE_PAD - DFE) / 16); i += nwg * NTHR) { const int row = i >> 3, c16 = i & 7;
                unsigned z0; asm volatile("v_mov_b32 %0, 0" : "=v"(z0)); *(u32x4*)(ws + WS_W2M + (size_t)row * DFE_PAD + DFE + 16 * c16) = (u32x4){z0, z0, z0, z0}; } }
        return;
    }
    const int n_ffn = moe ? (NEXP * 2 * IT_M1) : 0;
    for (int it = gw; it < n_fixed + n_ffn; it += NGW) {
        int r = it;
        if (r < IT_IN) { xpose_item(C.in[I_W_IN] + (size_t)l * D * NIN, D, NIN, (bf16*)(ws + WS_WIN), 0, 0, 0, scr, r, lane); continue; } r -= IT_IN;
        if (r < 4 * IT_B) { const int i = r / IT_B; xpose_item(C.in[I_W_BRANCH] + ((size_t)l * 4 + i) * 256 * D, 256, D, (bf16*)(ws + WS_WB), 0, 1024 * i, 0, scr, r % IT_B, lane); continue; } r -= 4 * IT_B;
        if (r < 4 * IT_G) { const int i = r / IT_G; xpose_item8(C.in[I_W_GATE] + ((size_t)l * 4 + i) * D * D, D, D, ws + WS_WG, 1, i, 0, scr, r % IT_G, lane); continue; } r -= 4 * IT_G;
        if (r < IT_O) { xpose_item(C.in[I_W_OUT] + (size_t)l * D * D, D, D, (bf16*)(ws + WS_WOUT), 0, 0, 0, scr, r, lane); continue; } r -= IT_O;
        { const int per = 2 * IT_M1, e = r / per; r -= e * per;
          if (r < IT_M1) { xpose_item8(C.in[I_MOE_W1] + ((size_t)l2 * NEXP + e) * D * DFE, D, DFE, ws + WS_W13, 2, e * 2 * DFE, 0, scr, r, lane); continue; } r -= IT_M1;
          xpose_item8(C.in[I_MOE_W3] + ((size_t)l2 * NEXP + e) * D * DFE, D, DFE, ws + WS_W13, 2, e * 2 * DFE, 1, scr, r, lane); }
    }
    bf16* WL = (bf16*)(ws + WS_WLORA);
    const float* w2 = C.in[I_RW_W2] + (size_t)l * 64 * 256; const float* a2 = C.in[I_RW_A2] + (size_t)l * 64 * 256; const float* g2 = C.in[I_RW_G2] + (size_t)l * 128 * 256;
    for (int i = C.bid * NTHR + C.tid; i < 768 * 256; i += C.G * NTHR) {
        const int n = i >> 8, k = i & 255; float v = 0.f;
        if (n < 256) { if (k < 64) v = w2[k * 256 + n]; }
        else if (n < 512) { if (k >= 64 && k < 128) v = a2[(k - 64) * 256 + (n - 256)]; }
        else { if (k >= 128) v = g2[(k - 128) * 256 + (n - 512)]; }
        WL[i] = f2bf(v);
    }
}

__device__ __forceinline__ void ph_norm_(const Ctx& C, const float* gain, bool route, const float* router, int moe_idx, bool combine = false, const float* src = nullptr, bool want_bf16 = true) {
    const int gw = C.bid * NWAVES + C.wave, NGW = C.G * NWAVES, lane = C.lane;
    bf16* H = (bf16*)(C.ws + WS_H);
    f32x4 g[4];
#pragma unroll
    for (int j = 0; j < 4; ++j) g[j] = *((const f32x4*)gain + lane + 64 * j);
    LAS unsigned* lcnt = (LAS unsigned*)(C.lds);
    if (route) { if (C.tid < 8) lcnt[C.tid] = 0u; __syncthreads(); }
    int* eidx = (int*)(C.ws + WS_EIDX); float* gate = (float*)(C.ws + WS_GATE);
    constexpr int NR = 2;
    for (int mb = gw; mb < T; mb += NR * NGW) {
        f32x4 vv[NR][4]; u32x2 ya[NR][4], yb[NR][4]; float g0v[NR], g1v[NR];
#pragma unroll
        for (int r = 0; r < NR; ++r) { const int m = mb + r * NGW; if (m < T) { const f32x4* xr = (const f32x4*)((src ? src : C.out) + (size_t)m * D) + lane;
#pragma unroll
            for (int j = 0; j < 4; ++j) vv[r][j] = xr[64 * j];
            if (src) { f32x4* xo = (f32x4*)(C.out + (size_t)m * D) + lane;
#pragma unroll
                for (int j = 0; j < 4; ++j) xo[64 * j] = vv[r][j]; }
            if (combine) { const int* slotof = (const int*)(C.ws + WS_SLOTOF); const float* gt = (const float*)(C.ws + WS_GATE); const bf16* YS = (const bf16*)(C.ws + WS_YS);
                const int s0 = slotof[2 * m], s1 = slotof[2 * m + 1]; g0v[r] = gt[2 * m]; g1v[r] = gt[2 * m + 1];
                const u32x2* y0 = (const u32x2*)(YS + (size_t)s0 * D) + lane; const u32x2* y1 = (const u32x2*)(YS + (size_t)s1 * D) + lane;
#pragma unroll
                for (int j = 0; j < 4; ++j) { ya[r][j] = y0[64 * j]; yb[r][j] = y1[64 * j]; } } } }
#pragma unroll
        for (int r = 0; r < NR; ++r) { const int m = mb + r * NGW; if (m < T) {
        f32x4* xr = (f32x4*)(C.out + (size_t)m * D) + lane;
        f32x4 v[4]; float s = 0.f;
#pragma unroll
        for (int j = 0; j < 4; ++j) v[j] = vv[r][j];
        if (combine) {
            const float g0 = g0v[r], g1 = g1v[r];
#pragma unroll
            for (int j = 0; j < 4; ++j) { const u32x2 a = ya[r][j], b = yb[r][j];
                v[j].x += g0 * bflo(a.x) + g1 * bflo(b.x); v[j].y += g0 * bfhi(a.x) + g1 * bfhi(b.x); v[j].z += g0 * bflo(a.y) + g1 * bflo(b.y); v[j].w += g0 * bfhi(a.y) + g1 * bfhi(b.y);
                xr[64 * j] = v[j]; }
        }
#pragma unroll
        for (int j = 0; j < 4; ++j) s += (v[j].x * v[j].x + v[j].y * v[j].y) + (v[j].z * v[j].z + v[j].w * v[j].w);
        const float rs = 1.0f / sqrtf(wave_sum(s, C.lane) * (1.f / D) + 1e-6f);
        unsigned long long* o8 = (unsigned long long*)(H + (size_t)m * D) + lane;
#pragma unroll
        for (int j = 0; j < 4; ++j) { v[j] = v[j] * rs * g[j]; if (want_bf16) o8[64 * j] = (unsigned long long)cvt_pk_bf16(v[j].x, v[j].y) | ((unsigned long long)cvt_pk_bf16(v[j].z, v[j].w) << 32);
            ((unsigned*)(C.ws + WS_H8 + (size_t)m * D))[lane + 64 * j] = pk4_fp8(v[j].x * F8_MUL_X, v[j].y * F8_MUL_X, v[j].z * F8_MUL_X, v[j].w * F8_MUL_X); }
        if (route) {
            float lg[8];
#pragma unroll
            for (int e = 0; e < 8; ++e) lg[e] = 0.f;
#pragma unroll
            for (int j = 0; j < 4; ++j)
#pragma unroll
                for (int q = 0; q < 4; ++q) { const int k = 4 * (lane + 64 * j) + q; const f32x4 r0 = *(const f32x4*)(router + (size_t)k * 8), r1 = *(const f32x4*)(router + (size_t)k * 8 + 4); const float hv = v[j][q];
                    lg[0] += hv * r0.x; lg[1] += hv * r0.y; lg[2] += hv * r0.z; lg[3] += hv * r0.w; lg[4] += hv * r1.x; lg[5] += hv * r1.y; lg[6] += hv * r1.z; lg[7] += hv * r1.w; }
#pragma unroll
            for (int e = 0; e < 8; ++e) lg[e] = wave_sum(lg[e], C.lane);
            int e0 = 0; float b0 = lg[0];
#pragma unroll
            for (int e = 1; e < 8; ++e) if (lg[e] > b0) { b0 = lg[e]; e0 = e; }
            int e1 = -1; float b1 = -3.0e38f;
#pragma unroll
            for (int e = 0; e < 8; ++e) if (e != e0 && lg[e] > b1) { b1 = lg[e]; e1 = e; }
            const float p1 = __expf(b1 - b0), inv = 1.f / (1.f + p1);
            if (lane == 0) { eidx[2 * m] = e0; eidx[2 * m + 1] = e1; gate[2 * m] = inv; gate[2 * m + 1] = p1 * inv; atomicAdd((unsigned*)&lcnt[e0], 1u); atomicAdd((unsigned*)&lcnt[e1], 1u); }
        }
        } }
    }
    if (route) { __syncthreads(); if (C.tid < 8) { unsigned* cw = (unsigned*)(C.ws + WS_CTL) + CW_MOE + moe_idx * 64; atomicAdd(&cw[C.tid], lcnt[C.tid]); } }
}

__device__ __forceinline__ void ph_rw_prep_(const Ctx& C, int l) {
    const bf16* RW = (const bf16*)(C.ws + WS_RW); bf16* RKVS = (bf16*)(C.ws + WS_RKVS); bf16* AL = (bf16*)(C.ws + WS_ALORA);
    const float* mu = C.in[I_RW_MU] + (size_t)l * 1024;
    const size_t gid = (size_t)C.bid * NTHR + C.tid, gsz = (size_t)C.G * NTHR;
    constexpr int NI = 4;
    for (size_t it0 = gid; it0 < (size_t)T * 128; it0 += NI * gsz) {
        u32x4 cuv[NI], pvv[NI];
#pragma unroll
        for (int r = 0; r < NI; ++r) { const size_t it = it0 + r * gsz; cuv[r] = (u32x4){0u, 0u, 0u, 0u}; pvv[r] = cuv[r];
            if (it < (size_t)T * 128) { const int m = (int)(it >> 7), c8 = (int)(it & 127) * 8, t = m & (SEQ - 1);
                cuv[r] = *(const u32x4*)(RW + (size_t)m * 1024 + c8); if (t) pvv[r] = *(const u32x4*)(RW + (size_t)(m - 1) * 1024 + c8); } }
#pragma unroll
        for (int r = 0; r < NI; ++r) { const size_t it = it0 + r * gsz; if (it < (size_t)T * 128) {
        const int m = (int)(it >> 7), c8 = (int)(it & 127) * 8;
        float a[8], b[8]; unpack8(cuv[r], a); unpack8(pvv[r], b);
        const f32x4 m0 = *(const f32x4*)(mu + c8), m1 = *(const f32x4*)(mu + c8 + 4);
        const float mm[8] = {m0.x, m0.y, m0.z, m0.w, m1.x, m1.y, m1.z, m1.w};
#pragma unroll
        for (int e = 0; e < 8; ++e) a[e] = a[e] + (b[e] - a[e]) * mm[e];
        if (c8 < 768) { *(u32x4*)(RKVS + (size_t)m * 768 + c8) = pack8(a); }
        else {
            if (c8 < 832) {
#pragma unroll
                for (int e = 0; e < 8; ++e) a[e] = 1.f - 2.f * __builtin_amdgcn_rcpf(1.f + __builtin_amdgcn_exp2f(2.f * LOG2E * a[e]));
            } else if (c8 >= 896) {
#pragma unroll
                for (int e = 0; e < 8; ++e) a[e] = sigm(a[e]);
            }
            *(u32x4*)(AL + (size_t)m * 256 + (c8 - 768)) = pack8(a);
        } } }
    }
}

__device__ __forceinline__ void ph_sb_prep_(const Ctx& C, int l) {
    bf16* SB = (bf16*)(C.ws + WS_SB);
    const int gw = C.bid * NWAVES + C.wave, NGW = C.G * NWAVES, lane = C.lane;
    const bool isk = lane >= 32; const int d0 = (lane & 7) * 8;
    const float* gn = (isk ? C.in[I_SB_KN] : C.in[I_SB_QN]) + (size_t)l * 64 + d0;
    float gg[8];
#pragma unroll
    for (int e = 0; e < 8; ++e) gg[e] = gn[e] * (isk ? 1.f : 0.125f * LOG2E);
    constexpr int NR = 4;
    for (int mb = gw; mb < T; mb += NR * NGW) {
        u32x4 uu[NR];
#pragma unroll
        for (int r = 0; r < NR; ++r) { const int m = mb + r * NGW; uu[r] = (u32x4){0u, 0u, 0u, 0u}; if (m < T) uu[r] = *(const u32x4*)(SB + (size_t)m * 768 + lane * 8); }
#pragma unroll
        for (int r = 0; r < NR; ++r) { const int m = mb + r * NGW; if (m < T) {
            bf16* p = SB + (size_t)m * 768 + lane * 8;
            float a[8]; unpack8(uu[r], a);
            float ss = 0.f;
#pragma unroll
            for (int e = 0; e < 8; ++e) ss += a[e] * a[e];
            ss += shx(ss, 1, lane); ss += shx(ss, 2, lane); ss += shx(ss, 4, lane);
            const float rs = 1.0f / sqrtf(ss * (1.f / 64.f) + 1e-6f);
#pragma unroll
            for (int e = 0; e < 8; ++e) a[e] = a[e] * rs * gg[e];
            *(u32x4*)p = pack8(a); } }
    }
}

__device__ __forceinline__ void ph_conv_(const Ctx& C, int l) {
    const bf16* CV = (const bf16*)(C.ws + WS_CV); bf16* Y = (bf16*)(C.ws + WS_Y);
    LAS float* U = (LAS float*)(C.lds); LAS float* OC = (LAS float*)(C.lds + 65536);
    const int tid = C.tid, c = tid & 255, half = tid >> 8;
    const float* dw = C.in[I_CONV_DW] + (size_t)l * 31 * 256; const float db = C.in[I_CONV_B][l * 256 + c];
    float dwr[31];
#pragma unroll
    for (int j = 0; j < 31; ++j) dwr[j] = dw[j * 256 + c];
    const float* lnw = C.in[I_CONV_LNW] + (size_t)l * 256; const float* lnb = C.in[I_CONV_LNB] + (size_t)l * 256;
    for (int u = C.bid; u < T / 32; u += C.G) {
        const int m0 = u * 32, t0 = m0 & (SEQ - 1);
        for (int it = tid; it < 62 * 32; it += NTHR) {
            const int r = it >> 5, c8 = (it & 31) * 8, tt = t0 - 30 + r; float a[8], b[8];
            if (tt >= 0) { const size_t mm = (size_t)(m0 - 30 + r); unpack8(*(const u32x4*)(CV + mm * 512 + c8), a); unpack8(*(const u32x4*)(CV + mm * 512 + 256 + c8), b);
#pragma unroll
                for (int e = 0; e < 8; ++e) a[e] = a[e] * sigm(b[e]); }
            else {
#pragma unroll
                for (int e = 0; e < 8; ++e) a[e] = 0.f; }
#pragma unroll
            for (int e = 0; e < 8; ++e) U[r * 256 + c8 + e] = a[e];
        }
        __syncthreads();
        { float win[46];
#pragma unroll
          for (int i = 0; i < 46; ++i) win[i] = U[(half * 16 + i) * 256 + c];
#pragma unroll
          for (int tt = 0; tt < 16; ++tt) { float acc = db;
#pragma unroll
              for (int j = 0; j < 31; ++j) acc += dwr[j] * win[tt + j];
              OC[(half * 16 + tt) * 256 + c] = acc; } }
        __syncthreads();
#pragma unroll 1
        for (int q = 0; q < 4; ++q) { const int tl = C.wave * 4 + q; float v[4]; float s = 0.f;
#pragma unroll
            for (int i = 0; i < 4; ++i) { v[i] = OC[tl * 256 + C.lane + 64 * i]; s += v[i]; }
            const float mean = wave_sum(s, C.lane) * (1.f / 256.f); float s2 = 0.f;
#pragma unroll
            for (int i = 0; i < 4; ++i) { v[i] -= mean; s2 += v[i] * v[i]; }
            const float rstd = 1.0f / sqrtf(wave_sum(s2, C.lane) * (1.f / 256.f) + 1e-5f);
#pragma unroll
            for (int i = 0; i < 4; ++i) { const int cc = C.lane + 64 * i; const float y = v[i] * rstd * lnw[cc] + lnb[cc]; Y[(size_t)(m0 + tl) * 1024 + 768 + cc] = f2bf(y * sigm(y)); } }
        __syncthreads();
    }
}

__device__ __forceinline__ float ret_log2gamma(int h) { return log2f(1.0f - exp2f(-5.0f - (float)h)); }
__device__ __forceinline__ void ret_load_rot(const Ctx& C, const bf16* RET, int m0, int coff, float scale, LAS float* dst) {
    const int s = C.tid >> 3, d0 = (C.tid & 7) * 4;
    const float* cs = (const float*)(C.ws + WS_COS); const float* sn = (const float*)(C.ws + WS_SIN);
    const int pos = (m0 + s) & (SEQ - 1);
    const u32x2 a = *(const u32x2*)(RET + (size_t)(m0 + s) * 1024 + coff + d0), b = *(const u32x2*)(RET + (size_t)(m0 + s) * 1024 + coff + 32 + d0);
    const float x1[4] = {bflo(a.x), bfhi(a.x), bflo(a.y), bfhi(a.y)}, x2[4] = {bflo(b.x), bfhi(b.x), bflo(b.y), bfhi(b.y)};
    const f32x4 cv = *(const f32x4*)(cs + (size_t)pos * 32 + d0), sv = *(const f32x4*)(sn + (size_t)pos * 32 + d0);
#pragma unroll
    for (int e = 0; e < 4; ++e) { dst[s * 65 + d0 + e] = (x1[e] * cv[e] - x2[e] * sv[e]) * scale; dst[s * 65 + 32 + d0 + e] = (x1[e] * sv[e] + x2[e] * cv[e]) * scale; }
}
__device__ __forceinline__ void ph_ret_kv_(const Ctx& C) {
    const bf16* RET = (const bf16*)(C.ws + WS_RET); float* KV = (float*)(C.ws + WS_KV);
    LAS float* KD = (LAS float*)(C.lds); LAS float* VV = (LAS float*)(C.lds + 32768);
    const int tid = C.tid;
    for (int u = C.bid; u < 2048; u += C.G) {
        const int bh = u >> 8, ch = u & 255, b = bh >> 2, h = bh & 3, m0 = b * SEQ + ch * 64;
        const float lg = ret_log2gamma(h);
        ret_load_rot(C, RET, m0, 256 + h * 64, 0.125f, KD);
        { const int s = tid >> 3, e0 = (tid & 7) * 8; float a[8]; unpack8(*(const u32x4*)(RET + (size_t)(m0 + s) * 1024 + 512 + h * 64 + e0), a);
          const float dec = exp2f(lg * (float)(63 - s));
#pragma unroll
          for (int e = 0; e < 8; ++e) VV[s * 64 + e0 + e] = a[e] * dec; }
        __syncthreads();
        const int d = tid >> 3, e0 = (tid & 7) * 8; float acc[8];
#pragma unroll
        for (int e = 0; e < 8; ++e) acc[e] = 0.f;
#pragma unroll 4
        for (int s = 0; s < 64; ++s) { const float kd = KD[s * 65 + d]; const f32x4 v0 = *(const LAS f32x4*)(VV + s * 64 + e0), v1 = *(const LAS f32x4*)(VV + s * 64 + e0 + 4);
            acc[0] += kd * v0.x; acc[1] += kd * v0.y; acc[2] += kd * v0.z; acc[3] += kd * v0.w; acc[4] += kd * v1.x; acc[5] += kd * v1.y; acc[6] += kd * v1.z; acc[7] += kd * v1.w; }
        float* o = KV + (size_t)u * 4096 + d * 64 + e0;
        *(f32x4*)o = (f32x4){acc[0], acc[1], acc[2], acc[3]}; *(f32x4*)(o + 4) = (f32x4){acc[4], acc[5], acc[6], acc[7]};
        __syncthreads();
    }
}
__device__ __forceinline__ void ph_ret_scan_(const Ctx& C) {
    float* KV = (float*)(C.ws + WS_KV);
    const int wg0 = (C.G >= 256) ? 128 : 0, nw = C.G - wg0;
    for (int i = (C.bid - wg0) * NTHR + C.tid; i < 8 * 4096 && C.bid >= wg0; i += nw * NTHR) {
        const int bh = i >> 12, el = i & 4095, h = bh & 3;
        const float cd = exp2f(ret_log2gamma(h) * 64.f);
        float* p = KV + (size_t)bh * 256 * 4096 + el; float S = 0.f;
#pragma unroll 1
        for (int c = 0; c < 256; c += 32) { float kv[32];
#pragma unroll
            for (int q = 0; q < 32; ++q) kv[q] = p[(size_t)(c + q) * 4096];
#pragma unroll
            for (int q = 0; q < 32; ++q) { p[(size_t)(c + q) * 4096] = S; S = S * cd + kv[q]; } }
    }
}
__device__ __forceinline__ void ph_ret_out_(const Ctx& C, int l, int first_wg, int nwg) {
    const bf16* RET = (const bf16*)(C.ws + WS_RET); const float* KV = (const float*)(C.ws + WS_KV); bf16* Y = (bf16*)(C.ws + WS_Y);
    LAS float* Q = (LAS float*)(C.lds); LAS float* Kk = (LAS float*)(C.lds + 16640); LAS float* VV = (LAS float*)(C.lds + 33280); LAS float* SS = (LAS float*)(C.lds + 49664); LAS float* SC = (LAS float*)(C.lds + 66048);
    const int tid = C.tid; const float* gn = C.in[I_RET_GN] + (size_t)l * 256;
    for (int u = C.bid - first_wg; u < 2048; u += nwg) {
        const int bh = u >> 8, ch = u & 255, b = bh >> 2, h = bh & 3, m0 = b * SEQ + ch * 64;
        const float lg = ret_log2gamma(h);
        ret_load_rot(C, RET, m0, h * 64, 1.0f, Q);
        ret_load_rot(C, RET, m0, 256 + h * 64, 0.125f, Kk);
        { const int s = tid >> 3, e0 = (tid & 7) * 8; float a[8]; unpack8(*(const u32x4*)(RET + (size_t)(m0 + s) * 1024 + 512 + h * 64 + e0), a);
#pragma unroll
          for (int e = 0; e < 8; ++e) VV[s * 64 + e0 + e] = a[e];
          const float* sp = KV + (size_t)u * 4096 + s * 64 + e0; const f32x4 s0 = *(const f32x4*)sp, s1 = *(const f32x4*)(sp + 4);
          *(LAS f32x4*)(SS + s * 64 + e0) = s0; *(LAS f32x4*)(SS + s * 64 + e0 + 4) = s1; }
        __syncthreads();
        const int t = tid >> 3, g8 = tid & 7;
        { float sc[8];
#pragma unroll
          for (int i = 0; i < 8; ++i) sc[i] = 0.f;
#pragma unroll 4
          for (int d = 0; d < 64; ++d) { const float qv = Q[t * 65 + d];
#pragma unroll
              for (int i = 0; i < 8; ++i) sc[i] += qv * Kk[(g8 * 8 + i) * 65 + d]; }
#pragma unroll
          for (int i = 0; i < 8; ++i) { const int s = g8 * 8 + i; SC[t * 65 + s] = (s <= t) ? sc[i] * exp2f(lg * (float)(t - s)) : 0.f; } }
        __syncthreads();
        { const int e0 = g8 * 8; float o[8], o2[8];
#pragma unroll
          for (int e = 0; e < 8; ++e) { o[e] = 0.f; o2[e] = 0.f; }
#pragma unroll 4
          for (int s = 0; s < 64; ++s) { const float p = SC[t * 65 + s]; const f32x4 v0 = *(const LAS f32x4*)(VV + s * 64 + e0), v1 = *(const LAS f32x4*)(VV + s * 64 + e0 + 4);
              o[0] += p * v0.x; o[1] += p * v0.y; o[2] += p * v0.z; o[3] += p * v0.w; o[4] += p * v1.x; o[5] += p * v1.y; o[6] += p * v1.z; o[7] += p * v1.w; }
#pragma unroll 4
          for (int d = 0; d < 64; ++d) { const float qv = Q[t * 65 + d]; const f32x4 v0 = *(const LAS f32x4*)(SS + d * 64 + e0), v1 = *(const LAS f32x4*)(SS + d * 64 + e0 + 4);
              o2[0] += qv * v0.x; o2[1] += qv * v0.y; o2[2] += qv * v0.z; o2[3] += qv * v0.w; o2[4] += qv * v1.x; o2[5] += qv * v1.y; o2[6] += qv * v1.z; o2[7] += qv * v1.w; }
          const float qd = exp2f(lg * (float)(t + 1)); float s1 = 0.f;
#pragma unroll
          for (int e = 0; e < 8; ++e) { o[e] += qd * o2[e]; s1 += o[e]; }
          s1 += shx(s1, 1, C.lane); s1 += shx(s1, 2, C.lane); s1 += shx(s1, 4, C.lane);
          const float mean = s1 * (1.f / 64.f); float s2 = 0.f;
#pragma unroll
          for (int e = 0; e < 8; ++e) { o[e] -= mean; s2 += o[e] * o[e]; }
          s2 += shx(s2, 1, C.lane); s2 += shx(s2, 2, C.lane); s2 += shx(s2, 4, C.lane);
          const float rstd = 1.0f / sqrtf(s2 * (1.f / 64.f) + 1e-5f);
          float gtv[8]; unpack8(*(const u32x4*)(RET + (size_t)(m0 + t) * 1024 + 768 + h * 64 + e0), gtv);
#pragma unroll
          for (int e = 0; e < 8; ++e) o[e] = o[e] * rstd * gn[h * 64 + e0 + e] * (gtv[e] * sigm(gtv[e]));
          *(u32x4*)(Y + (size_t)(m0 + t) * 1024 + 512 + h * 64 + e0) = pack8(o); }
        __syncthreads();
    }
}

constexpr int RWC = 64, RW_NCH = SEQ / RWC, RW_NU = 8 * RW_NCH;
constexpr int RW_SUP = 8, RW_NSC = RW_NCH / RW_SUP, RW_NSUP = 8 * RW_NSC;
__device__ __forceinline__ void ph_rw_local_(const Ctx& C, int l) {
    const bf16* RKVS = (const bf16*)(C.ws + WS_RKVS); const float* WDEC = (const float*)(C.ws + WS_WDEC); const bf16* AG = (const bf16*)(C.ws + WS_AG);
    bf16* Y0 = (bf16*)(C.ws + WS_Y0); bf16* RH = (bf16*)(C.ws + WS_RHAT); float* PQ = (float*)(C.ws + WS_PQ); float* BON = (float*)(C.ws + WS_BON);
    const int lane = C.lane;
    LAS float* base = (LAS float*)(C.lds + C.wave * 12288);
    for (int it = C.bid; it < RW_NU / 8; it += C.G) {
        const int u = it * 8 + C.wave, bh = u >> 8, ch = u & 255, b = bh >> 2, h = bh & 3, m0 = b * SEQ + ch * RWC, hc = h * 64 + lane;
        const float kkw = C.in[I_RW_KK][l * 256 + hc], kaw = C.in[I_RW_KA][l * 256 + hc], rkw = C.in[I_RW_RK][l * 256 + hc], w0l = C.in[I_RW_W0][l * 256 + hc], a0l = C.in[I_RW_A0][l * 256 + hc];
        f32x2 sL[32], sI[32];
        { int ln = lane; asm volatile("" : "+v"(ln));
#pragma unroll
          for (int k = 0; k < 32; ++k) { sL[k] = (f32x2){0.f, 0.f}; sI[k].x = (2 * k == ln) ? 1.f : 0.f; sI[k].y = (2 * k + 1 == ln) ? 1.f : 0.f; } }
#pragma unroll 1
        for (int sb = 0; sb < RWC / 8; ++sb) {
            asm volatile("" ::: "memory");
#pragma unroll
            for (int i = 0; i < 8; ++i) { const size_t m = (size_t)(m0 + sb * 8 + i);
                const float r = bf2f(RKVS[m * 768 + hc]), k = bf2f(RKVS[m * 768 + 256 + hc]), v = bf2f(RKVS[m * 768 + 512 + hc]);
                const float w = __builtin_amdgcn_exp2f(-0.606531f * LOG2E * sigm(WDEC[m * 256 + hc] + w0l)), a = sigm(bf2f(AG[m * 512 + hc]) + a0l);
                const float kr = k * kkw; const float nn = sqrtf(wave_sum(kr * kr, C.lane)); const float kk = kr / fmaxf(nn, 1e-12f);
                const float kp = k * (1.f + (a - 1.f) * kaw);
                const float bon = wave_sum(r * kp * rkw, C.lane);
                if (lane == 0) BON[m * 4 + h] = bon;
                base[0 * 512 + i * 64 + lane] = w; base[1 * 512 + i * 64 + lane] = kk; base[2 * 512 + i * 64 + lane] = kk * a; base[3 * 512 + i * 64 + lane] = kp; base[4 * 512 + i * 64 + lane] = r; base[5 * 512 + i * 64 + lane] = v; }
            asm volatile("" ::: "memory");
#pragma unroll 1
            for (int i = 0; i < 8; ++i) {
                const LAS f32x4* wv = (const LAS f32x4*)(base + 0 * 512 + i * 64); const LAS f32x4* kkv = (const LAS f32x4*)(base + 1 * 512 + i * 64); const LAS f32x4* kav = (const LAS f32x4*)(base + 2 * 512 + i * 64);
                const LAS f32x4* kpv = (const LAS f32x4*)(base + 3 * 512 + i * 64); const LAS f32x4* rv = (const LAS f32x4*)(base + 4 * 512 + i * 64);
                const float vv = base[5 * 512 + i * 64 + lane];
                f32x4 kq[2][4];
#pragma unroll
                for (int t = 0; t < 4; ++t) kq[0][t] = kkv[t];
                f32x2 dL0 = (f32x2){0.f, 0.f}, dL1 = dL0, dI0 = dL0, dI1 = dL0;
                f32x4 ga[2][4];
#pragma unroll
                for (int g = 0; g < 4; ++g) {
                    __builtin_amdgcn_sched_barrier(0);
                    if (g + 1 < 4) {
#pragma unroll
                        for (int t = 0; t < 4; ++t) kq[(g + 1) & 1][t] = kkv[4 * (g + 1) + t]; }
                    else { ga[0][0] = wv[0]; ga[0][1] = kav[0]; ga[0][2] = kpv[0]; ga[0][3] = rv[0]; }
                    __builtin_amdgcn_sched_barrier(0);
#pragma unroll
                    for (int t = 0; t < 4; ++t) { const int k4 = 4 * g + t; const f32x4 q4 = kq[g & 1][t];
                        dL0 += sL[2 * k4] * q4.xy; dL1 += sL[2 * k4 + 1] * q4.zw; dI0 += sI[2 * k4] * q4.xy; dI1 += sI[2 * k4 + 1] * q4.zw; }
                }
                const float saL = -((dL0.x + dL0.y) + (dL1.x + dL1.y)), saI = -((dI0.x + dI0.y) + (dI1.x + dI1.y));
                const f32x2 saLv = (f32x2){saL, saL}, saIv = (f32x2){saI, saI}, vvv = (f32x2){vv, vv};
                f32x2 yL0 = (f32x2){0.f, 0.f}, yL1 = yL0, yI0 = yL0, yI1 = yL0;
#pragma unroll
                for (int k4 = 0; k4 < 16; ++k4) {
                    __builtin_amdgcn_sched_barrier(0);
                    if (k4 + 1 < 16) { ga[(k4 + 1) & 1][0] = wv[k4 + 1]; ga[(k4 + 1) & 1][1] = kav[k4 + 1]; ga[(k4 + 1) & 1][2] = kpv[k4 + 1]; ga[(k4 + 1) & 1][3] = rv[k4 + 1]; }
                    __builtin_amdgcn_sched_barrier(0);
                    const f32x4 wq = ga[k4 & 1][0], aq = ga[k4 & 1][1], pq = ga[k4 & 1][2], rq = ga[k4 & 1][3];
                    sL[2 * k4]     = sL[2 * k4]     * wq.xy + saLv * aq.xy + vvv * pq.xy; yL0 += sL[2 * k4]     * rq.xy;
                    sL[2 * k4 + 1] = sL[2 * k4 + 1] * wq.zw + saLv * aq.zw + vvv * pq.zw; yL1 += sL[2 * k4 + 1] * rq.zw;
                    sI[2 * k4]     = sI[2 * k4]     * wq.xy + saIv * aq.xy;                  yI0 += sI[2 * k4]     * rq.xy;
                    sI[2 * k4 + 1] = sI[2 * k4 + 1] * wq.zw + saIv * aq.zw;                  yI1 += sI[2 * k4 + 1] * rq.zw;
                }
                __builtin_amdgcn_sched_barrier(0);
                const size_t m = (size_t)(m0 + sb * 8 + i);
                Y0[m * 256 + hc] = f2bf((yL0.x + yL0.y) + (yL1.x + yL1.y));
                RH[m * 256 + hc] = f2bf((yI0.x + yI0.y) + (yI1.x + yI1.y));
            }
        }
        float* oq = PQ + (size_t)u * 4096 + lane * 64; float* opt = PQ + ((size_t)RW_NU + u) * 4096 + lane;
#pragma unroll
        for (int k4 = 0; k4 < 16; ++k4) { *(f32x4*)(oq + 4 * k4) = (f32x4){sL[2 * k4].x, sL[2 * k4].y, sL[2 * k4 + 1].x, sL[2 * k4 + 1].y};
            opt[(4 * k4) * 64] = sI[2 * k4].x; opt[(4 * k4 + 1) * 64] = sI[2 * k4].y; opt[(4 * k4 + 2) * 64] = sI[2 * k4 + 1].x; opt[(4 * k4 + 3) * 64] = sI[2 * k4 + 1].y; }
    }
}
constexpr int WY_LT = 24;
constexpr int WY_ROWM = 0, WY_COLM = 36864, WY_AMAT = 73728, WY_AABF = 89088, WY_SB = 93184, WY_WT = 111616, WY_UT = 117760, WY_GH = 123904, WY_GC = 125952;
__device__ __forceinline__ f32x4 wy_mm16(const LAS bf16* X, const LAS bf16* Y, f32x4 acc, int li, int lq) {
#pragma unroll
    for (int ks = 0; ks < 2; ++ks) { const bf16x8 a = *(const LAS bf16x8*)(X + li * MM_LP + 32 * ks + 8 * lq), b = *(const LAS bf16x8*)(Y + li * MM_LP + 32 * ks + 8 * lq);
        acc = __builtin_amdgcn_mfma_f32_16x16x32_bf16(a, b, acc, 0, 0, 0); }
    return acc;
}
__device__ __forceinline__ f32x4 wy_mm16k16(const LAS bf16* X, const LAS bf16* Y, f32x4 acc, int li, int lq) {
    const s16x4 a = *(const LAS s16x4*)(X + li * WY_LT + 4 * lq), b = *(const LAS s16x4*)(Y + li * WY_LT + 4 * lq);
    return __builtin_amdgcn_mfma_f32_16x16x16bf16_1k(a, b, acc, 0, 0, 0);
}
__device__ __forceinline__ void ph_rw_local_wy_(const Ctx& C, int l) {
    const bf16* RKVS = (const bf16*)(C.ws + WS_RKVS); const float* WDEC = (const float*)(C.ws + WS_WDEC); const bf16* AG = (const bf16*)(C.ws + WS_AG);
    bf16* Y0 = (bf16*)(C.ws + WS_Y0); bf16* RH = (bf16*)(C.ws + WS_RHAT); float* PQ = (float*)(C.ws + WS_PQ); float* BON = (float*)(C.ws + WS_BON);
    const int lane = C.lane, w = C.wave, li = lane & 15, lq = lane >> 4, j32 = lane & 31, hi = lane >> 5, ti = w >> 1, tj = w & 1, sq = w >> 1, half = w & 1;
    LAS unsigned char* L = C.lds;
#define WY_ROW(q, m) ((LAS bf16*)(L + WY_ROWM + (q) * 9216 + (m) * 2304))
#define WY_COL(q, m) ((LAS bf16*)(L + WY_COLM + (q) * 9216 + (m) * 3072))
#define WY_A(q, id)  ((LAS bf16*)(L + WY_AMAT + (q) * 3840 + (id) * 768))
    LAS bf16* SB = (LAS bf16*)(L + WY_SB); LAS bf16* WT = (LAS bf16*)(L + WY_WT); LAS bf16* UT = (LAS bf16*)(L + WY_UT);
    LAS float* GH = (LAS float*)(L + WY_GH); LAS float* GCs = (LAS float*)(L + WY_GC);
    for (int su = C.bid; su < RW_NSUP; su += C.G) {
    f32x16 S;
#pragma unroll 1
    for (int cc = 0; cc < RW_SUP; ++cc) {
        const int u = su * RW_SUP + cc;
        const int bh = u >> 8, ch = u & 255, b = bh >> 2, h = bh & 3, m0 = b * SEQ + ch * RWC, hc = h * 64 + lane;
        const float kkw = C.in[I_RW_KK][l * 256 + hc], kaw = C.in[I_RW_KA][l * 256 + hc], rkw = C.in[I_RW_RK][l * 256 + hc], w0l = C.in[I_RW_W0][l * 256 + hc], a0l = C.in[I_RW_A0][l * 256 + hc];
        { float wv[8], kk[8], ka[8], kp[8], rr[8], vv[8];
#pragma unroll
          for (int i = 0; i < 8; ++i) { const size_t m = (size_t)(m0 + 8 * w + i);
              const float r = bf2f(RKVS[m * 768 + hc]), k = bf2f(RKVS[m * 768 + 256 + hc]); vv[i] = bf2f(RKVS[m * 768 + 512 + hc]);
              wv[i] = __builtin_amdgcn_exp2f(-0.606531f * LOG2E * sigm(WDEC[m * 256 + hc] + w0l)); const float a = sigm(bf2f(AG[m * 512 + hc]) + a0l);
              const float kr = k * kkw; const float nn = sqrtf(wave_sum(kr * kr, lane)); kk[i] = kr / fmaxf(nn, 1e-12f);
              kp[i] = k * (1.f + (a - 1.f) * kaw); ka[i] = kk[i] * a; rr[i] = r;
              const float bon = wave_sum(r * kp[i] * rkw, lane);
              if (lane == 0) BON[m * 4 + h] = bon; }
          float cp[8]; cp[0] = wv[0];
#pragma unroll
          for (int i = 1; i < 8; ++i) cp[i] = cp[i - 1] * wv[i];
          GH[w * 64 + lane] = cp[7];
          __syncthreads();
          const float pre = half ? GH[(w - 1) * 64 + lane] : 1.f, gC = half ? pre * cp[7] : cp[7] * GH[(w + 1) * 64 + lane];
          if (!half) GCs[sq * 64 + lane] = gC;
#pragma unroll
          for (int i = 0; i < 8; ++i) { const int t = 8 * half + i; const float G = pre * cp[i], Gm1 = (i == 0) ? pre : pre * cp[i - 1], rG = __builtin_amdgcn_rcpf(G);
              WY_ROW(sq, 0)[t * MM_LP + lane] = f2bf(-kk[i] * Gm1); WY_ROW(sq, 1)[t * MM_LP + lane] = f2bf(ka[i] * rG); WY_ROW(sq, 2)[t * MM_LP + lane] = f2bf(kp[i] * rG); WY_ROW(sq, 3)[t * MM_LP + lane] = f2bf(rr[i] * G);
              WY_COL(sq, 0)[lane * WY_LT + t] = f2bf(ka[i] * rG * gC); WY_COL(sq, 1)[lane * WY_LT + t] = f2bf(kp[i] * rG * gC); WY_COL(sq, 2)[lane * WY_LT + t] = f2bf(vv[i]); } }
        __syncthreads();
#pragma unroll
        for (int pp = 0; pp < 2; ++pp) { const int id = 2 * half + pp;
            f32x4 acc = (f32x4){0.f, 0.f, 0.f, 0.f};
            acc = wy_mm16(WY_ROW(sq, half ? 3 : 0), WY_ROW(sq, pp ? 2 : 1), acc, li, lq);
#pragma unroll
            for (int r = 0; r < 4; ++r) { const int t = 4 * lq + r; const bool keep = half ? (li <= t) : (li < t); const float val = keep ? acc[r] : 0.f;
                WY_A(sq, id)[t * WY_LT + li] = f2bf(val); if (id == 0) ((LAS float*)(L + WY_AABF + sq * 1024))[t * 16 + li] = val; } }
        __syncthreads();
        if (w < 4) { const LAS float* Af = (const LAS float*)(L + WY_AABF + w * 1024); float Tc[16];
#pragma unroll
            for (int t = 0; t < 16; ++t) { float acc = (t == li) ? 1.f : 0.f;
#pragma unroll
                for (int s4 = 0; s4 < 4; ++s4) { if (4 * s4 < t) { const f32x4 a4 = *(const LAS f32x4*)(Af + t * 16 + 4 * s4);
                    if (4 * s4 + 0 < t) acc += a4.x * Tc[4 * s4 + 0]; if (4 * s4 + 1 < t) acc += a4.y * Tc[4 * s4 + 1]; if (4 * s4 + 2 < t) acc += a4.z * Tc[4 * s4 + 2]; if (4 * s4 + 3 < t) acc += a4.w * Tc[4 * s4 + 3]; } }
                Tc[t] = acc; WY_A(w, 4)[t * WY_LT + li] = f2bf(acc); } }
        if (cc == 0) {
#pragma unroll
            for (int r = 0; r < 4; ++r)
#pragma unroll
                for (int e = 0; e < 4; ++e) { const int row = 32 * ti + 8 * r + 4 * hi + e, col = 32 * tj + j32; S[4 * r + e] = (ti >= 2 && row - 64 == col) ? 1.f : 0.f; }
#pragma unroll
            for (int r = 0; r < 4; ++r)
#pragma unroll
                for (int e = 0; e < 4; ++e) SB[(32 * ti + 8 * r + 4 * hi + e) * MM_LP + 32 * tj + j32] = f2bf(S[4 * r + e]);
        }
        __syncthreads();
#pragma unroll 1
        for (int q = 0; q < 4; ++q) {
            f32x4 accW = (f32x4){0.f, 0.f, 0.f, 0.f}, accY = accW;
            accW = wy_mm16(WY_ROW(q, 0), SB + 16 * w * MM_LP, accW, li, lq);
            accY = wy_mm16(WY_ROW(q, 3), SB + 16 * w * MM_LP, accY, li, lq);
            if (w < 4) accW = wy_mm16k16(WY_A(q, 1), WY_COL(q, 2) + 16 * w * WY_LT, accW, li, lq);
            { u32x2 pk; pk.x = cvt_pk_bf16(accW[0], accW[1]); pk.y = cvt_pk_bf16(accW[2], accW[3]); *(LAS u32x2*)(WT + (16 * w + li) * WY_LT + 4 * lq) = pk; }
            asm volatile("s_waitcnt lgkmcnt(0)" ::: "memory");
            { f32x4 accU = (f32x4){0.f, 0.f, 0.f, 0.f}; accU = wy_mm16k16(WY_A(q, 4), WT + 16 * w * WY_LT, accU, li, lq);
              u32x2 pk; pk.x = cvt_pk_bf16(accU[0], accU[1]); pk.y = cvt_pk_bf16(accU[2], accU[3]); *(LAS u32x2*)(UT + (16 * w + li) * WY_LT + 4 * lq) = pk; }
            asm volatile("s_waitcnt lgkmcnt(0)" ::: "memory");
            accY = wy_mm16k16(WY_A(q, 2), UT + 16 * w * WY_LT, accY, li, lq);
            if (w < 4) accY = wy_mm16k16(WY_A(q, 3), WY_COL(q, 2) + 16 * w * WY_LT, accY, li, lq);
            { bf16* dst = (w < 4) ? Y0 : RH; const int colo = h * 64 + ((16 * w) & 63) + li;
#pragma unroll
              for (int r = 0; r < 4; ++r) dst[(size_t)(m0 + 16 * q + 4 * lq + r) * 256 + colo] = f2bf(accY[r]); }
            __syncthreads();
            { const float gc = GCs[q * 64 + 32 * tj + j32];
#pragma unroll
              for (int i = 0; i < 16; ++i) S[i] *= gc;
              const bf16x8 ua = *(const LAS bf16x8*)(UT + (32 * ti + j32) * WY_LT + 8 * hi), bb = *(const LAS bf16x8*)(WY_COL(q, 0) + (32 * tj + j32) * WY_LT + 8 * hi);
              S = __builtin_amdgcn_mfma_f32_32x32x16_bf16(ua, bb, S, 0, 0, 0);
              if (ti < 2) { const bf16x8 va = *(const LAS bf16x8*)(WY_COL(q, 2) + (32 * ti + j32) * WY_LT + 8 * hi), kb = *(const LAS bf16x8*)(WY_COL(q, 1) + (32 * tj + j32) * WY_LT + 8 * hi);
                  S = __builtin_amdgcn_mfma_f32_32x32x16_bf16(va, kb, S, 0, 0, 0); } }
            {
#pragma unroll
                for (int r = 0; r < 4; ++r)
#pragma unroll
                    for (int e = 0; e < 4; ++e) SB[(32 * ti + 8 * r + 4 * hi + e) * MM_LP + 32 * tj + j32] = f2bf(S[4 * r + e]);
                __syncthreads(); }
        }
        if (cc == RW_SUP - 1) {
        if (ti < 2) { float* o = PQ + (size_t)su * 4096 + (size_t)(32 * ti + 4 * hi) * 64 + 32 * tj + j32;
#pragma unroll
            for (int r = 0; r < 4; ++r)
#pragma unroll
                for (int e = 0; e < 4; ++e) o[(8 * r + e) * 64] = S[4 * r + e]; }
        else { float* o = PQ + ((size_t)RW_NSUP + su) * 4096 + (size_t)(32 * tj + j32) * 64 + 32 * (ti - 2) + 4 * hi;
#pragma unroll
            for (int r = 0; r < 4; ++r) *(f32x4*)(o + 8 * r) = (f32x4){S[4 * r], S[4 * r + 1], S[4 * r + 2], S[4 * r + 3]}; }
        }
        __syncthreads();
    }
    }
#undef WY_ROW
#undef WY_COL
#undef WY_A
}
__device__ __forceinline__ void ph_rw_scan_(const Ctx& C, int wg) {
    const float* Qg = (const float*)(C.ws + WS_PQ); const float* Pg = Qg + (size_t)RW_NSUP * 4096; float* SST = (float*)(C.ws + WS_SST);
    LAS bf16* PT = (LAS bf16*)(C.lds);
    LAS bf16* SLb = PT + 2 * 64 * MM_LP;
    LAS float* QL = (LAS float*)(C.lds + (2 * 64 * MM_LP + 2 * 16 * MM_LP) * 2);
    LAS float* SO = QL + 2 * 16 * 64;
    const int lane = C.lane, wave = C.wave, bh = wg >> 2, rq = wg & 3, ct = wave & 3, li = lane & 15, lq = lane >> 4;
    const bool mm = wave < 4;
    const size_t ubase = (size_t)bh * RW_NSC;
    const int lt = C.tid & 255;
    const int qrow = lt >> 4, qc4 = (lt & 15) * 4;
    constexpr int PD = 6;
    f32x4 pr[PD][4], qr[PD];
#define SC_P_PIECE(i) (lt + 256 * (i))
#define SC_PUT_P(buf, sx_) do { LAS bf16* d_ = PT + (buf) * (64 * MM_LP); _Pragma("unroll") for (int i_ = 0; i_ < 4; ++i_) { const int idx_ = SC_P_PIECE(i_), r_ = (idx_ * 4) >> 6, k_ = (idx_ * 4) & 63; u32x2 w_; \
        w_.x = cvt_pk_bf16(pr[sx_][i_].x, pr[sx_][i_].y); w_.y = cvt_pk_bf16(pr[sx_][i_].z, pr[sx_][i_].w); *(LAS u32x2*)(d_ + r_ * MM_LP + k_) = w_; } } while (0)
#define SC_LOAD(sx_, cc) do { const f32x4* p4_ = (const f32x4*)(Pg + (ubase + (cc)) * 4096); _Pragma("unroll") for (int i_ = 0; i_ < 4; ++i_) pr[sx_][i_] = p4_[SC_P_PIECE(i_)]; \
        qr[sx_] = *(const f32x4*)(Qg + (ubase + (cc)) * 4096 + (rq * 16 + qrow) * 64 + qc4); } while (0)
    if (mm) {
#pragma unroll
        for (int r = 0; r < 4; ++r) SLb[(4 * lq + r) * MM_LP + ct * 16 + li] = (bf16)0;
    } else {
        { float z0; asm volatile("v_mov_b32 %0, 0" : "=v"(z0));
          *(f32x4*)(SST + ubase * 4096 + (rq * 16 + qrow) * 64 + qc4) = (f32x4){z0, z0, z0, z0}; }
        SC_LOAD(0, 0); SC_PUT_P(0, 0); *(LAS f32x4*)(QL + qrow * 64 + qc4) = qr[0];
#pragma unroll
        for (int x = 0; x < PD; ++x) SC_LOAD(x, 1 + x);
    }
    __syncthreads();
#pragma unroll 1
    for (int c2 = 0; c2 < RW_NSC; c2 += PD) {
#pragma unroll
        for (int x = 0; x < PD; ++x) {
            const int c = c2 + x;
            if (c < RW_NSC) {
            if (mm) {
                const LAS bf16* Pc = PT + (c & 1) * (64 * MM_LP); const LAS bf16* Sc = SLb + (c & 1) * (16 * MM_LP); const LAS float* Qc = QL + (c & 1) * (16 * 64);
                LAS bf16* Sn = SLb + ((c + 1) & 1) * (16 * MM_LP); LAS float* So = SO + ((c + 1) & 1) * (16 * 64);
                bf16x8 af[2], bfr[2];
#pragma unroll
                for (int ks = 0; ks < 2; ++ks) { af[ks] = *(const LAS bf16x8*)(Sc + li * MM_LP + 32 * ks + 8 * lq); bfr[ks] = *(const LAS bf16x8*)(Pc + (16 * ct + li) * MM_LP + 32 * ks + 8 * lq); }
                f32x4 acc;
#pragma unroll
                for (int r = 0; r < 4; ++r) acc[r] = Qc[(4 * lq + r) * 64 + ct * 16 + li];
#pragma unroll
                for (int ks = 0; ks < 2; ++ks) acc = __builtin_amdgcn_mfma_f32_16x16x32_bf16(af[ks], bfr[ks], acc, 0, 0, 0);
                if (c + 1 < RW_NSC) {
#pragma unroll
                    for (int r = 0; r < 4; ++r) { Sn[(4 * lq + r) * MM_LP + ct * 16 + li] = f2bf(acc[r]); So[(4 * lq + r) * 64 + ct * 16 + li] = acc[r]; } }
            } else {
                if (c > 0) *(f32x4*)(SST + (ubase + c) * 4096 + (rq * 16 + qrow) * 64 + qc4) = *(const LAS f32x4*)(SO + (c & 1) * (16 * 64) + qrow * 64 + qc4);
                if (c + 1 < RW_NSC) { SC_PUT_P((c + 1) & 1, x); *(LAS f32x4*)(QL + ((c + 1) & 1) * (16 * 64) + qrow * 64 + qc4) = qr[x]; }
                if (c + 1 + PD < RW_NSC) SC_LOAD(x, c + 1 + PD);
            }
            __syncthreads();
#ifdef SCAN_2BAR
            __syncthreads();
#endif
            }
        }
    }
#undef SC_PUT_P
#undef SC_LOAD
#undef SC_P_PIECE
}
__device__ __forceinline__ void ph_rw_out_(const Ctx& C, int l) {
    const bf16* RKVS = (const bf16*)(C.ws + WS_RKVS); const bf16* AG = (const bf16*)(C.ws + WS_AG); const bf16* Y0 = (const bf16*)(C.ws + WS_Y0); const bf16* RH = (const bf16*)(C.ws + WS_RHAT);
    const float* SST = (const float*)(C.ws + WS_SST); const float* BON = (const float*)(C.ws + WS_BON); bf16* Y = (bf16*)(C.ws + WS_Y);
    LAS float* RL = (LAS float*)(C.lds);
    const int lane = C.lane, wave = C.wave;
    for (int u = C.bid; u < RW_NU; u += C.G) {
        const int bh = u >> 8, ch = u & 255, b = bh >> 2, h = bh & 3, m0 = b * SEQ + ch * RWC, hc = h * 64 + lane;
        { const int t = C.tid >> 3, d0 = (C.tid & 7) * 8; float a[8];
          unpack8(*(const u32x4*)(RH + (size_t)(m0 + t) * 256 + h * 64 + d0), a);
#pragma unroll
          for (int e = 0; e < 8; ++e) RL[t * 64 + d0 + e] = a[e]; }
        float s[64];
        { const f32x4* sp = (const f32x4*)(SST + (size_t)u * 4096 + lane * 64);
#pragma unroll
          for (int k4 = 0; k4 < 16; ++k4) { const f32x4 v = sp[k4]; s[4 * k4] = v.x; s[4 * k4 + 1] = v.y; s[4 * k4 + 2] = v.z; s[4 * k4 + 3] = v.w; } }
        const float lnw = C.in[I_RW_LNW][l * 256 + hc], lnb = C.in[I_RW_LNB][l * 256 + hc];
        __syncthreads();
#pragma unroll 2
        for (int q = 0; q < 8; ++q) { const int t = wave * 8 + q; const size_t m = (size_t)(m0 + t);
            const LAS f32x4* rv = (const LAS f32x4*)(RL + t * 64);
            float y0 = 0.f, y1 = 0.f, y2 = 0.f, y3 = 0.f;
#pragma unroll
            for (int k4 = 0; k4 < 16; ++k4) { const f32x4 rq = rv[k4]; y0 += s[4 * k4] * rq.x; y1 += s[4 * k4 + 1] * rq.y; y2 += s[4 * k4 + 2] * rq.z; y3 += s[4 * k4 + 3] * rq.w; }
#ifndef RWDBG
#define RWDBG 0
#endif
            float y = ((RWDBG & 1) ? 0.f : (y0 + y1) + (y2 + y3)) + ((RWDBG & 2) ? 0.f : bf2f(Y0[m * 256 + hc]));
            const float mean = wave_sum(y, C.lane) * (1.f / 64.f); y -= mean;
            const float rstd = 1.0f / sqrtf(wave_sum(y * y, C.lane) * (1.f / 64.f) + 64e-5f);
            y = y * rstd * lnw + lnb;
            if (!(RWDBG & 4)) y += BON[m * 4 + h] * bf2f(RKVS[m * 768 + 512 + hc]);
            y *= bf2f(AG[m * 512 + 256 + hc]);
            if (RWDBG & 120) { y = 0.f; if (RWDBG & 8) y += ((const float*)(C.ws + WS_WDEC))[m * 256 + hc]; if (RWDBG & 16) y += bf2f(AG[m * 512 + hc]);
                if (RWDBG & 32) y += bf2f(RKVS[m * 768 + hc]) + bf2f(RKVS[m * 768 + 256 + hc]) + bf2f(RKVS[m * 768 + 512 + hc]); if (RWDBG & 64) y += BON[m * 4 + h]; }
            Y[m * 1024 + hc] = f2bf(y); }
        __syncthreads();
    }
}

constexpr int SB_VLD = 40;
__device__ __forceinline__ void ph_sb_attn_(const Ctx& C, int first_wg, int nwg) {
    const bf16* SB = (const bf16*)(C.ws + WS_SB); bf16* Y = (bf16*)(C.ws + WS_Y);
    const int lane = C.lane, j = lane & 31, hi = lane >> 5;
    LAS bf16* VT = (LAS bf16*)(C.lds + C.wave * (64 * SB_VLD * 2));
    for (int it = C.bid - first_wg; it < 512; it += nwg) {
        const int bh = it >> 6, b = bh >> 2, h = bh & 3, t0 = (it & 63) * 256 + C.wave * 32; const size_t mb = (size_t)b * SEQ;
        bf16x8 qf[4];
#pragma unroll
        for (int ks = 0; ks < 4; ++ks) qf[ks] = *(const bf16x8*)(SB + (mb + t0 + j) * 768 + h * 64 + 16 * ks + 8 * hi);
        f32x16 o0, o1;
#pragma unroll
        for (int i = 0; i < 16; ++i) { o0[i] = 0.f; o1[i] = 0.f; }
        float acc = 0.f;
#pragma unroll 1
        for (int kt = t0; kt >= 0; kt -= 32) {
            bf16x8 kf[4];
#pragma unroll
            for (int ks = 0; ks < 4; ++ks) kf[ks] = *(const bf16x8*)(SB + (mb + kt + j) * 768 + 256 + h * 64 + 16 * ks + 8 * hi);
            u32x4 vv[4];
#pragma unroll
            for (int i = 0; i < 4; ++i) { const int c = lane + 64 * i; vv[i] = *(const u32x4*)(SB + (mb + kt + (c >> 3)) * 768 + 512 + h * 64 + (c & 7) * 8); }
            f32x16 sc;
#pragma unroll
            for (int i = 0; i < 16; ++i) sc[i] = 0.f;
#pragma unroll
            for (int ks = 0; ks < 4; ++ks) sc = __builtin_amdgcn_mfma_f32_32x32x16_bf16(kf[ks], qf[ks], sc, 0, 0, 0);
#pragma unroll
            for (int i = 0; i < 4; ++i) { const int c = lane + 64 * i, key = c >> 3, d8 = (c & 7) * 8; const unsigned w[4] = {vv[i].x, vv[i].y, vv[i].z, vv[i].w};
#pragma unroll
                for (int e = 0; e < 4; ++e) { VT[(d8 + 2 * e) * SB_VLD + key] = (bf16)(w[e] & 0xffffu); VT[(d8 + 2 * e + 1) * SB_VLD + key] = (bf16)(w[e] >> 16); } }
            const bool diag = (kt == t0);
            float ls[16], g[4], og[4];
#pragma unroll
            for (int r = 0; r < 4; ++r) { g[r] = 0.f;
#pragma unroll
                for (int e = 0; e < 4; ++e) { const float z = sc[4 * r + e]; const bool valid = !diag || (8 * r + 4 * hi + e) < j;
                    const float l = (z > 40.f) ? -z : -__builtin_amdgcn_logf(1.f + __builtin_amdgcn_exp2f(z));
                    ls[4 * r + e] = valid ? l : 0.f; g[r] += ls[4 * r + e]; } }
#pragma unroll
            for (int r = 0; r < 4; ++r) og[r] = shx(g[r], 32, lane);
            float pw[16]; float run = acc;
#pragma unroll
            for (int r = 3; r >= 0; --r) { float cum = run + (hi == 0 ? og[r] : 0.f);
#pragma unroll
                for (int e = 3; e >= 0; --e) { cum += ls[4 * r + e]; const bool valid = !diag || (8 * r + 4 * hi + e) < j;
                    pw[4 * r + e] = valid ? __builtin_amdgcn_exp2f(sc[4 * r + e] + cum) : 0.f; }
                run += g[r] + og[r]; }
            acc = run;
            asm volatile("" ::: "memory");
#pragma unroll
            for (int ks = 0; ks < 2; ++ks) {
                u32x4 pk; pk.x = cvt_pk_bf16(pw[8 * ks], pw[8 * ks + 1]); pk.y = cvt_pk_bf16(pw[8 * ks + 2], pw[8 * ks + 3]); pk.z = cvt_pk_bf16(pw[8 * ks + 4], pw[8 * ks + 5]); pk.w = cvt_pk_bf16(pw[8 * ks + 6], pw[8 * ks + 7]);
                const bf16x8 pb = __builtin_bit_cast(bf16x8, pk);
                const s16x4 a0l = *(const LAS s16x4*)(VT + j * SB_VLD + 16 * ks + 4 * hi), a0h = *(const LAS s16x4*)(VT + j * SB_VLD + 16 * ks + 8 + 4 * hi);
                const s16x4 a1l = *(const LAS s16x4*)(VT + (32 + j) * SB_VLD + 16 * ks + 4 * hi), a1h = *(const LAS s16x4*)(VT + (32 + j) * SB_VLD + 16 * ks + 8 + 4 * hi);
                const bf16x8 va0 = __builtin_shufflevector(a0l, a0h, 0, 1, 2, 3, 4, 5, 6, 7), va1 = __builtin_shufflevector(a1l, a1h, 0, 1, 2, 3, 4, 5, 6, 7);
                o0 = __builtin_amdgcn_mfma_f32_32x32x16_bf16(va0, pb, o0, 0, 0, 0);
                o1 = __builtin_amdgcn_mfma_f32_32x32x16_bf16(va1, pb, o1, 0, 0, 0);
            }
            asm volatile("" ::: "memory");
            if (__builtin_amdgcn_ballot_w64(acc > -140.f) == 0ull) break;
        }
        bf16* yp = Y + (mb + t0 + j) * 1024 + 256 + h * 64 + 4 * hi;
#pragma unroll
        for (int r = 0; r < 4; ++r) { u32x2 w0, w1; w0.x = cvt_pk_bf16(o0[4 * r], o0[4 * r + 1]); w0.y = cvt_pk_bf16(o0[4 * r + 2], o0[4 * r + 3]); w1.x = cvt_pk_bf16(o1[4 * r], o1[4 * r + 1]); w1.y = cvt_pk_bf16(o1[4 * r + 2], o1[4 * r + 3]);
            *(u32x2*)(yp + 8 * r) = w0; *(u32x2*)(yp + 32 + 8 * r) = w1; }
    }
}


__device__ __forceinline__ f32x16 mm_tile(const LAS bf16* X, const LAS bf16* Y, int ti, int tj, int lane) {
    const int j = lane & 31, hi = lane >> 5; f32x16 acc;
#pragma unroll
    for (int i = 0; i < 16; ++i) acc[i] = 0.f;
#pragma unroll
    for (int ks = 0; ks < 4; ++ks) { const bf16x8 a = *(const LAS bf16x8*)(X + (32 * ti + j) * MM_LP + 16 * ks + 8 * hi), b = *(const LAS bf16x8*)(Y + (32 * tj + j) * MM_LP + 16 * ks + 8 * hi);
        acc = __builtin_amdgcn_mfma_f32_32x32x16_bf16(a, b, acc, 0, 0, 0); }
    return acc;
}
__device__ __forceinline__ void ln_pair_stats(const f32x16& x, LAS float* XCH, int tr, int tt, int lane, float eps, float& mean, float& rstd) {
    const int j = lane & 31, hi = lane >> 5; float s1 = 0.f, s2 = 0.f;
#pragma unroll
    for (int i = 0; i < 16; ++i) { s1 += x[i]; s2 += x[i] * x[i]; }
    s1 += shx(s1, 32, lane); s2 += shx(s2, 32, lane);
    if (hi == 0) { XCH[(tr * 64 + 32 * tt + j) * 2] = s1; XCH[(tr * 64 + 32 * tt + j) * 2 + 1] = s2; }
    __syncthreads();
    const float a1 = XCH[(32 * tt + j) * 2] + XCH[(64 + 32 * tt + j) * 2], a2 = XCH[(32 * tt + j) * 2 + 1] + XCH[(64 + 32 * tt + j) * 2 + 1];
    mean = a1 * (1.f / 64.f); const float var = fmaxf(a2 * (1.f / 64.f) - mean * mean, 0.f); rstd = 1.0f / sqrtf(var + eps);
}
__device__ __forceinline__ void rot_store(const Ctx& C, const bf16* src  , int pos, int d0, float scale, LAS bf16* dstrow) {
    const float* cs = (const float*)(C.ws + WS_COS) + (size_t)pos * 32 + d0; const float* sn = (const float*)(C.ws + WS_SIN) + (size_t)pos * 32 + d0;
    float x1[8], x2[8]; unpack8(*(const u32x4*)(src + d0), x1); unpack8(*(const u32x4*)(src + 32 + d0), x2);
    const f32x4 c0 = *(const f32x4*)cs, c1 = *(const f32x4*)(cs + 4), s0 = *(const f32x4*)sn, s1 = *(const f32x4*)(sn + 4);
    const float cc[8] = {c0.x, c0.y, c0.z, c0.w, c1.x, c1.y, c1.z, c1.w}, ss[8] = {s0.x, s0.y, s0.z, s0.w, s1.x, s1.y, s1.z, s1.w};
    float o1[8], o2[8];
#pragma unroll
    for (int e = 0; e < 8; ++e) { o1[e] = (x1[e] * cc[e] - x2[e] * ss[e]) * scale; o2[e] = (x1[e] * ss[e] + x2[e] * cc[e]) * scale; }
    *(LAS u32x4*)(dstrow + d0) = pack8(o1); *(LAS u32x4*)(dstrow + 32 + d0) = pack8(o2);
}

__device__ __forceinline__ void ph_ret_kv2_(const Ctx& C) {
    const bf16* RET = (const bf16*)(C.ws + WS_RET); float* KV = (float*)(C.ws + WS_KV);
    const int half = C.wave >> 2, w4 = C.wave & 3, th = C.tid & 255, lane = C.lane;
    LAS bf16* KT = (LAS bf16*)(C.lds + half * 36864);
    LAS bf16* VT = KT + 64 * MM_LP;
    LAS bf16* KR = VT + 64 * MM_LP;
    for (int it = C.bid; it < 1024; it += C.G) {
        const int u = it * 2 + half, bh = u >> 8, ch = u & 255, b = bh >> 2, h = bh & 3, m0 = b * SEQ + ch * 64;
        const float lg = ret_log2gamma(h);
        { const int srow = th >> 2, dq = th & 3; const size_t m = (size_t)(m0 + srow);
          rot_store(C, RET + m * 1024 + 256 + h * 64, (int)(m & (SEQ - 1)), dq * 8, 0.125f * exp2f(lg * (float)(63 - srow)), KR + srow * MM_LP);
          float a[8];
#pragma unroll
          for (int q = 0; q < 2; ++q) { const int e0 = dq * 16 + q * 8; unpack8(*(const u32x4*)(RET + m * 1024 + 512 + h * 64 + e0), a);
#pragma unroll
              for (int e = 0; e < 8; ++e) VT[(e0 + e) * MM_LP + srow] = f2bf(a[e]); } }
        __syncthreads();
        { const int d = th >> 2, s0 = (th & 3) * 16;
#pragma unroll
          for (int i = 0; i < 16; ++i) KT[d * MM_LP + s0 + i] = KR[(s0 + i) * MM_LP + d]; }
        __syncthreads();
        { const int ti = w4 >> 1, tj = w4 & 1, j = lane & 31, hi = lane >> 5;
          const f32x16 acc = mm_tile(VT, KT, ti, tj, lane);
          float* o = KV + (size_t)u * 4096 + (size_t)(32 * ti + 4 * hi) * 64 + 32 * tj + j;
#pragma unroll
          for (int r = 0; r < 4; ++r)
#pragma unroll
              for (int e = 0; e < 4; ++e) o[(8 * r + e) * 64] = acc[4 * r + e]; }
        __syncthreads();
    }
}
__device__ __forceinline__ void ph_ret_out2_(const Ctx& C, int l, int first_wg, int nwg) {
    const bf16* RET = (const bf16*)(C.ws + WS_RET); const float* KV = (const float*)(C.ws + WS_KV); bf16* Y = (bf16*)(C.ws + WS_Y);
    const int half = C.wave >> 2, w4 = C.wave & 3, th = C.tid & 255, lane = C.lane, j = lane & 31, hi = lane >> 5, te = w4 >> 1, tt = w4 & 1;
    LAS bf16* QL = (LAS bf16*)(C.lds + half * 40960);
    LAS bf16* KL = QL + 64 * MM_LP;
    LAS bf16* VT = KL + 64 * MM_LP;
    LAS bf16* ST = VT + 64 * MM_LP;
    LAS float* XCH = (LAS float*)(C.lds + half * 40960 + 4 * 64 * MM_LP * 2);
    const float* gn = C.in[I_RET_GN] + (size_t)l * 256;
    for (int it = C.bid - first_wg; it < 1024; it += nwg) {
        const int u = it * 2 + half, bh = u >> 8, ch = u & 255, b = bh >> 2, h = bh & 3, m0 = b * SEQ + ch * 64;
        const float lg = ret_log2gamma(h);
        { const int srow = th >> 2, dq = th & 3; const size_t m = (size_t)(m0 + srow); const int pos = (int)(m & (SEQ - 1));
          rot_store(C, RET + m * 1024 + h * 64, pos, dq * 8, 1.0f, QL + srow * MM_LP);
          rot_store(C, RET + m * 1024 + 256 + h * 64, pos, dq * 8, 0.125f, KL + srow * MM_LP);
          float a[8];
#pragma unroll
          for (int q = 0; q < 2; ++q) { const int e0 = dq * 16 + q * 8; unpack8(*(const u32x4*)(RET + m * 1024 + 512 + h * 64 + e0), a);
#pragma unroll
              for (int e = 0; e < 8; ++e) VT[(e0 + e) * MM_LP + srow] = f2bf(a[e]); }
          const float* sp = KV + (size_t)u * 4096 + srow * 64 + dq * 16;
          float sv[16];
#pragma unroll
          for (int q = 0; q < 4; ++q) { const f32x4 v4 = *(const f32x4*)(sp + 4 * q); sv[4 * q] = v4.x; sv[4 * q + 1] = v4.y; sv[4 * q + 2] = v4.z; sv[4 * q + 3] = v4.w; }
          *(LAS u32x4*)(ST + srow * MM_LP + dq * 16) = pack8(sv); *(LAS u32x4*)(ST + srow * MM_LP + dq * 16 + 8) = pack8(sv + 8); }
        __syncthreads();
        f32x16 acc = mm_tile(ST, QL, te, tt, lane);
        { const float qd = exp2f(lg * (float)(32 * tt + j + 1));
#pragma unroll
          for (int i = 0; i < 16; ++i) acc[i] *= qd; }
#pragma unroll
        for (int st = 0; st < 2; ++st) {
            if (st > tt) continue;
            const f32x16 sc = mm_tile(KL, QL, st, tt, lane);
            float pw[16];
#pragma unroll
            for (int r = 0; r < 4; ++r)
#pragma unroll
                for (int e = 0; e < 4; ++e) { const int sk = 32 * st + 8 * r + 4 * hi + e, tq = 32 * tt + j;
                    pw[4 * r + e] = (sk <= tq) ? sc[4 * r + e] * exp2f(lg * (float)(tq - sk)) : 0.f; }
#pragma unroll
            for (int ks = 0; ks < 2; ++ks) {
                u32x4 pk; pk.x = cvt_pk_bf16(pw[8 * ks], pw[8 * ks + 1]); pk.y = cvt_pk_bf16(pw[8 * ks + 2], pw[8 * ks + 3]); pk.z = cvt_pk_bf16(pw[8 * ks + 4], pw[8 * ks + 5]); pk.w = cvt_pk_bf16(pw[8 * ks + 6], pw[8 * ks + 7]);
                const bf16x8 pb = __builtin_bit_cast(bf16x8, pk);
                const LAS bf16* vr = VT + (32 * te + j) * MM_LP + 32 * st + 16 * ks + 4 * hi;
                const s16x4 al = *(const LAS s16x4*)vr, ah = *(const LAS s16x4*)(vr + 8);
                const bf16x8 va = __builtin_shufflevector(al, ah, 0, 1, 2, 3, 4, 5, 6, 7);
                acc = __builtin_amdgcn_mfma_f32_32x32x16_bf16(va, pb, acc, 0, 0, 0);
            }
        }
        float mean, rstd; ln_pair_stats(acc, XCH, te, tt, lane, 1e-5f, mean, rstd);
        { const size_t m = (size_t)(m0 + 32 * tt + j); const bf16* gp = RET + m * 1024 + 768 + h * 64 + 32 * te + 4 * hi; bf16* yp = Y + m * 1024 + 512 + h * 64 + 32 * te + 4 * hi;
          const float* gw = gn + h * 64 + 32 * te + 4 * hi;
#pragma unroll
          for (int r = 0; r < 4; ++r) { const u32x2 gt2 = *(const u32x2*)(gp + 8 * r); const float gtv[4] = {bflo(gt2.x), bfhi(gt2.x), bflo(gt2.y), bfhi(gt2.y)}; const f32x4 gwv = *(const f32x4*)(gw + 8 * r);
              float o[4];
#pragma unroll
              for (int e = 0; e < 4; ++e) o[e] = (acc[4 * r + e] - mean) * rstd * gwv[e] * (gtv[e] * sigm(gtv[e]));
              u32x2 w; w.x = cvt_pk_bf16(o[0], o[1]); w.y = cvt_pk_bf16(o[2], o[3]); *(u32x2*)(yp + 8 * r) = w; } }
        __syncthreads();
    }
}
__device__ __forceinline__ void ph_rw_out2_(const Ctx& C, int l) {
    const bf16* RKVS = (const bf16*)(C.ws + WS_RKVS); const bf16* AG = (const bf16*)(C.ws + WS_AG); const bf16* Y0 = (const bf16*)(C.ws + WS_Y0); const bf16* RH = (const bf16*)(C.ws + WS_RHAT);
    const float* SST = (const float*)(C.ws + WS_SST); const float* BON = (const float*)(C.ws + WS_BON); bf16* Y = (bf16*)(C.ws + WS_Y);
    const int half = C.wave >> 2, w4 = C.wave & 3, th = C.tid & 255, lane = C.lane, j = lane & 31, hi = lane >> 5, tv = w4 >> 1, tt = w4 & 1;
    LAS bf16* SL = (LAS bf16*)(C.lds + half * 20480);
    LAS bf16* RL = SL + 64 * MM_LP;
    LAS float* XCH = (LAS float*)(C.lds + half * 20480 + 2 * 64 * MM_LP * 2);
    for (int it = C.bid; it < RW_NU / 2; it += C.G) {
        const int u = it * 2 + half, bh = u >> 8, ch = u & 255, b = bh >> 2, h = bh & 3, m0 = b * SEQ + ch * RWC;
        { const int row = th >> 2, q4 = th & 3;
          const float* sp = SST + (size_t)(u >> 3) * 4096 + row * 64 + q4 * 16; float sv[16];
#pragma unroll
          for (int q = 0; q < 4; ++q) { const f32x4 v4 = *(const f32x4*)(sp + 4 * q); sv[4 * q] = v4.x; sv[4 * q + 1] = v4.y; sv[4 * q + 2] = v4.z; sv[4 * q + 3] = v4.w; }
          *(LAS u32x4*)(SL + row * MM_LP + q4 * 16) = pack8(sv); *(LAS u32x4*)(SL + row * MM_LP + q4 * 16 + 8) = pack8(sv + 8);
          const u32x4* rp = (const u32x4*)(RH + (size_t)(m0 + row) * 256 + h * 64 + q4 * 16);
          *(LAS u32x4*)(RL + row * MM_LP + q4 * 16) = rp[0]; *(LAS u32x4*)(RL + row * MM_LP + q4 * 16 + 8) = rp[1]; }
        __syncthreads();
        f32x16 acc = mm_tile(SL, RL, tv, tt, lane);
        const size_t m = (size_t)(m0 + 32 * tt + j); const int vb = h * 64 + 32 * tv + 4 * hi;
#pragma unroll
        for (int r = 0; r < 4; ++r) { const u32x2 y2 = *(const u32x2*)(Y0 + m * 256 + vb + 8 * r); acc[4 * r] += bflo(y2.x); acc[4 * r + 1] += bfhi(y2.x); acc[4 * r + 2] += bflo(y2.y); acc[4 * r + 3] += bfhi(y2.y); }
        float mean, rstd; ln_pair_stats(acc, XCH, tv, tt, lane, 64e-5f, mean, rstd);
        const float bon = BON[m * 4 + h];
#pragma unroll
        for (int r = 0; r < 4; ++r) { const int vc = vb + 8 * r;
            const f32x4 lw = *(const f32x4*)(C.in[I_RW_LNW] + (size_t)l * 256 + vc), lb = *(const f32x4*)(C.in[I_RW_LNB] + (size_t)l * 256 + vc);
            const u32x2 v2 = *(const u32x2*)(RKVS + m * 768 + 512 + vc), g2 = *(const u32x2*)(AG + m * 512 + 256 + vc);
            const float vv[4] = {bflo(v2.x), bfhi(v2.x), bflo(v2.y), bfhi(v2.y)}, gg[4] = {bflo(g2.x), bfhi(g2.x), bflo(g2.y), bfhi(g2.y)};
            float o[4];
#pragma unroll
            for (int e = 0; e < 4; ++e) o[e] = ((acc[4 * r + e] - mean) * rstd * lw[e] + lb[e] + bon * vv[e]) * gg[e];
            u32x2 w; w.x = cvt_pk_bf16(o[0], o[1]); w.y = cvt_pk_bf16(o[2], o[3]); *(u32x2*)(Y + m * 1024 + vc) = w; }
        __syncthreads();
    }
}

__device__ __forceinline__ void ph_moe_scatter_(const Ctx& C, int moe_idx) {
    unsigned* cw = (unsigned*)(C.ws + WS_CTL) + CW_MOE + moe_idx * 64;
    const int* eidx = (const int*)(C.ws + WS_EIDX); const float* gate = (const float*)(C.ws + WS_GATE);
    int* rowtok = (int*)(C.ws + WS_ROWTOK); float* rowgate = (float*)(C.ws + WS_ROWGATE); int* texp = (int*)(C.ws + WS_TEXP); int* segend = (int*)(C.ws + WS_SEGEND); int* ntp = (int*)(C.ws + WS_NT);
    const bf16* H = (const bf16*)(C.ws + WS_H); bf16* XS = (bf16*)(C.ws + WS_XS);
    LAS unsigned* lcnt = (LAS unsigned*)(C.lds); LAS unsigned* lbase = lcnt + 8; LAS int* sl = (LAS int*)(C.lds + 256);
    int cnt[8], segb[8]; int tot = 0;
#pragma unroll
    for (int e = 0; e < 8; ++e) { cnt[e] = (int)__hip_atomic_load(&cw[e], __ATOMIC_RELAXED, __HIP_MEMORY_SCOPE_AGENT); segb[e] = tot; tot += (cnt[e] + 255) & ~255; }
    if (C.bid == 0) {
        if (C.tid < 8) { const int e = C.tid; int sb = 0, ce = 0;
#pragma unroll
            for (int q = 0; q < 8; ++q) if (q == e) { sb = segb[q]; ce = cnt[q]; }
            for (int pm = sb >> 8; pm < ((sb + ((ce + 255) & ~255)) >> 8); ++pm) { texp[pm] = e; segend[pm] = sb + ce; } }
        if (C.tid == 0) *ntp = tot >> 8;
    }
    for (int blk = C.bid; blk < T / 256; blk += C.G) {
        __syncthreads();
        if (C.tid < 8) lcnt[C.tid] = 0u;
        __syncthreads();
        const int a = blk * 512 + C.tid, e = eidx[a];
        const unsigned rank = atomicAdd((unsigned*)&lcnt[e], 1u);
        __syncthreads();
        if (C.tid < 8) lbase[C.tid] = atomicAdd(&cw[16 + C.tid], lcnt[C.tid]);
        __syncthreads();
        int sb = 0;
#pragma unroll
        for (int q = 0; q < 8; ++q) if (q == e) sb = segb[q];
        const int slot = sb + (int)lbase[e] + (int)rank;
        rowtok[slot] = a >> 1; rowgate[slot] = gate[a]; sl[C.tid] = slot; ((int*)(C.ws + WS_SLOTOF))[a] = slot;
        __syncthreads();
        for (int i = C.wave; i < 512; i += NWAVES) { const int s2 = sl[i]; const u32x4* src = (const u32x4*)(C.ws + WS_H8 + (size_t)(blk * 256 + (i >> 1)) * D); u32x4* dst = (u32x4*)(C.ws + WS_XS + (size_t)s2 * D);
            dst[C.lane] = src[C.lane]; }
    }
}

__device__ __forceinline__ void grid_barrier(int wv) {
    const Ctx C = make_ctx(wv);
    XcdBarrier b; b.bar = (unsigned*)(C.ws + WS_CTL) + CW_BAR; b.x = xb_xcc_id(); b.st = (volatile LAS unsigned*)(C.lds + MISC_OFF) + 8;
    xcd_barrier(b, C.tid);
}
__device__ __forceinline__ void P_prologue(int wv) { const Ctx C = make_ctx(wv); ph_prologue_(C); }
__device__ __forceinline__ void P_weights_norm(int wv, int l) { const Ctx C = make_ctx(wv); ph_weights_(C, l, 0, 0, C.G); __syncthreads(); ph_norm_(C, C.in[I_NORM_MIX] + (size_t)l * D, false, nullptr, 0,  (l > 0) && ((l - 1) & 1), l == 0 ? C.in[I_X] : nullptr); }
__device__ __forceinline__ void P_gemm_in(int wv) { const Ctx C = make_ctx(wv); using namespace pg8; unsigned char* ws = C.ws;
    Gemm g{(const bf16*)(ws + WS_H), (const bf16*)(ws + WS_WIN), D, D}; StaticOrder S; S.init(T, NIN, C.G, C.bid);
    EpiRoute E{(bf16*)(ws + WS_RW), (bf16*)(ws + WS_SB), (bf16*)(ws + WS_RET), (bf16*)(ws + WS_CV)};
    gemm_phase<EpiRoute, StaticOrder, true>(C.lds, C.tid, g, S, E); }
#define REP2(bit, stmt) do { stmt; if constexpr ((PROBE2 >> (bit)) & 1) { __syncthreads(); stmt; } } while (0)
__device__ __forceinline__ void P_mix1(int wv, int l) { REP2(2, { const Ctx C = make_ctx(wv); ph_rw_prep_(C, l); }); { const Ctx C = make_ctx(wv); ph_sb_prep_(C, l); } REP2(3, { const Ctx C = make_ctx(wv); ph_conv_(C, l); }); REP2(4, { const Ctx C = make_ctx(wv); ph_ret_kv2_(C); }); }
__device__ __forceinline__ void P_mix2(int wv, int l) { { const Ctx C = make_ctx(wv); using namespace pg8; unsigned char* ws = C.ws;
    Gemm g{(const bf16*)(ws + WS_ALORA), (const bf16*)(ws + WS_WLORA), 256, 256}; StaticOrder S; S.init(T, 768, C.G, C.bid);
    EpiLora E{(float*)(ws + WS_WDEC), (bf16*)(ws + WS_AG), C.in[I_RW_W0] + (size_t)l * 256, C.in[I_RW_A0] + (size_t)l * 256};
    gemm_phase<EpiLora, StaticOrder, true>(C.lds, C.tid, g, S, E); }
    { const Ctx C = make_ctx(wv); ph_ret_scan_(C); } }
#ifndef MIX3_SEL
#define MIX3_SEL 3
#endif
__device__ __forceinline__ void P_mix3(int wv, int l) { REP2(0, { const Ctx C = make_ctx(wv); ph_rw_local_wy_(C, l); }); }
__device__ __forceinline__ void P_mix4(int wv, int l) { const Ctx C = make_ctx(wv);
    if (C.G >= 64) { if (C.bid < 32) { REP2(6, ph_rw_scan_(C, C.bid)); } else { REP2(7, ph_sb_attn_(C, 32, C.G - 32)); __syncthreads(); REP2(1, ph_ret_out2_(C, l, 32, C.G - 32)); __syncthreads(); ph_weights_(C, l, 1, 32, C.G - 32); } }
    else { for (int w = C.bid; w < 32; w += C.G) { ph_rw_scan_(C, w); __syncthreads(); } ph_sb_attn_(C, 0, C.G); __syncthreads(); ph_ret_out2_(C, l, 0, C.G); __syncthreads(); ph_weights_(C, l, 1, 0, C.G); } }
__device__ __forceinline__ void P_mix5(int wv, int l) { REP2(5, { const Ctx C = make_ctx(wv); ph_rw_out2_(C, l); }); }
__device__ __forceinline__ void P_gemm_branch(int wv) { const Ctx C = make_ctx(wv); using namespace pg8; unsigned char* ws = C.ws;
    Gemm g{(const bf16*)(ws + WS_Y), (const bf16*)(ws + WS_WB), D, 256}; StaticOrder S; S.init(T, 4096, C.G, C.bid, 2, 512);
    EpiBf16 E{(bf16*)(ws + WS_BALL), 4096, 0xffff, 1.0f};
    gemm_phase<EpiBf16, StaticOrder, false>(C.lds, C.tid, g, S, E); }
__device__ __forceinline__ void P_gemm_gate(int wv) { const Ctx C = make_ctx(wv); using namespace pg8; unsigned char* ws = C.ws;
    Gemm g{(const bf16*)(ws + WS_H8), (const bf16*)(ws + WS_WG), D, D}; StaticOrder S; S.init(T, 4096, C.G, C.bid);
    EpiGateMerge E{(const bf16*)(ws + WS_BALL), (bf16*)(ws + WS_MERGED)};
    gemm_phase8<EpiGateMerge, StaticOrder, true>(C.lds, C.tid, g, S, E); }
__device__ __forceinline__ void P_gemm_out(int wv) { const Ctx C = make_ctx(wv); using namespace pg8; unsigned char* ws = C.ws;
    Gemm g{(const bf16*)(ws + WS_MERGED), (const bf16*)(ws + WS_WOUT), D, D}; StaticOrder S; S.init(T, D, C.G, C.bid);
    EpiResidual E{C.out, 1.0f};
    gemm_phase<EpiResidual, StaticOrder, false>(C.lds, C.tid, g, S, E); }
__device__ __forceinline__ void P_norm_ffn(int wv, int l) { const Ctx C = make_ctx(wv); ph_norm_(C, C.in[I_NORM_FFN] + (size_t)l * D, (l & 1) != 0, C.in[I_ROUTER] + (size_t)(l >> 1) * D * NEXP, l >> 1, false, nullptr,  false); }
__device__ __forceinline__ void P_ffn_up(int wv) { const Ctx C = make_ctx(wv); using namespace pg8; unsigned char* ws = C.ws;
    Gemm g{(const bf16*)(ws + WS_H8), (const bf16*)(ws + WS_W13), D, D}; StaticOrder S; S.init(T, 2 * DFF, C.G, C.bid);
    EpiSwiglu E{ws + WS_HID, DFF, 1 << 20, false};
    gemm_phase8<EpiSwiglu, StaticOrder, true>(C.lds, C.tid, g, S, E); }
__device__ __forceinline__ void P_ffn_down(int wv) { const Ctx C = make_ctx(wv); using namespace pg8; unsigned char* ws = C.ws;
    Gemm g{(const bf16*)(ws + WS_HID), (const bf16*)(ws + WS_W2D), DFF, DFF}; StaticOrder S; S.init(T, D, C.G, C.bid);
    EpiResidual E{C.out, F8_DESCALE_DOWN};
    gemm_phase8<EpiResidual, StaticOrder, false>(C.lds, C.tid, g, S, E); }
__device__ __forceinline__ void P_moe_scatter(int wv, int l2) { const Ctx C = make_ctx(wv); ph_moe_scatter_(C, l2); }
__device__ __forceinline__ void P_moe_up(int wv) { const Ctx C = make_ctx(wv); using namespace pg8; unsigned char* ws = C.ws;
    Gemm g{(const bf16*)(ws + WS_XS), (const bf16*)(ws + WS_W13), D, D};
    MoeOrder S{(const int*)(ws + WS_TEXP), __builtin_amdgcn_readfirstlane(*(const int*)(ws + WS_NT)), 2 * DFE / 256, C.G, C.bid};
    EpiSwiglu E{ws + WS_HIDM, DFE_PAD, 2 * DFE / 256, true};
    gemm_phase8<EpiSwiglu, MoeOrder, true>(C.lds, C.tid, g, S, E); }
__device__ __forceinline__ void P_moe_down(int wv) { const Ctx C = make_ctx(wv); using namespace pg8; unsigned char* ws = C.ws;
    Gemm g{(const bf16*)(ws + WS_HIDM), (const bf16*)(ws + WS_W2M), DFE_PAD, DFE_PAD};
    MoeOrder S{(const int*)(ws + WS_TEXP), __builtin_amdgcn_readfirstlane(*(const int*)(ws + WS_NT)), D / 256, C.G, C.bid};
    EpiBf16 E{(bf16*)(ws + WS_YS), D, 3, F8_DESCALE_DOWN};
    gemm_phase8<EpiBf16, MoeOrder, true>(C.lds, C.tid, g, S, E); }
__device__ __forceinline__ void P_moe_combine(int wv) { const Ctx C = make_ctx(wv);
    const int gw = C.bid * NWAVES + C.wave, NGW = C.G * NWAVES, lane = C.lane;
    const int* slotof = (const int*)(C.ws + WS_SLOTOF); const float* gate = (const float*)(C.ws + WS_GATE); const bf16* YS = (const bf16*)(C.ws + WS_YS);
    for (int m = gw; m < T; m += NGW) {
        const int s0 = slotof[2 * m], s1 = slotof[2 * m + 1]; const float g0 = gate[2 * m], g1 = gate[2 * m + 1];
        f32x4* xr = (f32x4*)(C.out + (size_t)m * D) + lane;
        const u32x2* y0 = (const u32x2*)(YS + (size_t)s0 * D) + lane; const u32x2* y1 = (const u32x2*)(YS + (size_t)s1 * D) + lane;
#pragma unroll
        for (int j = 0; j < 4; ++j) { f32x4 v = xr[64 * j]; const u32x2 a = y0[64 * j], b = y1[64 * j];
            v.x += g0 * bflo(a.x) + g1 * bflo(b.x); v.y += g0 * bfhi(a.x) + g1 * bfhi(b.x); v.z += g0 * bflo(a.y) + g1 * bflo(b.y); v.w += g0 * bfhi(a.y) + g1 * bfhi(b.y);
            xr[64 * j] = v; }
    }
}

#ifndef PROBE_MASK
#define PROBE_MASK 0u
#endif
#ifndef PH_MASK
#define PH_MASK 0xffffffffu
#endif
__global__ void __launch_bounds__(NTHR, 2) hybrid_fwd(Args args) {
    (void)args;
    const int wv = __builtin_amdgcn_readfirstlane(threadIdx.x >> 6);
    { LAS unsigned char* lds = (LAS unsigned char*)lds_raw;
      for (int u = threadIdx.x; u < (LDS_BYTES - RING_BYTES) / 4; u += NTHR) ((LAS unsigned*)(lds + RING_BYTES))[u] = 0u; }
    __syncthreads();
    { const CAS Args* ka = ka_ptr();
      if (ka->ph_hi - ka->ph_lo > 1) { (void)xcd_barrier_post((unsigned*)(ka->ws + WS_CTL) + CW_BAR, (volatile LAS unsigned*)((LAS unsigned char*)lds_raw + MISC_OFF) + 8); } }
    int gp = 0;
#define PHASE(k, call) { const CAS Args* ka_ = ka_ptr(); const int lo_ = ka_->ph_lo, hi_ = ka_->ph_hi; if (lo_ <= gp && gp < hi_) { if constexpr ((PH_MASK >> (k)) & 1u) { call; if constexpr ((PROBE_MASK >> (k)) & 1u) { __syncthreads(); call; } } if (hi_ - lo_ > 1 && gp + 1 < hi_) grid_barrier(wv); } ++gp; }
    PHASE(0, P_prologue(wv))
#pragma unroll 1
    for (int l = 0; l < NLAYER; ++l) {
        PHASE(1, P_weights_norm(wv, l))
        PHASE(2, P_gemm_in(wv))
        PHASE(3, P_mix1(wv, l))
        PHASE(4, P_mix2(wv, l))
        PHASE(5, P_mix3(wv, l))
        PHASE(6, P_mix4(wv, l))
        PHASE(7, P_mix5(wv, l))
        PHASE(8, P_gemm_branch(wv))
        PHASE(9, P_gemm_gate(wv))
        PHASE(10, P_gemm_out(wv))
        PHASE(11, P_norm_ffn(wv, l))
        if (!(l & 1)) {
            PHASE(12, P_ffn_up(wv))
            PHASE(13, P_ffn_down(wv))
            gp += 2;
        } else {
            PHASE(14, P_moe_scatter(wv, l >> 1))
            PHASE(15, P_moe_up(wv))
            PHASE(16, P_moe_down(wv))
            if (l == NLAYER - 1) { PHASE(17, P_moe_combine(wv)) } else { ++gp; }
        }
    }
#undef PHASE
}
constexpr int N_PHASES = 1 + NLAYER * 15;

#ifndef MK_MULTI
#define MK_MULTI 0
#endif
extern "C" void kernel_launch(void* const* d_in, const int* in_sizes, int n_in, void* d_out, int out_size, void* d_ws, size_t ws_size, hipStream_t stream) {
    static int grid = 0;
    if (grid == 0) {
        if (n_in != 32 || in_sizes[0] != T * D || out_size != T * D || ws_size < WS_END) { fprintf(stderr, "kernel_launch: unexpected problem shape / workspace (%d inputs, ws %zu)\n", n_in, ws_size); grid = -1; return; }
        int dev = 0, cus = 0, per_cu = 0;
        if (hipGetDevice(&dev) != hipSuccess || hipDeviceGetAttribute(&cus, hipDeviceAttributeMultiprocessorCount, dev) != hipSuccess) { grid = -1; return; }
        if (hipFuncSetAttribute((const void*)hybrid_fwd, hipFuncAttributeMaxDynamicSharedMemorySize, LDS_BYTES) != hipSuccess) { fprintf(stderr, "kernel_launch: hipFuncSetAttribute failed\n"); grid = -1; return; }
        if (hipOccupancyMaxActiveBlocksPerMultiprocessor(&per_cu, (const void*)hybrid_fwd, NTHR, LDS_BYTES) != hipSuccess || per_cu < 1) { fprintf(stderr, "kernel_launch: occupancy query says %d\n", per_cu); }
        (void)hipGetLastError();
        grid = cus;
    }
    if (grid < 0) return;
    (void)hipMemsetAsync((char*)d_ws + WS_CTL, 0, CTL_ZERO_BYTES, stream);
#ifdef DBG_ZERO_WS
    (void)hipMemsetAsync((char*)d_ws + CTL_ZERO_BYTES, 0, WS_END - CTL_ZERO_BYTES, stream);
#endif
    Args a{};
    for (int i = 0; i < 32; ++i) a.in[i] = (const float*)d_in[i];
    a.out = (float*)d_out; a.ws = (unsigned char*)d_ws;
#if MK_MULTI
    for (int p = 0; p < N_PHASES; ++p) { a.ph_lo = p; a.ph_hi = p + 1; hipLaunchKernelGGL(hybrid_fwd, dim3(grid), dim3(NTHR), LDS_BYTES, stream, a); }
#else
    a.ph_lo = 0; a.ph_hi = N_PHASES; hipLaunchKernelGGL(hybrid_fwd, dim3(grid), dim3(NTHR), LDS_BYTES, stream, a);
#endif
}
```

```cpp
#include <hip/hip_runtime.h>
#include <cstdio>
#include <cstdint>

#define GAS __attribute__((address_space(1)))
#define LAS __attribute__((address_space(3)))
typedef unsigned short bf16;
typedef unsigned u32x4 __attribute__((ext_vector_type(4)));
typedef unsigned u32x2 __attribute__((ext_vector_type(2)));
typedef float f32x4 __attribute__((ext_vector_type(4)));
typedef float f32x2 __attribute__((ext_vector_type(2)));
typedef short bf16x8 __attribute__((ext_vector_type(8)));
typedef float f32x16 __attribute__((ext_vector_type(16)));
typedef short s16x4 __attribute__((ext_vector_type(4)));

constexpr int SEQ = 16384, NBATCH = 2, T = NBATCH * SEQ, D = 1024, NIN = 3328, DFF = 2816, DFE = 1408, NEXP = 8, NLAYER = 4;
constexpr int MPAD = 2 * T + NEXP * 256;
constexpr int NWAVES = 8, NTHR = 512;
constexpr float LOG2E = 1.4426950408889634f;
constexpr int MM_LP = 72;

typedef __bf16 bf16x2_t __attribute__((ext_vector_type(2)));
__device__ __forceinline__ unsigned cvt_pk_bf16(float lo, float hi) { const f32x2 v = {lo, hi}; const bf16x2_t b = __builtin_convertvector(v, bf16x2_t); return __builtin_bit_cast(unsigned, b); }
__device__ __forceinline__ float bflo(unsigned u) { return __builtin_bit_cast(float, u << 16); }
__device__ __forceinline__ float bfhi(unsigned u) { return __builtin_bit_cast(float, u & 0xffff0000u); }
__device__ __forceinline__ float bf2f(bf16 u) { return __builtin_bit_cast(float, (unsigned)u << 16); }
__device__ __forceinline__ bf16 f2bf(float f) { return (bf16)(cvt_pk_bf16(f, 0.f) & 0xffffu); }
__device__ __forceinline__ float sigm(float x) { return __builtin_amdgcn_rcpf(1.f + __builtin_amdgcn_exp2f(-x * LOG2E)); }
__device__ __forceinline__ float shx(float v, int o, int lane) { return __builtin_bit_cast(float, __builtin_amdgcn_ds_bpermute((lane ^ o) << 2, __builtin_bit_cast(int, v))); }
__device__ __forceinline__ float dpp_add(float v, const int ctrl_id) {
    const int x = __builtin_bit_cast(int, v);
    int y;
    if (ctrl_id == 0) y = __builtin_amdgcn_update_dpp(0, x, 0xB1, 0xF, 0xF, true);
    else if (ctrl_id == 1) y = __builtin_amdgcn_update_dpp(0, x, 0x4E, 0xF, 0xF, true);
    else if (ctrl_id == 2) y = __builtin_amdgcn_update_dpp(0, x, 0x141, 0xF, 0xF, true);
    else y = __builtin_amdgcn_update_dpp(0, x, 0x140, 0xF, 0xF, true);
    return v + __builtin_bit_cast(float, y);
}
__device__ __forceinline__ float wave_sum(float v, int lane) {
    (void)lane;
    v = dpp_add(v, 0); v = dpp_add(v, 1); v = dpp_add(v, 2); v = dpp_add(v, 3);
    const int x = __builtin_bit_cast(int, v);
    const float s0 = __builtin_bit_cast(float, __builtin_amdgcn_readlane(x, 0)), s1 = __builtin_bit_cast(float, __builtin_amdgcn_readlane(x, 16)),
                s2 = __builtin_bit_cast(float, __builtin_amdgcn_readlane(x, 32)), s3 = __builtin_bit_cast(float, __builtin_amdgcn_readlane(x, 48));
    return (s0 + s1) + (s2 + s3);
}
__device__ __forceinline__ void unpack8(const u32x4 v, float* f) {
    f[0] = bflo(v.x); f[1] = bfhi(v.x); f[2] = bflo(v.y); f[3] = bfhi(v.y); f[4] = bflo(v.z); f[5] = bfhi(v.z); f[6] = bflo(v.w); f[7] = bfhi(v.w);
}
__device__ __forceinline__ unsigned pk4_fp8(float a, float b, float c, float d) {
    a = __builtin_amdgcn_fmed3f(a, -440.f, 440.f); b = __builtin_amdgcn_fmed3f(b, -440.f, 440.f); c = __builtin_amdgcn_fmed3f(c, -440.f, 440.f); d = __builtin_amdgcn_fmed3f(d, -440.f, 440.f);
    int w = __builtin_amdgcn_cvt_pk_fp8_f32(a, b, 0, false); w = __builtin_amdgcn_cvt_pk_fp8_f32(c, d, w, true); return (unsigned)w; }
__device__ __forceinline__ u32x4 pack8(const float* f) {
    u32x4 w; w.x = cvt_pk_bf16(f[0], f[1]); w.y = cvt_pk_bf16(f[2], f[3]); w.z = cvt_pk_bf16(f[4], f[5]); w.w = cvt_pk_bf16(f[6], f[7]); return w;
}


#ifndef PROBE2
#define PROBE2 0
#endif
#ifndef GMASK
#define GMASK 15
#endif
#ifndef RWDBG
#define RWDBG 0
#endif
typedef int i32x8 __attribute__((ext_vector_type(8)));
constexpr float F8_MUL_X = 16.f, F8_MUL_W = 256.f, F8_DESCALE = 1.0f / (16.f * 256.f), F8_MUL_H = 4.f, F8_DESCALE_DOWN = 1.0f / (4.f * 256.f);
constexpr int DFE_PAD = 1536;
namespace pg8 {
typedef unsigned short bf16_t;
constexpr int BM = 256, BK = 64, HALF = 128, HTB = HALF * BK * 2, NXCD = 8, WGM = 8;
__host__ __device__ __forceinline__ int lds_byte(int r, int c) { const int st = (r >> 4) * 2 + (c >> 5), rr = r & 15, cc = c & 31, ob = rr * 64 + cc * 2; return st * 1024 + (ob ^ (((ob >> 9) & 1) << 5)); }
__host__ __device__ __forceinline__ void stage_rc(int b, int& R, int& C) { const int st = b / 1024, sb = b % 1024, swz = sb ^ (((sb >> 9) & 1) << 5); R = (st >> 1) * 16 + swz / 64; C = (st & 1) * 32 + (swz % 64) / 2; }
__host__ __device__ __forceinline__ int perm32(int rho) { const int n = rho >> 4, i = rho & 15; return 8 * (i >> 2) + 4 * n + (i & 3); }

struct Unit { int pm, pn, aoff; };
struct Gemm { const bf16_t* A; const bf16_t* Bt; int lda, K; };

struct StaticOrder {
    int nM, nN, nwg, G, c, ashift, amul;
    __device__ void init(int M, int N, int G_, int c_, int ashift_ = 0, int amul_ = 0) { nM = M / BM; nN = N / BM; nwg = nM * nN; G = G_; c = c_; ashift = ashift_; amul = amul_; }
    __device__ bool next(int i, Unit& u) const {
        const long L = (long)i * G + c; if (L >= nwg) return false;
        int wgid = (int)L; { const int q = nwg / NXCD, r = nwg % NXCD, xcd = wgid % NXCD, off = wgid / NXCD; wgid = (xcd < r ? xcd * (q + 1) : r * (q + 1) + (xcd - r) * q) + off; }
        const int nig = WGM * nN, gid = wgid / nig, fm = gid * WGM, gsz = (nM - fm) < WGM ? (nM - fm) : WGM;
        u.pm = fm + ((wgid % nig) % gsz); u.pn = (wgid % nig) / gsz; u.aoff = (u.pn >> ashift) * amul; return true;
    }
};
struct MoeOrder {
    const int* texp; int ntiles, ncol, G, c;
    __device__ bool next(int i, Unit& u) const {
        const int L = i * G + c; if (L >= ntiles * ncol) return false;
        const int pm = L / ncol, pl = L % ncol;
        u.pm = pm; u.pn = texp[pm] * ncol + pl; u.aoff = 0; return true;
    }
};

template <class Epi, class Sched, bool ALIGN_EPI>
__device__ __forceinline__ void gemm_phase(LAS unsigned char* lds, const int tid_in, const Gemm g, const Sched& S, const Epi& E) {
    const int tid = tid_in, wid = __builtin_amdgcn_readfirstlane(tid >> 6), lane = tid & 63, wr = wid >> 2, wc = wid & 3, fr = lane & 15, fq = lane >> 4;
    const int K = g.K, nt = K / BK, lda = g.lda;
    unsigned voffA[2], voffB[2];
#pragma unroll
    for (int i = 0; i < 2; ++i) { int R, C; stage_rc(tid * 16 + i * 8192, R, C); const int Rb = (R & ~31) + perm32(R & 31);
        voffA[i] = (unsigned)(R * lda + C) * 2u; voffB[i] = (unsigned)(Rb * K + C) * 2u; }
    const size_t kstep = (size_t)(BK * 2);
    const size_t hstepA = (size_t)HALF * lda * 2, tstepA = 2 * hstepA, hstepB = (size_t)HALF * K * 2, tstepB = 2 * hstepB;
    const unsigned ldsw = (unsigned)wid * 1024u;
    const int aoff = lds_byte(wr * 64 + fr, fq * 8), boff = lds_byte(wc * 32 + fr, fq * 8);
#define PG8_SA(b, h) (((b) * 2 + (h)) * HTB)
#define PG8_SB(b, h) ((4 + (b) * 2 + (h)) * HTB)
#define PG8_STAGE(bufoff, gbase, voff) do { _Pragma("unroll") for (int _i = 0; _i < 2; ++_i) \
        __builtin_amdgcn_global_load_lds((const unsigned*)((const char*)(gbase) + (voff)[_i]), (LAS unsigned*)(lds + (bufoff) + ldsw + _i * 8192), 16, 0, 0); } while (0)
#define PG8_LDA(dst, b, h) do { _Pragma("unroll") for (int m = 0; m < 4; ++m) _Pragma("unroll") for (int k = 0; k < 2; ++k) dst[m][k] = *(const LAS bf16x8*)(lds + PG8_SA(b, h) + aoff + m * 2048 + k * 1024); } while (0)
#define PG8_LDB(dst, b, h) do { _Pragma("unroll") for (int n = 0; n < 2; ++n) _Pragma("unroll") for (int k = 0; k < 2; ++k) dst[n][k] = *(const LAS bf16x8*)(lds + PG8_SB(b, h) + boff + n * 2048 + k * 1024); } while (0)
#define PG8_MMA(ai, bj, At, Bt) do { __builtin_amdgcn_s_setprio(1); _Pragma("unroll") for (int m = 0; m < 4; ++m) _Pragma("unroll") for (int n = 0; n < 2; ++n) _Pragma("unroll") for (int k = 0; k < 2; ++k) \
        acc[ai][bj][m][n] = __builtin_amdgcn_mfma_f32_16x16x32_bf16(Bt[n][k], At[m][k], acc[ai][bj][m][n], 0, 0, 0); __builtin_amdgcn_s_setprio(0); } while (0)
#define PG8_WAIT_V(n) asm volatile("s_waitcnt vmcnt(" #n ")" ::: "memory")
#define PG8_WAIT_L(n) asm volatile("s_waitcnt lgkmcnt(" #n ")" ::: "memory")
#define PG8_BAR __builtin_amdgcn_s_barrier()
#define PG8_SCHED __builtin_amdgcn_sched_barrier(0)
    Unit cur, nxt; int ui = 0;
    if (!S.next(0, cur)) return;
    f32x4 acc[2][2][4][2];
#pragma unroll
    for (int a = 0; a < 2; ++a)
#pragma unroll
        for (int b = 0; b < 2; ++b)
#pragma unroll
            for (int m = 0; m < 4; ++m)
#pragma unroll
                for (int n = 0; n < 2; ++n) acc[a][b][m][n] = (f32x4){0.f, 0.f, 0.f, 0.f};
    bf16x8 At[4][2], B0[2][2], B1[2][2];
    const char* cA = (const char*)g.A + (size_t)cur.pm * tstepA + cur.aoff; const char* cB = (const char*)g.Bt + (size_t)cur.pn * tstepB;
    PG8_STAGE(PG8_SB(0, 0), cB, voffB); PG8_STAGE(PG8_SB(0, 1), cB + hstepB, voffB); PG8_STAGE(PG8_SA(0, 0), cA, voffA); PG8_STAGE(PG8_SA(0, 1), cA + hstepA, voffA);
    if (wr == 1) PG8_BAR;
    PG8_WAIT_V(2); PG8_BAR;
    PG8_STAGE(PG8_SB(1, 0), cB + kstep, voffB); PG8_STAGE(PG8_SA(1, 0), cA + kstep, voffA); PG8_STAGE(PG8_SB(1, 1), cB + hstepB + kstep, voffB);
    PG8_WAIT_V(6); PG8_BAR;
    for (;;) {
        const bool has_next = S.next(ui + 1, nxt);
        const char* nA = has_next ? (const char*)g.A + (size_t)nxt.pm * tstepA + nxt.aoff : cA; const char* nB = has_next ? (const char*)g.Bt + (size_t)nxt.pn * tstepB : cB;
#pragma unroll 1
        for (int t = 0; t < nt; t += 2) {
            const bool last = (t == nt - 2);
            const char* a1 = cA + (size_t)(t + 1) * kstep;
            const char* a2 = last ? nA : cA + (size_t)(t + 2) * kstep; const char* b2 = last ? nB : cB + (size_t)(t + 2) * kstep;
            const char* a3 = a2 + kstep; const char* b3 = b2 + kstep;
            PG8_LDB(B0, 0, 0); PG8_LDB(B1, 0, 1); PG8_SCHED; PG8_LDA(At, 0, 0); PG8_STAGE(PG8_SA(1, 1), a1 + hstepA, voffA);
            PG8_WAIT_V(8); PG8_WAIT_L(0); PG8_BAR; PG8_MMA(0, 0, At, B0); PG8_MMA(0, 1, At, B1); PG8_BAR; PG8_SCHED;
            PG8_LDA(At, 0, 1); PG8_STAGE(PG8_SB(0, 0), b2, voffB); PG8_STAGE(PG8_SB(0, 1), b2 + hstepB, voffB); PG8_STAGE(PG8_SA(0, 0), a2, voffA);
            PG8_WAIT_V(8); PG8_WAIT_L(0); PG8_BAR; PG8_MMA(1, 0, At, B0); PG8_MMA(1, 1, At, B1); PG8_BAR; PG8_SCHED;
            PG8_LDB(B0, 1, 0); PG8_LDB(B1, 1, 1); PG8_SCHED; PG8_LDA(At, 1, 0); PG8_STAGE(PG8_SA(0, 1), a2 + hstepA, voffA);
            PG8_WAIT_V(8); PG8_WAIT_L(0); PG8_BAR; PG8_MMA(0, 0, At, B0); PG8_MMA(0, 1, At, B1); PG8_BAR; PG8_SCHED;
            PG8_LDA(At, 1, 1); PG8_STAGE(PG8_SB(1, 0), b3, voffB); PG8_STAGE(PG8_SB(1, 1), b3 + hstepB, voffB); PG8_STAGE(PG8_SA(1, 0), a3, voffA);
            PG8_WAIT_V(8); PG8_WAIT_L(0); PG8_BAR; PG8_MMA(1, 0, At, B0); PG8_MMA(1, 1, At, B1); PG8_BAR; PG8_SCHED;
        }
        if constexpr (ALIGN_EPI) { if (wr == 0) PG8_BAR; }
        { int ln_; asm volatile("v_mbcnt_lo_u32_b32 %0, -1, 0\n\tv_mbcnt_hi_u32_b32 %0, -1, %0" : "=v"(ln_)); E(acc, cur, wr, wc, ln_ & 15, ln_ >> 4); }
        if (!has_next) break;
#pragma unroll
        for (int a = 0; a < 2; ++a)
#pragma unroll
            for (int b = 0; b < 2; ++b)
#pragma unroll
                for (int m = 0; m < 4; ++m)
#pragma unroll
                    for (int n = 0; n < 2; ++n) acc[a][b][m][n] = (f32x4){0.f, 0.f, 0.f, 0.f};
        cur = nxt; cA = nA; cB = nB; ++ui;
        if constexpr (ALIGN_EPI) { if (wr == 1) PG8_BAR; }
    }
    PG8_WAIT_V(0);
    if constexpr (!ALIGN_EPI) { if (wr == 0) PG8_BAR; }
    PG8_BAR;
#undef PG8_SA
#undef PG8_SB
#undef PG8_STAGE
#undef PG8_LDA
#undef PG8_LDB
#undef PG8_MMA
#undef PG8_WAIT_V
#undef PG8_WAIT_L
#undef PG8_BAR
#undef PG8_SCHED
}

template <class Epi, class Sched, bool ALIGN_EPI>
__device__ __forceinline__ void gemm_phase8(LAS unsigned char* lds, const int tid_in, const Gemm g, const Sched& S, const Epi& E) {
    const int tid = tid_in, wid = __builtin_amdgcn_readfirstlane(tid >> 6), lane = tid & 63, wr = wid >> 2, wc = wid & 3, fr = lane & 15, fq = lane >> 4;
    const int K = g.K, nt = K / 128, lda = g.lda;
    unsigned voffA, voffB;
    { int R, C; stage_rc(tid * 16, R, C); const int Rb = (R & ~31) + perm32(R & 31); voffA = (unsigned)(R * lda + C * 2); voffB = (unsigned)(Rb * K + C * 2); }
    const unsigned pstepA = 64u * (unsigned)lda, pstepB = 64u * (unsigned)K;
    const unsigned kstep = (unsigned)(BK * 2);
    const unsigned hstepA = (unsigned)HALF * (unsigned)lda, tstepA = 2 * hstepA, hstepB = (unsigned)HALF * (unsigned)K, tstepB = 2 * hstepB;
    const __amdgpu_buffer_rsrc_t rsA = __builtin_amdgcn_make_buffer_rsrc((void*)g.A, 0, 0x7fffffff, 0x00020000), rsB = __builtin_amdgcn_make_buffer_rsrc((void*)g.Bt, 0, 0x7fffffff, 0x00020000);
    const unsigned ldsw = (unsigned)wid * 1024u;
    const int aoff0 = lds_byte(wr * 64 + fr, fq * 16), aoff1 = aoff0 + 16, boff0 = lds_byte(wc * 32 + fr, fq * 16), boff1 = boff0 + 16;
#define PG8_SA(b, h) (((b) * 2 + (h)) * HTB)
#define PG8_SB(b, h) ((4 + (b) * 2 + (h)) * HTB)
#define PG8_STAGE(bufoff, goff, voff, pstep) do { _Pragma("unroll") for (int _i = 0; _i < 2; ++_i) \
        __builtin_amdgcn_raw_ptr_buffer_load_lds(PG8_RS_##voff, (LAS unsigned*)(lds + (bufoff) + ldsw + _i * 8192), 16, (int)(voff), (int)((goff) + _i * (pstep)), 0, 0); } while (0)
#define PG8_RS_voffA rsA
#define PG8_RS_voffB rsB
#define PG8_LDA(dst, b, h) do { _Pragma("unroll") for (int m = 0; m < 4; ++m) { dst[m][0] = *(const LAS u32x4*)(lds + PG8_SA(b, h) + aoff0 + m * 2048); dst[m][1] = *(const LAS u32x4*)(lds + PG8_SA(b, h) + aoff1 + m * 2048); } } while (0)
#define PG8_LDB(dst, b, h) do { _Pragma("unroll") for (int n = 0; n < 2; ++n) { dst[n][0] = *(const LAS u32x4*)(lds + PG8_SB(b, h) + boff0 + n * 2048); dst[n][1] = *(const LAS u32x4*)(lds + PG8_SB(b, h) + boff1 + n * 2048); } } while (0)
#define PG8_J8(x) __builtin_bit_cast(i32x8, __builtin_shufflevector((x)[0], (x)[1], 0, 1, 2, 3, 4, 5, 6, 7))
#define PG8_MMA(ai, bj, At, Bt) do { __builtin_amdgcn_s_setprio(1); _Pragma("unroll") for (int m = 0; m < 4; ++m) _Pragma("unroll") for (int n = 0; n < 2; ++n) \
        acc[ai][bj][m][n] = __builtin_amdgcn_mfma_scale_f32_16x16x128_f8f6f4(PG8_J8(Bt[n]), PG8_J8(At[m]), acc[ai][bj][m][n], 0, 0, 0, 0, 0, 0);        __builtin_amdgcn_s_setprio(0); } while (0)
#define PG8_WAIT_V(n) asm volatile("s_waitcnt vmcnt(" #n ")" ::: "memory")
#define PG8_WAIT_L(n) asm volatile("s_waitcnt lgkmcnt(" #n ")" ::: "memory")
#define PG8_BAR __builtin_amdgcn_s_barrier()
#define PG8_SCHED __builtin_amdgcn_sched_barrier(0)
    Unit cur, nxt; int ui = 0;
    if (!S.next(0, cur)) return;
    f32x4 acc[2][2][4][2];
#pragma unroll
    for (int a = 0; a < 2; ++a)
#pragma unroll
        for (int b = 0; b < 2; ++b)
#pragma unroll
            for (int m = 0; m < 4; ++m)
#pragma unroll
                for (int n = 0; n < 2; ++n) acc[a][b][m][n] = (f32x4){0.f, 0.f, 0.f, 0.f};
    u32x4 At[4][2], B0[2][2], B1[2][2];
    unsigned cA = (unsigned)cur.pm * tstepA + (unsigned)cur.aoff, cB = (unsigned)cur.pn * tstepB;
    PG8_STAGE(PG8_SB(0, 0), cB, voffB, pstepB); PG8_STAGE(PG8_SB(0, 1), cB + hstepB, voffB, pstepB); PG8_STAGE(PG8_SA(0, 0), cA, voffA, pstepA); PG8_STAGE(PG8_SA(0, 1), cA + hstepA, voffA, pstepA);
    if (wr == 1) PG8_BAR;
    PG8_WAIT_V(2); PG8_BAR;
    PG8_STAGE(PG8_SB(1, 0), cB + kstep, voffB, pstepB); PG8_STAGE(PG8_SA(1, 0), cA + kstep, voffA, pstepA); PG8_STAGE(PG8_SB(1, 1), cB + hstepB + kstep, voffB, pstepB);
    PG8_WAIT_V(6); PG8_BAR;
    for (;;) {
        const bool has_next = S.next(ui + 1, nxt);
        const unsigned nA = has_next ? (unsigned)nxt.pm * tstepA + (unsigned)nxt.aoff : cA, nB = has_next ? (unsigned)nxt.pn * tstepB : cB;
#pragma unroll 1
        for (int t = 0; t < nt; t += 2) {
            const bool last = (t == nt - 2);
            const unsigned a1 = cA + (unsigned)(t + 1) * kstep;
            const unsigned a2 = last ? nA : cA + (unsigned)(t + 2) * kstep, b2 = last ? nB : cB + (unsigned)(t + 2) * kstep;
            const unsigned a3 = a2 + kstep, b3 = b2 + kstep;
            PG8_LDB(B0, 0, 0); PG8_LDB(B1, 0, 1); PG8_SCHED; PG8_LDA(At, 0, 0); PG8_STAGE(PG8_SA(1, 1), a1 + hstepA, voffA, pstepA);
            PG8_WAIT_V(8); PG8_WAIT_L(0); PG8_BAR; PG8_MMA(0, 0, At, B0); PG8_MMA(0, 1, At, B1); PG8_BAR; PG8_SCHED;
            PG8_LDA(At, 0, 1); PG8_STAGE(PG8_SB(0, 0), b2, voffB, pstepB); PG8_STAGE(PG8_SB(0, 1), b2 + hstepB, voffB, pstepB); PG8_STAGE(PG8_SA(0, 0), a2, voffA, pstepA);
            PG8_WAIT_V(8); PG8_WAIT_L(0); PG8_BAR; PG8_MMA(1, 0, At, B0); PG8_MMA(1, 1, At, B1); PG8_BAR; PG8_SCHED;
            PG8_LDB(B0, 1, 0); PG8_LDB(B1, 1, 1); PG8_SCHED; PG8_LDA(At, 1, 0); PG8_STAGE(PG8_SA(0, 1), a2 + hstepA, voffA, pstepA);
            PG8_WAIT_V(8); PG8_WAIT_L(0); PG8_BAR; PG8_MMA(0, 0, At, B0); PG8_MMA(0, 1, At, B1); PG8_BAR; PG8_SCHED;
            PG8_LDA(At, 1, 1); PG8_STAGE(PG8_SB(1, 0), b3, voffB, pstepB); PG8_STAGE(PG8_SB(1, 1), b3 + hstepB, voffB, pstepB); PG8_STAGE(PG8_SA(1, 0), a3, voffA, pstepA);
            PG8_WAIT_V(8); PG8_WAIT_L(0); PG8_BAR; PG8_MMA(1, 0, At, B0); PG8_MMA(1, 1, At, B1); PG8_BAR; PG8_SCHED;
        }
        if constexpr (ALIGN_EPI) { if (wr == 0) PG8_BAR; }
        { int ln_; asm volatile("v_mbcnt_lo_u32_b32 %0, -1, 0\n\tv_mbcnt_hi_u32_b32 %0, -1, %0" : "=v"(ln_)); E(acc, cur, wr, wc, ln_ & 15, ln_ >> 4); }
        if (!has_next) break;
#pragma unroll
        for (int a = 0; a < 2; ++a)
#pragma unroll
            for (int b = 0; b < 2; ++b)
#pragma unroll
                for (int m = 0; m < 4; ++m)
#pragma unroll
                    for (int n = 0; n < 2; ++n) acc[a][b][m][n] = (f32x4){0.f, 0.f, 0.f, 0.f};
        cur = nxt; cA = nA; cB = nB; ++ui;
        if constexpr (ALIGN_EPI) { if (wr == 1) PG8_BAR; }
    }
    PG8_WAIT_V(0);
    if constexpr (!ALIGN_EPI) { if (wr == 0) PG8_BAR; }
    PG8_BAR;
#undef PG8_SA
#undef PG8_SB
#undef PG8_STAGE
#undef PG8_RS_voffA
#undef PG8_RS_voffB
#undef PG8_LDA
#undef PG8_LDB
#undef PG8_MMA
#undef PG8_J8
#undef PG8_WAIT_V
#undef PG8_WAIT_L
#undef PG8_BAR
#undef PG8_SCHED
}

typedef f32x4 Acc[2][2][4][2];

struct EpiRoute {
    bf16_t *d0, *d1, *d2, *d3;
    __device__ __forceinline__ void operator()(const Acc& acc, const Unit& u, int wr, int wc, int fr, int fq) const {
        const int pn = u.pn; bf16_t* base; int ld, ct;
        if (pn < 4) { base = d0; ld = 1024; ct = pn; } else if (pn < 7) { base = d1; ld = 768; ct = pn - 4; } else if (pn < 11) { base = d2; ld = 1024; ct = pn - 7; } else { base = d3; ld = 512; ct = pn - 11; }
        const int row0 = u.pm * BM + wr * 64 + fr, col0 = ct * 256 + wc * 32 + 8 * fq;
#pragma unroll
        for (int ai = 0; ai < 2; ++ai)
#pragma unroll
            for (int m = 0; m < 4; ++m) { bf16_t* rowp = base + (size_t)(row0 + ai * HALF + m * 16) * ld + col0;
#pragma unroll
                for (int bj = 0; bj < 2; ++bj) { const f32x4 v0 = acc[ai][bj][m][0], v1 = acc[ai][bj][m][1]; u32x4 w;
                    w.x = cvt_pk_bf16(v0[0], v0[1]); w.y = cvt_pk_bf16(v0[2], v0[3]); w.z = cvt_pk_bf16(v1[0], v1[1]); w.w = cvt_pk_bf16(v1[2], v1[3]);
                    *(u32x4*)(rowp + bj * HALF) = w; } }
    }
};
struct EpiBf16 {
    bf16_t* O; int ld, pnmask; float sc;
    __device__ __forceinline__ void operator()(const Acc& acc, const Unit& u, int wr, int wc, int fr, int fq) const {
        const int row0 = u.pm * BM + wr * 64 + fr, col0 = (u.pn & pnmask) * 256 + wc * 32 + 8 * fq;
#pragma unroll
        for (int ai = 0; ai < 2; ++ai)
#pragma unroll
            for (int m = 0; m < 4; ++m) { bf16_t* rowp = O + (size_t)(row0 + ai * HALF + m * 16) * ld + col0;
#pragma unroll
                for (int bj = 0; bj < 2; ++bj) { const f32x4 v0 = acc[ai][bj][m][0] * sc, v1 = acc[ai][bj][m][1] * sc; u32x4 w;
                    w.x = cvt_pk_bf16(v0[0], v0[1]); w.y = cvt_pk_bf16(v0[2], v0[3]); w.z = cvt_pk_bf16(v1[0], v1[1]); w.w = cvt_pk_bf16(v1[2], v1[3]);
                    *(u32x4*)(rowp + bj * HALF) = w; } }
    }
};
struct EpiLora {
    float* wdec; bf16_t* ag; const float* w0; const float* a0;
    __device__ __forceinline__ void operator()(const Acc& acc, const Unit& u, int wr, int wc, int fr, int fq) const {
        const int row0 = u.pm * BM + wr * 64 + fr, cl0 = wc * 32 + 8 * fq, pn = u.pn;
#pragma unroll
        for (int ai = 0; ai < 2; ++ai)
#pragma unroll
            for (int m = 0; m < 4; ++m) { const size_t row = (size_t)(row0 + ai * HALF + m * 16);
#pragma unroll
                for (int bj = 0; bj < 2; ++bj) { const int col = bj * HALF + cl0; float v[8];
#pragma unroll
                    for (int n = 0; n < 2; ++n)
#pragma unroll
                        for (int e = 0; e < 4; ++e) v[4 * n + e] = acc[ai][bj][m][n][e];
                    if (pn == 0) {
                        *(f32x4*)(wdec + row * 256 + col) = (f32x4){v[0], v[1], v[2], v[3]}; *(f32x4*)(wdec + row * 256 + col + 4) = (f32x4){v[4], v[5], v[6], v[7]};
                    } else if (pn == 1) {
                        *(u32x4*)(ag + row * 512 + col) = pack8(v);
                    } else { *(u32x4*)(ag + row * 512 + 256 + col) = pack8(v); }
                } }
    }
};
struct EpiGateMerge {
    const bf16_t* ball; bf16_t* merged;
    __device__ __forceinline__ void operator()(const Acc& acc, const Unit& u, int wr, int wc, int fr, int fq) const {
        const int row0 = u.pm * BM + wr * 64 + fr, o0 = 64 * u.pn + 16 * wc + 4 * fq;
#pragma unroll
        for (int ai = 0; ai < 2; ++ai)
#pragma unroll
            for (int m = 0; m < 4; ++m) { const size_t row = (size_t)(row0 + ai * HALF + m * 16); float s[4] = {0.f, 0.f, 0.f, 0.f};
#pragma unroll
                for (int bj = 0; bj < 2; ++bj)
#pragma unroll
                    for (int n = 0; n < 2; ++n) { const int gi = 2 * bj + n; if (!((GMASK >> gi) & 1)) continue; const u32x2 b = *(const u32x2*)(ball + row * 4096 + 1024 * gi + o0);
                        const f32x4 a = acc[ai][bj][m][n] * F8_DESCALE;
                        s[0] += sigm(a[0]) * bflo(b.x); s[1] += sigm(a[1]) * bfhi(b.x); s[2] += sigm(a[2]) * bflo(b.y); s[3] += sigm(a[3]) * bfhi(b.y); }
                u32x2 w; w.x = cvt_pk_bf16(s[0], s[1]); w.y = cvt_pk_bf16(s[2], s[3]);
                *(u32x2*)(merged + row * 1024 + o0) = w; }
    }
};
struct EpiResidual {
    float* out; float sc;
    __device__ __forceinline__ void operator()(const Acc& acc, const Unit& u, int wr, int wc, int fr, int fq) const {
        const int row0 = u.pm * BM + wr * 64 + fr, col0 = u.pn * 256 + wc * 32 + 8 * fq;
#pragma unroll
        for (int ai = 0; ai < 2; ++ai)
#pragma unroll
            for (int m = 0; m < 4; ++m) { float* rowp = out + (size_t)(row0 + ai * HALF + m * 16) * 1024 + col0;
#pragma unroll
                for (int bj = 0; bj < 2; ++bj)
#pragma unroll
                    for (int n = 0; n < 2; ++n) { f32x4* p = (f32x4*)(rowp + bj * HALF + 4 * n); f32x4 v = *p; v = v + acc[ai][bj][m][n] * sc; *p = v; } }
    }
};
struct EpiSwiglu {
    unsigned char* hid; int ldh, ncol; bool pad;
    __device__ __forceinline__ void operator()(const Acc& acc, const Unit& u, int wr, int wc, int fr, int fq) const {
        const int pl = u.pn % ncol; const int row0 = u.pm * BM + wr * 64 + fr, col0 = pl * 128 + wc * 32 + 8 * fq;
        const bool dopad = pad && (pl == ncol - 1);
#pragma unroll
        for (int ai = 0; ai < 2; ++ai)
#pragma unroll
            for (int m = 0; m < 4; ++m) { float v[8];
#pragma unroll
                for (int n = 0; n < 2; ++n)
#pragma unroll
                    for (int e = 0; e < 4; ++e) { const float a = acc[ai][0][m][n][e] * F8_DESCALE, b = acc[ai][1][m][n][e] * F8_DESCALE; v[4 * n + e] = a * sigm(a) * b * F8_MUL_H; }
                unsigned char* rp = hid + (size_t)(row0 + ai * HALF + m * 16) * ldh + col0;
                u32x2 w; w.x = pk4_fp8(v[0], v[1], v[2], v[3]); w.y = pk4_fp8(v[4], v[5], v[6], v[7]); *(u32x2*)rp = w;
                if (dopad) { unsigned z0; asm volatile("v_mov_b32 %0, 0" : "=v"(z0)); *(u32x2*)(rp + 128) = (u32x2){z0, z0}; } }
    }
};
struct EpiMoeOut {
    float* out; const int* rowtok; const float* rowgate; const int* segend;
    __device__ __forceinline__ void operator()(const Acc& acc, const Unit& u, int wr, int wc, int fr, int fq) const {
        const int row0 = u.pm * BM + wr * 64 + fr, col0 = (u.pn & 3) * 256 + wc * 32 + 8 * fq, lim = segend[u.pm];
#pragma unroll
        for (int ai = 0; ai < 2; ++ai)
#pragma unroll
            for (int m = 0; m < 4; ++m) { const int row = row0 + ai * HALF + m * 16;
                if (row < lim) { const int tok = rowtok[row]; const float gt = rowgate[row]; float* rowp = out + (size_t)tok * 1024 + col0;
#pragma unroll
                    for (int bj = 0; bj < 2; ++bj)
#pragma unroll
                        for (int n = 0; n < 2; ++n)
#pragma unroll
                            for (int e = 0; e < 4; ++e) __hip_atomic_fetch_add(rowp + bj * HALF + 4 * n + e, gt * acc[ai][bj][m][n][e], __ATOMIC_RELAXED, __HIP_MEMORY_SCOPE_AGENT);
                } }
    }
};
}

#define XB_TMO      128
#define XB_XCNT(j)  (256  + 64 * (j))
#define XB_XSUB(j)  (1280 + 64 * (j))
#define XB_XGEN(j)  (2304 + 64 * (j))
#define XB_TOP      3328
#define XB_TOPGEN   3392
#define XCD_BAR_WORDS 3456
#define XB_SPIN_CAP (1u << 18)
__device__ __forceinline__ unsigned xb_ld(unsigned* p)              { return __hip_atomic_load(p, __ATOMIC_RELAXED, __HIP_MEMORY_SCOPE_AGENT); }
__device__ __forceinline__ unsigned xb_add(unsigned* p, unsigned v) { return __hip_atomic_fetch_add(p, v, __ATOMIC_RELAXED, __HIP_MEMORY_SCOPE_AGENT); }
__device__ __forceinline__ unsigned xb_xcc_id() { return (unsigned)__builtin_amdgcn_s_getreg((3 << 11) | 20) & 0xFu; }
#define XB_SPIN(cond, bar) do { unsigned _sp = 0; while (cond) { __builtin_amdgcn_s_sleep(1); \
    if ((++_sp & 255u) == 0u) { if (xb_ld(&(bar)[XB_TMO])) break; if (_sp > XB_SPIN_CAP) { atomicAdd(&(bar)[XB_TMO], 1u); break; } } } } while (0)
struct XcdBarrier { unsigned* bar; unsigned x; volatile LAS unsigned* st; };
__device__ __forceinline__ XcdBarrier xcd_barrier_post(unsigned* bar, volatile LAS unsigned* st) {
    XcdBarrier b; b.bar = bar; b.x = xb_xcc_id(); b.st = st;
    if (threadIdx.x == 0) (void)xb_add(&bar[XB_XCNT(b.x)], 1u);
    return b;
}
__device__ __forceinline__ void xcd_barrier_complete(unsigned* bar, unsigned x, unsigned& nloc, unsigned& nx) {
    const unsigned G = gridDim.x * gridDim.y * gridDim.z;
    unsigned sum, cnt, mine, sp = 0u;
    for (;;) {
        sum = 0u; cnt = 0u; mine = 0u;
#pragma unroll
        for (unsigned j = 0; j < 16; ++j) { const unsigned c = xb_ld(&bar[XB_XCNT(j)]); sum += c; cnt += (c > 0u) ? 1u : 0u; mine = (j == x) ? c : mine; }
        if (sum == G) break;
        __builtin_amdgcn_s_sleep(1);
        if ((++sp & 255u) == 0u) { if (xb_ld(&bar[XB_TMO])) break; if (sp > XB_SPIN_CAP) { atomicAdd(&bar[XB_TMO], 1u); break; } }
    }
    nloc = mine > 0u ? mine : 1u; nx = cnt > 0u ? cnt : 1u;
}
__device__ __forceinline__ void xcd_barrier(const XcdBarrier& b, const int tid) {
    asm volatile("s_waitcnt vmcnt(0)" ::: "memory");
    __syncthreads();
    if (tid == 0) {
        unsigned* bar = b.bar;
        __builtin_amdgcn_s_waitcnt(0);
        unsigned nloc = b.st[0], nx = b.st[1];
        if (nloc == 0u) { xcd_barrier_complete(bar, b.x, nloc, nx); b.st[0] = nloc; b.st[1] = nx; }
        const unsigned old = xb_add(&bar[XB_XSUB(b.x)], 1u);
        const unsigned gen = old / nloc;
        if (old + 1u == (gen + 1u) * nloc) {
            __builtin_amdgcn_fence(__ATOMIC_RELEASE, "agent");
            asm volatile("s_waitcnt vmcnt(0)" ::: "memory");
            const unsigned og = xb_add(&bar[XB_TOP], 1u);
            const unsigned tg = og / nx;
            if (og + 1u == (tg + 1u) * nx) xb_add(&bar[XB_TOPGEN], 1u);
            else XB_SPIN(xb_ld(&bar[XB_TOPGEN]) == tg, bar);
            __builtin_amdgcn_fence(__ATOMIC_ACQUIRE, "agent");
            xb_add(&bar[XB_XGEN(b.x)], 1u);
            asm volatile("s_waitcnt vmcnt(0)" ::: "memory");
        } else {
            XB_SPIN(xb_ld(&bar[XB_XGEN(b.x)]) == gen, bar);
            __builtin_amdgcn_fence(__ATOMIC_ACQUIRE, "agent");
            asm volatile("s_waitcnt vmcnt(0)" ::: "memory");
        }
    }
    __syncthreads();
}

constexpr size_t MiB = 1u << 20;
constexpr size_t WS_CTL = 0, CTL_ZERO_BYTES = 1 * MiB;
constexpr int CW_BAR = 4096;
constexpr int CW_QUEUE = 20480;
constexpr int CW_MOE = 16384;
constexpr size_t WS_EIDX = 1 * MiB, WS_GATE = WS_EIDX + 256 * 1024, WS_ROWTOK = WS_EIDX + 512 * 1024, WS_ROWGATE = 2 * MiB, WS_TEXP = 2 * MiB + 512 * 1024, WS_SEGEND = WS_TEXP + 4096, WS_NT = WS_TEXP + 8192;
constexpr size_t WS_SLOTOF = 2 * MiB + 768 * 1024;
constexpr size_t WS_BON = 3 * MiB, WS_COS = 4 * MiB, WS_SIN = 6 * MiB;
constexpr size_t WS_WIN = 8 * MiB, WS_WLORA = 15 * MiB, WS_WB = 16 * MiB, WS_WG = 18 * MiB, WS_WOUT = 26 * MiB, WS_W13 = 28 * MiB  , WS_W2D = 50 * MiB, WS_W2M = 50 * MiB, WS_H8 = 72 * MiB  ;
constexpr size_t WS_H = 104 * MiB, WS_Y = 168 * MiB, WS_BIG = 232 * MiB;
constexpr size_t WS_RW = WS_BIG, WS_WDEC = WS_BIG, WS_AG = WS_BIG + 32 * MiB, WS_SB = WS_BIG + 64 * MiB, WS_RET = WS_BIG + 112 * MiB, WS_CV = WS_BIG + 176 * MiB, WS_Y0 = WS_CV;
constexpr size_t WS_RKVS = WS_BIG + 208 * MiB, WS_ALORA = WS_BIG + 256 * MiB, WS_RHAT = WS_ALORA, WS_KV = WS_BIG + 272 * MiB, WS_SST = WS_WDEC  , WS_PQ = WS_BIG + 304 * MiB  , WS_END = WS_BIG + 368 * MiB;
constexpr size_t WS_BALL = WS_BIG, WS_MERGED = WS_BIG + 256 * MiB, WS_HID = WS_BIG, WS_XS = WS_BIG, WS_YS = WS_XS, WS_HIDM = WS_BIG + 132 * MiB;
static_assert(WS_HIDM + (size_t)MPAD * DFE * 2 <= WS_END && WS_MERGED + (size_t)T * D * 2 <= WS_END && WS_W2M + (size_t)NEXP * D * DFE * 2 <= WS_H8, "ws map");
static_assert(WS_W13 + (size_t)NEXP * 2 * DFE * D <= WS_W2M && WS_W13 + (size_t)2 * DFF * D <= WS_W2D && WS_W2M + (size_t)NEXP * D * DFE * 2 <= WS_H8 && WS_H8 + (size_t)T * D <= WS_H, "ws map weights");

constexpr int LDS_BYTES = 147456, RING_BYTES = 131072, MISC_OFF = RING_BYTES + 320;

struct Args { const float* in[32]; float* out; unsigned char* ws; int ph_lo, ph_hi; };
#define CAS __attribute__((address_space(4)))
struct Ctx {
    LAS unsigned char* lds; unsigned char* ws; float* out; const float* const CAS* in;
    int tid, lane, wave, G, bid;
};
__device__ __forceinline__ const CAS Args* ka_ptr() { const CAS Args* p = (const CAS Args*)__builtin_amdgcn_kernarg_segment_ptr(); asm volatile("" : "+s"(p)); return p; }
extern __shared__ __attribute__((aligned(16))) unsigned char lds_raw[];
__device__ __forceinline__ Ctx make_ctx(int wv) {
    const CAS Args* ka = ka_ptr();
    Ctx C; C.lds = (LAS unsigned char*)lds_raw; C.ws = ka->ws; C.out = ka->out; C.in = ka->in;
    int g_ = gridDim.x, b_ = blockIdx.x, w_ = wv; asm volatile("" : "+s"(g_), "+s"(b_), "+s"(w_));
    int ln_; asm volatile("v_mbcnt_lo_u32_b32 %0, -1, 0\n\tv_mbcnt_hi_u32_b32 %0, -1, %0" : "=v"(ln_));
    C.lane = ln_; C.wave = w_; C.tid = w_ * 64 + ln_; C.G = g_; C.bid = b_;
    return C;
}
enum { I_X = 0, I_NORM_MIX, I_W_IN, I_RW_MU, I_RW_W0, I_RW_W2, I_RW_A0, I_RW_A2, I_RW_G2, I_RW_KK, I_RW_KA, I_RW_RK, I_RW_LNW, I_RW_LNB, I_SB_QN, I_SB_KN, I_RET_GN,
       I_CONV_DW, I_CONV_B, I_CONV_LNW, I_CONV_LNB, I_W_GATE, I_W_BRANCH, I_W_OUT, I_NORM_FFN, I_FFN_W1, I_FFN_W3, I_FFN_W2, I_ROUTER, I_MOE_W1, I_MOE_W3, I_MOE_W2 };

__device__ __forceinline__ int q_next(const Ctx& C, unsigned* head) {
    LAS int* slot = (LAS int*)(C.lds + MISC_OFF + 64);
    __syncthreads();
    if (C.tid == 0) *slot = (int)__hip_atomic_fetch_add(head, 1u, __ATOMIC_RELAXED, __HIP_MEMORY_SCOPE_AGENT);
    __syncthreads();
    return *slot;
}
__device__ __forceinline__ void ph_prologue_(const Ctx& C) {
    const size_t gid = (size_t)C.bid * NTHR + C.tid, gsz = (size_t)C.G * NTHR;
    float* cs = (float*)(C.ws + WS_COS); float* sn = (float*)(C.ws + WS_SIN);
    for (size_t i = gid; i < (size_t)SEQ * 32; i += gsz) {
        const int pos = (int)(i >> 5), j = (int)(i & 31);
        const float inv = (float)pow(10000.0, -(double)(2 * j) / 64.0);
        const float ang = (float)pos * inv;
        cs[i] = (float)cos((double)ang); sn[i] = (float)sin((double)ang);
    }
}

__device__ __forceinline__ int dest_row(int mode, int roff, int which, int n) {
    if (mode == 0) return roff + n;
    if (mode == 1) { const int pn = n >> 6, oc = n & 63; return 256 * pn + 128 * (roff >> 1) + 32 * (oc >> 4) + 8 * ((oc >> 2) & 3) + 4 * (roff & 1) + (oc & 3); }
    return roff + 256 * (n >> 7) + 128 * which + (n & 127);
}
__device__ __forceinline__ void xpose_item(const float* W, int K, int N, bf16* WT, int mode, int roff, int which, LAS float* scr, int item, int lane) {
    const int nblk = N / 32, kb = item / nblk, nb = item % nblk, k0 = 64 * kb, n0 = 32 * nb;
#pragma unroll
    for (int i = 0; i < 8; ++i) { const int kk = (lane >> 3) + 8 * i, c4 = (lane & 7) * 4; const f32x4 v = *(const f32x4*)(W + (size_t)(k0 + kk) * N + n0 + c4);
        scr[kk * 33 + c4] = v.x; scr[kk * 33 + c4 + 1] = v.y; scr[kk * 33 + c4 + 2] = v.z; scr[kk * 33 + c4 + 3] = v.w; }
    asm volatile("s_waitcnt lgkmcnt(0)" ::: "memory");
    const int c = lane & 7;
#pragma unroll
    for (int j = 0; j < 4; ++j) { const int n = (lane >> 3) + 8 * j; const LAS float* s = scr + (8 * c) * 33 + n;
        u32x4 o; o.x = cvt_pk_bf16(s[0 * 33], s[1 * 33]); o.y = cvt_pk_bf16(s[2 * 33], s[3 * 33]); o.z = cvt_pk_bf16(s[4 * 33], s[5 * 33]); o.w = cvt_pk_bf16(s[6 * 33], s[7 * 33]);
        *(u32x4*)(WT + (size_t)dest_row(mode, roff, which, n0 + n) * K + k0 + 8 * c) = o; }
    asm volatile("s_waitcnt lgkmcnt(0)" ::: "memory");
}
__device__ __forceinline__ void xpose_item8(const float* W, int K, int N, unsigned char* WT, int mode, int roff, int which, LAS float* scr, int item, int lane, int ldk = 0) {
    if (ldk == 0) ldk = K;
    const int nblk = N / 32, kb = item / nblk, nb = item % nblk, k0 = 64 * kb, n0 = 32 * nb;
#pragma unroll
    for (int i = 0; i < 8; ++i) { const int kk = (lane >> 3) + 8 * i, c4 = (lane & 7) * 4; const f32x4 v = *(const f32x4*)(W + (size_t)(k0 + kk) * N + n0 + c4);
        scr[kk * 33 + c4] = v.x; scr[kk * 33 + c4 + 1] = v.y; scr[kk * 33 + c4 + 2] = v.z; scr[kk * 33 + c4 + 3] = v.w; }
    asm volatile("s_waitcnt lgkmcnt(0)" ::: "memory");
    const int c = lane & 3;
#pragma unroll
    for (int j = 0; j < 2; ++j) { const int n = (lane >> 2) + 16 * j; const LAS float* sp = scr + (16 * c) * 33 + n;
        u32x4 o;
        o.x = pk4_fp8(sp[0 * 33] * F8_MUL_W, sp[1 * 33] * F8_MUL_W, sp[2 * 33] * F8_MUL_W, sp[3 * 33] * F8_MUL_W);
        o.y = pk4_fp8(sp[4 * 33] * F8_MUL_W, sp[5 * 33] * F8_MUL_W, sp[6 * 33] * F8_MUL_W, sp[7 * 33] * F8_MUL_W);
        o.z = pk4_fp8(sp[8 * 33] * F8_MUL_W, sp[9 * 33] * F8_MUL_W, sp[10 * 33] * F8_MUL_W, sp[11 * 33] * F8_MUL_W);
        o.w = pk4_fp8(sp[12 * 33] * F8_MUL_W, sp[13 * 33] * F8_MUL_W, sp[14 * 33] * F8_MUL_W, sp[15 * 33] * F8_MUL_W);
        *(u32x4*)(WT + (size_t)dest_row(mode, roff, which, n0 + n) * ldk + k0 + 16 * c) = o; }
    asm volatile("s_waitcnt lgkmcnt(0)" ::: "memory");
}
__device__ __forceinline__ void ph_weights_(const Ctx& C, int l, int part, int first_wg, int nwg, unsigned* qhead = nullptr) {
    LAS float* scr = (LAS float*)(C.lds + C.wave * 16384);
    const int gw = (C.bid - first_wg) * NWAVES + C.wave, NGW = nwg * NWAVES, lane = C.lane;
    unsigned char* ws = C.ws;
    const bool moe = (l & 1);
    const int l2 = l >> 1;
    constexpr int IT_IN = (D / 64) * (NIN / 32), IT_B = (256 / 64) * (D / 32), IT_G = (D / 64) * (D / 32), IT_O = IT_G;
    constexpr int IT_F1 = (D / 64) * (DFF / 32), IT_F2 = (DFF / 64) * (D / 32), IT_M1 = (D / 64) * (DFE / 32), IT_M2 = (DFE / 64) * (D / 32);
    const int n_fixed = IT_IN + 4 * IT_B + 4 * IT_G + IT_O;
    if (part == 1) {
        if (C.bid < first_wg) return;
        const int n1 = moe ? NEXP * IT_M2 : (2 * IT_F1 + IT_F2);
        for (int it = qhead ? q_next(C, qhead) * NWAVES + C.wave : gw; qhead ? (it - C.wave < n1) : (it < n1); it = qhead ? q_next(C, qhead) * NWAVES + C.wave : it + NGW) {
            if (it >= n1) continue;
            int r = it;
            if (!moe) {
                if (r < IT_F1) { xpose_item8(C.in[I_FFN_W1] + (size_t)l2 * D * DFF, D, DFF, ws + WS_W13, 2, 0, 0, scr, r, lane); continue; } r -= IT_F1;
                if (r < IT_F1) { xpose_item8(C.in[I_FFN_W3] + (size_t)l2 * D * DFF, D, DFF, ws + WS_W13, 2, 0, 1, scr, r, lane); continue; } r -= IT_F1;
                xpose_item8(C.in[I_FFN_W2] + (size_t)l2 * DFF * D, DFF, D, ws + WS_W2D, 0, 0, 0, scr, r, lane);
            } else { const int e = r / IT_M2; r -= e * IT_M2;
                xpose_item8(C.in[I_MOE_W2] + ((size_t)l2 * NEXP + e) * DFE * D, DFE, D, ws + WS_W2M, 0, e * D, 0, scr, r, lane, DFE_PAD); }
        }
        if (moe) {
            for (int i = (C.bid - first_wg) * NTHR + C.tid; i < NEXP * D * ((DFE_PAD - DFE) / 16); i += nwg * NTHR) { const int row = i >> 3, c16 = i & 7;
                unsigned z0; asm volatile("v_mov_b32 %0, 0" : "=v"(z0)); *(u32x4*)(ws + WS_W2M + (size_t)row * DFE_PAD + DFE + 16 * c16) = (u32x4){z0, z0, z0, z0}; } }
        return;
    }
    const int n_ffn = moe ? (NEXP * 2 * IT_M1) : 0;
    for (int it = gw; it < n_fixed + n_ffn; it += NGW) {
        int r = it;
        if (r < IT_IN) { xpose_item(C.in[I_W_IN] + (size_t)l * D * NIN, D, NIN, (bf16*)(ws + WS_WIN), 0, 0, 0, scr, r, lane); continue; } r -= IT_IN;
        if (r < 4 * IT_B) { const int i = r / IT_B; xpose_item(C.in[I_W_BRANCH] + ((size_t)l * 4 + i) * 256 * D, 256, D, (bf16*)(ws + WS_WB), 0, 1024 * i, 0, scr, r % IT_B, lane); continue; } r -= 4 * IT_B;
        if (r < 4 * IT_G) { const int i = r / IT_G; xpose_item8(C.in[I_W_GATE] + ((size_t)l * 4 + i) * D * D, D, D, ws + WS_WG, 1, i, 0, scr, r % IT_G, lane); continue; } r -= 4 * IT_G;
        if (r < IT_O) { xpose_item(C.in[I_W_OUT] + (size_t)l * D * D, D, D, (bf16*)(ws + WS_WOUT), 0, 0, 0, scr, r, lane); continue; } r -= IT_O;
        { const int per = 2 * IT_M1, e = r / per; r -= e * per;
          if (r < IT_M1) { xpose_item8(C.in[I_MOE_W1] + ((size_t)l2 * NEXP + e) * D * DFE, D, DFE, ws + WS_W13, 2, e * 2 * DFE, 0, scr, r, lane); continue; } r -= IT_M1;
          xpose_item8(C.in[I_MOE_W3] + ((size_t)l2 * NEXP + e) * D * DFE, D, DFE, ws + WS_W13, 2, e * 2 * DFE, 1, scr, r, lane); }
    }
    bf16* WL = (bf16*)(ws + WS_WLORA);
    const float* w2 = C.in[I_RW_W2] + (size_t)l * 64 * 256; const float* a2 = C.in[I_RW_A2] + (size_t)l * 64 * 256; const float* g2 = C.in[I_RW_G2] + (size_t)l * 128 * 256;
    for (int i = C.bid * NTHR + C.tid; i < 768 * 256; i += C.G * NTHR) {
        const int n = i >> 8, k = i & 255; float v = 0.f;
        if (n < 256) { if (k < 64) v = w2[k * 256 + n]; }
        else if (n < 512) { if (k >= 64 && k < 128) v = a2[(k - 64) * 256 + (n - 256)]; }
        else { if (k >= 128) v = g2[(k - 128) * 256 + (n - 512)]; }
        WL[i] = f2bf(v);
    }
}

__device__ __forceinline__ void ph_norm_(const Ctx& C, const float* gain, bool route, const float* router, int moe_idx, bool combine = false, const float* src = nullptr, bool want_bf16 = true) {
    const int gw = C.bid * NWAVES + C.wave, NGW = C.G * NWAVES, lane = C.lane;
    bf16* H = (bf16*)(C.ws + WS_H);
    f32x4 g[4];
#pragma unroll
    for (int j = 0; j < 4; ++j) g[j] = *((const f32x4*)gain + lane + 64 * j);
    LAS unsigned* lcnt = (LAS unsigned*)(C.lds);
    if (route) { if (C.tid < 8) lcnt[C.tid] = 0u; __syncthreads(); }
    int* eidx = (int*)(C.ws + WS_EIDX); float* gate = (float*)(C.ws + WS_GATE);
    constexpr int NR = 2;
    for (int mb = gw; mb < T; mb += NR * NGW) {
        f32x4 vv[NR][4]; u32x2 ya[NR][4], yb[NR][4]; float g0v[NR], g1v[NR];
#pragma unroll
        for (int r = 0; r < NR; ++r) { const int m = mb + r * NGW; if (m < T) { const f32x4* xr = (const f32x4*)((src ? src : C.out) + (size_t)m * D) + lane;
#pragma unroll
            for (int j = 0; j < 4; ++j) vv[r][j] = xr[64 * j];
            if (src) { f32x4* xo = (f32x4*)(C.out + (size_t)m * D) + lane;
#pragma unroll
                for (int j = 0; j < 4; ++j) xo[64 * j] = vv[r][j]; }
            if (combine) { const int* slotof = (const int*)(C.ws + WS_SLOTOF); const float* gt = (const float*)(C.ws + WS_GATE); const bf16* YS = (const bf16*)(C.ws + WS_YS);
                const int s0 = slotof[2 * m], s1 = slotof[2 * m + 1]; g0v[r] = gt[2 * m]; g1v[r] = gt[2 * m + 1];
                const u32x2* y0 = (const u32x2*)(YS + (size_t)s0 * D) + lane; const u32x2* y1 = (const u32x2*)(YS + (size_t)s1 * D) + lane;
#pragma unroll
                for (int j = 0; j < 4; ++j) { ya[r][j] = y0[64 * j]; yb[r][j] = y1[64 * j]; } } } }
#pragma unroll
        for (int r = 0; r < NR; ++r) { const int m = mb + r * NGW; if (m < T) {
        f32x4* xr = (f32x4*)(C.out + (size_t)m * D) + lane;
        f32x4 v[4]; float s = 0.f;
#pragma unroll
        for (int j = 0; j < 4; ++j) v[j] = vv[r][j];
        if (combine) {
            const float g0 = g0v[r], g1 = g1v[r];
#pragma unroll
            for (int j = 0; j < 4; ++j) { const u32x2 a = ya[r][j], b = yb[r][j];
                v[j].x += g0 * bflo(a.x) + g1 * bflo(b.x); v[j].y += g0 * bfhi(a.x) + g1 * bfhi(b.x); v[j].z += g0 * bflo(a.y) + g1 * bflo(b.y); v[j].w += g0 * bfhi(a.y) + g1 * bfhi(b.y);
                xr[64 * j] = v[j]; }
        }
#pragma unroll
        for (int j = 0; j < 4; ++j) s += (v[j].x * v[j].x + v[j].y * v[j].y) + (v[j].z * v[j].z + v[j].w * v[j].w);
        const float rs = 1.0f / sqrtf(wave_sum(s, C.lane) * (1.f / D) + 1e-6f);
        unsigned long long* o8 = (unsigned long long*)(H + (size_t)m * D) + lane;
#pragma unroll
        for (int j = 0; j < 4; ++j) { v[j] = v[j] * rs * g[j]; if (want_bf16) o8[64 * j] = (unsigned long long)cvt_pk_bf16(v[j].x, v[j].y) | ((unsigned long long)cvt_pk_bf16(v[j].z, v[j].w) << 32);
            ((unsigned*)(C.ws + WS_H8 + (size_t)m * D))[lane + 64 * j] = pk4_fp8(v[j].x * F8_MUL_X, v[j].y * F8_MUL_X, v[j].z * F8_MUL_X, v[j].w * F8_MUL_X); }
        if (route) {
            float lg[8];
#pragma unroll
            for (int e = 0; e < 8; ++e) lg[e] = 0.f;
#pragma unroll
            for (int j = 0; j < 4; ++j)
#pragma unroll
                for (int q = 0; q < 4; ++q) { const int k = 4 * (lane + 64 * j) + q; const f32x4 r0 = *(const f32x4*)(router + (size_t)k * 8), r1 = *(const f32x4*)(router + (size_t)k * 8 + 4); const float hv = v[j][q];
                    lg[0] += hv * r0.x; lg[1] += hv * r0.y; lg[2] += hv * r0.z; lg[3] += hv * r0.w; lg[4] += hv * r1.x; lg[5] += hv * r1.y; lg[6] += hv * r1.z; lg[7] += hv * r1.w; }
#pragma unroll
            for (int e = 0; e < 8; ++e) lg[e] = wave_sum(lg[e], C.lane);
            int e0 = 0; float b0 = lg[0];
#pragma unroll
            for (int e = 1; e < 8; ++e) if (lg[e] > b0) { b0 = lg[e]; e0 = e; }
            int e1 = -1; float b1 = -3.0e38f;
#pragma unroll
            for (int e = 0; e < 8; ++e) if (e != e0 && lg[e] > b1) { b1 = lg[e]; e1 = e; }
            const float p1 = __expf(b1 - b0), inv = 1.f / (1.f + p1);
            if (lane == 0) { eidx[2 * m] = e0; eidx[2 * m + 1] = e1; gate[2 * m] = inv; gate[2 * m + 1] = p1 * inv; atomicAdd((unsigned*)&lcnt[e0], 1u); atomicAdd((unsigned*)&lcnt[e1], 1u); }
        }
        } }
    }
    if (route) { __syncthreads(); if (C.tid < 8) { unsigned* cw = (unsigned*)(C.ws + WS_CTL) + CW_MOE + moe_idx * 64; atomicAdd(&cw[C.tid], lcnt[C.tid]); } }
}

__device__ __forceinline__ void ph_rw_prep_(const Ctx& C, int l) {
    const bf16* RW = (const bf16*)(C.ws + WS_RW); bf16* RKVS = (bf16*)(C.ws + WS_RKVS); bf16* AL = (bf16*)(C.ws + WS_ALORA);
    const float* mu = C.in[I_RW_MU] + (size_t)l * 1024;
    const size_t gid = (size_t)C.bid * NTHR + C.tid, gsz = (size_t)C.G * NTHR;
    constexpr int NI = 4;
    for (size_t it0 = gid; it0 < (size_t)T * 128; it0 += NI * gsz) {
        u32x4 cuv[NI], pvv[NI];
#pragma unroll
        for (int r = 0; r < NI; ++r) { const size_t it = it0 + r * gsz; cuv[r] = (u32x4){0u, 0u, 0u, 0u}; pvv[r] = cuv[r];
            if (it < (size_t)T * 128) { const int m = (int)(it >> 7), c8 = (int)(it & 127) * 8, t = m & (SEQ - 1);
                cuv[r] = *(const u32x4*)(RW + (size_t)m * 1024 + c8); if (t) pvv[r] = *(const u32x4*)(RW + (size_t)(m - 1) * 1024 + c8); } }
#pragma unroll
        for (int r = 0; r < NI; ++r) { const size_t it = it0 + r * gsz; if (it < (size_t)T * 128) {
        const int m = (int)(it >> 7), c8 = (int)(it & 127) * 8;
        float a[8], b[8]; unpack8(cuv[r], a); unpack8(pvv[r], b);
        const f32x4 m0 = *(const f32x4*)(mu + c8), m1 = *(const f32x4*)(mu + c8 + 4);
        const float mm[8] = {m0.x, m0.y, m0.z, m0.w, m1.x, m1.y, m1.z, m1.w};
#pragma unroll
        for (int e = 0; e < 8; ++e) a[e] = a[e] + (b[e] - a[e]) * mm[e];
        if (c8 < 768) { *(u32x4*)(RKVS + (size_t)m * 768 + c8) = pack8(a); }
        else {
            if (c8 < 832) {
#pragma unroll
                for (int e = 0; e < 8; ++e) a[e] = 1.f - 2.f * __builtin_amdgcn_rcpf(1.f + __builtin_amdgcn_exp2f(2.f * LOG2E * a[e]));
            } else if (c8 >= 896) {
#pragma unroll
                for (int e = 0; e < 8; ++e) a[e] = sigm(a[e]);
            }
            *(u32x4*)(AL + (size_t)m * 256 + (c8 - 768)) = pack8(a);
        } } }
    }
}

__device__ __forceinline__ void ph_sb_prep_(const Ctx& C, int l) {
    bf16* SB = (bf16*)(C.ws + WS_SB);
    const int gw = C.bid * NWAVES + C.wave, NGW = C.G * NWAVES, lane = C.lane;
    const bool isk = lane >= 32; const int d0 = (lane & 7) * 8;
    const float* gn = (isk ? C.in[I_SB_KN] : C.in[I_SB_QN]) + (size_t)l * 64 + d0;
    float gg[8];
#pragma unroll
    for (int e = 0; e < 8; ++e) gg[e] = gn[e] * (isk ? 1.f : 0.125f * LOG2E);
    constexpr int NR = 4;
    for (int mb = gw; mb < T; mb += NR * NGW) {
        u32x4 uu[NR];
#pragma unroll
        for (int r = 0; r < NR; ++r) { const int m = mb + r * NGW; uu[r] = (u32x4){0u, 0u, 0u, 0u}; if (m < T) uu[r] = *(const u32x4*)(SB + (size_t)m * 768 + lane * 8); }
#pragma unroll
        for (int r = 0; r < NR; ++r) { const int m = mb + r * NGW; if (m < T) {
            bf16* p = SB + (size_t)m * 768 + lane * 8;
            float a[8]; unpack8(uu[r], a);
            float ss = 0.f;
#pragma unroll
            for (int e = 0; e < 8; ++e) ss += a[e] * a[e];
            ss += shx(ss, 1, lane); ss += shx(ss, 2, lane); ss += shx(ss, 4, lane);
            const float rs = 1.0f / sqrtf(ss * (1.f / 64.f) + 1e-6f);
#pragma unroll
            for (int e = 0; e < 8; ++e) a[e] = a[e] * rs * gg[e];
            *(u32x4*)p = pack8(a); } }
    }
}

__device__ __forceinline__ void ph_conv_(const Ctx& C, int l) {
    const bf16* CV = (const bf16*)(C.ws + WS_CV); bf16* Y = (bf16*)(C.ws + WS_Y);
    LAS float* U = (LAS float*)(C.lds); LAS float* OC = (LAS float*)(C.lds + 65536);
    const int tid = C.tid, c = tid & 255, half = tid >> 8;
    const float* dw = C.in[I_CONV_DW] + (size_t)l * 31 * 256; const float db = C.in[I_CONV_B][l * 256 + c];
    float dwr[31];
#pragma unroll
    for (int j = 0; j < 31; ++j) dwr[j] = dw[j * 256 + c];
    const float* lnw = C.in[I_CONV_LNW] + (size_t)l * 256; const float* lnb = C.in[I_CONV_LNB] + (size_t)l * 256;
    for (int u = C.bid; u < T / 32; u += C.G) {
        const int m0 = u * 32, t0 = m0 & (SEQ - 1);
        for (int it = tid; it < 62 * 32; it += NTHR) {
            const int r = it >> 5, c8 = (it & 31) * 8, tt = t0 - 30 + r; float a[8], b[8];
            if (tt >= 0) { const size_t mm = (size_t)(m0 - 30 + r); unpack8(*(const u32x4*)(CV + mm * 512 + c8), a); unpack8(*(const u32x4*)(CV + mm * 512 + 256 + c8), b);
#pragma unroll
                for (int e = 0; e < 8; ++e) a[e] = a[e] * sigm(b[e]); }
            else {
#pragma unroll
                for (int e = 0; e < 8; ++e) a[e] = 0.f; }
#pragma unroll
            for (int e = 0; e < 8; ++e) U[r * 256 + c8 + e] = a[e];
        }
        __syncthreads();
        { float win[46];
#pragma unroll
          for (int i = 0; i < 46; ++i) win[i] = U[(half * 16 + i) * 256 + c];
#pragma unroll
          for (int tt = 0; tt < 16; ++tt) { float acc = db;
#pragma unroll
              for (int j = 0; j < 31; ++j) acc += dwr[j] * win[tt + j];
              OC[(half * 16 + tt) * 256 + c] = acc; } }
        __syncthreads();
#pragma unroll 1
        for (int q = 0; q < 4; ++q) { const int tl = C.wave * 4 + q; float v[4]; float s = 0.f;
#pragma unroll
            for (int i = 0; i < 4; ++i) { v[i] = OC[tl * 256 + C.lane + 64 * i]; s += v[i]; }
            const float mean = wave_sum(s, C.lane) * (1.f / 256.f); float s2 = 0.f;
#pragma unroll
            for (int i = 0; i < 4; ++i) { v[i] -= mean; s2 += v[i] * v[i]; }
            const float rstd = 1.0f / sqrtf(wave_sum(s2, C.lane) * (1.f / 256.f) + 1e-5f);
#pragma unroll
            for (int i = 0; i < 4; ++i) { const int cc = C.lane + 64 * i; const float y = v[i] * rstd * lnw[cc] + lnb[cc]; Y[(size_t)(m0 + tl) * 1024 + 768 + cc] = f2bf(y * sigm(y)); } }
        __syncthreads();
    }
}

__device__ __forceinline__ float ret_log2gamma(int h) { return log2f(1.0f - exp2f(-5.0f - (float)h)); }
__device__ __forceinline__ void ret_load_rot(const Ctx& C, const bf16* RET, int m0, int coff, float scale, LAS float* dst) {
    const int s = C.tid >> 3, d0 = (C.tid & 7) * 4;
    const float* cs = (const float*)(C.ws + WS_COS); const float* sn = (const float*)(C.ws + WS_SIN);
    const int pos = (m0 + s) & (SEQ - 1);
    const u32x2 a = *(const u32x2*)(RET + (size_t)(m0 + s) * 1024 + coff + d0), b = *(const u32x2*)(RET + (size_t)(m0 + s) * 1024 + coff + 32 + d0);
    const float x1[4] = {bflo(a.x), bfhi(a.x), bflo(a.y), bfhi(a.y)}, x2[4] = {bflo(b.x), bfhi(b.x), bflo(b.y), bfhi(b.y)};
    const f32x4 cv = *(const f32x4*)(cs + (size_t)pos * 32 + d0), sv = *(const f32x4*)(sn + (size_t)pos * 32 + d0);
#pragma unroll
    for (int e = 0; e < 4; ++e) { dst[s * 65 + d0 + e] = (x1[e] * cv[e] - x2[e] * sv[e]) * scale; dst[s * 65 + 32 + d0 + e] = (x1[e] * sv[e] + x2[e] * cv[e]) * scale; }
}
__device__ __forceinline__ void ph_ret_kv_(const Ctx& C) {
    const bf16* RET = (const bf16*)(C.ws + WS_RET); float* KV = (float*)(C.ws + WS_KV);
    LAS float* KD = (LAS float*)(C.lds); LAS float* VV = (LAS float*)(C.lds + 32768);
    const int tid = C.tid;
    for (int u = C.bid; u < 2048; u += C.G) {
        const int bh = u >> 8, ch = u & 255, b = bh >> 2, h = bh & 3, m0 = b * SEQ + ch * 64;
        const float lg = ret_log2gamma(h);
        ret_load_rot(C, RET, m0, 256 + h * 64, 0.125f, KD);
        { const int s = tid >> 3, e0 = (tid & 7) * 8; float a[8]; unpack8(*(const u32x4*)(RET + (size_t)(m0 + s) * 1024 + 512 + h * 64 + e0), a);
          const float dec = exp2f(lg * (float)(63 - s));
#pragma unroll
          for (int e = 0; e < 8; ++e) VV[s * 64 + e0 + e] = a[e] * dec; }
        __syncthreads();
        const int d = tid >> 3, e0 = (tid & 7) * 8; float acc[8];
#pragma unroll
        for (int e = 0; e < 8; ++e) acc[e] = 0.f;
#pragma unroll 4
        for (int s = 0; s < 64; ++s) { const float kd = KD[s * 65 + d]; const f32x4 v0 = *(const LAS f32x4*)(VV + s * 64 + e0), v1 = *(const LAS f32x4*)(VV + s * 64 + e0 + 4);
            acc[0] += kd * v0.x; acc[1] += kd * v0.y; acc[2] += kd * v0.z; acc[3] += kd * v0.w; acc[4] += kd * v1.x; acc[5] += kd * v1.y; acc[6] += kd * v1.z; acc[7] += kd * v1.w; }
        float* o = KV + (size_t)u * 4096 + d * 64 + e0;
        *(f32x4*)o = (f32x4){acc[0], acc[1], acc[2], acc[3]}; *(f32x4*)(o + 4) = (f32x4){acc[4], acc[5], acc[6], acc[7]};
        __syncthreads();
    }
}
__device__ __forceinline__ void ph_ret_scan_(const Ctx& C) {
    float* KV = (float*)(C.ws + WS_KV);
    const int wg0 = (C.G >= 256) ? 128 : 0, nw = C.G - wg0;
    for (int i = (C.bid - wg0) * NTHR + C.tid; i < 8 * 4096 && C.bid >= wg0; i += nw * NTHR) {
        const int bh = i >> 12, el = i & 4095, h = bh & 3;
        const float cd = exp2f(ret_log2gamma(h) * 64.f);
        float* p = KV + (size_t)bh * 256 * 4096 + el; float S = 0.f;
#pragma unroll 1
        for (int c = 0; c < 256; c += 32) { float kv[32];
#pragma unroll
            for (int q = 0; q < 32; ++q) kv[q] = p[(size_t)(c + q) * 4096];
#pragma unroll
            for (int q = 0; q < 32; ++q) { p[(size_t)(c + q) * 4096] = S; S = S * cd + kv[q]; } }
    }
}
__device__ __forceinline__ void ph_ret_out_(const Ctx& C, int l, int first_wg, int nwg) {
    const bf16* RET = (const bf16*)(C.ws + WS_RET); const float* KV = (const float*)(C.ws + WS_KV); bf16* Y = (bf16*)(C.ws + WS_Y);
    LAS float* Q = (LAS float*)(C.lds); LAS float* Kk = (LAS float*)(C.lds + 16640); LAS float* VV = (LAS float*)(C.lds + 33280); LAS float* SS = (LAS float*)(C.lds + 49664); LAS float* SC = (LAS float*)(C.lds + 66048);
    const int tid = C.tid; const float* gn = C.in[I_RET_GN] + (size_t)l * 256;
    for (int u = C.bid - first_wg; u < 2048; u += nwg) {
        const int bh = u >> 8, ch = u & 255, b = bh >> 2, h = bh & 3, m0 = b * SEQ + ch * 64;
        const float lg = ret_log2gamma(h);
        ret_load_rot(C, RET, m0, h * 64, 1.0f, Q);
        ret_load_rot(C, RET, m0, 256 + h * 64, 0.125f, Kk);
        { const int s = tid >> 3, e0 = (tid & 7) * 8; float a[8]; unpack8(*(const u32x4*)(RET + (size_t)(m0 + s) * 1024 + 512 + h * 64 + e0), a);
#pragma unroll
          for (int e = 0; e < 8; ++e) VV[s * 64 + e0 + e] = a[e];
          const float* sp = KV + (size_t)u * 4096 + s * 64 + e0; const f32x4 s0 = *(const f32x4*)sp, s1 = *(const f32x4*)(sp + 4);
          *(LAS f32x4*)(SS + s * 64 + e0) = s0; *(LAS f32x4*)(SS + s * 64 + e0 + 4) = s1; }
        __syncthreads();
        const int t = tid >> 3, g8 = tid & 7;
        { float sc[8];
#pragma unroll
          for (int i = 0; i < 8; ++i) sc[i] = 0.f;
#pragma unroll 4
          for (int d = 0; d < 64; ++d) { const float qv = Q[t * 65 + d];
#pragma unroll
              for (int i = 0; i < 8; ++i) sc[i] += qv * Kk[(g8 * 8 + i) * 65 + d]; }
#pragma unroll
          for (int i = 0; i < 8; ++i) { const int s = g8 * 8 + i; SC[t * 65 + s] = (s <= t) ? sc[i] * exp2f(lg * (float)(t - s)) : 0.f; } }
        __syncthreads();
        { const int e0 = g8 * 8; float o[8], o2[8];
#pragma unroll
          for (int e = 0; e < 8; ++e) { o[e] = 0.f; o2[e] = 0.f; }
#pragma unroll 4
          for (int s = 0; s < 64; ++s) { const float p = SC[t * 65 + s]; const f32x4 v0 = *(const LAS f32x4*)(VV + s * 64 + e0), v1 = *(const LAS f32x4*)(VV + s * 64 + e0 + 4);
              o[0] += p * v0.x; o[1] += p * v0.y; o[2] += p * v0.z; o[3] += p * v0.w; o[4] += p * v1.x; o[5] += p * v1.y; o[6] += p * v1.z; o[7] += p * v1.w; }
#pragma unroll 4
          for (int d = 0; d < 64; ++d) { const float qv = Q[t * 65 + d]; const f32x4 v0 = *(const LAS f32x4*)(SS + d * 64 + e0), v1 = *(const LAS f32x4*)(SS + d * 64 + e0 + 4);
              o2[0] += qv * v0.x; o2[1] += qv * v0.y; o2[2] += qv * v0.z; o2[3] += qv * v0.w; o2[4] += qv * v1.x; o2[5] += qv * v1.y; o2[6] += qv * v1.z; o2[7] += qv * v1.w; }
          const float qd = exp2f(lg * (float)(t + 1)); float s1 = 0.f;
#pragma unroll
          for (int e = 0; e < 8; ++e) { o[e] += qd * o2[e]; s1 += o[e]; }
          s1 += shx(s1, 1, C.lane); s1 += shx(s1, 2, C.lane); s1 += shx(s1, 4, C.lane);
          const float mean = s1 * (1.f / 64.f); float s2 = 0.f;
#pragma unroll
          for (int e = 0; e < 8; ++e) { o[e] -= mean; s2 += o[e] * o[e]; }
          s2 += shx(s2, 1, C.lane); s2 += shx(s2, 2, C.lane); s2 += shx(s2, 4, C.lane);
          const float rstd = 1.0f / sqrtf(s2 * (1.f / 64.f) + 1e-5f);
          float gtv[8]; unpack8(*(const u32x4*)(RET + (size_t)(m0 + t) * 1024 + 768 + h * 64 + e0), gtv);
#pragma unroll
          for (int e = 0; e < 8; ++e) o[e] = o[e] * rstd * gn[h * 64 + e0 + e] * (gtv[e] * sigm(gtv[e]));
          *(u32x4*)(Y + (size_t)(m0 + t) * 1024 + 512 + h * 64 + e0) = pack8(o); }
        __syncthreads();
    }
}

constexpr int RWC = 64, RW_NCH = SEQ / RWC, RW_NU = 8 * RW_NCH;
constexpr int RW_SUP = 8, RW_NSC = RW_NCH / RW_SUP, RW_NSUP = 8 * RW_NSC;
__device__ __forceinline__ void ph_rw_local_(const Ctx& C, int l) {
    const bf16* RKVS = (const bf16*)(C.ws + WS_RKVS); const float* WDEC = (const float*)(C.ws + WS_WDEC); const bf16* AG = (const bf16*)(C.ws + WS_AG);
    bf16* Y0 = (bf16*)(C.ws + WS_Y0); bf16* RH = (bf16*)(C.ws + WS_RHAT); float* PQ = (float*)(C.ws + WS_PQ); float* BON = (float*)(C.ws + WS_BON);
    const int lane = C.lane;
    LAS float* base = (LAS float*)(C.lds + C.wave * 12288);
    for (int it = C.bid; it < RW_NU / 8; it += C.G) {
        const int u = it * 8 + C.wave, bh = u >> 8, ch = u & 255, b = bh >> 2, h = bh & 3, m0 = b * SEQ + ch * RWC, hc = h * 64 + lane;
        const float kkw = C.in[I_RW_KK][l * 256 + hc], kaw = C.in[I_RW_KA][l * 256 + hc], rkw = C.in[I_RW_RK][l * 256 + hc], w0l = C.in[I_RW_W0][l * 256 + hc], a0l = C.in[I_RW_A0][l * 256 + hc];
        f32x2 sL[32], sI[32];
        { int ln = lane; asm volatile("" : "+v"(ln));
#pragma unroll
          for (int k = 0; k < 32; ++k) { sL[k] = (f32x2){0.f, 0.f}; sI[k].x = (2 * k == ln) ? 1.f : 0.f; sI[k].y = (2 * k + 1 == ln) ? 1.f : 0.f; } }
#pragma unroll 1
        for (int sb = 0; sb < RWC / 8; ++sb) {
            asm volatile("" ::: "memory");
#pragma unroll
            for (int i = 0; i < 8; ++i) { const size_t m = (size_t)(m0 + sb * 8 + i);
                const float r = bf2f(RKVS[m * 768 + hc]), k = bf2f(RKVS[m * 768 + 256 + hc]), v = bf2f(RKVS[m * 768 + 512 + hc]);
                const float w = __builtin_amdgcn_exp2f(-0.606531f * LOG2E * sigm(WDEC[m * 256 + hc] + w0l)), a = sigm(bf2f(AG[m * 512 + hc]) + a0l);
                const float kr = k * kkw; const float nn = sqrtf(wave_sum(kr * kr, C.lane)); const float kk = kr / fmaxf(nn, 1e-12f);
                const float kp = k * (1.f + (a - 1.f) * kaw);
                const float bon = wave_sum(r * kp * rkw, C.lane);
                if (lane == 0) BON[m * 4 + h] = bon;
                base[0 * 512 + i * 64 + lane] = w; base[1 * 512 + i * 64 + lane] = kk; base[2 * 512 + i * 64 + lane] = kk * a; base[3 * 512 + i * 64 + lane] = kp; base[4 * 512 + i * 64 + lane] = r; base[5 * 512 + i * 64 + lane] = v; }
            asm volatile("" ::: "memory");
#pragma unroll 1
            for (int i = 0; i < 8; ++i) {
                const LAS f32x4* wv = (const LAS f32x4*)(base + 0 * 512 + i * 64); const LAS f32x4* kkv = (const LAS f32x4*)(base + 1 * 512 + i * 64); const LAS f32x4* kav = (const LAS f32x4*)(base + 2 * 512 + i * 64);
                const LAS f32x4* kpv = (const LAS f32x4*)(base + 3 * 512 + i * 64); const LAS f32x4* rv = (const LAS f32x4*)(base + 4 * 512 + i * 64);
                const float vv = base[5 * 512 + i * 64 + lane];
                f32x4 kq[2][4];
#pragma unroll
                for (int t = 0; t < 4; ++t) kq[0][t] = kkv[t];
                f32x2 dL0 = (f32x2){0.f, 0.f}, dL1 = dL0, dI0 = dL0, dI1 = dL0;
                f32x4 ga[2][4];
#pragma unroll
                for (int g = 0; g < 4; ++g) {
                    __builtin_amdgcn_sched_barrier(0);
                    if (g + 1 < 4) {
#pragma unroll
                        for (int t = 0; t < 4; ++t) kq[(g + 1) & 1][t] = kkv[4 * (g + 1) + t]; }
                    else { ga[0][0] = wv[0]; ga[0][1] = kav[0]; ga[0][2] = kpv[0]; ga[0][3] = rv[0]; }
                    __builtin_amdgcn_sched_barrier(0);
#pragma unroll
                    for (int t = 0; t < 4; ++t) { const int k4 = 4 * g + t; const f32x4 q4 = kq[g & 1][t];
                        dL0 += sL[2 * k4] * q4.xy; dL1 += sL[2 * k4 + 1] * q4.zw; dI0 += sI[2 * k4] * q4.xy; dI1 += sI[2 * k4 + 1] * q4.zw; }
                }
                const float saL = -((dL0.x + dL0.y) + (dL1.x + dL1.y)), saI = -((dI0.x + dI0.y) + (dI1.x + dI1.y));
                const f32x2 saLv = (f32x2){saL, saL}, saIv = (f32x2){saI, saI}, vvv = (f32x2){vv, vv};
                f32x2 yL0 = (f32x2){0.f, 0.f}, yL1 = yL0, yI0 = yL0, yI1 = yL0;
#pragma unroll
                for (int k4 = 0; k4 < 16; ++k4) {
                    __builtin_amdgcn_sched_barrier(0);
                    if (k4 + 1 < 16) { ga[(k4 + 1) & 1][0] = wv[k4 + 1]; ga[(k4 + 1) & 1][1] = kav[k4 + 1]; ga[(k4 + 1) & 1][2] = kpv[k4 + 1]; ga[(k4 + 1) & 1][3] = rv[k4 + 1]; }
                    __builtin_amdgcn_sched_barrier(0);
                    const f32x4 wq = ga[k4 & 1][0], aq = ga[k4 & 1][1], pq = ga[k4 & 1][2], rq = ga[k4 & 1][3];
                    sL[2 * k4]     = sL[2 * k4]     * wq.xy + saLv * aq.xy + vvv * pq.xy; yL0 += sL[2 * k4]     * rq.xy;
                    sL[2 * k4 + 1] = sL[2 * k4 + 1] * wq.zw + saLv * aq.zw + vvv * pq.zw; yL1 += sL[2 * k4 + 1] * rq.zw;
                    sI[2 * k4]     = sI[2 * k4]     * wq.xy + saIv * aq.xy;                  yI0 += sI[2 * k4]     * rq.xy;
                    sI[2 * k4 + 1] = sI[2 * k4 + 1] * wq.zw + saIv * aq.zw;                  yI1 += sI[2 * k4 + 1] * rq.zw;
                }
                __builtin_amdgcn_sched_barrier(0);
                const size_t m = (size_t)(m0 + sb * 8 + i);
                Y0[m * 256 + hc] = f2bf((yL0.x + yL0.y) + (yL1.x + yL1.y));
                RH[m * 256 + hc] = f2bf((yI0.x + yI0.y) + (yI1.x + yI1.y));
            }
        }
        float* oq = PQ + (size_t)u * 4096 + lane * 64; float* opt = PQ + ((size_t)RW_NU + u) * 4096 + lane;
#pragma unroll
        for (int k4 = 0; k4 < 16; ++k4) { *(f32x4*)(oq + 4 * k4) = (f32x4){sL[2 * k4].x, sL[2 * k4].y, sL[2 * k4 + 1].x, sL[2 * k4 + 1].y};
            opt[(4 * k4) * 64] = sI[2 * k4].x; opt[(4 * k4 + 1) * 64] = sI[2 * k4].y; opt[(4 * k4 + 2) * 64] = sI[2 * k4 + 1].x; opt[(4 * k4 + 3) * 64] = sI[2 * k4 + 1].y; }
    }
}
constexpr int WY_LT = 24;
constexpr int WY_ROWM = 0, WY_COLM = 36864, WY_AMAT = 73728, WY_AABF = 89088, WY_SB = 93184, WY_WT = 111616, WY_UT = 117760, WY_GH = 123904, WY_GC = 125952;
__device__ __forceinline__ f32x4 wy_mm16(const LAS bf16* X, const LAS bf16* Y, f32x4 acc, int li, int lq) {
#pragma unroll
    for (int ks = 0; ks < 2; ++ks) { const bf16x8 a = *(const LAS bf16x8*)(X + li * MM_LP + 32 * ks + 8 * lq), b = *(const LAS bf16x8*)(Y + li * MM_LP + 32 * ks + 8 * lq);
        acc = __builtin_amdgcn_mfma_f32_16x16x32_bf16(a, b, acc, 0, 0, 0); }
    return acc;
}
__device__ __forceinline__ f32x4 wy_mm16k16(const LAS bf16* X, const LAS bf16* Y, f32x4 acc, int li, int lq) {
    const s16x4 a = *(const LAS s16x4*)(X + li * WY_LT + 4 * lq), b = *(const LAS s16x4*)(Y + li * WY_LT + 4 * lq);
    return __builtin_amdgcn_mfma_f32_16x16x16bf16_1k(a, b, acc, 0, 0, 0);
}
__device__ __forceinline__ void ph_rw_local_wy_(const Ctx& C, int l) {
    const bf16* RKVS = (const bf16*)(C.ws + WS_RKVS); const float* WDEC = (const float*)(C.ws + WS_WDEC); const bf16* AG = (const bf16*)(C.ws + WS_AG);
    bf16* Y0 = (bf16*)(C.ws + WS_Y0); bf16* RH = (bf16*)(C.ws + WS_RHAT); float* PQ = (float*)(C.ws + WS_PQ); float* BON = (float*)(C.ws + WS_BON);
    const int lane = C.lane, w = C.wave, li = lane & 15, lq = lane >> 4, j32 = lane & 31, hi = lane >> 5, ti = w >> 1, tj = w & 1, sq = w >> 1, half = w & 1;
    LAS unsigned char* L = C.lds;
#define WY_ROW(q, m) ((LAS bf16*)(L + WY_ROWM + (q) * 9216 + (m) * 2304))
#define WY_COL(q, m) ((LAS bf16*)(L + WY_COLM + (q) * 9216 + (m) * 3072))
#define WY_A(q, id)  ((LAS bf16*)(L + WY_AMAT + (q) * 3840 + (id) * 768))
    LAS bf16* SB = (LAS bf16*)(L + WY_SB); LAS bf16* WT = (LAS bf16*)(L + WY_WT); LAS bf16* UT = (LAS bf16*)(L + WY_UT);
    LAS float* GH = (LAS float*)(L + WY_GH); LAS float* GCs = (LAS float*)(L + WY_GC);
    for (int su = C.bid; su < RW_NSUP; su += C.G) {
    f32x16 S;
#pragma unroll 1
    for (int cc = 0; cc < RW_SUP; ++cc) {
        const int u = su * RW_SUP + cc;
        const int bh = u >> 8, ch = u & 255, b = bh >> 2, h = bh & 3, m0 = b * SEQ + ch * RWC, hc = h * 64 + lane;
        const float kkw = C.in[I_RW_KK][l * 256 + hc], kaw = C.in[I_RW_KA][l * 256 + hc], rkw = C.in[I_RW_RK][l * 256 + hc], w0l = C.in[I_RW_W0][l * 256 + hc], a0l = C.in[I_RW_A0][l * 256 + hc];
        { float wv[8], kk[8], ka[8], kp[8], rr[8], vv[8];
#pragma unroll
          for (int i = 0; i < 8; ++i) { const size_t m = (size_t)(m0 + 8 * w + i);
              const float r = bf2f(RKVS[m * 768 + hc]), k = bf2f(RKVS[m * 768 + 256 + hc]); vv[i] = bf2f(RKVS[m * 768 + 512 + hc]);
              wv[i] = __builtin_amdgcn_exp2f(-0.606531f * LOG2E * sigm(WDEC[m * 256 + hc] + w0l)); const float a = sigm(bf2f(AG[m * 512 + hc]) + a0l);
              const float kr = k * kkw; kk[i] = kr * __builtin_amdgcn_rsqf(fmaxf(wave_sum(kr * kr, lane), 1e-24f));
              kp[i] = k * (1.f + (a - 1.f) * kaw); ka[i] = kk[i] * a; rr[i] = r;
              const float bon = wave_sum(r * kp[i] * rkw, lane);
              if (lane == 0) BON[m * 4 + h] = bon; }
          float cp[8]; cp[0] = wv[0];
#pragma unroll
          for (int i = 1; i < 8; ++i) cp[i] = cp[i - 1] * wv[i];
          GH[w * 64 + lane] = cp[7];
          __syncthreads();
          const float pre = half ? GH[(w - 1) * 64 + lane] : 1.f, gC = half ? pre * cp[7] : cp[7] * GH[(w + 1) * 64 + lane];
          if (!half) GCs[sq * 64 + lane] = gC;
#pragma unroll
          for (int i = 0; i < 8; ++i) { const int t = 8 * half + i; const float G = pre * cp[i], Gm1 = (i == 0) ? pre : pre * cp[i - 1], rG = __builtin_amdgcn_rcpf(G);
              WY_ROW(sq, 0)[t * MM_LP + lane] = f2bf(-kk[i] * Gm1); WY_ROW(sq, 1)[t * MM_LP + lane] = f2bf(ka[i] * rG); WY_ROW(sq, 2)[t * MM_LP + lane] = f2bf(kp[i] * rG); WY_ROW(sq, 3)[t * MM_LP + lane] = f2bf(rr[i] * G);
              WY_COL(sq, 0)[lane * WY_LT + t] = f2bf(ka[i] * rG * gC); WY_COL(sq, 1)[lane * WY_LT + t] = f2bf(kp[i] * rG * gC); WY_COL(sq, 2)[lane * WY_LT + t] = f2bf(vv[i]); } }
        __syncthreads();
#pragma unroll
        for (int pp = 0; pp < 2; ++pp) { const int id = 2 * half + pp;
            f32x4 acc = (f32x4){0.f, 0.f, 0.f, 0.f};
            acc = wy_mm16(WY_ROW(sq, half ? 3 : 0), WY_ROW(sq, pp ? 2 : 1), acc, li, lq);
#pragma unroll
            for (int r = 0; r < 4; ++r) { const int t = 4 * lq + r; const bool keep = half ? (li <= t) : (li < t); const float val = keep ? acc[r] : 0.f;
                WY_A(sq, id)[t * WY_LT + li] = f2bf(val); if (id == 0) ((LAS float*)(L + WY_AABF + sq * 1024))[t * 16 + li] = val; } }
        __syncthreads();
        if (w < 4) { const LAS float* Af = (const LAS float*)(L + WY_AABF + w * 1024); float Tc[16];
#pragma unroll
            for (int t = 0; t < 16; ++t) { float acc = (t == li) ? 1.f : 0.f;
#pragma unroll
                for (int s4 = 0; s4 < 4; ++s4) { if (4 * s4 < t) { const f32x4 a4 = *(const LAS f32x4*)(Af + t * 16 + 4 * s4);
                    if (4 * s4 + 0 < t) acc += a4.x * Tc[4 * s4 + 0]; if (4 * s4 + 1 < t) acc += a4.y * Tc[4 * s4 + 1]; if (4 * s4 + 2 < t) acc += a4.z * Tc[4 * s4 + 2]; if (4 * s4 + 3 < t) acc += a4.w * Tc[4 * s4 + 3]; } }
                Tc[t] = acc; WY_A(w, 4)[t * WY_LT + li] = f2bf(acc); } }
        if (cc == 0) {
#pragma unroll
            for (int r = 0; r < 4; ++r)
#pragma unroll
                for (int e = 0; e < 4; ++e) { const int row = 32 * ti + 8 * r + 4 * hi + e, col = 32 * tj + j32; S[4 * r + e] = (ti >= 2 && row - 64 == col) ? 1.f : 0.f; }
#pragma unroll
            for (int r = 0; r < 4; ++r)
#pragma unroll
                for (int e = 0; e < 4; ++e) SB[(32 * ti + 8 * r + 4 * hi + e) * MM_LP + 32 * tj + j32] = f2bf(S[4 * r + e]);
        }
        __syncthreads();
#pragma unroll 1
        for (int q = 0; q < 4; ++q) {
            f32x4 accW = (f32x4){0.f, 0.f, 0.f, 0.f}, accY = accW;
            accW = wy_mm16(WY_ROW(q, 0), SB + 16 * w * MM_LP, accW, li, lq);
            accY = wy_mm16(WY_ROW(q, 3), SB + 16 * w * MM_LP, accY, li, lq);
            if (w < 4) accW = wy_mm16k16(WY_A(q, 1), WY_COL(q, 2) + 16 * w * WY_LT, accW, li, lq);
            { u32x2 pk; pk.x = cvt_pk_bf16(accW[0], accW[1]); pk.y = cvt_pk_bf16(accW[2], accW[3]); *(LAS u32x2*)(WT + (16 * w + li) * WY_LT + 4 * lq) = pk; }
            asm volatile("s_waitcnt lgkmcnt(0)" ::: "memory");
            { f32x4 accU = (f32x4){0.f, 0.f, 0.f, 0.f}; accU = wy_mm16k16(WY_A(q, 4), WT + 16 * w * WY_LT, accU, li, lq);
              u32x2 pk; pk.x = cvt_pk_bf16(accU[0], accU[1]); pk.y = cvt_pk_bf16(accU[2], accU[3]); *(LAS u32x2*)(UT + (16 * w + li) * WY_LT + 4 * lq) = pk; }
            asm volatile("s_waitcnt lgkmcnt(0)" ::: "memory");
            accY = wy_mm16k16(WY_A(q, 2), UT + 16 * w * WY_LT, accY, li, lq);
            if (w < 4) accY = wy_mm16k16(WY_A(q, 3), WY_COL(q, 2) + 16 * w * WY_LT, accY, li, lq);
            { bf16* dst = (w < 4) ? Y0 : RH; const int colo = h * 64 + ((16 * w) & 63) + li;
#pragma unroll
              for (int r = 0; r < 4; ++r) dst[(size_t)(m0 + 16 * q + 4 * lq + r) * 256 + colo] = f2bf(accY[r]); }
            __syncthreads();
            { const float gc = GCs[q * 64 + 32 * tj + j32];
#pragma unroll
              for (int i = 0; i < 16; ++i) S[i] *= gc;
              const bf16x8 ua = *(const LAS bf16x8*)(UT + (32 * ti + j32) * WY_LT + 8 * hi), bb = *(const LAS bf16x8*)(WY_COL(q, 0) + (32 * tj + j32) * WY_LT + 8 * hi);
              S = __builtin_amdgcn_mfma_f32_32x32x16_bf16(ua, bb, S, 0, 0, 0);
              if (ti < 2) { const bf16x8 va = *(const LAS bf16x8*)(WY_COL(q, 2) + (32 * ti + j32) * WY_LT + 8 * hi), kb = *(const LAS bf16x8*)(WY_COL(q, 1) + (32 * tj + j32) * WY_LT + 8 * hi);
                  S = __builtin_amdgcn_mfma_f32_32x32x16_bf16(va, kb, S, 0, 0, 0); } }
            {
#pragma unroll
                for (int r = 0; r < 4; ++r)
#pragma unroll
                    for (int e = 0; e < 4; ++e) SB[(32 * ti + 8 * r + 4 * hi + e) * MM_LP + 32 * tj + j32] = f2bf(S[4 * r + e]);
                __syncthreads(); }
        }
        if (cc == RW_SUP - 1) {
        if (ti < 2) { float* o = PQ + (size_t)su * 4096 + (size_t)(32 * ti + 4 * hi) * 64 + 32 * tj + j32;
#pragma unroll
            for (int r = 0; r < 4; ++r)
#pragma unroll
                for (int e = 0; e < 4; ++e) o[(8 * r + e) * 64] = S[4 * r + e]; }
        else { float* o = PQ + ((size_t)RW_NSUP + su) * 4096 + (size_t)(32 * tj + j32) * 64 + 32 * (ti - 2) + 4 * hi;
#pragma unroll
            for (int r = 0; r < 4; ++r) *(f32x4*)(o + 8 * r) = (f32x4){S[4 * r], S[4 * r + 1], S[4 * r + 2], S[4 * r + 3]}; }
        }
        __syncthreads();
    }
    }
#undef WY_ROW
#undef WY_COL
#undef WY_A
}
__device__ __forceinline__ void ph_rw_scan_(const Ctx& C, int wg) {
    const float* Qg = (const float*)(C.ws + WS_PQ); const float* Pg = Qg + (size_t)RW_NSUP * 4096; float* SST = (float*)(C.ws + WS_SST);
    LAS bf16* PT = (LAS bf16*)(C.lds);
    LAS bf16* SLb = PT + 2 * 64 * MM_LP;
    LAS float* QL = (LAS float*)(C.lds + (2 * 64 * MM_LP + 2 * 16 * MM_LP) * 2);
    LAS float* SO = QL + 2 * 16 * 64;
    const int lane = C.lane, wave = C.wave, bh = wg >> 2, rq = wg & 3, ct = wave & 3, li = lane & 15, lq = lane >> 4;
    const bool mm = wave < 4;
    const size_t ubase = (size_t)bh * RW_NSC;
    const int lt = C.tid & 255;
    const int qrow = lt >> 4, qc4 = (lt & 15) * 4;
    constexpr int PD = 6;
    f32x4 pr[PD][4], qr[PD];
#define SC_P_PIECE(i) (lt + 256 * (i))
#define SC_PUT_P(buf, sx_) do { LAS bf16* d_ = PT + (buf) * (64 * MM_LP); _Pragma("unroll") for (int i_ = 0; i_ < 4; ++i_) { const int idx_ = SC_P_PIECE(i_), r_ = (idx_ * 4) >> 6, k_ = (idx_ * 4) & 63; u32x2 w_; \
        w_.x = cvt_pk_bf16(pr[sx_][i_].x, pr[sx_][i_].y); w_.y = cvt_pk_bf16(pr[sx_][i_].z, pr[sx_][i_].w); *(LAS u32x2*)(d_ + r_ * MM_LP + k_) = w_; } } while (0)
#define SC_LOAD(sx_, cc) do { const f32x4* p4_ = (const f32x4*)(Pg + (ubase + (cc)) * 4096); _Pragma("unroll") for (int i_ = 0; i_ < 4; ++i_) pr[sx_][i_] = p4_[SC_P_PIECE(i_)]; \
        qr[sx_] = *(const f32x4*)(Qg + (ubase + (cc)) * 4096 + (rq * 16 + qrow) * 64 + qc4); } while (0)
    if (mm) {
#pragma unroll
        for (int r = 0; r < 4; ++r) SLb[(4 * lq + r) * MM_LP + ct * 16 + li] = (bf16)0;
    } else {
        { float z0; asm volatile("v_mov_b32 %0, 0" : "=v"(z0));
          *(f32x4*)(SST + ubase * 4096 + (rq * 16 + qrow) * 64 + qc4) = (f32x4){z0, z0, z0, z0}; }
        SC_LOAD(0, 0); SC_PUT_P(0, 0); *(LAS f32x4*)(QL + qrow * 64 + qc4) = qr[0];
#pragma unroll
        for (int x = 0; x < PD; ++x) SC_LOAD(x, 1 + x);
    }
    __syncthreads();
#pragma unroll 1
    for (int c2 = 0; c2 < RW_NSC; c2 += PD) {
#pragma unroll
        for (int x = 0; x < PD; ++x) {
            const int c = c2 + x;
            if (c < RW_NSC) {
            if (mm) {
                const LAS bf16* Pc = PT + (c & 1) * (64 * MM_LP); const LAS bf16* Sc = SLb + (c & 1) * (16 * MM_LP); const LAS float* Qc = QL + (c & 1) * (16 * 64);
                LAS bf16* Sn = SLb + ((c + 1) & 1) * (16 * MM_LP); LAS float* So = SO + ((c + 1) & 1) * (16 * 64);
                bf16x8 af[2], bfr[2];
#pragma unroll
                for (int ks = 0; ks < 2; ++ks) { af[ks] = *(const LAS bf16x8*)(Sc + li * MM_LP + 32 * ks + 8 * lq); bfr[ks] = *(const LAS bf16x8*)(Pc + (16 * ct + li) * MM_LP + 32 * ks + 8 * lq); }
                f32x4 acc;
#pragma unroll
                for (int r = 0; r < 4; ++r) acc[r] = Qc[(4 * lq + r) * 64 + ct * 16 + li];
#pragma unroll
                for (int ks = 0; ks < 2; ++ks) acc = __builtin_amdgcn_mfma_f32_16x16x32_bf16(af[ks], bfr[ks], acc, 0, 0, 0);
                if (c + 1 < RW_NSC) {
#pragma unroll
                    for (int r = 0; r < 4; ++r) { Sn[(4 * lq + r) * MM_LP + ct * 16 + li] = f2bf(acc[r]); So[(4 * lq + r) * 64 + ct * 16 + li] = acc[r]; } }
            } else {
                if (c > 0) *(f32x4*)(SST + (ubase + c) * 4096 + (rq * 16 + qrow) * 64 + qc4) = *(const LAS f32x4*)(SO + (c & 1) * (16 * 64) + qrow * 64 + qc4);
                if (c + 1 < RW_NSC) { SC_PUT_P((c + 1) & 1, x); *(LAS f32x4*)(QL + ((c + 1) & 1) * (16 * 64) + qrow * 64 + qc4) = qr[x]; }
                if (c + 1 + PD < RW_NSC) SC_LOAD(x, c + 1 + PD);
            }
            __syncthreads();
#ifdef SCAN_2BAR
            __syncthreads();
#endif
            }
        }
    }
#undef SC_PUT_P
#undef SC_LOAD
#undef SC_P_PIECE
}
__device__ __forceinline__ void ph_rw_out_(const Ctx& C, int l) {
    const bf16* RKVS = (const bf16*)(C.ws + WS_RKVS); const bf16* AG = (const bf16*)(C.ws + WS_AG); const bf16* Y0 = (const bf16*)(C.ws + WS_Y0); const bf16* RH = (const bf16*)(C.ws + WS_RHAT);
    const float* SST = (const float*)(C.ws + WS_SST); const float* BON = (const float*)(C.ws + WS_BON); bf16* Y = (bf16*)(C.ws + WS_Y);
    LAS float* RL = (LAS float*)(C.lds);
    const int lane = C.lane, wave = C.wave;
    for (int u = C.bid; u < RW_NU; u += C.G) {
        const int bh = u >> 8, ch = u & 255, b = bh >> 2, h = bh & 3, m0 = b * SEQ + ch * RWC, hc = h * 64 + lane;
        { const int t = C.tid >> 3, d0 = (C.tid & 7) * 8; float a[8];
          unpack8(*(const u32x4*)(RH + (size_t)(m0 + t) * 256 + h * 64 + d0), a);
#pragma unroll
          for (int e = 0; e < 8; ++e) RL[t * 64 + d0 + e] = a[e]; }
        float s[64];
        { const f32x4* sp = (const f32x4*)(SST + (size_t)u * 4096 + lane * 64);
#pragma unroll
          for (int k4 = 0; k4 < 16; ++k4) { const f32x4 v = sp[k4]; s[4 * k4] = v.x; s[4 * k4 + 1] = v.y; s[4 * k4 + 2] = v.z; s[4 * k4 + 3] = v.w; } }
        const float lnw = C.in[I_RW_LNW][l * 256 + hc], lnb = C.in[I_RW_LNB][l * 256 + hc];
        __syncthreads();
#pragma unroll 2
        for (int q = 0; q < 8; ++q) { const int t = wave * 8 + q; const size_t m = (size_t)(m0 + t);
            const LAS f32x4* rv = (const LAS f32x4*)(RL + t * 64);
            float y0 = 0.f, y1 = 0.f, y2 = 0.f, y3 = 0.f;
#pragma unroll
            for (int k4 = 0; k4 < 16; ++k4) { const f32x4 rq = rv[k4]; y0 += s[4 * k4] * rq.x; y1 += s[4 * k4 + 1] * rq.y; y2 += s[4 * k4 + 2] * rq.z; y3 += s[4 * k4 + 3] * rq.w; }
#ifndef RWDBG
#define RWDBG 0
#endif
            float y = ((RWDBG & 1) ? 0.f : (y0 + y1) + (y2 + y3)) + ((RWDBG & 2) ? 0.f : bf2f(Y0[m * 256 + hc]));
            const float mean = wave_sum(y, C.lane) * (1.f / 64.f); y -= mean;
            const float rstd = 1.0f / sqrtf(wave_sum(y * y, C.lane) * (1.f / 64.f) + 64e-5f);
            y = y * rstd * lnw + lnb;
            if (!(RWDBG & 4)) y += BON[m * 4 + h] * bf2f(RKVS[m * 768 + 512 + hc]);
            y *= bf2f(AG[m * 512 + 256 + hc]);
            if (RWDBG & 120) { y = 0.f; if (RWDBG & 8) y += ((const float*)(C.ws + WS_WDEC))[m * 256 + hc]; if (RWDBG & 16) y += bf2f(AG[m * 512 + hc]);
                if (RWDBG & 32) y += bf2f(RKVS[m * 768 + hc]) + bf2f(RKVS[m * 768 + 256 + hc]) + bf2f(RKVS[m * 768 + 512 + hc]); if (RWDBG & 64) y += BON[m * 4 + h]; }
            Y[m * 1024 + hc] = f2bf(y); }
        __syncthreads();
    }
}

constexpr int SB_VLD = 40;
__device__ __forceinline__ void ph_sb_attn_(const Ctx& C, int first_wg, int nwg, unsigned* qhead = nullptr) {
    const bf16* SB = (const bf16*)(C.ws + WS_SB); bf16* Y = (bf16*)(C.ws + WS_Y);
    const int lane = C.lane, j = lane & 31, hi = lane >> 5;
    LAS bf16* VT = (LAS bf16*)(C.lds + C.wave * (64 * SB_VLD * 2));
    for (int it = qhead ? q_next(C, qhead) : C.bid - first_wg; it < 512; it = qhead ? q_next(C, qhead) : it + nwg) {
        const int bh = it >> 6, b = bh >> 2, h = bh & 3, t0 = (it & 63) * 256 + C.wave * 32; const size_t mb = (size_t)b * SEQ;
        bf16x8 qf[4];
#pragma unroll
        for (int ks = 0; ks < 4; ++ks) qf[ks] = *(const bf16x8*)(SB + (mb + t0 + j) * 768 + h * 64 + 16 * ks + 8 * hi);
        f32x16 o0, o1;
#pragma unroll
        for (int i = 0; i < 16; ++i) { o0[i] = 0.f; o1[i] = 0.f; }
        float acc = 0.f;
#pragma unroll 1
        for (int kt = t0; kt >= 0; kt -= 32) {
            bf16x8 kf[4];
#pragma unroll
            for (int ks = 0; ks < 4; ++ks) kf[ks] = *(const bf16x8*)(SB + (mb + kt + j) * 768 + 256 + h * 64 + 16 * ks + 8 * hi);
            u32x4 vv[4];
#pragma unroll
            for (int i = 0; i < 4; ++i) { const int c = lane + 64 * i; vv[i] = *(const u32x4*)(SB + (mb + kt + (c >> 3)) * 768 + 512 + h * 64 + (c & 7) * 8); }
            f32x16 sc;
#pragma unroll
            for (int i = 0; i < 16; ++i) sc[i] = 0.f;
#pragma unroll
            for (int ks = 0; ks < 4; ++ks) sc = __builtin_amdgcn_mfma_f32_32x32x16_bf16(kf[ks], qf[ks], sc, 0, 0, 0);
#pragma unroll
            for (int i = 0; i < 4; ++i) { const int c = lane + 64 * i, key = c >> 3, d8 = (c & 7) * 8; const unsigned w[4] = {vv[i].x, vv[i].y, vv[i].z, vv[i].w};
#pragma unroll
                for (int e = 0; e < 4; ++e) { VT[(d8 + 2 * e) * SB_VLD + key] = (bf16)(w[e] & 0xffffu); VT[(d8 + 2 * e + 1) * SB_VLD + key] = (bf16)(w[e] >> 16); } }
            const bool diag = (kt == t0);
            float ls[16], g[4], og[4];
#pragma unroll
            for (int r = 0; r < 4; ++r) { g[r] = 0.f;
#pragma unroll
                for (int e = 0; e < 4; ++e) { const float z = sc[4 * r + e]; const bool valid = !diag || (8 * r + 4 * hi + e) < j;
                    const float l = (z > 40.f) ? -z : -__builtin_amdgcn_logf(1.f + __builtin_amdgcn_exp2f(z));
                    ls[4 * r + e] = valid ? l : 0.f; g[r] += ls[4 * r + e]; } }
#pragma unroll
            for (int r = 0; r < 4; ++r) og[r] = shx(g[r], 32, lane);
            float pw[16]; float run = acc;
#pragma unroll
            for (int r = 3; r >= 0; --r) { float cum = run + (hi == 0 ? og[r] : 0.f);
#pragma unroll
                for (int e = 3; e >= 0; --e) { cum += ls[4 * r + e]; const bool valid = !diag || (8 * r + 4 * hi + e) < j;
                    pw[4 * r + e] = valid ? __builtin_amdgcn_exp2f(sc[4 * r + e] + cum) : 0.f; }
                run += g[r] + og[r]; }
            acc = run;
            asm volatile("" ::: "memory");
#pragma unroll
            for (int ks = 0; ks < 2; ++ks) {
                u32x4 pk; pk.x = cvt_pk_bf16(pw[8 * ks], pw[8 * ks + 1]); pk.y = cvt_pk_bf16(pw[8 * ks + 2], pw[8 * ks + 3]); pk.z = cvt_pk_bf16(pw[8 * ks + 4], pw[8 * ks + 5]); pk.w = cvt_pk_bf16(pw[8 * ks + 6], pw[8 * ks + 7]);
                const bf16x8 pb = __builtin_bit_cast(bf16x8, pk);
                const s16x4 a0l = *(const LAS s16x4*)(VT + j * SB_VLD + 16 * ks + 4 * hi), a0h = *(const LAS s16x4*)(VT + j * SB_VLD + 16 * ks + 8 + 4 * hi);
                const s16x4 a1l = *(const LAS s16x4*)(VT + (32 + j) * SB_VLD + 16 * ks + 4 * hi), a1h = *(const LAS s16x4*)(VT + (32 + j) * SB_VLD + 16 * ks + 8 + 4 * hi);
                const bf16x8 va0 = __builtin_shufflevector(a0l, a0h, 0, 1, 2, 3, 4, 5, 6, 7), va1 = __builtin_shufflevector(a1l, a1h, 0, 1, 2, 3, 4, 5, 6, 7);
                o0 = __builtin_amdgcn_mfma_f32_32x32x16_bf16(va0, pb, o0, 0, 0, 0);
                o1 = __builtin_amdgcn_mfma_f32_32x32x16_bf16(va1, pb, o1, 0, 0, 0);
            }
            asm volatile("" ::: "memory");
            if (__builtin_amdgcn_ballot_w64(acc > -140.f) == 0ull) break;
        }
        bf16* yp = Y + (mb + t0 + j) * 1024 + 256 + h * 64 + 4 * hi;
#pragma unroll
        for (int r = 0; r < 4; ++r) { u32x2 w0, w1; w0.x = cvt_pk_bf16(o0[4 * r], o0[4 * r + 1]); w0.y = cvt_pk_bf16(o0[4 * r + 2], o0[4 * r + 3]); w1.x = cvt_pk_bf16(o1[4 * r], o1[4 * r + 1]); w1.y = cvt_pk_bf16(o1[4 * r + 2], o1[4 * r + 3]);
            *(u32x2*)(yp + 8 * r) = w0; *(u32x2*)(yp + 32 + 8 * r) = w1; }
    }
}


__device__ __forceinline__ f32x16 mm_tile(const LAS bf16* X, const LAS bf16* Y, int ti, int tj, int lane) {
    const int j = lane & 31, hi = lane >> 5; f32x16 acc;
#pragma unroll
    for (int i = 0; i < 16; ++i) acc[i] = 0.f;
#pragma unroll
    for (int ks = 0; ks < 4; ++ks) { const bf16x8 a = *(const LAS bf16x8*)(X + (32 * ti + j) * MM_LP + 16 * ks + 8 * hi), b = *(const LAS bf16x8*)(Y + (32 * tj + j) * MM_LP + 16 * ks + 8 * hi);
        acc = __builtin_amdgcn_mfma_f32_32x32x16_bf16(a, b, acc, 0, 0, 0); }
    return acc;
}
__device__ __forceinline__ void ln_pair_stats(const f32x16& x, LAS float* XCH, int tr, int tt, int lane, float eps, float& mean, float& rstd) {
    const int j = lane & 31, hi = lane >> 5; float s1 = 0.f, s2 = 0.f;
#pragma unroll
    for (int i = 0; i < 16; ++i) { s1 += x[i]; s2 += x[i] * x[i]; }
    s1 += shx(s1, 32, lane); s2 += shx(s2, 32, lane);
    if (hi == 0) { XCH[(tr * 64 + 32 * tt + j) * 2] = s1; XCH[(tr * 64 + 32 * tt + j) * 2 + 1] = s2; }
    __syncthreads();
    const float a1 = XCH[(32 * tt + j) * 2] + XCH[(64 + 32 * tt + j) * 2], a2 = XCH[(32 * tt + j) * 2 + 1] + XCH[(64 + 32 * tt + j) * 2 + 1];
    mean = a1 * (1.f / 64.f); const float var = fmaxf(a2 * (1.f / 64.f) - mean * mean, 0.f); rstd = 1.0f / sqrtf(var + eps);
}
__device__ __forceinline__ void rot_store(const Ctx& C, const bf16* src  , int pos, int d0, float scale, LAS bf16* dstrow) {
    const float* cs = (const float*)(C.ws + WS_COS) + (size_t)pos * 32 + d0; const float* sn = (const float*)(C.ws + WS_SIN) + (size_t)pos * 32 + d0;
    float x1[8], x2[8]; unpack8(*(const u32x4*)(src + d0), x1); unpack8(*(const u32x4*)(src + 32 + d0), x2);
    const f32x4 c0 = *(const f32x4*)cs, c1 = *(const f32x4*)(cs + 4), s0 = *(const f32x4*)sn, s1 = *(const f32x4*)(sn + 4);
    const float cc[8] = {c0.x, c0.y, c0.z, c0.w, c1.x, c1.y, c1.z, c1.w}, ss[8] = {s0.x, s0.y, s0.z, s0.w, s1.x, s1.y, s1.z, s1.w};
    float o1[8], o2[8];
#pragma unroll
    for (int e = 0; e < 8; ++e) { o1[e] = (x1[e] * cc[e] - x2[e] * ss[e]) * scale; o2[e] = (x1[e] * ss[e] + x2[e] * cc[e]) * scale; }
    *(LAS u32x4*)(dstrow + d0) = pack8(o1); *(LAS u32x4*)(dstrow + 32 + d0) = pack8(o2);
}

__device__ __forceinline__ void ph_ret_kv2_(const Ctx& C) {
    const bf16* RET = (const bf16*)(C.ws + WS_RET); float* KV = (float*)(C.ws + WS_KV);
    const int half = C.wave >> 2, w4 = C.wave & 3, th = C.tid & 255, lane = C.lane;
    LAS bf16* KT = (LAS bf16*)(C.lds + half * 36864);
    LAS bf16* VT = KT + 64 * MM_LP;
    LAS bf16* KR = VT + 64 * MM_LP;
    for (int it = C.bid; it < 1024; it += C.G) {
        const int u = it * 2 + half, bh = u >> 8, ch = u & 255, b = bh >> 2, h = bh & 3, m0 = b * SEQ + ch * 64;
        const float lg = ret_log2gamma(h);
        { const int srow = th >> 2, dq = th & 3; const size_t m = (size_t)(m0 + srow);
          rot_store(C, RET + m * 1024 + 256 + h * 64, (int)(m & (SEQ - 1)), dq * 8, 0.125f * exp2f(lg * (float)(63 - srow)), KR + srow * MM_LP);
          float a[8];
#pragma unroll
          for (int q = 0; q < 2; ++q) { const int e0 = dq * 16 + q * 8; unpack8(*(const u32x4*)(RET + m * 1024 + 512 + h * 64 + e0), a);
#pragma unroll
              for (int e = 0; e < 8; ++e) VT[(e0 + e) * MM_LP + srow] = f2bf(a[e]); } }
        __syncthreads();
        { const int d = th >> 2, s0 = (th & 3) * 16;
#pragma unroll
          for (int i = 0; i < 16; ++i) KT[d * MM_LP + s0 + i] = KR[(s0 + i) * MM_LP + d]; }
        __syncthreads();
        { const int ti = w4 >> 1, tj = w4 & 1, j = lane & 31, hi = lane >> 5;
          const f32x16 acc = mm_tile(VT, KT, ti, tj, lane);
          float* o = KV + (size_t)u * 4096 + (size_t)(32 * ti + 4 * hi) * 64 + 32 * tj + j;
#pragma unroll
          for (int r = 0; r < 4; ++r)
#pragma unroll
              for (int e = 0; e < 4; ++e) o[(8 * r + e) * 64] = acc[4 * r + e]; }
        __syncthreads();
    }
}
__device__ __forceinline__ void ph_ret_out2_(const Ctx& C, int l, int first_wg, int nwg, unsigned* qhead = nullptr) {
    const bf16* RET = (const bf16*)(C.ws + WS_RET); const float* KV = (const float*)(C.ws + WS_KV); bf16* Y = (bf16*)(C.ws + WS_Y);
    const int half = C.wave >> 2, w4 = C.wave & 3, th = C.tid & 255, lane = C.lane, j = lane & 31, hi = lane >> 5, te = w4 >> 1, tt = w4 & 1;
    LAS bf16* QL = (LAS bf16*)(C.lds + half * 40960);
    LAS bf16* KL = QL + 64 * MM_LP;
    LAS bf16* VT = KL + 64 * MM_LP;
    LAS bf16* ST = VT + 64 * MM_LP;
    LAS float* XCH = (LAS float*)(C.lds + half * 40960 + 4 * 64 * MM_LP * 2);
    const float* gn = C.in[I_RET_GN] + (size_t)l * 256;
    for (int it = qhead ? q_next(C, qhead) : C.bid - first_wg; it < 1024; it = qhead ? q_next(C, qhead) : it + nwg) {
        const int u = it * 2 + half, bh = u >> 8, ch = u & 255, b = bh >> 2, h = bh & 3, m0 = b * SEQ + ch * 64;
        const float lg = ret_log2gamma(h);
        { const int srow = th >> 2, dq = th & 3; const size_t m = (size_t)(m0 + srow); const int pos = (int)(m & (SEQ - 1));
          rot_store(C, RET + m * 1024 + h * 64, pos, dq * 8, 1.0f, QL + srow * MM_LP);
          rot_store(C, RET + m * 1024 + 256 + h * 64, pos, dq * 8, 0.125f, KL + srow * MM_LP);
          float a[8];
#pragma unroll
          for (int q = 0; q < 2; ++q) { const int e0 = dq * 16 + q * 8; unpack8(*(const u32x4*)(RET + m * 1024 + 512 + h * 64 + e0), a);
#pragma unroll
              for (int e = 0; e < 8; ++e) VT[(e0 + e) * MM_LP + srow] = f2bf(a[e]); }
          const float* sp = KV + (size_t)u * 4096 + srow * 64 + dq * 16;
          float sv[16];
#pragma unroll
          for (int q = 0; q < 4; ++q) { const f32x4 v4 = *(const f32x4*)(sp + 4 * q); sv[4 * q] = v4.x; sv[4 * q + 1] = v4.y; sv[4 * q + 2] = v4.z; sv[4 * q + 3] = v4.w; }
          *(LAS u32x4*)(ST + srow * MM_LP + dq * 16) = pack8(sv); *(LAS u32x4*)(ST + srow * MM_LP + dq * 16 + 8) = pack8(sv + 8); }
        __syncthreads();
        f32x16 acc = mm_tile(ST, QL, te, tt, lane);
        { const float qd = exp2f(lg * (float)(32 * tt + j + 1));
#pragma unroll
          for (int i = 0; i < 16; ++i) acc[i] *= qd; }
#pragma unroll
        for (int st = 0; st < 2; ++st) {
            if (st > tt) continue;
            const f32x16 sc = mm_tile(KL, QL, st, tt, lane);
            float pw[16];
#pragma unroll
            for (int r = 0; r < 4; ++r)
#pragma unroll
                for (int e = 0; e < 4; ++e) { const int sk = 32 * st + 8 * r + 4 * hi + e, tq = 32 * tt + j;
                    pw[4 * r + e] = (sk <= tq) ? sc[4 * r + e] * exp2f(lg * (float)(tq - sk)) : 0.f; }
#pragma unroll
            for (int ks = 0; ks < 2; ++ks) {
                u32x4 pk; pk.x = cvt_pk_bf16(pw[8 * ks], pw[8 * ks + 1]); pk.y = cvt_pk_bf16(pw[8 * ks + 2], pw[8 * ks + 3]); pk.z = cvt_pk_bf16(pw[8 * ks + 4], pw[8 * ks + 5]); pk.w = cvt_pk_bf16(pw[8 * ks + 6], pw[8 * ks + 7]);
                const bf16x8 pb = __builtin_bit_cast(bf16x8, pk);
                const LAS bf16* vr = VT + (32 * te + j) * MM_LP + 32 * st + 16 * ks + 4 * hi;
                const s16x4 al = *(const LAS s16x4*)vr, ah = *(const LAS s16x4*)(vr + 8);
                const bf16x8 va = __builtin_shufflevector(al, ah, 0, 1, 2, 3, 4, 5, 6, 7);
                acc = __builtin_amdgcn_mfma_f32_32x32x16_bf16(va, pb, acc, 0, 0, 0);
            }
        }
        float mean, rstd; ln_pair_stats(acc, XCH, te, tt, lane, 1e-5f, mean, rstd);
        { const size_t m = (size_t)(m0 + 32 * tt + j); const bf16* gp = RET + m * 1024 + 768 + h * 64 + 32 * te + 4 * hi; bf16* yp = Y + m * 1024 + 512 + h * 64 + 32 * te + 4 * hi;
          const float* gw = gn + h * 64 + 32 * te + 4 * hi;
#pragma unroll
          for (int r = 0; r < 4; ++r) { const u32x2 gt2 = *(const u32x2*)(gp + 8 * r); const float gtv[4] = {bflo(gt2.x), bfhi(gt2.x), bflo(gt2.y), bfhi(gt2.y)}; const f32x4 gwv = *(const f32x4*)(gw + 8 * r);
              float o[4];
#pragma unroll
              for (int e = 0; e < 4; ++e) o[e] = (acc[4 * r + e] - mean) * rstd * gwv[e] * (gtv[e] * sigm(gtv[e]));
              u32x2 w; w.x = cvt_pk_bf16(o[0], o[1]); w.y = cvt_pk_bf16(o[2], o[3]); *(u32x2*)(yp + 8 * r) = w; } }
        __syncthreads();
    }
}
__device__ __forceinline__ void ph_rw_out2_(const Ctx& C, int l) {
    const bf16* RKVS = (const bf16*)(C.ws + WS_RKVS); const bf16* AG = (const bf16*)(C.ws + WS_AG); const bf16* Y0 = (const bf16*)(C.ws + WS_Y0); const bf16* RH = (const bf16*)(C.ws + WS_RHAT);
    const float* SST = (const float*)(C.ws + WS_SST); const float* BON = (const float*)(C.ws + WS_BON); bf16* Y = (bf16*)(C.ws + WS_Y);
    const int half = C.wave >> 2, w4 = C.wave & 3, th = C.tid & 255, lane = C.lane, j = lane & 31, hi = lane >> 5, tv = w4 >> 1, tt = w4 & 1;
    LAS bf16* SL = (LAS bf16*)(C.lds + half * 20480);
    LAS bf16* RL = SL + 64 * MM_LP;
    LAS float* XCH = (LAS float*)(C.lds + half * 20480 + 2 * 64 * MM_LP * 2);
    for (int it = C.bid; it < RW_NU / 2; it += C.G) {
        const int u = it * 2 + half, bh = u >> 8, ch = u & 255, b = bh >> 2, h = bh & 3, m0 = b * SEQ + ch * RWC;
        { const int row = th >> 2, q4 = th & 3;
          const float* sp = SST + (size_t)(u >> 3) * 4096 + row * 64 + q4 * 16; float sv[16];
#pragma unroll
          for (int q = 0; q < 4; ++q) { const f32x4 v4 = *(const f32x4*)(sp + 4 * q); sv[4 * q] = v4.x; sv[4 * q + 1] = v4.y; sv[4 * q + 2] = v4.z; sv[4 * q + 3] = v4.w; }
          *(LAS u32x4*)(SL + row * MM_LP + q4 * 16) = pack8(sv); *(LAS u32x4*)(SL + row * MM_LP + q4 * 16 + 8) = pack8(sv + 8);
          const u32x4* rp = (const u32x4*)(RH + (size_t)(m0 + row) * 256 + h * 64 + q4 * 16);
          *(LAS u32x4*)(RL + row * MM_LP + q4 * 16) = rp[0]; *(LAS u32x4*)(RL + row * MM_LP + q4 * 16 + 8) = rp[1]; }
        __syncthreads();
        f32x16 acc = mm_tile(SL, RL, tv, tt, lane);
        const size_t m = (size_t)(m0 + 32 * tt + j); const int vb = h * 64 + 32 * tv + 4 * hi;
#pragma unroll
        for (int r = 0; r < 4; ++r) { const u32x2 y2 = *(const u32x2*)(Y0 + m * 256 + vb + 8 * r); acc[4 * r] += bflo(y2.x); acc[4 * r + 1] += bfhi(y2.x); acc[4 * r + 2] += bflo(y2.y); acc[4 * r + 3] += bfhi(y2.y); }
        float mean, rstd; ln_pair_stats(acc, XCH, tv, tt, lane, 64e-5f, mean, rstd);
        const float bon = BON[m * 4 + h];
#pragma unroll
        for (int r = 0; r < 4; ++r) { const int vc = vb + 8 * r;
            const f32x4 lw = *(const f32x4*)(C.in[I_RW_LNW] + (size_t)l * 256 + vc), lb = *(const f32x4*)(C.in[I_RW_LNB] + (size_t)l * 256 + vc);
            const u32x2 v2 = *(const u32x2*)(RKVS + m * 768 + 512 + vc), g2 = *(const u32x2*)(AG + m * 512 + 256 + vc);
            const float vv[4] = {bflo(v2.x), bfhi(v2.x), bflo(v2.y), bfhi(v2.y)}, gg[4] = {bflo(g2.x), bfhi(g2.x), bflo(g2.y), bfhi(g2.y)};
            float o[4];
#pragma unroll
            for (int e = 0; e < 4; ++e) o[e] = ((acc[4 * r + e] - mean) * rstd * lw[e] + lb[e] + bon * vv[e]) * gg[e];
            u32x2 w; w.x = cvt_pk_bf16(o[0], o[1]); w.y = cvt_pk_bf16(o[2], o[3]); *(u32x2*)(Y + m * 1024 + vc) = w; }
        __syncthreads();
    }
}

__device__ __forceinline__ void ph_moe_scatter_(const Ctx& C, int moe_idx) {
    unsigned* cw = (unsigned*)(C.ws + WS_CTL) + CW_MOE + moe_idx * 64;
    const int* eidx = (const int*)(C.ws + WS_EIDX); const float* gate = (const float*)(C.ws + WS_GATE);
    int* rowtok = (int*)(C.ws + WS_ROWTOK); float* rowgate = (float*)(C.ws + WS_ROWGATE); int* texp = (int*)(C.ws + WS_TEXP); int* segend = (int*)(C.ws + WS_SEGEND); int* ntp = (int*)(C.ws + WS_NT);
    const bf16* H = (const bf16*)(C.ws + WS_H); bf16* XS = (bf16*)(C.ws + WS_XS);
    LAS unsigned* lcnt = (LAS unsigned*)(C.lds); LAS unsigned* lbase = lcnt + 8; LAS int* sl = (LAS int*)(C.lds + 256);
    int cnt[8], segb[8]; int tot = 0;
#pragma unroll
    for (int e = 0; e < 8; ++e) { cnt[e] = (int)__hip_atomic_load(&cw[e], __ATOMIC_RELAXED, __HIP_MEMORY_SCOPE_AGENT); segb[e] = tot; tot += (cnt[e] + 255) & ~255; }
    if (C.bid == 0) {
        if (C.tid < 8) { const int e = C.tid; int sb = 0, ce = 0;
#pragma unroll
            for (int q = 0; q < 8; ++q) if (q == e) { sb = segb[q]; ce = cnt[q]; }
            for (int pm = sb >> 8; pm < ((sb + ((ce + 255) & ~255)) >> 8); ++pm) { texp[pm] = e; segend[pm] = sb + ce; } }
        if (C.tid == 0) *ntp = tot >> 8;
    }
    for (int blk = C.bid; blk < T / 256; blk += C.G) {
        __syncthreads();
        if (C.tid < 8) lcnt[C.tid] = 0u;
        __syncthreads();
        const int a = blk * 512 + C.tid, e = eidx[a];
        const unsigned rank = atomicAdd((unsigned*)&lcnt[e], 1u);
        __syncthreads();
        if (C.tid < 8) lbase[C.tid] = atomicAdd(&cw[16 + C.tid], lcnt[C.tid]);
        __syncthreads();
        int sb = 0;
#pragma unroll
        for (int q = 0; q < 8; ++q) if (q == e) sb = segb[q];
        const int slot = sb + (int)lbase[e] + (int)rank;
        rowtok[slot] = a >> 1; rowgate[slot] = gate[a]; sl[C.tid] = slot; ((int*)(C.ws + WS_SLOTOF))[a] = slot;
        __syncthreads();
        for (int i = C.wave; i < 512; i += NWAVES) { const int s2 = sl[i]; const u32x4* src = (const u32x4*)(C.ws + WS_H8 + (size_t)(blk * 256 + (i >> 1)) * D); u32x4* dst = (u32x4*)(C.ws + WS_XS + (size_t)s2 * D);
            dst[C.lane] = src[C.lane]; }
    }
}

__device__ __forceinline__ void grid_barrier(int wv) {
    const Ctx C = make_ctx(wv);
    XcdBarrier b; b.bar = (unsigned*)(C.ws + WS_CTL) + CW_BAR; b.x = xb_xcc_id(); b.st = (volatile LAS unsigned*)(C.lds + MISC_OFF) + 8;
    xcd_barrier(b, C.tid);
}
__device__ __forceinline__ void P_prologue(int wv) { const Ctx C = make_ctx(wv); ph_prologue_(C); }
__device__ __forceinline__ void P_weights_norm(int wv, int l) { const Ctx C = make_ctx(wv); ph_weights_(C, l, 0, 0, C.G); __syncthreads(); ph_norm_(C, C.in[I_NORM_MIX] + (size_t)l * D, false, nullptr, 0,  (l > 0) && ((l - 1) & 1), l == 0 ? C.in[I_X] : nullptr); }
__device__ __forceinline__ void P_gemm_in(int wv) { const Ctx C = make_ctx(wv); using namespace pg8; unsigned char* ws = C.ws;
    Gemm g{(const bf16*)(ws + WS_H), (const bf16*)(ws + WS_WIN), D, D}; StaticOrder S; S.init(T, NIN, C.G, C.bid);
    EpiRoute E{(bf16*)(ws + WS_RW), (bf16*)(ws + WS_SB), (bf16*)(ws + WS_RET), (bf16*)(ws + WS_CV)};
    gemm_phase<EpiRoute, StaticOrder, true>(C.lds, C.tid, g, S, E); }
#define REP2(bit, stmt) do { stmt; if constexpr ((PROBE2 >> (bit)) & 1) { __syncthreads(); stmt; } } while (0)
__device__ __forceinline__ void P_mix1(int wv, int l) { REP2(2, { const Ctx C = make_ctx(wv); ph_rw_prep_(C, l); }); { const Ctx C = make_ctx(wv); ph_sb_prep_(C, l); } REP2(3, { const Ctx C = make_ctx(wv); ph_conv_(C, l); }); REP2(4, { const Ctx C = make_ctx(wv); ph_ret_kv2_(C); }); }
__device__ __forceinline__ void P_mix2(int wv, int l) { { const Ctx C = make_ctx(wv); using namespace pg8; unsigned char* ws = C.ws;
    Gemm g{(const bf16*)(ws + WS_ALORA), (const bf16*)(ws + WS_WLORA), 256, 256}; StaticOrder S; S.init(T, 768, C.G, C.bid);
    EpiLora E{(float*)(ws + WS_WDEC), (bf16*)(ws + WS_AG), C.in[I_RW_W0] + (size_t)l * 256, C.in[I_RW_A0] + (size_t)l * 256};
    gemm_phase<EpiLora, StaticOrder, true>(C.lds, C.tid, g, S, E); }
    { const Ctx C = make_ctx(wv); ph_ret_scan_(C); } }
#ifndef MIX3_SEL
#define MIX3_SEL 3
#endif
__device__ __forceinline__ void P_mix3(int wv, int l) { REP2(0, { const Ctx C = make_ctx(wv); ph_rw_local_wy_(C, l); }); }
__device__ __forceinline__ void P_mix4(int wv, int l) { const Ctx C = make_ctx(wv);
    unsigned* qh = (unsigned*)(C.ws + WS_CTL) + CW_QUEUE + l * 64;
    if (C.G >= 64) { if (C.bid < 32) { ph_rw_scan_(C, C.bid); __syncthreads(); }
        ph_sb_attn_(C, 0, C.G, qh); __syncthreads(); ph_ret_out2_(C, l, 0, C.G, qh + 16); __syncthreads(); ph_weights_(C, l, 1, 0, C.G, qh + 32); }
    else { for (int w = C.bid; w < 32; w += C.G) { ph_rw_scan_(C, w); __syncthreads(); } ph_sb_attn_(C, 0, C.G); __syncthreads(); ph_ret_out2_(C, l, 0, C.G); __syncthreads(); ph_weights_(C, l, 1, 0, C.G); } }
__device__ __forceinline__ void P_mix5(int wv, int l) { REP2(5, { const Ctx C = make_ctx(wv); ph_rw_out2_(C, l); }); }
__device__ __forceinline__ void P_gemm_branch(int wv) { const Ctx C = make_ctx(wv); using namespace pg8; unsigned char* ws = C.ws;
    Gemm g{(const bf16*)(ws + WS_Y), (const bf16*)(ws + WS_WB), D, 256}; StaticOrder S; S.init(T, 4096, C.G, C.bid, 2, 512);
    EpiBf16 E{(bf16*)(ws + WS_BALL), 4096, 0xffff, 1.0f};
    gemm_phase<EpiBf16, StaticOrder, false>(C.lds, C.tid, g, S, E); }
__device__ __forceinline__ void P_gemm_gate(int wv) { const Ctx C = make_ctx(wv); using namespace pg8; unsigned char* ws = C.ws;
    Gemm g{(const bf16*)(ws + WS_H8), (const bf16*)(ws + WS_WG), D, D}; StaticOrder S; S.init(T, 4096, C.G, C.bid);
    EpiGateMerge E{(const bf16*)(ws + WS_BALL), (bf16*)(ws + WS_MERGED)};
    gemm_phase8<EpiGateMerge, StaticOrder, true>(C.lds, C.tid, g, S, E); }
__device__ __forceinline__ void P_gemm_out(int wv) { const Ctx C = make_ctx(wv); using namespace pg8; unsigned char* ws = C.ws;
    Gemm g{(const bf16*)(ws + WS_MERGED), (const bf16*)(ws + WS_WOUT), D, D}; StaticOrder S; S.init(T, D, C.G, C.bid);
    EpiResidual E{C.out, 1.0f};
    gemm_phase<EpiResidual, StaticOrder, false>(C.lds, C.tid, g, S, E); }
__device__ __forceinline__ void P_norm_ffn(int wv, int l) { const Ctx C = make_ctx(wv); ph_norm_(C, C.in[I_NORM_FFN] + (size_t)l * D, (l & 1) != 0, C.in[I_ROUTER] + (size_t)(l >> 1) * D * NEXP, l >> 1, false, nullptr,  false); }
__device__ __forceinline__ void P_ffn_up(int wv) { const Ctx C = make_ctx(wv); using namespace pg8; unsigned char* ws = C.ws;
    Gemm g{(const bf16*)(ws + WS_H8), (const bf16*)(ws + WS_W13), D, D}; StaticOrder S; S.init(T, 2 * DFF, C.G, C.bid);
    EpiSwiglu E{ws + WS_HID, DFF, 1 << 20, false};
    gemm_phase8<EpiSwiglu, StaticOrder, true>(C.lds, C.tid, g, S, E); }
__device__ __forceinline__ void P_ffn_down(int wv) { const Ctx C = make_ctx(wv); using namespace pg8; unsigned char* ws = C.ws;
    Gemm g{(const bf16*)(ws + WS_HID), (const bf16*)(ws + WS_W2D), DFF, DFF}; StaticOrder S; S.init(T, D, C.G, C.bid);
    EpiResidual E{C.out, F8_DESCALE_DOWN};
    gemm_phase8<EpiResidual, StaticOrder, false>(C.lds, C.tid, g, S, E); }
__device__ __forceinline__ void P_moe_scatter(int wv, int l2) { const Ctx C = make_ctx(wv); ph_moe_scatter_(C, l2); }
__device__ __forceinline__ void P_moe_up(int wv) { const Ctx C = make_ctx(wv); using namespace pg8; unsigned char* ws = C.ws;
    Gemm g{(const bf16*)(ws + WS_XS), (const bf16*)(ws + WS_W13), D, D};
    MoeOrder S{(const int*)(ws + WS_TEXP), __builtin_amdgcn_readfirstlane(*(const int*)(ws + WS_NT)), 2 * DFE / 256, C.G, C.bid};
    EpiSwiglu E{ws + WS_HIDM, DFE_PAD, 2 * DFE / 256, true};
    gemm_phase8<EpiSwiglu, MoeOrder, true>(C.lds, C.tid, g, S, E); }
__device__ __forceinline__ void P_moe_down(int wv) { const Ctx C = make_ctx(wv); using namespace pg8; unsigned char* ws = C.ws;
    Gemm g{(const bf16*)(ws + WS_HIDM), (const bf16*)(ws + WS_W2M), DFE_PAD, DFE_PAD};
    MoeOrder S{(const int*)(ws + WS_TEXP), __builtin_amdgcn_readfirstlane(*(const int*)(ws + WS_NT)), D / 256, C.G, C.bid};
    EpiBf16 E{(bf16*)(ws + WS_YS), D, 3, F8_DESCALE_DOWN};
    gemm_phase8<EpiBf16, MoeOrder, true>(C.lds, C.tid, g, S, E); }
__device__ __forceinline__ void P_moe_combine(int wv) { const Ctx C = make_ctx(wv);
    const int gw = C.bid * NWAVES + C.wave, NGW = C.G * NWAVES, lane = C.lane;
    const int* slotof = (const int*)(C.ws + WS_SLOTOF); const float* gate = (const float*)(C.ws + WS_GATE); const bf16* YS = (const bf16*)(C.ws + WS_YS);
    for (int m = gw; m < T; m += NGW) {
        const int s0 = slotof[2 * m], s1 = slotof[2 * m + 1]; const float g0 = gate[2 * m], g1 = gate[2 * m + 1];
        f32x4* xr = (f32x4*)(C.out + (size_t)m * D) + lane;
        const u32x2* y0 = (const u32x2*)(YS + (size_t)s0 * D) + lane; const u32x2* y1 = (const u32x2*)(YS + (size_t)s1 * D) + lane;
#pragma unroll
        for (int j = 0; j < 4; ++j) { f32x4 v = xr[64 * j]; const u32x2 a = y0[64 * j], b = y1[64 * j];
            v.x += g0 * bflo(a.x) + g1 * bflo(b.x); v.y += g0 * bfhi(a.x) + g1 * bfhi(b.x); v.z += g0 * bflo(a.y) + g1 * bflo(b.y); v.w += g0 * bfhi(a.y) + g1 * bfhi(b.y);
            xr[64 * j] = v; }
    }
}

#ifndef PROBE_MASK
#define PROBE_MASK 0u
#endif
#ifndef PH_MASK
#define PH_MASK 0xffffffffu
#endif
__global__ void __launch_bounds__(NTHR, 2) hybrid_fwd(Args args) {
    (void)args;
    const int wv = __builtin_amdgcn_readfirstlane(threadIdx.x >> 6);
    { LAS unsigned char* lds = (LAS unsigned char*)lds_raw;
      for (int u = threadIdx.x; u < (LDS_BYTES - RING_BYTES) / 4; u += NTHR) ((LAS unsigned*)(lds + RING_BYTES))[u] = 0u; }
    __syncthreads();
    { const CAS Args* ka = ka_ptr();
      if (ka->ph_hi - ka->ph_lo > 1) { (void)xcd_barrier_post((unsigned*)(ka->ws + WS_CTL) + CW_BAR, (volatile LAS unsigned*)((LAS unsigned char*)lds_raw + MISC_OFF) + 8); } }
    int gp = 0;
#define PHASE(k, call) { const CAS Args* ka_ = ka_ptr(); const int lo_ = ka_->ph_lo, hi_ = ka_->ph_hi; if (lo_ <= gp && gp < hi_) { if constexpr ((PH_MASK >> (k)) & 1u) { call; if constexpr ((PROBE_MASK >> (k)) & 1u) { __syncthreads(); call; } } if (hi_ - lo_ > 1 && gp + 1 < hi_) grid_barrier(wv); } ++gp; }
    PHASE(0, P_prologue(wv))
#pragma unroll 1
    for (int l = 0; l < NLAYER; ++l) {
        PHASE(1, P_weights_norm(wv, l))
        PHASE(2, P_gemm_in(wv))
        PHASE(3, P_mix1(wv, l))
        PHASE(4, P_mix2(wv, l))
        PHASE(5, P_mix3(wv, l))
        PHASE(6, P_mix4(wv, l))
        PHASE(7, P_mix5(wv, l))
        PHASE(8, P_gemm_branch(wv))
        PHASE(9, P_gemm_gate(wv))
        PHASE(10, P_gemm_out(wv))
        PHASE(11, P_norm_ffn(wv, l))
        if (!(l & 1)) {
            PHASE(12, P_ffn_up(wv))
            PHASE(13, P_ffn_down(wv))
            gp += 2;
        } else {
            PHASE(14, P_moe_scatter(wv, l >> 1))
            PHASE(15, P_moe_up(wv))
            PHASE(16, P_moe_down(wv))
            if (l == NLAYER - 1) { PHASE(17, P_moe_combine(wv)) } else { ++gp; }
        }
    }
#undef PHASE
}
constexpr int N_PHASES = 1 + NLAYER * 15;

#ifndef MK_MULTI
#define MK_MULTI 0
#endif
extern "C" void kernel_launch(void* const* d_in, const int* in_sizes, int n_in, void* d_out, int out_size, void* d_ws, size_t ws_size, hipStream_t stream) {
    static int grid = 0;
    if (grid == 0) {
        if (n_in != 32 || in_sizes[0] != T * D || out_size != T * D || ws_size < WS_END) { fprintf(stderr, "kernel_launch: unexpected problem shape / workspace (%d inputs, ws %zu)\n", n_in, ws_size); grid = -1; return; }
        int dev = 0, cus = 0, per_cu = 0;
        if (hipGetDevice(&dev) != hipSuccess || hipDeviceGetAttribute(&cus, hipDeviceAttributeMultiprocessorCount, dev) != hipSuccess) { grid = -1; return; }
        if (hipFuncSetAttribute((const void*)hybrid_fwd, hipFuncAttributeMaxDynamicSharedMemorySize, LDS_BYTES) != hipSuccess) { fprintf(stderr, "kernel_launch: hipFuncSetAttribute failed\n"); grid = -1; return; }
        if (hipOccupancyMaxActiveBlocksPerMultiprocessor(&per_cu, (const void*)hybrid_fwd, NTHR, LDS_BYTES) != hipSuccess || per_cu < 1) { fprintf(stderr, "kernel_launch: occupancy query says %d\n", per_cu); }
        (void)hipGetLastError();
        grid = cus;
    }
    if (grid < 0) return;
    (void)hipMemsetAsync((char*)d_ws + WS_CTL, 0, CTL_ZERO_BYTES, stream);
#ifdef DBG_ZERO_WS
    (void)hipMemsetAsync((char*)d_ws + CTL_ZERO_BYTES, 0, WS_END - CTL_ZERO_BYTES, stream);
#endif
    Args a{};
    for (int i = 0; i < 32; ++i) a.in[i] = (const float*)d_in[i];
    a.out = (float*)d_out; a.ws = (unsigned char*)d_ws;
#if MK_MULTI
    for (int p = 0; p < N_PHASES; ++p) { a.ph_lo = p; a.ph_hi = p + 1; hipLaunchKernelGGL(hybrid_fwd, dim3(grid), dim3(NTHR), LDS_BYTES, stream, a); }
#else
    a.ph_lo = 0; a.ph_hi = N_PHASES; hipLaunchKernelGGL(hybrid_fwd, dim3(grid), dim3(NTHR), LDS_BYTES, stream, a);
#endif
}
```

```cpp
#include <hip/hip_runtime.h>
#include <cstdio>
#include <cstdint>

#define GAS __attribute__((address_space(1)))
#define LAS __attribute__((address_space(3)))
typedef unsigned short bf16;
typedef unsigned u32x4 __attribute__((ext_vector_type(4)));
typedef unsigned u32x2 __attribute__((ext_vector_type(2)));
typedef float f32x4 __attribute__((ext_vector_type(4)));
typedef float f32x2 __attribute__((ext_vector_type(2)));
typedef short bf16x8 __attribute__((ext_vector_type(8)));
typedef float f32x16 __attribute__((ext_vector_type(16)));
typedef short s16x4 __attribute__((ext_vector_type(4)));

constexpr int SEQ = 16384, NBATCH = 2, T = NBATCH * SEQ, D = 1024, NIN = 3328, DFF = 2816, DFE = 1408, NEXP = 8, NLAYER = 4;
constexpr int MPAD = 2 * T + NEXP * 256;
constexpr int NWAVES = 8, NTHR = 512;
constexpr float LOG2E = 1.4426950408889634f;
constexpr int MM_LP = 72;

typedef __bf16 bf16x2_t __attribute__((ext_vector_type(2)));
__device__ __forceinline__ unsigned cvt_pk_bf16(float lo, float hi) { const f32x2 v = {lo, hi}; const bf16x2_t b = __builtin_convertvector(v, bf16x2_t); return __builtin_bit_cast(unsigned, b); }
__device__ __forceinline__ float bflo(unsigned u) { return __builtin_bit_cast(float, u << 16); }
__device__ __forceinline__ float bfhi(unsigned u) { return __builtin_bit_cast(float, u & 0xffff0000u); }
__device__ __forceinline__ float bf2f(bf16 u) { return __builtin_bit_cast(float, (unsigned)u << 16); }
__device__ __forceinline__ bf16 f2bf(float f) { return (bf16)(cvt_pk_bf16(f, 0.f) & 0xffffu); }
__device__ __forceinline__ float sigm(float x) { return __builtin_amdgcn_rcpf(1.f + __builtin_amdgcn_exp2f(-x * LOG2E)); }
__device__ __forceinline__ float shx(float v, int o, int lane) { return __builtin_bit_cast(float, __builtin_amdgcn_ds_bpermute((lane ^ o) << 2, __builtin_bit_cast(int, v))); }
__device__ __forceinline__ float dpp_add(float v, const int ctrl_id) {
    const int x = __builtin_bit_cast(int, v);
    int y;
    if (ctrl_id == 0) y = __builtin_amdgcn_update_dpp(0, x, 0xB1, 0xF, 0xF, true);
    else if (ctrl_id == 1) y = __builtin_amdgcn_update_dpp(0, x, 0x4E, 0xF, 0xF, true);
    else if (ctrl_id == 2) y = __builtin_amdgcn_update_dpp(0, x, 0x141, 0xF, 0xF, true);
    else y = __builtin_amdgcn_update_dpp(0, x, 0x140, 0xF, 0xF, true);
    return v + __builtin_bit_cast(float, y);
}
__device__ __forceinline__ float wave_sum(float v, int lane) {
    (void)lane;
    v = dpp_add(v, 0); v = dpp_add(v, 1); v = dpp_add(v, 2); v = dpp_add(v, 3);
    const int x = __builtin_bit_cast(int, v);
    const float s0 = __builtin_bit_cast(float, __builtin_amdgcn_readlane(x, 0)), s1 = __builtin_bit_cast(float, __builtin_amdgcn_readlane(x, 16)),
                s2 = __builtin_bit_cast(float, __builtin_amdgcn_readlane(x, 32)), s3 = __builtin_bit_cast(float, __builtin_amdgcn_readlane(x, 48));
    return (s0 + s1) + (s2 + s3);
}
__device__ __forceinline__ void unpack8(const u32x4 v, float* f) {
    f[0] = bflo(v.x); f[1] = bfhi(v.x); f[2] = bflo(v.y); f[3] = bfhi(v.y); f[4] = bflo(v.z); f[5] = bfhi(v.z); f[6] = bflo(v.w); f[7] = bfhi(v.w);
}
__device__ __forceinline__ unsigned pk4_fp8(float a, float b, float c, float d) {
    a = __builtin_amdgcn_fmed3f(a, -440.f, 440.f); b = __builtin_amdgcn_fmed3f(b, -440.f, 440.f); c = __builtin_amdgcn_fmed3f(c, -440.f, 440.f); d = __builtin_amdgcn_fmed3f(d, -440.f, 440.f);
    int w = __builtin_amdgcn_cvt_pk_fp8_f32(a, b, 0, false); w = __builtin_amdgcn_cvt_pk_fp8_f32(c, d, w, true); return (unsigned)w; }
__device__ __forceinline__ u32x4 pack8(const float* f) {
    u32x4 w; w.x = cvt_pk_bf16(f[0], f[1]); w.y = cvt_pk_bf16(f[2], f[3]); w.z = cvt_pk_bf16(f[4], f[5]); w.w = cvt_pk_bf16(f[6], f[7]); return w;
}


#ifndef PROBE2
#define PROBE2 0
#endif
#ifndef GMASK
#define GMASK 15
#endif
#ifndef RWDBG
#define RWDBG 0
#endif
typedef int i32x8 __attribute__((ext_vector_type(8)));
constexpr float F8_MUL_X = 16.f, F8_MUL_W = 256.f, F8_DESCALE = 1.0f / (16.f * 256.f), F8_MUL_H = 4.f, F8_DESCALE_DOWN = 1.0f / (4.f * 256.f);
constexpr int DFE_PAD = 1536;
namespace pg8 {
typedef unsigned short bf16_t;
constexpr int BM = 256, BK = 64, HALF = 128, HTB = HALF * BK * 2, NXCD = 8, WGM = 8;
__host__ __device__ __forceinline__ int lds_byte(int r, int c) { const int st = (r >> 4) * 2 + (c >> 5), rr = r & 15, cc = c & 31, ob = rr * 64 + cc * 2; return st * 1024 + (ob ^ (((ob >> 9) & 1) << 5)); }
__host__ __device__ __forceinline__ void stage_rc(int b, int& R, int& C) { const int st = b / 1024, sb = b % 1024, swz = sb ^ (((sb >> 9) & 1) << 5); R = (st >> 1) * 16 + swz / 64; C = (st & 1) * 32 + (swz % 64) / 2; }
__host__ __device__ __forceinline__ int perm32(int rho) { const int n = rho >> 4, i = rho & 15; return 8 * (i >> 2) + 4 * n + (i & 3); }

struct Unit { int pm, pn, aoff; };
struct Gemm { const bf16_t* A; const bf16_t* Bt; int lda, K; };

struct StaticOrder {
    int nM, nN, nwg, G, c, ashift, amul;
    __device__ void init(int M, int N, int G_, int c_, int ashift_ = 0, int amul_ = 0) { nM = M / BM; nN = N / BM; nwg = nM * nN; G = G_; c = c_; ashift = ashift_; amul = amul_; }
    __device__ bool next(int i, Unit& u) const {
        const long L = (long)i * G + c; if (L >= nwg) return false;
        int wgid = (int)L; { const int q = nwg / NXCD, r = nwg % NXCD, xcd = wgid % NXCD, off = wgid / NXCD; wgid = (xcd < r ? xcd * (q + 1) : r * (q + 1) + (xcd - r) * q) + off; }
        const int nig = WGM * nN, gid = wgid / nig, fm = gid * WGM, gsz = (nM - fm) < WGM ? (nM - fm) : WGM;
        u.pm = fm + ((wgid % nig) % gsz); u.pn = (wgid % nig) / gsz; u.aoff = (u.pn >> ashift) * amul; return true;
    }
};
struct MoeOrder {
    const int* texp; int ntiles, ncol, G, c;
    __device__ bool next(int i, Unit& u) const {
        const int L = i * G + c; if (L >= ntiles * ncol) return false;
        const int pm = L / ncol, pl = L % ncol;
        u.pm = pm; u.pn = texp[pm] * ncol + pl; u.aoff = 0; return true;
    }
};

template <class Epi, class Sched, bool ALIGN_EPI>
__device__ __forceinline__ void gemm_phase(LAS unsigned char* lds, const int tid_in, const Gemm g, const Sched& S, const Epi& E) {
    const int tid = tid_in, wid = __builtin_amdgcn_readfirstlane(tid >> 6), lane = tid & 63, wr = wid >> 2, wc = wid & 3, fr = lane & 15, fq = lane >> 4;
    const int K = g.K, nt = K / BK, lda = g.lda;
    unsigned voffA[2], voffB[2];
#pragma unroll
    for (int i = 0; i < 2; ++i) { int R, C; stage_rc(tid * 16 + i * 8192, R, C); const int Rb = (R & ~31) + perm32(R & 31);
        voffA[i] = (unsigned)(R * lda + C) * 2u; voffB[i] = (unsigned)(Rb * K + C) * 2u; }
    const size_t kstep = (size_t)(BK * 2);
    const size_t hstepA = (size_t)HALF * lda * 2, tstepA = 2 * hstepA, hstepB = (size_t)HALF * K * 2, tstepB = 2 * hstepB;
    const unsigned ldsw = (unsigned)wid * 1024u;
    const int aoff = lds_byte(wr * 64 + fr, fq * 8), boff = lds_byte(wc * 32 + fr, fq * 8);
#define PG8_SA(b, h) (((b) * 2 + (h)) * HTB)
#define PG8_SB(b, h) ((4 + (b) * 2 + (h)) * HTB)
#define PG8_STAGE(bufoff, gbase, voff) do { _Pragma("unroll") for (int _i = 0; _i < 2; ++_i) \
        __builtin_amdgcn_global_load_lds((const unsigned*)((const char*)(gbase) + (voff)[_i]), (LAS unsigned*)(lds + (bufoff) + ldsw + _i * 8192), 16, 0, 0); } while (0)
#define PG8_LDA(dst, b, h) do { _Pragma("unroll") for (int m = 0; m < 4; ++m) _Pragma("unroll") for (int k = 0; k < 2; ++k) dst[m][k] = *(const LAS bf16x8*)(lds + PG8_SA(b, h) + aoff + m * 2048 + k * 1024); } while (0)
#define PG8_LDB(dst, b, h) do { _Pragma("unroll") for (int n = 0; n < 2; ++n) _Pragma("unroll") for (int k = 0; k < 2; ++k) dst[n][k] = *(const LAS bf16x8*)(lds + PG8_SB(b, h) + boff + n * 2048 + k * 1024); } while (0)
#define PG8_MMA(ai, bj, At, Bt) do { __builtin_amdgcn_s_setprio(1); _Pragma("unroll") for (int m = 0; m < 4; ++m) _Pragma("unroll") for (int n = 0; n < 2; ++n) _Pragma("unroll") for (int k = 0; k < 2; ++k) \
        acc[ai][bj][m][n] = __builtin_amdgcn_mfma_f32_16x16x32_bf16(Bt[n][k], At[m][k], acc[ai][bj][m][n], 0, 0, 0); __builtin_amdgcn_s_setprio(0); } while (0)
#define PG8_WAIT_V(n) asm volatile("s_waitcnt vmcnt(" #n ")" ::: "memory")
#define PG8_WAIT_L(n) asm volatile("s_waitcnt lgkmcnt(" #n ")" ::: "memory")
#define PG8_BAR __builtin_amdgcn_s_barrier()
#define PG8_SCHED __builtin_amdgcn_sched_barrier(0)
    Unit cur, nxt; int ui = 0;
    if (!S.next(0, cur)) return;
    f32x4 acc[2][2][4][2];
#pragma unroll
    for (int a = 0; a < 2; ++a)
#pragma unroll
        for (int b = 0; b < 2; ++b)
#pragma unroll
            for (int m = 0; m < 4; ++m)
#pragma unroll
                for (int n = 0; n < 2; ++n) acc[a][b][m][n] = (f32x4){0.f, 0.f, 0.f, 0.f};
    bf16x8 At[4][2], B0[2][2], B1[2][2];
    const char* cA = (const char*)g.A + (size_t)cur.pm * tstepA + cur.aoff; const char* cB = (const char*)g.Bt + (size_t)cur.pn * tstepB;
    PG8_STAGE(PG8_SB(0, 0), cB, voffB); PG8_STAGE(PG8_SB(0, 1), cB + hstepB, voffB); PG8_STAGE(PG8_SA(0, 0), cA, voffA); PG8_STAGE(PG8_SA(0, 1), cA + hstepA, voffA);
    if (wr == 1) PG8_BAR;
    PG8_WAIT_V(2); PG8_BAR;
    PG8_STAGE(PG8_SB(1, 0), cB + kstep, voffB); PG8_STAGE(PG8_SA(1, 0), cA + kstep, voffA); PG8_STAGE(PG8_SB(1, 1), cB + hstepB + kstep, voffB);
    PG8_WAIT_V(6); PG8_BAR;
    for (;;) {
        const bool has_next = S.next(ui + 1, nxt);
        const char* nA = has_next ? (const char*)g.A + (size_t)nxt.pm * tstepA + nxt.aoff : cA; const char* nB = has_next ? (const char*)g.Bt + (size_t)nxt.pn * tstepB : cB;
#pragma unroll 1
        for (int t = 0; t < nt; t += 2) {
            const bool last = (t == nt - 2);
            const char* a1 = cA + (size_t)(t + 1) * kstep;
            const char* a2 = last ? nA : cA + (size_t)(t + 2) * kstep; const char* b2 = last ? nB : cB + (size_t)(t + 2) * kstep;
            const char* a3 = a2 + kstep; const char* b3 = b2 + kstep;
            PG8_LDB(B0, 0, 0); PG8_LDB(B1, 0, 1); PG8_SCHED; PG8_LDA(At, 0, 0); PG8_STAGE(PG8_SA(1, 1), a1 + hstepA, voffA);
            PG8_WAIT_V(8); PG8_WAIT_L(0); PG8_BAR; PG8_MMA(0, 0, At, B0); PG8_MMA(0, 1, At, B1); PG8_BAR; PG8_SCHED;
            PG8_LDA(At, 0, 1); PG8_STAGE(PG8_SB(0, 0), b2, voffB); PG8_STAGE(PG8_SB(0, 1), b2 + hstepB, voffB); PG8_STAGE(PG8_SA(0, 0), a2, voffA);
            PG8_WAIT_V(8); PG8_WAIT_L(0); PG8_BAR; PG8_MMA(1, 0, At, B0); PG8_MMA(1, 1, At, B1); PG8_BAR; PG8_SCHED;
            PG8_LDB(B0, 1, 0); PG8_LDB(B1, 1, 1); PG8_SCHED; PG8_LDA(At, 1, 0); PG8_STAGE(PG8_SA(0, 1), a2 + hstepA, voffA);
            PG8_WAIT_V(8); PG8_WAIT_L(0); PG8_BAR; PG8_MMA(0, 0, At, B0); PG8_MMA(0, 1, At, B1); PG8_BAR; PG8_SCHED;
            PG8_LDA(At, 1, 1); PG8_STAGE(PG8_SB(1, 0), b3, voffB); PG8_STAGE(PG8_SB(1, 1), b3 + hstepB, voffB); PG8_STAGE(PG8_SA(1, 0), a3, voffA);
            PG8_WAIT_V(8); PG8_WAIT_L(0); PG8_BAR; PG8_MMA(1, 0, At, B0); PG8_MMA(1, 1, At, B1); PG8_BAR; PG8_SCHED;
        }
        if constexpr (ALIGN_EPI) { if (wr == 0) PG8_BAR; }
        { int ln_; asm volatile("v_mbcnt_lo_u32_b32 %0, -1, 0\n\tv_mbcnt_hi_u32_b32 %0, -1, %0" : "=v"(ln_)); E(acc, cur, wr, wc, ln_ & 15, ln_ >> 4); }
        if (!has_next) break;
#pragma unroll
        for (int a = 0; a < 2; ++a)
#pragma unroll
            for (int b = 0; b < 2; ++b)
#pragma unroll
                for (int m = 0; m < 4; ++m)
#pragma unroll
                    for (int n = 0; n < 2; ++n) acc[a][b][m][n] = (f32x4){0.f, 0.f, 0.f, 0.f};
        cur = nxt; cA = nA; cB = nB; ++ui;
        if constexpr (ALIGN_EPI) { if (wr == 1) PG8_BAR; }
    }
    PG8_WAIT_V(0);
    if constexpr (!ALIGN_EPI) { if (wr == 0) PG8_BAR; }
    PG8_BAR;
#undef PG8_SA
#undef PG8_SB
#undef PG8_STAGE
#undef PG8_LDA
#undef PG8_LDB
#undef PG8_MMA
#undef PG8_WAIT_V
#undef PG8_WAIT_L
#undef PG8_BAR
#undef PG8_SCHED
}

template <class Epi, class Sched, bool ALIGN_EPI>
__device__ __forceinline__ void gemm_phase8(LAS unsigned char* lds, const int tid_in, const Gemm g, const Sched& S, const Epi& E) {
    const int tid = tid_in, wid = __builtin_amdgcn_readfirstlane(tid >> 6), lane = tid & 63, wr = wid >> 2, wc = wid & 3, fr = lane & 15, fq = lane >> 4;
    const int K = g.K, nt = K / 128, lda = g.lda;
    unsigned voffA, voffB;
    { int R, C; stage_rc(tid * 16, R, C); const int Rb = (R & ~31) + perm32(R & 31); voffA = (unsigned)(R * lda + C * 2); voffB = (unsigned)(Rb * K + C * 2); }
    const unsigned pstepA = 64u * (unsigned)lda, pstepB = 64u * (unsigned)K;
    const unsigned kstep = (unsigned)(BK * 2);
    const unsigned hstepA = (unsigned)HALF * (unsigned)lda, tstepA = 2 * hstepA, hstepB = (unsigned)HALF * (unsigned)K, tstepB = 2 * hstepB;
    const __amdgpu_buffer_rsrc_t rsA = __builtin_amdgcn_make_buffer_rsrc((void*)g.A, 0, 0x7fffffff, 0x00020000), rsB = __builtin_amdgcn_make_buffer_rsrc((void*)g.Bt, 0, 0x7fffffff, 0x00020000);
    const unsigned ldsw = (unsigned)wid * 1024u;
    const int aoff0 = lds_byte(wr * 64 + fr, fq * 16), aoff1 = aoff0 + 16, boff0 = lds_byte(wc * 32 + fr, fq * 16), boff1 = boff0 + 16;
#define PG8_SA(b, h) (((b) * 2 + (h)) * HTB)
#define PG8_SB(b, h) ((4 + (b) * 2 + (h)) * HTB)
#define PG8_STAGE(bufoff, goff, voff, pstep) do { _Pragma("unroll") for (int _i = 0; _i < 2; ++_i) \
        __builtin_amdgcn_raw_ptr_buffer_load_lds(PG8_RS_##voff, (LAS unsigned*)(lds + (bufoff) + ldsw + _i * 8192), 16, (int)(voff), (int)((goff) + _i * (pstep)), 0, 0); } while (0)
#define PG8_RS_voffA rsA
#define PG8_RS_voffB rsB
#define PG8_LDA(dst, b, h) do { _Pragma("unroll") for (int m = 0; m < 4; ++m) { dst[m][0] = *(const LAS u32x4*)(lds + PG8_SA(b, h) + aoff0 + m * 2048); dst[m][1] = *(const LAS u32x4*)(lds + PG8_SA(b, h) + aoff1 + m * 2048); } } while (0)
#define PG8_LDB(dst, b, h) do { _Pragma("unroll") for (int n = 0; n < 2; ++n) { dst[n][0] = *(const LAS u32x4*)(lds + PG8_SB(b, h) + boff0 + n * 2048); dst[n][1] = *(const LAS u32x4*)(lds + PG8_SB(b, h) + boff1 + n * 2048); } } while (0)
#define PG8_J8(x) __builtin_bit_cast(i32x8, __builtin_shufflevector((x)[0], (x)[1], 0, 1, 2, 3, 4, 5, 6, 7))
#define PG8_MMA(ai, bj, At, Bt) do { __builtin_amdgcn_s_setprio(1); _Pragma("unroll") for (int m = 0; m < 4; ++m) _Pragma("unroll") for (int n = 0; n < 2; ++n) \
        acc[ai][bj][m][n] = __builtin_amdgcn_mfma_scale_f32_16x16x128_f8f6f4(PG8_J8(Bt[n]), PG8_J8(At[m]), acc[ai][bj][m][n], 0, 0, 0, 0, 0, 0);        __builtin_amdgcn_s_setprio(0); } while (0)
#define PG8_WAIT_V(n) asm volatile("s_waitcnt vmcnt(" #n ")" ::: "memory")
#define PG8_WAIT_L(n) asm volatile("s_waitcnt lgkmcnt(" #n ")" ::: "memory")
#define PG8_BAR __builtin_amdgcn_s_barrier()
#define PG8_SCHED __builtin_amdgcn_sched_barrier(0)
    Unit cur, nxt; int ui = 0;
    if (!S.next(0, cur)) return;
    f32x4 acc[2][2][4][2];
#pragma unroll
    for (int a = 0; a < 2; ++a)
#pragma unroll
        for (int b = 0; b < 2; ++b)
#pragma unroll
            for (int m = 0; m < 4; ++m)
#pragma unroll
                for (int n = 0; n < 2; ++n) acc[a][b][m][n] = (f32x4){0.f, 0.f, 0.f, 0.f};
    u32x4 At[4][2], B0[2][2], B1[2][2];
    unsigned cA = (unsigned)cur.pm * tstepA + (unsigned)cur.aoff, cB = (unsigned)cur.pn * tstepB;
    PG8_STAGE(PG8_SB(0, 0), cB, voffB, pstepB); PG8_STAGE(PG8_SB(0, 1), cB + hstepB, voffB, pstepB); PG8_STAGE(PG8_SA(0, 0), cA, voffA, pstepA); PG8_STAGE(PG8_SA(0, 1), cA + hstepA, voffA, pstepA);
    if (wr == 1) PG8_BAR;
    PG8_WAIT_V(2); PG8_BAR;
    PG8_STAGE(PG8_SB(1, 0), cB + kstep, voffB, pstepB); PG8_STAGE(PG8_SA(1, 0), cA + kstep, voffA, pstepA); PG8_STAGE(PG8_SB(1, 1), cB + hstepB + kstep, voffB, pstepB);
    PG8_WAIT_V(6); PG8_BAR;
    for (;;) {
        const bool has_next = S.next(ui + 1, nxt);
        const unsigned nA = has_next ? (unsigned)nxt.pm * tstepA + (unsigned)nxt.aoff : cA, nB = has_next ? (unsigned)nxt.pn * tstepB : cB;
#pragma unroll 1
        for (int t = 0; t < nt; t += 2) {
            const bool last = (t == nt - 2);
            const unsigned a1 = cA + (unsigned)(t + 1) * kstep;
            const unsigned a2 = last ? nA : cA + (unsigned)(t + 2) * kstep, b2 = last ? nB : cB + (unsigned)(t + 2) * kstep;
            const unsigned a3 = a2 + kstep, b3 = b2 + kstep;
            PG8_LDB(B0, 0, 0); PG8_LDB(B1, 0, 1); PG8_SCHED; PG8_LDA(At, 0, 0); PG8_STAGE(PG8_SA(1, 1), a1 + hstepA, voffA, pstepA);
            PG8_WAIT_V(8); PG8_WAIT_L(0); PG8_BAR; PG8_MMA(0, 0, At, B0); PG8_MMA(0, 1, At, B1); PG8_BAR; PG8_SCHED;
            PG8_LDA(At, 0, 1); PG8_STAGE(PG8_SB(0, 0), b2, voffB, pstepB); PG8_STAGE(PG8_SB(0, 1), b2 + hstepB, voffB, pstepB); PG8_STAGE(PG8_SA(0, 0), a2, voffA, pstepA);
            PG8_WAIT_V(8); PG8_WAIT_L(0); PG8_BAR; PG8_MMA(1, 0, At, B0); PG8_MMA(1, 1, At, B1); PG8_BAR; PG8_SCHED;
            PG8_LDB(B0, 1, 0); PG8_LDB(B1, 1, 1); PG8_SCHED; PG8_LDA(At, 1, 0); PG8_STAGE(PG8_SA(0, 1), a2 + hstepA, voffA, pstepA);
            PG8_WAIT_V(8); PG8_WAIT_L(0); PG8_BAR; PG8_MMA(0, 0, At, B0); PG8_MMA(0, 1, At, B1); PG8_BAR; PG8_SCHED;
            PG8_LDA(At, 1, 1); PG8_STAGE(PG8_SB(1, 0), b3, voffB, pstepB); PG8_STAGE(PG8_SB(1, 1), b3 + hstepB, voffB, pstepB); PG8_STAGE(PG8_SA(1, 0), a3, voffA, pstepA);
            PG8_WAIT_V(8); PG8_WAIT_L(0); PG8_BAR; PG8_MMA(1, 0, At, B0); PG8_MMA(1, 1, At, B1); PG8_BAR; PG8_SCHED;
        }
        if constexpr (ALIGN_EPI) { if (wr == 0) PG8_BAR; }
        { int ln_; asm volatile("v_mbcnt_lo_u32_b32 %0, -1, 0\n\tv_mbcnt_hi_u32_b32 %0, -1, %0" : "=v"(ln_)); E(acc, cur, wr, wc, ln_ & 15, ln_ >> 4); }
        if (!has_next) break;
#pragma unroll
        for (int a = 0; a < 2; ++a)
#pragma unroll
            for (int b = 0; b < 2; ++b)
#pragma unroll
                for (int m = 0; m < 4; ++m)
#pragma unroll
                    for (int n = 0; n < 2; ++n) acc[a][b][m][n] = (f32x4){0.f, 0.f, 0.f, 0.f};
        cur = nxt; cA = nA; cB = nB; ++ui;
        if constexpr (ALIGN_EPI) { if (wr == 1) PG8_BAR; }
    }
    PG8_WAIT_V(0);
    if constexpr (!ALIGN_EPI) { if (wr == 0) PG8_BAR; }
    PG8_BAR;
#undef PG8_SA
#undef PG8_SB
#undef PG8_STAGE
#undef PG8_RS_voffA
#undef PG8_RS_voffB
#undef PG8_LDA
#undef PG8_LDB
#undef PG8_MMA
#undef PG8_J8
#undef PG8_WAIT_V
#undef PG8_WAIT_L
#undef PG8_BAR
#undef PG8_SCHED
}

typedef f32x4 Acc[2][2][4][2];

struct EpiRoute {
    bf16_t *d0, *d1, *d2, *d3;
    __device__ __forceinline__ void operator()(const Acc& acc, const Unit& u, int wr, int wc, int fr, int fq) const {
        const int pn = u.pn; bf16_t* base; int ld, ct;
        if (pn < 4) { base = d0; ld = 1024; ct = pn; } else if (pn < 7) { base = d1; ld = 768; ct = pn - 4; } else if (pn < 11) { base = d2; ld = 1024; ct = pn - 7; } else { base = d3; ld = 512; ct = pn - 11; }
        const int row0 = u.pm * BM + wr * 64 + fr, col0 = ct * 256 + wc * 32 + 8 * fq;
#pragma unroll
        for (int ai = 0; ai < 2; ++ai)
#pragma unroll
            for (int m = 0; m < 4; ++m) { bf16_t* rowp = base + (size_t)(row0 + ai * HALF + m * 16) * ld + col0;
#pragma unroll
                for (int bj = 0; bj < 2; ++bj) { const f32x4 v0 = acc[ai][bj][m][0], v1 = acc[ai][bj][m][1]; u32x4 w;
                    w.x = cvt_pk_bf16(v0[0], v0[1]); w.y = cvt_pk_bf16(v0[2], v0[3]); w.z = cvt_pk_bf16(v1[0], v1[1]); w.w = cvt_pk_bf16(v1[2], v1[3]);
                    *(u32x4*)(rowp + bj * HALF) = w; } }
    }
};
struct EpiBf16 {
    bf16_t* O; int ld, pnmask; float sc;
    __device__ __forceinline__ void operator()(const Acc& acc, const Unit& u, int wr, int wc, int fr, int fq) const {
        const int row0 = u.pm * BM + wr * 64 + fr, col0 = (u.pn & pnmask) * 256 + wc * 32 + 8 * fq;
#pragma unroll
        for (int ai = 0; ai < 2; ++ai)
#pragma unroll
            for (int m = 0; m < 4; ++m) { bf16_t* rowp = O + (size_t)(row0 + ai * HALF + m * 16) * ld + col0;
#pragma unroll
                for (int bj = 0; bj < 2; ++bj) { const f32x4 v0 = acc[ai][bj][m][0] * sc, v1 = acc[ai][bj][m][1] * sc; u32x4 w;
                    w.x = cvt_pk_bf16(v0[0], v0[1]); w.y = cvt_pk_bf16(v0[2], v0[3]); w.z = cvt_pk_bf16(v1[0], v1[1]); w.w = cvt_pk_bf16(v1[2], v1[3]);
                    *(u32x4*)(rowp + bj * HALF) = w; } }
    }
};
struct EpiLora {
    float* wdec; bf16_t* ag; const float* w0; const float* a0;
    __device__ __forceinline__ void operator()(const Acc& acc, const Unit& u, int wr, int wc, int fr, int fq) const {
        const int row0 = u.pm * BM + wr * 64 + fr, cl0 = wc * 32 + 8 * fq, pn = u.pn;
#pragma unroll
        for (int ai = 0; ai < 2; ++ai)
#pragma unroll
            for (int m = 0; m < 4; ++m) { const size_t row = (size_t)(row0 + ai * HALF + m * 16);
#pragma unroll
                for (int bj = 0; bj < 2; ++bj) { const int col = bj * HALF + cl0; float v[8];
#pragma unroll
                    for (int n = 0; n < 2; ++n)
#pragma unroll
                        for (int e = 0; e < 4; ++e) v[4 * n + e] = acc[ai][bj][m][n][e];
                    if (pn == 0) {
                        *(f32x4*)(wdec + row * 256 + col) = (f32x4){v[0], v[1], v[2], v[3]}; *(f32x4*)(wdec + row * 256 + col + 4) = (f32x4){v[4], v[5], v[6], v[7]};
                    } else if (pn == 1) {
                        *(u32x4*)(ag + row * 512 + col) = pack8(v);
                    } else { *(u32x4*)(ag + row * 512 + 256 + col) = pack8(v); }
                } }
    }
};
struct EpiGateMerge {
    const bf16_t* ball; bf16_t* merged;
    __device__ __forceinline__ void operator()(const Acc& acc, const Unit& u, int wr, int wc, int fr, int fq) const {
        const int row0 = u.pm * BM + wr * 64 + fr, o0 = 64 * u.pn + 16 * wc + 4 * fq;
#pragma unroll
        for (int ai = 0; ai < 2; ++ai)
#pragma unroll
            for (int m = 0; m < 4; ++m) { const size_t row = (size_t)(row0 + ai * HALF + m * 16); float s[4] = {0.f, 0.f, 0.f, 0.f};
#pragma unroll
                for (int bj = 0; bj < 2; ++bj)
#pragma unroll
                    for (int n = 0; n < 2; ++n) { const int gi = 2 * bj + n; if (!((GMASK >> gi) & 1)) continue; const u32x2 b = *(const u32x2*)(ball + row * 4096 + 1024 * gi + o0);
                        const f32x4 a = acc[ai][bj][m][n] * F8_DESCALE;
                        s[0] += sigm(a[0]) * bflo(b.x); s[1] += sigm(a[1]) * bfhi(b.x); s[2] += sigm(a[2]) * bflo(b.y); s[3] += sigm(a[3]) * bfhi(b.y); }
                u32x2 w; w.x = cvt_pk_bf16(s[0], s[1]); w.y = cvt_pk_bf16(s[2], s[3]);
                *(u32x2*)(merged + row * 1024 + o0) = w; }
    }
};
struct EpiResidual {
    bf16_t* xb; float sc;
    __device__ __forceinline__ void operator()(const Acc& acc, const Unit& u, int wr, int wc, int fr, int fq) const {
        const int row0 = u.pm * BM + wr * 64 + fr, col0 = u.pn * 256 + wc * 32 + 8 * fq;
#pragma unroll
        for (int ai = 0; ai < 2; ++ai)
#pragma unroll
            for (int m = 0; m < 4; ++m) { bf16_t* rowp = xb + (size_t)(row0 + ai * HALF + m * 16) * 1024 + col0;
#pragma unroll
                for (int bj = 0; bj < 2; ++bj) { u32x4* p = (u32x4*)(rowp + bj * HALF); u32x4 t = *p; const f32x4 a0 = acc[ai][bj][m][0] * sc, a1 = acc[ai][bj][m][1] * sc;
                    t.x = cvt_pk_bf16(bflo(t.x) + a0[0], bfhi(t.x) + a0[1]); t.y = cvt_pk_bf16(bflo(t.y) + a0[2], bfhi(t.y) + a0[3]);
                    t.z = cvt_pk_bf16(bflo(t.z) + a1[0], bfhi(t.z) + a1[1]); t.w = cvt_pk_bf16(bflo(t.w) + a1[2], bfhi(t.w) + a1[3]); *p = t; } }
    }
};
struct EpiSwiglu {
    unsigned char* hid; int ldh, ncol; bool pad;
    __device__ __forceinline__ void operator()(const Acc& acc, const Unit& u, int wr, int wc, int fr, int fq) const {
        const int pl = u.pn % ncol; const int row0 = u.pm * BM + wr * 64 + fr, col0 = pl * 128 + wc * 32 + 8 * fq;
        const bool dopad = pad && (pl == ncol - 1);
#pragma unroll
        for (int ai = 0; ai < 2; ++ai)
#pragma unroll
            for (int m = 0; m < 4; ++m) { float v[8];
#pragma unroll
                for (int n = 0; n < 2; ++n)
#pragma unroll
                    for (int e = 0; e < 4; ++e) { const float a = acc[ai][0][m][n][e] * F8_DESCALE, b = acc[ai][1][m][n][e] * F8_DESCALE; v[4 * n + e] = a * sigm(a) * b * F8_MUL_H; }
                unsigned char* rp = hid + (size_t)(row0 + ai * HALF + m * 16) * ldh + col0;
                u32x2 w; w.x = pk4_fp8(v[0], v[1], v[2], v[3]); w.y = pk4_fp8(v[4], v[5], v[6], v[7]); *(u32x2*)rp = w;
                if (dopad) { unsigned z0; asm volatile("v_mov_b32 %0, 0" : "=v"(z0)); *(u32x2*)(rp + 128) = (u32x2){z0, z0}; } }
    }
};
struct EpiMoeOut {
    float* out; const int* rowtok; const float* rowgate; const int* segend;
    __device__ __forceinline__ void operator()(const Acc& acc, const Unit& u, int wr, int wc, int fr, int fq) const {
        const int row0 = u.pm * BM + wr * 64 + fr, col0 = (u.pn & 3) * 256 + wc * 32 + 8 * fq, lim = segend[u.pm];
#pragma unroll
        for (int ai = 0; ai < 2; ++ai)
#pragma unroll
            for (int m = 0; m < 4; ++m) { const int row = row0 + ai * HALF + m * 16;
                if (row < lim) { const int tok = rowtok[row]; const float gt = rowgate[row]; float* rowp = out + (size_t)tok * 1024 + col0;
#pragma unroll
                    for (int bj = 0; bj < 2; ++bj)
#pragma unroll
                        for (int n = 0; n < 2; ++n)
#pragma unroll
                            for (int e = 0; e < 4; ++e) __hip_atomic_fetch_add(rowp + bj * HALF + 4 * n + e, gt * acc[ai][bj][m][n][e], __ATOMIC_RELAXED, __HIP_MEMORY_SCOPE_AGENT);
                } }
    }
};
}

#define XB_TMO      128
#define XB_XCNT(j)  (256  + 64 * (j))
#define XB_XSUB(j)  (1280 + 64 * (j))
#define XB_XGEN(j)  (2304 + 64 * (j))
#define XB_TOP      3328
#define XB_TOPGEN   3392
#define XCD_BAR_WORDS 3456
#define XB_SPIN_CAP (1u << 18)
__device__ __forceinline__ unsigned xb_ld(unsigned* p)              { return __hip_atomic_load(p, __ATOMIC_RELAXED, __HIP_MEMORY_SCOPE_AGENT); }
__device__ __forceinline__ unsigned xb_add(unsigned* p, unsigned v) { return __hip_atomic_fetch_add(p, v, __ATOMIC_RELAXED, __HIP_MEMORY_SCOPE_AGENT); }
__device__ __forceinline__ unsigned xb_xcc_id() { return (unsigned)__builtin_amdgcn_s_getreg((3 << 11) | 20) & 0xFu; }
#define XB_SPIN(cond, bar) do { unsigned _sp = 0; while (cond) { __builtin_amdgcn_s_sleep(1); \
    if ((++_sp & 255u) == 0u) { if (xb_ld(&(bar)[XB_TMO])) break; if (_sp > XB_SPIN_CAP) { atomicAdd(&(bar)[XB_TMO], 1u); break; } } } } while (0)
struct XcdBarrier { unsigned* bar; unsigned x; volatile LAS unsigned* st; };
__device__ __forceinline__ XcdBarrier xcd_barrier_post(unsigned* bar, volatile LAS unsigned* st) {
    XcdBarrier b; b.bar = bar; b.x = xb_xcc_id(); b.st = st;
    if (threadIdx.x == 0) (void)xb_add(&bar[XB_XCNT(b.x)], 1u);
    return b;
}
__device__ __forceinline__ void xcd_barrier_complete(unsigned* bar, unsigned x, unsigned& nloc, unsigned& nx) {
    const unsigned G = gridDim.x * gridDim.y * gridDim.z;
    unsigned sum, cnt, mine, sp = 0u;
    for (;;) {
        sum = 0u; cnt = 0u; mine = 0u;
#pragma unroll
        for (unsigned j = 0; j < 16; ++j) { const unsigned c = xb_ld(&bar[XB_XCNT(j)]); sum += c; cnt += (c > 0u) ? 1u : 0u; mine = (j == x) ? c : mine; }
        if (sum == G) break;
        __builtin_amdgcn_s_sleep(1);
        if ((++sp & 255u) == 0u) { if (xb_ld(&bar[XB_TMO])) break; if (sp > XB_SPIN_CAP) { atomicAdd(&bar[XB_TMO], 1u); break; } }
    }
    nloc = mine > 0u ? mine : 1u; nx = cnt > 0u ? cnt : 1u;
}
__device__ __forceinline__ void xcd_barrier(const XcdBarrier& b, const int tid) {
    asm volatile("s_waitcnt vmcnt(0)" ::: "memory");
    __syncthreads();
    if (tid == 0) {
        unsigned* bar = b.bar;
        __builtin_amdgcn_s_waitcnt(0);
        unsigned nloc = b.st[0], nx = b.st[1];
        if (nloc == 0u) { xcd_barrier_complete(bar, b.x, nloc, nx); b.st[0] = nloc; b.st[1] = nx; }
        const unsigned old = xb_add(&bar[XB_XSUB(b.x)], 1u);
        const unsigned gen = old / nloc;
        if (old + 1u == (gen + 1u) * nloc) {
            __builtin_amdgcn_fence(__ATOMIC_RELEASE, "agent");
            asm volatile("s_waitcnt vmcnt(0)" ::: "memory");
            const unsigned og = xb_add(&bar[XB_TOP], 1u);
            const unsigned tg = og / nx;
            if (og + 1u == (tg + 1u) * nx) xb_add(&bar[XB_TOPGEN], 1u);
            else XB_SPIN(xb_ld(&bar[XB_TOPGEN]) == tg, bar);
            __builtin_amdgcn_fence(__ATOMIC_ACQUIRE, "agent");
            xb_add(&bar[XB_XGEN(b.x)], 1u);
            asm volatile("s_waitcnt vmcnt(0)" ::: "memory");
        } else {
            XB_SPIN(xb_ld(&bar[XB_XGEN(b.x)]) == gen, bar);
            __builtin_amdgcn_fence(__ATOMIC_ACQUIRE, "agent");
            asm volatile("s_waitcnt vmcnt(0)" ::: "memory");
        }
    }
    __syncthreads();
}

constexpr size_t MiB = 1u << 20;
constexpr size_t WS_CTL = 0, CTL_ZERO_BYTES = 1 * MiB;
constexpr int CW_BAR = 4096;
constexpr int CW_QUEUE = 20480;
constexpr int CW_MOE = 16384;
constexpr size_t WS_EIDX = 1 * MiB, WS_GATE = WS_EIDX + 256 * 1024, WS_ROWTOK = WS_EIDX + 512 * 1024, WS_ROWGATE = 2 * MiB, WS_TEXP = 2 * MiB + 512 * 1024, WS_SEGEND = WS_TEXP + 4096, WS_NT = WS_TEXP + 8192;
constexpr size_t WS_SLOTOF = 2 * MiB + 768 * 1024;
constexpr size_t WS_BON = 3 * MiB, WS_COS = 4 * MiB, WS_SIN = 6 * MiB;
constexpr size_t WS_WIN = 8 * MiB, WS_WLORA = 15 * MiB, WS_WB = 16 * MiB, WS_WG = 18 * MiB, WS_WOUT = 26 * MiB, WS_W13 = 28 * MiB  , WS_W2D = 50 * MiB, WS_W2M = 50 * MiB, WS_H8 = 72 * MiB  ;
constexpr size_t WS_XB = 104 * MiB  , WS_Y = 168 * MiB, WS_BIG = 232 * MiB;
constexpr size_t WS_RW = WS_BIG, WS_WDEC = WS_BIG, WS_AG = WS_BIG + 32 * MiB, WS_SB = WS_BIG + 64 * MiB, WS_RET = WS_BIG + 112 * MiB, WS_CV = WS_BIG + 176 * MiB, WS_Y0 = WS_CV;
constexpr size_t WS_RKVS = WS_BIG + 208 * MiB, WS_ALORA = WS_BIG + 256 * MiB, WS_RHAT = WS_ALORA, WS_KV = WS_BIG + 272 * MiB, WS_SST = WS_WDEC  , WS_PQ = WS_BIG + 304 * MiB  , WS_END = WS_BIG + 368 * MiB;
constexpr size_t WS_BALL = WS_BIG, WS_MERGED = WS_BIG + 256 * MiB, WS_HID = WS_BIG, WS_XS = WS_BIG, WS_YS = WS_XS, WS_HIDM = WS_BIG + 132 * MiB;
static_assert(WS_HIDM + (size_t)MPAD * DFE * 2 <= WS_END && WS_MERGED + (size_t)T * D * 2 <= WS_END && WS_W2M + (size_t)NEXP * D * DFE * 2 <= WS_H8, "ws map");
static_assert(WS_W13 + (size_t)NEXP * 2 * DFE * D <= WS_W2M && WS_W13 + (size_t)2 * DFF * D <= WS_W2D && WS_W2M + (size_t)NEXP * D * DFE * 2 <= WS_H8 && WS_H8 + (size_t)T * D <= WS_XB, "ws map weights");

constexpr int LDS_BYTES = 147456, RING_BYTES = 131072, MISC_OFF = RING_BYTES + 320;

struct Args { const float* in[32]; float* out; unsigned char* ws; int ph_lo, ph_hi; };
#define CAS __attribute__((address_space(4)))
struct Ctx {
    LAS unsigned char* lds; unsigned char* ws; float* out; const float* const CAS* in;
    int tid, lane, wave, G, bid;
};
__device__ __forceinline__ const CAS Args* ka_ptr() { const CAS Args* p = (const CAS Args*)__builtin_amdgcn_kernarg_segment_ptr(); asm volatile("" : "+s"(p)); return p; }
extern __shared__ __attribute__((aligned(16))) unsigned char lds_raw[];
__device__ __forceinline__ Ctx make_ctx(int wv) {
    const CAS Args* ka = ka_ptr();
    Ctx C; C.lds = (LAS unsigned char*)lds_raw; C.ws = ka->ws; C.out = ka->out; C.in = ka->in;
    int g_ = gridDim.x, b_ = blockIdx.x, w_ = wv; asm volatile("" : "+s"(g_), "+s"(b_), "+s"(w_));
    int ln_; asm volatile("v_mbcnt_lo_u32_b32 %0, -1, 0\n\tv_mbcnt_hi_u32_b32 %0, -1, %0" : "=v"(ln_));
    C.lane = ln_; C.wave = w_; C.tid = w_ * 64 + ln_; C.G = g_; C.bid = b_;
    return C;
}
enum { I_X = 0, I_NORM_MIX, I_W_IN, I_RW_MU, I_RW_W0, I_RW_W2, I_RW_A0, I_RW_A2, I_RW_G2, I_RW_KK, I_RW_KA, I_RW_RK, I_RW_LNW, I_RW_LNB, I_SB_QN, I_SB_KN, I_RET_GN,
       I_CONV_DW, I_CONV_B, I_CONV_LNW, I_CONV_LNB, I_W_GATE, I_W_BRANCH, I_W_OUT, I_NORM_FFN, I_FFN_W1, I_FFN_W3, I_FFN_W2, I_ROUTER, I_MOE_W1, I_MOE_W3, I_MOE_W2 };

__device__ __forceinline__ int q_next(const Ctx& C, unsigned* head) {
    LAS int* slot = (LAS int*)(C.lds + MISC_OFF + 64);
    __syncthreads();
    if (C.tid == 0) *slot = (int)__hip_atomic_fetch_add(head, 1u, __ATOMIC_RELAXED, __HIP_MEMORY_SCOPE_AGENT);
    __syncthreads();
    return *slot;
}
__device__ __forceinline__ void ph_prologue_(const Ctx& C) {
    const size_t gid = (size_t)C.bid * NTHR + C.tid, gsz = (size_t)C.G * NTHR;
    float* cs = (float*)(C.ws + WS_COS); float* sn = (float*)(C.ws + WS_SIN);
    for (size_t i = gid; i < (size_t)SEQ * 32; i += gsz) {
        const int pos = (int)(i >> 5), j = (int)(i & 31);
        const float inv = (float)pow(10000.0, -(double)(2 * j) / 64.0);
        const float ang = (float)pos * inv;
        cs[i] = (float)cos((double)ang); sn[i] = (float)sin((double)ang);
    }
}

__device__ __forceinline__ int dest_row(int mode, int roff, int which, int n) {
    if (mode == 0) return roff + n;
    if (mode == 1) { const int pn = n >> 6, oc = n & 63; return 256 * pn + 128 * (roff >> 1) + 32 * (oc >> 4) + 8 * ((oc >> 2) & 3) + 4 * (roff & 1) + (oc & 3); }
    return roff + 256 * (n >> 7) + 128 * which + (n & 127);
}
__device__ __forceinline__ void xpose_item(const float* W, int K, int N, bf16* WT, int mode, int roff, int which, LAS float* scr, int item, int lane) {
    const int nblk = N / 32, kb = item / nblk, nb = item % nblk, k0 = 64 * kb, n0 = 32 * nb;
#pragma unroll
    for (int i = 0; i < 8; ++i) { const int kk = (lane >> 3) + 8 * i, c4 = (lane & 7) * 4; const f32x4 v = *(const f32x4*)(W + (size_t)(k0 + kk) * N + n0 + c4);
        scr[kk * 33 + c4] = v.x; scr[kk * 33 + c4 + 1] = v.y; scr[kk * 33 + c4 + 2] = v.z; scr[kk * 33 + c4 + 3] = v.w; }
    asm volatile("s_waitcnt lgkmcnt(0)" ::: "memory");
    const int c = lane & 7;
#pragma unroll
    for (int j = 0; j < 4; ++j) { const int n = (lane >> 3) + 8 * j; const LAS float* s = scr + (8 * c) * 33 + n;
        u32x4 o; o.x = cvt_pk_bf16(s[0 * 33], s[1 * 33]); o.y = cvt_pk_bf16(s[2 * 33], s[3 * 33]); o.z = cvt_pk_bf16(s[4 * 33], s[5 * 33]); o.w = cvt_pk_bf16(s[6 * 33], s[7 * 33]);
        *(u32x4*)(WT + (size_t)dest_row(mode, roff, which, n0 + n) * K + k0 + 8 * c) = o; }
    asm volatile("s_waitcnt lgkmcnt(0)" ::: "memory");
}
__device__ __forceinline__ void xpose_item8(const float* W, int K, int N, unsigned char* WT, int mode, int roff, int which, LAS float* scr, int item, int lane, int ldk = 0) {
    if (ldk == 0) ldk = K;
    const int nblk = N / 32, kb = item / nblk, nb = item % nblk, k0 = 64 * kb, n0 = 32 * nb;
#pragma unroll
    for (int i = 0; i < 8; ++i) { const int kk = (lane >> 3) + 8 * i, c4 = (lane & 7) * 4; const f32x4 v = *(const f32x4*)(W + (size_t)(k0 + kk) * N + n0 + c4);
        scr[kk * 33 + c4] = v.x; scr[kk * 33 + c4 + 1] = v.y; scr[kk * 33 + c4 + 2] = v.z; scr[kk * 33 + c4 + 3] = v.w; }
    asm volatile("s_waitcnt lgkmcnt(0)" ::: "memory");
    const int c = lane & 3;
#pragma unroll
    for (int j = 0; j < 2; ++j) { const int n = (lane >> 2) + 16 * j; const LAS float* sp = scr + (16 * c) * 33 + n;
        u32x4 o;
        o.x = pk4_fp8(sp[0 * 33] * F8_MUL_W, sp[1 * 33] * F8_MUL_W, sp[2 * 33] * F8_MUL_W, sp[3 * 33] * F8_MUL_W);
        o.y = pk4_fp8(sp[4 * 33] * F8_MUL_W, sp[5 * 33] * F8_MUL_W, sp[6 * 33] * F8_MUL_W, sp[7 * 33] * F8_MUL_W);
        o.z = pk4_fp8(sp[8 * 33] * F8_MUL_W, sp[9 * 33] * F8_MUL_W, sp[10 * 33] * F8_MUL_W, sp[11 * 33] * F8_MUL_W);
        o.w = pk4_fp8(sp[12 * 33] * F8_MUL_W, sp[13 * 33] * F8_MUL_W, sp[14 * 33] * F8_MUL_W, sp[15 * 33] * F8_MUL_W);
        *(u32x4*)(WT + (size_t)dest_row(mode, roff, which, n0 + n) * ldk + k0 + 16 * c) = o; }
    asm volatile("s_waitcnt lgkmcnt(0)" ::: "memory");
}
__device__ __forceinline__ void ph_weights_(const Ctx& C, int l, int part, int first_wg, int nwg, unsigned* qhead = nullptr) {
    LAS float* scr = (LAS float*)(C.lds + C.wave * 16384);
    const int gw = (C.bid - first_wg) * NWAVES + C.wave, NGW = nwg * NWAVES, lane = C.lane;
    unsigned char* ws = C.ws;
    const bool moe = (l & 1);
    const int l2 = l >> 1;
    constexpr int IT_IN = (D / 64) * (NIN / 32), IT_B = (256 / 64) * (D / 32), IT_G = (D / 64) * (D / 32), IT_O = IT_G;
    constexpr int IT_F1 = (D / 64) * (DFF / 32), IT_F2 = (DFF / 64) * (D / 32), IT_M1 = (D / 64) * (DFE / 32), IT_M2 = (DFE / 64) * (D / 32);
    const int n_fixed = IT_IN + 4 * IT_B + 4 * IT_G + IT_O;
    if (part == 1) {
        if (C.bid < first_wg) return;
        const int n1 = moe ? NEXP * IT_M2 : (2 * IT_F1 + IT_F2);
        for (int it = qhead ? q_next(C, qhead) * NWAVES + C.wave : gw; qhead ? (it - C.wave < n1) : (it < n1); it = qhead ? q_next(C, qhead) * NWAVES + C.wave : it + NGW) {
            if (it >= n1) continue;
            int r = it;
            if (!moe) {
                if (r < IT_F1) { xpose_item8(C.in[I_FFN_W1] + (size_t)l2 * D * DFF, D, DFF, ws + WS_W13, 2, 0, 0, scr, r, lane); continue; } r -= IT_F1;
                if (r < IT_F1) { xpose_item8(C.in[I_FFN_W3] + (size_t)l2 * D * DFF, D, DFF, ws + WS_W13, 2, 0, 1, scr, r, lane); continue; } r -= IT_F1;
                xpose_item8(C.in[I_FFN_W2] + (size_t)l2 * DFF * D, DFF, D, ws + WS_W2D, 0, 0, 0, scr, r, lane);
            } else { const int e = r / IT_M2; r -= e * IT_M2;
                xpose_item8(C.in[I_MOE_W2] + ((size_t)l2 * NEXP + e) * DFE * D, DFE, D, ws + WS_W2M, 0, e * D, 0, scr, r, lane, DFE_PAD); }
        }
        if (moe) {
            for (int i = (C.bid - first_wg) * NTHR + C.tid; i < NEXP * D * ((DFE_PAD - DFE) / 16); i += nwg * NTHR) { const int row = i >> 3, c16 = i & 7;
                unsigned z0; asm volatile("v_mov_b32 %0, 0" : "=v"(z0)); *(u32x4*)(ws + WS_W2M + (size_t)row * DFE_PAD + DFE + 16 * c16) = (u32x4){z0, z0, z0, z0}; } }
        return;
    }
    const int n_ffn = moe ? (NEXP * 2 * IT_M1) : 0;
    for (int it = gw; it < n_fixed + n_ffn; it += NGW) {
        int r = it;
        if (r < IT_IN) { xpose_item(C.in[I_W_IN] + (size_t)l * D * NIN, D, NIN, (bf16*)(ws + WS_WIN), 0, 0, 0, scr, r, lane); continue; } r -= IT_IN;
        if (r < 4 * IT_B) { const int i = r / IT_B; xpose_item(C.in[I_W_BRANCH] + ((size_t)l * 4 + i) * 256 * D, 256, D, (bf16*)(ws + WS_WB), 0, 1024 * i, 0, scr, r % IT_B, lane); continue; } r -= 4 * IT_B;
        if (r < 4 * IT_G) { const int i = r / IT_G; xpose_item8(C.in[I_W_GATE] + ((size_t)l * 4 + i) * D * D, D, D, ws + WS_WG, 1, i, 0, scr, r % IT_G, lane); continue; } r -= 4 * IT_G;
        if (r < IT_O) { xpose_item(C.in[I_W_OUT] + (size_t)l * D * D, D, D, (bf16*)(ws + WS_WOUT), 0, 0, 0, scr, r, lane); continue; } r -= IT_O;
        { const int per = 2 * IT_M1, e = r / per; r -= e * per;
          if (r < IT_M1) { xpose_item8(C.in[I_MOE_W1] + ((size_t)l2 * NEXP + e) * D * DFE, D, DFE, ws + WS_W13, 2, e * 2 * DFE, 0, scr, r, lane); continue; } r -= IT_M1;
          xpose_item8(C.in[I_MOE_W3] + ((size_t)l2 * NEXP + e) * D * DFE, D, DFE, ws + WS_W13, 2, e * 2 * DFE, 1, scr, r, lane); }
    }
    bf16* WL = (bf16*)(ws + WS_WLORA);
    const float* w2 = C.in[I_RW_W2] + (size_t)l * 64 * 256; const float* a2 = C.in[I_RW_A2] + (size_t)l * 64 * 256; const float* g2 = C.in[I_RW_G2] + (size_t)l * 128 * 256;
    for (int i = C.bid * NTHR + C.tid; i < 768 * 256; i += C.G * NTHR) {
        const int n = i >> 8, k = i & 255; float v = 0.f;
        if (n < 256) { if (k < 64) v = w2[k * 256 + n]; }
        else if (n < 512) { if (k >= 64 && k < 128) v = a2[(k - 64) * 256 + (n - 256)]; }
        else { if (k >= 128) v = g2[(k - 128) * 256 + (n - 512)]; }
        WL[i] = f2bf(v);
    }
}

__device__ __forceinline__ void ph_norm_(const Ctx& C, const float* gain, bool route, const float* router, int moe_idx, bool combine = false, const float* src = nullptr, bool want_bf16 = true) {
    const int gw = C.bid * NWAVES + C.wave, NGW = C.G * NWAVES, lane = C.lane;
    bf16* H = (bf16*)C.out; bf16* XB = (bf16*)(C.ws + WS_XB);
    f32x4 g[4];
#pragma unroll
    for (int j = 0; j < 4; ++j) g[j] = *(const f32x4*)(gain + 8 * lane + 512 * (j >> 1) + 4 * (j & 1));
    LAS unsigned* lcnt = (LAS unsigned*)(C.lds);
    if (route) { if (C.tid < 8) lcnt[C.tid] = 0u; __syncthreads(); }
    int* eidx = (int*)(C.ws + WS_EIDX); float* gate = (float*)(C.ws + WS_GATE);
    constexpr int NR = 2;
    for (int mb = gw; mb < T; mb += NR * NGW) {
        f32x4 vv[NR][4]; u32x4 ya[NR][2], yb[NR][2]; float g0v[NR], g1v[NR];
#pragma unroll
        for (int r = 0; r < NR; ++r) { const int m = mb + r * NGW; if (m < T) {
            if (src) { const f32x4* xr = (const f32x4*)(src + (size_t)m * D + 8 * lane);
#pragma unroll
                for (int j = 0; j < 4; ++j) vv[r][j] = xr[128 * (j >> 1) + (j & 1)]; }
            else { const u32x4* xb = (const u32x4*)(XB + (size_t)m * D) + lane;
#pragma unroll
                for (int j = 0; j < 2; ++j) { const u32x4 t = xb[64 * j]; vv[r][2 * j] = f32x4{bflo(t.x), bfhi(t.x), bflo(t.y), bfhi(t.y)}; vv[r][2 * j + 1] = f32x4{bflo(t.z), bfhi(t.z), bflo(t.w), bfhi(t.w)}; } }
            if (combine) { const int* slotof = (const int*)(C.ws + WS_SLOTOF); const float* gt = (const float*)(C.ws + WS_GATE); const bf16* YS = (const bf16*)(C.ws + WS_YS);
                const int s0 = slotof[2 * m], s1 = slotof[2 * m + 1]; g0v[r] = gt[2 * m]; g1v[r] = gt[2 * m + 1];
                const u32x4* y0 = (const u32x4*)(YS + (size_t)s0 * D) + lane; const u32x4* y1 = (const u32x4*)(YS + (size_t)s1 * D) + lane;
#pragma unroll
                for (int j = 0; j < 2; ++j) { ya[r][j] = y0[64 * j]; yb[r][j] = y1[64 * j]; } } } }
#pragma unroll
        for (int r = 0; r < NR; ++r) { const int m = mb + r * NGW; if (m < T) {
        f32x4 v[4]; float s = 0.f;
#pragma unroll
        for (int j = 0; j < 4; ++j) v[j] = vv[r][j];
        if (combine) {
            const float g0 = g0v[r], g1 = g1v[r];
#pragma unroll
            for (int j = 0; j < 2; ++j) { const u32x4 a = ya[r][j], b = yb[r][j];
                v[2 * j].x += g0 * bflo(a.x) + g1 * bflo(b.x); v[2 * j].y += g0 * bfhi(a.x) + g1 * bfhi(b.x); v[2 * j].z += g0 * bflo(a.y) + g1 * bflo(b.y); v[2 * j].w += g0 * bfhi(a.y) + g1 * bfhi(b.y);
                v[2 * j + 1].x += g0 * bflo(a.z) + g1 * bflo(b.z); v[2 * j + 1].y += g0 * bfhi(a.z) + g1 * bfhi(b.z); v[2 * j + 1].z += g0 * bflo(a.w) + g1 * bflo(b.w); v[2 * j + 1].w += g0 * bfhi(a.w) + g1 * bfhi(b.w); }
        }
        if (combine || src) { u32x4* xo = (u32x4*)(XB + (size_t)m * D) + lane;
#pragma unroll
            for (int j = 0; j < 2; ++j) { u32x4 t; t.x = cvt_pk_bf16(v[2 * j].x, v[2 * j].y); t.y = cvt_pk_bf16(v[2 * j].z, v[2 * j].w); t.z = cvt_pk_bf16(v[2 * j + 1].x, v[2 * j + 1].y); t.w = cvt_pk_bf16(v[2 * j + 1].z, v[2 * j + 1].w); xo[64 * j] = t; } }
#pragma unroll
        for (int j = 0; j < 4; ++j) s += (v[j].x * v[j].x + v[j].y * v[j].y) + (v[j].z * v[j].z + v[j].w * v[j].w);
        const float rs = 1.0f / sqrtf(wave_sum(s, C.lane) * (1.f / D) + 1e-6f);
#pragma unroll
        for (int j = 0; j < 4; ++j) v[j] = v[j] * rs * g[j];
#pragma unroll
        for (int j = 0; j < 2; ++j) {
            if (want_bf16) { u32x4 t; t.x = cvt_pk_bf16(v[2 * j].x, v[2 * j].y); t.y = cvt_pk_bf16(v[2 * j].z, v[2 * j].w); t.z = cvt_pk_bf16(v[2 * j + 1].x, v[2 * j + 1].y); t.w = cvt_pk_bf16(v[2 * j + 1].z, v[2 * j + 1].w);
                ((u32x4*)(H + (size_t)m * D) + lane)[64 * j] = t; }
            u32x2 q; q.x = pk4_fp8(v[2 * j].x * F8_MUL_X, v[2 * j].y * F8_MUL_X, v[2 * j].z * F8_MUL_X, v[2 * j].w * F8_MUL_X); q.y = pk4_fp8(v[2 * j + 1].x * F8_MUL_X, v[2 * j + 1].y * F8_MUL_X, v[2 * j + 1].z * F8_MUL_X, v[2 * j + 1].w * F8_MUL_X);
            ((u32x2*)(C.ws + WS_H8 + (size_t)m * D) + lane)[64 * j] = q; }
        if (route) {
            float lg[8];
#pragma unroll
            for (int e = 0; e < 8; ++e) lg[e] = 0.f;
#pragma unroll
            for (int j = 0; j < 4; ++j)
#pragma unroll
                for (int q = 0; q < 4; ++q) { const int k = 8 * lane + 512 * (j >> 1) + 4 * (j & 1) + q; const f32x4 r0 = *(const f32x4*)(router + (size_t)k * 8), r1 = *(const f32x4*)(router + (size_t)k * 8 + 4); const float hv = v[j][q];
                    lg[0] += hv * r0.x; lg[1] += hv * r0.y; lg[2] += hv * r0.z; lg[3] += hv * r0.w; lg[4] += hv * r1.x; lg[5] += hv * r1.y; lg[6] += hv * r1.z; lg[7] += hv * r1.w; }
#pragma unroll
            for (int e = 0; e < 8; ++e) lg[e] = wave_sum(lg[e], C.lane);
            int e0 = 0; float b0 = lg[0];
#pragma unroll
            for (int e = 1; e < 8; ++e) if (lg[e] > b0) { b0 = lg[e]; e0 = e; }
            int e1 = -1; float b1 = -3.0e38f;
#pragma unroll
            for (int e = 0; e < 8; ++e) if (e != e0 && lg[e] > b1) { b1 = lg[e]; e1 = e; }
            const float p1 = __expf(b1 - b0), inv = 1.f / (1.f + p1);
            if (lane == 0) { eidx[2 * m] = e0; eidx[2 * m + 1] = e1; gate[2 * m] = inv; gate[2 * m + 1] = p1 * inv; atomicAdd((unsigned*)&lcnt[e0], 1u); atomicAdd((unsigned*)&lcnt[e1], 1u); }
        }
        } }
    }
    if (route) { __syncthreads(); if (C.tid < 8) { unsigned* cw = (unsigned*)(C.ws + WS_CTL) + CW_MOE + moe_idx * 64; atomicAdd(&cw[C.tid], lcnt[C.tid]); } }
}

__device__ __forceinline__ void ph_rw_prep_(const Ctx& C, int l) {
    const bf16* RW = (const bf16*)(C.ws + WS_RW); bf16* RKVS = (bf16*)(C.ws + WS_RKVS); bf16* AL = (bf16*)(C.ws + WS_ALORA);
    const float* mu = C.in[I_RW_MU] + (size_t)l * 1024;
    const size_t gid = (size_t)C.bid * NTHR + C.tid, gsz = (size_t)C.G * NTHR;
    constexpr int NI = 4;
    for (size_t it0 = gid; it0 < (size_t)T * 128; it0 += NI * gsz) {
        u32x4 cuv[NI], pvv[NI];
#pragma unroll
        for (int r = 0; r < NI; ++r) { const size_t it = it0 + r * gsz; cuv[r] = (u32x4){0u, 0u, 0u, 0u}; pvv[r] = cuv[r];
            if (it < (size_t)T * 128) { const int m = (int)(it >> 7), c8 = (int)(it & 127) * 8, t = m & (SEQ - 1);
                cuv[r] = *(const u32x4*)(RW + (size_t)m * 1024 + c8); if (t) pvv[r] = *(const u32x4*)(RW + (size_t)(m - 1) * 1024 + c8); } }
#pragma unroll
        for (int r = 0; r < NI; ++r) { const size_t it = it0 + r * gsz; if (it < (size_t)T * 128) {
        const int m = (int)(it >> 7), c8 = (int)(it & 127) * 8;
        float a[8], b[8]; unpack8(cuv[r], a); unpack8(pvv[r], b);
        const f32x4 m0 = *(const f32x4*)(mu + c8), m1 = *(const f32x4*)(mu + c8 + 4);
        const float mm[8] = {m0.x, m0.y, m0.z, m0.w, m1.x, m1.y, m1.z, m1.w};
#pragma unroll
        for (int e = 0; e < 8; ++e) a[e] = a[e] + (b[e] - a[e]) * mm[e];
        if (c8 < 768) { *(u32x4*)(RKVS + (size_t)m * 768 + c8) = pack8(a); }
        else {
            if (c8 < 832) {
#pragma unroll
                for (int e = 0; e < 8; ++e) a[e] = 1.f - 2.f * __builtin_amdgcn_rcpf(1.f + __builtin_amdgcn_exp2f(2.f * LOG2E * a[e]));
            } else if (c8 >= 896) {
#pragma unroll
                for (int e = 0; e < 8; ++e) a[e] = sigm(a[e]);
            }
            *(u32x4*)(AL + (size_t)m * 256 + (c8 - 768)) = pack8(a);
        } } }
    }
}

__device__ __forceinline__ void ph_sb_prep_(const Ctx& C, int l) {
    bf16* SB = (bf16*)(C.ws + WS_SB);
    const int gw = C.bid * NWAVES + C.wave, NGW = C.G * NWAVES, lane = C.lane;
    const bool isk = lane >= 32; const int d0 = (lane & 7) * 8;
    const float* gn = (isk ? C.in[I_SB_KN] : C.in[I_SB_QN]) + (size_t)l * 64 + d0;
    float gg[8];
#pragma unroll
    for (int e = 0; e < 8; ++e) gg[e] = gn[e] * (isk ? 1.f : 0.125f * LOG2E);
    constexpr int NR = 4;
    for (int mb = gw; mb < T; mb += NR * NGW) {
        u32x4 uu[NR];
#pragma unroll
        for (int r = 0; r < NR; ++r) { const int m = mb + r * NGW; uu[r] = (u32x4){0u, 0u, 0u, 0u}; if (m < T) uu[r] = *(const u32x4*)(SB + (size_t)m * 768 + lane * 8); }
#pragma unroll
        for (int r = 0; r < NR; ++r) { const int m = mb + r * NGW; if (m < T) {
            bf16* p = SB + (size_t)m * 768 + lane * 8;
            float a[8]; unpack8(uu[r], a);
            float ss = 0.f;
#pragma unroll
            for (int e = 0; e < 8; ++e) ss += a[e] * a[e];
            ss += shx(ss, 1, lane); ss += shx(ss, 2, lane); ss += shx(ss, 4, lane);
            const float rs = 1.0f / sqrtf(ss * (1.f / 64.f) + 1e-6f);
#pragma unroll
            for (int e = 0; e < 8; ++e) a[e] = a[e] * rs * gg[e];
            *(u32x4*)p = pack8(a); } }
    }
}

__device__ __forceinline__ void ph_conv_(const Ctx& C, int l) {
    const bf16* CV = (const bf16*)(C.ws + WS_CV); bf16* Y = (bf16*)(C.ws + WS_Y);
    LAS float* U = (LAS float*)(C.lds); LAS float* OC = (LAS float*)(C.lds + 65536);
    const int tid = C.tid, c = tid & 255, half = tid >> 8;
    const float* dw = C.in[I_CONV_DW] + (size_t)l * 31 * 256; const float db = C.in[I_CONV_B][l * 256 + c];
    float dwr[31];
#pragma unroll
    for (int j = 0; j < 31; ++j) dwr[j] = dw[j * 256 + c];
    const float* lnw = C.in[I_CONV_LNW] + (size_t)l * 256; const float* lnb = C.in[I_CONV_LNB] + (size_t)l * 256;
    for (int u = C.bid; u < T / 32; u += C.G) {
        const int m0 = u * 32, t0 = m0 & (SEQ - 1);
        for (int it = tid; it < 62 * 32; it += NTHR) {
            const int r = it >> 5, c8 = (it & 31) * 8, tt = t0 - 30 + r; float a[8], b[8];
            if (tt >= 0) { const size_t mm = (size_t)(m0 - 30 + r); unpack8(*(const u32x4*)(CV + mm * 512 + c8), a); unpack8(*(const u32x4*)(CV + mm * 512 + 256 + c8), b);
#pragma unroll
                for (int e = 0; e < 8; ++e) a[e] = a[e] * sigm(b[e]); }
            else {
#pragma unroll
                for (int e = 0; e < 8; ++e) a[e] = 0.f; }
#pragma unroll
            for (int e = 0; e < 8; ++e) U[r * 256 + c8 + e] = a[e];
        }
        __syncthreads();
        { float win[46];
#pragma unroll
          for (int i = 0; i < 46; ++i) win[i] = U[(half * 16 + i) * 256 + c];
#pragma unroll
          for (int tt = 0; tt < 16; ++tt) { float acc = db;
#pragma unroll
              for (int j = 0; j < 31; ++j) acc += dwr[j] * win[tt + j];
              OC[(half * 16 + tt) * 256 + c] = acc; } }
        __syncthreads();
#pragma unroll 1
        for (int q = 0; q < 4; ++q) { const int tl = C.wave * 4 + q; float v[4]; float s = 0.f;
#pragma unroll
            for (int i = 0; i < 4; ++i) { v[i] = OC[tl * 256 + C.lane + 64 * i]; s += v[i]; }
            const float mean = wave_sum(s, C.lane) * (1.f / 256.f); float s2 = 0.f;
#pragma unroll
            for (int i = 0; i < 4; ++i) { v[i] -= mean; s2 += v[i] * v[i]; }
            const float rstd = 1.0f / sqrtf(wave_sum(s2, C.lane) * (1.f / 256.f) + 1e-5f);
#pragma unroll
            for (int i = 0; i < 4; ++i) { const int cc = C.lane + 64 * i; const float y = v[i] * rstd * lnw[cc] + lnb[cc]; Y[(size_t)(m0 + tl) * 1024 + 768 + cc] = f2bf(y * sigm(y)); } }
        __syncthreads();
    }
}

__device__ __forceinline__ float ret_log2gamma(int h) { return log2f(1.0f - exp2f(-5.0f - (float)h)); }
__device__ __forceinline__ void ret_load_rot(const Ctx& C, const bf16* RET, int m0, int coff, float scale, LAS float* dst) {
    const int s = C.tid >> 3, d0 = (C.tid & 7) * 4;
    const float* cs = (const float*)(C.ws + WS_COS); const float* sn = (const float*)(C.ws + WS_SIN);
    const int pos = (m0 + s) & (SEQ - 1);
    const u32x2 a = *(const u32x2*)(RET + (size_t)(m0 + s) * 1024 + coff + d0), b = *(const u32x2*)(RET + (size_t)(m0 + s) * 1024 + coff + 32 + d0);
    const float x1[4] = {bflo(a.x), bfhi(a.x), bflo(a.y), bfhi(a.y)}, x2[4] = {bflo(b.x), bfhi(b.x), bflo(b.y), bfhi(b.y)};
    const f32x4 cv = *(const f32x4*)(cs + (size_t)pos * 32 + d0), sv = *(const f32x4*)(sn + (size_t)pos * 32 + d0);
#pragma unroll
    for (int e = 0; e < 4; ++e) { dst[s * 65 + d0 + e] = (x1[e] * cv[e] - x2[e] * sv[e]) * scale; dst[s * 65 + 32 + d0 + e] = (x1[e] * sv[e] + x2[e] * cv[e]) * scale; }
}
__device__ __forceinline__ void ph_ret_kv_(const Ctx& C) {
    const bf16* RET = (const bf16*)(C.ws + WS_RET); float* KV = (float*)(C.ws + WS_KV);
    LAS float* KD = (LAS float*)(C.lds); LAS float* VV = (LAS float*)(C.lds + 32768);
    const int tid = C.tid;
    for (int u = C.bid; u < 2048; u += C.G) {
        const int bh = u >> 8, ch = u & 255, b = bh >> 2, h = bh & 3, m0 = b * SEQ + ch * 64;
        const float lg = ret_log2gamma(h);
        ret_load_rot(C, RET, m0, 256 + h * 64, 0.125f, KD);
        { const int s = tid >> 3, e0 = (tid & 7) * 8; float a[8]; unpack8(*(const u32x4*)(RET + (size_t)(m0 + s) * 1024 + 512 + h * 64 + e0), a);
          const float dec = exp2f(lg * (float)(63 - s));
#pragma unroll
          for (int e = 0; e < 8; ++e) VV[s * 64 + e0 + e] = a[e] * dec; }
        __syncthreads();
        const int d = tid >> 3, e0 = (tid & 7) * 8; float acc[8];
#pragma unroll
        for (int e = 0; e < 8; ++e) acc[e] = 0.f;
#pragma unroll 4
        for (int s = 0; s < 64; ++s) { const float kd = KD[s * 65 + d]; const f32x4 v0 = *(const LAS f32x4*)(VV + s * 64 + e0), v1 = *(const LAS f32x4*)(VV + s * 64 + e0 + 4);
            acc[0] += kd * v0.x; acc[1] += kd * v0.y; acc[2] += kd * v0.z; acc[3] += kd * v0.w; acc[4] += kd * v1.x; acc[5] += kd * v1.y; acc[6] += kd * v1.z; acc[7] += kd * v1.w; }
        float* o = KV + (size_t)u * 4096 + d * 64 + e0;
        *(f32x4*)o = (f32x4){acc[0], acc[1], acc[2], acc[3]}; *(f32x4*)(o + 4) = (f32x4){acc[4], acc[5], acc[6], acc[7]};
        __syncthreads();
    }
}
__device__ __forceinline__ void ph_ret_scan_(const Ctx& C) {
    float* KV = (float*)(C.ws + WS_KV);
    const int wg0 = (C.G >= 256) ? 128 : 0, nw = C.G - wg0;
    for (int i = (C.bid - wg0) * NTHR + C.tid; i < 8 * 4096 && C.bid >= wg0; i += nw * NTHR) {
        const int bh = i >> 12, el = i & 4095, h = bh & 3;
        const float cd = exp2f(ret_log2gamma(h) * 64.f);
        float* p = KV + (size_t)bh * 256 * 4096 + el; float S = 0.f;
#pragma unroll 1
        for (int c = 0; c < 256; c += 32) { float kv[32];
#pragma unroll
            for (int q = 0; q < 32; ++q) kv[q] = p[(size_t)(c + q) * 4096];
#pragma unroll
            for (int q = 0; q < 32; ++q) { p[(size_t)(c + q) * 4096] = S; S = S * cd + kv[q]; } }
    }
}
__device__ __forceinline__ void ph_ret_out_(const Ctx& C, int l, int first_wg, int nwg) {
    const bf16* RET = (const bf16*)(C.ws + WS_RET); const float* KV = (const float*)(C.ws + WS_KV); bf16* Y = (bf16*)(C.ws + WS_Y);
    LAS float* Q = (LAS float*)(C.lds); LAS float* Kk = (LAS float*)(C.lds + 16640); LAS float* VV = (LAS float*)(C.lds + 33280); LAS float* SS = (LAS float*)(C.lds + 49664); LAS float* SC = (LAS float*)(C.lds + 66048);
    const int tid = C.tid; const float* gn = C.in[I_RET_GN] + (size_t)l * 256;
    for (int u = C.bid - first_wg; u < 2048; u += nwg) {
        const int bh = u >> 8, ch = u & 255, b = bh >> 2, h = bh & 3, m0 = b * SEQ + ch * 64;
        const float lg = ret_log2gamma(h);
        ret_load_rot(C, RET, m0, h * 64, 1.0f, Q);
        ret_load_rot(C, RET, m0, 256 + h * 64, 0.125f, Kk);
        { const int s = tid >> 3, e0 = (tid & 7) * 8; float a[8]; unpack8(*(const u32x4*)(RET + (size_t)(m0 + s) * 1024 + 512 + h * 64 + e0), a);
#pragma unroll
          for (int e = 0; e < 8; ++e) VV[s * 64 + e0 + e] = a[e];
          const float* sp = KV + (size_t)u * 4096 + s * 64 + e0; const f32x4 s0 = *(const f32x4*)sp, s1 = *(const f32x4*)(sp + 4);
          *(LAS f32x4*)(SS + s * 64 + e0) = s0; *(LAS f32x4*)(SS + s * 64 + e0 + 4) = s1; }
        __syncthreads();
        const int t = tid >> 3, g8 = tid & 7;
        { float sc[8];
#pragma unroll
          for (int i = 0; i < 8; ++i) sc[i] = 0.f;
#pragma unroll 4
          for (int d = 0; d < 64; ++d) { const float qv = Q[t * 65 + d];
#pragma unroll
              for (int i = 0; i < 8; ++i) sc[i] += qv * Kk[(g8 * 8 + i) * 65 + d]; }
#pragma unroll
          for (int i = 0; i < 8; ++i) { const int s = g8 * 8 + i; SC[t * 65 + s] = (s <= t) ? sc[i] * exp2f(lg * (float)(t - s)) : 0.f; } }
        __syncthreads();
        { const int e0 = g8 * 8; float o[8], o2[8];
#pragma unroll
          for (int e = 0; e < 8; ++e) { o[e] = 0.f; o2[e] = 0.f; }
#pragma unroll 4
          for (int s = 0; s < 64; ++s) { const float p = SC[t * 65 + s]; const f32x4 v0 = *(const LAS f32x4*)(VV + s * 64 + e0), v1 = *(const LAS f32x4*)(VV + s * 64 + e0 + 4);
              o[0] += p * v0.x; o[1] += p * v0.y; o[2] += p * v0.z; o[3] += p * v0.w; o[4] += p * v1.x; o[5] += p * v1.y; o[6] += p * v1.z; o[7] += p * v1.w; }
#pragma unroll 4
          for (int d = 0; d < 64; ++d) { const float qv = Q[t * 65 + d]; const f32x4 v0 = *(const LAS f32x4*)(SS + d * 64 + e0), v1 = *(const LAS f32x4*)(SS + d * 64 + e0 + 4);
              o2[0] += qv * v0.x; o2[1] += qv * v0.y; o2[2] += qv * v0.z; o2[3] += qv * v0.w; o2[4] += qv * v1.x; o2[5] += qv * v1.y; o2[6] += qv * v1.z; o2[7] += qv * v1.w; }
          const float qd = exp2f(lg * (float)(t + 1)); float s1 = 0.f;
#pragma unroll
          for (int e = 0; e < 8; ++e) { o[e] += qd * o2[e]; s1 += o[e]; }
          s1 += shx(s1, 1, C.lane); s1 += shx(s1, 2, C.lane); s1 += shx(s1, 4, C.lane);
          const float mean = s1 * (1.f / 64.f); float s2 = 0.f;
#pragma unroll
          for (int e = 0; e < 8; ++e) { o[e] -= mean; s2 += o[e] * o[e]; }
          s2 += shx(s2, 1, C.lane); s2 += shx(s2, 2, C.lane); s2 += shx(s2, 4, C.lane);
          const float rstd = 1.0f / sqrtf(s2 * (1.f / 64.f) + 1e-5f);
          float gtv[8]; unpack8(*(const u32x4*)(RET + (size_t)(m0 + t) * 1024 + 768 + h * 64 + e0), gtv);
#pragma unroll
          for (int e = 0; e < 8; ++e) o[e] = o[e] * rstd * gn[h * 64 + e0 + e] * (gtv[e] * sigm(gtv[e]));
          *(u32x4*)(Y + (size_t)(m0 + t) * 1024 + 512 + h * 64 + e0) = pack8(o); }
        __syncthreads();
    }
}

constexpr int RWC = 64, RW_NCH = SEQ / RWC, RW_NU = 8 * RW_NCH;
constexpr int RW_SUP = 8, RW_NSC = RW_NCH / RW_SUP, RW_NSUP = 8 * RW_NSC;
__device__ __forceinline__ void ph_rw_local_(const Ctx& C, int l) {
    const bf16* RKVS = (const bf16*)(C.ws + WS_RKVS); const float* WDEC = (const float*)(C.ws + WS_WDEC); const bf16* AG = (const bf16*)(C.ws + WS_AG);
    bf16* Y0 = (bf16*)(C.ws + WS_Y0); bf16* RH = (bf16*)(C.ws + WS_RHAT); float* PQ = (float*)(C.ws + WS_PQ); float* BON = (float*)(C.ws + WS_BON);
    const int lane = C.lane;
    LAS float* base = (LAS float*)(C.lds + C.wave * 12288);
    for (int it = C.bid; it < RW_NU / 8; it += C.G) {
        const int u = it * 8 + C.wave, bh = u >> 8, ch = u & 255, b = bh >> 2, h = bh & 3, m0 = b * SEQ + ch * RWC, hc = h * 64 + lane;
        const float kkw = C.in[I_RW_KK][l * 256 + hc], kaw = C.in[I_RW_KA][l * 256 + hc], rkw = C.in[I_RW_RK][l * 256 + hc], w0l = C.in[I_RW_W0][l * 256 + hc], a0l = C.in[I_RW_A0][l * 256 + hc];
        f32x2 sL[32], sI[32];
        { int ln = lane; asm volatile("" : "+v"(ln));
#pragma unroll
          for (int k = 0; k < 32; ++k) { sL[k] = (f32x2){0.f, 0.f}; sI[k].x = (2 * k == ln) ? 1.f : 0.f; sI[k].y = (2 * k + 1 == ln) ? 1.f : 0.f; } }
#pragma unroll 1
        for (int sb = 0; sb < RWC / 8; ++sb) {
            asm volatile("" ::: "memory");
#pragma unroll
            for (int i = 0; i < 8; ++i) { const size_t m = (size_t)(m0 + sb * 8 + i);
                const float r = bf2f(RKVS[m * 768 + hc]), k = bf2f(RKVS[m * 768 + 256 + hc]), v = bf2f(RKVS[m * 768 + 512 + hc]);
                const float w = __builtin_amdgcn_exp2f(-0.606531f * LOG2E * sigm(WDEC[m * 256 + hc] + w0l)), a = sigm(bf2f(AG[m * 512 + hc]) + a0l);
                const float kr = k * kkw; const float nn = sqrtf(wave_sum(kr * kr, C.lane)); const float kk = kr / fmaxf(nn, 1e-12f);
                const float kp = k * (1.f + (a - 1.f) * kaw);
                const float bon = wave_sum(r * kp * rkw, C.lane);
                if (lane == 0) BON[m * 4 + h] = bon;
                base[0 * 512 + i * 64 + lane] = w; base[1 * 512 + i * 64 + lane] = kk; base[2 * 512 + i * 64 + lane] = kk * a; base[3 * 512 + i * 64 + lane] = kp; base[4 * 512 + i * 64 + lane] = r; base[5 * 512 + i * 64 + lane] = v; }
            asm volatile("" ::: "memory");
#pragma unroll 1
            for (int i = 0; i < 8; ++i) {
                const LAS f32x4* wv = (const LAS f32x4*)(base + 0 * 512 + i * 64); const LAS f32x4* kkv = (const LAS f32x4*)(base + 1 * 512 + i * 64); const LAS f32x4* kav = (const LAS f32x4*)(base + 2 * 512 + i * 64);
                const LAS f32x4* kpv = (const LAS f32x4*)(base + 3 * 512 + i * 64); const LAS f32x4* rv = (const LAS f32x4*)(base + 4 * 512 + i * 64);
                const float vv = base[5 * 512 + i * 64 + lane];
                f32x4 kq[2][4];
#pragma unroll
                for (int t = 0; t < 4; ++t) kq[0][t] = kkv[t];
                f32x2 dL0 = (f32x2){0.f, 0.f}, dL1 = dL0, dI0 = dL0, dI1 = dL0;
                f32x4 ga[2][4];
#pragma unroll
                for (int g = 0; g < 4; ++g) {
                    __builtin_amdgcn_sched_barrier(0);
                    if (g + 1 < 4) {
#pragma unroll
                        for (int t = 0; t < 4; ++t) kq[(g + 1) & 1][t] = kkv[4 * (g + 1) + t]; }
                    else { ga[0][0] = wv[0]; ga[0][1] = kav[0]; ga[0][2] = kpv[0]; ga[0][3] = rv[0]; }
                    __builtin_amdgcn_sched_barrier(0);
#pragma unroll
                    for (int t = 0; t < 4; ++t) { const int k4 = 4 * g + t; const f32x4 q4 = kq[g & 1][t];
                        dL0 += sL[2 * k4] * q4.xy; dL1 += sL[2 * k4 + 1] * q4.zw; dI0 += sI[2 * k4] * q4.xy; dI1 += sI[2 * k4 + 1] * q4.zw; }
                }
                const float saL = -((dL0.x + dL0.y) + (dL1.x + dL1.y)), saI = -((dI0.x + dI0.y) + (dI1.x + dI1.y));
                const f32x2 saLv = (f32x2){saL, saL}, saIv = (f32x2){saI, saI}, vvv = (f32x2){vv, vv};
                f32x2 yL0 = (f32x2){0.f, 0.f}, yL1 = yL0, yI0 = yL0, yI1 = yL0;
#pragma unroll
                for (int k4 = 0; k4 < 16; ++k4) {
                    __builtin_amdgcn_sched_barrier(0);
                    if (k4 + 1 < 16) { ga[(k4 + 1) & 1][0] = wv[k4 + 1]; ga[(k4 + 1) & 1][1] = kav[k4 + 1]; ga[(k4 + 1) & 1][2] = kpv[k4 + 1]; ga[(k4 + 1) & 1][3] = rv[k4 + 1]; }
                    __builtin_amdgcn_sched_barrier(0);
                    const f32x4 wq = ga[k4 & 1][0], aq = ga[k4 & 1][1], pq = ga[k4 & 1][2], rq = ga[k4 & 1][3];
                    sL[2 * k4]     = sL[2 * k4]     * wq.xy + saLv * aq.xy + vvv * pq.xy; yL0 += sL[2 * k4]     * rq.xy;
                    sL[2 * k4 + 1] = sL[2 * k4 + 1] * wq.zw + saLv * aq.zw + vvv * pq.zw; yL1 += sL[2 * k4 + 1] * rq.zw;
                    sI[2 * k4]     = sI[2 * k4]     * wq.xy + saIv * aq.xy;                  yI0 += sI[2 * k4]     * rq.xy;
                    sI[2 * k4 + 1] = sI[2 * k4 + 1] * wq.zw + saIv * aq.zw;                  yI1 += sI[2 * k4 + 1] * rq.zw;
                }
                __builtin_amdgcn_sched_barrier(0);
                const size_t m = (size_t)(m0 + sb * 8 + i);
                Y0[m * 256 + hc] = f2bf((yL0.x + yL0.y) + (yL1.x + yL1.y));
                RH[m * 256 + hc] = f2bf((yI0.x + yI0.y) + (yI1.x + yI1.y));
            }
        }
        float* oq = PQ + (size_t)u * 4096 + lane * 64; float* opt = PQ + ((size_t)RW_NU + u) * 4096 + lane;
#pragma unroll
        for (int k4 = 0; k4 < 16; ++k4) { *(f32x4*)(oq + 4 * k4) = (f32x4){sL[2 * k4].x, sL[2 * k4].y, sL[2 * k4 + 1].x, sL[2 * k4 + 1].y};
            opt[(4 * k4) * 64] = sI[2 * k4].x; opt[(4 * k4 + 1) * 64] = sI[2 * k4].y; opt[(4 * k4 + 2) * 64] = sI[2 * k4 + 1].x; opt[(4 * k4 + 3) * 64] = sI[2 * k4 + 1].y; }
    }
}
constexpr int WY_LT = 24;
constexpr int WY_ROWM = 0, WY_COLM = 36864, WY_AMAT = 73728, WY_AABF = 89088, WY_SB = 93184, WY_WT = 111616, WY_UT = 117760, WY_GH = 123904, WY_GC = 125952;
__device__ __forceinline__ f32x4 wy_mm16(const LAS bf16* X, const LAS bf16* Y, f32x4 acc, int li, int lq) {
#pragma unroll
    for (int ks = 0; ks < 2; ++ks) { const bf16x8 a = *(const LAS bf16x8*)(X + li * MM_LP + 32 * ks + 8 * lq), b = *(const LAS bf16x8*)(Y + li * MM_LP + 32 * ks + 8 * lq);
        acc = __builtin_amdgcn_mfma_f32_16x16x32_bf16(a, b, acc, 0, 0, 0); }
    return acc;
}
__device__ __forceinline__ f32x4 wy_mm16k16(const LAS bf16* X, const LAS bf16* Y, f32x4 acc, int li, int lq) {
    const s16x4 a = *(const LAS s16x4*)(X + li * WY_LT + 4 * lq), b = *(const LAS s16x4*)(Y + li * WY_LT + 4 * lq);
    return __builtin_amdgcn_mfma_f32_16x16x16bf16_1k(a, b, acc, 0, 0, 0);
}
__device__ __forceinline__ void ph_rw_local_wy_(const Ctx& C, int l) {
    const bf16* RKVS = (const bf16*)(C.ws + WS_RKVS); const float* WDEC = (const float*)(C.ws + WS_WDEC); const bf16* AG = (const bf16*)(C.ws + WS_AG);
    bf16* Y0 = (bf16*)(C.ws + WS_Y0); bf16* RH = (bf16*)(C.ws + WS_RHAT); float* PQ = (float*)(C.ws + WS_PQ); float* BON = (float*)(C.ws + WS_BON);
    const int lane = C.lane, w = C.wave, li = lane & 15, lq = lane >> 4, j32 = lane & 31, hi = lane >> 5, ti = w >> 1, tj = w & 1, sq = w >> 1, half = w & 1;
    LAS unsigned char* L = C.lds;
#define WY_ROW(q, m) ((LAS bf16*)(L + WY_ROWM + (q) * 9216 + (m) * 2304))
#define WY_COL(q, m) ((LAS bf16*)(L + WY_COLM + (q) * 9216 + (m) * 3072))
#define WY_A(q, id)  ((LAS bf16*)(L + WY_AMAT + (q) * 3840 + (id) * 768))
    LAS bf16* SB = (LAS bf16*)(L + WY_SB); LAS bf16* WT = (LAS bf16*)(L + WY_WT); LAS bf16* UT = (LAS bf16*)(L + WY_UT);
    LAS float* GH = (LAS float*)(L + WY_GH); LAS float* GCs = (LAS float*)(L + WY_GC);
    for (int su = C.bid; su < RW_NSUP; su += C.G) {
    f32x16 S;
#pragma unroll 1
    for (int cc = 0; cc < RW_SUP; ++cc) {
        const int u = su * RW_SUP + cc;
        const int bh = u >> 8, ch = u & 255, b = bh >> 2, h = bh & 3, m0 = b * SEQ + ch * RWC, hc = h * 64 + lane;
        const float kkw = C.in[I_RW_KK][l * 256 + hc], kaw = C.in[I_RW_KA][l * 256 + hc], rkw = C.in[I_RW_RK][l * 256 + hc], w0l = C.in[I_RW_W0][l * 256 + hc], a0l = C.in[I_RW_A0][l * 256 + hc];
        { float wv[8], kk[8], ka[8], kp[8], rr[8], vv[8];
#pragma unroll
          for (int i = 0; i < 8; ++i) { const size_t m = (size_t)(m0 + 8 * w + i);
              const float r = bf2f(RKVS[m * 768 + hc]), k = bf2f(RKVS[m * 768 + 256 + hc]); vv[i] = bf2f(RKVS[m * 768 + 512 + hc]);
              wv[i] = __builtin_amdgcn_exp2f(-0.606531f * LOG2E * sigm(WDEC[m * 256 + hc] + w0l)); const float a = sigm(bf2f(AG[m * 512 + hc]) + a0l);
              const float kr = k * kkw; kk[i] = kr * __builtin_amdgcn_rsqf(fmaxf(wave_sum(kr * kr, lane), 1e-24f));
              kp[i] = k * (1.f + (a - 1.f) * kaw); ka[i] = kk[i] * a; rr[i] = r;
              const float bon = wave_sum(r * kp[i] * rkw, lane);
              if (lane == 0) BON[m * 4 + h] = bon; }
          float cp[8]; cp[0] = wv[0];
#pragma unroll
          for (int i = 1; i < 8; ++i) cp[i] = cp[i - 1] * wv[i];
          GH[w * 64 + lane] = cp[7];
          __syncthreads();
          const float pre = half ? GH[(w - 1) * 64 + lane] : 1.f, gC = half ? pre * cp[7] : cp[7] * GH[(w + 1) * 64 + lane];
          if (!half) GCs[sq * 64 + lane] = gC;
#pragma unroll
          for (int i = 0; i < 8; ++i) { const int t = 8 * half + i; const float G = pre * cp[i], Gm1 = (i == 0) ? pre : pre * cp[i - 1], rG = __builtin_amdgcn_rcpf(G);
              WY_ROW(sq, 0)[t * MM_LP + lane] = f2bf(-kk[i] * Gm1); WY_ROW(sq, 1)[t * MM_LP + lane] = f2bf(ka[i] * rG); WY_ROW(sq, 2)[t * MM_LP + lane] = f2bf(kp[i] * rG); WY_ROW(sq, 3)[t * MM_LP + lane] = f2bf(rr[i] * G);
              WY_COL(sq, 0)[lane * WY_LT + t] = f2bf(ka[i] * rG * gC); WY_COL(sq, 1)[lane * WY_LT + t] = f2bf(kp[i] * rG * gC); WY_COL(sq, 2)[lane * WY_LT + t] = f2bf(vv[i]); } }
        __syncthreads();
#pragma unroll
        for (int pp = 0; pp < 2; ++pp) { const int id = 2 * half + pp;
            f32x4 acc = (f32x4){0.f, 0.f, 0.f, 0.f};
            acc = wy_mm16(WY_ROW(sq, half ? 3 : 0), WY_ROW(sq, pp ? 2 : 1), acc, li, lq);
#pragma unroll
            for (int r = 0; r < 4; ++r) { const int t = 4 * lq + r; const bool keep = half ? (li <= t) : (li < t); const float val = keep ? acc[r] : 0.f;
                WY_A(sq, id)[t * WY_LT + li] = f2bf(val); if (id == 0) ((LAS float*)(L + WY_AABF + sq * 1024))[t * 16 + li] = val; } }
        __syncthreads();
        if (w < 4) { const LAS float* Af = (const LAS float*)(L + WY_AABF + w * 1024); float Tc[16];
#pragma unroll
            for (int t = 0; t < 16; ++t) { float acc = (t == li) ? 1.f : 0.f;
#pragma unroll
                for (int s4 = 0; s4 < 4; ++s4) { if (4 * s4 < t) { const f32x4 a4 = *(const LAS f32x4*)(Af + t * 16 + 4 * s4);
                    if (4 * s4 + 0 < t) acc += a4.x * Tc[4 * s4 + 0]; if (4 * s4 + 1 < t) acc += a4.y * Tc[4 * s4 + 1]; if (4 * s4 + 2 < t) acc += a4.z * Tc[4 * s4 + 2]; if (4 * s4 + 3 < t) acc += a4.w * Tc[4 * s4 + 3]; } }
                Tc[t] = acc; WY_A(w, 4)[t * WY_LT + li] = f2bf(acc); } }
        if (cc == 0) {
#pragma unroll
            for (int r = 0; r < 4; ++r)
#pragma unroll
                for (int e = 0; e < 4; ++e) { const int row = 32 * ti + 8 * r + 4 * hi + e, col = 32 * tj + j32; S[4 * r + e] = (ti >= 2 && row - 64 == col) ? 1.f : 0.f; }
#pragma unroll
            for (int r = 0; r < 4; ++r)
#pragma unroll
                for (int e = 0; e < 4; ++e) SB[(32 * ti + 8 * r + 4 * hi + e) * MM_LP + 32 * tj + j32] = f2bf(S[4 * r + e]);
        }
        __syncthreads();
#pragma unroll 1
        for (int q = 0; q < 4; ++q) {
            f32x4 accW = (f32x4){0.f, 0.f, 0.f, 0.f}, accY = accW;
            accW = wy_mm16(WY_ROW(q, 0), SB + 16 * w * MM_LP, accW, li, lq);
            accY = wy_mm16(WY_ROW(q, 3), SB + 16 * w * MM_LP, accY, li, lq);
            if (w < 4) accW = wy_mm16k16(WY_A(q, 1), WY_COL(q, 2) + 16 * w * WY_LT, accW, li, lq);
            { u32x2 pk; pk.x = cvt_pk_bf16(accW[0], accW[1]); pk.y = cvt_pk_bf16(accW[2], accW[3]); *(LAS u32x2*)(WT + (16 * w + li) * WY_LT + 4 * lq) = pk; }
            asm volatile("s_waitcnt lgkmcnt(0)" ::: "memory");
            { f32x4 accU = (f32x4){0.f, 0.f, 0.f, 0.f}; accU = wy_mm16k16(WY_A(q, 4), WT + 16 * w * WY_LT, accU, li, lq);
              u32x2 pk; pk.x = cvt_pk_bf16(accU[0], accU[1]); pk.y = cvt_pk_bf16(accU[2], accU[3]); *(LAS u32x2*)(UT + (16 * w + li) * WY_LT + 4 * lq) = pk; }
            asm volatile("s_waitcnt lgkmcnt(0)" ::: "memory");
            accY = wy_mm16k16(WY_A(q, 2), UT + 16 * w * WY_LT, accY, li, lq);
            if (w < 4) accY = wy_mm16k16(WY_A(q, 3), WY_COL(q, 2) + 16 * w * WY_LT, accY, li, lq);
            { bf16* dst = (w < 4) ? Y0 : RH; const int colo = h * 64 + ((16 * w) & 63) + li;
#pragma unroll
              for (int r = 0; r < 4; ++r) dst[(size_t)(m0 + 16 * q + 4 * lq + r) * 256 + colo] = f2bf(accY[r]); }
            __syncthreads();
            { const float gc = GCs[q * 64 + 32 * tj + j32];
#pragma unroll
              for (int i = 0; i < 16; ++i) S[i] *= gc;
              const bf16x8 ua = *(const LAS bf16x8*)(UT + (32 * ti + j32) * WY_LT + 8 * hi), bb = *(const LAS bf16x8*)(WY_COL(q, 0) + (32 * tj + j32) * WY_LT + 8 * hi);
              S = __builtin_amdgcn_mfma_f32_32x32x16_bf16(ua, bb, S, 0, 0, 0);
              if (ti < 2) { const bf16x8 va = *(const LAS bf16x8*)(WY_COL(q, 2) + (32 * ti + j32) * WY_LT + 8 * hi), kb = *(const LAS bf16x8*)(WY_COL(q, 1) + (32 * tj + j32) * WY_LT + 8 * hi);
                  S = __builtin_amdgcn_mfma_f32_32x32x16_bf16(va, kb, S, 0, 0, 0); } }
            {
#pragma unroll
                for (int r = 0; r < 4; ++r)
#pragma unroll
                    for (int e = 0; e < 4; ++e) SB[(32 * ti + 8 * r + 4 * hi + e) * MM_LP + 32 * tj + j32] = f2bf(S[4 * r + e]);
                __syncthreads(); }
        }
        if (cc == RW_SUP - 1) {
        if (ti < 2) { float* o = PQ + (size_t)su * 4096 + (size_t)(32 * ti + 4 * hi) * 64 + 32 * tj + j32;
#pragma unroll
            for (int r = 0; r < 4; ++r)
#pragma unroll
                for (int e = 0; e < 4; ++e) o[(8 * r + e) * 64] = S[4 * r + e]; }
        else { float* o = PQ + ((size_t)RW_NSUP + su) * 4096 + (size_t)(32 * tj + j32) * 64 + 32 * (ti - 2) + 4 * hi;
#pragma unroll
            for (int r = 0; r < 4; ++r) *(f32x4*)(o + 8 * r) = (f32x4){S[4 * r], S[4 * r + 1], S[4 * r + 2], S[4 * r + 3]}; }
        }
        __syncthreads();
    }
    }
#undef WY_ROW
#undef WY_COL
#undef WY_A
}
__device__ __forceinline__ void ph_rw_scan_(const Ctx& C, int wg) {
    const float* Qg = (const float*)(C.ws + WS_PQ); const float* Pg = Qg + (size_t)RW_NSUP * 4096; float* SST = (float*)(C.ws + WS_SST);
    LAS bf16* PT = (LAS bf16*)(C.lds);
    LAS bf16* SLb = PT + 2 * 64 * MM_LP;
    LAS float* QL = (LAS float*)(C.lds + (2 * 64 * MM_LP + 2 * 16 * MM_LP) * 2);
    LAS float* SO = QL + 2 * 16 * 64;
    const int lane = C.lane, wave = C.wave, bh = wg >> 2, rq = wg & 3, ct = wave & 3, li = lane & 15, lq = lane >> 4;
    const bool mm = wave < 4;
    const size_t ubase = (size_t)bh * RW_NSC;
    const int lt = C.tid & 255;
    const int qrow = lt >> 4, qc4 = (lt & 15) * 4;
    constexpr int PD = 6;
    f32x4 pr[PD][4], qr[PD];
#define SC_P_PIECE(i) (lt + 256 * (i))
#define SC_PUT_P(buf, sx_) do { LAS bf16* d_ = PT + (buf) * (64 * MM_LP); _Pragma("unroll") for (int i_ = 0; i_ < 4; ++i_) { const int idx_ = SC_P_PIECE(i_), r_ = (idx_ * 4) >> 6, k_ = (idx_ * 4) & 63; u32x2 w_; \
        w_.x = cvt_pk_bf16(pr[sx_][i_].x, pr[sx_][i_].y); w_.y = cvt_pk_bf16(pr[sx_][i_].z, pr[sx_][i_].w); *(LAS u32x2*)(d_ + r_ * MM_LP + k_) = w_; } } while (0)
#define SC_LOAD(sx_, cc) do { const f32x4* p4_ = (const f32x4*)(Pg + (ubase + (cc)) * 4096); _Pragma("unroll") for (int i_ = 0; i_ < 4; ++i_) pr[sx_][i_] = p4_[SC_P_PIECE(i_)]; \
        qr[sx_] = *(const f32x4*)(Qg + (ubase + (cc)) * 4096 + (rq * 16 + qrow) * 64 + qc4); } while (0)
    if (mm) {
#pragma unroll
        for (int r = 0; r < 4; ++r) SLb[(4 * lq + r) * MM_LP + ct * 16 + li] = (bf16)0;
    } else {
        { float z0; asm volatile("v_mov_b32 %0, 0" : "=v"(z0));
          *(f32x4*)(SST + ubase * 4096 + (rq * 16 + qrow) * 64 + qc4) = (f32x4){z0, z0, z0, z0}; }
        SC_LOAD(0, 0); SC_PUT_P(0, 0); *(LAS f32x4*)(QL + qrow * 64 + qc4) = qr[0];
#pragma unroll
        for (int x = 0; x < PD; ++x) SC_LOAD(x, 1 + x);
    }
    __syncthreads();
#pragma unroll 1
    for (int c2 = 0; c2 < RW_NSC; c2 += PD) {
#pragma unroll
        for (int x = 0; x < PD; ++x) {
            const int c = c2 + x;
            if (c < RW_NSC) {
            if (mm) {
                const LAS bf16* Pc = PT + (c & 1) * (64 * MM_LP); const LAS bf16* Sc = SLb + (c & 1) * (16 * MM_LP); const LAS float* Qc = QL + (c & 1) * (16 * 64);
                LAS bf16* Sn = SLb + ((c + 1) & 1) * (16 * MM_LP); LAS float* So = SO + ((c + 1) & 1) * (16 * 64);
                bf16x8 af[2], bfr[2];
#pragma unroll
                for (int ks = 0; ks < 2; ++ks) { af[ks] = *(const LAS bf16x8*)(Sc + li * MM_LP + 32 * ks + 8 * lq); bfr[ks] = *(const LAS bf16x8*)(Pc + (16 * ct + li) * MM_LP + 32 * ks + 8 * lq); }
                f32x4 acc;
#pragma unroll
                for (int r = 0; r < 4; ++r) acc[r] = Qc[(4 * lq + r) * 64 + ct * 16 + li];
#pragma unroll
                for (int ks = 0; ks < 2; ++ks) acc = __builtin_amdgcn_mfma_f32_16x16x32_bf16(af[ks], bfr[ks], acc, 0, 0, 0);
                if (c + 1 < RW_NSC) {
#pragma unroll
                    for (int r = 0; r < 4; ++r) { Sn[(4 * lq + r) * MM_LP + ct * 16 + li] = f2bf(acc[r]); So[(4 * lq + r) * 64 + ct * 16 + li] = acc[r]; } }
            } else {
                if (c > 0) *(f32x4*)(SST + (ubase + c) * 4096 + (rq * 16 + qrow) * 64 + qc4) = *(const LAS f32x4*)(SO + (c & 1) * (16 * 64) + qrow * 64 + qc4);
                if (c + 1 < RW_NSC) { SC_PUT_P((c + 1) & 1, x); *(LAS f32x4*)(QL + ((c + 1) & 1) * (16 * 64) + qrow * 64 + qc4) = qr[x]; }
                if (c + 1 + PD < RW_NSC) SC_LOAD(x, c + 1 + PD);
            }
            __syncthreads();
#ifdef SCAN_2BAR
            __syncthreads();
#endif
            }
        }
    }
#undef SC_PUT_P
#undef SC_LOAD
#undef SC_P_PIECE
}
__device__ __forceinline__ void ph_rw_out_(const Ctx& C, int l) {
    const bf16* RKVS = (const bf16*)(C.ws + WS_RKVS); const bf16* AG = (const bf16*)(C.ws + WS_AG); const bf16* Y0 = (const bf16*)(C.ws + WS_Y0); const bf16* RH = (const bf16*)(C.ws + WS_RHAT);
    const float* SST = (const float*)(C.ws + WS_SST); const float* BON = (const float*)(C.ws + WS_BON); bf16* Y = (bf16*)(C.ws + WS_Y);
    LAS float* RL = (LAS float*)(C.lds);
    const int lane = C.lane, wave = C.wave;
    for (int u = C.bid; u < RW_NU; u += C.G) {
        const int bh = u >> 8, ch = u & 255, b = bh >> 2, h = bh & 3, m0 = b * SEQ + ch * RWC, hc = h * 64 + lane;
        { const int t = C.tid >> 3, d0 = (C.tid & 7) * 8; float a[8];
          unpack8(*(const u32x4*)(RH + (size_t)(m0 + t) * 256 + h * 64 + d0), a);
#pragma unroll
          for (int e = 0; e < 8; ++e) RL[t * 64 + d0 + e] = a[e]; }
        float s[64];
        { const f32x4* sp = (const f32x4*)(SST + (size_t)u * 4096 + lane * 64);
#pragma unroll
          for (int k4 = 0; k4 < 16; ++k4) { const f32x4 v = sp[k4]; s[4 * k4] = v.x; s[4 * k4 + 1] = v.y; s[4 * k4 + 2] = v.z; s[4 * k4 + 3] = v.w; } }
        const float lnw = C.in[I_RW_LNW][l * 256 + hc], lnb = C.in[I_RW_LNB][l * 256 + hc];
        __syncthreads();
#pragma unroll 2
        for (int q = 0; q < 8; ++q) { const int t = wave * 8 + q; const size_t m = (size_t)(m0 + t);
            const LAS f32x4* rv = (const LAS f32x4*)(RL + t * 64);
            float y0 = 0.f, y1 = 0.f, y2 = 0.f, y3 = 0.f;
#pragma unroll
            for (int k4 = 0; k4 < 16; ++k4) { const f32x4 rq = rv[k4]; y0 += s[4 * k4] * rq.x; y1 += s[4 * k4 + 1] * rq.y; y2 += s[4 * k4 + 2] * rq.z; y3 += s[4 * k4 + 3] * rq.w; }
#ifndef RWDBG
#define RWDBG 0
#endif
            float y = ((RWDBG & 1) ? 0.f : (y0 + y1) + (y2 + y3)) + ((RWDBG & 2) ? 0.f : bf2f(Y0[m * 256 + hc]));
            const float mean = wave_sum(y, C.lane) * (1.f / 64.f); y -= mean;
            const float rstd = 1.0f / sqrtf(wave_sum(y * y, C.lane) * (1.f / 64.f) + 64e-5f);
            y = y * rstd * lnw + lnb;
            if (!(RWDBG & 4)) y += BON[m * 4 + h] * bf2f(RKVS[m * 768 + 512 + hc]);
            y *= bf2f(AG[m * 512 + 256 + hc]);
            if (RWDBG & 120) { y = 0.f; if (RWDBG & 8) y += ((const float*)(C.ws + WS_WDEC))[m * 256 + hc]; if (RWDBG & 16) y += bf2f(AG[m * 512 + hc]);
                if (RWDBG & 32) y += bf2f(RKVS[m * 768 + hc]) + bf2f(RKVS[m * 768 + 256 + hc]) + bf2f(RKVS[m * 768 + 512 + hc]); if (RWDBG & 64) y += BON[m * 4 + h]; }
            Y[m * 1024 + hc] = f2bf(y); }
        __syncthreads();
    }
}

constexpr int SB_VLD = 40;
__device__ __forceinline__ void ph_sb_attn_(const Ctx& C, int first_wg, int nwg, unsigned* qhead = nullptr) {
    const bf16* SB = (const bf16*)(C.ws + WS_SB); bf16* Y = (bf16*)(C.ws + WS_Y);
    const int lane = C.lane, j = lane & 31, hi = lane >> 5;
    LAS bf16* VT = (LAS bf16*)(C.lds + C.wave * (64 * SB_VLD * 2));
    for (int it = qhead ? q_next(C, qhead) : C.bid - first_wg; it < 512; it = qhead ? q_next(C, qhead) : it + nwg) {
        const int bh = it >> 6, b = bh >> 2, h = bh & 3, t0 = (it & 63) * 256 + C.wave * 32; const size_t mb = (size_t)b * SEQ;
        bf16x8 qf[4];
#pragma unroll
        for (int ks = 0; ks < 4; ++ks) qf[ks] = *(const bf16x8*)(SB + (mb + t0 + j) * 768 + h * 64 + 16 * ks + 8 * hi);
        f32x16 o0, o1;
#pragma unroll
        for (int i = 0; i < 16; ++i) { o0[i] = 0.f; o1[i] = 0.f; }
        float acc = 0.f;
#pragma unroll 1
        for (int kt = t0; kt >= 0; kt -= 32) {
            bf16x8 kf[4];
#pragma unroll
            for (int ks = 0; ks < 4; ++ks) kf[ks] = *(const bf16x8*)(SB + (mb + kt + j) * 768 + 256 + h * 64 + 16 * ks + 8 * hi);
            u32x4 vv[4];
#pragma unroll
            for (int i = 0; i < 4; ++i) { const int c = lane + 64 * i; vv[i] = *(const u32x4*)(SB + (mb + kt + (c >> 3)) * 768 + 512 + h * 64 + (c & 7) * 8); }
            f32x16 sc;
#pragma unroll
            for (int i = 0; i < 16; ++i) sc[i] = 0.f;
#pragma unroll
            for (int ks = 0; ks < 4; ++ks) sc = __builtin_amdgcn_mfma_f32_32x32x16_bf16(kf[ks], qf[ks], sc, 0, 0, 0);
#pragma unroll
            for (int i = 0; i < 4; ++i) { const int c = lane + 64 * i, key = c >> 3, d8 = (c & 7) * 8; const unsigned w[4] = {vv[i].x, vv[i].y, vv[i].z, vv[i].w};
#pragma unroll
                for (int e = 0; e < 4; ++e) { VT[(d8 + 2 * e) * SB_VLD + key] = (bf16)(w[e] & 0xffffu); VT[(d8 + 2 * e + 1) * SB_VLD + key] = (bf16)(w[e] >> 16); } }
            const bool diag = (kt == t0);
            float ls[16], g[4], og[4];
#pragma unroll
            for (int r = 0; r < 4; ++r) { g[r] = 0.f;
#pragma unroll
                for (int e = 0; e < 4; ++e) { const float z = sc[4 * r + e]; const bool valid = !diag || (8 * r + 4 * hi + e) < j;
                    const float l = (z > 40.f) ? -z : -__builtin_amdgcn_logf(1.f + __builtin_amdgcn_exp2f(z));
                    ls[4 * r + e] = valid ? l : 0.f; g[r] += ls[4 * r + e]; } }
#pragma unroll
            for (int r = 0; r < 4; ++r) og[r] = shx(g[r], 32, lane);
            float pw[16]; float run = acc;
#pragma unroll
            for (int r = 3; r >= 0; --r) { float cum = run + (hi == 0 ? og[r] : 0.f);
#pragma unroll
                for (int e = 3; e >= 0; --e) { cum += ls[4 * r + e]; const bool valid = !diag || (8 * r + 4 * hi + e) < j;
                    pw[4 * r + e] = valid ? __builtin_amdgcn_exp2f(sc[4 * r + e] + cum) : 0.f; }
                run += g[r] + og[r]; }
            acc = run;
            asm volatile("" ::: "memory");
#pragma unroll
            for (int ks = 0; ks < 2; ++ks) {
                u32x4 pk; pk.x = cvt_pk_bf16(pw[8 * ks], pw[8 * ks + 1]); pk.y = cvt_pk_bf16(pw[8 * ks + 2], pw[8 * ks + 3]); pk.z = cvt_pk_bf16(pw[8 * ks + 4], pw[8 * ks + 5]); pk.w = cvt_pk_bf16(pw[8 * ks + 6], pw[8 * ks + 7]);
                const bf16x8 pb = __builtin_bit_cast(bf16x8, pk);
                const s16x4 a0l = *(const LAS s16x4*)(VT + j * SB_VLD + 16 * ks + 4 * hi), a0h = *(const LAS s16x4*)(VT + j * SB_VLD + 16 * ks + 8 + 4 * hi);
                const s16x4 a1l = *(const LAS s16x4*)(VT + (32 + j) * SB_VLD + 16 * ks + 4 * hi), a1h = *(const LAS s16x4*)(VT + (32 + j) * SB_VLD + 16 * ks + 8 + 4 * hi);
                const bf16x8 va0 = __builtin_shufflevector(a0l, a0h, 0, 1, 2, 3, 4, 5, 6, 7), va1 = __builtin_shufflevector(a1l, a1h, 0, 1, 2, 3, 4, 5, 6, 7);
                o0 = __builtin_amdgcn_mfma_f32_32x32x16_bf16(va0, pb, o0, 0, 0, 0);
                o1 = __builtin_amdgcn_mfma_f32_32x32x16_bf16(va1, pb, o1, 0, 0, 0);
            }
            asm volatile("" ::: "memory");
            if (__builtin_amdgcn_ballot_w64(acc > -140.f) == 0ull) break;
        }
        bf16* yp = Y + (mb + t0 + j) * 1024 + 256 + h * 64 + 4 * hi;
#pragma unroll
        for (int r = 0; r < 4; ++r) { u32x2 w0, w1; w0.x = cvt_pk_bf16(o0[4 * r], o0[4 * r + 1]); w0.y = cvt_pk_bf16(o0[4 * r + 2], o0[4 * r + 3]); w1.x = cvt_pk_bf16(o1[4 * r], o1[4 * r + 1]); w1.y = cvt_pk_bf16(o1[4 * r + 2], o1[4 * r + 3]);
            *(u32x2*)(yp + 8 * r) = w0; *(u32x2*)(yp + 32 + 8 * r) = w1; }
    }
}


__device__ __forceinline__ f32x16 mm_tile(const LAS bf16* X, const LAS bf16* Y, int ti, int tj, int lane) {
    const int j = lane & 31, hi = lane >> 5; f32x16 acc;
#pragma unroll
    for (int i = 0; i < 16; ++i) acc[i] = 0.f;
#pragma unroll
    for (int ks = 0; ks < 4; ++ks) { const bf16x8 a = *(const LAS bf16x8*)(X + (32 * ti + j) * MM_LP + 16 * ks + 8 * hi), b = *(const LAS bf16x8*)(Y + (32 * tj + j) * MM_LP + 16 * ks + 8 * hi);
        acc = __builtin_amdgcn_mfma_f32_32x32x16_bf16(a, b, acc, 0, 0, 0); }
    return acc;
}
__device__ __forceinline__ void ln_pair_stats(const f32x16& x, LAS float* XCH, int tr, int tt, int lane, float eps, float& mean, float& rstd) {
    const int j = lane & 31, hi = lane >> 5; float s1 = 0.f, s2 = 0.f;
#pragma unroll
    for (int i = 0; i < 16; ++i) { s1 += x[i]; s2 += x[i] * x[i]; }
    s1 += shx(s1, 32, lane); s2 += shx(s2, 32, lane);
    if (hi == 0) { XCH[(tr * 64 + 32 * tt + j) * 2] = s1; XCH[(tr * 64 + 32 * tt + j) * 2 + 1] = s2; }
    __syncthreads();
    const float a1 = XCH[(32 * tt + j) * 2] + XCH[(64 + 32 * tt + j) * 2], a2 = XCH[(32 * tt + j) * 2 + 1] + XCH[(64 + 32 * tt + j) * 2 + 1];
    mean = a1 * (1.f / 64.f); const float var = fmaxf(a2 * (1.f / 64.f) - mean * mean, 0.f); rstd = 1.0f / sqrtf(var + eps);
}
__device__ __forceinline__ void rot_store(const Ctx& C, const bf16* src  , int pos, int d0, float scale, LAS bf16* dstrow) {
    const float* cs = (const float*)(C.ws + WS_COS) + (size_t)pos * 32 + d0; const float* sn = (const float*)(C.ws + WS_SIN) + (size_t)pos * 32 + d0;
    float x1[8], x2[8]; unpack8(*(const u32x4*)(src + d0), x1); unpack8(*(const u32x4*)(src + 32 + d0), x2);
    const f32x4 c0 = *(const f32x4*)cs, c1 = *(const f32x4*)(cs + 4), s0 = *(const f32x4*)sn, s1 = *(const f32x4*)(sn + 4);
    const float cc[8] = {c0.x, c0.y, c0.z, c0.w, c1.x, c1.y, c1.z, c1.w}, ss[8] = {s0.x, s0.y, s0.z, s0.w, s1.x, s1.y, s1.z, s1.w};
    float o1[8], o2[8];
#pragma unroll
    for (int e = 0; e < 8; ++e) { o1[e] = (x1[e] * cc[e] - x2[e] * ss[e]) * scale; o2[e] = (x1[e] * ss[e] + x2[e] * cc[e]) * scale; }
    *(LAS u32x4*)(dstrow + d0) = pack8(o1); *(LAS u32x4*)(dstrow + 32 + d0) = pack8(o2);
}

__device__ __forceinline__ void ph_ret_kv2_(const Ctx& C) {
    const bf16* RET = (const bf16*)(C.ws + WS_RET); float* KV = (float*)(C.ws + WS_KV);
    const int half = C.wave >> 2, w4 = C.wave & 3, th = C.tid & 255, lane = C.lane;
    LAS bf16* KT = (LAS bf16*)(C.lds + half * 36864);
    LAS bf16* VT = KT + 64 * MM_LP;
    LAS bf16* KR = VT + 64 * MM_LP;
    for (int it = C.bid; it < 1024; it += C.G) {
        const int u = it * 2 + half, bh = u >> 8, ch = u & 255, b = bh >> 2, h = bh & 3, m0 = b * SEQ + ch * 64;
        const float lg = ret_log2gamma(h);
        { const int srow = th >> 2, dq = th & 3; const size_t m = (size_t)(m0 + srow);
          rot_store(C, RET + m * 1024 + 256 + h * 64, (int)(m & (SEQ - 1)), dq * 8, 0.125f * exp2f(lg * (float)(63 - srow)), KR + srow * MM_LP);
          float a[8];
#pragma unroll
          for (int q = 0; q < 2; ++q) { const int e0 = dq * 16 + q * 8; unpack8(*(const u32x4*)(RET + m * 1024 + 512 + h * 64 + e0), a);
#pragma unroll
              for (int e = 0; e < 8; ++e) VT[(e0 + e) * MM_LP + srow] = f2bf(a[e]); } }
        __syncthreads();
        { const int d = th >> 2, s0 = (th & 3) * 16;
#pragma unroll
          for (int i = 0; i < 16; ++i) KT[d * MM_LP + s0 + i] = KR[(s0 + i) * MM_LP + d]; }
        __syncthreads();
        { const int ti = w4 >> 1, tj = w4 & 1, j = lane & 31, hi = lane >> 5;
          const f32x16 acc = mm_tile(VT, KT, ti, tj, lane);
          float* o = KV + (size_t)u * 4096 + (size_t)(32 * ti + 4 * hi) * 64 + 32 * tj + j;
#pragma unroll
          for (int r = 0; r < 4; ++r)
#pragma unroll
              for (int e = 0; e < 4; ++e) o[(8 * r + e) * 64] = acc[4 * r + e]; }
        __syncthreads();
    }
}
__device__ __forceinline__ void ph_ret_out2_(const Ctx& C, int l, int first_wg, int nwg, unsigned* qhead = nullptr) {
    const bf16* RET = (const bf16*)(C.ws + WS_RET); const float* KV = (const float*)(C.ws + WS_KV); bf16* Y = (bf16*)(C.ws + WS_Y);
    const int half = C.wave >> 2, w4 = C.wave & 3, th = C.tid & 255, lane = C.lane, j = lane & 31, hi = lane >> 5, te = w4 >> 1, tt = w4 & 1;
    LAS bf16* QL = (LAS bf16*)(C.lds + half * 40960);
    LAS bf16* KL = QL + 64 * MM_LP;
    LAS bf16* VT = KL + 64 * MM_LP;
    LAS bf16* ST = VT + 64 * MM_LP;
    LAS float* XCH = (LAS float*)(C.lds + half * 40960 + 4 * 64 * MM_LP * 2);
    const float* gn = C.in[I_RET_GN] + (size_t)l * 256;
    for (int it = qhead ? q_next(C, qhead) : C.bid - first_wg; it < 1024; it = qhead ? q_next(C, qhead) : it + nwg) {
        const int u = it * 2 + half, bh = u >> 8, ch = u & 255, b = bh >> 2, h = bh & 3, m0 = b * SEQ + ch * 64;
        const float lg = ret_log2gamma(h);
        { const int srow = th >> 2, dq = th & 3; const size_t m = (size_t)(m0 + srow); const int pos = (int)(m & (SEQ - 1));
          rot_store(C, RET + m * 1024 + h * 64, pos, dq * 8, 1.0f, QL + srow * MM_LP);
          rot_store(C, RET + m * 1024 + 256 + h * 64, pos, dq * 8, 0.125f, KL + srow * MM_LP);
          float a[8];
#pragma unroll
          for (int q = 0; q < 2; ++q) { const int e0 = dq * 16 + q * 8; unpack8(*(const u32x4*)(RET + m * 1024 + 512 + h * 64 + e0), a);
#pragma unroll
              for (int e = 0; e < 8; ++e) VT[(e0 + e) * MM_LP + srow] = f2bf(a[e]); }
          const float* sp = KV + (size_t)u * 4096 + srow * 64 + dq * 16;
          float sv[16];
#pragma unroll
          for (int q = 0; q < 4; ++q) { const f32x4 v4 = *(const f32x4*)(sp + 4 * q); sv[4 * q] = v4.x; sv[4 * q + 1] = v4.y; sv[4 * q + 2] = v4.z; sv[4 * q + 3] = v4.w; }
          *(LAS u32x4*)(ST + srow * MM_LP + dq * 16) = pack8(sv); *(LAS u32x4*)(ST + srow * MM_LP + dq * 16 + 8) = pack8(sv + 8); }
        __syncthreads();
        f32x16 acc = mm_tile(ST, QL, te, tt, lane);
        { const float qd = exp2f(lg * (float)(32 * tt + j + 1));
#pragma unroll
          for (int i = 0; i < 16; ++i) acc[i] *= qd; }
#pragma unroll
        for (int st = 0; st < 2; ++st) {
            if (st > tt) continue;
            const f32x16 sc = mm_tile(KL, QL, st, tt, lane);
            float pw[16];
#pragma unroll
            for (int r = 0; r < 4; ++r)
#pragma unroll
                for (int e = 0; e < 4; ++e) { const int sk = 32 * st + 8 * r + 4 * hi + e, tq = 32 * tt + j;
                    pw[4 * r + e] = (sk <= tq) ? sc[4 * r + e] * exp2f(lg * (float)(tq - sk)) : 0.f; }
#pragma unroll
            for (int ks = 0; ks < 2; ++ks) {
                u32x4 pk; pk.x = cvt_pk_bf16(pw[8 * ks], pw[8 * ks + 1]); pk.y = cvt_pk_bf16(pw[8 * ks + 2], pw[8 * ks + 3]); pk.z = cvt_pk_bf16(pw[8 * ks + 4], pw[8 * ks + 5]); pk.w = cvt_pk_bf16(pw[8 * ks + 6], pw[8 * ks + 7]);
                const bf16x8 pb = __builtin_bit_cast(bf16x8, pk);
                const LAS bf16* vr = VT + (32 * te + j) * MM_LP + 32 * st + 16 * ks + 4 * hi;
                const s16x4 al = *(const LAS s16x4*)vr, ah = *(const LAS s16x4*)(vr + 8);
                const bf16x8 va = __builtin_shufflevector(al, ah, 0, 1, 2, 3, 4, 5, 6, 7);
                acc = __builtin_amdgcn_mfma_f32_32x32x16_bf16(va, pb, acc, 0, 0, 0);
            }
        }
        float mean, rstd; ln_pair_stats(acc, XCH, te, tt, lane, 1e-5f, mean, rstd);
        { const size_t m = (size_t)(m0 + 32 * tt + j); const bf16* gp = RET + m * 1024 + 768 + h * 64 + 32 * te + 4 * hi; bf16* yp = Y + m * 1024 + 512 + h * 64 + 32 * te + 4 * hi;
          const float* gw = gn + h * 64 + 32 * te + 4 * hi;
#pragma unroll
          for (int r = 0; r < 4; ++r) { const u32x2 gt2 = *(const u32x2*)(gp + 8 * r); const float gtv[4] = {bflo(gt2.x), bfhi(gt2.x), bflo(gt2.y), bfhi(gt2.y)}; const f32x4 gwv = *(const f32x4*)(gw + 8 * r);
              float o[4];
#pragma unroll
              for (int e = 0; e < 4; ++e) o[e] = (acc[4 * r + e] - mean) * rstd * gwv[e] * (gtv[e] * sigm(gtv[e]));
              u32x2 w; w.x = cvt_pk_bf16(o[0], o[1]); w.y = cvt_pk_bf16(o[2], o[3]); *(u32x2*)(yp + 8 * r) = w; } }
        __syncthreads();
    }
}
__device__ __forceinline__ void ph_rw_out2_(const Ctx& C, int l) {
    const bf16* RKVS = (const bf16*)(C.ws + WS_RKVS); const bf16* AG = (const bf16*)(C.ws + WS_AG); const bf16* Y0 = (const bf16*)(C.ws + WS_Y0); const bf16* RH = (const bf16*)(C.ws + WS_RHAT);
    const float* SST = (const float*)(C.ws + WS_SST); const float* BON = (const float*)(C.ws + WS_BON); bf16* Y = (bf16*)(C.ws + WS_Y);
    const int half = C.wave >> 2, w4 = C.wave & 3, th = C.tid & 255, lane = C.lane, j = lane & 31, hi = lane >> 5, tv = w4 >> 1, tt = w4 & 1;
    LAS bf16* SL = (LAS bf16*)(C.lds + half * 20480);
    LAS bf16* RL = SL + 64 * MM_LP;
    LAS float* XCH = (LAS float*)(C.lds + half * 20480 + 2 * 64 * MM_LP * 2);
    for (int it = C.bid; it < RW_NU / 2; it += C.G) {
        const int u = it * 2 + half, bh = u >> 8, ch = u & 255, b = bh >> 2, h = bh & 3, m0 = b * SEQ + ch * RWC;
        { const int row = th >> 2, q4 = th & 3;
          const float* sp = SST + (size_t)(u >> 3) * 4096 + row * 64 + q4 * 16; float sv[16];
#pragma unroll
          for (int q = 0; q < 4; ++q) { const f32x4 v4 = *(const f32x4*)(sp + 4 * q); sv[4 * q] = v4.x; sv[4 * q + 1] = v4.y; sv[4 * q + 2] = v4.z; sv[4 * q + 3] = v4.w; }
          *(LAS u32x4*)(SL + row * MM_LP + q4 * 16) = pack8(sv); *(LAS u32x4*)(SL + row * MM_LP + q4 * 16 + 8) = pack8(sv + 8);
          const u32x4* rp = (const u32x4*)(RH + (size_t)(m0 + row) * 256 + h * 64 + q4 * 16);
          *(LAS u32x4*)(RL + row * MM_LP + q4 * 16) = rp[0]; *(LAS u32x4*)(RL + row * MM_LP + q4 * 16 + 8) = rp[1]; }
        __syncthreads();
        f32x16 acc = mm_tile(SL, RL, tv, tt, lane);
        const size_t m = (size_t)(m0 + 32 * tt + j); const int vb = h * 64 + 32 * tv + 4 * hi;
#pragma unroll
        for (int r = 0; r < 4; ++r) { const u32x2 y2 = *(const u32x2*)(Y0 + m * 256 + vb + 8 * r); acc[4 * r] += bflo(y2.x); acc[4 * r + 1] += bfhi(y2.x); acc[4 * r + 2] += bflo(y2.y); acc[4 * r + 3] += bfhi(y2.y); }
        float mean, rstd; ln_pair_stats(acc, XCH, tv, tt, lane, 64e-5f, mean, rstd);
        const float bon = BON[m * 4 + h];
#pragma unroll
        for (int r = 0; r < 4; ++r) { const int vc = vb + 8 * r;
            const f32x4 lw = *(const f32x4*)(C.in[I_RW_LNW] + (size_t)l * 256 + vc), lb = *(const f32x4*)(C.in[I_RW_LNB] + (size_t)l * 256 + vc);
            const u32x2 v2 = *(const u32x2*)(RKVS + m * 768 + 512 + vc), g2 = *(const u32x2*)(AG + m * 512 + 256 + vc);
            const float vv[4] = {bflo(v2.x), bfhi(v2.x), bflo(v2.y), bfhi(v2.y)}, gg[4] = {bflo(g2.x), bfhi(g2.x), bflo(g2.y), bfhi(g2.y)};
            float o[4];
#pragma unroll
            for (int e = 0; e < 4; ++e) o[e] = ((acc[4 * r + e] - mean) * rstd * lw[e] + lb[e] + bon * vv[e]) * gg[e];
            u32x2 w; w.x = cvt_pk_bf16(o[0], o[1]); w.y = cvt_pk_bf16(o[2], o[3]); *(u32x2*)(Y + m * 1024 + vc) = w; }
        __syncthreads();
    }
}

__device__ __forceinline__ void ph_moe_scatter_(const Ctx& C, int moe_idx) {
    unsigned* cw = (unsigned*)(C.ws + WS_CTL) + CW_MOE + moe_idx * 64;
    const int* eidx = (const int*)(C.ws + WS_EIDX); const float* gate = (const float*)(C.ws + WS_GATE);
    int* rowtok = (int*)(C.ws + WS_ROWTOK); float* rowgate = (float*)(C.ws + WS_ROWGATE); int* texp = (int*)(C.ws + WS_TEXP); int* segend = (int*)(C.ws + WS_SEGEND); int* ntp = (int*)(C.ws + WS_NT);
    bf16* XS = (bf16*)(C.ws + WS_XS);
    LAS unsigned* lcnt = (LAS unsigned*)(C.lds); LAS unsigned* lbase = lcnt + 8; LAS int* sl = (LAS int*)(C.lds + 256);
    int cnt[8], segb[8]; int tot = 0;
#pragma unroll
    for (int e = 0; e < 8; ++e) { cnt[e] = (int)__hip_atomic_load(&cw[e], __ATOMIC_RELAXED, __HIP_MEMORY_SCOPE_AGENT); segb[e] = tot; tot += (cnt[e] + 255) & ~255; }
    if (C.bid == 0) {
        if (C.tid < 8) { const int e = C.tid; int sb = 0, ce = 0;
#pragma unroll
            for (int q = 0; q < 8; ++q) if (q == e) { sb = segb[q]; ce = cnt[q]; }
            for (int pm = sb >> 8; pm < ((sb + ((ce + 255) & ~255)) >> 8); ++pm) { texp[pm] = e; segend[pm] = sb + ce; } }
        if (C.tid == 0) *ntp = tot >> 8;
    }
    for (int blk = C.bid; blk < T / 256; blk += C.G) {
        __syncthreads();
        if (C.tid < 8) lcnt[C.tid] = 0u;
        __syncthreads();
        const int a = blk * 512 + C.tid, e = eidx[a];
        const unsigned rank = atomicAdd((unsigned*)&lcnt[e], 1u);
        __syncthreads();
        if (C.tid < 8) lbase[C.tid] = atomicAdd(&cw[16 + C.tid], lcnt[C.tid]);
        __syncthreads();
        int sb = 0;
#pragma unroll
        for (int q = 0; q < 8; ++q) if (q == e) sb = segb[q];
        const int slot = sb + (int)lbase[e] + (int)rank;
        rowtok[slot] = a >> 1; rowgate[slot] = gate[a]; sl[C.tid] = slot; ((int*)(C.ws + WS_SLOTOF))[a] = slot;
        __syncthreads();
        for (int i = C.wave; i < 512; i += NWAVES) { const int s2 = sl[i]; const u32x4* src = (const u32x4*)(C.ws + WS_H8 + (size_t)(blk * 256 + (i >> 1)) * D); u32x4* dst = (u32x4*)(C.ws + WS_XS + (size_t)s2 * D);
            dst[C.lane] = src[C.lane]; }
    }
}

__device__ __forceinline__ void grid_barrier(int wv) {
    const Ctx C = make_ctx(wv);
    XcdBarrier b; b.bar = (unsigned*)(C.ws + WS_CTL) + CW_BAR; b.x = xb_xcc_id(); b.st = (volatile LAS unsigned*)(C.lds + MISC_OFF) + 8;
    xcd_barrier(b, C.tid);
}
__device__ __forceinline__ void P_prologue(int wv) { const Ctx C = make_ctx(wv); ph_prologue_(C); }
__device__ __forceinline__ void P_weights_norm(int wv, int l) { const Ctx C = make_ctx(wv); ph_weights_(C, l, 0, 0, C.G); __syncthreads(); ph_norm_(C, C.in[I_NORM_MIX] + (size_t)l * D, false, nullptr, 0,  (l > 0) && ((l - 1) & 1), l == 0 ? C.in[I_X] : nullptr); }
__device__ __forceinline__ void P_gemm_in(int wv) { const Ctx C = make_ctx(wv); using namespace pg8; unsigned char* ws = C.ws;
    Gemm g{(const bf16*)C.out, (const bf16*)(ws + WS_WIN), D, D}; StaticOrder S; S.init(T, NIN, C.G, C.bid);
    EpiRoute E{(bf16*)(ws + WS_RW), (bf16*)(ws + WS_SB), (bf16*)(ws + WS_RET), (bf16*)(ws + WS_CV)};
    gemm_phase<EpiRoute, StaticOrder, true>(C.lds, C.tid, g, S, E); }
#define REP2(bit, stmt) do { stmt; if constexpr ((PROBE2 >> (bit)) & 1) { __syncthreads(); stmt; } } while (0)
__device__ __forceinline__ void P_mix1(int wv, int l) { REP2(2, { const Ctx C = make_ctx(wv); ph_rw_prep_(C, l); }); { const Ctx C = make_ctx(wv); ph_sb_prep_(C, l); } REP2(3, { const Ctx C = make_ctx(wv); ph_conv_(C, l); }); REP2(4, { const Ctx C = make_ctx(wv); ph_ret_kv2_(C); }); }
__device__ __forceinline__ void P_mix2(int wv, int l) { { const Ctx C = make_ctx(wv); using namespace pg8; unsigned char* ws = C.ws;
    Gemm g{(const bf16*)(ws + WS_ALORA), (const bf16*)(ws + WS_WLORA), 256, 256}; StaticOrder S; S.init(T, 768, C.G, C.bid);
    EpiLora E{(float*)(ws + WS_WDEC), (bf16*)(ws + WS_AG), C.in[I_RW_W0] + (size_t)l * 256, C.in[I_RW_A0] + (size_t)l * 256};
    gemm_phase<EpiLora, StaticOrder, true>(C.lds, C.tid, g, S, E); }
    { const Ctx C = make_ctx(wv); ph_ret_scan_(C); } }
#ifndef MIX3_SEL
#define MIX3_SEL 3
#endif
__device__ __forceinline__ void P_mix3(int wv, int l) { REP2(0, { const Ctx C = make_ctx(wv); ph_rw_local_wy_(C, l); }); }
__device__ __forceinline__ void P_mix4(int wv, int l) { const Ctx C = make_ctx(wv);
    unsigned* qh = (unsigned*)(C.ws + WS_CTL) + CW_QUEUE + l * 64;
    if (C.G >= 64) { if (C.bid < 32) { ph_rw_scan_(C, C.bid); __syncthreads(); }
        ph_sb_attn_(C, 0, C.G, qh); __syncthreads(); ph_ret_out2_(C, l, 0, C.G, qh + 16); __syncthreads(); ph_weights_(C, l, 1, 0, C.G, qh + 32); }
    else { for (int w = C.bid; w < 32; w += C.G) { ph_rw_scan_(C, w); __syncthreads(); } ph_sb_attn_(C, 0, C.G); __syncthreads(); ph_ret_out2_(C, l, 0, C.G); __syncthreads(); ph_weights_(C, l, 1, 0, C.G); } }
__device__ __forceinline__ void P_mix5(int wv, int l) { REP2(5, { const Ctx C = make_ctx(wv); ph_rw_out2_(C, l); }); }
__device__ __forceinline__ void P_gemm_branch(int wv) { const Ctx C = make_ctx(wv); using namespace pg8; unsigned char* ws = C.ws;
    Gemm g{(const bf16*)(ws + WS_Y), (const bf16*)(ws + WS_WB), D, 256}; StaticOrder S; S.init(T, 4096, C.G, C.bid, 2, 512);
    EpiBf16 E{(bf16*)(ws + WS_BALL), 4096, 0xffff, 1.0f};
    gemm_phase<EpiBf16, StaticOrder, false>(C.lds, C.tid, g, S, E); }
__device__ __forceinline__ void P_gemm_gate(int wv) { const Ctx C = make_ctx(wv); using namespace pg8; unsigned char* ws = C.ws;
    Gemm g{(const bf16*)(ws + WS_H8), (const bf16*)(ws + WS_WG), D, D}; StaticOrder S; S.init(T, 4096, C.G, C.bid);
    EpiGateMerge E{(const bf16*)(ws + WS_BALL), (bf16*)(ws + WS_MERGED)};
    gemm_phase8<EpiGateMerge, StaticOrder, true>(C.lds, C.tid, g, S, E); }
__device__ __forceinline__ void P_gemm_out(int wv) { const Ctx C = make_ctx(wv); using namespace pg8; unsigned char* ws = C.ws;
    Gemm g{(const bf16*)(ws + WS_MERGED), (const bf16*)(ws + WS_WOUT), D, D}; StaticOrder S; S.init(T, D, C.G, C.bid);
    EpiResidual E{(bf16*)(ws + WS_XB), 1.0f};
    gemm_phase<EpiResidual, StaticOrder, false>(C.lds, C.tid, g, S, E); }
__device__ __forceinline__ void P_norm_ffn(int wv, int l) { const Ctx C = make_ctx(wv); ph_norm_(C, C.in[I_NORM_FFN] + (size_t)l * D, (l & 1) != 0, C.in[I_ROUTER] + (size_t)(l >> 1) * D * NEXP, l >> 1, false, nullptr,  false); }
__device__ __forceinline__ void P_ffn_up(int wv) { const Ctx C = make_ctx(wv); using namespace pg8; unsigned char* ws = C.ws;
    Gemm g{(const bf16*)(ws + WS_H8), (const bf16*)(ws + WS_W13), D, D}; StaticOrder S; S.init(T, 2 * DFF, C.G, C.bid);
    EpiSwiglu E{ws + WS_HID, DFF, 1 << 20, false};
    gemm_phase8<EpiSwiglu, StaticOrder, true>(C.lds, C.tid, g, S, E); }
__device__ __forceinline__ void P_ffn_down(int wv) { const Ctx C = make_ctx(wv); using namespace pg8; unsigned char* ws = C.ws;
    Gemm g{(const bf16*)(ws + WS_HID), (const bf16*)(ws + WS_W2D), DFF, DFF}; StaticOrder S; S.init(T, D, C.G, C.bid);
    EpiResidual E{(bf16*)(ws + WS_XB), F8_DESCALE_DOWN};
    gemm_phase8<EpiResidual, StaticOrder, false>(C.lds, C.tid, g, S, E); }
__device__ __forceinline__ void P_moe_scatter(int wv, int l2) { const Ctx C = make_ctx(wv); ph_moe_scatter_(C, l2); }
__device__ __forceinline__ void P_moe_up(int wv) { const Ctx C = make_ctx(wv); using namespace pg8; unsigned char* ws = C.ws;
    Gemm g{(const bf16*)(ws + WS_XS), (const bf16*)(ws + WS_W13), D, D};
    MoeOrder S{(const int*)(ws + WS_TEXP), __builtin_amdgcn_readfirstlane(*(const int*)(ws + WS_NT)), 2 * DFE / 256, C.G, C.bid};
    EpiSwiglu E{ws + WS_HIDM, DFE_PAD, 2 * DFE / 256, true};
    gemm_phase8<EpiSwiglu, MoeOrder, true>(C.lds, C.tid, g, S, E); }
__device__ __forceinline__ void P_moe_down(int wv) { const Ctx C = make_ctx(wv); using namespace pg8; unsigned char* ws = C.ws;
    Gemm g{(const bf16*)(ws + WS_HIDM), (const bf16*)(ws + WS_W2M), DFE_PAD, DFE_PAD};
    MoeOrder S{(const int*)(ws + WS_TEXP), __builtin_amdgcn_readfirstlane(*(const int*)(ws + WS_NT)), D / 256, C.G, C.bid};
    EpiBf16 E{(bf16*)(ws + WS_YS), D, 3, F8_DESCALE_DOWN};
    gemm_phase8<EpiBf16, MoeOrder, true>(C.lds, C.tid, g, S, E); }
__device__ __forceinline__ void P_moe_combine(int wv) { const Ctx C = make_ctx(wv);
    const int gw = C.bid * NWAVES + C.wave, NGW = C.G * NWAVES, lane = C.lane;
    const int* slotof = (const int*)(C.ws + WS_SLOTOF); const float* gate = (const float*)(C.ws + WS_GATE); const bf16* YS = (const bf16*)(C.ws + WS_YS); const bf16* XB = (const bf16*)(C.ws + WS_XB);
    for (int m = gw; m < T; m += NGW) {
        const int s0 = slotof[2 * m], s1 = slotof[2 * m + 1]; const float g0 = gate[2 * m], g1 = gate[2 * m + 1];
        const u32x4* xb = (const u32x4*)(XB + (size_t)m * D) + lane; f32x4* xo = (f32x4*)(C.out + (size_t)m * D + 8 * lane);
        const u32x4* y0 = (const u32x4*)(YS + (size_t)s0 * D) + lane; const u32x4* y1 = (const u32x4*)(YS + (size_t)s1 * D) + lane;
#pragma unroll
        for (int j = 0; j < 2; ++j) { const u32x4 x = xb[64 * j], a = y0[64 * j], b = y1[64 * j]; f32x4 v0, v1;
            v0.x = bflo(x.x) + g0 * bflo(a.x) + g1 * bflo(b.x); v0.y = bfhi(x.x) + g0 * bfhi(a.x) + g1 * bfhi(b.x); v0.z = bflo(x.y) + g0 * bflo(a.y) + g1 * bflo(b.y); v0.w = bfhi(x.y) + g0 * bfhi(a.y) + g1 * bfhi(b.y);
            v1.x = bflo(x.z) + g0 * bflo(a.z) + g1 * bflo(b.z); v1.y = bfhi(x.z) + g0 * bfhi(a.z) + g1 * bfhi(b.z); v1.z = bflo(x.w) + g0 * bflo(a.w) + g1 * bflo(b.w); v1.w = bfhi(x.w) + g0 * bfhi(a.w) + g1 * bfhi(b.w);
            xo[128 * j] = v0; xo[128 * j + 1] = v1; }
    }
}

#ifndef PROBE_MASK
#define PROBE_MASK 0u
#endif
#ifndef PH_MASK
#define PH_MASK 0xffffffffu
#endif
__global__ void __launch_bounds__(NTHR, 2) hybrid_fwd(Args args) {
    (void)args;
    const int wv = __builtin_amdgcn_readfirstlane(threadIdx.x >> 6);
    { LAS unsigned char* lds = (LAS unsigned char*)lds_raw;
      for (int u = threadIdx.x; u < (LDS_BYTES - RING_BYTES) / 4; u += NTHR) ((LAS unsigned*)(lds + RING_BYTES))[u] = 0u; }
    __syncthreads();
    { const CAS Args* ka = ka_ptr();
      if (ka->ph_hi - ka->ph_lo > 1) { (void)xcd_barrier_post((unsigned*)(ka->ws + WS_CTL) + CW_BAR, (volatile LAS unsigned*)((LAS unsigned char*)lds_raw + MISC_OFF) + 8); } }
    int gp = 0;
#define PHASE(k, call) { const CAS Args* ka_ = ka_ptr(); const int lo_ = ka_->ph_lo, hi_ = ka_->ph_hi; if (lo_ <= gp && gp < hi_) { if constexpr ((PH_MASK >> (k)) & 1u) { call; if constexpr ((PROBE_MASK >> (k)) & 1u) { __syncthreads(); call; } } if (hi_ - lo_ > 1 && gp + 1 < hi_) grid_barrier(wv); } ++gp; }
    PHASE(0, P_prologue(wv))
#pragma unroll 1
    for (int l = 0; l < NLAYER; ++l) {
        PHASE(1, P_weights_norm(wv, l))
        PHASE(2, P_gemm_in(wv))
        PHASE(3, P_mix1(wv, l))
        PHASE(4, P_mix2(wv, l))
        PHASE(5, P_mix3(wv, l))
        PHASE(6, P_mix4(wv, l))
        PHASE(7, P_mix5(wv, l))
        PHASE(8, P_gemm_branch(wv))
        PHASE(9, P_gemm_gate(wv))
        PHASE(10, P_gemm_out(wv))
        PHASE(11, P_norm_ffn(wv, l))
        if (!(l & 1)) {
            PHASE(12, P_ffn_up(wv))
            PHASE(13, P_ffn_down(wv))
            gp += 2;
        } else {
            PHASE(14, P_moe_scatter(wv, l >> 1))
            PHASE(15, P_moe_up(wv))
            PHASE(16, P_moe_down(wv))
            if (l == NLAYER - 1) { PHASE(17, P_moe_combine(wv)) } else { ++gp; }
        }
    }
#undef PHASE
}
constexpr int N_PHASES = 1 + NLAYER * 15;

#ifndef MK_MULTI
#define MK_MULTI 0
#endif
extern "C" void kernel_launch(void* const* d_in, const int* in_sizes, int n_in, void* d_out, int out_size, void* d_ws, size_t ws_size, hipStream_t stream) {
    static int grid = 0;
    if (grid == 0) {
        if (n_in != 32 || in_sizes[0] != T * D || out_size != T * D || ws_size < WS_END) { fprintf(stderr, "kernel_launch: unexpected problem shape / workspace (%d inputs, ws %zu)\n", n_in, ws_size); grid = -1; return; }
        int dev = 0, cus = 0, per_cu = 0;
        if (hipGetDevice(&dev) != hipSuccess || hipDeviceGetAttribute(&cus, hipDeviceAttributeMultiprocessorCount, dev) != hipSuccess) { grid = -1; return; }
        if (hipFuncSetAttribute((const void*)hybrid_fwd, hipFuncAttributeMaxDynamicSharedMemorySize, LDS_BYTES) != hipSuccess) { fprintf(stderr, "kernel_launch: hipFuncSetAttribute failed\n"); grid = -1; return; }
        if (hipOccupancyMaxActiveBlocksPerMultiprocessor(&per_cu, (const void*)hybrid_fwd, NTHR, LDS_BYTES) != hipSuccess || per_cu < 1) { fprintf(stderr, "kernel_launch: occupancy query says %d\n", per_cu); }
        (void)hipGetLastError();
        grid = cus;
    }
    if (grid < 0) return;
    (void)hipMemsetAsync((char*)d_ws + WS_CTL, 0, CTL_ZERO_BYTES, stream);
#ifdef DBG_ZERO_WS
    (void)hipMemsetAsync((char*)d_ws + CTL_ZERO_BYTES, 0, WS_END - CTL_ZERO_BYTES, stream);
#endif
    Args a{};
    for (int i = 0; i < 32; ++i) a.in[i] = (const float*)d_in[i];
    a.out = (float*)d_out; a.ws = (unsigned char*)d_ws;
#if MK_MULTI
    for (int p = 0; p < N_PHASES; ++p) { a.ph_lo = p; a.ph_hi = p + 1; hipLaunchKernelGGL(hybrid_fwd, dim3(grid), dim3(NTHR), LDS_BYTES, stream, a); }
#else
    a.ph_lo = 0; a.ph_hi = N_PHASES; hipLaunchKernelGGL(hybrid_fwd, dim3(grid), dim3(NTHR), LDS_BYTES, stream, a);
#endif
}
```

```cpp
#include <hip/hip_runtime.h>
#include <cstdio>
#include <cstdint>

#define GAS __attribute__((address_space(1)))
#define LAS __attribute__((address_space(3)))
typedef unsigned short bf16;
typedef unsigned u32x4 __attribute__((ext_vector_type(4)));
typedef unsigned u32x2 __attribute__((ext_vector_type(2)));
typedef float f32x4 __attribute__((ext_vector_type(4)));
typedef float f32x2 __attribute__((ext_vector_type(2)));
typedef short bf16x8 __attribute__((ext_vector_type(8)));
typedef float f32x16 __attribute__((ext_vector_type(16)));
typedef short s16x4 __attribute__((ext_vector_type(4)));

constexpr int SEQ = 16384, NBATCH = 2, T = NBATCH * SEQ, D = 1024, NIN = 3328, DFF = 2816, DFE = 1408, NEXP = 8, NLAYER = 4;
constexpr int MPAD = 2 * T + NEXP * 256;
constexpr int NWAVES = 8, NTHR = 512;
constexpr float LOG2E = 1.4426950408889634f;
constexpr int MM_LP = 72;

typedef __bf16 bf16x2_t __attribute__((ext_vector_type(2)));
__device__ __forceinline__ unsigned cvt_pk_bf16(float lo, float hi) { const f32x2 v = {lo, hi}; const bf16x2_t b = __builtin_convertvector(v, bf16x2_t); return __builtin_bit_cast(unsigned, b); }
__device__ __forceinline__ float bflo(unsigned u) { return __builtin_bit_cast(float, u << 16); }
__device__ __forceinline__ float bfhi(unsigned u) { return __builtin_bit_cast(float, u & 0xffff0000u); }
__device__ __forceinline__ float bf2f(bf16 u) { return __builtin_bit_cast(float, (unsigned)u << 16); }
__device__ __forceinline__ bf16 f2bf(float f) { return (bf16)(cvt_pk_bf16(f, 0.f) & 0xffffu); }
__device__ __forceinline__ float sigm(float x) { return __builtin_amdgcn_rcpf(1.f + __builtin_amdgcn_exp2f(-x * LOG2E)); }
__device__ __forceinline__ float shx(float v, int o, int lane) { return __builtin_bit_cast(float, __builtin_amdgcn_ds_bpermute((lane ^ o) << 2, __builtin_bit_cast(int, v))); }
__device__ __forceinline__ float dpp_add(float v, const int ctrl_id) {
    const int x = __builtin_bit_cast(int, v);
    int y;
    if (ctrl_id == 0) y = __builtin_amdgcn_update_dpp(0, x, 0xB1, 0xF, 0xF, true);
    else if (ctrl_id == 1) y = __builtin_amdgcn_update_dpp(0, x, 0x4E, 0xF, 0xF, true);
    else if (ctrl_id == 2) y = __builtin_amdgcn_update_dpp(0, x, 0x141, 0xF, 0xF, true);
    else y = __builtin_amdgcn_update_dpp(0, x, 0x140, 0xF, 0xF, true);
    return v + __builtin_bit_cast(float, y);
}
__device__ __forceinline__ float wave_sum(float v, int lane) {
    (void)lane;
    v = dpp_add(v, 0); v = dpp_add(v, 1); v = dpp_add(v, 2); v = dpp_add(v, 3);
    const int x = __builtin_bit_cast(int, v);
    const float s0 = __builtin_bit_cast(float, __builtin_amdgcn_readlane(x, 0)), s1 = __builtin_bit_cast(float, __builtin_amdgcn_readlane(x, 16)),
                s2 = __builtin_bit_cast(float, __builtin_amdgcn_readlane(x, 32)), s3 = __builtin_bit_cast(float, __builtin_amdgcn_readlane(x, 48));
    return (s0 + s1) + (s2 + s3);
}
__device__ __forceinline__ void unpack8(const u32x4 v, float* f) {
    f[0] = bflo(v.x); f[1] = bfhi(v.x); f[2] = bflo(v.y); f[3] = bfhi(v.y); f[4] = bflo(v.z); f[5] = bfhi(v.z); f[6] = bflo(v.w); f[7] = bfhi(v.w);
}
__device__ __forceinline__ unsigned pk4_fp8(float a, float b, float c, float d) {
    a = __builtin_amdgcn_fmed3f(a, -440.f, 440.f); b = __builtin_amdgcn_fmed3f(b, -440.f, 440.f); c = __builtin_amdgcn_fmed3f(c, -440.f, 440.f); d = __builtin_amdgcn_fmed3f(d, -440.f, 440.f);
    int w = __builtin_amdgcn_cvt_pk_fp8_f32(a, b, 0, false); w = __builtin_amdgcn_cvt_pk_fp8_f32(c, d, w, true); return (unsigned)w; }
__device__ __forceinline__ u32x4 pack8(const float* f) {
    u32x4 w; w.x = cvt_pk_bf16(f[0], f[1]); w.y = cvt_pk_bf16(f[2], f[3]); w.z = cvt_pk_bf16(f[4], f[5]); w.w = cvt_pk_bf16(f[6], f[7]); return w;
}


#ifndef PROBE2
#define PROBE2 0
#endif
#ifndef GMASK
#define GMASK 15
#endif
#ifndef RWDBG
#define RWDBG 0
#endif
typedef int i32x8 __attribute__((ext_vector_type(8)));
constexpr float F8_MUL_X = 16.f, F8_MUL_W = 256.f, F8_DESCALE = 1.0f / (16.f * 256.f), F8_MUL_H = 4.f, F8_DESCALE_DOWN = 1.0f / (4.f * 256.f);
constexpr int DFE_PAD = 1536;
namespace pg8 {
typedef unsigned short bf16_t;
constexpr int BM = 256, BK = 64, HALF = 128, HTB = HALF * BK * 2, NXCD = 8, WGM = 8;
__host__ __device__ __forceinline__ int lds_byte(int r, int c) { const int st = (r >> 4) * 2 + (c >> 5), rr = r & 15, cc = c & 31, ob = rr * 64 + cc * 2; return st * 1024 + (ob ^ (((ob >> 9) & 1) << 5)); }
__host__ __device__ __forceinline__ void stage_rc(int b, int& R, int& C) { const int st = b / 1024, sb = b % 1024, swz = sb ^ (((sb >> 9) & 1) << 5); R = (st >> 1) * 16 + swz / 64; C = (st & 1) * 32 + (swz % 64) / 2; }
__host__ __device__ __forceinline__ int perm32(int rho) { const int n = rho >> 4, i = rho & 15; return 8 * (i >> 2) + 4 * n + (i & 3); }

struct Unit { int pm, pn, aoff; };
struct Gemm { const bf16_t* A; const bf16_t* Bt; int lda, K; };

struct StaticOrder {
    int nM, nN, nwg, G, c, ashift, amul;
    __device__ void init(int M, int N, int G_, int c_, int ashift_ = 0, int amul_ = 0) { nM = M / BM; nN = N / BM; nwg = nM * nN; G = G_; c = c_; ashift = ashift_; amul = amul_; }
    __device__ bool next(int i, Unit& u) const {
        const long L = (long)i * G + c; if (L >= nwg) return false;
        int wgid = (int)L; { const int q = nwg / NXCD, r = nwg % NXCD, xcd = wgid % NXCD, off = wgid / NXCD; wgid = (xcd < r ? xcd * (q + 1) : r * (q + 1) + (xcd - r) * q) + off; }
        const int nig = WGM * nN, gid = wgid / nig, fm = gid * WGM, gsz = (nM - fm) < WGM ? (nM - fm) : WGM;
        u.pm = fm + ((wgid % nig) % gsz); u.pn = (wgid % nig) / gsz; u.aoff = (u.pn >> ashift) * amul; return true;
    }
};
struct MoeOrder {
    const int* texp; int ntiles, ncol, G, c;
    __device__ bool next(int i, Unit& u) const {
        const int L = i * G + c; if (L >= ntiles * ncol) return false;
        const int pm = L / ncol, pl = L % ncol;
        u.pm = pm; u.pn = texp[pm] * ncol + pl; u.aoff = 0; return true;
    }
};

template <class Epi, class Sched, bool ALIGN_EPI, int CMAP = 0>
__device__ __forceinline__ void gemm_phase(LAS unsigned char* lds, const int tid_in, const Gemm g, const Sched& S, const Epi& E) {
    const int tid = tid_in, wid = __builtin_amdgcn_readfirstlane(tid >> 6), lane = tid & 63, wr = wid >> 2, wc = wid & 3, fr = lane & 15, fq = lane >> 4;
    const int K = g.K, nt = K / BK, lda = g.lda;
    unsigned voffA[2], voffB[2];
#pragma unroll
    for (int i = 0; i < 2; ++i) { int R, C; stage_rc(tid * 16 + i * 8192, R, C); const int p32 = perm32(R & 31); const int Rb = CMAP ? 64 * (R >> 5) + 16 * (p32 >> 3) + (p32 & 7) : (R & ~31) + p32;
        voffA[i] = (unsigned)(R * lda + C) * 2u; voffB[i] = (unsigned)(Rb * K + C) * 2u; }
    const size_t kstep = (size_t)(BK * 2);
    const size_t hstepA = (size_t)HALF * lda * 2, tstepA = 2 * hstepA, hstepB = (size_t)(CMAP ? 8 : HALF) * K * 2, tstepB = (size_t)BM * K * 2;
    const unsigned ldsw = (unsigned)wid * 1024u;
    const int aoff = lds_byte(wr * 64 + fr, fq * 8), boff = lds_byte(wc * 32 + fr, fq * 8);
#define PG8_SA(b, h) (((b) * 2 + (h)) * HTB)
#define PG8_SB(b, h) ((4 + (b) * 2 + (h)) * HTB)
#define PG8_STAGE(bufoff, gbase, voff) do { _Pragma("unroll") for (int _i = 0; _i < 2; ++_i) \
        __builtin_amdgcn_global_load_lds((const unsigned*)((const char*)(gbase) + (voff)[_i]), (LAS unsigned*)(lds + (bufoff) + ldsw + _i * 8192), 16, 0, 0); } while (0)
#define PG8_LDA(dst, b, h) do { _Pragma("unroll") for (int m = 0; m < 4; ++m) _Pragma("unroll") for (int k = 0; k < 2; ++k) dst[m][k] = *(const LAS bf16x8*)(lds + PG8_SA(b, h) + aoff + m * 2048 + k * 1024); } while (0)
#define PG8_LDB(dst, b, h) do { _Pragma("unroll") for (int n = 0; n < 2; ++n) _Pragma("unroll") for (int k = 0; k < 2; ++k) dst[n][k] = *(const LAS bf16x8*)(lds + PG8_SB(b, h) + boff + n * 2048 + k * 1024); } while (0)
#define PG8_MMA(ai, bj, At, Bt) do { __builtin_amdgcn_s_setprio(1); _Pragma("unroll") for (int m = 0; m < 4; ++m) _Pragma("unroll") for (int n = 0; n < 2; ++n) _Pragma("unroll") for (int k = 0; k < 2; ++k) \
        acc[ai][bj][m][n] = __builtin_amdgcn_mfma_f32_16x16x32_bf16(Bt[n][k], At[m][k], acc[ai][bj][m][n], 0, 0, 0); __builtin_amdgcn_s_setprio(0); } while (0)
#define PG8_WAIT_V(n) asm volatile("s_waitcnt vmcnt(" #n ")" ::: "memory")
#define PG8_WAIT_L(n) asm volatile("s_waitcnt lgkmcnt(" #n ")" ::: "memory")
#define PG8_BAR __builtin_amdgcn_s_barrier()
#define PG8_SCHED __builtin_amdgcn_sched_barrier(0)
    Unit cur, nxt; int ui = 0;
    if (!S.next(0, cur)) return;
    f32x4 acc[2][2][4][2];
#pragma unroll
    for (int a = 0; a < 2; ++a)
#pragma unroll
        for (int b = 0; b < 2; ++b)
#pragma unroll
            for (int m = 0; m < 4; ++m)
#pragma unroll
                for (int n = 0; n < 2; ++n) acc[a][b][m][n] = (f32x4){0.f, 0.f, 0.f, 0.f};
    bf16x8 At[4][2], B0[2][2], B1[2][2];
    const char* cA = (const char*)g.A + (size_t)cur.pm * tstepA + cur.aoff; const char* cB = (const char*)g.Bt + (size_t)cur.pn * tstepB;
    PG8_STAGE(PG8_SB(0, 0), cB, voffB); PG8_STAGE(PG8_SB(0, 1), cB + hstepB, voffB); PG8_STAGE(PG8_SA(0, 0), cA, voffA); PG8_STAGE(PG8_SA(0, 1), cA + hstepA, voffA);
    if (wr == 1) PG8_BAR;
    PG8_WAIT_V(2); PG8_BAR;
    PG8_STAGE(PG8_SB(1, 0), cB + kstep, voffB); PG8_STAGE(PG8_SA(1, 0), cA + kstep, voffA); PG8_STAGE(PG8_SB(1, 1), cB + hstepB + kstep, voffB);
    PG8_WAIT_V(6); PG8_BAR;
    for (;;) {
        const bool has_next = S.next(ui + 1, nxt);
        const char* nA = has_next ? (const char*)g.A + (size_t)nxt.pm * tstepA + nxt.aoff : cA; const char* nB = has_next ? (const char*)g.Bt + (size_t)nxt.pn * tstepB : cB;
#pragma unroll 1
        for (int t = 0; t < nt; t += 2) {
            const bool last = (t == nt - 2);
            const char* a1 = cA + (size_t)(t + 1) * kstep;
            const char* a2 = last ? nA : cA + (size_t)(t + 2) * kstep; const char* b2 = last ? nB : cB + (size_t)(t + 2) * kstep;
            const char* a3 = a2 + kstep; const char* b3 = b2 + kstep;
            PG8_LDB(B0, 0, 0); PG8_LDB(B1, 0, 1); PG8_SCHED; PG8_LDA(At, 0, 0); PG8_STAGE(PG8_SA(1, 1), a1 + hstepA, voffA);
            PG8_WAIT_V(8); PG8_WAIT_L(0); PG8_BAR; PG8_MMA(0, 0, At, B0); PG8_MMA(0, 1, At, B1); PG8_BAR; PG8_SCHED;
            PG8_LDA(At, 0, 1); PG8_STAGE(PG8_SB(0, 0), b2, voffB); PG8_STAGE(PG8_SB(0, 1), b2 + hstepB, voffB); PG8_STAGE(PG8_SA(0, 0), a2, voffA);
            PG8_WAIT_V(8); PG8_WAIT_L(0); PG8_BAR; PG8_MMA(1, 0, At, B0); PG8_MMA(1, 1, At, B1); PG8_BAR; PG8_SCHED;
            PG8_LDB(B0, 1, 0); PG8_LDB(B1, 1, 1); PG8_SCHED; PG8_LDA(At, 1, 0); PG8_STAGE(PG8_SA(0, 1), a2 + hstepA, voffA);
            PG8_WAIT_V(8); PG8_WAIT_L(0); PG8_BAR; PG8_MMA(0, 0, At, B0); PG8_MMA(0, 1, At, B1); PG8_BAR; PG8_SCHED;
            PG8_LDA(At, 1, 1); PG8_STAGE(PG8_SB(1, 0), b3, voffB); PG8_STAGE(PG8_SB(1, 1), b3 + hstepB, voffB); PG8_STAGE(PG8_SA(1, 0), a3, voffA);
            PG8_WAIT_V(8); PG8_WAIT_L(0); PG8_BAR; PG8_MMA(1, 0, At, B0); PG8_MMA(1, 1, At, B1); PG8_BAR; PG8_SCHED;
        }
        if constexpr (ALIGN_EPI) { if (wr == 0) PG8_BAR; }
        { int ln_; asm volatile("v_mbcnt_lo_u32_b32 %0, -1, 0\n\tv_mbcnt_hi_u32_b32 %0, -1, %0" : "=v"(ln_)); E(acc, cur, wr, wc, ln_ & 15, ln_ >> 4); }
        if (!has_next) break;
#pragma unroll
        for (int a = 0; a < 2; ++a)
#pragma unroll
            for (int b = 0; b < 2; ++b)
#pragma unroll
                for (int m = 0; m < 4; ++m)
#pragma unroll
                    for (int n = 0; n < 2; ++n) acc[a][b][m][n] = (f32x4){0.f, 0.f, 0.f, 0.f};
        cur = nxt; cA = nA; cB = nB; ++ui;
        if constexpr (ALIGN_EPI) { if (wr == 1) PG8_BAR; }
    }
    PG8_WAIT_V(0);
    if constexpr (!ALIGN_EPI) { if (wr == 0) PG8_BAR; }
    PG8_BAR;
#undef PG8_SA
#undef PG8_SB
#undef PG8_STAGE
#undef PG8_LDA
#undef PG8_LDB
#undef PG8_MMA
#undef PG8_WAIT_V
#undef PG8_WAIT_L
#undef PG8_BAR
#undef PG8_SCHED
}

template <class Epi, class Sched, bool ALIGN_EPI, int CMAP = 0>
__device__ __forceinline__ void gemm_phase8(LAS unsigned char* lds, const int tid_in, const Gemm g, const Sched& S, const Epi& E) {
    const int tid = tid_in, wid = __builtin_amdgcn_readfirstlane(tid >> 6), lane = tid & 63, wr = wid >> 2, wc = wid & 3, fr = lane & 15, fq = lane >> 4;
    const int K = g.K, nt = K / 128, lda = g.lda;
    unsigned voffA, voffB;
    { int R, C; stage_rc(tid * 16, R, C); const int p32 = perm32(R & 31); const int Rb = CMAP ? 64 * (R >> 5) + 16 * (p32 >> 3) + (p32 & 7) : (R & ~31) + p32; voffA = (unsigned)(R * lda + C * 2); voffB = (unsigned)(Rb * K + C * 2); }
    const unsigned pstepA = 64u * (unsigned)lda, pstepB = (CMAP ? 128u : 64u) * (unsigned)K;
    const unsigned kstep = (unsigned)(BK * 2);
    const unsigned hstepA = (unsigned)HALF * (unsigned)lda, tstepA = 2 * hstepA, hstepB = (unsigned)(CMAP ? 8 : HALF) * (unsigned)K, tstepB = (unsigned)BM * (unsigned)K;
    const __amdgpu_buffer_rsrc_t rsA = __builtin_amdgcn_make_buffer_rsrc((void*)g.A, 0, 0x7fffffff, 0x00020000), rsB = __builtin_amdgcn_make_buffer_rsrc((void*)g.Bt, 0, 0x7fffffff, 0x00020000);
    const unsigned ldsw = (unsigned)wid * 1024u;
    const int aoff0 = lds_byte(wr * 64 + fr, fq * 16), aoff1 = aoff0 + 16, boff0 = lds_byte(wc * 32 + fr, fq * 16), boff1 = boff0 + 16;
#define PG8_SA(b, h) (((b) * 2 + (h)) * HTB)
#define PG8_SB(b, h) ((4 + (b) * 2 + (h)) * HTB)
#define PG8_STAGE(bufoff, goff, voff, pstep) do { _Pragma("unroll") for (int _i = 0; _i < 2; ++_i) \
        __builtin_amdgcn_raw_ptr_buffer_load_lds(PG8_RS_##voff, (LAS unsigned*)(lds + (bufoff) + ldsw + _i * 8192), 16, (int)(voff), (int)((goff) + _i * (pstep)), 0, 0); } while (0)
#define PG8_RS_voffA rsA
#define PG8_RS_voffB rsB
#define PG8_LDA(dst, b, h) do { _Pragma("unroll") for (int m = 0; m < 4; ++m) { dst[m][0] = *(const LAS u32x4*)(lds + PG8_SA(b, h) + aoff0 + m * 2048); dst[m][1] = *(const LAS u32x4*)(lds + PG8_SA(b, h) + aoff1 + m * 2048); } } while (0)
#define PG8_LDB(dst, b, h) do { _Pragma("unroll") for (int n = 0; n < 2; ++n) { dst[n][0] = *(const LAS u32x4*)(lds + PG8_SB(b, h) + boff0 + n * 2048); dst[n][1] = *(const LAS u32x4*)(lds + PG8_SB(b, h) + boff1 + n * 2048); } } while (0)
#define PG8_J8(x) __builtin_bit_cast(i32x8, __builtin_shufflevector((x)[0], (x)[1], 0, 1, 2, 3, 4, 5, 6, 7))
#define PG8_MMA(ai, bj, At, Bt) do { __builtin_amdgcn_s_setprio(1); _Pragma("unroll") for (int m = 0; m < 4; ++m) _Pragma("unroll") for (int n = 0; n < 2; ++n) \
        acc[ai][bj][m][n] = __builtin_amdgcn_mfma_scale_f32_16x16x128_f8f6f4(PG8_J8(Bt[n]), PG8_J8(At[m]), acc[ai][bj][m][n], 0, 0, 0, 0, 0, 0);        __builtin_amdgcn_s_setprio(0); } while (0)
#define PG8_WAIT_V(n) asm volatile("s_waitcnt vmcnt(" #n ")" ::: "memory")
#define PG8_WAIT_L(n) asm volatile("s_waitcnt lgkmcnt(" #n ")" ::: "memory")
#define PG8_BAR __builtin_amdgcn_s_barrier()
#define PG8_SCHED __builtin_amdgcn_sched_barrier(0)
    Unit cur, nxt; int ui = 0;
    if (!S.next(0, cur)) return;
    f32x4 acc[2][2][4][2];
#pragma unroll
    for (int a = 0; a < 2; ++a)
#pragma unroll
        for (int b = 0; b < 2; ++b)
#pragma unroll
            for (int m = 0; m < 4; ++m)
#pragma unroll
                for (int n = 0; n < 2; ++n) acc[a][b][m][n] = (f32x4){0.f, 0.f, 0.f, 0.f};
    u32x4 At[4][2], B0[2][2], B1[2][2];
    unsigned cA = (unsigned)cur.pm * tstepA + (unsigned)cur.aoff, cB = (unsigned)cur.pn * tstepB;
    PG8_STAGE(PG8_SB(0, 0), cB, voffB, pstepB); PG8_STAGE(PG8_SB(0, 1), cB + hstepB, voffB, pstepB); PG8_STAGE(PG8_SA(0, 0), cA, voffA, pstepA); PG8_STAGE(PG8_SA(0, 1), cA + hstepA, voffA, pstepA);
    if (wr == 1) PG8_BAR;
    PG8_WAIT_V(2); PG8_BAR;
    PG8_STAGE(PG8_SB(1, 0), cB + kstep, voffB, pstepB); PG8_STAGE(PG8_SA(1, 0), cA + kstep, voffA, pstepA); PG8_STAGE(PG8_SB(1, 1), cB + hstepB + kstep, voffB, pstepB);
    PG8_WAIT_V(6); PG8_BAR;
    for (;;) {
        const bool has_next = S.next(ui + 1, nxt);
        const unsigned nA = has_next ? (unsigned)nxt.pm * tstepA + (unsigned)nxt.aoff : cA, nB = has_next ? (unsigned)nxt.pn * tstepB : cB;
#pragma unroll 1
        for (int t = 0; t < nt; t += 2) {
            const bool last = (t == nt - 2);
            const unsigned a1 = cA + (unsigned)(t + 1) * kstep;
            const unsigned a2 = last ? nA : cA + (unsigned)(t + 2) * kstep, b2 = last ? nB : cB + (unsigned)(t + 2) * kstep;
            const unsigned a3 = a2 + kstep, b3 = b2 + kstep;
            PG8_LDB(B0, 0, 0); PG8_LDB(B1, 0, 1); PG8_SCHED; PG8_LDA(At, 0, 0); PG8_STAGE(PG8_SA(1, 1), a1 + hstepA, voffA, pstepA);
            PG8_WAIT_V(8); PG8_WAIT_L(0); PG8_BAR; PG8_MMA(0, 0, At, B0); PG8_MMA(0, 1, At, B1); PG8_BAR; PG8_SCHED;
            PG8_LDA(At, 0, 1); PG8_STAGE(PG8_SB(0, 0), b2, voffB, pstepB); PG8_STAGE(PG8_SB(0, 1), b2 + hstepB, voffB, pstepB); PG8_STAGE(PG8_SA(0, 0), a2, voffA, pstepA);
            PG8_WAIT_V(8); PG8_WAIT_L(0); PG8_BAR; PG8_MMA(1, 0, At, B0); PG8_MMA(1, 1, At, B1); PG8_BAR; PG8_SCHED;
            PG8_LDB(B0, 1, 0); PG8_LDB(B1, 1, 1); PG8_SCHED; PG8_LDA(At, 1, 0); PG8_STAGE(PG8_SA(0, 1), a2 + hstepA, voffA, pstepA);
            PG8_WAIT_V(8); PG8_WAIT_L(0); PG8_BAR; PG8_MMA(0, 0, At, B0); PG8_MMA(0, 1, At, B1); PG8_BAR; PG8_SCHED;
            PG8_LDA(At, 1, 1); PG8_STAGE(PG8_SB(1, 0), b3, voffB, pstepB); PG8_STAGE(PG8_SB(1, 1), b3 + hstepB, voffB, pstepB); PG8_STAGE(PG8_SA(1, 0), a3, voffA, pstepA);
            PG8_WAIT_V(8); PG8_WAIT_L(0); PG8_BAR; PG8_MMA(1, 0, At, B0); PG8_MMA(1, 1, At, B1); PG8_BAR; PG8_SCHED;
        }
        if constexpr (ALIGN_EPI) { if (wr == 0) PG8_BAR; }
        { int ln_; asm volatile("v_mbcnt_lo_u32_b32 %0, -1, 0\n\tv_mbcnt_hi_u32_b32 %0, -1, %0" : "=v"(ln_)); E(acc, cur, wr, wc, ln_ & 15, ln_ >> 4); }
        if (!has_next) break;
#pragma unroll
        for (int a = 0; a < 2; ++a)
#pragma unroll
            for (int b = 0; b < 2; ++b)
#pragma unroll
                for (int m = 0; m < 4; ++m)
#pragma unroll
                    for (int n = 0; n < 2; ++n) acc[a][b][m][n] = (f32x4){0.f, 0.f, 0.f, 0.f};
        cur = nxt; cA = nA; cB = nB; ++ui;
        if constexpr (ALIGN_EPI) { if (wr == 1) PG8_BAR; }
    }
    PG8_WAIT_V(0);
    if constexpr (!ALIGN_EPI) { if (wr == 0) PG8_BAR; }
    PG8_BAR;
#undef PG8_SA
#undef PG8_SB
#undef PG8_STAGE
#undef PG8_RS_voffA
#undef PG8_RS_voffB
#undef PG8_LDA
#undef PG8_LDB
#undef PG8_MMA
#undef PG8_J8
#undef PG8_WAIT_V
#undef PG8_WAIT_L
#undef PG8_BAR
#undef PG8_SCHED
}

typedef f32x4 Acc[2][2][4][2];

__device__ __forceinline__ unsigned dpp_ror8(unsigned v) { return (unsigned)__builtin_amdgcn_update_dpp(0, (int)v, 0x128, 0xf, 0xf, false); }
struct CmPair { unsigned a, b; };
__device__ __forceinline__ CmPair cm_swapv(bool lo, unsigned x0, unsigned x1) { const unsigned r = dpp_ror8(lo ? x1 : x0); CmPair o; o.a = lo ? x0 : r; o.b = lo ? r : x1; return o; }
#define CM_SWAP_U(lo, X0, X1) do { const CmPair r_ = cm_swapv(lo, X0, X1); X0 = r_.a; X1 = r_.b; } while (0)
#define CM_SWAP_F(lo, X0, X1) do { const CmPair r_ = cm_swapv(lo, __builtin_bit_cast(unsigned, (float)(X0)), __builtin_bit_cast(unsigned, (float)(X1))); X0 = __builtin_bit_cast(float, r_.a); X1 = __builtin_bit_cast(float, r_.b); } while (0)
#define cm_swap4(lo, w0, w1) do { CM_SWAP_U(lo, w0.x, w1.x); CM_SWAP_U(lo, w0.y, w1.y); CM_SWAP_U(lo, w0.z, w1.z); CM_SWAP_U(lo, w0.w, w1.w); } while (0)
struct EpiRoute {
    bf16_t *d0, *d1, *d2, *d3;
    __device__ __forceinline__ void operator()(const Acc& acc, const Unit& u, int wr, int wc, int fr, int fq) const {
        const int pn = u.pn; bf16_t* base; int ld, ct;
        if (pn < 4) { base = d0; ld = 1024; ct = pn; } else if (pn < 7) { base = d1; ld = 768; ct = pn - 4; } else if (pn < 11) { base = d2; ld = 1024; ct = pn - 7; } else { base = d3; ld = 512; ct = pn - 11; }
        const bool lo = fr < 8;
        const int row0 = u.pm * BM + wr * 64 + (fr & 7), col0 = ct * 256 + wc * 64 + 16 * fq + 8 * (fr >> 3);
#pragma unroll
        for (int ai = 0; ai < 2; ++ai)
#pragma unroll
            for (int m = 0; m < 4; ++m) { bf16_t* rowp = base + (size_t)(row0 + ai * HALF + m * 16) * ld + col0; u32x4 w0, w1;
                { const f32x4 v0 = acc[ai][0][m][0], v1 = acc[ai][0][m][1]; w0.x = cvt_pk_bf16(v0[0], v0[1]); w0.y = cvt_pk_bf16(v0[2], v0[3]); w0.z = cvt_pk_bf16(v1[0], v1[1]); w0.w = cvt_pk_bf16(v1[2], v1[3]); }
                { const f32x4 v0 = acc[ai][1][m][0], v1 = acc[ai][1][m][1]; w1.x = cvt_pk_bf16(v0[0], v0[1]); w1.y = cvt_pk_bf16(v0[2], v0[3]); w1.z = cvt_pk_bf16(v1[0], v1[1]); w1.w = cvt_pk_bf16(v1[2], v1[3]); }
                cm_swap4(lo, w0, w1);
                *(u32x4*)rowp = w0; *(u32x4*)(rowp + (size_t)8 * ld) = w1; }
    }
};
struct EpiBf16 {
    bf16_t* O; int ld, pnmask; float sc;
    __device__ __forceinline__ void operator()(const Acc& acc, const Unit& u, int wr, int wc, int fr, int fq) const {
        const bool lo = fr < 8;
        const int row0 = u.pm * BM + wr * 64 + (fr & 7), col0 = (u.pn & pnmask) * 256 + wc * 64 + 16 * fq + 8 * (fr >> 3);
#pragma unroll
        for (int ai = 0; ai < 2; ++ai)
#pragma unroll
            for (int m = 0; m < 4; ++m) { bf16_t* rowp = O + (size_t)(row0 + ai * HALF + m * 16) * ld + col0; u32x4 w0, w1;
                { const f32x4 v0 = acc[ai][0][m][0] * sc, v1 = acc[ai][0][m][1] * sc; w0.x = cvt_pk_bf16(v0[0], v0[1]); w0.y = cvt_pk_bf16(v0[2], v0[3]); w0.z = cvt_pk_bf16(v1[0], v1[1]); w0.w = cvt_pk_bf16(v1[2], v1[3]); }
                { const f32x4 v0 = acc[ai][1][m][0] * sc, v1 = acc[ai][1][m][1] * sc; w1.x = cvt_pk_bf16(v0[0], v0[1]); w1.y = cvt_pk_bf16(v0[2], v0[3]); w1.z = cvt_pk_bf16(v1[0], v1[1]); w1.w = cvt_pk_bf16(v1[2], v1[3]); }
                cm_swap4(lo, w0, w1);
                *(u32x4*)rowp = w0; *(u32x4*)(rowp + (size_t)8 * ld) = w1; }
    }
};
struct EpiLora {
    float* wdec; bf16_t* ag; const float* w0; const float* a0;
    __device__ __forceinline__ void operator()(const Acc& acc, const Unit& u, int wr, int wc, int fr, int fq) const {
        const int row0 = u.pm * BM + wr * 64 + fr, cl0 = wc * 32 + 8 * fq, pn = u.pn;
#pragma unroll
        for (int ai = 0; ai < 2; ++ai)
#pragma unroll
            for (int m = 0; m < 4; ++m) { const size_t row = (size_t)(row0 + ai * HALF + m * 16);
#pragma unroll
                for (int bj = 0; bj < 2; ++bj) { const int col = bj * HALF + cl0; float v[8];
#pragma unroll
                    for (int n = 0; n < 2; ++n)
#pragma unroll
                        for (int e = 0; e < 4; ++e) v[4 * n + e] = acc[ai][bj][m][n][e];
                    if (pn == 0) {
                        *(f32x4*)(wdec + row * 256 + col) = (f32x4){v[0], v[1], v[2], v[3]}; *(f32x4*)(wdec + row * 256 + col + 4) = (f32x4){v[4], v[5], v[6], v[7]};
                    } else if (pn == 1) {
                        *(u32x4*)(ag + row * 512 + col) = pack8(v);
                    } else { *(u32x4*)(ag + row * 512 + 256 + col) = pack8(v); }
                } }
    }
};
struct EpiBall {
    unsigned char* O;
    __device__ __forceinline__ void operator()(const Acc& acc, const Unit& u, int wr, int wc, int fr, int fq) const {
        unsigned char* base = O + ((size_t)(u.pm * 16 + u.pn) << 17) + (wr * 4 + wc) * 1024 + (fr + 16 * fq) * 16;
#pragma unroll
        for (int ai = 0; ai < 2; ++ai)
#pragma unroll
            for (int m = 0; m < 4; ++m)
#pragma unroll
                for (int bj = 0; bj < 2; ++bj) { const f32x4 v0 = acc[ai][bj][m][0], v1 = acc[ai][bj][m][1]; u32x4 w;
                    w.x = cvt_pk_bf16(v0[0], v0[1]); w.y = cvt_pk_bf16(v0[2], v0[3]); w.z = cvt_pk_bf16(v1[0], v1[1]); w.w = cvt_pk_bf16(v1[2], v1[3]);
                    *(u32x4*)(base + ((ai * 4 + m) * 2 + bj) * 8192) = w; }
    }
};
struct EpiGateMerge {
    const bf16_t* ball; bf16_t* merged;
    __device__ __forceinline__ void operator()(const Acc& acc, const Unit& u, int wr, int wc, int fr, int fq) const {
        const int row0 = u.pm * BM + wr * 64 + fr, o0 = 64 * u.pn + 16 * wc + 4 * fq;
        const int cw = 64 * (u.pn & 3) + 16 * wc + 4 * fq;
        const unsigned char* lbase = (const unsigned char*)ball + ((size_t)(u.pm * 16 + (u.pn >> 2)) << 17) + (cw >> 7) * 8192 + (wr * 4 + ((cw >> 5) & 3)) * 1024 + (fr + 16 * ((cw >> 3) & 3)) * 16 + ((cw >> 2) & 1) * 8;
#pragma unroll
        for (int ai = 0; ai < 2; ++ai)
#pragma unroll
            for (int m = 0; m < 4; ++m) { const size_t row = (size_t)(row0 + ai * HALF + m * 16); float s[4] = {0.f, 0.f, 0.f, 0.f};
#pragma unroll
                for (int bj = 0; bj < 2; ++bj)
#pragma unroll
                    for (int n = 0; n < 2; ++n) { const int gi = 2 * bj + n; if (!((GMASK >> gi) & 1)) continue; const u32x2 b = *(const u32x2*)(lbase + ((size_t)gi << 19) + (ai * 4 + m) * 16384);
                        const f32x4 a = acc[ai][bj][m][n] * F8_DESCALE;
                        s[0] += sigm(a[0]) * bflo(b.x); s[1] += sigm(a[1]) * bfhi(b.x); s[2] += sigm(a[2]) * bflo(b.y); s[3] += sigm(a[3]) * bfhi(b.y); }
                u32x2 w; w.x = cvt_pk_bf16(s[0], s[1]); w.y = cvt_pk_bf16(s[2], s[3]);
                *(u32x2*)(merged + row * 1024 + o0) = w; }
    }
};
struct EpiResidual {
    bf16_t* xb; float sc;
    __device__ __forceinline__ void operator()(const Acc& acc, const Unit& u, int wr, int wc, int fr, int fq) const {
        const bool lo = fr < 8;
        const int row0 = u.pm * BM + wr * 64 + (fr & 7), col0 = u.pn * 256 + wc * 64 + 16 * fq + 8 * (fr >> 3);
#pragma unroll
        for (int ai = 0; ai < 2; ++ai)
#pragma unroll
            for (int m = 0; m < 4; ++m) { u32x4* p0 = (u32x4*)(xb + (size_t)(row0 + ai * HALF + m * 16) * 1024 + col0); u32x4* p1 = (u32x4*)((bf16_t*)p0 + 8 * 1024);
                const u32x4 t0 = *p0, t1 = *p1;
                f32x4 a0 = acc[ai][0][m][0] * sc, a1 = acc[ai][0][m][1] * sc, b0 = acc[ai][1][m][0] * sc, b1 = acc[ai][1][m][1] * sc;
#pragma unroll
                for (int e = 0; e < 4; ++e) { CM_SWAP_F(lo, a0[e], b0[e]); CM_SWAP_F(lo, a1[e], b1[e]); }
                u32x4 w0, w1;
                w0.x = cvt_pk_bf16(bflo(t0.x) + a0[0], bfhi(t0.x) + a0[1]); w0.y = cvt_pk_bf16(bflo(t0.y) + a0[2], bfhi(t0.y) + a0[3]); w0.z = cvt_pk_bf16(bflo(t0.z) + a1[0], bfhi(t0.z) + a1[1]); w0.w = cvt_pk_bf16(bflo(t0.w) + a1[2], bfhi(t0.w) + a1[3]);
                w1.x = cvt_pk_bf16(bflo(t1.x) + b0[0], bfhi(t1.x) + b0[1]); w1.y = cvt_pk_bf16(bflo(t1.y) + b0[2], bfhi(t1.y) + b0[3]); w1.z = cvt_pk_bf16(bflo(t1.z) + b1[0], bfhi(t1.z) + b1[1]); w1.w = cvt_pk_bf16(bflo(t1.w) + b1[2], bfhi(t1.w) + b1[3]);
                *p0 = w0; *p1 = w1; }
    }
};
struct EpiSwiglu {
    unsigned char* hid; int ldh, ncol; bool pad;
    __device__ __forceinline__ void operator()(const Acc& acc, const Unit& u, int wr, int wc, int fr, int fq) const {
        const int pl = u.pn % ncol; const int row0 = u.pm * BM + wr * 64 + fr, col0 = pl * 128 + wc * 32 + 8 * fq;
        const bool dopad = pad && (pl == ncol - 1);
#pragma unroll
        for (int ai = 0; ai < 2; ++ai)
#pragma unroll
            for (int m = 0; m < 4; ++m) { float v[8];
#pragma unroll
                for (int n = 0; n < 2; ++n)
#pragma unroll
                    for (int e = 0; e < 4; ++e) { const float a = acc[ai][0][m][n][e] * F8_DESCALE, b = acc[ai][1][m][n][e] * F8_DESCALE; v[4 * n + e] = a * sigm(a) * b * F8_MUL_H; }
                unsigned char* rp = hid + (size_t)(row0 + ai * HALF + m * 16) * ldh + col0;
                u32x2 w; w.x = pk4_fp8(v[0], v[1], v[2], v[3]); w.y = pk4_fp8(v[4], v[5], v[6], v[7]); *(u32x2*)rp = w;
                if (dopad) { unsigned z0; asm volatile("v_mov_b32 %0, 0" : "=v"(z0)); *(u32x2*)(rp + 128) = (u32x2){z0, z0}; } }
    }
};
struct EpiMoeOut {
    float* out; const int* rowtok; const float* rowgate; const int* segend;
    __device__ __forceinline__ void operator()(const Acc& acc, const Unit& u, int wr, int wc, int fr, int fq) const {
        const int row0 = u.pm * BM + wr * 64 + fr, col0 = (u.pn & 3) * 256 + wc * 32 + 8 * fq, lim = segend[u.pm];
#pragma unroll
        for (int ai = 0; ai < 2; ++ai)
#pragma unroll
            for (int m = 0; m < 4; ++m) { const int row = row0 + ai * HALF + m * 16;
                if (row < lim) { const int tok = rowtok[row]; const float gt = rowgate[row]; float* rowp = out + (size_t)tok * 1024 + col0;
#pragma unroll
                    for (int bj = 0; bj < 2; ++bj)
#pragma unroll
                        for (int n = 0; n < 2; ++n)
#pragma unroll
                            for (int e = 0; e < 4; ++e) __hip_atomic_fetch_add(rowp + bj * HALF + 4 * n + e, gt * acc[ai][bj][m][n][e], __ATOMIC_RELAXED, __HIP_MEMORY_SCOPE_AGENT);
                } }
    }
};
}

#define XB_TMO      128
#define XB_XCNT(j)  (256  + 64 * (j))
#define XB_XSUB(j)  (1280 + 64 * (j))
#define XB_XGEN(j)  (2304 + 64 * (j))
#define XB_TOP      3328
#define XB_TOPGEN   3392
#define XCD_BAR_WORDS 3456
#define XB_SPIN_CAP (1u << 18)
__device__ __forceinline__ unsigned xb_ld(unsigned* p)              { return __hip_atomic_load(p, __ATOMIC_RELAXED, __HIP_MEMORY_SCOPE_AGENT); }
__device__ __forceinline__ unsigned xb_add(unsigned* p, unsigned v) { return __hip_atomic_fetch_add(p, v, __ATOMIC_RELAXED, __HIP_MEMORY_SCOPE_AGENT); }
__device__ __forceinline__ unsigned xb_xcc_id() { return (unsigned)__builtin_amdgcn_s_getreg((3 << 11) | 20) & 0xFu; }
#define XB_SPIN(cond, bar) do { unsigned _sp = 0; while (cond) { __builtin_amdgcn_s_sleep(1); \
    if ((++_sp & 255u) == 0u) { if (xb_ld(&(bar)[XB_TMO])) break; if (_sp > XB_SPIN_CAP) { atomicAdd(&(bar)[XB_TMO], 1u); break; } } } } while (0)
struct XcdBarrier { unsigned* bar; unsigned x; volatile LAS unsigned* st; };
__device__ __forceinline__ XcdBarrier xcd_barrier_post(unsigned* bar, volatile LAS unsigned* st) {
    XcdBarrier b; b.bar = bar; b.x = xb_xcc_id(); b.st = st;
    if (threadIdx.x == 0) (void)xb_add(&bar[XB_XCNT(b.x)], 1u);
    return b;
}
__device__ __forceinline__ void xcd_barrier_complete(unsigned* bar, unsigned x, unsigned& nloc, unsigned& nx) {
    const unsigned G = gridDim.x * gridDim.y * gridDim.z;
    unsigned sum, cnt, mine, sp = 0u;
    for (;;) {
        sum = 0u; cnt = 0u; mine = 0u;
#pragma unroll
        for (unsigned j = 0; j < 16; ++j) { const unsigned c = xb_ld(&bar[XB_XCNT(j)]); sum += c; cnt += (c > 0u) ? 1u : 0u; mine = (j == x) ? c : mine; }
        if (sum == G) break;
        __builtin_amdgcn_s_sleep(1);
        if ((++sp & 255u) == 0u) { if (xb_ld(&bar[XB_TMO])) break; if (sp > XB_SPIN_CAP) { atomicAdd(&bar[XB_TMO], 1u); break; } }
    }
    nloc = mine > 0u ? mine : 1u; nx = cnt > 0u ? cnt : 1u;
}
__device__ __forceinline__ void xcd_barrier(const XcdBarrier& b, const int tid) {
    asm volatile("s_waitcnt vmcnt(0)" ::: "memory");
    __syncthreads();
    if (tid == 0) {
        unsigned* bar = b.bar;
        __builtin_amdgcn_s_waitcnt(0);
        unsigned nloc = b.st[0], nx = b.st[1];
        if (nloc == 0u) { xcd_barrier_complete(bar, b.x, nloc, nx); b.st[0] = nloc; b.st[1] = nx; }
        const unsigned old = xb_add(&bar[XB_XSUB(b.x)], 1u);
        const unsigned gen = old / nloc;
        if (old + 1u == (gen + 1u) * nloc) {
            __builtin_amdgcn_fence(__ATOMIC_RELEASE, "agent");
            asm volatile("s_waitcnt vmcnt(0)" ::: "memory");
            const unsigned og = xb_add(&bar[XB_TOP], 1u);
            const unsigned tg = og / nx;
            if (og + 1u == (tg + 1u) * nx) xb_add(&bar[XB_TOPGEN], 1u);
            else XB_SPIN(xb_ld(&bar[XB_TOPGEN]) == tg, bar);
            __builtin_amdgcn_fence(__ATOMIC_ACQUIRE, "agent");
            xb_add(&bar[XB_XGEN(b.x)], 1u);
            asm volatile("s_waitcnt vmcnt(0)" ::: "memory");
        } else {
            XB_SPIN(xb_ld(&bar[XB_XGEN(b.x)]) == gen, bar);
            __builtin_amdgcn_fence(__ATOMIC_ACQUIRE, "agent");
            asm volatile("s_waitcnt vmcnt(0)" ::: "memory");
        }
    }
    __syncthreads();
}

constexpr size_t MiB = 1u << 20;
constexpr size_t WS_CTL = 0, CTL_ZERO_BYTES = 1 * MiB;
constexpr int CW_BAR = 4096;
constexpr int CW_QUEUE = 20480;
constexpr int CW_MOE = 16384;
constexpr size_t WS_EIDX = 1 * MiB, WS_GATE = WS_EIDX + 256 * 1024, WS_ROWTOK = WS_EIDX + 512 * 1024, WS_ROWGATE = 2 * MiB, WS_TEXP = 2 * MiB + 512 * 1024, WS_SEGEND = WS_TEXP + 4096, WS_NT = WS_TEXP + 8192;
constexpr size_t WS_SLOTOF = 2 * MiB + 768 * 1024;
constexpr size_t WS_BON = 3 * MiB, WS_COS = 4 * MiB, WS_SIN = 6 * MiB;
constexpr size_t WS_WIN = 8 * MiB, WS_WLORA = 15 * MiB, WS_WB = 16 * MiB, WS_WG = 18 * MiB, WS_WOUT = 26 * MiB, WS_W13 = 28 * MiB  , WS_W2D = 50 * MiB, WS_W2M = 50 * MiB, WS_H8 = 72 * MiB  ;
constexpr size_t WS_XB = 104 * MiB  , WS_Y = 168 * MiB, WS_BIG = 232 * MiB;
constexpr size_t WS_RW = WS_BIG, WS_WDEC = WS_BIG, WS_AG = WS_BIG + 32 * MiB, WS_SB = WS_BIG + 64 * MiB, WS_RET = WS_BIG + 112 * MiB, WS_CV = WS_BIG + 176 * MiB, WS_Y0 = WS_CV;
constexpr size_t WS_RKVS = WS_BIG + 208 * MiB, WS_ALORA = WS_BIG + 256 * MiB, WS_RHAT = WS_ALORA, WS_KV = WS_BIG + 272 * MiB, WS_SST = WS_WDEC  , WS_PQ = WS_BIG + 304 * MiB  , WS_END = WS_BIG + 368 * MiB;
constexpr size_t WS_BALL = WS_BIG, WS_MERGED = WS_BIG + 256 * MiB, WS_HID = WS_BIG, WS_XS = WS_BIG, WS_YS = WS_XS, WS_HIDM = WS_BIG + 132 * MiB;
static_assert(WS_HIDM + (size_t)MPAD * DFE * 2 <= WS_END && WS_MERGED + (size_t)T * D * 2 <= WS_END && WS_W2M + (size_t)NEXP * D * DFE * 2 <= WS_H8, "ws map");
static_assert(WS_W13 + (size_t)NEXP * 2 * DFE * D <= WS_W2M && WS_W13 + (size_t)2 * DFF * D <= WS_W2D && WS_W2M + (size_t)NEXP * D * DFE * 2 <= WS_H8 && WS_H8 + (size_t)T * D <= WS_XB, "ws map weights");

constexpr int LDS_BYTES = 147456, RING_BYTES = 131072, MISC_OFF = RING_BYTES + 320;

struct Args { const float* in[32]; float* out; unsigned char* ws; int ph_lo, ph_hi; };
#define CAS __attribute__((address_space(4)))
struct Ctx {
    LAS unsigned char* lds; unsigned char* ws; float* out; const float* const CAS* in;
    int tid, lane, wave, G, bid;
};
__device__ __forceinline__ const CAS Args* ka_ptr() { const CAS Args* p = (const CAS Args*)__builtin_amdgcn_kernarg_segment_ptr(); asm volatile("" : "+s"(p)); return p; }
extern __shared__ __attribute__((aligned(16))) unsigned char lds_raw[];
__device__ __forceinline__ Ctx make_ctx(int wv) {
    const CAS Args* ka = ka_ptr();
    Ctx C; C.lds = (LAS unsigned char*)lds_raw; C.ws = ka->ws; C.out = ka->out; C.in = ka->in;
    int g_ = gridDim.x, b_ = blockIdx.x, w_ = wv; asm volatile("" : "+s"(g_), "+s"(b_), "+s"(w_));
    int ln_; asm volatile("v_mbcnt_lo_u32_b32 %0, -1, 0\n\tv_mbcnt_hi_u32_b32 %0, -1, %0" : "=v"(ln_));
    C.lane = ln_; C.wave = w_; C.tid = w_ * 64 + ln_; C.G = g_; C.bid = b_;
    return C;
}
enum { I_X = 0, I_NORM_MIX, I_W_IN, I_RW_MU, I_RW_W0, I_RW_W2, I_RW_A0, I_RW_A2, I_RW_G2, I_RW_KK, I_RW_KA, I_RW_RK, I_RW_LNW, I_RW_LNB, I_SB_QN, I_SB_KN, I_RET_GN,
       I_CONV_DW, I_CONV_B, I_CONV_LNW, I_CONV_LNB, I_W_GATE, I_W_BRANCH, I_W_OUT, I_NORM_FFN, I_FFN_W1, I_FFN_W3, I_FFN_W2, I_ROUTER, I_MOE_W1, I_MOE_W3, I_MOE_W2 };

__device__ __forceinline__ int q_next(const Ctx& C, unsigned* head) {
    LAS int* slot = (LAS int*)(C.lds + MISC_OFF + 64);
    __syncthreads();
    if (C.tid == 0) *slot = (int)__hip_atomic_fetch_add(head, 1u, __ATOMIC_RELAXED, __HIP_MEMORY_SCOPE_AGENT);
    __syncthreads();
    return *slot;
}
__device__ __forceinline__ void ph_prologue_(const Ctx& C) {
    const size_t gid = (size_t)C.bid * NTHR + C.tid, gsz = (size_t)C.G * NTHR;
    float* cs = (float*)(C.ws + WS_COS); float* sn = (float*)(C.ws + WS_SIN);
    for (size_t i = gid; i < (size_t)SEQ * 32; i += gsz) {
        const int pos = (int)(i >> 5), j = (int)(i & 31);
        const float inv = (float)pow(10000.0, -(double)(2 * j) / 64.0);
        const float ang = (float)pos * inv;
        cs[i] = (float)cos((double)ang); sn[i] = (float)sin((double)ang);
    }
}

__device__ __forceinline__ int dest_row(int mode, int roff, int which, int n) {
    if (mode == 0) return roff + n;
    if (mode == 1) { const int pn = n >> 6, oc = n & 63; return 256 * pn + 128 * (roff >> 1) + 32 * (oc >> 4) + 8 * ((oc >> 2) & 3) + 4 * (roff & 1) + (oc & 3); }
    return roff + 256 * (n >> 7) + 128 * which + (n & 127);
}
__device__ __forceinline__ void xpose_item(const float* W, int K, int N, bf16* WT, int mode, int roff, int which, LAS float* scr, int item, int lane) {
    const int nblk = N / 32, kb = item / nblk, nb = item % nblk, k0 = 64 * kb, n0 = 32 * nb;
#pragma unroll
    for (int i = 0; i < 8; ++i) { const int kk = (lane >> 3) + 8 * i, c4 = (lane & 7) * 4; const f32x4 v = *(const f32x4*)(W + (size_t)(k0 + kk) * N + n0 + c4);
        scr[kk * 33 + c4] = v.x; scr[kk * 33 + c4 + 1] = v.y; scr[kk * 33 + c4 + 2] = v.z; scr[kk * 33 + c4 + 3] = v.w; }
    asm volatile("s_waitcnt lgkmcnt(0)" ::: "memory");
    const int c = lane & 7;
#pragma unroll
    for (int j = 0; j < 4; ++j) { const int n = (lane >> 3) + 8 * j; const LAS float* s = scr + (8 * c) * 33 + n;
        u32x4 o; o.x = cvt_pk_bf16(s[0 * 33], s[1 * 33]); o.y = cvt_pk_bf16(s[2 * 33], s[3 * 33]); o.z = cvt_pk_bf16(s[4 * 33], s[5 * 33]); o.w = cvt_pk_bf16(s[6 * 33], s[7 * 33]);
        *(u32x4*)(WT + (size_t)dest_row(mode, roff, which, n0 + n) * K + k0 + 8 * c) = o; }
    asm volatile("s_waitcnt lgkmcnt(0)" ::: "memory");
}
__device__ __forceinline__ void xpose_item8(const float* W, int K, int N, unsigned char* WT, int mode, int roff, int which, LAS float* scr, int item, int lane, int ldk = 0) {
    if (ldk == 0) ldk = K;
    const int nblk = N / 32, kb = item / nblk, nb = item % nblk, k0 = 64 * kb, n0 = 32 * nb;
#pragma unroll
    for (int i = 0; i < 8; ++i) { const int kk = (lane >> 3) + 8 * i, c4 = (lane & 7) * 4; const f32x4 v = *(const f32x4*)(W + (size_t)(k0 + kk) * N + n0 + c4);
        scr[kk * 33 + c4] = v.x; scr[kk * 33 + c4 + 1] = v.y; scr[kk * 33 + c4 + 2] = v.z; scr[kk * 33 + c4 + 3] = v.w; }
    asm volatile("s_waitcnt lgkmcnt(0)" ::: "memory");
    const int c = lane & 3;
#pragma unroll
    for (int j = 0; j < 2; ++j) { const int n = (lane >> 2) + 16 * j; const LAS float* sp = scr + (16 * c) * 33 + n;
        u32x4 o;
        o.x = pk4_fp8(sp[0 * 33] * F8_MUL_W, sp[1 * 33] * F8_MUL_W, sp[2 * 33] * F8_MUL_W, sp[3 * 33] * F8_MUL_W);
        o.y = pk4_fp8(sp[4 * 33] * F8_MUL_W, sp[5 * 33] * F8_MUL_W, sp[6 * 33] * F8_MUL_W, sp[7 * 33] * F8_MUL_W);
        o.z = pk4_fp8(sp[8 * 33] * F8_MUL_W, sp[9 * 33] * F8_MUL_W, sp[10 * 33] * F8_MUL_W, sp[11 * 33] * F8_MUL_W);
        o.w = pk4_fp8(sp[12 * 33] * F8_MUL_W, sp[13 * 33] * F8_MUL_W, sp[14 * 33] * F8_MUL_W, sp[15 * 33] * F8_MUL_W);
        *(u32x4*)(WT + (size_t)dest_row(mode, roff, which, n0 + n) * ldk + k0 + 16 * c) = o; }
    asm volatile("s_waitcnt lgkmcnt(0)" ::: "memory");
}
__device__ __forceinline__ void ph_weights_(const Ctx& C, int l, int part, int first_wg, int nwg, unsigned* qhead = nullptr) {
    LAS float* scr = (LAS float*)(C.lds + C.wave * 16384);
    const int gw = (C.bid - first_wg) * NWAVES + C.wave, NGW = nwg * NWAVES, lane = C.lane;
    unsigned char* ws = C.ws;
    const bool moe = (l & 1);
    const int l2 = l >> 1;
    constexpr int IT_IN = (D / 64) * (NIN / 32), IT_B = (256 / 64) * (D / 32), IT_G = (D / 64) * (D / 32), IT_O = IT_G;
    constexpr int IT_F1 = (D / 64) * (DFF / 32), IT_F2 = (DFF / 64) * (D / 32), IT_M1 = (D / 64) * (DFE / 32), IT_M2 = (DFE / 64) * (D / 32);
    const int n_fixed = IT_IN + 4 * IT_B + 4 * IT_G + IT_O;
    if (part == 1) {
        if (C.bid < first_wg) return;
        const int n1 = moe ? NEXP * IT_M2 : (2 * IT_F1 + IT_F2);
        for (int it = qhead ? q_next(C, qhead) * NWAVES + C.wave : gw; qhead ? (it - C.wave < n1) : (it < n1); it = qhead ? q_next(C, qhead) * NWAVES + C.wave : it + NGW) {
            if (it >= n1) continue;
            int r = it;
            if (!moe) {
                if (r < IT_F1) { xpose_item8(C.in[I_FFN_W1] + (size_t)l2 * D * DFF, D, DFF, ws + WS_W13, 2, 0, 0, scr, r, lane); continue; } r -= IT_F1;
                if (r < IT_F1) { xpose_item8(C.in[I_FFN_W3] + (size_t)l2 * D * DFF, D, DFF, ws + WS_W13, 2, 0, 1, scr, r, lane); continue; } r -= IT_F1;
                xpose_item8(C.in[I_FFN_W2] + (size_t)l2 * DFF * D, DFF, D, ws + WS_W2D, 0, 0, 0, scr, r, lane);
            } else { const int e = r / IT_M2; r -= e * IT_M2;
                xpose_item8(C.in[I_MOE_W2] + ((size_t)l2 * NEXP + e) * DFE * D, DFE, D, ws + WS_W2M, 0, e * D, 0, scr, r, lane, DFE_PAD); }
        }
        if (moe) {
            for (int i = (C.bid - first_wg) * NTHR + C.tid; i < NEXP * D * ((DFE_PAD - DFE) / 16); i += nwg * NTHR) { const int row = i >> 3, c16 = i & 7;
                unsigned z0; asm volatile("v_mov_b32 %0, 0" : "=v"(z0)); *(u32x4*)(ws + WS_W2M + (size_t)row * DFE_PAD + DFE + 16 * c16) = (u32x4){z0, z0, z0, z0}; } }
        return;
    }
    const int n_ffn = moe ? (NEXP * 2 * IT_M1) : 0;
    for (int it = gw; it < n_fixed + n_ffn; it += NGW) {
        int r = it;
        if (r < IT_IN) { xpose_item(C.in[I_W_IN] + (size_t)l * D * NIN, D, NIN, (bf16*)(ws + WS_WIN), 0, 0, 0, scr, r, lane); continue; } r -= IT_IN;
        if (r < 4 * IT_B) { const int i = r / IT_B; xpose_item(C.in[I_W_BRANCH] + ((size_t)l * 4 + i) * 256 * D, 256, D, (bf16*)(ws + WS_WB), 0, 1024 * i, 0, scr, r % IT_B, lane); continue; } r -= 4 * IT_B;
        if (r < 4 * IT_G) { const int i = r / IT_G; xpose_item8(C.in[I_W_GATE] + ((size_t)l * 4 + i) * D * D, D, D, ws + WS_WG, 1, i, 0, scr, r % IT_G, lane); continue; } r -= 4 * IT_G;
        if (r < IT_O) { xpose_item(C.in[I_W_OUT] + (size_t)l * D * D, D, D, (bf16*)(ws + WS_WOUT), 0, 0, 0, scr, r, lane); continue; } r -= IT_O;
        { const int per = 2 * IT_M1, e = r / per; r -= e * per;
          if (r < IT_M1) { xpose_item8(C.in[I_MOE_W1] + ((size_t)l2 * NEXP + e) * D * DFE, D, DFE, ws + WS_W13, 2, e * 2 * DFE, 0, scr, r, lane); continue; } r -= IT_M1;
          xpose_item8(C.in[I_MOE_W3] + ((size_t)l2 * NEXP + e) * D * DFE, D, DFE, ws + WS_W13, 2, e * 2 * DFE, 1, scr, r, lane); }
    }
    bf16* WL = (bf16*)(ws + WS_WLORA);
    const float* w2 = C.in[I_RW_W2] + (size_t)l * 64 * 256; const float* a2 = C.in[I_RW_A2] + (size_t)l * 64 * 256; const float* g2 = C.in[I_RW_G2] + (size_t)l * 128 * 256;
    for (int i = C.bid * NTHR + C.tid; i < 768 * 256; i += C.G * NTHR) {
        const int n = i >> 8, k = i & 255; float v = 0.f;
        if (n < 256) { if (k < 64) v = w2[k * 256 + n]; }
        else if (n < 512) { if (k >= 64 && k < 128) v = a2[(k - 64) * 256 + (n - 256)]; }
        else { if (k >= 128) v = g2[(k - 128) * 256 + (n - 512)]; }
        WL[i] = f2bf(v);
    }
}

__device__ __forceinline__ void ph_norm_(const Ctx& C, const float* gain, bool route, const float* router, int moe_idx, bool combine = false, const float* src = nullptr, bool want_bf16 = true) {
    const int gw = C.bid * NWAVES + C.wave, NGW = C.G * NWAVES, lane = C.lane;
    bf16* H = (bf16*)C.out; bf16* XB = (bf16*)(C.ws + WS_XB);
    f32x4 g[4];
#pragma unroll
    for (int j = 0; j < 4; ++j) g[j] = *(const f32x4*)(gain + 8 * lane + 512 * (j >> 1) + 4 * (j & 1));
    LAS unsigned* lcnt = (LAS unsigned*)(C.lds);
    if (route) { if (C.tid < 8) lcnt[C.tid] = 0u; __syncthreads(); }
    int* eidx = (int*)(C.ws + WS_EIDX); float* gate = (float*)(C.ws + WS_GATE);
    constexpr int NR = 2;
    for (int mb = gw; mb < T; mb += NR * NGW) {
        f32x4 vv[NR][4]; u32x4 ya[NR][2], yb[NR][2]; float g0v[NR], g1v[NR];
#pragma unroll
        for (int r = 0; r < NR; ++r) { const int m = mb + r * NGW; if (m < T) {
            if (src) { const f32x4* xr = (const f32x4*)(src + (size_t)m * D + 8 * lane);
#pragma unroll
                for (int j = 0; j < 4; ++j) vv[r][j] = xr[128 * (j >> 1) + (j & 1)]; }
            else { const u32x4* xb = (const u32x4*)(XB + (size_t)m * D) + lane;
#pragma unroll
                for (int j = 0; j < 2; ++j) { const u32x4 t = xb[64 * j]; vv[r][2 * j] = f32x4{bflo(t.x), bfhi(t.x), bflo(t.y), bfhi(t.y)}; vv[r][2 * j + 1] = f32x4{bflo(t.z), bfhi(t.z), bflo(t.w), bfhi(t.w)}; } }
            if (combine) { const int* slotof = (const int*)(C.ws + WS_SLOTOF); const float* gt = (const float*)(C.ws + WS_GATE); const bf16* YS = (const bf16*)(C.ws + WS_YS);
                const int s0 = slotof[2 * m], s1 = slotof[2 * m + 1]; g0v[r] = gt[2 * m]; g1v[r] = gt[2 * m + 1];
                const u32x4* y0 = (const u32x4*)(YS + (size_t)s0 * D) + lane; const u32x4* y1 = (const u32x4*)(YS + (size_t)s1 * D) + lane;
#pragma unroll
                for (int j = 0; j < 2; ++j) { ya[r][j] = y0[64 * j]; yb[r][j] = y1[64 * j]; } } } }
#pragma unroll
        for (int r = 0; r < NR; ++r) { const int m = mb + r * NGW; if (m < T) {
        f32x4 v[4]; float s = 0.f;
#pragma unroll
        for (int j = 0; j < 4; ++j) v[j] = vv[r][j];
        if (combine) {
            const float g0 = g0v[r], g1 = g1v[r];
#pragma unroll
            for (int j = 0; j < 2; ++j) { const u32x4 a = ya[r][j], b = yb[r][j];
                v[2 * j].x += g0 * bflo(a.x) + g1 * bflo(b.x); v[2 * j].y += g0 * bfhi(a.x) + g1 * bfhi(b.x); v[2 * j].z += g0 * bflo(a.y) + g1 * bflo(b.y); v[2 * j].w += g0 * bfhi(a.y) + g1 * bfhi(b.y);
                v[2 * j + 1].x += g0 * bflo(a.z) + g1 * bflo(b.z); v[2 * j + 1].y += g0 * bfhi(a.z) + g1 * bfhi(b.z); v[2 * j + 1].z += g0 * bflo(a.w) + g1 * bflo(b.w); v[2 * j + 1].w += g0 * bfhi(a.w) + g1 * bfhi(b.w); }
        }
        if (combine || src) { u32x4* xo = (u32x4*)(XB + (size_t)m * D) + lane;
#pragma unroll
            for (int j = 0; j < 2; ++j) { u32x4 t; t.x = cvt_pk_bf16(v[2 * j].x, v[2 * j].y); t.y = cvt_pk_bf16(v[2 * j].z, v[2 * j].w); t.z = cvt_pk_bf16(v[2 * j + 1].x, v[2 * j + 1].y); t.w = cvt_pk_bf16(v[2 * j + 1].z, v[2 * j + 1].w); xo[64 * j] = t; } }
#pragma unroll
        for (int j = 0; j < 4; ++j) s += (v[j].x * v[j].x + v[j].y * v[j].y) + (v[j].z * v[j].z + v[j].w * v[j].w);
        const float rs = 1.0f / sqrtf(wave_sum(s, C.lane) * (1.f / D) + 1e-6f);
#pragma unroll
        for (int j = 0; j < 4; ++j) v[j] = v[j] * rs * g[j];
#pragma unroll
        for (int j = 0; j < 2; ++j) {
            if (want_bf16) { u32x4 t; t.x = cvt_pk_bf16(v[2 * j].x, v[2 * j].y); t.y = cvt_pk_bf16(v[2 * j].z, v[2 * j].w); t.z = cvt_pk_bf16(v[2 * j + 1].x, v[2 * j + 1].y); t.w = cvt_pk_bf16(v[2 * j + 1].z, v[2 * j + 1].w);
                ((u32x4*)(H + (size_t)m * D) + lane)[64 * j] = t; }
            u32x2 q; q.x = pk4_fp8(v[2 * j].x * F8_MUL_X, v[2 * j].y * F8_MUL_X, v[2 * j].z * F8_MUL_X, v[2 * j].w * F8_MUL_X); q.y = pk4_fp8(v[2 * j + 1].x * F8_MUL_X, v[2 * j + 1].y * F8_MUL_X, v[2 * j + 1].z * F8_MUL_X, v[2 * j + 1].w * F8_MUL_X);
            ((u32x2*)(C.ws + WS_H8 + (size_t)m * D) + lane)[64 * j] = q; }
        if (route) {
            float lg[8];
#pragma unroll
            for (int e = 0; e < 8; ++e) lg[e] = 0.f;
#pragma unroll
            for (int j = 0; j < 4; ++j)
#pragma unroll
                for (int q = 0; q < 4; ++q) { const int k = 8 * lane + 512 * (j >> 1) + 4 * (j & 1) + q; const f32x4 r0 = *(const f32x4*)(router + (size_t)k * 8), r1 = *(const f32x4*)(router + (size_t)k * 8 + 4); const float hv = v[j][q];
                    lg[0] += hv * r0.x; lg[1] += hv * r0.y; lg[2] += hv * r0.z; lg[3] += hv * r0.w; lg[4] += hv * r1.x; lg[5] += hv * r1.y; lg[6] += hv * r1.z; lg[7] += hv * r1.w; }
#pragma unroll
            for (int e = 0; e < 8; ++e) lg[e] = wave_sum(lg[e], C.lane);
            int e0 = 0; float b0 = lg[0];
#pragma unroll
            for (int e = 1; e < 8; ++e) if (lg[e] > b0) { b0 = lg[e]; e0 = e; }
            int e1 = -1; float b1 = -3.0e38f;
#pragma unroll
            for (int e = 0; e < 8; ++e) if (e != e0 && lg[e] > b1) { b1 = lg[e]; e1 = e; }
            const float p1 = __expf(b1 - b0), inv = 1.f / (1.f + p1);
            if (lane == 0) { eidx[2 * m] = e0; eidx[2 * m + 1] = e1; gate[2 * m] = inv; gate[2 * m + 1] = p1 * inv; atomicAdd((unsigned*)&lcnt[e0], 1u); atomicAdd((unsigned*)&lcnt[e1], 1u); }
        }
        } }
    }
    if (route) { __syncthreads(); if (C.tid < 8) { unsigned* cw = (unsigned*)(C.ws + WS_CTL) + CW_MOE + moe_idx * 64; atomicAdd(&cw[C.tid], lcnt[C.tid]); } }
}

__device__ __forceinline__ void ph_rw_prep_(const Ctx& C, int l) {
    const bf16* RW = (const bf16*)(C.ws + WS_RW); bf16* RKVS = (bf16*)(C.ws + WS_RKVS); bf16* AL = (bf16*)(C.ws + WS_ALORA);
    const float* mu = C.in[I_RW_MU] + (size_t)l * 1024;
    const size_t gid = (size_t)C.bid * NTHR + C.tid, gsz = (size_t)C.G * NTHR;
    constexpr int NI = 4;
    for (size_t it0 = gid; it0 < (size_t)T * 128; it0 += NI * gsz) {
        u32x4 cuv[NI], pvv[NI];
#pragma unroll
        for (int r = 0; r < NI; ++r) { const size_t it = it0 + r * gsz; cuv[r] = (u32x4){0u, 0u, 0u, 0u}; pvv[r] = cuv[r];
            if (it < (size_t)T * 128) { const int m = (int)(it >> 7), c8 = (int)(it & 127) * 8, t = m & (SEQ - 1);
                cuv[r] = *(const u32x4*)(RW + (size_t)m * 1024 + c8); if (t) pvv[r] = *(const u32x4*)(RW + (size_t)(m - 1) * 1024 + c8); } }
#pragma unroll
        for (int r = 0; r < NI; ++r) { const size_t it = it0 + r * gsz; if (it < (size_t)T * 128) {
        const int m = (int)(it >> 7), c8 = (int)(it & 127) * 8;
        float a[8], b[8]; unpack8(cuv[r], a); unpack8(pvv[r], b);
        const f32x4 m0 = *(const f32x4*)(mu + c8), m1 = *(const f32x4*)(mu + c8 + 4);
        const float mm[8] = {m0.x, m0.y, m0.z, m0.w, m1.x, m1.y, m1.z, m1.w};
#pragma unroll
        for (int e = 0; e < 8; ++e) a[e] = a[e] + (b[e] - a[e]) * mm[e];
        if (c8 < 768) { *(u32x4*)(RKVS + (size_t)m * 768 + c8) = pack8(a); }
        else {
            if (c8 < 832) {
#pragma unroll
                for (int e = 0; e < 8; ++e) a[e] = 1.f - 2.f * __builtin_amdgcn_rcpf(1.f + __builtin_amdgcn_exp2f(2.f * LOG2E * a[e]));
            } else if (c8 >= 896) {
#pragma unroll
                for (int e = 0; e < 8; ++e) a[e] = sigm(a[e]);
            }
            *(u32x4*)(AL + (size_t)m * 256 + (c8 - 768)) = pack8(a);
        } } }
    }
}

__device__ __forceinline__ void ph_sb_prep_(const Ctx& C, int l) {
    bf16* SB = (bf16*)(C.ws + WS_SB);
    const int gw = C.bid * NWAVES + C.wave, NGW = C.G * NWAVES, lane = C.lane;
    const bool isk = lane >= 32; const int d0 = (lane & 7) * 8;
    const float* gn = (isk ? C.in[I_SB_KN] : C.in[I_SB_QN]) + (size_t)l * 64 + d0;
    float gg[8];
#pragma unroll
    for (int e = 0; e < 8; ++e) gg[e] = gn[e] * (isk ? 1.f : 0.125f * LOG2E);
    constexpr int NR = 4;
    for (int mb = gw; mb < T; mb += NR * NGW) {
        u32x4 uu[NR];
#pragma unroll
        for (int r = 0; r < NR; ++r) { const int m = mb + r * NGW; uu[r] = (u32x4){0u, 0u, 0u, 0u}; if (m < T) uu[r] = *(const u32x4*)(SB + (size_t)m * 768 + lane * 8); }
#pragma unroll
        for (int r = 0; r < NR; ++r) { const int m = mb + r * NGW; if (m < T) {
            bf16* p = SB + (size_t)m * 768 + lane * 8;
            float a[8]; unpack8(uu[r], a);
            float ss = 0.f;
#pragma unroll
            for (int e = 0; e < 8; ++e) ss += a[e] * a[e];
            ss += shx(ss, 1, lane); ss += shx(ss, 2, lane); ss += shx(ss, 4, lane);
            const float rs = 1.0f / sqrtf(ss * (1.f / 64.f) + 1e-6f);
#pragma unroll
            for (int e = 0; e < 8; ++e) a[e] = a[e] * rs * gg[e];
            *(u32x4*)p = pack8(a); } }
    }
}

__device__ __forceinline__ void ph_conv_(const Ctx& C, int l) {
    const bf16* CV = (const bf16*)(C.ws + WS_CV); bf16* Y = (bf16*)(C.ws + WS_Y);
    LAS float* U = (LAS float*)(C.lds); LAS float* OC = (LAS float*)(C.lds + 65536);
    const int tid = C.tid, c = tid & 255, half = tid >> 8;
    const float* dw = C.in[I_CONV_DW] + (size_t)l * 31 * 256; const float db = C.in[I_CONV_B][l * 256 + c];
    float dwr[31];
#pragma unroll
    for (int j = 0; j < 31; ++j) dwr[j] = dw[j * 256 + c];
    const float* lnw = C.in[I_CONV_LNW] + (size_t)l * 256; const float* lnb = C.in[I_CONV_LNB] + (size_t)l * 256;
    for (int u = C.bid; u < T / 32; u += C.G) {
        const int m0 = u * 32, t0 = m0 & (SEQ - 1);
        for (int it = tid; it < 62 * 32; it += NTHR) {
            const int r = it >> 5, c8 = (it & 31) * 8, tt = t0 - 30 + r; float a[8], b[8];
            if (tt >= 0) { const size_t mm = (size_t)(m0 - 30 + r); unpack8(*(const u32x4*)(CV + mm * 512 + c8), a); unpack8(*(const u32x4*)(CV + mm * 512 + 256 + c8), b);
#pragma unroll
                for (int e = 0; e < 8; ++e) a[e] = a[e] * sigm(b[e]); }
            else {
#pragma unroll
                for (int e = 0; e < 8; ++e) a[e] = 0.f; }
#pragma unroll
            for (int e = 0; e < 8; ++e) U[r * 256 + c8 + e] = a[e];
        }
        __syncthreads();
        { float win[46];
#pragma unroll
          for (int i = 0; i < 46; ++i) win[i] = U[(half * 16 + i) * 256 + c];
#pragma unroll
          for (int tt = 0; tt < 16; ++tt) { float acc = db;
#pragma unroll
              for (int j = 0; j < 31; ++j) acc += dwr[j] * win[tt + j];
              OC[(half * 16 + tt) * 256 + c] = acc; } }
        __syncthreads();
#pragma unroll 1
        for (int q = 0; q < 4; ++q) { const int tl = C.wave * 4 + q; float v[4]; float s = 0.f;
#pragma unroll
            for (int i = 0; i < 4; ++i) { v[i] = OC[tl * 256 + C.lane + 64 * i]; s += v[i]; }
            const float mean = wave_sum(s, C.lane) * (1.f / 256.f); float s2 = 0.f;
#pragma unroll
            for (int i = 0; i < 4; ++i) { v[i] -= mean; s2 += v[i] * v[i]; }
            const float rstd = 1.0f / sqrtf(wave_sum(s2, C.lane) * (1.f / 256.f) + 1e-5f);
#pragma unroll
            for (int i = 0; i < 4; ++i) { const int cc = C.lane + 64 * i; const float y = v[i] * rstd * lnw[cc] + lnb[cc]; Y[(size_t)(m0 + tl) * 1024 + 768 + cc] = f2bf(y * sigm(y)); } }
        __syncthreads();
    }
}

__device__ __forceinline__ float ret_log2gamma(int h) { return log2f(1.0f - exp2f(-5.0f - (float)h)); }
__device__ __forceinline__ void ret_load_rot(const Ctx& C, const bf16* RET, int m0, int coff, float scale, LAS float* dst) {
    const int s = C.tid >> 3, d0 = (C.tid & 7) * 4;
    const float* cs = (const float*)(C.ws + WS_COS); const float* sn = (const float*)(C.ws + WS_SIN);
    const int pos = (m0 + s) & (SEQ - 1);
    const u32x2 a = *(const u32x2*)(RET + (size_t)(m0 + s) * 1024 + coff + d0), b = *(const u32x2*)(RET + (size_t)(m0 + s) * 1024 + coff + 32 + d0);
    const float x1[4] = {bflo(a.x), bfhi(a.x), bflo(a.y), bfhi(a.y)}, x2[4] = {bflo(b.x), bfhi(b.x), bflo(b.y), bfhi(b.y)};
    const f32x4 cv = *(const f32x4*)(cs + (size_t)pos * 32 + d0), sv = *(const f32x4*)(sn + (size_t)pos * 32 + d0);
#pragma unroll
    for (int e = 0; e < 4; ++e) { dst[s * 65 + d0 + e] = (x1[e] * cv[e] - x2[e] * sv[e]) * scale; dst[s * 65 + 32 + d0 + e] = (x1[e] * sv[e] + x2[e] * cv[e]) * scale; }
}
__device__ __forceinline__ void ph_ret_kv_(const Ctx& C) {
    const bf16* RET = (const bf16*)(C.ws + WS_RET); float* KV = (float*)(C.ws + WS_KV);
    LAS float* KD = (LAS float*)(C.lds); LAS float* VV = (LAS float*)(C.lds + 32768);
    const int tid = C.tid;
    for (int u = C.bid; u < 2048; u += C.G) {
        const int bh = u >> 8, ch = u & 255, b = bh >> 2, h = bh & 3, m0 = b * SEQ + ch * 64;
        const float lg = ret_log2gamma(h);
        ret_load_rot(C, RET, m0, 256 + h * 64, 0.125f, KD);
        { const int s = tid >> 3, e0 = (tid & 7) * 8; float a[8]; unpack8(*(const u32x4*)(RET + (size_t)(m0 + s) * 1024 + 512 + h * 64 + e0), a);
          const float dec = exp2f(lg * (float)(63 - s));
#pragma unroll
          for (int e = 0; e < 8; ++e) VV[s * 64 + e0 + e] = a[e] * dec; }
        __syncthreads();
        const int d = tid >> 3, e0 = (tid & 7) * 8; float acc[8];
#pragma unroll
        for (int e = 0; e < 8; ++e) acc[e] = 0.f;
#pragma unroll 4
        for (int s = 0; s < 64; ++s) { const float kd = KD[s * 65 + d]; const f32x4 v0 = *(const LAS f32x4*)(VV + s * 64 + e0), v1 = *(const LAS f32x4*)(VV + s * 64 + e0 + 4);
            acc[0] += kd * v0.x; acc[1] += kd * v0.y; acc[2] += kd * v0.z; acc[3] += kd * v0.w; acc[4] += kd * v1.x; acc[5] += kd * v1.y; acc[6] += kd * v1.z; acc[7] += kd * v1.w; }
        float* o = KV + (size_t)u * 4096 + d * 64 + e0;
        *(f32x4*)o = (f32x4){acc[0], acc[1], acc[2], acc[3]}; *(f32x4*)(o + 4) = (f32x4){acc[4], acc[5], acc[6], acc[7]};
        __syncthreads();
    }
}
__device__ __forceinline__ void ph_ret_scan_(const Ctx& C) {
    float* KV = (float*)(C.ws + WS_KV);
    const int wg0 = (C.G >= 256) ? 128 : 0, nw = C.G - wg0;
    for (int i = (C.bid - wg0) * NTHR + C.tid; i < 8 * 4096 && C.bid >= wg0; i += nw * NTHR) {
        const int bh = i >> 12, el = i & 4095, h = bh & 3;
        const float cd = exp2f(ret_log2gamma(h) * 64.f);
        float* p = KV + (size_t)bh * 256 * 4096 + el; float S = 0.f;
#pragma unroll 1
        for (int c = 0; c < 256; c += 32) { float kv[32];
#pragma unroll
            for (int q = 0; q < 32; ++q) kv[q] = p[(size_t)(c + q) * 4096];
#pragma unroll
            for (int q = 0; q < 32; ++q) { p[(size_t)(c + q) * 4096] = S; S = S * cd + kv[q]; } }
    }
}
__device__ __forceinline__ void ph_ret_out_(const Ctx& C, int l, int first_wg, int nwg) {
    const bf16* RET = (const bf16*)(C.ws + WS_RET); const float* KV = (const float*)(C.ws + WS_KV); bf16* Y = (bf16*)(C.ws + WS_Y);
    LAS float* Q = (LAS float*)(C.lds); LAS float* Kk = (LAS float*)(C.lds + 16640); LAS float* VV = (LAS float*)(C.lds + 33280); LAS float* SS = (LAS float*)(C.lds + 49664); LAS float* SC = (LAS float*)(C.lds + 66048);
    const int tid = C.tid; const float* gn = C.in[I_RET_GN] + (size_t)l * 256;
    for (int u = C.bid - first_wg; u < 2048; u += nwg) {
        const int bh = u >> 8, ch = u & 255, b = bh >> 2, h = bh & 3, m0 = b * SEQ + ch * 64;
        const float lg = ret_log2gamma(h);
        ret_load_rot(C, RET, m0, h * 64, 1.0f, Q);
        ret_load_rot(C, RET, m0, 256 + h * 64, 0.125f, Kk);
        { const int s = tid >> 3, e0 = (tid & 7) * 8; float a[8]; unpack8(*(const u32x4*)(RET + (size_t)(m0 + s) * 1024 + 512 + h * 64 + e0), a);
#pragma unroll
          for (int e = 0; e < 8; ++e) VV[s * 64 + e0 + e] = a[e];
          const float* sp = KV + (size_t)u * 4096 + s * 64 + e0; const f32x4 s0 = *(const f32x4*)sp, s1 = *(const f32x4*)(sp + 4);
          *(LAS f32x4*)(SS + s * 64 + e0) = s0; *(LAS f32x4*)(SS + s * 64 + e0 + 4) = s1; }
        __syncthreads();
        const int t = tid >> 3, g8 = tid & 7;
        { float sc[8];
#pragma unroll
          for (int i = 0; i < 8; ++i) sc[i] = 0.f;
#pragma unroll 4
          for (int d = 0; d < 64; ++d) { const float qv = Q[t * 65 + d];
#pragma unroll
              for (int i = 0; i < 8; ++i) sc[i] += qv * Kk[(g8 * 8 + i) * 65 + d]; }
#pragma unroll
          for (int i = 0; i < 8; ++i) { const int s = g8 * 8 + i; SC[t * 65 + s] = (s <= t) ? sc[i] * exp2f(lg * (float)(t - s)) : 0.f; } }
        __syncthreads();
        { const int e0 = g8 * 8; float o[8], o2[8];
#pragma unroll
          for (int e = 0; e < 8; ++e) { o[e] = 0.f; o2[e] = 0.f; }
#pragma unroll 4
          for (int s = 0; s < 64; ++s) { const float p = SC[t * 65 + s]; const f32x4 v0 = *(const LAS f32x4*)(VV + s * 64 + e0), v1 = *(const LAS f32x4*)(VV + s * 64 + e0 + 4);
              o[0] += p * v0.x; o[1] += p * v0.y; o[2] += p * v0.z; o[3] += p * v0.w; o[4] += p * v1.x; o[5] += p * v1.y; o[6] += p * v1.z; o[7] += p * v1.w; }
#pragma unroll 4
          for (int d = 0; d < 64; ++d) { const float qv = Q[t * 65 + d]; const f32x4 v0 = *(const LAS f32x4*)(SS + d * 64 + e0), v1 = *(const LAS f32x4*)(SS + d * 64 + e0 + 4);
              o2[0] += qv * v0.x; o2[1] += qv * v0.y; o2[2] += qv * v0.z; o2[3] += qv * v0.w; o2[4] += qv * v1.x; o2[5] += qv * v1.y; o2[6] += qv * v1.z; o2[7] += qv * v1.w; }
          const float qd = exp2f(lg * (float)(t + 1)); float s1 = 0.f;
#pragma unroll
          for (int e = 0; e < 8; ++e) { o[e] += qd * o2[e]; s1 += o[e]; }
          s1 += shx(s1, 1, C.lane); s1 += shx(s1, 2, C.lane); s1 += shx(s1, 4, C.lane);
          const float mean = s1 * (1.f / 64.f); float s2 = 0.f;
#pragma unroll
          for (int e = 0; e < 8; ++e) { o[e] -= mean; s2 += o[e] * o[e]; }
          s2 += shx(s2, 1, C.lane); s2 += shx(s2, 2, C.lane); s2 += shx(s2, 4, C.lane);
          const float rstd = 1.0f / sqrtf(s2 * (1.f / 64.f) + 1e-5f);
          float gtv[8]; unpack8(*(const u32x4*)(RET + (size_t)(m0 + t) * 1024 + 768 + h * 64 + e0), gtv);
#pragma unroll
          for (int e = 0; e < 8; ++e) o[e] = o[e] * rstd * gn[h * 64 + e0 + e] * (gtv[e] * sigm(gtv[e]));
          *(u32x4*)(Y + (size_t)(m0 + t) * 1024 + 512 + h * 64 + e0) = pack8(o); }
        __syncthreads();
    }
}

constexpr int RWC = 64, RW_NCH = SEQ / RWC, RW_NU = 8 * RW_NCH;
constexpr int RW_SUP = 8, RW_NSC = RW_NCH / RW_SUP, RW_NSUP = 8 * RW_NSC;
__device__ __forceinline__ void ph_rw_local_(const Ctx& C, int l) {
    const bf16* RKVS = (const bf16*)(C.ws + WS_RKVS); const float* WDEC = (const float*)(C.ws + WS_WDEC); const bf16* AG = (const bf16*)(C.ws + WS_AG);
    bf16* Y0 = (bf16*)(C.ws + WS_Y0); bf16* RH = (bf16*)(C.ws + WS_RHAT); float* PQ = (float*)(C.ws + WS_PQ); float* BON = (float*)(C.ws + WS_BON);
    const int lane = C.lane;
    LAS float* base = (LAS float*)(C.lds + C.wave * 12288);
    for (int it = C.bid; it < RW_NU / 8; it += C.G) {
        const int u = it * 8 + C.wave, bh = u >> 8, ch = u & 255, b = bh >> 2, h = bh & 3, m0 = b * SEQ + ch * RWC, hc = h * 64 + lane;
        const float kkw = C.in[I_RW_KK][l * 256 + hc], kaw = C.in[I_RW_KA][l * 256 + hc], rkw = C.in[I_RW_RK][l * 256 + hc], w0l = C.in[I_RW_W0][l * 256 + hc], a0l = C.in[I_RW_A0][l * 256 + hc];
        f32x2 sL[32], sI[32];
        { int ln = lane; asm volatile("" : "+v"(ln));
#pragma unroll
          for (int k = 0; k < 32; ++k) { sL[k] = (f32x2){0.f, 0.f}; sI[k].x = (2 * k == ln) ? 1.f : 0.f; sI[k].y = (2 * k + 1 == ln) ? 1.f : 0.f; } }
#pragma unroll 1
        for (int sb = 0; sb < RWC / 8; ++sb) {
            asm volatile("" ::: "memory");
#pragma unroll
            for (int i = 0; i < 8; ++i) { const size_t m = (size_t)(m0 + sb * 8 + i);
                const float r = bf2f(RKVS[m * 768 + hc]), k = bf2f(RKVS[m * 768 + 256 + hc]), v = bf2f(RKVS[m * 768 + 512 + hc]);
                const float w = __builtin_amdgcn_exp2f(-0.606531f * LOG2E * sigm(WDEC[m * 256 + hc] + w0l)), a = sigm(bf2f(AG[m * 512 + hc]) + a0l);
                const float kr = k * kkw; const float nn = sqrtf(wave_sum(kr * kr, C.lane)); const float kk = kr / fmaxf(nn, 1e-12f);
                const float kp = k * (1.f + (a - 1.f) * kaw);
                const float bon = wave_sum(r * kp * rkw, C.lane);
                if (lane == 0) BON[m * 4 + h] = bon;
                base[0 * 512 + i * 64 + lane] = w; base[1 * 512 + i * 64 + lane] = kk; base[2 * 512 + i * 64 + lane] = kk * a; base[3 * 512 + i * 64 + lane] = kp; base[4 * 512 + i * 64 + lane] = r; base[5 * 512 + i * 64 + lane] = v; }
            asm volatile("" ::: "memory");
#pragma unroll 1
            for (int i = 0; i < 8; ++i) {
                const LAS f32x4* wv = (const LAS f32x4*)(base + 0 * 512 + i * 64); const LAS f32x4* kkv = (const LAS f32x4*)(base + 1 * 512 + i * 64); const LAS f32x4* kav = (const LAS f32x4*)(base + 2 * 512 + i * 64);
                const LAS f32x4* kpv = (const LAS f32x4*)(base + 3 * 512 + i * 64); const LAS f32x4* rv = (const LAS f32x4*)(base + 4 * 512 + i * 64);
                const float vv = base[5 * 512 + i * 64 + lane];
                f32x4 kq[2][4];
#pragma unroll
                for (int t = 0; t < 4; ++t) kq[0][t] = kkv[t];
                f32x2 dL0 = (f32x2){0.f, 0.f}, dL1 = dL0, dI0 = dL0, dI1 = dL0;
                f32x4 ga[2][4];
#pragma unroll
                for (int g = 0; g < 4; ++g) {
                    __builtin_amdgcn_sched_barrier(0);
                    if (g + 1 < 4) {
#pragma unroll
                        for (int t = 0; t < 4; ++t) kq[(g + 1) & 1][t] = kkv[4 * (g + 1) + t]; }
                    else { ga[0][0] = wv[0]; ga[0][1] = kav[0]; ga[0][2] = kpv[0]; ga[0][3] = rv[0]; }
                    __builtin_amdgcn_sched_barrier(0);
#pragma unroll
                    for (int t = 0; t < 4; ++t) { const int k4 = 4 * g + t; const f32x4 q4 = kq[g & 1][t];
                        dL0 += sL[2 * k4] * q4.xy; dL1 += sL[2 * k4 + 1] * q4.zw; dI0 += sI[2 * k4] * q4.xy; dI1 += sI[2 * k4 + 1] * q4.zw; }
                }
                const float saL = -((dL0.x + dL0.y) + (dL1.x + dL1.y)), saI = -((dI0.x + dI0.y) + (dI1.x + dI1.y));
                const f32x2 saLv = (f32x2){saL, saL}, saIv = (f32x2){saI, saI}, vvv = (f32x2){vv, vv};
                f32x2 yL0 = (f32x2){0.f, 0.f}, yL1 = yL0, yI0 = yL0, yI1 = yL0;
#pragma unroll
                for (int k4 = 0; k4 < 16; ++k4) {
                    __builtin_amdgcn_sched_barrier(0);
                    if (k4 + 1 < 16) { ga[(k4 + 1) & 1][0] = wv[k4 + 1]; ga[(k4 + 1) & 1][1] = kav[k4 + 1]; ga[(k4 + 1) & 1][2] = kpv[k4 + 1]; ga[(k4 + 1) & 1][3] = rv[k4 + 1]; }
                    __builtin_amdgcn_sched_barrier(0);
                    const f32x4 wq = ga[k4 & 1][0], aq = ga[k4 & 1][1], pq = ga[k4 & 1][2], rq = ga[k4 & 1][3];
                    sL[2 * k4]     = sL[2 * k4]     * wq.xy + saLv * aq.xy + vvv * pq.xy; yL0 += sL[2 * k4]     * rq.xy;
                    sL[2 * k4 + 1] = sL[2 * k4 + 1] * wq.zw + saLv * aq.zw + vvv * pq.zw; yL1 += sL[2 * k4 + 1] * rq.zw;
                    sI[2 * k4]     = sI[2 * k4]     * wq.xy + saIv * aq.xy;                  yI0 += sI[2 * k4]     * rq.xy;
                    sI[2 * k4 + 1] = sI[2 * k4 + 1] * wq.zw + saIv * aq.zw;                  yI1 += sI[2 * k4 + 1] * rq.zw;
                }
                __builtin_amdgcn_sched_barrier(0);
                const size_t m = (size_t)(m0 + sb * 8 + i);
                Y0[m * 256 + hc] = f2bf((yL0.x + yL0.y) + (yL1.x + yL1.y));
                RH[m * 256 + hc] = f2bf((yI0.x + yI0.y) + (yI1.x + yI1.y));
            }
        }
        float* oq = PQ + (size_t)u * 4096 + lane * 64; float* opt = PQ + ((size_t)RW_NU + u) * 4096 + lane;
#pragma unroll
        for (int k4 = 0; k4 < 16; ++k4) { *(f32x4*)(oq + 4 * k4) = (f32x4){sL[2 * k4].x, sL[2 * k4].y, sL[2 * k4 + 1].x, sL[2 * k4 + 1].y};
            opt[(4 * k4) * 64] = sI[2 * k4].x; opt[(4 * k4 + 1) * 64] = sI[2 * k4].y; opt[(4 * k4 + 2) * 64] = sI[2 * k4 + 1].x; opt[(4 * k4 + 3) * 64] = sI[2 * k4 + 1].y; }
    }
}
constexpr int WY_LT = 24;
constexpr int WY_ROWM = 0, WY_COLM = 36864, WY_AMAT = 73728, WY_AABF = 89088, WY_SB = 93184, WY_WT = 111616, WY_UT = 117760, WY_GH = 123904, WY_GC = 125952;
__device__ __forceinline__ f32x4 wy_mm16(const LAS bf16* X, const LAS bf16* Y, f32x4 acc, int li, int lq) {
#pragma unroll
    for (int ks = 0; ks < 2; ++ks) { const bf16x8 a = *(const LAS bf16x8*)(X + li * MM_LP + 32 * ks + 8 * lq), b = *(const LAS bf16x8*)(Y + li * MM_LP + 32 * ks + 8 * lq);
        acc = __builtin_amdgcn_mfma_f32_16x16x32_bf16(a, b, acc, 0, 0, 0); }
    return acc;
}
__device__ __forceinline__ f32x4 wy_mm16k16(const LAS bf16* X, const LAS bf16* Y, f32x4 acc, int li, int lq) {
    const s16x4 a = *(const LAS s16x4*)(X + li * WY_LT + 4 * lq), b = *(const LAS s16x4*)(Y + li * WY_LT + 4 * lq);
    return __builtin_amdgcn_mfma_f32_16x16x16bf16_1k(a, b, acc, 0, 0, 0);
}
__device__ __forceinline__ void ph_rw_local_wy_(const Ctx& C, int l) {
    const bf16* RKVS = (const bf16*)(C.ws + WS_RKVS); const float* WDEC = (const float*)(C.ws + WS_WDEC); const bf16* AG = (const bf16*)(C.ws + WS_AG);
    bf16* Y0 = (bf16*)(C.ws + WS_Y0); bf16* RH = (bf16*)(C.ws + WS_RHAT); float* PQ = (float*)(C.ws + WS_PQ); float* BON = (float*)(C.ws + WS_BON);
    const int lane = C.lane, w = C.wave, li = lane & 15, lq = lane >> 4, j32 = lane & 31, hi = lane >> 5, ti = w >> 1, tj = w & 1, sq = w >> 1, half = w & 1;
    LAS unsigned char* L = C.lds;
#define WY_ROW(q, m) ((LAS bf16*)(L + WY_ROWM + (q) * 9216 + (m) * 2304))
#define WY_COL(q, m) ((LAS bf16*)(L + WY_COLM + (q) * 9216 + (m) * 3072))
#define WY_A(q, id)  ((LAS bf16*)(L + WY_AMAT + (q) * 3840 + (id) * 768))
    LAS bf16* SB = (LAS bf16*)(L + WY_SB); LAS bf16* WT = (LAS bf16*)(L + WY_WT); LAS bf16* UT = (LAS bf16*)(L + WY_UT);
    LAS float* GH = (LAS float*)(L + WY_GH); LAS float* GCs = (LAS float*)(L + WY_GC);
    for (int su = C.bid; su < RW_NSUP; su += C.G) {
    f32x16 S;
#pragma unroll 1
    for (int cc = 0; cc < RW_SUP; ++cc) {
        const int u = su * RW_SUP + cc;
        const int bh = u >> 8, ch = u & 255, b = bh >> 2, h = bh & 3, m0 = b * SEQ + ch * RWC, hc = h * 64 + lane;
        const float kkw = C.in[I_RW_KK][l * 256 + hc], kaw = C.in[I_RW_KA][l * 256 + hc], rkw = C.in[I_RW_RK][l * 256 + hc], w0l = C.in[I_RW_W0][l * 256 + hc], a0l = C.in[I_RW_A0][l * 256 + hc];
        { float wv[8], kk[8], ka[8], kp[8], rr[8], vv[8];
#pragma unroll
          for (int i = 0; i < 8; ++i) { const size_t m = (size_t)(m0 + 8 * w + i);
              const float r = bf2f(RKVS[m * 768 + hc]), k = bf2f(RKVS[m * 768 + 256 + hc]); vv[i] = bf2f(RKVS[m * 768 + 512 + hc]);
              wv[i] = __builtin_amdgcn_exp2f(-0.606531f * LOG2E * sigm(WDEC[m * 256 + hc] + w0l)); const float a = sigm(bf2f(AG[m * 512 + hc]) + a0l);
              const float kr = k * kkw; kk[i] = kr * __builtin_amdgcn_rsqf(fmaxf(wave_sum(kr * kr, lane), 1e-24f));
              kp[i] = k * (1.f + (a - 1.f) * kaw); ka[i] = kk[i] * a; rr[i] = r;
              const float bon = wave_sum(r * kp[i] * rkw, lane);
              if (lane == 0) BON[m * 4 + h] = bon; }
          float cp[8]; cp[0] = wv[0];
#pragma unroll
          for (int i = 1; i < 8; ++i) cp[i] = cp[i - 1] * wv[i];
          GH[w * 64 + lane] = cp[7];
          __syncthreads();
          const float pre = half ? GH[(w - 1) * 64 + lane] : 1.f, gC = half ? pre * cp[7] : cp[7] * GH[(w + 1) * 64 + lane];
          if (!half) GCs[sq * 64 + lane] = gC;
#pragma unroll
          for (int i = 0; i < 8; ++i) { const int t = 8 * half + i; const float G = pre * cp[i], Gm1 = (i == 0) ? pre : pre * cp[i - 1], rG = __builtin_amdgcn_rcpf(G);
              WY_ROW(sq, 0)[t * MM_LP + lane] = f2bf(-kk[i] * Gm1); WY_ROW(sq, 1)[t * MM_LP + lane] = f2bf(ka[i] * rG); WY_ROW(sq, 2)[t * MM_LP + lane] = f2bf(kp[i] * rG); WY_ROW(sq, 3)[t * MM_LP + lane] = f2bf(rr[i] * G);
              WY_COL(sq, 0)[lane * WY_LT + t] = f2bf(ka[i] * rG * gC); WY_COL(sq, 1)[lane * WY_LT + t] = f2bf(kp[i] * rG * gC); WY_COL(sq, 2)[lane * WY_LT + t] = f2bf(vv[i]); } }
        __syncthreads();
#pragma unroll
        for (int pp = 0; pp < 2; ++pp) { const int id = 2 * half + pp;
            f32x4 acc = (f32x4){0.f, 0.f, 0.f, 0.f};
            acc = wy_mm16(WY_ROW(sq, half ? 3 : 0), WY_ROW(sq, pp ? 2 : 1), acc, li, lq);
#pragma unroll
            for (int r = 0; r < 4; ++r) { const int t = 4 * lq + r; const bool keep = half ? (li <= t) : (li < t); const float val = keep ? acc[r] : 0.f;
                WY_A(sq, id)[t * WY_LT + li] = f2bf(val); if (id == 0) ((LAS float*)(L + WY_AABF + sq * 1024))[t * 16 + li] = val; } }
        __syncthreads();
        if (w < 4) { const LAS float* Af = (const LAS float*)(L + WY_AABF + w * 1024); float Tc[16];
#pragma unroll
            for (int t = 0; t < 16; ++t) { float acc = (t == li) ? 1.f : 0.f;
#pragma unroll
                for (int s4 = 0; s4 < 4; ++s4) { if (4 * s4 < t) { const f32x4 a4 = *(const LAS f32x4*)(Af + t * 16 + 4 * s4);
                    if (4 * s4 + 0 < t) acc += a4.x * Tc[4 * s4 + 0]; if (4 * s4 + 1 < t) acc += a4.y * Tc[4 * s4 + 1]; if (4 * s4 + 2 < t) acc += a4.z * Tc[4 * s4 + 2]; if (4 * s4 + 3 < t) acc += a4.w * Tc[4 * s4 + 3]; } }
                Tc[t] = acc; WY_A(w, 4)[t * WY_LT + li] = f2bf(acc); } }
        if (cc == 0) {
#pragma unroll
            for (int r = 0; r < 4; ++r)
#pragma unroll
                for (int e = 0; e < 4; ++e) { const int row = 32 * ti + 8 * r + 4 * hi + e, col = 32 * tj + j32; S[4 * r + e] = (ti >= 2 && row - 64 == col) ? 1.f : 0.f; }
#pragma unroll
            for (int r = 0; r < 4; ++r)
#pragma unroll
                for (int e = 0; e < 4; ++e) SB[(32 * ti + 8 * r + 4 * hi + e) * MM_LP + 32 * tj + j32] = f2bf(S[4 * r + e]);
        }
        __syncthreads();
#pragma unroll 1
        for (int q = 0; q < 4; ++q) {
            f32x4 accW = (f32x4){0.f, 0.f, 0.f, 0.f}, accY = accW;
            accW = wy_mm16(WY_ROW(q, 0), SB + 16 * w * MM_LP, accW, li, lq);
            accY = wy_mm16(WY_ROW(q, 3), SB + 16 * w * MM_LP, accY, li, lq);
            if (w < 4) accW = wy_mm16k16(WY_A(q, 1), WY_COL(q, 2) + 16 * w * WY_LT, accW, li, lq);
            { u32x2 pk; pk.x = cvt_pk_bf16(accW[0], accW[1]); pk.y = cvt_pk_bf16(accW[2], accW[3]); *(LAS u32x2*)(WT + (16 * w + li) * WY_LT + 4 * lq) = pk; }
            asm volatile("s_waitcnt lgkmcnt(0)" ::: "memory");
            { f32x4 accU = (f32x4){0.f, 0.f, 0.f, 0.f}; accU = wy_mm16k16(WY_A(q, 4), WT + 16 * w * WY_LT, accU, li, lq);
              u32x2 pk; pk.x = cvt_pk_bf16(accU[0], accU[1]); pk.y = cvt_pk_bf16(accU[2], accU[3]); *(LAS u32x2*)(UT + (16 * w + li) * WY_LT + 4 * lq) = pk; }
            asm volatile("s_waitcnt lgkmcnt(0)" ::: "memory");
            accY = wy_mm16k16(WY_A(q, 2), UT + 16 * w * WY_LT, accY, li, lq);
            if (w < 4) accY = wy_mm16k16(WY_A(q, 3), WY_COL(q, 2) + 16 * w * WY_LT, accY, li, lq);
            { bf16* dst = (w < 4) ? Y0 : RH; const int colo = h * 64 + ((16 * w) & 63) + li;
#pragma unroll
              for (int r = 0; r < 4; ++r) dst[(size_t)(m0 + 16 * q + 4 * lq + r) * 256 + colo] = f2bf(accY[r]); }
            __syncthreads();
            { const float gc = GCs[q * 64 + 32 * tj + j32];
#pragma unroll
              for (int i = 0; i < 16; ++i) S[i] *= gc;
              const bf16x8 ua = *(const LAS bf16x8*)(UT + (32 * ti + j32) * WY_LT + 8 * hi), bb = *(const LAS bf16x8*)(WY_COL(q, 0) + (32 * tj + j32) * WY_LT + 8 * hi);
              S = __builtin_amdgcn_mfma_f32_32x32x16_bf16(ua, bb, S, 0, 0, 0);
              if (ti < 2) { const bf16x8 va = *(const LAS bf16x8*)(WY_COL(q, 2) + (32 * ti + j32) * WY_LT + 8 * hi), kb = *(const LAS bf16x8*)(WY_COL(q, 1) + (32 * tj + j32) * WY_LT + 8 * hi);
                  S = __builtin_amdgcn_mfma_f32_32x32x16_bf16(va, kb, S, 0, 0, 0); } }
            {
#pragma unroll
                for (int r = 0; r < 4; ++r)
#pragma unroll
                    for (int e = 0; e < 4; ++e) SB[(32 * ti + 8 * r + 4 * hi + e) * MM_LP + 32 * tj + j32] = f2bf(S[4 * r + e]);
                __syncthreads(); }
        }
        if (cc == RW_SUP - 1) {
        if (ti < 2) { float* o = PQ + (size_t)su * 4096 + (size_t)(32 * ti + 4 * hi) * 64 + 32 * tj + j32;
#pragma unroll
            for (int r = 0; r < 4; ++r)
#pragma unroll
                for (int e = 0; e < 4; ++e) o[(8 * r + e) * 64] = S[4 * r + e]; }
        else { float* o = PQ + ((size_t)RW_NSUP + su) * 4096 + (size_t)(32 * tj + j32) * 64 + 32 * (ti - 2) + 4 * hi;
#pragma unroll
            for (int r = 0; r < 4; ++r) *(f32x4*)(o + 8 * r) = (f32x4){S[4 * r], S[4 * r + 1], S[4 * r + 2], S[4 * r + 3]}; }
        }
        __syncthreads();
    }
    }
#undef WY_ROW
#undef WY_COL
#undef WY_A
}
__device__ __forceinline__ void ph_rw_scan_(const Ctx& C, int wg) {
    const float* Qg = (const float*)(C.ws + WS_PQ); const float* Pg = Qg + (size_t)RW_NSUP * 4096; float* SST = (float*)(C.ws + WS_SST);
    LAS bf16* PT = (LAS bf16*)(C.lds);
    LAS bf16* SLb = PT + 2 * 64 * MM_LP;
    LAS float* QL = (LAS float*)(C.lds + (2 * 64 * MM_LP + 2 * 16 * MM_LP) * 2);
    LAS float* SO = QL + 2 * 16 * 64;
    const int lane = C.lane, wave = C.wave, bh = wg >> 2, rq = wg & 3, ct = wave & 3, li = lane & 15, lq = lane >> 4;
    const bool mm = wave < 4;
    const size_t ubase = (size_t)bh * RW_NSC;
    const int lt = C.tid & 255;
    const int qrow = lt >> 4, qc4 = (lt & 15) * 4;
    constexpr int PD = 6;
    f32x4 pr[PD][4], qr[PD];
#define SC_P_PIECE(i) (lt + 256 * (i))
#define SC_PUT_P(buf, sx_) do { LAS bf16* d_ = PT + (buf) * (64 * MM_LP); _Pragma("unroll") for (int i_ = 0; i_ < 4; ++i_) { const int idx_ = SC_P_PIECE(i_), r_ = (idx_ * 4) >> 6, k_ = (idx_ * 4) & 63; u32x2 w_; \
        w_.x = cvt_pk_bf16(pr[sx_][i_].x, pr[sx_][i_].y); w_.y = cvt_pk_bf16(pr[sx_][i_].z, pr[sx_][i_].w); *(LAS u32x2*)(d_ + r_ * MM_LP + k_) = w_; } } while (0)
#define SC_LOAD(sx_, cc) do { const f32x4* p4_ = (const f32x4*)(Pg + (ubase + (cc)) * 4096); _Pragma("unroll") for (int i_ = 0; i_ < 4; ++i_) pr[sx_][i_] = p4_[SC_P_PIECE(i_)]; \
        qr[sx_] = *(const f32x4*)(Qg + (ubase + (cc)) * 4096 + (rq * 16 + qrow) * 64 + qc4); } while (0)
    if (mm) {
#pragma unroll
        for (int r = 0; r < 4; ++r) SLb[(4 * lq + r) * MM_LP + ct * 16 + li] = (bf16)0;
    } else {
        { float z0; asm volatile("v_mov_b32 %0, 0" : "=v"(z0));
          *(f32x4*)(SST + ubase * 4096 + (rq * 16 + qrow) * 64 + qc4) = (f32x4){z0, z0, z0, z0}; }
        SC_LOAD(0, 0); SC_PUT_P(0, 0); *(LAS f32x4*)(QL + qrow * 64 + qc4) = qr[0];
#pragma unroll
        for (int x = 0; x < PD; ++x) SC_LOAD(x, 1 + x);
    }
    __syncthreads();
#pragma unroll 1
    for (int c2 = 0; c2 < RW_NSC; c2 += PD) {
#pragma unroll
        for (int x = 0; x < PD; ++x) {
            const int c = c2 + x;
            if (c < RW_NSC) {
            if (mm) {
                const LAS bf16* Pc = PT + (c & 1) * (64 * MM_LP); const LAS bf16* Sc = SLb + (c & 1) * (16 * MM_LP); const LAS float* Qc = QL + (c & 1) * (16 * 64);
                LAS bf16* Sn = SLb + ((c + 1) & 1) * (16 * MM_LP); LAS float* So = SO + ((c + 1) & 1) * (16 * 64);
                bf16x8 af[2], bfr[2];
#pragma unroll
                for (int ks = 0; ks < 2; ++ks) { af[ks] = *(const LAS bf16x8*)(Sc + li * MM_LP + 32 * ks + 8 * lq); bfr[ks] = *(const LAS bf16x8*)(Pc + (16 * ct + li) * MM_LP + 32 * ks + 8 * lq); }
                f32x4 acc;
#pragma unroll
                for (int r = 0; r < 4; ++r) acc[r] = Qc[(4 * lq + r) * 64 + ct * 16 + li];
#pragma unroll
                for (int ks = 0; ks < 2; ++ks) acc = __builtin_amdgcn_mfma_f32_16x16x32_bf16(af[ks], bfr[ks], acc, 0, 0, 0);
                if (c + 1 < RW_NSC) {
#pragma unroll
                    for (int r = 0; r < 4; ++r) { Sn[(4 * lq + r) * MM_LP + ct * 16 + li] = f2bf(acc[r]); So[(4 * lq + r) * 64 + ct * 16 + li] = acc[r]; } }
            } else {
                if (c > 0) *(f32x4*)(SST + (ubase + c) * 4096 + (rq * 16 + qrow) * 64 + qc4) = *(const LAS f32x4*)(SO + (c & 1) * (16 * 64) + qrow * 64 + qc4);
                if (c + 1 < RW_NSC) { SC_PUT_P((c + 1) & 1, x); *(LAS f32x4*)(QL + ((c + 1) & 1) * (16 * 64) + qrow * 64 + qc4) = qr[x]; }
                if (c + 1 + PD < RW_NSC) SC_LOAD(x, c + 1 + PD);
            }
            __syncthreads();
#ifdef SCAN_2BAR
            __syncthreads();
#endif
            }
        }
    }
#undef SC_PUT_P
#undef SC_LOAD
#undef SC_P_PIECE
}
__device__ __forceinline__ void ph_rw_out_(const Ctx& C, int l) {
    const bf16* RKVS = (const bf16*)(C.ws + WS_RKVS); const bf16* AG = (const bf16*)(C.ws + WS_AG); const bf16* Y0 = (const bf16*)(C.ws + WS_Y0); const bf16* RH = (const bf16*)(C.ws + WS_RHAT);
    const float* SST = (const float*)(C.ws + WS_SST); const float* BON = (const float*)(C.ws + WS_BON); bf16* Y = (bf16*)(C.ws + WS_Y);
    LAS float* RL = (LAS float*)(C.lds);
    const int lane = C.lane, wave = C.wave;
    for (int u = C.bid; u < RW_NU; u += C.G) {
        const int bh = u >> 8, ch = u & 255, b = bh >> 2, h = bh & 3, m0 = b * SEQ + ch * RWC, hc = h * 64 + lane;
        { const int t = C.tid >> 3, d0 = (C.tid & 7) * 8; float a[8];
          unpack8(*(const u32x4*)(RH + (size_t)(m0 + t) * 256 + h * 64 + d0), a);
#pragma unroll
          for (int e = 0; e < 8; ++e) RL[t * 64 + d0 + e] = a[e]; }
        float s[64];
        { const f32x4* sp = (const f32x4*)(SST + (size_t)u * 4096 + lane * 64);
#pragma unroll
          for (int k4 = 0; k4 < 16; ++k4) { const f32x4 v = sp[k4]; s[4 * k4] = v.x; s[4 * k4 + 1] = v.y; s[4 * k4 + 2] = v.z; s[4 * k4 + 3] = v.w; } }
        const float lnw = C.in[I_RW_LNW][l * 256 + hc], lnb = C.in[I_RW_LNB][l * 256 + hc];
        __syncthreads();
#pragma unroll 2
        for (int q = 0; q < 8; ++q) { const int t = wave * 8 + q; const size_t m = (size_t)(m0 + t);
            const LAS f32x4* rv = (const LAS f32x4*)(RL + t * 64);
            float y0 = 0.f, y1 = 0.f, y2 = 0.f, y3 = 0.f;
#pragma unroll
            for (int k4 = 0; k4 < 16; ++k4) { const f32x4 rq = rv[k4]; y0 += s[4 * k4] * rq.x; y1 += s[4 * k4 + 1] * rq.y; y2 += s[4 * k4 + 2] * rq.z; y3 += s[4 * k4 + 3] * rq.w; }
#ifndef RWDBG
#define RWDBG 0
#endif
            float y = ((RWDBG & 1) ? 0.f : (y0 + y1) + (y2 + y3)) + ((RWDBG & 2) ? 0.f : bf2f(Y0[m * 256 + hc]));
            const float mean = wave_sum(y, C.lane) * (1.f / 64.f); y -= mean;
            const float rstd = 1.0f / sqrtf(wave_sum(y * y, C.lane) * (1.f / 64.f) + 64e-5f);
            y = y * rstd * lnw + lnb;
            if (!(RWDBG & 4)) y += BON[m * 4 + h] * bf2f(RKVS[m * 768 + 512 + hc]);
            y *= bf2f(AG[m * 512 + 256 + hc]);
            if (RWDBG & 120) { y = 0.f; if (RWDBG & 8) y += ((const float*)(C.ws + WS_WDEC))[m * 256 + hc]; if (RWDBG & 16) y += bf2f(AG[m * 512 + hc]);
                if (RWDBG & 32) y += bf2f(RKVS[m * 768 + hc]) + bf2f(RKVS[m * 768 + 256 + hc]) + bf2f(RKVS[m * 768 + 512 + hc]); if (RWDBG & 64) y += BON[m * 4 + h]; }
            Y[m * 1024 + hc] = f2bf(y); }
        __syncthreads();
    }
}

constexpr int SB_VLD = 40;
__device__ __forceinline__ void ph_sb_attn_(const Ctx& C, int first_wg, int nwg, unsigned* qhead = nullptr) {
    const bf16* SB = (const bf16*)(C.ws + WS_SB); bf16* Y = (bf16*)(C.ws + WS_Y);
    const int lane = C.lane, j = lane & 31, hi = lane >> 5;
    LAS bf16* VT = (LAS bf16*)(C.lds + C.wave * (64 * SB_VLD * 2));
    for (int it = qhead ? q_next(C, qhead) : C.bid - first_wg; it < 512; it = qhead ? q_next(C, qhead) : it + nwg) {
        const int bh = it >> 6, b = bh >> 2, h = bh & 3, t0 = (it & 63) * 256 + C.wave * 32; const size_t mb = (size_t)b * SEQ;
        bf16x8 qf[4];
#pragma unroll
        for (int ks = 0; ks < 4; ++ks) qf[ks] = *(const bf16x8*)(SB + (mb + t0 + j) * 768 + h * 64 + 16 * ks + 8 * hi);
        f32x16 o0, o1;
#pragma unroll
        for (int i = 0; i < 16; ++i) { o0[i] = 0.f; o1[i] = 0.f; }
        float acc = 0.f;
#pragma unroll 1
        for (int kt = t0; kt >= 0; kt -= 32) {
            bf16x8 kf[4];
#pragma unroll
            for (int ks = 0; ks < 4; ++ks) kf[ks] = *(const bf16x8*)(SB + (mb + kt + j) * 768 + 256 + h * 64 + 16 * ks + 8 * hi);
            u32x4 vv[4];
#pragma unroll
            for (int i = 0; i < 4; ++i) { const int c = lane + 64 * i; vv[i] = *(const u32x4*)(SB + (mb + kt + (c >> 3)) * 768 + 512 + h * 64 + (c & 7) * 8); }
            f32x16 sc;
#pragma unroll
            for (int i = 0; i < 16; ++i) sc[i] = 0.f;
#pragma unroll
            for (int ks = 0; ks < 4; ++ks) sc = __builtin_amdgcn_mfma_f32_32x32x16_bf16(kf[ks], qf[ks], sc, 0, 0, 0);
#pragma unroll
            for (int i = 0; i < 4; ++i) { const int c = lane + 64 * i, key = c >> 3, d8 = (c & 7) * 8; const unsigned w[4] = {vv[i].x, vv[i].y, vv[i].z, vv[i].w};
#pragma unroll
                for (int e = 0; e < 4; ++e) { VT[(d8 + 2 * e) * SB_VLD + key] = (bf16)(w[e] & 0xffffu); VT[(d8 + 2 * e + 1) * SB_VLD + key] = (bf16)(w[e] >> 16); } }
            const bool diag = (kt == t0);
            float ls[16], g[4], og[4];
#pragma unroll
            for (int r = 0; r < 4; ++r) { g[r] = 0.f;
#pragma unroll
                for (int e = 0; e < 4; ++e) { const float z = sc[4 * r + e]; const bool valid = !diag || (8 * r + 4 * hi + e) < j;
                    const float l = (z > 40.f) ? -z : -__builtin_amdgcn_logf(1.f + __builtin_amdgcn_exp2f(z));
                    ls[4 * r + e] = valid ? l : 0.f; g[r] += ls[4 * r + e]; } }
#pragma unroll
            for (int r = 0; r < 4; ++r) og[r] = shx(g[r], 32, lane);
            float pw[16]; float run = acc;
#pragma unroll
            for (int r = 3; r >= 0; --r) { float cum = run + (hi == 0 ? og[r] : 0.f);
#pragma unroll
                for (int e = 3; e >= 0; --e) { cum += ls[4 * r + e]; const bool valid = !diag || (8 * r + 4 * hi + e) < j;
                    pw[4 * r + e] = valid ? __builtin_amdgcn_exp2f(sc[4 * r + e] + cum) : 0.f; }
                run += g[r] + og[r]; }
            acc = run;
            asm volatile("" ::: "memory");
#pragma unroll
            for (int ks = 0; ks < 2; ++ks) {
                u32x4 pk; pk.x = cvt_pk_bf16(pw[8 * ks], pw[8 * ks + 1]); pk.y = cvt_pk_bf16(pw[8 * ks + 2], pw[8 * ks + 3]); pk.z = cvt_pk_bf16(pw[8 * ks + 4], pw[8 * ks + 5]); pk.w = cvt_pk_bf16(pw[8 * ks + 6], pw[8 * ks + 7]);
                const bf16x8 pb = __builtin_bit_cast(bf16x8, pk);
                const s16x4 a0l = *(const LAS s16x4*)(VT + j * SB_VLD + 16 * ks + 4 * hi), a0h = *(const LAS s16x4*)(VT + j * SB_VLD + 16 * ks + 8 + 4 * hi);
                const s16x4 a1l = *(const LAS s16x4*)(VT + (32 + j) * SB_VLD + 16 * ks + 4 * hi), a1h = *(const LAS s16x4*)(VT + (32 + j) * SB_VLD + 16 * ks + 8 + 4 * hi);
                const bf16x8 va0 = __builtin_shufflevector(a0l, a0h, 0, 1, 2, 3, 4, 5, 6, 7), va1 = __builtin_shufflevector(a1l, a1h, 0, 1, 2, 3, 4, 5, 6, 7);
                o0 = __builtin_amdgcn_mfma_f32_32x32x16_bf16(va0, pb, o0, 0, 0, 0);
                o1 = __builtin_amdgcn_mfma_f32_32x32x16_bf16(va1, pb, o1, 0, 0, 0);
            }
            asm volatile("" ::: "memory");
            if (__builtin_amdgcn_ballot_w64(acc > -140.f) == 0ull) break;
        }
        bf16* yp = Y + (mb + t0 + j) * 1024 + 256 + h * 64 + 4 * hi;
#pragma unroll
        for (int r = 0; r < 4; ++r) { u32x2 w0, w1; w0.x = cvt_pk_bf16(o0[4 * r], o0[4 * r + 1]); w0.y = cvt_pk_bf16(o0[4 * r + 2], o0[4 * r + 3]); w1.x = cvt_pk_bf16(o1[4 * r], o1[4 * r + 1]); w1.y = cvt_pk_bf16(o1[4 * r + 2], o1[4 * r + 3]);
            *(u32x2*)(yp + 8 * r) = w0; *(u32x2*)(yp + 32 + 8 * r) = w1; }
    }
}


__device__ __forceinline__ f32x16 mm_tile(const LAS bf16* X, const LAS bf16* Y, int ti, int tj, int lane) {
    const int j = lane & 31, hi = lane >> 5; f32x16 acc;
#pragma unroll
    for (int i = 0; i < 16; ++i) acc[i] = 0.f;
#pragma unroll
    for (int ks = 0; ks < 4; ++ks) { const bf16x8 a = *(const LAS bf16x8*)(X + (32 * ti + j) * MM_LP + 16 * ks + 8 * hi), b = *(const LAS bf16x8*)(Y + (32 * tj + j) * MM_LP + 16 * ks + 8 * hi);
        acc = __builtin_amdgcn_mfma_f32_32x32x16_bf16(a, b, acc, 0, 0, 0); }
    return acc;
}
__device__ __forceinline__ void ln_pair_stats(const f32x16& x, LAS float* XCH, int tr, int tt, int lane, float eps, float& mean, float& rstd) {
    const int j = lane & 31, hi = lane >> 5; float s1 = 0.f, s2 = 0.f;
#pragma unroll
    for (int i = 0; i < 16; ++i) { s1 += x[i]; s2 += x[i] * x[i]; }
    s1 += shx(s1, 32, lane); s2 += shx(s2, 32, lane);
    if (hi == 0) { XCH[(tr * 64 + 32 * tt + j) * 2] = s1; XCH[(tr * 64 + 32 * tt + j) * 2 + 1] = s2; }
    __syncthreads();
    const float a1 = XCH[(32 * tt + j) * 2] + XCH[(64 + 32 * tt + j) * 2], a2 = XCH[(32 * tt + j) * 2 + 1] + XCH[(64 + 32 * tt + j) * 2 + 1];
    mean = a1 * (1.f / 64.f); const float var = fmaxf(a2 * (1.f / 64.f) - mean * mean, 0.f); rstd = 1.0f / sqrtf(var + eps);
}
__device__ __forceinline__ void rot_store(const Ctx& C, const bf16* src  , int pos, int d0, float scale, LAS bf16* dstrow) {
    const float* cs = (const float*)(C.ws + WS_COS) + (size_t)pos * 32 + d0; const float* sn = (const float*)(C.ws + WS_SIN) + (size_t)pos * 32 + d0;
    float x1[8], x2[8]; unpack8(*(const u32x4*)(src + d0), x1); unpack8(*(const u32x4*)(src + 32 + d0), x2);
    const f32x4 c0 = *(const f32x4*)cs, c1 = *(const f32x4*)(cs + 4), s0 = *(const f32x4*)sn, s1 = *(const f32x4*)(sn + 4);
    const float cc[8] = {c0.x, c0.y, c0.z, c0.w, c1.x, c1.y, c1.z, c1.w}, ss[8] = {s0.x, s0.y, s0.z, s0.w, s1.x, s1.y, s1.z, s1.w};
    float o1[8], o2[8];
#pragma unroll
    for (int e = 0; e < 8; ++e) { o1[e] = (x1[e] * cc[e] - x2[e] * ss[e]) * scale; o2[e] = (x1[e] * ss[e] + x2[e] * cc[e]) * scale; }
    *(LAS u32x4*)(dstrow + d0) = pack8(o1); *(LAS u32x4*)(dstrow + 32 + d0) = pack8(o2);
}

__device__ __forceinline__ void ph_ret_kv2_(const Ctx& C) {
    const bf16* RET = (const bf16*)(C.ws + WS_RET); float* KV = (float*)(C.ws + WS_KV);
    const int half = C.wave >> 2, w4 = C.wave & 3, th = C.tid & 255, lane = C.lane;
    LAS bf16* KT = (LAS bf16*)(C.lds + half * 36864);
    LAS bf16* VT = KT + 64 * MM_LP;
    LAS bf16* KR = VT + 64 * MM_LP;
    for (int it = C.bid; it < 1024; it += C.G) {
        const int u = it * 2 + half, bh = u >> 8, ch = u & 255, b = bh >> 2, h = bh & 3, m0 = b * SEQ + ch * 64;
        const float lg = ret_log2gamma(h);
        { const int srow = th >> 2, dq = th & 3; const size_t m = (size_t)(m0 + srow);
          rot_store(C, RET + m * 1024 + 256 + h * 64, (int)(m & (SEQ - 1)), dq * 8, 0.125f * exp2f(lg * (float)(63 - srow)), KR + srow * MM_LP);
          float a[8];
#pragma unroll
          for (int q = 0; q < 2; ++q) { const int e0 = dq * 16 + q * 8; unpack8(*(const u32x4*)(RET + m * 1024 + 512 + h * 64 + e0), a);
#pragma unroll
              for (int e = 0; e < 8; ++e) VT[(e0 + e) * MM_LP + srow] = f2bf(a[e]); } }
        __syncthreads();
        { const int d = th >> 2, s0 = (th & 3) * 16;
#pragma unroll
          for (int i = 0; i < 16; ++i) KT[d * MM_LP + s0 + i] = KR[(s0 + i) * MM_LP + d]; }
        __syncthreads();
        { const int ti = w4 >> 1, tj = w4 & 1, j = lane & 31, hi = lane >> 5;
          const f32x16 acc = mm_tile(VT, KT, ti, tj, lane);
          float* o = KV + (size_t)u * 4096 + (size_t)(32 * ti + 4 * hi) * 64 + 32 * tj + j;
#pragma unroll
          for (int r = 0; r < 4; ++r)
#pragma unroll
              for (int e = 0; e < 4; ++e) o[(8 * r + e) * 64] = acc[4 * r + e]; }
        __syncthreads();
    }
}
__device__ __forceinline__ void ph_ret_out2_(const Ctx& C, int l, int first_wg, int nwg, unsigned* qhead = nullptr) {
    const bf16* RET = (const bf16*)(C.ws + WS_RET); const float* KV = (const float*)(C.ws + WS_KV); bf16* Y = (bf16*)(C.ws + WS_Y);
    const int half = C.wave >> 2, w4 = C.wave & 3, th = C.tid & 255, lane = C.lane, j = lane & 31, hi = lane >> 5, te = w4 >> 1, tt = w4 & 1;
    LAS bf16* QL = (LAS bf16*)(C.lds + half * 40960);
    LAS bf16* KL = QL + 64 * MM_LP;
    LAS bf16* VT = KL + 64 * MM_LP;
    LAS bf16* ST = VT + 64 * MM_LP;
    LAS float* XCH = (LAS float*)(C.lds + half * 40960 + 4 * 64 * MM_LP * 2);
    const float* gn = C.in[I_RET_GN] + (size_t)l * 256;
    for (int it = qhead ? q_next(C, qhead) : C.bid - first_wg; it < 1024; it = qhead ? q_next(C, qhead) : it + nwg) {
        const int u = it * 2 + half, bh = u >> 8, ch = u & 255, b = bh >> 2, h = bh & 3, m0 = b * SEQ + ch * 64;
        const float lg = ret_log2gamma(h);
        { const int srow = th >> 2, dq = th & 3; const size_t m = (size_t)(m0 + srow); const int pos = (int)(m & (SEQ - 1));
          rot_store(C, RET + m * 1024 + h * 64, pos, dq * 8, 1.0f, QL + srow * MM_LP);
          rot_store(C, RET + m * 1024 + 256 + h * 64, pos, dq * 8, 0.125f, KL + srow * MM_LP);
          float a[8];
#pragma unroll
          for (int q = 0; q < 2; ++q) { const int e0 = dq * 16 + q * 8; unpack8(*(const u32x4*)(RET + m * 1024 + 512 + h * 64 + e0), a);
#pragma unroll
              for (int e = 0; e < 8; ++e) VT[(e0 + e) * MM_LP + srow] = f2bf(a[e]); }
          const float* sp = KV + (size_t)u * 4096 + srow * 64 + dq * 16;
          float sv[16];
#pragma unroll
          for (int q = 0; q < 4; ++q) { const f32x4 v4 = *(const f32x4*)(sp + 4 * q); sv[4 * q] = v4.x; sv[4 * q + 1] = v4.y; sv[4 * q + 2] = v4.z; sv[4 * q + 3] = v4.w; }
          *(LAS u32x4*)(ST + srow * MM_LP + dq * 16) = pack8(sv); *(LAS u32x4*)(ST + srow * MM_LP + dq * 16 + 8) = pack8(sv + 8); }
        __syncthreads();
        f32x16 acc = mm_tile(ST, QL, te, tt, lane);
        { const float qd = exp2f(lg * (float)(32 * tt + j + 1));
#pragma unroll
          for (int i = 0; i < 16; ++i) acc[i] *= qd; }
#pragma unroll
        for (int st = 0; st < 2; ++st) {
            if (st > tt) continue;
            const f32x16 sc = mm_tile(KL, QL, st, tt, lane);
            float pw[16];
#pragma unroll
            for (int r = 0; r < 4; ++r)
#pragma unroll
                for (int e = 0; e < 4; ++e) { const int sk = 32 * st + 8 * r + 4 * hi + e, tq = 32 * tt + j;
                    pw[4 * r + e] = (sk <= tq) ? sc[4 * r + e] * exp2f(lg * (float)(tq - sk)) : 0.f; }
#pragma unroll
            for (int ks = 0; ks < 2; ++ks) {
                u32x4 pk; pk.x = cvt_pk_bf16(pw[8 * ks], pw[8 * ks + 1]); pk.y = cvt_pk_bf16(pw[8 * ks + 2], pw[8 * ks + 3]); pk.z = cvt_pk_bf16(pw[8 * ks + 4], pw[8 * ks + 5]); pk.w = cvt_pk_bf16(pw[8 * ks + 6], pw[8 * ks + 7]);
                const bf16x8 pb = __builtin_bit_cast(bf16x8, pk);
                const LAS bf16* vr = VT + (32 * te + j) * MM_LP + 32 * st + 16 * ks + 4 * hi;
                const s16x4 al = *(const LAS s16x4*)vr, ah = *(const LAS s16x4*)(vr + 8);
                const bf16x8 va = __builtin_shufflevector(al, ah, 0, 1, 2, 3, 4, 5, 6, 7);
                acc = __builtin_amdgcn_mfma_f32_32x32x16_bf16(va, pb, acc, 0, 0, 0);
            }
        }
        float mean, rstd; ln_pair_stats(acc, XCH, te, tt, lane, 1e-5f, mean, rstd);
        { const size_t m = (size_t)(m0 + 32 * tt + j); const bf16* gp = RET + m * 1024 + 768 + h * 64 + 32 * te + 4 * hi; bf16* yp = Y + m * 1024 + 512 + h * 64 + 32 * te + 4 * hi;
          const float* gw = gn + h * 64 + 32 * te + 4 * hi;
#pragma unroll
          for (int r = 0; r < 4; ++r) { const u32x2 gt2 = *(const u32x2*)(gp + 8 * r); const float gtv[4] = {bflo(gt2.x), bfhi(gt2.x), bflo(gt2.y), bfhi(gt2.y)}; const f32x4 gwv = *(const f32x4*)(gw + 8 * r);
              float o[4];
#pragma unroll
              for (int e = 0; e < 4; ++e) o[e] = (acc[4 * r + e] - mean) * rstd * gwv[e] * (gtv[e] * sigm(gtv[e]));
              u32x2 w; w.x = cvt_pk_bf16(o[0], o[1]); w.y = cvt_pk_bf16(o[2], o[3]); *(u32x2*)(yp + 8 * r) = w; } }
        __syncthreads();
    }
}
__device__ __forceinline__ void ph_rw_out2_(const Ctx& C, int l) {
    const bf16* RKVS = (const bf16*)(C.ws + WS_RKVS); const bf16* AG = (const bf16*)(C.ws + WS_AG); const bf16* Y0 = (const bf16*)(C.ws + WS_Y0); const bf16* RH = (const bf16*)(C.ws + WS_RHAT);
    const float* SST = (const float*)(C.ws + WS_SST); const float* BON = (const float*)(C.ws + WS_BON); bf16* Y = (bf16*)(C.ws + WS_Y);
    const int half = C.wave >> 2, w4 = C.wave & 3, th = C.tid & 255, lane = C.lane, j = lane & 31, hi = lane >> 5, tv = w4 >> 1, tt = w4 & 1;
    LAS bf16* SL = (LAS bf16*)(C.lds + half * 20480);
    LAS bf16* RL = SL + 64 * MM_LP;
    LAS float* XCH = (LAS float*)(C.lds + half * 20480 + 2 * 64 * MM_LP * 2);
    for (int it = C.bid; it < RW_NU / 2; it += C.G) {
        const int u = it * 2 + half, bh = u >> 8, ch = u & 255, b = bh >> 2, h = bh & 3, m0 = b * SEQ + ch * RWC;
        { const int row = th >> 2, q4 = th & 3;
          const float* sp = SST + (size_t)(u >> 3) * 4096 + row * 64 + q4 * 16; float sv[16];
#pragma unroll
          for (int q = 0; q < 4; ++q) { const f32x4 v4 = *(const f32x4*)(sp + 4 * q); sv[4 * q] = v4.x; sv[4 * q + 1] = v4.y; sv[4 * q + 2] = v4.z; sv[4 * q + 3] = v4.w; }
          *(LAS u32x4*)(SL + row * MM_LP + q4 * 16) = pack8(sv); *(LAS u32x4*)(SL + row * MM_LP + q4 * 16 + 8) = pack8(sv + 8);
          const u32x4* rp = (const u32x4*)(RH + (size_t)(m0 + row) * 256 + h * 64 + q4 * 16);
          *(LAS u32x4*)(RL + row * MM_LP + q4 * 16) = rp[0]; *(LAS u32x4*)(RL + row * MM_LP + q4 * 16 + 8) = rp[1]; }
        __syncthreads();
        f32x16 acc = mm_tile(SL, RL, tv, tt, lane);
        const size_t m = (size_t)(m0 + 32 * tt + j); const int vb = h * 64 + 32 * tv + 4 * hi;
#pragma unroll
        for (int r = 0; r < 4; ++r) { const u32x2 y2 = *(const u32x2*)(Y0 + m * 256 + vb + 8 * r); acc[4 * r] += bflo(y2.x); acc[4 * r + 1] += bfhi(y2.x); acc[4 * r + 2] += bflo(y2.y); acc[4 * r + 3] += bfhi(y2.y); }
        float mean, rstd; ln_pair_stats(acc, XCH, tv, tt, lane, 64e-5f, mean, rstd);
        const float bon = BON[m * 4 + h];
#pragma unroll
        for (int r = 0; r < 4; ++r) { const int vc = vb + 8 * r;
            const f32x4 lw = *(const f32x4*)(C.in[I_RW_LNW] + (size_t)l * 256 + vc), lb = *(const f32x4*)(C.in[I_RW_LNB] + (size_t)l * 256 + vc);
            const u32x2 v2 = *(const u32x2*)(RKVS + m * 768 + 512 + vc), g2 = *(const u32x2*)(AG + m * 512 + 256 + vc);
            const float vv[4] = {bflo(v2.x), bfhi(v2.x), bflo(v2.y), bfhi(v2.y)}, gg[4] = {bflo(g2.x), bfhi(g2.x), bflo(g2.y), bfhi(g2.y)};
            float o[4];
#pragma unroll
            for (int e = 0; e < 4; ++e) o[e] = ((acc[4 * r + e] - mean) * rstd * lw[e] + lb[e] + bon * vv[e]) * gg[e];
            u32x2 w; w.x = cvt_pk_bf16(o[0], o[1]); w.y = cvt_pk_bf16(o[2], o[3]); *(u32x2*)(Y + m * 1024 + vc) = w; }
        __syncthreads();
    }
}

__device__ __forceinline__ void ph_moe_scatter_(const Ctx& C, int moe_idx) {
    unsigned* cw = (unsigned*)(C.ws + WS_CTL) + CW_MOE + moe_idx * 64;
    const int* eidx = (const int*)(C.ws + WS_EIDX); const float* gate = (const float*)(C.ws + WS_GATE);
    int* rowtok = (int*)(C.ws + WS_ROWTOK); float* rowgate = (float*)(C.ws + WS_ROWGATE); int* texp = (int*)(C.ws + WS_TEXP); int* segend = (int*)(C.ws + WS_SEGEND); int* ntp = (int*)(C.ws + WS_NT);
    bf16* XS = (bf16*)(C.ws + WS_XS);
    LAS unsigned* lcnt = (LAS unsigned*)(C.lds); LAS unsigned* lbase = lcnt + 8; LAS int* sl = (LAS int*)(C.lds + 256);
    int cnt[8], segb[8]; int tot = 0;
#pragma unroll
    for (int e = 0; e < 8; ++e) { cnt[e] = (int)__hip_atomic_load(&cw[e], __ATOMIC_RELAXED, __HIP_MEMORY_SCOPE_AGENT); segb[e] = tot; tot += (cnt[e] + 255) & ~255; }
    if (C.bid == 0) {
        if (C.tid < 8) { const int e = C.tid; int sb = 0, ce = 0;
#pragma unroll
            for (int q = 0; q < 8; ++q) if (q == e) { sb = segb[q]; ce = cnt[q]; }
            for (int pm = sb >> 8; pm < ((sb + ((ce + 255) & ~255)) >> 8); ++pm) { texp[pm] = e; segend[pm] = sb + ce; } }
        if (C.tid == 0) *ntp = tot >> 8;
    }
    for (int blk = C.bid; blk < T / 256; blk += C.G) {
        __syncthreads();
        if (C.tid < 8) lcnt[C.tid] = 0u;
        __syncthreads();
        const int a = blk * 512 + C.tid, e = eidx[a];
        const unsigned rank = atomicAdd((unsigned*)&lcnt[e], 1u);
        __syncthreads();
        if (C.tid < 8) lbase[C.tid] = atomicAdd(&cw[16 + C.tid], lcnt[C.tid]);
        __syncthreads();
        int sb = 0;
#pragma unroll
        for (int q = 0; q < 8; ++q) if (q == e) sb = segb[q];
        const int slot = sb + (int)lbase[e] + (int)rank;
        rowtok[slot] = a >> 1; rowgate[slot] = gate[a]; sl[C.tid] = slot; ((int*)(C.ws + WS_SLOTOF))[a] = slot;
        __syncthreads();
        for (int i = C.wave; i < 512; i += NWAVES) { const int s2 = sl[i]; const u32x4* src = (const u32x4*)(C.ws + WS_H8 + (size_t)(blk * 256 + (i >> 1)) * D); u32x4* dst = (u32x4*)(C.ws + WS_XS + (size_t)s2 * D);
            dst[C.lane] = src[C.lane]; }
    }
}

__device__ __forceinline__ void grid_barrier(int wv) {
    const Ctx C = make_ctx(wv);
    XcdBarrier b; b.bar = (unsigned*)(C.ws + WS_CTL) + CW_BAR; b.x = xb_xcc_id(); b.st = (volatile LAS unsigned*)(C.lds + MISC_OFF) + 8;
    xcd_barrier(b, C.tid);
}
__device__ __forceinline__ void P_prologue(int wv) { const Ctx C = make_ctx(wv); ph_prologue_(C); }
__device__ __forceinline__ void P_weights_norm(int wv, int l) { const Ctx C = make_ctx(wv); ph_weights_(C, l, 0, 0, C.G); __syncthreads(); ph_norm_(C, C.in[I_NORM_MIX] + (size_t)l * D, false, nullptr, 0,  (l > 0) && ((l - 1) & 1), l == 0 ? C.in[I_X] : nullptr); }
__device__ __forceinline__ void P_gemm_in(int wv) { const Ctx C = make_ctx(wv); using namespace pg8; unsigned char* ws = C.ws;
    Gemm g{(const bf16*)C.out, (const bf16*)(ws + WS_WIN), D, D}; StaticOrder S; S.init(T, NIN, C.G, C.bid);
    EpiRoute E{(bf16*)(ws + WS_RW), (bf16*)(ws + WS_SB), (bf16*)(ws + WS_RET), (bf16*)(ws + WS_CV)};
    gemm_phase<EpiRoute, StaticOrder, true, 1>(C.lds, C.tid, g, S, E); }
#define REP2(bit, stmt) do { stmt; if constexpr ((PROBE2 >> (bit)) & 1) { __syncthreads(); stmt; } } while (0)
__device__ __forceinline__ void P_mix1(int wv, int l) { REP2(2, { const Ctx C = make_ctx(wv); ph_rw_prep_(C, l); }); { const Ctx C = make_ctx(wv); ph_sb_prep_(C, l); } REP2(3, { const Ctx C = make_ctx(wv); ph_conv_(C, l); }); REP2(4, { const Ctx C = make_ctx(wv); ph_ret_kv2_(C); }); }
__device__ __forceinline__ void P_mix2(int wv, int l) { { const Ctx C = make_ctx(wv); using namespace pg8; unsigned char* ws = C.ws;
    Gemm g{(const bf16*)(ws + WS_ALORA), (const bf16*)(ws + WS_WLORA), 256, 256}; StaticOrder S; S.init(T, 768, C.G, C.bid);
    EpiLora E{(float*)(ws + WS_WDEC), (bf16*)(ws + WS_AG), C.in[I_RW_W0] + (size_t)l * 256, C.in[I_RW_A0] + (size_t)l * 256};
    gemm_phase<EpiLora, StaticOrder, true>(C.lds, C.tid, g, S, E); }
    { const Ctx C = make_ctx(wv); ph_ret_scan_(C); } }
#ifndef MIX3_SEL
#define MIX3_SEL 3
#endif
__device__ __forceinline__ void P_mix3(int wv, int l) { REP2(0, { const Ctx C = make_ctx(wv); ph_rw_local_wy_(C, l); }); }
__device__ __forceinline__ void P_mix4(int wv, int l) { const Ctx C = make_ctx(wv);
    unsigned* qh = (unsigned*)(C.ws + WS_CTL) + CW_QUEUE + l * 64;
    if (C.G >= 64) { if (C.bid < 32) { ph_rw_scan_(C, C.bid); __syncthreads(); }
        ph_sb_attn_(C, 0, C.G, qh); __syncthreads(); ph_ret_out2_(C, l, 0, C.G, qh + 16); __syncthreads(); ph_weights_(C, l, 1, 0, C.G, qh + 32); }
    else { for (int w = C.bid; w < 32; w += C.G) { ph_rw_scan_(C, w); __syncthreads(); } ph_sb_attn_(C, 0, C.G); __syncthreads(); ph_ret_out2_(C, l, 0, C.G); __syncthreads(); ph_weights_(C, l, 1, 0, C.G); } }
__device__ __forceinline__ void P_mix5(int wv, int l) { REP2(5, { const Ctx C = make_ctx(wv); ph_rw_out2_(C, l); }); }
__device__ __forceinline__ void P_gemm_branch(int wv) { const Ctx C = make_ctx(wv); using namespace pg8; unsigned char* ws = C.ws;
    Gemm g{(const bf16*)(ws + WS_Y), (const bf16*)(ws + WS_WB), D, 256}; StaticOrder S; S.init(T, 4096, C.G, C.bid, 2, 512);
    EpiBall E{ws + WS_BALL};
    gemm_phase<EpiBall, StaticOrder, false>(C.lds, C.tid, g, S, E); }
__device__ __forceinline__ void P_gemm_gate(int wv) { const Ctx C = make_ctx(wv); using namespace pg8; unsigned char* ws = C.ws;
    Gemm g{(const bf16*)(ws + WS_H8), (const bf16*)(ws + WS_WG), D, D}; StaticOrder S; S.init(T, 4096, C.G, C.bid);
    EpiGateMerge E{(const bf16*)(ws + WS_BALL), (bf16*)(ws + WS_MERGED)};
    gemm_phase8<EpiGateMerge, StaticOrder, true>(C.lds, C.tid, g, S, E); }
__device__ __forceinline__ void P_gemm_out(int wv) { const Ctx C = make_ctx(wv); using namespace pg8; unsigned char* ws = C.ws;
    Gemm g{(const bf16*)(ws + WS_MERGED), (const bf16*)(ws + WS_WOUT), D, D}; StaticOrder S; S.init(T, D, C.G, C.bid);
    EpiResidual E{(bf16*)(ws + WS_XB), 1.0f};
    gemm_phase<EpiResidual, StaticOrder, false, 1>(C.lds, C.tid, g, S, E); }
__device__ __forceinline__ void P_norm_ffn(int wv, int l) { const Ctx C = make_ctx(wv); ph_norm_(C, C.in[I_NORM_FFN] + (size_t)l * D, (l & 1) != 0, C.in[I_ROUTER] + (size_t)(l >> 1) * D * NEXP, l >> 1, false, nullptr,  false); }
__device__ __forceinline__ void P_ffn_up(int wv) { const Ctx C = make_ctx(wv); using namespace pg8; unsigned char* ws = C.ws;
    Gemm g{(const bf16*)(ws + WS_H8), (const bf16*)(ws + WS_W13), D, D}; StaticOrder S; S.init(T, 2 * DFF, C.G, C.bid);
    EpiSwiglu E{ws + WS_HID, DFF, 1 << 20, false};
    gemm_phase8<EpiSwiglu, StaticOrder, true>(C.lds, C.tid, g, S, E); }
__device__ __forceinline__ void P_ffn_down(int wv) { const Ctx C = make_ctx(wv); using namespace pg8; unsigned char* ws = C.ws;
    Gemm g{(const bf16*)(ws + WS_HID), (const bf16*)(ws + WS_W2D), DFF, DFF}; StaticOrder S; S.init(T, D, C.G, C.bid);
    EpiResidual E{(bf16*)(ws + WS_XB), F8_DESCALE_DOWN};
    gemm_phase8<EpiResidual, StaticOrder, false, 1>(C.lds, C.tid, g, S, E); }
__device__ __forceinline__ void P_moe_scatter(int wv, int l2) { const Ctx C = make_ctx(wv); ph_moe_scatter_(C, l2); }
__device__ __forceinline__ void P_moe_up(int wv) { const Ctx C = make_ctx(wv); using namespace pg8; unsigned char* ws = C.ws;
    Gemm g{(const bf16*)(ws + WS_XS), (const bf16*)(ws + WS_W13), D, D};
    MoeOrder S{(const int*)(ws + WS_TEXP), __builtin_amdgcn_readfirstlane(*(const int*)(ws + WS_NT)), 2 * DFE / 256, C.G, C.bid};
    EpiSwiglu E{ws + WS_HIDM, DFE_PAD, 2 * DFE / 256, true};
    gemm_phase8<EpiSwiglu, MoeOrder, true>(C.lds, C.tid, g, S, E); }
__device__ __forceinline__ void P_moe_down(int wv) { const Ctx C = make_ctx(wv); using namespace pg8; unsigned char* ws = C.ws;
    Gemm g{(const bf16*)(ws + WS_HIDM), (const bf16*)(ws + WS_W2M), DFE_PAD, DFE_PAD};
    MoeOrder S{(const int*)(ws + WS_TEXP), __builtin_amdgcn_readfirstlane(*(const int*)(ws + WS_NT)), D / 256, C.G, C.bid};
    EpiBf16 E{(bf16*)(ws + WS_YS), D, 3, F8_DESCALE_DOWN};
    gemm_phase8<EpiBf16, MoeOrder, true, 1>(C.lds, C.tid, g, S, E); }
__device__ __forceinline__ void P_moe_combine(int wv) { const Ctx C = make_ctx(wv);
    const int gw = C.bid * NWAVES + C.wave, NGW = C.G * NWAVES, lane = C.lane;
    const int* slotof = (const int*)(C.ws + WS_SLOTOF); const float* gate = (const float*)(C.ws + WS_GATE); const bf16* YS = (const bf16*)(C.ws + WS_YS); const bf16* XB = (const bf16*)(C.ws + WS_XB);
    for (int m = gw; m < T; m += NGW) {
        const int s0 = slotof[2 * m], s1 = slotof[2 * m + 1]; const float g0 = gate[2 * m], g1 = gate[2 * m + 1];
        const u32x4* xb = (const u32x4*)(XB + (size_t)m * D) + lane; f32x4* xo = (f32x4*)(C.out + (size_t)m * D + 8 * lane);
        const u32x4* y0 = (const u32x4*)(YS + (size_t)s0 * D) + lane; const u32x4* y1 = (const u32x4*)(YS + (size_t)s1 * D) + lane;
#pragma unroll
        for (int j = 0; j < 2; ++j) { const u32x4 x = xb[64 * j], a = y0[64 * j], b = y1[64 * j]; f32x4 v0, v1;
            v0.x = bflo(x.x) + g0 * bflo(a.x) + g1 * bflo(b.x); v0.y = bfhi(x.x) + g0 * bfhi(a.x) + g1 * bfhi(b.x); v0.z = bflo(x.y) + g0 * bflo(a.y) + g1 * bflo(b.y); v0.w = bfhi(x.y) + g0 * bfhi(a.y) + g1 * bfhi(b.y);
            v1.x = bflo(x.z) + g0 * bflo(a.z) + g1 * bflo(b.z); v1.y = bfhi(x.z) + g0 * bfhi(a.z) + g1 * bfhi(b.z); v1.z = bflo(x.w) + g0 * bflo(a.w) + g1 * bflo(b.w); v1.w = bfhi(x.w) + g0 * bfhi(a.w) + g1 * bfhi(b.w);
            xo[128 * j] = v0; xo[128 * j + 1] = v1; }
    }
}

#ifndef PROBE_MASK
#define PROBE_MASK 0u
#endif
#ifndef PH_MASK
#define PH_MASK 0xffffffffu
#endif
__global__ void __launch_bounds__(NTHR, 2) hybrid_fwd(Args args) {
    (void)args;
    const int wv = __builtin_amdgcn_readfirstlane(threadIdx.x >> 6);
    { LAS unsigned char* lds = (LAS unsigned char*)lds_raw;
      for (int u = threadIdx.x; u < (LDS_BYTES - RING_BYTES) / 4; u += NTHR) ((LAS unsigned*)(lds + RING_BYTES))[u] = 0u; }
    __syncthreads();
    { const CAS Args* ka = ka_ptr();
      if (ka->ph_hi - ka->ph_lo > 1) { (void)xcd_barrier_post((unsigned*)(ka->ws + WS_CTL) + CW_BAR, (volatile LAS unsigned*)((LAS unsigned char*)lds_raw + MISC_OFF) + 8); } }
    int gp = 0;
#define PHASE(k, call) { const CAS Args* ka_ = ka_ptr(); const int lo_ = ka_->ph_lo, hi_ = ka_->ph_hi; if (lo_ <= gp && gp < hi_) { if constexpr ((PH_MASK >> (k)) & 1u) { call; if constexpr ((PROBE_MASK >> (k)) & 1u) { __syncthreads(); call; } } if (hi_ - lo_ > 1 && gp + 1 < hi_) grid_barrier(wv); } ++gp; }
    PHASE(0, P_prologue(wv))
#pragma unroll 1
    for (int l = 0; l < NLAYER; ++l) {
        PHASE(1, P_weights_norm(wv, l))
        PHASE(2, P_gemm_in(wv))
        PHASE(3, P_mix1(wv, l))
        PHASE(4, P_mix2(wv, l))
        PHASE(5, P_mix3(wv, l))
        PHASE(6, P_mix4(wv, l))
        PHASE(7, P_mix5(wv, l))
        PHASE(8, P_gemm_branch(wv))
        PHASE(9, P_gemm_gate(wv))
        PHASE(10, P_gemm_out(wv))
        PHASE(11, P_norm_ffn(wv, l))
        if (!(l & 1)) {
            PHASE(12, P_ffn_up(wv))
            PHASE(13, P_ffn_down(wv))
            gp += 2;
        } else {
            PHASE(14, P_moe_scatter(wv, l >> 1))
            PHASE(15, P_moe_up(wv))
            PHASE(16, P_moe_down(wv))
            if (l == NLAYER - 1) { PHASE(17, P_moe_combine(wv)) } else { ++gp; }
        }
    }
#undef PHASE
}
constexpr int N_PHASES = 1 + NLAYER * 15;

#ifndef MK_MULTI
#define MK_MULTI 0
#endif
extern "C" void kernel_launch(void* const* d_in, const int* in_sizes, int n_in, void* d_out, int out_size, void* d_ws, size_t ws_size, hipStream_t stream) {
    static int grid = 0;
    if (grid == 0) {
        if (n_in != 32 || in_sizes[0] != T * D || out_size != T * D || ws_size < WS_END) { fprintf(stderr, "kernel_launch: unexpected problem shape / workspace (%d inputs, ws %zu)\n", n_in, ws_size); grid = -1; return; }
        int dev = 0, cus = 0, per_cu = 0;
        if (hipGetDevice(&dev) != hipSuccess || hipDeviceGetAttribute(&cus, hipDeviceAttributeMultiprocessorCount, dev) != hipSuccess) { grid = -1; return; }
        if (hipFuncSetAttribute((const void*)hybrid_fwd, hipFuncAttributeMaxDynamicSharedMemorySize, LDS_BYTES) != hipSuccess) { fprintf(stderr, "kernel_launch: hipFuncSetAttribute failed\n"); grid = -1; return; }
        if (hipOccupancyMaxActiveBlocksPerMultiprocessor(&per_cu, (const void*)hybrid_fwd, NTHR, LDS_BYTES) != hipSuccess || per_cu < 1) { fprintf(stderr, "kernel_launch: occupancy query says %d\n", per_cu); }
        (void)hipGetLastError();
        grid = cus;
    }
    if (grid < 0) return;
    (void)hipMemsetAsync((char*)d_ws + WS_CTL, 0, CTL_ZERO_BYTES, stream);
#ifdef DBG_ZERO_WS
    (void)hipMemsetAsync((char*)d_ws + CTL_ZERO_BYTES, 0, WS_END - CTL_ZERO_BYTES, stream);
#endif
    Args a{};
    for (int i = 0; i < 32; ++i) a.in[i] = (const float*)d_in[i];
    a.out = (float*)d_out; a.ws = (unsigned char*)d_ws;
#if MK_MULTI
    for (int p = 0; p < N_PHASES; ++p) { a.ph_lo = p; a.ph_hi = p + 1; hipLaunchKernelGGL(hybrid_fwd, dim3(grid), dim3(NTHR), LDS_BYTES, stream, a); }
#else
    a.ph_lo = 0; a.ph_hi = N_PHASES; hipLaunchKernelGGL(hybrid_fwd, dim3(grid), dim3(NTHR), LDS_BYTES, stream, a);
#endif
}
```

```cpp
#include <hip/hip_runtime.h>
#include <cstdio>
#include <cstdint>

#define GAS __attribute__((address_space(1)))
#define LAS __attribute__((address_space(3)))
typedef unsigned short bf16;
typedef unsigned u32x4 __attribute__((ext_vector_type(4)));
typedef unsigned u32x2 __attribute__((ext_vector_type(2)));
typedef float f32x4 __attribute__((ext_vector_type(4)));
typedef float f32x2 __attribute__((ext_vector_type(2)));
typedef short bf16x8 __attribute__((ext_vector_type(8)));
typedef float f32x16 __attribute__((ext_vector_type(16)));
typedef short s16x4 __attribute__((ext_vector_type(4)));

constexpr int SEQ = 16384, NBATCH = 2, T = NBATCH * SEQ, D = 1024, NIN = 3328, DFF = 2816, DFE = 1408, NEXP = 8, NLAYER = 4;
constexpr int MPAD = 2 * T + NEXP * 256;
constexpr int NWAVES = 8, NTHR = 512;
constexpr float LOG2E = 1.4426950408889634f;
constexpr int MM_LP = 72;

typedef __bf16 bf16x2_t __attribute__((ext_vector_type(2)));
__device__ __forceinline__ unsigned cvt_pk_bf16(float lo, float hi) { const f32x2 v = {lo, hi}; const bf16x2_t b = __builtin_convertvector(v, bf16x2_t); return __builtin_bit_cast(unsigned, b); }
__device__ __forceinline__ float bflo(unsigned u) { return __builtin_bit_cast(float, u << 16); }
__device__ __forceinline__ float bfhi(unsigned u) { return __builtin_bit_cast(float, u & 0xffff0000u); }
__device__ __forceinline__ float bf2f(bf16 u) { return __builtin_bit_cast(float, (unsigned)u << 16); }
__device__ __forceinline__ bf16 f2bf(float f) { return (bf16)(cvt_pk_bf16(f, 0.f) & 0xffffu); }
__device__ __forceinline__ float sigm(float x) { return __builtin_amdgcn_rcpf(1.f + __builtin_amdgcn_exp2f(-x * LOG2E)); }
__device__ __forceinline__ float shx(float v, int o, int lane) { return __builtin_bit_cast(float, __builtin_amdgcn_ds_bpermute((lane ^ o) << 2, __builtin_bit_cast(int, v))); }
__device__ __forceinline__ float dpp_add(float v, const int ctrl_id) {
    const int x = __builtin_bit_cast(int, v);
    int y;
    if (ctrl_id == 0) y = __builtin_amdgcn_update_dpp(0, x, 0xB1, 0xF, 0xF, true);
    else if (ctrl_id == 1) y = __builtin_amdgcn_update_dpp(0, x, 0x4E, 0xF, 0xF, true);
    else if (ctrl_id == 2) y = __builtin_amdgcn_update_dpp(0, x, 0x141, 0xF, 0xF, true);
    else y = __builtin_amdgcn_update_dpp(0, x, 0x140, 0xF, 0xF, true);
    return v + __builtin_bit_cast(float, y);
}
__device__ __forceinline__ float wave_sum(float v, int lane) {
    (void)lane;
    v = dpp_add(v, 0); v = dpp_add(v, 1); v = dpp_add(v, 2); v = dpp_add(v, 3);
    const int x = __builtin_bit_cast(int, v);
    const float s0 = __builtin_bit_cast(float, __builtin_amdgcn_readlane(x, 0)), s1 = __builtin_bit_cast(float, __builtin_amdgcn_readlane(x, 16)),
                s2 = __builtin_bit_cast(float, __builtin_amdgcn_readlane(x, 32)), s3 = __builtin_bit_cast(float, __builtin_amdgcn_readlane(x, 48));
    return (s0 + s1) + (s2 + s3);
}
__device__ __forceinline__ void unpack8(const u32x4 v, float* f) {
    f[0] = bflo(v.x); f[1] = bfhi(v.x); f[2] = bflo(v.y); f[3] = bfhi(v.y); f[4] = bflo(v.z); f[5] = bfhi(v.z); f[6] = bflo(v.w); f[7] = bfhi(v.w);
}
__device__ __forceinline__ unsigned pk4_fp8(float a, float b, float c, float d) {
    a = __builtin_amdgcn_fmed3f(a, -440.f, 440.f); b = __builtin_amdgcn_fmed3f(b, -440.f, 440.f); c = __builtin_amdgcn_fmed3f(c, -440.f, 440.f); d = __builtin_amdgcn_fmed3f(d, -440.f, 440.f);
    int w = __builtin_amdgcn_cvt_pk_fp8_f32(a, b, 0, false); w = __builtin_amdgcn_cvt_pk_fp8_f32(c, d, w, true); return (unsigned)w; }
__device__ __forceinline__ u32x4 pack8(const float* f) {
    u32x4 w; w.x = cvt_pk_bf16(f[0], f[1]); w.y = cvt_pk_bf16(f[2], f[3]); w.z = cvt_pk_bf16(f[4], f[5]); w.w = cvt_pk_bf16(f[6], f[7]); return w;
}


#ifndef PROBE2
#define PROBE2 0
#endif
#ifndef GMASK
#define GMASK 15
#endif
#ifndef RWDBG
#define RWDBG 0
#endif
typedef int i32x8 __attribute__((ext_vector_type(8)));
constexpr float F8_MUL_X = 16.f, F8_MUL_W = 256.f, F8_DESCALE = 1.0f / (16.f * 256.f), F8_MUL_H = 4.f, F8_DESCALE_DOWN = 1.0f / (4.f * 256.f);
constexpr int DFE_PAD = 1536;
namespace pg8 {
typedef unsigned short bf16_t;
constexpr int BM = 256, BK = 64, HALF = 128, HTB = HALF * BK * 2, NXCD = 8, WGM = 8;
__host__ __device__ __forceinline__ int lds_byte(int r, int c) { const int st = (r >> 4) * 2 + (c >> 5), rr = r & 15, cc = c & 31, ob = rr * 64 + cc * 2; return st * 1024 + (ob ^ (((ob >> 9) & 1) << 5)); }
__host__ __device__ __forceinline__ void stage_rc(int b, int& R, int& C) { const int st = b / 1024, sb = b % 1024, swz = sb ^ (((sb >> 9) & 1) << 5); R = (st >> 1) * 16 + swz / 64; C = (st & 1) * 32 + (swz % 64) / 2; }
__host__ __device__ __forceinline__ int perm32(int rho) { const int n = rho >> 4, i = rho & 15; return 8 * (i >> 2) + 4 * n + (i & 3); }

struct Unit { int pm, pn, aoff; };
struct Gemm { const bf16_t* A; const bf16_t* Bt; int lda, K; };

struct StaticOrder {
    int nM, nN, nwg, G, c, ashift, amul;
    __device__ void init(int M, int N, int G_, int c_, int ashift_ = 0, int amul_ = 0) { nM = M / BM; nN = N / BM; nwg = nM * nN; G = G_; c = c_; ashift = ashift_; amul = amul_; }
    __device__ bool next(int i, Unit& u) const {
        const long L = (long)i * G + c; if (L >= nwg) return false;
        int wgid = (int)L; { const int q = nwg / NXCD, r = nwg % NXCD, xcd = wgid % NXCD, off = wgid / NXCD; wgid = (xcd < r ? xcd * (q + 1) : r * (q + 1) + (xcd - r) * q) + off; }
        const int nig = WGM * nN, gid = wgid / nig, fm = gid * WGM, gsz = (nM - fm) < WGM ? (nM - fm) : WGM;
        u.pm = fm + ((wgid % nig) % gsz); u.pn = (wgid % nig) / gsz; u.aoff = (u.pn >> ashift) * amul; return true;
    }
};
struct MoeOrder {
    const int* texp; int ntiles, ncol, G, c;
    __device__ bool next(int i, Unit& u) const {
        const int L = i * G + c; if (L >= ntiles * ncol) return false;
        const int pm = L / ncol, pl = L % ncol;
        u.pm = pm; u.pn = texp[pm] * ncol + pl; u.aoff = 0; return true;
    }
};

template <class Epi, class Sched, bool ALIGN_EPI, int CMAP = 0>
__device__ __forceinline__ void gemm_phase(LAS unsigned char* lds, const int tid_in, const Gemm g, const Sched& S, const Epi& E) {
    const int tid = tid_in, wid = __builtin_amdgcn_readfirstlane(tid >> 6), lane = tid & 63, wr = wid >> 2, wc = wid & 3, fr = lane & 15, fq = lane >> 4;
    const int K = g.K, nt = K / BK, lda = g.lda;
    unsigned voffA[2], voffB[2];
#pragma unroll
    for (int i = 0; i < 2; ++i) { int R, C; stage_rc(tid * 16 + i * 8192, R, C); const int p32 = perm32(R & 31); const int Rb = CMAP ? 64 * (R >> 5) + 16 * (p32 >> 3) + (p32 & 7) : (R & ~31) + p32;
        voffA[i] = (unsigned)(R * lda + C) * 2u; voffB[i] = (unsigned)(Rb * K + C) * 2u; }
    const size_t kstep = (size_t)(BK * 2);
    const size_t hstepA = (size_t)HALF * lda * 2, tstepA = 2 * hstepA, hstepB = (size_t)(CMAP ? 8 : HALF) * K * 2, tstepB = (size_t)BM * K * 2;
    const unsigned ldsw = (unsigned)wid * 1024u;
    const int aoff = lds_byte(wr * 64 + fr, fq * 8), boff = lds_byte(wc * 32 + fr, fq * 8);
#define PG8_SA(b, h) (((b) * 2 + (h)) * HTB)
#define PG8_SB(b, h) ((4 + (b) * 2 + (h)) * HTB)
#define PG8_STAGE(bufoff, gbase, voff) do { _Pragma("unroll") for (int _i = 0; _i < 2; ++_i) \
        __builtin_amdgcn_global_load_lds((const unsigned*)((const char*)(gbase) + (voff)[_i]), (LAS unsigned*)(lds + (bufoff) + ldsw + _i * 8192), 16, 0, 0); } while (0)
#define PG8_LDA(dst, b, h) do { _Pragma("unroll") for (int m = 0; m < 4; ++m) _Pragma("unroll") for (int k = 0; k < 2; ++k) dst[m][k] = *(const LAS bf16x8*)(lds + PG8_SA(b, h) + aoff + m * 2048 + k * 1024); } while (0)
#define PG8_LDB(dst, b, h) do { _Pragma("unroll") for (int n = 0; n < 2; ++n) _Pragma("unroll") for (int k = 0; k < 2; ++k) dst[n][k] = *(const LAS bf16x8*)(lds + PG8_SB(b, h) + boff + n * 2048 + k * 1024); } while (0)
#define PG8_MMA(ai, bj, At, Bt) do { __builtin_amdgcn_s_setprio(1); _Pragma("unroll") for (int m = 0; m < 4; ++m) _Pragma("unroll") for (int n = 0; n < 2; ++n) _Pragma("unroll") for (int k = 0; k < 2; ++k) \
        acc[ai][bj][m][n] = __builtin_amdgcn_mfma_f32_16x16x32_bf16(Bt[n][k], At[m][k], acc[ai][bj][m][n], 0, 0, 0); __builtin_amdgcn_s_setprio(0); } while (0)
#define PG8_WAIT_V(n) asm volatile("s_waitcnt vmcnt(" #n ")" ::: "memory")
#define PG8_WAIT_L(n) asm volatile("s_waitcnt lgkmcnt(" #n ")" ::: "memory")
#define PG8_BAR __builtin_amdgcn_s_barrier()
#define PG8_SCHED __builtin_amdgcn_sched_barrier(0)
    Unit cur, nxt; int ui = 0;
    if (!S.next(0, cur)) return;
    f32x4 acc[2][2][4][2];
#pragma unroll
    for (int a = 0; a < 2; ++a)
#pragma unroll
        for (int b = 0; b < 2; ++b)
#pragma unroll
            for (int m = 0; m < 4; ++m)
#pragma unroll
                for (int n = 0; n < 2; ++n) acc[a][b][m][n] = (f32x4){0.f, 0.f, 0.f, 0.f};
    bf16x8 At[4][2], B0[2][2], B1[2][2];
    const char* cA = (const char*)g.A + (size_t)cur.pm * tstepA + cur.aoff; const char* cB = (const char*)g.Bt + (size_t)cur.pn * tstepB;
    PG8_STAGE(PG8_SB(0, 0), cB, voffB); PG8_STAGE(PG8_SB(0, 1), cB + hstepB, voffB); PG8_STAGE(PG8_SA(0, 0), cA, voffA); PG8_STAGE(PG8_SA(0, 1), cA + hstepA, voffA);
    if (wr == 1) PG8_BAR;
    PG8_WAIT_V(2); PG8_BAR;
    PG8_STAGE(PG8_SB(1, 0), cB + kstep, voffB); PG8_STAGE(PG8_SA(1, 0), cA + kstep, voffA); PG8_STAGE(PG8_SB(1, 1), cB + hstepB + kstep, voffB);
    PG8_WAIT_V(6); PG8_BAR;
    for (;;) {
        const bool has_next = S.next(ui + 1, nxt);
        const char* nA = has_next ? (const char*)g.A + (size_t)nxt.pm * tstepA + nxt.aoff : cA; const char* nB = has_next ? (const char*)g.Bt + (size_t)nxt.pn * tstepB : cB;
#pragma unroll 1
        for (int t = 0; t < nt; t += 2) {
            const bool last = (t == nt - 2);
            const char* a1 = cA + (size_t)(t + 1) * kstep;
            const char* a2 = last ? nA : cA + (size_t)(t + 2) * kstep; const char* b2 = last ? nB : cB + (size_t)(t + 2) * kstep;
            const char* a3 = a2 + kstep; const char* b3 = b2 + kstep;
            PG8_LDB(B0, 0, 0); PG8_LDB(B1, 0, 1); PG8_SCHED; PG8_LDA(At, 0, 0); PG8_STAGE(PG8_SA(1, 1), a1 + hstepA, voffA);
            PG8_WAIT_V(8); PG8_WAIT_L(0); PG8_BAR; PG8_MMA(0, 0, At, B0); PG8_MMA(0, 1, At, B1); PG8_BAR; PG8_SCHED;
            PG8_LDA(At, 0, 1); PG8_STAGE(PG8_SB(0, 0), b2, voffB); PG8_STAGE(PG8_SB(0, 1), b2 + hstepB, voffB); PG8_STAGE(PG8_SA(0, 0), a2, voffA);
            PG8_WAIT_V(8); PG8_WAIT_L(0); PG8_BAR; PG8_MMA(1, 0, At, B0); PG8_MMA(1, 1, At, B1); PG8_BAR; PG8_SCHED;
            PG8_LDB(B0, 1, 0); PG8_LDB(B1, 1, 1); PG8_SCHED; PG8_LDA(At, 1, 0); PG8_STAGE(PG8_SA(0, 1), a2 + hstepA, voffA);
            PG8_WAIT_V(8); PG8_WAIT_L(0); PG8_BAR; PG8_MMA(0, 0, At, B0); PG8_MMA(0, 1, At, B1); PG8_BAR; PG8_SCHED;
            PG8_LDA(At, 1, 1); PG8_STAGE(PG8_SB(1, 0), b3, voffB); PG8_STAGE(PG8_SB(1, 1), b3 + hstepB, voffB); PG8_STAGE(PG8_SA(1, 0), a3, voffA);
            PG8_WAIT_V(8); PG8_WAIT_L(0); PG8_BAR; PG8_MMA(1, 0, At, B0); PG8_MMA(1, 1, At, B1); PG8_BAR; PG8_SCHED;
        }
        if constexpr (ALIGN_EPI) { if (wr == 0) PG8_BAR; }
        { int ln_; asm volatile("v_mbcnt_lo_u32_b32 %0, -1, 0\n\tv_mbcnt_hi_u32_b32 %0, -1, %0" : "=v"(ln_)); E(acc, cur, wr, wc, ln_ & 15, ln_ >> 4); }
        if (!has_next) break;
#pragma unroll
        for (int a = 0; a < 2; ++a)
#pragma unroll
            for (int b = 0; b < 2; ++b)
#pragma unroll
                for (int m = 0; m < 4; ++m)
#pragma unroll
                    for (int n = 0; n < 2; ++n) acc[a][b][m][n] = (f32x4){0.f, 0.f, 0.f, 0.f};
        cur = nxt; cA = nA; cB = nB; ++ui;
        if constexpr (ALIGN_EPI) { if (wr == 1) PG8_BAR; }
    }
    PG8_WAIT_V(0);
    if constexpr (!ALIGN_EPI) { if (wr == 0) PG8_BAR; }
    PG8_BAR;
#undef PG8_SA
#undef PG8_SB
#undef PG8_STAGE
#undef PG8_LDA
#undef PG8_LDB
#undef PG8_MMA
#undef PG8_WAIT_V
#undef PG8_WAIT_L
#undef PG8_BAR
#undef PG8_SCHED
}

template <class Epi, class Sched, bool ALIGN_EPI, int CMAP = 0>
__device__ __forceinline__ void gemm_phase8(LAS unsigned char* lds, const int tid_in, const Gemm g, const Sched& S, const Epi& E) {
    const int tid = tid_in, wid = __builtin_amdgcn_readfirstlane(tid >> 6), lane = tid & 63, wr = wid >> 2, wc = wid & 3, fr = lane & 15, fq = lane >> 4;
    const int K = g.K, nt = K / 128, lda = g.lda;
    unsigned voffA, voffB;
    { int R, C; stage_rc(tid * 16, R, C); const int p32 = perm32(R & 31); const int Rb = CMAP ? 64 * (R >> 5) + 16 * (p32 >> 3) + (p32 & 7) : (R & ~31) + p32; voffA = (unsigned)(R * lda + C * 2); voffB = (unsigned)(Rb * K + C * 2); }
    const unsigned pstepA = 64u * (unsigned)lda, pstepB = (CMAP ? 128u : 64u) * (unsigned)K;
    const unsigned kstep = (unsigned)(BK * 2);
    const unsigned hstepA = (unsigned)HALF * (unsigned)lda, tstepA = 2 * hstepA, hstepB = (unsigned)(CMAP ? 8 : HALF) * (unsigned)K, tstepB = (unsigned)BM * (unsigned)K;
    const __amdgpu_buffer_rsrc_t rsA = __builtin_amdgcn_make_buffer_rsrc((void*)g.A, 0, 0x7fffffff, 0x00020000), rsB = __builtin_amdgcn_make_buffer_rsrc((void*)g.Bt, 0, 0x7fffffff, 0x00020000);
    const unsigned ldsw = (unsigned)wid * 1024u;
    const int aoff0 = lds_byte(wr * 64 + fr, fq * 8), aoff1 = aoff0 + 1024, boff0 = lds_byte(wc * 32 + fr, fq * 8), boff1 = boff0 + 1024;
#define PG8_SA(b, h) (((b) * 2 + (h)) * HTB)
#define PG8_SB(b, h) ((4 + (b) * 2 + (h)) * HTB)
#define PG8_STAGE(bufoff, goff, voff, pstep) do { _Pragma("unroll") for (int _i = 0; _i < 2; ++_i) \
        __builtin_amdgcn_raw_ptr_buffer_load_lds(PG8_RS_##voff, (LAS unsigned*)(lds + (bufoff) + ldsw + _i * 8192), 16, (int)(voff), (int)((goff) + _i * (pstep)), 0, 0); } while (0)
#define PG8_RS_voffA rsA
#define PG8_RS_voffB rsB
#define PG8_LDA(dst, b, h) do { _Pragma("unroll") for (int m = 0; m < 4; ++m) { dst[m][0] = *(const LAS u32x4*)(lds + PG8_SA(b, h) + aoff0 + m * 2048); dst[m][1] = *(const LAS u32x4*)(lds + PG8_SA(b, h) + aoff1 + m * 2048); } } while (0)
#define PG8_LDB(dst, b, h) do { _Pragma("unroll") for (int n = 0; n < 2; ++n) { dst[n][0] = *(const LAS u32x4*)(lds + PG8_SB(b, h) + boff0 + n * 2048); dst[n][1] = *(const LAS u32x4*)(lds + PG8_SB(b, h) + boff1 + n * 2048); } } while (0)
#define PG8_J8(x) __builtin_bit_cast(i32x8, __builtin_shufflevector((x)[0], (x)[1], 0, 1, 2, 3, 4, 5, 6, 7))
#define PG8_MMA(ai, bj, At, Bt) do { __builtin_amdgcn_s_setprio(1); _Pragma("unroll") for (int m = 0; m < 4; ++m) _Pragma("unroll") for (int n = 0; n < 2; ++n) \
        acc[ai][bj][m][n] = __builtin_amdgcn_mfma_scale_f32_16x16x128_f8f6f4(PG8_J8(Bt[n]), PG8_J8(At[m]), acc[ai][bj][m][n], 0, 0, 0, 0, 0, 0);        __builtin_amdgcn_s_setprio(0); } while (0)
#define PG8_WAIT_V(n) asm volatile("s_waitcnt vmcnt(" #n ")" ::: "memory")
#define PG8_WAIT_L(n) asm volatile("s_waitcnt lgkmcnt(" #n ")" ::: "memory")
#define PG8_BAR __builtin_amdgcn_s_barrier()
#define PG8_SCHED __builtin_amdgcn_sched_barrier(0)
    Unit cur, nxt; int ui = 0;
    if (!S.next(0, cur)) return;
    f32x4 acc[2][2][4][2];
#pragma unroll
    for (int a = 0; a < 2; ++a)
#pragma unroll
        for (int b = 0; b < 2; ++b)
#pragma unroll
            for (int m = 0; m < 4; ++m)
#pragma unroll
                for (int n = 0; n < 2; ++n) acc[a][b][m][n] = (f32x4){0.f, 0.f, 0.f, 0.f};
    u32x4 At[4][2], B0[2][2], B1[2][2];
    unsigned cA = (unsigned)cur.pm * tstepA + (unsigned)cur.aoff, cB = (unsigned)cur.pn * tstepB;
    PG8_STAGE(PG8_SB(0, 0), cB, voffB, pstepB); PG8_STAGE(PG8_SB(0, 1), cB + hstepB, voffB, pstepB); PG8_STAGE(PG8_SA(0, 0), cA, voffA, pstepA); PG8_STAGE(PG8_SA(0, 1), cA + hstepA, voffA, pstepA);
    if (wr == 1) PG8_BAR;
    PG8_WAIT_V(2); PG8_BAR;
    PG8_STAGE(PG8_SB(1, 0), cB + kstep, voffB, pstepB); PG8_STAGE(PG8_SA(1, 0), cA + kstep, voffA, pstepA); PG8_STAGE(PG8_SB(1, 1), cB + hstepB + kstep, voffB, pstepB);
    PG8_WAIT_V(6); PG8_BAR;
    for (;;) {
        const bool has_next = S.next(ui + 1, nxt);
        const unsigned nA = has_next ? (unsigned)nxt.pm * tstepA + (unsigned)nxt.aoff : cA, nB = has_next ? (unsigned)nxt.pn * tstepB : cB;
#pragma unroll 1
        for (int t = 0; t < nt; t += 2) {
            const bool last = (t == nt - 2);
            const unsigned a1 = cA + (unsigned)(t + 1) * kstep;
            const unsigned a2 = last ? nA : cA + (unsigned)(t + 2) * kstep, b2 = last ? nB : cB + (unsigned)(t + 2) * kstep;
            const unsigned a3 = a2 + kstep, b3 = b2 + kstep;
            PG8_LDB(B0, 0, 0); PG8_LDB(B1, 0, 1); PG8_SCHED; PG8_LDA(At, 0, 0); PG8_STAGE(PG8_SA(1, 1), a1 + hstepA, voffA, pstepA);
            PG8_WAIT_V(8); PG8_WAIT_L(0); PG8_BAR; PG8_MMA(0, 0, At, B0); PG8_MMA(0, 1, At, B1); PG8_BAR; PG8_SCHED;
            PG8_LDA(At, 0, 1); PG8_STAGE(PG8_SB(0, 0), b2, voffB, pstepB); PG8_STAGE(PG8_SB(0, 1), b2 + hstepB, voffB, pstepB); PG8_STAGE(PG8_SA(0, 0), a2, voffA, pstepA);
            PG8_WAIT_V(8); PG8_WAIT_L(0); PG8_BAR; PG8_MMA(1, 0, At, B0); PG8_MMA(1, 1, At, B1); PG8_BAR; PG8_SCHED;
            PG8_LDB(B0, 1, 0); PG8_LDB(B1, 1, 1); PG8_SCHED; PG8_LDA(At, 1, 0); PG8_STAGE(PG8_SA(0, 1), a2 + hstepA, voffA, pstepA);
            PG8_WAIT_V(8); PG8_WAIT_L(0); PG8_BAR; PG8_MMA(0, 0, At, B0); PG8_MMA(0, 1, At, B1); PG8_BAR; PG8_SCHED;
            PG8_LDA(At, 1, 1); PG8_STAGE(PG8_SB(1, 0), b3, voffB, pstepB); PG8_STAGE(PG8_SB(1, 1), b3 + hstepB, voffB, pstepB); PG8_STAGE(PG8_SA(1, 0), a3, voffA, pstepA);
            PG8_WAIT_V(8); PG8_WAIT_L(0); PG8_BAR; PG8_MMA(1, 0, At, B0); PG8_MMA(1, 1, At, B1); PG8_BAR; PG8_SCHED;
        }
        if constexpr (ALIGN_EPI) { if (wr == 0) PG8_BAR; }
        { int ln_; asm volatile("v_mbcnt_lo_u32_b32 %0, -1, 0\n\tv_mbcnt_hi_u32_b32 %0, -1, %0" : "=v"(ln_)); E(acc, cur, wr, wc, ln_ & 15, ln_ >> 4); }
        if (!has_next) break;
#pragma unroll
        for (int a = 0; a < 2; ++a)
#pragma unroll
            for (int b = 0; b < 2; ++b)
#pragma unroll
                for (int m = 0; m < 4; ++m)
#pragma unroll
                    for (int n = 0; n < 2; ++n) acc[a][b][m][n] = (f32x4){0.f, 0.f, 0.f, 0.f};
        cur = nxt; cA = nA; cB = nB; ++ui;
        if constexpr (ALIGN_EPI) { if (wr == 1) PG8_BAR; }
    }
    PG8_WAIT_V(0);
    if constexpr (!ALIGN_EPI) { if (wr == 0) PG8_BAR; }
    PG8_BAR;
#undef PG8_SA
#undef PG8_SB
#undef PG8_STAGE
#undef PG8_RS_voffA
#undef PG8_RS_voffB
#undef PG8_LDA
#undef PG8_LDB
#undef PG8_MMA
#undef PG8_J8
#undef PG8_WAIT_V
#undef PG8_WAIT_L
#undef PG8_BAR
#undef PG8_SCHED
}

typedef f32x4 Acc[2][2][4][2];

__device__ __forceinline__ unsigned dpp_ror8(unsigned v) { return (unsigned)__builtin_amdgcn_update_dpp(0, (int)v, 0x128, 0xf, 0xf, false); }
struct CmPair { unsigned a, b; };
__device__ __forceinline__ CmPair cm_swapv(bool lo, unsigned x0, unsigned x1) { const unsigned r = dpp_ror8(lo ? x1 : x0); CmPair o; o.a = lo ? x0 : r; o.b = lo ? r : x1; return o; }
#define CM_SWAP_U(lo, X0, X1) do { const CmPair r_ = cm_swapv(lo, X0, X1); X0 = r_.a; X1 = r_.b; } while (0)
#define CM_SWAP_F(lo, X0, X1) do { const CmPair r_ = cm_swapv(lo, __builtin_bit_cast(unsigned, (float)(X0)), __builtin_bit_cast(unsigned, (float)(X1))); X0 = __builtin_bit_cast(float, r_.a); X1 = __builtin_bit_cast(float, r_.b); } while (0)
#define cm_swap4(lo, w0, w1) do { CM_SWAP_U(lo, w0.x, w1.x); CM_SWAP_U(lo, w0.y, w1.y); CM_SWAP_U(lo, w0.z, w1.z); CM_SWAP_U(lo, w0.w, w1.w); } while (0)
struct EpiRoute {
    bf16_t *d0, *d1, *d2, *d3;
    __device__ __forceinline__ void operator()(const Acc& acc, const Unit& u, int wr, int wc, int fr, int fq) const {
        const int pn = u.pn; bf16_t* base; int ld, ct;
        if (pn < 4) { base = d0; ld = 1024; ct = pn; } else if (pn < 7) { base = d1; ld = 768; ct = pn - 4; } else if (pn < 11) { base = d2; ld = 1024; ct = pn - 7; } else { base = d3; ld = 512; ct = pn - 11; }
        const bool lo = fr < 8;
        const int row0 = u.pm * BM + wr * 64 + (fr & 7), col0 = ct * 256 + wc * 64 + 16 * fq + 8 * (fr >> 3);
#pragma unroll
        for (int ai = 0; ai < 2; ++ai)
#pragma unroll
            for (int m = 0; m < 4; ++m) { bf16_t* rowp = base + (size_t)(row0 + ai * HALF + m * 16) * ld + col0; u32x4 w0, w1;
                { const f32x4 v0 = acc[ai][0][m][0], v1 = acc[ai][0][m][1]; w0.x = cvt_pk_bf16(v0[0], v0[1]); w0.y = cvt_pk_bf16(v0[2], v0[3]); w0.z = cvt_pk_bf16(v1[0], v1[1]); w0.w = cvt_pk_bf16(v1[2], v1[3]); }
                { const f32x4 v0 = acc[ai][1][m][0], v1 = acc[ai][1][m][1]; w1.x = cvt_pk_bf16(v0[0], v0[1]); w1.y = cvt_pk_bf16(v0[2], v0[3]); w1.z = cvt_pk_bf16(v1[0], v1[1]); w1.w = cvt_pk_bf16(v1[2], v1[3]); }
                cm_swap4(lo, w0, w1);
                *(u32x4*)rowp = w0; *(u32x4*)(rowp + (size_t)8 * ld) = w1; }
    }
};
struct EpiBf16 {
    bf16_t* O; int ld, pnmask; float sc;
    __device__ __forceinline__ void operator()(const Acc& acc, const Unit& u, int wr, int wc, int fr, int fq) const {
        const bool lo = fr < 8;
        const int row0 = u.pm * BM + wr * 64 + (fr & 7), col0 = (u.pn & pnmask) * 256 + wc * 64 + 16 * fq + 8 * (fr >> 3);
#pragma unroll
        for (int ai = 0; ai < 2; ++ai)
#pragma unroll
            for (int m = 0; m < 4; ++m) { bf16_t* rowp = O + (size_t)(row0 + ai * HALF + m * 16) * ld + col0; u32x4 w0, w1;
                { const f32x4 v0 = acc[ai][0][m][0] * sc, v1 = acc[ai][0][m][1] * sc; w0.x = cvt_pk_bf16(v0[0], v0[1]); w0.y = cvt_pk_bf16(v0[2], v0[3]); w0.z = cvt_pk_bf16(v1[0], v1[1]); w0.w = cvt_pk_bf16(v1[2], v1[3]); }
                { const f32x4 v0 = acc[ai][1][m][0] * sc, v1 = acc[ai][1][m][1] * sc; w1.x = cvt_pk_bf16(v0[0], v0[1]); w1.y = cvt_pk_bf16(v0[2], v0[3]); w1.z = cvt_pk_bf16(v1[0], v1[1]); w1.w = cvt_pk_bf16(v1[2], v1[3]); }
                cm_swap4(lo, w0, w1);
                *(u32x4*)rowp = w0; *(u32x4*)(rowp + (size_t)8 * ld) = w1; }
    }
};
struct EpiLora {
    float* wdec; bf16_t* ag; const float* w0; const float* a0;
    __device__ __forceinline__ void operator()(const Acc& acc, const Unit& u, int wr, int wc, int fr, int fq) const {
        const int row0 = u.pm * BM + wr * 64 + fr, cl0 = wc * 32 + 8 * fq, pn = u.pn;
#pragma unroll
        for (int ai = 0; ai < 2; ++ai)
#pragma unroll
            for (int m = 0; m < 4; ++m) { const size_t row = (size_t)(row0 + ai * HALF + m * 16);
#pragma unroll
                for (int bj = 0; bj < 2; ++bj) { const int col = bj * HALF + cl0; float v[8];
#pragma unroll
                    for (int n = 0; n < 2; ++n)
#pragma unroll
                        for (int e = 0; e < 4; ++e) v[4 * n + e] = acc[ai][bj][m][n][e];
                    if (pn == 0) {
                        *(f32x4*)(wdec + row * 256 + col) = (f32x4){v[0], v[1], v[2], v[3]}; *(f32x4*)(wdec + row * 256 + col + 4) = (f32x4){v[4], v[5], v[6], v[7]};
                    } else if (pn == 1) {
                        *(u32x4*)(ag + row * 512 + col) = pack8(v);
                    } else { *(u32x4*)(ag + row * 512 + 256 + col) = pack8(v); }
                } }
    }
};
struct EpiBall {
    unsigned char* O;
    __device__ __forceinline__ void operator()(const Acc& acc, const Unit& u, int wr, int wc, int fr, int fq) const {
        unsigned char* base = O + ((size_t)(u.pm * 16 + u.pn) << 17) + (wc >> 1) * 32768 + (wr * 2 + (wc & 1)) * 1024 + (fr + 16 * fq) * 16;
#pragma unroll
        for (int ai = 0; ai < 2; ++ai)
#pragma unroll
            for (int m = 0; m < 4; ++m)
#pragma unroll
                for (int bj = 0; bj < 2; ++bj) { const f32x4 v0 = acc[ai][bj][m][0], v1 = acc[ai][bj][m][1]; u32x4 w;
                    w.x = cvt_pk_bf16(v0[0], v0[1]); w.y = cvt_pk_bf16(v0[2], v0[3]); w.z = cvt_pk_bf16(v1[0], v1[1]); w.w = cvt_pk_bf16(v1[2], v1[3]);
                    __builtin_nontemporal_store(w, (u32x4*)(base + bj * 65536 + (ai * 4 + m) * 4096)); }
    }
};
struct EpiGateMerge {
    const bf16_t* ball; bf16_t* merged;
    __device__ __forceinline__ void operator()(const Acc& acc, const Unit& u, int wr, int wc, int fr, int fq) const {
        const int row0 = u.pm * BM + wr * 64 + fr, o0 = 64 * u.pn + 16 * wc + 4 * fq;
        const int cw = 64 * (u.pn & 3) + 16 * wc + 4 * fq;
        const unsigned char* lbase = (const unsigned char*)ball + ((size_t)(u.pm * 16 + (u.pn >> 2)) << 17) + (cw >> 7) * 65536 + ((cw >> 6) & 1) * 32768 + (wr * 2 + ((cw >> 5) & 1)) * 1024 + (fr + 16 * ((cw >> 3) & 3)) * 16 + ((cw >> 2) & 1) * 8;
        u32x2 bb[2][4][4];
#pragma unroll
        for (int ai = 0; ai < 2; ++ai)
#pragma unroll
            for (int m = 0; m < 4; ++m)
#pragma unroll
                for (int gi = 0; gi < 4; ++gi) bb[ai][m][gi] = __builtin_nontemporal_load((const u32x2*)(lbase + ((size_t)gi << 19) + (ai * 4 + m) * 4096));
#pragma unroll
        for (int ai = 0; ai < 2; ++ai)
#pragma unroll
            for (int m = 0; m < 4; ++m) { const size_t row = (size_t)(row0 + ai * HALF + m * 16); float s[4] = {0.f, 0.f, 0.f, 0.f};
#pragma unroll
                for (int bj = 0; bj < 2; ++bj)
#pragma unroll
                    for (int n = 0; n < 2; ++n) { const int gi = 2 * bj + n; const u32x2 b = bb[ai][m][gi];
                        const f32x4 a = acc[ai][bj][m][n] * F8_DESCALE;
                        s[0] += sigm(a[0]) * bflo(b.x); s[1] += sigm(a[1]) * bfhi(b.x); s[2] += sigm(a[2]) * bflo(b.y); s[3] += sigm(a[3]) * bfhi(b.y); }
                u32x2 w; w.x = cvt_pk_bf16(s[0], s[1]); w.y = cvt_pk_bf16(s[2], s[3]);
                *(u32x2*)(merged + row * 1024 + o0) = w; }
    }
};
struct EpiResidual {
    bf16_t* xb; float sc;
    __device__ __forceinline__ void operator()(const Acc& acc, const Unit& u, int wr, int wc, int fr, int fq) const {
        const bool lo = fr < 8;
        const int row0 = u.pm * BM + wr * 64 + (fr & 7), col0 = u.pn * 256 + wc * 64 + 16 * fq + 8 * (fr >> 3);
#pragma unroll
        for (int ai = 0; ai < 2; ++ai)
#pragma unroll
            for (int m = 0; m < 4; ++m) { u32x4* p0 = (u32x4*)(xb + (size_t)(row0 + ai * HALF + m * 16) * 1024 + col0); u32x4* p1 = (u32x4*)((bf16_t*)p0 + 8 * 1024);
                const u32x4 t0 = *p0, t1 = *p1;
                f32x4 a0 = acc[ai][0][m][0] * sc, a1 = acc[ai][0][m][1] * sc, b0 = acc[ai][1][m][0] * sc, b1 = acc[ai][1][m][1] * sc;
#pragma unroll
                for (int e = 0; e < 4; ++e) { CM_SWAP_F(lo, a0[e], b0[e]); CM_SWAP_F(lo, a1[e], b1[e]); }
                u32x4 w0, w1;
                w0.x = cvt_pk_bf16(bflo(t0.x) + a0[0], bfhi(t0.x) + a0[1]); w0.y = cvt_pk_bf16(bflo(t0.y) + a0[2], bfhi(t0.y) + a0[3]); w0.z = cvt_pk_bf16(bflo(t0.z) + a1[0], bfhi(t0.z) + a1[1]); w0.w = cvt_pk_bf16(bflo(t0.w) + a1[2], bfhi(t0.w) + a1[3]);
                w1.x = cvt_pk_bf16(bflo(t1.x) + b0[0], bfhi(t1.x) + b0[1]); w1.y = cvt_pk_bf16(bflo(t1.y) + b0[2], bfhi(t1.y) + b0[3]); w1.z = cvt_pk_bf16(bflo(t1.z) + b1[0], bfhi(t1.z) + b1[1]); w1.w = cvt_pk_bf16(bflo(t1.w) + b1[2], bfhi(t1.w) + b1[3]);
                *p0 = w0; *p1 = w1; }
    }
};
struct EpiSwiglu {
    unsigned char* hid; int ldh, ncol; bool pad;
    __device__ __forceinline__ void operator()(const Acc& acc, const Unit& u, int wr, int wc, int fr, int fq) const {
        const int pl = u.pn % ncol; const int row0 = u.pm * BM + wr * 64 + fr, col0 = pl * 128 + wc * 32 + 8 * fq;
        const bool dopad = pad && (pl == ncol - 1);
#pragma unroll
        for (int ai = 0; ai < 2; ++ai)
#pragma unroll
            for (int m = 0; m < 4; ++m) { float v[8];
#pragma unroll
                for (int n = 0; n < 2; ++n)
#pragma unroll
                    for (int e = 0; e < 4; ++e) { const float a = acc[ai][0][m][n][e] * F8_DESCALE, b = acc[ai][1][m][n][e] * F8_DESCALE; v[4 * n + e] = a * sigm(a) * b * F8_MUL_H; }
                unsigned char* rp = hid + (size_t)(row0 + ai * HALF + m * 16) * ldh + col0;
                u32x2 w; w.x = pk4_fp8(v[0], v[1], v[2], v[3]); w.y = pk4_fp8(v[4], v[5], v[6], v[7]); *(u32x2*)rp = w;
                if (dopad) { unsigned z0; asm volatile("v_mov_b32 %0, 0" : "=v"(z0)); *(u32x2*)(rp + 128) = (u32x2){z0, z0}; } }
    }
};
struct EpiMoeOut {
    float* out; const int* rowtok; const float* rowgate; const int* segend;
    __device__ __forceinline__ void operator()(const Acc& acc, const Unit& u, int wr, int wc, int fr, int fq) const {
        const int row0 = u.pm * BM + wr * 64 + fr, col0 = (u.pn & 3) * 256 + wc * 32 + 8 * fq, lim = segend[u.pm];
#pragma unroll
        for (int ai = 0; ai < 2; ++ai)
#pragma unroll
            for (int m = 0; m < 4; ++m) { const int row = row0 + ai * HALF + m * 16;
                if (row < lim) { const int tok = rowtok[row]; const float gt = rowgate[row]; float* rowp = out + (size_t)tok * 1024 + col0;
#pragma unroll
                    for (int bj = 0; bj < 2; ++bj)
#pragma unroll
                        for (int n = 0; n < 2; ++n)
#pragma unroll
                            for (int e = 0; e < 4; ++e) __hip_atomic_fetch_add(rowp + bj * HALF + 4 * n + e, gt * acc[ai][bj][m][n][e], __ATOMIC_RELAXED, __HIP_MEMORY_SCOPE_AGENT);
                } }
    }
};
}

#define XB_TMO      128
#define XB_XCNT(j)  (256  + 64 * (j))
#define XB_XSUB(j)  (1280 + 64 * (j))
#define XB_XGEN(j)  (2304 + 64 * (j))
#define XB_TOP      3328
#define XB_TOPGEN   3392
#define XCD_BAR_WORDS 3456
#define XB_SPIN_CAP (1u << 18)
__device__ __forceinline__ unsigned xb_ld(unsigned* p)              { return __hip_atomic_load(p, __ATOMIC_RELAXED, __HIP_MEMORY_SCOPE_AGENT); }
__device__ __forceinline__ unsigned xb_add(unsigned* p, unsigned v) { return __hip_atomic_fetch_add(p, v, __ATOMIC_RELAXED, __HIP_MEMORY_SCOPE_AGENT); }
__device__ __forceinline__ unsigned xb_xcc_id() { return (unsigned)__builtin_amdgcn_s_getreg((3 << 11) | 20) & 0xFu; }
#define XB_SPIN(cond, bar) do { unsigned _sp = 0; while (cond) { __builtin_amdgcn_s_sleep(1); \
    if ((++_sp & 255u) == 0u) { if (xb_ld(&(bar)[XB_TMO])) break; if (_sp > XB_SPIN_CAP) { atomicAdd(&(bar)[XB_TMO], 1u); break; } } } } while (0)
struct XcdBarrier { unsigned* bar; unsigned x; volatile LAS unsigned* st; };
__device__ __forceinline__ XcdBarrier xcd_barrier_post(unsigned* bar, volatile LAS unsigned* st) {
    XcdBarrier b; b.bar = bar; b.x = xb_xcc_id(); b.st = st;
    if (threadIdx.x == 0) (void)xb_add(&bar[XB_XCNT(b.x)], 1u);
    return b;
}
__device__ __forceinline__ void xcd_barrier_complete(unsigned* bar, unsigned x, unsigned& nloc, unsigned& nx) {
    const unsigned G = gridDim.x * gridDim.y * gridDim.z;
    unsigned sum, cnt, mine, sp = 0u;
    for (;;) {
        sum = 0u; cnt = 0u; mine = 0u;
#pragma unroll
        for (unsigned j = 0; j < 16; ++j) { const unsigned c = xb_ld(&bar[XB_XCNT(j)]); sum += c; cnt += (c > 0u) ? 1u : 0u; mine = (j == x) ? c : mine; }
        if (sum == G) break;
        __builtin_amdgcn_s_sleep(1);
        if ((++sp & 255u) == 0u) { if (xb_ld(&bar[XB_TMO])) break; if (sp > XB_SPIN_CAP) { atomicAdd(&bar[XB_TMO], 1u); break; } }
    }
    nloc = mine > 0u ? mine : 1u; nx = cnt > 0u ? cnt : 1u;
}
__device__ __forceinline__ void xcd_barrier(const XcdBarrier& b, const int tid) {
    asm volatile("s_waitcnt vmcnt(0)" ::: "memory");
    __syncthreads();
    if (tid == 0) {
        unsigned* bar = b.bar;
        __builtin_amdgcn_s_waitcnt(0);
        unsigned nloc = b.st[0], nx = b.st[1];
        if (nloc == 0u) { xcd_barrier_complete(bar, b.x, nloc, nx); b.st[0] = nloc; b.st[1] = nx; }
        const unsigned old = xb_add(&bar[XB_XSUB(b.x)], 1u);
        const unsigned gen = old / nloc;
        if (old + 1u == (gen + 1u) * nloc) {
            __builtin_amdgcn_fence(__ATOMIC_RELEASE, "agent");
            asm volatile("s_waitcnt vmcnt(0)" ::: "memory");
            const unsigned og = xb_add(&bar[XB_TOP], 1u);
            const unsigned tg = og / nx;
            if (og + 1u == (tg + 1u) * nx) xb_add(&bar[XB_TOPGEN], 1u);
            else XB_SPIN(xb_ld(&bar[XB_TOPGEN]) == tg, bar);
            __builtin_amdgcn_fence(__ATOMIC_ACQUIRE, "agent");
            xb_add(&bar[XB_XGEN(b.x)], 1u);
            asm volatile("s_waitcnt vmcnt(0)" ::: "memory");
        } else {
            XB_SPIN(xb_ld(&bar[XB_XGEN(b.x)]) == gen, bar);
            __builtin_amdgcn_fence(__ATOMIC_ACQUIRE, "agent");
            asm volatile("s_waitcnt vmcnt(0)" ::: "memory");
        }
    }
    __syncthreads();
}

constexpr size_t MiB = 1u << 20;
constexpr size_t WS_CTL = 0, CTL_ZERO_BYTES = 1 * MiB;
constexpr int CW_BAR = 4096;
constexpr int CW_QUEUE = 20480;
constexpr int CW_MOE = 16384;
constexpr size_t WS_EIDX = 1 * MiB, WS_GATE = WS_EIDX + 256 * 1024, WS_ROWTOK = WS_EIDX + 512 * 1024, WS_ROWGATE = 2 * MiB, WS_TEXP = 2 * MiB + 512 * 1024, WS_SEGEND = WS_TEXP + 4096, WS_NT = WS_TEXP + 8192;
constexpr size_t WS_SLOTOF = 2 * MiB + 768 * 1024;
constexpr size_t WS_BON = 3 * MiB, WS_COS = 4 * MiB, WS_SIN = 6 * MiB;
constexpr size_t WS_WIN = 8 * MiB, WS_WLORA = 15 * MiB, WS_WB = 16 * MiB, WS_WG = 18 * MiB, WS_WOUT = 26 * MiB, WS_W13 = 28 * MiB  , WS_W2D = 50 * MiB, WS_W2M = 50 * MiB, WS_H8 = 72 * MiB  ;
constexpr size_t WS_XB = 104 * MiB  , WS_Y = 168 * MiB, WS_BIG = 232 * MiB;
constexpr size_t WS_RW = WS_BIG, WS_WDEC = WS_BIG, WS_AG = WS_BIG + 32 * MiB, WS_SB = WS_BIG + 64 * MiB, WS_RET = WS_BIG + 112 * MiB, WS_CV = WS_BIG + 176 * MiB, WS_Y0 = WS_CV;
constexpr size_t WS_RKVS = WS_BIG + 208 * MiB, WS_ALORA = WS_BIG + 256 * MiB, WS_RHAT = WS_ALORA, WS_KV = WS_BIG + 272 * MiB, WS_SST = WS_WDEC  , WS_PQ = WS_BIG + 304 * MiB  , WS_END = WS_BIG + 368 * MiB;
constexpr size_t WS_BALL = WS_BIG, WS_MERGED = WS_BIG + 256 * MiB, WS_HID = WS_BIG, WS_XS = WS_BIG, WS_YS = WS_XS, WS_HIDM = WS_BIG + 132 * MiB;
static_assert(WS_HIDM + (size_t)MPAD * DFE * 2 <= WS_END && WS_MERGED + (size_t)T * D * 2 <= WS_END && WS_W2M + (size_t)NEXP * D * DFE * 2 <= WS_H8, "ws map");
static_assert(WS_W13 + (size_t)NEXP * 2 * DFE * D <= WS_W2M && WS_W13 + (size_t)2 * DFF * D <= WS_W2D && WS_W2M + (size_t)NEXP * D * DFE * 2 <= WS_H8 && WS_H8 + (size_t)T * D <= WS_XB, "ws map weights");

constexpr int LDS_BYTES = 147456, RING_BYTES = 131072, MISC_OFF = RING_BYTES + 320;

struct Args { const float* in[32]; float* out; unsigned char* ws; int ph_lo, ph_hi; };
#define CAS __attribute__((address_space(4)))
struct Ctx {
    LAS unsigned char* lds; unsigned char* ws; float* out; const float* const CAS* in;
    int tid, lane, wave, G, bid;
};
__device__ __forceinline__ const CAS Args* ka_ptr() { const CAS Args* p = (const CAS Args*)__builtin_amdgcn_kernarg_segment_ptr(); asm volatile("" : "+s"(p)); return p; }
extern __shared__ __attribute__((aligned(16))) unsigned char lds_raw[];
__device__ __forceinline__ Ctx make_ctx(int wv) {
    const CAS Args* ka = ka_ptr();
    Ctx C; C.lds = (LAS unsigned char*)lds_raw; C.ws = ka->ws; C.out = ka->out; C.in = ka->in;
    int g_ = gridDim.x, b_ = blockIdx.x, w_ = wv; asm volatile("" : "+s"(g_), "+s"(b_), "+s"(w_));
    int ln_; asm volatile("v_mbcnt_lo_u32_b32 %0, -1, 0\n\tv_mbcnt_hi_u32_b32 %0, -1, %0" : "=v"(ln_));
    C.lane = ln_; C.wave = w_; C.tid = w_ * 64 + ln_; C.G = g_; C.bid = b_;
    return C;
}
enum { I_X = 0, I_NORM_MIX, I_W_IN, I_RW_MU, I_RW_W0, I_RW_W2, I_RW_A0, I_RW_A2, I_RW_G2, I_RW_KK, I_RW_KA, I_RW_RK, I_RW_LNW, I_RW_LNB, I_SB_QN, I_SB_KN, I_RET_GN,
       I_CONV_DW, I_CONV_B, I_CONV_LNW, I_CONV_LNB, I_W_GATE, I_W_BRANCH, I_W_OUT, I_NORM_FFN, I_FFN_W1, I_FFN_W3, I_FFN_W2, I_ROUTER, I_MOE_W1, I_MOE_W3, I_MOE_W2 };

__device__ __forceinline__ int q_next(const Ctx& C, unsigned* head) {
    LAS int* slot = (LAS int*)(C.lds + MISC_OFF + 64);
    __syncthreads();
    if (C.tid == 0) *slot = (int)__hip_atomic_fetch_add(head, 1u, __ATOMIC_RELAXED, __HIP_MEMORY_SCOPE_AGENT);
    __syncthreads();
    return *slot;
}
__device__ __forceinline__ void ph_prologue_(const Ctx& C) {
    const size_t gid = (size_t)C.bid * NTHR + C.tid, gsz = (size_t)C.G * NTHR;
    float* cs = (float*)(C.ws + WS_COS); float* sn = (float*)(C.ws + WS_SIN);
    for (size_t i = gid; i < (size_t)SEQ * 32; i += gsz) {
        const int pos = (int)(i >> 5), j = (int)(i & 31);
        const float inv = (float)pow(10000.0, -(double)(2 * j) / 64.0);
        const float ang = (float)pos * inv;
        cs[i] = (float)cos((double)ang); sn[i] = (float)sin((double)ang);
    }
}

__device__ __forceinline__ int dest_row(int mode, int roff, int which, int n) {
    if (mode == 0) return roff + n;
    if (mode == 1) { const int pn = n >> 6, oc = n & 63; return 256 * pn + 128 * (roff >> 1) + 32 * (oc >> 4) + 8 * ((oc >> 2) & 3) + 4 * (roff & 1) + (oc & 3); }
    return roff + 256 * (n >> 7) + 128 * which + (n & 127);
}
__device__ __forceinline__ void xpose_item(const float* W, int K, int N, bf16* WT, int mode, int roff, int which, LAS float* scr, int item, int lane) {
    const int nblk = N / 32, kb = item / nblk, nb = item % nblk, k0 = 64 * kb, n0 = 32 * nb;
#pragma unroll
    for (int i = 0; i < 8; ++i) { const int kk = (lane >> 3) + 8 * i, c4 = (lane & 7) * 4; const f32x4 v = *(const f32x4*)(W + (size_t)(k0 + kk) * N + n0 + c4);
        scr[kk * 33 + c4] = v.x; scr[kk * 33 + c4 + 1] = v.y; scr[kk * 33 + c4 + 2] = v.z; scr[kk * 33 + c4 + 3] = v.w; }
    asm volatile("s_waitcnt lgkmcnt(0)" ::: "memory");
    const int c = lane & 7;
#pragma unroll
    for (int j = 0; j < 4; ++j) { const int n = (lane >> 3) + 8 * j; const LAS float* s = scr + (8 * c) * 33 + n;
        u32x4 o; o.x = cvt_pk_bf16(s[0 * 33], s[1 * 33]); o.y = cvt_pk_bf16(s[2 * 33], s[3 * 33]); o.z = cvt_pk_bf16(s[4 * 33], s[5 * 33]); o.w = cvt_pk_bf16(s[6 * 33], s[7 * 33]);
        *(u32x4*)(WT + (size_t)dest_row(mode, roff, which, n0 + n) * K + k0 + 8 * c) = o; }
    asm volatile("s_waitcnt lgkmcnt(0)" ::: "memory");
}
__device__ __forceinline__ void xpose_item8(const float* W, int K, int N, unsigned char* WT, int mode, int roff, int which, LAS float* scr, int item, int lane, int ldk = 0) {
    if (ldk == 0) ldk = K;
    const int nblk = N / 32, kb = item / nblk, nb = item % nblk, k0 = 64 * kb, n0 = 32 * nb;
#pragma unroll
    for (int i = 0; i < 8; ++i) { const int kk = (lane >> 3) + 8 * i, c4 = (lane & 7) * 4; const f32x4 v = *(const f32x4*)(W + (size_t)(k0 + kk) * N + n0 + c4);
        scr[kk * 33 + c4] = v.x; scr[kk * 33 + c4 + 1] = v.y; scr[kk * 33 + c4 + 2] = v.z; scr[kk * 33 + c4 + 3] = v.w; }
    asm volatile("s_waitcnt lgkmcnt(0)" ::: "memory");
    const int c = lane & 3;
#pragma unroll
    for (int j = 0; j < 2; ++j) { const int n = (lane >> 2) + 16 * j; const LAS float* sp = scr + (16 * c) * 33 + n;
        u32x4 o;
        o.x = pk4_fp8(sp[0 * 33] * F8_MUL_W, sp[1 * 33] * F8_MUL_W, sp[2 * 33] * F8_MUL_W, sp[3 * 33] * F8_MUL_W);
        o.y = pk4_fp8(sp[4 * 33] * F8_MUL_W, sp[5 * 33] * F8_MUL_W, sp[6 * 33] * F8_MUL_W, sp[7 * 33] * F8_MUL_W);
        o.z = pk4_fp8(sp[8 * 33] * F8_MUL_W, sp[9 * 33] * F8_MUL_W, sp[10 * 33] * F8_MUL_W, sp[11 * 33] * F8_MUL_W);
        o.w = pk4_fp8(sp[12 * 33] * F8_MUL_W, sp[13 * 33] * F8_MUL_W, sp[14 * 33] * F8_MUL_W, sp[15 * 33] * F8_MUL_W);
        *(u32x4*)(WT + (size_t)dest_row(mode, roff, which, n0 + n) * ldk + k0 + 16 * c) = o; }
    asm volatile("s_waitcnt lgkmcnt(0)" ::: "memory");
}
__device__ __forceinline__ void ph_weights_(const Ctx& C, int l, int part, int first_wg, int nwg, unsigned* qhead = nullptr) {
    LAS float* scr = (LAS float*)(C.lds + C.wave * 16384);
    const int gw = (C.bid - first_wg) * NWAVES + C.wave, NGW = nwg * NWAVES, lane = C.lane;
    unsigned char* ws = C.ws;
    const bool moe = (l & 1);
    const int l2 = l >> 1;
    constexpr int IT_IN = (D / 64) * (NIN / 32), IT_B = (256 / 64) * (D / 32), IT_G = (D / 64) * (D / 32), IT_O = IT_G;
    constexpr int IT_F1 = (D / 64) * (DFF / 32), IT_F2 = (DFF / 64) * (D / 32), IT_M1 = (D / 64) * (DFE / 32), IT_M2 = (DFE / 64) * (D / 32);
    const int n_fixed = IT_IN + 4 * IT_B + 4 * IT_G + IT_O;
    if (part == 1) {
        if (C.bid < first_wg) return;
        const int n1 = moe ? NEXP * IT_M2 : (2 * IT_F1 + IT_F2);
        for (int it = qhead ? q_next(C, qhead) * NWAVES + C.wave : gw; qhead ? (it - C.wave < n1) : (it < n1); it = qhead ? q_next(C, qhead) * NWAVES + C.wave : it + NGW) {
            if (it >= n1) continue;
            int r = it;
            if (!moe) {
                if (r < IT_F1) { xpose_item8(C.in[I_FFN_W1] + (size_t)l2 * D * DFF, D, DFF, ws + WS_W13, 2, 0, 0, scr, r, lane); continue; } r -= IT_F1;
                if (r < IT_F1) { xpose_item8(C.in[I_FFN_W3] + (size_t)l2 * D * DFF, D, DFF, ws + WS_W13, 2, 0, 1, scr, r, lane); continue; } r -= IT_F1;
                xpose_item8(C.in[I_FFN_W2] + (size_t)l2 * DFF * D, DFF, D, ws + WS_W2D, 0, 0, 0, scr, r, lane);
            } else { const int e = r / IT_M2; r -= e * IT_M2;
                xpose_item8(C.in[I_MOE_W2] + ((size_t)l2 * NEXP + e) * DFE * D, DFE, D, ws + WS_W2M, 0, e * D, 0, scr, r, lane, DFE_PAD); }
        }
        if (moe) {
            for (int i = (C.bid - first_wg) * NTHR + C.tid; i < NEXP * D * ((DFE_PAD - DFE) / 16); i += nwg * NTHR) { const int row = i >> 3, c16 = i & 7;
                unsigned z0; asm volatile("v_mov_b32 %0, 0" : "=v"(z0)); *(u32x4*)(ws + WS_W2M + (size_t)row * DFE_PAD + DFE + 16 * c16) = (u32x4){z0, z0, z0, z0}; } }
        return;
    }
    const int n_ffn = moe ? (NEXP * 2 * IT_M1) : 0;
    for (int it = gw; it < n_fixed + n_ffn; it += NGW) {
        int r = it;
        if (r < IT_IN) { xpose_item(C.in[I_W_IN] + (size_t)l * D * NIN, D, NIN, (bf16*)(ws + WS_WIN), 0, 0, 0, scr, r, lane); continue; } r -= IT_IN;
        if (r < 4 * IT_B) { const int i = r / IT_B; xpose_item(C.in[I_W_BRANCH] + ((size_t)l * 4 + i) * 256 * D, 256, D, (bf16*)(ws + WS_WB), 0, 1024 * i, 0, scr, r % IT_B, lane); continue; } r -= 4 * IT_B;
        if (r < 4 * IT_G) { const int i = r / IT_G; xpose_item8(C.in[I_W_GATE] + ((size_t)l * 4 + i) * D * D, D, D, ws + WS_WG, 1, i, 0, scr, r % IT_G, lane); continue; } r -= 4 * IT_G;
        if (r < IT_O) { xpose_item(C.in[I_W_OUT] + (size_t)l * D * D, D, D, (bf16*)(ws + WS_WOUT), 0, 0, 0, scr, r, lane); continue; } r -= IT_O;
        { const int per = 2 * IT_M1, e = r / per; r -= e * per;
          if (r < IT_M1) { xpose_item8(C.in[I_MOE_W1] + ((size_t)l2 * NEXP + e) * D * DFE, D, DFE, ws + WS_W13, 2, e * 2 * DFE, 0, scr, r, lane); continue; } r -= IT_M1;
          xpose_item8(C.in[I_MOE_W3] + ((size_t)l2 * NEXP + e) * D * DFE, D, DFE, ws + WS_W13, 2, e * 2 * DFE, 1, scr, r, lane); }
    }
    bf16* WL = (bf16*)(ws + WS_WLORA);
    const float* w2 = C.in[I_RW_W2] + (size_t)l * 64 * 256; const float* a2 = C.in[I_RW_A2] + (size_t)l * 64 * 256; const float* g2 = C.in[I_RW_G2] + (size_t)l * 128 * 256;
    for (int i = C.bid * NTHR + C.tid; i < 768 * 256; i += C.G * NTHR) {
        const int n = i >> 8, k = i & 255; float v = 0.f;
        if (n < 256) { if (k < 64) v = w2[k * 256 + n]; }
        else if (n < 512) { if (k >= 64 && k < 128) v = a2[(k - 64) * 256 + (n - 256)]; }
        else { if (k >= 128) v = g2[(k - 128) * 256 + (n - 512)]; }
        WL[i] = f2bf(v);
    }
}

__device__ __forceinline__ void ph_norm_(const Ctx& C, const float* gain, bool route, const float* router, int moe_idx, bool combine = false, const float* src = nullptr, bool want_bf16 = true) {
    const int gw = C.bid * NWAVES + C.wave, NGW = C.G * NWAVES, lane = C.lane;
    bf16* H = (bf16*)C.out; bf16* XB = (bf16*)(C.ws + WS_XB);
    f32x4 g[4];
#pragma unroll
    for (int j = 0; j < 4; ++j) g[j] = *(const f32x4*)(gain + 8 * lane + 512 * (j >> 1) + 4 * (j & 1));
    LAS unsigned* lcnt = (LAS unsigned*)(C.lds);
    if (route) { if (C.tid < 8) lcnt[C.tid] = 0u; __syncthreads(); }
    int* eidx = (int*)(C.ws + WS_EIDX); float* gate = (float*)(C.ws + WS_GATE);
    constexpr int NR = 2;
    for (int mb = gw; mb < T; mb += NR * NGW) {
        f32x4 vv[NR][4]; u32x4 ya[NR][2], yb[NR][2]; float g0v[NR], g1v[NR];
#pragma unroll
        for (int r = 0; r < NR; ++r) { const int m = mb + r * NGW; if (m < T) {
            if (src) { const f32x4* xr = (const f32x4*)(src + (size_t)m * D + 8 * lane);
#pragma unroll
                for (int j = 0; j < 4; ++j) vv[r][j] = xr[128 * (j >> 1) + (j & 1)]; }
            else { const u32x4* xb = (const u32x4*)(XB + (size_t)m * D) + lane;
#pragma unroll
                for (int j = 0; j < 2; ++j) { const u32x4 t = xb[64 * j]; vv[r][2 * j] = f32x4{bflo(t.x), bfhi(t.x), bflo(t.y), bfhi(t.y)}; vv[r][2 * j + 1] = f32x4{bflo(t.z), bfhi(t.z), bflo(t.w), bfhi(t.w)}; } }
            if (combine) { const int* slotof = (const int*)(C.ws + WS_SLOTOF); const float* gt = (const float*)(C.ws + WS_GATE); const bf16* YS = (const bf16*)(C.ws + WS_YS);
                const int s0 = slotof[2 * m], s1 = slotof[2 * m + 1]; g0v[r] = gt[2 * m]; g1v[r] = gt[2 * m + 1];
                const u32x4* y0 = (const u32x4*)(YS + (size_t)s0 * D) + lane; const u32x4* y1 = (const u32x4*)(YS + (size_t)s1 * D) + lane;
#pragma unroll
                for (int j = 0; j < 2; ++j) { ya[r][j] = y0[64 * j]; yb[r][j] = y1[64 * j]; } } } }
#pragma unroll
        for (int r = 0; r < NR; ++r) { const int m = mb + r * NGW; if (m < T) {
        f32x4 v[4]; float s = 0.f;
#pragma unroll
        for (int j = 0; j < 4; ++j) v[j] = vv[r][j];
        if (combine) {
            const float g0 = g0v[r], g1 = g1v[r];
#pragma unroll
            for (int j = 0; j < 2; ++j) { const u32x4 a = ya[r][j], b = yb[r][j];
                v[2 * j].x += g0 * bflo(a.x) + g1 * bflo(b.x); v[2 * j].y += g0 * bfhi(a.x) + g1 * bfhi(b.x); v[2 * j].z += g0 * bflo(a.y) + g1 * bflo(b.y); v[2 * j].w += g0 * bfhi(a.y) + g1 * bfhi(b.y);
                v[2 * j + 1].x += g0 * bflo(a.z) + g1 * bflo(b.z); v[2 * j + 1].y += g0 * bfhi(a.z) + g1 * bfhi(b.z); v[2 * j + 1].z += g0 * bflo(a.w) + g1 * bflo(b.w); v[2 * j + 1].w += g0 * bfhi(a.w) + g1 * bfhi(b.w); }
        }
        if (combine || src) { u32x4* xo = (u32x4*)(XB + (size_t)m * D) + lane;
#pragma unroll
            for (int j = 0; j < 2; ++j) { u32x4 t; t.x = cvt_pk_bf16(v[2 * j].x, v[2 * j].y); t.y = cvt_pk_bf16(v[2 * j].z, v[2 * j].w); t.z = cvt_pk_bf16(v[2 * j + 1].x, v[2 * j + 1].y); t.w = cvt_pk_bf16(v[2 * j + 1].z, v[2 * j + 1].w); xo[64 * j] = t; } }
#pragma unroll
        for (int j = 0; j < 4; ++j) s += (v[j].x * v[j].x + v[j].y * v[j].y) + (v[j].z * v[j].z + v[j].w * v[j].w);
        const float rs = 1.0f / sqrtf(wave_sum(s, C.lane) * (1.f / D) + 1e-6f);
#pragma unroll
        for (int j = 0; j < 4; ++j) v[j] = v[j] * rs * g[j];
#pragma unroll
        for (int j = 0; j < 2; ++j) {
            if (want_bf16) { u32x4 t; t.x = cvt_pk_bf16(v[2 * j].x, v[2 * j].y); t.y = cvt_pk_bf16(v[2 * j].z, v[2 * j].w); t.z = cvt_pk_bf16(v[2 * j + 1].x, v[2 * j + 1].y); t.w = cvt_pk_bf16(v[2 * j + 1].z, v[2 * j + 1].w);
                ((u32x4*)(H + (size_t)m * D) + lane)[64 * j] = t; }
            u32x2 q; q.x = pk4_fp8(v[2 * j].x * F8_MUL_X, v[2 * j].y * F8_MUL_X, v[2 * j].z * F8_MUL_X, v[2 * j].w * F8_MUL_X); q.y = pk4_fp8(v[2 * j + 1].x * F8_MUL_X, v[2 * j + 1].y * F8_MUL_X, v[2 * j + 1].z * F8_MUL_X, v[2 * j + 1].w * F8_MUL_X);
            ((u32x2*)(C.ws + WS_H8 + (size_t)m * D) + lane)[64 * j] = q; }
        if (route) {
            float lg[8];
#pragma unroll
            for (int e = 0; e < 8; ++e) lg[e] = 0.f;
#pragma unroll
            for (int j = 0; j < 4; ++j)
#pragma unroll
                for (int q = 0; q < 4; ++q) { const int k = 8 * lane + 512 * (j >> 1) + 4 * (j & 1) + q; const f32x4 r0 = *(const f32x4*)(router + (size_t)k * 8), r1 = *(const f32x4*)(router + (size_t)k * 8 + 4); const float hv = v[j][q];
                    lg[0] += hv * r0.x; lg[1] += hv * r0.y; lg[2] += hv * r0.z; lg[3] += hv * r0.w; lg[4] += hv * r1.x; lg[5] += hv * r1.y; lg[6] += hv * r1.z; lg[7] += hv * r1.w; }
#pragma unroll
            for (int e = 0; e < 8; ++e) lg[e] = wave_sum(lg[e], C.lane);
            int e0 = 0; float b0 = lg[0];
#pragma unroll
            for (int e = 1; e < 8; ++e) if (lg[e] > b0) { b0 = lg[e]; e0 = e; }
            int e1 = -1; float b1 = -3.0e38f;
#pragma unroll
            for (int e = 0; e < 8; ++e) if (e != e0 && lg[e] > b1) { b1 = lg[e]; e1 = e; }
            const float p1 = __expf(b1 - b0), inv = 1.f / (1.f + p1);
            if (lane == 0) { eidx[2 * m] = e0; eidx[2 * m + 1] = e1; gate[2 * m] = inv; gate[2 * m + 1] = p1 * inv; atomicAdd((unsigned*)&lcnt[e0], 1u); atomicAdd((unsigned*)&lcnt[e1], 1u); }
        }
        } }
    }
    if (route) { __syncthreads(); if (C.tid < 8) { unsigned* cw = (unsigned*)(C.ws + WS_CTL) + CW_MOE + moe_idx * 64; atomicAdd(&cw[C.tid], lcnt[C.tid]); } }
}

__device__ __forceinline__ void ph_rw_prep_(const Ctx& C, int l) {
    const bf16* RW = (const bf16*)(C.ws + WS_RW); bf16* RKVS = (bf16*)(C.ws + WS_RKVS); bf16* AL = (bf16*)(C.ws + WS_ALORA);
    const float* mu = C.in[I_RW_MU] + (size_t)l * 1024;
    const size_t gid = (size_t)C.bid * NTHR + C.tid, gsz = (size_t)C.G * NTHR;
    constexpr int NI = 4;
    for (size_t it0 = gid; it0 < (size_t)T * 128; it0 += NI * gsz) {
        u32x4 cuv[NI], pvv[NI];
#pragma unroll
        for (int r = 0; r < NI; ++r) { const size_t it = it0 + r * gsz; cuv[r] = (u32x4){0u, 0u, 0u, 0u}; pvv[r] = cuv[r];
            if (it < (size_t)T * 128) { const int m = (int)(it >> 7), c8 = (int)(it & 127) * 8, t = m & (SEQ - 1);
                cuv[r] = *(const u32x4*)(RW + (size_t)m * 1024 + c8); if (t) pvv[r] = *(const u32x4*)(RW + (size_t)(m - 1) * 1024 + c8); } }
#pragma unroll
        for (int r = 0; r < NI; ++r) { const size_t it = it0 + r * gsz; if (it < (size_t)T * 128) {
        const int m = (int)(it >> 7), c8 = (int)(it & 127) * 8;
        float a[8], b[8]; unpack8(cuv[r], a); unpack8(pvv[r], b);
        const f32x4 m0 = *(const f32x4*)(mu + c8), m1 = *(const f32x4*)(mu + c8 + 4);
        const float mm[8] = {m0.x, m0.y, m0.z, m0.w, m1.x, m1.y, m1.z, m1.w};
#pragma unroll
        for (int e = 0; e < 8; ++e) a[e] = a[e] + (b[e] - a[e]) * mm[e];
        if (c8 < 768) { *(u32x4*)(RKVS + (size_t)m * 768 + c8) = pack8(a); }
        else {
            if (c8 < 832) {
#pragma unroll
                for (int e = 0; e < 8; ++e) a[e] = 1.f - 2.f * __builtin_amdgcn_rcpf(1.f + __builtin_amdgcn_exp2f(2.f * LOG2E * a[e]));
            } else if (c8 >= 896) {
#pragma unroll
                for (int e = 0; e < 8; ++e) a[e] = sigm(a[e]);
            }
            *(u32x4*)(AL + (size_t)m * 256 + (c8 - 768)) = pack8(a);
        } } }
    }
}

__device__ __forceinline__ void ph_sb_prep_(const Ctx& C, int l) {
    bf16* SB = (bf16*)(C.ws + WS_SB);
    const int gw = C.bid * NWAVES + C.wave, NGW = C.G * NWAVES, lane = C.lane;
    const bool isk = lane >= 32; const int d0 = (lane & 7) * 8;
    const float* gn = (isk ? C.in[I_SB_KN] : C.in[I_SB_QN]) + (size_t)l * 64 + d0;
    float gg[8];
#pragma unroll
    for (int e = 0; e < 8; ++e) gg[e] = gn[e] * (isk ? 1.f : 0.125f * LOG2E);
    constexpr int NR = 4;
    for (int mb = gw; mb < T; mb += NR * NGW) {
        u32x4 uu[NR];
#pragma unroll
        for (int r = 0; r < NR; ++r) { const int m = mb + r * NGW; uu[r] = (u32x4){0u, 0u, 0u, 0u}; if (m < T) uu[r] = *(const u32x4*)(SB + (size_t)m * 768 + lane * 8); }
#pragma unroll
        for (int r = 0; r < NR; ++r) { const int m = mb + r * NGW; if (m < T) {
            bf16* p = SB + (size_t)m * 768 + lane * 8;
            float a[8]; unpack8(uu[r], a);
            float ss = 0.f;
#pragma unroll
            for (int e = 0; e < 8; ++e) ss += a[e] * a[e];
            ss += shx(ss, 1, lane); ss += shx(ss, 2, lane); ss += shx(ss, 4, lane);
            const float rs = 1.0f / sqrtf(ss * (1.f / 64.f) + 1e-6f);
#pragma unroll
            for (int e = 0; e < 8; ++e) a[e] = a[e] * rs * gg[e];
            *(u32x4*)p = pack8(a); } }
    }
}

__device__ __forceinline__ void ph_conv_(const Ctx& C, int l) {
    const bf16* CV = (const bf16*)(C.ws + WS_CV); bf16* Y = (bf16*)(C.ws + WS_Y);
    LAS float* U = (LAS float*)(C.lds); LAS float* OC = (LAS float*)(C.lds + 65536);
    const int tid = C.tid, c = tid & 255, half = tid >> 8;
    const float* dw = C.in[I_CONV_DW] + (size_t)l * 31 * 256; const float db = C.in[I_CONV_B][l * 256 + c];
    float dwr[31];
#pragma unroll
    for (int j = 0; j < 31; ++j) dwr[j] = dw[j * 256 + c];
    const float* lnw = C.in[I_CONV_LNW] + (size_t)l * 256; const float* lnb = C.in[I_CONV_LNB] + (size_t)l * 256;
    for (int u = C.bid; u < T / 32; u += C.G) {
        const int m0 = u * 32, t0 = m0 & (SEQ - 1);
        for (int it = tid; it < 62 * 32; it += NTHR) {
            const int r = it >> 5, c8 = (it & 31) * 8, tt = t0 - 30 + r; float a[8], b[8];
            if (tt >= 0) { const size_t mm = (size_t)(m0 - 30 + r); unpack8(*(const u32x4*)(CV + mm * 512 + c8), a); unpack8(*(const u32x4*)(CV + mm * 512 + 256 + c8), b);
#pragma unroll
                for (int e = 0; e < 8; ++e) a[e] = a[e] * sigm(b[e]); }
            else {
#pragma unroll
                for (int e = 0; e < 8; ++e) a[e] = 0.f; }
#pragma unroll
            for (int e = 0; e < 8; ++e) U[r * 256 + c8 + e] = a[e];
        }
        __syncthreads();
        { float win[46];
#pragma unroll
          for (int i = 0; i < 46; ++i) win[i] = U[(half * 16 + i) * 256 + c];
#pragma unroll
          for (int tt = 0; tt < 16; ++tt) { float acc = db;
#pragma unroll
              for (int j = 0; j < 31; ++j) acc += dwr[j] * win[tt + j];
              OC[(half * 16 + tt) * 256 + c] = acc; } }
        __syncthreads();
#pragma unroll 1
        for (int q = 0; q < 4; ++q) { const int tl = C.wave * 4 + q; float v[4]; float s = 0.f;
#pragma unroll
            for (int i = 0; i < 4; ++i) { v[i] = OC[tl * 256 + C.lane + 64 * i]; s += v[i]; }
            const float mean = wave_sum(s, C.lane) * (1.f / 256.f); float s2 = 0.f;
#pragma unroll
            for (int i = 0; i < 4; ++i) { v[i] -= mean; s2 += v[i] * v[i]; }
            const float rstd = 1.0f / sqrtf(wave_sum(s2, C.lane) * (1.f / 256.f) + 1e-5f);
#pragma unroll
            for (int i = 0; i < 4; ++i) { const int cc = C.lane + 64 * i; const float y = v[i] * rstd * lnw[cc] + lnb[cc]; Y[(size_t)(m0 + tl) * 1024 + 768 + cc] = f2bf(y * sigm(y)); } }
        __syncthreads();
    }
}

__device__ __forceinline__ float ret_log2gamma(int h) { return log2f(1.0f - exp2f(-5.0f - (float)h)); }
__device__ __forceinline__ void ret_load_rot(const Ctx& C, const bf16* RET, int m0, int coff, float scale, LAS float* dst) {
    const int s = C.tid >> 3, d0 = (C.tid & 7) * 4;
    const float* cs = (const float*)(C.ws + WS_COS); const float* sn = (const float*)(C.ws + WS_SIN);
    const int pos = (m0 + s) & (SEQ - 1);
    const u32x2 a = *(const u32x2*)(RET + (size_t)(m0 + s) * 1024 + coff + d0), b = *(const u32x2*)(RET + (size_t)(m0 + s) * 1024 + coff + 32 + d0);
    const float x1[4] = {bflo(a.x), bfhi(a.x), bflo(a.y), bfhi(a.y)}, x2[4] = {bflo(b.x), bfhi(b.x), bflo(b.y), bfhi(b.y)};
    const f32x4 cv = *(const f32x4*)(cs + (size_t)pos * 32 + d0), sv = *(const f32x4*)(sn + (size_t)pos * 32 + d0);
#pragma unroll
    for (int e = 0; e < 4; ++e) { dst[s * 65 + d0 + e] = (x1[e] * cv[e] - x2[e] * sv[e]) * scale; dst[s * 65 + 32 + d0 + e] = (x1[e] * sv[e] + x2[e] * cv[e]) * scale; }
}
__device__ __forceinline__ void ph_ret_kv_(const Ctx& C) {
    const bf16* RET = (const bf16*)(C.ws + WS_RET); float* KV = (float*)(C.ws + WS_KV);
    LAS float* KD = (LAS float*)(C.lds); LAS float* VV = (LAS float*)(C.lds + 32768);
    const int tid = C.tid;
    for (int u = C.bid; u < 2048; u += C.G) {
        const int bh = u >> 8, ch = u & 255, b = bh >> 2, h = bh & 3, m0 = b * SEQ + ch * 64;
        const float lg = ret_log2gamma(h);
        ret_load_rot(C, RET, m0, 256 + h * 64, 0.125f, KD);
        { const int s = tid >> 3, e0 = (tid & 7) * 8; float a[8]; unpack8(*(const u32x4*)(RET + (size_t)(m0 + s) * 1024 + 512 + h * 64 + e0), a);
          const float dec = exp2f(lg * (float)(63 - s));
#pragma unroll
          for (int e = 0; e < 8; ++e) VV[s * 64 + e0 + e] = a[e] * dec; }
        __syncthreads();
        const int d = tid >> 3, e0 = (tid & 7) * 8; float acc[8];
#pragma unroll
        for (int e = 0; e < 8; ++e) acc[e] = 0.f;
#pragma unroll 4
        for (int s = 0; s < 64; ++s) { const float kd = KD[s * 65 + d]; const f32x4 v0 = *(const LAS f32x4*)(VV + s * 64 + e0), v1 = *(const LAS f32x4*)(VV + s * 64 + e0 + 4);
            acc[0] += kd * v0.x; acc[1] += kd * v0.y; acc[2] += kd * v0.z; acc[3] += kd * v0.w; acc[4] += kd * v1.x; acc[5] += kd * v1.y; acc[6] += kd * v1.z; acc[7] += kd * v1.w; }
        float* o = KV + (size_t)u * 4096 + d * 64 + e0;
        *(f32x4*)o = (f32x4){acc[0], acc[1], acc[2], acc[3]}; *(f32x4*)(o + 4) = (f32x4){acc[4], acc[5], acc[6], acc[7]};
        __syncthreads();
    }
}
__device__ __forceinline__ void ph_ret_scan_(const Ctx& C) {
    float* KV = (float*)(C.ws + WS_KV);
    const int wg0 = (C.G >= 256) ? 128 : 0, nw = C.G - wg0;
    for (int i = (C.bid - wg0) * NTHR + C.tid; i < 8 * 4096 && C.bid >= wg0; i += nw * NTHR) {
        const int bh = i >> 12, el = i & 4095, h = bh & 3;
        const float cd = exp2f(ret_log2gamma(h) * 64.f);
        float* p = KV + (size_t)bh * 256 * 4096 + el; float S = 0.f;
#pragma unroll 1
        for (int c = 0; c < 256; c += 32) { float kv[32];
#pragma unroll
            for (int q = 0; q < 32; ++q) kv[q] = p[(size_t)(c + q) * 4096];
#pragma unroll
            for (int q = 0; q < 32; ++q) { p[(size_t)(c + q) * 4096] = S; S = S * cd + kv[q]; } }
    }
}
__device__ __forceinline__ void ph_ret_out_(const Ctx& C, int l, int first_wg, int nwg) {
    const bf16* RET = (const bf16*)(C.ws + WS_RET); const float* KV = (const float*)(C.ws + WS_KV); bf16* Y = (bf16*)(C.ws + WS_Y);
    LAS float* Q = (LAS float*)(C.lds); LAS float* Kk = (LAS float*)(C.lds + 16640); LAS float* VV = (LAS float*)(C.lds + 33280); LAS float* SS = (LAS float*)(C.lds + 49664); LAS float* SC = (LAS float*)(C.lds + 66048);
    const int tid = C.tid; const float* gn = C.in[I_RET_GN] + (size_t)l * 256;
    for (int u = C.bid - first_wg; u < 2048; u += nwg) {
        const int bh = u >> 8, ch = u & 255, b = bh >> 2, h = bh & 3, m0 = b * SEQ + ch * 64;
        const float lg = ret_log2gamma(h);
        ret_load_rot(C, RET, m0, h * 64, 1.0f, Q);
        ret_load_rot(C, RET, m0, 256 + h * 64, 0.125f, Kk);
        { const int s = tid >> 3, e0 = (tid & 7) * 8; float a[8]; unpack8(*(const u32x4*)(RET + (size_t)(m0 + s) * 1024 + 512 + h * 64 + e0), a);
#pragma unroll
          for (int e = 0; e < 8; ++e) VV[s * 64 + e0 + e] = a[e];
          const float* sp = KV + (size_t)u * 4096 + s * 64 + e0; const f32x4 s0 = *(const f32x4*)sp, s1 = *(const f32x4*)(sp + 4);
          *(LAS f32x4*)(SS + s * 64 + e0) = s0; *(LAS f32x4*)(SS + s * 64 + e0 + 4) = s1; }
        __syncthreads();
        const int t = tid >> 3, g8 = tid & 7;
        { float sc[8];
#pragma unroll
          for (int i = 0; i < 8; ++i) sc[i] = 0.f;
#pragma unroll 4
          for (int d = 0; d < 64; ++d) { const float qv = Q[t * 65 + d];
#pragma unroll
              for (int i = 0; i < 8; ++i) sc[i] += qv * Kk[(g8 * 8 + i) * 65 + d]; }
#pragma unroll
          for (int i = 0; i < 8; ++i) { const int s = g8 * 8 + i; SC[t * 65 + s] = (s <= t) ? sc[i] * exp2f(lg * (float)(t - s)) : 0.f; } }
        __syncthreads();
        { const int e0 = g8 * 8; float o[8], o2[8];
#pragma unroll
          for (int e = 0; e < 8; ++e) { o[e] = 0.f; o2[e] = 0.f; }
#pragma unroll 4
          for (int s = 0; s < 64; ++s) { const float p = SC[t * 65 + s]; const f32x4 v0 = *(const LAS f32x4*)(VV + s * 64 + e0), v1 = *(const LAS f32x4*)(VV + s * 64 + e0 + 4);
              o[0] += p * v0.x; o[1] += p * v0.y; o[2] += p * v0.z; o[3] += p * v0.w; o[4] += p * v1.x; o[5] += p * v1.y; o[6] += p * v1.z; o[7] += p * v1.w; }
#pragma unroll 4
          for (int d = 0; d < 64; ++d) { const float qv = Q[t * 65 + d]; const f32x4 v0 = *(const LAS f32x4*)(SS + d * 64 + e0), v1 = *(const LAS f32x4*)(SS + d * 64 + e0 + 4);
              o2[0] += qv * v0.x; o2[1] += qv * v0.y; o2[2] += qv * v0.z; o2[3] += qv * v0.w; o2[4] += qv * v1.x; o2[5] += qv * v1.y; o2[6] += qv * v1.z; o2[7] += qv * v1.w; }
          const float qd = exp2f(lg * (float)(t + 1)); float s1 = 0.f;
#pragma unroll
          for (int e = 0; e < 8; ++e) { o[e] += qd * o2[e]; s1 += o[e]; }
          s1 += shx(s1, 1, C.lane); s1 += shx(s1, 2, C.lane); s1 += shx(s1, 4, C.lane);
          const float mean = s1 * (1.f / 64.f); float s2 = 0.f;
#pragma unroll
          for (int e = 0; e < 8; ++e) { o[e] -= mean; s2 += o[e] * o[e]; }
          s2 += shx(s2, 1, C.lane); s2 += shx(s2, 2, C.lane); s2 += shx(s2, 4, C.lane);
          const float rstd = 1.0f / sqrtf(s2 * (1.f / 64.f) + 1e-5f);
          float gtv[8]; unpack8(*(const u32x4*)(RET + (size_t)(m0 + t) * 1024 + 768 + h * 64 + e0), gtv);
#pragma unroll
          for (int e = 0; e < 8; ++e) o[e] = o[e] * rstd * gn[h * 64 + e0 + e] * (gtv[e] * sigm(gtv[e]));
          *(u32x4*)(Y + (size_t)(m0 + t) * 1024 + 512 + h * 64 + e0) = pack8(o); }
        __syncthreads();
    }
}

constexpr int RWC = 64, RW_NCH = SEQ / RWC, RW_NU = 8 * RW_NCH;
constexpr int RW_SUP = 8, RW_NSC = RW_NCH / RW_SUP, RW_NSUP = 8 * RW_NSC;
__device__ __forceinline__ void ph_rw_local_(const Ctx& C, int l) {
    const bf16* RKVS = (const bf16*)(C.ws + WS_RKVS); const float* WDEC = (const float*)(C.ws + WS_WDEC); const bf16* AG = (const bf16*)(C.ws + WS_AG);
    bf16* Y0 = (bf16*)(C.ws + WS_Y0); bf16* RH = (bf16*)(C.ws + WS_RHAT); float* PQ = (float*)(C.ws + WS_PQ); float* BON = (float*)(C.ws + WS_BON);
    const int lane = C.lane;
    LAS float* base = (LAS float*)(C.lds + C.wave * 12288);
    for (int it = C.bid; it < RW_NU / 8; it += C.G) {
        const int u = it * 8 + C.wave, bh = u >> 8, ch = u & 255, b = bh >> 2, h = bh & 3, m0 = b * SEQ + ch * RWC, hc = h * 64 + lane;
        const float kkw = C.in[I_RW_KK][l * 256 + hc], kaw = C.in[I_RW_KA][l * 256 + hc], rkw = C.in[I_RW_RK][l * 256 + hc], w0l = C.in[I_RW_W0][l * 256 + hc], a0l = C.in[I_RW_A0][l * 256 + hc];
        f32x2 sL[32], sI[32];
        { int ln = lane; asm volatile("" : "+v"(ln));
#pragma unroll
          for (int k = 0; k < 32; ++k) { sL[k] = (f32x2){0.f, 0.f}; sI[k].x = (2 * k == ln) ? 1.f : 0.f; sI[k].y = (2 * k + 1 == ln) ? 1.f : 0.f; } }
#pragma unroll 1
        for (int sb = 0; sb < RWC / 8; ++sb) {
            asm volatile("" ::: "memory");
#pragma unroll
            for (int i = 0; i < 8; ++i) { const size_t m = (size_t)(m0 + sb * 8 + i);
                const float r = bf2f(RKVS[m * 768 + hc]), k = bf2f(RKVS[m * 768 + 256 + hc]), v = bf2f(RKVS[m * 768 + 512 + hc]);
                const float w = __builtin_amdgcn_exp2f(-0.606531f * LOG2E * sigm(WDEC[m * 256 + hc] + w0l)), a = sigm(bf2f(AG[m * 512 + hc]) + a0l);
                const float kr = k * kkw; const float nn = sqrtf(wave_sum(kr * kr, C.lane)); const float kk = kr / fmaxf(nn, 1e-12f);
                const float kp = k * (1.f + (a - 1.f) * kaw);
                const float bon = wave_sum(r * kp * rkw, C.lane);
                if (lane == 0) BON[m * 4 + h] = bon;
                base[0 * 512 + i * 64 + lane] = w; base[1 * 512 + i * 64 + lane] = kk; base[2 * 512 + i * 64 + lane] = kk * a; base[3 * 512 + i * 64 + lane] = kp; base[4 * 512 + i * 64 + lane] = r; base[5 * 512 + i * 64 + lane] = v; }
            asm volatile("" ::: "memory");
#pragma unroll 1
            for (int i = 0; i < 8; ++i) {
                const LAS f32x4* wv = (const LAS f32x4*)(base + 0 * 512 + i * 64); const LAS f32x4* kkv = (const LAS f32x4*)(base + 1 * 512 + i * 64); const LAS f32x4* kav = (const LAS f32x4*)(base + 2 * 512 + i * 64);
                const LAS f32x4* kpv = (const LAS f32x4*)(base + 3 * 512 + i * 64); const LAS f32x4* rv = (const LAS f32x4*)(base + 4 * 512 + i * 64);
                const float vv = base[5 * 512 + i * 64 + lane];
                f32x4 kq[2][4];
#pragma unroll
                for (int t = 0; t < 4; ++t) kq[0][t] = kkv[t];
                f32x2 dL0 = (f32x2){0.f, 0.f}, dL1 = dL0, dI0 = dL0, dI1 = dL0;
                f32x4 ga[2][4];
#pragma unroll
                for (int g = 0; g < 4; ++g) {
                    __builtin_amdgcn_sched_barrier(0);
                    if (g + 1 < 4) {
#pragma unroll
                        for (int t = 0; t < 4; ++t) kq[(g + 1) & 1][t] = kkv[4 * (g + 1) + t]; }
                    else { ga[0][0] = wv[0]; ga[0][1] = kav[0]; ga[0][2] = kpv[0]; ga[0][3] = rv[0]; }
                    __builtin_amdgcn_sched_barrier(0);
#pragma unroll
                    for (int t = 0; t < 4; ++t) { const int k4 = 4 * g + t; const f32x4 q4 = kq[g & 1][t];
                        dL0 += sL[2 * k4] * q4.xy; dL1 += sL[2 * k4 + 1] * q4.zw; dI0 += sI[2 * k4] * q4.xy; dI1 += sI[2 * k4 + 1] * q4.zw; }
                }
                const float saL = -((dL0.x + dL0.y) + (dL1.x + dL1.y)), saI = -((dI0.x + dI0.y) + (dI1.x + dI1.y));
                const f32x2 saLv = (f32x2){saL, saL}, saIv = (f32x2){saI, saI}, vvv = (f32x2){vv, vv};
                f32x2 yL0 = (f32x2){0.f, 0.f}, yL1 = yL0, yI0 = yL0, yI1 = yL0;
#pragma unroll
                for (int k4 = 0; k4 < 16; ++k4) {
                    __builtin_amdgcn_sched_barrier(0);
                    if (k4 + 1 < 16) { ga[(k4 + 1) & 1][0] = wv[k4 + 1]; ga[(k4 + 1) & 1][1] = kav[k4 + 1]; ga[(k4 + 1) & 1][2] = kpv[k4 + 1]; ga[(k4 + 1) & 1][3] = rv[k4 + 1]; }
                    __builtin_amdgcn_sched_barrier(0);
                    const f32x4 wq = ga[k4 & 1][0], aq = ga[k4 & 1][1], pq = ga[k4 & 1][2], rq = ga[k4 & 1][3];
                    sL[2 * k4]     = sL[2 * k4]     * wq.xy + saLv * aq.xy + vvv * pq.xy; yL0 += sL[2 * k4]     * rq.xy;
                    sL[2 * k4 + 1] = sL[2 * k4 + 1] * wq.zw + saLv * aq.zw + vvv * pq.zw; yL1 += sL[2 * k4 + 1] * rq.zw;
                    sI[2 * k4]     = sI[2 * k4]     * wq.xy + saIv * aq.xy;                  yI0 += sI[2 * k4]     * rq.xy;
                    sI[2 * k4 + 1] = sI[2 * k4 + 1] * wq.zw + saIv * aq.zw;                  yI1 += sI[2 * k4 + 1] * rq.zw;
                }
                __builtin_amdgcn_sched_barrier(0);
                const size_t m = (size_t)(m0 + sb * 8 + i);
                Y0[m * 256 + hc] = f2bf((yL0.x + yL0.y) + (yL1.x + yL1.y));
                RH[m * 256 + hc] = f2bf((yI0.x + yI0.y) + (yI1.x + yI1.y));
            }
        }
        float* oq = PQ + (size_t)u * 4096 + lane * 64; float* opt = PQ + ((size_t)RW_NU + u) * 4096 + lane;
#pragma unroll
        for (int k4 = 0; k4 < 16; ++k4) { *(f32x4*)(oq + 4 * k4) = (f32x4){sL[2 * k4].x, sL[2 * k4].y, sL[2 * k4 + 1].x, sL[2 * k4 + 1].y};
            opt[(4 * k4) * 64] = sI[2 * k4].x; opt[(4 * k4 + 1) * 64] = sI[2 * k4].y; opt[(4 * k4 + 2) * 64] = sI[2 * k4 + 1].x; opt[(4 * k4 + 3) * 64] = sI[2 * k4 + 1].y; }
    }
}
constexpr int WY_LT = 24;
constexpr int WY_ROWM = 0, WY_COLM = 36864, WY_AMAT = 73728, WY_AABF = 89088, WY_SB = 93184, WY_WT = 111616, WY_UT = 117760, WY_GH = 123904, WY_GC = 125952;
__device__ __forceinline__ f32x4 wy_mm16(const LAS bf16* X, const LAS bf16* Y, f32x4 acc, int li, int lq) {
#pragma unroll
    for (int ks = 0; ks < 2; ++ks) { const bf16x8 a = *(const LAS bf16x8*)(X + li * MM_LP + 32 * ks + 8 * lq), b = *(const LAS bf16x8*)(Y + li * MM_LP + 32 * ks + 8 * lq);
        acc = __builtin_amdgcn_mfma_f32_16x16x32_bf16(a, b, acc, 0, 0, 0); }
    return acc;
}
__device__ __forceinline__ f32x4 wy_mm16k16(const LAS bf16* X, const LAS bf16* Y, f32x4 acc, int li, int lq) {
    const s16x4 a = *(const LAS s16x4*)(X + li * WY_LT + 4 * lq), b = *(const LAS s16x4*)(Y + li * WY_LT + 4 * lq);
    return __builtin_amdgcn_mfma_f32_16x16x16bf16_1k(a, b, acc, 0, 0, 0);
}
__device__ __forceinline__ void ph_rw_local_wy_(const Ctx& C, int l) {
    const bf16* RKVS = (const bf16*)(C.ws + WS_RKVS); const float* WDEC = (const float*)(C.ws + WS_WDEC); const bf16* AG = (const bf16*)(C.ws + WS_AG);
    bf16* Y0 = (bf16*)(C.ws + WS_Y0); bf16* RH = (bf16*)(C.ws + WS_RHAT); float* PQ = (float*)(C.ws + WS_PQ); float* BON = (float*)(C.ws + WS_BON);
    const int lane = C.lane, w = C.wave, li = lane & 15, lq = lane >> 4, j32 = lane & 31, hi = lane >> 5, ti = w >> 1, tj = w & 1, sq = w >> 1, half = w & 1;
    LAS unsigned char* L = C.lds;
#define WY_ROW(q, m) ((LAS bf16*)(L + WY_ROWM + (q) * 9216 + (m) * 2304))
#define WY_COL(q, m) ((LAS bf16*)(L + WY_COLM + (q) * 9216 + (m) * 3072))
#define WY_A(q, id)  ((LAS bf16*)(L + WY_AMAT + (q) * 3840 + (id) * 768))
    LAS bf16* SB = (LAS bf16*)(L + WY_SB); LAS bf16* WT = (LAS bf16*)(L + WY_WT); LAS bf16* UT = (LAS bf16*)(L + WY_UT);
    LAS float* GH = (LAS float*)(L + WY_GH); LAS float* GCs = (LAS float*)(L + WY_GC);
    for (int su = C.bid; su < RW_NSUP; su += C.G) {
    f32x16 S;
    bf16 r16[8], k16[8], v16[8], a16[8]; float wd[8];
#define WY_RAW(uu) do { const int u_ = (uu), bh_ = u_ >> 8, ch_ = u_ & 255; const size_t mb_ = (size_t)((bh_ >> 2) * SEQ + ch_ * RWC + 8 * w); const int hc_ = (bh_ & 3) * 64 + lane; _Pragma("unroll") for (int i = 0; i < 8; ++i) { const size_t m = mb_ + i; \
        r16[i] = RKVS[m * 768 + hc_]; k16[i] = RKVS[m * 768 + 256 + hc_]; v16[i] = RKVS[m * 768 + 512 + hc_]; wd[i] = WDEC[m * 256 + hc_]; a16[i] = AG[m * 512 + hc_]; } } while (0)
    WY_RAW(su * RW_SUP);
#pragma unroll 1
    for (int cc = 0; cc < RW_SUP; ++cc) {
        const int u = su * RW_SUP + cc;
        const int bh = u >> 8, ch = u & 255, b = bh >> 2, h = bh & 3, m0 = b * SEQ + ch * RWC, hc = h * 64 + lane;
        const float kkw = C.in[I_RW_KK][l * 256 + hc], kaw = C.in[I_RW_KA][l * 256 + hc], rkw = C.in[I_RW_RK][l * 256 + hc], w0l = C.in[I_RW_W0][l * 256 + hc], a0l = C.in[I_RW_A0][l * 256 + hc];
        { float wv[8], kk[8], ka[8], kp[8], rr[8], vv[8];
          float bon8[8], rf[8], kf[8], af[8], wf[8];
#pragma unroll
          for (int i = 0; i < 8; ++i) { rf[i] = bf2f(r16[i]); kf[i] = bf2f(k16[i]); vv[i] = bf2f(v16[i]); af[i] = bf2f(a16[i]); wf[i] = wd[i]; }
          if (cc + 1 < RW_SUP) WY_RAW(u + 1);
#pragma unroll
          for (int i = 0; i < 8; ++i) {
              const float r = rf[i], k = kf[i];
              wv[i] = __builtin_amdgcn_exp2f(-0.606531f * LOG2E * sigm(wf[i] + w0l)); const float a = sigm(af[i] + a0l);
              const float kr = k * kkw; kk[i] = kr * __builtin_amdgcn_rsqf(fmaxf(wave_sum(kr * kr, lane), 1e-24f));
              kp[i] = k * (1.f + (a - 1.f) * kaw); ka[i] = kk[i] * a; rr[i] = r;
              bon8[i] = wave_sum(r * kp[i] * rkw, lane); }
          if (lane == 0) {
#pragma unroll
              for (int i = 0; i < 8; ++i) BON[(size_t)(m0 + 8 * w + i) * 4 + h] = bon8[i]; }
          float cp[8]; cp[0] = wv[0];
#pragma unroll
          for (int i = 1; i < 8; ++i) cp[i] = cp[i - 1] * wv[i];
          GH[w * 64 + lane] = cp[7];
          __syncthreads();
          const float pre = half ? GH[(w - 1) * 64 + lane] : 1.f, gC = half ? pre * cp[7] : cp[7] * GH[(w + 1) * 64 + lane];
          if (!half) GCs[sq * 64 + lane] = gC;
#pragma unroll
          for (int i = 0; i < 8; ++i) { const int t = 8 * half + i; const float G = pre * cp[i], Gm1 = (i == 0) ? pre : pre * cp[i - 1], rG = __builtin_amdgcn_rcpf(G);
              WY_ROW(sq, 0)[t * MM_LP + lane] = f2bf(-kk[i] * Gm1); WY_ROW(sq, 1)[t * MM_LP + lane] = f2bf(ka[i] * rG); WY_ROW(sq, 2)[t * MM_LP + lane] = f2bf(kp[i] * rG); WY_ROW(sq, 3)[t * MM_LP + lane] = f2bf(rr[i] * G);
              WY_COL(sq, 0)[lane * WY_LT + t] = f2bf(ka[i] * rG * gC); WY_COL(sq, 1)[lane * WY_LT + t] = f2bf(kp[i] * rG * gC); WY_COL(sq, 2)[lane * WY_LT + t] = f2bf(vv[i]); } }
        __syncthreads();
#pragma unroll
        for (int pp = 0; pp < 2; ++pp) { const int id = 2 * half + pp;
            f32x4 acc = (f32x4){0.f, 0.f, 0.f, 0.f};
            acc = wy_mm16(WY_ROW(sq, half ? 3 : 0), WY_ROW(sq, pp ? 2 : 1), acc, li, lq);
#pragma unroll
            for (int r = 0; r < 4; ++r) { const int t = 4 * lq + r; const bool keep = half ? (li <= t) : (li < t); const float val = keep ? acc[r] : 0.f;
                WY_A(sq, id)[t * WY_LT + li] = f2bf(val); if (id == 0) ((LAS float*)(L + WY_AABF + sq * 1024))[t * 16 + li] = val; } }
        __syncthreads();
        if (w < 4) { const LAS float* Af = (const LAS float*)(L + WY_AABF + w * 1024); float Tc[16];
#pragma unroll
            for (int t = 0; t < 16; ++t) { float acc = (t == li) ? 1.f : 0.f;
#pragma unroll
                for (int s4 = 0; s4 < 4; ++s4) { if (4 * s4 < t) { const f32x4 a4 = *(const LAS f32x4*)(Af + t * 16 + 4 * s4);
                    if (4 * s4 + 0 < t) acc += a4.x * Tc[4 * s4 + 0]; if (4 * s4 + 1 < t) acc += a4.y * Tc[4 * s4 + 1]; if (4 * s4 + 2 < t) acc += a4.z * Tc[4 * s4 + 2]; if (4 * s4 + 3 < t) acc += a4.w * Tc[4 * s4 + 3]; } }
                Tc[t] = acc; WY_A(w, 4)[t * WY_LT + li] = f2bf(acc); } }
        if (cc == 0) {
#pragma unroll
            for (int r = 0; r < 4; ++r)
#pragma unroll
                for (int e = 0; e < 4; ++e) { const int row = 32 * ti + 8 * r + 4 * hi + e, col = 32 * tj + j32; S[4 * r + e] = (ti >= 2 && row - 64 == col) ? 1.f : 0.f; }
#pragma unroll
            for (int r = 0; r < 4; ++r)
#pragma unroll
                for (int e = 0; e < 4; ++e) SB[(32 * ti + 8 * r + 4 * hi + e) * MM_LP + 32 * tj + j32] = f2bf(S[4 * r + e]);
        }
        __syncthreads();
#pragma unroll 1
        for (int q = 0; q < 4; ++q) {
            f32x4 accW = (f32x4){0.f, 0.f, 0.f, 0.f}, accY = accW;
            accW = wy_mm16(WY_ROW(q, 0), SB + 16 * w * MM_LP, accW, li, lq);
            accY = wy_mm16(WY_ROW(q, 3), SB + 16 * w * MM_LP, accY, li, lq);
            if (w < 4) accW = wy_mm16k16(WY_A(q, 1), WY_COL(q, 2) + 16 * w * WY_LT, accW, li, lq);
            { u32x2 pk; pk.x = cvt_pk_bf16(accW[0], accW[1]); pk.y = cvt_pk_bf16(accW[2], accW[3]); *(LAS u32x2*)(WT + (16 * w + li) * WY_LT + 4 * lq) = pk; }
            asm volatile("s_waitcnt lgkmcnt(0)" ::: "memory");
            { f32x4 accU = (f32x4){0.f, 0.f, 0.f, 0.f}; accU = wy_mm16k16(WY_A(q, 4), WT + 16 * w * WY_LT, accU, li, lq);
              u32x2 pk; pk.x = cvt_pk_bf16(accU[0], accU[1]); pk.y = cvt_pk_bf16(accU[2], accU[3]); *(LAS u32x2*)(UT + (16 * w + li) * WY_LT + 4 * lq) = pk; }
            asm volatile("s_waitcnt lgkmcnt(0)" ::: "memory");
            accY = wy_mm16k16(WY_A(q, 2), UT + 16 * w * WY_LT, accY, li, lq);
            if (w < 4) accY = wy_mm16k16(WY_A(q, 3), WY_COL(q, 2) + 16 * w * WY_LT, accY, li, lq);
            { bf16* dst = (w < 4) ? Y0 : RH; const int colo = h * 64 + ((16 * w) & 63) + li;
#pragma unroll
              for (int r = 0; r < 4; ++r) dst[(size_t)(m0 + 16 * q + 4 * lq + r) * 256 + colo] = f2bf(accY[r]); }
            __syncthreads();
            { const float gc = GCs[q * 64 + 32 * tj + j32];
#pragma unroll
              for (int i = 0; i < 16; ++i) S[i] *= gc;
              const bf16x8 ua = *(const LAS bf16x8*)(UT + (32 * ti + j32) * WY_LT + 8 * hi), bb = *(const LAS bf16x8*)(WY_COL(q, 0) + (32 * tj + j32) * WY_LT + 8 * hi);
              S = __builtin_amdgcn_mfma_f32_32x32x16_bf16(ua, bb, S, 0, 0, 0);
              if (ti < 2) { const bf16x8 va = *(const LAS bf16x8*)(WY_COL(q, 2) + (32 * ti + j32) * WY_LT + 8 * hi), kb = *(const LAS bf16x8*)(WY_COL(q, 1) + (32 * tj + j32) * WY_LT + 8 * hi);
                  S = __builtin_amdgcn_mfma_f32_32x32x16_bf16(va, kb, S, 0, 0, 0); } }
            {
#pragma unroll
                for (int r = 0; r < 4; ++r)
#pragma unroll
                    for (int e = 0; e < 4; ++e) SB[(32 * ti + 8 * r + 4 * hi + e) * MM_LP + 32 * tj + j32] = f2bf(S[4 * r + e]);
                __syncthreads(); }
        }
        if (cc == RW_SUP - 1) {
        if (ti < 2) { float* o = PQ + (size_t)su * 4096 + (size_t)(32 * ti + 4 * hi) * 64 + 32 * tj + j32;
#pragma unroll
            for (int r = 0; r < 4; ++r)
#pragma unroll
                for (int e = 0; e < 4; ++e) o[(8 * r + e) * 64] = S[4 * r + e]; }
        else { float* o = PQ + ((size_t)RW_NSUP + su) * 4096 + (size_t)(32 * tj + j32) * 64 + 32 * (ti - 2) + 4 * hi;
#pragma unroll
            for (int r = 0; r < 4; ++r) *(f32x4*)(o + 8 * r) = (f32x4){S[4 * r], S[4 * r + 1], S[4 * r + 2], S[4 * r + 3]}; }
        }
        __syncthreads();
    }
    }
#undef WY_ROW
#undef WY_COL
#undef WY_A
#undef WY_RAW
}
__device__ __forceinline__ void ph_rw_scan_(const Ctx& C, int wg) {
    const float* Qg = (const float*)(C.ws + WS_PQ); const float* Pg = Qg + (size_t)RW_NSUP * 4096; float* SST = (float*)(C.ws + WS_SST);
    LAS bf16* PT = (LAS bf16*)(C.lds);
    LAS bf16* SLb = PT + 2 * 64 * MM_LP;
    LAS float* QL = (LAS float*)(C.lds + (2 * 64 * MM_LP + 2 * 16 * MM_LP) * 2);
    LAS float* SO = QL + 2 * 16 * 64;
    const int lane = C.lane, wave = C.wave, bh = wg >> 2, rq = wg & 3, ct = wave & 3, li = lane & 15, lq = lane >> 4;
    const bool mm = wave < 4;
    const size_t ubase = (size_t)bh * RW_NSC;
    const int lt = C.tid & 255;
    const int qrow = lt >> 4, qc4 = (lt & 15) * 4;
    constexpr int PD = 6;
    f32x4 pr[PD][4], qr[PD];
#define SC_P_PIECE(i) (lt + 256 * (i))
#define SC_PUT_P(buf, sx_) do { LAS bf16* d_ = PT + (buf) * (64 * MM_LP); _Pragma("unroll") for (int i_ = 0; i_ < 4; ++i_) { const int idx_ = SC_P_PIECE(i_), r_ = (idx_ * 4) >> 6, k_ = (idx_ * 4) & 63; u32x2 w_; \
        w_.x = cvt_pk_bf16(pr[sx_][i_].x, pr[sx_][i_].y); w_.y = cvt_pk_bf16(pr[sx_][i_].z, pr[sx_][i_].w); *(LAS u32x2*)(d_ + r_ * MM_LP + k_) = w_; } } while (0)
#define SC_LOAD(sx_, cc) do { const f32x4* p4_ = (const f32x4*)(Pg + (ubase + (cc)) * 4096); _Pragma("unroll") for (int i_ = 0; i_ < 4; ++i_) pr[sx_][i_] = p4_[SC_P_PIECE(i_)]; \
        qr[sx_] = *(const f32x4*)(Qg + (ubase + (cc)) * 4096 + (rq * 16 + qrow) * 64 + qc4); } while (0)
    if (mm) {
#pragma unroll
        for (int r = 0; r < 4; ++r) SLb[(4 * lq + r) * MM_LP + ct * 16 + li] = (bf16)0;
    } else {
        { float z0; asm volatile("v_mov_b32 %0, 0" : "=v"(z0));
          *(f32x4*)(SST + ubase * 4096 + (rq * 16 + qrow) * 64 + qc4) = (f32x4){z0, z0, z0, z0}; }
        SC_LOAD(0, 0); SC_PUT_P(0, 0); *(LAS f32x4*)(QL + qrow * 64 + qc4) = qr[0];
#pragma unroll
        for (int x = 0; x < PD; ++x) SC_LOAD(x, 1 + x);
    }
    __syncthreads();
#pragma unroll 1
    for (int c2 = 0; c2 < RW_NSC; c2 += PD) {
#pragma unroll
        for (int x = 0; x < PD; ++x) {
            const int c = c2 + x;
            if (c < RW_NSC) {
            if (mm) {
                const LAS bf16* Pc = PT + (c & 1) * (64 * MM_LP); const LAS bf16* Sc = SLb + (c & 1) * (16 * MM_LP); const LAS float* Qc = QL + (c & 1) * (16 * 64);
                LAS bf16* Sn = SLb + ((c + 1) & 1) * (16 * MM_LP); LAS float* So = SO + ((c + 1) & 1) * (16 * 64);
                bf16x8 af[2], bfr[2];
#pragma unroll
                for (int ks = 0; ks < 2; ++ks) { af[ks] = *(const LAS bf16x8*)(Sc + li * MM_LP + 32 * ks + 8 * lq); bfr[ks] = *(const LAS bf16x8*)(Pc + (16 * ct + li) * MM_LP + 32 * ks + 8 * lq); }
                f32x4 acc;
#pragma unroll
                for (int r = 0; r < 4; ++r) acc[r] = Qc[(4 * lq + r) * 64 + ct * 16 + li];
#pragma unroll
                for (int ks = 0; ks < 2; ++ks) acc = __builtin_amdgcn_mfma_f32_16x16x32_bf16(af[ks], bfr[ks], acc, 0, 0, 0);
                if (c + 1 < RW_NSC) {
#pragma unroll
                    for (int r = 0; r < 4; ++r) { Sn[(4 * lq + r) * MM_LP + ct * 16 + li] = f2bf(acc[r]); So[(4 * lq + r) * 64 + ct * 16 + li] = acc[r]; } }
            } else {
                if (c > 0) *(f32x4*)(SST + (ubase + c) * 4096 + (rq * 16 + qrow) * 64 + qc4) = *(const LAS f32x4*)(SO + (c & 1) * (16 * 64) + qrow * 64 + qc4);
                if (c + 1 < RW_NSC) { SC_PUT_P((c + 1) & 1, x); *(LAS f32x4*)(QL + ((c + 1) & 1) * (16 * 64) + qrow * 64 + qc4) = qr[x]; }
                if (c + 1 + PD < RW_NSC) SC_LOAD(x, c + 1 + PD);
            }
            __syncthreads();
#ifdef SCAN_2BAR
            __syncthreads();
#endif
            }
        }
    }
#undef SC_PUT_P
#undef SC_LOAD
#undef SC_P_PIECE
}
__device__ __forceinline__ void ph_rw_out_(const Ctx& C, int l) {
    const bf16* RKVS = (const bf16*)(C.ws + WS_RKVS); const bf16* AG = (const bf16*)(C.ws + WS_AG); const bf16* Y0 = (const bf16*)(C.ws + WS_Y0); const bf16* RH = (const bf16*)(C.ws + WS_RHAT);
    const float* SST = (const float*)(C.ws + WS_SST); const float* BON = (const float*)(C.ws + WS_BON); bf16* Y = (bf16*)(C.ws + WS_Y);
    LAS float* RL = (LAS float*)(C.lds);
    const int lane = C.lane, wave = C.wave;
    for (int u = C.bid; u < RW_NU; u += C.G) {
        const int bh = u >> 8, ch = u & 255, b = bh >> 2, h = bh & 3, m0 = b * SEQ + ch * RWC, hc = h * 64 + lane;
        { const int t = C.tid >> 3, d0 = (C.tid & 7) * 8; float a[8];
          unpack8(*(const u32x4*)(RH + (size_t)(m0 + t) * 256 + h * 64 + d0), a);
#pragma unroll
          for (int e = 0; e < 8; ++e) RL[t * 64 + d0 + e] = a[e]; }
        float s[64];
        { const f32x4* sp = (const f32x4*)(SST + (size_t)u * 4096 + lane * 64);
#pragma unroll
          for (int k4 = 0; k4 < 16; ++k4) { const f32x4 v = sp[k4]; s[4 * k4] = v.x; s[4 * k4 + 1] = v.y; s[4 * k4 + 2] = v.z; s[4 * k4 + 3] = v.w; } }
        const float lnw = C.in[I_RW_LNW][l * 256 + hc], lnb = C.in[I_RW_LNB][l * 256 + hc];
        __syncthreads();
#pragma unroll 2
        for (int q = 0; q < 8; ++q) { const int t = wave * 8 + q; const size_t m = (size_t)(m0 + t);
            const LAS f32x4* rv = (const LAS f32x4*)(RL + t * 64);
            float y0 = 0.f, y1 = 0.f, y2 = 0.f, y3 = 0.f;
#pragma unroll
            for (int k4 = 0; k4 < 16; ++k4) { const f32x4 rq = rv[k4]; y0 += s[4 * k4] * rq.x; y1 += s[4 * k4 + 1] * rq.y; y2 += s[4 * k4 + 2] * rq.z; y3 += s[4 * k4 + 3] * rq.w; }
#ifndef RWDBG
#define RWDBG 0
#endif
            float y = ((RWDBG & 1) ? 0.f : (y0 + y1) + (y2 + y3)) + ((RWDBG & 2) ? 0.f : bf2f(Y0[m * 256 + hc]));
            const float mean = wave_sum(y, C.lane) * (1.f / 64.f); y -= mean;
            const float rstd = 1.0f / sqrtf(wave_sum(y * y, C.lane) * (1.f / 64.f) + 64e-5f);
            y = y * rstd * lnw + lnb;
            if (!(RWDBG & 4)) y += BON[m * 4 + h] * bf2f(RKVS[m * 768 + 512 + hc]);
            y *= bf2f(AG[m * 512 + 256 + hc]);
            if (RWDBG & 120) { y = 0.f; if (RWDBG & 8) y += ((const float*)(C.ws + WS_WDEC))[m * 256 + hc]; if (RWDBG & 16) y += bf2f(AG[m * 512 + hc]);
                if (RWDBG & 32) y += bf2f(RKVS[m * 768 + hc]) + bf2f(RKVS[m * 768 + 256 + hc]) + bf2f(RKVS[m * 768 + 512 + hc]); if (RWDBG & 64) y += BON[m * 4 + h]; }
            Y[m * 1024 + hc] = f2bf(y); }
        __syncthreads();
    }
}

constexpr int SB_VLD = 40;
__device__ __forceinline__ void ph_sb_attn_(const Ctx& C, int first_wg, int nwg, unsigned* qhead = nullptr) {
    const bf16* SB = (const bf16*)(C.ws + WS_SB); bf16* Y = (bf16*)(C.ws + WS_Y);
    const int lane = C.lane, j = lane & 31, hi = lane >> 5;
    LAS bf16* VT = (LAS bf16*)(C.lds + C.wave * (64 * SB_VLD * 2));
    for (int it = qhead ? q_next(C, qhead) : C.bid - first_wg; it < 512; it = qhead ? q_next(C, qhead) : it + nwg) {
        const int bh = it >> 6, b = bh >> 2, h = bh & 3, t0 = (it & 63) * 256 + C.wave * 32; const size_t mb = (size_t)b * SEQ;
        bf16x8 qf[4];
#pragma unroll
        for (int ks = 0; ks < 4; ++ks) qf[ks] = *(const bf16x8*)(SB + (mb + t0 + j) * 768 + h * 64 + 16 * ks + 8 * hi);
        f32x16 o0, o1;
#pragma unroll
        for (int i = 0; i < 16; ++i) { o0[i] = 0.f; o1[i] = 0.f; }
        float acc = 0.f;
#pragma unroll 1
        for (int kt = t0; kt >= 0; kt -= 32) {
            bf16x8 kf[4];
#pragma unroll
            for (int ks = 0; ks < 4; ++ks) kf[ks] = *(const bf16x8*)(SB + (mb + kt + j) * 768 + 256 + h * 64 + 16 * ks + 8 * hi);
            u32x4 vv[4];
#pragma unroll
            for (int i = 0; i < 4; ++i) { const int c = lane + 64 * i; vv[i] = *(const u32x4*)(SB + (mb + kt + (c >> 3)) * 768 + 512 + h * 64 + (c & 7) * 8); }
            f32x16 sc;
#pragma unroll
            for (int i = 0; i < 16; ++i) sc[i] = 0.f;
#pragma unroll
            for (int ks = 0; ks < 4; ++ks) sc = __builtin_amdgcn_mfma_f32_32x32x16_bf16(kf[ks], qf[ks], sc, 0, 0, 0);
#pragma unroll
            for (int i = 0; i < 4; ++i) { const int c = lane + 64 * i, key = c >> 3, d8 = (c & 7) * 8; const unsigned w[4] = {vv[i].x, vv[i].y, vv[i].z, vv[i].w};
#pragma unroll
                for (int e = 0; e < 4; ++e) { VT[(d8 + 2 * e) * SB_VLD + key] = (bf16)(w[e] & 0xffffu); VT[(d8 + 2 * e + 1) * SB_VLD + key] = (bf16)(w[e] >> 16); } }
            const bool diag = (kt == t0);
            float ls[16], g[4], og[4];
#pragma unroll
            for (int r = 0; r < 4; ++r) { g[r] = 0.f;
#pragma unroll
                for (int e = 0; e < 4; ++e) { const float z = sc[4 * r + e]; const bool valid = !diag || (8 * r + 4 * hi + e) < j;
                    const float l = (z > 40.f) ? -z : -__builtin_amdgcn_logf(1.f + __builtin_amdgcn_exp2f(z));
                    ls[4 * r + e] = valid ? l : 0.f; g[r] += ls[4 * r + e]; } }
#pragma unroll
            for (int r = 0; r < 4; ++r) og[r] = shx(g[r], 32, lane);
            float pw[16]; float run = acc;
#pragma unroll
            for (int r = 3; r >= 0; --r) { float cum = run + (hi == 0 ? og[r] : 0.f);
#pragma unroll
                for (int e = 3; e >= 0; --e) { cum += ls[4 * r + e]; const bool valid = !diag || (8 * r + 4 * hi + e) < j;
                    pw[4 * r + e] = valid ? __builtin_amdgcn_exp2f(sc[4 * r + e] + cum) : 0.f; }
                run += g[r] + og[r]; }
            acc = run;
            asm volatile("" ::: "memory");
#pragma unroll
            for (int ks = 0; ks < 2; ++ks) {
                u32x4 pk; pk.x = cvt_pk_bf16(pw[8 * ks], pw[8 * ks + 1]); pk.y = cvt_pk_bf16(pw[8 * ks + 2], pw[8 * ks + 3]); pk.z = cvt_pk_bf16(pw[8 * ks + 4], pw[8 * ks + 5]); pk.w = cvt_pk_bf16(pw[8 * ks + 6], pw[8 * ks + 7]);
                const bf16x8 pb = __builtin_bit_cast(bf16x8, pk);
                const s16x4 a0l = *(const LAS s16x4*)(VT + j * SB_VLD + 16 * ks + 4 * hi), a0h = *(const LAS s16x4*)(VT + j * SB_VLD + 16 * ks + 8 + 4 * hi);
                const s16x4 a1l = *(const LAS s16x4*)(VT + (32 + j) * SB_VLD + 16 * ks + 4 * hi), a1h = *(const LAS s16x4*)(VT + (32 + j) * SB_VLD + 16 * ks + 8 + 4 * hi);
                const bf16x8 va0 = __builtin_shufflevector(a0l, a0h, 0, 1, 2, 3, 4, 5, 6, 7), va1 = __builtin_shufflevector(a1l, a1h, 0, 1, 2, 3, 4, 5, 6, 7);
                o0 = __builtin_amdgcn_mfma_f32_32x32x16_bf16(va0, pb, o0, 0, 0, 0);
                o1 = __builtin_amdgcn_mfma_f32_32x32x16_bf16(va1, pb, o1, 0, 0, 0);
            }
            asm volatile("" ::: "memory");
            if (__builtin_amdgcn_ballot_w64(acc > -140.f) == 0ull) break;
        }
        bf16* yp = Y + (mb + t0 + j) * 1024 + 256 + h * 64 + 4 * hi;
#pragma unroll
        for (int r = 0; r < 4; ++r) { u32x2 w0, w1; w0.x = cvt_pk_bf16(o0[4 * r], o0[4 * r + 1]); w0.y = cvt_pk_bf16(o0[4 * r + 2], o0[4 * r + 3]); w1.x = cvt_pk_bf16(o1[4 * r], o1[4 * r + 1]); w1.y = cvt_pk_bf16(o1[4 * r + 2], o1[4 * r + 3]);
            *(u32x2*)(yp + 8 * r) = w0; *(u32x2*)(yp + 32 + 8 * r) = w1; }
    }
}


__device__ __forceinline__ f32x16 mm_tile(const LAS bf16* X, const LAS bf16* Y, int ti, int tj, int lane) {
    const int j = lane & 31, hi = lane >> 5; f32x16 acc;
#pragma unroll
    for (int i = 0; i < 16; ++i) acc[i] = 0.f;
#pragma unroll
    for (int ks = 0; ks < 4; ++ks) { const bf16x8 a = *(const LAS bf16x8*)(X + (32 * ti + j) * MM_LP + 16 * ks + 8 * hi), b = *(const LAS bf16x8*)(Y + (32 * tj + j) * MM_LP + 16 * ks + 8 * hi);
        acc = __builtin_amdgcn_mfma_f32_32x32x16_bf16(a, b, acc, 0, 0, 0); }
    return acc;
}
__device__ __forceinline__ void ln_pair_stats(const f32x16& x, LAS float* XCH, int tr, int tt, int lane, float eps, float& mean, float& rstd) {
    const int j = lane & 31, hi = lane >> 5; float s1 = 0.f, s2 = 0.f;
#pragma unroll
    for (int i = 0; i < 16; ++i) { s1 += x[i]; s2 += x[i] * x[i]; }
    s1 += shx(s1, 32, lane); s2 += shx(s2, 32, lane);
    if (hi == 0) { XCH[(tr * 64 + 32 * tt + j) * 2] = s1; XCH[(tr * 64 + 32 * tt + j) * 2 + 1] = s2; }
    __syncthreads();
    const float a1 = XCH[(32 * tt + j) * 2] + XCH[(64 + 32 * tt + j) * 2], a2 = XCH[(32 * tt + j) * 2 + 1] + XCH[(64 + 32 * tt + j) * 2 + 1];
    mean = a1 * (1.f / 64.f); const float var = fmaxf(a2 * (1.f / 64.f) - mean * mean, 0.f); rstd = 1.0f / sqrtf(var + eps);
}
__device__ __forceinline__ void rot_store(const Ctx& C, const bf16* src  , int pos, int d0, float scale, LAS bf16* dstrow) {
    const float* cs = (const float*)(C.ws + WS_COS) + (size_t)pos * 32 + d0; const float* sn = (const float*)(C.ws + WS_SIN) + (size_t)pos * 32 + d0;
    float x1[8], x2[8]; unpack8(*(const u32x4*)(src + d0), x1); unpack8(*(const u32x4*)(src + 32 + d0), x2);
    const f32x4 c0 = *(const f32x4*)cs, c1 = *(const f32x4*)(cs + 4), s0 = *(const f32x4*)sn, s1 = *(const f32x4*)(sn + 4);
    const float cc[8] = {c0.x, c0.y, c0.z, c0.w, c1.x, c1.y, c1.z, c1.w}, ss[8] = {s0.x, s0.y, s0.z, s0.w, s1.x, s1.y, s1.z, s1.w};
    float o1[8], o2[8];
#pragma unroll
    for (int e = 0; e < 8; ++e) { o1[e] = (x1[e] * cc[e] - x2[e] * ss[e]) * scale; o2[e] = (x1[e] * ss[e] + x2[e] * cc[e]) * scale; }
    *(LAS u32x4*)(dstrow + d0) = pack8(o1); *(LAS u32x4*)(dstrow + 32 + d0) = pack8(o2);
}

__device__ __forceinline__ void ph_ret_kv2_(const Ctx& C) {
    const bf16* RET = (const bf16*)(C.ws + WS_RET); float* KV = (float*)(C.ws + WS_KV);
    const int half = C.wave >> 2, w4 = C.wave & 3, th = C.tid & 255, lane = C.lane;
    LAS bf16* KT = (LAS bf16*)(C.lds + half * 36864);
    LAS bf16* VT = KT + 64 * MM_LP;
    LAS bf16* KR = VT + 64 * MM_LP;
    for (int it = C.bid; it < 1024; it += C.G) {
        const int u = it * 2 + half, bh = u >> 8, ch = u & 255, b = bh >> 2, h = bh & 3, m0 = b * SEQ + ch * 64;
        const float lg = ret_log2gamma(h);
        { const int srow = th >> 2, dq = th & 3; const size_t m = (size_t)(m0 + srow);
          rot_store(C, RET + m * 1024 + 256 + h * 64, (int)(m & (SEQ - 1)), dq * 8, 0.125f * exp2f(lg * (float)(63 - srow)), KR + srow * MM_LP);
          float a[8];
#pragma unroll
          for (int q = 0; q < 2; ++q) { const int e0 = dq * 16 + q * 8; unpack8(*(const u32x4*)(RET + m * 1024 + 512 + h * 64 + e0), a);
#pragma unroll
              for (int e = 0; e < 8; ++e) VT[(e0 + e) * MM_LP + srow] = f2bf(a[e]); } }
        __syncthreads();
        { const int d = th >> 2, s0 = (th & 3) * 16;
#pragma unroll
          for (int i = 0; i < 16; ++i) KT[d * MM_LP + s0 + i] = KR[(s0 + i) * MM_LP + d]; }
        __syncthreads();
        { const int ti = w4 >> 1, tj = w4 & 1, j = lane & 31, hi = lane >> 5;
          const f32x16 acc = mm_tile(VT, KT, ti, tj, lane);
          float* o = KV + (size_t)u * 4096 + (size_t)(32 * ti + 4 * hi) * 64 + 32 * tj + j;
#pragma unroll
          for (int r = 0; r < 4; ++r)
#pragma unroll
              for (int e = 0; e < 4; ++e) o[(8 * r + e) * 64] = acc[4 * r + e]; }
        __syncthreads();
    }
}
__device__ __forceinline__ void ph_ret_out2_(const Ctx& C, int l, int first_wg, int nwg, unsigned* qhead = nullptr) {
    const bf16* RET = (const bf16*)(C.ws + WS_RET); const float* KV = (const float*)(C.ws + WS_KV); bf16* Y = (bf16*)(C.ws + WS_Y);
    const int half = C.wave >> 2, w4 = C.wave & 3, th = C.tid & 255, lane = C.lane, j = lane & 31, hi = lane >> 5, te = w4 >> 1, tt = w4 & 1;
    LAS bf16* QL = (LAS bf16*)(C.lds + half * 40960);
    LAS bf16* KL = QL + 64 * MM_LP;
    LAS bf16* VT = KL + 64 * MM_LP;
    LAS bf16* ST = VT + 64 * MM_LP;
    LAS float* XCH = (LAS float*)(C.lds + half * 40960 + 4 * 64 * MM_LP * 2);
    const float* gn = C.in[I_RET_GN] + (size_t)l * 256;
    for (int it = qhead ? q_next(C, qhead) : C.bid - first_wg; it < 1024; it = qhead ? q_next(C, qhead) : it + nwg) {
        const int u = it * 2 + half, bh = u >> 8, ch = u & 255, b = bh >> 2, h = bh & 3, m0 = b * SEQ + ch * 64;
        const float lg = ret_log2gamma(h);
        { const int srow = th >> 2, dq = th & 3; const size_t m = (size_t)(m0 + srow); const int pos = (int)(m & (SEQ - 1));
          rot_store(C, RET + m * 1024 + h * 64, pos, dq * 8, 1.0f, QL + srow * MM_LP);
          rot_store(C, RET + m * 1024 + 256 + h * 64, pos, dq * 8, 0.125f, KL + srow * MM_LP);
          float a[8];
#pragma unroll
          for (int q = 0; q < 2; ++q) { const int e0 = dq * 16 + q * 8; unpack8(*(const u32x4*)(RET + m * 1024 + 512 + h * 64 + e0), a);
#pragma unroll
              for (int e = 0; e < 8; ++e) VT[(e0 + e) * MM_LP + srow] = f2bf(a[e]); }
          const float* sp = KV + (size_t)u * 4096 + srow * 64 + dq * 16;
          float sv[16];
#pragma unroll
          for (int q = 0; q < 4; ++q) { const f32x4 v4 = *(const f32x4*)(sp + 4 * q); sv[4 * q] = v4.x; sv[4 * q + 1] = v4.y; sv[4 * q + 2] = v4.z; sv[4 * q + 3] = v4.w; }
          *(LAS u32x4*)(ST + srow * MM_LP + dq * 16) = pack8(sv); *(LAS u32x4*)(ST + srow * MM_LP + dq * 16 + 8) = pack8(sv + 8); }
        __syncthreads();
        f32x16 acc = mm_tile(ST, QL, te, tt, lane);
        { const float qd = exp2f(lg * (float)(32 * tt + j + 1));
#pragma unroll
          for (int i = 0; i < 16; ++i) acc[i] *= qd; }
#pragma unroll
        for (int st = 0; st < 2; ++st) {
            if (st > tt) continue;
            const f32x16 sc = mm_tile(KL, QL, st, tt, lane);
            float pw[16];
#pragma unroll
            for (int r = 0; r < 4; ++r)
#pragma unroll
                for (int e = 0; e < 4; ++e) { const int sk = 32 * st + 8 * r + 4 * hi + e, tq = 32 * tt + j;
                    pw[4 * r + e] = (sk <= tq) ? sc[4 * r + e] * exp2f(lg * (float)(tq - sk)) : 0.f; }
#pragma unroll
            for (int ks = 0; ks < 2; ++ks) {
                u32x4 pk; pk.x = cvt_pk_bf16(pw[8 * ks], pw[8 * ks + 1]); pk.y = cvt_pk_bf16(pw[8 * ks + 2], pw[8 * ks + 3]); pk.z = cvt_pk_bf16(pw[8 * ks + 4], pw[8 * ks + 5]); pk.w = cvt_pk_bf16(pw[8 * ks + 6], pw[8 * ks + 7]);
                const bf16x8 pb = __builtin_bit_cast(bf16x8, pk);
                const LAS bf16* vr = VT + (32 * te + j) * MM_LP + 32 * st + 16 * ks + 4 * hi;
                const s16x4 al = *(const LAS s16x4*)vr, ah = *(const LAS s16x4*)(vr + 8);
                const bf16x8 va = __builtin_shufflevector(al, ah, 0, 1, 2, 3, 4, 5, 6, 7);
                acc = __builtin_amdgcn_mfma_f32_32x32x16_bf16(va, pb, acc, 0, 0, 0);
            }
        }
        float mean, rstd; ln_pair_stats(acc, XCH, te, tt, lane, 1e-5f, mean, rstd);
        { const size_t m = (size_t)(m0 + 32 * tt + j); const bf16* gp = RET + m * 1024 + 768 + h * 64 + 32 * te + 4 * hi; bf16* yp = Y + m * 1024 + 512 + h * 64 + 32 * te + 4 * hi;
          const float* gw = gn + h * 64 + 32 * te + 4 * hi;
#pragma unroll
          for (int r = 0; r < 4; ++r) { const u32x2 gt2 = *(const u32x2*)(gp + 8 * r); const float gtv[4] = {bflo(gt2.x), bfhi(gt2.x), bflo(gt2.y), bfhi(gt2.y)}; const f32x4 gwv = *(const f32x4*)(gw + 8 * r);
              float o[4];
#pragma unroll
              for (int e = 0; e < 4; ++e) o[e] = (acc[4 * r + e] - mean) * rstd * gwv[e] * (gtv[e] * sigm(gtv[e]));
              u32x2 w; w.x = cvt_pk_bf16(o[0], o[1]); w.y = cvt_pk_bf16(o[2], o[3]); *(u32x2*)(yp + 8 * r) = w; } }
        __syncthreads();
    }
}
__device__ __forceinline__ void ph_rw_out2_(const Ctx& C, int l) {
    const bf16* RKVS = (const bf16*)(C.ws + WS_RKVS); const bf16* AG = (const bf16*)(C.ws + WS_AG); const bf16* Y0 = (const bf16*)(C.ws + WS_Y0); const bf16* RH = (const bf16*)(C.ws + WS_RHAT);
    const float* SST = (const float*)(C.ws + WS_SST); const float* BON = (const float*)(C.ws + WS_BON); bf16* Y = (bf16*)(C.ws + WS_Y);
    const int half = C.wave >> 2, w4 = C.wave & 3, th = C.tid & 255, lane = C.lane, j = lane & 31, hi = lane >> 5, tv = w4 >> 1, tt = w4 & 1;
    LAS bf16* SL = (LAS bf16*)(C.lds + half * 20480);
    LAS bf16* RL = SL + 64 * MM_LP;
    LAS float* XCH = (LAS float*)(C.lds + half * 20480 + 2 * 64 * MM_LP * 2);
    for (int it = C.bid; it < RW_NU / 2; it += C.G) {
        const int u = it * 2 + half, bh = u >> 8, ch = u & 255, b = bh >> 2, h = bh & 3, m0 = b * SEQ + ch * RWC;
        { const int row = th >> 2, q4 = th & 3;
          const float* sp = SST + (size_t)(u >> 3) * 4096 + row * 64 + q4 * 16; float sv[16];
#pragma unroll
          for (int q = 0; q < 4; ++q) { const f32x4 v4 = *(const f32x4*)(sp + 4 * q); sv[4 * q] = v4.x; sv[4 * q + 1] = v4.y; sv[4 * q + 2] = v4.z; sv[4 * q + 3] = v4.w; }
          *(LAS u32x4*)(SL + row * MM_LP + q4 * 16) = pack8(sv); *(LAS u32x4*)(SL + row * MM_LP + q4 * 16 + 8) = pack8(sv + 8);
          const u32x4* rp = (const u32x4*)(RH + (size_t)(m0 + row) * 256 + h * 64 + q4 * 16);
          *(LAS u32x4*)(RL + row * MM_LP + q4 * 16) = rp[0]; *(LAS u32x4*)(RL + row * MM_LP + q4 * 16 + 8) = rp[1]; }
        __syncthreads();
        f32x16 acc = mm_tile(SL, RL, tv, tt, lane);
        const size_t m = (size_t)(m0 + 32 * tt + j); const int vb = h * 64 + 32 * tv + 4 * hi;
#pragma unroll
        for (int r = 0; r < 4; ++r) { const u32x2 y2 = *(const u32x2*)(Y0 + m * 256 + vb + 8 * r); acc[4 * r] += bflo(y2.x); acc[4 * r + 1] += bfhi(y2.x); acc[4 * r + 2] += bflo(y2.y); acc[4 * r + 3] += bfhi(y2.y); }
        float mean, rstd; ln_pair_stats(acc, XCH, tv, tt, lane, 64e-5f, mean, rstd);
        const float bon = BON[m * 4 + h];
#pragma unroll
        for (int r = 0; r < 4; ++r) { const int vc = vb + 8 * r;
            const f32x4 lw = *(const f32x4*)(C.in[I_RW_LNW] + (size_t)l * 256 + vc), lb = *(const f32x4*)(C.in[I_RW_LNB] + (size_t)l * 256 + vc);
            const u32x2 v2 = *(const u32x2*)(RKVS + m * 768 + 512 + vc), g2 = *(const u32x2*)(AG + m * 512 + 256 + vc);
            const float vv[4] = {bflo(v2.x), bfhi(v2.x), bflo(v2.y), bfhi(v2.y)}, gg[4] = {bflo(g2.x), bfhi(g2.x), bflo(g2.y), bfhi(g2.y)};
            float o[4];
#pragma unroll
            for (int e = 0; e < 4; ++e) o[e] = ((acc[4 * r + e] - mean) * rstd * lw[e] + lb[e] + bon * vv[e]) * gg[e];
            u32x2 w; w.x = cvt_pk_bf16(o[0], o[1]); w.y = cvt_pk_bf16(o[2], o[3]); *(u32x2*)(Y + m * 1024 + vc) = w; }
        __syncthreads();
    }
}

__device__ __forceinline__ void ph_moe_scatter_(const Ctx& C, int moe_idx) {
    unsigned* cw = (unsigned*)(C.ws + WS_CTL) + CW_MOE + moe_idx * 64;
    const int* eidx = (const int*)(C.ws + WS_EIDX); const float* gate = (const float*)(C.ws + WS_GATE);
    int* rowtok = (int*)(C.ws + WS_ROWTOK); float* rowgate = (float*)(C.ws + WS_ROWGATE); int* texp = (int*)(C.ws + WS_TEXP); int* segend = (int*)(C.ws + WS_SEGEND); int* ntp = (int*)(C.ws + WS_NT);
    bf16* XS = (bf16*)(C.ws + WS_XS);
    LAS unsigned* lcnt = (LAS unsigned*)(C.lds); LAS unsigned* lbase = lcnt + 8; LAS int* sl = (LAS int*)(C.lds + 256);
    int cnt[8], segb[8]; int tot = 0;
#pragma unroll
    for (int e = 0; e < 8; ++e) { cnt[e] = (int)__hip_atomic_load(&cw[e], __ATOMIC_RELAXED, __HIP_MEMORY_SCOPE_AGENT); segb[e] = tot; tot += (cnt[e] + 255) & ~255; }
    if (C.bid == 0) {
        if (C.tid < 8) { const int e = C.tid; int sb = 0, ce = 0;
#pragma unroll
            for (int q = 0; q < 8; ++q) if (q == e) { sb = segb[q]; ce = cnt[q]; }
            for (int pm = sb >> 8; pm < ((sb + ((ce + 255) & ~255)) >> 8); ++pm) { texp[pm] = e; segend[pm] = sb + ce; } }
        if (C.tid == 0) *ntp = tot >> 8;
    }
    for (int blk = C.bid; blk < T / 256; blk += C.G) {
        __syncthreads();
        if (C.tid < 8) lcnt[C.tid] = 0u;
        __syncthreads();
        const int a = blk * 512 + C.tid, e = eidx[a];
        const unsigned rank = atomicAdd((unsigned*)&lcnt[e], 1u);
        __syncthreads();
        if (C.tid < 8) lbase[C.tid] = atomicAdd(&cw[16 + C.tid], lcnt[C.tid]);
        __syncthreads();
        int sb = 0;
#pragma unroll
        for (int q = 0; q < 8; ++q) if (q == e) sb = segb[q];
        const int slot = sb + (int)lbase[e] + (int)rank;
        rowtok[slot] = a >> 1; rowgate[slot] = gate[a]; sl[C.tid] = slot; ((int*)(C.ws + WS_SLOTOF))[a] = slot;
        __syncthreads();
        for (int i = C.wave; i < 512; i += NWAVES) { const int s2 = sl[i]; const u32x4* src = (const u32x4*)(C.ws + WS_H8 + (size_t)(blk * 256 + (i >> 1)) * D); u32x4* dst = (u32x4*)(C.ws + WS_XS + (size_t)s2 * D);
            dst[C.lane] = src[C.lane]; }
    }
}

__device__ __forceinline__ void grid_barrier(int wv) {
    const Ctx C = make_ctx(wv);
    XcdBarrier b; b.bar = (unsigned*)(C.ws + WS_CTL) + CW_BAR; b.x = xb_xcc_id(); b.st = (volatile LAS unsigned*)(C.lds + MISC_OFF) + 8;
    xcd_barrier(b, C.tid);
}
__device__ __forceinline__ void P_prologue(int wv) { const Ctx C = make_ctx(wv); ph_prologue_(C); }
__device__ __forceinline__ void P_weights_norm(int wv, int l) { const Ctx C = make_ctx(wv); ph_weights_(C, l, 0, 0, C.G); __syncthreads(); ph_norm_(C, C.in[I_NORM_MIX] + (size_t)l * D, false, nullptr, 0,  (l > 0) && ((l - 1) & 1), l == 0 ? C.in[I_X] : nullptr); }
__device__ __forceinline__ void P_gemm_in(int wv) { const Ctx C = make_ctx(wv); using namespace pg8; unsigned char* ws = C.ws;
    Gemm g{(const bf16*)C.out, (const bf16*)(ws + WS_WIN), D, D}; StaticOrder S; S.init(T, NIN, C.G, C.bid);
    EpiRoute E{(bf16*)(ws + WS_RW), (bf16*)(ws + WS_SB), (bf16*)(ws + WS_RET), (bf16*)(ws + WS_CV)};
    gemm_phase<EpiRoute, StaticOrder, true, 1>(C.lds, C.tid, g, S, E); }
#define REP2(bit, stmt) do { stmt; if constexpr ((PROBE2 >> (bit)) & 1) { __syncthreads(); stmt; } } while (0)
__device__ __forceinline__ void P_mix1(int wv, int l) { REP2(2, { const Ctx C = make_ctx(wv); ph_rw_prep_(C, l); }); { const Ctx C = make_ctx(wv); ph_sb_prep_(C, l); } REP2(3, { const Ctx C = make_ctx(wv); ph_conv_(C, l); }); REP2(4, { const Ctx C = make_ctx(wv); ph_ret_kv2_(C); }); }
__device__ __forceinline__ void P_mix2(int wv, int l) { { const Ctx C = make_ctx(wv); using namespace pg8; unsigned char* ws = C.ws;
    Gemm g{(const bf16*)(ws + WS_ALORA), (const bf16*)(ws + WS_WLORA), 256, 256}; StaticOrder S; S.init(T, 768, C.G, C.bid);
    EpiLora E{(float*)(ws + WS_WDEC), (bf16*)(ws + WS_AG), C.in[I_RW_W0] + (size_t)l * 256, C.in[I_RW_A0] + (size_t)l * 256};
    gemm_phase<EpiLora, StaticOrder, true>(C.lds, C.tid, g, S, E); }
    { const Ctx C = make_ctx(wv); ph_ret_scan_(C); } }
#ifndef MIX3_SEL
#define MIX3_SEL 3
#endif
__device__ __forceinline__ void P_mix3(int wv, int l) { REP2(0, { const Ctx C = make_ctx(wv); ph_rw_local_wy_(C, l); }); }
__device__ __forceinline__ void P_mix4(int wv, int l) { const Ctx C = make_ctx(wv);
    unsigned* qh = (unsigned*)(C.ws + WS_CTL) + CW_QUEUE + l * 64;
    if (C.G >= 64) { if (C.bid < 32) { ph_rw_scan_(C, C.bid); __syncthreads(); }
        ph_sb_attn_(C, 0, C.G, qh); __syncthreads(); ph_ret_out2_(C, l, 0, C.G, qh + 16); __syncthreads(); ph_weights_(C, l, 1, 0, C.G, qh + 32); }
    else { for (int w = C.bid; w < 32; w += C.G) { ph_rw_scan_(C, w); __syncthreads(); } ph_sb_attn_(C, 0, C.G); __syncthreads(); ph_ret_out2_(C, l, 0, C.G); __syncthreads(); ph_weights_(C, l, 1, 0, C.G); } }
__device__ __forceinline__ void P_mix5(int wv, int l) { REP2(5, { const Ctx C = make_ctx(wv); ph_rw_out2_(C, l); }); }
__device__ __forceinline__ void P_gemm_branch(int wv) { const Ctx C = make_ctx(wv); using namespace pg8; unsigned char* ws = C.ws;
    Gemm g{(const bf16*)(ws + WS_Y), (const bf16*)(ws + WS_WB), D, 256}; StaticOrder S; S.init(T, 4096, C.G, C.bid, 2, 512);
    EpiBall E{ws + WS_BALL};
    gemm_phase<EpiBall, StaticOrder, false>(C.lds, C.tid, g, S, E); }
__device__ __forceinline__ void P_gemm_gate(int wv) { const Ctx C = make_ctx(wv); using namespace pg8; unsigned char* ws = C.ws;
    Gemm g{(const bf16*)(ws + WS_H8), (const bf16*)(ws + WS_WG), D, D}; StaticOrder S; S.init(T, 4096, C.G, C.bid);
    EpiGateMerge E{(const bf16*)(ws + WS_BALL), (bf16*)(ws + WS_MERGED)};
    gemm_phase8<EpiGateMerge, StaticOrder, true>(C.lds, C.tid, g, S, E); }
__device__ __forceinline__ void P_gemm_out(int wv) { const Ctx C = make_ctx(wv); using namespace pg8; unsigned char* ws = C.ws;
    Gemm g{(const bf16*)(ws + WS_MERGED), (const bf16*)(ws + WS_WOUT), D, D}; StaticOrder S; S.init(T, D, C.G, C.bid);
    EpiResidual E{(bf16*)(ws + WS_XB), 1.0f};
    gemm_phase<EpiResidual, StaticOrder, false, 1>(C.lds, C.tid, g, S, E); }
__device__ __forceinline__ void P_norm_ffn(int wv, int l) { const Ctx C = make_ctx(wv); ph_norm_(C, C.in[I_NORM_FFN] + (size_t)l * D, (l & 1) != 0, C.in[I_ROUTER] + (size_t)(l >> 1) * D * NEXP, l >> 1, false, nullptr,  false); }
__device__ __forceinline__ void P_ffn_up(int wv) { const Ctx C = make_ctx(wv); using namespace pg8; unsigned char* ws = C.ws;
    Gemm g{(const bf16*)(ws + WS_H8), (const bf16*)(ws + WS_W13), D, D}; StaticOrder S; S.init(T, 2 * DFF, C.G, C.bid);
    EpiSwiglu E{ws + WS_HID, DFF, 1 << 20, false};
    gemm_phase8<EpiSwiglu, StaticOrder, true>(C.lds, C.tid, g, S, E); }
__device__ __forceinline__ void P_ffn_down(int wv) { const Ctx C = make_ctx(wv); using namespace pg8; unsigned char* ws = C.ws;
    Gemm g{(const bf16*)(ws + WS_HID), (const bf16*)(ws + WS_W2D), DFF, DFF}; StaticOrder S; S.init(T, D, C.G, C.bid);
    EpiResidual E{(bf16*)(ws + WS_XB), F8_DESCALE_DOWN};
    gemm_phase8<EpiResidual, StaticOrder, false, 1>(C.lds, C.tid, g, S, E); }
__device__ __forceinline__ void P_moe_scatter(int wv, int l2) { const Ctx C = make_ctx(wv); ph_moe_scatter_(C, l2); }
__device__ __forceinline__ void P_moe_up(int wv) { const Ctx C = make_ctx(wv); using namespace pg8; unsigned char* ws = C.ws;
    Gemm g{(const bf16*)(ws + WS_XS), (const bf16*)(ws + WS_W13), D, D};
    MoeOrder S{(const int*)(ws + WS_TEXP), __builtin_amdgcn_readfirstlane(*(const int*)(ws + WS_NT)), 2 * DFE / 256, C.G, C.bid};
    EpiSwiglu E{ws + WS_HIDM, DFE_PAD, 2 * DFE / 256, true};
    gemm_phase8<EpiSwiglu, MoeOrder, true>(C.lds, C.tid, g, S, E); }
__device__ __forceinline__ void P_moe_down(int wv) { const Ctx C = make_ctx(wv); using namespace pg8; unsigned char* ws = C.ws;
    Gemm g{(const bf16*)(ws + WS_HIDM), (const bf16*)(ws + WS_W2M), DFE_PAD, DFE_PAD};
    MoeOrder S{(const int*)(ws + WS_TEXP), __builtin_amdgcn_readfirstlane(*(const int*)(ws + WS_NT)), D / 256, C.G, C.bid};
    EpiBf16 E{(bf16*)(ws + WS_YS), D, 3, F8_DESCALE_DOWN};
    gemm_phase8<EpiBf16, MoeOrder, true, 1>(C.lds, C.tid, g, S, E); }
__device__ __forceinline__ void P_moe_combine(int wv) { const Ctx C = make_ctx(wv);
    const int gw = C.bid * NWAVES + C.wave, NGW = C.G * NWAVES, lane = C.lane;
    const int* slotof = (const int*)(C.ws + WS_SLOTOF); const float* gate = (const float*)(C.ws + WS_GATE); const bf16* YS = (const bf16*)(C.ws + WS_YS); const bf16* XB = (const bf16*)(C.ws + WS_XB);
    for (int m = gw; m < T; m += NGW) {
        const int s0 = slotof[2 * m], s1 = slotof[2 * m + 1]; const float g0 = gate[2 * m], g1 = gate[2 * m + 1];
        const u32x4* xb = (const u32x4*)(XB + (size_t)m * D) + lane; f32x4* xo = (f32x4*)(C.out + (size_t)m * D + 8 * lane);
        const u32x4* y0 = (const u32x4*)(YS + (size_t)s0 * D) + lane; const u32x4* y1 = (const u32x4*)(YS + (size_t)s1 * D) + lane;
#pragma unroll
        for (int j = 0; j < 2; ++j) { const u32x4 x = xb[64 * j], a = y0[64 * j], b = y1[64 * j]; f32x4 v0, v1;
            v0.x = bflo(x.x) + g0 * bflo(a.x) + g1 * bflo(b.x); v0.y = bfhi(x.x) + g0 * bfhi(a.x) + g1 * bfhi(b.x); v0.z = bflo(x.y) + g0 * bflo(a.y) + g1 * bflo(b.y); v0.w = bfhi(x.y) + g0 * bfhi(a.y) + g1 * bfhi(b.y);
            v1.x = bflo(x.z) + g0 * bflo(a.z) + g1 * bflo(b.z); v1.y = bfhi(x.z) + g0 * bfhi(a.z) + g1 * bfhi(b.z); v1.z = bflo(x.w) + g0 * bflo(a.w) + g1 * bflo(b.w); v1.w = bfhi(x.w) + g0 * bfhi(a.w) + g1 * bfhi(b.w);
            xo[128 * j] = v0; xo[128 * j + 1] = v1; }
    }
}

#ifndef PROBE_MASK
#define PROBE_MASK 0u
#endif
#ifndef PH_MASK
#define PH_MASK 0xffffffffu
#endif
__global__ void __launch_bounds__(NTHR, 2) hybrid_fwd(Args args) {
    (void)args;
    const int wv = __builtin_amdgcn_readfirstlane(threadIdx.x >> 6);
    { LAS unsigned char* lds = (LAS unsigned char*)lds_raw;
      for (int u = threadIdx.x; u < (LDS_BYTES - RING_BYTES) / 4; u += NTHR) ((LAS unsigned*)(lds + RING_BYTES))[u] = 0u; }
    __syncthreads();
    { const CAS Args* ka = ka_ptr();
      if (ka->ph_hi - ka->ph_lo > 1) { (void)xcd_barrier_post((unsigned*)(ka->ws + WS_CTL) + CW_BAR, (volatile LAS unsigned*)((LAS unsigned char*)lds_raw + MISC_OFF) + 8); } }
    int gp = 0;
#define PHASE(k, call) { const CAS Args* ka_ = ka_ptr(); const int lo_ = ka_->ph_lo, hi_ = ka_->ph_hi; if (lo_ <= gp && gp < hi_) { if constexpr ((PH_MASK >> (k)) & 1u) { call; if constexpr ((PROBE_MASK >> (k)) & 1u) { __syncthreads(); call; } } if (hi_ - lo_ > 1 && gp + 1 < hi_) grid_barrier(wv); } ++gp; }
    PHASE(0, P_prologue(wv))
#pragma unroll 1
    for (int l = 0; l < NLAYER; ++l) {
        PHASE(1, P_weights_norm(wv, l))
        PHASE(2, P_gemm_in(wv))
        PHASE(3, P_mix1(wv, l))
        PHASE(4, P_mix2(wv, l))
        PHASE(5, P_mix3(wv, l))
        PHASE(6, P_mix4(wv, l))
        PHASE(7, P_mix5(wv, l))
        PHASE(8, P_gemm_branch(wv))
        PHASE(9, P_gemm_gate(wv))
        PHASE(10, P_gemm_out(wv))
        PHASE(11, P_norm_ffn(wv, l))
        if (!(l & 1)) {
            PHASE(12, P_ffn_up(wv))
            PHASE(13, P_ffn_down(wv))
            gp += 2;
        } else {
            PHASE(14, P_moe_scatter(wv, l >> 1))
            PHASE(15, P_moe_up(wv))
            PHASE(16, P_moe_down(wv))
            if (l == NLAYER - 1) { PHASE(17, P_moe_combine(wv)) } else { ++gp; }
        }
    }
#undef PHASE
}
constexpr int N_PHASES = 1 + NLAYER * 15;

#ifndef MK_MULTI
#define MK_MULTI 0
#endif
extern "C" void kernel_launch(void* const* d_in, const int* in_sizes, int n_in, void* d_out, int out_size, void* d_ws, size_t ws_size, hipStream_t stream) {
    static int grid = 0;
    if (grid == 0) {
        if (n_in != 32 || in_sizes[0] != T * D || out_size != T * D || ws_size < WS_END) { fprintf(stderr, "kernel_launch: unexpected problem shape / workspace (%d inputs, ws %zu)\n", n_in, ws_size); grid = -1; return; }
        int dev = 0, cus = 0, per_cu = 0;
        if (hipGetDevice(&dev) != hipSuccess || hipDeviceGetAttribute(&cus, hipDeviceAttributeMultiprocessorCount, dev) != hipSuccess) { grid = -1; return; }
        if (hipFuncSetAttribute((const void*)hybrid_fwd, hipFuncAttributeMaxDynamicSharedMemorySize, LDS_BYTES) != hipSuccess) { fprintf(stderr, "kernel_launch: hipFuncSetAttribute failed\n"); grid = -1; return; }
        if (hipOccupancyMaxActiveBlocksPerMultiprocessor(&per_cu, (const void*)hybrid_fwd, NTHR, LDS_BYTES) != hipSuccess || per_cu < 1) { fprintf(stderr, "kernel_launch: occupancy query says %d\n", per_cu); }
        (void)hipGetLastError();
        grid = cus;
    }
    if (grid < 0) return;
    (void)hipMemsetAsync((char*)d_ws + WS_CTL, 0, CTL_ZERO_BYTES, stream);
#ifdef DBG_ZERO_WS
    (void)hipMemsetAsync((char*)d_ws + CTL_ZERO_BYTES, 0, WS_END - CTL_ZERO_BYTES, stream);
#endif
    Args a{};
    for (int i = 0; i < 32; ++i) a.in[i] = (const float*)d_in[i];
    a.out = (float*)d_out; a.ws = (unsigned char*)d_ws;
#if MK_MULTI
    for (int p = 0; p < N_PHASES; ++p) { a.ph_lo = p; a.ph_hi = p + 1; hipLaunchKernelGGL(hybrid_fwd, dim3(grid), dim3(NTHR), LDS_BYTES, stream, a); }
#else
    a.ph_lo = 0; a.ph_hi = N_PHASES; hipLaunchKernelGGL(hybrid_fwd, dim3(grid), dim3(NTHR), LDS_BYTES, stream, a);
#endif
}
```

```cpp
#include <hip/hip_runtime.h>
#include <cstdio>
#include <cstdint>

#define GAS __attribute__((address_space(1)))
#define LAS __attribute__((address_space(3)))
typedef unsigned short bf16;
typedef unsigned u32x4 __attribute__((ext_vector_type(4)));
typedef unsigned u32x2 __attribute__((ext_vector_type(2)));
typedef float f32x4 __attribute__((ext_vector_type(4)));
typedef float f32x2 __attribute__((ext_vector_type(2)));
typedef short bf16x8 __attribute__((ext_vector_type(8)));
typedef float f32x16 __attribute__((ext_vector_type(16)));
typedef short s16x4 __attribute__((ext_vector_type(4)));

constexpr int SEQ = 16384, NBATCH = 2, T = NBATCH * SEQ, D = 1024, NIN = 3328, DFF = 2816, DFE = 1408, NEXP = 8, NLAYER = 4;
constexpr int MPAD = 2 * T + NEXP * 256;
constexpr int NWAVES = 8, NTHR = 512;
constexpr float LOG2E = 1.4426950408889634f;
constexpr int MM_LP = 72;

typedef __bf16 bf16x2_t __attribute__((ext_vector_type(2)));
__device__ __forceinline__ unsigned cvt_pk_bf16(float lo, float hi) { const f32x2 v = {lo, hi}; const bf16x2_t b = __builtin_convertvector(v, bf16x2_t); return __builtin_bit_cast(unsigned, b); }
__device__ __forceinline__ float bflo(unsigned u) { return __builtin_bit_cast(float, u << 16); }
__device__ __forceinline__ float bfhi(unsigned u) { return __builtin_bit_cast(float, u & 0xffff0000u); }
__device__ __forceinline__ float bf2f(bf16 u) { return __builtin_bit_cast(float, (unsigned)u << 16); }
__device__ __forceinline__ bf16 f2bf(float f) { return (bf16)(cvt_pk_bf16(f, 0.f) & 0xffffu); }
__device__ __forceinline__ float sigm(float x) { return __builtin_amdgcn_rcpf(1.f + __builtin_amdgcn_exp2f(-x * LOG2E)); }
__device__ __forceinline__ float shx(float v, int o, int lane) { return __builtin_bit_cast(float, __builtin_amdgcn_ds_bpermute((lane ^ o) << 2, __builtin_bit_cast(int, v))); }
__device__ __forceinline__ float dpp_add(float v, const int ctrl_id) {
    const int x = __builtin_bit_cast(int, v);
    int y;
    if (ctrl_id == 0) y = __builtin_amdgcn_update_dpp(0, x, 0xB1, 0xF, 0xF, true);
    else if (ctrl_id == 1) y = __builtin_amdgcn_update_dpp(0, x, 0x4E, 0xF, 0xF, true);
    else if (ctrl_id == 2) y = __builtin_amdgcn_update_dpp(0, x, 0x141, 0xF, 0xF, true);
    else y = __builtin_amdgcn_update_dpp(0, x, 0x140, 0xF, 0xF, true);
    return v + __builtin_bit_cast(float, y);
}
__device__ __forceinline__ float wave_sum(float v, int lane) {
    (void)lane;
    v = dpp_add(v, 0); v = dpp_add(v, 1); v = dpp_add(v, 2); v = dpp_add(v, 3);
    const int x = __builtin_bit_cast(int, v);
    const float s0 = __builtin_bit_cast(float, __builtin_amdgcn_readlane(x, 0)), s1 = __builtin_bit_cast(float, __builtin_amdgcn_readlane(x, 16)),
                s2 = __builtin_bit_cast(float, __builtin_amdgcn_readlane(x, 32)), s3 = __builtin_bit_cast(float, __builtin_amdgcn_readlane(x, 48));
    return (s0 + s1) + (s2 + s3);
}
__device__ __forceinline__ void unpack8(const u32x4 v, float* f) {
    f[0] = bflo(v.x); f[1] = bfhi(v.x); f[2] = bflo(v.y); f[3] = bfhi(v.y); f[4] = bflo(v.z); f[5] = bfhi(v.z); f[6] = bflo(v.w); f[7] = bfhi(v.w);
}
__device__ __forceinline__ unsigned pk4_fp8(float a, float b, float c, float d) {
    a = __builtin_amdgcn_fmed3f(a, -440.f, 440.f); b = __builtin_amdgcn_fmed3f(b, -440.f, 440.f); c = __builtin_amdgcn_fmed3f(c, -440.f, 440.f); d = __builtin_amdgcn_fmed3f(d, -440.f, 440.f);
    int w = __builtin_amdgcn_cvt_pk_fp8_f32(a, b, 0, false); w = __builtin_amdgcn_cvt_pk_fp8_f32(c, d, w, true); return (unsigned)w; }
__device__ __forceinline__ u32x4 pack8(const float* f) {
    u32x4 w; w.x = cvt_pk_bf16(f[0], f[1]); w.y = cvt_pk_bf16(f[2], f[3]); w.z = cvt_pk_bf16(f[4], f[5]); w.w = cvt_pk_bf16(f[6], f[7]); return w;
}


#ifndef PROBE2
#define PROBE2 0
#endif
#ifndef GMASK
#define GMASK 15
#endif
#ifndef RWDBG
#define RWDBG 0
#endif
typedef int i32x8 __attribute__((ext_vector_type(8)));
constexpr float F8_MUL_X = 16.f, F8_MUL_W = 256.f, F8_DESCALE = 1.0f / (16.f * 256.f), F8_MUL_H = 4.f, F8_DESCALE_DOWN = 1.0f / (4.f * 256.f);
constexpr int DFE_PAD = 1536;
namespace pg8 {
typedef unsigned short bf16_t;
constexpr int BM = 256, BK = 64, HALF = 128, HTB = HALF * BK * 2, NXCD = 8, WGM = 8;
__host__ __device__ __forceinline__ int lds_byte(int r, int c) { const int st = (r >> 4) * 2 + (c >> 5), rr = r & 15, cc = c & 31, ob = rr * 64 + cc * 2; return st * 1024 + (ob ^ (((ob >> 9) & 1) << 5)); }
__host__ __device__ __forceinline__ void stage_rc(int b, int& R, int& C) { const int st = b / 1024, sb = b % 1024, swz = sb ^ (((sb >> 9) & 1) << 5); R = (st >> 1) * 16 + swz / 64; C = (st & 1) * 32 + (swz % 64) / 2; }
__host__ __device__ __forceinline__ int perm32(int rho) { const int n = rho >> 4, i = rho & 15; return 8 * (i >> 2) + 4 * n + (i & 3); }

struct Unit { int pm, pn, aoff; };
struct Gemm { const bf16_t* A; const bf16_t* Bt; int lda, K; };

struct StaticOrder {
    int nM, nN, nwg, G, c, ashift, amul;
    __device__ void init(int M, int N, int G_, int c_, int ashift_ = 0, int amul_ = 0) { nM = M / BM; nN = N / BM; nwg = nM * nN; G = G_; c = c_; ashift = ashift_; amul = amul_; }
    __device__ bool next(int i, Unit& u) const {
        const long L = (long)i * G + c; if (L >= nwg) return false;
        int wgid = (int)L; { const int q = nwg / NXCD, r = nwg % NXCD, xcd = wgid % NXCD, off = wgid / NXCD; wgid = (xcd < r ? xcd * (q + 1) : r * (q + 1) + (xcd - r) * q) + off; }
        const int nig = WGM * nN, gid = wgid / nig, fm = gid * WGM, gsz = (nM - fm) < WGM ? (nM - fm) : WGM;
        u.pm = fm + ((wgid % nig) % gsz); u.pn = (wgid % nig) / gsz; u.aoff = (u.pn >> ashift) * amul; return true;
    }
};
struct MoeOrder {
    const int* texp; int ntiles, ncol, G, c;
    __device__ bool next(int i, Unit& u) const {
        const int L = i * G + c; if (L >= ntiles * ncol) return false;
        const int pm = L / ncol, pl = L % ncol;
        u.pm = pm; u.pn = texp[pm] * ncol + pl; u.aoff = 0; return true;
    }
};

template <class Epi, class Sched, bool ALIGN_EPI, int CMAP = 0>
__device__ __forceinline__ void gemm_phase(LAS unsigned char* lds, const int tid_in, const Gemm g, const Sched& S, const Epi& E) {
    const int tid = tid_in, wid = __builtin_amdgcn_readfirstlane(tid >> 6), lane = tid & 63, wr = wid >> 2, wc = wid & 3, fr = lane & 15, fq = lane >> 4;
    const int K = g.K, nt = K / BK, lda = g.lda;
    unsigned voffA[2], voffB[2];
#pragma unroll
    for (int i = 0; i < 2; ++i) { int R, C; stage_rc(tid * 16 + i * 8192, R, C); const int p32 = perm32(R & 31); const int Rb = CMAP ? 64 * (R >> 5) + 16 * (p32 >> 3) + (p32 & 7) : (R & ~31) + p32;
        voffA[i] = (unsigned)(R * lda + C) * 2u; voffB[i] = (unsigned)(Rb * K + C) * 2u; }
    const size_t kstep = (size_t)(BK * 2);
    const size_t hstepA = (size_t)HALF * lda * 2, tstepA = 2 * hstepA, hstepB = (size_t)(CMAP ? 8 : HALF) * K * 2, tstepB = (size_t)BM * K * 2;
    const unsigned ldsw = (unsigned)wid * 1024u;
    const int aoff = lds_byte(wr * 64 + fr, fq * 8), boff = lds_byte(wc * 32 + fr, fq * 8);
#define PG8_SA(b, h) (((b) * 2 + (h)) * HTB)
#define PG8_SB(b, h) ((4 + (b) * 2 + (h)) * HTB)
#define PG8_STAGE(bufoff, gbase, voff) do { _Pragma("unroll") for (int _i = 0; _i < 2; ++_i) \
        __builtin_amdgcn_global_load_lds((const unsigned*)((const char*)(gbase) + (voff)[_i]), (LAS unsigned*)(lds + (bufoff) + ldsw + _i * 8192), 16, 0, 0); } while (0)
#define PG8_LDA(dst, b, h) do { _Pragma("unroll") for (int m = 0; m < 4; ++m) _Pragma("unroll") for (int k = 0; k < 2; ++k) dst[m][k] = *(const LAS bf16x8*)(lds + PG8_SA(b, h) + aoff + m * 2048 + k * 1024); } while (0)
#define PG8_LDB(dst, b, h) do { _Pragma("unroll") for (int n = 0; n < 2; ++n) _Pragma("unroll") for (int k = 0; k < 2; ++k) dst[n][k] = *(const LAS bf16x8*)(lds + PG8_SB(b, h) + boff + n * 2048 + k * 1024); } while (0)
#define PG8_MMA(ai, bj, At, Bt) do { __builtin_amdgcn_s_setprio(1); _Pragma("unroll") for (int m = 0; m < 4; ++m) _Pragma("unroll") for (int n = 0; n < 2; ++n) _Pragma("unroll") for (int k = 0; k < 2; ++k) \
        acc[ai][bj][m][n] = __builtin_amdgcn_mfma_f32_16x16x32_bf16(Bt[n][k], At[m][k], acc[ai][bj][m][n], 0, 0, 0); __builtin_amdgcn_s_setprio(0); } while (0)
#define PG8_WAIT_V(n) asm volatile("s_waitcnt vmcnt(" #n ")" ::: "memory")
#define PG8_WAIT_L(n) asm volatile("s_waitcnt lgkmcnt(" #n ")" ::: "memory")
#define PG8_BAR __builtin_amdgcn_s_barrier()
#define PG8_SCHED __builtin_amdgcn_sched_barrier(0)
    Unit cur, nxt; int ui = 0;
    if (!S.next(0, cur)) return;
    f32x4 acc[2][2][4][2];
#pragma unroll
    for (int a = 0; a < 2; ++a)
#pragma unroll
        for (int b = 0; b < 2; ++b)
#pragma unroll
            for (int m = 0; m < 4; ++m)
#pragma unroll
                for (int n = 0; n < 2; ++n) acc[a][b][m][n] = (f32x4){0.f, 0.f, 0.f, 0.f};
    bf16x8 At[4][2], B0[2][2], B1[2][2];
    const char* cA = (const char*)g.A + (size_t)cur.pm * tstepA + cur.aoff; const char* cB = (const char*)g.Bt + (size_t)cur.pn * tstepB;
    PG8_STAGE(PG8_SB(0, 0), cB, voffB); PG8_STAGE(PG8_SB(0, 1), cB + hstepB, voffB); PG8_STAGE(PG8_SA(0, 0), cA, voffA); PG8_STAGE(PG8_SA(0, 1), cA + hstepA, voffA);
    if (wr == 1) PG8_BAR;
    PG8_WAIT_V(2); PG8_BAR;
    PG8_STAGE(PG8_SB(1, 0), cB + kstep, voffB); PG8_STAGE(PG8_SA(1, 0), cA + kstep, voffA); PG8_STAGE(PG8_SB(1, 1), cB + hstepB + kstep, voffB);
    PG8_WAIT_V(6); PG8_BAR;
    for (;;) {
        const bool has_next = S.next(ui + 1, nxt);
        const char* nA = has_next ? (const char*)g.A + (size_t)nxt.pm * tstepA + nxt.aoff : cA; const char* nB = has_next ? (const char*)g.Bt + (size_t)nxt.pn * tstepB : cB;
#pragma unroll 1
        for (int t = 0; t < nt; t += 2) {
            const bool last = (t == nt - 2);
            const char* a1 = cA + (size_t)(t + 1) * kstep;
            const char* a2 = last ? nA : cA + (size_t)(t + 2) * kstep; const char* b2 = last ? nB : cB + (size_t)(t + 2) * kstep;
            const char* a3 = a2 + kstep; const char* b3 = b2 + kstep;
            PG8_LDB(B0, 0, 0); PG8_LDB(B1, 0, 1); PG8_SCHED; PG8_LDA(At, 0, 0); PG8_STAGE(PG8_SA(1, 1), a1 + hstepA, voffA);
            PG8_WAIT_V(8); PG8_WAIT_L(0); PG8_BAR; PG8_MMA(0, 0, At, B0); PG8_MMA(0, 1, At, B1); PG8_BAR; PG8_SCHED;
            PG8_LDA(At, 0, 1); PG8_STAGE(PG8_SB(0, 0), b2, voffB); PG8_STAGE(PG8_SB(0, 1), b2 + hstepB, voffB); PG8_STAGE(PG8_SA(0, 0), a2, voffA);
            PG8_WAIT_V(8); PG8_WAIT_L(0); PG8_BAR; PG8_MMA(1, 0, At, B0); PG8_MMA(1, 1, At, B1); PG8_BAR; PG8_SCHED;
            PG8_LDB(B0, 1, 0); PG8_LDB(B1, 1, 1); PG8_SCHED; PG8_LDA(At, 1, 0); PG8_STAGE(PG8_SA(0, 1), a2 + hstepA, voffA);
            PG8_WAIT_V(8); PG8_WAIT_L(0); PG8_BAR; PG8_MMA(0, 0, At, B0); PG8_MMA(0, 1, At, B1); PG8_BAR; PG8_SCHED;
            PG8_LDA(At, 1, 1); PG8_STAGE(PG8_SB(1, 0), b3, voffB); PG8_STAGE(PG8_SB(1, 1), b3 + hstepB, voffB); PG8_STAGE(PG8_SA(1, 0), a3, voffA);
            PG8_WAIT_V(8); PG8_WAIT_L(0); PG8_BAR; PG8_MMA(1, 0, At, B0); PG8_MMA(1, 1, At, B1); PG8_BAR; PG8_SCHED;
        }
        if constexpr (ALIGN_EPI) { if (wr == 0) PG8_BAR; }
        { int ln_; asm volatile("v_mbcnt_lo_u32_b32 %0, -1, 0\n\tv_mbcnt_hi_u32_b32 %0, -1, %0" : "=v"(ln_)); E(acc, cur, wr, wc, ln_ & 15, ln_ >> 4); }
        if (!has_next) break;
#pragma unroll
        for (int a = 0; a < 2; ++a)
#pragma unroll
            for (int b = 0; b < 2; ++b)
#pragma unroll
                for (int m = 0; m < 4; ++m)
#pragma unroll
                    for (int n = 0; n < 2; ++n) acc[a][b][m][n] = (f32x4){0.f, 0.f, 0.f, 0.f};
        cur = nxt; cA = nA; cB = nB; ++ui;
        if constexpr (ALIGN_EPI) { if (wr == 1) PG8_BAR; }
    }
    PG8_WAIT_V(0);
    if constexpr (!ALIGN_EPI) { if (wr == 0) PG8_BAR; }
    PG8_BAR;
#undef PG8_SA
#undef PG8_SB
#undef PG8_STAGE
#undef PG8_LDA
#undef PG8_LDB
#undef PG8_MMA
#undef PG8_WAIT_V
#undef PG8_WAIT_L
#undef PG8_BAR
#undef PG8_SCHED
}

template <class Epi, class Sched, bool ALIGN_EPI, int CMAP = 0>
__device__ __forceinline__ void gemm_phase8(LAS unsigned char* lds, const int tid_in, const Gemm g, const Sched& S, const Epi& E) {
    const int tid = tid_in, wid = __builtin_amdgcn_readfirstlane(tid >> 6), lane = tid & 63, wr = wid >> 2, wc = wid & 3, fr = lane & 15, fq = lane >> 4;
    const int K = g.K, nt = K / 128, lda = g.lda;
    unsigned voffA, voffB;
    { int R, C; stage_rc(tid * 16, R, C); const int p32 = perm32(R & 31); const int Rb = CMAP ? 64 * (R >> 5) + 16 * (p32 >> 3) + (p32 & 7) : (R & ~31) + p32; voffA = (unsigned)(R * lda + C * 2); voffB = (unsigned)(Rb * K + C * 2); }
    const unsigned pstepA = 64u * (unsigned)lda, pstepB = (CMAP ? 128u : 64u) * (unsigned)K;
    const unsigned kstep = (unsigned)(BK * 2);
    const unsigned hstepA = (unsigned)HALF * (unsigned)lda, tstepA = 2 * hstepA, hstepB = (unsigned)(CMAP ? 8 : HALF) * (unsigned)K, tstepB = (unsigned)BM * (unsigned)K;
    const __amdgpu_buffer_rsrc_t rsA = __builtin_amdgcn_make_buffer_rsrc((void*)g.A, 0, 0x7fffffff, 0x00020000), rsB = __builtin_amdgcn_make_buffer_rsrc((void*)g.Bt, 0, 0x7fffffff, 0x00020000);
    const unsigned ldsw = (unsigned)wid * 1024u;
    const int aoff0 = lds_byte(wr * 64 + fr, fq * 8), aoff1 = aoff0 + 1024, boff0 = lds_byte(wc * 32 + fr, fq * 8), boff1 = boff0 + 1024;
#define PG8_SA(b, h) (((b) * 2 + (h)) * HTB)
#define PG8_SB(b, h) ((4 + (b) * 2 + (h)) * HTB)
#define PG8_STAGE(bufoff, goff, voff, pstep) do { _Pragma("unroll") for (int _i = 0; _i < 2; ++_i) \
        __builtin_amdgcn_raw_ptr_buffer_load_lds(PG8_RS_##voff, (LAS unsigned*)(lds + (bufoff) + ldsw + _i * 8192), 16, (int)(voff), (int)((goff) + _i * (pstep)), 0, 0); } while (0)
#define PG8_RS_voffA rsA
#define PG8_RS_voffB rsB
#define PG8_LDA(dst, b, h) do { _Pragma("unroll") for (int m = 0; m < 4; ++m) { dst[m][0] = *(const LAS u32x4*)(lds + PG8_SA(b, h) + aoff0 + m * 2048); dst[m][1] = *(const LAS u32x4*)(lds + PG8_SA(b, h) + aoff1 + m * 2048); } } while (0)
#define PG8_LDB(dst, b, h) do { _Pragma("unroll") for (int n = 0; n < 2; ++n) { dst[n][0] = *(const LAS u32x4*)(lds + PG8_SB(b, h) + boff0 + n * 2048); dst[n][1] = *(const LAS u32x4*)(lds + PG8_SB(b, h) + boff1 + n * 2048); } } while (0)
#define PG8_J8(x) __builtin_bit_cast(i32x8, __builtin_shufflevector((x)[0], (x)[1], 0, 1, 2, 3, 4, 5, 6, 7))
#define PG8_MMA(ai, bj, At, Bt) do { __builtin_amdgcn_s_setprio(1); _Pragma("unroll") for (int m = 0; m < 4; ++m) _Pragma("unroll") for (int n = 0; n < 2; ++n) \
        acc[ai][bj][m][n] = __builtin_amdgcn_mfma_scale_f32_16x16x128_f8f6f4(PG8_J8(Bt[n]), PG8_J8(At[m]), acc[ai][bj][m][n], 0, 0, 0, 0, 0, 0);        __builtin_amdgcn_s_setprio(0); } while (0)
#define PG8_WAIT_V(n) asm volatile("s_waitcnt vmcnt(" #n ")" ::: "memory")
#define PG8_WAIT_L(n) asm volatile("s_waitcnt lgkmcnt(" #n ")" ::: "memory")
#define PG8_BAR __builtin_amdgcn_s_barrier()
#define PG8_SCHED __builtin_amdgcn_sched_barrier(0)
    Unit cur, nxt; int ui = 0;
    if (!S.next(0, cur)) return;
    f32x4 acc[2][2][4][2];
#pragma unroll
    for (int a = 0; a < 2; ++a)
#pragma unroll
        for (int b = 0; b < 2; ++b)
#pragma unroll
            for (int m = 0; m < 4; ++m)
#pragma unroll
                for (int n = 0; n < 2; ++n) acc[a][b][m][n] = (f32x4){0.f, 0.f, 0.f, 0.f};
    u32x4 At[4][2], B0[2][2], B1[2][2];
    unsigned cA = (unsigned)cur.pm * tstepA + (unsigned)cur.aoff, cB = (unsigned)cur.pn * tstepB;
    PG8_STAGE(PG8_SB(0, 0), cB, voffB, pstepB); PG8_STAGE(PG8_SB(0, 1), cB + hstepB, voffB, pstepB); PG8_STAGE(PG8_SA(0, 0), cA, voffA, pstepA); PG8_STAGE(PG8_SA(0, 1), cA + hstepA, voffA, pstepA);
    if (wr == 1) PG8_BAR;
    PG8_WAIT_V(2); PG8_BAR;
    PG8_STAGE(PG8_SB(1, 0), cB + kstep, voffB, pstepB); PG8_STAGE(PG8_SA(1, 0), cA + kstep, voffA, pstepA); PG8_STAGE(PG8_SB(1, 1), cB + hstepB + kstep, voffB, pstepB);
    PG8_WAIT_V(6); PG8_BAR;
    for (;;) {
        const bool has_next = S.next(ui + 1, nxt);
        const unsigned nA = has_next ? (unsigned)nxt.pm * tstepA + (unsigned)nxt.aoff : cA, nB = has_next ? (unsigned)nxt.pn * tstepB : cB;
#pragma unroll 1
        for (int t = 0; t < nt; t += 2) {
            const bool last = (t == nt - 2);
            const unsigned a1 = cA + (unsigned)(t + 1) * kstep;
            const unsigned a2 = last ? nA : cA + (unsigned)(t + 2) * kstep, b2 = last ? nB : cB + (unsigned)(t + 2) * kstep;
            const unsigned a3 = a2 + kstep, b3 = b2 + kstep;
            PG8_LDB(B0, 0, 0); PG8_LDB(B1, 0, 1); PG8_SCHED; PG8_LDA(At, 0, 0); PG8_STAGE(PG8_SA(1, 1), a1 + hstepA, voffA, pstepA);
            PG8_WAIT_V(8); PG8_WAIT_L(0); PG8_BAR; PG8_MMA(0, 0, At, B0); PG8_MMA(0, 1, At, B1); PG8_BAR; PG8_SCHED;
            PG8_LDA(At, 0, 1); PG8_STAGE(PG8_SB(0, 0), b2, voffB, pstepB); PG8_STAGE(PG8_SB(0, 1), b2 + hstepB, voffB, pstepB); PG8_STAGE(PG8_SA(0, 0), a2, voffA, pstepA);
            PG8_WAIT_V(8); PG8_WAIT_L(0); PG8_BAR; PG8_MMA(1, 0, At, B0); PG8_MMA(1, 1, At, B1); PG8_BAR; PG8_SCHED;
            PG8_LDB(B0, 1, 0); PG8_LDB(B1, 1, 1); PG8_SCHED; PG8_LDA(At, 1, 0); PG8_STAGE(PG8_SA(0, 1), a2 + hstepA, voffA, pstepA);
            PG8_WAIT_V(8); PG8_WAIT_L(0); PG8_BAR; PG8_MMA(0, 0, At, B0); PG8_MMA(0, 1, At, B1); PG8_BAR; PG8_SCHED;
            PG8_LDA(At, 1, 1); PG8_STAGE(PG8_SB(1, 0), b3, voffB, pstepB); PG8_STAGE(PG8_SB(1, 1), b3 + hstepB, voffB, pstepB); PG8_STAGE(PG8_SA(1, 0), a3, voffA, pstepA);
            PG8_WAIT_V(8); PG8_WAIT_L(0); PG8_BAR; PG8_MMA(1, 0, At, B0); PG8_MMA(1, 1, At, B1); PG8_BAR; PG8_SCHED;
        }
        if constexpr (ALIGN_EPI) { if (wr == 0) PG8_BAR; }
        { int ln_; asm volatile("v_mbcnt_lo_u32_b32 %0, -1, 0\n\tv_mbcnt_hi_u32_b32 %0, -1, %0" : "=v"(ln_)); E(acc, cur, wr, wc, ln_ & 15, ln_ >> 4); }
        if (!has_next) break;
#pragma unroll
        for (int a = 0; a < 2; ++a)
#pragma unroll
            for (int b = 0; b < 2; ++b)
#pragma unroll
                for (int m = 0; m < 4; ++m)
#pragma unroll
                    for (int n = 0; n < 2; ++n) acc[a][b][m][n] = (f32x4){0.f, 0.f, 0.f, 0.f};
        cur = nxt; cA = nA; cB = nB; ++ui;
        if constexpr (ALIGN_EPI) { if (wr == 1) PG8_BAR; }
    }
    PG8_WAIT_V(0);
    if constexpr (!ALIGN_EPI) { if (wr == 0) PG8_BAR; }
    PG8_BAR;
#undef PG8_SA
#undef PG8_SB
#undef PG8_STAGE
#undef PG8_RS_voffA
#undef PG8_RS_voffB
#undef PG8_LDA
#undef PG8_LDB
#undef PG8_MMA
#undef PG8_J8
#undef PG8_WAIT_V
#undef PG8_WAIT_L
#undef PG8_BAR
#undef PG8_SCHED
}

typedef f32x4 Acc[2][2][4][2];

__device__ __forceinline__ unsigned dpp_ror8(unsigned v) { return (unsigned)__builtin_amdgcn_update_dpp(0, (int)v, 0x128, 0xf, 0xf, false); }
struct CmPair { unsigned a, b; };
__device__ __forceinline__ CmPair cm_swapv(bool lo, unsigned x0, unsigned x1) { const unsigned r = dpp_ror8(lo ? x1 : x0); CmPair o; o.a = lo ? x0 : r; o.b = lo ? r : x1; return o; }
#define CM_SWAP_U(lo, X0, X1) do { const CmPair r_ = cm_swapv(lo, X0, X1); X0 = r_.a; X1 = r_.b; } while (0)
#define CM_SWAP_F(lo, X0, X1) do { const CmPair r_ = cm_swapv(lo, __builtin_bit_cast(unsigned, (float)(X0)), __builtin_bit_cast(unsigned, (float)(X1))); X0 = __builtin_bit_cast(float, r_.a); X1 = __builtin_bit_cast(float, r_.b); } while (0)
#define cm_swap4(lo, w0, w1) do { CM_SWAP_U(lo, w0.x, w1.x); CM_SWAP_U(lo, w0.y, w1.y); CM_SWAP_U(lo, w0.z, w1.z); CM_SWAP_U(lo, w0.w, w1.w); } while (0)
struct EpiRoute {
    bf16_t *d0, *d1, *d2, *d3;
    __device__ __forceinline__ void operator()(const Acc& acc, const Unit& u, int wr, int wc, int fr, int fq) const {
        const int pn = u.pn; bf16_t* base; int ld, ct;
        if (pn < 4) { base = d0; ld = 1024; ct = pn; } else if (pn < 7) { base = d1; ld = 768; ct = pn - 4; } else if (pn < 11) { base = d2; ld = 1024; ct = pn - 7; } else { base = d3; ld = 512; ct = pn - 11; }
        const bool lo = fr < 8;
        const int row0 = u.pm * BM + wr * 64 + (fr & 7), col0 = ct * 256 + wc * 64 + 16 * fq + 8 * (fr >> 3);
#pragma unroll
        for (int ai = 0; ai < 2; ++ai)
#pragma unroll
            for (int m = 0; m < 4; ++m) { bf16_t* rowp = base + (size_t)(row0 + ai * HALF + m * 16) * ld + col0; u32x4 w0, w1;
                { const f32x4 v0 = acc[ai][0][m][0], v1 = acc[ai][0][m][1]; w0.x = cvt_pk_bf16(v0[0], v0[1]); w0.y = cvt_pk_bf16(v0[2], v0[3]); w0.z = cvt_pk_bf16(v1[0], v1[1]); w0.w = cvt_pk_bf16(v1[2], v1[3]); }
                { const f32x4 v0 = acc[ai][1][m][0], v1 = acc[ai][1][m][1]; w1.x = cvt_pk_bf16(v0[0], v0[1]); w1.y = cvt_pk_bf16(v0[2], v0[3]); w1.z = cvt_pk_bf16(v1[0], v1[1]); w1.w = cvt_pk_bf16(v1[2], v1[3]); }
                cm_swap4(lo, w0, w1);
                *(u32x4*)rowp = w0; *(u32x4*)(rowp + (size_t)8 * ld) = w1; }
    }
};
struct EpiBf16 {
    bf16_t* O; int ld, pnmask; float sc;
    __device__ __forceinline__ void operator()(const Acc& acc, const Unit& u, int wr, int wc, int fr, int fq) const {
        const bool lo = fr < 8;
        const int row0 = u.pm * BM + wr * 64 + (fr & 7), col0 = (u.pn & pnmask) * 256 + wc * 64 + 16 * fq + 8 * (fr >> 3);
#pragma unroll
        for (int ai = 0; ai < 2; ++ai)
#pragma unroll
            for (int m = 0; m < 4; ++m) { bf16_t* rowp = O + (size_t)(row0 + ai * HALF + m * 16) * ld + col0; u32x4 w0, w1;
                { const f32x4 v0 = acc[ai][0][m][0] * sc, v1 = acc[ai][0][m][1] * sc; w0.x = cvt_pk_bf16(v0[0], v0[1]); w0.y = cvt_pk_bf16(v0[2], v0[3]); w0.z = cvt_pk_bf16(v1[0], v1[1]); w0.w = cvt_pk_bf16(v1[2], v1[3]); }
                { const f32x4 v0 = acc[ai][1][m][0] * sc, v1 = acc[ai][1][m][1] * sc; w1.x = cvt_pk_bf16(v0[0], v0[1]); w1.y = cvt_pk_bf16(v0[2], v0[3]); w1.z = cvt_pk_bf16(v1[0], v1[1]); w1.w = cvt_pk_bf16(v1[2], v1[3]); }
                cm_swap4(lo, w0, w1);
                *(u32x4*)rowp = w0; *(u32x4*)(rowp + (size_t)8 * ld) = w1; }
    }
};
struct EpiLora {
    float* wdec; bf16_t* ag; const float* w0; const float* a0;
    __device__ __forceinline__ void operator()(const Acc& acc, const Unit& u, int wr, int wc, int fr, int fq) const {
        const int row0 = u.pm * BM + wr * 64 + fr, cl0 = wc * 32 + 8 * fq, pn = u.pn;
#pragma unroll
        for (int ai = 0; ai < 2; ++ai)
#pragma unroll
            for (int m = 0; m < 4; ++m) { const size_t row = (size_t)(row0 + ai * HALF + m * 16);
#pragma unroll
                for (int bj = 0; bj < 2; ++bj) { const int col = bj * HALF + cl0; float v[8];
#pragma unroll
                    for (int n = 0; n < 2; ++n)
#pragma unroll
                        for (int e = 0; e < 4; ++e) v[4 * n + e] = acc[ai][bj][m][n][e];
                    if (pn == 0) {
                        *(f32x4*)(wdec + row * 256 + col) = (f32x4){v[0], v[1], v[2], v[3]}; *(f32x4*)(wdec + row * 256 + col + 4) = (f32x4){v[4], v[5], v[6], v[7]};
                    } else if (pn == 1) {
                        *(u32x4*)(ag + row * 512 + col) = pack8(v);
                    } else { *(u32x4*)(ag + row * 512 + 256 + col) = pack8(v); }
                } }
    }
};
struct EpiBall {
    unsigned char* O;
    __device__ __forceinline__ void operator()(const Acc& acc, const Unit& u, int wr, int wc, int fr, int fq) const {
        unsigned char* base = O + ((size_t)(u.pm * 16 + u.pn) << 17) + (wc >> 1) * 32768 + (wr * 2 + (wc & 1)) * 1024 + (fr + 16 * fq) * 16;
#pragma unroll
        for (int ai = 0; ai < 2; ++ai)
#pragma unroll
            for (int m = 0; m < 4; ++m)
#pragma unroll
                for (int bj = 0; bj < 2; ++bj) { const f32x4 v0 = acc[ai][bj][m][0], v1 = acc[ai][bj][m][1]; u32x4 w;
                    w.x = cvt_pk_bf16(v0[0], v0[1]); w.y = cvt_pk_bf16(v0[2], v0[3]); w.z = cvt_pk_bf16(v1[0], v1[1]); w.w = cvt_pk_bf16(v1[2], v1[3]);
                    __builtin_nontemporal_store(w, (u32x4*)(base + bj * 65536 + (ai * 4 + m) * 4096)); }
    }
};
struct EpiGateMerge {
    const bf16_t* ball; bf16_t* merged;
    __device__ __forceinline__ void operator()(const Acc& acc, const Unit& u, int wr, int wc, int fr, int fq) const {
        const int row0 = u.pm * BM + wr * 64 + fr, o0 = 64 * u.pn + 16 * wc + 4 * fq;
        const int cw = 64 * (u.pn & 3) + 16 * wc + 4 * fq;
        const unsigned char* lbase = (const unsigned char*)ball + ((size_t)(u.pm * 16 + (u.pn >> 2)) << 17) + (cw >> 7) * 65536 + ((cw >> 6) & 1) * 32768 + (wr * 2 + ((cw >> 5) & 1)) * 1024 + (fr + 16 * ((cw >> 3) & 3)) * 16 + ((cw >> 2) & 1) * 8;
        u32x2 bb[2][4][4];
#pragma unroll
        for (int ai = 0; ai < 2; ++ai)
#pragma unroll
            for (int m = 0; m < 4; ++m)
#pragma unroll
                for (int gi = 0; gi < 4; ++gi) bb[ai][m][gi] = __builtin_nontemporal_load((const u32x2*)(lbase + ((size_t)gi << 19) + (ai * 4 + m) * 4096));
#pragma unroll
        for (int ai = 0; ai < 2; ++ai)
#pragma unroll
            for (int m = 0; m < 4; ++m) { const size_t row = (size_t)(row0 + ai * HALF + m * 16); float s[4] = {0.f, 0.f, 0.f, 0.f};
#pragma unroll
                for (int bj = 0; bj < 2; ++bj)
#pragma unroll
                    for (int n = 0; n < 2; ++n) { const int gi = 2 * bj + n; const u32x2 b = bb[ai][m][gi];
                        const f32x4 a = acc[ai][bj][m][n] * F8_DESCALE;
                        s[0] += sigm(a[0]) * bflo(b.x); s[1] += sigm(a[1]) * bfhi(b.x); s[2] += sigm(a[2]) * bflo(b.y); s[3] += sigm(a[3]) * bfhi(b.y); }
                u32x2 w; w.x = cvt_pk_bf16(s[0], s[1]); w.y = cvt_pk_bf16(s[2], s[3]);
                *(u32x2*)(merged + row * 1024 + o0) = w; }
    }
};
struct EpiResidual {
    bf16_t* xb; float sc;
    __device__ __forceinline__ void operator()(const Acc& acc, const Unit& u, int wr, int wc, int fr, int fq) const {
        const bool lo = fr < 8;
        const int row0 = u.pm * BM + wr * 64 + (fr & 7), col0 = u.pn * 256 + wc * 64 + 16 * fq + 8 * (fr >> 3);
#pragma unroll
        for (int ai = 0; ai < 2; ++ai)
#pragma unroll
            for (int m = 0; m < 4; ++m) { u32x4* p0 = (u32x4*)(xb + (size_t)(row0 + ai * HALF + m * 16) * 1024 + col0); u32x4* p1 = (u32x4*)((bf16_t*)p0 + 8 * 1024);
                const u32x4 t0 = *p0, t1 = *p1;
                f32x4 a0 = acc[ai][0][m][0] * sc, a1 = acc[ai][0][m][1] * sc, b0 = acc[ai][1][m][0] * sc, b1 = acc[ai][1][m][1] * sc;
#pragma unroll
                for (int e = 0; e < 4; ++e) { CM_SWAP_F(lo, a0[e], b0[e]); CM_SWAP_F(lo, a1[e], b1[e]); }
                u32x4 w0, w1;
                w0.x = cvt_pk_bf16(bflo(t0.x) + a0[0], bfhi(t0.x) + a0[1]); w0.y = cvt_pk_bf16(bflo(t0.y) + a0[2], bfhi(t0.y) + a0[3]); w0.z = cvt_pk_bf16(bflo(t0.z) + a1[0], bfhi(t0.z) + a1[1]); w0.w = cvt_pk_bf16(bflo(t0.w) + a1[2], bfhi(t0.w) + a1[3]);
                w1.x = cvt_pk_bf16(bflo(t1.x) + b0[0], bfhi(t1.x) + b0[1]); w1.y = cvt_pk_bf16(bflo(t1.y) + b0[2], bfhi(t1.y) + b0[3]); w1.z = cvt_pk_bf16(bflo(t1.z) + b1[0], bfhi(t1.z) + b1[1]); w1.w = cvt_pk_bf16(bflo(t1.w) + b1[2], bfhi(t1.w) + b1[3]);
                *p0 = w0; *p1 = w1; }
    }
};
struct EpiSwiglu {
    unsigned char* hid; int ldh, ncol; bool pad;
    __device__ __forceinline__ void operator()(const Acc& acc, const Unit& u, int wr, int wc, int fr, int fq) const {
        const int pl = u.pn % ncol; const int row0 = u.pm * BM + wr * 64 + fr, col0 = pl * 128 + wc * 32 + 8 * fq;
        const bool dopad = pad && (pl == ncol - 1);
#pragma unroll
        for (int ai = 0; ai < 2; ++ai)
#pragma unroll
            for (int m = 0; m < 4; ++m) { float v[8];
#pragma unroll
                for (int n = 0; n < 2; ++n)
#pragma unroll
                    for (int e = 0; e < 4; ++e) { const float a = acc[ai][0][m][n][e] * F8_DESCALE, b = acc[ai][1][m][n][e] * F8_DESCALE; v[4 * n + e] = a * sigm(a) * b * F8_MUL_H; }
                unsigned char* rp = hid + (size_t)(row0 + ai * HALF + m * 16) * ldh + col0;
                u32x2 w; w.x = pk4_fp8(v[0], v[1], v[2], v[3]); w.y = pk4_fp8(v[4], v[5], v[6], v[7]); *(u32x2*)rp = w;
                if (dopad) { unsigned z0; asm volatile("v_mov_b32 %0, 0" : "=v"(z0)); *(u32x2*)(rp + 128) = (u32x2){z0, z0}; } }
    }
};
struct EpiMoeOut {
    float* out; const int* rowtok; const float* rowgate; const int* segend;
    __device__ __forceinline__ void operator()(const Acc& acc, const Unit& u, int wr, int wc, int fr, int fq) const {
        const int row0 = u.pm * BM + wr * 64 + fr, col0 = (u.pn & 3) * 256 + wc * 32 + 8 * fq, lim = segend[u.pm];
#pragma unroll
        for (int ai = 0; ai < 2; ++ai)
#pragma unroll
            for (int m = 0; m < 4; ++m) { const int row = row0 + ai * HALF + m * 16;
                if (row < lim) { const int tok = rowtok[row]; const float gt = rowgate[row]; float* rowp = out + (size_t)tok * 1024 + col0;
#pragma unroll
                    for (int bj = 0; bj < 2; ++bj)
#pragma unroll
                        for (int n = 0; n < 2; ++n)
#pragma unroll
                            for (int e = 0; e < 4; ++e) __hip_atomic_fetch_add(rowp + bj * HALF + 4 * n + e, gt * acc[ai][bj][m][n][e], __ATOMIC_RELAXED, __HIP_MEMORY_SCOPE_AGENT);
                } }
    }
};
}

#define XB_TMO      128
#define XB_XCNT(j)  (256  + 64 * (j))
#define XB_XSUB(j)  (1280 + 64 * (j))
#define XB_XGEN(j)  (2304 + 64 * (j))
#define XB_TOP      3328
#define XB_TOPGEN   3392
#define XCD_BAR_WORDS 3456
#define XB_SPIN_CAP (1u << 18)
__device__ __forceinline__ unsigned xb_ld(unsigned* p)              { return __hip_atomic_load(p, __ATOMIC_RELAXED, __HIP_MEMORY_SCOPE_AGENT); }
__device__ __forceinline__ unsigned xb_add(unsigned* p, unsigned v) { return __hip_atomic_fetch_add(p, v, __ATOMIC_RELAXED, __HIP_MEMORY_SCOPE_AGENT); }
__device__ __forceinline__ unsigned xb_xcc_id() { return (unsigned)__builtin_amdgcn_s_getreg((3 << 11) | 20) & 0xFu; }
#define XB_SPIN(cond, bar) do { unsigned _sp = 0; while (cond) { __builtin_amdgcn_s_sleep(1); \
    if ((++_sp & 255u) == 0u) { if (xb_ld(&(bar)[XB_TMO])) break; if (_sp > XB_SPIN_CAP) { atomicAdd(&(bar)[XB_TMO], 1u); break; } } } } while (0)
struct XcdBarrier { unsigned* bar; unsigned x; volatile LAS unsigned* st; };
__device__ __forceinline__ XcdBarrier xcd_barrier_post(unsigned* bar, volatile LAS unsigned* st) {
    XcdBarrier b; b.bar = bar; b.x = xb_xcc_id(); b.st = st;
    if (threadIdx.x == 0) (void)xb_add(&bar[XB_XCNT(b.x)], 1u);
    return b;
}
__device__ __forceinline__ void xcd_barrier_complete(unsigned* bar, unsigned x, unsigned& nloc, unsigned& nx) {
    const unsigned G = gridDim.x * gridDim.y * gridDim.z;
    unsigned sum, cnt, mine, sp = 0u;
    for (;;) {
        sum = 0u; cnt = 0u; mine = 0u;
#pragma unroll
        for (unsigned j = 0; j < 16; ++j) { const unsigned c = xb_ld(&bar[XB_XCNT(j)]); sum += c; cnt += (c > 0u) ? 1u : 0u; mine = (j == x) ? c : mine; }
        if (sum == G) break;
        __builtin_amdgcn_s_sleep(1);
        if ((++sp & 255u) == 0u) { if (xb_ld(&bar[XB_TMO])) break; if (sp > XB_SPIN_CAP) { atomicAdd(&bar[XB_TMO], 1u); break; } }
    }
    nloc = mine > 0u ? mine : 1u; nx = cnt > 0u ? cnt : 1u;
}
__device__ __forceinline__ void xcd_barrier(const XcdBarrier& b, const int tid) {
    asm volatile("s_waitcnt vmcnt(0)" ::: "memory");
    __syncthreads();
    if (tid == 0) {
        unsigned* bar = b.bar;
        __builtin_amdgcn_s_waitcnt(0);
        unsigned nloc = b.st[0], nx = b.st[1];
        if (nloc == 0u) { xcd_barrier_complete(bar, b.x, nloc, nx); b.st[0] = nloc; b.st[1] = nx; }
        const unsigned old = xb_add(&bar[XB_XSUB(b.x)], 1u);
        const unsigned gen = old / nloc;
        if (old + 1u == (gen + 1u) * nloc) {
            __builtin_amdgcn_fence(__ATOMIC_RELEASE, "agent");
            asm volatile("s_waitcnt vmcnt(0)" ::: "memory");
            const unsigned og = xb_add(&bar[XB_TOP], 1u);
            const unsigned tg = og / nx;
            if (og + 1u == (tg + 1u) * nx) xb_add(&bar[XB_TOPGEN], 1u);
            else XB_SPIN(xb_ld(&bar[XB_TOPGEN]) == tg, bar);
            __builtin_amdgcn_fence(__ATOMIC_ACQUIRE, "agent");
            xb_add(&bar[XB_XGEN(b.x)], 1u);
            asm volatile("s_waitcnt vmcnt(0)" ::: "memory");
        } else {
            XB_SPIN(xb_ld(&bar[XB_XGEN(b.x)]) == gen, bar);
            __builtin_amdgcn_fence(__ATOMIC_ACQUIRE, "agent");
            asm volatile("s_waitcnt vmcnt(0)" ::: "memory");
        }
    }
    __syncthreads();
}

constexpr size_t MiB = 1u << 20;
constexpr size_t WS_CTL = 0, CTL_ZERO_BYTES = 1 * MiB;
constexpr int CW_BAR = 4096;
constexpr int CW_QUEUE = 20480;
constexpr int CW_MOE = 16384;
constexpr size_t WS_EIDX = 1 * MiB, WS_GATE = WS_EIDX + 256 * 1024, WS_ROWTOK = WS_EIDX + 512 * 1024, WS_ROWGATE = 2 * MiB, WS_TEXP = 2 * MiB + 512 * 1024, WS_SEGEND = WS_TEXP + 4096, WS_NT = WS_TEXP + 8192;
constexpr size_t WS_SLOTOF = 2 * MiB + 768 * 1024;
constexpr size_t WS_BON = 3 * MiB, WS_COS = 4 * MiB, WS_SIN = 6 * MiB;
constexpr size_t WS_WIN = 8 * MiB, WS_WLORA = 15 * MiB, WS_WB = 16 * MiB, WS_WG = 18 * MiB, WS_WOUT = 26 * MiB, WS_W13 = 28 * MiB  , WS_W2D = 50 * MiB, WS_W2M = 50 * MiB, WS_H8 = 72 * MiB  ;
constexpr size_t WS_XB = 104 * MiB  , WS_Y = 168 * MiB, WS_BIG = 232 * MiB;
constexpr size_t WS_RW = WS_BIG, WS_WDEC = WS_BIG, WS_AG = WS_BIG + 32 * MiB, WS_SB = WS_BIG + 64 * MiB, WS_RET = WS_BIG + 112 * MiB, WS_CV = WS_BIG + 176 * MiB, WS_Y0 = WS_CV;
constexpr size_t WS_RKVS = WS_BIG + 208 * MiB, WS_ALORA = WS_BIG + 256 * MiB, WS_RHAT = WS_ALORA, WS_KV = WS_BIG + 272 * MiB, WS_SST = WS_WDEC  , WS_PQ = WS_BIG + 304 * MiB  , WS_END = WS_BIG + 368 * MiB;
constexpr size_t WS_BALL = WS_BIG, WS_MERGED = WS_BIG + 256 * MiB, WS_HID = WS_BIG, WS_XS = WS_BIG, WS_YS = WS_XS, WS_HIDM = WS_BIG + 132 * MiB;
static_assert(WS_HIDM + (size_t)MPAD * DFE * 2 <= WS_END && WS_MERGED + (size_t)T * D * 2 <= WS_END && WS_W2M + (size_t)NEXP * D * DFE * 2 <= WS_H8, "ws map");
static_assert(WS_W13 + (size_t)NEXP * 2 * DFE * D <= WS_W2M && WS_W13 + (size_t)2 * DFF * D <= WS_W2D && WS_W2M + (size_t)NEXP * D * DFE * 2 <= WS_H8 && WS_H8 + (size_t)T * D <= WS_XB, "ws map weights");

constexpr int LDS_BYTES = 147456, RING_BYTES = 131072, MISC_OFF = RING_BYTES + 320;

struct Args { const float* in[32]; float* out; unsigned char* ws; int ph_lo, ph_hi; };
#define CAS __attribute__((address_space(4)))
struct Ctx {
    LAS unsigned char* lds; unsigned char* ws; float* out; const float* const CAS* in;
    int tid, lane, wave, G, bid;
};
__device__ __forceinline__ const CAS Args* ka_ptr() { const CAS Args* p = (const CAS Args*)__builtin_amdgcn_kernarg_segment_ptr(); asm volatile("" : "+s"(p)); return p; }
extern __shared__ __attribute__((aligned(16))) unsigned char lds_raw[];
__device__ __forceinline__ Ctx make_ctx(int wv) {
    const CAS Args* ka = ka_ptr();
    Ctx C; C.lds = (LAS unsigned char*)lds_raw; C.ws = ka->ws; C.out = ka->out; C.in = ka->in;
    int g_ = gridDim.x, b_ = blockIdx.x, w_ = wv; asm volatile("" : "+s"(g_), "+s"(b_), "+s"(w_));
    int ln_; asm volatile("v_mbcnt_lo_u32_b32 %0, -1, 0\n\tv_mbcnt_hi_u32_b32 %0, -1, %0" : "=v"(ln_));
    C.lane = ln_; C.wave = w_; C.tid = w_ * 64 + ln_; C.G = g_; C.bid = b_;
    return C;
}
enum { I_X = 0, I_NORM_MIX, I_W_IN, I_RW_MU, I_RW_W0, I_RW_W2, I_RW_A0, I_RW_A2, I_RW_G2, I_RW_KK, I_RW_KA, I_RW_RK, I_RW_LNW, I_RW_LNB, I_SB_QN, I_SB_KN, I_RET_GN,
       I_CONV_DW, I_CONV_B, I_CONV_LNW, I_CONV_LNB, I_W_GATE, I_W_BRANCH, I_W_OUT, I_NORM_FFN, I_FFN_W1, I_FFN_W3, I_FFN_W2, I_ROUTER, I_MOE_W1, I_MOE_W3, I_MOE_W2 };

__device__ __forceinline__ int q_next(const Ctx& C, unsigned* head) {
    LAS int* slot = (LAS int*)(C.lds + MISC_OFF + 64);
    __syncthreads();
    if (C.tid == 0) *slot = (int)__hip_atomic_fetch_add(head, 1u, __ATOMIC_RELAXED, __HIP_MEMORY_SCOPE_AGENT);
    __syncthreads();
    return *slot;
}
__device__ __forceinline__ void ph_prologue_(const Ctx& C) {
    const size_t gid = (size_t)C.bid * NTHR + C.tid, gsz = (size_t)C.G * NTHR;
    float* cs = (float*)(C.ws + WS_COS); float* sn = (float*)(C.ws + WS_SIN);
    for (size_t i = gid; i < (size_t)SEQ * 32; i += gsz) {
        const int pos = (int)(i >> 5), j = (int)(i & 31);
        const float inv = (float)pow(10000.0, -(double)(2 * j) / 64.0);
        const float ang = (float)pos * inv;
        cs[i] = (float)cos((double)ang); sn[i] = (float)sin((double)ang);
    }
}

__device__ __forceinline__ int dest_row(int mode, int roff, int which, int n) {
    if (mode == 0) return roff + n;
    if (mode == 1) { const int pn = n >> 6, oc = n & 63; return 256 * pn + 128 * (roff >> 1) + 32 * (oc >> 4) + 8 * ((oc >> 2) & 3) + 4 * (roff & 1) + (oc & 3); }
    return roff + 256 * (n >> 7) + 128 * which + (n & 127);
}
__device__ __forceinline__ void xpose_item(const float* W, int K, int N, bf16* WT, int mode, int roff, int which, LAS float* scr, int item, int lane) {
    const int nblk = N / 32, kb = item / nblk, nb = item % nblk, k0 = 64 * kb, n0 = 32 * nb;
#pragma unroll
    for (int i = 0; i < 8; ++i) { const int kk = (lane >> 3) + 8 * i, c4 = (lane & 7) * 4; const f32x4 v = *(const f32x4*)(W + (size_t)(k0 + kk) * N + n0 + c4);
        scr[kk * 33 + c4] = v.x; scr[kk * 33 + c4 + 1] = v.y; scr[kk * 33 + c4 + 2] = v.z; scr[kk * 33 + c4 + 3] = v.w; }
    asm volatile("s_waitcnt lgkmcnt(0)" ::: "memory");
    const int c = lane & 7;
#pragma unroll
    for (int j = 0; j < 4; ++j) { const int n = (lane >> 3) + 8 * j; const LAS float* s = scr + (8 * c) * 33 + n;
        u32x4 o; o.x = cvt_pk_bf16(s[0 * 33], s[1 * 33]); o.y = cvt_pk_bf16(s[2 * 33], s[3 * 33]); o.z = cvt_pk_bf16(s[4 * 33], s[5 * 33]); o.w = cvt_pk_bf16(s[6 * 33], s[7 * 33]);
        *(u32x4*)(WT + (size_t)dest_row(mode, roff, which, n0 + n) * K + k0 + 8 * c) = o; }
    asm volatile("s_waitcnt lgkmcnt(0)" ::: "memory");
}
__device__ __forceinline__ void xpose_item8(const float* W, int K, int N, unsigned char* WT, int mode, int roff, int which, LAS float* scr, int item, int lane, int ldk = 0) {
    if (ldk == 0) ldk = K;
    const int nblk = N / 32, kb = item / nblk, nb = item % nblk, k0 = 64 * kb, n0 = 32 * nb;
#pragma unroll
    for (int i = 0; i < 8; ++i) { const int kk = (lane >> 3) + 8 * i, c4 = (lane & 7) * 4; const f32x4 v = *(const f32x4*)(W + (size_t)(k0 + kk) * N + n0 + c4);
        scr[kk * 33 + c4] = v.x; scr[kk * 33 + c4 + 1] = v.y; scr[kk * 33 + c4 + 2] = v.z; scr[kk * 33 + c4 + 3] = v.w; }
    asm volatile("s_waitcnt lgkmcnt(0)" ::: "memory");
    const int c = lane & 3;
#pragma unroll
    for (int j = 0; j < 2; ++j) { const int n = (lane >> 2) + 16 * j; const LAS float* sp = scr + (16 * c) * 33 + n;
        u32x4 o;
        o.x = pk4_fp8(sp[0 * 33] * F8_MUL_W, sp[1 * 33] * F8_MUL_W, sp[2 * 33] * F8_MUL_W, sp[3 * 33] * F8_MUL_W);
        o.y = pk4_fp8(sp[4 * 33] * F8_MUL_W, sp[5 * 33] * F8_MUL_W, sp[6 * 33] * F8_MUL_W, sp[7 * 33] * F8_MUL_W);
        o.z = pk4_fp8(sp[8 * 33] * F8_MUL_W, sp[9 * 33] * F8_MUL_W, sp[10 * 33] * F8_MUL_W, sp[11 * 33] * F8_MUL_W);
        o.w = pk4_fp8(sp[12 * 33] * F8_MUL_W, sp[13 * 33] * F8_MUL_W, sp[14 * 33] * F8_MUL_W, sp[15 * 33] * F8_MUL_W);
        *(u32x4*)(WT + (size_t)dest_row(mode, roff, which, n0 + n) * ldk + k0 + 16 * c) = o; }
    asm volatile("s_waitcnt lgkmcnt(0)" ::: "memory");
}
__device__ __forceinline__ void ph_weights_(const Ctx& C, int l, int part, int first_wg, int nwg, unsigned* qhead = nullptr) {
    LAS float* scr = (LAS float*)(C.lds + C.wave * 16384);
    const int gw = (C.bid - first_wg) * NWAVES + C.wave, NGW = nwg * NWAVES, lane = C.lane;
    unsigned char* ws = C.ws;
    const bool moe = (l & 1);
    const int l2 = l >> 1;
    constexpr int IT_IN = (D / 64) * (NIN / 32), IT_B = (256 / 64) * (D / 32), IT_G = (D / 64) * (D / 32), IT_O = IT_G;
    constexpr int IT_F1 = (D / 64) * (DFF / 32), IT_F2 = (DFF / 64) * (D / 32), IT_M1 = (D / 64) * (DFE / 32), IT_M2 = (DFE / 64) * (D / 32);
    const int n_fixed = IT_IN + 4 * IT_B + 4 * IT_G + IT_O;
    if (part == 1) {
        if (C.bid < first_wg) return;
        const int n1 = moe ? NEXP * IT_M2 : (2 * IT_F1 + IT_F2);
        for (int it = qhead ? q_next(C, qhead) * NWAVES + C.wave : gw; qhead ? (it - C.wave < n1) : (it < n1); it = qhead ? q_next(C, qhead) * NWAVES + C.wave : it + NGW) {
            if (it >= n1) continue;
            int r = it;
            if (!moe) {
                if (r < IT_F1) { xpose_item8(C.in[I_FFN_W1] + (size_t)l2 * D * DFF, D, DFF, ws + WS_W13, 2, 0, 0, scr, r, lane); continue; } r -= IT_F1;
                if (r < IT_F1) { xpose_item8(C.in[I_FFN_W3] + (size_t)l2 * D * DFF, D, DFF, ws + WS_W13, 2, 0, 1, scr, r, lane); continue; } r -= IT_F1;
                xpose_item8(C.in[I_FFN_W2] + (size_t)l2 * DFF * D, DFF, D, ws + WS_W2D, 0, 0, 0, scr, r, lane);
            } else { const int e = r / IT_M2; r -= e * IT_M2;
                xpose_item8(C.in[I_MOE_W2] + ((size_t)l2 * NEXP + e) * DFE * D, DFE, D, ws + WS_W2M, 0, e * D, 0, scr, r, lane, DFE_PAD); }
        }
        if (moe) {
            for (int i = (C.bid - first_wg) * NTHR + C.tid; i < NEXP * D * ((DFE_PAD - DFE) / 16); i += nwg * NTHR) { const int row = i >> 3, c16 = i & 7;
                unsigned z0; asm volatile("v_mov_b32 %0, 0" : "=v"(z0)); *(u32x4*)(ws + WS_W2M + (size_t)row * DFE_PAD + DFE + 16 * c16) = (u32x4){z0, z0, z0, z0}; } }
        return;
    }
    const int n_ffn = moe ? (NEXP * 2 * IT_M1) : 0;
    for (int it = gw; it < n_fixed + n_ffn; it += NGW) {
        int r = it;
        if (r < IT_IN) { xpose_item(C.in[I_W_IN] + (size_t)l * D * NIN, D, NIN, (bf16*)(ws + WS_WIN), 0, 0, 0, scr, r, lane); continue; } r -= IT_IN;
        if (r < 4 * IT_B) { const int i = r / IT_B; xpose_item(C.in[I_W_BRANCH] + ((size_t)l * 4 + i) * 256 * D, 256, D, (bf16*)(ws + WS_WB), 0, 1024 * i, 0, scr, r % IT_B, lane); continue; } r -= 4 * IT_B;
        if (r < 4 * IT_G) { const int i = r / IT_G; xpose_item8(C.in[I_W_GATE] + ((size_t)l * 4 + i) * D * D, D, D, ws + WS_WG, 1, i, 0, scr, r % IT_G, lane); continue; } r -= 4 * IT_G;
        if (r < IT_O) { xpose_item(C.in[I_W_OUT] + (size_t)l * D * D, D, D, (bf16*)(ws + WS_WOUT), 0, 0, 0, scr, r, lane); continue; } r -= IT_O;
        { const int per = 2 * IT_M1, e = r / per; r -= e * per;
          if (r < IT_M1) { xpose_item8(C.in[I_MOE_W1] + ((size_t)l2 * NEXP + e) * D * DFE, D, DFE, ws + WS_W13, 2, e * 2 * DFE, 0, scr, r, lane); continue; } r -= IT_M1;
          xpose_item8(C.in[I_MOE_W3] + ((size_t)l2 * NEXP + e) * D * DFE, D, DFE, ws + WS_W13, 2, e * 2 * DFE, 1, scr, r, lane); }
    }
    bf16* WL = (bf16*)(ws + WS_WLORA);
    const float* w2 = C.in[I_RW_W2] + (size_t)l * 64 * 256; const float* a2 = C.in[I_RW_A2] + (size_t)l * 64 * 256; const float* g2 = C.in[I_RW_G2] + (size_t)l * 128 * 256;
    for (int i = C.bid * NTHR + C.tid; i < 768 * 256; i += C.G * NTHR) {
        const int n = i >> 8, k = i & 255; float v = 0.f;
        if (n < 256) { if (k < 64) v = w2[k * 256 + n]; }
        else if (n < 512) { if (k >= 64 && k < 128) v = a2[(k - 64) * 256 + (n - 256)]; }
        else { if (k >= 128) v = g2[(k - 128) * 256 + (n - 512)]; }
        WL[i] = f2bf(v);
    }
}

__device__ __forceinline__ void ph_norm_(const Ctx& C, const float* gain, bool route, const float* router, int moe_idx, bool combine = false, const float* src = nullptr, bool want_bf16 = true) {
    const int gw = C.bid * NWAVES + C.wave, NGW = C.G * NWAVES, lane = C.lane;
    bf16* H = (bf16*)C.out; bf16* XB = (bf16*)(C.ws + WS_XB);
    f32x4 g[4];
#pragma unroll
    for (int j = 0; j < 4; ++j) g[j] = *(const f32x4*)(gain + 8 * lane + 512 * (j >> 1) + 4 * (j & 1));
    LAS unsigned* lcnt = (LAS unsigned*)(C.lds);
    if (route) { if (C.tid < 8) lcnt[C.tid] = 0u; __syncthreads(); }
    int* eidx = (int*)(C.ws + WS_EIDX); float* gate = (float*)(C.ws + WS_GATE);
    constexpr int NR = 4;
    for (int mb = gw; mb < T; mb += NR * NGW) {
        f32x4 vv[NR][4]; u32x4 ya[NR][2], yb[NR][2]; float g0v[NR], g1v[NR];
#pragma unroll
        for (int r = 0; r < NR; ++r) { const int m = mb + r * NGW; if (m < T) {
            if (src) { const f32x4* xr = (const f32x4*)(src + (size_t)m * D + 8 * lane);
#pragma unroll
                for (int j = 0; j < 4; ++j) vv[r][j] = xr[128 * (j >> 1) + (j & 1)]; }
            else { const u32x4* xb = (const u32x4*)(XB + (size_t)m * D) + lane;
#pragma unroll
                for (int j = 0; j < 2; ++j) { const u32x4 t = xb[64 * j]; vv[r][2 * j] = f32x4{bflo(t.x), bfhi(t.x), bflo(t.y), bfhi(t.y)}; vv[r][2 * j + 1] = f32x4{bflo(t.z), bfhi(t.z), bflo(t.w), bfhi(t.w)}; } }
            if (combine) { const int* slotof = (const int*)(C.ws + WS_SLOTOF); const float* gt = (const float*)(C.ws + WS_GATE); const bf16* YS = (const bf16*)(C.ws + WS_YS);
                const int s0 = slotof[2 * m], s1 = slotof[2 * m + 1]; g0v[r] = gt[2 * m]; g1v[r] = gt[2 * m + 1];
                const u32x4* y0 = (const u32x4*)(YS + (size_t)s0 * D) + lane; const u32x4* y1 = (const u32x4*)(YS + (size_t)s1 * D) + lane;
#pragma unroll
                for (int j = 0; j < 2; ++j) { ya[r][j] = y0[64 * j]; yb[r][j] = y1[64 * j]; } } } }
#pragma unroll
        for (int r = 0; r < NR; ++r) { const int m = mb + r * NGW; if (m < T) {
        f32x4 v[4]; float s = 0.f;
#pragma unroll
        for (int j = 0; j < 4; ++j) v[j] = vv[r][j];
        if (combine) {
            const float g0 = g0v[r], g1 = g1v[r];
#pragma unroll
            for (int j = 0; j < 2; ++j) { const u32x4 a = ya[r][j], b = yb[r][j];
                v[2 * j].x += g0 * bflo(a.x) + g1 * bflo(b.x); v[2 * j].y += g0 * bfhi(a.x) + g1 * bfhi(b.x); v[2 * j].z += g0 * bflo(a.y) + g1 * bflo(b.y); v[2 * j].w += g0 * bfhi(a.y) + g1 * bfhi(b.y);
                v[2 * j + 1].x += g0 * bflo(a.z) + g1 * bflo(b.z); v[2 * j + 1].y += g0 * bfhi(a.z) + g1 * bfhi(b.z); v[2 * j + 1].z += g0 * bflo(a.w) + g1 * bflo(b.w); v[2 * j + 1].w += g0 * bfhi(a.w) + g1 * bfhi(b.w); }
        }
        if (combine || src) { u32x4* xo = (u32x4*)(XB + (size_t)m * D) + lane;
#pragma unroll
            for (int j = 0; j < 2; ++j) { u32x4 t; t.x = cvt_pk_bf16(v[2 * j].x, v[2 * j].y); t.y = cvt_pk_bf16(v[2 * j].z, v[2 * j].w); t.z = cvt_pk_bf16(v[2 * j + 1].x, v[2 * j + 1].y); t.w = cvt_pk_bf16(v[2 * j + 1].z, v[2 * j + 1].w); xo[64 * j] = t; } }
#pragma unroll
        for (int j = 0; j < 4; ++j) s += (v[j].x * v[j].x + v[j].y * v[j].y) + (v[j].z * v[j].z + v[j].w * v[j].w);
        const float rs = 1.0f / sqrtf(wave_sum(s, C.lane) * (1.f / D) + 1e-6f);
#pragma unroll
        for (int j = 0; j < 4; ++j) v[j] = v[j] * rs * g[j];
#pragma unroll
        for (int j = 0; j < 2; ++j) {
            if (want_bf16) { u32x4 t; t.x = cvt_pk_bf16(v[2 * j].x, v[2 * j].y); t.y = cvt_pk_bf16(v[2 * j].z, v[2 * j].w); t.z = cvt_pk_bf16(v[2 * j + 1].x, v[2 * j + 1].y); t.w = cvt_pk_bf16(v[2 * j + 1].z, v[2 * j + 1].w);
                ((u32x4*)(H + (size_t)m * D) + lane)[64 * j] = t; }
            u32x2 q; q.x = pk4_fp8(v[2 * j].x * F8_MUL_X, v[2 * j].y * F8_MUL_X, v[2 * j].z * F8_MUL_X, v[2 * j].w * F8_MUL_X); q.y = pk4_fp8(v[2 * j + 1].x * F8_MUL_X, v[2 * j + 1].y * F8_MUL_X, v[2 * j + 1].z * F8_MUL_X, v[2 * j + 1].w * F8_MUL_X);
            ((u32x2*)(C.ws + WS_H8 + (size_t)m * D) + lane)[64 * j] = q; }
        if (route) {
            float lg[8];
#pragma unroll
            for (int e = 0; e < 8; ++e) lg[e] = 0.f;
#pragma unroll
            for (int j = 0; j < 4; ++j)
#pragma unroll
                for (int q = 0; q < 4; ++q) { const int k = 8 * lane + 512 * (j >> 1) + 4 * (j & 1) + q; const f32x4 r0 = *(const f32x4*)(router + (size_t)k * 8), r1 = *(const f32x4*)(router + (size_t)k * 8 + 4); const float hv = v[j][q];
                    lg[0] += hv * r0.x; lg[1] += hv * r0.y; lg[2] += hv * r0.z; lg[3] += hv * r0.w; lg[4] += hv * r1.x; lg[5] += hv * r1.y; lg[6] += hv * r1.z; lg[7] += hv * r1.w; }
#pragma unroll
            for (int e = 0; e < 8; ++e) lg[e] = wave_sum(lg[e], C.lane);
            int e0 = 0; float b0 = lg[0];
#pragma unroll
            for (int e = 1; e < 8; ++e) if (lg[e] > b0) { b0 = lg[e]; e0 = e; }
            int e1 = -1; float b1 = -3.0e38f;
#pragma unroll
            for (int e = 0; e < 8; ++e) if (e != e0 && lg[e] > b1) { b1 = lg[e]; e1 = e; }
            const float p1 = __expf(b1 - b0), inv = 1.f / (1.f + p1);
            if (lane == 0) { eidx[2 * m] = e0; eidx[2 * m + 1] = e1; gate[2 * m] = inv; gate[2 * m + 1] = p1 * inv; atomicAdd((unsigned*)&lcnt[e0], 1u); atomicAdd((unsigned*)&lcnt[e1], 1u); }
        }
        } }
    }
    if (route) { __syncthreads(); if (C.tid < 8) { unsigned* cw = (unsigned*)(C.ws + WS_CTL) + CW_MOE + moe_idx * 64; atomicAdd(&cw[C.tid], lcnt[C.tid]); } }
}

__device__ __forceinline__ void ph_rw_prep_(const Ctx& C, int l) {
    const bf16* RW = (const bf16*)(C.ws + WS_RW); bf16* RKVS = (bf16*)(C.ws + WS_RKVS); bf16* AL = (bf16*)(C.ws + WS_ALORA);
    const float* mu = C.in[I_RW_MU] + (size_t)l * 1024;
    const size_t gid = (size_t)C.bid * NTHR + C.tid, gsz = (size_t)C.G * NTHR;
    constexpr int NI = 4;
    for (size_t it0 = gid; it0 < (size_t)T * 128; it0 += NI * gsz) {
        u32x4 cuv[NI], pvv[NI]; f32x4 mu0[NI], mu1[NI];
#pragma unroll
        for (int r = 0; r < NI; ++r) { const size_t it = it0 + r * gsz; cuv[r] = (u32x4){0u, 0u, 0u, 0u}; pvv[r] = cuv[r]; mu0[r] = (f32x4){0.f, 0.f, 0.f, 0.f}; mu1[r] = mu0[r];
            if (it < (size_t)T * 128) { const int m = (int)(it >> 7), c8 = (int)(it & 127) * 8, t = m & (SEQ - 1);
                cuv[r] = *(const u32x4*)(RW + (size_t)m * 1024 + c8); if (t) pvv[r] = *(const u32x4*)(RW + (size_t)(m - 1) * 1024 + c8); mu0[r] = *(const f32x4*)(mu + c8); mu1[r] = *(const f32x4*)(mu + c8 + 4); } }
#pragma unroll
        for (int r = 0; r < NI; ++r) { const size_t it = it0 + r * gsz; if (it < (size_t)T * 128) {
        const int m = (int)(it >> 7), c8 = (int)(it & 127) * 8;
        float a[8], b[8]; unpack8(cuv[r], a); unpack8(pvv[r], b);
        const f32x4 m0 = mu0[r], m1 = mu1[r];
        const float mm[8] = {m0.x, m0.y, m0.z, m0.w, m1.x, m1.y, m1.z, m1.w};
#pragma unroll
        for (int e = 0; e < 8; ++e) a[e] = a[e] + (b[e] - a[e]) * mm[e];
        if (c8 < 768) { *(u32x4*)(RKVS + (size_t)m * 768 + c8) = pack8(a); }
        else {
            if (c8 < 832) {
#pragma unroll
                for (int e = 0; e < 8; ++e) a[e] = 1.f - 2.f * __builtin_amdgcn_rcpf(1.f + __builtin_amdgcn_exp2f(2.f * LOG2E * a[e]));
            } else if (c8 >= 896) {
#pragma unroll
                for (int e = 0; e < 8; ++e) a[e] = sigm(a[e]);
            }
            *(u32x4*)(AL + (size_t)m * 256 + (c8 - 768)) = pack8(a);
        } } }
    }
}

__device__ __forceinline__ void ph_sb_prep_(const Ctx& C, int l) {
    bf16* SB = (bf16*)(C.ws + WS_SB);
    const int gw = C.bid * NWAVES + C.wave, NGW = C.G * NWAVES, lane = C.lane;
    const bool isk = lane >= 32; const int d0 = (lane & 7) * 8;
    const float* gn = (isk ? C.in[I_SB_KN] : C.in[I_SB_QN]) + (size_t)l * 64 + d0;
    float gg[8];
#pragma unroll
    for (int e = 0; e < 8; ++e) gg[e] = gn[e] * (isk ? 1.f : 0.125f * LOG2E);
    constexpr int NR = 4;
    for (int mb = gw; mb < T; mb += NR * NGW) {
        u32x4 uu[NR];
#pragma unroll
        for (int r = 0; r < NR; ++r) { const int m = mb + r * NGW; uu[r] = (u32x4){0u, 0u, 0u, 0u}; if (m < T) uu[r] = *(const u32x4*)(SB + (size_t)m * 768 + lane * 8); }
#pragma unroll
        for (int r = 0; r < NR; ++r) { const int m = mb + r * NGW; if (m < T) {
            bf16* p = SB + (size_t)m * 768 + lane * 8;
            float a[8]; unpack8(uu[r], a);
            float ss = 0.f;
#pragma unroll
            for (int e = 0; e < 8; ++e) ss += a[e] * a[e];
            ss += shx(ss, 1, lane); ss += shx(ss, 2, lane); ss += shx(ss, 4, lane);
            const float rs = 1.0f / sqrtf(ss * (1.f / 64.f) + 1e-6f);
#pragma unroll
            for (int e = 0; e < 8; ++e) a[e] = a[e] * rs * gg[e];
            *(u32x4*)p = pack8(a); } }
    }
}

__device__ __forceinline__ void ph_conv_(const Ctx& C, int l) {
    const bf16* CV = (const bf16*)(C.ws + WS_CV); bf16* Y = (bf16*)(C.ws + WS_Y);
    LAS float* U = (LAS float*)(C.lds); LAS float* OC = (LAS float*)(C.lds + 65536);
    const int tid = C.tid, c = tid & 255, half = tid >> 8;
    const float* dw = C.in[I_CONV_DW] + (size_t)l * 31 * 256; const float db = C.in[I_CONV_B][l * 256 + c];
    float dwr[31];
#pragma unroll
    for (int j = 0; j < 31; ++j) dwr[j] = dw[j * 256 + c];
    const float* lnw = C.in[I_CONV_LNW] + (size_t)l * 256; const float* lnb = C.in[I_CONV_LNB] + (size_t)l * 256;
    for (int u = C.bid; u < T / 32; u += C.G) {
        const int m0 = u * 32, t0 = m0 & (SEQ - 1);
        for (int it = tid; it < 62 * 32; it += NTHR) {
            const int r = it >> 5, c8 = (it & 31) * 8, tt = t0 - 30 + r; float a[8], b[8];
            if (tt >= 0) { const size_t mm = (size_t)(m0 - 30 + r); unpack8(*(const u32x4*)(CV + mm * 512 + c8), a); unpack8(*(const u32x4*)(CV + mm * 512 + 256 + c8), b);
#pragma unroll
                for (int e = 0; e < 8; ++e) a[e] = a[e] * sigm(b[e]); }
            else {
#pragma unroll
                for (int e = 0; e < 8; ++e) a[e] = 0.f; }
#pragma unroll
            for (int e = 0; e < 8; ++e) U[r * 256 + c8 + e] = a[e];
        }
        __syncthreads();
        { float win[46];
#pragma unroll
          for (int i = 0; i < 46; ++i) win[i] = U[(half * 16 + i) * 256 + c];
#pragma unroll
          for (int tt = 0; tt < 16; ++tt) { float acc = db;
#pragma unroll
              for (int j = 0; j < 31; ++j) acc += dwr[j] * win[tt + j];
              OC[(half * 16 + tt) * 256 + c] = acc; } }
        __syncthreads();
#pragma unroll 1
        for (int q = 0; q < 4; ++q) { const int tl = C.wave * 4 + q; float v[4]; float s = 0.f;
#pragma unroll
            for (int i = 0; i < 4; ++i) { v[i] = OC[tl * 256 + C.lane + 64 * i]; s += v[i]; }
            const float mean = wave_sum(s, C.lane) * (1.f / 256.f); float s2 = 0.f;
#pragma unroll
            for (int i = 0; i < 4; ++i) { v[i] -= mean; s2 += v[i] * v[i]; }
            const float rstd = 1.0f / sqrtf(wave_sum(s2, C.lane) * (1.f / 256.f) + 1e-5f);
#pragma unroll
            for (int i = 0; i < 4; ++i) { const int cc = C.lane + 64 * i; const float y = v[i] * rstd * lnw[cc] + lnb[cc]; Y[(size_t)(m0 + tl) * 1024 + 768 + cc] = f2bf(y * sigm(y)); } }
        __syncthreads();
    }
}

__device__ __forceinline__ float ret_log2gamma(int h) { return log2f(1.0f - exp2f(-5.0f - (float)h)); }
__device__ __forceinline__ void ret_load_rot(const Ctx& C, const bf16* RET, int m0, int coff, float scale, LAS float* dst) {
    const int s = C.tid >> 3, d0 = (C.tid & 7) * 4;
    const float* cs = (const float*)(C.ws + WS_COS); const float* sn = (const float*)(C.ws + WS_SIN);
    const int pos = (m0 + s) & (SEQ - 1);
    const u32x2 a = *(const u32x2*)(RET + (size_t)(m0 + s) * 1024 + coff + d0), b = *(const u32x2*)(RET + (size_t)(m0 + s) * 1024 + coff + 32 + d0);
    const float x1[4] = {bflo(a.x), bfhi(a.x), bflo(a.y), bfhi(a.y)}, x2[4] = {bflo(b.x), bfhi(b.x), bflo(b.y), bfhi(b.y)};
    const f32x4 cv = *(const f32x4*)(cs + (size_t)pos * 32 + d0), sv = *(const f32x4*)(sn + (size_t)pos * 32 + d0);
#pragma unroll
    for (int e = 0; e < 4; ++e) { dst[s * 65 + d0 + e] = (x1[e] * cv[e] - x2[e] * sv[e]) * scale; dst[s * 65 + 32 + d0 + e] = (x1[e] * sv[e] + x2[e] * cv[e]) * scale; }
}
__device__ __forceinline__ void ph_ret_kv_(const Ctx& C) {
    const bf16* RET = (const bf16*)(C.ws + WS_RET); float* KV = (float*)(C.ws + WS_KV);
    LAS float* KD = (LAS float*)(C.lds); LAS float* VV = (LAS float*)(C.lds + 32768);
    const int tid = C.tid;
    for (int u = C.bid; u < 2048; u += C.G) {
        const int bh = u >> 8, ch = u & 255, b = bh >> 2, h = bh & 3, m0 = b * SEQ + ch * 64;
        const float lg = ret_log2gamma(h);
        ret_load_rot(C, RET, m0, 256 + h * 64, 0.125f, KD);
        { const int s = tid >> 3, e0 = (tid & 7) * 8; float a[8]; unpack8(*(const u32x4*)(RET + (size_t)(m0 + s) * 1024 + 512 + h * 64 + e0), a);
          const float dec = exp2f(lg * (float)(63 - s));
#pragma unroll
          for (int e = 0; e < 8; ++e) VV[s * 64 + e0 + e] = a[e] * dec; }
        __syncthreads();
        const int d = tid >> 3, e0 = (tid & 7) * 8; float acc[8];
#pragma unroll
        for (int e = 0; e < 8; ++e) acc[e] = 0.f;
#pragma unroll 4
        for (int s = 0; s < 64; ++s) { const float kd = KD[s * 65 + d]; const f32x4 v0 = *(const LAS f32x4*)(VV + s * 64 + e0), v1 = *(const LAS f32x4*)(VV + s * 64 + e0 + 4);
            acc[0] += kd * v0.x; acc[1] += kd * v0.y; acc[2] += kd * v0.z; acc[3] += kd * v0.w; acc[4] += kd * v1.x; acc[5] += kd * v1.y; acc[6] += kd * v1.z; acc[7] += kd * v1.w; }
        float* o = KV + (size_t)u * 4096 + d * 64 + e0;
        *(f32x4*)o = (f32x4){acc[0], acc[1], acc[2], acc[3]}; *(f32x4*)(o + 4) = (f32x4){acc[4], acc[5], acc[6], acc[7]};
        __syncthreads();
    }
}
__device__ __forceinline__ void ph_ret_scan_(const Ctx& C) {
    float* KV = (float*)(C.ws + WS_KV);
    const int wg0 = (C.G >= 256) ? 128 : 0, nw = C.G - wg0;
    for (int i = (C.bid - wg0) * NTHR + C.tid; i < 8 * 4096 && C.bid >= wg0; i += nw * NTHR) {
        const int bh = i >> 12, el = i & 4095, h = bh & 3;
        const float cd = exp2f(ret_log2gamma(h) * 64.f);
        float* p = KV + (size_t)bh * 256 * 4096 + el; float S = 0.f;
#pragma unroll 1
        for (int c = 0; c < 256; c += 32) { float kv[32];
#pragma unroll
            for (int q = 0; q < 32; ++q) kv[q] = p[(size_t)(c + q) * 4096];
#pragma unroll
            for (int q = 0; q < 32; ++q) { p[(size_t)(c + q) * 4096] = S; S = S * cd + kv[q]; } }
    }
}
__device__ __forceinline__ void ph_ret_out_(const Ctx& C, int l, int first_wg, int nwg) {
    const bf16* RET = (const bf16*)(C.ws + WS_RET); const float* KV = (const float*)(C.ws + WS_KV); bf16* Y = (bf16*)(C.ws + WS_Y);
    LAS float* Q = (LAS float*)(C.lds); LAS float* Kk = (LAS float*)(C.lds + 16640); LAS float* VV = (LAS float*)(C.lds + 33280); LAS float* SS = (LAS float*)(C.lds + 49664); LAS float* SC = (LAS float*)(C.lds + 66048);
    const int tid = C.tid; const float* gn = C.in[I_RET_GN] + (size_t)l * 256;
    for (int u = C.bid - first_wg; u < 2048; u += nwg) {
        const int bh = u >> 8, ch = u & 255, b = bh >> 2, h = bh & 3, m0 = b * SEQ + ch * 64;
        const float lg = ret_log2gamma(h);
        ret_load_rot(C, RET, m0, h * 64, 1.0f, Q);
        ret_load_rot(C, RET, m0, 256 + h * 64, 0.125f, Kk);
        { const int s = tid >> 3, e0 = (tid & 7) * 8; float a[8]; unpack8(*(const u32x4*)(RET + (size_t)(m0 + s) * 1024 + 512 + h * 64 + e0), a);
#pragma unroll
          for (int e = 0; e < 8; ++e) VV[s * 64 + e0 + e] = a[e];
          const float* sp = KV + (size_t)u * 4096 + s * 64 + e0; const f32x4 s0 = *(const f32x4*)sp, s1 = *(const f32x4*)(sp + 4);
          *(LAS f32x4*)(SS + s * 64 + e0) = s0; *(LAS f32x4*)(SS + s * 64 + e0 + 4) = s1; }
        __syncthreads();
        const int t = tid >> 3, g8 = tid & 7;
        { float sc[8];
#pragma unroll
          for (int i = 0; i < 8; ++i) sc[i] = 0.f;
#pragma unroll 4
          for (int d = 0; d < 64; ++d) { const float qv = Q[t * 65 + d];
#pragma unroll
              for (int i = 0; i < 8; ++i) sc[i] += qv * Kk[(g8 * 8 + i) * 65 + d]; }
#pragma unroll
          for (int i = 0; i < 8; ++i) { const int s = g8 * 8 + i; SC[t * 65 + s] = (s <= t) ? sc[i] * exp2f(lg * (float)(t - s)) : 0.f; } }
        __syncthreads();
        { const int e0 = g8 * 8; float o[8], o2[8];
#pragma unroll
          for (int e = 0; e < 8; ++e) { o[e] = 0.f; o2[e] = 0.f; }
#pragma unroll 4
          for (int s = 0; s < 64; ++s) { const float p = SC[t * 65 + s]; const f32x4 v0 = *(const LAS f32x4*)(VV + s * 64 + e0), v1 = *(const LAS f32x4*)(VV + s * 64 + e0 + 4);
              o[0] += p * v0.x; o[1] += p * v0.y; o[2] += p * v0.z; o[3] += p * v0.w; o[4] += p * v1.x; o[5] += p * v1.y; o[6] += p * v1.z; o[7] += p * v1.w; }
#pragma unroll 4
          for (int d = 0; d < 64; ++d) { const float qv = Q[t * 65 + d]; const f32x4 v0 = *(const LAS f32x4*)(SS + d * 64 + e0), v1 = *(const LAS f32x4*)(SS + d * 64 + e0 + 4);
              o2[0] += qv * v0.x; o2[1] += qv * v0.y; o2[2] += qv * v0.z; o2[3] += qv * v0.w; o2[4] += qv * v1.x; o2[5] += qv * v1.y; o2[6] += qv * v1.z; o2[7] += qv * v1.w; }
          const float qd = exp2f(lg * (float)(t + 1)); float s1 = 0.f;
#pragma unroll
          for (int e = 0; e < 8; ++e) { o[e] += qd * o2[e]; s1 += o[e]; }
          s1 += shx(s1, 1, C.lane); s1 += shx(s1, 2, C.lane); s1 += shx(s1, 4, C.lane);
          const float mean = s1 * (1.f / 64.f); float s2 = 0.f;
#pragma unroll
          for (int e = 0; e < 8; ++e) { o[e] -= mean; s2 += o[e] * o[e]; }
          s2 += shx(s2, 1, C.lane); s2 += shx(s2, 2, C.lane); s2 += shx(s2, 4, C.lane);
          const float rstd = 1.0f / sqrtf(s2 * (1.f / 64.f) + 1e-5f);
          float gtv[8]; unpack8(*(const u32x4*)(RET + (size_t)(m0 + t) * 1024 + 768 + h * 64 + e0), gtv);
#pragma unroll
          for (int e = 0; e < 8; ++e) o[e] = o[e] * rstd * gn[h * 64 + e0 + e] * (gtv[e] * sigm(gtv[e]));
          *(u32x4*)(Y + (size_t)(m0 + t) * 1024 + 512 + h * 64 + e0) = pack8(o); }
        __syncthreads();
    }
}

constexpr int RWC = 64, RW_NCH = SEQ / RWC, RW_NU = 8 * RW_NCH;
constexpr int RW_SUP = 8, RW_NSC = RW_NCH / RW_SUP, RW_NSUP = 8 * RW_NSC;
__device__ __forceinline__ void ph_rw_local_(const Ctx& C, int l) {
    const bf16* RKVS = (const bf16*)(C.ws + WS_RKVS); const float* WDEC = (const float*)(C.ws + WS_WDEC); const bf16* AG = (const bf16*)(C.ws + WS_AG);
    bf16* Y0 = (bf16*)(C.ws + WS_Y0); bf16* RH = (bf16*)(C.ws + WS_RHAT); float* PQ = (float*)(C.ws + WS_PQ); float* BON = (float*)(C.ws + WS_BON);
    const int lane = C.lane;
    LAS float* base = (LAS float*)(C.lds + C.wave * 12288);
    for (int it = C.bid; it < RW_NU / 8; it += C.G) {
        const int u = it * 8 + C.wave, bh = u >> 8, ch = u & 255, b = bh >> 2, h = bh & 3, m0 = b * SEQ + ch * RWC, hc = h * 64 + lane;
        const float kkw = C.in[I_RW_KK][l * 256 + hc], kaw = C.in[I_RW_KA][l * 256 + hc], rkw = C.in[I_RW_RK][l * 256 + hc], w0l = C.in[I_RW_W0][l * 256 + hc], a0l = C.in[I_RW_A0][l * 256 + hc];
        f32x2 sL[32], sI[32];
        { int ln = lane; asm volatile("" : "+v"(ln));
#pragma unroll
          for (int k = 0; k < 32; ++k) { sL[k] = (f32x2){0.f, 0.f}; sI[k].x = (2 * k == ln) ? 1.f : 0.f; sI[k].y = (2 * k + 1 == ln) ? 1.f : 0.f; } }
#pragma unroll 1
        for (int sb = 0; sb < RWC / 8; ++sb) {
            asm volatile("" ::: "memory");
#pragma unroll
            for (int i = 0; i < 8; ++i) { const size_t m = (size_t)(m0 + sb * 8 + i);
                const float r = bf2f(RKVS[m * 768 + hc]), k = bf2f(RKVS[m * 768 + 256 + hc]), v = bf2f(RKVS[m * 768 + 512 + hc]);
                const float w = __builtin_amdgcn_exp2f(-0.606531f * LOG2E * sigm(WDEC[m * 256 + hc] + w0l)), a = sigm(bf2f(AG[m * 512 + hc]) + a0l);
                const float kr = k * kkw; const float nn = sqrtf(wave_sum(kr * kr, C.lane)); const float kk = kr / fmaxf(nn, 1e-12f);
                const float kp = k * (1.f + (a - 1.f) * kaw);
                const float bon = wave_sum(r * kp * rkw, C.lane);
                if (lane == 0) BON[m * 4 + h] = bon;
                base[0 * 512 + i * 64 + lane] = w; base[1 * 512 + i * 64 + lane] = kk; base[2 * 512 + i * 64 + lane] = kk * a; base[3 * 512 + i * 64 + lane] = kp; base[4 * 512 + i * 64 + lane] = r; base[5 * 512 + i * 64 + lane] = v; }
            asm volatile("" ::: "memory");
#pragma unroll 1
            for (int i = 0; i < 8; ++i) {
                const LAS f32x4* wv = (const LAS f32x4*)(base + 0 * 512 + i * 64); const LAS f32x4* kkv = (const LAS f32x4*)(base + 1 * 512 + i * 64); const LAS f32x4* kav = (const LAS f32x4*)(base + 2 * 512 + i * 64);
                const LAS f32x4* kpv = (const LAS f32x4*)(base + 3 * 512 + i * 64); const LAS f32x4* rv = (const LAS f32x4*)(base + 4 * 512 + i * 64);
                const float vv = base[5 * 512 + i * 64 + lane];
                f32x4 kq[2][4];
#pragma unroll
                for (int t = 0; t < 4; ++t) kq[0][t] = kkv[t];
                f32x2 dL0 = (f32x2){0.f, 0.f}, dL1 = dL0, dI0 = dL0, dI1 = dL0;
                f32x4 ga[2][4];
#pragma unroll
                for (int g = 0; g < 4; ++g) {
                    __builtin_amdgcn_sched_barrier(0);
                    if (g + 1 < 4) {
#pragma unroll
                        for (int t = 0; t < 4; ++t) kq[(g + 1) & 1][t] = kkv[4 * (g + 1) + t]; }
                    else { ga[0][0] = wv[0]; ga[0][1] = kav[0]; ga[0][2] = kpv[0]; ga[0][3] = rv[0]; }
                    __builtin_amdgcn_sched_barrier(0);
#pragma unroll
                    for (int t = 0; t < 4; ++t) { const int k4 = 4 * g + t; const f32x4 q4 = kq[g & 1][t];
                        dL0 += sL[2 * k4] * q4.xy; dL1 += sL[2 * k4 + 1] * q4.zw; dI0 += sI[2 * k4] * q4.xy; dI1 += sI[2 * k4 + 1] * q4.zw; }
                }
                const float saL = -((dL0.x + dL0.y) + (dL1.x + dL1.y)), saI = -((dI0.x + dI0.y) + (dI1.x + dI1.y));
                const f32x2 saLv = (f32x2){saL, saL}, saIv = (f32x2){saI, saI}, vvv = (f32x2){vv, vv};
                f32x2 yL0 = (f32x2){0.f, 0.f}, yL1 = yL0, yI0 = yL0, yI1 = yL0;
#pragma unroll
                for (int k4 = 0; k4 < 16; ++k4) {
                    __builtin_amdgcn_sched_barrier(0);
                    if (k4 + 1 < 16) { ga[(k4 + 1) & 1][0] = wv[k4 + 1]; ga[(k4 + 1) & 1][1] = kav[k4 + 1]; ga[(k4 + 1) & 1][2] = kpv[k4 + 1]; ga[(k4 + 1) & 1][3] = rv[k4 + 1]; }
                    __builtin_amdgcn_sched_barrier(0);
                    const f32x4 wq = ga[k4 & 1][0], aq = ga[k4 & 1][1], pq = ga[k4 & 1][2], rq = ga[k4 & 1][3];
                    sL[2 * k4]     = sL[2 * k4]     * wq.xy + saLv * aq.xy + vvv * pq.xy; yL0 += sL[2 * k4]     * rq.xy;
                    sL[2 * k4 + 1] = sL[2 * k4 + 1] * wq.zw + saLv * aq.zw + vvv * pq.zw; yL1 += sL[2 * k4 + 1] * rq.zw;
                    sI[2 * k4]     = sI[2 * k4]     * wq.xy + saIv * aq.xy;                  yI0 += sI[2 * k4]     * rq.xy;
                    sI[2 * k4 + 1] = sI[2 * k4 + 1] * wq.zw + saIv * aq.zw;                  yI1 += sI[2 * k4 + 1] * rq.zw;
                }
                __builtin_amdgcn_sched_barrier(0);
                const size_t m = (size_t)(m0 + sb * 8 + i);
                Y0[m * 256 + hc] = f2bf((yL0.x + yL0.y) + (yL1.x + yL1.y));
                RH[m * 256 + hc] = f2bf((yI0.x + yI0.y) + (yI1.x + yI1.y));
            }
        }
        float* oq = PQ + (size_t)u * 4096 + lane * 64; float* opt = PQ + ((size_t)RW_NU + u) * 4096 + lane;
#pragma unroll
        for (int k4 = 0; k4 < 16; ++k4) { *(f32x4*)(oq + 4 * k4) = (f32x4){sL[2 * k4].x, sL[2 * k4].y, sL[2 * k4 + 1].x, sL[2 * k4 + 1].y};
            opt[(4 * k4) * 64] = sI[2 * k4].x; opt[(4 * k4 + 1) * 64] = sI[2 * k4].y; opt[(4 * k4 + 2) * 64] = sI[2 * k4 + 1].x; opt[(4 * k4 + 3) * 64] = sI[2 * k4 + 1].y; }
    }
}
constexpr int WY_LT = 24;
constexpr int WY_ROWM = 0, WY_COLM = 36864, WY_AMAT = 73728, WY_AABF = 89088, WY_SB = 93184, WY_WT = 111616, WY_UT = 117760, WY_GH = 123904, WY_GC = 125952;
__device__ __forceinline__ f32x4 wy_mm16(const LAS bf16* X, const LAS bf16* Y, f32x4 acc, int li, int lq) {
#pragma unroll
    for (int ks = 0; ks < 2; ++ks) { const bf16x8 a = *(const LAS bf16x8*)(X + li * MM_LP + 32 * ks + 8 * lq), b = *(const LAS bf16x8*)(Y + li * MM_LP + 32 * ks + 8 * lq);
        acc = __builtin_amdgcn_mfma_f32_16x16x32_bf16(a, b, acc, 0, 0, 0); }
    return acc;
}
__device__ __forceinline__ f32x4 wy_mm16k16(const LAS bf16* X, const LAS bf16* Y, f32x4 acc, int li, int lq) {
    const s16x4 a = *(const LAS s16x4*)(X + li * WY_LT + 4 * lq), b = *(const LAS s16x4*)(Y + li * WY_LT + 4 * lq);
    return __builtin_amdgcn_mfma_f32_16x16x16bf16_1k(a, b, acc, 0, 0, 0);
}
__device__ __forceinline__ void ph_rw_local_wy_(const Ctx& C, int l) {
    const bf16* RKVS = (const bf16*)(C.ws + WS_RKVS); const float* WDEC = (const float*)(C.ws + WS_WDEC); const bf16* AG = (const bf16*)(C.ws + WS_AG);
    bf16* Y0 = (bf16*)(C.ws + WS_Y0); bf16* RH = (bf16*)(C.ws + WS_RHAT); float* PQ = (float*)(C.ws + WS_PQ); float* BON = (float*)(C.ws + WS_BON);
    const int lane = C.lane, w = C.wave, li = lane & 15, lq = lane >> 4, j32 = lane & 31, hi = lane >> 5, ti = w >> 1, tj = w & 1, sq = w >> 1, half = w & 1;
    LAS unsigned char* L = C.lds;
#define WY_ROW(q, m) ((LAS bf16*)(L + WY_ROWM + (q) * 9216 + (m) * 2304))
#define WY_COL(q, m) ((LAS bf16*)(L + WY_COLM + (q) * 9216 + (m) * 3072))
#define WY_A(q, id)  ((LAS bf16*)(L + WY_AMAT + (q) * 3840 + (id) * 768))
    LAS bf16* SB = (LAS bf16*)(L + WY_SB); LAS bf16* WT = (LAS bf16*)(L + WY_WT); LAS bf16* UT = (LAS bf16*)(L + WY_UT);
    LAS float* GH = (LAS float*)(L + WY_GH); LAS float* GCs = (LAS float*)(L + WY_GC);
    for (int su = C.bid; su < RW_NSUP; su += C.G) {
    f32x16 S;
    bf16 r16[8], k16[8], v16[8], a16[8]; float wd[8];
#define WY_RAW(uu) do { const int u_ = (uu), bh_ = u_ >> 8, ch_ = u_ & 255; const size_t mb_ = (size_t)((bh_ >> 2) * SEQ + ch_ * RWC + 8 * w); const int hc_ = (bh_ & 3) * 64 + lane; _Pragma("unroll") for (int i = 0; i < 8; ++i) { const size_t m = mb_ + i; \
        r16[i] = RKVS[m * 768 + hc_]; k16[i] = RKVS[m * 768 + 256 + hc_]; v16[i] = RKVS[m * 768 + 512 + hc_]; wd[i] = WDEC[m * 256 + hc_]; a16[i] = AG[m * 512 + hc_]; } } while (0)
    WY_RAW(su * RW_SUP);
#pragma unroll 1
    for (int cc = 0; cc < RW_SUP; ++cc) {
        const int u = su * RW_SUP + cc;
        const int bh = u >> 8, ch = u & 255, b = bh >> 2, h = bh & 3, m0 = b * SEQ + ch * RWC, hc = h * 64 + lane;
        const float kkw = C.in[I_RW_KK][l * 256 + hc], kaw = C.in[I_RW_KA][l * 256 + hc], rkw = C.in[I_RW_RK][l * 256 + hc], w0l = C.in[I_RW_W0][l * 256 + hc], a0l = C.in[I_RW_A0][l * 256 + hc];
        { float wv[8], kk[8], ka[8], kp[8], rr[8], vv[8];
          float bon8[8], rf[8], kf[8], af[8], wf[8];
#pragma unroll
          for (int i = 0; i < 8; ++i) { rf[i] = bf2f(r16[i]); kf[i] = bf2f(k16[i]); vv[i] = bf2f(v16[i]); af[i] = bf2f(a16[i]); wf[i] = wd[i]; }
          if (cc + 1 < RW_SUP) WY_RAW(u + 1);
#pragma unroll
          for (int i = 0; i < 8; ++i) {
              const float r = rf[i], k = kf[i];
              wv[i] = __builtin_amdgcn_exp2f(-0.606531f * LOG2E * sigm(wf[i] + w0l)); const float a = sigm(af[i] + a0l);
              const float kr = k * kkw; kk[i] = kr * __builtin_amdgcn_rsqf(fmaxf(wave_sum(kr * kr, lane), 1e-24f));
              kp[i] = k * (1.f + (a - 1.f) * kaw); ka[i] = kk[i] * a; rr[i] = r;
              bon8[i] = wave_sum(r * kp[i] * rkw, lane); }
          if (lane == 0) {
#pragma unroll
              for (int i = 0; i < 8; ++i) BON[(size_t)(m0 + 8 * w + i) * 4 + h] = bon8[i]; }
          float cp[8]; cp[0] = wv[0];
#pragma unroll
          for (int i = 1; i < 8; ++i) cp[i] = cp[i - 1] * wv[i];
          GH[w * 64 + lane] = cp[7];
          __syncthreads();
          const float pre = half ? GH[(w - 1) * 64 + lane] : 1.f, gC = half ? pre * cp[7] : cp[7] * GH[(w + 1) * 64 + lane];
          if (!half) GCs[sq * 64 + lane] = gC;
#pragma unroll
          for (int i = 0; i < 8; ++i) { const int t = 8 * half + i; const float G = pre * cp[i], Gm1 = (i == 0) ? pre : pre * cp[i - 1], rG = __builtin_amdgcn_rcpf(G);
              WY_ROW(sq, 0)[t * MM_LP + lane] = f2bf(-kk[i] * Gm1); WY_ROW(sq, 1)[t * MM_LP + lane] = f2bf(ka[i] * rG); WY_ROW(sq, 2)[t * MM_LP + lane] = f2bf(kp[i] * rG); WY_ROW(sq, 3)[t * MM_LP + lane] = f2bf(rr[i] * G);
              WY_COL(sq, 0)[lane * WY_LT + t] = f2bf(ka[i] * rG * gC); WY_COL(sq, 1)[lane * WY_LT + t] = f2bf(kp[i] * rG * gC); WY_COL(sq, 2)[lane * WY_LT + t] = f2bf(vv[i]); } }
        __syncthreads();
#pragma unroll
        for (int pp = 0; pp < 2; ++pp) { const int id = 2 * half + pp;
            f32x4 acc = (f32x4){0.f, 0.f, 0.f, 0.f};
            acc = wy_mm16(WY_ROW(sq, half ? 3 : 0), WY_ROW(sq, pp ? 2 : 1), acc, li, lq);
#pragma unroll
            for (int r = 0; r < 4; ++r) { const int t = 4 * lq + r; const bool keep = half ? (li <= t) : (li < t); const float val = keep ? acc[r] : 0.f;
                WY_A(sq, id)[t * WY_LT + li] = f2bf(val); if (id == 0) ((LAS float*)(L + WY_AABF + sq * 1024))[t * 16 + li] = val; } }
        __syncthreads();
        if (w < 4) { const LAS float* Af = (const LAS float*)(L + WY_AABF + w * 1024); float Tc[16];
#pragma unroll
            for (int t = 0; t < 16; ++t) { float acc = (t == li) ? 1.f : 0.f;
#pragma unroll
                for (int s4 = 0; s4 < 4; ++s4) { if (4 * s4 < t) { const f32x4 a4 = *(const LAS f32x4*)(Af + t * 16 + 4 * s4);
                    if (4 * s4 + 0 < t) acc += a4.x * Tc[4 * s4 + 0]; if (4 * s4 + 1 < t) acc += a4.y * Tc[4 * s4 + 1]; if (4 * s4 + 2 < t) acc += a4.z * Tc[4 * s4 + 2]; if (4 * s4 + 3 < t) acc += a4.w * Tc[4 * s4 + 3]; } }
                Tc[t] = acc; WY_A(w, 4)[t * WY_LT + li] = f2bf(acc); } }
        if (cc == 0) {
#pragma unroll
            for (int r = 0; r < 4; ++r)
#pragma unroll
                for (int e = 0; e < 4; ++e) { const int row = 32 * ti + 8 * r + 4 * hi + e, col = 32 * tj + j32; S[4 * r + e] = (ti >= 2 && row - 64 == col) ? 1.f : 0.f; }
#pragma unroll
            for (int r = 0; r < 4; ++r)
#pragma unroll
                for (int e = 0; e < 4; ++e) SB[(32 * ti + 8 * r + 4 * hi + e) * MM_LP + 32 * tj + j32] = f2bf(S[4 * r + e]);
        }
        __syncthreads();
#pragma unroll 1
        for (int q = 0; q < 4; ++q) {
            f32x4 accW = (f32x4){0.f, 0.f, 0.f, 0.f}, accY = accW;
            accW = wy_mm16(WY_ROW(q, 0), SB + 16 * w * MM_LP, accW, li, lq);
            accY = wy_mm16(WY_ROW(q, 3), SB + 16 * w * MM_LP, accY, li, lq);
            if (w < 4) accW = wy_mm16k16(WY_A(q, 1), WY_COL(q, 2) + 16 * w * WY_LT, accW, li, lq);
            { u32x2 pk; pk.x = cvt_pk_bf16(accW[0], accW[1]); pk.y = cvt_pk_bf16(accW[2], accW[3]); *(LAS u32x2*)(WT + (16 * w + li) * WY_LT + 4 * lq) = pk; }
            asm volatile("s_waitcnt lgkmcnt(0)" ::: "memory");
            { f32x4 accU = (f32x4){0.f, 0.f, 0.f, 0.f}; accU = wy_mm16k16(WY_A(q, 4), WT + 16 * w * WY_LT, accU, li, lq);
              u32x2 pk; pk.x = cvt_pk_bf16(accU[0], accU[1]); pk.y = cvt_pk_bf16(accU[2], accU[3]); *(LAS u32x2*)(UT + (16 * w + li) * WY_LT + 4 * lq) = pk; }
            asm volatile("s_waitcnt lgkmcnt(0)" ::: "memory");
            accY = wy_mm16k16(WY_A(q, 2), UT + 16 * w * WY_LT, accY, li, lq);
            if (w < 4) accY = wy_mm16k16(WY_A(q, 3), WY_COL(q, 2) + 16 * w * WY_LT, accY, li, lq);
            { bf16* dst = (w < 4) ? Y0 : RH; const int colo = h * 64 + ((16 * w) & 63) + li;
#pragma unroll
              for (int r = 0; r < 4; ++r) dst[(size_t)(m0 + 16 * q + 4 * lq + r) * 256 + colo] = f2bf(accY[r]); }
            __syncthreads();
            { const float gc = GCs[q * 64 + 32 * tj + j32];
#pragma unroll
              for (int i = 0; i < 16; ++i) S[i] *= gc;
              const bf16x8 ua = *(const LAS bf16x8*)(UT + (32 * ti + j32) * WY_LT + 8 * hi), bb = *(const LAS bf16x8*)(WY_COL(q, 0) + (32 * tj + j32) * WY_LT + 8 * hi);
              S = __builtin_amdgcn_mfma_f32_32x32x16_bf16(ua, bb, S, 0, 0, 0);
              if (ti < 2) { const bf16x8 va = *(const LAS bf16x8*)(WY_COL(q, 2) + (32 * ti + j32) * WY_LT + 8 * hi), kb = *(const LAS bf16x8*)(WY_COL(q, 1) + (32 * tj + j32) * WY_LT + 8 * hi);
                  S = __builtin_amdgcn_mfma_f32_32x32x16_bf16(va, kb, S, 0, 0, 0); } }
            {
#pragma unroll
                for (int r = 0; r < 4; ++r)
#pragma unroll
                    for (int e = 0; e < 4; ++e) SB[(32 * ti + 8 * r + 4 * hi + e) * MM_LP + 32 * tj + j32] = f2bf(S[4 * r + e]);
                __syncthreads(); }
        }
        if (cc == RW_SUP - 1) {
        if (ti < 2) { float* o = PQ + (size_t)su * 4096 + (size_t)(32 * ti + 4 * hi) * 64 + 32 * tj + j32;
#pragma unroll
            for (int r = 0; r < 4; ++r)
#pragma unroll
                for (int e = 0; e < 4; ++e) o[(8 * r + e) * 64] = S[4 * r + e]; }
        else { float* o = PQ + ((size_t)RW_NSUP + su) * 4096 + (size_t)(32 * tj + j32) * 64 + 32 * (ti - 2) + 4 * hi;
#pragma unroll
            for (int r = 0; r < 4; ++r) *(f32x4*)(o + 8 * r) = (f32x4){S[4 * r], S[4 * r + 1], S[4 * r + 2], S[4 * r + 3]}; }
        }
        __syncthreads();
    }
    }
#undef WY_ROW
#undef WY_COL
#undef WY_A
#undef WY_RAW
}
__device__ __forceinline__ void ph_rw_scan_(const Ctx& C, int wg) {
    const float* Qg = (const float*)(C.ws + WS_PQ); const float* Pg = Qg + (size_t)RW_NSUP * 4096; float* SST = (float*)(C.ws + WS_SST);
    LAS bf16* PT = (LAS bf16*)(C.lds);
    LAS bf16* SLb = PT + 2 * 64 * MM_LP;
    LAS float* QL = (LAS float*)(C.lds + (2 * 64 * MM_LP + 2 * 16 * MM_LP) * 2);
    LAS float* SO = QL + 2 * 16 * 64;
    const int lane = C.lane, wave = C.wave, bh = wg >> 2, rq = wg & 3, ct = wave & 3, li = lane & 15, lq = lane >> 4;
    const bool mm = wave < 4;
    const size_t ubase = (size_t)bh * RW_NSC;
    const int lt = C.tid & 255;
    const int qrow = lt >> 4, qc4 = (lt & 15) * 4;
    constexpr int PD = 6;
    f32x4 pr[PD][4], qr[PD];
#define SC_P_PIECE(i) (lt + 256 * (i))
#define SC_PUT_P(buf, sx_) do { LAS bf16* d_ = PT + (buf) * (64 * MM_LP); _Pragma("unroll") for (int i_ = 0; i_ < 4; ++i_) { const int idx_ = SC_P_PIECE(i_), r_ = (idx_ * 4) >> 6, k_ = (idx_ * 4) & 63; u32x2 w_; \
        w_.x = cvt_pk_bf16(pr[sx_][i_].x, pr[sx_][i_].y); w_.y = cvt_pk_bf16(pr[sx_][i_].z, pr[sx_][i_].w); *(LAS u32x2*)(d_ + r_ * MM_LP + k_) = w_; } } while (0)
#define SC_LOAD(sx_, cc) do { const f32x4* p4_ = (const f32x4*)(Pg + (ubase + (cc)) * 4096); _Pragma("unroll") for (int i_ = 0; i_ < 4; ++i_) pr[sx_][i_] = p4_[SC_P_PIECE(i_)]; \
        qr[sx_] = *(const f32x4*)(Qg + (ubase + (cc)) * 4096 + (rq * 16 + qrow) * 64 + qc4); } while (0)
    if (mm) {
#pragma unroll
        for (int r = 0; r < 4; ++r) SLb[(4 * lq + r) * MM_LP + ct * 16 + li] = (bf16)0;
    } else {
        { float z0; asm volatile("v_mov_b32 %0, 0" : "=v"(z0));
          *(f32x4*)(SST + ubase * 4096 + (rq * 16 + qrow) * 64 + qc4) = (f32x4){z0, z0, z0, z0}; }
        SC_LOAD(0, 0); SC_PUT_P(0, 0); *(LAS f32x4*)(QL + qrow * 64 + qc4) = qr[0];
#pragma unroll
        for (int x = 0; x < PD; ++x) SC_LOAD(x, 1 + x);
    }
    __syncthreads();
#pragma unroll 1
    for (int c2 = 0; c2 < RW_NSC; c2 += PD) {
#pragma unroll
        for (int x = 0; x < PD; ++x) {
            const int c = c2 + x;
            if (c < RW_NSC) {
            if (mm) {
                const LAS bf16* Pc = PT + (c & 1) * (64 * MM_LP); const LAS bf16* Sc = SLb + (c & 1) * (16 * MM_LP); const LAS float* Qc = QL + (c & 1) * (16 * 64);
                LAS bf16* Sn = SLb + ((c + 1) & 1) * (16 * MM_LP); LAS float* So = SO + ((c + 1) & 1) * (16 * 64);
                bf16x8 af[2], bfr[2];
#pragma unroll
                for (int ks = 0; ks < 2; ++ks) { af[ks] = *(const LAS bf16x8*)(Sc + li * MM_LP + 32 * ks + 8 * lq); bfr[ks] = *(const LAS bf16x8*)(Pc + (16 * ct + li) * MM_LP + 32 * ks + 8 * lq); }
                f32x4 acc;
#pragma unroll
                for (int r = 0; r < 4; ++r) acc[r] = Qc[(4 * lq + r) * 64 + ct * 16 + li];
#pragma unroll
                for (int ks = 0; ks < 2; ++ks) acc = __builtin_amdgcn_mfma_f32_16x16x32_bf16(af[ks], bfr[ks], acc, 0, 0, 0);
                if (c + 1 < RW_NSC) {
#pragma unroll
                    for (int r = 0; r < 4; ++r) { Sn[(4 * lq + r) * MM_LP + ct * 16 + li] = f2bf(acc[r]); So[(4 * lq + r) * 64 + ct * 16 + li] = acc[r]; } }
            } else {
                if (c > 0) *(f32x4*)(SST + (ubase + c) * 4096 + (rq * 16 + qrow) * 64 + qc4) = *(const LAS f32x4*)(SO + (c & 1) * (16 * 64) + qrow * 64 + qc4);
                if (c + 1 < RW_NSC) { SC_PUT_P((c + 1) & 1, x); *(LAS f32x4*)(QL + ((c + 1) & 1) * (16 * 64) + qrow * 64 + qc4) = qr[x]; }
                if (c + 1 + PD < RW_NSC) SC_LOAD(x, c + 1 + PD);
            }
            __syncthreads();
#ifdef SCAN_2BAR
            __syncthreads();
#endif
            }
        }
    }
#undef SC_PUT_P
#undef SC_LOAD
#undef SC_P_PIECE
}
__device__ __forceinline__ void ph_rw_out_(const Ctx& C, int l) {
    const bf16* RKVS = (const bf16*)(C.ws + WS_RKVS); const bf16* AG = (const bf16*)(C.ws + WS_AG); const bf16* Y0 = (const bf16*)(C.ws + WS_Y0); const bf16* RH = (const bf16*)(C.ws + WS_RHAT);
    const float* SST = (const float*)(C.ws + WS_SST); const float* BON = (const float*)(C.ws + WS_BON); bf16* Y = (bf16*)(C.ws + WS_Y);
    LAS float* RL = (LAS float*)(C.lds);
    const int lane = C.lane, wave = C.wave;
    for (int u = C.bid; u < RW_NU; u += C.G) {
        const int bh = u >> 8, ch = u & 255, b = bh >> 2, h = bh & 3, m0 = b * SEQ + ch * RWC, hc = h * 64 + lane;
        { const int t = C.tid >> 3, d0 = (C.tid & 7) * 8; float a[8];
          unpack8(*(const u32x4*)(RH + (size_t)(m0 + t) * 256 + h * 64 + d0), a);
#pragma unroll
          for (int e = 0; e < 8; ++e) RL[t * 64 + d0 + e] = a[e]; }
        float s[64];
        { const f32x4* sp = (const f32x4*)(SST + (size_t)u * 4096 + lane * 64);
#pragma unroll
          for (int k4 = 0; k4 < 16; ++k4) { const f32x4 v = sp[k4]; s[4 * k4] = v.x; s[4 * k4 + 1] = v.y; s[4 * k4 + 2] = v.z; s[4 * k4 + 3] = v.w; } }
        const float lnw = C.in[I_RW_LNW][l * 256 + hc], lnb = C.in[I_RW_LNB][l * 256 + hc];
        __syncthreads();
#pragma unroll 2
        for (int q = 0; q < 8; ++q) { const int t = wave * 8 + q; const size_t m = (size_t)(m0 + t);
            const LAS f32x4* rv = (const LAS f32x4*)(RL + t * 64);
            float y0 = 0.f, y1 = 0.f, y2 = 0.f, y3 = 0.f;
#pragma unroll
            for (int k4 = 0; k4 < 16; ++k4) { const f32x4 rq = rv[k4]; y0 += s[4 * k4] * rq.x; y1 += s[4 * k4 + 1] * rq.y; y2 += s[4 * k4 + 2] * rq.z; y3 += s[4 * k4 + 3] * rq.w; }
#ifndef RWDBG
#define RWDBG 0
#endif
            float y = ((RWDBG & 1) ? 0.f : (y0 + y1) + (y2 + y3)) + ((RWDBG & 2) ? 0.f : bf2f(Y0[m * 256 + hc]));
            const float mean = wave_sum(y, C.lane) * (1.f / 64.f); y -= mean;
            const float rstd = 1.0f / sqrtf(wave_sum(y * y, C.lane) * (1.f / 64.f) + 64e-5f);
            y = y * rstd * lnw + lnb;
            if (!(RWDBG & 4)) y += BON[m * 4 + h] * bf2f(RKVS[m * 768 + 512 + hc]);
            y *= bf2f(AG[m * 512 + 256 + hc]);
            if (RWDBG & 120) { y = 0.f; if (RWDBG & 8) y += ((const float*)(C.ws + WS_WDEC))[m * 256 + hc]; if (RWDBG & 16) y += bf2f(AG[m * 512 + hc]);
                if (RWDBG & 32) y += bf2f(RKVS[m * 768 + hc]) + bf2f(RKVS[m * 768 + 256 + hc]) + bf2f(RKVS[m * 768 + 512 + hc]); if (RWDBG & 64) y += BON[m * 4 + h]; }
            Y[m * 1024 + hc] = f2bf(y); }
        __syncthreads();
    }
}

constexpr int SB_VLD = 40;
__device__ __forceinline__ void ph_sb_attn_(const Ctx& C, int first_wg, int nwg, unsigned* qhead = nullptr) {
    const bf16* SB = (const bf16*)(C.ws + WS_SB); bf16* Y = (bf16*)(C.ws + WS_Y);
    const int lane = C.lane, j = lane & 31, hi = lane >> 5;
    LAS bf16* VT = (LAS bf16*)(C.lds + C.wave * (64 * SB_VLD * 2));
    for (int it = qhead ? q_next(C, qhead) : C.bid - first_wg; it < 512; it = qhead ? q_next(C, qhead) : it + nwg) {
        const int bh = it >> 6, b = bh >> 2, h = bh & 3, t0 = (it & 63) * 256 + C.wave * 32; const size_t mb = (size_t)b * SEQ;
        bf16x8 qf[4];
#pragma unroll
        for (int ks = 0; ks < 4; ++ks) qf[ks] = *(const bf16x8*)(SB + (mb + t0 + j) * 768 + h * 64 + 16 * ks + 8 * hi);
        f32x16 o0, o1;
#pragma unroll
        for (int i = 0; i < 16; ++i) { o0[i] = 0.f; o1[i] = 0.f; }
        float acc = 0.f;
#pragma unroll 1
        for (int kt = t0; kt >= 0; kt -= 32) {
            bf16x8 kf[4];
#pragma unroll
            for (int ks = 0; ks < 4; ++ks) kf[ks] = *(const bf16x8*)(SB + (mb + kt + j) * 768 + 256 + h * 64 + 16 * ks + 8 * hi);
            u32x4 vv[4];
#pragma unroll
            for (int i = 0; i < 4; ++i) { const int c = lane + 64 * i; vv[i] = *(const u32x4*)(SB + (mb + kt + (c >> 3)) * 768 + 512 + h * 64 + (c & 7) * 8); }
            f32x16 sc;
#pragma unroll
            for (int i = 0; i < 16; ++i) sc[i] = 0.f;
#pragma unroll
            for (int ks = 0; ks < 4; ++ks) sc = __builtin_amdgcn_mfma_f32_32x32x16_bf16(kf[ks], qf[ks], sc, 0, 0, 0);
#pragma unroll
            for (int i = 0; i < 4; ++i) { const int c = lane + 64 * i, key = c >> 3, d8 = (c & 7) * 8; const unsigned w[4] = {vv[i].x, vv[i].y, vv[i].z, vv[i].w};
#pragma unroll
                for (int e = 0; e < 4; ++e) { VT[(d8 + 2 * e) * SB_VLD + key] = (bf16)(w[e] & 0xffffu); VT[(d8 + 2 * e + 1) * SB_VLD + key] = (bf16)(w[e] >> 16); } }
            const bool diag = (kt == t0);
            float ls[16], g[4], og[4];
#pragma unroll
            for (int r = 0; r < 4; ++r) { g[r] = 0.f;
#pragma unroll
                for (int e = 0; e < 4; ++e) { const float z = sc[4 * r + e]; const bool valid = !diag || (8 * r + 4 * hi + e) < j;
                    const float l = (z > 40.f) ? -z : -__builtin_amdgcn_logf(1.f + __builtin_amdgcn_exp2f(z));
                    ls[4 * r + e] = valid ? l : 0.f; g[r] += ls[4 * r + e]; } }
#pragma unroll
            for (int r = 0; r < 4; ++r) og[r] = shx(g[r], 32, lane);
            float pw[16]; float run = acc;
#pragma unroll
            for (int r = 3; r >= 0; --r) { float cum = run + (hi == 0 ? og[r] : 0.f);
#pragma unroll
                for (int e = 3; e >= 0; --e) { cum += ls[4 * r + e]; const bool valid = !diag || (8 * r + 4 * hi + e) < j;
                    pw[4 * r + e] = valid ? __builtin_amdgcn_exp2f(sc[4 * r + e] + cum) : 0.f; }
                run += g[r] + og[r]; }
            acc = run;
            asm volatile("" ::: "memory");
#pragma unroll
            for (int ks = 0; ks < 2; ++ks) {
                u32x4 pk; pk.x = cvt_pk_bf16(pw[8 * ks], pw[8 * ks + 1]); pk.y = cvt_pk_bf16(pw[8 * ks + 2], pw[8 * ks + 3]); pk.z = cvt_pk_bf16(pw[8 * ks + 4], pw[8 * ks + 5]); pk.w = cvt_pk_bf16(pw[8 * ks + 6], pw[8 * ks + 7]);
                const bf16x8 pb = __builtin_bit_cast(bf16x8, pk);
                const s16x4 a0l = *(const LAS s16x4*)(VT + j * SB_VLD + 16 * ks + 4 * hi), a0h = *(const LAS s16x4*)(VT + j * SB_VLD + 16 * ks + 8 + 4 * hi);
                const s16x4 a1l = *(const LAS s16x4*)(VT + (32 + j) * SB_VLD + 16 * ks + 4 * hi), a1h = *(const LAS s16x4*)(VT + (32 + j) * SB_VLD + 16 * ks + 8 + 4 * hi);
                const bf16x8 va0 = __builtin_shufflevector(a0l, a0h, 0, 1, 2, 3, 4, 5, 6, 7), va1 = __builtin_shufflevector(a1l, a1h, 0, 1, 2, 3, 4, 5, 6, 7);
                o0 = __builtin_amdgcn_mfma_f32_32x32x16_bf16(va0, pb, o0, 0, 0, 0);
                o1 = __builtin_amdgcn_mfma_f32_32x32x16_bf16(va1, pb, o1, 0, 0, 0);
            }
            asm volatile("" ::: "memory");
            if (__builtin_amdgcn_ballot_w64(acc > -140.f) == 0ull) break;
        }
        bf16* yp = Y + (mb + t0 + j) * 1024 + 256 + h * 64 + 4 * hi;
#pragma unroll
        for (int r = 0; r < 4; ++r) { u32x2 w0, w1; w0.x = cvt_pk_bf16(o0[4 * r], o0[4 * r + 1]); w0.y = cvt_pk_bf16(o0[4 * r + 2], o0[4 * r + 3]); w1.x = cvt_pk_bf16(o1[4 * r], o1[4 * r + 1]); w1.y = cvt_pk_bf16(o1[4 * r + 2], o1[4 * r + 3]);
            *(u32x2*)(yp + 8 * r) = w0; *(u32x2*)(yp + 32 + 8 * r) = w1; }
    }
}


__device__ __forceinline__ f32x16 mm_tile(const LAS bf16* X, const LAS bf16* Y, int ti, int tj, int lane) {
    const int j = lane & 31, hi = lane >> 5; f32x16 acc;
#pragma unroll
    for (int i = 0; i < 16; ++i) acc[i] = 0.f;
#pragma unroll
    for (int ks = 0; ks < 4; ++ks) { const bf16x8 a = *(const LAS bf16x8*)(X + (32 * ti + j) * MM_LP + 16 * ks + 8 * hi), b = *(const LAS bf16x8*)(Y + (32 * tj + j) * MM_LP + 16 * ks + 8 * hi);
        acc = __builtin_amdgcn_mfma_f32_32x32x16_bf16(a, b, acc, 0, 0, 0); }
    return acc;
}
__device__ __forceinline__ void ln_pair_stats(const f32x16& x, LAS float* XCH, int tr, int tt, int lane, float eps, float& mean, float& rstd) {
    const int j = lane & 31, hi = lane >> 5; float s1 = 0.f, s2 = 0.f;
#pragma unroll
    for (int i = 0; i < 16; ++i) { s1 += x[i]; s2 += x[i] * x[i]; }
    s1 += shx(s1, 32, lane); s2 += shx(s2, 32, lane);
    if (hi == 0) { XCH[(tr * 64 + 32 * tt + j) * 2] = s1; XCH[(tr * 64 + 32 * tt + j) * 2 + 1] = s2; }
    __syncthreads();
    const float a1 = XCH[(32 * tt + j) * 2] + XCH[(64 + 32 * tt + j) * 2], a2 = XCH[(32 * tt + j) * 2 + 1] + XCH[(64 + 32 * tt + j) * 2 + 1];
    mean = a1 * (1.f / 64.f); const float var = fmaxf(a2 * (1.f / 64.f) - mean * mean, 0.f); rstd = 1.0f / sqrtf(var + eps);
}
__device__ __forceinline__ void rot_store(const Ctx& C, const bf16* src  , int pos, int d0, float scale, LAS bf16* dstrow) {
    const float* cs = (const float*)(C.ws + WS_COS) + (size_t)pos * 32 + d0; const float* sn = (const float*)(C.ws + WS_SIN) + (size_t)pos * 32 + d0;
    float x1[8], x2[8]; unpack8(*(const u32x4*)(src + d0), x1); unpack8(*(const u32x4*)(src + 32 + d0), x2);
    const f32x4 c0 = *(const f32x4*)cs, c1 = *(const f32x4*)(cs + 4), s0 = *(const f32x4*)sn, s1 = *(const f32x4*)(sn + 4);
    const float cc[8] = {c0.x, c0.y, c0.z, c0.w, c1.x, c1.y, c1.z, c1.w}, ss[8] = {s0.x, s0.y, s0.z, s0.w, s1.x, s1.y, s1.z, s1.w};
    float o1[8], o2[8];
#pragma unroll
    for (int e = 0; e < 8; ++e) { o1[e] = (x1[e] * cc[e] - x2[e] * ss[e]) * scale; o2[e] = (x1[e] * ss[e] + x2[e] * cc[e]) * scale; }
    *(LAS u32x4*)(dstrow + d0) = pack8(o1); *(LAS u32x4*)(dstrow + 32 + d0) = pack8(o2);
}

__device__ __forceinline__ void ph_ret_kv2_(const Ctx& C) {
    const bf16* RET = (const bf16*)(C.ws + WS_RET); float* KV = (float*)(C.ws + WS_KV);
    const int half = C.wave >> 2, w4 = C.wave & 3, th = C.tid & 255, lane = C.lane;
    LAS bf16* KT = (LAS bf16*)(C.lds + half * 36864);
    LAS bf16* VT = KT + 64 * MM_LP;
    LAS bf16* KR = VT + 64 * MM_LP;
    for (int it = C.bid; it < 1024; it += C.G) {
        const int u = it * 2 + half, bh = u >> 8, ch = u & 255, b = bh >> 2, h = bh & 3, m0 = b * SEQ + ch * 64;
        const float lg = ret_log2gamma(h);
        { const int srow = th >> 2, dq = th & 3; const size_t m = (size_t)(m0 + srow);
          rot_store(C, RET + m * 1024 + 256 + h * 64, (int)(m & (SEQ - 1)), dq * 8, 0.125f * exp2f(lg * (float)(63 - srow)), KR + srow * MM_LP);
          float a[8];
#pragma unroll
          for (int q = 0; q < 2; ++q) { const int e0 = dq * 16 + q * 8; unpack8(*(const u32x4*)(RET + m * 1024 + 512 + h * 64 + e0), a);
#pragma unroll
              for (int e = 0; e < 8; ++e) VT[(e0 + e) * MM_LP + srow] = f2bf(a[e]); } }
        __syncthreads();
        { const int d = th >> 2, s0 = (th & 3) * 16;
#pragma unroll
          for (int i = 0; i < 16; ++i) KT[d * MM_LP + s0 + i] = KR[(s0 + i) * MM_LP + d]; }
        __syncthreads();
        { const int ti = w4 >> 1, tj = w4 & 1, j = lane & 31, hi = lane >> 5;
          const f32x16 acc = mm_tile(VT, KT, ti, tj, lane);
          float* o = KV + (size_t)u * 4096 + (size_t)(32 * ti + 4 * hi) * 64 + 32 * tj + j;
#pragma unroll
          for (int r = 0; r < 4; ++r)
#pragma unroll
              for (int e = 0; e < 4; ++e) o[(8 * r + e) * 64] = acc[4 * r + e]; }
        __syncthreads();
    }
}
__device__ __forceinline__ void ph_ret_out2_(const Ctx& C, int l, int first_wg, int nwg, unsigned* qhead = nullptr) {
    const bf16* RET = (const bf16*)(C.ws + WS_RET); const float* KV = (const float*)(C.ws + WS_KV); bf16* Y = (bf16*)(C.ws + WS_Y);
    const int half = C.wave >> 2, w4 = C.wave & 3, th = C.tid & 255, lane = C.lane, j = lane & 31, hi = lane >> 5, te = w4 >> 1, tt = w4 & 1;
    LAS bf16* QL = (LAS bf16*)(C.lds + half * 40960);
    LAS bf16* KL = QL + 64 * MM_LP;
    LAS bf16* VT = KL + 64 * MM_LP;
    LAS bf16* ST = VT + 64 * MM_LP;
    LAS float* XCH = (LAS float*)(C.lds + half * 40960 + 4 * 64 * MM_LP * 2);
    const float* gn = C.in[I_RET_GN] + (size_t)l * 256;
    for (int it = qhead ? q_next(C, qhead) : C.bid - first_wg; it < 1024; it = qhead ? q_next(C, qhead) : it + nwg) {
        const int u = it * 2 + half, bh = u >> 8, ch = u & 255, b = bh >> 2, h = bh & 3, m0 = b * SEQ + ch * 64;
        const float lg = ret_log2gamma(h);
        { const int srow = th >> 2, dq = th & 3; const size_t m = (size_t)(m0 + srow); const int pos = (int)(m & (SEQ - 1));
          rot_store(C, RET + m * 1024 + h * 64, pos, dq * 8, 1.0f, QL + srow * MM_LP);
          rot_store(C, RET + m * 1024 + 256 + h * 64, pos, dq * 8, 0.125f, KL + srow * MM_LP);
          float a[8];
#pragma unroll
          for (int q = 0; q < 2; ++q) { const int e0 = dq * 16 + q * 8; unpack8(*(const u32x4*)(RET + m * 1024 + 512 + h * 64 + e0), a);
#pragma unroll
              for (int e = 0; e < 8; ++e) VT[(e0 + e) * MM_LP + srow] = f2bf(a[e]); }
          const float* sp = KV + (size_t)u * 4096 + srow * 64 + dq * 16;
          float sv[16];
#pragma unroll
          for (int q = 0; q < 4; ++q) { const f32x4 v4 = *(const f32x4*)(sp + 4 * q); sv[4 * q] = v4.x; sv[4 * q + 1] = v4.y; sv[4 * q + 2] = v4.z; sv[4 * q + 3] = v4.w; }
          *(LAS u32x4*)(ST + srow * MM_LP + dq * 16) = pack8(sv); *(LAS u32x4*)(ST + srow * MM_LP + dq * 16 + 8) = pack8(sv + 8); }
        __syncthreads();
        f32x16 acc = mm_tile(ST, QL, te, tt, lane);
        { const float qd = exp2f(lg * (float)(32 * tt + j + 1));
#pragma unroll
          for (int i = 0; i < 16; ++i) acc[i] *= qd; }
#pragma unroll
        for (int st = 0; st < 2; ++st) {
            if (st > tt) continue;
            const f32x16 sc = mm_tile(KL, QL, st, tt, lane);
            float pw[16];
#pragma unroll
            for (int r = 0; r < 4; ++r)
#pragma unroll
                for (int e = 0; e < 4; ++e) { const int sk = 32 * st + 8 * r + 4 * hi + e, tq = 32 * tt + j;
                    pw[4 * r + e] = (sk <= tq) ? sc[4 * r + e] * exp2f(lg * (float)(tq - sk)) : 0.f; }
#pragma unroll
            for (int ks = 0; ks < 2; ++ks) {
                u32x4 pk; pk.x = cvt_pk_bf16(pw[8 * ks], pw[8 * ks + 1]); pk.y = cvt_pk_bf16(pw[8 * ks + 2], pw[8 * ks + 3]); pk.z = cvt_pk_bf16(pw[8 * ks + 4], pw[8 * ks + 5]); pk.w = cvt_pk_bf16(pw[8 * ks + 6], pw[8 * ks + 7]);
                const bf16x8 pb = __builtin_bit_cast(bf16x8, pk);
                const LAS bf16* vr = VT + (32 * te + j) * MM_LP + 32 * st + 16 * ks + 4 * hi;
                const s16x4 al = *(const LAS s16x4*)vr, ah = *(const LAS s16x4*)(vr + 8);
                const bf16x8 va = __builtin_shufflevector(al, ah, 0, 1, 2, 3, 4, 5, 6, 7);
                acc = __builtin_amdgcn_mfma_f32_32x32x16_bf16(va, pb, acc, 0, 0, 0);
            }
        }
        float mean, rstd; ln_pair_stats(acc, XCH, te, tt, lane, 1e-5f, mean, rstd);
        { const size_t m = (size_t)(m0 + 32 * tt + j); const bf16* gp = RET + m * 1024 + 768 + h * 64 + 32 * te + 4 * hi; bf16* yp = Y + m * 1024 + 512 + h * 64 + 32 * te + 4 * hi;
          const float* gw = gn + h * 64 + 32 * te + 4 * hi;
#pragma unroll
          for (int r = 0; r < 4; ++r) { const u32x2 gt2 = *(const u32x2*)(gp + 8 * r); const float gtv[4] = {bflo(gt2.x), bfhi(gt2.x), bflo(gt2.y), bfhi(gt2.y)}; const f32x4 gwv = *(const f32x4*)(gw + 8 * r);
              float o[4];
#pragma unroll
              for (int e = 0; e < 4; ++e) o[e] = (acc[4 * r + e] - mean) * rstd * gwv[e] * (gtv[e] * sigm(gtv[e]));
              u32x2 w; w.x = cvt_pk_bf16(o[0], o[1]); w.y = cvt_pk_bf16(o[2], o[3]); *(u32x2*)(yp + 8 * r) = w; } }
        __syncthreads();
    }
}
__device__ __forceinline__ void ph_rw_out2_(const Ctx& C, int l) {
    const bf16* RKVS = (const bf16*)(C.ws + WS_RKVS); const bf16* AG = (const bf16*)(C.ws + WS_AG); const bf16* Y0 = (const bf16*)(C.ws + WS_Y0); const bf16* RH = (const bf16*)(C.ws + WS_RHAT);
    const float* SST = (const float*)(C.ws + WS_SST); const float* BON = (const float*)(C.ws + WS_BON); bf16* Y = (bf16*)(C.ws + WS_Y);
    const int half = C.wave >> 2, w4 = C.wave & 3, th = C.tid & 255, lane = C.lane, j = lane & 31, hi = lane >> 5, tv = w4 >> 1, tt = w4 & 1;
    LAS bf16* SL = (LAS bf16*)(C.lds + half * 20480);
    LAS bf16* RL = SL + 64 * MM_LP;
    LAS float* XCH = (LAS float*)(C.lds + half * 20480 + 2 * 64 * MM_LP * 2);
    for (int it = C.bid; it < RW_NU / 2; it += C.G) {
        const int u = it * 2 + half, bh = u >> 8, ch = u & 255, b = bh >> 2, h = bh & 3, m0 = b * SEQ + ch * RWC;
        { const int row = th >> 2, q4 = th & 3;
          const float* sp = SST + (size_t)(u >> 3) * 4096 + row * 64 + q4 * 16; float sv[16];
#pragma unroll
          for (int q = 0; q < 4; ++q) { const f32x4 v4 = *(const f32x4*)(sp + 4 * q); sv[4 * q] = v4.x; sv[4 * q + 1] = v4.y; sv[4 * q + 2] = v4.z; sv[4 * q + 3] = v4.w; }
          *(LAS u32x4*)(SL + row * MM_LP + q4 * 16) = pack8(sv); *(LAS u32x4*)(SL + row * MM_LP + q4 * 16 + 8) = pack8(sv + 8);
          const u32x4* rp = (const u32x4*)(RH + (size_t)(m0 + row) * 256 + h * 64 + q4 * 16);
          *(LAS u32x4*)(RL + row * MM_LP + q4 * 16) = rp[0]; *(LAS u32x4*)(RL + row * MM_LP + q4 * 16 + 8) = rp[1]; }
        __syncthreads();
        f32x16 acc = mm_tile(SL, RL, tv, tt, lane);
        const size_t m = (size_t)(m0 + 32 * tt + j); const int vb = h * 64 + 32 * tv + 4 * hi;
#pragma unroll
        for (int r = 0; r < 4; ++r) { const u32x2 y2 = *(const u32x2*)(Y0 + m * 256 + vb + 8 * r); acc[4 * r] += bflo(y2.x); acc[4 * r + 1] += bfhi(y2.x); acc[4 * r + 2] += bflo(y2.y); acc[4 * r + 3] += bfhi(y2.y); }
        float mean, rstd; ln_pair_stats(acc, XCH, tv, tt, lane, 64e-5f, mean, rstd);
        const float bon = BON[m * 4 + h];
#pragma unroll
        for (int r = 0; r < 4; ++r) { const int vc = vb + 8 * r;
            const f32x4 lw = *(const f32x4*)(C.in[I_RW_LNW] + (size_t)l * 256 + vc), lb = *(const f32x4*)(C.in[I_RW_LNB] + (size_t)l * 256 + vc);
            const u32x2 v2 = *(const u32x2*)(RKVS + m * 768 + 512 + vc), g2 = *(const u32x2*)(AG + m * 512 + 256 + vc);
            const float vv[4] = {bflo(v2.x), bfhi(v2.x), bflo(v2.y), bfhi(v2.y)}, gg[4] = {bflo(g2.x), bfhi(g2.x), bflo(g2.y), bfhi(g2.y)};
            float o[4];
#pragma unroll
            for (int e = 0; e < 4; ++e) o[e] = ((acc[4 * r + e] - mean) * rstd * lw[e] + lb[e] + bon * vv[e]) * gg[e];
            u32x2 w; w.x = cvt_pk_bf16(o[0], o[1]); w.y = cvt_pk_bf16(o[2], o[3]); *(u32x2*)(Y + m * 1024 + vc) = w; }
        __syncthreads();
    }
}

__device__ __forceinline__ void ph_moe_scatter_(const Ctx& C, int moe_idx) {
    unsigned* cw = (unsigned*)(C.ws + WS_CTL) + CW_MOE + moe_idx * 64;
    const int* eidx = (const int*)(C.ws + WS_EIDX); const float* gate = (const float*)(C.ws + WS_GATE);
    int* rowtok = (int*)(C.ws + WS_ROWTOK); float* rowgate = (float*)(C.ws + WS_ROWGATE); int* texp = (int*)(C.ws + WS_TEXP); int* segend = (int*)(C.ws + WS_SEGEND); int* ntp = (int*)(C.ws + WS_NT);
    bf16* XS = (bf16*)(C.ws + WS_XS);
    LAS unsigned* lcnt = (LAS unsigned*)(C.lds); LAS unsigned* lbase = lcnt + 8; LAS int* sl = (LAS int*)(C.lds + 256);
    int cnt[8], segb[8]; int tot = 0;
#pragma unroll
    for (int e = 0; e < 8; ++e) { cnt[e] = (int)__hip_atomic_load(&cw[e], __ATOMIC_RELAXED, __HIP_MEMORY_SCOPE_AGENT); segb[e] = tot; tot += (cnt[e] + 255) & ~255; }
    if (C.bid == 0) {
        if (C.tid < 8) { const int e = C.tid; int sb = 0, ce = 0;
#pragma unroll
            for (int q = 0; q < 8; ++q) if (q == e) { sb = segb[q]; ce = cnt[q]; }
            for (int pm = sb >> 8; pm < ((sb + ((ce + 255) & ~255)) >> 8); ++pm) { texp[pm] = e; segend[pm] = sb + ce; } }
        if (C.tid == 0) *ntp = tot >> 8;
    }
    for (int blk = C.bid; blk < T / 256; blk += C.G) {
        __syncthreads();
        if (C.tid < 8) lcnt[C.tid] = 0u;
        __syncthreads();
        const int a = blk * 512 + C.tid, e = eidx[a];
        const unsigned rank = atomicAdd((unsigned*)&lcnt[e], 1u);
        __syncthreads();
        if (C.tid < 8) lbase[C.tid] = atomicAdd(&cw[16 + C.tid], lcnt[C.tid]);
        __syncthreads();
        int sb = 0;
#pragma unroll
        for (int q = 0; q < 8; ++q) if (q == e) sb = segb[q];
        const int slot = sb + (int)lbase[e] + (int)rank;
        rowtok[slot] = a >> 1; rowgate[slot] = gate[a]; sl[C.tid] = slot; ((int*)(C.ws + WS_SLOTOF))[a] = slot;
        __syncthreads();
#pragma unroll 1
        for (int i0 = C.wave; i0 < 512; i0 += 8 * NWAVES) { u32x4 rowv[8];
#pragma unroll
            for (int j = 0; j < 8; ++j) { const int i = i0 + j * NWAVES; rowv[j] = ((const u32x4*)(C.ws + WS_H8 + (size_t)(blk * 256 + (i >> 1)) * D))[C.lane]; }
#pragma unroll
            for (int j = 0; j < 8; ++j) { const int i = i0 + j * NWAVES; ((u32x4*)(C.ws + WS_XS + (size_t)sl[i] * D))[C.lane] = rowv[j]; } }
    }
}

__device__ __forceinline__ void grid_barrier(int wv) {
    const Ctx C = make_ctx(wv);
    XcdBarrier b; b.bar = (unsigned*)(C.ws + WS_CTL) + CW_BAR; b.x = xb_xcc_id(); b.st = (volatile LAS unsigned*)(C.lds + MISC_OFF) + 8;
    xcd_barrier(b, C.tid);
}
__device__ __forceinline__ void P_prologue(int wv) { const Ctx C = make_ctx(wv); ph_prologue_(C); }
__device__ __forceinline__ void P_weights_norm(int wv, int l) { const Ctx C = make_ctx(wv); ph_weights_(C, l, 0, 0, C.G); __syncthreads(); ph_norm_(C, C.in[I_NORM_MIX] + (size_t)l * D, false, nullptr, 0,  (l > 0) && ((l - 1) & 1), l == 0 ? C.in[I_X] : nullptr); }
__device__ __forceinline__ void P_gemm_in(int wv) { const Ctx C = make_ctx(wv); using namespace pg8; unsigned char* ws = C.ws;
    Gemm g{(const bf16*)C.out, (const bf16*)(ws + WS_WIN), D, D}; StaticOrder S; S.init(T, NIN, C.G, C.bid);
    EpiRoute E{(bf16*)(ws + WS_RW), (bf16*)(ws + WS_SB), (bf16*)(ws + WS_RET), (bf16*)(ws + WS_CV)};
    gemm_phase<EpiRoute, StaticOrder, true, 1>(C.lds, C.tid, g, S, E); }
#define REP2(bit, stmt) do { stmt; if constexpr ((PROBE2 >> (bit)) & 1) { __syncthreads(); stmt; } } while (0)
__device__ __forceinline__ void P_mix1(int wv, int l) { REP2(2, { const Ctx C = make_ctx(wv); ph_rw_prep_(C, l); }); { const Ctx C = make_ctx(wv); ph_sb_prep_(C, l); } REP2(3, { const Ctx C = make_ctx(wv); ph_conv_(C, l); }); REP2(4, { const Ctx C = make_ctx(wv); ph_ret_kv2_(C); }); }
__device__ __forceinline__ void P_mix2(int wv, int l) { { const Ctx C = make_ctx(wv); using namespace pg8; unsigned char* ws = C.ws;
    Gemm g{(const bf16*)(ws + WS_ALORA), (const bf16*)(ws + WS_WLORA), 256, 256}; StaticOrder S; S.init(T, 768, C.G, C.bid);
    EpiLora E{(float*)(ws + WS_WDEC), (bf16*)(ws + WS_AG), C.in[I_RW_W0] + (size_t)l * 256, C.in[I_RW_A0] + (size_t)l * 256};
    gemm_phase<EpiLora, StaticOrder, true>(C.lds, C.tid, g, S, E); }
    { const Ctx C = make_ctx(wv); ph_ret_scan_(C); } }
#ifndef MIX3_SEL
#define MIX3_SEL 3
#endif
__device__ __forceinline__ void P_mix3(int wv, int l) { REP2(0, { const Ctx C = make_ctx(wv); ph_rw_local_wy_(C, l); }); }
__device__ __forceinline__ void P_mix4(int wv, int l) { const Ctx C = make_ctx(wv);
    unsigned* qh = (unsigned*)(C.ws + WS_CTL) + CW_QUEUE + l * 64;
    if (C.G >= 64) { if (C.bid < 32) { ph_rw_scan_(C, C.bid); __syncthreads(); }
        ph_sb_attn_(C, 0, C.G, qh); __syncthreads(); ph_ret_out2_(C, l, 0, C.G, qh + 16); __syncthreads(); ph_weights_(C, l, 1, 0, C.G, qh + 32); }
    else { for (int w = C.bid; w < 32; w += C.G) { ph_rw_scan_(C, w); __syncthreads(); } ph_sb_attn_(C, 0, C.G); __syncthreads(); ph_ret_out2_(C, l, 0, C.G); __syncthreads(); ph_weights_(C, l, 1, 0, C.G); } }
__device__ __forceinline__ void P_mix5(int wv, int l) { REP2(5, { const Ctx C = make_ctx(wv); ph_rw_out2_(C, l); }); }
__device__ __forceinline__ void P_gemm_branch(int wv) { const Ctx C = make_ctx(wv); using namespace pg8; unsigned char* ws = C.ws;
    Gemm g{(const bf16*)(ws + WS_Y), (const bf16*)(ws + WS_WB), D, 256}; StaticOrder S; S.init(T, 4096, C.G, C.bid, 2, 512);
    EpiBall E{ws + WS_BALL};
    gemm_phase<EpiBall, StaticOrder, false>(C.lds, C.tid, g, S, E); }
__device__ __forceinline__ void P_gemm_gate(int wv) { const Ctx C = make_ctx(wv); using namespace pg8; unsigned char* ws = C.ws;
    Gemm g{(const bf16*)(ws + WS_H8), (const bf16*)(ws + WS_WG), D, D}; StaticOrder S; S.init(T, 4096, C.G, C.bid);
    EpiGateMerge E{(const bf16*)(ws + WS_BALL), (bf16*)(ws + WS_MERGED)};
    gemm_phase8<EpiGateMerge, StaticOrder, true>(C.lds, C.tid, g, S, E); }
__device__ __forceinline__ void P_gemm_out(int wv) { const Ctx C = make_ctx(wv); using namespace pg8; unsigned char* ws = C.ws;
    Gemm g{(const bf16*)(ws + WS_MERGED), (const bf16*)(ws + WS_WOUT), D, D}; StaticOrder S; S.init(T, D, C.G, C.bid);
    EpiResidual E{(bf16*)(ws + WS_XB), 1.0f};
    gemm_phase<EpiResidual, StaticOrder, true, 1>(C.lds, C.tid, g, S, E); }
__device__ __forceinline__ void P_norm_ffn(int wv, int l) { const Ctx C = make_ctx(wv); ph_norm_(C, C.in[I_NORM_FFN] + (size_t)l * D, (l & 1) != 0, C.in[I_ROUTER] + (size_t)(l >> 1) * D * NEXP, l >> 1, false, nullptr,  false); }
__device__ __forceinline__ void P_ffn_up(int wv) { const Ctx C = make_ctx(wv); using namespace pg8; unsigned char* ws = C.ws;
    Gemm g{(const bf16*)(ws + WS_H8), (const bf16*)(ws + WS_W13), D, D}; StaticOrder S; S.init(T, 2 * DFF, C.G, C.bid);
    EpiSwiglu E{ws + WS_HID, DFF, 1 << 20, false};
    gemm_phase8<EpiSwiglu, StaticOrder, true>(C.lds, C.tid, g, S, E); }
__device__ __forceinline__ void P_ffn_down(int wv) { const Ctx C = make_ctx(wv); using namespace pg8; unsigned char* ws = C.ws;
    Gemm g{(const bf16*)(ws + WS_HID), (const bf16*)(ws + WS_W2D), DFF, DFF}; StaticOrder S; S.init(T, D, C.G, C.bid);
    EpiResidual E{(bf16*)(ws + WS_XB), F8_DESCALE_DOWN};
    gemm_phase8<EpiResidual, StaticOrder, true, 1>(C.lds, C.tid, g, S, E); }
__device__ __forceinline__ void P_moe_scatter(int wv, int l2) { const Ctx C = make_ctx(wv); ph_moe_scatter_(C, l2); }
__device__ __forceinline__ void P_moe_up(int wv) { const Ctx C = make_ctx(wv); using namespace pg8; unsigned char* ws = C.ws;
    Gemm g{(const bf16*)(ws + WS_XS), (const bf16*)(ws + WS_W13), D, D};
    MoeOrder S{(const int*)(ws + WS_TEXP), __builtin_amdgcn_readfirstlane(*(const int*)(ws + WS_NT)), 2 * DFE / 256, C.G, C.bid};
    EpiSwiglu E{ws + WS_HIDM, DFE_PAD, 2 * DFE / 256, true};
    gemm_phase8<EpiSwiglu, MoeOrder, true>(C.lds, C.tid, g, S, E); }
__device__ __forceinline__ void P_moe_down(int wv) { const Ctx C = make_ctx(wv); using namespace pg8; unsigned char* ws = C.ws;
    Gemm g{(const bf16*)(ws + WS_HIDM), (const bf16*)(ws + WS_W2M), DFE_PAD, DFE_PAD};
    MoeOrder S{(const int*)(ws + WS_TEXP), __builtin_amdgcn_readfirstlane(*(const int*)(ws + WS_NT)), D / 256, C.G, C.bid};
    EpiBf16 E{(bf16*)(ws + WS_YS), D, 3, F8_DESCALE_DOWN};
    gemm_phase8<EpiBf16, MoeOrder, true, 1>(C.lds, C.tid, g, S, E); }
__device__ __forceinline__ void P_moe_combine(int wv) { const Ctx C = make_ctx(wv);
    const int gw = C.bid * NWAVES + C.wave, NGW = C.G * NWAVES, lane = C.lane;
    const int* slotof = (const int*)(C.ws + WS_SLOTOF); const float* gate = (const float*)(C.ws + WS_GATE); const bf16* YS = (const bf16*)(C.ws + WS_YS); const bf16* XB = (const bf16*)(C.ws + WS_XB);
    constexpr int NRC = 4;
    for (int mb = gw; mb < T; mb += NRC * NGW) {
        int s0[NRC], s1[NRC]; float g0[NRC], g1[NRC]; u32x4 x[NRC][2], ya[NRC][2], yb[NRC][2];
#pragma unroll
        for (int r = 0; r < NRC; ++r) { const int m = mb + r * NGW < T ? mb + r * NGW : T - 1; s0[r] = slotof[2 * m]; s1[r] = slotof[2 * m + 1]; g0[r] = gate[2 * m]; g1[r] = gate[2 * m + 1];
            const u32x4* xb = (const u32x4*)(XB + (size_t)m * D) + lane; x[r][0] = xb[0]; x[r][1] = xb[64]; }
#pragma unroll
        for (int r = 0; r < NRC; ++r) { const u32x4* y0 = (const u32x4*)(YS + (size_t)s0[r] * D) + lane; const u32x4* y1 = (const u32x4*)(YS + (size_t)s1[r] * D) + lane;
            ya[r][0] = y0[0]; ya[r][1] = y0[64]; yb[r][0] = y1[0]; yb[r][1] = y1[64]; }
#pragma unroll
        for (int r = 0; r < NRC; ++r) { const int m = mb + r * NGW; if (m < T) { f32x4* xo = (f32x4*)(C.out + (size_t)m * D + 8 * lane); const float G0 = g0[r], G1 = g1[r];
#pragma unroll
            for (int j = 0; j < 2; ++j) { const u32x4 xx = x[r][j], a = ya[r][j], b = yb[r][j]; f32x4 v0, v1;
                v0.x = bflo(xx.x) + G0 * bflo(a.x) + G1 * bflo(b.x); v0.y = bfhi(xx.x) + G0 * bfhi(a.x) + G1 * bfhi(b.x); v0.z = bflo(xx.y) + G0 * bflo(a.y) + G1 * bflo(b.y); v0.w = bfhi(xx.y) + G0 * bfhi(a.y) + G1 * bfhi(b.y);
                v1.x = bflo(xx.z) + G0 * bflo(a.z) + G1 * bflo(b.z); v1.y = bfhi(xx.z) + G0 * bfhi(a.z) + G1 * bfhi(b.z); v1.z = bflo(xx.w) + G0 * bflo(a.w) + G1 * bflo(b.w); v1.w = bfhi(xx.w) + G0 * bfhi(a.w) + G1 * bfhi(b.w);
                xo[128 * j] = v0; xo[128 * j + 1] = v1; } } }
    }
}

#ifndef PROBE_MASK
#define PROBE_MASK 0u
#endif
#ifndef PH_MASK
#define PH_MASK 0xffffffffu
#endif
__global__ void __launch_bounds__(NTHR, 2) hybrid_fwd(Args args) {
    (void)args;
    const int wv = __builtin_amdgcn_readfirstlane(threadIdx.x >> 6);
    { LAS unsigned char* lds = (LAS unsigned char*)lds_raw;
      for (int u = threadIdx.x; u < (LDS_BYTES - RING_BYTES) / 4; u += NTHR) ((LAS unsigned*)(lds + RING_BYTES))[u] = 0u; }
    __syncthreads();
    { const CAS Args* ka = ka_ptr();
      if (ka->ph_hi - ka->ph_lo > 1) { (void)xcd_barrier_post((unsigned*)(ka->ws + WS_CTL) + CW_BAR, (volatile LAS unsigned*)((LAS unsigned char*)lds_raw + MISC_OFF) + 8); } }
    int gp = 0;
#define PHASE(k, call) { const CAS Args* ka_ = ka_ptr(); const int lo_ = ka_->ph_lo, hi_ = ka_->ph_hi; if (lo_ <= gp && gp < hi_) { if constexpr ((PH_MASK >> (k)) & 1u) { call; if constexpr ((PROBE_MASK >> (k)) & 1u) { __syncthreads(); call; } } if (hi_ - lo_ > 1 && gp + 1 < hi_) grid_barrier(wv); } ++gp; }
    PHASE(0, P_prologue(wv))
#pragma unroll 1
    for (int l = 0; l < NLAYER; ++l) {
        PHASE(1, P_weights_norm(wv, l))
        PHASE(2, P_gemm_in(wv))
        PHASE(3, P_mix1(wv, l))
        PHASE(4, P_mix2(wv, l))
        PHASE(5, P_mix3(wv, l))
        PHASE(6, P_mix4(wv, l))
        PHASE(7, P_mix5(wv, l))
        PHASE(8, P_gemm_branch(wv))
        PHASE(9, P_gemm_gate(wv))
        PHASE(10, P_gemm_out(wv))
        PHASE(11, P_norm_ffn(wv, l))
        if (!(l & 1)) {
            PHASE(12, P_ffn_up(wv))
            PHASE(13, P_ffn_down(wv))
            gp += 2;
        } else {
            PHASE(14, P_moe_scatter(wv, l >> 1))
            PHASE(15, P_moe_up(wv))
            PHASE(16, P_moe_down(wv))
            if (l == NLAYER - 1) { PHASE(17, P_moe_combine(wv)) } else { ++gp; }
        }
    }
#undef PHASE
}
constexpr int N_PHASES = 1 + NLAYER * 15;

#ifndef MK_MULTI
#define MK_MULTI 0
#endif
extern "C" void kernel_launch(void* const* d_in, const int* in_sizes, int n_in, void* d_out, int out_size, void* d_ws, size_t ws_size, hipStream_t stream) {
    static int grid = 0;
    if (grid == 0) {
        if (n_in != 32 || in_sizes[0] != T * D || out_size != T * D || ws_size < WS_END) { fprintf(stderr, "kernel_launch: unexpected problem shape / workspace (%d inputs, ws %zu)\n", n_in, ws_size); grid = -1; return; }
        int dev = 0, cus = 0, per_cu = 0;
        if (hipGetDevice(&dev) != hipSuccess || hipDeviceGetAttribute(&cus, hipDeviceAttributeMultiprocessorCount, dev) != hipSuccess) { grid = -1; return; }
        if (hipFuncSetAttribute((const void*)hybrid_fwd, hipFuncAttributeMaxDynamicSharedMemorySize, LDS_BYTES) != hipSuccess) { fprintf(stderr, "kernel_launch: hipFuncSetAttribute failed\n"); grid = -1; return; }
        if (hipOccupancyMaxActiveBlocksPerMultiprocessor(&per_cu, (const void*)hybrid_fwd, NTHR, LDS_BYTES) != hipSuccess || per_cu < 1) { fprintf(stderr, "kernel_launch: occupancy query says %d\n", per_cu); }
        (void)hipGetLastError();
        grid = cus;
    }
    if (grid < 0) return;
    (void)hipMemsetAsync((char*)d_ws + WS_CTL, 0, CTL_ZERO_BYTES, stream);
#ifdef DBG_ZERO_WS
    (void)hipMemsetAsync((char*)d_ws + CTL_ZERO_BYTES, 0, WS_END - CTL_ZERO_BYTES, stream);
#endif
    Args a{};
    for (int i = 0; i < 32; ++i) a.in[i] = (const float*)d_in[i];
    a.out = (float*)d_out; a.ws = (unsigned char*)d_ws;
#if MK_MULTI
    for (int p = 0; p < N_PHASES; ++p) { a.ph_lo = p; a.ph_hi = p + 1; hipLaunchKernelGGL(hybrid_fwd, dim3(grid), dim3(NTHR), LDS_BYTES, stream, a); }
#else
    a.ph_lo = 0; a.ph_hi = N_PHASES; hipLaunchKernelGGL(hybrid_fwd, dim3(grid), dim3(NTHR), LDS_BYTES, stream, a);
#endif
}
```

```cpp
#include <hip/hip_runtime.h>
#include <cstdio>
#include <cstdint>

#define GAS __attribute__((address_space(1)))
#define LAS __attribute__((address_space(3)))
typedef unsigned short bf16;
typedef unsigned u32x4 __attribute__((ext_vector_type(4)));
typedef unsigned u32x2 __attribute__((ext_vector_type(2)));
typedef float f32x4 __attribute__((ext_vector_type(4)));
typedef float f32x2 __attribute__((ext_vector_type(2)));
typedef short bf16x8 __attribute__((ext_vector_type(8)));
typedef float f32x16 __attribute__((ext_vector_type(16)));
typedef short s16x4 __attribute__((ext_vector_type(4)));

constexpr int SEQ = 16384, NBATCH = 2, T = NBATCH * SEQ, D = 1024, NIN = 3328, DFF = 2816, DFE = 1408, NEXP = 8, NLAYER = 4;
constexpr int MPAD = 2 * T + NEXP * 256;
constexpr int NWAVES = 8, NTHR = 512;
constexpr float LOG2E = 1.4426950408889634f;
constexpr int MM_LP = 72;

typedef __bf16 bf16x2_t __attribute__((ext_vector_type(2)));
__device__ __forceinline__ unsigned cvt_pk_bf16(float lo, float hi) { const f32x2 v = {lo, hi}; const bf16x2_t b = __builtin_convertvector(v, bf16x2_t); return __builtin_bit_cast(unsigned, b); }
__device__ __forceinline__ float bflo(unsigned u) { return __builtin_bit_cast(float, u << 16); }
__device__ __forceinline__ float bfhi(unsigned u) { return __builtin_bit_cast(float, u & 0xffff0000u); }
__device__ __forceinline__ float bf2f(bf16 u) { return __builtin_bit_cast(float, (unsigned)u << 16); }
__device__ __forceinline__ bf16 f2bf(float f) { return (bf16)(cvt_pk_bf16(f, 0.f) & 0xffffu); }
__device__ __forceinline__ float sigm(float x) { return __builtin_amdgcn_rcpf(1.f + __builtin_amdgcn_exp2f(-x * LOG2E)); }
__device__ __forceinline__ float shx(float v, int o, int lane) { return __builtin_bit_cast(float, __builtin_amdgcn_ds_bpermute((lane ^ o) << 2, __builtin_bit_cast(int, v))); }
__device__ __forceinline__ float dpp_add(float v, const int ctrl_id) {
    const int x = __builtin_bit_cast(int, v);
    int y;
    if (ctrl_id == 0) y = __builtin_amdgcn_update_dpp(0, x, 0xB1, 0xF, 0xF, true);
    else if (ctrl_id == 1) y = __builtin_amdgcn_update_dpp(0, x, 0x4E, 0xF, 0xF, true);
    else if (ctrl_id == 2) y = __builtin_amdgcn_update_dpp(0, x, 0x141, 0xF, 0xF, true);
    else y = __builtin_amdgcn_update_dpp(0, x, 0x140, 0xF, 0xF, true);
    return v + __builtin_bit_cast(float, y);
}
__device__ __forceinline__ float wave_sum(float v, int lane) {
    (void)lane;
    v = dpp_add(v, 0); v = dpp_add(v, 1); v = dpp_add(v, 2); v = dpp_add(v, 3);
    const int x = __builtin_bit_cast(int, v);
    const float s0 = __builtin_bit_cast(float, __builtin_amdgcn_readlane(x, 0)), s1 = __builtin_bit_cast(float, __builtin_amdgcn_readlane(x, 16)),
                s2 = __builtin_bit_cast(float, __builtin_amdgcn_readlane(x, 32)), s3 = __builtin_bit_cast(float, __builtin_amdgcn_readlane(x, 48));
    return (s0 + s1) + (s2 + s3);
}
__device__ __forceinline__ void unpack8(const u32x4 v, float* f) {
    f[0] = bflo(v.x); f[1] = bfhi(v.x); f[2] = bflo(v.y); f[3] = bfhi(v.y); f[4] = bflo(v.z); f[5] = bfhi(v.z); f[6] = bflo(v.w); f[7] = bfhi(v.w);
}
__device__ __forceinline__ unsigned pk4_fp8(float a, float b, float c, float d) {
    a = __builtin_amdgcn_fmed3f(a, -440.f, 440.f); b = __builtin_amdgcn_fmed3f(b, -440.f, 440.f); c = __builtin_amdgcn_fmed3f(c, -440.f, 440.f); d = __builtin_amdgcn_fmed3f(d, -440.f, 440.f);
    int w = __builtin_amdgcn_cvt_pk_fp8_f32(a, b, 0, false); w = __builtin_amdgcn_cvt_pk_fp8_f32(c, d, w, true); return (unsigned)w; }
__device__ __forceinline__ u32x4 pack8(const float* f) {
    u32x4 w; w.x = cvt_pk_bf16(f[0], f[1]); w.y = cvt_pk_bf16(f[2], f[3]); w.z = cvt_pk_bf16(f[4], f[5]); w.w = cvt_pk_bf16(f[6], f[7]); return w;
}


#ifndef PROBE2
#define PROBE2 0
#endif
#ifndef GMASK
#define GMASK 15
#endif
#ifndef RWDBG
#define RWDBG 0
#endif
typedef int i32x8 __attribute__((ext_vector_type(8)));
constexpr float F8_MUL_X = 16.f, F8_MUL_W = 256.f, F8_DESCALE = 1.0f / (16.f * 256.f), F8_MUL_H = 4.f, F8_DESCALE_DOWN = 1.0f / (4.f * 256.f);
constexpr int DFE_PAD = 1536;
namespace pg8 {
typedef unsigned short bf16_t;
constexpr int BM = 256, BK = 64, HALF = 128, HTB = HALF * BK * 2, NXCD = 8, WGM = 8;
__host__ __device__ __forceinline__ int lds_byte(int r, int c) { const int st = (r >> 4) * 2 + (c >> 5), rr = r & 15, cc = c & 31, ob = rr * 64 + cc * 2; return st * 1024 + (ob ^ (((ob >> 9) & 1) << 5)); }
__host__ __device__ __forceinline__ void stage_rc(int b, int& R, int& C) { const int st = b / 1024, sb = b % 1024, swz = sb ^ (((sb >> 9) & 1) << 5); R = (st >> 1) * 16 + swz / 64; C = (st & 1) * 32 + (swz % 64) / 2; }
__host__ __device__ __forceinline__ int perm32(int rho) { const int n = rho >> 4, i = rho & 15; return 8 * (i >> 2) + 4 * n + (i & 3); }

struct Unit { int pm, pn, aoff; };
struct Gemm { const bf16_t* A; const bf16_t* Bt; int lda, K; };

struct StaticOrder {
    int nM, nN, nwg, G, c, ashift, amul;
    __device__ void init(int M, int N, int G_, int c_, int ashift_ = 0, int amul_ = 0) { nM = M / BM; nN = N / BM; nwg = nM * nN; G = G_; c = c_; ashift = ashift_; amul = amul_; }
    __device__ bool next(int i, Unit& u) const {
        const long L = (long)i * G + c; if (L >= nwg) return false;
        int wgid = (int)L; { const int q = nwg / NXCD, r = nwg % NXCD, xcd = wgid % NXCD, off = wgid / NXCD; wgid = (xcd < r ? xcd * (q + 1) : r * (q + 1) + (xcd - r) * q) + off; }
        const int nig = WGM * nN, gid = wgid / nig, fm = gid * WGM, gsz = (nM - fm) < WGM ? (nM - fm) : WGM;
        u.pm = fm + ((wgid % nig) % gsz); u.pn = (wgid % nig) / gsz; u.aoff = (u.pn >> ashift) * amul; return true;
    }
};
struct MoeOrder {
    const int* texp; int ntiles, ncol, G, c;
    __device__ bool next(int i, Unit& u) const {
        const int L = i * G + c; if (L >= ntiles * ncol) return false;
        const int pm = L / ncol, pl = L % ncol;
        u.pm = pm; u.pn = texp[pm] * ncol + pl; u.aoff = 0; return true;
    }
};

template <class Epi, class Sched, bool ALIGN_EPI, int CMAP = 0>
__device__ __forceinline__ void gemm_phase(LAS unsigned char* lds, const int tid_in, const Gemm g, const Sched& S, const Epi& E) {
    const int tid = tid_in, wid = __builtin_amdgcn_readfirstlane(tid >> 6), lane = tid & 63, wr = wid >> 2, wc = wid & 3, fr = lane & 15, fq = lane >> 4;
    const int K = g.K, nt = K / BK, lda = g.lda;
    unsigned voffA[2], voffB[2];
#pragma unroll
    for (int i = 0; i < 2; ++i) { int R, C; stage_rc(tid * 16 + i * 8192, R, C); const int p32 = perm32(R & 31); const int Rb = CMAP ? 64 * (R >> 5) + 16 * (p32 >> 3) + (p32 & 7) : (R & ~31) + p32;
        voffA[i] = (unsigned)(R * lda + C) * 2u; voffB[i] = (unsigned)(Rb * K + C) * 2u; }
    const size_t kstep = (size_t)(BK * 2);
    const size_t hstepA = (size_t)HALF * lda * 2, tstepA = 2 * hstepA, hstepB = (size_t)(CMAP ? 8 : HALF) * K * 2, tstepB = (size_t)BM * K * 2;
    const unsigned ldsw = (unsigned)wid * 1024u;
    const int aoff = lds_byte(wr * 64 + fr, fq * 8), boff = lds_byte(wc * 32 + fr, fq * 8);
#define PG8_SA(b, h) (((b) * 2 + (h)) * HTB)
#define PG8_SB(b, h) ((4 + (b) * 2 + (h)) * HTB)
#define PG8_STAGE(bufoff, gbase, voff) do { _Pragma("unroll") for (int _i = 0; _i < 2; ++_i) \
        __builtin_amdgcn_global_load_lds((const unsigned*)((const char*)(gbase) + (voff)[_i]), (LAS unsigned*)(lds + (bufoff) + ldsw + _i * 8192), 16, 0, 0); } while (0)
#define PG8_LDA(dst, b, h) do { _Pragma("unroll") for (int m = 0; m < 4; ++m) _Pragma("unroll") for (int k = 0; k < 2; ++k) dst[m][k] = *(const LAS bf16x8*)(lds + PG8_SA(b, h) + aoff + m * 2048 + k * 1024); } while (0)
#define PG8_LDB(dst, b, h) do { _Pragma("unroll") for (int n = 0; n < 2; ++n) _Pragma("unroll") for (int k = 0; k < 2; ++k) dst[n][k] = *(const LAS bf16x8*)(lds + PG8_SB(b, h) + boff + n * 2048 + k * 1024); } while (0)
#define PG8_MMA(ai, bj, At, Bt) do { __builtin_amdgcn_s_setprio(1); _Pragma("unroll") for (int m = 0; m < 4; ++m) _Pragma("unroll") for (int n = 0; n < 2; ++n) _Pragma("unroll") for (int k = 0; k < 2; ++k) \
        acc[ai][bj][m][n] = __builtin_amdgcn_mfma_f32_16x16x32_bf16(Bt[n][k], At[m][k], acc[ai][bj][m][n], 0, 0, 0); __builtin_amdgcn_s_setprio(0); } while (0)
#define PG8_WAIT_V(n) asm volatile("s_waitcnt vmcnt(" #n ")" ::: "memory")
#define PG8_WAIT_L(n) asm volatile("s_waitcnt lgkmcnt(" #n ")" ::: "memory")
#define PG8_BAR __builtin_amdgcn_s_barrier()
#define PG8_SCHED __builtin_amdgcn_sched_barrier(0)
    Unit cur, nxt; int ui = 0;
    if (!S.next(0, cur)) return;
    f32x4 acc[2][2][4][2];
#pragma unroll
    for (int a = 0; a < 2; ++a)
#pragma unroll
        for (int b = 0; b < 2; ++b)
#pragma unroll
            for (int m = 0; m < 4; ++m)
#pragma unroll
                for (int n = 0; n < 2; ++n) acc[a][b][m][n] = (f32x4){0.f, 0.f, 0.f, 0.f};
    bf16x8 At[4][2], B0[2][2], B1[2][2];
    const char* cA = (const char*)g.A + (size_t)cur.pm * tstepA + cur.aoff; const char* cB = (const char*)g.Bt + (size_t)cur.pn * tstepB;
    PG8_STAGE(PG8_SB(0, 0), cB, voffB); PG8_STAGE(PG8_SB(0, 1), cB + hstepB, voffB); PG8_STAGE(PG8_SA(0, 0), cA, voffA); PG8_STAGE(PG8_SA(0, 1), cA + hstepA, voffA);
    if (wr == 1) PG8_BAR;
    PG8_WAIT_V(2); PG8_BAR;
    PG8_STAGE(PG8_SB(1, 0), cB + kstep, voffB); PG8_STAGE(PG8_SA(1, 0), cA + kstep, voffA); PG8_STAGE(PG8_SB(1, 1), cB + hstepB + kstep, voffB);
    PG8_WAIT_V(6); PG8_BAR;
    for (;;) {
        const bool has_next = S.next(ui + 1, nxt);
        const char* nA = has_next ? (const char*)g.A + (size_t)nxt.pm * tstepA + nxt.aoff : cA; const char* nB = has_next ? (const char*)g.Bt + (size_t)nxt.pn * tstepB : cB;
#pragma unroll 1
        for (int t = 0; t < nt; t += 2) {
            const bool last = (t == nt - 2);
            const char* a1 = cA + (size_t)(t + 1) * kstep;
            const char* a2 = last ? nA : cA + (size_t)(t + 2) * kstep; const char* b2 = last ? nB : cB + (size_t)(t + 2) * kstep;
            const char* a3 = a2 + kstep; const char* b3 = b2 + kstep;
            PG8_LDB(B0, 0, 0); PG8_LDB(B1, 0, 1); PG8_SCHED; PG8_LDA(At, 0, 0); PG8_STAGE(PG8_SA(1, 1), a1 + hstepA, voffA);
            PG8_WAIT_V(8); PG8_WAIT_L(0); PG8_BAR; PG8_MMA(0, 0, At, B0); PG8_MMA(0, 1, At, B1); PG8_BAR; PG8_SCHED;
            PG8_LDA(At, 0, 1); PG8_STAGE(PG8_SB(0, 0), b2, voffB); PG8_STAGE(PG8_SB(0, 1), b2 + hstepB, voffB); PG8_STAGE(PG8_SA(0, 0), a2, voffA);
            PG8_WAIT_V(8); PG8_WAIT_L(0); PG8_BAR; PG8_MMA(1, 0, At, B0); PG8_MMA(1, 1, At, B1); PG8_BAR; PG8_SCHED;
            PG8_LDB(B0, 1, 0); PG8_LDB(B1, 1, 1); PG8_SCHED; PG8_LDA(At, 1, 0); PG8_STAGE(PG8_SA(0, 1), a2 + hstepA, voffA);
            PG8_WAIT_V(8); PG8_WAIT_L(0); PG8_BAR; PG8_MMA(0, 0, At, B0); PG8_MMA(0, 1, At, B1); PG8_BAR; PG8_SCHED;
            PG8_LDA(At, 1, 1); PG8_STAGE(PG8_SB(1, 0), b3, voffB); PG8_STAGE(PG8_SB(1, 1), b3 + hstepB, voffB); PG8_STAGE(PG8_SA(1, 0), a3, voffA);
            PG8_WAIT_V(8); PG8_WAIT_L(0); PG8_BAR; PG8_MMA(1, 0, At, B0); PG8_MMA(1, 1, At, B1); PG8_BAR; PG8_SCHED;
        }
        if constexpr (ALIGN_EPI) { if (wr == 0) PG8_BAR; }
        { int ln_; asm volatile("v_mbcnt_lo_u32_b32 %0, -1, 0\n\tv_mbcnt_hi_u32_b32 %0, -1, %0" : "=v"(ln_)); E(acc, cur, wr, wc, ln_ & 15, ln_ >> 4); }
        if (!has_next) break;
#pragma unroll
        for (int a = 0; a < 2; ++a)
#pragma unroll
            for (int b = 0; b < 2; ++b)
#pragma unroll
                for (int m = 0; m < 4; ++m)
#pragma unroll
                    for (int n = 0; n < 2; ++n) acc[a][b][m][n] = (f32x4){0.f, 0.f, 0.f, 0.f};
        cur = nxt; cA = nA; cB = nB; ++ui;
        if constexpr (ALIGN_EPI) { if (wr == 1) PG8_BAR; }
    }
    PG8_WAIT_V(0);
    if constexpr (!ALIGN_EPI) { if (wr == 0) PG8_BAR; }
    PG8_BAR;
#undef PG8_SA
#undef PG8_SB
#undef PG8_STAGE
#undef PG8_LDA
#undef PG8_LDB
#undef PG8_MMA
#undef PG8_WAIT_V
#undef PG8_WAIT_L
#undef PG8_BAR
#undef PG8_SCHED
}

template <class Epi, class Sched, bool ALIGN_EPI, int CMAP = 0>
__device__ __forceinline__ void gemm_phase8(LAS unsigned char* lds, const int tid_in, const Gemm g, const Sched& S, const Epi& E) {
    const int tid = tid_in, wid = __builtin_amdgcn_readfirstlane(tid >> 6), lane = tid & 63, wr = wid >> 2, wc = wid & 3, fr = lane & 15, fq = lane >> 4;
    const int K = g.K, nt = K / 128, lda = g.lda;
    unsigned voffA, voffB;
    { int R, C; stage_rc(tid * 16, R, C); const int p32 = perm32(R & 31); const int Rb = CMAP ? 64 * (R >> 5) + 16 * (p32 >> 3) + (p32 & 7) : (R & ~31) + p32; voffA = (unsigned)(R * lda + C * 2); voffB = (unsigned)(Rb * K + C * 2); }
    const unsigned pstepA = 64u * (unsigned)lda, pstepB = (CMAP ? 128u : 64u) * (unsigned)K;
    const unsigned kstep = (unsigned)(BK * 2);
    const unsigned hstepA = (unsigned)HALF * (unsigned)lda, tstepA = 2 * hstepA, hstepB = (unsigned)(CMAP ? 8 : HALF) * (unsigned)K, tstepB = (unsigned)BM * (unsigned)K;
    const __amdgpu_buffer_rsrc_t rsA = __builtin_amdgcn_make_buffer_rsrc((void*)g.A, 0, 0x7fffffff, 0x00020000), rsB = __builtin_amdgcn_make_buffer_rsrc((void*)g.Bt, 0, 0x7fffffff, 0x00020000);
    const unsigned ldsw = (unsigned)wid * 1024u;
    const int aoff0 = lds_byte(wr * 64 + fr, fq * 8), aoff1 = aoff0 + 1024, boff0 = lds_byte(wc * 32 + fr, fq * 8), boff1 = boff0 + 1024;
#define PG8_SA(b, h) (((b) * 2 + (h)) * HTB)
#define PG8_SB(b, h) ((4 + (b) * 2 + (h)) * HTB)
#define PG8_STAGE(bufoff, goff, voff, pstep) do { _Pragma("unroll") for (int _i = 0; _i < 2; ++_i) \
        __builtin_amdgcn_raw_ptr_buffer_load_lds(PG8_RS_##voff, (LAS unsigned*)(lds + (bufoff) + ldsw + _i * 8192), 16, (int)(voff), (int)((goff) + _i * (pstep)), 0, 0); } while (0)
#define PG8_RS_voffA rsA
#define PG8_RS_voffB rsB
#define PG8_LDA(dst, b, h) do { _Pragma("unroll") for (int m = 0; m < 4; ++m) { dst[m][0] = *(const LAS u32x4*)(lds + PG8_SA(b, h) + aoff0 + m * 2048); dst[m][1] = *(const LAS u32x4*)(lds + PG8_SA(b, h) + aoff1 + m * 2048); } } while (0)
#define PG8_LDB(dst, b, h) do { _Pragma("unroll") for (int n = 0; n < 2; ++n) { dst[n][0] = *(const LAS u32x4*)(lds + PG8_SB(b, h) + boff0 + n * 2048); dst[n][1] = *(const LAS u32x4*)(lds + PG8_SB(b, h) + boff1 + n * 2048); } } while (0)
#define PG8_J8(x) __builtin_bit_cast(i32x8, __builtin_shufflevector((x)[0], (x)[1], 0, 1, 2, 3, 4, 5, 6, 7))
#define PG8_MMA(ai, bj, At, Bt) do { __builtin_amdgcn_s_setprio(1); _Pragma("unroll") for (int m = 0; m < 4; ++m) _Pragma("unroll") for (int n = 0; n < 2; ++n) \
        acc[ai][bj][m][n] = __builtin_amdgcn_mfma_scale_f32_16x16x128_f8f6f4(PG8_J8(Bt[n]), PG8_J8(At[m]), acc[ai][bj][m][n], 0, 0, 0, 0, 0, 0);        __builtin_amdgcn_s_setprio(0); } while (0)
#define PG8_WAIT_V(n) asm volatile("s_waitcnt vmcnt(" #n ")" ::: "memory")
#define PG8_WAIT_L(n) asm volatile("s_waitcnt lgkmcnt(" #n ")" ::: "memory")
#define PG8_BAR __builtin_amdgcn_s_barrier()
#define PG8_SCHED __builtin_amdgcn_sched_barrier(0)
    Unit cur, nxt; int ui = 0;
    if (!S.next(0, cur)) return;
    f32x4 acc[2][2][4][2];
#pragma unroll
    for (int a = 0; a < 2; ++a)
#pragma unroll
        for (int b = 0; b < 2; ++b)
#pragma unroll
            for (int m = 0; m < 4; ++m)
#pragma unroll
                for (int n = 0; n < 2; ++n) acc[a][b][m][n] = (f32x4){0.f, 0.f, 0.f, 0.f};
    u32x4 At[4][2], B0[2][2], B1[2][2];
    unsigned cA = (unsigned)cur.pm * tstepA + (unsigned)cur.aoff, cB = (unsigned)cur.pn * tstepB;
    PG8_STAGE(PG8_SB(0, 0), cB, voffB, pstepB); PG8_STAGE(PG8_SB(0, 1), cB + hstepB, voffB, pstepB); PG8_STAGE(PG8_SA(0, 0), cA, voffA, pstepA); PG8_STAGE(PG8_SA(0, 1), cA + hstepA, voffA, pstepA);
    if (wr == 1) PG8_BAR;
    PG8_WAIT_V(2); PG8_BAR;
    PG8_STAGE(PG8_SB(1, 0), cB + kstep, voffB, pstepB); PG8_STAGE(PG8_SA(1, 0), cA + kstep, voffA, pstepA); PG8_STAGE(PG8_SB(1, 1), cB + hstepB + kstep, voffB, pstepB);
    PG8_WAIT_V(6); PG8_BAR;
    for (;;) {
        const bool has_next = S.next(ui + 1, nxt);
        const unsigned nA = has_next ? (unsigned)nxt.pm * tstepA + (unsigned)nxt.aoff : cA, nB = has_next ? (unsigned)nxt.pn * tstepB : cB;
#pragma unroll 1
        for (int t = 0; t < nt; t += 2) {
            const bool last = (t == nt - 2);
            const unsigned a1 = cA + (unsigned)(t + 1) * kstep;
            const unsigned a2 = last ? nA : cA + (unsigned)(t + 2) * kstep, b2 = last ? nB : cB + (unsigned)(t + 2) * kstep;
            const unsigned a3 = a2 + kstep, b3 = b2 + kstep;
            PG8_LDB(B0, 0, 0); PG8_LDB(B1, 0, 1); PG8_SCHED; PG8_LDA(At, 0, 0); PG8_STAGE(PG8_SA(1, 1), a1 + hstepA, voffA, pstepA);
            PG8_WAIT_V(8); PG8_WAIT_L(0); PG8_BAR; PG8_MMA(0, 0, At, B0); PG8_MMA(0, 1, At, B1); PG8_BAR; PG8_SCHED;
            PG8_LDA(At, 0, 1); PG8_STAGE(PG8_SB(0, 0), b2, voffB, pstepB); PG8_STAGE(PG8_SB(0, 1), b2 + hstepB, voffB, pstepB); PG8_STAGE(PG8_SA(0, 0), a2, voffA, pstepA);
            PG8_WAIT_V(8); PG8_WAIT_L(0); PG8_BAR; PG8_MMA(1, 0, At, B0); PG8_MMA(1, 1, At, B1); PG8_BAR; PG8_SCHED;
            PG8_LDB(B0, 1, 0); PG8_LDB(B1, 1, 1); PG8_SCHED; PG8_LDA(At, 1, 0); PG8_STAGE(PG8_SA(0, 1), a2 + hstepA, voffA, pstepA);
            PG8_WAIT_V(8); PG8_WAIT_L(0); PG8_BAR; PG8_MMA(0, 0, At, B0); PG8_MMA(0, 1, At, B1); PG8_BAR; PG8_SCHED;
            PG8_LDA(At, 1, 1); PG8_STAGE(PG8_SB(1, 0), b3, voffB, pstepB); PG8_STAGE(PG8_SB(1, 1), b3 + hstepB, voffB, pstepB); PG8_STAGE(PG8_SA(1, 0), a3, voffA, pstepA);
            PG8_WAIT_V(8); PG8_WAIT_L(0); PG8_BAR; PG8_MMA(1, 0, At, B0); PG8_MMA(1, 1, At, B1); PG8_BAR; PG8_SCHED;
        }
        if constexpr (ALIGN_EPI) { if (wr == 0) PG8_BAR; }
        { int ln_; asm volatile("v_mbcnt_lo_u32_b32 %0, -1, 0\n\tv_mbcnt_hi_u32_b32 %0, -1, %0" : "=v"(ln_)); E(acc, cur, wr, wc, ln_ & 15, ln_ >> 4); }
        if (!has_next) break;
#pragma unroll
        for (int a = 0; a < 2; ++a)
#pragma unroll
            for (int b = 0; b < 2; ++b)
#pragma unroll
                for (int m = 0; m < 4; ++m)
#pragma unroll
                    for (int n = 0; n < 2; ++n) acc[a][b][m][n] = (f32x4){0.f, 0.f, 0.f, 0.f};
        cur = nxt; cA = nA; cB = nB; ++ui;
        if constexpr (ALIGN_EPI) { if (wr == 1) PG8_BAR; }
    }
    PG8_WAIT_V(0);
    if constexpr (!ALIGN_EPI) { if (wr == 0) PG8_BAR; }
    PG8_BAR;
#undef PG8_SA
#undef PG8_SB
#undef PG8_STAGE
#undef PG8_RS_voffA
#undef PG8_RS_voffB
#undef PG8_LDA
#undef PG8_LDB
#undef PG8_MMA
#undef PG8_J8
#undef PG8_WAIT_V
#undef PG8_WAIT_L
#undef PG8_BAR
#undef PG8_SCHED
}

typedef f32x4 Acc[2][2][4][2];

__device__ __forceinline__ unsigned dpp_ror8(unsigned v) { return (unsigned)__builtin_amdgcn_update_dpp(0, (int)v, 0x128, 0xf, 0xf, false); }
struct CmPair { unsigned a, b; };
__device__ __forceinline__ CmPair cm_swapv(bool lo, unsigned x0, unsigned x1) { const unsigned r = dpp_ror8(lo ? x1 : x0); CmPair o; o.a = lo ? x0 : r; o.b = lo ? r : x1; return o; }
#define CM_SWAP_U(lo, X0, X1) do { const CmPair r_ = cm_swapv(lo, X0, X1); X0 = r_.a; X1 = r_.b; } while (0)
#define CM_SWAP_F(lo, X0, X1) do { const CmPair r_ = cm_swapv(lo, __builtin_bit_cast(unsigned, (float)(X0)), __builtin_bit_cast(unsigned, (float)(X1))); X0 = __builtin_bit_cast(float, r_.a); X1 = __builtin_bit_cast(float, r_.b); } while (0)
#define cm_swap4(lo, w0, w1) do { CM_SWAP_U(lo, w0.x, w1.x); CM_SWAP_U(lo, w0.y, w1.y); CM_SWAP_U(lo, w0.z, w1.z); CM_SWAP_U(lo, w0.w, w1.w); } while (0)
struct EpiRoute {
    bf16_t *d0, *d1, *d2, *d3; const float* qn; const float* kn;
    template <int NORM> __device__ __forceinline__ void run(const Acc& acc, const Unit& u, int wr, int wc, int fr, int fq, bf16_t* base, int ld, int ct) const {
        const bool lo = fr < 8;
        const int row0 = u.pm * BM + wr * 64 + (fr & 7), col0 = ct * 256 + wc * 64 + 16 * fq + 8 * (fr >> 3);
        f32x4 gg[2][2];
        if constexpr (NORM) { const float* gn = (u.pn == 4) ? qn : kn; const float gs = (u.pn == 4) ? 0.125f * LOG2E : 1.0f;
#pragma unroll
            for (int bj = 0; bj < 2; ++bj)
#pragma unroll
                for (int n = 0; n < 2; ++n) gg[bj][n] = *(const f32x4*)(gn + 16 * fq + 8 * bj + 4 * n) * gs; }
#pragma unroll
        for (int ai = 0; ai < 2; ++ai)
#pragma unroll
            for (int m = 0; m < 4; ++m) { bf16_t* rowp = base + (size_t)(row0 + ai * HALF + m * 16) * ld + col0; u32x4 w0, w1;
                f32x4 v00 = acc[ai][0][m][0], v01 = acc[ai][0][m][1], v10 = acc[ai][1][m][0], v11 = acc[ai][1][m][1];
                if constexpr (NORM) { float ss = 0.f;
#pragma unroll
                    for (int e = 0; e < 4; ++e) ss += (v00[e] * v00[e] + v01[e] * v01[e]) + (v10[e] * v10[e] + v11[e] * v11[e]);
                    ss += shx(ss, 16, fr + 16 * fq); ss += shx(ss, 32, fr + 16 * fq);
                    const float rs = __builtin_amdgcn_rsqf(ss * (1.f / 64.f) + 1e-6f);
                    v00 = v00 * rs * gg[0][0]; v01 = v01 * rs * gg[0][1]; v10 = v10 * rs * gg[1][0]; v11 = v11 * rs * gg[1][1]; }
                w0.x = cvt_pk_bf16(v00[0], v00[1]); w0.y = cvt_pk_bf16(v00[2], v00[3]); w0.z = cvt_pk_bf16(v01[0], v01[1]); w0.w = cvt_pk_bf16(v01[2], v01[3]);
                w1.x = cvt_pk_bf16(v10[0], v10[1]); w1.y = cvt_pk_bf16(v10[2], v10[3]); w1.z = cvt_pk_bf16(v11[0], v11[1]); w1.w = cvt_pk_bf16(v11[2], v11[3]);
                cm_swap4(lo, w0, w1);
                *(u32x4*)rowp = w0; *(u32x4*)(rowp + (size_t)8 * ld) = w1; }
    }
    __device__ __forceinline__ void operator()(const Acc& acc, const Unit& u, int wr, int wc, int fr, int fq) const {
        const int pn = u.pn; bf16_t* base; int ld, ct;
        if (pn < 4) { base = d0; ld = 1024; ct = pn; } else if (pn < 7) { base = d1; ld = 768; ct = pn - 4; } else if (pn < 11) { base = d2; ld = 1024; ct = pn - 7; } else { base = d3; ld = 512; ct = pn - 11; }
        if (pn >= 11) {
            const int row0 = u.pm * BM + wr * 64 + fr, c0 = (pn - 11) * 128 + 32 * wc + 8 * fq;
#pragma unroll
            for (int ai = 0; ai < 2; ++ai)
#pragma unroll
                for (int m = 0; m < 4; ++m) { const f32x4 a0 = acc[ai][0][m][0], a1 = acc[ai][0][m][1], b0 = acc[ai][1][m][0], b1 = acc[ai][1][m][1]; u32x4 w;
                    w.x = cvt_pk_bf16(a0[0] * sigm(b0[0]), a0[1] * sigm(b0[1])); w.y = cvt_pk_bf16(a0[2] * sigm(b0[2]), a0[3] * sigm(b0[3]));
                    w.z = cvt_pk_bf16(a1[0] * sigm(b1[0]), a1[1] * sigm(b1[1])); w.w = cvt_pk_bf16(a1[2] * sigm(b1[2]), a1[3] * sigm(b1[3]));
                    *(u32x4*)(d3 + (size_t)(row0 + ai * HALF + m * 16) * 256 + c0) = w; }
            return; }
        if (pn == 4 || pn == 5) run<1>(acc, u, wr, wc, fr, fq, base, ld, ct); else run<0>(acc, u, wr, wc, fr, fq, base, ld, ct);
    }
};
struct EpiBf16 {
    bf16_t* O; int ld, pnmask; float sc;
    __device__ __forceinline__ void operator()(const Acc& acc, const Unit& u, int wr, int wc, int fr, int fq) const {
        const bool lo = fr < 8;
        const int row0 = u.pm * BM + wr * 64 + (fr & 7), col0 = (u.pn & pnmask) * 256 + wc * 64 + 16 * fq + 8 * (fr >> 3);
#pragma unroll
        for (int ai = 0; ai < 2; ++ai)
#pragma unroll
            for (int m = 0; m < 4; ++m) { bf16_t* rowp = O + (size_t)(row0 + ai * HALF + m * 16) * ld + col0; u32x4 w0, w1;
                { const f32x4 v0 = acc[ai][0][m][0] * sc, v1 = acc[ai][0][m][1] * sc; w0.x = cvt_pk_bf16(v0[0], v0[1]); w0.y = cvt_pk_bf16(v0[2], v0[3]); w0.z = cvt_pk_bf16(v1[0], v1[1]); w0.w = cvt_pk_bf16(v1[2], v1[3]); }
                { const f32x4 v0 = acc[ai][1][m][0] * sc, v1 = acc[ai][1][m][1] * sc; w1.x = cvt_pk_bf16(v0[0], v0[1]); w1.y = cvt_pk_bf16(v0[2], v0[3]); w1.z = cvt_pk_bf16(v1[0], v1[1]); w1.w = cvt_pk_bf16(v1[2], v1[3]); }
                cm_swap4(lo, w0, w1);
                *(u32x4*)rowp = w0; *(u32x4*)(rowp + (size_t)8 * ld) = w1; }
    }
};
struct EpiLora {
    float* wdec; bf16_t* ag; const float* w0; const float* a0;
    __device__ __forceinline__ void operator()(const Acc& acc, const Unit& u, int wr, int wc, int fr, int fq) const {
        const int row0 = u.pm * BM + wr * 64 + fr, cl0 = wc * 32 + 8 * fq, pn = u.pn;
#pragma unroll
        for (int ai = 0; ai < 2; ++ai)
#pragma unroll
            for (int m = 0; m < 4; ++m) { const size_t row = (size_t)(row0 + ai * HALF + m * 16);
#pragma unroll
                for (int bj = 0; bj < 2; ++bj) { const int col = bj * HALF + cl0; float v[8];
#pragma unroll
                    for (int n = 0; n < 2; ++n)
#pragma unroll
                        for (int e = 0; e < 4; ++e) v[4 * n + e] = acc[ai][bj][m][n][e];
                    if (pn == 0) {
                        *(f32x4*)(wdec + row * 256 + col) = (f32x4){v[0], v[1], v[2], v[3]}; *(f32x4*)(wdec + row * 256 + col + 4) = (f32x4){v[4], v[5], v[6], v[7]};
                    } else if (pn == 1) {
                        *(u32x4*)(ag + row * 512 + col) = pack8(v);
                    } else { *(u32x4*)(ag + row * 512 + 256 + col) = pack8(v); }
                } }
    }
};
struct EpiBall {
    unsigned char* O;
    __device__ __forceinline__ void operator()(const Acc& acc, const Unit& u, int wr, int wc, int fr, int fq) const {
        unsigned char* base = O + ((size_t)(u.pm * 16 + u.pn) << 17) + (wc >> 1) * 32768 + (wr * 2 + (wc & 1)) * 1024 + (fr + 16 * fq) * 16;
#pragma unroll
        for (int ai = 0; ai < 2; ++ai)
#pragma unroll
            for (int m = 0; m < 4; ++m)
#pragma unroll
                for (int bj = 0; bj < 2; ++bj) { const f32x4 v0 = acc[ai][bj][m][0], v1 = acc[ai][bj][m][1]; u32x4 w;
                    w.x = cvt_pk_bf16(v0[0], v0[1]); w.y = cvt_pk_bf16(v0[2], v0[3]); w.z = cvt_pk_bf16(v1[0], v1[1]); w.w = cvt_pk_bf16(v1[2], v1[3]);
                    __builtin_nontemporal_store(w, (u32x4*)(base + bj * 65536 + (ai * 4 + m) * 4096)); }
    }
};
struct EpiGateMerge {
    const bf16_t* ball; bf16_t* merged;
    __device__ __forceinline__ void operator()(const Acc& acc, const Unit& u, int wr, int wc, int fr, int fq) const {
        const int row0 = u.pm * BM + wr * 64 + fr, o0 = 64 * u.pn + 16 * wc + 4 * fq;
        const int cw = 64 * (u.pn & 3) + 16 * wc + 4 * fq;
        const unsigned char* lbase = (const unsigned char*)ball + ((size_t)(u.pm * 16 + (u.pn >> 2)) << 17) + (cw >> 7) * 65536 + ((cw >> 6) & 1) * 32768 + (wr * 2 + ((cw >> 5) & 1)) * 1024 + (fr + 16 * ((cw >> 3) & 3)) * 16 + ((cw >> 2) & 1) * 8;
        u32x2 bb[2][4][4];
#pragma unroll
        for (int ai = 0; ai < 2; ++ai)
#pragma unroll
            for (int m = 0; m < 4; ++m)
#pragma unroll
                for (int gi = 0; gi < 4; ++gi) bb[ai][m][gi] = __builtin_nontemporal_load((const u32x2*)(lbase + ((size_t)gi << 19) + (ai * 4 + m) * 4096));
#pragma unroll
        for (int ai = 0; ai < 2; ++ai)
#pragma unroll
            for (int m = 0; m < 4; ++m) { const size_t row = (size_t)(row0 + ai * HALF + m * 16); float s[4] = {0.f, 0.f, 0.f, 0.f};
#pragma unroll
                for (int bj = 0; bj < 2; ++bj)
#pragma unroll
                    for (int n = 0; n < 2; ++n) { const int gi = 2 * bj + n; const u32x2 b = bb[ai][m][gi];
                        const f32x4 a = acc[ai][bj][m][n] * F8_DESCALE;
                        s[0] += sigm(a[0]) * bflo(b.x); s[1] += sigm(a[1]) * bfhi(b.x); s[2] += sigm(a[2]) * bflo(b.y); s[3] += sigm(a[3]) * bfhi(b.y); }
                u32x2 w; w.x = cvt_pk_bf16(s[0], s[1]); w.y = cvt_pk_bf16(s[2], s[3]);
                *(u32x2*)(merged + row * 1024 + o0) = w; }
    }
};
struct EpiResidual {
    bf16_t* xb; float sc;
    __device__ __forceinline__ void operator()(const Acc& acc, const Unit& u, int wr, int wc, int fr, int fq) const {
        const bool lo = fr < 8;
        const int row0 = u.pm * BM + wr * 64 + (fr & 7), col0 = u.pn * 256 + wc * 64 + 16 * fq + 8 * (fr >> 3);
#pragma unroll
        for (int ai = 0; ai < 2; ++ai)
#pragma unroll
            for (int m = 0; m < 4; ++m) { u32x4* p0 = (u32x4*)(xb + (size_t)(row0 + ai * HALF + m * 16) * 1024 + col0); u32x4* p1 = (u32x4*)((bf16_t*)p0 + 8 * 1024);
                const u32x4 t0 = *p0, t1 = *p1;
                f32x4 a0 = acc[ai][0][m][0] * sc, a1 = acc[ai][0][m][1] * sc, b0 = acc[ai][1][m][0] * sc, b1 = acc[ai][1][m][1] * sc;
#pragma unroll
                for (int e = 0; e < 4; ++e) { CM_SWAP_F(lo, a0[e], b0[e]); CM_SWAP_F(lo, a1[e], b1[e]); }
                u32x4 w0, w1;
                w0.x = cvt_pk_bf16(bflo(t0.x) + a0[0], bfhi(t0.x) + a0[1]); w0.y = cvt_pk_bf16(bflo(t0.y) + a0[2], bfhi(t0.y) + a0[3]); w0.z = cvt_pk_bf16(bflo(t0.z) + a1[0], bfhi(t0.z) + a1[1]); w0.w = cvt_pk_bf16(bflo(t0.w) + a1[2], bfhi(t0.w) + a1[3]);
                w1.x = cvt_pk_bf16(bflo(t1.x) + b0[0], bfhi(t1.x) + b0[1]); w1.y = cvt_pk_bf16(bflo(t1.y) + b0[2], bfhi(t1.y) + b0[3]); w1.z = cvt_pk_bf16(bflo(t1.z) + b1[0], bfhi(t1.z) + b1[1]); w1.w = cvt_pk_bf16(bflo(t1.w) + b1[2], bfhi(t1.w) + b1[3]);
                *p0 = w0; *p1 = w1; }
    }
};
struct EpiSwiglu {
    unsigned char* hid; int ldh, ncol; bool pad;
    __device__ __forceinline__ void operator()(const Acc& acc, const Unit& u, int wr, int wc, int fr, int fq) const {
        const int pl = u.pn % ncol; const int row0 = u.pm * BM + wr * 64 + fr, col0 = pl * 128 + wc * 32 + 8 * fq;
        const bool dopad = pad && (pl == ncol - 1);
#pragma unroll
        for (int ai = 0; ai < 2; ++ai)
#pragma unroll
            for (int m = 0; m < 4; ++m) { float v[8];
#pragma unroll
                for (int n = 0; n < 2; ++n)
#pragma unroll
                    for (int e = 0; e < 4; ++e) { const float a = acc[ai][0][m][n][e] * F8_DESCALE, b = acc[ai][1][m][n][e] * F8_DESCALE; v[4 * n + e] = a * sigm(a) * b * F8_MUL_H; }
                unsigned char* rp = hid + (size_t)(row0 + ai * HALF + m * 16) * ldh + col0;
                u32x2 w; w.x = pk4_fp8(v[0], v[1], v[2], v[3]); w.y = pk4_fp8(v[4], v[5], v[6], v[7]); *(u32x2*)rp = w;
                if (dopad) { unsigned z0; asm volatile("v_mov_b32 %0, 0" : "=v"(z0)); *(u32x2*)(rp + 128) = (u32x2){z0, z0}; } }
    }
};
struct EpiMoeOut {
    float* out; const int* rowtok; const float* rowgate; const int* segend;
    __device__ __forceinline__ void operator()(const Acc& acc, const Unit& u, int wr, int wc, int fr, int fq) const {
        const int row0 = u.pm * BM + wr * 64 + fr, col0 = (u.pn & 3) * 256 + wc * 32 + 8 * fq, lim = segend[u.pm];
#pragma unroll
        for (int ai = 0; ai < 2; ++ai)
#pragma unroll
            for (int m = 0; m < 4; ++m) { const int row = row0 + ai * HALF + m * 16;
                if (row < lim) { const int tok = rowtok[row]; const float gt = rowgate[row]; float* rowp = out + (size_t)tok * 1024 + col0;
#pragma unroll
                    for (int bj = 0; bj < 2; ++bj)
#pragma unroll
                        for (int n = 0; n < 2; ++n)
#pragma unroll
                            for (int e = 0; e < 4; ++e) __hip_atomic_fetch_add(rowp + bj * HALF + 4 * n + e, gt * acc[ai][bj][m][n][e], __ATOMIC_RELAXED, __HIP_MEMORY_SCOPE_AGENT);
                } }
    }
};
}

#define XB_TMO      128
#define XB_XCNT(j)  (256  + 64 * (j))
#define XB_XSUB(j)  (1280 + 64 * (j))
#define XB_XGEN(j)  (2304 + 64 * (j))
#define XB_TOP      3328
#define XB_TOPGEN   3392
#define XCD_BAR_WORDS 3456
#define XB_SPIN_CAP (1u << 18)
__device__ __forceinline__ unsigned xb_ld(unsigned* p)              { return __hip_atomic_load(p, __ATOMIC_RELAXED, __HIP_MEMORY_SCOPE_AGENT); }
__device__ __forceinline__ unsigned xb_add(unsigned* p, unsigned v) { return __hip_atomic_fetch_add(p, v, __ATOMIC_RELAXED, __HIP_MEMORY_SCOPE_AGENT); }
__device__ __forceinline__ unsigned xb_xcc_id() { return (unsigned)__builtin_amdgcn_s_getreg((3 << 11) | 20) & 0xFu; }
#define XB_SPIN(cond, bar) do { unsigned _sp = 0; while (cond) { __builtin_amdgcn_s_sleep(1); \
    if ((++_sp & 255u) == 0u) { if (xb_ld(&(bar)[XB_TMO])) break; if (_sp > XB_SPIN_CAP) { atomicAdd(&(bar)[XB_TMO], 1u); break; } } } } while (0)
struct XcdBarrier { unsigned* bar; unsigned x; volatile LAS unsigned* st; };
__device__ __forceinline__ XcdBarrier xcd_barrier_post(unsigned* bar, volatile LAS unsigned* st) {
    XcdBarrier b; b.bar = bar; b.x = xb_xcc_id(); b.st = st;
    if (threadIdx.x == 0) (void)xb_add(&bar[XB_XCNT(b.x)], 1u);
    return b;
}
__device__ __forceinline__ void xcd_barrier_complete(unsigned* bar, unsigned x, unsigned& nloc, unsigned& nx) {
    const unsigned G = gridDim.x * gridDim.y * gridDim.z;
    unsigned sum, cnt, mine, sp = 0u;
    for (;;) {
        sum = 0u; cnt = 0u; mine = 0u;
#pragma unroll
        for (unsigned j = 0; j < 16; ++j) { const unsigned c = xb_ld(&bar[XB_XCNT(j)]); sum += c; cnt += (c > 0u) ? 1u : 0u; mine = (j == x) ? c : mine; }
        if (sum == G) break;
        __builtin_amdgcn_s_sleep(1);
        if ((++sp & 255u) == 0u) { if (xb_ld(&bar[XB_TMO])) break; if (sp > XB_SPIN_CAP) { atomicAdd(&bar[XB_TMO], 1u); break; } }
    }
    nloc = mine > 0u ? mine : 1u; nx = cnt > 0u ? cnt : 1u;
}
__device__ __forceinline__ void xcd_barrier(const XcdBarrier& b, const int tid) {
    asm volatile("s_waitcnt vmcnt(0)" ::: "memory");
    __syncthreads();
    if (tid == 0) {
        unsigned* bar = b.bar;
        __builtin_amdgcn_s_waitcnt(0);
        unsigned nloc = b.st[0], nx = b.st[1];
        if (nloc == 0u) { xcd_barrier_complete(bar, b.x, nloc, nx); b.st[0] = nloc; b.st[1] = nx; }
        const unsigned old = xb_add(&bar[XB_XSUB(b.x)], 1u);
        const unsigned gen = old / nloc;
        if (old + 1u == (gen + 1u) * nloc) {
            __builtin_amdgcn_fence(__ATOMIC_RELEASE, "agent");
            asm volatile("s_waitcnt vmcnt(0)" ::: "memory");
            const unsigned og = xb_add(&bar[XB_TOP], 1u);
            const unsigned tg = og / nx;
            if (og + 1u == (tg + 1u) * nx) xb_add(&bar[XB_TOPGEN], 1u);
            else XB_SPIN(xb_ld(&bar[XB_TOPGEN]) == tg, bar);
            __builtin_amdgcn_fence(__ATOMIC_ACQUIRE, "agent");
            xb_add(&bar[XB_XGEN(b.x)], 1u);
            asm volatile("s_waitcnt vmcnt(0)" ::: "memory");
        } else {
            XB_SPIN(xb_ld(&bar[XB_XGEN(b.x)]) == gen, bar);
            __builtin_amdgcn_fence(__ATOMIC_ACQUIRE, "agent");
            asm volatile("s_waitcnt vmcnt(0)" ::: "memory");
        }
    }
    __syncthreads();
}

constexpr size_t MiB = 1u << 20;
constexpr size_t WS_CTL = 0, CTL_ZERO_BYTES = 1 * MiB;
constexpr int CW_BAR = 4096;
constexpr int CW_QUEUE = 20480;
constexpr int CW_MOE = 16384;
constexpr size_t WS_EIDX = 1 * MiB, WS_GATE = WS_EIDX + 256 * 1024, WS_ROWTOK = WS_EIDX + 512 * 1024, WS_ROWGATE = 2 * MiB, WS_TEXP = 2 * MiB + 512 * 1024, WS_SEGEND = WS_TEXP + 4096, WS_NT = WS_TEXP + 8192;
constexpr size_t WS_SLOTOF = 2 * MiB + 768 * 1024;
constexpr size_t WS_BON = 3 * MiB, WS_COS = 4 * MiB, WS_SIN = 6 * MiB;
constexpr size_t WS_WIN = 8 * MiB, WS_WLORA = 15 * MiB, WS_WB = 16 * MiB, WS_WG = 18 * MiB, WS_WOUT = 26 * MiB, WS_W13 = 28 * MiB  , WS_W2D = 50 * MiB, WS_W2M = 50 * MiB, WS_H8 = 72 * MiB  ;
constexpr size_t WS_XB = 104 * MiB  , WS_Y = 168 * MiB, WS_BIG = 232 * MiB;
constexpr size_t WS_RW = WS_BIG, WS_WDEC = WS_BIG, WS_AG = WS_BIG + 32 * MiB, WS_SB = WS_BIG + 64 * MiB, WS_RET = WS_BIG + 112 * MiB, WS_CV = WS_BIG + 176 * MiB, WS_Y0 = WS_CV;
constexpr size_t WS_RKVS = WS_BIG + 208 * MiB, WS_ALORA = WS_BIG + 256 * MiB, WS_RHAT = WS_ALORA, WS_KV = WS_BIG + 272 * MiB, WS_SST = WS_WDEC  , WS_PQ = WS_BIG + 304 * MiB  , WS_END = WS_BIG + 368 * MiB;
constexpr size_t WS_BALL = WS_BIG, WS_MERGED = WS_BIG + 256 * MiB, WS_HID = WS_BIG, WS_XS = WS_BIG, WS_YS = WS_XS, WS_HIDM = WS_BIG + 132 * MiB;
static_assert(WS_HIDM + (size_t)MPAD * DFE * 2 <= WS_END && WS_MERGED + (size_t)T * D * 2 <= WS_END && WS_W2M + (size_t)NEXP * D * DFE * 2 <= WS_H8, "ws map");
static_assert(WS_W13 + (size_t)NEXP * 2 * DFE * D <= WS_W2M && WS_W13 + (size_t)2 * DFF * D <= WS_W2D && WS_W2M + (size_t)NEXP * D * DFE * 2 <= WS_H8 && WS_H8 + (size_t)T * D <= WS_XB, "ws map weights");

constexpr int LDS_BYTES = 147456, RING_BYTES = 131072, MISC_OFF = RING_BYTES + 320;

struct Args { const float* in[32]; float* out; unsigned char* ws; int ph_lo, ph_hi; };
#define CAS __attribute__((address_space(4)))
struct Ctx {
    LAS unsigned char* lds; unsigned char* ws; float* out; const float* const CAS* in;
    int tid, lane, wave, G, bid;
};
__device__ __forceinline__ const CAS Args* ka_ptr() { const CAS Args* p = (const CAS Args*)__builtin_amdgcn_kernarg_segment_ptr(); asm volatile("" : "+s"(p)); return p; }
extern __shared__ __attribute__((aligned(16))) unsigned char lds_raw[];
__device__ __forceinline__ Ctx make_ctx(int wv) {
    const CAS Args* ka = ka_ptr();
    Ctx C; C.lds = (LAS unsigned char*)lds_raw; C.ws = ka->ws; C.out = ka->out; C.in = ka->in;
    int g_ = gridDim.x, b_ = blockIdx.x, w_ = wv; asm volatile("" : "+s"(g_), "+s"(b_), "+s"(w_));
    int ln_; asm volatile("v_mbcnt_lo_u32_b32 %0, -1, 0\n\tv_mbcnt_hi_u32_b32 %0, -1, %0" : "=v"(ln_));
    C.lane = ln_; C.wave = w_; C.tid = w_ * 64 + ln_; C.G = g_; C.bid = b_;
    return C;
}
enum { I_X = 0, I_NORM_MIX, I_W_IN, I_RW_MU, I_RW_W0, I_RW_W2, I_RW_A0, I_RW_A2, I_RW_G2, I_RW_KK, I_RW_KA, I_RW_RK, I_RW_LNW, I_RW_LNB, I_SB_QN, I_SB_KN, I_RET_GN,
       I_CONV_DW, I_CONV_B, I_CONV_LNW, I_CONV_LNB, I_W_GATE, I_W_BRANCH, I_W_OUT, I_NORM_FFN, I_FFN_W1, I_FFN_W3, I_FFN_W2, I_ROUTER, I_MOE_W1, I_MOE_W3, I_MOE_W2 };

__device__ __forceinline__ int q_next(const Ctx& C, unsigned* head) {
    LAS int* slot = (LAS int*)(C.lds + MISC_OFF + 64);
    __syncthreads();
    if (C.tid == 0) *slot = (int)__hip_atomic_fetch_add(head, 1u, __ATOMIC_RELAXED, __HIP_MEMORY_SCOPE_AGENT);
    __syncthreads();
    return *slot;
}
__device__ __forceinline__ void ph_prologue_(const Ctx& C) {
    const size_t gid = (size_t)C.bid * NTHR + C.tid, gsz = (size_t)C.G * NTHR;
    float* cs = (float*)(C.ws + WS_COS); float* sn = (float*)(C.ws + WS_SIN);
    for (size_t i = gid; i < (size_t)SEQ * 32; i += gsz) {
        const int pos = (int)(i >> 5), j = (int)(i & 31);
        const float inv = (float)pow(10000.0, -(double)(2 * j) / 64.0);
        const float ang = (float)pos * inv;
        cs[i] = (float)cos((double)ang); sn[i] = (float)sin((double)ang);
    }
}

__device__ __forceinline__ int dest_row(int mode, int roff, int which, int n) {
    if (mode == 0) return roff + n;
    if (mode == 1) { const int pn = n >> 6, oc = n & 63; return 256 * pn + 128 * (roff >> 1) + 32 * (oc >> 4) + 8 * ((oc >> 2) & 3) + 4 * (roff & 1) + (oc & 3); }
    if (mode == 3) {
        if (n < 2816) return n;
        const int j = n - 2816, isb = j >> 8, jl = j & 127, t = (j >> 7) & 1;
        return 2816 + 256 * t + 64 * (jl >> 5) + 16 * ((jl >> 3) & 3) + 8 * isb + (jl & 7); }
    return roff + 256 * (n >> 7) + 128 * which + (n & 127);
}
__device__ __forceinline__ void xpose_item(const float* W, int K, int N, bf16* WT, int mode, int roff, int which, LAS float* scr, int item, int lane) {
    const int nblk = N / 32, kb = item / nblk, nb = item % nblk, k0 = 64 * kb, n0 = 32 * nb;
#pragma unroll
    for (int i = 0; i < 8; ++i) { const int kk = (lane >> 3) + 8 * i, c4 = (lane & 7) * 4; const f32x4 v = *(const f32x4*)(W + (size_t)(k0 + kk) * N + n0 + c4);
        scr[kk * 33 + c4] = v.x; scr[kk * 33 + c4 + 1] = v.y; scr[kk * 33 + c4 + 2] = v.z; scr[kk * 33 + c4 + 3] = v.w; }
    asm volatile("s_waitcnt lgkmcnt(0)" ::: "memory");
    const int c = lane & 7;
#pragma unroll
    for (int j = 0; j < 4; ++j) { const int n = (lane >> 3) + 8 * j; const LAS float* s = scr + (8 * c) * 33 + n;
        u32x4 o; o.x = cvt_pk_bf16(s[0 * 33], s[1 * 33]); o.y = cvt_pk_bf16(s[2 * 33], s[3 * 33]); o.z = cvt_pk_bf16(s[4 * 33], s[5 * 33]); o.w = cvt_pk_bf16(s[6 * 33], s[7 * 33]);
        *(u32x4*)(WT + (size_t)dest_row(mode, roff, which, n0 + n) * K + k0 + 8 * c) = o; }
    asm volatile("s_waitcnt lgkmcnt(0)" ::: "memory");
}
__device__ __forceinline__ void xpose_item8(const float* W, int K, int N, unsigned char* WT, int mode, int roff, int which, LAS float* scr, int item, int lane, int ldk = 0) {
    if (ldk == 0) ldk = K;
    const int nblk = N / 32, kb = item / nblk, nb = item % nblk, k0 = 64 * kb, n0 = 32 * nb;
#pragma unroll
    for (int i = 0; i < 8; ++i) { const int kk = (lane >> 3) + 8 * i, c4 = (lane & 7) * 4; const f32x4 v = *(const f32x4*)(W + (size_t)(k0 + kk) * N + n0 + c4);
        scr[kk * 33 + c4] = v.x; scr[kk * 33 + c4 + 1] = v.y; scr[kk * 33 + c4 + 2] = v.z; scr[kk * 33 + c4 + 3] = v.w; }
    asm volatile("s_waitcnt lgkmcnt(0)" ::: "memory");
    const int c = lane & 3;
#pragma unroll
    for (int j = 0; j < 2; ++j) { const int n = (lane >> 2) + 16 * j; const LAS float* sp = scr + (16 * c) * 33 + n;
        u32x4 o;
        o.x = pk4_fp8(sp[0 * 33] * F8_MUL_W, sp[1 * 33] * F8_MUL_W, sp[2 * 33] * F8_MUL_W, sp[3 * 33] * F8_MUL_W);
        o.y = pk4_fp8(sp[4 * 33] * F8_MUL_W, sp[5 * 33] * F8_MUL_W, sp[6 * 33] * F8_MUL_W, sp[7 * 33] * F8_MUL_W);
        o.z = pk4_fp8(sp[8 * 33] * F8_MUL_W, sp[9 * 33] * F8_MUL_W, sp[10 * 33] * F8_MUL_W, sp[11 * 33] * F8_MUL_W);
        o.w = pk4_fp8(sp[12 * 33] * F8_MUL_W, sp[13 * 33] * F8_MUL_W, sp[14 * 33] * F8_MUL_W, sp[15 * 33] * F8_MUL_W);
        *(u32x4*)(WT + (size_t)dest_row(mode, roff, which, n0 + n) * ldk + k0 + 16 * c) = o; }
    asm volatile("s_waitcnt lgkmcnt(0)" ::: "memory");
}
__device__ __forceinline__ void ph_weights_(const Ctx& C, int l, int part, int first_wg, int nwg, unsigned* qhead = nullptr) {
    LAS float* scr = (LAS float*)(C.lds + C.wave * 16384);
    const int gw = (C.bid - first_wg) * NWAVES + C.wave, NGW = nwg * NWAVES, lane = C.lane;
    unsigned char* ws = C.ws;
    const bool moe = (l & 1);
    const int l2 = l >> 1;
    constexpr int IT_IN = (D / 64) * (NIN / 32), IT_B = (256 / 64) * (D / 32), IT_G = (D / 64) * (D / 32), IT_O = IT_G;
    constexpr int IT_F1 = (D / 64) * (DFF / 32), IT_F2 = (DFF / 64) * (D / 32), IT_M1 = (D / 64) * (DFE / 32), IT_M2 = (DFE / 64) * (D / 32);
    const int n_fixed = IT_IN + 4 * IT_B + 4 * IT_G + IT_O;
    if (part == 1) {
        if (C.bid < first_wg) return;
        const int n1 = moe ? NEXP * IT_M2 : (2 * IT_F1 + IT_F2);
        for (int it = qhead ? q_next(C, qhead) * NWAVES + C.wave : gw; qhead ? (it - C.wave < n1) : (it < n1); it = qhead ? q_next(C, qhead) * NWAVES + C.wave : it + NGW) {
            if (it >= n1) continue;
            int r = it;
            if (!moe) {
                if (r < IT_F1) { xpose_item8(C.in[I_FFN_W1] + (size_t)l2 * D * DFF, D, DFF, ws + WS_W13, 2, 0, 0, scr, r, lane); continue; } r -= IT_F1;
                if (r < IT_F1) { xpose_item8(C.in[I_FFN_W3] + (size_t)l2 * D * DFF, D, DFF, ws + WS_W13, 2, 0, 1, scr, r, lane); continue; } r -= IT_F1;
                xpose_item8(C.in[I_FFN_W2] + (size_t)l2 * DFF * D, DFF, D, ws + WS_W2D, 0, 0, 0, scr, r, lane);
            } else { const int e = r / IT_M2; r -= e * IT_M2;
                xpose_item8(C.in[I_MOE_W2] + ((size_t)l2 * NEXP + e) * DFE * D, DFE, D, ws + WS_W2M, 0, e * D, 0, scr, r, lane, DFE_PAD); }
        }
        if (moe) {
            for (int i = (C.bid - first_wg) * NTHR + C.tid; i < NEXP * D * ((DFE_PAD - DFE) / 16); i += nwg * NTHR) { const int row = i >> 3, c16 = i & 7;
                unsigned z0; asm volatile("v_mov_b32 %0, 0" : "=v"(z0)); *(u32x4*)(ws + WS_W2M + (size_t)row * DFE_PAD + DFE + 16 * c16) = (u32x4){z0, z0, z0, z0}; } }
        return;
    }
    const int n_ffn = moe ? (NEXP * 2 * IT_M1) : 0;
    for (int it = gw; it < n_fixed + n_ffn; it += NGW) {
        int r = it;
        if (r < IT_IN) { xpose_item(C.in[I_W_IN] + (size_t)l * D * NIN, D, NIN, (bf16*)(ws + WS_WIN), 3, 0, 0, scr, r, lane); continue; } r -= IT_IN;
        if (r < 4 * IT_B) { const int i = r / IT_B; xpose_item(C.in[I_W_BRANCH] + ((size_t)l * 4 + i) * 256 * D, 256, D, (bf16*)(ws + WS_WB), 0, 1024 * i, 0, scr, r % IT_B, lane); continue; } r -= 4 * IT_B;
        if (r < 4 * IT_G) { const int i = r / IT_G; xpose_item8(C.in[I_W_GATE] + ((size_t)l * 4 + i) * D * D, D, D, ws + WS_WG, 1, i, 0, scr, r % IT_G, lane); continue; } r -= 4 * IT_G;
        if (r < IT_O) { xpose_item(C.in[I_W_OUT] + (size_t)l * D * D, D, D, (bf16*)(ws + WS_WOUT), 0, 0, 0, scr, r, lane); continue; } r -= IT_O;
        { const int per = 2 * IT_M1, e = r / per; r -= e * per;
          if (r < IT_M1) { xpose_item8(C.in[I_MOE_W1] + ((size_t)l2 * NEXP + e) * D * DFE, D, DFE, ws + WS_W13, 2, e * 2 * DFE, 0, scr, r, lane); continue; } r -= IT_M1;
          xpose_item8(C.in[I_MOE_W3] + ((size_t)l2 * NEXP + e) * D * DFE, D, DFE, ws + WS_W13, 2, e * 2 * DFE, 1, scr, r, lane); }
    }
    bf16* WL = (bf16*)(ws + WS_WLORA);
    const float* w2 = C.in[I_RW_W2] + (size_t)l * 64 * 256; const float* a2 = C.in[I_RW_A2] + (size_t)l * 64 * 256; const float* g2 = C.in[I_RW_G2] + (size_t)l * 128 * 256;
    for (int i = C.bid * NTHR + C.tid; i < 768 * 256; i += C.G * NTHR) {
        const int n = i >> 8, k = i & 255; float v = 0.f;
        if (n < 256) { if (k < 64) v = w2[k * 256 + n]; }
        else if (n < 512) { if (k >= 64 && k < 128) v = a2[(k - 64) * 256 + (n - 256)]; }
        else { if (k >= 128) v = g2[(k - 128) * 256 + (n - 512)]; }
        WL[i] = f2bf(v);
    }
}

__device__ __forceinline__ void ph_norm_(const Ctx& C, const float* gain, bool route, const float* router, int moe_idx, bool combine = false, const float* src = nullptr, bool want_bf16 = true) {
    const int gw = C.bid * NWAVES + C.wave, NGW = C.G * NWAVES, lane = C.lane;
    bf16* H = (bf16*)C.out; bf16* XB = (bf16*)(C.ws + WS_XB);
    f32x4 g[4];
#pragma unroll
    for (int j = 0; j < 4; ++j) g[j] = *(const f32x4*)(gain + 8 * lane + 512 * (j >> 1) + 4 * (j & 1));
    LAS unsigned* lcnt = (LAS unsigned*)(C.lds);
    if (route) { if (C.tid < 8) lcnt[C.tid] = 0u; __syncthreads(); }
    int* eidx = (int*)(C.ws + WS_EIDX); float* gate = (float*)(C.ws + WS_GATE);
    constexpr int NR = 4;
    for (int mb = gw; mb < T; mb += NR * NGW) {
        f32x4 vv[NR][4]; u32x4 ya[NR][2], yb[NR][2]; float g0v[NR], g1v[NR];
#pragma unroll
        for (int r = 0; r < NR; ++r) { const int m = mb + r * NGW; if (m < T) {
            if (src) { const f32x4* xr = (const f32x4*)(src + (size_t)m * D + 8 * lane);
#pragma unroll
                for (int j = 0; j < 4; ++j) vv[r][j] = xr[128 * (j >> 1) + (j & 1)]; }
            else { const u32x4* xb = (const u32x4*)(XB + (size_t)m * D) + lane;
#pragma unroll
                for (int j = 0; j < 2; ++j) { const u32x4 t = xb[64 * j]; vv[r][2 * j] = f32x4{bflo(t.x), bfhi(t.x), bflo(t.y), bfhi(t.y)}; vv[r][2 * j + 1] = f32x4{bflo(t.z), bfhi(t.z), bflo(t.w), bfhi(t.w)}; } }
            if (combine) { const int* slotof = (const int*)(C.ws + WS_SLOTOF); const float* gt = (const float*)(C.ws + WS_GATE); const bf16* YS = (const bf16*)(C.ws + WS_YS);
                const int s0 = slotof[2 * m], s1 = slotof[2 * m + 1]; g0v[r] = gt[2 * m]; g1v[r] = gt[2 * m + 1];
                const u32x4* y0 = (const u32x4*)(YS + (size_t)s0 * D) + lane; const u32x4* y1 = (const u32x4*)(YS + (size_t)s1 * D) + lane;
#pragma unroll
                for (int j = 0; j < 2; ++j) { ya[r][j] = y0[64 * j]; yb[r][j] = y1[64 * j]; } } } }
#pragma unroll
        for (int r = 0; r < NR; ++r) { const int m = mb + r * NGW; if (m < T) {
        f32x4 v[4]; float s = 0.f;
#pragma unroll
        for (int j = 0; j < 4; ++j) v[j] = vv[r][j];
        if (combine) {
            const float g0 = g0v[r], g1 = g1v[r];
#pragma unroll
            for (int j = 0; j < 2; ++j) { const u32x4 a = ya[r][j], b = yb[r][j];
                v[2 * j].x += g0 * bflo(a.x) + g1 * bflo(b.x); v[2 * j].y += g0 * bfhi(a.x) + g1 * bfhi(b.x); v[2 * j].z += g0 * bflo(a.y) + g1 * bflo(b.y); v[2 * j].w += g0 * bfhi(a.y) + g1 * bfhi(b.y);
                v[2 * j + 1].x += g0 * bflo(a.z) + g1 * bflo(b.z); v[2 * j + 1].y += g0 * bfhi(a.z) + g1 * bfhi(b.z); v[2 * j + 1].z += g0 * bflo(a.w) + g1 * bflo(b.w); v[2 * j + 1].w += g0 * bfhi(a.w) + g1 * bfhi(b.w); }
        }
        if (combine || src) { u32x4* xo = (u32x4*)(XB + (size_t)m * D) + lane;
#pragma unroll
            for (int j = 0; j < 2; ++j) { u32x4 t; t.x = cvt_pk_bf16(v[2 * j].x, v[2 * j].y); t.y = cvt_pk_bf16(v[2 * j].z, v[2 * j].w); t.z = cvt_pk_bf16(v[2 * j + 1].x, v[2 * j + 1].y); t.w = cvt_pk_bf16(v[2 * j + 1].z, v[2 * j + 1].w); xo[64 * j] = t; } }
#pragma unroll
        for (int j = 0; j < 4; ++j) s += (v[j].x * v[j].x + v[j].y * v[j].y) + (v[j].z * v[j].z + v[j].w * v[j].w);
        const float rs = 1.0f / sqrtf(wave_sum(s, C.lane) * (1.f / D) + 1e-6f);
#pragma unroll
        for (int j = 0; j < 4; ++j) v[j] = v[j] * rs * g[j];
#pragma unroll
        for (int j = 0; j < 2; ++j) {
            if (want_bf16) { u32x4 t; t.x = cvt_pk_bf16(v[2 * j].x, v[2 * j].y); t.y = cvt_pk_bf16(v[2 * j].z, v[2 * j].w); t.z = cvt_pk_bf16(v[2 * j + 1].x, v[2 * j + 1].y); t.w = cvt_pk_bf16(v[2 * j + 1].z, v[2 * j + 1].w);
                ((u32x4*)(H + (size_t)m * D) + lane)[64 * j] = t; }
            u32x2 q; q.x = pk4_fp8(v[2 * j].x * F8_MUL_X, v[2 * j].y * F8_MUL_X, v[2 * j].z * F8_MUL_X, v[2 * j].w * F8_MUL_X); q.y = pk4_fp8(v[2 * j + 1].x * F8_MUL_X, v[2 * j + 1].y * F8_MUL_X, v[2 * j + 1].z * F8_MUL_X, v[2 * j + 1].w * F8_MUL_X);
            ((u32x2*)(C.ws + WS_H8 + (size_t)m * D) + lane)[64 * j] = q; }
        if (route) {
            float lg[8];
#pragma unroll
            for (int e = 0; e < 8; ++e) lg[e] = 0.f;
#pragma unroll
            for (int j = 0; j < 4; ++j)
#pragma unroll
                for (int q = 0; q < 4; ++q) { const int k = 8 * lane + 512 * (j >> 1) + 4 * (j & 1) + q; const f32x4 r0 = *(const f32x4*)(router + (size_t)k * 8), r1 = *(const f32x4*)(router + (size_t)k * 8 + 4); const float hv = v[j][q];
                    lg[0] += hv * r0.x; lg[1] += hv * r0.y; lg[2] += hv * r0.z; lg[3] += hv * r0.w; lg[4] += hv * r1.x; lg[5] += hv * r1.y; lg[6] += hv * r1.z; lg[7] += hv * r1.w; }
#pragma unroll
            for (int e = 0; e < 8; ++e) lg[e] = wave_sum(lg[e], C.lane);
            int e0 = 0; float b0 = lg[0];
#pragma unroll
            for (int e = 1; e < 8; ++e) if (lg[e] > b0) { b0 = lg[e]; e0 = e; }
            int e1 = -1; float b1 = -3.0e38f;
#pragma unroll
            for (int e = 0; e < 8; ++e) if (e != e0 && lg[e] > b1) { b1 = lg[e]; e1 = e; }
            const float p1 = __expf(b1 - b0), inv = 1.f / (1.f + p1);
            if (lane == 0) { eidx[2 * m] = e0; eidx[2 * m + 1] = e1; gate[2 * m] = inv; gate[2 * m + 1] = p1 * inv; atomicAdd((unsigned*)&lcnt[e0], 1u); atomicAdd((unsigned*)&lcnt[e1], 1u); }
        }
        } }
    }
    if (route) { __syncthreads(); if (C.tid < 8) { unsigned* cw = (unsigned*)(C.ws + WS_CTL) + CW_MOE + moe_idx * 64; atomicAdd(&cw[C.tid], lcnt[C.tid]); } }
}

__device__ __forceinline__ void ph_rw_prep_(const Ctx& C, int l) {
    const bf16* RW = (const bf16*)(C.ws + WS_RW); bf16* RKVS = (bf16*)(C.ws + WS_RKVS); bf16* AL = (bf16*)(C.ws + WS_ALORA);
    const float* mu = C.in[I_RW_MU] + (size_t)l * 1024;
    const size_t gid = (size_t)C.bid * NTHR + C.tid, gsz = (size_t)C.G * NTHR;
    constexpr int NI = 4;
    for (size_t it0 = gid; it0 < (size_t)T * 128; it0 += NI * gsz) {
        u32x4 cuv[NI], pvv[NI]; f32x4 mu0[NI], mu1[NI];
#pragma unroll
        for (int r = 0; r < NI; ++r) { const size_t it = it0 + r * gsz; cuv[r] = (u32x4){0u, 0u, 0u, 0u}; pvv[r] = cuv[r]; mu0[r] = (f32x4){0.f, 0.f, 0.f, 0.f}; mu1[r] = mu0[r];
            if (it < (size_t)T * 128) { const int m = (int)(it >> 7), c8 = (int)(it & 127) * 8, t = m & (SEQ - 1);
                cuv[r] = *(const u32x4*)(RW + (size_t)m * 1024 + c8); if (t) pvv[r] = *(const u32x4*)(RW + (size_t)(m - 1) * 1024 + c8); mu0[r] = *(const f32x4*)(mu + c8); mu1[r] = *(const f32x4*)(mu + c8 + 4); } }
#pragma unroll
        for (int r = 0; r < NI; ++r) { const size_t it = it0 + r * gsz; if (it < (size_t)T * 128) {
        const int m = (int)(it >> 7), c8 = (int)(it & 127) * 8;
        float a[8], b[8]; unpack8(cuv[r], a); unpack8(pvv[r], b);
        const f32x4 m0 = mu0[r], m1 = mu1[r];
        const float mm[8] = {m0.x, m0.y, m0.z, m0.w, m1.x, m1.y, m1.z, m1.w};
#pragma unroll
        for (int e = 0; e < 8; ++e) a[e] = a[e] + (b[e] - a[e]) * mm[e];
        if (c8 < 768) { *(u32x4*)(RKVS + (size_t)m * 768 + c8) = pack8(a); }
        else {
            if (c8 < 832) {
#pragma unroll
                for (int e = 0; e < 8; ++e) a[e] = 1.f - 2.f * __builtin_amdgcn_rcpf(1.f + __builtin_amdgcn_exp2f(2.f * LOG2E * a[e]));
            } else if (c8 >= 896) {
#pragma unroll
                for (int e = 0; e < 8; ++e) a[e] = sigm(a[e]);
            }
            *(u32x4*)(AL + (size_t)m * 256 + (c8 - 768)) = pack8(a);
        } } }
    }
}

__device__ __forceinline__ void ph_sb_prep_(const Ctx& C, int l) {
    bf16* SB = (bf16*)(C.ws + WS_SB);
    const int gw = C.bid * NWAVES + C.wave, NGW = C.G * NWAVES, lane = C.lane;
    const bool isk = lane >= 32; const int d0 = (lane & 7) * 8;
    const float* gn = (isk ? C.in[I_SB_KN] : C.in[I_SB_QN]) + (size_t)l * 64 + d0;
    float gg[8];
#pragma unroll
    for (int e = 0; e < 8; ++e) gg[e] = gn[e] * (isk ? 1.f : 0.125f * LOG2E);
    constexpr int NR = 4;
    for (int mb = gw; mb < T; mb += NR * NGW) {
        u32x4 uu[NR];
#pragma unroll
        for (int r = 0; r < NR; ++r) { const int m = mb + r * NGW; uu[r] = (u32x4){0u, 0u, 0u, 0u}; if (m < T) uu[r] = *(const u32x4*)(SB + (size_t)m * 768 + lane * 8); }
#pragma unroll
        for (int r = 0; r < NR; ++r) { const int m = mb + r * NGW; if (m < T) {
            bf16* p = SB + (size_t)m * 768 + lane * 8;
            float a[8]; unpack8(uu[r], a);
            float ss = 0.f;
#pragma unroll
            for (int e = 0; e < 8; ++e) ss += a[e] * a[e];
            ss += shx(ss, 1, lane); ss += shx(ss, 2, lane); ss += shx(ss, 4, lane);
            const float rs = 1.0f / sqrtf(ss * (1.f / 64.f) + 1e-6f);
#pragma unroll
            for (int e = 0; e < 8; ++e) a[e] = a[e] * rs * gg[e];
            *(u32x4*)p = pack8(a); } }
    }
}

__device__ __forceinline__ void ph_conv_(const Ctx& C, int l) {
    const bf16* CV = (const bf16*)(C.ws + WS_CV); bf16* Y = (bf16*)(C.ws + WS_Y);
    LAS float* U = (LAS float*)(C.lds); LAS float* OC = (LAS float*)(C.lds + 65536);
    const int tid = C.tid, c = tid & 255, half = tid >> 8;
    const float* dw = C.in[I_CONV_DW] + (size_t)l * 31 * 256; const float db = C.in[I_CONV_B][l * 256 + c];
    float dwr[31];
#pragma unroll
    for (int j = 0; j < 31; ++j) dwr[j] = dw[j * 256 + c];
    const float* lnw = C.in[I_CONV_LNW] + (size_t)l * 256; const float* lnb = C.in[I_CONV_LNB] + (size_t)l * 256;
    for (int u = C.bid; u < T / 32; u += C.G) {
        const int m0 = u * 32, t0 = m0 & (SEQ - 1);
        for (int it = tid; it < 62 * 32; it += NTHR) {
            const int r = it >> 5, c8 = (it & 31) * 8, tt = t0 - 30 + r; float a[8], b[8];
            if (tt >= 0) { const size_t mm = (size_t)(m0 - 30 + r); unpack8(*(const u32x4*)(CV + mm * 256 + c8), a); (void)b; }
            else {
#pragma unroll
                for (int e = 0; e < 8; ++e) a[e] = 0.f; }
#pragma unroll
            for (int e = 0; e < 8; ++e) U[r * 256 + c8 + e] = a[e];
        }
        __syncthreads();
        { float win[46];
#pragma unroll
          for (int i = 0; i < 46; ++i) win[i] = U[(half * 16 + i) * 256 + c];
#pragma unroll
          for (int tt = 0; tt < 16; ++tt) { float acc = db;
#pragma unroll
              for (int j = 0; j < 31; ++j) acc += dwr[j] * win[tt + j];
              OC[(half * 16 + tt) * 256 + c] = acc; } }
        __syncthreads();
#pragma unroll 1
        for (int q = 0; q < 4; ++q) { const int tl = C.wave * 4 + q; float v[4]; float s = 0.f;
#pragma unroll
            for (int i = 0; i < 4; ++i) { v[i] = OC[tl * 256 + C.lane + 64 * i]; s += v[i]; }
            const float mean = wave_sum(s, C.lane) * (1.f / 256.f); float s2 = 0.f;
#pragma unroll
            for (int i = 0; i < 4; ++i) { v[i] -= mean; s2 += v[i] * v[i]; }
            const float rstd = 1.0f / sqrtf(wave_sum(s2, C.lane) * (1.f / 256.f) + 1e-5f);
#pragma unroll
            for (int i = 0; i < 4; ++i) { const int cc = C.lane + 64 * i; const float y = v[i] * rstd * lnw[cc] + lnb[cc]; Y[(size_t)(m0 + tl) * 1024 + 768 + cc] = f2bf(y * sigm(y)); } }
        __syncthreads();
    }
}

__device__ __forceinline__ float ret_log2gamma(int h) { return log2f(1.0f - exp2f(-5.0f - (float)h)); }
__device__ __forceinline__ void ret_load_rot(const Ctx& C, const bf16* RET, int m0, int coff, float scale, LAS float* dst) {
    const int s = C.tid >> 3, d0 = (C.tid & 7) * 4;
    const float* cs = (const float*)(C.ws + WS_COS); const float* sn = (const float*)(C.ws + WS_SIN);
    const int pos = (m0 + s) & (SEQ - 1);
    const u32x2 a = *(const u32x2*)(RET + (size_t)(m0 + s) * 1024 + coff + d0), b = *(const u32x2*)(RET + (size_t)(m0 + s) * 1024 + coff + 32 + d0);
    const float x1[4] = {bflo(a.x), bfhi(a.x), bflo(a.y), bfhi(a.y)}, x2[4] = {bflo(b.x), bfhi(b.x), bflo(b.y), bfhi(b.y)};
    const f32x4 cv = *(const f32x4*)(cs + (size_t)pos * 32 + d0), sv = *(const f32x4*)(sn + (size_t)pos * 32 + d0);
#pragma unroll
    for (int e = 0; e < 4; ++e) { dst[s * 65 + d0 + e] = (x1[e] * cv[e] - x2[e] * sv[e]) * scale; dst[s * 65 + 32 + d0 + e] = (x1[e] * sv[e] + x2[e] * cv[e]) * scale; }
}
__device__ __forceinline__ void ph_ret_kv_(const Ctx& C) {
    const bf16* RET = (const bf16*)(C.ws + WS_RET); float* KV = (float*)(C.ws + WS_KV);
    LAS float* KD = (LAS float*)(C.lds); LAS float* VV = (LAS float*)(C.lds + 32768);
    const int tid = C.tid;
    for (int u = C.bid; u < 2048; u += C.G) {
        const int bh = u >> 8, ch = u & 255, b = bh >> 2, h = bh & 3, m0 = b * SEQ + ch * 64;
        const float lg = ret_log2gamma(h);
        ret_load_rot(C, RET, m0, 256 + h * 64, 0.125f, KD);
        { const int s = tid >> 3, e0 = (tid & 7) * 8; float a[8]; unpack8(*(const u32x4*)(RET + (size_t)(m0 + s) * 1024 + 512 + h * 64 + e0), a);
          const float dec = exp2f(lg * (float)(63 - s));
#pragma unroll
          for (int e = 0; e < 8; ++e) VV[s * 64 + e0 + e] = a[e] * dec; }
        __syncthreads();
        const int d = tid >> 3, e0 = (tid & 7) * 8; float acc[8];
#pragma unroll
        for (int e = 0; e < 8; ++e) acc[e] = 0.f;
#pragma unroll 4
        for (int s = 0; s < 64; ++s) { const float kd = KD[s * 65 + d]; const f32x4 v0 = *(const LAS f32x4*)(VV + s * 64 + e0), v1 = *(const LAS f32x4*)(VV + s * 64 + e0 + 4);
            acc[0] += kd * v0.x; acc[1] += kd * v0.y; acc[2] += kd * v0.z; acc[3] += kd * v0.w; acc[4] += kd * v1.x; acc[5] += kd * v1.y; acc[6] += kd * v1.z; acc[7] += kd * v1.w; }
        float* o = KV + (size_t)u * 4096 + d * 64 + e0;
        *(f32x4*)o = (f32x4){acc[0], acc[1], acc[2], acc[3]}; *(f32x4*)(o + 4) = (f32x4){acc[4], acc[5], acc[6], acc[7]};
        __syncthreads();
    }
}
__device__ __forceinline__ void ph_ret_scan_(const Ctx& C) {
    float* KV = (float*)(C.ws + WS_KV);
    const int wg0 = (C.G >= 256) ? 128 : 0, nw = C.G - wg0;
    for (int i = (C.bid - wg0) * NTHR + C.tid; i < 8 * 4096 && C.bid >= wg0; i += nw * NTHR) {
        const int bh = i >> 12, el = i & 4095, h = bh & 3;
        const float cd = exp2f(ret_log2gamma(h) * 64.f);
        float* p = KV + (size_t)bh * 256 * 4096 + el; float S = 0.f;
#pragma unroll 1
        for (int c = 0; c < 256; c += 32) { float kv[32];
#pragma unroll
            for (int q = 0; q < 32; ++q) kv[q] = p[(size_t)(c + q) * 4096];
#pragma unroll
            for (int q = 0; q < 32; ++q) { p[(size_t)(c + q) * 4096] = S; S = S * cd + kv[q]; } }
    }
}
__device__ __forceinline__ void ph_ret_out_(const Ctx& C, int l, int first_wg, int nwg) {
    const bf16* RET = (const bf16*)(C.ws + WS_RET); const float* KV = (const float*)(C.ws + WS_KV); bf16* Y = (bf16*)(C.ws + WS_Y);
    LAS float* Q = (LAS float*)(C.lds); LAS float* Kk = (LAS float*)(C.lds + 16640); LAS float* VV = (LAS float*)(C.lds + 33280); LAS float* SS = (LAS float*)(C.lds + 49664); LAS float* SC = (LAS float*)(C.lds + 66048);
    const int tid = C.tid; const float* gn = C.in[I_RET_GN] + (size_t)l * 256;
    for (int u = C.bid - first_wg; u < 2048; u += nwg) {
        const int bh = u >> 8, ch = u & 255, b = bh >> 2, h = bh & 3, m0 = b * SEQ + ch * 64;
        const float lg = ret_log2gamma(h);
        ret_load_rot(C, RET, m0, h * 64, 1.0f, Q);
        ret_load_rot(C, RET, m0, 256 + h * 64, 0.125f, Kk);
        { const int s = tid >> 3, e0 = (tid & 7) * 8; float a[8]; unpack8(*(const u32x4*)(RET + (size_t)(m0 + s) * 1024 + 512 + h * 64 + e0), a);
#pragma unroll
          for (int e = 0; e < 8; ++e) VV[s * 64 + e0 + e] = a[e];
          const float* sp = KV + (size_t)u * 4096 + s * 64 + e0; const f32x4 s0 = *(const f32x4*)sp, s1 = *(const f32x4*)(sp + 4);
          *(LAS f32x4*)(SS + s * 64 + e0) = s0; *(LAS f32x4*)(SS + s * 64 + e0 + 4) = s1; }
        __syncthreads();
        const int t = tid >> 3, g8 = tid & 7;
        { float sc[8];
#pragma unroll
          for (int i = 0; i < 8; ++i) sc[i] = 0.f;
#pragma unroll 4
          for (int d = 0; d < 64; ++d) { const float qv = Q[t * 65 + d];
#pragma unroll
              for (int i = 0; i < 8; ++i) sc[i] += qv * Kk[(g8 * 8 + i) * 65 + d]; }
#pragma unroll
          for (int i = 0; i < 8; ++i) { const int s = g8 * 8 + i; SC[t * 65 + s] = (s <= t) ? sc[i] * exp2f(lg * (float)(t - s)) : 0.f; } }
        __syncthreads();
        { const int e0 = g8 * 8; float o[8], o2[8];
#pragma unroll
          for (int e = 0; e < 8; ++e) { o[e] = 0.f; o2[e] = 0.f; }
#pragma unroll 4
          for (int s = 0; s < 64; ++s) { const float p = SC[t * 65 + s]; const f32x4 v0 = *(const LAS f32x4*)(VV + s * 64 + e0), v1 = *(const LAS f32x4*)(VV + s * 64 + e0 + 4);
              o[0] += p * v0.x; o[1] += p * v0.y; o[2] += p * v0.z; o[3] += p * v0.w; o[4] += p * v1.x; o[5] += p * v1.y; o[6] += p * v1.z; o[7] += p * v1.w; }
#pragma unroll 4
          for (int d = 0; d < 64; ++d) { const float qv = Q[t * 65 + d]; const f32x4 v0 = *(const LAS f32x4*)(SS + d * 64 + e0), v1 = *(const LAS f32x4*)(SS + d * 64 + e0 + 4);
              o2[0] += qv * v0.x; o2[1] += qv * v0.y; o2[2] += qv * v0.z; o2[3] += qv * v0.w; o2[4] += qv * v1.x; o2[5] += qv * v1.y; o2[6] += qv * v1.z; o2[7] += qv * v1.w; }
          const float qd = exp2f(lg * (float)(t + 1)); float s1 = 0.f;
#pragma unroll
          for (int e = 0; e < 8; ++e) { o[e] += qd * o2[e]; s1 += o[e]; }
          s1 += shx(s1, 1, C.lane); s1 += shx(s1, 2, C.lane); s1 += shx(s1, 4, C.lane);
          const float mean = s1 * (1.f / 64.f); float s2 = 0.f;
#pragma unroll
          for (int e = 0; e < 8; ++e) { o[e] -= mean; s2 += o[e] * o[e]; }
          s2 += shx(s2, 1, C.lane); s2 += shx(s2, 2, C.lane); s2 += shx(s2, 4, C.lane);
          const float rstd = 1.0f / sqrtf(s2 * (1.f / 64.f) + 1e-5f);
          float gtv[8]; unpack8(*(const u32x4*)(RET + (size_t)(m0 + t) * 1024 + 768 + h * 64 + e0), gtv);
#pragma unroll
          for (int e = 0; e < 8; ++e) o[e] = o[e] * rstd * gn[h * 64 + e0 + e] * (gtv[e] * sigm(gtv[e]));
          *(u32x4*)(Y + (size_t)(m0 + t) * 1024 + 512 + h * 64 + e0) = pack8(o); }
        __syncthreads();
    }
}

constexpr int RWC = 64, RW_NCH = SEQ / RWC, RW_NU = 8 * RW_NCH;
constexpr int RW_SUP = 8, RW_NSC = RW_NCH / RW_SUP, RW_NSUP = 8 * RW_NSC;
__device__ __forceinline__ void ph_rw_local_(const Ctx& C, int l) {
    const bf16* RKVS = (const bf16*)(C.ws + WS_RKVS); const float* WDEC = (const float*)(C.ws + WS_WDEC); const bf16* AG = (const bf16*)(C.ws + WS_AG);
    bf16* Y0 = (bf16*)(C.ws + WS_Y0); bf16* RH = (bf16*)(C.ws + WS_RHAT); float* PQ = (float*)(C.ws + WS_PQ); float* BON = (float*)(C.ws + WS_BON);
    const int lane = C.lane;
    LAS float* base = (LAS float*)(C.lds + C.wave * 12288);
    for (int it = C.bid; it < RW_NU / 8; it += C.G) {
        const int u = it * 8 + C.wave, bh = u >> 8, ch = u & 255, b = bh >> 2, h = bh & 3, m0 = b * SEQ + ch * RWC, hc = h * 64 + lane;
        const float kkw = C.in[I_RW_KK][l * 256 + hc], kaw = C.in[I_RW_KA][l * 256 + hc], rkw = C.in[I_RW_RK][l * 256 + hc], w0l = C.in[I_RW_W0][l * 256 + hc], a0l = C.in[I_RW_A0][l * 256 + hc];
        f32x2 sL[32], sI[32];
        { int ln = lane; asm volatile("" : "+v"(ln));
#pragma unroll
          for (int k = 0; k < 32; ++k) { sL[k] = (f32x2){0.f, 0.f}; sI[k].x = (2 * k == ln) ? 1.f : 0.f; sI[k].y = (2 * k + 1 == ln) ? 1.f : 0.f; } }
#pragma unroll 1
        for (int sb = 0; sb < RWC / 8; ++sb) {
            asm volatile("" ::: "memory");
#pragma unroll
            for (int i = 0; i < 8; ++i) { const size_t m = (size_t)(m0 + sb * 8 + i);
                const float r = bf2f(RKVS[m * 768 + hc]), k = bf2f(RKVS[m * 768 + 256 + hc]), v = bf2f(RKVS[m * 768 + 512 + hc]);
                const float w = __builtin_amdgcn_exp2f(-0.606531f * LOG2E * sigm(WDEC[m * 256 + hc] + w0l)), a = sigm(bf2f(AG[m * 512 + hc]) + a0l);
                const float kr = k * kkw; const float nn = sqrtf(wave_sum(kr * kr, C.lane)); const float kk = kr / fmaxf(nn, 1e-12f);
                const float kp = k * (1.f + (a - 1.f) * kaw);
                const float bon = wave_sum(r * kp * rkw, C.lane);
                if (lane == 0) BON[m * 4 + h] = bon;
                base[0 * 512 + i * 64 + lane] = w; base[1 * 512 + i * 64 + lane] = kk; base[2 * 512 + i * 64 + lane] = kk * a; base[3 * 512 + i * 64 + lane] = kp; base[4 * 512 + i * 64 + lane] = r; base[5 * 512 + i * 64 + lane] = v; }
            asm volatile("" ::: "memory");
#pragma unroll 1
            for (int i = 0; i < 8; ++i) {
                const LAS f32x4* wv = (const LAS f32x4*)(base + 0 * 512 + i * 64); const LAS f32x4* kkv = (const LAS f32x4*)(base + 1 * 512 + i * 64); const LAS f32x4* kav = (const LAS f32x4*)(base + 2 * 512 + i * 64);
                const LAS f32x4* kpv = (const LAS f32x4*)(base + 3 * 512 + i * 64); const LAS f32x4* rv = (const LAS f32x4*)(base + 4 * 512 + i * 64);
                const float vv = base[5 * 512 + i * 64 + lane];
                f32x4 kq[2][4];
#pragma unroll
                for (int t = 0; t < 4; ++t) kq[0][t] = kkv[t];
                f32x2 dL0 = (f32x2){0.f, 0.f}, dL1 = dL0, dI0 = dL0, dI1 = dL0;
                f32x4 ga[2][4];
#pragma unroll
                for (int g = 0; g < 4; ++g) {
                    __builtin_amdgcn_sched_barrier(0);
                    if (g + 1 < 4) {
#pragma unroll
                        for (int t = 0; t < 4; ++t) kq[(g + 1) & 1][t] = kkv[4 * (g + 1) + t]; }
                    else { ga[0][0] = wv[0]; ga[0][1] = kav[0]; ga[0][2] = kpv[0]; ga[0][3] = rv[0]; }
                    __builtin_amdgcn_sched_barrier(0);
#pragma unroll
                    for (int t = 0; t < 4; ++t) { const int k4 = 4 * g + t; const f32x4 q4 = kq[g & 1][t];
                        dL0 += sL[2 * k4] * q4.xy; dL1 += sL[2 * k4 + 1] * q4.zw; dI0 += sI[2 * k4] * q4.xy; dI1 += sI[2 * k4 + 1] * q4.zw; }
                }
                const float saL = -((dL0.x + dL0.y) + (dL1.x + dL1.y)), saI = -((dI0.x + dI0.y) + (dI1.x + dI1.y));
                const f32x2 saLv = (f32x2){saL, saL}, saIv = (f32x2){saI, saI}, vvv = (f32x2){vv, vv};
                f32x2 yL0 = (f32x2){0.f, 0.f}, yL1 = yL0, yI0 = yL0, yI1 = yL0;
#pragma unroll
                for (int k4 = 0; k4 < 16; ++k4) {
                    __builtin_amdgcn_sched_barrier(0);
                    if (k4 + 1 < 16) { ga[(k4 + 1) & 1][0] = wv[k4 + 1]; ga[(k4 + 1) & 1][1] = kav[k4 + 1]; ga[(k4 + 1) & 1][2] = kpv[k4 + 1]; ga[(k4 + 1) & 1][3] = rv[k4 + 1]; }
                    __builtin_amdgcn_sched_barrier(0);
                    const f32x4 wq = ga[k4 & 1][0], aq = ga[k4 & 1][1], pq = ga[k4 & 1][2], rq = ga[k4 & 1][3];
                    sL[2 * k4]     = sL[2 * k4]     * wq.xy + saLv * aq.xy + vvv * pq.xy; yL0 += sL[2 * k4]     * rq.xy;
                    sL[2 * k4 + 1] = sL[2 * k4 + 1] * wq.zw + saLv * aq.zw + vvv * pq.zw; yL1 += sL[2 * k4 + 1] * rq.zw;
                    sI[2 * k4]     = sI[2 * k4]     * wq.xy + saIv * aq.xy;                  yI0 += sI[2 * k4]     * rq.xy;
                    sI[2 * k4 + 1] = sI[2 * k4 + 1] * wq.zw + saIv * aq.zw;                  yI1 += sI[2 * k4 + 1] * rq.zw;
                }
                __builtin_amdgcn_sched_barrier(0);
                const size_t m = (size_t)(m0 + sb * 8 + i);
                Y0[m * 256 + hc] = f2bf((yL0.x + yL0.y) + (yL1.x + yL1.y));
                RH[m * 256 + hc] = f2bf((yI0.x + yI0.y) + (yI1.x + yI1.y));
            }
        }
        float* oq = PQ + (size_t)u * 4096 + lane * 64; float* opt = PQ + ((size_t)RW_NU + u) * 4096 + lane;
#pragma unroll
        for (int k4 = 0; k4 < 16; ++k4) { *(f32x4*)(oq + 4 * k4) = (f32x4){sL[2 * k4].x, sL[2 * k4].y, sL[2 * k4 + 1].x, sL[2 * k4 + 1].y};
            opt[(4 * k4) * 64] = sI[2 * k4].x; opt[(4 * k4 + 1) * 64] = sI[2 * k4].y; opt[(4 * k4 + 2) * 64] = sI[2 * k4 + 1].x; opt[(4 * k4 + 3) * 64] = sI[2 * k4 + 1].y; }
    }
}
constexpr int WY_LT = 24;
constexpr int WY_ROWM = 0, WY_COLM = 36864, WY_AMAT = 73728, WY_AABF = 89088, WY_SB = 93184, WY_WT = 111616, WY_UT = 117760, WY_GH = 123904, WY_GC = 125952;
__device__ __forceinline__ f32x4 wy_mm16(const LAS bf16* X, const LAS bf16* Y, f32x4 acc, int li, int lq) {
#pragma unroll
    for (int ks = 0; ks < 2; ++ks) { const bf16x8 a = *(const LAS bf16x8*)(X + li * MM_LP + 32 * ks + 8 * lq), b = *(const LAS bf16x8*)(Y + li * MM_LP + 32 * ks + 8 * lq);
        acc = __builtin_amdgcn_mfma_f32_16x16x32_bf16(a, b, acc, 0, 0, 0); }
    return acc;
}
__device__ __forceinline__ f32x4 wy_mm16k16(const LAS bf16* X, const LAS bf16* Y, f32x4 acc, int li, int lq) {
    const s16x4 a = *(const LAS s16x4*)(X + li * WY_LT + 4 * lq), b = *(const LAS s16x4*)(Y + li * WY_LT + 4 * lq);
    return __builtin_amdgcn_mfma_f32_16x16x16bf16_1k(a, b, acc, 0, 0, 0);
}
__device__ __forceinline__ void ph_rw_local_wy_(const Ctx& C, int l) {
    const bf16* RKVS = (const bf16*)(C.ws + WS_RKVS); const float* WDEC = (const float*)(C.ws + WS_WDEC); const bf16* AG = (const bf16*)(C.ws + WS_AG);
    bf16* Y0 = (bf16*)(C.ws + WS_Y0); bf16* RH = (bf16*)(C.ws + WS_RHAT); float* PQ = (float*)(C.ws + WS_PQ); float* BON = (float*)(C.ws + WS_BON);
    const int lane = C.lane, w = C.wave, li = lane & 15, lq = lane >> 4, j32 = lane & 31, hi = lane >> 5, ti = w >> 1, tj = w & 1, sq = w >> 1, half = w & 1;
    LAS unsigned char* L = C.lds;
#define WY_ROW(q, m) ((LAS bf16*)(L + WY_ROWM + (q) * 9216 + (m) * 2304))
#define WY_COL(q, m) ((LAS bf16*)(L + WY_COLM + (q) * 9216 + (m) * 3072))
#define WY_A(q, id)  ((LAS bf16*)(L + WY_AMAT + (q) * 3840 + (id) * 768))
    LAS bf16* SB = (LAS bf16*)(L + WY_SB); LAS bf16* WT = (LAS bf16*)(L + WY_WT); LAS bf16* UT = (LAS bf16*)(L + WY_UT);
    LAS float* GH = (LAS float*)(L + WY_GH); LAS float* GCs = (LAS float*)(L + WY_GC);
    for (int su = C.bid; su < RW_NSUP; su += C.G) {
    f32x16 S;
    bf16 r16[8], k16[8], v16[8], a16[8]; float wd[8];
#define WY_RAW(uu) do { const int u_ = (uu), bh_ = u_ >> 8, ch_ = u_ & 255; const size_t mb_ = (size_t)((bh_ >> 2) * SEQ + ch_ * RWC + 8 * w); const int hc_ = (bh_ & 3) * 64 + lane; _Pragma("unroll") for (int i = 0; i < 8; ++i) { const size_t m = mb_ + i; \
        r16[i] = RKVS[m * 768 + hc_]; k16[i] = RKVS[m * 768 + 256 + hc_]; v16[i] = RKVS[m * 768 + 512 + hc_]; wd[i] = WDEC[m * 256 + hc_]; a16[i] = AG[m * 512 + hc_]; } } while (0)
    WY_RAW(su * RW_SUP);
#pragma unroll 1
    for (int cc = 0; cc < RW_SUP; ++cc) {
        const int u = su * RW_SUP + cc;
        const int bh = u >> 8, ch = u & 255, b = bh >> 2, h = bh & 3, m0 = b * SEQ + ch * RWC, hc = h * 64 + lane;
        const float kkw = C.in[I_RW_KK][l * 256 + hc], kaw = C.in[I_RW_KA][l * 256 + hc], rkw = C.in[I_RW_RK][l * 256 + hc], w0l = C.in[I_RW_W0][l * 256 + hc], a0l = C.in[I_RW_A0][l * 256 + hc];
        { float wv[8], kk[8], ka[8], kp[8], rr[8], vv[8];
          float bon8[8], rf[8], kf[8], af[8], wf[8];
#pragma unroll
          for (int i = 0; i < 8; ++i) { rf[i] = bf2f(r16[i]); kf[i] = bf2f(k16[i]); vv[i] = bf2f(v16[i]); af[i] = bf2f(a16[i]); wf[i] = wd[i]; }
          if (cc + 1 < RW_SUP) WY_RAW(u + 1);
#pragma unroll
          for (int i = 0; i < 8; ++i) {
              const float r = rf[i], k = kf[i];
              wv[i] = __builtin_amdgcn_exp2f(-0.606531f * LOG2E * sigm(wf[i] + w0l)); const float a = sigm(af[i] + a0l);
              const float kr = k * kkw; kk[i] = kr * __builtin_amdgcn_rsqf(fmaxf(wave_sum(kr * kr, lane), 1e-24f));
              kp[i] = k * (1.f + (a - 1.f) * kaw); ka[i] = kk[i] * a; rr[i] = r;
              bon8[i] = wave_sum(r * kp[i] * rkw, lane); }
          if (lane == 0) {
#pragma unroll
              for (int i = 0; i < 8; ++i) BON[(size_t)(m0 + 8 * w + i) * 4 + h] = bon8[i]; }
          float cp[8]; cp[0] = wv[0];
#pragma unroll
          for (int i = 1; i < 8; ++i) cp[i] = cp[i - 1] * wv[i];
          GH[w * 64 + lane] = cp[7];
          __syncthreads();
          const float pre = half ? GH[(w - 1) * 64 + lane] : 1.f, gC = half ? pre * cp[7] : cp[7] * GH[(w + 1) * 64 + lane];
          if (!half) GCs[sq * 64 + lane] = gC;
#pragma unroll
          for (int i = 0; i < 8; ++i) { const int t = 8 * half + i; const float G = pre * cp[i], Gm1 = (i == 0) ? pre : pre * cp[i - 1], rG = __builtin_amdgcn_rcpf(G);
              WY_ROW(sq, 0)[t * MM_LP + lane] = f2bf(-kk[i] * Gm1); WY_ROW(sq, 1)[t * MM_LP + lane] = f2bf(ka[i] * rG); WY_ROW(sq, 2)[t * MM_LP + lane] = f2bf(kp[i] * rG); WY_ROW(sq, 3)[t * MM_LP + lane] = f2bf(rr[i] * G);
              WY_COL(sq, 0)[lane * WY_LT + t] = f2bf(ka[i] * rG * gC); WY_COL(sq, 1)[lane * WY_LT + t] = f2bf(kp[i] * rG * gC); WY_COL(sq, 2)[lane * WY_LT + t] = f2bf(vv[i]); } }
        __syncthreads();
#pragma unroll
        for (int pp = 0; pp < 2; ++pp) { const int id = 2 * half + pp;
            f32x4 acc = (f32x4){0.f, 0.f, 0.f, 0.f};
            acc = wy_mm16(WY_ROW(sq, half ? 3 : 0), WY_ROW(sq, pp ? 2 : 1), acc, li, lq);
#pragma unroll
            for (int r = 0; r < 4; ++r) { const int t = 4 * lq + r; const bool keep = half ? (li <= t) : (li < t); const float val = keep ? acc[r] : 0.f;
                WY_A(sq, id)[t * WY_LT + li] = f2bf(val); if (id == 0) ((LAS float*)(L + WY_AABF + sq * 1024))[t * 16 + li] = val; } }
        __syncthreads();
        if (w < 4) { const LAS float* Af = (const LAS float*)(L + WY_AABF + w * 1024); float Tc[16];
#pragma unroll
            for (int t = 0; t < 16; ++t) { float acc = (t == li) ? 1.f : 0.f;
#pragma unroll
                for (int s4 = 0; s4 < 4; ++s4) { if (4 * s4 < t) { const f32x4 a4 = *(const LAS f32x4*)(Af + t * 16 + 4 * s4);
                    if (4 * s4 + 0 < t) acc += a4.x * Tc[4 * s4 + 0]; if (4 * s4 + 1 < t) acc += a4.y * Tc[4 * s4 + 1]; if (4 * s4 + 2 < t) acc += a4.z * Tc[4 * s4 + 2]; if (4 * s4 + 3 < t) acc += a4.w * Tc[4 * s4 + 3]; } }
                Tc[t] = acc; WY_A(w, 4)[t * WY_LT + li] = f2bf(acc); } }
        if (cc == 0) {
#pragma unroll
            for (int r = 0; r < 4; ++r)
#pragma unroll
                for (int e = 0; e < 4; ++e) { const int row = 32 * ti + 8 * r + 4 * hi + e, col = 32 * tj + j32; S[4 * r + e] = (ti >= 2 && row - 64 == col) ? 1.f : 0.f; }
#pragma unroll
            for (int r = 0; r < 4; ++r)
#pragma unroll
                for (int e = 0; e < 4; ++e) SB[(32 * ti + 8 * r + 4 * hi + e) * MM_LP + 32 * tj + j32] = f2bf(S[4 * r + e]);
        }
        __syncthreads();
#pragma unroll 1
        for (int q = 0; q < 4; ++q) {
            f32x4 accW = (f32x4){0.f, 0.f, 0.f, 0.f}, accY = accW;
            accW = wy_mm16(WY_ROW(q, 0), SB + 16 * w * MM_LP, accW, li, lq);
            accY = wy_mm16(WY_ROW(q, 3), SB + 16 * w * MM_LP, accY, li, lq);
            if (w < 4) accW = wy_mm16k16(WY_A(q, 1), WY_COL(q, 2) + 16 * w * WY_LT, accW, li, lq);
            { u32x2 pk; pk.x = cvt_pk_bf16(accW[0], accW[1]); pk.y = cvt_pk_bf16(accW[2], accW[3]); *(LAS u32x2*)(WT + (16 * w + li) * WY_LT + 4 * lq) = pk; }
            asm volatile("s_waitcnt lgkmcnt(0)" ::: "memory");
            { f32x4 accU = (f32x4){0.f, 0.f, 0.f, 0.f}; accU = wy_mm16k16(WY_A(q, 4), WT + 16 * w * WY_LT, accU, li, lq);
              u32x2 pk; pk.x = cvt_pk_bf16(accU[0], accU[1]); pk.y = cvt_pk_bf16(accU[2], accU[3]); *(LAS u32x2*)(UT + (16 * w + li) * WY_LT + 4 * lq) = pk; }
            asm volatile("s_waitcnt lgkmcnt(0)" ::: "memory");
            accY = wy_mm16k16(WY_A(q, 2), UT + 16 * w * WY_LT, accY, li, lq);
            if (w < 4) accY = wy_mm16k16(WY_A(q, 3), WY_COL(q, 2) + 16 * w * WY_LT, accY, li, lq);
            { bf16* dst = (w < 4) ? Y0 : RH; const int colo = h * 64 + ((16 * w) & 63) + li;
#pragma unroll
              for (int r = 0; r < 4; ++r) dst[(size_t)(m0 + 16 * q + 4 * lq + r) * 256 + colo] = f2bf(accY[r]); }
            __syncthreads();
            { const float gc = GCs[q * 64 + 32 * tj + j32];
#pragma unroll
              for (int i = 0; i < 16; ++i) S[i] *= gc;
              const bf16x8 ua = *(const LAS bf16x8*)(UT + (32 * ti + j32) * WY_LT + 8 * hi), bb = *(const LAS bf16x8*)(WY_COL(q, 0) + (32 * tj + j32) * WY_LT + 8 * hi);
              S = __builtin_amdgcn_mfma_f32_32x32x16_bf16(ua, bb, S, 0, 0, 0);
              if (ti < 2) { const bf16x8 va = *(const LAS bf16x8*)(WY_COL(q, 2) + (32 * ti + j32) * WY_LT + 8 * hi), kb = *(const LAS bf16x8*)(WY_COL(q, 1) + (32 * tj + j32) * WY_LT + 8 * hi);
                  S = __builtin_amdgcn_mfma_f32_32x32x16_bf16(va, kb, S, 0, 0, 0); } }
            {
#pragma unroll
                for (int r = 0; r < 4; ++r)
#pragma unroll
                    for (int e = 0; e < 4; ++e) SB[(32 * ti + 8 * r + 4 * hi + e) * MM_LP + 32 * tj + j32] = f2bf(S[4 * r + e]);
                __syncthreads(); }
        }
        if (cc == RW_SUP - 1) {
        if (ti < 2) { float* o = PQ + (size_t)su * 4096 + (size_t)(32 * ti + 4 * hi) * 64 + 32 * tj + j32;
#pragma unroll
            for (int r = 0; r < 4; ++r)
#pragma unroll
                for (int e = 0; e < 4; ++e) o[(8 * r + e) * 64] = S[4 * r + e]; }
        else { float* o = PQ + ((size_t)RW_NSUP + su) * 4096 + (size_t)(32 * tj + j32) * 64 + 32 * (ti - 2) + 4 * hi;
#pragma unroll
            for (int r = 0; r < 4; ++r) *(f32x4*)(o + 8 * r) = (f32x4){S[4 * r], S[4 * r + 1], S[4 * r + 2], S[4 * r + 3]}; }
        }
        __syncthreads();
    }
    }
#undef WY_ROW
#undef WY_COL
#undef WY_A
#undef WY_RAW
}
__device__ __forceinline__ void ph_rw_scan_(const Ctx& C, int wg) {
    const float* Qg = (const float*)(C.ws + WS_PQ); const float* Pg = Qg + (size_t)RW_NSUP * 4096; float* SST = (float*)(C.ws + WS_SST);
    LAS bf16* PT = (LAS bf16*)(C.lds);
    LAS bf16* SLb = PT + 2 * 64 * MM_LP;
    LAS float* QL = (LAS float*)(C.lds + (2 * 64 * MM_LP + 2 * 16 * MM_LP) * 2);
    LAS float* SO = QL + 2 * 16 * 64;
    const int lane = C.lane, wave = C.wave, bh = wg >> 2, rq = wg & 3, ct = wave & 3, li = lane & 15, lq = lane >> 4;
    const bool mm = wave < 4;
    const size_t ubase = (size_t)bh * RW_NSC;
    const int lt = C.tid & 255;
    const int qrow = lt >> 4, qc4 = (lt & 15) * 4;
    constexpr int PD = 6;
    f32x4 pr[PD][4], qr[PD];
#define SC_P_PIECE(i) (lt + 256 * (i))
#define SC_PUT_P(buf, sx_) do { LAS bf16* d_ = PT + (buf) * (64 * MM_LP); _Pragma("unroll") for (int i_ = 0; i_ < 4; ++i_) { const int idx_ = SC_P_PIECE(i_), r_ = (idx_ * 4) >> 6, k_ = (idx_ * 4) & 63; u32x2 w_; \
        w_.x = cvt_pk_bf16(pr[sx_][i_].x, pr[sx_][i_].y); w_.y = cvt_pk_bf16(pr[sx_][i_].z, pr[sx_][i_].w); *(LAS u32x2*)(d_ + r_ * MM_LP + k_) = w_; } } while (0)
#define SC_LOAD(sx_, cc) do { const f32x4* p4_ = (const f32x4*)(Pg + (ubase + (cc)) * 4096); _Pragma("unroll") for (int i_ = 0; i_ < 4; ++i_) pr[sx_][i_] = p4_[SC_P_PIECE(i_)]; \
        qr[sx_] = *(const f32x4*)(Qg + (ubase + (cc)) * 4096 + (rq * 16 + qrow) * 64 + qc4); } while (0)
    if (mm) {
#pragma unroll
        for (int r = 0; r < 4; ++r) SLb[(4 * lq + r) * MM_LP + ct * 16 + li] = (bf16)0;
    } else {
        { float z0; asm volatile("v_mov_b32 %0, 0" : "=v"(z0));
          *(f32x4*)(SST + ubase * 4096 + (rq * 16 + qrow) * 64 + qc4) = (f32x4){z0, z0, z0, z0}; }
        SC_LOAD(0, 0); SC_PUT_P(0, 0); *(LAS f32x4*)(QL + qrow * 64 + qc4) = qr[0];
#pragma unroll
        for (int x = 0; x < PD; ++x) SC_LOAD(x, 1 + x);
    }
    __syncthreads();
#pragma unroll 1
    for (int c2 = 0; c2 < RW_NSC; c2 += PD) {
#pragma unroll
        for (int x = 0; x < PD; ++x) {
            const int c = c2 + x;
            if (c < RW_NSC) {
            if (mm) {
                const LAS bf16* Pc = PT + (c & 1) * (64 * MM_LP); const LAS bf16* Sc = SLb + (c & 1) * (16 * MM_LP); const LAS float* Qc = QL + (c & 1) * (16 * 64);
                LAS bf16* Sn = SLb + ((c + 1) & 1) * (16 * MM_LP); LAS float* So = SO + ((c + 1) & 1) * (16 * 64);
                bf16x8 af[2], bfr[2];
#pragma unroll
                for (int ks = 0; ks < 2; ++ks) { af[ks] = *(const LAS bf16x8*)(Sc + li * MM_LP + 32 * ks + 8 * lq); bfr[ks] = *(const LAS bf16x8*)(Pc + (16 * ct + li) * MM_LP + 32 * ks + 8 * lq); }
                f32x4 acc;
#pragma unroll
                for (int r = 0; r < 4; ++r) acc[r] = Qc[(4 * lq + r) * 64 + ct * 16 + li];
#pragma unroll
                for (int ks = 0; ks < 2; ++ks) acc = __builtin_amdgcn_mfma_f32_16x16x32_bf16(af[ks], bfr[ks], acc, 0, 0, 0);
                if (c + 1 < RW_NSC) {
#pragma unroll
                    for (int r = 0; r < 4; ++r) { Sn[(4 * lq + r) * MM_LP + ct * 16 + li] = f2bf(acc[r]); So[(4 * lq + r) * 64 + ct * 16 + li] = acc[r]; } }
            } else {
                if (c > 0) *(f32x4*)(SST + (ubase + c) * 4096 + (rq * 16 + qrow) * 64 + qc4) = *(const LAS f32x4*)(SO + (c & 1) * (16 * 64) + qrow * 64 + qc4);
                if (c + 1 < RW_NSC) { SC_PUT_P((c + 1) & 1, x); *(LAS f32x4*)(QL + ((c + 1) & 1) * (16 * 64) + qrow * 64 + qc4) = qr[x]; }
                if (c + 1 + PD < RW_NSC) SC_LOAD(x, c + 1 + PD);
            }
            __syncthreads();
#ifdef SCAN_2BAR
            __syncthreads();
#endif
            }
        }
    }
#undef SC_PUT_P
#undef SC_LOAD
#undef SC_P_PIECE
}
__device__ __forceinline__ void ph_rw_out_(const Ctx& C, int l) {
    const bf16* RKVS = (const bf16*)(C.ws + WS_RKVS); const bf16* AG = (const bf16*)(C.ws + WS_AG); const bf16* Y0 = (const bf16*)(C.ws + WS_Y0); const bf16* RH = (const bf16*)(C.ws + WS_RHAT);
    const float* SST = (const float*)(C.ws + WS_SST); const float* BON = (const float*)(C.ws + WS_BON); bf16* Y = (bf16*)(C.ws + WS_Y);
    LAS float* RL = (LAS float*)(C.lds);
    const int lane = C.lane, wave = C.wave;
    for (int u = C.bid; u < RW_NU; u += C.G) {
        const int bh = u >> 8, ch = u & 255, b = bh >> 2, h = bh & 3, m0 = b * SEQ + ch * RWC, hc = h * 64 + lane;
        { const int t = C.tid >> 3, d0 = (C.tid & 7) * 8; float a[8];
          unpack8(*(const u32x4*)(RH + (size_t)(m0 + t) * 256 + h * 64 + d0), a);
#pragma unroll
          for (int e = 0; e < 8; ++e) RL[t * 64 + d0 + e] = a[e]; }
        float s[64];
        { const f32x4* sp = (const f32x4*)(SST + (size_t)u * 4096 + lane * 64);
#pragma unroll
          for (int k4 = 0; k4 < 16; ++k4) { const f32x4 v = sp[k4]; s[4 * k4] = v.x; s[4 * k4 + 1] = v.y; s[4 * k4 + 2] = v.z; s[4 * k4 + 3] = v.w; } }
        const float lnw = C.in[I_RW_LNW][l * 256 + hc], lnb = C.in[I_RW_LNB][l * 256 + hc];
        __syncthreads();
#pragma unroll 2
        for (int q = 0; q < 8; ++q) { const int t = wave * 8 + q; const size_t m = (size_t)(m0 + t);
            const LAS f32x4* rv = (const LAS f32x4*)(RL + t * 64);
            float y0 = 0.f, y1 = 0.f, y2 = 0.f, y3 = 0.f;
#pragma unroll
            for (int k4 = 0; k4 < 16; ++k4) { const f32x4 rq = rv[k4]; y0 += s[4 * k4] * rq.x; y1 += s[4 * k4 + 1] * rq.y; y2 += s[4 * k4 + 2] * rq.z; y3 += s[4 * k4 + 3] * rq.w; }
#ifndef RWDBG
#define RWDBG 0
#endif
            float y = ((RWDBG & 1) ? 0.f : (y0 + y1) + (y2 + y3)) + ((RWDBG & 2) ? 0.f : bf2f(Y0[m * 256 + hc]));
            const float mean = wave_sum(y, C.lane) * (1.f / 64.f); y -= mean;
            const float rstd = 1.0f / sqrtf(wave_sum(y * y, C.lane) * (1.f / 64.f) + 64e-5f);
            y = y * rstd * lnw + lnb;
            if (!(RWDBG & 4)) y += BON[m * 4 + h] * bf2f(RKVS[m * 768 + 512 + hc]);
            y *= bf2f(AG[m * 512 + 256 + hc]);
            if (RWDBG & 120) { y = 0.f; if (RWDBG & 8) y += ((const float*)(C.ws + WS_WDEC))[m * 256 + hc]; if (RWDBG & 16) y += bf2f(AG[m * 512 + hc]);
                if (RWDBG & 32) y += bf2f(RKVS[m * 768 + hc]) + bf2f(RKVS[m * 768 + 256 + hc]) + bf2f(RKVS[m * 768 + 512 + hc]); if (RWDBG & 64) y += BON[m * 4 + h]; }
            Y[m * 1024 + hc] = f2bf(y); }
        __syncthreads();
    }
}

constexpr int SB_VLD = 40;
__device__ __forceinline__ void ph_sb_attn_(const Ctx& C, int first_wg, int nwg, unsigned* qhead = nullptr) {
    const bf16* SB = (const bf16*)(C.ws + WS_SB); bf16* Y = (bf16*)(C.ws + WS_Y);
    const int lane = C.lane, j = lane & 31, hi = lane >> 5;
    LAS bf16* VT = (LAS bf16*)(C.lds + C.wave * (64 * SB_VLD * 2));
    for (int it = qhead ? q_next(C, qhead) : C.bid - first_wg; it < 512; it = qhead ? q_next(C, qhead) : it + nwg) {
        const int bh = it >> 6, b = bh >> 2, h = bh & 3, t0 = (it & 63) * 256 + C.wave * 32; const size_t mb = (size_t)b * SEQ;
        bf16x8 qf[4];
#pragma unroll
        for (int ks = 0; ks < 4; ++ks) qf[ks] = *(const bf16x8*)(SB + (mb + t0 + j) * 768 + h * 64 + 16 * ks + 8 * hi);
        f32x16 o0, o1;
#pragma unroll
        for (int i = 0; i < 16; ++i) { o0[i] = 0.f; o1[i] = 0.f; }
        float acc = 0.f;
#pragma unroll 1
        for (int kt = t0; kt >= 0; kt -= 32) {
            bf16x8 kf[4];
#pragma unroll
            for (int ks = 0; ks < 4; ++ks) kf[ks] = *(const bf16x8*)(SB + (mb + kt + j) * 768 + 256 + h * 64 + 16 * ks + 8 * hi);
            u32x4 vv[4];
#pragma unroll
            for (int i = 0; i < 4; ++i) { const int c = lane + 64 * i; vv[i] = *(const u32x4*)(SB + (mb + kt + (c >> 3)) * 768 + 512 + h * 64 + (c & 7) * 8); }
            f32x16 sc;
#pragma unroll
            for (int i = 0; i < 16; ++i) sc[i] = 0.f;
#pragma unroll
            for (int ks = 0; ks < 4; ++ks) sc = __builtin_amdgcn_mfma_f32_32x32x16_bf16(kf[ks], qf[ks], sc, 0, 0, 0);
#pragma unroll
            for (int i = 0; i < 4; ++i) { const int c = lane + 64 * i, key = c >> 3, d8 = (c & 7) * 8; const unsigned w[4] = {vv[i].x, vv[i].y, vv[i].z, vv[i].w};
#pragma unroll
                for (int e = 0; e < 4; ++e) { VT[(d8 + 2 * e) * SB_VLD + key] = (bf16)(w[e] & 0xffffu); VT[(d8 + 2 * e + 1) * SB_VLD + key] = (bf16)(w[e] >> 16); } }
            const bool diag = (kt == t0);
            float ls[16], g[4], og[4];
#pragma unroll
            for (int r = 0; r < 4; ++r) { g[r] = 0.f;
#pragma unroll
                for (int e = 0; e < 4; ++e) { const float z = sc[4 * r + e]; const bool valid = !diag || (8 * r + 4 * hi + e) < j;
                    const float l = (z > 40.f) ? -z : -__builtin_amdgcn_logf(1.f + __builtin_amdgcn_exp2f(z));
                    ls[4 * r + e] = valid ? l : 0.f; g[r] += ls[4 * r + e]; } }
#pragma unroll
            for (int r = 0; r < 4; ++r) og[r] = shx(g[r], 32, lane);
            float pw[16]; float run = acc;
#pragma unroll
            for (int r = 3; r >= 0; --r) { float cum = run + (hi == 0 ? og[r] : 0.f);
#pragma unroll
                for (int e = 3; e >= 0; --e) { cum += ls[4 * r + e]; const bool valid = !diag || (8 * r + 4 * hi + e) < j;
                    pw[4 * r + e] = valid ? __builtin_amdgcn_exp2f(sc[4 * r + e] + cum) : 0.f; }
                run += g[r] + og[r]; }
            acc = run;
            asm volatile("" ::: "memory");
#pragma unroll
            for (int ks = 0; ks < 2; ++ks) {
                u32x4 pk; pk.x = cvt_pk_bf16(pw[8 * ks], pw[8 * ks + 1]); pk.y = cvt_pk_bf16(pw[8 * ks + 2], pw[8 * ks + 3]); pk.z = cvt_pk_bf16(pw[8 * ks + 4], pw[8 * ks + 5]); pk.w = cvt_pk_bf16(pw[8 * ks + 6], pw[8 * ks + 7]);
                const bf16x8 pb = __builtin_bit_cast(bf16x8, pk);
                const s16x4 a0l = *(const LAS s16x4*)(VT + j * SB_VLD + 16 * ks + 4 * hi), a0h = *(const LAS s16x4*)(VT + j * SB_VLD + 16 * ks + 8 + 4 * hi);
                const s16x4 a1l = *(const LAS s16x4*)(VT + (32 + j) * SB_VLD + 16 * ks + 4 * hi), a1h = *(const LAS s16x4*)(VT + (32 + j) * SB_VLD + 16 * ks + 8 + 4 * hi);
                const bf16x8 va0 = __builtin_shufflevector(a0l, a0h, 0, 1, 2, 3, 4, 5, 6, 7), va1 = __builtin_shufflevector(a1l, a1h, 0, 1, 2, 3, 4, 5, 6, 7);
                o0 = __builtin_amdgcn_mfma_f32_32x32x16_bf16(va0, pb, o0, 0, 0, 0);
                o1 = __builtin_amdgcn_mfma_f32_32x32x16_bf16(va1, pb, o1, 0, 0, 0);
            }
            asm volatile("" ::: "memory");
            if (__builtin_amdgcn_ballot_w64(acc > -140.f) == 0ull) break;
        }
        bf16* yp = Y + (mb + t0 + j) * 1024 + 256 + h * 64 + 4 * hi;
#pragma unroll
        for (int r = 0; r < 4; ++r) { u32x2 w0, w1; w0.x = cvt_pk_bf16(o0[4 * r], o0[4 * r + 1]); w0.y = cvt_pk_bf16(o0[4 * r + 2], o0[4 * r + 3]); w1.x = cvt_pk_bf16(o1[4 * r], o1[4 * r + 1]); w1.y = cvt_pk_bf16(o1[4 * r + 2], o1[4 * r + 3]);
            *(u32x2*)(yp + 8 * r) = w0; *(u32x2*)(yp + 32 + 8 * r) = w1; }
    }
}


__device__ __forceinline__ f32x16 mm_tile(const LAS bf16* X, const LAS bf16* Y, int ti, int tj, int lane) {
    const int j = lane & 31, hi = lane >> 5; f32x16 acc;
#pragma unroll
    for (int i = 0; i < 16; ++i) acc[i] = 0.f;
#pragma unroll
    for (int ks = 0; ks < 4; ++ks) { const bf16x8 a = *(const LAS bf16x8*)(X + (32 * ti + j) * MM_LP + 16 * ks + 8 * hi), b = *(const LAS bf16x8*)(Y + (32 * tj + j) * MM_LP + 16 * ks + 8 * hi);
        acc = __builtin_amdgcn_mfma_f32_32x32x16_bf16(a, b, acc, 0, 0, 0); }
    return acc;
}
__device__ __forceinline__ void ln_pair_stats(const f32x16& x, LAS float* XCH, int tr, int tt, int lane, float eps, float& mean, float& rstd) {
    const int j = lane & 31, hi = lane >> 5; float s1 = 0.f, s2 = 0.f;
#pragma unroll
    for (int i = 0; i < 16; ++i) { s1 += x[i]; s2 += x[i] * x[i]; }
    s1 += shx(s1, 32, lane); s2 += shx(s2, 32, lane);
    if (hi == 0) { XCH[(tr * 64 + 32 * tt + j) * 2] = s1; XCH[(tr * 64 + 32 * tt + j) * 2 + 1] = s2; }
    __syncthreads();
    const float a1 = XCH[(32 * tt + j) * 2] + XCH[(64 + 32 * tt + j) * 2], a2 = XCH[(32 * tt + j) * 2 + 1] + XCH[(64 + 32 * tt + j) * 2 + 1];
    mean = a1 * (1.f / 64.f); const float var = fmaxf(a2 * (1.f / 64.f) - mean * mean, 0.f); rstd = 1.0f / sqrtf(var + eps);
}
__device__ __forceinline__ void rot_store(const Ctx& C, const bf16* src  , int pos, int d0, float scale, LAS bf16* dstrow) {
    const float* cs = (const float*)(C.ws + WS_COS) + (size_t)pos * 32 + d0; const float* sn = (const float*)(C.ws + WS_SIN) + (size_t)pos * 32 + d0;
    float x1[8], x2[8]; unpack8(*(const u32x4*)(src + d0), x1); unpack8(*(const u32x4*)(src + 32 + d0), x2);
    const f32x4 c0 = *(const f32x4*)cs, c1 = *(const f32x4*)(cs + 4), s0 = *(const f32x4*)sn, s1 = *(const f32x4*)(sn + 4);
    const float cc[8] = {c0.x, c0.y, c0.z, c0.w, c1.x, c1.y, c1.z, c1.w}, ss[8] = {s0.x, s0.y, s0.z, s0.w, s1.x, s1.y, s1.z, s1.w};
    float o1[8], o2[8];
#pragma unroll
    for (int e = 0; e < 8; ++e) { o1[e] = (x1[e] * cc[e] - x2[e] * ss[e]) * scale; o2[e] = (x1[e] * ss[e] + x2[e] * cc[e]) * scale; }
    *(LAS u32x4*)(dstrow + d0) = pack8(o1); *(LAS u32x4*)(dstrow + 32 + d0) = pack8(o2);
}

__device__ __forceinline__ void ph_ret_kv2_(const Ctx& C) {
    const bf16* RET = (const bf16*)(C.ws + WS_RET); float* KV = (float*)(C.ws + WS_KV);
    const int half = C.wave >> 2, w4 = C.wave & 3, th = C.tid & 255, lane = C.lane;
    LAS bf16* KT = (LAS bf16*)(C.lds + half * 36864);
    LAS bf16* VT = KT + 64 * MM_LP;
    LAS bf16* KR = VT + 64 * MM_LP;
    for (int it = C.bid; it < 1024; it += C.G) {
        const int u = it * 2 + half, bh = u >> 8, ch = u & 255, b = bh >> 2, h = bh & 3, m0 = b * SEQ + ch * 64;
        const float lg = ret_log2gamma(h);
        { const int srow = th >> 2, dq = th & 3; const size_t m = (size_t)(m0 + srow);
          rot_store(C, RET + m * 1024 + 256 + h * 64, (int)(m & (SEQ - 1)), dq * 8, 0.125f * exp2f(lg * (float)(63 - srow)), KR + srow * MM_LP);
          float a[8];
#pragma unroll
          for (int q = 0; q < 2; ++q) { const int e0 = dq * 16 + q * 8; unpack8(*(const u32x4*)(RET + m * 1024 + 512 + h * 64 + e0), a);
#pragma unroll
              for (int e = 0; e < 8; ++e) VT[(e0 + e) * MM_LP + srow] = f2bf(a[e]); } }
        __syncthreads();
        { const int d = th >> 2, s0 = (th & 3) * 16;
#pragma unroll
          for (int i = 0; i < 16; ++i) KT[d * MM_LP + s0 + i] = KR[(s0 + i) * MM_LP + d]; }
        __syncthreads();
        { const int ti = w4 >> 1, tj = w4 & 1, j = lane & 31, hi = lane >> 5;
          const f32x16 acc = mm_tile(VT, KT, ti, tj, lane);
          float* o = KV + (size_t)u * 4096 + (size_t)(32 * ti + 4 * hi) * 64 + 32 * tj + j;
#pragma unroll
          for (int r = 0; r < 4; ++r)
#pragma unroll
              for (int e = 0; e < 4; ++e) o[(8 * r + e) * 64] = acc[4 * r + e]; }
        __syncthreads();
    }
}
__device__ __forceinline__ void ph_ret_out2_(const Ctx& C, int l, int first_wg, int nwg, unsigned* qhead = nullptr) {
    const bf16* RET = (const bf16*)(C.ws + WS_RET); const float* KV = (const float*)(C.ws + WS_KV); bf16* Y = (bf16*)(C.ws + WS_Y);
    const int half = C.wave >> 2, w4 = C.wave & 3, th = C.tid & 255, lane = C.lane, j = lane & 31, hi = lane >> 5, te = w4 >> 1, tt = w4 & 1;
    LAS bf16* QL = (LAS bf16*)(C.lds + half * 40960);
    LAS bf16* KL = QL + 64 * MM_LP;
    LAS bf16* VT = KL + 64 * MM_LP;
    LAS bf16* ST = VT + 64 * MM_LP;
    LAS float* XCH = (LAS float*)(C.lds + half * 40960 + 4 * 64 * MM_LP * 2);
    const float* gn = C.in[I_RET_GN] + (size_t)l * 256;
    for (int it = qhead ? q_next(C, qhead) : C.bid - first_wg; it < 1024; it = qhead ? q_next(C, qhead) : it + nwg) {
        const int u = it * 2 + half, bh = u >> 8, ch = u & 255, b = bh >> 2, h = bh & 3, m0 = b * SEQ + ch * 64;
        const float lg = ret_log2gamma(h);
        { const int srow = th >> 2, dq = th & 3; const size_t m = (size_t)(m0 + srow); const int pos = (int)(m & (SEQ - 1));
          rot_store(C, RET + m * 1024 + h * 64, pos, dq * 8, 1.0f, QL + srow * MM_LP);
          rot_store(C, RET + m * 1024 + 256 + h * 64, pos, dq * 8, 0.125f, KL + srow * MM_LP);
          float a[8];
#pragma unroll
          for (int q = 0; q < 2; ++q) { const int e0 = dq * 16 + q * 8; unpack8(*(const u32x4*)(RET + m * 1024 + 512 + h * 64 + e0), a);
#pragma unroll
              for (int e = 0; e < 8; ++e) VT[(e0 + e) * MM_LP + srow] = f2bf(a[e]); }
          const float* sp = KV + (size_t)u * 4096 + srow * 64 + dq * 16;
          float sv[16];
#pragma unroll
          for (int q = 0; q < 4; ++q) { const f32x4 v4 = *(const f32x4*)(sp + 4 * q); sv[4 * q] = v4.x; sv[4 * q + 1] = v4.y; sv[4 * q + 2] = v4.z; sv[4 * q + 3] = v4.w; }
          *(LAS u32x4*)(ST + srow * MM_LP + dq * 16) = pack8(sv); *(LAS u32x4*)(ST + srow * MM_LP + dq * 16 + 8) = pack8(sv + 8); }
        __syncthreads();
        f32x16 acc = mm_tile(ST, QL, te, tt, lane);
        { const float qd = exp2f(lg * (float)(32 * tt + j + 1));
#pragma unroll
          for (int i = 0; i < 16; ++i) acc[i] *= qd; }
#pragma unroll
        for (int st = 0; st < 2; ++st) {
            if (st > tt) continue;
            const f32x16 sc = mm_tile(KL, QL, st, tt, lane);
            float pw[16];
#pragma unroll
            for (int r = 0; r < 4; ++r)
#pragma unroll
                for (int e = 0; e < 4; ++e) { const int sk = 32 * st + 8 * r + 4 * hi + e, tq = 32 * tt + j;
                    pw[4 * r + e] = (sk <= tq) ? sc[4 * r + e] * exp2f(lg * (float)(tq - sk)) : 0.f; }
#pragma unroll
            for (int ks = 0; ks < 2; ++ks) {
                u32x4 pk; pk.x = cvt_pk_bf16(pw[8 * ks], pw[8 * ks + 1]); pk.y = cvt_pk_bf16(pw[8 * ks + 2], pw[8 * ks + 3]); pk.z = cvt_pk_bf16(pw[8 * ks + 4], pw[8 * ks + 5]); pk.w = cvt_pk_bf16(pw[8 * ks + 6], pw[8 * ks + 7]);
                const bf16x8 pb = __builtin_bit_cast(bf16x8, pk);
                const LAS bf16* vr = VT + (32 * te + j) * MM_LP + 32 * st + 16 * ks + 4 * hi;
                const s16x4 al = *(const LAS s16x4*)vr, ah = *(const LAS s16x4*)(vr + 8);
                const bf16x8 va = __builtin_shufflevector(al, ah, 0, 1, 2, 3, 4, 5, 6, 7);
                acc = __builtin_amdgcn_mfma_f32_32x32x16_bf16(va, pb, acc, 0, 0, 0);
            }
        }
        float mean, rstd; ln_pair_stats(acc, XCH, te, tt, lane, 1e-5f, mean, rstd);
        { const size_t m = (size_t)(m0 + 32 * tt + j); const bf16* gp = RET + m * 1024 + 768 + h * 64 + 32 * te + 4 * hi; bf16* yp = Y + m * 1024 + 512 + h * 64 + 32 * te + 4 * hi;
          const float* gw = gn + h * 64 + 32 * te + 4 * hi;
#pragma unroll
          for (int r = 0; r < 4; ++r) { const u32x2 gt2 = *(const u32x2*)(gp + 8 * r); const float gtv[4] = {bflo(gt2.x), bfhi(gt2.x), bflo(gt2.y), bfhi(gt2.y)}; const f32x4 gwv = *(const f32x4*)(gw + 8 * r);
              float o[4];
#pragma unroll
              for (int e = 0; e < 4; ++e) o[e] = (acc[4 * r + e] - mean) * rstd * gwv[e] * (gtv[e] * sigm(gtv[e]));
              u32x2 w; w.x = cvt_pk_bf16(o[0], o[1]); w.y = cvt_pk_bf16(o[2], o[3]); *(u32x2*)(yp + 8 * r) = w; } }
        __syncthreads();
    }
}
__device__ __forceinline__ void ph_rw_out2_(const Ctx& C, int l) {
    const bf16* RKVS = (const bf16*)(C.ws + WS_RKVS); const bf16* AG = (const bf16*)(C.ws + WS_AG); const bf16* Y0 = (const bf16*)(C.ws + WS_Y0); const bf16* RH = (const bf16*)(C.ws + WS_RHAT);
    const float* SST = (const float*)(C.ws + WS_SST); const float* BON = (const float*)(C.ws + WS_BON); bf16* Y = (bf16*)(C.ws + WS_Y);
    const int half = C.wave >> 2, w4 = C.wave & 3, th = C.tid & 255, lane = C.lane, j = lane & 31, hi = lane >> 5, tv = w4 >> 1, tt = w4 & 1;
    LAS bf16* SL = (LAS bf16*)(C.lds + half * 20480);
    LAS bf16* RL = SL + 64 * MM_LP;
    LAS float* XCH = (LAS float*)(C.lds + half * 20480 + 2 * 64 * MM_LP * 2);
    for (int it = C.bid; it < RW_NU / 2; it += C.G) {
        const int u = it * 2 + half, bh = u >> 8, ch = u & 255, b = bh >> 2, h = bh & 3, m0 = b * SEQ + ch * RWC;
        { const int row = th >> 2, q4 = th & 3;
          const float* sp = SST + (size_t)(u >> 3) * 4096 + row * 64 + q4 * 16; float sv[16];
#pragma unroll
          for (int q = 0; q < 4; ++q) { const f32x4 v4 = *(const f32x4*)(sp + 4 * q); sv[4 * q] = v4.x; sv[4 * q + 1] = v4.y; sv[4 * q + 2] = v4.z; sv[4 * q + 3] = v4.w; }
          *(LAS u32x4*)(SL + row * MM_LP + q4 * 16) = pack8(sv); *(LAS u32x4*)(SL + row * MM_LP + q4 * 16 + 8) = pack8(sv + 8);
          const u32x4* rp = (const u32x4*)(RH + (size_t)(m0 + row) * 256 + h * 64 + q4 * 16);
          *(LAS u32x4*)(RL + row * MM_LP + q4 * 16) = rp[0]; *(LAS u32x4*)(RL + row * MM_LP + q4 * 16 + 8) = rp[1]; }
        __syncthreads();
        f32x16 acc = mm_tile(SL, RL, tv, tt, lane);
        const size_t m = (size_t)(m0 + 32 * tt + j); const int vb = h * 64 + 32 * tv + 4 * hi;
#pragma unroll
        for (int r = 0; r < 4; ++r) { const u32x2 y2 = *(const u32x2*)(Y0 + m * 256 + vb + 8 * r); acc[4 * r] += bflo(y2.x); acc[4 * r + 1] += bfhi(y2.x); acc[4 * r + 2] += bflo(y2.y); acc[4 * r + 3] += bfhi(y2.y); }
        float mean, rstd; ln_pair_stats(acc, XCH, tv, tt, lane, 64e-5f, mean, rstd);
        const float bon = BON[m * 4 + h];
#pragma unroll
        for (int r = 0; r < 4; ++r) { const int vc = vb + 8 * r;
            const f32x4 lw = *(const f32x4*)(C.in[I_RW_LNW] + (size_t)l * 256 + vc), lb = *(const f32x4*)(C.in[I_RW_LNB] + (size_t)l * 256 + vc);
            const u32x2 v2 = *(const u32x2*)(RKVS + m * 768 + 512 + vc), g2 = *(const u32x2*)(AG + m * 512 + 256 + vc);
            const float vv[4] = {bflo(v2.x), bfhi(v2.x), bflo(v2.y), bfhi(v2.y)}, gg[4] = {bflo(g2.x), bfhi(g2.x), bflo(g2.y), bfhi(g2.y)};
            float o[4];
#pragma unroll
            for (int e = 0; e < 4; ++e) o[e] = ((acc[4 * r + e] - mean) * rstd * lw[e] + lb[e] + bon * vv[e]) * gg[e];
            u32x2 w; w.x = cvt_pk_bf16(o[0], o[1]); w.y = cvt_pk_bf16(o[2], o[3]); *(u32x2*)(Y + m * 1024 + vc) = w; }
        __syncthreads();
    }
}

__device__ __forceinline__ void ph_moe_scatter_(const Ctx& C, int moe_idx) {
    unsigned* cw = (unsigned*)(C.ws + WS_CTL) + CW_MOE + moe_idx * 64;
    const int* eidx = (const int*)(C.ws + WS_EIDX); const float* gate = (const float*)(C.ws + WS_GATE);
    int* rowtok = (int*)(C.ws + WS_ROWTOK); float* rowgate = (float*)(C.ws + WS_ROWGATE); int* texp = (int*)(C.ws + WS_TEXP); int* segend = (int*)(C.ws + WS_SEGEND); int* ntp = (int*)(C.ws + WS_NT);
    bf16* XS = (bf16*)(C.ws + WS_XS);
    LAS unsigned* lcnt = (LAS unsigned*)(C.lds); LAS unsigned* lbase = lcnt + 8; LAS int* sl = (LAS int*)(C.lds + 256);
    int cnt[8], segb[8]; int tot = 0;
#pragma unroll
    for (int e = 0; e < 8; ++e) { cnt[e] = (int)__hip_atomic_load(&cw[e], __ATOMIC_RELAXED, __HIP_MEMORY_SCOPE_AGENT); segb[e] = tot; tot += (cnt[e] + 255) & ~255; }
    if (C.bid == 0) {
        if (C.tid < 8) { const int e = C.tid; int sb = 0, ce = 0;
#pragma unroll
            for (int q = 0; q < 8; ++q) if (q == e) { sb = segb[q]; ce = cnt[q]; }
            for (int pm = sb >> 8; pm < ((sb + ((ce + 255) & ~255)) >> 8); ++pm) { texp[pm] = e; segend[pm] = sb + ce; } }
        if (C.tid == 0) *ntp = tot >> 8;
    }
    for (int blk = C.bid; blk < T / 256; blk += C.G) {
        __syncthreads();
        if (C.tid < 8) lcnt[C.tid] = 0u;
        __syncthreads();
        const int a = blk * 512 + C.tid, e = eidx[a];
        const unsigned rank = atomicAdd((unsigned*)&lcnt[e], 1u);
        __syncthreads();
        if (C.tid < 8) lbase[C.tid] = atomicAdd(&cw[16 + C.tid], lcnt[C.tid]);
        __syncthreads();
        int sb = 0;
#pragma unroll
        for (int q = 0; q < 8; ++q) if (q == e) sb = segb[q];
        const int slot = sb + (int)lbase[e] + (int)rank;
        rowtok[slot] = a >> 1; rowgate[slot] = gate[a]; sl[C.tid] = slot; ((int*)(C.ws + WS_SLOTOF))[a] = slot;
        __syncthreads();
#pragma unroll 1
        for (int i0 = C.wave; i0 < 512; i0 += 8 * NWAVES) { u32x4 rowv[8];
#pragma unroll
            for (int j = 0; j < 8; ++j) { const int i = i0 + j * NWAVES; rowv[j] = ((const u32x4*)(C.ws + WS_H8 + (size_t)(blk * 256 + (i >> 1)) * D))[C.lane]; }
#pragma unroll
            for (int j = 0; j < 8; ++j) { const int i = i0 + j * NWAVES; ((u32x4*)(C.ws + WS_XS + (size_t)sl[i] * D))[C.lane] = rowv[j]; } }
    }
}

__device__ __forceinline__ void grid_barrier(int wv) {
    const Ctx C = make_ctx(wv);
    XcdBarrier b; b.bar = (unsigned*)(C.ws + WS_CTL) + CW_BAR; b.x = xb_xcc_id(); b.st = (volatile LAS unsigned*)(C.lds + MISC_OFF) + 8;
    xcd_barrier(b, C.tid);
}
__device__ __forceinline__ void P_prologue(int wv) { const Ctx C = make_ctx(wv); ph_prologue_(C); }
__device__ __forceinline__ void P_weights_norm(int wv, int l) { const Ctx C = make_ctx(wv); ph_weights_(C, l, 0, 0, C.G); __syncthreads(); ph_norm_(C, C.in[I_NORM_MIX] + (size_t)l * D, false, nullptr, 0,  (l > 0) && ((l - 1) & 1), l == 0 ? C.in[I_X] : nullptr); }
__device__ __forceinline__ void P_gemm_in(int wv, int l) { const Ctx C = make_ctx(wv); using namespace pg8; unsigned char* ws = C.ws;
    Gemm g{(const bf16*)C.out, (const bf16*)(ws + WS_WIN), D, D}; StaticOrder S; S.init(T, NIN, C.G, C.bid);
    EpiRoute E{(bf16*)(ws + WS_RW), (bf16*)(ws + WS_SB), (bf16*)(ws + WS_RET), (bf16*)(ws + WS_CV), C.in[I_SB_QN] + (size_t)l * 64, C.in[I_SB_KN] + (size_t)l * 64};
    gemm_phase<EpiRoute, StaticOrder, true, 1>(C.lds, C.tid, g, S, E); }
#define REP2(bit, stmt) do { stmt; if constexpr ((PROBE2 >> (bit)) & 1) { __syncthreads(); stmt; } } while (0)
__device__ __forceinline__ void P_mix1(int wv, int l) { REP2(2, { const Ctx C = make_ctx(wv); ph_rw_prep_(C, l); }); REP2(3, { const Ctx C = make_ctx(wv); ph_conv_(C, l); }); REP2(4, { const Ctx C = make_ctx(wv); ph_ret_kv2_(C); }); }
__device__ __forceinline__ void P_mix2(int wv, int l) { { const Ctx C = make_ctx(wv); using namespace pg8; unsigned char* ws = C.ws;
    Gemm g{(const bf16*)(ws + WS_ALORA), (const bf16*)(ws + WS_WLORA), 256, 256}; StaticOrder S; S.init(T, 768, C.G, C.bid);
    EpiLora E{(float*)(ws + WS_WDEC), (bf16*)(ws + WS_AG), C.in[I_RW_W0] + (size_t)l * 256, C.in[I_RW_A0] + (size_t)l * 256};
    gemm_phase<EpiLora, StaticOrder, true>(C.lds, C.tid, g, S, E); }
    { const Ctx C = make_ctx(wv); ph_ret_scan_(C); } }
#ifndef MIX3_SEL
#define MIX3_SEL 3
#endif
__device__ __forceinline__ void P_mix3(int wv, int l) { REP2(0, { const Ctx C = make_ctx(wv); ph_rw_local_wy_(C, l); }); }
__device__ __forceinline__ void P_mix4(int wv, int l) { const Ctx C = make_ctx(wv);
    unsigned* qh = (unsigned*)(C.ws + WS_CTL) + CW_QUEUE + l * 64;
    if (C.G >= 64) { if (C.bid < 32) { ph_rw_scan_(C, C.bid); __syncthreads(); }
        ph_sb_attn_(C, 0, C.G, qh); __syncthreads(); ph_ret_out2_(C, l, 0, C.G, qh + 16); __syncthreads(); ph_weights_(C, l, 1, 0, C.G, qh + 32); }
    else { for (int w = C.bid; w < 32; w += C.G) { ph_rw_scan_(C, w); __syncthreads(); } ph_sb_attn_(C, 0, C.G); __syncthreads(); ph_ret_out2_(C, l, 0, C.G); __syncthreads(); ph_weights_(C, l, 1, 0, C.G); } }
__device__ __forceinline__ void P_mix5(int wv, int l) { REP2(5, { const Ctx C = make_ctx(wv); ph_rw_out2_(C, l); }); }
__device__ __forceinline__ void P_gemm_branch(int wv) { const Ctx C = make_ctx(wv); using namespace pg8; unsigned char* ws = C.ws;
    Gemm g{(const bf16*)(ws + WS_Y), (const bf16*)(ws + WS_WB), D, 256}; StaticOrder S; S.init(T, 4096, C.G, C.bid, 2, 512);
    EpiBall E{ws + WS_BALL};
    gemm_phase<EpiBall, StaticOrder, false>(C.lds, C.tid, g, S, E); }
__device__ __forceinline__ void P_gemm_gate(int wv) { const Ctx C = make_ctx(wv); using namespace pg8; unsigned char* ws = C.ws;
    Gemm g{(const bf16*)(ws + WS_H8), (const bf16*)(ws + WS_WG), D, D}; StaticOrder S; S.init(T, 4096, C.G, C.bid);
    EpiGateMerge E{(const bf16*)(ws + WS_BALL), (bf16*)(ws + WS_MERGED)};
    gemm_phase8<EpiGateMerge, StaticOrder, true>(C.lds, C.tid, g, S, E); }
__device__ __forceinline__ void P_gemm_out(int wv) { const Ctx C = make_ctx(wv); using namespace pg8; unsigned char* ws = C.ws;
    Gemm g{(const bf16*)(ws + WS_MERGED), (const bf16*)(ws + WS_WOUT), D, D}; StaticOrder S; S.init(T, D, C.G, C.bid);
    EpiResidual E{(bf16*)(ws + WS_XB), 1.0f};
    gemm_phase<EpiResidual, StaticOrder, true, 1>(C.lds, C.tid, g, S, E); }
__device__ __forceinline__ void P_norm_ffn(int wv, int l) { const Ctx C = make_ctx(wv); ph_norm_(C, C.in[I_NORM_FFN] + (size_t)l * D, (l & 1) != 0, C.in[I_ROUTER] + (size_t)(l >> 1) * D * NEXP, l >> 1, false, nullptr,  false); }
__device__ __forceinline__ void P_ffn_up(int wv) { const Ctx C = make_ctx(wv); using namespace pg8; unsigned char* ws = C.ws;
    Gemm g{(const bf16*)(ws + WS_H8), (const bf16*)(ws + WS_W13), D, D}; StaticOrder S; S.init(T, 2 * DFF, C.G, C.bid);
    EpiSwiglu E{ws + WS_HID, DFF, 1 << 20, false};
    gemm_phase8<EpiSwiglu, StaticOrder, true>(C.lds, C.tid, g, S, E); }
__device__ __forceinline__ void P_ffn_down(int wv) { const Ctx C = make_ctx(wv); using namespace pg8; unsigned char* ws = C.ws;
    Gemm g{(const bf16*)(ws + WS_HID), (const bf16*)(ws + WS_W2D), DFF, DFF}; StaticOrder S; S.init(T, D, C.G, C.bid);
    EpiResidual E{(bf16*)(ws + WS_XB), F8_DESCALE_DOWN};
    gemm_phase8<EpiResidual, StaticOrder, true, 1>(C.lds, C.tid, g, S, E); }
__device__ __forceinline__ void P_moe_scatter(int wv, int l2) { const Ctx C = make_ctx(wv); ph_moe_scatter_(C, l2); }
__device__ __forceinline__ void P_moe_up(int wv) { const Ctx C = make_ctx(wv); using namespace pg8; unsigned char* ws = C.ws;
    Gemm g{(const bf16*)(ws + WS_XS), (const bf16*)(ws + WS_W13), D, D};
    MoeOrder S{(const int*)(ws + WS_TEXP), __builtin_amdgcn_readfirstlane(*(const int*)(ws + WS_NT)), 2 * DFE / 256, C.G, C.bid};
    EpiSwiglu E{ws + WS_HIDM, DFE_PAD, 2 * DFE / 256, true};
    gemm_phase8<EpiSwiglu, MoeOrder, true>(C.lds, C.tid, g, S, E); }
__device__ __forceinline__ void P_moe_down(int wv) { const Ctx C = make_ctx(wv); using namespace pg8; unsigned char* ws = C.ws;
    Gemm g{(const bf16*)(ws + WS_HIDM), (const bf16*)(ws + WS_W2M), DFE_PAD, DFE_PAD};
    MoeOrder S{(const int*)(ws + WS_TEXP), __builtin_amdgcn_readfirstlane(*(const int*)(ws + WS_NT)), D / 256, C.G, C.bid};
    EpiBf16 E{(bf16*)(ws + WS_YS), D, 3, F8_DESCALE_DOWN};
    gemm_phase8<EpiBf16, MoeOrder, true, 1>(C.lds, C.tid, g, S, E); }
__device__ __forceinline__ void P_moe_combine(int wv) { const Ctx C = make_ctx(wv);
    const int gw = C.bid * NWAVES + C.wave, NGW = C.G * NWAVES, lane = C.lane;
    const int* slotof = (const int*)(C.ws + WS_SLOTOF); const float* gate = (const float*)(C.ws + WS_GATE); const bf16* YS = (const bf16*)(C.ws + WS_YS); const bf16* XB = (const bf16*)(C.ws + WS_XB);
    constexpr int NRC = 4;
    for (int mb = gw; mb < T; mb += NRC * NGW) {
        int s0[NRC], s1[NRC]; float g0[NRC], g1[NRC]; u32x4 x[NRC][2], ya[NRC][2], yb[NRC][2];
#pragma unroll
        for (int r = 0; r < NRC; ++r) { const int m = mb + r * NGW < T ? mb + r * NGW : T - 1; s0[r] = slotof[2 * m]; s1[r] = slotof[2 * m + 1]; g0[r] = gate[2 * m]; g1[r] = gate[2 * m + 1];
            const u32x4* xb = (const u32x4*)(XB + (size_t)m * D) + lane; x[r][0] = xb[0]; x[r][1] = xb[64]; }
#pragma unroll
        for (int r = 0; r < NRC; ++r) { const u32x4* y0 = (const u32x4*)(YS + (size_t)s0[r] * D) + lane; const u32x4* y1 = (const u32x4*)(YS + (size_t)s1[r] * D) + lane;
            ya[r][0] = y0[0]; ya[r][1] = y0[64]; yb[r][0] = y1[0]; yb[r][1] = y1[64]; }
#pragma unroll
        for (int r = 0; r < NRC; ++r) { const int m = mb + r * NGW; if (m < T) { f32x4* xo = (f32x4*)(C.out + (size_t)m * D + 8 * lane); const float G0 = g0[r], G1 = g1[r];
#pragma unroll
            for (int j = 0; j < 2; ++j) { const u32x4 xx = x[r][j], a = ya[r][j], b = yb[r][j]; f32x4 v0, v1;
                v0.x = bflo(xx.x) + G0 * bflo(a.x) + G1 * bflo(b.x); v0.y = bfhi(xx.x) + G0 * bfhi(a.x) + G1 * bfhi(b.x); v0.z = bflo(xx.y) + G0 * bflo(a.y) + G1 * bflo(b.y); v0.w = bfhi(xx.y) + G0 * bfhi(a.y) + G1 * bfhi(b.y);
                v1.x = bflo(xx.z) + G0 * bflo(a.z) + G1 * bflo(b.z); v1.y = bfhi(xx.z) + G0 * bfhi(a.z) + G1 * bfhi(b.z); v1.z = bflo(xx.w) + G0 * bflo(a.w) + G1 * bflo(b.w); v1.w = bfhi(xx.w) + G0 * bfhi(a.w) + G1 * bfhi(b.w);
                xo[128 * j] = v0; xo[128 * j + 1] = v1; } } }
    }
}

#ifndef PROBE_MASK
#define PROBE_MASK 0u
#endif
#ifndef PH_MASK
#define PH_MASK 0xffffffffu
#endif
__global__ void __launch_bounds__(NTHR, 2) hybrid_fwd(Args args) {
    (void)args;
    const int wv = __builtin_amdgcn_readfirstlane(threadIdx.x >> 6);
    { LAS unsigned char* lds = (LAS unsigned char*)lds_raw;
      for (int u = threadIdx.x; u < (LDS_BYTES - RING_BYTES) / 4; u += NTHR) ((LAS unsigned*)(lds + RING_BYTES))[u] = 0u; }
    __syncthreads();
    { const CAS Args* ka = ka_ptr();
      if (ka->ph_hi - ka->ph_lo > 1) { (void)xcd_barrier_post((unsigned*)(ka->ws + WS_CTL) + CW_BAR, (volatile LAS unsigned*)((LAS unsigned char*)lds_raw + MISC_OFF) + 8); } }
    int gp = 0;
#define PHASE(k, call) { const CAS Args* ka_ = ka_ptr(); const int lo_ = ka_->ph_lo, hi_ = ka_->ph_hi; if (lo_ <= gp && gp < hi_) { if constexpr ((PH_MASK >> (k)) & 1u) { call; if constexpr ((PROBE_MASK >> (k)) & 1u) { __syncthreads(); call; } } if (hi_ - lo_ > 1 && gp + 1 < hi_) grid_barrier(wv); } ++gp; }
    PHASE(0, P_prologue(wv))
#pragma unroll 1
    for (int l = 0; l < NLAYER; ++l) {
        PHASE(1, P_weights_norm(wv, l))
        PHASE(2, P_gemm_in(wv, l))
        PHASE(3, P_mix1(wv, l))
        PHASE(4, P_mix2(wv, l))
        PHASE(5, P_mix3(wv, l))
        PHASE(6, P_mix4(wv, l))
        PHASE(7, P_mix5(wv, l))
        PHASE(8, P_gemm_branch(wv))
        PHASE(9, P_gemm_gate(wv))
        PHASE(10, P_gemm_out(wv))
        PHASE(11, P_norm_ffn(wv, l))
        if (!(l & 1)) {
            PHASE(12, P_ffn_up(wv))
            PHASE(13, P_ffn_down(wv))
            gp += 2;
        } else {
            PHASE(14, P_moe_scatter(wv, l >> 1))
            PHASE(15, P_moe_up(wv))
            PHASE(16, P_moe_down(wv))
            if (l == NLAYER - 1) { PHASE(17, P_moe_combine(wv)) } else { ++gp; }
        }
    }
#undef PHASE
}
constexpr int N_PHASES = 1 + NLAYER * 15;

#ifndef MK_MULTI
#define MK_MULTI 0
#endif
extern "C" void kernel_launch(void* const* d_in, const int* in_sizes, int n_in, void* d_out, int out_size, void* d_ws, size_t ws_size, hipStream_t stream) {
    static int grid = 0;
    if (grid == 0) {
        if (n_in != 32 || in_sizes[0] != T * D || out_size != T * D || ws_size < WS_END) { fprintf(stderr, "kernel_launch: unexpected problem shape / workspace (%d inputs, ws %zu)\n", n_in, ws_size); grid = -1; return; }
        int dev = 0, cus = 0, per_cu = 0;
        if (hipGetDevice(&dev) != hipSuccess || hipDeviceGetAttribute(&cus, hipDeviceAttributeMultiprocessorCount, dev) != hipSuccess) { grid = -1; return; }
        if (hipFuncSetAttribute((const void*)hybrid_fwd, hipFuncAttributeMaxDynamicSharedMemorySize, LDS_BYTES) != hipSuccess) { fprintf(stderr, "kernel_launch: hipFuncSetAttribute failed\n"); grid = -1; return; }
        if (hipOccupancyMaxActiveBlocksPerMultiprocessor(&per_cu, (const void*)hybrid_fwd, NTHR, LDS_BYTES) != hipSuccess || per_cu < 1) { fprintf(stderr, "kernel_launch: occupancy query says %d\n", per_cu); }
        (void)hipGetLastError();
        grid = cus;
    }
    if (grid < 0) return;
    (void)hipMemsetAsync((char*)d_ws + WS_CTL, 0, CTL_ZERO_BYTES, stream);
#ifdef DBG_ZERO_WS
    (void)hipMemsetAsync((char*)d_ws + CTL_ZERO_BYTES, 0, WS_END - CTL_ZERO_BYTES, stream);
#endif
    Args a{};
    for (int i = 0; i < 32; ++i) a.in[i] = (const float*)d_in[i];
    a.out = (float*)d_out; a.ws = (unsigned char*)d_ws;
#if MK_MULTI
    for (int p = 0; p < N_PHASES; ++p) { a.ph_lo = p; a.ph_hi = p + 1; hipLaunchKernelGGL(hybrid_fwd, dim3(grid), dim3(NTHR), LDS_BYTES, stream, a); }
#else
    a.ph_lo = 0; a.ph_hi = N_PHASES; hipLaunchKernelGGL(hybrid_fwd, dim3(grid), dim3(NTHR), LDS_BYTES, stream, a);
#endif
}
```

```cpp
#include <hip/hip_runtime.h>
#include <cstdio>
#include <cstdint>

#define GAS __attribute__((address_space(1)))
#define LAS __attribute__((address_space(3)))
typedef unsigned short bf16;
typedef unsigned u32x4 __attribute__((ext_vector_type(4)));
typedef unsigned u32x2 __attribute__((ext_vector_type(2)));
typedef float f32x4 __attribute__((ext_vector_type(4)));
typedef float f32x2 __attribute__((ext_vector_type(2)));
typedef short bf16x8 __attribute__((ext_vector_type(8)));
typedef float f32x16 __attribute__((ext_vector_type(16)));
typedef short s16x4 __attribute__((ext_vector_type(4)));

constexpr int SEQ = 16384, NBATCH = 2, T = NBATCH * SEQ, D = 1024, NIN = 3328, DFF = 2816, DFE = 1408, NEXP = 8, NLAYER = 4;
constexpr int MPAD = 2 * T + NEXP * 256;
constexpr int NWAVES = 8, NTHR = 512;
constexpr float LOG2E = 1.4426950408889634f;
constexpr int MM_LP = 72;

typedef __bf16 bf16x2_t __attribute__((ext_vector_type(2)));
__device__ __forceinline__ unsigned cvt_pk_bf16(float lo, float hi) { const f32x2 v = {lo, hi}; const bf16x2_t b = __builtin_convertvector(v, bf16x2_t); return __builtin_bit_cast(unsigned, b); }
__device__ __forceinline__ float bflo(unsigned u) { return __builtin_bit_cast(float, u << 16); }
__device__ __forceinline__ float bfhi(unsigned u) { return __builtin_bit_cast(float, u & 0xffff0000u); }
__device__ __forceinline__ float bf2f(bf16 u) { return __builtin_bit_cast(float, (unsigned)u << 16); }
__device__ __forceinline__ bf16 f2bf(float f) { return (bf16)(cvt_pk_bf16(f, 0.f) & 0xffffu); }
__device__ __forceinline__ float sigm(float x) { return __builtin_amdgcn_rcpf(1.f + __builtin_amdgcn_exp2f(-x * LOG2E)); }
__device__ __forceinline__ float shx(float v, int o, int lane) { return __builtin_bit_cast(float, __builtin_amdgcn_ds_bpermute((lane ^ o) << 2, __builtin_bit_cast(int, v))); }
__device__ __forceinline__ float dpp_add(float v, const int ctrl_id) {
    const int x = __builtin_bit_cast(int, v);
    int y;
    if (ctrl_id == 0) y = __builtin_amdgcn_update_dpp(0, x, 0xB1, 0xF, 0xF, true);
    else if (ctrl_id == 1) y = __builtin_amdgcn_update_dpp(0, x, 0x4E, 0xF, 0xF, true);
    else if (ctrl_id == 2) y = __builtin_amdgcn_update_dpp(0, x, 0x141, 0xF, 0xF, true);
    else y = __builtin_amdgcn_update_dpp(0, x, 0x140, 0xF, 0xF, true);
    return v + __builtin_bit_cast(float, y);
}
__device__ __forceinline__ float wave_sum(float v, int lane) {
    (void)lane;
    v = dpp_add(v, 0); v = dpp_add(v, 1); v = dpp_add(v, 2); v = dpp_add(v, 3);
    const int x = __builtin_bit_cast(int, v);
    const float s0 = __builtin_bit_cast(float, __builtin_amdgcn_readlane(x, 0)), s1 = __builtin_bit_cast(float, __builtin_amdgcn_readlane(x, 16)),
                s2 = __builtin_bit_cast(float, __builtin_amdgcn_readlane(x, 32)), s3 = __builtin_bit_cast(float, __builtin_amdgcn_readlane(x, 48));
    return (s0 + s1) + (s2 + s3);
}
__device__ __forceinline__ void unpack8(const u32x4 v, float* f) {
    f[0] = bflo(v.x); f[1] = bfhi(v.x); f[2] = bflo(v.y); f[3] = bfhi(v.y); f[4] = bflo(v.z); f[5] = bfhi(v.z); f[6] = bflo(v.w); f[7] = bfhi(v.w);
}
__device__ __forceinline__ unsigned pk4_fp8(float a, float b, float c, float d) {
    a = __builtin_amdgcn_fmed3f(a, -440.f, 440.f); b = __builtin_amdgcn_fmed3f(b, -440.f, 440.f); c = __builtin_amdgcn_fmed3f(c, -440.f, 440.f); d = __builtin_amdgcn_fmed3f(d, -440.f, 440.f);
    int w = __builtin_amdgcn_cvt_pk_fp8_f32(a, b, 0, false); w = __builtin_amdgcn_cvt_pk_fp8_f32(c, d, w, true); return (unsigned)w; }
__device__ __forceinline__ u32x4 pack8(const float* f) {
    u32x4 w; w.x = cvt_pk_bf16(f[0], f[1]); w.y = cvt_pk_bf16(f[2], f[3]); w.z = cvt_pk_bf16(f[4], f[5]); w.w = cvt_pk_bf16(f[6], f[7]); return w;
}


#ifndef PROBE2
#define PROBE2 0
#endif
#ifndef GMASK
#define GMASK 15
#endif
#ifndef RWDBG
#define RWDBG 0
#endif
typedef int i32x8 __attribute__((ext_vector_type(8)));
constexpr float F8_MUL_X = 16.f, F8_MUL_W = 256.f, F8_DESCALE = 1.0f / (16.f * 256.f), F8_MUL_H = 4.f, F8_DESCALE_DOWN = 1.0f / (4.f * 256.f);
constexpr int DFE_PAD = 1536;
namespace pg8 {
typedef unsigned short bf16_t;
constexpr int BM = 256, BK = 64, HALF = 128, HTB = HALF * BK * 2, NXCD = 8, WGM = 8;
__host__ __device__ __forceinline__ int lds_byte(int r, int c) { const int st = (r >> 4) * 2 + (c >> 5), rr = r & 15, cc = c & 31, ob = rr * 64 + cc * 2; return st * 1024 + (ob ^ (((ob >> 9) & 1) << 5)); }
__host__ __device__ __forceinline__ void stage_rc(int b, int& R, int& C) { const int st = b / 1024, sb = b % 1024, swz = sb ^ (((sb >> 9) & 1) << 5); R = (st >> 1) * 16 + swz / 64; C = (st & 1) * 32 + (swz % 64) / 2; }
__host__ __device__ __forceinline__ int perm32(int rho) { const int n = rho >> 4, i = rho & 15; return 8 * (i >> 2) + 4 * n + (i & 3); }

struct Unit { int pm, pn, aoff; };
struct Gemm { const bf16_t* A; const bf16_t* Bt; int lda, K; };

struct StaticOrder {
    int nM, nN, nwg, G, c, ashift, amul;
    __device__ void init(int M, int N, int G_, int c_, int ashift_ = 0, int amul_ = 0) { nM = M / BM; nN = N / BM; nwg = nM * nN; G = G_; c = c_; ashift = ashift_; amul = amul_; }
    __device__ bool next(int i, Unit& u) const {
        const long L = (long)i * G + c; if (L >= nwg) return false;
        int wgid = (int)L; { const int q = nwg / NXCD, r = nwg % NXCD, xcd = wgid % NXCD, off = wgid / NXCD; wgid = (xcd < r ? xcd * (q + 1) : r * (q + 1) + (xcd - r) * q) + off; }
        const int nig = WGM * nN, gid = wgid / nig, fm = gid * WGM, gsz = (nM - fm) < WGM ? (nM - fm) : WGM;
        u.pm = fm + ((wgid % nig) % gsz); u.pn = (wgid % nig) / gsz; u.aoff = (u.pn >> ashift) * amul; return true;
    }
};
struct MoeOrder {
    const int* texp; int ntiles, ncol, G, c;
    __device__ bool next(int i, Unit& u) const {
        const int L = i * G + c; if (L >= ntiles * ncol) return false;
        const int pm = L / ncol, pl = L % ncol;
        u.pm = pm; u.pn = texp[pm] * ncol + pl; u.aoff = 0; return true;
    }
};

template <class Epi, class Sched, bool ALIGN_EPI, int CMAP = 0>
__device__ __forceinline__ void gemm_phase(LAS unsigned char* lds, const int tid_in, const Gemm g, const Sched& S, const Epi& E) {
    const int tid = tid_in, wid = __builtin_amdgcn_readfirstlane(tid >> 6), lane = tid & 63, wr = wid >> 2, wc = wid & 3, fr = lane & 15, fq = lane >> 4;
    const int K = g.K, nt = K / BK, lda = g.lda;
    unsigned voffA[2], voffB[2];
#pragma unroll
    for (int i = 0; i < 2; ++i) { int R, C; stage_rc(tid * 16 + i * 8192, R, C); const int p32 = perm32(R & 31); const int Rb = CMAP ? 64 * (R >> 5) + 16 * (p32 >> 3) + (p32 & 7) : (R & ~31) + p32;
        voffA[i] = (unsigned)(R * lda + C) * 2u; voffB[i] = (unsigned)(Rb * K + C) * 2u; }
    const size_t kstep = (size_t)(BK * 2);
    const size_t hstepA = (size_t)HALF * lda * 2, tstepA = 2 * hstepA, hstepB = (size_t)(CMAP ? 8 : HALF) * K * 2, tstepB = (size_t)BM * K * 2;
    const unsigned ldsw = (unsigned)wid * 1024u;
    const int aoff = lds_byte(wr * 64 + fr, fq * 8), boff = lds_byte(wc * 32 + fr, fq * 8);
#define PG8_SA(b, h) (((b) * 2 + (h)) * HTB)
#define PG8_SB(b, h) ((4 + (b) * 2 + (h)) * HTB)
#define PG8_STAGE(bufoff, gbase, voff) do { _Pragma("unroll") for (int _i = 0; _i < 2; ++_i) \
        __builtin_amdgcn_global_load_lds((const unsigned*)((const char*)(gbase) + (voff)[_i]), (LAS unsigned*)(lds + (bufoff) + ldsw + _i * 8192), 16, 0, 0); } while (0)
#define PG8_LDA(dst, b, h) do { _Pragma("unroll") for (int m = 0; m < 4; ++m) _Pragma("unroll") for (int k = 0; k < 2; ++k) dst[m][k] = *(const LAS bf16x8*)(lds + PG8_SA(b, h) + aoff + m * 2048 + k * 1024); } while (0)
#define PG8_LDB(dst, b, h) do { _Pragma("unroll") for (int n = 0; n < 2; ++n) _Pragma("unroll") for (int k = 0; k < 2; ++k) dst[n][k] = *(const LAS bf16x8*)(lds + PG8_SB(b, h) + boff + n * 2048 + k * 1024); } while (0)
#define PG8_MMA(ai, bj, At, Bt) do { __builtin_amdgcn_s_setprio(1); _Pragma("unroll") for (int m = 0; m < 4; ++m) _Pragma("unroll") for (int n = 0; n < 2; ++n) _Pragma("unroll") for (int k = 0; k < 2; ++k) \
        acc[ai][bj][m][n] = __builtin_amdgcn_mfma_f32_16x16x32_bf16(Bt[n][k], At[m][k], acc[ai][bj][m][n], 0, 0, 0); __builtin_amdgcn_s_setprio(0); } while (0)
#define PG8_WAIT_V(n) asm volatile("s_waitcnt vmcnt(" #n ")" ::: "memory")
#define PG8_WAIT_L(n) asm volatile("s_waitcnt lgkmcnt(" #n ")" ::: "memory")
#define PG8_BAR __builtin_amdgcn_s_barrier()
#define PG8_SCHED __builtin_amdgcn_sched_barrier(0)
    Unit cur, nxt; int ui = 0;
    if (!S.next(0, cur)) return;
    f32x4 acc[2][2][4][2];
#pragma unroll
    for (int a = 0; a < 2; ++a)
#pragma unroll
        for (int b = 0; b < 2; ++b)
#pragma unroll
            for (int m = 0; m < 4; ++m)
#pragma unroll
                for (int n = 0; n < 2; ++n) acc[a][b][m][n] = (f32x4){0.f, 0.f, 0.f, 0.f};
    bf16x8 At[4][2], B0[2][2], B1[2][2];
    const char* cA = (const char*)g.A + (size_t)cur.pm * tstepA + cur.aoff; const char* cB = (const char*)g.Bt + (size_t)cur.pn * tstepB;
    PG8_STAGE(PG8_SB(0, 0), cB, voffB); PG8_STAGE(PG8_SB(0, 1), cB + hstepB, voffB); PG8_STAGE(PG8_SA(0, 0), cA, voffA); PG8_STAGE(PG8_SA(0, 1), cA + hstepA, voffA);
    if (wr == 1) PG8_BAR;
    PG8_WAIT_V(2); PG8_BAR;
    PG8_STAGE(PG8_SB(1, 0), cB + kstep, voffB); PG8_STAGE(PG8_SA(1, 0), cA + kstep, voffA); PG8_STAGE(PG8_SB(1, 1), cB + hstepB + kstep, voffB);
    PG8_WAIT_V(6); PG8_BAR;
    for (;;) {
        const bool has_next = S.next(ui + 1, nxt);
        const char* nA = has_next ? (const char*)g.A + (size_t)nxt.pm * tstepA + nxt.aoff : cA; const char* nB = has_next ? (const char*)g.Bt + (size_t)nxt.pn * tstepB : cB;
#pragma unroll 1
        for (int t = 0; t < nt; t += 2) {
            const bool last = (t == nt - 2);
            const char* a1 = cA + (size_t)(t + 1) * kstep;
            const char* a2 = last ? nA : cA + (size_t)(t + 2) * kstep; const char* b2 = last ? nB : cB + (size_t)(t + 2) * kstep;
            const char* a3 = a2 + kstep; const char* b3 = b2 + kstep;
            PG8_LDB(B0, 0, 0); PG8_LDB(B1, 0, 1); PG8_SCHED; PG8_LDA(At, 0, 0); PG8_STAGE(PG8_SA(1, 1), a1 + hstepA, voffA);
            PG8_WAIT_V(8); PG8_WAIT_L(0); PG8_BAR; PG8_MMA(0, 0, At, B0); PG8_MMA(0, 1, At, B1); PG8_BAR; PG8_SCHED;
            PG8_LDA(At, 0, 1); PG8_STAGE(PG8_SB(0, 0), b2, voffB); PG8_STAGE(PG8_SB(0, 1), b2 + hstepB, voffB); PG8_STAGE(PG8_SA(0, 0), a2, voffA);
            PG8_WAIT_V(8); PG8_WAIT_L(0); PG8_BAR; PG8_MMA(1, 0, At, B0); PG8_MMA(1, 1, At, B1); PG8_BAR; PG8_SCHED;
            PG8_LDB(B0, 1, 0); PG8_LDB(B1, 1, 1); PG8_SCHED; PG8_LDA(At, 1, 0); PG8_STAGE(PG8_SA(0, 1), a2 + hstepA, voffA);
            PG8_WAIT_V(8); PG8_WAIT_L(0); PG8_BAR; PG8_MMA(0, 0, At, B0); PG8_MMA(0, 1, At, B1); PG8_BAR; PG8_SCHED;
            PG8_LDA(At, 1, 1); PG8_STAGE(PG8_SB(1, 0), b3, voffB); PG8_STAGE(PG8_SB(1, 1), b3 + hstepB, voffB); PG8_STAGE(PG8_SA(1, 0), a3, voffA);
            PG8_WAIT_V(8); PG8_WAIT_L(0); PG8_BAR; PG8_MMA(1, 0, At, B0); PG8_MMA(1, 1, At, B1); PG8_BAR; PG8_SCHED;
        }
        if constexpr (ALIGN_EPI) { if (wr == 0) PG8_BAR; }
        { int ln_; asm volatile("v_mbcnt_lo_u32_b32 %0, -1, 0\n\tv_mbcnt_hi_u32_b32 %0, -1, %0" : "=v"(ln_)); E(acc, cur, wr, wc, ln_ & 15, ln_ >> 4); }
        if (!has_next) break;
#pragma unroll
        for (int a = 0; a < 2; ++a)
#pragma unroll
            for (int b = 0; b < 2; ++b)
#pragma unroll
                for (int m = 0; m < 4; ++m)
#pragma unroll
                    for (int n = 0; n < 2; ++n) acc[a][b][m][n] = (f32x4){0.f, 0.f, 0.f, 0.f};
        cur = nxt; cA = nA; cB = nB; ++ui;
        if constexpr (ALIGN_EPI) { if (wr == 1) PG8_BAR; }
    }
    PG8_WAIT_V(0);
    if constexpr (!ALIGN_EPI) { if (wr == 0) PG8_BAR; }
    PG8_BAR;
#undef PG8_SA
#undef PG8_SB
#undef PG8_STAGE
#undef PG8_LDA
#undef PG8_LDB
#undef PG8_MMA
#undef PG8_WAIT_V
#undef PG8_WAIT_L
#undef PG8_BAR
#undef PG8_SCHED
}

template <class Epi, class Sched, bool ALIGN_EPI, int CMAP = 0>
__device__ __forceinline__ void gemm_phase8(LAS unsigned char* lds, const int tid_in, const Gemm g, const Sched& S, const Epi& E) {
    const int tid = tid_in, wid = __builtin_amdgcn_readfirstlane(tid >> 6), lane = tid & 63, wr = wid >> 2, wc = wid & 3, fr = lane & 15, fq = lane >> 4;
    const int K = g.K, nt = K / 128, lda = g.lda;
    unsigned voffA, voffB;
    { int R, C; stage_rc(tid * 16, R, C); const int p32 = perm32(R & 31); const int Rb = CMAP ? 64 * (R >> 5) + 16 * (p32 >> 3) + (p32 & 7) : (R & ~31) + p32; voffA = (unsigned)(R * lda + C * 2); voffB = (unsigned)(Rb * K + C * 2); }
    const unsigned pstepA = 64u * (unsigned)lda, pstepB = (CMAP ? 128u : 64u) * (unsigned)K;
    const unsigned kstep = (unsigned)(BK * 2);
    const unsigned hstepA = (unsigned)HALF * (unsigned)lda, tstepA = 2 * hstepA, hstepB = (unsigned)(CMAP ? 8 : HALF) * (unsigned)K, tstepB = (unsigned)BM * (unsigned)K;
    const __amdgpu_buffer_rsrc_t rsA = __builtin_amdgcn_make_buffer_rsrc((void*)g.A, 0, 0x7fffffff, 0x00020000), rsB = __builtin_amdgcn_make_buffer_rsrc((void*)g.Bt, 0, 0x7fffffff, 0x00020000);
    const unsigned ldsw = (unsigned)wid * 1024u;
    const int aoff0 = lds_byte(wr * 64 + fr, fq * 8), aoff1 = aoff0 + 1024, boff0 = lds_byte(wc * 32 + fr, fq * 8), boff1 = boff0 + 1024;
#define PG8_SA(b, h) (((b) * 2 + (h)) * HTB)
#define PG8_SB(b, h) ((4 + (b) * 2 + (h)) * HTB)
#define PG8_STAGE(bufoff, goff, voff, pstep) do { _Pragma("unroll") for (int _i = 0; _i < 2; ++_i) \
        __builtin_amdgcn_raw_ptr_buffer_load_lds(PG8_RS_##voff, (LAS unsigned*)(lds + (bufoff) + ldsw + _i * 8192), 16, (int)(voff), (int)((goff) + _i * (pstep)), 0, 0); } while (0)
#define PG8_RS_voffA rsA
#define PG8_RS_voffB rsB
#define PG8_LDA(dst, b, h) do { _Pragma("unroll") for (int m = 0; m < 4; ++m) { dst[m][0] = *(const LAS u32x4*)(lds + PG8_SA(b, h) + aoff0 + m * 2048); dst[m][1] = *(const LAS u32x4*)(lds + PG8_SA(b, h) + aoff1 + m * 2048); } } while (0)
#define PG8_LDB(dst, b, h) do { _Pragma("unroll") for (int n = 0; n < 2; ++n) { dst[n][0] = *(const LAS u32x4*)(lds + PG8_SB(b, h) + boff0 + n * 2048); dst[n][1] = *(const LAS u32x4*)(lds + PG8_SB(b, h) + boff1 + n * 2048); } } while (0)
#define PG8_J8(x) __builtin_bit_cast(i32x8, __builtin_shufflevector((x)[0], (x)[1], 0, 1, 2, 3, 4, 5, 6, 7))
#define PG8_MMA(ai, bj, At, Bt) do { __builtin_amdgcn_s_setprio(1); _Pragma("unroll") for (int m = 0; m < 4; ++m) _Pragma("unroll") for (int n = 0; n < 2; ++n) \
        acc[ai][bj][m][n] = __builtin_amdgcn_mfma_scale_f32_16x16x128_f8f6f4(PG8_J8(Bt[n]), PG8_J8(At[m]), acc[ai][bj][m][n], 0, 0, 0, 0, 0, 0);        __builtin_amdgcn_s_setprio(0); } while (0)
#define PG8_WAIT_V(n) asm volatile("s_waitcnt vmcnt(" #n ")" ::: "memory")
#define PG8_WAIT_L(n) asm volatile("s_waitcnt lgkmcnt(" #n ")" ::: "memory")
#define PG8_BAR __builtin_amdgcn_s_barrier()
#define PG8_SCHED __builtin_amdgcn_sched_barrier(0)
    Unit cur, nxt; int ui = 0;
    if (!S.next(0, cur)) return;
    f32x4 acc[2][2][4][2];
#pragma unroll
    for (int a = 0; a < 2; ++a)
#pragma unroll
        for (int b = 0; b < 2; ++b)
#pragma unroll
            for (int m = 0; m < 4; ++m)
#pragma unroll
                for (int n = 0; n < 2; ++n) acc[a][b][m][n] = (f32x4){0.f, 0.f, 0.f, 0.f};
    u32x4 At[4][2], B0[2][2], B1[2][2];
    unsigned cA = (unsigned)cur.pm * tstepA + (unsigned)cur.aoff, cB = (unsigned)cur.pn * tstepB;
    PG8_STAGE(PG8_SB(0, 0), cB, voffB, pstepB); PG8_STAGE(PG8_SB(0, 1), cB + hstepB, voffB, pstepB); PG8_STAGE(PG8_SA(0, 0), cA, voffA, pstepA); PG8_STAGE(PG8_SA(0, 1), cA + hstepA, voffA, pstepA);
    if (wr == 1) PG8_BAR;
    PG8_WAIT_V(2); PG8_BAR;
    PG8_STAGE(PG8_SB(1, 0), cB + kstep, voffB, pstepB); PG8_STAGE(PG8_SA(1, 0), cA + kstep, voffA, pstepA); PG8_STAGE(PG8_SB(1, 1), cB + hstepB + kstep, voffB, pstepB);
    PG8_WAIT_V(6); PG8_BAR;
    for (;;) {
        const bool has_next = S.next(ui + 1, nxt);
        const unsigned nA = has_next ? (unsigned)nxt.pm * tstepA + (unsigned)nxt.aoff : cA, nB = has_next ? (unsigned)nxt.pn * tstepB : cB;
#pragma unroll 1
        for (int t = 0; t < nt; t += 2) {
            const bool last = (t == nt - 2);
            const unsigned a1 = cA + (unsigned)(t + 1) * kstep;
            const unsigned a2 = last ? nA : cA + (unsigned)(t + 2) * kstep, b2 = last ? nB : cB + (unsigned)(t + 2) * kstep;
            const unsigned a3 = a2 + kstep, b3 = b2 + kstep;
            PG8_LDB(B0, 0, 0); PG8_LDB(B1, 0, 1); PG8_SCHED; PG8_LDA(At, 0, 0); PG8_STAGE(PG8_SA(1, 1), a1 + hstepA, voffA, pstepA);
            PG8_WAIT_V(8); PG8_WAIT_L(0); PG8_BAR; PG8_MMA(0, 0, At, B0); PG8_MMA(0, 1, At, B1); PG8_BAR; PG8_SCHED;
            PG8_LDA(At, 0, 1); PG8_STAGE(PG8_SB(0, 0), b2, voffB, pstepB); PG8_STAGE(PG8_SB(0, 1), b2 + hstepB, voffB, pstepB); PG8_STAGE(PG8_SA(0, 0), a2, voffA, pstepA);
            PG8_WAIT_V(8); PG8_WAIT_L(0); PG8_BAR; PG8_MMA(1, 0, At, B0); PG8_MMA(1, 1, At, B1); PG8_BAR; PG8_SCHED;
            PG8_LDB(B0, 1, 0); PG8_LDB(B1, 1, 1); PG8_SCHED; PG8_LDA(At, 1, 0); PG8_STAGE(PG8_SA(0, 1), a2 + hstepA, voffA, pstepA);
            PG8_WAIT_V(8); PG8_WAIT_L(0); PG8_BAR; PG8_MMA(0, 0, At, B0); PG8_MMA(0, 1, At, B1); PG8_BAR; PG8_SCHED;
            PG8_LDA(At, 1, 1); PG8_STAGE(PG8_SB(1, 0), b3, voffB, pstepB); PG8_STAGE(PG8_SB(1, 1), b3 + hstepB, voffB, pstepB); PG8_STAGE(PG8_SA(1, 0), a3, voffA, pstepA);
            PG8_WAIT_V(8); PG8_WAIT_L(0); PG8_BAR; PG8_MMA(1, 0, At, B0); PG8_MMA(1, 1, At, B1); PG8_BAR; PG8_SCHED;
        }
        if constexpr (ALIGN_EPI) { if (wr == 0) PG8_BAR; }
        { int ln_; asm volatile("v_mbcnt_lo_u32_b32 %0, -1, 0\n\tv_mbcnt_hi_u32_b32 %0, -1, %0" : "=v"(ln_)); E(acc, cur, wr, wc, ln_ & 15, ln_ >> 4); }
        if (!has_next) break;
#pragma unroll
        for (int a = 0; a < 2; ++a)
#pragma unroll
            for (int b = 0; b < 2; ++b)
#pragma unroll
                for (int m = 0; m < 4; ++m)
#pragma unroll
                    for (int n = 0; n < 2; ++n) acc[a][b][m][n] = (f32x4){0.f, 0.f, 0.f, 0.f};
        cur = nxt; cA = nA; cB = nB; ++ui;
        if constexpr (ALIGN_EPI) { if (wr == 1) PG8_BAR; }
    }
    PG8_WAIT_V(0);
    if constexpr (!ALIGN_EPI) { if (wr == 0) PG8_BAR; }
    PG8_BAR;
#undef PG8_SA
#undef PG8_SB
#undef PG8_STAGE
#undef PG8_RS_voffA
#undef PG8_RS_voffB
#undef PG8_LDA
#undef PG8_LDB
#undef PG8_MMA
#undef PG8_J8
#undef PG8_WAIT_V
#undef PG8_WAIT_L
#undef PG8_BAR
#undef PG8_SCHED
}

typedef f32x4 Acc[2][2][4][2];

__device__ __forceinline__ unsigned dpp_ror8(unsigned v) { return (unsigned)__builtin_amdgcn_update_dpp(0, (int)v, 0x128, 0xf, 0xf, false); }
struct CmPair { unsigned a, b; };
__device__ __forceinline__ CmPair cm_swapv(bool lo, unsigned x0, unsigned x1) { const unsigned r = dpp_ror8(lo ? x1 : x0); CmPair o; o.a = lo ? x0 : r; o.b = lo ? r : x1; return o; }
#define CM_SWAP_U(lo, X0, X1) do { const CmPair r_ = cm_swapv(lo, X0, X1); X0 = r_.a; X1 = r_.b; } while (0)
#define CM_SWAP_F(lo, X0, X1) do { const CmPair r_ = cm_swapv(lo, __builtin_bit_cast(unsigned, (float)(X0)), __builtin_bit_cast(unsigned, (float)(X1))); X0 = __builtin_bit_cast(float, r_.a); X1 = __builtin_bit_cast(float, r_.b); } while (0)
#define cm_swap4(lo, w0, w1) do { CM_SWAP_U(lo, w0.x, w1.x); CM_SWAP_U(lo, w0.y, w1.y); CM_SWAP_U(lo, w0.z, w1.z); CM_SWAP_U(lo, w0.w, w1.w); } while (0)
struct EpiRoute {
    bf16_t *d0, *d1, *d2, *d3; const float* qn; const float* kn;
    template <int NORM> __device__ __forceinline__ void run(const Acc& acc, const Unit& u, int wr, int wc, int fr, int fq, bf16_t* base, int ld, int ct) const {
        const bool lo = fr < 8;
        const int row0 = u.pm * BM + wr * 64 + (fr & 7), col0 = ct * 256 + wc * 64 + 16 * fq + 8 * (fr >> 3);
        f32x4 gg[2][2];
        if constexpr (NORM) { const float* gn = (u.pn == 4) ? qn : kn; const float gs = (u.pn == 4) ? 0.125f * LOG2E : 1.0f;
#pragma unroll
            for (int bj = 0; bj < 2; ++bj)
#pragma unroll
                for (int n = 0; n < 2; ++n) gg[bj][n] = *(const f32x4*)(gn + 16 * fq + 8 * bj + 4 * n) * gs; }
#pragma unroll
        for (int ai = 0; ai < 2; ++ai)
#pragma unroll
            for (int m = 0; m < 4; ++m) { bf16_t* rowp = base + (size_t)(row0 + ai * HALF + m * 16) * ld + col0; u32x4 w0, w1;
                f32x4 v00 = acc[ai][0][m][0], v01 = acc[ai][0][m][1], v10 = acc[ai][1][m][0], v11 = acc[ai][1][m][1];
                if constexpr (NORM) { float ss = 0.f;
#pragma unroll
                    for (int e = 0; e < 4; ++e) ss += (v00[e] * v00[e] + v01[e] * v01[e]) + (v10[e] * v10[e] + v11[e] * v11[e]);
                    ss += shx(ss, 16, fr + 16 * fq); ss += shx(ss, 32, fr + 16 * fq);
                    const float rs = __builtin_amdgcn_rsqf(ss * (1.f / 64.f) + 1e-6f);
                    v00 = v00 * rs * gg[0][0]; v01 = v01 * rs * gg[0][1]; v10 = v10 * rs * gg[1][0]; v11 = v11 * rs * gg[1][1]; }
                w0.x = cvt_pk_bf16(v00[0], v00[1]); w0.y = cvt_pk_bf16(v00[2], v00[3]); w0.z = cvt_pk_bf16(v01[0], v01[1]); w0.w = cvt_pk_bf16(v01[2], v01[3]);
                w1.x = cvt_pk_bf16(v10[0], v10[1]); w1.y = cvt_pk_bf16(v10[2], v10[3]); w1.z = cvt_pk_bf16(v11[0], v11[1]); w1.w = cvt_pk_bf16(v11[2], v11[3]);
                cm_swap4(lo, w0, w1);
                *(u32x4*)rowp = w0; *(u32x4*)(rowp + (size_t)8 * ld) = w1; }
    }
    __device__ __forceinline__ void operator()(const Acc& acc, const Unit& u, int wr, int wc, int fr, int fq) const {
        const int pn = u.pn; bf16_t* base; int ld, ct;
        if (pn < 4) { base = d0; ld = 1024; ct = pn; } else if (pn < 7) { base = d1; ld = 768; ct = pn - 4; } else if (pn < 11) { base = d2; ld = 1024; ct = pn - 7; } else { base = d3; ld = 512; ct = pn - 11; }
        if (pn >= 11) {
            const int row0 = u.pm * BM + wr * 64 + fr, c0 = (pn - 11) * 128 + 32 * wc + 8 * fq;
#pragma unroll
            for (int ai = 0; ai < 2; ++ai)
#pragma unroll
                for (int m = 0; m < 4; ++m) { const f32x4 a0 = acc[ai][0][m][0], a1 = acc[ai][0][m][1], b0 = acc[ai][1][m][0], b1 = acc[ai][1][m][1]; u32x4 w;
                    w.x = cvt_pk_bf16(a0[0] * sigm(b0[0]), a0[1] * sigm(b0[1])); w.y = cvt_pk_bf16(a0[2] * sigm(b0[2]), a0[3] * sigm(b0[3]));
                    w.z = cvt_pk_bf16(a1[0] * sigm(b1[0]), a1[1] * sigm(b1[1])); w.w = cvt_pk_bf16(a1[2] * sigm(b1[2]), a1[3] * sigm(b1[3]));
                    *(u32x4*)(d3 + (size_t)(row0 + ai * HALF + m * 16) * 256 + c0) = w; }
            return; }
        if (pn == 4 || pn == 5) run<1>(acc, u, wr, wc, fr, fq, base, ld, ct); else run<0>(acc, u, wr, wc, fr, fq, base, ld, ct);
    }
};
struct EpiBf16 {
    bf16_t* O; int ld, pnmask; float sc;
    __device__ __forceinline__ void operator()(const Acc& acc, const Unit& u, int wr, int wc, int fr, int fq) const {
        const bool lo = fr < 8;
        const int row0 = u.pm * BM + wr * 64 + (fr & 7), col0 = (u.pn & pnmask) * 256 + wc * 64 + 16 * fq + 8 * (fr >> 3);
#pragma unroll
        for (int ai = 0; ai < 2; ++ai)
#pragma unroll
            for (int m = 0; m < 4; ++m) { bf16_t* rowp = O + (size_t)(row0 + ai * HALF + m * 16) * ld + col0; u32x4 w0, w1;
                { const f32x4 v0 = acc[ai][0][m][0] * sc, v1 = acc[ai][0][m][1] * sc; w0.x = cvt_pk_bf16(v0[0], v0[1]); w0.y = cvt_pk_bf16(v0[2], v0[3]); w0.z = cvt_pk_bf16(v1[0], v1[1]); w0.w = cvt_pk_bf16(v1[2], v1[3]); }
                { const f32x4 v0 = acc[ai][1][m][0] * sc, v1 = acc[ai][1][m][1] * sc; w1.x = cvt_pk_bf16(v0[0], v0[1]); w1.y = cvt_pk_bf16(v0[2], v0[3]); w1.z = cvt_pk_bf16(v1[0], v1[1]); w1.w = cvt_pk_bf16(v1[2], v1[3]); }
                cm_swap4(lo, w0, w1);
                *(u32x4*)rowp = w0; *(u32x4*)(rowp + (size_t)8 * ld) = w1; }
    }
};
struct EpiLora {
    float* wdec; bf16_t* ag; bf16_t* gp; const float* w0; const float* a0;
    __device__ __forceinline__ void operator()(const Acc& acc, const Unit& u, int wr, int wc, int fr, int fq) const {
        const int row0 = u.pm * BM + wr * 64 + fr, cl0 = wc * 32 + 8 * fq, pn = u.pn;
#pragma unroll
        for (int ai = 0; ai < 2; ++ai)
#pragma unroll
            for (int m = 0; m < 4; ++m) { const size_t row = (size_t)(row0 + ai * HALF + m * 16);
#pragma unroll
                for (int bj = 0; bj < 2; ++bj) { const int col = bj * HALF + cl0; float v[8];
#pragma unroll
                    for (int n = 0; n < 2; ++n)
#pragma unroll
                        for (int e = 0; e < 4; ++e) v[4 * n + e] = acc[ai][bj][m][n][e];
                    if (pn == 0) {
                        *(f32x4*)(wdec + row * 256 + col) = (f32x4){v[0], v[1], v[2], v[3]}; *(f32x4*)(wdec + row * 256 + col + 4) = (f32x4){v[4], v[5], v[6], v[7]};
                    } else if (pn == 1) {
                        *(u32x4*)(ag + row * 256 + col) = pack8(v);
                    } else { *(u32x4*)(gp + row * 256 + col) = pack8(v); }
                } }
    }
};
struct EpiBall {
    unsigned char* O;
    __device__ __forceinline__ void operator()(const Acc& acc, const Unit& u, int wr, int wc, int fr, int fq) const {
        unsigned char* base = O + ((size_t)(u.pm * 16 + u.pn) << 17) + (wc >> 1) * 32768 + (wr * 2 + (wc & 1)) * 1024 + (fr + 16 * fq) * 16;
#pragma unroll
        for (int ai = 0; ai < 2; ++ai)
#pragma unroll
            for (int m = 0; m < 4; ++m)
#pragma unroll
                for (int bj = 0; bj < 2; ++bj) { const f32x4 v0 = acc[ai][bj][m][0], v1 = acc[ai][bj][m][1]; u32x4 w;
                    w.x = cvt_pk_bf16(v0[0], v0[1]); w.y = cvt_pk_bf16(v0[2], v0[3]); w.z = cvt_pk_bf16(v1[0], v1[1]); w.w = cvt_pk_bf16(v1[2], v1[3]);
                    __builtin_nontemporal_store(w, (u32x4*)(base + bj * 65536 + (ai * 4 + m) * 4096)); }
    }
};
struct EpiGateMerge {
    const bf16_t* ball; bf16_t* merged;
    __device__ __forceinline__ void operator()(const Acc& acc, const Unit& u, int wr, int wc, int fr, int fq) const {
        const int row0 = u.pm * BM + wr * 64 + fr, o0 = 64 * u.pn + 16 * wc + 4 * fq;
        const int cw = 64 * (u.pn & 3) + 16 * wc + 4 * fq;
        const unsigned char* lbase = (const unsigned char*)ball + ((size_t)(u.pm * 16 + (u.pn >> 2)) << 17) + (cw >> 7) * 65536 + ((cw >> 6) & 1) * 32768 + (wr * 2 + ((cw >> 5) & 1)) * 1024 + (fr + 16 * ((cw >> 3) & 3)) * 16 + ((cw >> 2) & 1) * 8;
        u32x2 bb[2][4][4];
#pragma unroll
        for (int ai = 0; ai < 2; ++ai)
#pragma unroll
            for (int m = 0; m < 4; ++m)
#pragma unroll
                for (int gi = 0; gi < 4; ++gi) bb[ai][m][gi] = __builtin_nontemporal_load((const u32x2*)(lbase + ((size_t)gi << 19) + (ai * 4 + m) * 4096));
#pragma unroll
        for (int ai = 0; ai < 2; ++ai)
#pragma unroll
            for (int m = 0; m < 4; ++m) { const size_t row = (size_t)(row0 + ai * HALF + m * 16); float s[4] = {0.f, 0.f, 0.f, 0.f};
#pragma unroll
                for (int bj = 0; bj < 2; ++bj)
#pragma unroll
                    for (int n = 0; n < 2; ++n) { const int gi = 2 * bj + n; const u32x2 b = bb[ai][m][gi];
                        const f32x4 a = acc[ai][bj][m][n] * F8_DESCALE;
                        s[0] += sigm(a[0]) * bflo(b.x); s[1] += sigm(a[1]) * bfhi(b.x); s[2] += sigm(a[2]) * bflo(b.y); s[3] += sigm(a[3]) * bfhi(b.y); }
                u32x2 w; w.x = cvt_pk_bf16(s[0], s[1]); w.y = cvt_pk_bf16(s[2], s[3]);
                *(u32x2*)(merged + row * 1024 + o0) = w; }
    }
};
struct EpiResidual {
    bf16_t* xb; float sc;
    __device__ __forceinline__ void operator()(const Acc& acc, const Unit& u, int wr, int wc, int fr, int fq) const {
        const bool lo = fr < 8;
        const int row0 = u.pm * BM + wr * 64 + (fr & 7), col0 = u.pn * 256 + wc * 64 + 16 * fq + 8 * (fr >> 3);
#pragma unroll
        for (int ai = 0; ai < 2; ++ai)
#pragma unroll
            for (int m = 0; m < 4; ++m) { u32x4* p0 = (u32x4*)(xb + (size_t)(row0 + ai * HALF + m * 16) * 1024 + col0); u32x4* p1 = (u32x4*)((bf16_t*)p0 + 8 * 1024);
                const u32x4 t0 = *p0, t1 = *p1;
                f32x4 a0 = acc[ai][0][m][0] * sc, a1 = acc[ai][0][m][1] * sc, b0 = acc[ai][1][m][0] * sc, b1 = acc[ai][1][m][1] * sc;
#pragma unroll
                for (int e = 0; e < 4; ++e) { CM_SWAP_F(lo, a0[e], b0[e]); CM_SWAP_F(lo, a1[e], b1[e]); }
                u32x4 w0, w1;
                w0.x = cvt_pk_bf16(bflo(t0.x) + a0[0], bfhi(t0.x) + a0[1]); w0.y = cvt_pk_bf16(bflo(t0.y) + a0[2], bfhi(t0.y) + a0[3]); w0.z = cvt_pk_bf16(bflo(t0.z) + a1[0], bfhi(t0.z) + a1[1]); w0.w = cvt_pk_bf16(bflo(t0.w) + a1[2], bfhi(t0.w) + a1[3]);
                w1.x = cvt_pk_bf16(bflo(t1.x) + b0[0], bfhi(t1.x) + b0[1]); w1.y = cvt_pk_bf16(bflo(t1.y) + b0[2], bfhi(t1.y) + b0[3]); w1.z = cvt_pk_bf16(bflo(t1.z) + b1[0], bfhi(t1.z) + b1[1]); w1.w = cvt_pk_bf16(bflo(t1.w) + b1[2], bfhi(t1.w) + b1[3]);
                *p0 = w0; *p1 = w1; }
    }
};
struct EpiSwiglu {
    unsigned char* hid; int ldh, ncol; bool pad;
    __device__ __forceinline__ void operator()(const Acc& acc, const Unit& u, int wr, int wc, int fr, int fq) const {
        const int pl = u.pn % ncol; const int row0 = u.pm * BM + wr * 64 + fr, col0 = pl * 128 + wc * 32 + 8 * fq;
        const bool dopad = pad && (pl == ncol - 1);
#pragma unroll
        for (int ai = 0; ai < 2; ++ai)
#pragma unroll
            for (int m = 0; m < 4; ++m) { float v[8];
#pragma unroll
                for (int n = 0; n < 2; ++n)
#pragma unroll
                    for (int e = 0; e < 4; ++e) { const float a = acc[ai][0][m][n][e] * F8_DESCALE, b = acc[ai][1][m][n][e] * F8_DESCALE; v[4 * n + e] = a * sigm(a) * b * F8_MUL_H; }
                unsigned char* rp = hid + (size_t)(row0 + ai * HALF + m * 16) * ldh + col0;
                u32x2 w; w.x = pk4_fp8(v[0], v[1], v[2], v[3]); w.y = pk4_fp8(v[4], v[5], v[6], v[7]); *(u32x2*)rp = w;
                if (dopad) { unsigned z0; asm volatile("v_mov_b32 %0, 0" : "=v"(z0)); *(u32x2*)(rp + 128) = (u32x2){z0, z0}; } }
    }
};
struct EpiMoeOut {
    float* out; const int* rowtok; const float* rowgate; const int* segend;
    __device__ __forceinline__ void operator()(const Acc& acc, const Unit& u, int wr, int wc, int fr, int fq) const {
        const int row0 = u.pm * BM + wr * 64 + fr, col0 = (u.pn & 3) * 256 + wc * 32 + 8 * fq, lim = segend[u.pm];
#pragma unroll
        for (int ai = 0; ai < 2; ++ai)
#pragma unroll
            for (int m = 0; m < 4; ++m) { const int row = row0 + ai * HALF + m * 16;
                if (row < lim) { const int tok = rowtok[row]; const float gt = rowgate[row]; float* rowp = out + (size_t)tok * 1024 + col0;
#pragma unroll
                    for (int bj = 0; bj < 2; ++bj)
#pragma unroll
                        for (int n = 0; n < 2; ++n)
#pragma unroll
                            for (int e = 0; e < 4; ++e) __hip_atomic_fetch_add(rowp + bj * HALF + 4 * n + e, gt * acc[ai][bj][m][n][e], __ATOMIC_RELAXED, __HIP_MEMORY_SCOPE_AGENT);
                } }
    }
};
}

#define XB_TMO      128
#define XB_XCNT(j)  (256  + 64 * (j))
#define XB_XSUB(j)  (1280 + 64 * (j))
#define XB_XGEN(j)  (2304 + 64 * (j))
#define XB_TOP      3328
#define XB_TOPGEN   3392
#define XCD_BAR_WORDS 3456
#define XB_SPIN_CAP (1u << 18)
__device__ __forceinline__ unsigned xb_ld(unsigned* p)              { return __hip_atomic_load(p, __ATOMIC_RELAXED, __HIP_MEMORY_SCOPE_AGENT); }
__device__ __forceinline__ unsigned xb_add(unsigned* p, unsigned v) { return __hip_atomic_fetch_add(p, v, __ATOMIC_RELAXED, __HIP_MEMORY_SCOPE_AGENT); }
__device__ __forceinline__ unsigned xb_xcc_id() { return (unsigned)__builtin_amdgcn_s_getreg((3 << 11) | 20) & 0xFu; }
#define XB_SPIN(cond, bar) do { unsigned _sp = 0; while (cond) { __builtin_amdgcn_s_sleep(1); \
    if ((++_sp & 255u) == 0u) { if (xb_ld(&(bar)[XB_TMO])) break; if (_sp > XB_SPIN_CAP) { atomicAdd(&(bar)[XB_TMO], 1u); break; } } } } while (0)
struct XcdBarrier { unsigned* bar; unsigned x; volatile LAS unsigned* st; };
__device__ __forceinline__ XcdBarrier xcd_barrier_post(unsigned* bar, volatile LAS unsigned* st) {
    XcdBarrier b; b.bar = bar; b.x = xb_xcc_id(); b.st = st;
    if (threadIdx.x == 0) (void)xb_add(&bar[XB_XCNT(b.x)], 1u);
    return b;
}
__device__ __forceinline__ void xcd_barrier_complete(unsigned* bar, unsigned x, unsigned& nloc, unsigned& nx) {
    const unsigned G = gridDim.x * gridDim.y * gridDim.z;
    unsigned sum, cnt, mine, sp = 0u;
    for (;;) {
        sum = 0u; cnt = 0u; mine = 0u;
#pragma unroll
        for (unsigned j = 0; j < 16; ++j) { const unsigned c = xb_ld(&bar[XB_XCNT(j)]); sum += c; cnt += (c > 0u) ? 1u : 0u; mine = (j == x) ? c : mine; }
        if (sum == G) break;
        __builtin_amdgcn_s_sleep(1);
        if ((++sp & 255u) == 0u) { if (xb_ld(&bar[XB_TMO])) break; if (sp > XB_SPIN_CAP) { atomicAdd(&bar[XB_TMO], 1u); break; } }
    }
    nloc = mine > 0u ? mine : 1u; nx = cnt > 0u ? cnt : 1u;
}
__device__ __forceinline__ void xcd_barrier(const XcdBarrier& b, const int tid) {
    asm volatile("s_waitcnt vmcnt(0)" ::: "memory");
    __syncthreads();
    if (tid == 0) {
        unsigned* bar = b.bar;
        __builtin_amdgcn_s_waitcnt(0);
        unsigned nloc = b.st[0], nx = b.st[1];
        if (nloc == 0u) { xcd_barrier_complete(bar, b.x, nloc, nx); b.st[0] = nloc; b.st[1] = nx; }
        const unsigned old = xb_add(&bar[XB_XSUB(b.x)], 1u);
        const unsigned gen = old / nloc;
        if (old + 1u == (gen + 1u) * nloc) {
            __builtin_amdgcn_fence(__ATOMIC_RELEASE, "agent");
            asm volatile("s_waitcnt vmcnt(0)" ::: "memory");
            const unsigned og = xb_add(&bar[XB_TOP], 1u);
            const unsigned tg = og / nx;
            if (og + 1u == (tg + 1u) * nx) xb_add(&bar[XB_TOPGEN], 1u);
            else XB_SPIN(xb_ld(&bar[XB_TOPGEN]) == tg, bar);
            __builtin_amdgcn_fence(__ATOMIC_ACQUIRE, "agent");
            xb_add(&bar[XB_XGEN(b.x)], 1u);
            asm volatile("s_waitcnt vmcnt(0)" ::: "memory");
        } else {
            XB_SPIN(xb_ld(&bar[XB_XGEN(b.x)]) == gen, bar);
            __builtin_amdgcn_fence(__ATOMIC_ACQUIRE, "agent");
            asm volatile("s_waitcnt vmcnt(0)" ::: "memory");
        }
    }
    __syncthreads();
}

constexpr size_t MiB = 1u << 20;
constexpr size_t WS_CTL = 0, CTL_ZERO_BYTES = 1 * MiB;
constexpr int CW_BAR = 4096;
constexpr int CW_QUEUE = 20480;
constexpr int CW_MOE = 16384;
constexpr size_t WS_EIDX = 1 * MiB, WS_GATE = WS_EIDX + 256 * 1024, WS_ROWTOK = WS_EIDX + 512 * 1024, WS_ROWGATE = 2 * MiB, WS_TEXP = 2 * MiB + 512 * 1024, WS_SEGEND = WS_TEXP + 4096, WS_NT = WS_TEXP + 8192;
constexpr size_t WS_SLOTOF = 2 * MiB + 768 * 1024;
constexpr size_t WS_BON = 3 * MiB, WS_COS = 4 * MiB, WS_SIN = 6 * MiB;
constexpr size_t WS_WIN = 8 * MiB, WS_WLORA = 15 * MiB, WS_WB = 16 * MiB, WS_WG = 18 * MiB, WS_WOUT = 26 * MiB, WS_W13 = 28 * MiB  , WS_W2D = 50 * MiB, WS_W2M = 50 * MiB, WS_H8 = 72 * MiB  ;
constexpr size_t WS_XB = 104 * MiB  , WS_Y = 168 * MiB, WS_BIG = 232 * MiB;
constexpr size_t WS_RW = WS_BIG, WS_WDEC = WS_BIG + 208 * MiB  , WS_AP = WS_BIG + 240 * MiB  , WS_GP = WS_BIG + 192 * MiB  , WS_AG = WS_BIG + 32 * MiB  , WS_SB = WS_BIG + 64 * MiB, WS_RET = WS_BIG + 112 * MiB, WS_CV = WS_BIG + 176 * MiB, WS_Y0 = WS_CV;
constexpr size_t WS_RKVS = WS_BIG + 208 * MiB, WS_ALORA = WS_BIG + 256 * MiB, WS_RHAT = WS_ALORA, WS_KV = WS_BIG + 272 * MiB, WS_SST = WS_WDEC  , WS_PQ = WS_BIG + 304 * MiB  , WS_END = WS_BIG + 368 * MiB;
constexpr size_t WS_BALL = WS_BIG, WS_MERGED = WS_BIG + 256 * MiB, WS_HID = WS_BIG, WS_XS = WS_BIG, WS_YS = WS_XS, WS_HIDM = WS_BIG + 132 * MiB;
static_assert(WS_HIDM + (size_t)MPAD * DFE * 2 <= WS_END && WS_MERGED + (size_t)T * D * 2 <= WS_END && WS_W2M + (size_t)NEXP * D * DFE * 2 <= WS_H8, "ws map");
static_assert(WS_W13 + (size_t)NEXP * 2 * DFE * D <= WS_W2M && WS_W13 + (size_t)2 * DFF * D <= WS_W2D && WS_W2M + (size_t)NEXP * D * DFE * 2 <= WS_H8 && WS_H8 + (size_t)T * D <= WS_XB, "ws map weights");

constexpr int LDS_BYTES = 147456, RING_BYTES = 131072, MISC_OFF = RING_BYTES + 320;

struct Args { const float* in[32]; float* out; unsigned char* ws; int ph_lo, ph_hi; };
#define CAS __attribute__((address_space(4)))
struct Ctx {
    LAS unsigned char* lds; unsigned char* ws; float* out; const float* const CAS* in;
    int tid, lane, wave, G, bid;
};
__device__ __forceinline__ const CAS Args* ka_ptr() { const CAS Args* p = (const CAS Args*)__builtin_amdgcn_kernarg_segment_ptr(); asm volatile("" : "+s"(p)); return p; }
extern __shared__ __attribute__((aligned(16))) unsigned char lds_raw[];
__device__ __forceinline__ Ctx make_ctx(int wv) {
    const CAS Args* ka = ka_ptr();
    Ctx C; C.lds = (LAS unsigned char*)lds_raw; C.ws = ka->ws; C.out = ka->out; C.in = ka->in;
    int g_ = gridDim.x, b_ = blockIdx.x, w_ = wv; asm volatile("" : "+s"(g_), "+s"(b_), "+s"(w_));
    int ln_; asm volatile("v_mbcnt_lo_u32_b32 %0, -1, 0\n\tv_mbcnt_hi_u32_b32 %0, -1, %0" : "=v"(ln_));
    C.lane = ln_; C.wave = w_; C.tid = w_ * 64 + ln_; C.G = g_; C.bid = b_;
    return C;
}
enum { I_X = 0, I_NORM_MIX, I_W_IN, I_RW_MU, I_RW_W0, I_RW_W2, I_RW_A0, I_RW_A2, I_RW_G2, I_RW_KK, I_RW_KA, I_RW_RK, I_RW_LNW, I_RW_LNB, I_SB_QN, I_SB_KN, I_RET_GN,
       I_CONV_DW, I_CONV_B, I_CONV_LNW, I_CONV_LNB, I_W_GATE, I_W_BRANCH, I_W_OUT, I_NORM_FFN, I_FFN_W1, I_FFN_W3, I_FFN_W2, I_ROUTER, I_MOE_W1, I_MOE_W3, I_MOE_W2 };

__device__ __forceinline__ int q_next(const Ctx& C, unsigned* head) {
    LAS int* slot = (LAS int*)(C.lds + MISC_OFF + 64);
    __syncthreads();
    if (C.tid == 0) *slot = (int)__hip_atomic_fetch_add(head, 1u, __ATOMIC_RELAXED, __HIP_MEMORY_SCOPE_AGENT);
    __syncthreads();
    return *slot;
}
__device__ __forceinline__ void ph_prologue_(const Ctx& C) {
    const size_t gid = (size_t)C.bid * NTHR + C.tid, gsz = (size_t)C.G * NTHR;
    float* cs = (float*)(C.ws + WS_COS); float* sn = (float*)(C.ws + WS_SIN);
    for (size_t i = gid; i < (size_t)SEQ * 32; i += gsz) {
        const int pos = (int)(i >> 5), j = (int)(i & 31);
        const float inv = (float)pow(10000.0, -(double)(2 * j) / 64.0);
        const float ang = (float)pos * inv;
        cs[i] = (float)cos((double)ang); sn[i] = (float)sin((double)ang);
    }
}

__device__ __forceinline__ int dest_row(int mode, int roff, int which, int n) {
    if (mode == 0) return roff + n;
    if (mode == 1) { const int pn = n >> 6, oc = n & 63; return 256 * pn + 128 * (roff >> 1) + 32 * (oc >> 4) + 8 * ((oc >> 2) & 3) + 4 * (roff & 1) + (oc & 3); }
    if (mode == 3) {
        if (n < 2816) return n;
        const int j = n - 2816, isb = j >> 8, jl = j & 127, t = (j >> 7) & 1;
        return 2816 + 256 * t + 64 * (jl >> 5) + 16 * ((jl >> 3) & 3) + 8 * isb + (jl & 7); }
    return roff + 256 * (n >> 7) + 128 * which + (n & 127);
}
__device__ __forceinline__ void xpose_item(const float* W, int K, int N, bf16* WT, int mode, int roff, int which, LAS float* scr, int item, int lane) {
    const int nblk = N / 32, kb = item / nblk, nb = item % nblk, k0 = 64 * kb, n0 = 32 * nb;
#pragma unroll
    for (int i = 0; i < 8; ++i) { const int kk = (lane >> 3) + 8 * i, c4 = (lane & 7) * 4; const f32x4 v = *(const f32x4*)(W + (size_t)(k0 + kk) * N + n0 + c4);
        scr[kk * 33 + c4] = v.x; scr[kk * 33 + c4 + 1] = v.y; scr[kk * 33 + c4 + 2] = v.z; scr[kk * 33 + c4 + 3] = v.w; }
    asm volatile("s_waitcnt lgkmcnt(0)" ::: "memory");
    const int c = lane & 7;
#pragma unroll
    for (int j = 0; j < 4; ++j) { const int n = (lane >> 3) + 8 * j; const LAS float* s = scr + (8 * c) * 33 + n;
        u32x4 o; o.x = cvt_pk_bf16(s[0 * 33], s[1 * 33]); o.y = cvt_pk_bf16(s[2 * 33], s[3 * 33]); o.z = cvt_pk_bf16(s[4 * 33], s[5 * 33]); o.w = cvt_pk_bf16(s[6 * 33], s[7 * 33]);
        *(u32x4*)(WT + (size_t)dest_row(mode, roff, which, n0 + n) * K + k0 + 8 * c) = o; }
    asm volatile("s_waitcnt lgkmcnt(0)" ::: "memory");
}
__device__ __forceinline__ void xpose_item8(const float* W, int K, int N, unsigned char* WT, int mode, int roff, int which, LAS float* scr, int item, int lane, int ldk = 0) {
    if (ldk == 0) ldk = K;
    const int nblk = N / 32, kb = item / nblk, nb = item % nblk, k0 = 64 * kb, n0 = 32 * nb;
#pragma unroll
    for (int i = 0; i < 8; ++i) { const int kk = (lane >> 3) + 8 * i, c4 = (lane & 7) * 4; const f32x4 v = *(const f32x4*)(W + (size_t)(k0 + kk) * N + n0 + c4);
        scr[kk * 33 + c4] = v.x; scr[kk * 33 + c4 + 1] = v.y; scr[kk * 33 + c4 + 2] = v.z; scr[kk * 33 + c4 + 3] = v.w; }
    asm volatile("s_waitcnt lgkmcnt(0)" ::: "memory");
    const int c = lane & 3;
#pragma unroll
    for (int j = 0; j < 2; ++j) { const int n = (lane >> 2) + 16 * j; const LAS float* sp = scr + (16 * c) * 33 + n;
        u32x4 o;
        o.x = pk4_fp8(sp[0 * 33] * F8_MUL_W, sp[1 * 33] * F8_MUL_W, sp[2 * 33] * F8_MUL_W, sp[3 * 33] * F8_MUL_W);
        o.y = pk4_fp8(sp[4 * 33] * F8_MUL_W, sp[5 * 33] * F8_MUL_W, sp[6 * 33] * F8_MUL_W, sp[7 * 33] * F8_MUL_W);
        o.z = pk4_fp8(sp[8 * 33] * F8_MUL_W, sp[9 * 33] * F8_MUL_W, sp[10 * 33] * F8_MUL_W, sp[11 * 33] * F8_MUL_W);
        o.w = pk4_fp8(sp[12 * 33] * F8_MUL_W, sp[13 * 33] * F8_MUL_W, sp[14 * 33] * F8_MUL_W, sp[15 * 33] * F8_MUL_W);
        *(u32x4*)(WT + (size_t)dest_row(mode, roff, which, n0 + n) * ldk + k0 + 16 * c) = o; }
    asm volatile("s_waitcnt lgkmcnt(0)" ::: "memory");
}
__device__ __forceinline__ void ph_weights_(const Ctx& C, int l, int part, int first_wg, int nwg, unsigned* qhead = nullptr) {
    LAS float* scr = (LAS float*)(C.lds + C.wave * 16384);
    const int gw = (C.bid - first_wg) * NWAVES + C.wave, NGW = nwg * NWAVES, lane = C.lane;
    unsigned char* ws = C.ws;
    const bool moe = (l & 1);
    const int l2 = l >> 1;
    constexpr int IT_IN = (D / 64) * (NIN / 32), IT_B = (256 / 64) * (D / 32), IT_G = (D / 64) * (D / 32), IT_O = IT_G;
    constexpr int IT_F1 = (D / 64) * (DFF / 32), IT_F2 = (DFF / 64) * (D / 32), IT_M1 = (D / 64) * (DFE / 32), IT_M2 = (DFE / 64) * (D / 32);
    const int n_fixed = IT_IN + 4 * IT_B + 4 * IT_G + IT_O;
    if (part == 1) {
        if (C.bid < first_wg) return;
        const int n1 = moe ? NEXP * IT_M2 : (2 * IT_F1 + IT_F2);
        for (int it = qhead ? q_next(C, qhead) * NWAVES + C.wave : gw; qhead ? (it - C.wave < n1) : (it < n1); it = qhead ? q_next(C, qhead) * NWAVES + C.wave : it + NGW) {
            if (it >= n1) continue;
            int r = it;
            if (!moe) {
                if (r < IT_F1) { xpose_item8(C.in[I_FFN_W1] + (size_t)l2 * D * DFF, D, DFF, ws + WS_W13, 2, 0, 0, scr, r, lane); continue; } r -= IT_F1;
                if (r < IT_F1) { xpose_item8(C.in[I_FFN_W3] + (size_t)l2 * D * DFF, D, DFF, ws + WS_W13, 2, 0, 1, scr, r, lane); continue; } r -= IT_F1;
                xpose_item8(C.in[I_FFN_W2] + (size_t)l2 * DFF * D, DFF, D, ws + WS_W2D, 0, 0, 0, scr, r, lane);
            } else { const int e = r / IT_M2; r -= e * IT_M2;
                xpose_item8(C.in[I_MOE_W2] + ((size_t)l2 * NEXP + e) * DFE * D, DFE, D, ws + WS_W2M, 0, e * D, 0, scr, r, lane, DFE_PAD); }
        }
        if (moe) {
            for (int i = (C.bid - first_wg) * NTHR + C.tid; i < NEXP * D * ((DFE_PAD - DFE) / 16); i += nwg * NTHR) { const int row = i >> 3, c16 = i & 7;
                unsigned z0; asm volatile("v_mov_b32 %0, 0" : "=v"(z0)); *(u32x4*)(ws + WS_W2M + (size_t)row * DFE_PAD + DFE + 16 * c16) = (u32x4){z0, z0, z0, z0}; } }
        return;
    }
    const int n_ffn = moe ? (NEXP * 2 * IT_M1) : 0;
    for (int it = gw; it < n_fixed + n_ffn; it += NGW) {
        int r = it;
        if (r < IT_IN) { xpose_item(C.in[I_W_IN] + (size_t)l * D * NIN, D, NIN, (bf16*)(ws + WS_WIN), 3, 0, 0, scr, r, lane); continue; } r -= IT_IN;
        if (r < 4 * IT_B) { const int i = r / IT_B; xpose_item(C.in[I_W_BRANCH] + ((size_t)l * 4 + i) * 256 * D, 256, D, (bf16*)(ws + WS_WB), 0, 1024 * i, 0, scr, r % IT_B, lane); continue; } r -= 4 * IT_B;
        if (r < 4 * IT_G) { const int i = r / IT_G; xpose_item8(C.in[I_W_GATE] + ((size_t)l * 4 + i) * D * D, D, D, ws + WS_WG, 1, i, 0, scr, r % IT_G, lane); continue; } r -= 4 * IT_G;
        if (r < IT_O) { xpose_item(C.in[I_W_OUT] + (size_t)l * D * D, D, D, (bf16*)(ws + WS_WOUT), 0, 0, 0, scr, r, lane); continue; } r -= IT_O;
        { const int per = 2 * IT_M1, e = r / per; r -= e * per;
          if (r < IT_M1) { xpose_item8(C.in[I_MOE_W1] + ((size_t)l2 * NEXP + e) * D * DFE, D, DFE, ws + WS_W13, 2, e * 2 * DFE, 0, scr, r, lane); continue; } r -= IT_M1;
          xpose_item8(C.in[I_MOE_W3] + ((size_t)l2 * NEXP + e) * D * DFE, D, DFE, ws + WS_W13, 2, e * 2 * DFE, 1, scr, r, lane); }
    }
    bf16* WL = (bf16*)(ws + WS_WLORA);
    const float* w2 = C.in[I_RW_W2] + (size_t)l * 64 * 256; const float* a2 = C.in[I_RW_A2] + (size_t)l * 64 * 256; const float* g2 = C.in[I_RW_G2] + (size_t)l * 128 * 256;
    for (int i = C.bid * NTHR + C.tid; i < 768 * 256; i += C.G * NTHR) {
        const int n = i >> 8, k = i & 255; float v = 0.f;
        if (n < 256) { if (k < 64) v = w2[k * 256 + n]; }
        else if (n < 512) { if (k >= 64 && k < 128) v = a2[(k - 64) * 256 + (n - 256)]; }
        else { if (k >= 128) v = g2[(k - 128) * 256 + (n - 512)]; }
        WL[i] = f2bf(v);
    }
}

__device__ __forceinline__ void ph_norm_(const Ctx& C, const float* gain, bool route, const float* router, int moe_idx, bool combine = false, const float* src = nullptr, bool want_bf16 = true) {
    const int gw = C.bid * NWAVES + C.wave, NGW = C.G * NWAVES, lane = C.lane;
    bf16* H = (bf16*)C.out; bf16* XB = (bf16*)(C.ws + WS_XB);
    f32x4 g[4];
#pragma unroll
    for (int j = 0; j < 4; ++j) g[j] = *(const f32x4*)(gain + 8 * lane + 512 * (j >> 1) + 4 * (j & 1));
    LAS unsigned* lcnt = (LAS unsigned*)(C.lds);
    if (route) { if (C.tid < 8) lcnt[C.tid] = 0u; __syncthreads(); }
    int* eidx = (int*)(C.ws + WS_EIDX); float* gate = (float*)(C.ws + WS_GATE);
    constexpr int NR = 4;
    for (int mb = gw; mb < T; mb += NR * NGW) {
        f32x4 vv[NR][4]; u32x4 ya[NR][2], yb[NR][2]; float g0v[NR], g1v[NR];
#pragma unroll
        for (int r = 0; r < NR; ++r) { const int m = mb + r * NGW; if (m < T) {
            if (src) { const f32x4* xr = (const f32x4*)(src + (size_t)m * D + 8 * lane);
#pragma unroll
                for (int j = 0; j < 4; ++j) vv[r][j] = xr[128 * (j >> 1) + (j & 1)]; }
            else { const u32x4* xb = (const u32x4*)(XB + (size_t)m * D) + lane;
#pragma unroll
                for (int j = 0; j < 2; ++j) { const u32x4 t = xb[64 * j]; vv[r][2 * j] = f32x4{bflo(t.x), bfhi(t.x), bflo(t.y), bfhi(t.y)}; vv[r][2 * j + 1] = f32x4{bflo(t.z), bfhi(t.z), bflo(t.w), bfhi(t.w)}; } }
            if (combine) { const int* slotof = (const int*)(C.ws + WS_SLOTOF); const float* gt = (const float*)(C.ws + WS_GATE); const bf16* YS = (const bf16*)(C.ws + WS_YS);
                const int s0 = slotof[2 * m], s1 = slotof[2 * m + 1]; g0v[r] = gt[2 * m]; g1v[r] = gt[2 * m + 1];
                const u32x4* y0 = (const u32x4*)(YS + (size_t)s0 * D) + lane; const u32x4* y1 = (const u32x4*)(YS + (size_t)s1 * D) + lane;
#pragma unroll
                for (int j = 0; j < 2; ++j) { ya[r][j] = y0[64 * j]; yb[r][j] = y1[64 * j]; } } } }
#pragma unroll
        for (int r = 0; r < NR; ++r) { const int m = mb + r * NGW; if (m < T) {
        f32x4 v[4]; float s = 0.f;
#pragma unroll
        for (int j = 0; j < 4; ++j) v[j] = vv[r][j];
        if (combine) {
            const float g0 = g0v[r], g1 = g1v[r];
#pragma unroll
            for (int j = 0; j < 2; ++j) { const u32x4 a = ya[r][j], b = yb[r][j];
                v[2 * j].x += g0 * bflo(a.x) + g1 * bflo(b.x); v[2 * j].y += g0 * bfhi(a.x) + g1 * bfhi(b.x); v[2 * j].z += g0 * bflo(a.y) + g1 * bflo(b.y); v[2 * j].w += g0 * bfhi(a.y) + g1 * bfhi(b.y);
                v[2 * j + 1].x += g0 * bflo(a.z) + g1 * bflo(b.z); v[2 * j + 1].y += g0 * bfhi(a.z) + g1 * bfhi(b.z); v[2 * j + 1].z += g0 * bflo(a.w) + g1 * bflo(b.w); v[2 * j + 1].w += g0 * bfhi(a.w) + g1 * bfhi(b.w); }
        }
        if (combine || src) { u32x4* xo = (u32x4*)(XB + (size_t)m * D) + lane;
#pragma unroll
            for (int j = 0; j < 2; ++j) { u32x4 t; t.x = cvt_pk_bf16(v[2 * j].x, v[2 * j].y); t.y = cvt_pk_bf16(v[2 * j].z, v[2 * j].w); t.z = cvt_pk_bf16(v[2 * j + 1].x, v[2 * j + 1].y); t.w = cvt_pk_bf16(v[2 * j + 1].z, v[2 * j + 1].w); xo[64 * j] = t; } }
#pragma unroll
        for (int j = 0; j < 4; ++j) s += (v[j].x * v[j].x + v[j].y * v[j].y) + (v[j].z * v[j].z + v[j].w * v[j].w);
        const float rs = 1.0f / sqrtf(wave_sum(s, C.lane) * (1.f / D) + 1e-6f);
#pragma unroll
        for (int j = 0; j < 4; ++j) v[j] = v[j] * rs * g[j];
#pragma unroll
        for (int j = 0; j < 2; ++j) {
            if (want_bf16) { u32x4 t; t.x = cvt_pk_bf16(v[2 * j].x, v[2 * j].y); t.y = cvt_pk_bf16(v[2 * j].z, v[2 * j].w); t.z = cvt_pk_bf16(v[2 * j + 1].x, v[2 * j + 1].y); t.w = cvt_pk_bf16(v[2 * j + 1].z, v[2 * j + 1].w);
                ((u32x4*)(H + (size_t)m * D) + lane)[64 * j] = t; }
            u32x2 q; q.x = pk4_fp8(v[2 * j].x * F8_MUL_X, v[2 * j].y * F8_MUL_X, v[2 * j].z * F8_MUL_X, v[2 * j].w * F8_MUL_X); q.y = pk4_fp8(v[2 * j + 1].x * F8_MUL_X, v[2 * j + 1].y * F8_MUL_X, v[2 * j + 1].z * F8_MUL_X, v[2 * j + 1].w * F8_MUL_X);
            ((u32x2*)(C.ws + WS_H8 + (size_t)m * D) + lane)[64 * j] = q; }
        if (route) {
            float lg[8];
#pragma unroll
            for (int e = 0; e < 8; ++e) lg[e] = 0.f;
#pragma unroll
            for (int j = 0; j < 4; ++j)
#pragma unroll
                for (int q = 0; q < 4; ++q) { const int k = 8 * lane + 512 * (j >> 1) + 4 * (j & 1) + q; const f32x4 r0 = *(const f32x4*)(router + (size_t)k * 8), r1 = *(const f32x4*)(router + (size_t)k * 8 + 4); const float hv = v[j][q];
                    lg[0] += hv * r0.x; lg[1] += hv * r0.y; lg[2] += hv * r0.z; lg[3] += hv * r0.w; lg[4] += hv * r1.x; lg[5] += hv * r1.y; lg[6] += hv * r1.z; lg[7] += hv * r1.w; }
#pragma unroll
            for (int e = 0; e < 8; ++e) lg[e] = wave_sum(lg[e], C.lane);
            int e0 = 0; float b0 = lg[0];
#pragma unroll
            for (int e = 1; e < 8; ++e) if (lg[e] > b0) { b0 = lg[e]; e0 = e; }
            int e1 = -1; float b1 = -3.0e38f;
#pragma unroll
            for (int e = 0; e < 8; ++e) if (e != e0 && lg[e] > b1) { b1 = lg[e]; e1 = e; }
            const float p1 = __expf(b1 - b0), inv = 1.f / (1.f + p1);
            if (lane == 0) { eidx[2 * m] = e0; eidx[2 * m + 1] = e1; gate[2 * m] = inv; gate[2 * m + 1] = p1 * inv; atomicAdd((unsigned*)&lcnt[e0], 1u); atomicAdd((unsigned*)&lcnt[e1], 1u); }
        }
        } }
    }
    if (route) { __syncthreads(); if (C.tid < 8) { unsigned* cw = (unsigned*)(C.ws + WS_CTL) + CW_MOE + moe_idx * 64; atomicAdd(&cw[C.tid], lcnt[C.tid]); } }
}

__device__ __forceinline__ void ph_rw_prep_(const Ctx& C, int l) {
    const bf16* RW = (const bf16*)(C.ws + WS_RW); bf16* AL = (bf16*)(C.ws + WS_ALORA);
    const float* mu = C.in[I_RW_MU] + (size_t)l * 1024;
    const size_t gid = (size_t)C.bid * NTHR + C.tid, gsz = (size_t)C.G * NTHR;
    constexpr int NI = 4;
    for (size_t it0 = gid; it0 < (size_t)T * 32; it0 += NI * gsz) {
        u32x4 cuv[NI], pvv[NI]; f32x4 mu0[NI], mu1[NI];
#pragma unroll
        for (int r = 0; r < NI; ++r) { const size_t it = it0 + r * gsz; cuv[r] = (u32x4){0u, 0u, 0u, 0u}; pvv[r] = cuv[r]; mu0[r] = (f32x4){0.f, 0.f, 0.f, 0.f}; mu1[r] = mu0[r];
            if (it < (size_t)T * 32) { const int m = (int)(it >> 5), c8 = 768 + (int)(it & 31) * 8, t = m & (SEQ - 1);
                cuv[r] = *(const u32x4*)(RW + (size_t)m * 1024 + c8); if (t) pvv[r] = *(const u32x4*)(RW + (size_t)(m - 1) * 1024 + c8); mu0[r] = *(const f32x4*)(mu + c8); mu1[r] = *(const f32x4*)(mu + c8 + 4); } }
#pragma unroll
        for (int r = 0; r < NI; ++r) { const size_t it = it0 + r * gsz; if (it < (size_t)T * 32) {
        const int m = (int)(it >> 5), c8 = 768 + (int)(it & 31) * 8;
        float a[8], b[8]; unpack8(cuv[r], a); unpack8(pvv[r], b);
        const f32x4 m0 = mu0[r], m1 = mu1[r];
        const float mm[8] = {m0.x, m0.y, m0.z, m0.w, m1.x, m1.y, m1.z, m1.w};
#pragma unroll
        for (int e = 0; e < 8; ++e) a[e] = a[e] + (b[e] - a[e]) * mm[e];
        if (c8 < 832) {
#pragma unroll
            for (int e = 0; e < 8; ++e) a[e] = 1.f - 2.f * __builtin_amdgcn_rcpf(1.f + __builtin_amdgcn_exp2f(2.f * LOG2E * a[e]));
        } else if (c8 >= 896) {
#pragma unroll
            for (int e = 0; e < 8; ++e) a[e] = sigm(a[e]);
        }
        *(u32x4*)(AL + (size_t)m * 256 + (c8 - 768)) = pack8(a);
        } }
    }
}

__device__ __forceinline__ void ph_sb_prep_(const Ctx& C, int l) {
    bf16* SB = (bf16*)(C.ws + WS_SB);
    const int gw = C.bid * NWAVES + C.wave, NGW = C.G * NWAVES, lane = C.lane;
    const bool isk = lane >= 32; const int d0 = (lane & 7) * 8;
    const float* gn = (isk ? C.in[I_SB_KN] : C.in[I_SB_QN]) + (size_t)l * 64 + d0;
    float gg[8];
#pragma unroll
    for (int e = 0; e < 8; ++e) gg[e] = gn[e] * (isk ? 1.f : 0.125f * LOG2E);
    constexpr int NR = 4;
    for (int mb = gw; mb < T; mb += NR * NGW) {
        u32x4 uu[NR];
#pragma unroll
        for (int r = 0; r < NR; ++r) { const int m = mb + r * NGW; uu[r] = (u32x4){0u, 0u, 0u, 0u}; if (m < T) uu[r] = *(const u32x4*)(SB + (size_t)m * 768 + lane * 8); }
#pragma unroll
        for (int r = 0; r < NR; ++r) { const int m = mb + r * NGW; if (m < T) {
            bf16* p = SB + (size_t)m * 768 + lane * 8;
            float a[8]; unpack8(uu[r], a);
            float ss = 0.f;
#pragma unroll
            for (int e = 0; e < 8; ++e) ss += a[e] * a[e];
            ss += shx(ss, 1, lane); ss += shx(ss, 2, lane); ss += shx(ss, 4, lane);
            const float rs = 1.0f / sqrtf(ss * (1.f / 64.f) + 1e-6f);
#pragma unroll
            for (int e = 0; e < 8; ++e) a[e] = a[e] * rs * gg[e];
            *(u32x4*)p = pack8(a); } }
    }
}

__device__ __forceinline__ void ph_conv_(const Ctx& C, int l) {
    const bf16* CV = (const bf16*)(C.ws + WS_CV); bf16* Y = (bf16*)(C.ws + WS_Y);
    LAS float* U = (LAS float*)(C.lds); LAS float* OC = (LAS float*)(C.lds + 65536);
    const int tid = C.tid, c = tid & 255, half = tid >> 8;
    const float* dw = C.in[I_CONV_DW] + (size_t)l * 31 * 256; const float db = C.in[I_CONV_B][l * 256 + c];
    float dwr[31];
#pragma unroll
    for (int j = 0; j < 31; ++j) dwr[j] = dw[j * 256 + c];
    const float* lnw = C.in[I_CONV_LNW] + (size_t)l * 256; const float* lnb = C.in[I_CONV_LNB] + (size_t)l * 256;
    for (int u = C.bid; u < T / 32; u += C.G) {
        const int m0 = u * 32, t0 = m0 & (SEQ - 1);
        for (int it = tid; it < 62 * 32; it += NTHR) {
            const int r = it >> 5, c8 = (it & 31) * 8, tt = t0 - 30 + r; float a[8], b[8];
            if (tt >= 0) { const size_t mm = (size_t)(m0 - 30 + r); unpack8(*(const u32x4*)(CV + mm * 256 + c8), a); (void)b; }
            else {
#pragma unroll
                for (int e = 0; e < 8; ++e) a[e] = 0.f; }
#pragma unroll
            for (int e = 0; e < 8; ++e) U[r * 256 + c8 + e] = a[e];
        }
        __syncthreads();
        { float win[46];
#pragma unroll
          for (int i = 0; i < 46; ++i) win[i] = U[(half * 16 + i) * 256 + c];
#pragma unroll
          for (int tt = 0; tt < 16; ++tt) { float acc = db;
#pragma unroll
              for (int j = 0; j < 31; ++j) acc += dwr[j] * win[tt + j];
              OC[(half * 16 + tt) * 256 + c] = acc; } }
        __syncthreads();
#pragma unroll 1
        for (int q = 0; q < 4; ++q) { const int tl = C.wave * 4 + q; float v[4]; float s = 0.f;
#pragma unroll
            for (int i = 0; i < 4; ++i) { v[i] = OC[tl * 256 + C.lane + 64 * i]; s += v[i]; }
            const float mean = wave_sum(s, C.lane) * (1.f / 256.f); float s2 = 0.f;
#pragma unroll
            for (int i = 0; i < 4; ++i) { v[i] -= mean; s2 += v[i] * v[i]; }
            const float rstd = 1.0f / sqrtf(wave_sum(s2, C.lane) * (1.f / 256.f) + 1e-5f);
#pragma unroll
            for (int i = 0; i < 4; ++i) { const int cc = C.lane + 64 * i; const float y = v[i] * rstd * lnw[cc] + lnb[cc]; Y[(size_t)(m0 + tl) * 1024 + 768 + cc] = f2bf(y * sigm(y)); } }
        __syncthreads();
    }
}

__device__ __forceinline__ float ret_log2gamma(int h) { return log2f(1.0f - exp2f(-5.0f - (float)h)); }
__device__ __forceinline__ void ret_load_rot(const Ctx& C, const bf16* RET, int m0, int coff, float scale, LAS float* dst) {
    const int s = C.tid >> 3, d0 = (C.tid & 7) * 4;
    const float* cs = (const float*)(C.ws + WS_COS); const float* sn = (const float*)(C.ws + WS_SIN);
    const int pos = (m0 + s) & (SEQ - 1);
    const u32x2 a = *(const u32x2*)(RET + (size_t)(m0 + s) * 1024 + coff + d0), b = *(const u32x2*)(RET + (size_t)(m0 + s) * 1024 + coff + 32 + d0);
    const float x1[4] = {bflo(a.x), bfhi(a.x), bflo(a.y), bfhi(a.y)}, x2[4] = {bflo(b.x), bfhi(b.x), bflo(b.y), bfhi(b.y)};
    const f32x4 cv = *(const f32x4*)(cs + (size_t)pos * 32 + d0), sv = *(const f32x4*)(sn + (size_t)pos * 32 + d0);
#pragma unroll
    for (int e = 0; e < 4; ++e) { dst[s * 65 + d0 + e] = (x1[e] * cv[e] - x2[e] * sv[e]) * scale; dst[s * 65 + 32 + d0 + e] = (x1[e] * sv[e] + x2[e] * cv[e]) * scale; }
}
__device__ __forceinline__ void ph_ret_kv_(const Ctx& C) {
    const bf16* RET = (const bf16*)(C.ws + WS_RET); float* KV = (float*)(C.ws + WS_KV);
    LAS float* KD = (LAS float*)(C.lds); LAS float* VV = (LAS float*)(C.lds + 32768);
    const int tid = C.tid;
    for (int u = C.bid; u < 2048; u += C.G) {
        const int bh = u >> 8, ch = u & 255, b = bh >> 2, h = bh & 3, m0 = b * SEQ + ch * 64;
        const float lg = ret_log2gamma(h);
        ret_load_rot(C, RET, m0, 256 + h * 64, 0.125f, KD);
        { const int s = tid >> 3, e0 = (tid & 7) * 8; float a[8]; unpack8(*(const u32x4*)(RET + (size_t)(m0 + s) * 1024 + 512 + h * 64 + e0), a);
          const float dec = exp2f(lg * (float)(63 - s));
#pragma unroll
          for (int e = 0; e < 8; ++e) VV[s * 64 + e0 + e] = a[e] * dec; }
        __syncthreads();
        const int d = tid >> 3, e0 = (tid & 7) * 8; float acc[8];
#pragma unroll
        for (int e = 0; e < 8; ++e) acc[e] = 0.f;
#pragma unroll 4
        for (int s = 0; s < 64; ++s) { const float kd = KD[s * 65 + d]; const f32x4 v0 = *(const LAS f32x4*)(VV + s * 64 + e0), v1 = *(const LAS f32x4*)(VV + s * 64 + e0 + 4);
            acc[0] += kd * v0.x; acc[1] += kd * v0.y; acc[2] += kd * v0.z; acc[3] += kd * v0.w; acc[4] += kd * v1.x; acc[5] += kd * v1.y; acc[6] += kd * v1.z; acc[7] += kd * v1.w; }
        float* o = KV + (size_t)u * 4096 + d * 64 + e0;
        *(f32x4*)o = (f32x4){acc[0], acc[1], acc[2], acc[3]}; *(f32x4*)(o + 4) = (f32x4){acc[4], acc[5], acc[6], acc[7]};
        __syncthreads();
    }
}
__device__ __forceinline__ void ph_ret_scan_(const Ctx& C) {
    float* KV = (float*)(C.ws + WS_KV);
    const int wg0 = (C.G >= 256) ? 128 : 0, nw = C.G - wg0;
    for (int i = (C.bid - wg0) * NTHR + C.tid; i < 8 * 4096 && C.bid >= wg0; i += nw * NTHR) {
        const int bh = i >> 12, el = i & 4095, h = bh & 3;
        const float cd = exp2f(ret_log2gamma(h) * 64.f);
        float* p = KV + (size_t)bh * 256 * 4096 + el; float S = 0.f;
#pragma unroll 1
        for (int c = 0; c < 256; c += 32) { float kv[32];
#pragma unroll
            for (int q = 0; q < 32; ++q) kv[q] = p[(size_t)(c + q) * 4096];
#pragma unroll
            for (int q = 0; q < 32; ++q) { p[(size_t)(c + q) * 4096] = S; S = S * cd + kv[q]; } }
    }
}
__device__ __forceinline__ void ph_ret_out_(const Ctx& C, int l, int first_wg, int nwg) {
    const bf16* RET = (const bf16*)(C.ws + WS_RET); const float* KV = (const float*)(C.ws + WS_KV); bf16* Y = (bf16*)(C.ws + WS_Y);
    LAS float* Q = (LAS float*)(C.lds); LAS float* Kk = (LAS float*)(C.lds + 16640); LAS float* VV = (LAS float*)(C.lds + 33280); LAS float* SS = (LAS float*)(C.lds + 49664); LAS float* SC = (LAS float*)(C.lds + 66048);
    const int tid = C.tid; const float* gn = C.in[I_RET_GN] + (size_t)l * 256;
    for (int u = C.bid - first_wg; u < 2048; u += nwg) {
        const int bh = u >> 8, ch = u & 255, b = bh >> 2, h = bh & 3, m0 = b * SEQ + ch * 64;
        const float lg = ret_log2gamma(h);
        ret_load_rot(C, RET, m0, h * 64, 1.0f, Q);
        ret_load_rot(C, RET, m0, 256 + h * 64, 0.125f, Kk);
        { const int s = tid >> 3, e0 = (tid & 7) * 8; float a[8]; unpack8(*(const u32x4*)(RET + (size_t)(m0 + s) * 1024 + 512 + h * 64 + e0), a);
#pragma unroll
          for (int e = 0; e < 8; ++e) VV[s * 64 + e0 + e] = a[e];
          const float* sp = KV + (size_t)u * 4096 + s * 64 + e0; const f32x4 s0 = *(const f32x4*)sp, s1 = *(const f32x4*)(sp + 4);
          *(LAS f32x4*)(SS + s * 64 + e0) = s0; *(LAS f32x4*)(SS + s * 64 + e0 + 4) = s1; }
        __syncthreads();
        const int t = tid >> 3, g8 = tid & 7;
        { float sc[8];
#pragma unroll
          for (int i = 0; i < 8; ++i) sc[i] = 0.f;
#pragma unroll 4
          for (int d = 0; d < 64; ++d) { const float qv = Q[t * 65 + d];
#pragma unroll
              for (int i = 0; i < 8; ++i) sc[i] += qv * Kk[(g8 * 8 + i) * 65 + d]; }
#pragma unroll
          for (int i = 0; i < 8; ++i) { const int s = g8 * 8 + i; SC[t * 65 + s] = (s <= t) ? sc[i] * exp2f(lg * (float)(t - s)) : 0.f; } }
        __syncthreads();
        { const int e0 = g8 * 8; float o[8], o2[8];
#pragma unroll
          for (int e = 0; e < 8; ++e) { o[e] = 0.f; o2[e] = 0.f; }
#pragma unroll 4
          for (int s = 0; s < 64; ++s) { const float p = SC[t * 65 + s]; const f32x4 v0 = *(const LAS f32x4*)(VV + s * 64 + e0), v1 = *(const LAS f32x4*)(VV + s * 64 + e0 + 4);
              o[0] += p * v0.x; o[1] += p * v0.y; o[2] += p * v0.z; o[3] += p * v0.w; o[4] += p * v1.x; o[5] += p * v1.y; o[6] += p * v1.z; o[7] += p * v1.w; }
#pragma unroll 4
          for (int d = 0; d < 64; ++d) { const float qv = Q[t * 65 + d]; const f32x4 v0 = *(const LAS f32x4*)(SS + d * 64 + e0), v1 = *(const LAS f32x4*)(SS + d * 64 + e0 + 4);
              o2[0] += qv * v0.x; o2[1] += qv * v0.y; o2[2] += qv * v0.z; o2[3] += qv * v0.w; o2[4] += qv * v1.x; o2[5] += qv * v1.y; o2[6] += qv * v1.z; o2[7] += qv * v1.w; }
          const float qd = exp2f(lg * (float)(t + 1)); float s1 = 0.f;
#pragma unroll
          for (int e = 0; e < 8; ++e) { o[e] += qd * o2[e]; s1 += o[e]; }
          s1 += shx(s1, 1, C.lane); s1 += shx(s1, 2, C.lane); s1 += shx(s1, 4, C.lane);
          const float mean = s1 * (1.f / 64.f); float s2 = 0.f;
#pragma unroll
          for (int e = 0; e < 8; ++e) { o[e] -= mean; s2 += o[e] * o[e]; }
          s2 += shx(s2, 1, C.lane); s2 += shx(s2, 2, C.lane); s2 += shx(s2, 4, C.lane);
          const float rstd = 1.0f / sqrtf(s2 * (1.f / 64.f) + 1e-5f);
          float gtv[8]; unpack8(*(const u32x4*)(RET + (size_t)(m0 + t) * 1024 + 768 + h * 64 + e0), gtv);
#pragma unroll
          for (int e = 0; e < 8; ++e) o[e] = o[e] * rstd * gn[h * 64 + e0 + e] * (gtv[e] * sigm(gtv[e]));
          *(u32x4*)(Y + (size_t)(m0 + t) * 1024 + 512 + h * 64 + e0) = pack8(o); }
        __syncthreads();
    }
}

constexpr int RWC = 64, RW_NCH = SEQ / RWC, RW_NU = 8 * RW_NCH;
constexpr int RW_SUP = 8, RW_NSC = RW_NCH / RW_SUP, RW_NSUP = 8 * RW_NSC;
__device__ __forceinline__ void ph_rw_local_(const Ctx& C, int l) {
    const bf16* RKVS = (const bf16*)(C.ws + WS_RKVS); const float* WDEC = (const float*)(C.ws + WS_WDEC); const bf16* AG = (const bf16*)(C.ws + WS_AG);
    bf16* Y0 = (bf16*)(C.ws + WS_Y0); bf16* RH = (bf16*)(C.ws + WS_RHAT); float* PQ = (float*)(C.ws + WS_PQ); float* BON = (float*)(C.ws + WS_BON);
    const int lane = C.lane;
    LAS float* base = (LAS float*)(C.lds + C.wave * 12288);
    for (int it = C.bid; it < RW_NU / 8; it += C.G) {
        const int u = it * 8 + C.wave, bh = u >> 8, ch = u & 255, b = bh >> 2, h = bh & 3, m0 = b * SEQ + ch * RWC, hc = h * 64 + lane;
        const float mur = C.in[I_RW_MU][l * 1024 + hc], muk = C.in[I_RW_MU][l * 1024 + 256 + hc], muv = C.in[I_RW_MU][l * 1024 + 512 + hc];
        const float kkw = C.in[I_RW_KK][l * 256 + hc], kaw = C.in[I_RW_KA][l * 256 + hc], rkw = C.in[I_RW_RK][l * 256 + hc], w0l = C.in[I_RW_W0][l * 256 + hc], a0l = C.in[I_RW_A0][l * 256 + hc];
        f32x2 sL[32], sI[32];
        { int ln = lane; asm volatile("" : "+v"(ln));
#pragma unroll
          for (int k = 0; k < 32; ++k) { sL[k] = (f32x2){0.f, 0.f}; sI[k].x = (2 * k == ln) ? 1.f : 0.f; sI[k].y = (2 * k + 1 == ln) ? 1.f : 0.f; } }
#pragma unroll 1
        for (int sb = 0; sb < RWC / 8; ++sb) {
            asm volatile("" ::: "memory");
#pragma unroll
            for (int i = 0; i < 8; ++i) { const size_t m = (size_t)(m0 + sb * 8 + i);
                const float r = bf2f(RKVS[m * 768 + hc]), k = bf2f(RKVS[m * 768 + 256 + hc]), v = bf2f(RKVS[m * 768 + 512 + hc]);
                const float w = __builtin_amdgcn_exp2f(-0.606531f * LOG2E * sigm(WDEC[m * 256 + hc] + w0l)), a = sigm(bf2f(AG[m * 512 + hc]) + a0l);
                const float kr = k * kkw; const float nn = sqrtf(wave_sum(kr * kr, C.lane)); const float kk = kr / fmaxf(nn, 1e-12f);
                const float kp = k * (1.f + (a - 1.f) * kaw);
                const float bon = wave_sum(r * kp * rkw, C.lane);
                if (lane == 0) BON[m * 4 + h] = bon;
                base[0 * 512 + i * 64 + lane] = w; base[1 * 512 + i * 64 + lane] = kk; base[2 * 512 + i * 64 + lane] = kk * a; base[3 * 512 + i * 64 + lane] = kp; base[4 * 512 + i * 64 + lane] = r; base[5 * 512 + i * 64 + lane] = v; }
            asm volatile("" ::: "memory");
#pragma unroll 1
            for (int i = 0; i < 8; ++i) {
                const LAS f32x4* wv = (const LAS f32x4*)(base + 0 * 512 + i * 64); const LAS f32x4* kkv = (const LAS f32x4*)(base + 1 * 512 + i * 64); const LAS f32x4* kav = (const LAS f32x4*)(base + 2 * 512 + i * 64);
                const LAS f32x4* kpv = (const LAS f32x4*)(base + 3 * 512 + i * 64); const LAS f32x4* rv = (const LAS f32x4*)(base + 4 * 512 + i * 64);
                const float vv = base[5 * 512 + i * 64 + lane];
                f32x4 kq[2][4];
#pragma unroll
                for (int t = 0; t < 4; ++t) kq[0][t] = kkv[t];
                f32x2 dL0 = (f32x2){0.f, 0.f}, dL1 = dL0, dI0 = dL0, dI1 = dL0;
                f32x4 ga[2][4];
#pragma unroll
                for (int g = 0; g < 4; ++g) {
                    __builtin_amdgcn_sched_barrier(0);
                    if (g + 1 < 4) {
#pragma unroll
                        for (int t = 0; t < 4; ++t) kq[(g + 1) & 1][t] = kkv[4 * (g + 1) + t]; }
                    else { ga[0][0] = wv[0]; ga[0][1] = kav[0]; ga[0][2] = kpv[0]; ga[0][3] = rv[0]; }
                    __builtin_amdgcn_sched_barrier(0);
#pragma unroll
                    for (int t = 0; t < 4; ++t) { const int k4 = 4 * g + t; const f32x4 q4 = kq[g & 1][t];
                        dL0 += sL[2 * k4] * q4.xy; dL1 += sL[2 * k4 + 1] * q4.zw; dI0 += sI[2 * k4] * q4.xy; dI1 += sI[2 * k4 + 1] * q4.zw; }
                }
                const float saL = -((dL0.x + dL0.y) + (dL1.x + dL1.y)), saI = -((dI0.x + dI0.y) + (dI1.x + dI1.y));
                const f32x2 saLv = (f32x2){saL, saL}, saIv = (f32x2){saI, saI}, vvv = (f32x2){vv, vv};
                f32x2 yL0 = (f32x2){0.f, 0.f}, yL1 = yL0, yI0 = yL0, yI1 = yL0;
#pragma unroll
                for (int k4 = 0; k4 < 16; ++k4) {
                    __builtin_amdgcn_sched_barrier(0);
                    if (k4 + 1 < 16) { ga[(k4 + 1) & 1][0] = wv[k4 + 1]; ga[(k4 + 1) & 1][1] = kav[k4 + 1]; ga[(k4 + 1) & 1][2] = kpv[k4 + 1]; ga[(k4 + 1) & 1][3] = rv[k4 + 1]; }
                    __builtin_amdgcn_sched_barrier(0);
                    const f32x4 wq = ga[k4 & 1][0], aq = ga[k4 & 1][1], pq = ga[k4 & 1][2], rq = ga[k4 & 1][3];
                    sL[2 * k4]     = sL[2 * k4]     * wq.xy + saLv * aq.xy + vvv * pq.xy; yL0 += sL[2 * k4]     * rq.xy;
                    sL[2 * k4 + 1] = sL[2 * k4 + 1] * wq.zw + saLv * aq.zw + vvv * pq.zw; yL1 += sL[2 * k4 + 1] * rq.zw;
                    sI[2 * k4]     = sI[2 * k4]     * wq.xy + saIv * aq.xy;                  yI0 += sI[2 * k4]     * rq.xy;
                    sI[2 * k4 + 1] = sI[2 * k4 + 1] * wq.zw + saIv * aq.zw;                  yI1 += sI[2 * k4 + 1] * rq.zw;
                }
                __builtin_amdgcn_sched_barrier(0);
                const size_t m = (size_t)(m0 + sb * 8 + i);
                Y0[m * 256 + hc] = f2bf((yL0.x + yL0.y) + (yL1.x + yL1.y));
                RH[m * 256 + hc] = f2bf((yI0.x + yI0.y) + (yI1.x + yI1.y));
            }
        }
        float* oq = PQ + (size_t)u * 4096 + lane * 64; float* opt = PQ + ((size_t)RW_NU + u) * 4096 + lane;
#pragma unroll
        for (int k4 = 0; k4 < 16; ++k4) { *(f32x4*)(oq + 4 * k4) = (f32x4){sL[2 * k4].x, sL[2 * k4].y, sL[2 * k4 + 1].x, sL[2 * k4 + 1].y};
            opt[(4 * k4) * 64] = sI[2 * k4].x; opt[(4 * k4 + 1) * 64] = sI[2 * k4].y; opt[(4 * k4 + 2) * 64] = sI[2 * k4 + 1].x; opt[(4 * k4 + 3) * 64] = sI[2 * k4 + 1].y; }
    }
}
constexpr int WY_LT = 24;
constexpr int WY_ROWM = 0, WY_COLM = 36864, WY_AMAT = 73728, WY_AABF = 89088, WY_SB = 93184, WY_WT = 111616, WY_UT = 117760, WY_GH = 123904, WY_GC = 125952;
__device__ __forceinline__ f32x4 wy_mm16(const LAS bf16* X, const LAS bf16* Y, f32x4 acc, int li, int lq) {
#pragma unroll
    for (int ks = 0; ks < 2; ++ks) { const bf16x8 a = *(const LAS bf16x8*)(X + li * MM_LP + 32 * ks + 8 * lq), b = *(const LAS bf16x8*)(Y + li * MM_LP + 32 * ks + 8 * lq);
        acc = __builtin_amdgcn_mfma_f32_16x16x32_bf16(a, b, acc, 0, 0, 0); }
    return acc;
}
__device__ __forceinline__ f32x4 wy_mm16k16(const LAS bf16* X, const LAS bf16* Y, f32x4 acc, int li, int lq) {
    const s16x4 a = *(const LAS s16x4*)(X + li * WY_LT + 4 * lq), b = *(const LAS s16x4*)(Y + li * WY_LT + 4 * lq);
    return __builtin_amdgcn_mfma_f32_16x16x16bf16_1k(a, b, acc, 0, 0, 0);
}
__device__ __forceinline__ void ph_rw_local_wy_(const Ctx& C, int l) {
    const bf16* RWp = (const bf16*)(C.ws + WS_RW); const float* WDEC = (const float*)(C.ws + WS_WDEC); const bf16* AG = (const bf16*)(C.ws + WS_AP);
    bf16* Y0 = (bf16*)(C.ws + WS_Y0); bf16* RH = (bf16*)(C.ws + WS_RHAT); float* PQ = (float*)(C.ws + WS_PQ); float* BON = (float*)(C.ws + WS_BON);
    const int lane = C.lane, w = C.wave, li = lane & 15, lq = lane >> 4, j32 = lane & 31, hi = lane >> 5, ti = w >> 1, tj = w & 1, sq = w >> 1, half = w & 1;
    LAS unsigned char* L = C.lds;
#define WY_ROW(q, m) ((LAS bf16*)(L + WY_ROWM + (q) * 9216 + (m) * 2304))
#define WY_COL(q, m) ((LAS bf16*)(L + WY_COLM + (q) * 9216 + (m) * 3072))
#define WY_A(q, id)  ((LAS bf16*)(L + WY_AMAT + (q) * 3840 + (id) * 768))
    LAS bf16* SB = (LAS bf16*)(L + WY_SB); LAS bf16* WT = (LAS bf16*)(L + WY_WT); LAS bf16* UT = (LAS bf16*)(L + WY_UT);
    LAS float* GH = (LAS float*)(L + WY_GH); LAS float* GCs = (LAS float*)(L + WY_GC);
    for (int su = C.bid; su < RW_NSUP; su += C.G) {
    f32x16 S;
    bf16 r16[9], k16[9], v16[9], a16[8]; float wd[8];
#define WY_RAW(uu) do { const int u_ = (uu), bh_ = u_ >> 8, ch_ = u_ & 255; const size_t mb_ = (size_t)((bh_ >> 2) * SEQ + ch_ * RWC + 8 * w); const int hc_ = (bh_ & 3) * 64 + lane; \
        r16[0] = 0; k16[0] = 0; v16[0] = 0; if (ch_ * RWC + 8 * w > 0) { r16[0] = RWp[(mb_ - 1) * 1024 + hc_]; k16[0] = RWp[(mb_ - 1) * 1024 + 256 + hc_]; v16[0] = RWp[(mb_ - 1) * 1024 + 512 + hc_]; } \
        _Pragma("unroll") for (int i = 0; i < 8; ++i) { const size_t m = mb_ + i; \
        r16[i + 1] = RWp[m * 1024 + hc_]; k16[i + 1] = RWp[m * 1024 + 256 + hc_]; v16[i + 1] = RWp[m * 1024 + 512 + hc_]; wd[i] = WDEC[m * 256 + hc_]; a16[i] = AG[m * 256 + hc_]; } } while (0)
    WY_RAW(su * RW_SUP);
#pragma unroll 1
    for (int cc = 0; cc < RW_SUP; ++cc) {
        const int u = su * RW_SUP + cc;
        const int bh = u >> 8, ch = u & 255, b = bh >> 2, h = bh & 3, m0 = b * SEQ + ch * RWC, hc = h * 64 + lane;
        const float mur = C.in[I_RW_MU][l * 1024 + hc], muk = C.in[I_RW_MU][l * 1024 + 256 + hc], muv = C.in[I_RW_MU][l * 1024 + 512 + hc];
        const float kkw = C.in[I_RW_KK][l * 256 + hc], kaw = C.in[I_RW_KA][l * 256 + hc], rkw = C.in[I_RW_RK][l * 256 + hc], w0l = C.in[I_RW_W0][l * 256 + hc], a0l = C.in[I_RW_A0][l * 256 + hc];
        { float wv[8], kk[8], ka[8], kp[8], rr[8], vv[8];
          float bon8[8], rf[8], kf[8], af[8], wf[8];
#pragma unroll
          for (int i = 0; i < 8; ++i) { const float rc = bf2f(r16[i + 1]), kc = bf2f(k16[i + 1]), vc = bf2f(v16[i + 1]);
              rf[i] = rc + (bf2f(r16[i]) - rc) * mur; kf[i] = kc + (bf2f(k16[i]) - kc) * muk; vv[i] = vc + (bf2f(v16[i]) - vc) * muv; af[i] = bf2f(a16[i]); wf[i] = wd[i]; }
          if (cc + 1 < RW_SUP) WY_RAW(u + 1);
#pragma unroll
          for (int i = 0; i < 8; ++i) {
              const float r = rf[i], k = kf[i];
              wv[i] = __builtin_amdgcn_exp2f(-0.606531f * LOG2E * sigm(wf[i] + w0l)); const float a = sigm(af[i] + a0l);
              const float kr = k * kkw; kk[i] = kr * __builtin_amdgcn_rsqf(fmaxf(wave_sum(kr * kr, lane), 1e-24f));
              kp[i] = k * (1.f + (a - 1.f) * kaw); ka[i] = kk[i] * a; rr[i] = r;
              bon8[i] = wave_sum(r * kp[i] * rkw, lane); }
          if (lane == 0) {
#pragma unroll
              for (int i = 0; i < 8; ++i) BON[(size_t)(m0 + 8 * w + i) * 4 + h] = bon8[i]; }
          float cp[8]; cp[0] = wv[0];
#pragma unroll
          for (int i = 1; i < 8; ++i) cp[i] = cp[i - 1] * wv[i];
          GH[w * 64 + lane] = cp[7];
          __syncthreads();
          const float pre = half ? GH[(w - 1) * 64 + lane] : 1.f, gC = half ? pre * cp[7] : cp[7] * GH[(w + 1) * 64 + lane];
          if (!half) GCs[sq * 64 + lane] = gC;
#pragma unroll
          for (int i = 0; i < 8; ++i) { const int t = 8 * half + i; const float G = pre * cp[i], Gm1 = (i == 0) ? pre : pre * cp[i - 1], rG = __builtin_amdgcn_rcpf(G);
              WY_ROW(sq, 0)[t * MM_LP + lane] = f2bf(-kk[i] * Gm1); WY_ROW(sq, 1)[t * MM_LP + lane] = f2bf(ka[i] * rG); WY_ROW(sq, 2)[t * MM_LP + lane] = f2bf(kp[i] * rG); WY_ROW(sq, 3)[t * MM_LP + lane] = f2bf(rr[i] * G);
              WY_COL(sq, 0)[lane * WY_LT + t] = f2bf(ka[i] * rG * gC); WY_COL(sq, 1)[lane * WY_LT + t] = f2bf(kp[i] * rG * gC); WY_COL(sq, 2)[lane * WY_LT + t] = f2bf(vv[i]); } }
        __syncthreads();
#pragma unroll
        for (int pp = 0; pp < 2; ++pp) { const int id = 2 * half + pp;
            f32x4 acc = (f32x4){0.f, 0.f, 0.f, 0.f};
            acc = wy_mm16(WY_ROW(sq, half ? 3 : 0), WY_ROW(sq, pp ? 2 : 1), acc, li, lq);
#pragma unroll
            for (int r = 0; r < 4; ++r) { const int t = 4 * lq + r; const bool keep = half ? (li <= t) : (li < t); const float val = keep ? acc[r] : 0.f;
                WY_A(sq, id)[t * WY_LT + li] = f2bf(val); if (id == 0) ((LAS float*)(L + WY_AABF + sq * 1024))[t * 16 + li] = val; } }
        __syncthreads();
        if (w < 4) { const LAS float* Af = (const LAS float*)(L + WY_AABF + w * 1024); float Tc[16];
#pragma unroll
            for (int t = 0; t < 16; ++t) { float acc = (t == li) ? 1.f : 0.f;
#pragma unroll
                for (int s4 = 0; s4 < 4; ++s4) { if (4 * s4 < t) { const f32x4 a4 = *(const LAS f32x4*)(Af + t * 16 + 4 * s4);
                    if (4 * s4 + 0 < t) acc += a4.x * Tc[4 * s4 + 0]; if (4 * s4 + 1 < t) acc += a4.y * Tc[4 * s4 + 1]; if (4 * s4 + 2 < t) acc += a4.z * Tc[4 * s4 + 2]; if (4 * s4 + 3 < t) acc += a4.w * Tc[4 * s4 + 3]; } }
                Tc[t] = acc; WY_A(w, 4)[t * WY_LT + li] = f2bf(acc); } }
        if (cc == 0) {
#pragma unroll
            for (int r = 0; r < 4; ++r)
#pragma unroll
                for (int e = 0; e < 4; ++e) { const int row = 32 * ti + 8 * r + 4 * hi + e, col = 32 * tj + j32; S[4 * r + e] = (ti >= 2 && row - 64 == col) ? 1.f : 0.f; }
#pragma unroll
            for (int r = 0; r < 4; ++r)
#pragma unroll
                for (int e = 0; e < 4; ++e) SB[(32 * ti + 8 * r + 4 * hi + e) * MM_LP + 32 * tj + j32] = f2bf(S[4 * r + e]);
        }
        __syncthreads();
#pragma unroll 1
        for (int q = 0; q < 4; ++q) {
            f32x4 accW = (f32x4){0.f, 0.f, 0.f, 0.f}, accY = accW;
            accW = wy_mm16(WY_ROW(q, 0), SB + 16 * w * MM_LP, accW, li, lq);
            accY = wy_mm16(WY_ROW(q, 3), SB + 16 * w * MM_LP, accY, li, lq);
            if (w < 4) accW = wy_mm16k16(WY_A(q, 1), WY_COL(q, 2) + 16 * w * WY_LT, accW, li, lq);
            { u32x2 pk; pk.x = cvt_pk_bf16(accW[0], accW[1]); pk.y = cvt_pk_bf16(accW[2], accW[3]); *(LAS u32x2*)(WT + (16 * w + li) * WY_LT + 4 * lq) = pk; }
            asm volatile("s_waitcnt lgkmcnt(0)" ::: "memory");
            { f32x4 accU = (f32x4){0.f, 0.f, 0.f, 0.f}; accU = wy_mm16k16(WY_A(q, 4), WT + 16 * w * WY_LT, accU, li, lq);
              u32x2 pk; pk.x = cvt_pk_bf16(accU[0], accU[1]); pk.y = cvt_pk_bf16(accU[2], accU[3]); *(LAS u32x2*)(UT + (16 * w + li) * WY_LT + 4 * lq) = pk; }
            asm volatile("s_waitcnt lgkmcnt(0)" ::: "memory");
            accY = wy_mm16k16(WY_A(q, 2), UT + 16 * w * WY_LT, accY, li, lq);
            if (w < 4) accY = wy_mm16k16(WY_A(q, 3), WY_COL(q, 2) + 16 * w * WY_LT, accY, li, lq);
            { bf16* dst = (w < 4) ? Y0 : RH; const int colo = h * 64 + ((16 * w) & 63) + li;
#pragma unroll
              for (int r = 0; r < 4; ++r) dst[(size_t)(m0 + 16 * q + 4 * lq + r) * 256 + colo] = f2bf(accY[r]); }
            __syncthreads();
            { const float gc = GCs[q * 64 + 32 * tj + j32];
#pragma unroll
              for (int i = 0; i < 16; ++i) S[i] *= gc;
              const bf16x8 ua = *(const LAS bf16x8*)(UT + (32 * ti + j32) * WY_LT + 8 * hi), bb = *(const LAS bf16x8*)(WY_COL(q, 0) + (32 * tj + j32) * WY_LT + 8 * hi);
              S = __builtin_amdgcn_mfma_f32_32x32x16_bf16(ua, bb, S, 0, 0, 0);
              if (ti < 2) { const bf16x8 va = *(const LAS bf16x8*)(WY_COL(q, 2) + (32 * ti + j32) * WY_LT + 8 * hi), kb = *(const LAS bf16x8*)(WY_COL(q, 1) + (32 * tj + j32) * WY_LT + 8 * hi);
                  S = __builtin_amdgcn_mfma_f32_32x32x16_bf16(va, kb, S, 0, 0, 0); } }
            {
#pragma unroll
                for (int r = 0; r < 4; ++r)
#pragma unroll
                    for (int e = 0; e < 4; ++e) SB[(32 * ti + 8 * r + 4 * hi + e) * MM_LP + 32 * tj + j32] = f2bf(S[4 * r + e]);
                __syncthreads(); }
        }
        if (cc == RW_SUP - 1) {
        if (ti < 2) { float* o = PQ + (size_t)su * 4096 + (size_t)(32 * ti + 4 * hi) * 64 + 32 * tj + j32;
#pragma unroll
            for (int r = 0; r < 4; ++r)
#pragma unroll
                for (int e = 0; e < 4; ++e) o[(8 * r + e) * 64] = S[4 * r + e]; }
        else { float* o = PQ + ((size_t)RW_NSUP + su) * 4096 + (size_t)(32 * tj + j32) * 64 + 32 * (ti - 2) + 4 * hi;
#pragma unroll
            for (int r = 0; r < 4; ++r) *(f32x4*)(o + 8 * r) = (f32x4){S[4 * r], S[4 * r + 1], S[4 * r + 2], S[4 * r + 3]}; }
        }
        __syncthreads();
    }
    }
#undef WY_ROW
#undef WY_COL
#undef WY_A
#undef WY_RAW
}
__device__ __forceinline__ void ph_rw_scan_(const Ctx& C, int wg) {
    const float* Qg = (const float*)(C.ws + WS_PQ); const float* Pg = Qg + (size_t)RW_NSUP * 4096; float* SST = (float*)(C.ws + WS_SST);
    LAS bf16* PT = (LAS bf16*)(C.lds);
    LAS bf16* SLb = PT + 2 * 64 * MM_LP;
    LAS float* QL = (LAS float*)(C.lds + (2 * 64 * MM_LP + 2 * 16 * MM_LP) * 2);
    LAS float* SO = QL + 2 * 16 * 64;
    const int lane = C.lane, wave = C.wave, bh = wg >> 2, rq = wg & 3, ct = wave & 3, li = lane & 15, lq = lane >> 4;
    const bool mm = wave < 4;
    const size_t ubase = (size_t)bh * RW_NSC;
    const int lt = C.tid & 255;
    const int qrow = lt >> 4, qc4 = (lt & 15) * 4;
    constexpr int PD = 6;
    f32x4 pr[PD][4], qr[PD];
#define SC_P_PIECE(i) (lt + 256 * (i))
#define SC_PUT_P(buf, sx_) do { LAS bf16* d_ = PT + (buf) * (64 * MM_LP); _Pragma("unroll") for (int i_ = 0; i_ < 4; ++i_) { const int idx_ = SC_P_PIECE(i_), r_ = (idx_ * 4) >> 6, k_ = (idx_ * 4) & 63; u32x2 w_; \
        w_.x = cvt_pk_bf16(pr[sx_][i_].x, pr[sx_][i_].y); w_.y = cvt_pk_bf16(pr[sx_][i_].z, pr[sx_][i_].w); *(LAS u32x2*)(d_ + r_ * MM_LP + k_) = w_; } } while (0)
#define SC_LOAD(sx_, cc) do { const f32x4* p4_ = (const f32x4*)(Pg + (ubase + (cc)) * 4096); _Pragma("unroll") for (int i_ = 0; i_ < 4; ++i_) pr[sx_][i_] = p4_[SC_P_PIECE(i_)]; \
        qr[sx_] = *(const f32x4*)(Qg + (ubase + (cc)) * 4096 + (rq * 16 + qrow) * 64 + qc4); } while (0)
    if (mm) {
#pragma unroll
        for (int r = 0; r < 4; ++r) SLb[(4 * lq + r) * MM_LP + ct * 16 + li] = (bf16)0;
    } else {
        { float z0; asm volatile("v_mov_b32 %0, 0" : "=v"(z0));
          *(f32x4*)(SST + ubase * 4096 + (rq * 16 + qrow) * 64 + qc4) = (f32x4){z0, z0, z0, z0}; }
        SC_LOAD(0, 0); SC_PUT_P(0, 0); *(LAS f32x4*)(QL + qrow * 64 + qc4) = qr[0];
#pragma unroll
        for (int x = 0; x < PD; ++x) SC_LOAD(x, 1 + x);
    }
    __syncthreads();
#pragma unroll 1
    for (int c2 = 0; c2 < RW_NSC; c2 += PD) {
#pragma unroll
        for (int x = 0; x < PD; ++x) {
            const int c = c2 + x;
            if (c < RW_NSC) {
            if (mm) {
                const LAS bf16* Pc = PT + (c & 1) * (64 * MM_LP); const LAS bf16* Sc = SLb + (c & 1) * (16 * MM_LP); const LAS float* Qc = QL + (c & 1) * (16 * 64);
                LAS bf16* Sn = SLb + ((c + 1) & 1) * (16 * MM_LP); LAS float* So = SO + ((c + 1) & 1) * (16 * 64);
                bf16x8 af[2], bfr[2];
#pragma unroll
                for (int ks = 0; ks < 2; ++ks) { af[ks] = *(const LAS bf16x8*)(Sc + li * MM_LP + 32 * ks + 8 * lq); bfr[ks] = *(const LAS bf16x8*)(Pc + (16 * ct + li) * MM_LP + 32 * ks + 8 * lq); }
                f32x4 acc;
#pragma unroll
                for (int r = 0; r < 4; ++r) acc[r] = Qc[(4 * lq + r) * 64 + ct * 16 + li];
#pragma unroll
                for (int ks = 0; ks < 2; ++ks) acc = __builtin_amdgcn_mfma_f32_16x16x32_bf16(af[ks], bfr[ks], acc, 0, 0, 0);
                if (c + 1 < RW_NSC) {
#pragma unroll
                    for (int r = 0; r < 4; ++r) { Sn[(4 * lq + r) * MM_LP + ct * 16 + li] = f2bf(acc[r]); So[(4 * lq + r) * 64 + ct * 16 + li] = acc[r]; } }
            } else {
                if (c > 0) *(f32x4*)(SST + (ubase + c) * 4096 + (rq * 16 + qrow) * 64 + qc4) = *(const LAS f32x4*)(SO + (c & 1) * (16 * 64) + qrow * 64 + qc4);
                if (c + 1 < RW_NSC) { SC_PUT_P((c + 1) & 1, x); *(LAS f32x4*)(QL + ((c + 1) & 1) * (16 * 64) + qrow * 64 + qc4) = qr[x]; }
                if (c + 1 + PD < RW_NSC) SC_LOAD(x, c + 1 + PD);
            }
            __syncthreads();
#ifdef SCAN_2BAR
            __syncthreads();
#endif
            }
        }
    }
#undef SC_PUT_P
#undef SC_LOAD
#undef SC_P_PIECE
}
__device__ __forceinline__ void ph_rw_out_(const Ctx& C, int l) {
    const bf16* RKVS = (const bf16*)(C.ws + WS_RKVS); const bf16* AG = (const bf16*)(C.ws + WS_AG); const bf16* Y0 = (const bf16*)(C.ws + WS_Y0); const bf16* RH = (const bf16*)(C.ws + WS_RHAT);
    const float* SST = (const float*)(C.ws + WS_SST); const float* BON = (const float*)(C.ws + WS_BON); bf16* Y = (bf16*)(C.ws + WS_Y);
    LAS float* RL = (LAS float*)(C.lds);
    const int lane = C.lane, wave = C.wave;
    for (int u = C.bid; u < RW_NU; u += C.G) {
        const int bh = u >> 8, ch = u & 255, b = bh >> 2, h = bh & 3, m0 = b * SEQ + ch * RWC, hc = h * 64 + lane;
        { const int t = C.tid >> 3, d0 = (C.tid & 7) * 8; float a[8];
          unpack8(*(const u32x4*)(RH + (size_t)(m0 + t) * 256 + h * 64 + d0), a);
#pragma unroll
          for (int e = 0; e < 8; ++e) RL[t * 64 + d0 + e] = a[e]; }
        float s[64];
        { const f32x4* sp = (const f32x4*)(SST + (size_t)u * 4096 + lane * 64);
#pragma unroll
          for (int k4 = 0; k4 < 16; ++k4) { const f32x4 v = sp[k4]; s[4 * k4] = v.x; s[4 * k4 + 1] = v.y; s[4 * k4 + 2] = v.z; s[4 * k4 + 3] = v.w; } }
        const float lnw = C.in[I_RW_LNW][l * 256 + hc], lnb = C.in[I_RW_LNB][l * 256 + hc];
        __syncthreads();
#pragma unroll 2
        for (int q = 0; q < 8; ++q) { const int t = wave * 8 + q; const size_t m = (size_t)(m0 + t);
            const LAS f32x4* rv = (const LAS f32x4*)(RL + t * 64);
            float y0 = 0.f, y1 = 0.f, y2 = 0.f, y3 = 0.f;
#pragma unroll
            for (int k4 = 0; k4 < 16; ++k4) { const f32x4 rq = rv[k4]; y0 += s[4 * k4] * rq.x; y1 += s[4 * k4 + 1] * rq.y; y2 += s[4 * k4 + 2] * rq.z; y3 += s[4 * k4 + 3] * rq.w; }
#ifndef RWDBG
#define RWDBG 0
#endif
            float y = ((RWDBG & 1) ? 0.f : (y0 + y1) + (y2 + y3)) + ((RWDBG & 2) ? 0.f : bf2f(Y0[m * 256 + hc]));
            const float mean = wave_sum(y, C.lane) * (1.f / 64.f); y -= mean;
            const float rstd = 1.0f / sqrtf(wave_sum(y * y, C.lane) * (1.f / 64.f) + 64e-5f);
            y = y * rstd * lnw + lnb;
            if (!(RWDBG & 4)) y += BON[m * 4 + h] * bf2f(RKVS[m * 768 + 512 + hc]);
            y *= bf2f(AG[m * 512 + 256 + hc]);
            if (RWDBG & 120) { y = 0.f; if (RWDBG & 8) y += ((const float*)(C.ws + WS_WDEC))[m * 256 + hc]; if (RWDBG & 16) y += bf2f(AG[m * 512 + hc]);
                if (RWDBG & 32) y += bf2f(RKVS[m * 768 + hc]) + bf2f(RKVS[m * 768 + 256 + hc]) + bf2f(RKVS[m * 768 + 512 + hc]); if (RWDBG & 64) y += BON[m * 4 + h]; }
            Y[m * 1024 + hc] = f2bf(y); }
        __syncthreads();
    }
}

constexpr int SB_VLD = 40;
__device__ __forceinline__ void ph_sb_attn_(const Ctx& C, int first_wg, int nwg, unsigned* qhead = nullptr) {
    const bf16* SB = (const bf16*)(C.ws + WS_SB); bf16* Y = (bf16*)(C.ws + WS_Y);
    const int lane = C.lane, j = lane & 31, hi = lane >> 5;
    LAS bf16* VT = (LAS bf16*)(C.lds + C.wave * (64 * SB_VLD * 2));
    for (int it = qhead ? q_next(C, qhead) : C.bid - first_wg; it < 512; it = qhead ? q_next(C, qhead) : it + nwg) {
        const int bh = it >> 6, b = bh >> 2, h = bh & 3, t0 = (it & 63) * 256 + C.wave * 32; const size_t mb = (size_t)b * SEQ;
        bf16x8 qf[4];
#pragma unroll
        for (int ks = 0; ks < 4; ++ks) qf[ks] = *(const bf16x8*)(SB + (mb + t0 + j) * 768 + h * 64 + 16 * ks + 8 * hi);
        f32x16 o0, o1;
#pragma unroll
        for (int i = 0; i < 16; ++i) { o0[i] = 0.f; o1[i] = 0.f; }
        float acc = 0.f;
#pragma unroll 1
        for (int kt = t0; kt >= 0; kt -= 32) {
            bf16x8 kf[4];
#pragma unroll
            for (int ks = 0; ks < 4; ++ks) kf[ks] = *(const bf16x8*)(SB + (mb + kt + j) * 768 + 256 + h * 64 + 16 * ks + 8 * hi);
            u32x4 vv[4];
#pragma unroll
            for (int i = 0; i < 4; ++i) { const int c = lane + 64 * i; vv[i] = *(const u32x4*)(SB + (mb + kt + (c >> 3)) * 768 + 512 + h * 64 + (c & 7) * 8); }
            f32x16 sc;
#pragma unroll
            for (int i = 0; i < 16; ++i) sc[i] = 0.f;
#pragma unroll
            for (int ks = 0; ks < 4; ++ks) sc = __builtin_amdgcn_mfma_f32_32x32x16_bf16(kf[ks], qf[ks], sc, 0, 0, 0);
#pragma unroll
            for (int i = 0; i < 4; ++i) { const int c = lane + 64 * i, key = c >> 3, d8 = (c & 7) * 8; const unsigned w[4] = {vv[i].x, vv[i].y, vv[i].z, vv[i].w};
#pragma unroll
                for (int e = 0; e < 4; ++e) { VT[(d8 + 2 * e) * SB_VLD + key] = (bf16)(w[e] & 0xffffu); VT[(d8 + 2 * e + 1) * SB_VLD + key] = (bf16)(w[e] >> 16); } }
            const bool diag = (kt == t0);
            float ls[16], g[4], og[4];
#pragma unroll
            for (int r = 0; r < 4; ++r) { g[r] = 0.f;
#pragma unroll
                for (int e = 0; e < 4; ++e) { const float z = sc[4 * r + e]; const bool valid = !diag || (8 * r + 4 * hi + e) < j;
                    const float l = (z > 40.f) ? -z : -__builtin_amdgcn_logf(1.f + __builtin_amdgcn_exp2f(z));
                    ls[4 * r + e] = valid ? l : 0.f; g[r] += ls[4 * r + e]; } }
#pragma unroll
            for (int r = 0; r < 4; ++r) og[r] = shx(g[r], 32, lane);
            float pw[16]; float run = acc;
#pragma unroll
            for (int r = 3; r >= 0; --r) { float cum = run + (hi == 0 ? og[r] : 0.f);
#pragma unroll
                for (int e = 3; e >= 0; --e) { cum += ls[4 * r + e]; const bool valid = !diag || (8 * r + 4 * hi + e) < j;
                    pw[4 * r + e] = valid ? __builtin_amdgcn_exp2f(sc[4 * r + e] + cum) : 0.f; }
                run += g[r] + og[r]; }
            acc = run;
            asm volatile("" ::: "memory");
#pragma unroll
            for (int ks = 0; ks < 2; ++ks) {
                u32x4 pk; pk.x = cvt_pk_bf16(pw[8 * ks], pw[8 * ks + 1]); pk.y = cvt_pk_bf16(pw[8 * ks + 2], pw[8 * ks + 3]); pk.z = cvt_pk_bf16(pw[8 * ks + 4], pw[8 * ks + 5]); pk.w = cvt_pk_bf16(pw[8 * ks + 6], pw[8 * ks + 7]);
                const bf16x8 pb = __builtin_bit_cast(bf16x8, pk);
                const s16x4 a0l = *(const LAS s16x4*)(VT + j * SB_VLD + 16 * ks + 4 * hi), a0h = *(const LAS s16x4*)(VT + j * SB_VLD + 16 * ks + 8 + 4 * hi);
                const s16x4 a1l = *(const LAS s16x4*)(VT + (32 + j) * SB_VLD + 16 * ks + 4 * hi), a1h = *(const LAS s16x4*)(VT + (32 + j) * SB_VLD + 16 * ks + 8 + 4 * hi);
                const bf16x8 va0 = __builtin_shufflevector(a0l, a0h, 0, 1, 2, 3, 4, 5, 6, 7), va1 = __builtin_shufflevector(a1l, a1h, 0, 1, 2, 3, 4, 5, 6, 7);
                o0 = __builtin_amdgcn_mfma_f32_32x32x16_bf16(va0, pb, o0, 0, 0, 0);
                o1 = __builtin_amdgcn_mfma_f32_32x32x16_bf16(va1, pb, o1, 0, 0, 0);
            }
            asm volatile("" ::: "memory");
            if (__builtin_amdgcn_ballot_w64(acc > -140.f) == 0ull) break;
        }
        bf16* yp = Y + (mb + t0 + j) * 1024 + 256 + h * 64 + 4 * hi;
#pragma unroll
        for (int r = 0; r < 4; ++r) { u32x2 w0, w1; w0.x = cvt_pk_bf16(o0[4 * r], o0[4 * r + 1]); w0.y = cvt_pk_bf16(o0[4 * r + 2], o0[4 * r + 3]); w1.x = cvt_pk_bf16(o1[4 * r], o1[4 * r + 1]); w1.y = cvt_pk_bf16(o1[4 * r + 2], o1[4 * r + 3]);
            *(u32x2*)(yp + 8 * r) = w0; *(u32x2*)(yp + 32 + 8 * r) = w1; }
    }
}


__device__ __forceinline__ f32x16 mm_tile(const LAS bf16* X, const LAS bf16* Y, int ti, int tj, int lane) {
    const int j = lane & 31, hi = lane >> 5; f32x16 acc;
#pragma unroll
    for (int i = 0; i < 16; ++i) acc[i] = 0.f;
#pragma unroll
    for (int ks = 0; ks < 4; ++ks) { const bf16x8 a = *(const LAS bf16x8*)(X + (32 * ti + j) * MM_LP + 16 * ks + 8 * hi), b = *(const LAS bf16x8*)(Y + (32 * tj + j) * MM_LP + 16 * ks + 8 * hi);
        acc = __builtin_amdgcn_mfma_f32_32x32x16_bf16(a, b, acc, 0, 0, 0); }
    return acc;
}
__device__ __forceinline__ void ln_pair_stats(const f32x16& x, LAS float* XCH, int tr, int tt, int lane, float eps, float& mean, float& rstd) {
    const int j = lane & 31, hi = lane >> 5; float s1 = 0.f, s2 = 0.f;
#pragma unroll
    for (int i = 0; i < 16; ++i) { s1 += x[i]; s2 += x[i] * x[i]; }
    s1 += shx(s1, 32, lane); s2 += shx(s2, 32, lane);
    if (hi == 0) { XCH[(tr * 64 + 32 * tt + j) * 2] = s1; XCH[(tr * 64 + 32 * tt + j) * 2 + 1] = s2; }
    __syncthreads();
    const float a1 = XCH[(32 * tt + j) * 2] + XCH[(64 + 32 * tt + j) * 2], a2 = XCH[(32 * tt + j) * 2 + 1] + XCH[(64 + 32 * tt + j) * 2 + 1];
    mean = a1 * (1.f / 64.f); const float var = fmaxf(a2 * (1.f / 64.f) - mean * mean, 0.f); rstd = 1.0f / sqrtf(var + eps);
}
__device__ __forceinline__ void rot_store(const Ctx& C, const bf16* src  , int pos, int d0, float scale, LAS bf16* dstrow) {
    const float* cs = (const float*)(C.ws + WS_COS) + (size_t)pos * 32 + d0; const float* sn = (const float*)(C.ws + WS_SIN) + (size_t)pos * 32 + d0;
    float x1[8], x2[8]; unpack8(*(const u32x4*)(src + d0), x1); unpack8(*(const u32x4*)(src + 32 + d0), x2);
    const f32x4 c0 = *(const f32x4*)cs, c1 = *(const f32x4*)(cs + 4), s0 = *(const f32x4*)sn, s1 = *(const f32x4*)(sn + 4);
    const float cc[8] = {c0.x, c0.y, c0.z, c0.w, c1.x, c1.y, c1.z, c1.w}, ss[8] = {s0.x, s0.y, s0.z, s0.w, s1.x, s1.y, s1.z, s1.w};
    float o1[8], o2[8];
#pragma unroll
    for (int e = 0; e < 8; ++e) { o1[e] = (x1[e] * cc[e] - x2[e] * ss[e]) * scale; o2[e] = (x1[e] * ss[e] + x2[e] * cc[e]) * scale; }
    *(LAS u32x4*)(dstrow + d0) = pack8(o1); *(LAS u32x4*)(dstrow + 32 + d0) = pack8(o2);
}

__device__ __forceinline__ void ph_ret_kv2_(const Ctx& C) {
    const bf16* RET = (const bf16*)(C.ws + WS_RET); float* KV = (float*)(C.ws + WS_KV);
    const int half = C.wave >> 2, w4 = C.wave & 3, th = C.tid & 255, lane = C.lane;
    LAS bf16* KT = (LAS bf16*)(C.lds + half * 36864);
    LAS bf16* VT = KT + 64 * MM_LP;
    LAS bf16* KR = VT + 64 * MM_LP;
    for (int it = C.bid; it < 1024; it += C.G) {
        const int u = it * 2 + half, bh = u >> 8, ch = u & 255, b = bh >> 2, h = bh & 3, m0 = b * SEQ + ch * 64;
        const float lg = ret_log2gamma(h);
        { const int srow = th >> 2, dq = th & 3; const size_t m = (size_t)(m0 + srow);
          rot_store(C, RET + m * 1024 + 256 + h * 64, (int)(m & (SEQ - 1)), dq * 8, 0.125f * exp2f(lg * (float)(63 - srow)), KR + srow * MM_LP);
          float a[8];
#pragma unroll
          for (int q = 0; q < 2; ++q) { const int e0 = dq * 16 + q * 8; unpack8(*(const u32x4*)(RET + m * 1024 + 512 + h * 64 + e0), a);
#pragma unroll
              for (int e = 0; e < 8; ++e) VT[(e0 + e) * MM_LP + srow] = f2bf(a[e]); } }
        __syncthreads();
        { const int d = th >> 2, s0 = (th & 3) * 16;
#pragma unroll
          for (int i = 0; i < 16; ++i) KT[d * MM_LP + s0 + i] = KR[(s0 + i) * MM_LP + d]; }
        __syncthreads();
        { const int ti = w4 >> 1, tj = w4 & 1, j = lane & 31, hi = lane >> 5;
          const f32x16 acc = mm_tile(VT, KT, ti, tj, lane);
          float* o = KV + (size_t)u * 4096 + (size_t)(32 * ti + 4 * hi) * 64 + 32 * tj + j;
#pragma unroll
          for (int r = 0; r < 4; ++r)
#pragma unroll
              for (int e = 0; e < 4; ++e) o[(8 * r + e) * 64] = acc[4 * r + e]; }
        __syncthreads();
    }
}
__device__ __forceinline__ void ph_ret_out2_(const Ctx& C, int l, int first_wg, int nwg, unsigned* qhead = nullptr) {
    const bf16* RET = (const bf16*)(C.ws + WS_RET); const float* KV = (const float*)(C.ws + WS_KV); bf16* Y = (bf16*)(C.ws + WS_Y);
    const int half = C.wave >> 2, w4 = C.wave & 3, th = C.tid & 255, lane = C.lane, j = lane & 31, hi = lane >> 5, te = w4 >> 1, tt = w4 & 1;
    LAS bf16* QL = (LAS bf16*)(C.lds + half * 40960);
    LAS bf16* KL = QL + 64 * MM_LP;
    LAS bf16* VT = KL + 64 * MM_LP;
    LAS bf16* ST = VT + 64 * MM_LP;
    LAS float* XCH = (LAS float*)(C.lds + half * 40960 + 4 * 64 * MM_LP * 2);
    const float* gn = C.in[I_RET_GN] + (size_t)l * 256;
    for (int it = qhead ? q_next(C, qhead) : C.bid - first_wg; it < 1024; it = qhead ? q_next(C, qhead) : it + nwg) {
        const int u = it * 2 + half, bh = u >> 8, ch = u & 255, b = bh >> 2, h = bh & 3, m0 = b * SEQ + ch * 64;
        const float lg = ret_log2gamma(h);
        { const int srow = th >> 2, dq = th & 3; const size_t m = (size_t)(m0 + srow); const int pos = (int)(m & (SEQ - 1));
          rot_store(C, RET + m * 1024 + h * 64, pos, dq * 8, 1.0f, QL + srow * MM_LP);
          rot_store(C, RET + m * 1024 + 256 + h * 64, pos, dq * 8, 0.125f, KL + srow * MM_LP);
          float a[8];
#pragma unroll
          for (int q = 0; q < 2; ++q) { const int e0 = dq * 16 + q * 8; unpack8(*(const u32x4*)(RET + m * 1024 + 512 + h * 64 + e0), a);
#pragma unroll
              for (int e = 0; e < 8; ++e) VT[(e0 + e) * MM_LP + srow] = f2bf(a[e]); }
          const float* sp = KV + (size_t)u * 4096 + srow * 64 + dq * 16;
          float sv[16];
#pragma unroll
          for (int q = 0; q < 4; ++q) { const f32x4 v4 = *(const f32x4*)(sp + 4 * q); sv[4 * q] = v4.x; sv[4 * q + 1] = v4.y; sv[4 * q + 2] = v4.z; sv[4 * q + 3] = v4.w; }
          *(LAS u32x4*)(ST + srow * MM_LP + dq * 16) = pack8(sv); *(LAS u32x4*)(ST + srow * MM_LP + dq * 16 + 8) = pack8(sv + 8); }
        __syncthreads();
        f32x16 acc = mm_tile(ST, QL, te, tt, lane);
        { const float qd = exp2f(lg * (float)(32 * tt + j + 1));
#pragma unroll
          for (int i = 0; i < 16; ++i) acc[i] *= qd; }
#pragma unroll
        for (int st = 0; st < 2; ++st) {
            if (st > tt) continue;
            const f32x16 sc = mm_tile(KL, QL, st, tt, lane);
            float pw[16];
#pragma unroll
            for (int r = 0; r < 4; ++r)
#pragma unroll
                for (int e = 0; e < 4; ++e) { const int sk = 32 * st + 8 * r + 4 * hi + e, tq = 32 * tt + j;
                    pw[4 * r + e] = (sk <= tq) ? sc[4 * r + e] * exp2f(lg * (float)(tq - sk)) : 0.f; }
#pragma unroll
            for (int ks = 0; ks < 2; ++ks) {
                u32x4 pk; pk.x = cvt_pk_bf16(pw[8 * ks], pw[8 * ks + 1]); pk.y = cvt_pk_bf16(pw[8 * ks + 2], pw[8 * ks + 3]); pk.z = cvt_pk_bf16(pw[8 * ks + 4], pw[8 * ks + 5]); pk.w = cvt_pk_bf16(pw[8 * ks + 6], pw[8 * ks + 7]);
                const bf16x8 pb = __builtin_bit_cast(bf16x8, pk);
                const LAS bf16* vr = VT + (32 * te + j) * MM_LP + 32 * st + 16 * ks + 4 * hi;
                const s16x4 al = *(const LAS s16x4*)vr, ah = *(const LAS s16x4*)(vr + 8);
                const bf16x8 va = __builtin_shufflevector(al, ah, 0, 1, 2, 3, 4, 5, 6, 7);
                acc = __builtin_amdgcn_mfma_f32_32x32x16_bf16(va, pb, acc, 0, 0, 0);
            }
        }
        float mean, rstd; ln_pair_stats(acc, XCH, te, tt, lane, 1e-5f, mean, rstd);
        { const size_t m = (size_t)(m0 + 32 * tt + j); const bf16* gp = RET + m * 1024 + 768 + h * 64 + 32 * te + 4 * hi; bf16* yp = Y + m * 1024 + 512 + h * 64 + 32 * te + 4 * hi;
          const float* gw = gn + h * 64 + 32 * te + 4 * hi;
#pragma unroll
          for (int r = 0; r < 4; ++r) { const u32x2 gt2 = *(const u32x2*)(gp + 8 * r); const float gtv[4] = {bflo(gt2.x), bfhi(gt2.x), bflo(gt2.y), bfhi(gt2.y)}; const f32x4 gwv = *(const f32x4*)(gw + 8 * r);
              float o[4];
#pragma unroll
              for (int e = 0; e < 4; ++e) o[e] = (acc[4 * r + e] - mean) * rstd * gwv[e] * (gtv[e] * sigm(gtv[e]));
              u32x2 w; w.x = cvt_pk_bf16(o[0], o[1]); w.y = cvt_pk_bf16(o[2], o[3]); *(u32x2*)(yp + 8 * r) = w; } }
        __syncthreads();
    }
}
__device__ __forceinline__ void ph_rw_out2_(const Ctx& C, int l, unsigned* qhead = nullptr) {
    const bf16* RWp = (const bf16*)(C.ws + WS_RW); const bf16* GP = (const bf16*)(C.ws + WS_GP); const bf16* Y0 = (const bf16*)(C.ws + WS_Y0); const bf16* RH = (const bf16*)(C.ws + WS_RHAT);
    const float* SST = (const float*)(C.ws + WS_SST); const float* BON = (const float*)(C.ws + WS_BON); bf16* Y = (bf16*)(C.ws + WS_Y);
    const int half = C.wave >> 2, w4 = C.wave & 3, th = C.tid & 255, lane = C.lane, j = lane & 31, hi = lane >> 5, tv = w4 >> 1, tt = w4 & 1;
    LAS bf16* SL = (LAS bf16*)(C.lds + half * 20480);
    LAS bf16* RL = SL + 64 * MM_LP;
    LAS float* XCH = (LAS float*)(C.lds + half * 20480 + 2 * 64 * MM_LP * 2);
    for (int it = qhead ? q_next(C, qhead) : C.bid; it < RW_NU / 2; it = qhead ? q_next(C, qhead) : it + C.G) {
        const int u = it * 2 + half, bh = u >> 8, ch = u & 255, b = bh >> 2, h = bh & 3, m0 = b * SEQ + ch * RWC;
        { const int row = th >> 2, q4 = th & 3;
          const float* sp = SST + (size_t)(u >> 3) * 4096 + row * 64 + q4 * 16; float sv[16];
#pragma unroll
          for (int q = 0; q < 4; ++q) { const f32x4 v4 = *(const f32x4*)(sp + 4 * q); sv[4 * q] = v4.x; sv[4 * q + 1] = v4.y; sv[4 * q + 2] = v4.z; sv[4 * q + 3] = v4.w; }
          *(LAS u32x4*)(SL + row * MM_LP + q4 * 16) = pack8(sv); *(LAS u32x4*)(SL + row * MM_LP + q4 * 16 + 8) = pack8(sv + 8);
          const u32x4* rp = (const u32x4*)(RH + (size_t)(m0 + row) * 256 + h * 64 + q4 * 16);
          *(LAS u32x4*)(RL + row * MM_LP + q4 * 16) = rp[0]; *(LAS u32x4*)(RL + row * MM_LP + q4 * 16 + 8) = rp[1]; }
        __syncthreads();
        f32x16 acc = mm_tile(SL, RL, tv, tt, lane);
        const size_t m = (size_t)(m0 + 32 * tt + j); const int vb = h * 64 + 32 * tv + 4 * hi;
#pragma unroll
        for (int r = 0; r < 4; ++r) { const u32x2 y2 = *(const u32x2*)(Y0 + m * 256 + vb + 8 * r); acc[4 * r] += bflo(y2.x); acc[4 * r + 1] += bfhi(y2.x); acc[4 * r + 2] += bflo(y2.y); acc[4 * r + 3] += bfhi(y2.y); }
        float mean, rstd; ln_pair_stats(acc, XCH, tv, tt, lane, 64e-5f, mean, rstd);
        const float bon = BON[m * 4 + h];
#pragma unroll
        for (int r = 0; r < 4; ++r) { const int vc = vb + 8 * r;
            const f32x4 lw = *(const f32x4*)(C.in[I_RW_LNW] + (size_t)l * 256 + vc), lb = *(const f32x4*)(C.in[I_RW_LNB] + (size_t)l * 256 + vc);
            const u32x2 v2 = *(const u32x2*)(RWp + m * 1024 + 512 + vc), g2 = *(const u32x2*)(GP + m * 256 + vc); u32x2 vp = (u32x2){0u, 0u};
            if ((32 * tt + j) | (ch * RWC)) vp = *(const u32x2*)(RWp + (m - 1) * 1024 + 512 + vc);
            const f32x4 mv = *(const f32x4*)(C.in[I_RW_MU] + (size_t)l * 1024 + 512 + vc);
            const float vc4[4] = {bflo(v2.x), bfhi(v2.x), bflo(v2.y), bfhi(v2.y)}, vq4[4] = {bflo(vp.x), bfhi(vp.x), bflo(vp.y), bfhi(vp.y)};
            const float vv[4] = {vc4[0] + (vq4[0] - vc4[0]) * mv[0], vc4[1] + (vq4[1] - vc4[1]) * mv[1], vc4[2] + (vq4[2] - vc4[2]) * mv[2], vc4[3] + (vq4[3] - vc4[3]) * mv[3]}, gg[4] = {bflo(g2.x), bfhi(g2.x), bflo(g2.y), bfhi(g2.y)};
            float o[4];
#pragma unroll
            for (int e = 0; e < 4; ++e) o[e] = ((acc[4 * r + e] - mean) * rstd * lw[e] + lb[e] + bon * vv[e]) * gg[e];
            u32x2 w; w.x = cvt_pk_bf16(o[0], o[1]); w.y = cvt_pk_bf16(o[2], o[3]); *(u32x2*)(Y + m * 1024 + vc) = w; }
        __syncthreads();
    }
}

__device__ __forceinline__ void ph_moe_scatter_(const Ctx& C, int moe_idx) {
    unsigned* cw = (unsigned*)(C.ws + WS_CTL) + CW_MOE + moe_idx * 64;
    const int* eidx = (const int*)(C.ws + WS_EIDX); const float* gate = (const float*)(C.ws + WS_GATE);
    int* rowtok = (int*)(C.ws + WS_ROWTOK); float* rowgate = (float*)(C.ws + WS_ROWGATE); int* texp = (int*)(C.ws + WS_TEXP); int* segend = (int*)(C.ws + WS_SEGEND); int* ntp = (int*)(C.ws + WS_NT);
    bf16* XS = (bf16*)(C.ws + WS_XS);
    LAS unsigned* lcnt = (LAS unsigned*)(C.lds); LAS unsigned* lbase = lcnt + 8; LAS int* sl = (LAS int*)(C.lds + 256);
    int cnt[8], segb[8]; int tot = 0;
#pragma unroll
    for (int e = 0; e < 8; ++e) { cnt[e] = (int)__hip_atomic_load(&cw[e], __ATOMIC_RELAXED, __HIP_MEMORY_SCOPE_AGENT); segb[e] = tot; tot += (cnt[e] + 255) & ~255; }
    if (C.bid == 0) {
        if (C.tid < 8) { const int e = C.tid; int sb = 0, ce = 0;
#pragma unroll
            for (int q = 0; q < 8; ++q) if (q == e) { sb = segb[q]; ce = cnt[q]; }
            for (int pm = sb >> 8; pm < ((sb + ((ce + 255) & ~255)) >> 8); ++pm) { texp[pm] = e; segend[pm] = sb + ce; } }
        if (C.tid == 0) *ntp = tot >> 8;
    }
    for (int blk = C.bid; blk < T / 256; blk += C.G) {
        __syncthreads();
        if (C.tid < 8) lcnt[C.tid] = 0u;
        __syncthreads();
        const int a = blk * 512 + C.tid, e = eidx[a];
        const unsigned rank = atomicAdd((unsigned*)&lcnt[e], 1u);
        __syncthreads();
        if (C.tid < 8) lbase[C.tid] = atomicAdd(&cw[16 + C.tid], lcnt[C.tid]);
        __syncthreads();
        int sb = 0;
#pragma unroll
        for (int q = 0; q < 8; ++q) if (q == e) sb = segb[q];
        const int slot = sb + (int)lbase[e] + (int)rank;
        rowtok[slot] = a >> 1; rowgate[slot] = gate[a]; sl[C.tid] = slot; ((int*)(C.ws + WS_SLOTOF))[a] = slot;
        __syncthreads();
#pragma unroll 1
        for (int i0 = C.wave; i0 < 512; i0 += 8 * NWAVES) { u32x4 rowv[8];
#pragma unroll
            for (int j = 0; j < 8; ++j) { const int i = i0 + j * NWAVES; rowv[j] = ((const u32x4*)(C.ws + WS_H8 + (size_t)(blk * 256 + (i >> 1)) * D))[C.lane]; }
#pragma unroll
            for (int j = 0; j < 8; ++j) { const int i = i0 + j * NWAVES; ((u32x4*)(C.ws + WS_XS + (size_t)sl[i] * D))[C.lane] = rowv[j]; } }
    }
}

__device__ __forceinline__ void grid_barrier(int wv) {
    const Ctx C = make_ctx(wv);
    XcdBarrier b; b.bar = (unsigned*)(C.ws + WS_CTL) + CW_BAR; b.x = xb_xcc_id(); b.st = (volatile LAS unsigned*)(C.lds + MISC_OFF) + 8;
    xcd_barrier(b, C.tid);
}
__device__ __forceinline__ void P_prologue(int wv) { const Ctx C = make_ctx(wv); ph_prologue_(C); }
__device__ __forceinline__ void P_weights_norm(int wv, int l) { const Ctx C = make_ctx(wv); ph_weights_(C, l, 0, 0, C.G); __syncthreads(); ph_norm_(C, C.in[I_NORM_MIX] + (size_t)l * D, false, nullptr, 0,  (l > 0) && ((l - 1) & 1), l == 0 ? C.in[I_X] : nullptr); }
__device__ __forceinline__ void P_gemm_in(int wv, int l) { const Ctx C = make_ctx(wv); using namespace pg8; unsigned char* ws = C.ws;
    Gemm g{(const bf16*)C.out, (const bf16*)(ws + WS_WIN), D, D}; StaticOrder S; S.init(T, NIN, C.G, C.bid);
    EpiRoute E{(bf16*)(ws + WS_RW), (bf16*)(ws + WS_SB), (bf16*)(ws + WS_RET), (bf16*)(ws + WS_CV), C.in[I_SB_QN] + (size_t)l * 64, C.in[I_SB_KN] + (size_t)l * 64};
    gemm_phase<EpiRoute, StaticOrder, true, 1>(C.lds, C.tid, g, S, E); }
#define REP2(bit, stmt) do { stmt; if constexpr ((PROBE2 >> (bit)) & 1) { __syncthreads(); stmt; } } while (0)
__device__ __forceinline__ void P_mix1(int wv, int l) { REP2(2, { const Ctx C = make_ctx(wv); ph_rw_prep_(C, l); }); REP2(3, { const Ctx C = make_ctx(wv); ph_conv_(C, l); }); REP2(4, { const Ctx C = make_ctx(wv); ph_ret_kv2_(C); }); }
__device__ __forceinline__ void P_mix2(int wv, int l) { { const Ctx C = make_ctx(wv); using namespace pg8; unsigned char* ws = C.ws;
    Gemm g{(const bf16*)(ws + WS_ALORA), (const bf16*)(ws + WS_WLORA), 256, 256}; StaticOrder S; S.init(T, 768, C.G, C.bid);
    EpiLora E{(float*)(ws + WS_WDEC), (bf16*)(ws + WS_AP), (bf16*)(ws + WS_GP), C.in[I_RW_W0] + (size_t)l * 256, C.in[I_RW_A0] + (size_t)l * 256};
    gemm_phase<EpiLora, StaticOrder, true>(C.lds, C.tid, g, S, E); }
    { const Ctx C = make_ctx(wv); ph_ret_scan_(C); } }
#ifndef MIX3_SEL
#define MIX3_SEL 3
#endif
__device__ __forceinline__ void P_mix3(int wv, int l) { REP2(0, { const Ctx C = make_ctx(wv); ph_rw_local_wy_(C, l); }); }
__device__ __forceinline__ void scan_done_post(const Ctx& C, unsigned* cnt) {
    asm volatile("s_waitcnt vmcnt(0)" ::: "memory"); __syncthreads();
    if (C.tid == 0) { __builtin_amdgcn_fence(__ATOMIC_RELEASE, "agent"); asm volatile("s_waitcnt vmcnt(0)" ::: "memory"); (void)xb_add(cnt, 1u); }
}
__device__ __forceinline__ void scan_done_wait(const Ctx& C, unsigned* cnt) {
    __syncthreads();
    if (C.tid == 0) { unsigned sp = 0u; while (xb_ld(cnt) < 32u) { __builtin_amdgcn_s_sleep(2); if (++sp > (1u << 24)) break; }
        __builtin_amdgcn_fence(__ATOMIC_ACQUIRE, "agent"); asm volatile("s_waitcnt vmcnt(0)" ::: "memory"); }
    __syncthreads();
}
__device__ __forceinline__ void P_mix4(int wv, int l) { const Ctx C = make_ctx(wv);
    unsigned* qh = (unsigned*)(C.ws + WS_CTL) + CW_QUEUE + l * 64;
    if (C.G >= 64) { if (C.bid < 32) { ph_rw_scan_(C, C.bid); scan_done_post(C, qh + 48); }
        ph_sb_attn_(C, 0, C.G, qh); __syncthreads(); ph_ret_out2_(C, l, 0, C.G, qh + 16); __syncthreads(); ph_weights_(C, l, 1, 0, C.G, qh + 32);
        scan_done_wait(C, qh + 48); ph_rw_out2_(C, l, qh + 40); }
    else { for (int w = C.bid; w < 32; w += C.G) { ph_rw_scan_(C, w); scan_done_post(C, qh + 48); } ph_sb_attn_(C, 0, C.G); __syncthreads(); ph_ret_out2_(C, l, 0, C.G); __syncthreads(); ph_weights_(C, l, 1, 0, C.G);
        scan_done_wait(C, qh + 48); ph_rw_out2_(C, l); } }
__device__ __forceinline__ void P_gemm_branch(int wv) { const Ctx C = make_ctx(wv); using namespace pg8; unsigned char* ws = C.ws;
    Gemm g{(const bf16*)(ws + WS_Y), (const bf16*)(ws + WS_WB), D, 256}; StaticOrder S; S.init(T, 4096, C.G, C.bid, 2, 512);
    EpiBall E{ws + WS_BALL};
    gemm_phase<EpiBall, StaticOrder, false>(C.lds, C.tid, g, S, E); }
__device__ __forceinline__ void P_gemm_gate(int wv) { const Ctx C = make_ctx(wv); using namespace pg8; unsigned char* ws = C.ws;
    Gemm g{(const bf16*)(ws + WS_H8), (const bf16*)(ws + WS_WG), D, D}; StaticOrder S; S.init(T, 4096, C.G, C.bid);
    EpiGateMerge E{(const bf16*)(ws + WS_BALL), (bf16*)(ws + WS_MERGED)};
    gemm_phase8<EpiGateMerge, StaticOrder, true>(C.lds, C.tid, g, S, E); }
__device__ __forceinline__ void P_gemm_out(int wv) { const Ctx C = make_ctx(wv); using namespace pg8; unsigned char* ws = C.ws;
    Gemm g{(const bf16*)(ws + WS_MERGED), (const bf16*)(ws + WS_WOUT), D, D}; StaticOrder S; S.init(T, D, C.G, C.bid);
    EpiResidual E{(bf16*)(ws + WS_XB), 1.0f};
    gemm_phase<EpiResidual, StaticOrder, true, 1>(C.lds, C.tid, g, S, E); }
__device__ __forceinline__ void P_norm_ffn(int wv, int l) { const Ctx C = make_ctx(wv); ph_norm_(C, C.in[I_NORM_FFN] + (size_t)l * D, (l & 1) != 0, C.in[I_ROUTER] + (size_t)(l >> 1) * D * NEXP, l >> 1, false, nullptr,  false); }
__device__ __forceinline__ void P_ffn_up(int wv) { const Ctx C = make_ctx(wv); using namespace pg8; unsigned char* ws = C.ws;
    Gemm g{(const bf16*)(ws + WS_H8), (const bf16*)(ws + WS_W13), D, D}; StaticOrder S; S.init(T, 2 * DFF, C.G, C.bid);
    EpiSwiglu E{ws + WS_HID, DFF, 1 << 20, false};
    gemm_phase8<EpiSwiglu, StaticOrder, true>(C.lds, C.tid, g, S, E); }
__device__ __forceinline__ void P_ffn_down(int wv) { const Ctx C = make_ctx(wv); using namespace pg8; unsigned char* ws = C.ws;
    Gemm g{(const bf16*)(ws + WS_HID), (const bf16*)(ws + WS_W2D), DFF, DFF}; StaticOrder S; S.init(T, D, C.G, C.bid);
    EpiResidual E{(bf16*)(ws + WS_XB), F8_DESCALE_DOWN};
    gemm_phase8<EpiResidual, StaticOrder, true, 1>(C.lds, C.tid, g, S, E); }
__device__ __forceinline__ void P_moe_scatter(int wv, int l2) { const Ctx C = make_ctx(wv); ph_moe_scatter_(C, l2); }
__device__ __forceinline__ void P_moe_up(int wv) { const Ctx C = make_ctx(wv); using namespace pg8; unsigned char* ws = C.ws;
    Gemm g{(const bf16*)(ws + WS_XS), (const bf16*)(ws + WS_W13), D, D};
    MoeOrder S{(const int*)(ws + WS_TEXP), __builtin_amdgcn_readfirstlane(*(const int*)(ws + WS_NT)), 2 * DFE / 256, C.G, C.bid};
    EpiSwiglu E{ws + WS_HIDM, DFE_PAD, 2 * DFE / 256, true};
    gemm_phase8<EpiSwiglu, MoeOrder, true>(C.lds, C.tid, g, S, E); }
__device__ __forceinline__ void P_moe_down(int wv) { const Ctx C = make_ctx(wv); using namespace pg8; unsigned char* ws = C.ws;
    Gemm g{(const bf16*)(ws + WS_HIDM), (const bf16*)(ws + WS_W2M), DFE_PAD, DFE_PAD};
    MoeOrder S{(const int*)(ws + WS_TEXP), __builtin_amdgcn_readfirstlane(*(const int*)(ws + WS_NT)), D / 256, C.G, C.bid};
    EpiBf16 E{(bf16*)(ws + WS_YS), D, 3, F8_DESCALE_DOWN};
    gemm_phase8<EpiBf16, MoeOrder, true, 1>(C.lds, C.tid, g, S, E); }
__device__ __forceinline__ void P_moe_combine(int wv) { const Ctx C = make_ctx(wv);
    const int gw = C.bid * NWAVES + C.wave, NGW = C.G * NWAVES, lane = C.lane;
    const int* slotof = (const int*)(C.ws + WS_SLOTOF); const float* gate = (const float*)(C.ws + WS_GATE); const bf16* YS = (const bf16*)(C.ws + WS_YS); const bf16* XB = (const bf16*)(C.ws + WS_XB);
    constexpr int NRC = 4;
    for (int mb = gw; mb < T; mb += NRC * NGW) {
        int s0[NRC], s1[NRC]; float g0[NRC], g1[NRC]; u32x4 x[NRC][2], ya[NRC][2], yb[NRC][2];
#pragma unroll
        for (int r = 0; r < NRC; ++r) { const int m = mb + r * NGW < T ? mb + r * NGW : T - 1; s0[r] = slotof[2 * m]; s1[r] = slotof[2 * m + 1]; g0[r] = gate[2 * m]; g1[r] = gate[2 * m + 1];
            const u32x4* xb = (const u32x4*)(XB + (size_t)m * D) + lane; x[r][0] = xb[0]; x[r][1] = xb[64]; }
#pragma unroll
        for (int r = 0; r < NRC; ++r) { const u32x4* y0 = (const u32x4*)(YS + (size_t)s0[r] * D) + lane; const u32x4* y1 = (const u32x4*)(YS + (size_t)s1[r] * D) + lane;
            ya[r][0] = y0[0]; ya[r][1] = y0[64]; yb[r][0] = y1[0]; yb[r][1] = y1[64]; }
#pragma unroll
        for (int r = 0; r < NRC; ++r) { const int m = mb + r * NGW; if (m < T) { f32x4* xo = (f32x4*)(C.out + (size_t)m * D + 8 * lane); const float G0 = g0[r], G1 = g1[r];
#pragma unroll
            for (int j = 0; j < 2; ++j) { const u32x4 xx = x[r][j], a = ya[r][j], b = yb[r][j]; f32x4 v0, v1;
                v0.x = bflo(xx.x) + G0 * bflo(a.x) + G1 * bflo(b.x); v0.y = bfhi(xx.x) + G0 * bfhi(a.x) + G1 * bfhi(b.x); v0.z = bflo(xx.y) + G0 * bflo(a.y) + G1 * bflo(b.y); v0.w = bfhi(xx.y) + G0 * bfhi(a.y) + G1 * bfhi(b.y);
                v1.x = bflo(xx.z) + G0 * bflo(a.z) + G1 * bflo(b.z); v1.y = bfhi(xx.z) + G0 * bfhi(a.z) + G1 * bfhi(b.z); v1.z = bflo(xx.w) + G0 * bflo(a.w) + G1 * bflo(b.w); v1.w = bfhi(xx.w) + G0 * bfhi(a.w) + G1 * bfhi(b.w);
                xo[128 * j] = v0; xo[128 * j + 1] = v1; } } }
    }
}

#ifndef PROBE_MASK
#define PROBE_MASK 0u
#endif
#ifndef PH_MASK
#define PH_MASK 0xffffffffu
#endif
__global__ void __launch_bounds__(NTHR, 2) hybrid_fwd(Args args) {
    (void)args;
    const int wv = __builtin_amdgcn_readfirstlane(threadIdx.x >> 6);
    { LAS unsigned char* lds = (LAS unsigned char*)lds_raw;
      for (int u = threadIdx.x; u < (LDS_BYTES - RING_BYTES) / 4; u += NTHR) ((LAS unsigned*)(lds + RING_BYTES))[u] = 0u; }
    __syncthreads();
    { const CAS Args* ka = ka_ptr();
      if (ka->ph_hi - ka->ph_lo > 1) { (void)xcd_barrier_post((unsigned*)(ka->ws + WS_CTL) + CW_BAR, (volatile LAS unsigned*)((LAS unsigned char*)lds_raw + MISC_OFF) + 8); } }
    int gp = 0;
#define PHASE(k, call) { const CAS Args* ka_ = ka_ptr(); const int lo_ = ka_->ph_lo, hi_ = ka_->ph_hi; if (lo_ <= gp && gp < hi_) { if constexpr ((PH_MASK >> (k)) & 1u) { call; if constexpr ((PROBE_MASK >> (k)) & 1u) { __syncthreads(); call; } } if (hi_ - lo_ > 1 && gp + 1 < hi_) grid_barrier(wv); } ++gp; }
    PHASE(0, P_prologue(wv))
#pragma unroll 1
    for (int l = 0; l < NLAYER; ++l) {
        PHASE(1, P_weights_norm(wv, l))
        PHASE(2, P_gemm_in(wv, l))
        PHASE(3, P_mix1(wv, l))
        PHASE(4, P_mix2(wv, l))
        PHASE(5, P_mix3(wv, l))
        PHASE(6, P_mix4(wv, l))
        ++gp;
        PHASE(8, P_gemm_branch(wv))
        PHASE(9, P_gemm_gate(wv))
        PHASE(10, P_gemm_out(wv))
        PHASE(11, P_norm_ffn(wv, l))
        if (!(l & 1)) {
            PHASE(12, P_ffn_up(wv))
            PHASE(13, P_ffn_down(wv))
            gp += 2;
        } else {
            PHASE(14, P_moe_scatter(wv, l >> 1))
            PHASE(15, P_moe_up(wv))
            PHASE(16, P_moe_down(wv))
            if (l == NLAYER - 1) { PHASE(17, P_moe_combine(wv)) } else { ++gp; }
        }
    }
#undef PHASE
}
constexpr int N_PHASES = 1 + NLAYER * 15;

#ifndef MK_MULTI
#define MK_MULTI 0
#endif
extern "C" void kernel_launch(void* const* d_in, const int* in_sizes, int n_in, void* d_out, int out_size, void* d_ws, size_t ws_size, hipStream_t stream) {
    static int grid = 0;
    if (grid == 0) {
        if (n_in != 32 || in_sizes[0] != T * D || out_size != T * D || ws_size < WS_END) { fprintf(stderr, "kernel_launch: unexpected problem shape / workspace (%d inputs, ws %zu)\n", n_in, ws_size); grid = -1; return; }
        int dev = 0, cus = 0, per_cu = 0;
        if (hipGetDevice(&dev) != hipSuccess || hipDeviceGetAttribute(&cus, hipDeviceAttributeMultiprocessorCount, dev) != hipSuccess) { grid = -1; return; }
        if (hipFuncSetAttribute((const void*)hybrid_fwd, hipFuncAttributeMaxDynamicSharedMemorySize, LDS_BYTES) != hipSuccess) { fprintf(stderr, "kernel_launch: hipFuncSetAttribute failed\n"); grid = -1; return; }
        if (hipOccupancyMaxActiveBlocksPerMultiprocessor(&per_cu, (const void*)hybrid_fwd, NTHR, LDS_BYTES) != hipSuccess || per_cu < 1) { fprintf(stderr, "kernel_launch: occupancy query says %d\n", per_cu); }
        (void)hipGetLastError();
        grid = cus;
    }
    if (grid < 0) return;
    (void)hipMemsetAsync((char*)d_ws + WS_CTL, 0, CTL_ZERO_BYTES, stream);
#ifdef DBG_ZERO_WS
    (void)hipMemsetAsync((char*)d_ws + CTL_ZERO_BYTES, 0, WS_END - CTL_ZERO_BYTES, stream);
#endif
    Args a{};
    for (int i = 0; i < 32; ++i) a.in[i] = (const float*)d_in[i];
    a.out = (float*)d_out; a.ws = (unsigned char*)d_ws;
#if MK_MULTI
    for (int p = 0; p < N_PHASES; ++p) { a.ph_lo = p; a.ph_hi = p + 1; hipLaunchKernelGGL(hybrid_fwd, dim3(grid), dim3(NTHR), LDS_BYTES, stream, a); }
#else
    a.ph_lo = 0; a.ph_hi = N_PHASES; hipLaunchKernelGGL(hybrid_fwd, dim3(grid), dim3(NTHR), LDS_BYTES, stream, a);
#endif
}
```

```cpp
#include <hip/hip_runtime.h>
#include <cstdio>
#include <cstdint>

#define GAS __attribute__((address_space(1)))
#define LAS __attribute__((address_space(3)))
typedef unsigned short bf16;
typedef unsigned u32x4 __attribute__((ext_vector_type(4)));
typedef unsigned u32x2 __attribute__((ext_vector_type(2)));
typedef float f32x4 __attribute__((ext_vector_type(4)));
typedef float f32x2 __attribute__((ext_vector_type(2)));
typedef short bf16x8 __attribute__((ext_vector_type(8)));
typedef float f32x16 __attribute__((ext_vector_type(16)));
typedef short s16x4 __attribute__((ext_vector_type(4)));

constexpr int SEQ = 16384, NBATCH = 2, T = NBATCH * SEQ, D = 1024, NIN = 3328, DFF = 2816, DFE = 1408, NEXP = 8, NLAYER = 4;
constexpr int MPAD = 2 * T + NEXP * 256;
constexpr int NWAVES = 8, NTHR = 512;
constexpr float LOG2E = 1.4426950408889634f;
constexpr int MM_LP = 72;

typedef __bf16 bf16x2_t __attribute__((ext_vector_type(2)));
__device__ __forceinline__ unsigned cvt_pk_bf16(float lo, float hi) { const f32x2 v = {lo, hi}; const bf16x2_t b = __builtin_convertvector(v, bf16x2_t); return __builtin_bit_cast(unsigned, b); }
__device__ __forceinline__ float bflo(unsigned u) { return __builtin_bit_cast(float, u << 16); }
__device__ __forceinline__ float bfhi(unsigned u) { return __builtin_bit_cast(float, u & 0xffff0000u); }
__device__ __forceinline__ float bf2f(bf16 u) { return __builtin_bit_cast(float, (unsigned)u << 16); }
__device__ __forceinline__ bf16 f2bf(float f) { return (bf16)(cvt_pk_bf16(f, 0.f) & 0xffffu); }
__device__ __forceinline__ float sigm(float x) { return __builtin_amdgcn_rcpf(1.f + __builtin_amdgcn_exp2f(-x * LOG2E)); }
__device__ __forceinline__ float shx(float v, int o, int lane) { return __builtin_bit_cast(float, __builtin_amdgcn_ds_bpermute((lane ^ o) << 2, __builtin_bit_cast(int, v))); }
__device__ __forceinline__ float dpp_add(float v, const int ctrl_id) {
    const int x = __builtin_bit_cast(int, v);
    int y;
    if (ctrl_id == 0) y = __builtin_amdgcn_update_dpp(0, x, 0xB1, 0xF, 0xF, true);
    else if (ctrl_id == 1) y = __builtin_amdgcn_update_dpp(0, x, 0x4E, 0xF, 0xF, true);
    else if (ctrl_id == 2) y = __builtin_amdgcn_update_dpp(0, x, 0x141, 0xF, 0xF, true);
    else y = __builtin_amdgcn_update_dpp(0, x, 0x140, 0xF, 0xF, true);
    return v + __builtin_bit_cast(float, y);
}
__device__ __forceinline__ float wave_sum(float v, int lane) {
    (void)lane;
    v = dpp_add(v, 0); v = dpp_add(v, 1); v = dpp_add(v, 2); v = dpp_add(v, 3);
    const int x = __builtin_bit_cast(int, v);
    const float s0 = __builtin_bit_cast(float, __builtin_amdgcn_readlane(x, 0)), s1 = __builtin_bit_cast(float, __builtin_amdgcn_readlane(x, 16)),
                s2 = __builtin_bit_cast(float, __builtin_amdgcn_readlane(x, 32)), s3 = __builtin_bit_cast(float, __builtin_amdgcn_readlane(x, 48));
    return (s0 + s1) + (s2 + s3);
}
__device__ __forceinline__ void unpack8(const u32x4 v, float* f) {
    f[0] = bflo(v.x); f[1] = bfhi(v.x); f[2] = bflo(v.y); f[3] = bfhi(v.y); f[4] = bflo(v.z); f[5] = bfhi(v.z); f[6] = bflo(v.w); f[7] = bfhi(v.w);
}
__device__ __forceinline__ unsigned pk4_fp8(float a, float b, float c, float d) {
    a = __builtin_amdgcn_fmed3f(a, -440.f, 440.f); b = __builtin_amdgcn_fmed3f(b, -440.f, 440.f); c = __builtin_amdgcn_fmed3f(c, -440.f, 440.f); d = __builtin_amdgcn_fmed3f(d, -440.f, 440.f);
    int w = __builtin_amdgcn_cvt_pk_fp8_f32(a, b, 0, false); w = __builtin_amdgcn_cvt_pk_fp8_f32(c, d, w, true); return (unsigned)w; }
__device__ __forceinline__ u32x4 pack8(const float* f) {
    u32x4 w; w.x = cvt_pk_bf16(f[0], f[1]); w.y = cvt_pk_bf16(f[2], f[3]); w.z = cvt_pk_bf16(f[4], f[5]); w.w = cvt_pk_bf16(f[6], f[7]); return w;
}


#ifndef PROBE2
#define PROBE2 0
#endif
#ifndef GMASK
#define GMASK 15
#endif
#ifndef RWDBG
#define RWDBG 0
#endif
typedef int i32x8 __attribute__((ext_vector_type(8)));
constexpr float F8_MUL_X = 16.f, F8_MUL_W = 256.f, F8_DESCALE = 1.0f / (16.f * 256.f), F8_MUL_H = 4.f, F8_DESCALE_DOWN = 1.0f / (4.f * 256.f);
constexpr int DFE_PAD = 1536;
namespace pg8 {
typedef unsigned short bf16_t;
constexpr int BM = 256, BK = 64, HALF = 128, HTB = HALF * BK * 2, NXCD = 8, WGM = 8;
__host__ __device__ __forceinline__ int lds_byte(int r, int c) { const int st = (r >> 4) * 2 + (c >> 5), rr = r & 15, cc = c & 31, ob = rr * 64 + cc * 2; return st * 1024 + (ob ^ (((ob >> 9) & 1) << 5)); }
__host__ __device__ __forceinline__ void stage_rc(int b, int& R, int& C) { const int st = b / 1024, sb = b % 1024, swz = sb ^ (((sb >> 9) & 1) << 5); R = (st >> 1) * 16 + swz / 64; C = (st & 1) * 32 + (swz % 64) / 2; }
__host__ __device__ __forceinline__ int perm32(int rho) { const int n = rho >> 4, i = rho & 15; return 8 * (i >> 2) + 4 * n + (i & 3); }

struct Unit { int pm, pn, aoff; };
struct Gemm { const bf16_t* A; const bf16_t* Bt; int lda, K; };

struct StaticOrder {
    int nM, nN, nwg, G, c, ashift, amul;
    __device__ void init(int M, int N, int G_, int c_, int ashift_ = 0, int amul_ = 0) { nM = M / BM; nN = N / BM; nwg = nM * nN; G = G_; c = c_; ashift = ashift_; amul = amul_; }
    __device__ bool next(int i, Unit& u) const {
        const long L = (long)i * G + c; if (L >= nwg) return false;
        int wgid = (int)L; { const int q = nwg / NXCD, r = nwg % NXCD, xcd = wgid % NXCD, off = wgid / NXCD; wgid = (xcd < r ? xcd * (q + 1) : r * (q + 1) + (xcd - r) * q) + off; }
        const int nig = WGM * nN, gid = wgid / nig, fm = gid * WGM, gsz = (nM - fm) < WGM ? (nM - fm) : WGM;
        u.pm = fm + ((wgid % nig) % gsz); u.pn = (wgid % nig) / gsz; u.aoff = (u.pn >> ashift) * amul; return true;
    }
};
struct MoeOrder {
    const int* texp; int ntiles, ncol, G, c;
    __device__ bool next(int i, Unit& u) const {
        const int L = i * G + c; if (L >= ntiles * ncol) return false;
        const int pm = L / ncol, pl = L % ncol;
        u.pm = pm; u.pn = texp[pm] * ncol + pl; u.aoff = 0; return true;
    }
};

template <class Epi, class Sched, bool ALIGN_EPI, int CMAP = 0>
__device__ __forceinline__ void gemm_phase(LAS unsigned char* lds, const int tid_in, const Gemm g, const Sched& S, const Epi& E) {
    const int tid = tid_in, wid = __builtin_amdgcn_readfirstlane(tid >> 6), lane = tid & 63, wr = wid >> 2, wc = wid & 3, fr = lane & 15, fq = lane >> 4;
    const int K = g.K, nt = K / BK, lda = g.lda;
    unsigned voffA[2], voffB[2];
#pragma unroll
    for (int i = 0; i < 2; ++i) { int R, C; stage_rc(tid * 16 + i * 8192, R, C); const int p32 = perm32(R & 31); const int Rb = CMAP ? 64 * (R >> 5) + 16 * (p32 >> 3) + (p32 & 7) : (R & ~31) + p32;
        voffA[i] = (unsigned)(R * lda + C) * 2u; voffB[i] = (unsigned)(Rb * K + C) * 2u; }
    const size_t kstep = (size_t)(BK * 2);
    const size_t hstepA = (size_t)HALF * lda * 2, tstepA = 2 * hstepA, hstepB = (size_t)(CMAP ? 8 : HALF) * K * 2, tstepB = (size_t)BM * K * 2;
    const unsigned ldsw = (unsigned)wid * 1024u;
    const int aoff = lds_byte(wr * 64 + fr, fq * 8), boff = lds_byte(wc * 32 + fr, fq * 8);
#define PG8_SA(b, h) (((b) * 2 + (h)) * HTB)
#define PG8_SB(b, h) ((4 + (b) * 2 + (h)) * HTB)
#define PG8_STAGE(bufoff, gbase, voff) do { _Pragma("unroll") for (int _i = 0; _i < 2; ++_i) \
        __builtin_amdgcn_global_load_lds((const unsigned*)((const char*)(gbase) + (voff)[_i]), (LAS unsigned*)(lds + (bufoff) + ldsw + _i * 8192), 16, 0, 0); } while (0)
#define PG8_LDA(dst, b, h) do { _Pragma("unroll") for (int m = 0; m < 4; ++m) _Pragma("unroll") for (int k = 0; k < 2; ++k) dst[m][k] = *(const LAS bf16x8*)(lds + PG8_SA(b, h) + aoff + m * 2048 + k * 1024); } while (0)
#define PG8_LDB(dst, b, h) do { _Pragma("unroll") for (int n = 0; n < 2; ++n) _Pragma("unroll") for (int k = 0; k < 2; ++k) dst[n][k] = *(const LAS bf16x8*)(lds + PG8_SB(b, h) + boff + n * 2048 + k * 1024); } while (0)
#define PG8_MMA(ai, bj, At, Bt) do { __builtin_amdgcn_s_setprio(1); _Pragma("unroll") for (int m = 0; m < 4; ++m) _Pragma("unroll") for (int n = 0; n < 2; ++n) _Pragma("unroll") for (int k = 0; k < 2; ++k) \
        acc[ai][bj][m][n] = __builtin_amdgcn_mfma_f32_16x16x32_bf16(Bt[n][k], At[m][k], acc[ai][bj][m][n], 0, 0, 0); __builtin_amdgcn_s_setprio(0); } while (0)
#define PG8_WAIT_V(n) asm volatile("s_waitcnt vmcnt(" #n ")" ::: "memory")
#define PG8_WAIT_L(n) asm volatile("s_waitcnt lgkmcnt(" #n ")" ::: "memory")
#define PG8_BAR __builtin_amdgcn_s_barrier()
#define PG8_SCHED __builtin_amdgcn_sched_barrier(0)
    Unit cur, nxt; int ui = 0;
    if (!S.next(0, cur)) return;
    f32x4 acc[2][2][4][2];
#pragma unroll
    for (int a = 0; a < 2; ++a)
#pragma unroll
        for (int b = 0; b < 2; ++b)
#pragma unroll
            for (int m = 0; m < 4; ++m)
#pragma unroll
                for (int n = 0; n < 2; ++n) acc[a][b][m][n] = (f32x4){0.f, 0.f, 0.f, 0.f};
    bf16x8 At[4][2], B0[2][2], B1[2][2];
    const char* cA = (const char*)g.A + (size_t)cur.pm * tstepA + cur.aoff; const char* cB = (const char*)g.Bt + (size_t)cur.pn * tstepB;
    PG8_STAGE(PG8_SB(0, 0), cB, voffB); PG8_STAGE(PG8_SB(0, 1), cB + hstepB, voffB); PG8_STAGE(PG8_SA(0, 0), cA, voffA); PG8_STAGE(PG8_SA(0, 1), cA + hstepA, voffA);
    if (wr == 1) PG8_BAR;
    PG8_WAIT_V(2); PG8_BAR;
    PG8_STAGE(PG8_SB(1, 0), cB + kstep, voffB); PG8_STAGE(PG8_SA(1, 0), cA + kstep, voffA); PG8_STAGE(PG8_SB(1, 1), cB + hstepB + kstep, voffB);
    PG8_WAIT_V(6); PG8_BAR;
    for (;;) {
        const bool has_next = S.next(ui + 1, nxt);
        const char* nA = has_next ? (const char*)g.A + (size_t)nxt.pm * tstepA + nxt.aoff : cA; const char* nB = has_next ? (const char*)g.Bt + (size_t)nxt.pn * tstepB : cB;
#pragma unroll 1
        for (int t = 0; t < nt; t += 2) {
            const bool last = (t == nt - 2);
            const char* a1 = cA + (size_t)(t + 1) * kstep;
            const char* a2 = last ? nA : cA + (size_t)(t + 2) * kstep; const char* b2 = last ? nB : cB + (size_t)(t + 2) * kstep;
            const char* a3 = a2 + kstep; const char* b3 = b2 + kstep;
            PG8_LDB(B0, 0, 0); PG8_LDB(B1, 0, 1); PG8_SCHED; PG8_LDA(At, 0, 0); PG8_STAGE(PG8_SA(1, 1), a1 + hstepA, voffA);
            PG8_WAIT_V(8); PG8_WAIT_L(0); PG8_BAR; PG8_MMA(0, 0, At, B0); PG8_MMA(0, 1, At, B1); PG8_BAR; PG8_SCHED;
            PG8_LDA(At, 0, 1); PG8_STAGE(PG8_SB(0, 0), b2, voffB); PG8_STAGE(PG8_SB(0, 1), b2 + hstepB, voffB); PG8_STAGE(PG8_SA(0, 0), a2, voffA);
            PG8_WAIT_V(8); PG8_WAIT_L(0); PG8_BAR; PG8_MMA(1, 0, At, B0); PG8_MMA(1, 1, At, B1); PG8_BAR; PG8_SCHED;
            PG8_LDB(B0, 1, 0); PG8_LDB(B1, 1, 1); PG8_SCHED; PG8_LDA(At, 1, 0); PG8_STAGE(PG8_SA(0, 1), a2 + hstepA, voffA);
            PG8_WAIT_V(8); PG8_WAIT_L(0); PG8_BAR; PG8_MMA(0, 0, At, B0); PG8_MMA(0, 1, At, B1); PG8_BAR; PG8_SCHED;
            PG8_LDA(At, 1, 1); PG8_STAGE(PG8_SB(1, 0), b3, voffB); PG8_STAGE(PG8_SB(1, 1), b3 + hstepB, voffB); PG8_STAGE(PG8_SA(1, 0), a3, voffA);
            PG8_WAIT_V(8); PG8_WAIT_L(0); PG8_BAR; PG8_MMA(1, 0, At, B0); PG8_MMA(1, 1, At, B1); PG8_BAR; PG8_SCHED;
        }
        if constexpr (ALIGN_EPI) { if (wr == 0) PG8_BAR; }
        { int ln_; asm volatile("v_mbcnt_lo_u32_b32 %0, -1, 0\n\tv_mbcnt_hi_u32_b32 %0, -1, %0" : "=v"(ln_)); E(acc, cur, wr, wc, ln_ & 15, ln_ >> 4); }
        if (!has_next) break;
#pragma unroll
        for (int a = 0; a < 2; ++a)
#pragma unroll
            for (int b = 0; b < 2; ++b)
#pragma unroll
                for (int m = 0; m < 4; ++m)
#pragma unroll
                    for (int n = 0; n < 2; ++n) acc[a][b][m][n] = (f32x4){0.f, 0.f, 0.f, 0.f};
        cur = nxt; cA = nA; cB = nB; ++ui;
        if constexpr (ALIGN_EPI) { if (wr == 1) PG8_BAR; }
    }
    PG8_WAIT_V(0);
    if constexpr (!ALIGN_EPI) { if (wr == 0) PG8_BAR; }
    PG8_BAR;
#undef PG8_SA
#undef PG8_SB
#undef PG8_STAGE
#undef PG8_LDA
#undef PG8_LDB
#undef PG8_MMA
#undef PG8_WAIT_V
#undef PG8_WAIT_L
#undef PG8_BAR
#undef PG8_SCHED
}

template <class Epi, class Sched, bool ALIGN_EPI, int CMAP = 0>
__device__ __forceinline__ void gemm_phase8(LAS unsigned char* lds, const int tid_in, const Gemm g, const Sched& S, const Epi& E) {
    const int tid = tid_in, wid = __builtin_amdgcn_readfirstlane(tid >> 6), lane = tid & 63, wr = wid >> 2, wc = wid & 3, fr = lane & 15, fq = lane >> 4;
    const int K = g.K, nt = K / 128, lda = g.lda;
    unsigned voffA, voffB;
    { int R, C; stage_rc(tid * 16, R, C); const int p32 = perm32(R & 31); const int Rb = CMAP ? 64 * (R >> 5) + 16 * (p32 >> 3) + (p32 & 7) : (R & ~31) + p32; voffA = (unsigned)(R * lda + C * 2); voffB = (unsigned)(Rb * K + C * 2); }
    const unsigned pstepA = 64u * (unsigned)lda, pstepB = (CMAP ? 128u : 64u) * (unsigned)K;
    const unsigned kstep = (unsigned)(BK * 2);
    const unsigned hstepA = (unsigned)HALF * (unsigned)lda, tstepA = 2 * hstepA, hstepB = (unsigned)(CMAP ? 8 : HALF) * (unsigned)K, tstepB = (unsigned)BM * (unsigned)K;
    const __amdgpu_buffer_rsrc_t rsA = __builtin_amdgcn_make_buffer_rsrc((void*)g.A, 0, 0x7fffffff, 0x00020000), rsB = __builtin_amdgcn_make_buffer_rsrc((void*)g.Bt, 0, 0x7fffffff, 0x00020000);
    const unsigned ldsw = (unsigned)wid * 1024u;
    const int aoff0 = lds_byte(wr * 64 + fr, fq * 8), aoff1 = aoff0 + 1024, boff0 = lds_byte(wc * 32 + fr, fq * 8), boff1 = boff0 + 1024;
#define PG8_SA(b, h) (((b) * 2 + (h)) * HTB)
#define PG8_SB(b, h) ((4 + (b) * 2 + (h)) * HTB)
#define PG8_STAGE(bufoff, goff, voff, pstep) do { _Pragma("unroll") for (int _i = 0; _i < 2; ++_i) \
        __builtin_amdgcn_raw_ptr_buffer_load_lds(PG8_RS_##voff, (LAS unsigned*)(lds + (bufoff) + ldsw + _i * 8192), 16, (int)(voff), (int)((goff) + _i * (pstep)), 0, 0); } while (0)
#define PG8_RS_voffA rsA
#define PG8_RS_voffB rsB
#define PG8_LDA(dst, b, h) do { _Pragma("unroll") for (int m = 0; m < 4; ++m) { dst[m][0] = *(const LAS u32x4*)(lds + PG8_SA(b, h) + aoff0 + m * 2048); dst[m][1] = *(const LAS u32x4*)(lds + PG8_SA(b, h) + aoff1 + m * 2048); } } while (0)
#define PG8_LDB(dst, b, h) do { _Pragma("unroll") for (int n = 0; n < 2; ++n) { dst[n][0] = *(const LAS u32x4*)(lds + PG8_SB(b, h) + boff0 + n * 2048); dst[n][1] = *(const LAS u32x4*)(lds + PG8_SB(b, h) + boff1 + n * 2048); } } while (0)
#define PG8_J8(x) __builtin_bit_cast(i32x8, __builtin_shufflevector((x)[0], (x)[1], 0, 1, 2, 3, 4, 5, 6, 7))
#define PG8_MMA(ai, bj, At, Bt) do { __builtin_amdgcn_s_setprio(1); _Pragma("unroll") for (int m = 0; m < 4; ++m) _Pragma("unroll") for (int n = 0; n < 2; ++n) \
        acc[ai][bj][m][n] = __builtin_amdgcn_mfma_scale_f32_16x16x128_f8f6f4(PG8_J8(Bt[n]), PG8_J8(At[m]), acc[ai][bj][m][n], 0, 0, 0, 0, 0, 0);        __builtin_amdgcn_s_setprio(0); } while (0)
#define PG8_WAIT_V(n) asm volatile("s_waitcnt vmcnt(" #n ")" ::: "memory")
#define PG8_WAIT_L(n) asm volatile("s_waitcnt lgkmcnt(" #n ")" ::: "memory")
#define PG8_BAR __builtin_amdgcn_s_barrier()
#define PG8_SCHED __builtin_amdgcn_sched_barrier(0)
    Unit cur, nxt; int ui = 0;
    if (!S.next(0, cur)) return;
    f32x4 acc[2][2][4][2];
#pragma unroll
    for (int a = 0; a < 2; ++a)
#pragma unroll
        for (int b = 0; b < 2; ++b)
#pragma unroll
            for (int m = 0; m < 4; ++m)
#pragma unroll
                for (int n = 0; n < 2; ++n) acc[a][b][m][n] = (f32x4){0.f, 0.f, 0.f, 0.f};
    u32x4 At[4][2], B0[2][2], B1[2][2];
    unsigned cA = (unsigned)cur.pm * tstepA + (unsigned)cur.aoff, cB = (unsigned)cur.pn * tstepB;
    PG8_STAGE(PG8_SB(0, 0), cB, voffB, pstepB); PG8_STAGE(PG8_SB(0, 1), cB + hstepB, voffB, pstepB); PG8_STAGE(PG8_SA(0, 0), cA, voffA, pstepA); PG8_STAGE(PG8_SA(0, 1), cA + hstepA, voffA, pstepA);
    if (wr == 1) PG8_BAR;
    PG8_WAIT_V(2); PG8_BAR;
    PG8_STAGE(PG8_SB(1, 0), cB + kstep, voffB, pstepB); PG8_STAGE(PG8_SA(1, 0), cA + kstep, voffA, pstepA); PG8_STAGE(PG8_SB(1, 1), cB + hstepB + kstep, voffB, pstepB);
    PG8_WAIT_V(6); PG8_BAR;
    for (;;) {
        const bool has_next = S.next(ui + 1, nxt);
        const unsigned nA = has_next ? (unsigned)nxt.pm * tstepA + (unsigned)nxt.aoff : cA, nB = has_next ? (unsigned)nxt.pn * tstepB : cB;
#pragma unroll 1
        for (int t = 0; t < nt; t += 2) {
            const bool last = (t == nt - 2);
            const unsigned a1 = cA + (unsigned)(t + 1) * kstep;
            const unsigned a2 = last ? nA : cA + (unsigned)(t + 2) * kstep, b2 = last ? nB : cB + (unsigned)(t + 2) * kstep;
            const unsigned a3 = a2 + kstep, b3 = b2 + kstep;
            PG8_LDB(B0, 0, 0); PG8_LDB(B1, 0, 1); PG8_SCHED; PG8_LDA(At, 0, 0); PG8_STAGE(PG8_SA(1, 1), a1 + hstepA, voffA, pstepA);
            PG8_WAIT_V(8); PG8_WAIT_L(0); PG8_BAR; PG8_MMA(0, 0, At, B0); PG8_MMA(0, 1, At, B1); PG8_BAR; PG8_SCHED;
            PG8_LDA(At, 0, 1); PG8_STAGE(PG8_SB(0, 0), b2, voffB, pstepB); PG8_STAGE(PG8_SB(0, 1), b2 + hstepB, voffB, pstepB); PG8_STAGE(PG8_SA(0, 0), a2, voffA, pstepA);
            PG8_WAIT_V(8); PG8_WAIT_L(0); PG8_BAR; PG8_MMA(1, 0, At, B0); PG8_MMA(1, 1, At, B1); PG8_BAR; PG8_SCHED;
            PG8_LDB(B0, 1, 0); PG8_LDB(B1, 1, 1); PG8_SCHED; PG8_LDA(At, 1, 0); PG8_STAGE(PG8_SA(0, 1), a2 + hstepA, voffA, pstepA);
            PG8_WAIT_V(8); PG8_WAIT_L(0); PG8_BAR; PG8_MMA(0, 0, At, B0); PG8_MMA(0, 1, At, B1); PG8_BAR; PG8_SCHED;
            PG8_LDA(At, 1, 1); PG8_STAGE(PG8_SB(1, 0), b3, voffB, pstepB); PG8_STAGE(PG8_SB(1, 1), b3 + hstepB, voffB, pstepB); PG8_STAGE(PG8_SA(1, 0), a3, voffA, pstepA);
            PG8_WAIT_V(8); PG8_WAIT_L(0); PG8_BAR; PG8_MMA(1, 0, At, B0); PG8_MMA(1, 1, At, B1); PG8_BAR; PG8_SCHED;
        }
        if constexpr (ALIGN_EPI) { if (wr == 0) PG8_BAR; }
        { int ln_; asm volatile("v_mbcnt_lo_u32_b32 %0, -1, 0\n\tv_mbcnt_hi_u32_b32 %0, -1, %0" : "=v"(ln_)); E(acc, cur, wr, wc, ln_ & 15, ln_ >> 4); }
        if (!has_next) break;
#pragma unroll
        for (int a = 0; a < 2; ++a)
#pragma unroll
            for (int b = 0; b < 2; ++b)
#pragma unroll
                for (int m = 0; m < 4; ++m)
#pragma unroll
                    for (int n = 0; n < 2; ++n) acc[a][b][m][n] = (f32x4){0.f, 0.f, 0.f, 0.f};
        cur = nxt; cA = nA; cB = nB; ++ui;
        if constexpr (ALIGN_EPI) { if (wr == 1) PG8_BAR; }
    }
    PG8_WAIT_V(0);
    if constexpr (!ALIGN_EPI) { if (wr == 0) PG8_BAR; }
    PG8_BAR;
#undef PG8_SA
#undef PG8_SB
#undef PG8_STAGE
#undef PG8_RS_voffA
#undef PG8_RS_voffB
#undef PG8_LDA
#undef PG8_LDB
#undef PG8_MMA
#undef PG8_J8
#undef PG8_WAIT_V
#undef PG8_WAIT_L
#undef PG8_BAR
#undef PG8_SCHED
}

typedef f32x4 Acc[2][2][4][2];

__device__ __forceinline__ unsigned dpp_ror8(unsigned v) { return (unsigned)__builtin_amdgcn_update_dpp(0, (int)v, 0x128, 0xf, 0xf, false); }
struct CmPair { unsigned a, b; };
__device__ __forceinline__ CmPair cm_swapv(bool lo, unsigned x0, unsigned x1) { const unsigned r = dpp_ror8(lo ? x1 : x0); CmPair o; o.a = lo ? x0 : r; o.b = lo ? r : x1; return o; }
#define CM_SWAP_U(lo, X0, X1) do { const CmPair r_ = cm_swapv(lo, X0, X1); X0 = r_.a; X1 = r_.b; } while (0)
#define CM_SWAP_F(lo, X0, X1) do { const CmPair r_ = cm_swapv(lo, __builtin_bit_cast(unsigned, (float)(X0)), __builtin_bit_cast(unsigned, (float)(X1))); X0 = __builtin_bit_cast(float, r_.a); X1 = __builtin_bit_cast(float, r_.b); } while (0)
#define cm_swap4(lo, w0, w1) do { CM_SWAP_U(lo, w0.x, w1.x); CM_SWAP_U(lo, w0.y, w1.y); CM_SWAP_U(lo, w0.z, w1.z); CM_SWAP_U(lo, w0.w, w1.w); } while (0)
struct EpiRoute {
    bf16_t *d0, *d1, *d2, *d3; const float* qn; const float* kn;
    template <int NORM> __device__ __forceinline__ void run(const Acc& acc, const Unit& u, int wr, int wc, int fr, int fq, bf16_t* base, int ld, int ct) const {
        const bool lo = fr < 8;
        const int row0 = u.pm * BM + wr * 64 + (fr & 7), col0 = ct * 256 + wc * 64 + 16 * fq + 8 * (fr >> 3);
        f32x4 gg[2][2];
        if constexpr (NORM) { const float* gn = (u.pn == 4) ? qn : kn; const float gs = (u.pn == 4) ? 0.125f * LOG2E : 1.0f;
#pragma unroll
            for (int bj = 0; bj < 2; ++bj)
#pragma unroll
                for (int n = 0; n < 2; ++n) gg[bj][n] = *(const f32x4*)(gn + 16 * fq + 8 * bj + 4 * n) * gs; }
#pragma unroll
        for (int ai = 0; ai < 2; ++ai)
#pragma unroll
            for (int m = 0; m < 4; ++m) { bf16_t* rowp = base + (size_t)(row0 + ai * HALF + m * 16) * ld + col0; u32x4 w0, w1;
                f32x4 v00 = acc[ai][0][m][0], v01 = acc[ai][0][m][1], v10 = acc[ai][1][m][0], v11 = acc[ai][1][m][1];
                if constexpr (NORM) { float ss = 0.f;
#pragma unroll
                    for (int e = 0; e < 4; ++e) ss += (v00[e] * v00[e] + v01[e] * v01[e]) + (v10[e] * v10[e] + v11[e] * v11[e]);
                    ss += shx(ss, 16, fr + 16 * fq); ss += shx(ss, 32, fr + 16 * fq);
                    const float rs = __builtin_amdgcn_rsqf(ss * (1.f / 64.f) + 1e-6f);
                    v00 = v00 * rs * gg[0][0]; v01 = v01 * rs * gg[0][1]; v10 = v10 * rs * gg[1][0]; v11 = v11 * rs * gg[1][1]; }
                w0.x = cvt_pk_bf16(v00[0], v00[1]); w0.y = cvt_pk_bf16(v00[2], v00[3]); w0.z = cvt_pk_bf16(v01[0], v01[1]); w0.w = cvt_pk_bf16(v01[2], v01[3]);
                w1.x = cvt_pk_bf16(v10[0], v10[1]); w1.y = cvt_pk_bf16(v10[2], v10[3]); w1.z = cvt_pk_bf16(v11[0], v11[1]); w1.w = cvt_pk_bf16(v11[2], v11[3]);
                cm_swap4(lo, w0, w1);
                *(u32x4*)rowp = w0; *(u32x4*)(rowp + (size_t)8 * ld) = w1; }
    }
    __device__ __forceinline__ void operator()(const Acc& acc, const Unit& u, int wr, int wc, int fr, int fq) const {
        const int pn = u.pn; bf16_t* base; int ld, ct;
        if (pn < 4) { base = d0; ld = 1024; ct = pn; } else if (pn < 7) { base = d1; ld = 768; ct = pn - 4; } else if (pn < 11) { base = d2; ld = 1024; ct = pn - 7; } else { base = d3; ld = 512; ct = pn - 11; }
        if (pn >= 11) {
            const int row0 = u.pm * BM + wr * 64 + fr, c0 = (pn - 11) * 128 + 32 * wc + 8 * fq;
#pragma unroll
            for (int ai = 0; ai < 2; ++ai)
#pragma unroll
                for (int m = 0; m < 4; ++m) { const f32x4 a0 = acc[ai][0][m][0], a1 = acc[ai][0][m][1], b0 = acc[ai][1][m][0], b1 = acc[ai][1][m][1]; u32x4 w;
                    w.x = cvt_pk_bf16(a0[0] * sigm(b0[0]), a0[1] * sigm(b0[1])); w.y = cvt_pk_bf16(a0[2] * sigm(b0[2]), a0[3] * sigm(b0[3]));
                    w.z = cvt_pk_bf16(a1[0] * sigm(b1[0]), a1[1] * sigm(b1[1])); w.w = cvt_pk_bf16(a1[2] * sigm(b1[2]), a1[3] * sigm(b1[3]));
                    *(u32x4*)(d3 + (size_t)(row0 + ai * HALF + m * 16) * 256 + c0) = w; }
            return; }
        if (pn == 4 || pn == 5) run<1>(acc, u, wr, wc, fr, fq, base, ld, ct); else run<0>(acc, u, wr, wc, fr, fq, base, ld, ct);
    }
};
struct EpiBf16 {
    bf16_t* O; int ld, pnmask; float sc;
    __device__ __forceinline__ void operator()(const Acc& acc, const Unit& u, int wr, int wc, int fr, int fq) const {
        const bool lo = fr < 8;
        const int row0 = u.pm * BM + wr * 64 + (fr & 7), col0 = (u.pn & pnmask) * 256 + wc * 64 + 16 * fq + 8 * (fr >> 3);
#pragma unroll
        for (int ai = 0; ai < 2; ++ai)
#pragma unroll
            for (int m = 0; m < 4; ++m) { bf16_t* rowp = O + (size_t)(row0 + ai * HALF + m * 16) * ld + col0; u32x4 w0, w1;
                { const f32x4 v0 = acc[ai][0][m][0] * sc, v1 = acc[ai][0][m][1] * sc; w0.x = cvt_pk_bf16(v0[0], v0[1]); w0.y = cvt_pk_bf16(v0[2], v0[3]); w0.z = cvt_pk_bf16(v1[0], v1[1]); w0.w = cvt_pk_bf16(v1[2], v1[3]); }
                { const f32x4 v0 = acc[ai][1][m][0] * sc, v1 = acc[ai][1][m][1] * sc; w1.x = cvt_pk_bf16(v0[0], v0[1]); w1.y = cvt_pk_bf16(v0[2], v0[3]); w1.z = cvt_pk_bf16(v1[0], v1[1]); w1.w = cvt_pk_bf16(v1[2], v1[3]); }
                cm_swap4(lo, w0, w1);
                *(u32x4*)rowp = w0; *(u32x4*)(rowp + (size_t)8 * ld) = w1; }
    }
};
struct EpiLora {
    float* wdec; bf16_t* ag; bf16_t* gp; const float* w0; const float* a0;
    __device__ __forceinline__ void operator()(const Acc& acc, const Unit& u, int wr, int wc, int fr, int fq) const {
        const int row0 = u.pm * BM + wr * 64 + fr, cl0 = wc * 32 + 8 * fq, pn = u.pn;
#pragma unroll
        for (int ai = 0; ai < 2; ++ai)
#pragma unroll
            for (int m = 0; m < 4; ++m) { const size_t row = (size_t)(row0 + ai * HALF + m * 16);
#pragma unroll
                for (int bj = 0; bj < 2; ++bj) { const int col = bj * HALF + cl0; float v[8];
#pragma unroll
                    for (int n = 0; n < 2; ++n)
#pragma unroll
                        for (int e = 0; e < 4; ++e) v[4 * n + e] = acc[ai][bj][m][n][e];
                    if (pn == 0) {
                        *(f32x4*)(wdec + row * 256 + col) = (f32x4){v[0], v[1], v[2], v[3]}; *(f32x4*)(wdec + row * 256 + col + 4) = (f32x4){v[4], v[5], v[6], v[7]};
                    } else if (pn == 1) {
                        *(u32x4*)(ag + row * 256 + col) = pack8(v);
                    } else { *(u32x4*)(gp + row * 256 + col) = pack8(v); }
                } }
    }
};
struct EpiBall {
    unsigned char* O;
    __device__ __forceinline__ void operator()(const Acc& acc, const Unit& u, int wr, int wc, int fr, int fq) const {
        unsigned char* base = O + ((size_t)(u.pm * 16 + u.pn) << 17) + (wc >> 1) * 32768 + (wr * 2 + (wc & 1)) * 1024 + (fr + 16 * fq) * 16;
#pragma unroll
        for (int ai = 0; ai < 2; ++ai)
#pragma unroll
            for (int m = 0; m < 4; ++m)
#pragma unroll
                for (int bj = 0; bj < 2; ++bj) { const f32x4 v0 = acc[ai][bj][m][0], v1 = acc[ai][bj][m][1]; u32x4 w;
                    w.x = cvt_pk_bf16(v0[0], v0[1]); w.y = cvt_pk_bf16(v0[2], v0[3]); w.z = cvt_pk_bf16(v1[0], v1[1]); w.w = cvt_pk_bf16(v1[2], v1[3]);
                    __builtin_nontemporal_store(w, (u32x4*)(base + bj * 65536 + (ai * 4 + m) * 4096)); }
    }
};
struct EpiGateMerge {
    const bf16_t* ball; bf16_t* merged;
    __device__ __forceinline__ void operator()(const Acc& acc, const Unit& u, int wr, int wc, int fr, int fq) const {
        const int row0 = u.pm * BM + wr * 64 + fr, o0 = 64 * u.pn + 16 * wc + 4 * fq;
        const int cw = 64 * (u.pn & 3) + 16 * wc + 4 * fq;
        const unsigned char* lbase = (const unsigned char*)ball + ((size_t)(u.pm * 16 + (u.pn >> 2)) << 17) + (cw >> 7) * 65536 + ((cw >> 6) & 1) * 32768 + (wr * 2 + ((cw >> 5) & 1)) * 1024 + (fr + 16 * ((cw >> 3) & 3)) * 16 + ((cw >> 2) & 1) * 8;
        u32x2 bb[2][4][4];
#pragma unroll
        for (int ai = 0; ai < 2; ++ai)
#pragma unroll
            for (int m = 0; m < 4; ++m)
#pragma unroll
                for (int gi = 0; gi < 4; ++gi) bb[ai][m][gi] = __builtin_nontemporal_load((const u32x2*)(lbase + ((size_t)gi << 19) + (ai * 4 + m) * 4096));
#pragma unroll
        for (int ai = 0; ai < 2; ++ai)
#pragma unroll
            for (int m = 0; m < 4; ++m) { const size_t row = (size_t)(row0 + ai * HALF + m * 16); float s[4] = {0.f, 0.f, 0.f, 0.f};
#pragma unroll
                for (int bj = 0; bj < 2; ++bj)
#pragma unroll
                    for (int n = 0; n < 2; ++n) { const int gi = 2 * bj + n; const u32x2 b = bb[ai][m][gi];
                        const f32x4 a = acc[ai][bj][m][n] * (-F8_DESCALE * LOG2E);
#define SG2_(x) __builtin_amdgcn_rcpf(1.f + __builtin_amdgcn_exp2f(x))
                        s[0] += SG2_(a[0]) * bflo(b.x); s[1] += SG2_(a[1]) * bfhi(b.x); s[2] += SG2_(a[2]) * bflo(b.y); s[3] += SG2_(a[3]) * bfhi(b.y); }
#undef SG2_
                u32x2 w; w.x = cvt_pk_bf16(s[0], s[1]); w.y = cvt_pk_bf16(s[2], s[3]);
                *(u32x2*)(merged + row * 1024 + o0) = w; }
    }
};
struct EpiResidual {
    bf16_t* xb; float sc;
    __device__ __forceinline__ void operator()(const Acc& acc, const Unit& u, int wr, int wc, int fr, int fq) const {
        const bool lo = fr < 8;
        const int row0 = u.pm * BM + wr * 64 + (fr & 7), col0 = u.pn * 256 + wc * 64 + 16 * fq + 8 * (fr >> 3);
#pragma unroll
        for (int ai = 0; ai < 2; ++ai)
#pragma unroll
            for (int m = 0; m < 4; ++m) { u32x4* p0 = (u32x4*)(xb + (size_t)(row0 + ai * HALF + m * 16) * 1024 + col0); u32x4* p1 = (u32x4*)((bf16_t*)p0 + 8 * 1024);
                const u32x4 t0 = *p0, t1 = *p1;
                f32x4 a0 = acc[ai][0][m][0] * sc, a1 = acc[ai][0][m][1] * sc, b0 = acc[ai][1][m][0] * sc, b1 = acc[ai][1][m][1] * sc;
#pragma unroll
                for (int e = 0; e < 4; ++e) { CM_SWAP_F(lo, a0[e], b0[e]); CM_SWAP_F(lo, a1[e], b1[e]); }
                u32x4 w0, w1;
                w0.x = cvt_pk_bf16(bflo(t0.x) + a0[0], bfhi(t0.x) + a0[1]); w0.y = cvt_pk_bf16(bflo(t0.y) + a0[2], bfhi(t0.y) + a0[3]); w0.z = cvt_pk_bf16(bflo(t0.z) + a1[0], bfhi(t0.z) + a1[1]); w0.w = cvt_pk_bf16(bflo(t0.w) + a1[2], bfhi(t0.w) + a1[3]);
                w1.x = cvt_pk_bf16(bflo(t1.x) + b0[0], bfhi(t1.x) + b0[1]); w1.y = cvt_pk_bf16(bflo(t1.y) + b0[2], bfhi(t1.y) + b0[3]); w1.z = cvt_pk_bf16(bflo(t1.z) + b1[0], bfhi(t1.z) + b1[1]); w1.w = cvt_pk_bf16(bflo(t1.w) + b1[2], bfhi(t1.w) + b1[3]);
                *p0 = w0; *p1 = w1; }
    }
};
struct EpiSwiglu {
    unsigned char* hid; int ldh, ncol; bool pad;
    __device__ __forceinline__ void operator()(const Acc& acc, const Unit& u, int wr, int wc, int fr, int fq) const {
        const int pl = u.pn % ncol; const int row0 = u.pm * BM + wr * 64 + fr, col0 = pl * 128 + wc * 32 + 8 * fq;
        const bool dopad = pad && (pl == ncol - 1);
#pragma unroll
        for (int ai = 0; ai < 2; ++ai)
#pragma unroll
            for (int m = 0; m < 4; ++m) { float v[8];
#pragma unroll
                for (int n = 0; n < 2; ++n)
#pragma unroll
                    for (int e = 0; e < 4; ++e) { const float a = acc[ai][0][m][n][e], b = acc[ai][1][m][n][e];
                        v[4 * n + e] = (a * b) * (F8_DESCALE * F8_DESCALE * F8_MUL_H) * __builtin_amdgcn_rcpf(1.f + __builtin_amdgcn_exp2f(a * (-F8_DESCALE * LOG2E))); }
                unsigned char* rp = hid + (size_t)(row0 + ai * HALF + m * 16) * ldh + col0;
                u32x2 w; w.x = pk4_fp8(v[0], v[1], v[2], v[3]); w.y = pk4_fp8(v[4], v[5], v[6], v[7]); *(u32x2*)rp = w;
                if (dopad) { unsigned z0; asm volatile("v_mov_b32 %0, 0" : "=v"(z0)); *(u32x2*)(rp + 128) = (u32x2){z0, z0}; } }
    }
};
struct EpiMoeOut {
    float* out; const int* rowtok; const float* rowgate; const int* segend;
    __device__ __forceinline__ void operator()(const Acc& acc, const Unit& u, int wr, int wc, int fr, int fq) const {
        const int row0 = u.pm * BM + wr * 64 + fr, col0 = (u.pn & 3) * 256 + wc * 32 + 8 * fq, lim = segend[u.pm];
#pragma unroll
        for (int ai = 0; ai < 2; ++ai)
#pragma unroll
            for (int m = 0; m < 4; ++m) { const int row = row0 + ai * HALF + m * 16;
                if (row < lim) { const int tok = rowtok[row]; const float gt = rowgate[row]; float* rowp = out + (size_t)tok * 1024 + col0;
#pragma unroll
                    for (int bj = 0; bj < 2; ++bj)
#pragma unroll
                        for (int n = 0; n < 2; ++n)
#pragma unroll
                            for (int e = 0; e < 4; ++e) __hip_atomic_fetch_add(rowp + bj * HALF + 4 * n + e, gt * acc[ai][bj][m][n][e], __ATOMIC_RELAXED, __HIP_MEMORY_SCOPE_AGENT);
                } }
    }
};
}

#define XB_TMO      128
#define XB_XCNT(j)  (256  + 64 * (j))
#define XB_XSUB(j)  (1280 + 64 * (j))
#define XB_XGEN(j)  (2304 + 64 * (j))
#define XB_TOP      3328
#define XB_TOPGEN   3392
#define XCD_BAR_WORDS 3456
#define XB_SPIN_CAP (1u << 18)
__device__ __forceinline__ unsigned xb_ld(unsigned* p)              { return __hip_atomic_load(p, __ATOMIC_RELAXED, __HIP_MEMORY_SCOPE_AGENT); }
__device__ __forceinline__ unsigned xb_add(unsigned* p, unsigned v) { return __hip_atomic_fetch_add(p, v, __ATOMIC_RELAXED, __HIP_MEMORY_SCOPE_AGENT); }
__device__ __forceinline__ unsigned xb_xcc_id() { return (unsigned)__builtin_amdgcn_s_getreg((3 << 11) | 20) & 0xFu; }
#define XB_SPIN(cond, bar) do { unsigned _sp = 0; while (cond) { __builtin_amdgcn_s_sleep(1); \
    if ((++_sp & 255u) == 0u) { if (xb_ld(&(bar)[XB_TMO])) break; if (_sp > XB_SPIN_CAP) { atomicAdd(&(bar)[XB_TMO], 1u); break; } } } } while (0)
struct XcdBarrier { unsigned* bar; unsigned x; volatile LAS unsigned* st; };
__device__ __forceinline__ XcdBarrier xcd_barrier_post(unsigned* bar, volatile LAS unsigned* st) {
    XcdBarrier b; b.bar = bar; b.x = xb_xcc_id(); b.st = st;
    if (threadIdx.x == 0) (void)xb_add(&bar[XB_XCNT(b.x)], 1u);
    return b;
}
__device__ __forceinline__ void xcd_barrier_complete(unsigned* bar, unsigned x, unsigned& nloc, unsigned& nx) {
    const unsigned G = gridDim.x * gridDim.y * gridDim.z;
    unsigned sum, cnt, mine, sp = 0u;
    for (;;) {
        sum = 0u; cnt = 0u; mine = 0u;
#pragma unroll
        for (unsigned j = 0; j < 16; ++j) { const unsigned c = xb_ld(&bar[XB_XCNT(j)]); sum += c; cnt += (c > 0u) ? 1u : 0u; mine = (j == x) ? c : mine; }
        if (sum == G) break;
        __builtin_amdgcn_s_sleep(1);
        if ((++sp & 255u) == 0u) { if (xb_ld(&bar[XB_TMO])) break; if (sp > XB_SPIN_CAP) { atomicAdd(&bar[XB_TMO], 1u); break; } }
    }
    nloc = mine > 0u ? mine : 1u; nx = cnt > 0u ? cnt : 1u;
}
__device__ __forceinline__ void xcd_barrier(const XcdBarrier& b, const int tid) {
    asm volatile("s_waitcnt vmcnt(0)" ::: "memory");
    __syncthreads();
    if (tid == 0) {
        unsigned* bar = b.bar;
        __builtin_amdgcn_s_waitcnt(0);
        unsigned nloc = b.st[0], nx = b.st[1];
        if (nloc == 0u) { xcd_barrier_complete(bar, b.x, nloc, nx); b.st[0] = nloc; b.st[1] = nx; }
        const unsigned old = xb_add(&bar[XB_XSUB(b.x)], 1u);
        const unsigned gen = old / nloc;
        if (old + 1u == (gen + 1u) * nloc) {
            __builtin_amdgcn_fence(__ATOMIC_RELEASE, "agent");
            asm volatile("s_waitcnt vmcnt(0)" ::: "memory");
            const unsigned og = xb_add(&bar[XB_TOP], 1u);
            const unsigned tg = og / nx;
            if (og + 1u == (tg + 1u) * nx) xb_add(&bar[XB_TOPGEN], 1u);
            else XB_SPIN(xb_ld(&bar[XB_TOPGEN]) == tg, bar);
            __builtin_amdgcn_fence(__ATOMIC_ACQUIRE, "agent");
            xb_add(&bar[XB_XGEN(b.x)], 1u);
            asm volatile("s_waitcnt vmcnt(0)" ::: "memory");
        } else {
            XB_SPIN(xb_ld(&bar[XB_XGEN(b.x)]) == gen, bar);
            __builtin_amdgcn_fence(__ATOMIC_ACQUIRE, "agent");
            asm volatile("s_waitcnt vmcnt(0)" ::: "memory");
        }
    }
    __syncthreads();
}

constexpr size_t MiB = 1u << 20;
constexpr size_t WS_CTL = 0, CTL_ZERO_BYTES = 1 * MiB;
constexpr int CW_BAR = 4096;
constexpr int CW_QUEUE = 20480;
constexpr int CW_MOE = 16384;
constexpr size_t WS_EIDX = 1 * MiB, WS_GATE = WS_EIDX + 256 * 1024, WS_ROWTOK = WS_EIDX + 512 * 1024, WS_ROWGATE = 2 * MiB, WS_TEXP = 2 * MiB + 512 * 1024, WS_SEGEND = WS_TEXP + 4096, WS_NT = WS_TEXP + 8192;
constexpr size_t WS_SLOTOF = 2 * MiB + 768 * 1024;
constexpr size_t WS_BON = 3 * MiB, WS_COS = 4 * MiB, WS_SIN = 6 * MiB;
constexpr size_t WS_WIN = 8 * MiB, WS_WLORA = 15 * MiB, WS_WB = 16 * MiB, WS_WG = 18 * MiB, WS_WOUT = 26 * MiB, WS_W13 = 28 * MiB  , WS_W2D = 50 * MiB, WS_W2M = 50 * MiB, WS_H8 = 72 * MiB  ;
constexpr size_t WS_XB = 104 * MiB  , WS_Y = 168 * MiB, WS_BIG = 232 * MiB;
constexpr size_t WS_RW = WS_BIG, WS_WDEC = WS_BIG + 208 * MiB  , WS_AP = WS_BIG + 240 * MiB  , WS_GP = WS_BIG + 192 * MiB  , WS_AG = WS_BIG + 32 * MiB  , WS_SB = WS_BIG + 64 * MiB, WS_RET = WS_BIG + 112 * MiB, WS_CV = WS_BIG + 176 * MiB, WS_Y0 = WS_CV;
constexpr size_t WS_RKVS = WS_BIG + 208 * MiB, WS_ALORA = WS_BIG + 256 * MiB, WS_RHAT = WS_ALORA, WS_KV = WS_BIG + 272 * MiB, WS_SST = WS_WDEC  , WS_PQ = WS_BIG + 304 * MiB  , WS_END = WS_BIG + 368 * MiB;
constexpr size_t WS_BALL = WS_BIG, WS_MERGED = WS_BIG + 256 * MiB, WS_HID = WS_BIG, WS_XS = WS_BIG, WS_YS = WS_XS, WS_HIDM = WS_BIG + 132 * MiB;
static_assert(WS_HIDM + (size_t)MPAD * DFE * 2 <= WS_END && WS_MERGED + (size_t)T * D * 2 <= WS_END && WS_W2M + (size_t)NEXP * D * DFE * 2 <= WS_H8, "ws map");
static_assert(WS_W13 + (size_t)NEXP * 2 * DFE * D <= WS_W2M && WS_W13 + (size_t)2 * DFF * D <= WS_W2D && WS_W2M + (size_t)NEXP * D * DFE * 2 <= WS_H8 && WS_H8 + (size_t)T * D <= WS_XB, "ws map weights");

constexpr int LDS_BYTES = 147456, RING_BYTES = 131072, MISC_OFF = RING_BYTES + 320;

struct Args { const float* in[32]; float* out; unsigned char* ws; int ph_lo, ph_hi; };
#define CAS __attribute__((address_space(4)))
struct Ctx {
    LAS unsigned char* lds; unsigned char* ws; float* out; const float* const CAS* in;
    int tid, lane, wave, G, bid;
};
__device__ __forceinline__ const CAS Args* ka_ptr() { const CAS Args* p = (const CAS Args*)__builtin_amdgcn_kernarg_segment_ptr(); asm volatile("" : "+s"(p)); return p; }
extern __shared__ __attribute__((aligned(16))) unsigned char lds_raw[];
__device__ __forceinline__ Ctx make_ctx(int wv) {
    const CAS Args* ka = ka_ptr();
    Ctx C; C.lds = (LAS unsigned char*)lds_raw; C.ws = ka->ws; C.out = ka->out; C.in = ka->in;
    int g_ = gridDim.x, b_ = blockIdx.x, w_ = wv; asm volatile("" : "+s"(g_), "+s"(b_), "+s"(w_));
    int ln_; asm volatile("v_mbcnt_lo_u32_b32 %0, -1, 0\n\tv_mbcnt_hi_u32_b32 %0, -1, %0" : "=v"(ln_));
    C.lane = ln_; C.wave = w_; C.tid = w_ * 64 + ln_; C.G = g_; C.bid = b_;
    return C;
}
enum { I_X = 0, I_NORM_MIX, I_W_IN, I_RW_MU, I_RW_W0, I_RW_W2, I_RW_A0, I_RW_A2, I_RW_G2, I_RW_KK, I_RW_KA, I_RW_RK, I_RW_LNW, I_RW_LNB, I_SB_QN, I_SB_KN, I_RET_GN,
       I_CONV_DW, I_CONV_B, I_CONV_LNW, I_CONV_LNB, I_W_GATE, I_W_BRANCH, I_W_OUT, I_NORM_FFN, I_FFN_W1, I_FFN_W3, I_FFN_W2, I_ROUTER, I_MOE_W1, I_MOE_W3, I_MOE_W2 };

__device__ __forceinline__ int q_next(const Ctx& C, unsigned* head) {
    LAS int* slot = (LAS int*)(C.lds + MISC_OFF + 64);
    __syncthreads();
    if (C.tid == 0) *slot = (int)__hip_atomic_fetch_add(head, 1u, __ATOMIC_RELAXED, __HIP_MEMORY_SCOPE_AGENT);
    __syncthreads();
    return *slot;
}
__device__ __forceinline__ void ph_prologue_(const Ctx& C) {
    const size_t gid = (size_t)C.bid * NTHR + C.tid, gsz = (size_t)C.G * NTHR;
    float* cs = (float*)(C.ws + WS_COS); float* sn = (float*)(C.ws + WS_SIN);
    for (size_t i = gid; i < (size_t)SEQ * 32; i += gsz) {
        const int pos = (int)(i >> 5), j = (int)(i & 31);
        const float inv = (float)pow(10000.0, -(double)(2 * j) / 64.0);
        const float ang = (float)pos * inv;
        cs[i] = (float)cos((double)ang); sn[i] = (float)sin((double)ang);
    }
}

__device__ __forceinline__ int dest_row(int mode, int roff, int which, int n) {
    if (mode == 0) return roff + n;
    if (mode == 1) { const int pn = n >> 6, oc = n & 63; return 256 * pn + 128 * (roff >> 1) + 32 * (oc >> 4) + 8 * ((oc >> 2) & 3) + 4 * (roff & 1) + (oc & 3); }
    if (mode == 3) {
        if (n < 2816) return n;
        const int j = n - 2816, isb = j >> 8, jl = j & 127, t = (j >> 7) & 1;
        return 2816 + 256 * t + 64 * (jl >> 5) + 16 * ((jl >> 3) & 3) + 8 * isb + (jl & 7); }
    return roff + 256 * (n >> 7) + 128 * which + (n & 127);
}
__device__ __forceinline__ void xpose_item(const float* W, int K, int N, bf16* WT, int mode, int roff, int which, LAS float* scr, int item, int lane) {
    const int nblk = N / 32, kb = item / nblk, nb = item % nblk, k0 = 64 * kb, n0 = 32 * nb;
#pragma unroll
    for (int i = 0; i < 8; ++i) { const int kk = (lane >> 3) + 8 * i, c4 = (lane & 7) * 4; const f32x4 v = *(const f32x4*)(W + (size_t)(k0 + kk) * N + n0 + c4);
        scr[kk * 33 + c4] = v.x; scr[kk * 33 + c4 + 1] = v.y; scr[kk * 33 + c4 + 2] = v.z; scr[kk * 33 + c4 + 3] = v.w; }
    asm volatile("s_waitcnt lgkmcnt(0)" ::: "memory");
    const int c = lane & 7;
#pragma unroll
    for (int j = 0; j < 4; ++j) { const int n = (lane >> 3) + 8 * j; const LAS float* s = scr + (8 * c) * 33 + n;
        u32x4 o; o.x = cvt_pk_bf16(s[0 * 33], s[1 * 33]); o.y = cvt_pk_bf16(s[2 * 33], s[3 * 33]); o.z = cvt_pk_bf16(s[4 * 33], s[5 * 33]); o.w = cvt_pk_bf16(s[6 * 33], s[7 * 33]);
        *(u32x4*)(WT + (size_t)dest_row(mode, roff, which, n0 + n) * K + k0 + 8 * c) = o; }
    asm volatile("s_waitcnt lgkmcnt(0)" ::: "memory");
}
__device__ __forceinline__ void xpose_item8(const float* W, int K, int N, unsigned char* WT, int mode, int roff, int which, LAS float* scr, int item, int lane, int ldk = 0) {
    if (ldk == 0) ldk = K;
    const int nblk = N / 32, kb = item / nblk, nb = item % nblk, k0 = 64 * kb, n0 = 32 * nb;
#pragma unroll
    for (int i = 0; i < 8; ++i) { const int kk = (lane >> 3) + 8 * i, c4 = (lane & 7) * 4; const f32x4 v = *(const f32x4*)(W + (size_t)(k0 + kk) * N + n0 + c4);
        scr[kk * 33 + c4] = v.x; scr[kk * 33 + c4 + 1] = v.y; scr[kk * 33 + c4 + 2] = v.z; scr[kk * 33 + c4 + 3] = v.w; }
    asm volatile("s_waitcnt lgkmcnt(0)" ::: "memory");
    const int c = lane & 3;
#pragma unroll
    for (int j = 0; j < 2; ++j) { const int n = (lane >> 2) + 16 * j; const LAS float* sp = scr + (16 * c) * 33 + n;
        u32x4 o;
        o.x = pk4_fp8(sp[0 * 33] * F8_MUL_W, sp[1 * 33] * F8_MUL_W, sp[2 * 33] * F8_MUL_W, sp[3 * 33] * F8_MUL_W);
        o.y = pk4_fp8(sp[4 * 33] * F8_MUL_W, sp[5 * 33] * F8_MUL_W, sp[6 * 33] * F8_MUL_W, sp[7 * 33] * F8_MUL_W);
        o.z = pk4_fp8(sp[8 * 33] * F8_MUL_W, sp[9 * 33] * F8_MUL_W, sp[10 * 33] * F8_MUL_W, sp[11 * 33] * F8_MUL_W);
        o.w = pk4_fp8(sp[12 * 33] * F8_MUL_W, sp[13 * 33] * F8_MUL_W, sp[14 * 33] * F8_MUL_W, sp[15 * 33] * F8_MUL_W);
        *(u32x4*)(WT + (size_t)dest_row(mode, roff, which, n0 + n) * ldk + k0 + 16 * c) = o; }
    asm volatile("s_waitcnt lgkmcnt(0)" ::: "memory");
}
__device__ __forceinline__ void ph_weights_(const Ctx& C, int l, int part, int first_wg, int nwg, unsigned* qhead = nullptr) {
    LAS float* scr = (LAS float*)(C.lds + C.wave * 16384);
    const int gw = (C.bid - first_wg) * NWAVES + C.wave, NGW = nwg * NWAVES, lane = C.lane;
    unsigned char* ws = C.ws;
    const bool moe = (l & 1);
    const int l2 = l >> 1;
    constexpr int IT_IN = (D / 64) * (NIN / 32), IT_B = (256 / 64) * (D / 32), IT_G = (D / 64) * (D / 32), IT_O = IT_G;
    constexpr int IT_F1 = (D / 64) * (DFF / 32), IT_F2 = (DFF / 64) * (D / 32), IT_M1 = (D / 64) * (DFE / 32), IT_M2 = (DFE / 64) * (D / 32);
    const int n_fixed = IT_IN + 4 * IT_B + 4 * IT_G + IT_O;
    if (part == 1) {
        if (C.bid < first_wg) return;
        const int n1 = moe ? NEXP * IT_M2 : (2 * IT_F1 + IT_F2);
        for (int it = qhead ? q_next(C, qhead) * NWAVES + C.wave : gw; qhead ? (it - C.wave < n1) : (it < n1); it = qhead ? q_next(C, qhead) * NWAVES + C.wave : it + NGW) {
            if (it >= n1) continue;
            int r = it;
            if (!moe) {
                if (r < IT_F1) { xpose_item8(C.in[I_FFN_W1] + (size_t)l2 * D * DFF, D, DFF, ws + WS_W13, 2, 0, 0, scr, r, lane); continue; } r -= IT_F1;
                if (r < IT_F1) { xpose_item8(C.in[I_FFN_W3] + (size_t)l2 * D * DFF, D, DFF, ws + WS_W13, 2, 0, 1, scr, r, lane); continue; } r -= IT_F1;
                xpose_item8(C.in[I_FFN_W2] + (size_t)l2 * DFF * D, DFF, D, ws + WS_W2D, 0, 0, 0, scr, r, lane);
            } else { const int e = r / IT_M2; r -= e * IT_M2;
                xpose_item8(C.in[I_MOE_W2] + ((size_t)l2 * NEXP + e) * DFE * D, DFE, D, ws + WS_W2M, 0, e * D, 0, scr, r, lane, DFE_PAD); }
        }
        if (moe) {
            for (int i = (C.bid - first_wg) * NTHR + C.tid; i < NEXP * D * ((DFE_PAD - DFE) / 16); i += nwg * NTHR) { const int row = i >> 3, c16 = i & 7;
                unsigned z0; asm volatile("v_mov_b32 %0, 0" : "=v"(z0)); *(u32x4*)(ws + WS_W2M + (size_t)row * DFE_PAD + DFE + 16 * c16) = (u32x4){z0, z0, z0, z0}; } }
        return;
    }
    const int n_ffn = moe ? (NEXP * 2 * IT_M1) : 0;
    for (int it = gw; it < n_fixed + n_ffn; it += NGW) {
        int r = it;
        if (r < IT_IN) { xpose_item(C.in[I_W_IN] + (size_t)l * D * NIN, D, NIN, (bf16*)(ws + WS_WIN), 3, 0, 0, scr, r, lane); continue; } r -= IT_IN;
        if (r < 4 * IT_B) { const int i = r / IT_B; xpose_item(C.in[I_W_BRANCH] + ((size_t)l * 4 + i) * 256 * D, 256, D, (bf16*)(ws + WS_WB), 0, 1024 * i, 0, scr, r % IT_B, lane); continue; } r -= 4 * IT_B;
        if (r < 4 * IT_G) { const int i = r / IT_G; xpose_item8(C.in[I_W_GATE] + ((size_t)l * 4 + i) * D * D, D, D, ws + WS_WG, 1, i, 0, scr, r % IT_G, lane); continue; } r -= 4 * IT_G;
        if (r < IT_O) { xpose_item(C.in[I_W_OUT] + (size_t)l * D * D, D, D, (bf16*)(ws + WS_WOUT), 0, 0, 0, scr, r, lane); continue; } r -= IT_O;
        { const int per = 2 * IT_M1, e = r / per; r -= e * per;
          if (r < IT_M1) { xpose_item8(C.in[I_MOE_W1] + ((size_t)l2 * NEXP + e) * D * DFE, D, DFE, ws + WS_W13, 2, e * 2 * DFE, 0, scr, r, lane); continue; } r -= IT_M1;
          xpose_item8(C.in[I_MOE_W3] + ((size_t)l2 * NEXP + e) * D * DFE, D, DFE, ws + WS_W13, 2, e * 2 * DFE, 1, scr, r, lane); }
    }
    bf16* WL = (bf16*)(ws + WS_WLORA);
    const float* w2 = C.in[I_RW_W2] + (size_t)l * 64 * 256; const float* a2 = C.in[I_RW_A2] + (size_t)l * 64 * 256; const float* g2 = C.in[I_RW_G2] + (size_t)l * 128 * 256;
    for (int i = C.bid * NTHR + C.tid; i < 768 * 256; i += C.G * NTHR) {
        const int n = i >> 8, k = i & 255; float v = 0.f;
        if (n < 256) { if (k < 64) v = w2[k * 256 + n]; }
        else if (n < 512) { if (k >= 64 && k < 128) v = a2[(k - 64) * 256 + (n - 256)]; }
        else { if (k >= 128) v = g2[(k - 128) * 256 + (n - 512)]; }
        WL[i] = f2bf(v);
    }
}

__device__ __forceinline__ void ph_norm_(const Ctx& C, const float* gain, bool route, const float* router, int moe_idx, bool combine = false, const float* src = nullptr, bool want_bf16 = true) {
    const int gw = C.bid * NWAVES + C.wave, NGW = C.G * NWAVES, lane = C.lane;
    bf16* H = (bf16*)C.out; bf16* XB = (bf16*)(C.ws + WS_XB);
    f32x4 g[4];
#pragma unroll
    for (int j = 0; j < 4; ++j) g[j] = *(const f32x4*)(gain + 8 * lane + 512 * (j >> 1) + 4 * (j & 1));
    LAS unsigned* lcnt = (LAS unsigned*)(C.lds);
    if (route) { if (C.tid < 8) lcnt[C.tid] = 0u; __syncthreads(); }
    int* eidx = (int*)(C.ws + WS_EIDX); float* gate = (float*)(C.ws + WS_GATE);
    constexpr int NR = 4;
    for (int mb = gw; mb < T; mb += NR * NGW) {
        f32x4 vv[NR][4]; u32x4 ya[NR][2], yb[NR][2]; float g0v[NR], g1v[NR];
#pragma unroll
        for (int r = 0; r < NR; ++r) { const int m = mb + r * NGW; if (m < T) {
            if (src) { const f32x4* xr = (const f32x4*)(src + (size_t)m * D + 8 * lane);
#pragma unroll
                for (int j = 0; j < 4; ++j) vv[r][j] = xr[128 * (j >> 1) + (j & 1)]; }
            else { const u32x4* xb = (const u32x4*)(XB + (size_t)m * D) + lane;
#pragma unroll
                for (int j = 0; j < 2; ++j) { const u32x4 t = xb[64 * j]; vv[r][2 * j] = f32x4{bflo(t.x), bfhi(t.x), bflo(t.y), bfhi(t.y)}; vv[r][2 * j + 1] = f32x4{bflo(t.z), bfhi(t.z), bflo(t.w), bfhi(t.w)}; } }
            if (combine) { const int* slotof = (const int*)(C.ws + WS_SLOTOF); const float* gt = (const float*)(C.ws + WS_GATE); const bf16* YS = (const bf16*)(C.ws + WS_YS);
                const int s0 = slotof[2 * m], s1 = slotof[2 * m + 1]; g0v[r] = gt[2 * m]; g1v[r] = gt[2 * m + 1];
                const u32x4* y0 = (const u32x4*)(YS + (size_t)s0 * D) + lane; const u32x4* y1 = (const u32x4*)(YS + (size_t)s1 * D) + lane;
#pragma unroll
                for (int j = 0; j < 2; ++j) { ya[r][j] = y0[64 * j]; yb[r][j] = y1[64 * j]; } } } }
#pragma unroll
        for (int r = 0; r < NR; ++r) { const int m = mb + r * NGW; if (m < T) {
        f32x4 v[4]; float s = 0.f;
#pragma unroll
        for (int j = 0; j < 4; ++j) v[j] = vv[r][j];
        if (combine) {
            const float g0 = g0v[r], g1 = g1v[r];
#pragma unroll
            for (int j = 0; j < 2; ++j) { const u32x4 a = ya[r][j], b = yb[r][j];
                v[2 * j].x += g0 * bflo(a.x) + g1 * bflo(b.x); v[2 * j].y += g0 * bfhi(a.x) + g1 * bfhi(b.x); v[2 * j].z += g0 * bflo(a.y) + g1 * bflo(b.y); v[2 * j].w += g0 * bfhi(a.y) + g1 * bfhi(b.y);
                v[2 * j + 1].x += g0 * bflo(a.z) + g1 * bflo(b.z); v[2 * j + 1].y += g0 * bfhi(a.z) + g1 * bfhi(b.z); v[2 * j + 1].z += g0 * bflo(a.w) + g1 * bflo(b.w); v[2 * j + 1].w += g0 * bfhi(a.w) + g1 * bfhi(b.w); }
        }
        if (combine || src) { u32x4* xo = (u32x4*)(XB + (size_t)m * D) + lane;
#pragma unroll
            for (int j = 0; j < 2; ++j) { u32x4 t; t.x = cvt_pk_bf16(v[2 * j].x, v[2 * j].y); t.y = cvt_pk_bf16(v[2 * j].z, v[2 * j].w); t.z = cvt_pk_bf16(v[2 * j + 1].x, v[2 * j + 1].y); t.w = cvt_pk_bf16(v[2 * j + 1].z, v[2 * j + 1].w); xo[64 * j] = t; } }
#pragma unroll
        for (int j = 0; j < 4; ++j) s += (v[j].x * v[j].x + v[j].y * v[j].y) + (v[j].z * v[j].z + v[j].w * v[j].w);
        const float rs = 1.0f / sqrtf(wave_sum(s, C.lane) * (1.f / D) + 1e-6f);
#pragma unroll
        for (int j = 0; j < 4; ++j) v[j] = v[j] * rs * g[j];
#pragma unroll
        for (int j = 0; j < 2; ++j) {
            if (want_bf16) { u32x4 t; t.x = cvt_pk_bf16(v[2 * j].x, v[2 * j].y); t.y = cvt_pk_bf16(v[2 * j].z, v[2 * j].w); t.z = cvt_pk_bf16(v[2 * j + 1].x, v[2 * j + 1].y); t.w = cvt_pk_bf16(v[2 * j + 1].z, v[2 * j + 1].w);
                ((u32x4*)(H + (size_t)m * D) + lane)[64 * j] = t; }
            u32x2 q; q.x = pk4_fp8(v[2 * j].x * F8_MUL_X, v[2 * j].y * F8_MUL_X, v[2 * j].z * F8_MUL_X, v[2 * j].w * F8_MUL_X); q.y = pk4_fp8(v[2 * j + 1].x * F8_MUL_X, v[2 * j + 1].y * F8_MUL_X, v[2 * j + 1].z * F8_MUL_X, v[2 * j + 1].w * F8_MUL_X);
            ((u32x2*)(C.ws + WS_H8 + (size_t)m * D) + lane)[64 * j] = q; }
        if (route) {
            float lg[8];
#pragma unroll
            for (int e = 0; e < 8; ++e) lg[e] = 0.f;
#pragma unroll
            for (int j = 0; j < 4; ++j)
#pragma unroll
                for (int q = 0; q < 4; ++q) { const int k = 8 * lane + 512 * (j >> 1) + 4 * (j & 1) + q; const f32x4 r0 = *(const f32x4*)(router + (size_t)k * 8), r1 = *(const f32x4*)(router + (size_t)k * 8 + 4); const float hv = v[j][q];
                    lg[0] += hv * r0.x; lg[1] += hv * r0.y; lg[2] += hv * r0.z; lg[3] += hv * r0.w; lg[4] += hv * r1.x; lg[5] += hv * r1.y; lg[6] += hv * r1.z; lg[7] += hv * r1.w; }
#pragma unroll
            for (int e = 0; e < 8; ++e) lg[e] = wave_sum(lg[e], C.lane);
            int e0 = 0; float b0 = lg[0];
#pragma unroll
            for (int e = 1; e < 8; ++e) if (lg[e] > b0) { b0 = lg[e]; e0 = e; }
            int e1 = -1; float b1 = -3.0e38f;
#pragma unroll
            for (int e = 0; e < 8; ++e) if (e != e0 && lg[e] > b1) { b1 = lg[e]; e1 = e; }
            const float p1 = __expf(b1 - b0), inv = 1.f / (1.f + p1);
            if (lane == 0) { eidx[2 * m] = e0; eidx[2 * m + 1] = e1; gate[2 * m] = inv; gate[2 * m + 1] = p1 * inv; atomicAdd((unsigned*)&lcnt[e0], 1u); atomicAdd((unsigned*)&lcnt[e1], 1u); }
        }
        } }
    }
    if (route) { __syncthreads(); if (C.tid < 8) { unsigned* cw = (unsigned*)(C.ws + WS_CTL) + CW_MOE + moe_idx * 64; atomicAdd(&cw[C.tid], lcnt[C.tid]); } }
}

__device__ __forceinline__ void ph_rw_prep_(const Ctx& C, int l) {
    const bf16* RW = (const bf16*)(C.ws + WS_RW); bf16* AL = (bf16*)(C.ws + WS_ALORA);
    const float* mu = C.in[I_RW_MU] + (size_t)l * 1024;
    const size_t gid = (size_t)C.bid * NTHR + C.tid, gsz = (size_t)C.G * NTHR;
    constexpr int NI = 4;
    for (size_t it0 = gid; it0 < (size_t)T * 32; it0 += NI * gsz) {
        u32x4 cuv[NI], pvv[NI]; f32x4 mu0[NI], mu1[NI];
#pragma unroll
        for (int r = 0; r < NI; ++r) { const size_t it = it0 + r * gsz; cuv[r] = (u32x4){0u, 0u, 0u, 0u}; pvv[r] = cuv[r]; mu0[r] = (f32x4){0.f, 0.f, 0.f, 0.f}; mu1[r] = mu0[r];
            if (it < (size_t)T * 32) { const int m = (int)(it >> 5), c8 = 768 + (int)(it & 31) * 8, t = m & (SEQ - 1);
                cuv[r] = *(const u32x4*)(RW + (size_t)m * 1024 + c8); if (t) pvv[r] = *(const u32x4*)(RW + (size_t)(m - 1) * 1024 + c8); mu0[r] = *(const f32x4*)(mu + c8); mu1[r] = *(const f32x4*)(mu + c8 + 4); } }
#pragma unroll
        for (int r = 0; r < NI; ++r) { const size_t it = it0 + r * gsz; if (it < (size_t)T * 32) {
        const int m = (int)(it >> 5), c8 = 768 + (int)(it & 31) * 8;
        float a[8], b[8]; unpack8(cuv[r], a); unpack8(pvv[r], b);
        const f32x4 m0 = mu0[r], m1 = mu1[r];
        const float mm[8] = {m0.x, m0.y, m0.z, m0.w, m1.x, m1.y, m1.z, m1.w};
#pragma unroll
        for (int e = 0; e < 8; ++e) a[e] = a[e] + (b[e] - a[e]) * mm[e];
        if (c8 < 832) {
#pragma unroll
            for (int e = 0; e < 8; ++e) a[e] = 1.f - 2.f * __builtin_amdgcn_rcpf(1.f + __builtin_amdgcn_exp2f(2.f * LOG2E * a[e]));
        } else if (c8 >= 896) {
#pragma unroll
            for (int e = 0; e < 8; ++e) a[e] = sigm(a[e]);
        }
        *(u32x4*)(AL + (size_t)m * 256 + (c8 - 768)) = pack8(a);
        } }
    }
}

__device__ __forceinline__ void ph_sb_prep_(const Ctx& C, int l) {
    bf16* SB = (bf16*)(C.ws + WS_SB);
    const int gw = C.bid * NWAVES + C.wave, NGW = C.G * NWAVES, lane = C.lane;
    const bool isk = lane >= 32; const int d0 = (lane & 7) * 8;
    const float* gn = (isk ? C.in[I_SB_KN] : C.in[I_SB_QN]) + (size_t)l * 64 + d0;
    float gg[8];
#pragma unroll
    for (int e = 0; e < 8; ++e) gg[e] = gn[e] * (isk ? 1.f : 0.125f * LOG2E);
    constexpr int NR = 4;
    for (int mb = gw; mb < T; mb += NR * NGW) {
        u32x4 uu[NR];
#pragma unroll
        for (int r = 0; r < NR; ++r) { const int m = mb + r * NGW; uu[r] = (u32x4){0u, 0u, 0u, 0u}; if (m < T) uu[r] = *(const u32x4*)(SB + (size_t)m * 768 + lane * 8); }
#pragma unroll
        for (int r = 0; r < NR; ++r) { const int m = mb + r * NGW; if (m < T) {
            bf16* p = SB + (size_t)m * 768 + lane * 8;
            float a[8]; unpack8(uu[r], a);
            float ss = 0.f;
#pragma unroll
            for (int e = 0; e < 8; ++e) ss += a[e] * a[e];
            ss += shx(ss, 1, lane); ss += shx(ss, 2, lane); ss += shx(ss, 4, lane);
            const float rs = 1.0f / sqrtf(ss * (1.f / 64.f) + 1e-6f);
#pragma unroll
            for (int e = 0; e < 8; ++e) a[e] = a[e] * rs * gg[e];
            *(u32x4*)p = pack8(a); } }
    }
}

__device__ __forceinline__ void ph_conv_(const Ctx& C, int l) {
    const bf16* CV = (const bf16*)(C.ws + WS_CV); bf16* Y = (bf16*)(C.ws + WS_Y);
    LAS float* U = (LAS float*)(C.lds); LAS float* OC = (LAS float*)(C.lds + 65536);
    const int tid = C.tid, c = tid & 255, half = tid >> 8;
    const float* dw = C.in[I_CONV_DW] + (size_t)l * 31 * 256; const float db = C.in[I_CONV_B][l * 256 + c];
    float dwr[31];
#pragma unroll
    for (int j = 0; j < 31; ++j) dwr[j] = dw[j * 256 + c];
    const float* lnw = C.in[I_CONV_LNW] + (size_t)l * 256; const float* lnb = C.in[I_CONV_LNB] + (size_t)l * 256;
    for (int u = C.bid; u < T / 32; u += C.G) {
        const int m0 = u * 32, t0 = m0 & (SEQ - 1);
        for (int it = tid; it < 62 * 32; it += NTHR) {
            const int r = it >> 5, c8 = (it & 31) * 8, tt = t0 - 30 + r; float a[8], b[8];
            if (tt >= 0) { const size_t mm = (size_t)(m0 - 30 + r); unpack8(*(const u32x4*)(CV + mm * 256 + c8), a); (void)b; }
            else {
#pragma unroll
                for (int e = 0; e < 8; ++e) a[e] = 0.f; }
#pragma unroll
            for (int e = 0; e < 8; ++e) U[r * 256 + c8 + e] = a[e];
        }
        __syncthreads();
        { float win[46];
#pragma unroll
          for (int i = 0; i < 46; ++i) win[i] = U[(half * 16 + i) * 256 + c];
#pragma unroll
          for (int tt = 0; tt < 16; ++tt) { float acc = db;
#pragma unroll
              for (int j = 0; j < 31; ++j) acc += dwr[j] * win[tt + j];
              OC[(half * 16 + tt) * 256 + c] = acc; } }
        __syncthreads();
#pragma unroll 1
        for (int q = 0; q < 4; ++q) { const int tl = C.wave * 4 + q; float v[4]; float s = 0.f;
#pragma unroll
            for (int i = 0; i < 4; ++i) { v[i] = OC[tl * 256 + C.lane + 64 * i]; s += v[i]; }
            const float mean = wave_sum(s, C.lane) * (1.f / 256.f); float s2 = 0.f;
#pragma unroll
            for (int i = 0; i < 4; ++i) { v[i] -= mean; s2 += v[i] * v[i]; }
            const float rstd = 1.0f / sqrtf(wave_sum(s2, C.lane) * (1.f / 256.f) + 1e-5f);
#pragma unroll
            for (int i = 0; i < 4; ++i) { const int cc = C.lane + 64 * i; const float y = v[i] * rstd * lnw[cc] + lnb[cc]; Y[(size_t)(m0 + tl) * 1024 + 768 + cc] = f2bf(y * sigm(y)); } }
        __syncthreads();
    }
}

__device__ __forceinline__ float ret_log2gamma(int h) { return log2f(1.0f - exp2f(-5.0f - (float)h)); }
__device__ __forceinline__ void ret_load_rot(const Ctx& C, const bf16* RET, int m0, int coff, float scale, LAS float* dst) {
    const int s = C.tid >> 3, d0 = (C.tid & 7) * 4;
    const float* cs = (const float*)(C.ws + WS_COS); const float* sn = (const float*)(C.ws + WS_SIN);
    const int pos = (m0 + s) & (SEQ - 1);
    const u32x2 a = *(const u32x2*)(RET + (size_t)(m0 + s) * 1024 + coff + d0), b = *(const u32x2*)(RET + (size_t)(m0 + s) * 1024 + coff + 32 + d0);
    const float x1[4] = {bflo(a.x), bfhi(a.x), bflo(a.y), bfhi(a.y)}, x2[4] = {bflo(b.x), bfhi(b.x), bflo(b.y), bfhi(b.y)};
    const f32x4 cv = *(const f32x4*)(cs + (size_t)pos * 32 + d0), sv = *(const f32x4*)(sn + (size_t)pos * 32 + d0);
#pragma unroll
    for (int e = 0; e < 4; ++e) { dst[s * 65 + d0 + e] = (x1[e] * cv[e] - x2[e] * sv[e]) * scale; dst[s * 65 + 32 + d0 + e] = (x1[e] * sv[e] + x2[e] * cv[e]) * scale; }
}
__device__ __forceinline__ void ph_ret_kv_(const Ctx& C) {
    const bf16* RET = (const bf16*)(C.ws + WS_RET); float* KV = (float*)(C.ws + WS_KV);
    LAS float* KD = (LAS float*)(C.lds); LAS float* VV = (LAS float*)(C.lds + 32768);
    const int tid = C.tid;
    for (int u = C.bid; u < 2048; u += C.G) {
        const int bh = u >> 8, ch = u & 255, b = bh >> 2, h = bh & 3, m0 = b * SEQ + ch * 64;
        const float lg = ret_log2gamma(h);
        ret_load_rot(C, RET, m0, 256 + h * 64, 0.125f, KD);
        { const int s = tid >> 3, e0 = (tid & 7) * 8; float a[8]; unpack8(*(const u32x4*)(RET + (size_t)(m0 + s) * 1024 + 512 + h * 64 + e0), a);
          const float dec = exp2f(lg * (float)(63 - s));
#pragma unroll
          for (int e = 0; e < 8; ++e) VV[s * 64 + e0 + e] = a[e] * dec; }
        __syncthreads();
        const int d = tid >> 3, e0 = (tid & 7) * 8; float acc[8];
#pragma unroll
        for (int e = 0; e < 8; ++e) acc[e] = 0.f;
#pragma unroll 4
        for (int s = 0; s < 64; ++s) { const float kd = KD[s * 65 + d]; const f32x4 v0 = *(const LAS f32x4*)(VV + s * 64 + e0), v1 = *(const LAS f32x4*)(VV + s * 64 + e0 + 4);
            acc[0] += kd * v0.x; acc[1] += kd * v0.y; acc[2] += kd * v0.z; acc[3] += kd * v0.w; acc[4] += kd * v1.x; acc[5] += kd * v1.y; acc[6] += kd * v1.z; acc[7] += kd * v1.w; }
        float* o = KV + (size_t)u * 4096 + d * 64 + e0;
        *(f32x4*)o = (f32x4){acc[0], acc[1], acc[2], acc[3]}; *(f32x4*)(o + 4) = (f32x4){acc[4], acc[5], acc[6], acc[7]};
        __syncthreads();
    }
}
__device__ __forceinline__ void ph_ret_scan_(const Ctx& C) {
    float* KV = (float*)(C.ws + WS_KV);
    const int wg0 = (C.G >= 256) ? 128 : 0, nw = C.G - wg0;
    for (int i = (C.bid - wg0) * NTHR + C.tid; i < 8 * 4096 && C.bid >= wg0; i += nw * NTHR) {
        const int bh = i >> 12, el = i & 4095, h = bh & 3;
        const float cd = exp2f(ret_log2gamma(h) * 64.f);
        float* p = KV + (size_t)bh * 256 * 4096 + el; float S = 0.f;
#pragma unroll 1
        for (int c = 0; c < 256; c += 32) { float kv[32];
#pragma unroll
            for (int q = 0; q < 32; ++q) kv[q] = p[(size_t)(c + q) * 4096];
#pragma unroll
            for (int q = 0; q < 32; ++q) { p[(size_t)(c + q) * 4096] = S; S = S * cd + kv[q]; } }
    }
}
__device__ __forceinline__ void ph_ret_out_(const Ctx& C, int l, int first_wg, int nwg) {
    const bf16* RET = (const bf16*)(C.ws + WS_RET); const float* KV = (const float*)(C.ws + WS_KV); bf16* Y = (bf16*)(C.ws + WS_Y);
    LAS float* Q = (LAS float*)(C.lds); LAS float* Kk = (LAS float*)(C.lds + 16640); LAS float* VV = (LAS float*)(C.lds + 33280); LAS float* SS = (LAS float*)(C.lds + 49664); LAS float* SC = (LAS float*)(C.lds + 66048);
    const int tid = C.tid; const float* gn = C.in[I_RET_GN] + (size_t)l * 256;
    for (int u = C.bid - first_wg; u < 2048; u += nwg) {
        const int bh = u >> 8, ch = u & 255, b = bh >> 2, h = bh & 3, m0 = b * SEQ + ch * 64;
        const float lg = ret_log2gamma(h);
        ret_load_rot(C, RET, m0, h * 64, 1.0f, Q);
        ret_load_rot(C, RET, m0, 256 + h * 64, 0.125f, Kk);
        { const int s = tid >> 3, e0 = (tid & 7) * 8; float a[8]; unpack8(*(const u32x4*)(RET + (size_t)(m0 + s) * 1024 + 512 + h * 64 + e0), a);
#pragma unroll
          for (int e = 0; e < 8; ++e) VV[s * 64 + e0 + e] = a[e];
          const float* sp = KV + (size_t)u * 4096 + s * 64 + e0; const f32x4 s0 = *(const f32x4*)sp, s1 = *(const f32x4*)(sp + 4);
          *(LAS f32x4*)(SS + s * 64 + e0) = s0; *(LAS f32x4*)(SS + s * 64 + e0 + 4) = s1; }
        __syncthreads();
        const int t = tid >> 3, g8 = tid & 7;
        { float sc[8];
#pragma unroll
          for (int i = 0; i < 8; ++i) sc[i] = 0.f;
#pragma unroll 4
          for (int d = 0; d < 64; ++d) { const float qv = Q[t * 65 + d];
#pragma unroll
              for (int i = 0; i < 8; ++i) sc[i] += qv * Kk[(g8 * 8 + i) * 65 + d]; }
#pragma unroll
          for (int i = 0; i < 8; ++i) { const int s = g8 * 8 + i; SC[t * 65 + s] = (s <= t) ? sc[i] * exp2f(lg * (float)(t - s)) : 0.f; } }
        __syncthreads();
        { const int e0 = g8 * 8; float o[8], o2[8];
#pragma unroll
          for (int e = 0; e < 8; ++e) { o[e] = 0.f; o2[e] = 0.f; }
#pragma unroll 4
          for (int s = 0; s < 64; ++s) { const float p = SC[t * 65 + s]; const f32x4 v0 = *(const LAS f32x4*)(VV + s * 64 + e0), v1 = *(const LAS f32x4*)(VV + s * 64 + e0 + 4);
              o[0] += p * v0.x; o[1] += p * v0.y; o[2] += p * v0.z; o[3] += p * v0.w; o[4] += p * v1.x; o[5] += p * v1.y; o[6] += p * v1.z; o[7] += p * v1.w; }
#pragma unroll 4
          for (int d = 0; d < 64; ++d) { const float qv = Q[t * 65 + d]; const f32x4 v0 = *(const LAS f32x4*)(SS + d * 64 + e0), v1 = *(const LAS f32x4*)(SS + d * 64 + e0 + 4);
              o2[0] += qv * v0.x; o2[1] += qv * v0.y; o2[2] += qv * v0.z; o2[3] += qv * v0.w; o2[4] += qv * v1.x; o2[5] += qv * v1.y; o2[6] += qv * v1.z; o2[7] += qv * v1.w; }
          const float qd = exp2f(lg * (float)(t + 1)); float s1 = 0.f;
#pragma unroll
          for (int e = 0; e < 8; ++e) { o[e] += qd * o2[e]; s1 += o[e]; }
          s1 += shx(s1, 1, C.lane); s1 += shx(s1, 2, C.lane); s1 += shx(s1, 4, C.lane);
          const float mean = s1 * (1.f / 64.f); float s2 = 0.f;
#pragma unroll
          for (int e = 0; e < 8; ++e) { o[e] -= mean; s2 += o[e] * o[e]; }
          s2 += shx(s2, 1, C.lane); s2 += shx(s2, 2, C.lane); s2 += shx(s2, 4, C.lane);
          const float rstd = 1.0f / sqrtf(s2 * (1.f / 64.f) + 1e-5f);
          float gtv[8]; unpack8(*(const u32x4*)(RET + (size_t)(m0 + t) * 1024 + 768 + h * 64 + e0), gtv);
#pragma unroll
          for (int e = 0; e < 8; ++e) o[e] = o[e] * rstd * gn[h * 64 + e0 + e] * (gtv[e] * sigm(gtv[e]));
          *(u32x4*)(Y + (size_t)(m0 + t) * 1024 + 512 + h * 64 + e0) = pack8(o); }
        __syncthreads();
    }
}

constexpr int RWC = 64, RW_NCH = SEQ / RWC, RW_NU = 8 * RW_NCH;
constexpr int RW_SUP = 8, RW_NSC = RW_NCH / RW_SUP, RW_NSUP = 8 * RW_NSC;
__device__ __forceinline__ void ph_rw_local_(const Ctx& C, int l) {
    const bf16* RKVS = (const bf16*)(C.ws + WS_RKVS); const float* WDEC = (const float*)(C.ws + WS_WDEC); const bf16* AG = (const bf16*)(C.ws + WS_AG);
    bf16* Y0 = (bf16*)(C.ws + WS_Y0); bf16* RH = (bf16*)(C.ws + WS_RHAT); float* PQ = (float*)(C.ws + WS_PQ); float* BON = (float*)(C.ws + WS_BON);
    const int lane = C.lane;
    LAS float* base = (LAS float*)(C.lds + C.wave * 12288);
    for (int it = C.bid; it < RW_NU / 8; it += C.G) {
        const int u = it * 8 + C.wave, bh = u >> 8, ch = u & 255, b = bh >> 2, h = bh & 3, m0 = b * SEQ + ch * RWC, hc = h * 64 + lane;
        const float mur = C.in[I_RW_MU][l * 1024 + hc], muk = C.in[I_RW_MU][l * 1024 + 256 + hc], muv = C.in[I_RW_MU][l * 1024 + 512 + hc];
        const float kkw = C.in[I_RW_KK][l * 256 + hc], kaw = C.in[I_RW_KA][l * 256 + hc], rkw = C.in[I_RW_RK][l * 256 + hc], w0l = C.in[I_RW_W0][l * 256 + hc], a0l = C.in[I_RW_A0][l * 256 + hc];
        f32x2 sL[32], sI[32];
        { int ln = lane; asm volatile("" : "+v"(ln));
#pragma unroll
          for (int k = 0; k < 32; ++k) { sL[k] = (f32x2){0.f, 0.f}; sI[k].x = (2 * k == ln) ? 1.f : 0.f; sI[k].y = (2 * k + 1 == ln) ? 1.f : 0.f; } }
#pragma unroll 1
        for (int sb = 0; sb < RWC / 8; ++sb) {
            asm volatile("" ::: "memory");
#pragma unroll
            for (int i = 0; i < 8; ++i) { const size_t m = (size_t)(m0 + sb * 8 + i);
                const float r = bf2f(RKVS[m * 768 + hc]), k = bf2f(RKVS[m * 768 + 256 + hc]), v = bf2f(RKVS[m * 768 + 512 + hc]);
                const float w = __builtin_amdgcn_exp2f(-0.606531f * LOG2E * sigm(WDEC[m * 256 + hc] + w0l)), a = sigm(bf2f(AG[m * 512 + hc]) + a0l);
                const float kr = k * kkw; const float nn = sqrtf(wave_sum(kr * kr, C.lane)); const float kk = kr / fmaxf(nn, 1e-12f);
                const float kp = k * (1.f + (a - 1.f) * kaw);
                const float bon = wave_sum(r * kp * rkw, C.lane);
                if (lane == 0) BON[m * 4 + h] = bon;
                base[0 * 512 + i * 64 + lane] = w; base[1 * 512 + i * 64 + lane] = kk; base[2 * 512 + i * 64 + lane] = kk * a; base[3 * 512 + i * 64 + lane] = kp; base[4 * 512 + i * 64 + lane] = r; base[5 * 512 + i * 64 + lane] = v; }
            asm volatile("" ::: "memory");
#pragma unroll 1
            for (int i = 0; i < 8; ++i) {
                const LAS f32x4* wv = (const LAS f32x4*)(base + 0 * 512 + i * 64); const LAS f32x4* kkv = (const LAS f32x4*)(base + 1 * 512 + i * 64); const LAS f32x4* kav = (const LAS f32x4*)(base + 2 * 512 + i * 64);
                const LAS f32x4* kpv = (const LAS f32x4*)(base + 3 * 512 + i * 64); const LAS f32x4* rv = (const LAS f32x4*)(base + 4 * 512 + i * 64);
                const float vv = base[5 * 512 + i * 64 + lane];
                f32x4 kq[2][4];
#pragma unroll
                for (int t = 0; t < 4; ++t) kq[0][t] = kkv[t];
                f32x2 dL0 = (f32x2){0.f, 0.f}, dL1 = dL0, dI0 = dL0, dI1 = dL0;
                f32x4 ga[2][4];
#pragma unroll
                for (int g = 0; g < 4; ++g) {
                    __builtin_amdgcn_sched_barrier(0);
                    if (g + 1 < 4) {
#pragma unroll
                        for (int t = 0; t < 4; ++t) kq[(g + 1) & 1][t] = kkv[4 * (g + 1) + t]; }
                    else { ga[0][0] = wv[0]; ga[0][1] = kav[0]; ga[0][2] = kpv[0]; ga[0][3] = rv[0]; }
                    __builtin_amdgcn_sched_barrier(0);
#pragma unroll
                    for (int t = 0; t < 4; ++t) { const int k4 = 4 * g + t; const f32x4 q4 = kq[g & 1][t];
                        dL0 += sL[2 * k4] * q4.xy; dL1 += sL[2 * k4 + 1] * q4.zw; dI0 += sI[2 * k4] * q4.xy; dI1 += sI[2 * k4 + 1] * q4.zw; }
                }
                const float saL = -((dL0.x + dL0.y) + (dL1.x + dL1.y)), saI = -((dI0.x + dI0.y) + (dI1.x + dI1.y));
                const f32x2 saLv = (f32x2){saL, saL}, saIv = (f32x2){saI, saI}, vvv = (f32x2){vv, vv};
                f32x2 yL0 = (f32x2){0.f, 0.f}, yL1 = yL0, yI0 = yL0, yI1 = yL0;
#pragma unroll
                for (int k4 = 0; k4 < 16; ++k4) {
                    __builtin_amdgcn_sched_barrier(0);
                    if (k4 + 1 < 16) { ga[(k4 + 1) & 1][0] = wv[k4 + 1]; ga[(k4 + 1) & 1][1] = kav[k4 + 1]; ga[(k4 + 1) & 1][2] = kpv[k4 + 1]; ga[(k4 + 1) & 1][3] = rv[k4 + 1]; }
                    __builtin_amdgcn_sched_barrier(0);
                    const f32x4 wq = ga[k4 & 1][0], aq = ga[k4 & 1][1], pq = ga[k4 & 1][2], rq = ga[k4 & 1][3];
                    sL[2 * k4]     = sL[2 * k4]     * wq.xy + saLv * aq.xy + vvv * pq.xy; yL0 += sL[2 * k4]     * rq.xy;
                    sL[2 * k4 + 1] = sL[2 * k4 + 1] * wq.zw + saLv * aq.zw + vvv * pq.zw; yL1 += sL[2 * k4 + 1] * rq.zw;
                    sI[2 * k4]     = sI[2 * k4]     * wq.xy + saIv * aq.xy;                  yI0 += sI[2 * k4]     * rq.xy;
                    sI[2 * k4 + 1] = sI[2 * k4 + 1] * wq.zw + saIv * aq.zw;                  yI1 += sI[2 * k4 + 1] * rq.zw;
                }
                __builtin_amdgcn_sched_barrier(0);
                const size_t m = (size_t)(m0 + sb * 8 + i);
                Y0[m * 256 + hc] = f2bf((yL0.x + yL0.y) + (yL1.x + yL1.y));
                RH[m * 256 + hc] = f2bf((yI0.x + yI0.y) + (yI1.x + yI1.y));
            }
        }
        float* oq = PQ + (size_t)u * 4096 + lane * 64; float* opt = PQ + ((size_t)RW_NU + u) * 4096 + lane;
#pragma unroll
        for (int k4 = 0; k4 < 16; ++k4) { *(f32x4*)(oq + 4 * k4) = (f32x4){sL[2 * k4].x, sL[2 * k4].y, sL[2 * k4 + 1].x, sL[2 * k4 + 1].y};
            opt[(4 * k4) * 64] = sI[2 * k4].x; opt[(4 * k4 + 1) * 64] = sI[2 * k4].y; opt[(4 * k4 + 2) * 64] = sI[2 * k4 + 1].x; opt[(4 * k4 + 3) * 64] = sI[2 * k4 + 1].y; }
    }
}
constexpr int WY_LT = 24;
constexpr int WY_ROWM = 0, WY_COLM = 36864, WY_AMAT = 73728, WY_AABF = 89088, WY_SB = 93184, WY_WT = 111616, WY_UT = 117760, WY_GH = 123904, WY_GC = 125952;
__device__ __forceinline__ f32x4 wy_mm16(const LAS bf16* X, const LAS bf16* Y, f32x4 acc, int li, int lq) {
#pragma unroll
    for (int ks = 0; ks < 2; ++ks) { const bf16x8 a = *(const LAS bf16x8*)(X + li * MM_LP + 32 * ks + 8 * lq), b = *(const LAS bf16x8*)(Y + li * MM_LP + 32 * ks + 8 * lq);
        acc = __builtin_amdgcn_mfma_f32_16x16x32_bf16(a, b, acc, 0, 0, 0); }
    return acc;
}
__device__ __forceinline__ f32x4 wy_mm16k16(const LAS bf16* X, const LAS bf16* Y, f32x4 acc, int li, int lq) {
    const s16x4 a = *(const LAS s16x4*)(X + li * WY_LT + 4 * lq), b = *(const LAS s16x4*)(Y + li * WY_LT + 4 * lq);
    return __builtin_amdgcn_mfma_f32_16x16x16bf16_1k(a, b, acc, 0, 0, 0);
}
__device__ __forceinline__ void ph_rw_local_wy_(const Ctx& C, int l) {
    const bf16* RWp = (const bf16*)(C.ws + WS_RW); const float* WDEC = (const float*)(C.ws + WS_WDEC); const bf16* AG = (const bf16*)(C.ws + WS_AP);
    bf16* Y0 = (bf16*)(C.ws + WS_Y0); bf16* RH = (bf16*)(C.ws + WS_RHAT); float* PQ = (float*)(C.ws + WS_PQ); float* BON = (float*)(C.ws + WS_BON);
    const int lane = C.lane, w = C.wave, li = lane & 15, lq = lane >> 4, j32 = lane & 31, hi = lane >> 5, ti = w >> 1, tj = w & 1, sq = w >> 1, half = w & 1;
    LAS unsigned char* L = C.lds;
#define WY_ROW(q, m) ((LAS bf16*)(L + WY_ROWM + (q) * 9216 + (m) * 2304))
#define WY_COL(q, m) ((LAS bf16*)(L + WY_COLM + (q) * 9216 + (m) * 3072))
#define WY_A(q, id)  ((LAS bf16*)(L + WY_AMAT + (q) * 3840 + (id) * 768))
    LAS bf16* SB = (LAS bf16*)(L + WY_SB); LAS bf16* WT = (LAS bf16*)(L + WY_WT); LAS bf16* UT = (LAS bf16*)(L + WY_UT);
    LAS float* GH = (LAS float*)(L + WY_GH); LAS float* GCs = (LAS float*)(L + WY_GC);
    for (int su = C.bid; su < RW_NSUP; su += C.G) {
    f32x16 S;
    bf16 r16[9], k16[9], v16[9], a16[8]; float wd[8];
#define WY_RAW(uu) do { const int u_ = (uu), bh_ = u_ >> 8, ch_ = u_ & 255; const size_t mb_ = (size_t)((bh_ >> 2) * SEQ + ch_ * RWC + 8 * w); const int hc_ = (bh_ & 3) * 64 + lane; \
        r16[0] = 0; k16[0] = 0; v16[0] = 0; if (ch_ * RWC + 8 * w > 0) { r16[0] = RWp[(mb_ - 1) * 1024 + hc_]; k16[0] = RWp[(mb_ - 1) * 1024 + 256 + hc_]; v16[0] = RWp[(mb_ - 1) * 1024 + 512 + hc_]; } \
        _Pragma("unroll") for (int i = 0; i < 8; ++i) { const size_t m = mb_ + i; \
        r16[i + 1] = RWp[m * 1024 + hc_]; k16[i + 1] = RWp[m * 1024 + 256 + hc_]; v16[i + 1] = RWp[m * 1024 + 512 + hc_]; wd[i] = WDEC[m * 256 + hc_]; a16[i] = AG[m * 256 + hc_]; } } while (0)
    WY_RAW(su * RW_SUP);
#pragma unroll 1
    for (int cc = 0; cc < RW_SUP; ++cc) {
        const int u = su * RW_SUP + cc;
        const int bh = u >> 8, ch = u & 255, b = bh >> 2, h = bh & 3, m0 = b * SEQ + ch * RWC, hc = h * 64 + lane;
        const float mur = C.in[I_RW_MU][l * 1024 + hc], muk = C.in[I_RW_MU][l * 1024 + 256 + hc], muv = C.in[I_RW_MU][l * 1024 + 512 + hc];
        const float kkw = C.in[I_RW_KK][l * 256 + hc], kaw = C.in[I_RW_KA][l * 256 + hc], rkw = C.in[I_RW_RK][l * 256 + hc], w0l = C.in[I_RW_W0][l * 256 + hc], a0l = C.in[I_RW_A0][l * 256 + hc];
        { float wv[8], kk[8], ka[8], kp[8], rr[8], vv[8];
          float bon8[8], rf[8], kf[8], af[8], wf[8];
#pragma unroll
          for (int i = 0; i < 8; ++i) { const float rc = bf2f(r16[i + 1]), kc = bf2f(k16[i + 1]), vc = bf2f(v16[i + 1]);
              rf[i] = rc + (bf2f(r16[i]) - rc) * mur; kf[i] = kc + (bf2f(k16[i]) - kc) * muk; vv[i] = vc + (bf2f(v16[i]) - vc) * muv; af[i] = bf2f(a16[i]); wf[i] = wd[i]; }
          if (cc + 1 < RW_SUP) WY_RAW(u + 1);
#pragma unroll
          for (int i = 0; i < 8; ++i) {
              const float r = rf[i], k = kf[i];
              wv[i] = __builtin_amdgcn_exp2f(-0.606531f * LOG2E * sigm(wf[i] + w0l)); const float a = sigm(af[i] + a0l);
              const float kr = k * kkw; kk[i] = kr * __builtin_amdgcn_rsqf(fmaxf(wave_sum(kr * kr, lane), 1e-24f));
              kp[i] = k * (1.f + (a - 1.f) * kaw); ka[i] = kk[i] * a; rr[i] = r;
              bon8[i] = wave_sum(r * kp[i] * rkw, lane); }
          if (lane == 0) {
#pragma unroll
              for (int i = 0; i < 8; ++i) BON[(size_t)(m0 + 8 * w + i) * 4 + h] = bon8[i]; }
          float cp[8]; cp[0] = wv[0];
#pragma unroll
          for (int i = 1; i < 8; ++i) cp[i] = cp[i - 1] * wv[i];
          GH[w * 64 + lane] = cp[7];
          __syncthreads();
          const float pre = half ? GH[(w - 1) * 64 + lane] : 1.f, gC = half ? pre * cp[7] : cp[7] * GH[(w + 1) * 64 + lane];
          if (!half) GCs[sq * 64 + lane] = gC;
#pragma unroll
          for (int i = 0; i < 8; ++i) { const int t = 8 * half + i; const float G = pre * cp[i], Gm1 = (i == 0) ? pre : pre * cp[i - 1], rG = __builtin_amdgcn_rcpf(G);
              WY_ROW(sq, 0)[t * MM_LP + lane] = f2bf(-kk[i] * Gm1); WY_ROW(sq, 1)[t * MM_LP + lane] = f2bf(ka[i] * rG); WY_ROW(sq, 2)[t * MM_LP + lane] = f2bf(kp[i] * rG); WY_ROW(sq, 3)[t * MM_LP + lane] = f2bf(rr[i] * G);
              WY_COL(sq, 0)[lane * WY_LT + t] = f2bf(ka[i] * rG * gC); WY_COL(sq, 1)[lane * WY_LT + t] = f2bf(kp[i] * rG * gC); WY_COL(sq, 2)[lane * WY_LT + t] = f2bf(vv[i]); } }
        __syncthreads();
#pragma unroll
        for (int pp = 0; pp < 2; ++pp) { const int id = 2 * half + pp;
            f32x4 acc = (f32x4){0.f, 0.f, 0.f, 0.f};
            acc = wy_mm16(WY_ROW(sq, half ? 3 : 0), WY_ROW(sq, pp ? 2 : 1), acc, li, lq);
#pragma unroll
            for (int r = 0; r < 4; ++r) { const int t = 4 * lq + r; const bool keep = half ? (li <= t) : (li < t); const float val = keep ? acc[r] : 0.f;
                WY_A(sq, id)[t * WY_LT + li] = f2bf(val); if (id == 0) ((LAS float*)(L + WY_AABF + sq * 1024))[t * 16 + li] = val; } }
        __syncthreads();
        if (w < 4) { const LAS float* Af = (const LAS float*)(L + WY_AABF + w * 1024); float Tc[16];
#pragma unroll
            for (int t = 0; t < 16; ++t) { float acc = (t == li) ? 1.f : 0.f;
#pragma unroll
                for (int s4 = 0; s4 < 4; ++s4) { if (4 * s4 < t) { const f32x4 a4 = *(const LAS f32x4*)(Af + t * 16 + 4 * s4);
                    if (4 * s4 + 0 < t) acc += a4.x * Tc[4 * s4 + 0]; if (4 * s4 + 1 < t) acc += a4.y * Tc[4 * s4 + 1]; if (4 * s4 + 2 < t) acc += a4.z * Tc[4 * s4 + 2]; if (4 * s4 + 3 < t) acc += a4.w * Tc[4 * s4 + 3]; } }
                Tc[t] = acc; WY_A(w, 4)[t * WY_LT + li] = f2bf(acc); } }
        if (cc == 0) {
#pragma unroll
            for (int r = 0; r < 4; ++r)
#pragma unroll
                for (int e = 0; e < 4; ++e) { const int row = 32 * ti + 8 * r + 4 * hi + e, col = 32 * tj + j32; S[4 * r + e] = (ti >= 2 && row - 64 == col) ? 1.f : 0.f; }
#pragma unroll
            for (int r = 0; r < 4; ++r)
#pragma unroll
                for (int e = 0; e < 4; ++e) SB[(32 * ti + 8 * r + 4 * hi + e) * MM_LP + 32 * tj + j32] = f2bf(S[4 * r + e]);
        }
        __syncthreads();
#pragma unroll 1
        for (int q = 0; q < 4; ++q) {
            f32x4 accW = (f32x4){0.f, 0.f, 0.f, 0.f}, accY = accW;
            accW = wy_mm16(WY_ROW(q, 0), SB + 16 * w * MM_LP, accW, li, lq);
            accY = wy_mm16(WY_ROW(q, 3), SB + 16 * w * MM_LP, accY, li, lq);
            if (w < 4) accW = wy_mm16k16(WY_A(q, 1), WY_COL(q, 2) + 16 * w * WY_LT, accW, li, lq);
            { u32x2 pk; pk.x = cvt_pk_bf16(accW[0], accW[1]); pk.y = cvt_pk_bf16(accW[2], accW[3]); *(LAS u32x2*)(WT + (16 * w + li) * WY_LT + 4 * lq) = pk; }
            asm volatile("s_waitcnt lgkmcnt(0)" ::: "memory");
            { f32x4 accU = (f32x4){0.f, 0.f, 0.f, 0.f}; accU = wy_mm16k16(WY_A(q, 4), WT + 16 * w * WY_LT, accU, li, lq);
              u32x2 pk; pk.x = cvt_pk_bf16(accU[0], accU[1]); pk.y = cvt_pk_bf16(accU[2], accU[3]); *(LAS u32x2*)(UT + (16 * w + li) * WY_LT + 4 * lq) = pk; }
            asm volatile("s_waitcnt lgkmcnt(0)" ::: "memory");
            accY = wy_mm16k16(WY_A(q, 2), UT + 16 * w * WY_LT, accY, li, lq);
            if (w < 4) accY = wy_mm16k16(WY_A(q, 3), WY_COL(q, 2) + 16 * w * WY_LT, accY, li, lq);
            { bf16* dst = (w < 4) ? Y0 : RH; const int colo = h * 64 + ((16 * w) & 63) + li;
#pragma unroll
              for (int r = 0; r < 4; ++r) dst[(size_t)(m0 + 16 * q + 4 * lq + r) * 256 + colo] = f2bf(accY[r]); }
            __syncthreads();
            { const float gc = GCs[q * 64 + 32 * tj + j32];
#pragma unroll
              for (int i = 0; i < 16; ++i) S[i] *= gc;
              const bf16x8 ua = *(const LAS bf16x8*)(UT + (32 * ti + j32) * WY_LT + 8 * hi), bb = *(const LAS bf16x8*)(WY_COL(q, 0) + (32 * tj + j32) * WY_LT + 8 * hi);
              S = __builtin_amdgcn_mfma_f32_32x32x16_bf16(ua, bb, S, 0, 0, 0);
              if (ti < 2) { const bf16x8 va = *(const LAS bf16x8*)(WY_COL(q, 2) + (32 * ti + j32) * WY_LT + 8 * hi), kb = *(const LAS bf16x8*)(WY_COL(q, 1) + (32 * tj + j32) * WY_LT + 8 * hi);
                  S = __builtin_amdgcn_mfma_f32_32x32x16_bf16(va, kb, S, 0, 0, 0); } }
            {
#pragma unroll
                for (int r = 0; r < 4; ++r)
#pragma unroll
                    for (int e = 0; e < 4; ++e) SB[(32 * ti + 8 * r + 4 * hi + e) * MM_LP + 32 * tj + j32] = f2bf(S[4 * r + e]);
                __syncthreads(); }
        }
        if (cc == RW_SUP - 1) {
        if (ti < 2) { float* o = PQ + (size_t)su * 4096 + (size_t)(32 * ti + 4 * hi) * 64 + 32 * tj + j32;
#pragma unroll
            for (int r = 0; r < 4; ++r)
#pragma unroll
                for (int e = 0; e < 4; ++e) o[(8 * r + e) * 64] = S[4 * r + e]; }
        else { float* o = PQ + ((size_t)RW_NSUP + su) * 4096 + (size_t)(32 * tj + j32) * 64 + 32 * (ti - 2) + 4 * hi;
#pragma unroll
            for (int r = 0; r < 4; ++r) *(f32x4*)(o + 8 * r) = (f32x4){S[4 * r], S[4 * r + 1], S[4 * r + 2], S[4 * r + 3]}; }
        }
        __syncthreads();
    }
    }
#undef WY_ROW
#undef WY_COL
#undef WY_A
#undef WY_RAW
}
__device__ __forceinline__ void ph_rw_scan_(const Ctx& C, int wg) {
    const float* Qg = (const float*)(C.ws + WS_PQ); const float* Pg = Qg + (size_t)RW_NSUP * 4096; float* SST = (float*)(C.ws + WS_SST);
    LAS bf16* PT = (LAS bf16*)(C.lds);
    LAS bf16* SLb = PT + 2 * 64 * MM_LP;
    LAS float* QL = (LAS float*)(C.lds + (2 * 64 * MM_LP + 2 * 16 * MM_LP) * 2);
    LAS float* SO = QL + 2 * 16 * 64;
    const int lane = C.lane, wave = C.wave, bh = wg >> 2, rq = wg & 3, ct = wave & 3, li = lane & 15, lq = lane >> 4;
    const bool mm = wave < 4;
    const size_t ubase = (size_t)bh * RW_NSC;
    const int lt = C.tid & 255;
    const int qrow = lt >> 4, qc4 = (lt & 15) * 4;
    constexpr int PD = 6;
    f32x4 pr[PD][4], qr[PD];
#define SC_P_PIECE(i) (lt + 256 * (i))
#define SC_PUT_P(buf, sx_) do { LAS bf16* d_ = PT + (buf) * (64 * MM_LP); _Pragma("unroll") for (int i_ = 0; i_ < 4; ++i_) { const int idx_ = SC_P_PIECE(i_), r_ = (idx_ * 4) >> 6, k_ = (idx_ * 4) & 63; u32x2 w_; \
        w_.x = cvt_pk_bf16(pr[sx_][i_].x, pr[sx_][i_].y); w_.y = cvt_pk_bf16(pr[sx_][i_].z, pr[sx_][i_].w); *(LAS u32x2*)(d_ + r_ * MM_LP + k_) = w_; } } while (0)
#define SC_LOAD(sx_, cc) do { const f32x4* p4_ = (const f32x4*)(Pg + (ubase + (cc)) * 4096); _Pragma("unroll") for (int i_ = 0; i_ < 4; ++i_) pr[sx_][i_] = p4_[SC_P_PIECE(i_)]; \
        qr[sx_] = *(const f32x4*)(Qg + (ubase + (cc)) * 4096 + (rq * 16 + qrow) * 64 + qc4); } while (0)
    if (mm) {
#pragma unroll
        for (int r = 0; r < 4; ++r) SLb[(4 * lq + r) * MM_LP + ct * 16 + li] = (bf16)0;
    } else {
        { float z0; asm volatile("v_mov_b32 %0, 0" : "=v"(z0));
          *(f32x4*)(SST + ubase * 4096 + (rq * 16 + qrow) * 64 + qc4) = (f32x4){z0, z0, z0, z0}; }
        SC_LOAD(0, 0); SC_PUT_P(0, 0); *(LAS f32x4*)(QL + qrow * 64 + qc4) = qr[0];
#pragma unroll
        for (int x = 0; x < PD; ++x) SC_LOAD(x, 1 + x);
    }
    __syncthreads();
#pragma unroll 1
    for (int c2 = 0; c2 < RW_NSC; c2 += PD) {
#pragma unroll
        for (int x = 0; x < PD; ++x) {
            const int c = c2 + x;
            if (c < RW_NSC) {
            if (mm) {
                const LAS bf16* Pc = PT + (c & 1) * (64 * MM_LP); const LAS bf16* Sc = SLb + (c & 1) * (16 * MM_LP); const LAS float* Qc = QL + (c & 1) * (16 * 64);
                LAS bf16* Sn = SLb + ((c + 1) & 1) * (16 * MM_LP); LAS float* So = SO + ((c + 1) & 1) * (16 * 64);
                bf16x8 af[2], bfr[2];
#pragma unroll
                for (int ks = 0; ks < 2; ++ks) { af[ks] = *(const LAS bf16x8*)(Sc + li * MM_LP + 32 * ks + 8 * lq); bfr[ks] = *(const LAS bf16x8*)(Pc + (16 * ct + li) * MM_LP + 32 * ks + 8 * lq); }
                f32x4 acc;
#pragma unroll
                for (int r = 0; r < 4; ++r) acc[r] = Qc[(4 * lq + r) * 64 + ct * 16 + li];
#pragma unroll
                for (int ks = 0; ks < 2; ++ks) acc = __builtin_amdgcn_mfma_f32_16x16x32_bf16(af[ks], bfr[ks], acc, 0, 0, 0);
                if (c + 1 < RW_NSC) {
#pragma unroll
                    for (int r = 0; r < 4; ++r) { Sn[(4 * lq + r) * MM_LP + ct * 16 + li] = f2bf(acc[r]); So[(4 * lq + r) * 64 + ct * 16 + li] = acc[r]; } }
            } else {
                if (c > 0) *(f32x4*)(SST + (ubase + c) * 4096 + (rq * 16 + qrow) * 64 + qc4) = *(const LAS f32x4*)(SO + (c & 1) * (16 * 64) + qrow * 64 + qc4);
                if (c + 1 < RW_NSC) { SC_PUT_P((c + 1) & 1, x); *(LAS f32x4*)(QL + ((c + 1) & 1) * (16 * 64) + qrow * 64 + qc4) = qr[x]; }
                if (c + 1 + PD < RW_NSC) SC_LOAD(x, c + 1 + PD);
            }
            __syncthreads();
#ifdef SCAN_2BAR
            __syncthreads();
#endif
            }
        }
    }
#undef SC_PUT_P
#undef SC_LOAD
#undef SC_P_PIECE
}
__device__ __forceinline__ void ph_rw_out_(const Ctx& C, int l) {
    const bf16* RKVS = (const bf16*)(C.ws + WS_RKVS); const bf16* AG = (const bf16*)(C.ws + WS_AG); const bf16* Y0 = (const bf16*)(C.ws + WS_Y0); const bf16* RH = (const bf16*)(C.ws + WS_RHAT);
    const float* SST = (const float*)(C.ws + WS_SST); const float* BON = (const float*)(C.ws + WS_BON); bf16* Y = (bf16*)(C.ws + WS_Y);
    LAS float* RL = (LAS float*)(C.lds);
    const int lane = C.lane, wave = C.wave;
    for (int u = C.bid; u < RW_NU; u += C.G) {
        const int bh = u >> 8, ch = u & 255, b = bh >> 2, h = bh & 3, m0 = b * SEQ + ch * RWC, hc = h * 64 + lane;
        { const int t = C.tid >> 3, d0 = (C.tid & 7) * 8; float a[8];
          unpack8(*(const u32x4*)(RH + (size_t)(m0 + t) * 256 + h * 64 + d0), a);
#pragma unroll
          for (int e = 0; e < 8; ++e) RL[t * 64 + d0 + e] = a[e]; }
        float s[64];
        { const f32x4* sp = (const f32x4*)(SST + (size_t)u * 4096 + lane * 64);
#pragma unroll
          for (int k4 = 0; k4 < 16; ++k4) { const f32x4 v = sp[k4]; s[4 * k4] = v.x; s[4 * k4 + 1] = v.y; s[4 * k4 + 2] = v.z; s[4 * k4 + 3] = v.w; } }
        const float lnw = C.in[I_RW_LNW][l * 256 + hc], lnb = C.in[I_RW_LNB][l * 256 + hc];
        __syncthreads();
#pragma unroll 2
        for (int q = 0; q < 8; ++q) { const int t = wave * 8 + q; const size_t m = (size_t)(m0 + t);
            const LAS f32x4* rv = (const LAS f32x4*)(RL + t * 64);
            float y0 = 0.f, y1 = 0.f, y2 = 0.f, y3 = 0.f;
#pragma unroll
            for (int k4 = 0; k4 < 16; ++k4) { const f32x4 rq = rv[k4]; y0 += s[4 * k4] * rq.x; y1 += s[4 * k4 + 1] * rq.y; y2 += s[4 * k4 + 2] * rq.z; y3 += s[4 * k4 + 3] * rq.w; }
#ifndef RWDBG
#define RWDBG 0
#endif
            float y = ((RWDBG & 1) ? 0.f : (y0 + y1) + (y2 + y3)) + ((RWDBG & 2) ? 0.f : bf2f(Y0[m * 256 + hc]));
            const float mean = wave_sum(y, C.lane) * (1.f / 64.f); y -= mean;
            const float rstd = 1.0f / sqrtf(wave_sum(y * y, C.lane) * (1.f / 64.f) + 64e-5f);
            y = y * rstd * lnw + lnb;
            if (!(RWDBG & 4)) y += BON[m * 4 + h] * bf2f(RKVS[m * 768 + 512 + hc]);
            y *= bf2f(AG[m * 512 + 256 + hc]);
            if (RWDBG & 120) { y = 0.f; if (RWDBG & 8) y += ((const float*)(C.ws + WS_WDEC))[m * 256 + hc]; if (RWDBG & 16) y += bf2f(AG[m * 512 + hc]);
                if (RWDBG & 32) y += bf2f(RKVS[m * 768 + hc]) + bf2f(RKVS[m * 768 + 256 + hc]) + bf2f(RKVS[m * 768 + 512 + hc]); if (RWDBG & 64) y += BON[m * 4 + h]; }
            Y[m * 1024 + hc] = f2bf(y); }
        __syncthreads();
    }
}

constexpr int SB_VLD = 40;
__device__ __forceinline__ void ph_sb_attn_(const Ctx& C, int first_wg, int nwg, unsigned* qhead = nullptr) {
    const bf16* SB = (const bf16*)(C.ws + WS_SB); bf16* Y = (bf16*)(C.ws + WS_Y);
    const int lane = C.lane, j = lane & 31, hi = lane >> 5;
    LAS bf16* VT = (LAS bf16*)(C.lds + C.wave * (64 * SB_VLD * 2));
    for (int it = qhead ? q_next(C, qhead) : C.bid - first_wg; it < 512; it = qhead ? q_next(C, qhead) : it + nwg) {
        const int bh = it >> 6, b = bh >> 2, h = bh & 3, t0 = (it & 63) * 256 + C.wave * 32; const size_t mb = (size_t)b * SEQ;
        bf16x8 qf[4];
#pragma unroll
        for (int ks = 0; ks < 4; ++ks) qf[ks] = *(const bf16x8*)(SB + (mb + t0 + j) * 768 + h * 64 + 16 * ks + 8 * hi);
        f32x16 o0, o1;
#pragma unroll
        for (int i = 0; i < 16; ++i) { o0[i] = 0.f; o1[i] = 0.f; }
        float acc = 0.f;
#pragma unroll 1
        for (int kt = t0; kt >= 0; kt -= 32) {
            bf16x8 kf[4];
#pragma unroll
            for (int ks = 0; ks < 4; ++ks) kf[ks] = *(const bf16x8*)(SB + (mb + kt + j) * 768 + 256 + h * 64 + 16 * ks + 8 * hi);
            u32x4 vv[4];
#pragma unroll
            for (int i = 0; i < 4; ++i) { const int c = lane + 64 * i; vv[i] = *(const u32x4*)(SB + (mb + kt + (c >> 3)) * 768 + 512 + h * 64 + (c & 7) * 8); }
            f32x16 sc;
#pragma unroll
            for (int i = 0; i < 16; ++i) sc[i] = 0.f;
#pragma unroll
            for (int ks = 0; ks < 4; ++ks) sc = __builtin_amdgcn_mfma_f32_32x32x16_bf16(kf[ks], qf[ks], sc, 0, 0, 0);
#pragma unroll
            for (int i = 0; i < 4; ++i) { const int c = lane + 64 * i, key = c >> 3, d8 = (c & 7) * 8; const unsigned w[4] = {vv[i].x, vv[i].y, vv[i].z, vv[i].w};
#pragma unroll
                for (int e = 0; e < 4; ++e) { VT[(d8 + 2 * e) * SB_VLD + key] = (bf16)(w[e] & 0xffffu); VT[(d8 + 2 * e + 1) * SB_VLD + key] = (bf16)(w[e] >> 16); } }
            const bool diag = (kt == t0);
            float ls[16], g[4], og[4];
#pragma unroll
            for (int r = 0; r < 4; ++r) { g[r] = 0.f;
#pragma unroll
                for (int e = 0; e < 4; ++e) { const float z = sc[4 * r + e]; const bool valid = !diag || (8 * r + 4 * hi + e) < j;
                    const float l = (z > 40.f) ? -z : -__builtin_amdgcn_logf(1.f + __builtin_amdgcn_exp2f(z));
                    ls[4 * r + e] = valid ? l : 0.f; g[r] += ls[4 * r + e]; } }
#pragma unroll
            for (int r = 0; r < 4; ++r) og[r] = shx(g[r], 32, lane);
            float pw[16]; float run = acc;
#pragma unroll
            for (int r = 3; r >= 0; --r) { float cum = run + (hi == 0 ? og[r] : 0.f);
#pragma unroll
                for (int e = 3; e >= 0; --e) { cum += ls[4 * r + e]; const bool valid = !diag || (8 * r + 4 * hi + e) < j;
                    pw[4 * r + e] = valid ? __builtin_amdgcn_exp2f(sc[4 * r + e] + cum) : 0.f; }
                run += g[r] + og[r]; }
            acc = run;
            asm volatile("" ::: "memory");
#pragma unroll
            for (int ks = 0; ks < 2; ++ks) {
                u32x4 pk; pk.x = cvt_pk_bf16(pw[8 * ks], pw[8 * ks + 1]); pk.y = cvt_pk_bf16(pw[8 * ks + 2], pw[8 * ks + 3]); pk.z = cvt_pk_bf16(pw[8 * ks + 4], pw[8 * ks + 5]); pk.w = cvt_pk_bf16(pw[8 * ks + 6], pw[8 * ks + 7]);
                const bf16x8 pb = __builtin_bit_cast(bf16x8, pk);
                const s16x4 a0l = *(const LAS s16x4*)(VT + j * SB_VLD + 16 * ks + 4 * hi), a0h = *(const LAS s16x4*)(VT + j * SB_VLD + 16 * ks + 8 + 4 * hi);
                const s16x4 a1l = *(const LAS s16x4*)(VT + (32 + j) * SB_VLD + 16 * ks + 4 * hi), a1h = *(const LAS s16x4*)(VT + (32 + j) * SB_VLD + 16 * ks + 8 + 4 * hi);
                const bf16x8 va0 = __builtin_shufflevector(a0l, a0h, 0, 1, 2, 3, 4, 5, 6, 7), va1 = __builtin_shufflevector(a1l, a1h, 0, 1, 2, 3, 4, 5, 6, 7);
                o0 = __builtin_amdgcn_mfma_f32_32x32x16_bf16(va0, pb, o0, 0, 0, 0);
                o1 = __builtin_amdgcn_mfma_f32_32x32x16_bf16(va1, pb, o1, 0, 0, 0);
            }
            asm volatile("" ::: "memory");
            if (__builtin_amdgcn_ballot_w64(acc > -140.f) == 0ull) break;
        }
        bf16* yp = Y + (mb + t0 + j) * 1024 + 256 + h * 64 + 4 * hi;
#pragma unroll
        for (int r = 0; r < 4; ++r) { u32x2 w0, w1; w0.x = cvt_pk_bf16(o0[4 * r], o0[4 * r + 1]); w0.y = cvt_pk_bf16(o0[4 * r + 2], o0[4 * r + 3]); w1.x = cvt_pk_bf16(o1[4 * r], o1[4 * r + 1]); w1.y = cvt_pk_bf16(o1[4 * r + 2], o1[4 * r + 3]);
            *(u32x2*)(yp + 8 * r) = w0; *(u32x2*)(yp + 32 + 8 * r) = w1; }
    }
}


__device__ __forceinline__ f32x16 mm_tile(const LAS bf16* X, const LAS bf16* Y, int ti, int tj, int lane) {
    const int j = lane & 31, hi = lane >> 5; f32x16 acc;
#pragma unroll
    for (int i = 0; i < 16; ++i) acc[i] = 0.f;
#pragma unroll
    for (int ks = 0; ks < 4; ++ks) { const bf16x8 a = *(const LAS bf16x8*)(X + (32 * ti + j) * MM_LP + 16 * ks + 8 * hi), b = *(const LAS bf16x8*)(Y + (32 * tj + j) * MM_LP + 16 * ks + 8 * hi);
        acc = __builtin_amdgcn_mfma_f32_32x32x16_bf16(a, b, acc, 0, 0, 0); }
    return acc;
}
__device__ __forceinline__ void ln_pair_stats(const f32x16& x, LAS float* XCH, int tr, int tt, int lane, float eps, float& mean, float& rstd) {
    const int j = lane & 31, hi = lane >> 5; float s1 = 0.f, s2 = 0.f;
#pragma unroll
    for (int i = 0; i < 16; ++i) { s1 += x[i]; s2 += x[i] * x[i]; }
    s1 += shx(s1, 32, lane); s2 += shx(s2, 32, lane);
    if (hi == 0) { XCH[(tr * 64 + 32 * tt + j) * 2] = s1; XCH[(tr * 64 + 32 * tt + j) * 2 + 1] = s2; }
    __syncthreads();
    const float a1 = XCH[(32 * tt + j) * 2] + XCH[(64 + 32 * tt + j) * 2], a2 = XCH[(32 * tt + j) * 2 + 1] + XCH[(64 + 32 * tt + j) * 2 + 1];
    mean = a1 * (1.f / 64.f); const float var = fmaxf(a2 * (1.f / 64.f) - mean * mean, 0.f); rstd = 1.0f / sqrtf(var + eps);
}
__device__ __forceinline__ void rot_store(const Ctx& C, const bf16* src  , int pos, int d0, float scale, LAS bf16* dstrow) {
    const float* cs = (const float*)(C.ws + WS_COS) + (size_t)pos * 32 + d0; const float* sn = (const float*)(C.ws + WS_SIN) + (size_t)pos * 32 + d0;
    float x1[8], x2[8]; unpack8(*(const u32x4*)(src + d0), x1); unpack8(*(const u32x4*)(src + 32 + d0), x2);
    const f32x4 c0 = *(const f32x4*)cs, c1 = *(const f32x4*)(cs + 4), s0 = *(const f32x4*)sn, s1 = *(const f32x4*)(sn + 4);
    const float cc[8] = {c0.x, c0.y, c0.z, c0.w, c1.x, c1.y, c1.z, c1.w}, ss[8] = {s0.x, s0.y, s0.z, s0.w, s1.x, s1.y, s1.z, s1.w};
    float o1[8], o2[8];
#pragma unroll
    for (int e = 0; e < 8; ++e) { o1[e] = (x1[e] * cc[e] - x2[e] * ss[e]) * scale; o2[e] = (x1[e] * ss[e] + x2[e] * cc[e]) * scale; }
    *(LAS u32x4*)(dstrow + d0) = pack8(o1); *(LAS u32x4*)(dstrow + 32 + d0) = pack8(o2);
}

__device__ __forceinline__ void ph_ret_kv2_(const Ctx& C) {
    const bf16* RET = (const bf16*)(C.ws + WS_RET); float* KV = (float*)(C.ws + WS_KV);
    const int half = C.wave >> 2, w4 = C.wave & 3, th = C.tid & 255, lane = C.lane;
    LAS bf16* KT = (LAS bf16*)(C.lds + half * 36864);
    LAS bf16* VT = KT + 64 * MM_LP;
    LAS bf16* KR = VT + 64 * MM_LP;
    for (int it = C.bid; it < 1024; it += C.G) {
        const int u = it * 2 + half, bh = u >> 8, ch = u & 255, b = bh >> 2, h = bh & 3, m0 = b * SEQ + ch * 64;
        const float lg = ret_log2gamma(h);
        { const int srow = th >> 2, dq = th & 3; const size_t m = (size_t)(m0 + srow);
          rot_store(C, RET + m * 1024 + 256 + h * 64, (int)(m & (SEQ - 1)), dq * 8, 0.125f * exp2f(lg * (float)(63 - srow)), KR + srow * MM_LP);
          float a[8];
#pragma unroll
          for (int q = 0; q < 2; ++q) { const int e0 = dq * 16 + q * 8; unpack8(*(const u32x4*)(RET + m * 1024 + 512 + h * 64 + e0), a);
#pragma unroll
              for (int e = 0; e < 8; ++e) VT[(e0 + e) * MM_LP + srow] = f2bf(a[e]); } }
        __syncthreads();
        { const int d = th >> 2, s0 = (th & 3) * 16;
#pragma unroll
          for (int i = 0; i < 16; ++i) KT[d * MM_LP + s0 + i] = KR[(s0 + i) * MM_LP + d]; }
        __syncthreads();
        { const int ti = w4 >> 1, tj = w4 & 1, j = lane & 31, hi = lane >> 5;
          const f32x16 acc = mm_tile(VT, KT, ti, tj, lane);
          float* o = KV + (size_t)u * 4096 + (size_t)(32 * ti + 4 * hi) * 64 + 32 * tj + j;
#pragma unroll
          for (int r = 0; r < 4; ++r)
#pragma unroll
              for (int e = 0; e < 4; ++e) o[(8 * r + e) * 64] = acc[4 * r + e]; }
        __syncthreads();
    }
}
__device__ __forceinline__ void ph_ret_out2_(const Ctx& C, int l, int first_wg, int nwg, unsigned* qhead = nullptr) {
    const bf16* RET = (const bf16*)(C.ws + WS_RET); const float* KV = (const float*)(C.ws + WS_KV); bf16* Y = (bf16*)(C.ws + WS_Y);
    const int half = C.wave >> 2, w4 = C.wave & 3, th = C.tid & 255, lane = C.lane, j = lane & 31, hi = lane >> 5, te = w4 >> 1, tt = w4 & 1;
    LAS bf16* QL = (LAS bf16*)(C.lds + half * 40960);
    LAS bf16* KL = QL + 64 * MM_LP;
    LAS bf16* VT = KL + 64 * MM_LP;
    LAS bf16* ST = VT + 64 * MM_LP;
    LAS float* XCH = (LAS float*)(C.lds + half * 40960 + 4 * 64 * MM_LP * 2);
    const float* gn = C.in[I_RET_GN] + (size_t)l * 256;
    for (int it = qhead ? q_next(C, qhead) : C.bid - first_wg; it < 1024; it = qhead ? q_next(C, qhead) : it + nwg) {
        const int u = it * 2 + half, bh = u >> 8, ch = u & 255, b = bh >> 2, h = bh & 3, m0 = b * SEQ + ch * 64;
        const float lg = ret_log2gamma(h);
        { const int srow = th >> 2, dq = th & 3; const size_t m = (size_t)(m0 + srow); const int pos = (int)(m & (SEQ - 1));
          rot_store(C, RET + m * 1024 + h * 64, pos, dq * 8, 1.0f, QL + srow * MM_LP);
          rot_store(C, RET + m * 1024 + 256 + h * 64, pos, dq * 8, 0.125f, KL + srow * MM_LP);
          float a[8];
#pragma unroll
          for (int q = 0; q < 2; ++q) { const int e0 = dq * 16 + q * 8; unpack8(*(const u32x4*)(RET + m * 1024 + 512 + h * 64 + e0), a);
#pragma unroll
              for (int e = 0; e < 8; ++e) VT[(e0 + e) * MM_LP + srow] = f2bf(a[e]); }
          const float* sp = KV + (size_t)u * 4096 + srow * 64 + dq * 16;
          float sv[16];
#pragma unroll
          for (int q = 0; q < 4; ++q) { const f32x4 v4 = *(const f32x4*)(sp + 4 * q); sv[4 * q] = v4.x; sv[4 * q + 1] = v4.y; sv[4 * q + 2] = v4.z; sv[4 * q + 3] = v4.w; }
          *(LAS u32x4*)(ST + srow * MM_LP + dq * 16) = pack8(sv); *(LAS u32x4*)(ST + srow * MM_LP + dq * 16 + 8) = pack8(sv + 8); }
        __syncthreads();
        f32x16 acc = mm_tile(ST, QL, te, tt, lane);
        { const float qd = exp2f(lg * (float)(32 * tt + j + 1));
#pragma unroll
          for (int i = 0; i < 16; ++i) acc[i] *= qd; }
#pragma unroll
        for (int st = 0; st < 2; ++st) {
            if (st > tt) continue;
            const f32x16 sc = mm_tile(KL, QL, st, tt, lane);
            float pw[16];
#pragma unroll
            for (int r = 0; r < 4; ++r)
#pragma unroll
                for (int e = 0; e < 4; ++e) { const int sk = 32 * st + 8 * r + 4 * hi + e, tq = 32 * tt + j;
                    pw[4 * r + e] = (sk <= tq) ? sc[4 * r + e] * exp2f(lg * (float)(tq - sk)) : 0.f; }
#pragma unroll
            for (int ks = 0; ks < 2; ++ks) {
                u32x4 pk; pk.x = cvt_pk_bf16(pw[8 * ks], pw[8 * ks + 1]); pk.y = cvt_pk_bf16(pw[8 * ks + 2], pw[8 * ks + 3]); pk.z = cvt_pk_bf16(pw[8 * ks + 4], pw[8 * ks + 5]); pk.w = cvt_pk_bf16(pw[8 * ks + 6], pw[8 * ks + 7]);
                const bf16x8 pb = __builtin_bit_cast(bf16x8, pk);
                const LAS bf16* vr = VT + (32 * te + j) * MM_LP + 32 * st + 16 * ks + 4 * hi;
                const s16x4 al = *(const LAS s16x4*)vr, ah = *(const LAS s16x4*)(vr + 8);
                const bf16x8 va = __builtin_shufflevector(al, ah, 0, 1, 2, 3, 4, 5, 6, 7);
                acc = __builtin_amdgcn_mfma_f32_32x32x16_bf16(va, pb, acc, 0, 0, 0);
            }
        }
        float mean, rstd; ln_pair_stats(acc, XCH, te, tt, lane, 1e-5f, mean, rstd);
        { const size_t m = (size_t)(m0 + 32 * tt + j); const bf16* gp = RET + m * 1024 + 768 + h * 64 + 32 * te + 4 * hi; bf16* yp = Y + m * 1024 + 512 + h * 64 + 32 * te + 4 * hi;
          const float* gw = gn + h * 64 + 32 * te + 4 * hi;
#pragma unroll
          for (int r = 0; r < 4; ++r) { const u32x2 gt2 = *(const u32x2*)(gp + 8 * r); const float gtv[4] = {bflo(gt2.x), bfhi(gt2.x), bflo(gt2.y), bfhi(gt2.y)}; const f32x4 gwv = *(const f32x4*)(gw + 8 * r);
              float o[4];
#pragma unroll
              for (int e = 0; e < 4; ++e) o[e] = (acc[4 * r + e] - mean) * rstd * gwv[e] * (gtv[e] * sigm(gtv[e]));
              u32x2 w; w.x = cvt_pk_bf16(o[0], o[1]); w.y = cvt_pk_bf16(o[2], o[3]); *(u32x2*)(yp + 8 * r) = w; } }
        __syncthreads();
    }
}
__device__ __forceinline__ void ph_rw_out2_(const Ctx& C, int l, unsigned* qhead = nullptr) {
    const bf16* RWp = (const bf16*)(C.ws + WS_RW); const bf16* GP = (const bf16*)(C.ws + WS_GP); const bf16* Y0 = (const bf16*)(C.ws + WS_Y0); const bf16* RH = (const bf16*)(C.ws + WS_RHAT);
    const float* SST = (const float*)(C.ws + WS_SST); const float* BON = (const float*)(C.ws + WS_BON); bf16* Y = (bf16*)(C.ws + WS_Y);
    const int half = C.wave >> 2, w4 = C.wave & 3, th = C.tid & 255, lane = C.lane, j = lane & 31, hi = lane >> 5, tv = w4 >> 1, tt = w4 & 1;
    LAS bf16* SL = (LAS bf16*)(C.lds + half * 20480);
    LAS bf16* RL = SL + 64 * MM_LP;
    LAS float* XCH = (LAS float*)(C.lds + half * 20480 + 2 * 64 * MM_LP * 2);
    for (int it = qhead ? q_next(C, qhead) : C.bid; it < RW_NU / 2; it = qhead ? q_next(C, qhead) : it + C.G) {
        const int u = it * 2 + half, bh = u >> 8, ch = u & 255, b = bh >> 2, h = bh & 3, m0 = b * SEQ + ch * RWC;
        { const int row = th >> 2, q4 = th & 3;
          const float* sp = SST + (size_t)(u >> 3) * 4096 + row * 64 + q4 * 16; float sv[16];
#pragma unroll
          for (int q = 0; q < 4; ++q) { const f32x4 v4 = *(const f32x4*)(sp + 4 * q); sv[4 * q] = v4.x; sv[4 * q + 1] = v4.y; sv[4 * q + 2] = v4.z; sv[4 * q + 3] = v4.w; }
          *(LAS u32x4*)(SL + row * MM_LP + q4 * 16) = pack8(sv); *(LAS u32x4*)(SL + row * MM_LP + q4 * 16 + 8) = pack8(sv + 8);
          const u32x4* rp = (const u32x4*)(RH + (size_t)(m0 + row) * 256 + h * 64 + q4 * 16);
          *(LAS u32x4*)(RL + row * MM_LP + q4 * 16) = rp[0]; *(LAS u32x4*)(RL + row * MM_LP + q4 * 16 + 8) = rp[1]; }
        __syncthreads();
        f32x16 acc = mm_tile(SL, RL, tv, tt, lane);
        const size_t m = (size_t)(m0 + 32 * tt + j); const int vb = h * 64 + 32 * tv + 4 * hi;
#pragma unroll
        for (int r = 0; r < 4; ++r) { const u32x2 y2 = *(const u32x2*)(Y0 + m * 256 + vb + 8 * r); acc[4 * r] += bflo(y2.x); acc[4 * r + 1] += bfhi(y2.x); acc[4 * r + 2] += bflo(y2.y); acc[4 * r + 3] += bfhi(y2.y); }
        float mean, rstd; ln_pair_stats(acc, XCH, tv, tt, lane, 64e-5f, mean, rstd);
        const float bon = BON[m * 4 + h];
#pragma unroll
        for (int r = 0; r < 4; ++r) { const int vc = vb + 8 * r;
            const f32x4 lw = *(const f32x4*)(C.in[I_RW_LNW] + (size_t)l * 256 + vc), lb = *(const f32x4*)(C.in[I_RW_LNB] + (size_t)l * 256 + vc);
            const u32x2 v2 = *(const u32x2*)(RWp + m * 1024 + 512 + vc), g2 = *(const u32x2*)(GP + m * 256 + vc); u32x2 vp = (u32x2){0u, 0u};
            if ((32 * tt + j) | (ch * RWC)) vp = *(const u32x2*)(RWp + (m - 1) * 1024 + 512 + vc);
            const f32x4 mv = *(const f32x4*)(C.in[I_RW_MU] + (size_t)l * 1024 + 512 + vc);
            const float vc4[4] = {bflo(v2.x), bfhi(v2.x), bflo(v2.y), bfhi(v2.y)}, vq4[4] = {bflo(vp.x), bfhi(vp.x), bflo(vp.y), bfhi(vp.y)};
            const float vv[4] = {vc4[0] + (vq4[0] - vc4[0]) * mv[0], vc4[1] + (vq4[1] - vc4[1]) * mv[1], vc4[2] + (vq4[2] - vc4[2]) * mv[2], vc4[3] + (vq4[3] - vc4[3]) * mv[3]}, gg[4] = {bflo(g2.x), bfhi(g2.x), bflo(g2.y), bfhi(g2.y)};
            float o[4];
#pragma unroll
            for (int e = 0; e < 4; ++e) o[e] = ((acc[4 * r + e] - mean) * rstd * lw[e] + lb[e] + bon * vv[e]) * gg[e];
            u32x2 w; w.x = cvt_pk_bf16(o[0], o[1]); w.y = cvt_pk_bf16(o[2], o[3]); *(u32x2*)(Y + m * 1024 + vc) = w; }
        __syncthreads();
    }
}

__device__ __forceinline__ void ph_moe_scatter_(const Ctx& C, int moe_idx) {
    unsigned* cw = (unsigned*)(C.ws + WS_CTL) + CW_MOE + moe_idx * 64;
    const int* eidx = (const int*)(C.ws + WS_EIDX); const float* gate = (const float*)(C.ws + WS_GATE);
    int* rowtok = (int*)(C.ws + WS_ROWTOK); float* rowgate = (float*)(C.ws + WS_ROWGATE); int* texp = (int*)(C.ws + WS_TEXP); int* segend = (int*)(C.ws + WS_SEGEND); int* ntp = (int*)(C.ws + WS_NT);
    bf16* XS = (bf16*)(C.ws + WS_XS);
    LAS unsigned* lcnt = (LAS unsigned*)(C.lds); LAS unsigned* lbase = lcnt + 8; LAS int* sl = (LAS int*)(C.lds + 256);
    int cnt[8], segb[8]; int tot = 0;
#pragma unroll
    for (int e = 0; e < 8; ++e) { cnt[e] = (int)__hip_atomic_load(&cw[e], __ATOMIC_RELAXED, __HIP_MEMORY_SCOPE_AGENT); segb[e] = tot; tot += (cnt[e] + 255) & ~255; }
    if (C.bid == 0) {
        if (C.tid < 8) { const int e = C.tid; int sb = 0, ce = 0;
#pragma unroll
            for (int q = 0; q < 8; ++q) if (q == e) { sb = segb[q]; ce = cnt[q]; }
            for (int pm = sb >> 8; pm < ((sb + ((ce + 255) & ~255)) >> 8); ++pm) { texp[pm] = e; segend[pm] = sb + ce; } }
        if (C.tid == 0) *ntp = tot >> 8;
    }
    for (int blk = C.bid; blk < T / 256; blk += C.G) {
        __syncthreads();
        if (C.tid < 8) lcnt[C.tid] = 0u;
        __syncthreads();
        const int a = blk * 512 + C.tid, e = eidx[a];
        const unsigned rank = atomicAdd((unsigned*)&lcnt[e], 1u);
        __syncthreads();
        if (C.tid < 8) lbase[C.tid] = atomicAdd(&cw[16 + C.tid], lcnt[C.tid]);
        __syncthreads();
        int sb = 0;
#pragma unroll
        for (int q = 0; q < 8; ++q) if (q == e) sb = segb[q];
        const int slot = sb + (int)lbase[e] + (int)rank;
        rowtok[slot] = a >> 1; rowgate[slot] = gate[a]; sl[C.tid] = slot; ((int*)(C.ws + WS_SLOTOF))[a] = slot;
        __syncthreads();
#pragma unroll 1
        for (int i0 = C.wave; i0 < 512; i0 += 8 * NWAVES) { u32x4 rowv[8];
#pragma unroll
            for (int j = 0; j < 8; ++j) { const int i = i0 + j * NWAVES; rowv[j] = ((const u32x4*)(C.ws + WS_H8 + (size_t)(blk * 256 + (i >> 1)) * D))[C.lane]; }
#pragma unroll
            for (int j = 0; j < 8; ++j) { const int i = i0 + j * NWAVES; ((u32x4*)(C.ws + WS_XS + (size_t)sl[i] * D))[C.lane] = rowv[j]; } }
    }
}

__device__ __forceinline__ void grid_barrier(int wv) {
    const Ctx C = make_ctx(wv);
    XcdBarrier b; b.bar = (unsigned*)(C.ws + WS_CTL) + CW_BAR; b.x = xb_xcc_id(); b.st = (volatile LAS unsigned*)(C.lds + MISC_OFF) + 8;
    xcd_barrier(b, C.tid);
}
__device__ __forceinline__ void P_prologue(int wv) { const Ctx C = make_ctx(wv); ph_prologue_(C); }
__device__ __forceinline__ void P_weights_norm(int wv, int l) { const Ctx C = make_ctx(wv); ph_weights_(C, l, 0, 0, C.G); __syncthreads(); ph_norm_(C, C.in[I_NORM_MIX] + (size_t)l * D, false, nullptr, 0,  (l > 0) && ((l - 1) & 1), l == 0 ? C.in[I_X] : nullptr); }
__device__ __forceinline__ void P_gemm_in(int wv, int l) { const Ctx C = make_ctx(wv); using namespace pg8; unsigned char* ws = C.ws;
    Gemm g{(const bf16*)C.out, (const bf16*)(ws + WS_WIN), D, D}; StaticOrder S; S.init(T, NIN, C.G, C.bid);
    EpiRoute E{(bf16*)(ws + WS_RW), (bf16*)(ws + WS_SB), (bf16*)(ws + WS_RET), (bf16*)(ws + WS_CV), C.in[I_SB_QN] + (size_t)l * 64, C.in[I_SB_KN] + (size_t)l * 64};
    gemm_phase<EpiRoute, StaticOrder, true, 1>(C.lds, C.tid, g, S, E); }
#define REP2(bit, stmt) do { stmt; if constexpr ((PROBE2 >> (bit)) & 1) { __syncthreads(); stmt; } } while (0)
__device__ __forceinline__ void P_mix1(int wv, int l) { REP2(2, { const Ctx C = make_ctx(wv); ph_rw_prep_(C, l); }); REP2(3, { const Ctx C = make_ctx(wv); ph_conv_(C, l); }); REP2(4, { const Ctx C = make_ctx(wv); ph_ret_kv2_(C); }); }
__device__ __forceinline__ void P_mix2(int wv, int l) { { const Ctx C = make_ctx(wv); using namespace pg8; unsigned char* ws = C.ws;
    Gemm g{(const bf16*)(ws + WS_ALORA), (const bf16*)(ws + WS_WLORA), 256, 256}; StaticOrder S; S.init(T, 768, C.G, C.bid);
    EpiLora E{(float*)(ws + WS_WDEC), (bf16*)(ws + WS_AP), (bf16*)(ws + WS_GP), C.in[I_RW_W0] + (size_t)l * 256, C.in[I_RW_A0] + (size_t)l * 256};
    gemm_phase<EpiLora, StaticOrder, true>(C.lds, C.tid, g, S, E); }
    { const Ctx C = make_ctx(wv); ph_ret_scan_(C); } }
#ifndef MIX3_SEL
#define MIX3_SEL 3
#endif
__device__ __forceinline__ void P_mix3(int wv, int l) { REP2(0, { const Ctx C = make_ctx(wv); ph_rw_local_wy_(C, l); }); }
__device__ __forceinline__ void scan_done_post(const Ctx& C, unsigned* cnt) {
    asm volatile("s_waitcnt vmcnt(0)" ::: "memory"); __syncthreads();
    if (C.tid == 0) { __builtin_amdgcn_fence(__ATOMIC_RELEASE, "agent"); asm volatile("s_waitcnt vmcnt(0)" ::: "memory"); (void)xb_add(cnt, 1u); }
}
__device__ __forceinline__ void scan_done_wait(const Ctx& C, unsigned* cnt) {
    __syncthreads();
    if (C.tid == 0) { unsigned sp = 0u; while (xb_ld(cnt) < 32u) { __builtin_amdgcn_s_sleep(2); if (++sp > (1u << 24)) break; }
        __builtin_amdgcn_fence(__ATOMIC_ACQUIRE, "agent"); asm volatile("s_waitcnt vmcnt(0)" ::: "memory"); }
    __syncthreads();
}
__device__ __forceinline__ void P_mix4(int wv, int l) { const Ctx C = make_ctx(wv);
    unsigned* qh = (unsigned*)(C.ws + WS_CTL) + CW_QUEUE + l * 64;
    if (C.G >= 64) { if (C.bid < 32) { ph_rw_scan_(C, C.bid); scan_done_post(C, qh + 48); }
        ph_sb_attn_(C, 0, C.G, qh); __syncthreads(); ph_ret_out2_(C, l, 0, C.G, qh + 16); __syncthreads(); ph_weights_(C, l, 1, 0, C.G, qh + 32);
        scan_done_wait(C, qh + 48); ph_rw_out2_(C, l, qh + 40); }
    else { for (int w = C.bid; w < 32; w += C.G) { ph_rw_scan_(C, w); scan_done_post(C, qh + 48); } ph_sb_attn_(C, 0, C.G); __syncthreads(); ph_ret_out2_(C, l, 0, C.G); __syncthreads(); ph_weights_(C, l, 1, 0, C.G);
        scan_done_wait(C, qh + 48); ph_rw_out2_(C, l); } }
__device__ __forceinline__ void P_gemm_branch(int wv) { const Ctx C = make_ctx(wv); using namespace pg8; unsigned char* ws = C.ws;
    Gemm g{(const bf16*)(ws + WS_Y), (const bf16*)(ws + WS_WB), D, 256}; StaticOrder S; S.init(T, 4096, C.G, C.bid, 2, 512);
    EpiBall E{ws + WS_BALL};
    gemm_phase<EpiBall, StaticOrder, false>(C.lds, C.tid, g, S, E); }
__device__ __forceinline__ void P_gemm_gate(int wv) { const Ctx C = make_ctx(wv); using namespace pg8; unsigned char* ws = C.ws;
    Gemm g{(const bf16*)(ws + WS_H8), (const bf16*)(ws + WS_WG), D, D}; StaticOrder S; S.init(T, 4096, C.G, C.bid);
    EpiGateMerge E{(const bf16*)(ws + WS_BALL), (bf16*)(ws + WS_MERGED)};
    gemm_phase8<EpiGateMerge, StaticOrder, true>(C.lds, C.tid, g, S, E); }
__device__ __forceinline__ void P_gemm_out(int wv) { const Ctx C = make_ctx(wv); using namespace pg8; unsigned char* ws = C.ws;
    Gemm g{(const bf16*)(ws + WS_MERGED), (const bf16*)(ws + WS_WOUT), D, D}; StaticOrder S; S.init(T, D, C.G, C.bid);
    EpiResidual E{(bf16*)(ws + WS_XB), 1.0f};
    gemm_phase<EpiResidual, StaticOrder, true, 1>(C.lds, C.tid, g, S, E); }
__device__ __forceinline__ void P_norm_ffn(int wv, int l) { const Ctx C = make_ctx(wv); ph_norm_(C, C.in[I_NORM_FFN] + (size_t)l * D, (l & 1) != 0, C.in[I_ROUTER] + (size_t)(l >> 1) * D * NEXP, l >> 1, false, nullptr,  false); }
__device__ __forceinline__ void P_ffn_up(int wv) { const Ctx C = make_ctx(wv); using namespace pg8; unsigned char* ws = C.ws;
    Gemm g{(const bf16*)(ws + WS_H8), (const bf16*)(ws + WS_W13), D, D}; StaticOrder S; S.init(T, 2 * DFF, C.G, C.bid);
    EpiSwiglu E{ws + WS_HID, DFF, 1 << 20, false};
    gemm_phase8<EpiSwiglu, StaticOrder, true>(C.lds, C.tid, g, S, E); }
__device__ __forceinline__ void P_ffn_down(int wv) { const Ctx C = make_ctx(wv); using namespace pg8; unsigned char* ws = C.ws;
    Gemm g{(const bf16*)(ws + WS_HID), (const bf16*)(ws + WS_W2D), DFF, DFF}; StaticOrder S; S.init(T, D, C.G, C.bid);
    EpiResidual E{(bf16*)(ws + WS_XB), F8_DESCALE_DOWN};
    gemm_phase8<EpiResidual, StaticOrder, true, 1>(C.lds, C.tid, g, S, E); }
__device__ __forceinline__ void P_moe_scatter(int wv, int l2) { const Ctx C = make_ctx(wv); ph_moe_scatter_(C, l2); }
__device__ __forceinline__ void P_moe_up(int wv) { const Ctx C = make_ctx(wv); using namespace pg8; unsigned char* ws = C.ws;
    Gemm g{(const bf16*)(ws + WS_XS), (const bf16*)(ws + WS_W13), D, D};
    MoeOrder S{(const int*)(ws + WS_TEXP), __builtin_amdgcn_readfirstlane(*(const int*)(ws + WS_NT)), 2 * DFE / 256, C.G, C.bid};
    EpiSwiglu E{ws + WS_HIDM, DFE_PAD, 2 * DFE / 256, true};
    gemm_phase8<EpiSwiglu, MoeOrder, true>(C.lds, C.tid, g, S, E); }
__device__ __forceinline__ void P_moe_down(int wv) { const Ctx C = make_ctx(wv); using namespace pg8; unsigned char* ws = C.ws;
    Gemm g{(const bf16*)(ws + WS_HIDM), (const bf16*)(ws + WS_W2M), DFE_PAD, DFE_PAD};
    MoeOrder S{(const int*)(ws + WS_TEXP), __builtin_amdgcn_readfirstlane(*(const int*)(ws + WS_NT)), D / 256, C.G, C.bid};
    EpiBf16 E{(bf16*)(ws + WS_YS), D, 3, F8_DESCALE_DOWN};
    gemm_phase8<EpiBf16, MoeOrder, true, 1>(C.lds, C.tid, g, S, E); }
__device__ __forceinline__ void P_moe_combine(int wv) { const Ctx C = make_ctx(wv);
    const int gw = C.bid * NWAVES + C.wave, NGW = C.G * NWAVES, lane = C.lane;
    const int* slotof = (const int*)(C.ws + WS_SLOTOF); const float* gate = (const float*)(C.ws + WS_GATE); const bf16* YS = (const bf16*)(C.ws + WS_YS); const bf16* XB = (const bf16*)(C.ws + WS_XB);
    constexpr int NRC = 4;
    for (int mb = gw; mb < T; mb += NRC * NGW) {
        int s0[NRC], s1[NRC]; float g0[NRC], g1[NRC]; u32x4 x[NRC][2], ya[NRC][2], yb[NRC][2];
#pragma unroll
        for (int r = 0; r < NRC; ++r) { const int m = mb + r * NGW < T ? mb + r * NGW : T - 1; s0[r] = slotof[2 * m]; s1[r] = slotof[2 * m + 1]; g0[r] = gate[2 * m]; g1[r] = gate[2 * m + 1];
            const u32x4* xb = (const u32x4*)(XB + (size_t)m * D) + lane; x[r][0] = xb[0]; x[r][1] = xb[64]; }
#pragma unroll
        for (int r = 0; r < NRC; ++r) { const u32x4* y0 = (const u32x4*)(YS + (size_t)s0[r] * D) + lane; const u32x4* y1 = (const u32x4*)(YS + (size_t)s1[r] * D) + lane;
            ya[r][0] = y0[0]; ya[r][1] = y0[64]; yb[r][0] = y1[0]; yb[r][1] = y1[64]; }
#pragma unroll
        for (int r = 0; r < NRC; ++r) { const int m = mb + r * NGW; if (m < T) { f32x4* xo = (f32x4*)(C.out + (size_t)m * D + 8 * lane); const float G0 = g0[r], G1 = g1[r];
#pragma unroll
            for (int j = 0; j < 2; ++j) { const u32x4 xx = x[r][j], a = ya[r][j], b = yb[r][j]; f32x4 v0, v1;
                v0.x = bflo(xx.x) + G0 * bflo(a.x) + G1 * bflo(b.x); v0.y = bfhi(xx.x) + G0 * bfhi(a.x) + G1 * bfhi(b.x); v0.z = bflo(xx.y) + G0 * bflo(a.y) + G1 * bflo(b.y); v0.w = bfhi(xx.y) + G0 * bfhi(a.y) + G1 * bfhi(b.y);
                v1.x = bflo(xx.z) + G0 * bflo(a.z) + G1 * bflo(b.z); v1.y = bfhi(xx.z) + G0 * bfhi(a.z) + G1 * bfhi(b.z); v1.z = bflo(xx.w) + G0 * bflo(a.w) + G1 * bflo(b.w); v1.w = bfhi(xx.w) + G0 * bfhi(a.w) + G1 * bfhi(b.w);
                xo[128 * j] = v0; xo[128 * j + 1] = v1; } } }
    }
}

#ifndef PROBE_MASK
#define PROBE_MASK 0u
#endif
#ifndef PH_MASK
#define PH_MASK 0xffffffffu
#endif
__global__ void __launch_bounds__(NTHR, 2) hybrid_fwd(Args args) {
    (void)args;
    const int wv = __builtin_amdgcn_readfirstlane(threadIdx.x >> 6);
    { LAS unsigned char* lds = (LAS unsigned char*)lds_raw;
      for (int u = threadIdx.x; u < (LDS_BYTES - RING_BYTES) / 4; u += NTHR) ((LAS unsigned*)(lds + RING_BYTES))[u] = 0u; }
    __syncthreads();
    { const CAS Args* ka = ka_ptr();
      if (ka->ph_hi - ka->ph_lo > 1) { (void)xcd_barrier_post((unsigned*)(ka->ws + WS_CTL) + CW_BAR, (volatile LAS unsigned*)((LAS unsigned char*)lds_raw + MISC_OFF) + 8); } }
    int gp = 0;
#define PHASE(k, call) { const CAS Args* ka_ = ka_ptr(); const int lo_ = ka_->ph_lo, hi_ = ka_->ph_hi; if (lo_ <= gp && gp < hi_) { if constexpr ((PH_MASK >> (k)) & 1u) { call; if constexpr ((PROBE_MASK >> (k)) & 1u) { __syncthreads(); call; } } if (hi_ - lo_ > 1 && gp + 1 < hi_) grid_barrier(wv); } ++gp; }
    PHASE(0, P_prologue(wv))
#pragma unroll 1
    for (int l = 0; l < NLAYER; ++l) {
        PHASE(1, P_weights_norm(wv, l))
        PHASE(2, P_gemm_in(wv, l))
        PHASE(3, P_mix1(wv, l))
        PHASE(4, P_mix2(wv, l))
        PHASE(5, P_mix3(wv, l))
        PHASE(6, P_mix4(wv, l))
        ++gp;
        PHASE(8, P_gemm_branch(wv))
        PHASE(9, P_gemm_gate(wv))
        PHASE(10, P_gemm_out(wv))
        PHASE(11, P_norm_ffn(wv, l))
        if (!(l & 1)) {
            PHASE(12, P_ffn_up(wv))
            PHASE(13, P_ffn_down(wv))
            gp += 2;
        } else {
            PHASE(14, P_moe_scatter(wv, l >> 1))
            PHASE(15, P_moe_up(wv))
            PHASE(16, P_moe_down(wv))
            if (l == NLAYER - 1) { PHASE(17, P_moe_combine(wv)) } else { ++gp; }
        }
    }
#undef PHASE
}
constexpr int N_PHASES = 1 + NLAYER * 15;

#ifndef MK_MULTI
#define MK_MULTI 0
#endif
extern "C" void kernel_launch(void* const* d_in, const int* in_sizes, int n_in, void* d_out, int out_size, void* d_ws, size_t ws_size, hipStream_t stream) {
    static int grid = 0;
    if (grid == 0) {
        if (n_in != 32 || in_sizes[0] != T * D || out_size != T * D || ws_size < WS_END) { fprintf(stderr, "kernel_launch: unexpected problem shape / workspace (%d inputs, ws %zu)\n", n_in, ws_size); grid = -1; return; }
        int dev = 0, cus = 0, per_cu = 0;
        if (hipGetDevice(&dev) != hipSuccess || hipDeviceGetAttribute(&cus, hipDeviceAttributeMultiprocessorCount, dev) != hipSuccess) { grid = -1; return; }
        if (hipFuncSetAttribute((const void*)hybrid_fwd, hipFuncAttributeMaxDynamicSharedMemorySize, LDS_BYTES) != hipSuccess) { fprintf(stderr, "kernel_launch: hipFuncSetAttribute failed\n"); grid = -1; return; }
        if (hipOccupancyMaxActiveBlocksPerMultiprocessor(&per_cu, (const void*)hybrid_fwd, NTHR, LDS_BYTES) != hipSuccess || per_cu < 1) { fprintf(stderr, "kernel_launch: occupancy query says %d\n", per_cu); }
        (void)hipGetLastError();
        grid = cus;
    }
    if (grid < 0) return;
    (void)hipMemsetAsync((char*)d_ws + WS_CTL, 0, CTL_ZERO_BYTES, stream);
#ifdef DBG_ZERO_WS
    (void)hipMemsetAsync((char*)d_ws + CTL_ZERO_BYTES, 0, WS_END - CTL_ZERO_BYTES, stream);
#endif
    Args a{};
    for (int i = 0; i < 32; ++i) a.in[i] = (const float*)d_in[i];
    a.out = (float*)d_out; a.ws = (unsigned char*)d_ws;
#if MK_MULTI
    for (int p = 0; p < N_PHASES; ++p) { a.ph_lo = p; a.ph_hi = p + 1; hipLaunchKernelGGL(hybrid_fwd, dim3(grid), dim3(NTHR), LDS_BYTES, stream, a); }
#else
    a.ph_lo = 0; a.ph_hi = N_PHASES; hipLaunchKernelGGL(hybrid_fwd, dim3(grid), dim3(NTHR), LDS_BYTES, stream, a);
#endif
}
```

```cpp
#include <hip/hip_runtime.h>
#include <cstdio>
#include <cstdint>

#define GAS __attribute__((address_space(1)))
#define LAS __attribute__((address_space(3)))
typedef unsigned short bf16;
typedef unsigned u32x4 __attribute__((ext_vector_type(4)));
typedef unsigned u32x2 __attribute__((ext_vector_type(2)));
typedef float f32x4 __attribute__((ext_vector_type(4)));
typedef float f32x2 __attribute__((ext_vector_type(2)));
typedef short bf16x8 __attribute__((ext_vector_type(8)));
typedef float f32x16 __attribute__((ext_vector_type(16)));
typedef short s16x4 __attribute__((ext_vector_type(4)));

constexpr int SEQ = 16384, NBATCH = 2, T = NBATCH * SEQ, D = 1024, NIN = 3328, DFF = 2816, DFE = 1408, NEXP = 8, NLAYER = 4;
constexpr int MPAD = 2 * T + NEXP * 256;
constexpr int NWAVES = 8, NTHR = 512;
constexpr float LOG2E = 1.4426950408889634f;
constexpr int MM_LP = 72;

typedef __bf16 bf16x2_t __attribute__((ext_vector_type(2)));
__device__ __forceinline__ unsigned cvt_pk_bf16(float lo, float hi) { const f32x2 v = {lo, hi}; const bf16x2_t b = __builtin_convertvector(v, bf16x2_t); return __builtin_bit_cast(unsigned, b); }
__device__ __forceinline__ float bflo(unsigned u) { return __builtin_bit_cast(float, u << 16); }
__device__ __forceinline__ float bfhi(unsigned u) { return __builtin_bit_cast(float, u & 0xffff0000u); }
__device__ __forceinline__ float bf2f(bf16 u) { return __builtin_bit_cast(float, (unsigned)u << 16); }
__device__ __forceinline__ bf16 f2bf(float f) { return (bf16)(cvt_pk_bf16(f, 0.f) & 0xffffu); }
__device__ __forceinline__ float sigm(float x) { return __builtin_amdgcn_rcpf(1.f + __builtin_amdgcn_exp2f(-x * LOG2E)); }
__device__ __forceinline__ float shx(float v, int o, int lane) { return __builtin_bit_cast(float, __builtin_amdgcn_ds_bpermute((lane ^ o) << 2, __builtin_bit_cast(int, v))); }
__device__ __forceinline__ float dpp_add(float v, const int ctrl_id) {
    const int x = __builtin_bit_cast(int, v);
    int y;
    if (ctrl_id == 0) y = __builtin_amdgcn_update_dpp(0, x, 0xB1, 0xF, 0xF, true);
    else if (ctrl_id == 1) y = __builtin_amdgcn_update_dpp(0, x, 0x4E, 0xF, 0xF, true);
    else if (ctrl_id == 2) y = __builtin_amdgcn_update_dpp(0, x, 0x141, 0xF, 0xF, true);
    else y = __builtin_amdgcn_update_dpp(0, x, 0x140, 0xF, 0xF, true);
    return v + __builtin_bit_cast(float, y);
}
__device__ __forceinline__ float wave_sum(float v, int lane) {
    (void)lane;
    v = dpp_add(v, 0); v = dpp_add(v, 1); v = dpp_add(v, 2); v = dpp_add(v, 3);
    v += __builtin_bit_cast(float, __builtin_amdgcn_update_dpp(0, __builtin_bit_cast(int, v), 0x142, 0xA, 0xF, false));
    v += __builtin_bit_cast(float, __builtin_amdgcn_update_dpp(0, __builtin_bit_cast(int, v), 0x143, 0xC, 0xF, false));
    return __builtin_bit_cast(float, __builtin_amdgcn_readlane(__builtin_bit_cast(int, v), 63));
}
__device__ __forceinline__ void unpack8(const u32x4 v, float* f) {
    f[0] = bflo(v.x); f[1] = bfhi(v.x); f[2] = bflo(v.y); f[3] = bfhi(v.y); f[4] = bflo(v.z); f[5] = bfhi(v.z); f[6] = bflo(v.w); f[7] = bfhi(v.w);
}
__device__ __forceinline__ unsigned pk4_fp8(float a, float b, float c, float d) {
    a = __builtin_amdgcn_fmed3f(a, -440.f, 440.f); b = __builtin_amdgcn_fmed3f(b, -440.f, 440.f); c = __builtin_amdgcn_fmed3f(c, -440.f, 440.f); d = __builtin_amdgcn_fmed3f(d, -440.f, 440.f);
    int w = __builtin_amdgcn_cvt_pk_fp8_f32(a, b, 0, false); w = __builtin_amdgcn_cvt_pk_fp8_f32(c, d, w, true); return (unsigned)w; }
__device__ __forceinline__ u32x4 pack8(const float* f) {
    u32x4 w; w.x = cvt_pk_bf16(f[0], f[1]); w.y = cvt_pk_bf16(f[2], f[3]); w.z = cvt_pk_bf16(f[4], f[5]); w.w = cvt_pk_bf16(f[6], f[7]); return w;
}


#ifndef PROBE2
#define PROBE2 0
#endif
#ifndef GMASK
#define GMASK 15
#endif
#ifndef RWDBG
#define RWDBG 0
#endif
typedef int i32x8 __attribute__((ext_vector_type(8)));
constexpr float F8_MUL_X = 16.f, F8_MUL_W = 256.f, F8_DESCALE = 1.0f / (16.f * 256.f), F8_MUL_H = 4.f, F8_DESCALE_DOWN = 1.0f / (4.f * 256.f);
constexpr int DFE_PAD = 1536;
namespace pg8 {
typedef unsigned short bf16_t;
constexpr int BM = 256, BK = 64, HALF = 128, HTB = HALF * BK * 2, NXCD = 8, WGM = 8;
__host__ __device__ __forceinline__ int lds_byte(int r, int c) { const int st = (r >> 4) * 2 + (c >> 5), rr = r & 15, cc = c & 31, ob = rr * 64 + cc * 2; return st * 1024 + (ob ^ (((ob >> 9) & 1) << 5)); }
__host__ __device__ __forceinline__ void stage_rc(int b, int& R, int& C) { const int st = b / 1024, sb = b % 1024, swz = sb ^ (((sb >> 9) & 1) << 5); R = (st >> 1) * 16 + swz / 64; C = (st & 1) * 32 + (swz % 64) / 2; }
__host__ __device__ __forceinline__ int perm32(int rho) { const int n = rho >> 4, i = rho & 15; return 8 * (i >> 2) + 4 * n + (i & 3); }

struct Unit { int pm, pn, aoff; };
struct Gemm { const bf16_t* A; const bf16_t* Bt; int lda, K; };

struct StaticOrder {
    int nM, nN, nwg, G, c, ashift, amul;
    __device__ void init(int M, int N, int G_, int c_, int ashift_ = 0, int amul_ = 0) { nM = M / BM; nN = N / BM; nwg = nM * nN; G = G_; c = c_; ashift = ashift_; amul = amul_; }
    __device__ bool next(int i, Unit& u) const {
        const long L = (long)i * G + c; if (L >= nwg) return false;
        int wgid = (int)L; { const int q = nwg / NXCD, r = nwg % NXCD, xcd = wgid % NXCD, off = wgid / NXCD; wgid = (xcd < r ? xcd * (q + 1) : r * (q + 1) + (xcd - r) * q) + off; }
        const int nig = WGM * nN, gid = wgid / nig, fm = gid * WGM, gsz = (nM - fm) < WGM ? (nM - fm) : WGM;
        u.pm = fm + ((wgid % nig) % gsz); u.pn = (wgid % nig) / gsz; u.aoff = (u.pn >> ashift) * amul; return true;
    }
};
struct MoeOrder {
    const int* texp; int ntiles, ncol, G, c;
    __device__ bool next(int i, Unit& u) const {
        const int L = i * G + c; if (L >= ntiles * ncol) return false;
        const int pm = L / ncol, pl = L % ncol;
        u.pm = pm; u.pn = texp[pm] * ncol + pl; u.aoff = 0; return true;
    }
};

template <class Epi, class Sched, bool ALIGN_EPI, int CMAP = 0>
__device__ __forceinline__ void gemm_phase(LAS unsigned char* lds, const int tid_in, const Gemm g, const Sched& S, const Epi& E) {
    const int tid = tid_in, wid = __builtin_amdgcn_readfirstlane(tid >> 6), lane = tid & 63, wr = wid >> 2, wc = wid & 3, fr = lane & 15, fq = lane >> 4;
    const int K = g.K, nt = K / BK, lda = g.lda;
    unsigned voffA[2], voffB[2];
#pragma unroll
    for (int i = 0; i < 2; ++i) { int R, C; stage_rc(tid * 16 + i * 8192, R, C); const int p32 = perm32(R & 31); const int Rb = CMAP ? 64 * (R >> 5) + 16 * (p32 >> 3) + (p32 & 7) : (R & ~31) + p32;
        voffA[i] = (unsigned)(R * lda + C) * 2u; voffB[i] = (unsigned)(Rb * K + C) * 2u; }
    const size_t kstep = (size_t)(BK * 2);
    const size_t hstepA = (size_t)HALF * lda * 2, tstepA = 2 * hstepA, hstepB = (size_t)(CMAP ? 8 : HALF) * K * 2, tstepB = (size_t)BM * K * 2;
    const unsigned ldsw = (unsigned)wid * 1024u;
    const int aoff = lds_byte(wr * 64 + fr, fq * 8), boff = lds_byte(wc * 32 + fr, fq * 8);
#define PG8_SA(b, h) (((b) * 2 + (h)) * HTB)
#define PG8_SB(b, h) ((4 + (b) * 2 + (h)) * HTB)
#define PG8_STAGE(bufoff, gbase, voff) do { _Pragma("unroll") for (int _i = 0; _i < 2; ++_i) \
        __builtin_amdgcn_global_load_lds((const unsigned*)((const char*)(gbase) + (voff)[_i]), (LAS unsigned*)(lds + (bufoff) + ldsw + _i * 8192), 16, 0, 0); } while (0)
#define PG8_LDA(dst, b, h) do { _Pragma("unroll") for (int m = 0; m < 4; ++m) _Pragma("unroll") for (int k = 0; k < 2; ++k) dst[m][k] = *(const LAS bf16x8*)(lds + PG8_SA(b, h) + aoff + m * 2048 + k * 1024); } while (0)
#define PG8_LDB(dst, b, h) do { _Pragma("unroll") for (int n = 0; n < 2; ++n) _Pragma("unroll") for (int k = 0; k < 2; ++k) dst[n][k] = *(const LAS bf16x8*)(lds + PG8_SB(b, h) + boff + n * 2048 + k * 1024); } while (0)
#define PG8_MMA(ai, bj, At, Bt) do { __builtin_amdgcn_s_setprio(1); _Pragma("unroll") for (int m = 0; m < 4; ++m) _Pragma("unroll") for (int n = 0; n < 2; ++n) _Pragma("unroll") for (int k = 0; k < 2; ++k) \
        acc[ai][bj][m][n] = __builtin_amdgcn_mfma_f32_16x16x32_bf16(Bt[n][k], At[m][k], acc[ai][bj][m][n], 0, 0, 0); __builtin_amdgcn_s_setprio(0); } while (0)
#define PG8_WAIT_V(n) asm volatile("s_waitcnt vmcnt(" #n ")" ::: "memory")
#define PG8_WAIT_L(n) asm volatile("s_waitcnt lgkmcnt(" #n ")" ::: "memory")
#define PG8_BAR __builtin_amdgcn_s_barrier()
#define PG8_SCHED __builtin_amdgcn_sched_barrier(0)
    Unit cur, nxt; int ui = 0;
    if (!S.next(0, cur)) return;
    f32x4 acc[2][2][4][2];
#pragma unroll
    for (int a = 0; a < 2; ++a)
#pragma unroll
        for (int b = 0; b < 2; ++b)
#pragma unroll
            for (int m = 0; m < 4; ++m)
#pragma unroll
                for (int n = 0; n < 2; ++n) acc[a][b][m][n] = (f32x4){0.f, 0.f, 0.f, 0.f};
    bf16x8 At[4][2], B0[2][2], B1[2][2];
    const char* cA = (const char*)g.A + (size_t)cur.pm * tstepA + cur.aoff; const char* cB = (const char*)g.Bt + (size_t)cur.pn * tstepB;
    PG8_STAGE(PG8_SB(0, 0), cB, voffB); PG8_STAGE(PG8_SB(0, 1), cB + hstepB, voffB); PG8_STAGE(PG8_SA(0, 0), cA, voffA); PG8_STAGE(PG8_SA(0, 1), cA + hstepA, voffA);
    if (wr == 1) PG8_BAR;
    PG8_WAIT_V(2); PG8_BAR;
    PG8_STAGE(PG8_SB(1, 0), cB + kstep, voffB); PG8_STAGE(PG8_SA(1, 0), cA + kstep, voffA); PG8_STAGE(PG8_SB(1, 1), cB + hstepB + kstep, voffB);
    PG8_WAIT_V(6); PG8_BAR;
    for (;;) {
        const bool has_next = S.next(ui + 1, nxt);
        const char* nA = has_next ? (const char*)g.A + (size_t)nxt.pm * tstepA + nxt.aoff : cA; const char* nB = has_next ? (const char*)g.Bt + (size_t)nxt.pn * tstepB : cB;
#pragma unroll 1
        for (int t = 0; t < nt; t += 2) {
            const bool last = (t == nt - 2);
            const char* a1 = cA + (size_t)(t + 1) * kstep;
            const char* a2 = last ? nA : cA + (size_t)(t + 2) * kstep; const char* b2 = last ? nB : cB + (size_t)(t + 2) * kstep;
            const char* a3 = a2 + kstep; const char* b3 = b2 + kstep;
            PG8_LDB(B0, 0, 0); PG8_LDB(B1, 0, 1); PG8_SCHED; PG8_LDA(At, 0, 0); PG8_STAGE(PG8_SA(1, 1), a1 + hstepA, voffA);
            PG8_WAIT_V(8); PG8_WAIT_L(0); PG8_BAR; PG8_MMA(0, 0, At, B0); PG8_MMA(0, 1, At, B1); PG8_BAR; PG8_SCHED;
            PG8_LDA(At, 0, 1); PG8_STAGE(PG8_SB(0, 0), b2, voffB); PG8_STAGE(PG8_SB(0, 1), b2 + hstepB, voffB); PG8_STAGE(PG8_SA(0, 0), a2, voffA);
            PG8_WAIT_V(8); PG8_WAIT_L(0); PG8_BAR; PG8_MMA(1, 0, At, B0); PG8_MMA(1, 1, At, B1); PG8_BAR; PG8_SCHED;
            PG8_LDB(B0, 1, 0); PG8_LDB(B1, 1, 1); PG8_SCHED; PG8_LDA(At, 1, 0); PG8_STAGE(PG8_SA(0, 1), a2 + hstepA, voffA);
            PG8_WAIT_V(8); PG8_WAIT_L(0); PG8_BAR; PG8_MMA(0, 0, At, B0); PG8_MMA(0, 1, At, B1); PG8_BAR; PG8_SCHED;
            PG8_LDA(At, 1, 1); PG8_STAGE(PG8_SB(1, 0), b3, voffB); PG8_STAGE(PG8_SB(1, 1), b3 + hstepB, voffB); PG8_STAGE(PG8_SA(1, 0), a3, voffA);
            PG8_WAIT_V(8); PG8_WAIT_L(0); PG8_BAR; PG8_MMA(1, 0, At, B0); PG8_MMA(1, 1, At, B1); PG8_BAR; PG8_SCHED;
        }
        if constexpr (ALIGN_EPI) { if (wr == 0) PG8_BAR; }
        { int ln_; asm volatile("v_mbcnt_lo_u32_b32 %0, -1, 0\n\tv_mbcnt_hi_u32_b32 %0, -1, %0" : "=v"(ln_)); E(acc, cur, wr, wc, ln_ & 15, ln_ >> 4); }
        if (!has_next) break;
#pragma unroll
        for (int a = 0; a < 2; ++a)
#pragma unroll
            for (int b = 0; b < 2; ++b)
#pragma unroll
                for (int m = 0; m < 4; ++m)
#pragma unroll
                    for (int n = 0; n < 2; ++n) acc[a][b][m][n] = (f32x4){0.f, 0.f, 0.f, 0.f};
        cur = nxt; cA = nA; cB = nB; ++ui;
        if constexpr (ALIGN_EPI) { if (wr == 1) PG8_BAR; }
    }
    PG8_WAIT_V(0);
    if constexpr (!ALIGN_EPI) { if (wr == 0) PG8_BAR; }
    PG8_BAR;
#undef PG8_SA
#undef PG8_SB
#undef PG8_STAGE
#undef PG8_LDA
#undef PG8_LDB
#undef PG8_MMA
#undef PG8_WAIT_V
#undef PG8_WAIT_L
#undef PG8_BAR
#undef PG8_SCHED
}

template <class Epi, class Sched, bool ALIGN_EPI, int CMAP = 0>
__device__ __forceinline__ void gemm_phase8(LAS unsigned char* lds, const int tid_in, const Gemm g, const Sched& S, const Epi& E) {
    const int tid = tid_in, wid = __builtin_amdgcn_readfirstlane(tid >> 6), lane = tid & 63, wr = wid >> 2, wc = wid & 3, fr = lane & 15, fq = lane >> 4;
    const int K = g.K, nt = K / 128, lda = g.lda;
    unsigned voffA, voffB;
    { int R, C; stage_rc(tid * 16, R, C); const int p32 = perm32(R & 31); const int Rb = CMAP ? 64 * (R >> 5) + 16 * (p32 >> 3) + (p32 & 7) : (R & ~31) + p32; voffA = (unsigned)(R * lda + C * 2); voffB = (unsigned)(Rb * K + C * 2); }
    const unsigned pstepA = 64u * (unsigned)lda, pstepB = (CMAP ? 128u : 64u) * (unsigned)K;
    const unsigned kstep = (unsigned)(BK * 2);
    const unsigned hstepA = (unsigned)HALF * (unsigned)lda, tstepA = 2 * hstepA, hstepB = (unsigned)(CMAP ? 8 : HALF) * (unsigned)K, tstepB = (unsigned)BM * (unsigned)K;
    const __amdgpu_buffer_rsrc_t rsA = __builtin_amdgcn_make_buffer_rsrc((void*)g.A, 0, 0x7fffffff, 0x00020000), rsB = __builtin_amdgcn_make_buffer_rsrc((void*)g.Bt, 0, 0x7fffffff, 0x00020000);
    const unsigned ldsw = (unsigned)wid * 1024u;
    const int aoff0 = lds_byte(wr * 64 + fr, fq * 8), aoff1 = aoff0 + 1024, boff0 = lds_byte(wc * 32 + fr, fq * 8), boff1 = boff0 + 1024;
#define PG8_SA(b, h) (((b) * 2 + (h)) * HTB)
#define PG8_SB(b, h) ((4 + (b) * 2 + (h)) * HTB)
#define PG8_STAGE(bufoff, goff, voff, pstep) do { _Pragma("unroll") for (int _i = 0; _i < 2; ++_i) \
        __builtin_amdgcn_raw_ptr_buffer_load_lds(PG8_RS_##voff, (LAS unsigned*)(lds + (bufoff) + ldsw + _i * 8192), 16, (int)(voff), (int)((goff) + _i * (pstep)), 0, 0); } while (0)
#define PG8_RS_voffA rsA
#define PG8_RS_voffB rsB
#define PG8_LDA(dst, b, h) do { _Pragma("unroll") for (int m = 0; m < 4; ++m) { dst[m][0] = *(const LAS u32x4*)(lds + PG8_SA(b, h) + aoff0 + m * 2048); dst[m][1] = *(const LAS u32x4*)(lds + PG8_SA(b, h) + aoff1 + m * 2048); } } while (0)
#define PG8_LDB(dst, b, h) do { _Pragma("unroll") for (int n = 0; n < 2; ++n) { dst[n][0] = *(const LAS u32x4*)(lds + PG8_SB(b, h) + boff0 + n * 2048); dst[n][1] = *(const LAS u32x4*)(lds + PG8_SB(b, h) + boff1 + n * 2048); } } while (0)
#define PG8_J8(x) __builtin_bit_cast(i32x8, __builtin_shufflevector((x)[0], (x)[1], 0, 1, 2, 3, 4, 5, 6, 7))
#define PG8_MMA(ai, bj, At, Bt) do { __builtin_amdgcn_s_setprio(1); _Pragma("unroll") for (int m = 0; m < 4; ++m) _Pragma("unroll") for (int n = 0; n < 2; ++n) \
        acc[ai][bj][m][n] = __builtin_amdgcn_mfma_scale_f32_16x16x128_f8f6f4(PG8_J8(Bt[n]), PG8_J8(At[m]), acc[ai][bj][m][n], 0, 0, 0, 0, 0, 0);        __builtin_amdgcn_s_setprio(0); } while (0)
#define PG8_WAIT_V(n) asm volatile("s_waitcnt vmcnt(" #n ")" ::: "memory")
#define PG8_WAIT_L(n) asm volatile("s_waitcnt lgkmcnt(" #n ")" ::: "memory")
#define PG8_BAR __builtin_amdgcn_s_barrier()
#define PG8_SCHED __builtin_amdgcn_sched_barrier(0)
    Unit cur, nxt; int ui = 0;
    if (!S.next(0, cur)) return;
    f32x4 acc[2][2][4][2];
#pragma unroll
    for (int a = 0; a < 2; ++a)
#pragma unroll
        for (int b = 0; b < 2; ++b)
#pragma unroll
            for (int m = 0; m < 4; ++m)
#pragma unroll
                for (int n = 0; n < 2; ++n) acc[a][b][m][n] = (f32x4){0.f, 0.f, 0.f, 0.f};
    u32x4 At[4][2], B0[2][2], B1[2][2];
    unsigned cA = (unsigned)cur.pm * tstepA + (unsigned)cur.aoff, cB = (unsigned)cur.pn * tstepB;
    PG8_STAGE(PG8_SB(0, 0), cB, voffB, pstepB); PG8_STAGE(PG8_SB(0, 1), cB + hstepB, voffB, pstepB); PG8_STAGE(PG8_SA(0, 0), cA, voffA, pstepA); PG8_STAGE(PG8_SA(0, 1), cA + hstepA, voffA, pstepA);
    if (wr == 1) PG8_BAR;
    PG8_WAIT_V(2); PG8_BAR;
    PG8_STAGE(PG8_SB(1, 0), cB + kstep, voffB, pstepB); PG8_STAGE(PG8_SA(1, 0), cA + kstep, voffA, pstepA); PG8_STAGE(PG8_SB(1, 1), cB + hstepB + kstep, voffB, pstepB);
    PG8_WAIT_V(6); PG8_BAR;
    for (;;) {
        const bool has_next = S.next(ui + 1, nxt);
        const unsigned nA = has_next ? (unsigned)nxt.pm * tstepA + (unsigned)nxt.aoff : cA, nB = has_next ? (unsigned)nxt.pn * tstepB : cB;
#pragma unroll 1
        for (int t = 0; t < nt; t += 2) {
            const bool last = (t == nt - 2);
            const unsigned a1 = cA + (unsigned)(t + 1) * kstep;
            const unsigned a2 = last ? nA : cA + (unsigned)(t + 2) * kstep, b2 = last ? nB : cB + (unsigned)(t + 2) * kstep;
            const unsigned a3 = a2 + kstep, b3 = b2 + kstep;
            PG8_LDB(B0, 0, 0); PG8_LDB(B1, 0, 1); PG8_SCHED; PG8_LDA(At, 0, 0); PG8_STAGE(PG8_SA(1, 1), a1 + hstepA, voffA, pstepA);
            PG8_WAIT_V(8); PG8_WAIT_L(0); PG8_BAR; PG8_MMA(0, 0, At, B0); PG8_MMA(0, 1, At, B1); PG8_BAR; PG8_SCHED;
            PG8_LDA(At, 0, 1); PG8_STAGE(PG8_SB(0, 0), b2, voffB, pstepB); PG8_STAGE(PG8_SB(0, 1), b2 + hstepB, voffB, pstepB); PG8_STAGE(PG8_SA(0, 0), a2, voffA, pstepA);
            PG8_WAIT_V(8); PG8_WAIT_L(0); PG8_BAR; PG8_MMA(1, 0, At, B0); PG8_MMA(1, 1, At, B1); PG8_BAR; PG8_SCHED;
            PG8_LDB(B0, 1, 0); PG8_LDB(B1, 1, 1); PG8_SCHED; PG8_LDA(At, 1, 0); PG8_STAGE(PG8_SA(0, 1), a2 + hstepA, voffA, pstepA);
            PG8_WAIT_V(8); PG8_WAIT_L(0); PG8_BAR; PG8_MMA(0, 0, At, B0); PG8_MMA(0, 1, At, B1); PG8_BAR; PG8_SCHED;
            PG8_LDA(At, 1, 1); PG8_STAGE(PG8_SB(1, 0), b3, voffB, pstepB); PG8_STAGE(PG8_SB(1, 1), b3 + hstepB, voffB, pstepB); PG8_STAGE(PG8_SA(1, 0), a3, voffA, pstepA);
            PG8_WAIT_V(8); PG8_WAIT_L(0); PG8_BAR; PG8_MMA(1, 0, At, B0); PG8_MMA(1, 1, At, B1); PG8_BAR; PG8_SCHED;
        }
        if constexpr (ALIGN_EPI) { if (wr == 0) PG8_BAR; }
        { int ln_; asm volatile("v_mbcnt_lo_u32_b32 %0, -1, 0\n\tv_mbcnt_hi_u32_b32 %0, -1, %0" : "=v"(ln_)); E(acc, cur, wr, wc, ln_ & 15, ln_ >> 4); }
        if (!has_next) break;
#pragma unroll
        for (int a = 0; a < 2; ++a)
#pragma unroll
            for (int b = 0; b < 2; ++b)
#pragma unroll
                for (int m = 0; m < 4; ++m)
#pragma unroll
                    for (int n = 0; n < 2; ++n) acc[a][b][m][n] = (f32x4){0.f, 0.f, 0.f, 0.f};
        cur = nxt; cA = nA; cB = nB; ++ui;
        if constexpr (ALIGN_EPI) { if (wr == 1) PG8_BAR; }
    }
    PG8_WAIT_V(0);
    if constexpr (!ALIGN_EPI) { if (wr == 0) PG8_BAR; }
    PG8_BAR;
#undef PG8_SA
#undef PG8_SB
#undef PG8_STAGE
#undef PG8_RS_voffA
#undef PG8_RS_voffB
#undef PG8_LDA
#undef PG8_LDB
#undef PG8_MMA
#undef PG8_J8
#undef PG8_WAIT_V
#undef PG8_WAIT_L
#undef PG8_BAR
#undef PG8_SCHED
}

typedef f32x4 Acc[2][2][4][2];

__device__ __forceinline__ unsigned dpp_ror8(unsigned v) { return (unsigned)__builtin_amdgcn_update_dpp(0, (int)v, 0x128, 0xf, 0xf, false); }
struct CmPair { unsigned a, b; };
__device__ __forceinline__ CmPair cm_swapv(bool lo, unsigned x0, unsigned x1) { const unsigned r = dpp_ror8(lo ? x1 : x0); CmPair o; o.a = lo ? x0 : r; o.b = lo ? r : x1; return o; }
#define CM_SWAP_U(lo, X0, X1) do { const CmPair r_ = cm_swapv(lo, X0, X1); X0 = r_.a; X1 = r_.b; } while (0)
#define CM_SWAP_F(lo, X0, X1) do { const CmPair r_ = cm_swapv(lo, __builtin_bit_cast(unsigned, (float)(X0)), __builtin_bit_cast(unsigned, (float)(X1))); X0 = __builtin_bit_cast(float, r_.a); X1 = __builtin_bit_cast(float, r_.b); } while (0)
#define cm_swap4(lo, w0, w1) do { CM_SWAP_U(lo, w0.x, w1.x); CM_SWAP_U(lo, w0.y, w1.y); CM_SWAP_U(lo, w0.z, w1.z); CM_SWAP_U(lo, w0.w, w1.w); } while (0)
struct EpiRoute {
    bf16_t *d0, *d1, *d2, *d3; const float* qn; const float* kn; const float* srow;
    template <int NORM> __device__ __forceinline__ void run(const Acc& acc, const Unit& u, int wr, int wc, int fr, int fq, bf16_t* base, int ld, int ct) const {
        const bool lo = fr < 8;
        const int row0 = u.pm * BM + wr * 64 + (fr & 7), col0 = ct * 256 + wc * 64 + 16 * fq + 8 * (fr >> 3);
        f32x4 gg[2][2];
        if constexpr (NORM) { const float* gn = (u.pn == 4) ? qn : kn; const float gs = (u.pn == 4) ? 0.125f * LOG2E : 1.0f;
#pragma unroll
            for (int bj = 0; bj < 2; ++bj)
#pragma unroll
                for (int n = 0; n < 2; ++n) gg[bj][n] = *(const f32x4*)(gn + 16 * fq + 8 * bj + 4 * n) * gs; }
#pragma unroll
        for (int ai = 0; ai < 2; ++ai)
#pragma unroll
            for (int m = 0; m < 4; ++m) { bf16_t* rowp = base + (size_t)(row0 + ai * HALF + m * 16) * ld + col0; u32x4 w0, w1;
                f32x4 v00 = acc[ai][0][m][0], v01 = acc[ai][0][m][1], v10 = acc[ai][1][m][0], v11 = acc[ai][1][m][1];
                if constexpr (!NORM) { const float rsc = srow[u.pm * BM + wr * 64 + fr + ai * HALF + m * 16]; v00 = v00 * rsc; v01 = v01 * rsc; v10 = v10 * rsc; v11 = v11 * rsc; }
                if constexpr (NORM) { float ss = 0.f;
#pragma unroll
                    for (int e = 0; e < 4; ++e) ss += (v00[e] * v00[e] + v01[e] * v01[e]) + (v10[e] * v10[e] + v11[e] * v11[e]);
                    ss += shx(ss, 16, fr + 16 * fq); ss += shx(ss, 32, fr + 16 * fq);
                    const float rsc = srow[u.pm * BM + wr * 64 + fr + ai * HALF + m * 16];
                    const float rs = __builtin_amdgcn_rsqf(ss * (1.f / 64.f) + 1e-6f * __builtin_amdgcn_rcpf(rsc * rsc));
                    v00 = v00 * rs * gg[0][0]; v01 = v01 * rs * gg[0][1]; v10 = v10 * rs * gg[1][0]; v11 = v11 * rs * gg[1][1]; }
                w0.x = cvt_pk_bf16(v00[0], v00[1]); w0.y = cvt_pk_bf16(v00[2], v00[3]); w0.z = cvt_pk_bf16(v01[0], v01[1]); w0.w = cvt_pk_bf16(v01[2], v01[3]);
                w1.x = cvt_pk_bf16(v10[0], v10[1]); w1.y = cvt_pk_bf16(v10[2], v10[3]); w1.z = cvt_pk_bf16(v11[0], v11[1]); w1.w = cvt_pk_bf16(v11[2], v11[3]);
                cm_swap4(lo, w0, w1);
                __builtin_nontemporal_store(w0, (u32x4*)rowp); __builtin_nontemporal_store(w1, (u32x4*)(rowp + (size_t)8 * ld)); }
    }
    __device__ __forceinline__ void operator()(const Acc& acc, const Unit& u, int wr, int wc, int fr, int fq) const {
        const int pn = u.pn; bf16_t* base; int ld, ct;
        if (pn < 4) { base = d0; ld = 1024; ct = pn; } else if (pn < 7) { base = d1; ld = 768; ct = pn - 4; } else if (pn < 11) { base = d2; ld = 1024; ct = pn - 7; } else { base = d3; ld = 512; ct = pn - 11; }
        if (pn >= 11) {
            const int row0 = u.pm * BM + wr * 64 + fr, c0 = (pn - 11) * 128 + 32 * wc + 8 * fq;
#pragma unroll
            for (int ai = 0; ai < 2; ++ai)
#pragma unroll
                for (int m = 0; m < 4; ++m) { const float rsc = srow[row0 + ai * HALF + m * 16]; const f32x4 a0 = acc[ai][0][m][0] * rsc, a1 = acc[ai][0][m][1] * rsc, b0 = acc[ai][1][m][0] * rsc, b1 = acc[ai][1][m][1] * rsc; u32x4 w;
                    w.x = cvt_pk_bf16(a0[0] * sigm(b0[0]), a0[1] * sigm(b0[1])); w.y = cvt_pk_bf16(a0[2] * sigm(b0[2]), a0[3] * sigm(b0[3]));
                    w.z = cvt_pk_bf16(a1[0] * sigm(b1[0]), a1[1] * sigm(b1[1])); w.w = cvt_pk_bf16(a1[2] * sigm(b1[2]), a1[3] * sigm(b1[3]));
                    __builtin_nontemporal_store(w, (u32x4*)(d3 + (size_t)(row0 + ai * HALF + m * 16) * 256 + c0)); }
            return; }
        if (pn == 4 || pn == 5) run<1>(acc, u, wr, wc, fr, fq, base, ld, ct); else run<0>(acc, u, wr, wc, fr, fq, base, ld, ct);
    }
};
struct EpiBf16 {
    bf16_t* O; int ld, pnmask; float sc;
    __device__ __forceinline__ void operator()(const Acc& acc, const Unit& u, int wr, int wc, int fr, int fq) const {
        const bool lo = fr < 8;
        const int row0 = u.pm * BM + wr * 64 + (fr & 7), col0 = (u.pn & pnmask) * 256 + wc * 64 + 16 * fq + 8 * (fr >> 3);
#pragma unroll
        for (int ai = 0; ai < 2; ++ai)
#pragma unroll
            for (int m = 0; m < 4; ++m) { bf16_t* rowp = O + (size_t)(row0 + ai * HALF + m * 16) * ld + col0; u32x4 w0, w1;
                { const f32x4 v0 = acc[ai][0][m][0] * sc, v1 = acc[ai][0][m][1] * sc; w0.x = cvt_pk_bf16(v0[0], v0[1]); w0.y = cvt_pk_bf16(v0[2], v0[3]); w0.z = cvt_pk_bf16(v1[0], v1[1]); w0.w = cvt_pk_bf16(v1[2], v1[3]); }
                { const f32x4 v0 = acc[ai][1][m][0] * sc, v1 = acc[ai][1][m][1] * sc; w1.x = cvt_pk_bf16(v0[0], v0[1]); w1.y = cvt_pk_bf16(v0[2], v0[3]); w1.z = cvt_pk_bf16(v1[0], v1[1]); w1.w = cvt_pk_bf16(v1[2], v1[3]); }
                cm_swap4(lo, w0, w1);
                *(u32x4*)rowp = w0; *(u32x4*)(rowp + (size_t)8 * ld) = w1; }
    }
};
struct EpiLora {
    float* wdec; bf16_t* ag; bf16_t* gp; const float* w0; const float* a0;
    __device__ __forceinline__ void operator()(const Acc& acc, const Unit& u, int wr, int wc, int fr, int fq) const {
        const int row0 = u.pm * BM + wr * 64 + fr, cl0 = wc * 32 + 8 * fq, pn = u.pn;
#pragma unroll
        for (int ai = 0; ai < 2; ++ai)
#pragma unroll
            for (int m = 0; m < 4; ++m) { const size_t row = (size_t)(row0 + ai * HALF + m * 16);
#pragma unroll
                for (int bj = 0; bj < 2; ++bj) { const int col = bj * HALF + cl0; float v[8];
#pragma unroll
                    for (int n = 0; n < 2; ++n)
#pragma unroll
                        for (int e = 0; e < 4; ++e) v[4 * n + e] = acc[ai][bj][m][n][e];
                    if (pn == 0) {
                        *(f32x4*)(wdec + row * 256 + col) = (f32x4){v[0], v[1], v[2], v[3]}; *(f32x4*)(wdec + row * 256 + col + 4) = (f32x4){v[4], v[5], v[6], v[7]};
                    } else if (pn == 1) {
                        *(u32x4*)(ag + row * 256 + col) = pack8(v);
                    } else { *(u32x4*)(gp + row * 256 + col) = pack8(v); }
                } }
    }
};
struct EpiBall {
    unsigned char* O;
    __device__ __forceinline__ void operator()(const Acc& acc, const Unit& u, int wr, int wc, int fr, int fq) const {
        unsigned char* base = O + ((size_t)(u.pm * 16 + u.pn) << 17) + (wc >> 1) * 32768 + (wr * 2 + (wc & 1)) * 1024 + (fr + 16 * fq) * 16;
#pragma unroll
        for (int ai = 0; ai < 2; ++ai)
#pragma unroll
            for (int m = 0; m < 4; ++m)
#pragma unroll
                for (int bj = 0; bj < 2; ++bj) { const f32x4 v0 = acc[ai][bj][m][0], v1 = acc[ai][bj][m][1]; u32x4 w;
                    w.x = cvt_pk_bf16(v0[0], v0[1]); w.y = cvt_pk_bf16(v0[2], v0[3]); w.z = cvt_pk_bf16(v1[0], v1[1]); w.w = cvt_pk_bf16(v1[2], v1[3]);
                    __builtin_nontemporal_store(w, (u32x4*)(base + bj * 65536 + (ai * 4 + m) * 4096)); }
    }
};
struct EpiGateMerge {
    const bf16_t* ball; bf16_t* merged;
    __device__ __forceinline__ void operator()(const Acc& acc, const Unit& u, int wr, int wc, int fr, int fq) const {
        const int row0 = u.pm * BM + wr * 64 + fr, o0 = 64 * u.pn + 16 * wc + 4 * fq;
        const int cw = 64 * (u.pn & 3) + 16 * wc + 4 * fq;
        const unsigned char* lbase = (const unsigned char*)ball + ((size_t)(u.pm * 16 + (u.pn >> 2)) << 17) + (cw >> 7) * 65536 + ((cw >> 6) & 1) * 32768 + (wr * 2 + ((cw >> 5) & 1)) * 1024 + (fr + 16 * ((cw >> 3) & 3)) * 16 + ((cw >> 2) & 1) * 8;
        u32x2 bb[2][4][4];
#pragma unroll
        for (int ai = 0; ai < 2; ++ai)
#pragma unroll
            for (int m = 0; m < 4; ++m)
#pragma unroll
                for (int gi = 0; gi < 4; ++gi) bb[ai][m][gi] = __builtin_nontemporal_load((const u32x2*)(lbase + ((size_t)gi << 19) + (ai * 4 + m) * 4096));
#pragma unroll
        for (int ai = 0; ai < 2; ++ai)
#pragma unroll
            for (int m = 0; m < 4; ++m) { const size_t row = (size_t)(row0 + ai * HALF + m * 16); float s[4] = {0.f, 0.f, 0.f, 0.f};
#pragma unroll
                for (int bj = 0; bj < 2; ++bj)
#pragma unroll
                    for (int n = 0; n < 2; ++n) { const int gi = 2 * bj + n; const u32x2 b = bb[ai][m][gi];
                        const f32x4 a = acc[ai][bj][m][n] * (-F8_DESCALE * LOG2E);
#define SG2_(x) __builtin_amdgcn_rcpf(1.f + __builtin_amdgcn_exp2f(x))
                        s[0] += SG2_(a[0]) * bflo(b.x); s[1] += SG2_(a[1]) * bfhi(b.x); s[2] += SG2_(a[2]) * bflo(b.y); s[3] += SG2_(a[3]) * bfhi(b.y); }
#undef SG2_
                u32x2 w; w.x = cvt_pk_bf16(s[0], s[1]); w.y = cvt_pk_bf16(s[2], s[3]);
                *(u32x2*)(merged + row * 1024 + o0) = w; }
    }
};
struct EpiResidual {
    bf16_t* xb; float sc;
    __device__ __forceinline__ void operator()(const Acc& acc, const Unit& u, int wr, int wc, int fr, int fq) const {
        const bool lo = fr < 8;
        const int row0 = u.pm * BM + wr * 64 + (fr & 7), col0 = u.pn * 256 + wc * 64 + 16 * fq + 8 * (fr >> 3);
#pragma unroll
        for (int ai = 0; ai < 2; ++ai)
#pragma unroll
            for (int m = 0; m < 4; ++m) { u32x4* p0 = (u32x4*)(xb + (size_t)(row0 + ai * HALF + m * 16) * 1024 + col0); u32x4* p1 = (u32x4*)((bf16_t*)p0 + 8 * 1024);
                const u32x4 t0 = *p0, t1 = *p1;
                f32x4 a0 = acc[ai][0][m][0] * sc, a1 = acc[ai][0][m][1] * sc, b0 = acc[ai][1][m][0] * sc, b1 = acc[ai][1][m][1] * sc;
#pragma unroll
                for (int e = 0; e < 4; ++e) { CM_SWAP_F(lo, a0[e], b0[e]); CM_SWAP_F(lo, a1[e], b1[e]); }
                u32x4 w0, w1;
                w0.x = cvt_pk_bf16(bflo(t0.x) + a0[0], bfhi(t0.x) + a0[1]); w0.y = cvt_pk_bf16(bflo(t0.y) + a0[2], bfhi(t0.y) + a0[3]); w0.z = cvt_pk_bf16(bflo(t0.z) + a1[0], bfhi(t0.z) + a1[1]); w0.w = cvt_pk_bf16(bflo(t0.w) + a1[2], bfhi(t0.w) + a1[3]);
                w1.x = cvt_pk_bf16(bflo(t1.x) + b0[0], bfhi(t1.x) + b0[1]); w1.y = cvt_pk_bf16(bflo(t1.y) + b0[2], bfhi(t1.y) + b0[3]); w1.z = cvt_pk_bf16(bflo(t1.z) + b1[0], bfhi(t1.z) + b1[1]); w1.w = cvt_pk_bf16(bflo(t1.w) + b1[2], bfhi(t1.w) + b1[3]);
                *p0 = w0; *p1 = w1; }
    }
};
struct EpiSwiglu {
    unsigned char* hid; int ldh, ncol; bool pad;
    __device__ __forceinline__ void operator()(const Acc& acc, const Unit& u, int wr, int wc, int fr, int fq) const {
        const int pl = u.pn % ncol; const int row0 = u.pm * BM + wr * 64 + fr, col0 = pl * 128 + wc * 32 + 8 * fq;
        const bool dopad = pad && (pl == ncol - 1);
#pragma unroll
        for (int ai = 0; ai < 2; ++ai)
#pragma unroll
            for (int m = 0; m < 4; ++m) { float v[8];
#pragma unroll
                for (int n = 0; n < 2; ++n)
#pragma unroll
                    for (int e = 0; e < 4; ++e) { const float a = acc[ai][0][m][n][e], b = acc[ai][1][m][n][e];
                        v[4 * n + e] = (a * b) * (F8_DESCALE * F8_DESCALE * F8_MUL_H) * __builtin_amdgcn_rcpf(1.f + __builtin_amdgcn_exp2f(a * (-F8_DESCALE * LOG2E))); }
                unsigned char* rp = hid + (size_t)(row0 + ai * HALF + m * 16) * ldh + col0;
                u32x2 w; w.x = pk4_fp8(v[0], v[1], v[2], v[3]); w.y = pk4_fp8(v[4], v[5], v[6], v[7]); *(u32x2*)rp = w;
                if (dopad) { unsigned z0; asm volatile("v_mov_b32 %0, 0" : "=v"(z0)); *(u32x2*)(rp + 128) = (u32x2){z0, z0}; } }
    }
};
struct EpiMoeOut {
    float* out; const int* rowtok; const float* rowgate; const int* segend;
    __device__ __forceinline__ void operator()(const Acc& acc, const Unit& u, int wr, int wc, int fr, int fq) const {
        const int row0 = u.pm * BM + wr * 64 + fr, col0 = (u.pn & 3) * 256 + wc * 32 + 8 * fq, lim = segend[u.pm];
#pragma unroll
        for (int ai = 0; ai < 2; ++ai)
#pragma unroll
            for (int m = 0; m < 4; ++m) { const int row = row0 + ai * HALF + m * 16;
                if (row < lim) { const int tok = rowtok[row]; const float gt = rowgate[row]; float* rowp = out + (size_t)tok * 1024 + col0;
#pragma unroll
                    for (int bj = 0; bj < 2; ++bj)
#pragma unroll
                        for (int n = 0; n < 2; ++n)
#pragma unroll
                            for (int e = 0; e < 4; ++e) __hip_atomic_fetch_add(rowp + bj * HALF + 4 * n + e, gt * acc[ai][bj][m][n][e], __ATOMIC_RELAXED, __HIP_MEMORY_SCOPE_AGENT);
                } }
    }
};
}

#define XB_TMO      128
#define XB_XCNT(j)  (256  + 64 * (j))
#define XB_XSUB(j)  (1280 + 64 * (j))
#define XB_XGEN(j)  (2304 + 64 * (j))
#define XB_TOP      3328
#define XB_TOPGEN   3392
#define XCD_BAR_WORDS 3456
#define XB_SPIN_CAP (1u << 18)
__device__ __forceinline__ unsigned xb_ld(unsigned* p)              { return __hip_atomic_load(p, __ATOMIC_RELAXED, __HIP_MEMORY_SCOPE_AGENT); }
__device__ __forceinline__ unsigned xb_add(unsigned* p, unsigned v) { return __hip_atomic_fetch_add(p, v, __ATOMIC_RELAXED, __HIP_MEMORY_SCOPE_AGENT); }
__device__ __forceinline__ unsigned xb_xcc_id() { return (unsigned)__builtin_amdgcn_s_getreg((3 << 11) | 20) & 0xFu; }
#define XB_SPIN(cond, bar) do { unsigned _sp = 0; while (cond) { __builtin_amdgcn_s_sleep(1); \
    if ((++_sp & 255u) == 0u) { if (xb_ld(&(bar)[XB_TMO])) break; if (_sp > XB_SPIN_CAP) { atomicAdd(&(bar)[XB_TMO], 1u); break; } } } } while (0)
struct XcdBarrier { unsigned* bar; unsigned x; volatile LAS unsigned* st; };
__device__ __forceinline__ XcdBarrier xcd_barrier_post(unsigned* bar, volatile LAS unsigned* st) {
    XcdBarrier b; b.bar = bar; b.x = xb_xcc_id(); b.st = st;
    if (threadIdx.x == 0) (void)xb_add(&bar[XB_XCNT(b.x)], 1u);
    return b;
}
__device__ __forceinline__ void xcd_barrier_complete(unsigned* bar, unsigned x, unsigned& nloc, unsigned& nx) {
    const unsigned G = gridDim.x * gridDim.y * gridDim.z;
    unsigned sum, cnt, mine, sp = 0u;
    for (;;) {
        sum = 0u; cnt = 0u; mine = 0u;
#pragma unroll
        for (unsigned j = 0; j < 16; ++j) { const unsigned c = xb_ld(&bar[XB_XCNT(j)]); sum += c; cnt += (c > 0u) ? 1u : 0u; mine = (j == x) ? c : mine; }
        if (sum == G) break;
        __builtin_amdgcn_s_sleep(1);
        if ((++sp & 255u) == 0u) { if (xb_ld(&bar[XB_TMO])) break; if (sp > XB_SPIN_CAP) { atomicAdd(&bar[XB_TMO], 1u); break; } }
    }
    nloc = mine > 0u ? mine : 1u; nx = cnt > 0u ? cnt : 1u;
}
__device__ __forceinline__ void xcd_barrier(const XcdBarrier& b, const int tid) {
    asm volatile("s_waitcnt vmcnt(0)" ::: "memory");
    __syncthreads();
    if (tid == 0) {
        unsigned* bar = b.bar;
        __builtin_amdgcn_s_waitcnt(0);
        unsigned nloc = b.st[0], nx = b.st[1];
        if (nloc == 0u) { xcd_barrier_complete(bar, b.x, nloc, nx); b.st[0] = nloc; b.st[1] = nx; }
        const unsigned old = xb_add(&bar[XB_XSUB(b.x)], 1u);
        const unsigned gen = old / nloc;
        if (old + 1u == (gen + 1u) * nloc) {
            __builtin_amdgcn_fence(__ATOMIC_RELEASE, "agent");
            asm volatile("s_waitcnt vmcnt(0)" ::: "memory");
            const unsigned og = xb_add(&bar[XB_TOP], 1u);
            const unsigned tg = og / nx;
            if (og + 1u == (tg + 1u) * nx) xb_add(&bar[XB_TOPGEN], 1u);
            else XB_SPIN(xb_ld(&bar[XB_TOPGEN]) == tg, bar);
            __builtin_amdgcn_fence(__ATOMIC_ACQUIRE, "agent");
            xb_add(&bar[XB_XGEN(b.x)], 1u);
            asm volatile("s_waitcnt vmcnt(0)" ::: "memory");
        } else {
            XB_SPIN(xb_ld(&bar[XB_XGEN(b.x)]) == gen, bar);
            __builtin_amdgcn_fence(__ATOMIC_ACQUIRE, "agent");
            asm volatile("s_waitcnt vmcnt(0)" ::: "memory");
        }
    }
    __syncthreads();
}

constexpr size_t MiB = 1u << 20;
constexpr size_t WS_CTL = 0, CTL_ZERO_BYTES = 1 * MiB;
constexpr int CW_BAR = 4096;
constexpr int CW_QUEUE = 20480;
constexpr int CW_MOE = 16384;
constexpr size_t WS_EIDX = 1 * MiB, WS_GATE = WS_EIDX + 256 * 1024, WS_ROWTOK = WS_EIDX + 512 * 1024, WS_ROWGATE = 2 * MiB, WS_TEXP = 2 * MiB + 512 * 1024, WS_SEGEND = WS_TEXP + 4096, WS_NT = WS_TEXP + 8192;
constexpr size_t WS_SLOTOF = 2 * MiB + 768 * 1024;
constexpr size_t WS_SROW = 3 * MiB + 512 * 1024  , WS_BON = 3 * MiB, WS_COS = 4 * MiB, WS_SIN = 6 * MiB;
constexpr size_t WS_WIN = 8 * MiB, WS_WLORA = 15 * MiB, WS_WB = 16 * MiB, WS_WG = 18 * MiB, WS_WOUT = 26 * MiB, WS_W13 = 28 * MiB  , WS_W2D = 50 * MiB, WS_W2M = 50 * MiB, WS_H8 = 72 * MiB  ;
constexpr size_t WS_XB = 104 * MiB  , WS_Y = 168 * MiB, WS_BIG = 232 * MiB;
constexpr size_t WS_RW = WS_BIG, WS_WDEC = WS_BIG + 208 * MiB  , WS_AP = WS_BIG + 240 * MiB  , WS_GP = WS_BIG + 192 * MiB  , WS_AG = WS_BIG + 32 * MiB  , WS_SB = WS_BIG + 64 * MiB, WS_RET = WS_BIG + 112 * MiB, WS_CV = WS_BIG + 176 * MiB, WS_Y0 = WS_CV;
constexpr size_t WS_RKVS = WS_BIG + 208 * MiB, WS_ALORA = WS_BIG + 256 * MiB, WS_RHAT = WS_ALORA, WS_KV = WS_BIG + 272 * MiB, WS_SST = WS_WDEC  , WS_PQ = WS_BIG + 304 * MiB  , WS_END = WS_BIG + 368 * MiB;
constexpr size_t WS_BALL = WS_BIG, WS_MERGED = WS_BIG + 256 * MiB, WS_HID = WS_BIG, WS_XS = WS_BIG, WS_YS = WS_XS, WS_HIDM = WS_BIG + 132 * MiB;
static_assert(WS_HIDM + (size_t)MPAD * DFE * 2 <= WS_END && WS_MERGED + (size_t)T * D * 2 <= WS_END && WS_W2M + (size_t)NEXP * D * DFE * 2 <= WS_H8, "ws map");
static_assert(WS_W13 + (size_t)NEXP * 2 * DFE * D <= WS_W2M && WS_W13 + (size_t)2 * DFF * D <= WS_W2D && WS_W2M + (size_t)NEXP * D * DFE * 2 <= WS_H8 && WS_H8 + (size_t)T * D <= WS_XB, "ws map weights");

constexpr int LDS_BYTES = 147456, RING_BYTES = 131072, MISC_OFF = RING_BYTES + 320;

struct Args { const float* in[32]; float* out; unsigned char* ws; int ph_lo, ph_hi; };
#define CAS __attribute__((address_space(4)))
struct Ctx {
    LAS unsigned char* lds; unsigned char* ws; float* out; const float* const CAS* in;
    int tid, lane, wave, G, bid;
};
__device__ __forceinline__ const CAS Args* ka_ptr() { const CAS Args* p = (const CAS Args*)__builtin_amdgcn_kernarg_segment_ptr(); asm volatile("" : "+s"(p)); return p; }
extern __shared__ __attribute__((aligned(16))) unsigned char lds_raw[];
__device__ __forceinline__ Ctx make_ctx(int wv) {
    const CAS Args* ka = ka_ptr();
    Ctx C; C.lds = (LAS unsigned char*)lds_raw; C.ws = ka->ws; C.out = ka->out; C.in = ka->in;
    int g_ = gridDim.x, b_ = blockIdx.x, w_ = wv; asm volatile("" : "+s"(g_), "+s"(b_), "+s"(w_));
    int ln_; asm volatile("v_mbcnt_lo_u32_b32 %0, -1, 0\n\tv_mbcnt_hi_u32_b32 %0, -1, %0" : "=v"(ln_));
    C.lane = ln_; C.wave = w_; C.tid = w_ * 64 + ln_; C.G = g_; C.bid = b_;
    return C;
}
enum { I_X = 0, I_NORM_MIX, I_W_IN, I_RW_MU, I_RW_W0, I_RW_W2, I_RW_A0, I_RW_A2, I_RW_G2, I_RW_KK, I_RW_KA, I_RW_RK, I_RW_LNW, I_RW_LNB, I_SB_QN, I_SB_KN, I_RET_GN,
       I_CONV_DW, I_CONV_B, I_CONV_LNW, I_CONV_LNB, I_W_GATE, I_W_BRANCH, I_W_OUT, I_NORM_FFN, I_FFN_W1, I_FFN_W3, I_FFN_W2, I_ROUTER, I_MOE_W1, I_MOE_W3, I_MOE_W2 };

__device__ __forceinline__ int q_next(const Ctx& C, unsigned* head) {
    LAS int* slot = (LAS int*)(C.lds + MISC_OFF + 64);
    __syncthreads();
    if (C.tid == 0) *slot = (int)__hip_atomic_fetch_add(head, 1u, __ATOMIC_RELAXED, __HIP_MEMORY_SCOPE_AGENT);
    __syncthreads();
    return *slot;
}
__device__ __forceinline__ void ph_prologue_(const Ctx& C) {
    const size_t gid = (size_t)C.bid * NTHR + C.tid, gsz = (size_t)C.G * NTHR;
    float* cs = (float*)(C.ws + WS_COS); float* sn = (float*)(C.ws + WS_SIN);
    for (size_t i = gid; i < (size_t)SEQ * 32; i += gsz) {
        const int pos = (int)(i >> 5), j = (int)(i & 31);
        const float inv = (float)pow(10000.0, -(double)(2 * j) / 64.0);
        const float ang = (float)pos * inv;
        cs[i] = (float)cos((double)ang); sn[i] = (float)sin((double)ang);
    }
}

__device__ __forceinline__ int dest_row(int mode, int roff, int which, int n) {
    if (mode == 0) return roff + n;
    if (mode == 1) { const int pn = n >> 6, oc = n & 63; return 256 * pn + 128 * (roff >> 1) + 32 * (oc >> 4) + 8 * ((oc >> 2) & 3) + 4 * (roff & 1) + (oc & 3); }
    if (mode == 3) {
        if (n < 2816) return n;
        const int j = n - 2816, isb = j >> 8, jl = j & 127, t = (j >> 7) & 1;
        return 2816 + 256 * t + 64 * (jl >> 5) + 16 * ((jl >> 3) & 3) + 8 * isb + (jl & 7); }
    return roff + 256 * (n >> 7) + 128 * which + (n & 127);
}
__device__ __forceinline__ void xpose_item(const float* W, int K, int N, bf16* WT, int mode, int roff, int which, LAS float* scr, int item, int lane, const float* ks = nullptr) {
    const int nblk = N / 32, kb = item / nblk, nb = item % nblk, k0 = 64 * kb, n0 = 32 * nb;
#pragma unroll
    for (int i = 0; i < 8; ++i) { const int kk = (lane >> 3) + 8 * i, c4 = (lane & 7) * 4; f32x4 v = __builtin_nontemporal_load((const f32x4*)(W + (size_t)(k0 + kk) * N + n0 + c4)); if (ks) v = v * ks[k0 + kk];
        scr[kk * 33 + c4] = v.x; scr[kk * 33 + c4 + 1] = v.y; scr[kk * 33 + c4 + 2] = v.z; scr[kk * 33 + c4 + 3] = v.w; }
    asm volatile("s_waitcnt lgkmcnt(0)" ::: "memory");
    const int c = lane & 7;
#pragma unroll
    for (int j = 0; j < 4; ++j) { const int n = (lane >> 3) + 8 * j; const LAS float* s = scr + (8 * c) * 33 + n;
        u32x4 o; o.x = cvt_pk_bf16(s[0 * 33], s[1 * 33]); o.y = cvt_pk_bf16(s[2 * 33], s[3 * 33]); o.z = cvt_pk_bf16(s[4 * 33], s[5 * 33]); o.w = cvt_pk_bf16(s[6 * 33], s[7 * 33]);
        *(u32x4*)(WT + (size_t)dest_row(mode, roff, which, n0 + n) * K + k0 + 8 * c) = o; }
    asm volatile("s_waitcnt lgkmcnt(0)" ::: "memory");
}
__device__ __forceinline__ void xpose_item8(const float* W, int K, int N, unsigned char* WT, int mode, int roff, int which, LAS float* scr, int item, int lane, int ldk = 0) {
    if (ldk == 0) ldk = K;
    const int nblk = N / 32, kb = item / nblk, nb = item % nblk, k0 = 64 * kb, n0 = 32 * nb;
#pragma unroll
    for (int i = 0; i < 8; ++i) { const int kk = (lane >> 3) + 8 * i, c4 = (lane & 7) * 4; const f32x4 v = __builtin_nontemporal_load((const f32x4*)(W + (size_t)(k0 + kk) * N + n0 + c4));
        scr[kk * 33 + c4] = v.x; scr[kk * 33 + c4 + 1] = v.y; scr[kk * 33 + c4 + 2] = v.z; scr[kk * 33 + c4 + 3] = v.w; }
    asm volatile("s_waitcnt lgkmcnt(0)" ::: "memory");
    const int c = lane & 3;
#pragma unroll
    for (int j = 0; j < 2; ++j) { const int n = (lane >> 2) + 16 * j; const LAS float* sp = scr + (16 * c) * 33 + n;
        u32x4 o;
        o.x = pk4_fp8(sp[0 * 33] * F8_MUL_W, sp[1 * 33] * F8_MUL_W, sp[2 * 33] * F8_MUL_W, sp[3 * 33] * F8_MUL_W);
        o.y = pk4_fp8(sp[4 * 33] * F8_MUL_W, sp[5 * 33] * F8_MUL_W, sp[6 * 33] * F8_MUL_W, sp[7 * 33] * F8_MUL_W);
        o.z = pk4_fp8(sp[8 * 33] * F8_MUL_W, sp[9 * 33] * F8_MUL_W, sp[10 * 33] * F8_MUL_W, sp[11 * 33] * F8_MUL_W);
        o.w = pk4_fp8(sp[12 * 33] * F8_MUL_W, sp[13 * 33] * F8_MUL_W, sp[14 * 33] * F8_MUL_W, sp[15 * 33] * F8_MUL_W);
        *(u32x4*)(WT + (size_t)dest_row(mode, roff, which, n0 + n) * ldk + k0 + 16 * c) = o; }
    asm volatile("s_waitcnt lgkmcnt(0)" ::: "memory");
}
__device__ __forceinline__ void ph_weights_(const Ctx& C, int l, int part, int first_wg, int nwg, unsigned* qhead = nullptr, int max_blocks = 1 << 30, bool pad = true) {
    LAS float* scr = (LAS float*)(C.lds + C.wave * 16384);
    const int gw = (C.bid - first_wg) * NWAVES + C.wave, NGW = nwg * NWAVES, lane = C.lane;
    unsigned char* ws = C.ws;
    const bool moe = (l & 1);
    const int l2 = l >> 1;
    constexpr int IT_IN = (D / 64) * (NIN / 32), IT_B = (256 / 64) * (D / 32), IT_G = (D / 64) * (D / 32), IT_O = IT_G;
    constexpr int IT_F1 = (D / 64) * (DFF / 32), IT_F2 = (DFF / 64) * (D / 32), IT_M1 = (D / 64) * (DFE / 32), IT_M2 = (DFE / 64) * (D / 32);
    const int n_fixed = IT_IN + 4 * IT_B + 4 * IT_G + IT_O;
    if (part == 1) {
        if (C.bid < first_wg) return;
        const int n1 = moe ? NEXP * IT_M2 : (2 * IT_F1 + IT_F2);
        int nb = 0;
        for (int it = qhead ? q_next(C, qhead) * NWAVES + C.wave : gw; qhead ? (it - C.wave < n1) : (it < n1); it = (qhead && ++nb >= max_blocks) ? n1 + C.wave : qhead ? q_next(C, qhead) * NWAVES + C.wave : it + NGW) {
            if (it >= n1) continue;
            int r = it;
            if (!moe) {
                if (r < IT_F1) { xpose_item8(C.in[I_FFN_W1] + (size_t)l2 * D * DFF, D, DFF, ws + WS_W13, 2, 0, 0, scr, r, lane); continue; } r -= IT_F1;
                if (r < IT_F1) { xpose_item8(C.in[I_FFN_W3] + (size_t)l2 * D * DFF, D, DFF, ws + WS_W13, 2, 0, 1, scr, r, lane); continue; } r -= IT_F1;
                xpose_item8(C.in[I_FFN_W2] + (size_t)l2 * DFF * D, DFF, D, ws + WS_W2D, 0, 0, 0, scr, r, lane);
            } else { const int e = r / IT_M2; r -= e * IT_M2;
                xpose_item8(C.in[I_MOE_W2] + ((size_t)l2 * NEXP + e) * DFE * D, DFE, D, ws + WS_W2M, 0, e * D, 0, scr, r, lane, DFE_PAD); }
        }
        if (moe && pad) {
            for (int i = (C.bid - first_wg) * NTHR + C.tid; i < NEXP * D * ((DFE_PAD - DFE) / 16); i += nwg * NTHR) { const int row = i >> 3, c16 = i & 7;
                unsigned z0; asm volatile("v_mov_b32 %0, 0" : "=v"(z0)); *(u32x4*)(ws + WS_W2M + (size_t)row * DFE_PAD + DFE + 16 * c16) = (u32x4){z0, z0, z0, z0}; } }
        return;
    }
    const int n_ffn = moe ? (NEXP * 2 * IT_M1) : 0;
    for (int it = gw; it < n_fixed + n_ffn; it += NGW) {
        int r = it;
        if (r < IT_IN) { xpose_item(C.in[I_W_IN] + (size_t)l * D * NIN, D, NIN, (bf16*)(ws + WS_WIN), 3, 0, 0, scr, r, lane, C.in[I_NORM_MIX] + (size_t)l * D); continue; } r -= IT_IN;
        if (r < 4 * IT_B) { const int i = r / IT_B; xpose_item(C.in[I_W_BRANCH] + ((size_t)l * 4 + i) * 256 * D, 256, D, (bf16*)(ws + WS_WB), 0, 1024 * i, 0, scr, r % IT_B, lane); continue; } r -= 4 * IT_B;
        if (r < 4 * IT_G) { const int i = r / IT_G; xpose_item8(C.in[I_W_GATE] + ((size_t)l * 4 + i) * D * D, D, D, ws + WS_WG, 1, i, 0, scr, r % IT_G, lane); continue; } r -= 4 * IT_G;
        if (r < IT_O) { xpose_item(C.in[I_W_OUT] + (size_t)l * D * D, D, D, (bf16*)(ws + WS_WOUT), 0, 0, 0, scr, r, lane); continue; } r -= IT_O;
        { const int per = 2 * IT_M1, e = r / per; r -= e * per;
          if (r < IT_M1) { xpose_item8(C.in[I_MOE_W1] + ((size_t)l2 * NEXP + e) * D * DFE, D, DFE, ws + WS_W13, 2, e * 2 * DFE, 0, scr, r, lane); continue; } r -= IT_M1;
          xpose_item8(C.in[I_MOE_W3] + ((size_t)l2 * NEXP + e) * D * DFE, D, DFE, ws + WS_W13, 2, e * 2 * DFE, 1, scr, r, lane); }
    }
    bf16* WL = (bf16*)(ws + WS_WLORA);
    const float* w2 = C.in[I_RW_W2] + (size_t)l * 64 * 256; const float* a2 = C.in[I_RW_A2] + (size_t)l * 64 * 256; const float* g2 = C.in[I_RW_G2] + (size_t)l * 128 * 256;
    for (int i = C.bid * NTHR + C.tid; i < 768 * 256; i += C.G * NTHR) {
        const int n = i >> 8, k = i & 255; float v = 0.f;
        if (n < 256) { if (k < 64) v = w2[k * 256 + n]; }
        else if (n < 512) { if (k >= 64 && k < 128) v = a2[(k - 64) * 256 + (n - 256)]; }
        else { if (k >= 128) v = g2[(k - 128) * 256 + (n - 512)]; }
        WL[i] = f2bf(v);
    }
}

__device__ __forceinline__ void ph_norm_(const Ctx& C, const float* gain, bool route, const float* router, int moe_idx, bool combine = false, const float* src = nullptr, bool want_bf16 = true, float* srow = nullptr) {
    const int gw = C.bid * NWAVES + C.wave, NGW = C.G * NWAVES, lane = C.lane;
    bf16* H = (bf16*)C.out; bf16* XB = (bf16*)(C.ws + WS_XB);
    f32x4 g[4];
#pragma unroll
    for (int j = 0; j < 4; ++j) g[j] = *(const f32x4*)(gain + 8 * lane + 512 * (j >> 1) + 4 * (j & 1));
    LAS unsigned* lcnt = (LAS unsigned*)(C.lds);
    if (route) { if (C.tid < 8) lcnt[C.tid] = 0u; __syncthreads(); }
    int* eidx = (int*)(C.ws + WS_EIDX); float* gate = (float*)(C.ws + WS_GATE);
    constexpr int NR = 4;
    for (int mb = gw; mb < T; mb += NR * NGW) {
        f32x4 vv[NR][4]; u32x4 ya[NR][2], yb[NR][2]; float g0v[NR], g1v[NR];
#pragma unroll
        for (int r = 0; r < NR; ++r) { const int m = mb + r * NGW; if (m < T) {
            if (src) { const f32x4* xr = (const f32x4*)(src + (size_t)m * D + 8 * lane);
#pragma unroll
                for (int j = 0; j < 4; ++j) vv[r][j] = __builtin_nontemporal_load(xr + 128 * (j >> 1) + (j & 1)); }
            else { const u32x4* xb = (const u32x4*)(XB + (size_t)m * D) + lane;
#pragma unroll
                for (int j = 0; j < 2; ++j) { const u32x4 t = srow ? xb[64 * j] : __builtin_nontemporal_load(xb + 64 * j); vv[r][2 * j] = f32x4{bflo(t.x), bfhi(t.x), bflo(t.y), bfhi(t.y)}; vv[r][2 * j + 1] = f32x4{bflo(t.z), bfhi(t.z), bflo(t.w), bfhi(t.w)}; } }
            if (combine) { const int* slotof = (const int*)(C.ws + WS_SLOTOF); const float* gt = (const float*)(C.ws + WS_GATE); const bf16* YS = (const bf16*)(C.ws + WS_YS);
                const int s0 = slotof[2 * m], s1 = slotof[2 * m + 1]; g0v[r] = gt[2 * m]; g1v[r] = gt[2 * m + 1];
                const u32x4* y0 = (const u32x4*)(YS + (size_t)s0 * D) + lane; const u32x4* y1 = (const u32x4*)(YS + (size_t)s1 * D) + lane;
#pragma unroll
                for (int j = 0; j < 2; ++j) { ya[r][j] = __builtin_nontemporal_load(y0 + 64 * j); yb[r][j] = __builtin_nontemporal_load(y1 + 64 * j); } } } }
#pragma unroll
        for (int r = 0; r < NR; ++r) { const int m = mb + r * NGW; if (m < T) {
        f32x4 v[4]; float s = 0.f;
#pragma unroll
        for (int j = 0; j < 4; ++j) v[j] = vv[r][j];
        if (combine) {
            const float g0 = g0v[r], g1 = g1v[r];
#pragma unroll
            for (int j = 0; j < 2; ++j) { const u32x4 a = ya[r][j], b = yb[r][j];
                v[2 * j].x += g0 * bflo(a.x) + g1 * bflo(b.x); v[2 * j].y += g0 * bfhi(a.x) + g1 * bfhi(b.x); v[2 * j].z += g0 * bflo(a.y) + g1 * bflo(b.y); v[2 * j].w += g0 * bfhi(a.y) + g1 * bfhi(b.y);
                v[2 * j + 1].x += g0 * bflo(a.z) + g1 * bflo(b.z); v[2 * j + 1].y += g0 * bfhi(a.z) + g1 * bfhi(b.z); v[2 * j + 1].z += g0 * bflo(a.w) + g1 * bflo(b.w); v[2 * j + 1].w += g0 * bfhi(a.w) + g1 * bfhi(b.w); }
        }
        if (combine || src) { u32x4* xo = (u32x4*)(XB + (size_t)m * D) + lane;
#pragma unroll
            for (int j = 0; j < 2; ++j) { u32x4 t; t.x = cvt_pk_bf16(v[2 * j].x, v[2 * j].y); t.y = cvt_pk_bf16(v[2 * j].z, v[2 * j].w); t.z = cvt_pk_bf16(v[2 * j + 1].x, v[2 * j + 1].y); t.w = cvt_pk_bf16(v[2 * j + 1].z, v[2 * j + 1].w); xo[64 * j] = t; } }
#pragma unroll
        for (int j = 0; j < 4; ++j) s += (v[j].x * v[j].x + v[j].y * v[j].y) + (v[j].z * v[j].z + v[j].w * v[j].w);
        const float rs = 1.0f / sqrtf(wave_sum(s, C.lane) * (1.f / D) + 1e-6f);
        if (srow && lane == 0) srow[m] = rs;
#pragma unroll
        for (int j = 0; j < 4; ++j) v[j] = v[j] * rs * g[j];
#pragma unroll
        for (int j = 0; j < 2; ++j) {
            if (want_bf16) { u32x4 t; t.x = cvt_pk_bf16(v[2 * j].x, v[2 * j].y); t.y = cvt_pk_bf16(v[2 * j].z, v[2 * j].w); t.z = cvt_pk_bf16(v[2 * j + 1].x, v[2 * j + 1].y); t.w = cvt_pk_bf16(v[2 * j + 1].z, v[2 * j + 1].w);
                ((u32x4*)(H + (size_t)m * D) + lane)[64 * j] = t; }
            u32x2 q; q.x = pk4_fp8(v[2 * j].x * F8_MUL_X, v[2 * j].y * F8_MUL_X, v[2 * j].z * F8_MUL_X, v[2 * j].w * F8_MUL_X); q.y = pk4_fp8(v[2 * j + 1].x * F8_MUL_X, v[2 * j + 1].y * F8_MUL_X, v[2 * j + 1].z * F8_MUL_X, v[2 * j + 1].w * F8_MUL_X);
            u32x2* hp = (u32x2*)(C.ws + WS_H8 + (size_t)m * D) + lane + 64 * j;
            if (srow) __builtin_nontemporal_store(q, hp); else *hp = q; }
        if (route) {
            float lg[8];
#pragma unroll
            for (int e = 0; e < 8; ++e) lg[e] = 0.f;
#pragma unroll
            for (int j = 0; j < 4; ++j)
#pragma unroll
                for (int q = 0; q < 4; ++q) { const int k = 8 * lane + 512 * (j >> 1) + 4 * (j & 1) + q; const f32x4 r0 = *(const f32x4*)(router + (size_t)k * 8), r1 = *(const f32x4*)(router + (size_t)k * 8 + 4); const float hv = v[j][q];
                    lg[0] += hv * r0.x; lg[1] += hv * r0.y; lg[2] += hv * r0.z; lg[3] += hv * r0.w; lg[4] += hv * r1.x; lg[5] += hv * r1.y; lg[6] += hv * r1.z; lg[7] += hv * r1.w; }
#pragma unroll
            for (int e = 0; e < 8; ++e) lg[e] = wave_sum(lg[e], C.lane);
            int e0 = 0; float b0 = lg[0];
#pragma unroll
            for (int e = 1; e < 8; ++e) if (lg[e] > b0) { b0 = lg[e]; e0 = e; }
            int e1 = -1; float b1 = -3.0e38f;
#pragma unroll
            for (int e = 0; e < 8; ++e) if (e != e0 && lg[e] > b1) { b1 = lg[e]; e1 = e; }
            const float p1 = __expf(b1 - b0), inv = 1.f / (1.f + p1);
            if (lane == 0) { eidx[2 * m] = e0; eidx[2 * m + 1] = e1; gate[2 * m] = inv; gate[2 * m + 1] = p1 * inv; atomicAdd((unsigned*)&lcnt[e0], 1u); atomicAdd((unsigned*)&lcnt[e1], 1u); }
        }
        } }
    }
    if (route) { __syncthreads(); if (C.tid < 8) { unsigned* cw = (unsigned*)(C.ws + WS_CTL) + CW_MOE + moe_idx * 64; atomicAdd(&cw[C.tid], lcnt[C.tid]); } }
}

__device__ __forceinline__ void ph_rw_prep_(const Ctx& C, int l) {
    const bf16* RW = (const bf16*)(C.ws + WS_RW); bf16* AL = (bf16*)(C.ws + WS_ALORA);
    const float* mu = C.in[I_RW_MU] + (size_t)l * 1024;
    const size_t gid = (size_t)C.bid * NTHR + C.tid, gsz = (size_t)C.G * NTHR;
    constexpr int NI = 4;
    for (size_t it0 = gid; it0 < (size_t)T * 32; it0 += NI * gsz) {
        u32x4 cuv[NI], pvv[NI]; f32x4 mu0[NI], mu1[NI];
#pragma unroll
        for (int r = 0; r < NI; ++r) { const size_t it = it0 + r * gsz; cuv[r] = (u32x4){0u, 0u, 0u, 0u}; pvv[r] = cuv[r]; mu0[r] = (f32x4){0.f, 0.f, 0.f, 0.f}; mu1[r] = mu0[r];
            if (it < (size_t)T * 32) { const int m = (int)(it >> 5), c8 = 768 + (int)(it & 31) * 8, t = m & (SEQ - 1);
                cuv[r] = *(const u32x4*)(RW + (size_t)m * 1024 + c8); if (t) pvv[r] = *(const u32x4*)(RW + (size_t)(m - 1) * 1024 + c8); mu0[r] = *(const f32x4*)(mu + c8); mu1[r] = *(const f32x4*)(mu + c8 + 4); } }
#pragma unroll
        for (int r = 0; r < NI; ++r) { const size_t it = it0 + r * gsz; if (it < (size_t)T * 32) {
        const int m = (int)(it >> 5), c8 = 768 + (int)(it & 31) * 8;
        float a[8], b[8]; unpack8(cuv[r], a); unpack8(pvv[r], b);
        const f32x4 m0 = mu0[r], m1 = mu1[r];
        const float mm[8] = {m0.x, m0.y, m0.z, m0.w, m1.x, m1.y, m1.z, m1.w};
#pragma unroll
        for (int e = 0; e < 8; ++e) a[e] = a[e] + (b[e] - a[e]) * mm[e];
        if (c8 < 832) {
#pragma unroll
            for (int e = 0; e < 8; ++e) a[e] = 1.f - 2.f * __builtin_amdgcn_rcpf(1.f + __builtin_amdgcn_exp2f(2.f * LOG2E * a[e]));
        } else if (c8 >= 896) {
#pragma unroll
            for (int e = 0; e < 8; ++e) a[e] = sigm(a[e]);
        }
        *(u32x4*)(AL + (size_t)m * 256 + (c8 - 768)) = pack8(a);
        } }
    }
}

__device__ __forceinline__ void ph_rw_lora_(const Ctx& C, int l) {
    const bf16* RW = (const bf16*)(C.ws + WS_RW); const bf16* WL = (const bf16*)(C.ws + WS_WLORA);
    float* WDEC = (float*)(C.ws + WS_WDEC); bf16* AP = (bf16*)(C.ws + WS_AP); bf16* GP = (bf16*)(C.ws + WS_GP);
    constexpr int LP = 264;
    LAS bf16* AT = (LAS bf16*)C.lds;
    const int tid = C.tid, lane = C.lane, j = lane & 31, hi = lane >> 5, w = C.wave, c8 = (tid & 31) * 8;
    const f32x4 mu0 = *(const f32x4*)(C.in[I_RW_MU] + (size_t)l * 1024 + 768 + c8), mu1 = *(const f32x4*)(C.in[I_RW_MU] + (size_t)l * 1024 + 768 + c8 + 4);
    const float mm[8] = {mu0.x, mu0.y, mu0.z, mu0.w, mu1.x, mu1.y, mu1.z, mu1.w};
    for (int u = C.bid; u < T / 64; u += C.G) { const int m0 = u * 64;
        u32x4 cuv[4], pvv[4];
#pragma unroll
        for (int k = 0; k < 4; ++k) { const int tok = (tid >> 5) + 16 * k; const size_t m = (size_t)(m0 + tok);
            cuv[k] = *(const u32x4*)(RW + m * 1024 + 768 + c8); pvv[k] = (u32x4){0u, 0u, 0u, 0u}; if ((m0 + tok) & (SEQ - 1)) pvv[k] = *(const u32x4*)(RW + (m - 1) * 1024 + 768 + c8); }
#pragma unroll
        for (int k = 0; k < 4; ++k) { const int tok = (tid >> 5) + 16 * k; float a[8], b[8]; unpack8(cuv[k], a); unpack8(pvv[k], b);
#pragma unroll
            for (int e = 0; e < 8; ++e) a[e] = a[e] + (b[e] - a[e]) * mm[e];
            if (c8 < 64) {
#pragma unroll
                for (int e = 0; e < 8; ++e) a[e] = 1.f - 2.f * __builtin_amdgcn_rcpf(1.f + __builtin_amdgcn_exp2f(2.f * LOG2E * a[e]));
            } else if (c8 >= 128) {
#pragma unroll
                for (int e = 0; e < 8; ++e) a[e] = sigm(a[e]);
            }
            *(LAS u32x4*)(AT + tok * LP + c8) = pack8(a); }
        bf16x8 bn[8];
#define LORA_LOADB(tj_) do { const int kb_ = (tj_) < 8 ? 0 : ((tj_) < 16 ? 64 : 128); const bf16* br_ = WL + (size_t)(32 * (tj_) + j) * 256 + kb_ + 8 * hi; _Pragma("unroll") for (int ks = 0; ks < 8; ++ks) bn[ks] = *(const bf16x8*)(br_ + 16 * ks); } while (0)
        LORA_LOADB(w * 3);
        __syncthreads();
#pragma unroll
        for (int q = 0; q < 3; ++q) { const int tj = w * 3 + q;
            const int kb = tj < 8 ? 0 : (tj < 16 ? 64 : 128);
            bf16x8 bfr[8];
#pragma unroll
            for (int ks = 0; ks < 8; ++ks) bfr[ks] = bn[ks];
            if (q < 2) LORA_LOADB(tj + 1);
#pragma unroll
            for (int ti = 0; ti < 2; ++ti) {
                const LAS bf16* ar = AT + (32 * ti + j) * LP + kb + 8 * hi;
                f32x16 acc;
#pragma unroll
                for (int i = 0; i < 16; ++i) acc[i] = 0.f;
#pragma unroll
                for (int ks = 0; ks < 4; ++ks) acc = __builtin_amdgcn_mfma_f32_32x32x16_bf16(*(const LAS bf16x8*)(ar + 16 * ks), bfr[ks], acc, 0, 0, 0);
                if (tj >= 16) {
#pragma unroll
                    for (int ks = 4; ks < 8; ++ks) acc = __builtin_amdgcn_mfma_f32_32x32x16_bf16(*(const LAS bf16x8*)(ar + 16 * ks), bfr[ks], acc, 0, 0, 0); }
                const size_t tb = (size_t)(m0 + 32 * ti + 4 * hi); const int n = 32 * (tj & 7) + j;
                if (tj < 8) { const float w0n = C.in[I_RW_W0][l * 256 + n];
#pragma unroll
                    for (int r = 0; r < 4; ++r)
#pragma unroll
                        for (int e = 0; e < 4; ++e) WDEC[(tb + 8 * r + e) * 256 + n] = __builtin_amdgcn_exp2f(-0.606531f * LOG2E * sigm(acc[4 * r + e] + w0n));
                } else if (tj < 16) { const float a0n = C.in[I_RW_A0][l * 256 + n];
#pragma unroll
                    for (int r = 0; r < 4; ++r)
#pragma unroll
                        for (int e = 0; e < 4; ++e) AP[(tb + 8 * r + e) * 256 + n] = f2bf(sigm(acc[4 * r + e] + a0n));
                } else {
#pragma unroll
                    for (int r = 0; r < 4; ++r)
#pragma unroll
                        for (int e = 0; e < 4; ++e) GP[(tb + 8 * r + e) * 256 + n] = f2bf(acc[4 * r + e]); } } }
#undef LORA_LOADB
        __syncthreads();
    }
}

__device__ __forceinline__ void ph_sb_prep_(const Ctx& C, int l) {
    bf16* SB = (bf16*)(C.ws + WS_SB);
    const int gw = C.bid * NWAVES + C.wave, NGW = C.G * NWAVES, lane = C.lane;
    const bool isk = lane >= 32; const int d0 = (lane & 7) * 8;
    const float* gn = (isk ? C.in[I_SB_KN] : C.in[I_SB_QN]) + (size_t)l * 64 + d0;
    float gg[8];
#pragma unroll
    for (int e = 0; e < 8; ++e) gg[e] = gn[e] * (isk ? 1.f : 0.125f * LOG2E);
    constexpr int NR = 4;
    for (int mb = gw; mb < T; mb += NR * NGW) {
        u32x4 uu[NR];
#pragma unroll
        for (int r = 0; r < NR; ++r) { const int m = mb + r * NGW; uu[r] = (u32x4){0u, 0u, 0u, 0u}; if (m < T) uu[r] = *(const u32x4*)(SB + (size_t)m * 768 + lane * 8); }
#pragma unroll
        for (int r = 0; r < NR; ++r) { const int m = mb + r * NGW; if (m < T) {
            bf16* p = SB + (size_t)m * 768 + lane * 8;
            float a[8]; unpack8(uu[r], a);
            float ss = 0.f;
#pragma unroll
            for (int e = 0; e < 8; ++e) ss += a[e] * a[e];
            ss += shx(ss, 1, lane); ss += shx(ss, 2, lane); ss += shx(ss, 4, lane);
            const float rs = 1.0f / sqrtf(ss * (1.f / 64.f) + 1e-6f);
#pragma unroll
            for (int e = 0; e < 8; ++e) a[e] = a[e] * rs * gg[e];
            *(u32x4*)p = pack8(a); } }
    }
}

__device__ __forceinline__ void ph_conv_(const Ctx& C, int l) {
    const bf16* CV = (const bf16*)(C.ws + WS_CV); bf16* Y = (bf16*)(C.ws + WS_Y);
    LAS float* U = (LAS float*)(C.lds); LAS float* OC = (LAS float*)(C.lds + 65536);
    const int tid = C.tid, c = tid & 255, half = tid >> 8;
    const float* dw = C.in[I_CONV_DW] + (size_t)l * 31 * 256; const float db = C.in[I_CONV_B][l * 256 + c];
    float dwr[31];
#pragma unroll
    for (int j = 0; j < 31; ++j) dwr[j] = dw[j * 256 + c];
    const float* lnw = C.in[I_CONV_LNW] + (size_t)l * 256; const float* lnb = C.in[I_CONV_LNB] + (size_t)l * 256;
    for (int u = C.bid; u < T / 32; u += C.G) {
        const int m0 = u * 32, t0 = m0 & (SEQ - 1);
        for (int it = tid; it < 62 * 32; it += NTHR) {
            const int r = it >> 5, c8 = (it & 31) * 8, tt = t0 - 30 + r; float a[8], b[8];
            if (tt >= 0) { const size_t mm = (size_t)(m0 - 30 + r); unpack8(*(const u32x4*)(CV + mm * 256 + c8), a); (void)b; }
            else {
#pragma unroll
                for (int e = 0; e < 8; ++e) a[e] = 0.f; }
#pragma unroll
            for (int e = 0; e < 8; ++e) U[r * 256 + c8 + e] = a[e];
        }
        __syncthreads();
        { float win[46];
#pragma unroll
          for (int i = 0; i < 46; ++i) win[i] = U[(half * 16 + i) * 256 + c];
#pragma unroll
          for (int tt = 0; tt < 16; ++tt) { float acc = db;
#pragma unroll
              for (int j = 0; j < 31; ++j) acc += dwr[j] * win[tt + j];
              OC[(half * 16 + tt) * 256 + c] = acc; } }
        __syncthreads();
#pragma unroll 1
        for (int q = 0; q < 4; ++q) { const int tl = C.wave * 4 + q; float v[4]; float s = 0.f;
#pragma unroll
            for (int i = 0; i < 4; ++i) { v[i] = OC[tl * 256 + C.lane + 64 * i]; s += v[i]; }
            const float mean = wave_sum(s, C.lane) * (1.f / 256.f); float s2 = 0.f;
#pragma unroll
            for (int i = 0; i < 4; ++i) { v[i] -= mean; s2 += v[i] * v[i]; }
            const float rstd = 1.0f / sqrtf(wave_sum(s2, C.lane) * (1.f / 256.f) + 1e-5f);
#pragma unroll
            for (int i = 0; i < 4; ++i) { const int cc = C.lane + 64 * i; const float y = v[i] * rstd * lnw[cc] + lnb[cc]; Y[(size_t)(m0 + tl) * 1024 + 768 + cc] = f2bf(y * sigm(y)); } }
        __syncthreads();
    }
}

__device__ __forceinline__ float ret_log2gamma(int h) { return log2f(1.0f - exp2f(-5.0f - (float)h)); }
__device__ __forceinline__ void ret_load_rot(const Ctx& C, const bf16* RET, int m0, int coff, float scale, LAS float* dst) {
    const int s = C.tid >> 3, d0 = (C.tid & 7) * 4;
    const float* cs = (const float*)(C.ws + WS_COS); const float* sn = (const float*)(C.ws + WS_SIN);
    const int pos = (m0 + s) & (SEQ - 1);
    const u32x2 a = *(const u32x2*)(RET + (size_t)(m0 + s) * 1024 + coff + d0), b = *(const u32x2*)(RET + (size_t)(m0 + s) * 1024 + coff + 32 + d0);
    const float x1[4] = {bflo(a.x), bfhi(a.x), bflo(a.y), bfhi(a.y)}, x2[4] = {bflo(b.x), bfhi(b.x), bflo(b.y), bfhi(b.y)};
    const f32x4 cv = *(const f32x4*)(cs + (size_t)pos * 32 + d0), sv = *(const f32x4*)(sn + (size_t)pos * 32 + d0);
#pragma unroll
    for (int e = 0; e < 4; ++e) { dst[s * 65 + d0 + e] = (x1[e] * cv[e] - x2[e] * sv[e]) * scale; dst[s * 65 + 32 + d0 + e] = (x1[e] * sv[e] + x2[e] * cv[e]) * scale; }
}
__device__ __forceinline__ void ph_ret_kv_(const Ctx& C) {
    const bf16* RET = (const bf16*)(C.ws + WS_RET); float* KV = (float*)(C.ws + WS_KV);
    LAS float* KD = (LAS float*)(C.lds); LAS float* VV = (LAS float*)(C.lds + 32768);
    const int tid = C.tid;
    for (int u = C.bid; u < 2048; u += C.G) {
        const int bh = u >> 8, ch = u & 255, b = bh >> 2, h = bh & 3, m0 = b * SEQ + ch * 64;
        const float lg = ret_log2gamma(h);
        ret_load_rot(C, RET, m0, 256 + h * 64, 0.125f, KD);
        { const int s = tid >> 3, e0 = (tid & 7) * 8; float a[8]; unpack8(*(const u32x4*)(RET + (size_t)(m0 + s) * 1024 + 512 + h * 64 + e0), a);
          const float dec = exp2f(lg * (float)(63 - s));
#pragma unroll
          for (int e = 0; e < 8; ++e) VV[s * 64 + e0 + e] = a[e] * dec; }
        __syncthreads();
        const int d = tid >> 3, e0 = (tid & 7) * 8; float acc[8];
#pragma unroll
        for (int e = 0; e < 8; ++e) acc[e] = 0.f;
#pragma unroll 4
        for (int s = 0; s < 64; ++s) { const float kd = KD[s * 65 + d]; const f32x4 v0 = *(const LAS f32x4*)(VV + s * 64 + e0), v1 = *(const LAS f32x4*)(VV + s * 64 + e0 + 4);
            acc[0] += kd * v0.x; acc[1] += kd * v0.y; acc[2] += kd * v0.z; acc[3] += kd * v0.w; acc[4] += kd * v1.x; acc[5] += kd * v1.y; acc[6] += kd * v1.z; acc[7] += kd * v1.w; }
        float* o = KV + (size_t)u * 4096 + d * 64 + e0;
        *(f32x4*)o = (f32x4){acc[0], acc[1], acc[2], acc[3]}; *(f32x4*)(o + 4) = (f32x4){acc[4], acc[5], acc[6], acc[7]};
        __syncthreads();
    }
}
__device__ __forceinline__ void ph_ret_scan_(const Ctx& C, int wg0, int nw) {
    float* KV = (float*)(C.ws + WS_KV);
    for (int i = (C.bid - wg0) * NTHR + C.tid; i < 8 * 4096 && C.bid >= wg0 && C.bid < wg0 + nw; i += nw * NTHR) {
        const int bh = i >> 12, el = i & 4095, h = bh & 3;
        const float cd = exp2f(ret_log2gamma(h) * 64.f);
        float* p = KV + (size_t)bh * 256 * 4096 + el; float S = 0.f;
#pragma unroll 1
        for (int c = 0; c < 256; c += 32) { float kv[32];
#pragma unroll
            for (int q = 0; q < 32; ++q) kv[q] = p[(size_t)(c + q) * 4096];
#pragma unroll
            for (int q = 0; q < 32; ++q) { p[(size_t)(c + q) * 4096] = S; S = S * cd + kv[q]; } }
    }
}
__device__ __forceinline__ void ph_ret_out_(const Ctx& C, int l, int first_wg, int nwg) {
    const bf16* RET = (const bf16*)(C.ws + WS_RET); const float* KV = (const float*)(C.ws + WS_KV); bf16* Y = (bf16*)(C.ws + WS_Y);
    LAS float* Q = (LAS float*)(C.lds); LAS float* Kk = (LAS float*)(C.lds + 16640); LAS float* VV = (LAS float*)(C.lds + 33280); LAS float* SS = (LAS float*)(C.lds + 49664); LAS float* SC = (LAS float*)(C.lds + 66048);
    const int tid = C.tid; const float* gn = C.in[I_RET_GN] + (size_t)l * 256;
    for (int u = C.bid - first_wg; u < 2048; u += nwg) {
        const int bh = u >> 8, ch = u & 255, b = bh >> 2, h = bh & 3, m0 = b * SEQ + ch * 64;
        const float lg = ret_log2gamma(h);
        ret_load_rot(C, RET, m0, h * 64, 1.0f, Q);
        ret_load_rot(C, RET, m0, 256 + h * 64, 0.125f, Kk);
        { const int s = tid >> 3, e0 = (tid & 7) * 8; float a[8]; unpack8(*(const u32x4*)(RET + (size_t)(m0 + s) * 1024 + 512 + h * 64 + e0), a);
#pragma unroll
          for (int e = 0; e < 8; ++e) VV[s * 64 + e0 + e] = a[e];
          const float* sp = KV + (size_t)u * 4096 + s * 64 + e0; const f32x4 s0 = *(const f32x4*)sp, s1 = *(const f32x4*)(sp + 4);
          *(LAS f32x4*)(SS + s * 64 + e0) = s0; *(LAS f32x4*)(SS + s * 64 + e0 + 4) = s1; }
        __syncthreads();
        const int t = tid >> 3, g8 = tid & 7;
        { float sc[8];
#pragma unroll
          for (int i = 0; i < 8; ++i) sc[i] = 0.f;
#pragma unroll 4
          for (int d = 0; d < 64; ++d) { const float qv = Q[t * 65 + d];
#pragma unroll
              for (int i = 0; i < 8; ++i) sc[i] += qv * Kk[(g8 * 8 + i) * 65 + d]; }
#pragma unroll
          for (int i = 0; i < 8; ++i) { const int s = g8 * 8 + i; SC[t * 65 + s] = (s <= t) ? sc[i] * exp2f(lg * (float)(t - s)) : 0.f; } }
        __syncthreads();
        { const int e0 = g8 * 8; float o[8], o2[8];
#pragma unroll
          for (int e = 0; e < 8; ++e) { o[e] = 0.f; o2[e] = 0.f; }
#pragma unroll 4
          for (int s = 0; s < 64; ++s) { const float p = SC[t * 65 + s]; const f32x4 v0 = *(const LAS f32x4*)(VV + s * 64 + e0), v1 = *(const LAS f32x4*)(VV + s * 64 + e0 + 4);
              o[0] += p * v0.x; o[1] += p * v0.y; o[2] += p * v0.z; o[3] += p * v0.w; o[4] += p * v1.x; o[5] += p * v1.y; o[6] += p * v1.z; o[7] += p * v1.w; }
#pragma unroll 4
          for (int d = 0; d < 64; ++d) { const float qv = Q[t * 65 + d]; const f32x4 v0 = *(const LAS f32x4*)(SS + d * 64 + e0), v1 = *(const LAS f32x4*)(SS + d * 64 + e0 + 4);
              o2[0] += qv * v0.x; o2[1] += qv * v0.y; o2[2] += qv * v0.z; o2[3] += qv * v0.w; o2[4] += qv * v1.x; o2[5] += qv * v1.y; o2[6] += qv * v1.z; o2[7] += qv * v1.w; }
          const float qd = exp2f(lg * (float)(t + 1)); float s1 = 0.f;
#pragma unroll
          for (int e = 0; e < 8; ++e) { o[e] += qd * o2[e]; s1 += o[e]; }
          s1 += shx(s1, 1, C.lane); s1 += shx(s1, 2, C.lane); s1 += shx(s1, 4, C.lane);
          const float mean = s1 * (1.f / 64.f); float s2 = 0.f;
#pragma unroll
          for (int e = 0; e < 8; ++e) { o[e] -= mean; s2 += o[e] * o[e]; }
          s2 += shx(s2, 1, C.lane); s2 += shx(s2, 2, C.lane); s2 += shx(s2, 4, C.lane);
          const float rstd = 1.0f / sqrtf(s2 * (1.f / 64.f) + 1e-5f);
          float gtv[8]; unpack8(*(const u32x4*)(RET + (size_t)(m0 + t) * 1024 + 768 + h * 64 + e0), gtv);
#pragma unroll
          for (int e = 0; e < 8; ++e) o[e] = o[e] * rstd * gn[h * 64 + e0 + e] * (gtv[e] * sigm(gtv[e]));
          *(u32x4*)(Y + (size_t)(m0 + t) * 1024 + 512 + h * 64 + e0) = pack8(o); }
        __syncthreads();
    }
}

constexpr int RWC = 64, RW_NCH = SEQ / RWC, RW_NU = 8 * RW_NCH;
constexpr int RW_SUP = 8, RW_NSC = RW_NCH / RW_SUP, RW_NSUP = 8 * RW_NSC;
__device__ __forceinline__ void ph_rw_local_(const Ctx& C, int l) {
    const bf16* RKVS = (const bf16*)(C.ws + WS_RKVS); const float* WDEC = (const float*)(C.ws + WS_WDEC); const bf16* AG = (const bf16*)(C.ws + WS_AG);
    bf16* Y0 = (bf16*)(C.ws + WS_Y0); bf16* RH = (bf16*)(C.ws + WS_RHAT); float* PQ = (float*)(C.ws + WS_PQ); float* BON = (float*)(C.ws + WS_BON);
    const int lane = C.lane;
    LAS float* base = (LAS float*)(C.lds + C.wave * 12288);
    for (int it = C.bid; it < RW_NU / 8; it += C.G) {
        const int u = it * 8 + C.wave, bh = u >> 8, ch = u & 255, b = bh >> 2, h = bh & 3, m0 = b * SEQ + ch * RWC, hc = h * 64 + lane;
        const float mur = C.in[I_RW_MU][l * 1024 + hc], muk = C.in[I_RW_MU][l * 1024 + 256 + hc], muv = C.in[I_RW_MU][l * 1024 + 512 + hc];
        const float kkw = C.in[I_RW_KK][l * 256 + hc], kaw = C.in[I_RW_KA][l * 256 + hc], rkw = C.in[I_RW_RK][l * 256 + hc], w0l = C.in[I_RW_W0][l * 256 + hc], a0l = C.in[I_RW_A0][l * 256 + hc];
        f32x2 sL[32], sI[32];
        { int ln = lane; asm volatile("" : "+v"(ln));
#pragma unroll
          for (int k = 0; k < 32; ++k) { sL[k] = (f32x2){0.f, 0.f}; sI[k].x = (2 * k == ln) ? 1.f : 0.f; sI[k].y = (2 * k + 1 == ln) ? 1.f : 0.f; } }
#pragma unroll 1
        for (int sb = 0; sb < RWC / 8; ++sb) {
            asm volatile("" ::: "memory");
#pragma unroll
            for (int i = 0; i < 8; ++i) { const size_t m = (size_t)(m0 + sb * 8 + i);
                const float r = bf2f(RKVS[m * 768 + hc]), k = bf2f(RKVS[m * 768 + 256 + hc]), v = bf2f(RKVS[m * 768 + 512 + hc]);
                const float w = __builtin_amdgcn_exp2f(-0.606531f * LOG2E * sigm(WDEC[m * 256 + hc] + w0l)), a = sigm(bf2f(AG[m * 512 + hc]) + a0l);
                const float kr = k * kkw; const float nn = sqrtf(wave_sum(kr * kr, C.lane)); const float kk = kr / fmaxf(nn, 1e-12f);
                const float kp = k * (1.f + (a - 1.f) * kaw);
                const float bon = wave_sum(r * kp * rkw, C.lane);
                if (lane == 0) BON[m * 4 + h] = bon;
                base[0 * 512 + i * 64 + lane] = w; base[1 * 512 + i * 64 + lane] = kk; base[2 * 512 + i * 64 + lane] = kk * a; base[3 * 512 + i * 64 + lane] = kp; base[4 * 512 + i * 64 + lane] = r; base[5 * 512 + i * 64 + lane] = v; }
            asm volatile("" ::: "memory");
#pragma unroll 1
            for (int i = 0; i < 8; ++i) {
                const LAS f32x4* wv = (const LAS f32x4*)(base + 0 * 512 + i * 64); const LAS f32x4* kkv = (const LAS f32x4*)(base + 1 * 512 + i * 64); const LAS f32x4* kav = (const LAS f32x4*)(base + 2 * 512 + i * 64);
                const LAS f32x4* kpv = (const LAS f32x4*)(base + 3 * 512 + i * 64); const LAS f32x4* rv = (const LAS f32x4*)(base + 4 * 512 + i * 64);
                const float vv = base[5 * 512 + i * 64 + lane];
                f32x4 kq[2][4];
#pragma unroll
                for (int t = 0; t < 4; ++t) kq[0][t] = kkv[t];
                f32x2 dL0 = (f32x2){0.f, 0.f}, dL1 = dL0, dI0 = dL0, dI1 = dL0;
                f32x4 ga[2][4];
#pragma unroll
                for (int g = 0; g < 4; ++g) {
                    __builtin_amdgcn_sched_barrier(0);
                    if (g + 1 < 4) {
#pragma unroll
                        for (int t = 0; t < 4; ++t) kq[(g + 1) & 1][t] = kkv[4 * (g + 1) + t]; }
                    else { ga[0][0] = wv[0]; ga[0][1] = kav[0]; ga[0][2] = kpv[0]; ga[0][3] = rv[0]; }
                    __builtin_amdgcn_sched_barrier(0);
#pragma unroll
                    for (int t = 0; t < 4; ++t) { const int k4 = 4 * g + t; const f32x4 q4 = kq[g & 1][t];
                        dL0 += sL[2 * k4] * q4.xy; dL1 += sL[2 * k4 + 1] * q4.zw; dI0 += sI[2 * k4] * q4.xy; dI1 += sI[2 * k4 + 1] * q4.zw; }
                }
                const float saL = -((dL0.x + dL0.y) + (dL1.x + dL1.y)), saI = -((dI0.x + dI0.y) + (dI1.x + dI1.y));
                const f32x2 saLv = (f32x2){saL, saL}, saIv = (f32x2){saI, saI}, vvv = (f32x2){vv, vv};
                f32x2 yL0 = (f32x2){0.f, 0.f}, yL1 = yL0, yI0 = yL0, yI1 = yL0;
#pragma unroll
                for (int k4 = 0; k4 < 16; ++k4) {
                    __builtin_amdgcn_sched_barrier(0);
                    if (k4 + 1 < 16) { ga[(k4 + 1) & 1][0] = wv[k4 + 1]; ga[(k4 + 1) & 1][1] = kav[k4 + 1]; ga[(k4 + 1) & 1][2] = kpv[k4 + 1]; ga[(k4 + 1) & 1][3] = rv[k4 + 1]; }
                    __builtin_amdgcn_sched_barrier(0);
                    const f32x4 wq = ga[k4 & 1][0], aq = ga[k4 & 1][1], pq = ga[k4 & 1][2], rq = ga[k4 & 1][3];
                    sL[2 * k4]     = sL[2 * k4]     * wq.xy + saLv * aq.xy + vvv * pq.xy; yL0 += sL[2 * k4]     * rq.xy;
                    sL[2 * k4 + 1] = sL[2 * k4 + 1] * wq.zw + saLv * aq.zw + vvv * pq.zw; yL1 += sL[2 * k4 + 1] * rq.zw;
                    sI[2 * k4]     = sI[2 * k4]     * wq.xy + saIv * aq.xy;                  yI0 += sI[2 * k4]     * rq.xy;
                    sI[2 * k4 + 1] = sI[2 * k4 + 1] * wq.zw + saIv * aq.zw;                  yI1 += sI[2 * k4 + 1] * rq.zw;
                }
                __builtin_amdgcn_sched_barrier(0);
                const size_t m = (size_t)(m0 + sb * 8 + i);
                Y0[m * 256 + hc] = f2bf((yL0.x + yL0.y) + (yL1.x + yL1.y));
                RH[m * 256 + hc] = f2bf((yI0.x + yI0.y) + (yI1.x + yI1.y));
            }
        }
        float* oq = PQ + (size_t)u * 4096 + lane * 64; float* opt = PQ + ((size_t)RW_NU + u) * 4096 + lane;
#pragma unroll
        for (int k4 = 0; k4 < 16; ++k4) { *(f32x4*)(oq + 4 * k4) = (f32x4){sL[2 * k4].x, sL[2 * k4].y, sL[2 * k4 + 1].x, sL[2 * k4 + 1].y};
            opt[(4 * k4) * 64] = sI[2 * k4].x; opt[(4 * k4 + 1) * 64] = sI[2 * k4].y; opt[(4 * k4 + 2) * 64] = sI[2 * k4 + 1].x; opt[(4 * k4 + 3) * 64] = sI[2 * k4 + 1].y; }
    }
}
constexpr int WY_LT = 24;
constexpr int WY_ROWM = 0, WY_COLM = 36864, WY_AMAT = 73728, WY_AABF = 89088, WY_SB = 93184, WY_WT = 111616, WY_UT = 117760, WY_GH = 123904, WY_GC = 125952;
__device__ __forceinline__ f32x4 wy_mm16(const LAS bf16* X, const LAS bf16* Y, f32x4 acc, int li, int lq) {
#pragma unroll
    for (int ks = 0; ks < 2; ++ks) { const bf16x8 a = *(const LAS bf16x8*)(X + li * MM_LP + 32 * ks + 8 * lq), b = *(const LAS bf16x8*)(Y + li * MM_LP + 32 * ks + 8 * lq);
        acc = __builtin_amdgcn_mfma_f32_16x16x32_bf16(a, b, acc, 0, 0, 0); }
    return acc;
}
__device__ __forceinline__ f32x4 wy_mm16k16(const LAS bf16* X, const LAS bf16* Y, f32x4 acc, int li, int lq) {
    const s16x4 a = *(const LAS s16x4*)(X + li * WY_LT + 4 * lq), b = *(const LAS s16x4*)(Y + li * WY_LT + 4 * lq);
    return __builtin_amdgcn_mfma_f32_16x16x16bf16_1k(a, b, acc, 0, 0, 0);
}
__device__ __forceinline__ void ph_rw_local_wy_(const Ctx& C, int l) {
    const bf16* RWp = (const bf16*)(C.ws + WS_RW); const float* WDEC = (const float*)(C.ws + WS_WDEC); const bf16* AG = (const bf16*)(C.ws + WS_AP);
    bf16* Y0 = (bf16*)(C.ws + WS_Y0); bf16* RH = (bf16*)(C.ws + WS_RHAT); float* PQ = (float*)(C.ws + WS_PQ); float* BON = (float*)(C.ws + WS_BON);
    const int lane = C.lane, w = C.wave, li = lane & 15, lq = lane >> 4, j32 = lane & 31, hi = lane >> 5, ti = w >> 1, tj = w & 1, sq = w >> 1, half = w & 1;
    LAS unsigned char* L = C.lds;
#define WY_ROW(q, m) ((LAS bf16*)(L + WY_ROWM + (q) * 9216 + (m) * 2304))
#define WY_COL(q, m) ((LAS bf16*)(L + WY_COLM + (q) * 9216 + (m) * 3072))
#define WY_A(q, id)  ((LAS bf16*)(L + WY_AMAT + (q) * 3840 + (id) * 768))
    LAS bf16* SB = (LAS bf16*)(L + WY_SB); LAS bf16* WT = (LAS bf16*)(L + WY_WT); LAS bf16* UT = (LAS bf16*)(L + WY_UT);
    LAS float* GH = (LAS float*)(L + WY_GH); LAS float* GCs = (LAS float*)(L + WY_GC);
    for (int su = C.bid; su < RW_NSUP; su += C.G) {
    f32x16 S;
    bf16 r16[9], k16[9], v16[9], a16[8]; float wd[8];
#define WY_RAW(uu) do { const int u_ = (uu), bh_ = u_ >> 8, ch_ = u_ & 255; const size_t mb_ = (size_t)((bh_ >> 2) * SEQ + ch_ * RWC + 8 * w); const int hc_ = (bh_ & 3) * 64 + lane; \
        r16[0] = 0; k16[0] = 0; v16[0] = 0; if (ch_ * RWC + 8 * w > 0) { r16[0] = RWp[(mb_ - 1) * 1024 + hc_]; k16[0] = RWp[(mb_ - 1) * 1024 + 256 + hc_]; v16[0] = RWp[(mb_ - 1) * 1024 + 512 + hc_]; } \
        _Pragma("unroll") for (int i = 0; i < 8; ++i) { const size_t m = mb_ + i; \
        r16[i + 1] = RWp[m * 1024 + hc_]; k16[i + 1] = RWp[m * 1024 + 256 + hc_]; v16[i + 1] = RWp[m * 1024 + 512 + hc_]; wd[i] = WDEC[m * 256 + hc_]; a16[i] = AG[m * 256 + hc_]; } } while (0)
    WY_RAW(su * RW_SUP);
#pragma unroll 1
    for (int cc = 0; cc < RW_SUP; ++cc) {
        const int u = su * RW_SUP + cc;
        const int bh = u >> 8, ch = u & 255, b = bh >> 2, h = bh & 3, m0 = b * SEQ + ch * RWC, hc = h * 64 + lane;
        const float mur = C.in[I_RW_MU][l * 1024 + hc], muk = C.in[I_RW_MU][l * 1024 + 256 + hc], muv = C.in[I_RW_MU][l * 1024 + 512 + hc];
        const float kkw = C.in[I_RW_KK][l * 256 + hc], kaw = C.in[I_RW_KA][l * 256 + hc], rkw = C.in[I_RW_RK][l * 256 + hc], w0l = C.in[I_RW_W0][l * 256 + hc], a0l = C.in[I_RW_A0][l * 256 + hc];
        { float wv[8], kk[8], ka[8], kp[8], rr[8], vv[8];
          float bon8[8], rf[8], kf[8], af[8], wf[8];
#pragma unroll
          for (int i = 0; i < 8; ++i) { const float rc = bf2f(r16[i + 1]), kc = bf2f(k16[i + 1]), vc = bf2f(v16[i + 1]);
              rf[i] = rc + (bf2f(r16[i]) - rc) * mur; kf[i] = kc + (bf2f(k16[i]) - kc) * muk; vv[i] = vc + (bf2f(v16[i]) - vc) * muv; af[i] = bf2f(a16[i]); wf[i] = wd[i]; }
          if (cc + 1 < RW_SUP) WY_RAW(u + 1);
#pragma unroll
          for (int i = 0; i < 8; ++i) {
              const float r = rf[i], k = kf[i];
              wv[i] = wf[i]; const float a = af[i];
              const float kr = k * kkw; kk[i] = kr * __builtin_amdgcn_rsqf(fmaxf(wave_sum(kr * kr, lane), 1e-24f));
              kp[i] = k * (1.f + (a - 1.f) * kaw); ka[i] = kk[i] * a; rr[i] = r;
              bon8[i] = wave_sum(r * kp[i] * rkw, lane); }
          if (lane == 0) {
#pragma unroll
              for (int i = 0; i < 8; ++i) BON[(size_t)(m0 + 8 * w + i) * 4 + h] = bon8[i]; }
          float cp[8]; cp[0] = wv[0];
#pragma unroll
          for (int i = 1; i < 8; ++i) cp[i] = cp[i - 1] * wv[i];
          GH[w * 64 + lane] = cp[7];
          __syncthreads();
          const float pre = half ? GH[(w - 1) * 64 + lane] : 1.f, gC = half ? pre * cp[7] : cp[7] * GH[(w + 1) * 64 + lane];
          if (!half) GCs[sq * 64 + lane] = gC;
          float c0[8], c1[8];
#pragma unroll
          for (int i = 0; i < 8; ++i) { const int t = 8 * half + i; const float G = pre * cp[i], Gm1 = (i == 0) ? pre : pre * cp[i - 1], rG = __builtin_amdgcn_rcpf(G);
              WY_ROW(sq, 0)[t * MM_LP + lane] = f2bf(-kk[i] * Gm1); WY_ROW(sq, 1)[t * MM_LP + lane] = f2bf(ka[i] * rG); WY_ROW(sq, 2)[t * MM_LP + lane] = f2bf(kp[i] * rG); WY_ROW(sq, 3)[t * MM_LP + lane] = f2bf(rr[i] * G);
              c0[i] = ka[i] * rG * gC; c1[i] = kp[i] * rG * gC; }
          *(LAS u32x4*)(WY_COL(sq, 0) + lane * WY_LT + 8 * half) = pack8(c0); *(LAS u32x4*)(WY_COL(sq, 1) + lane * WY_LT + 8 * half) = pack8(c1); *(LAS u32x4*)(WY_COL(sq, 2) + lane * WY_LT + 8 * half) = pack8(vv); }
        __syncthreads();
#pragma unroll
        for (int pp = 0; pp < 2; ++pp) { const int id = 2 * half + pp;
            f32x4 acc = (f32x4){0.f, 0.f, 0.f, 0.f};
            acc = wy_mm16(WY_ROW(sq, half ? 3 : 0), WY_ROW(sq, pp ? 2 : 1), acc, li, lq);
#pragma unroll
            for (int r = 0; r < 4; ++r) { const int t = 4 * lq + r; const bool keep = half ? (li <= t) : (li < t); const float val = keep ? acc[r] : 0.f;
                WY_A(sq, id)[t * WY_LT + li] = f2bf(val); if (id == 0) ((LAS float*)(L + WY_AABF + sq * 1024))[t * 16 + li] = val; } }
        __syncthreads();
        if (w < 4) { const LAS float* Af = (const LAS float*)(L + WY_AABF + w * 1024); float Tc[16];
#pragma unroll
            for (int t = 0; t < 16; ++t) { float acc = (t == li) ? 1.f : 0.f;
#pragma unroll
                for (int s4 = 0; s4 < 4; ++s4) { if (4 * s4 < t) { const f32x4 a4 = *(const LAS f32x4*)(Af + t * 16 + 4 * s4);
                    if (4 * s4 + 0 < t) acc += a4.x * Tc[4 * s4 + 0]; if (4 * s4 + 1 < t) acc += a4.y * Tc[4 * s4 + 1]; if (4 * s4 + 2 < t) acc += a4.z * Tc[4 * s4 + 2]; if (4 * s4 + 3 < t) acc += a4.w * Tc[4 * s4 + 3]; } }
                Tc[t] = acc; WY_A(w, 4)[t * WY_LT + li] = f2bf(acc); } }
        if (cc == 0) {
#pragma unroll
            for (int r = 0; r < 4; ++r)
#pragma unroll
                for (int e = 0; e < 4; ++e) { const int row = 32 * ti + 8 * r + 4 * hi + e, col = 32 * tj + j32; S[4 * r + e] = (ti >= 2 && row - 64 == col) ? 1.f : 0.f; }
#pragma unroll
            for (int r = 0; r < 4; ++r)
#pragma unroll
                for (int e = 0; e < 4; ++e) SB[(32 * ti + 8 * r + 4 * hi + e) * MM_LP + 32 * tj + j32] = f2bf(S[4 * r + e]);
        }
        __syncthreads();
#pragma unroll 1
        for (int q = 0; q < 4; ++q) {
            f32x4 accW = (f32x4){0.f, 0.f, 0.f, 0.f}, accY = accW;
            accW = wy_mm16(WY_ROW(q, 0), SB + 16 * w * MM_LP, accW, li, lq);
            accY = wy_mm16(WY_ROW(q, 3), SB + 16 * w * MM_LP, accY, li, lq);
            if (w < 4) accW = wy_mm16k16(WY_A(q, 1), WY_COL(q, 2) + 16 * w * WY_LT, accW, li, lq);
            { u32x2 pk; pk.x = cvt_pk_bf16(accW[0], accW[1]); pk.y = cvt_pk_bf16(accW[2], accW[3]); *(LAS u32x2*)(WT + (16 * w + li) * WY_LT + 4 * lq) = pk; }
            asm volatile("s_waitcnt lgkmcnt(0)" ::: "memory");
            { f32x4 accU = (f32x4){0.f, 0.f, 0.f, 0.f}; accU = wy_mm16k16(WY_A(q, 4), WT + 16 * w * WY_LT, accU, li, lq);
              u32x2 pk; pk.x = cvt_pk_bf16(accU[0], accU[1]); pk.y = cvt_pk_bf16(accU[2], accU[3]); *(LAS u32x2*)(UT + (16 * w + li) * WY_LT + 4 * lq) = pk; }
            asm volatile("s_waitcnt lgkmcnt(0)" ::: "memory");
            accY = wy_mm16k16(WY_A(q, 2), UT + 16 * w * WY_LT, accY, li, lq);
            if (w < 4) accY = wy_mm16k16(WY_A(q, 3), WY_COL(q, 2) + 16 * w * WY_LT, accY, li, lq);
            { bf16* dst = (w < 4) ? Y0 : RH; const int colo = h * 64 + ((16 * w) & 63) + li;
#pragma unroll
              for (int r = 0; r < 4; ++r) dst[(size_t)(m0 + 16 * q + 4 * lq + r) * 256 + colo] = f2bf(accY[r]); }
            __syncthreads();
            { const float gc = GCs[q * 64 + 32 * tj + j32];
#pragma unroll
              for (int i = 0; i < 16; ++i) S[i] *= gc;
              const bf16x8 ua = *(const LAS bf16x8*)(UT + (32 * ti + j32) * WY_LT + 8 * hi), bb = *(const LAS bf16x8*)(WY_COL(q, 0) + (32 * tj + j32) * WY_LT + 8 * hi);
              S = __builtin_amdgcn_mfma_f32_32x32x16_bf16(ua, bb, S, 0, 0, 0);
              if (ti < 2) { const bf16x8 va = *(const LAS bf16x8*)(WY_COL(q, 2) + (32 * ti + j32) * WY_LT + 8 * hi), kb = *(const LAS bf16x8*)(WY_COL(q, 1) + (32 * tj + j32) * WY_LT + 8 * hi);
                  S = __builtin_amdgcn_mfma_f32_32x32x16_bf16(va, kb, S, 0, 0, 0); } }
            {
#pragma unroll
                for (int r = 0; r < 4; ++r)
#pragma unroll
                    for (int e = 0; e < 4; ++e) SB[(32 * ti + 8 * r + 4 * hi + e) * MM_LP + 32 * tj + j32] = f2bf(S[4 * r + e]);
                __syncthreads(); }
        }
        if (cc == RW_SUP - 1) {
        if (ti < 2) { float* o = PQ + (size_t)su * 4096 + (size_t)(32 * ti + 4 * hi) * 64 + 32 * tj + j32;
#pragma unroll
            for (int r = 0; r < 4; ++r)
#pragma unroll
                for (int e = 0; e < 4; ++e) o[(8 * r + e) * 64] = S[4 * r + e]; }
        else { float* o = PQ + ((size_t)RW_NSUP + su) * 4096 + (size_t)(32 * tj + j32) * 64 + 32 * (ti - 2) + 4 * hi;
#pragma unroll
            for (int r = 0; r < 4; ++r) *(f32x4*)(o + 8 * r) = (f32x4){S[4 * r], S[4 * r + 1], S[4 * r + 2], S[4 * r + 3]}; }
        }
        __syncthreads();
    }
    }
#undef WY_ROW
#undef WY_COL
#undef WY_A
#undef WY_RAW
}
__device__ __forceinline__ void ph_rw_scan_(const Ctx& C, int wg) {
    const float* Qg = (const float*)(C.ws + WS_PQ); const float* Pg = Qg + (size_t)RW_NSUP * 4096; float* SST = (float*)(C.ws + WS_SST);
    LAS bf16* PT = (LAS bf16*)(C.lds);
    LAS bf16* SLb = PT + 2 * 64 * MM_LP;
    LAS float* QL = (LAS float*)(C.lds + (2 * 64 * MM_LP + 2 * 16 * MM_LP) * 2);
    LAS float* SO = QL + 2 * 16 * 64;
    const int lane = C.lane, wave = C.wave, bh = wg >> 2, rq = wg & 3, ct = wave & 3, li = lane & 15, lq = lane >> 4;
    const bool mm = wave < 4;
    const size_t ubase = (size_t)bh * RW_NSC;
    const int lt = C.tid & 255;
    const int qrow = lt >> 4, qc4 = (lt & 15) * 4;
    constexpr int PD = 6;
    f32x4 pr[PD][4], qr[PD];
#define SC_P_PIECE(i) (lt + 256 * (i))
#define SC_PUT_P(buf, sx_) do { LAS bf16* d_ = PT + (buf) * (64 * MM_LP); _Pragma("unroll") for (int i_ = 0; i_ < 4; ++i_) { const int idx_ = SC_P_PIECE(i_), r_ = (idx_ * 4) >> 6, k_ = (idx_ * 4) & 63; u32x2 w_; \
        w_.x = cvt_pk_bf16(pr[sx_][i_].x, pr[sx_][i_].y); w_.y = cvt_pk_bf16(pr[sx_][i_].z, pr[sx_][i_].w); *(LAS u32x2*)(d_ + r_ * MM_LP + k_) = w_; } } while (0)
#define SC_LOAD(sx_, cc) do { const f32x4* p4_ = (const f32x4*)(Pg + (ubase + (cc)) * 4096); _Pragma("unroll") for (int i_ = 0; i_ < 4; ++i_) pr[sx_][i_] = p4_[SC_P_PIECE(i_)]; \
        qr[sx_] = *(const f32x4*)(Qg + (ubase + (cc)) * 4096 + (rq * 16 + qrow) * 64 + qc4); } while (0)
    if (mm) {
#pragma unroll
        for (int r = 0; r < 4; ++r) SLb[(4 * lq + r) * MM_LP + ct * 16 + li] = (bf16)0;
    } else {
        { float z0; asm volatile("v_mov_b32 %0, 0" : "=v"(z0));
          *(f32x4*)(SST + ubase * 4096 + (rq * 16 + qrow) * 64 + qc4) = (f32x4){z0, z0, z0, z0}; }
        SC_LOAD(0, 0); SC_PUT_P(0, 0); *(LAS f32x4*)(QL + qrow * 64 + qc4) = qr[0];
#pragma unroll
        for (int x = 0; x < PD; ++x) SC_LOAD(x, 1 + x);
    }
    __syncthreads();
#pragma unroll 1
    for (int c2 = 0; c2 < RW_NSC; c2 += PD) {
#pragma unroll
        for (int x = 0; x < PD; ++x) {
            const int c = c2 + x;
            if (c < RW_NSC) {
            if (mm) {
                const LAS bf16* Pc = PT + (c & 1) * (64 * MM_LP); const LAS bf16* Sc = SLb + (c & 1) * (16 * MM_LP); const LAS float* Qc = QL + (c & 1) * (16 * 64);
                LAS bf16* Sn = SLb + ((c + 1) & 1) * (16 * MM_LP); LAS float* So = SO + ((c + 1) & 1) * (16 * 64);
                bf16x8 af[2], bfr[2];
#pragma unroll
                for (int ks = 0; ks < 2; ++ks) { af[ks] = *(const LAS bf16x8*)(Sc + li * MM_LP + 32 * ks + 8 * lq); bfr[ks] = *(const LAS bf16x8*)(Pc + (16 * ct + li) * MM_LP + 32 * ks + 8 * lq); }
                f32x4 acc;
#pragma unroll
                for (int r = 0; r < 4; ++r) acc[r] = Qc[(4 * lq + r) * 64 + ct * 16 + li];
#pragma unroll
                for (int ks = 0; ks < 2; ++ks) acc = __builtin_amdgcn_mfma_f32_16x16x32_bf16(af[ks], bfr[ks], acc, 0, 0, 0);
                if (c + 1 < RW_NSC) {
#pragma unroll
                    for (int r = 0; r < 4; ++r) { Sn[(4 * lq + r) * MM_LP + ct * 16 + li] = f2bf(acc[r]); So[(4 * lq + r) * 64 + ct * 16 + li] = acc[r]; } }
            } else {
                if (c > 0) *(f32x4*)(SST + (ubase + c) * 4096 + (rq * 16 + qrow) * 64 + qc4) = *(const LAS f32x4*)(SO + (c & 1) * (16 * 64) + qrow * 64 + qc4);
                if (c + 1 < RW_NSC) { SC_PUT_P((c + 1) & 1, x); *(LAS f32x4*)(QL + ((c + 1) & 1) * (16 * 64) + qrow * 64 + qc4) = qr[x]; }
                if (c + 1 + PD < RW_NSC) SC_LOAD(x, c + 1 + PD);
            }
            __syncthreads();
#ifdef SCAN_2BAR
            __syncthreads();
#endif
            }
        }
    }
#undef SC_PUT_P
#undef SC_LOAD
#undef SC_P_PIECE
}
__device__ __forceinline__ void ph_rw_out_(const Ctx& C, int l) {
    const bf16* RKVS = (const bf16*)(C.ws + WS_RKVS); const bf16* AG = (const bf16*)(C.ws + WS_AG); const bf16* Y0 = (const bf16*)(C.ws + WS_Y0); const bf16* RH = (const bf16*)(C.ws + WS_RHAT);
    const float* SST = (const float*)(C.ws + WS_SST); const float* BON = (const float*)(C.ws + WS_BON); bf16* Y = (bf16*)(C.ws + WS_Y);
    LAS float* RL = (LAS float*)(C.lds);
    const int lane = C.lane, wave = C.wave;
    for (int u = C.bid; u < RW_NU; u += C.G) {
        const int bh = u >> 8, ch = u & 255, b = bh >> 2, h = bh & 3, m0 = b * SEQ + ch * RWC, hc = h * 64 + lane;
        { const int t = C.tid >> 3, d0 = (C.tid & 7) * 8; float a[8];
          unpack8(*(const u32x4*)(RH + (size_t)(m0 + t) * 256 + h * 64 + d0), a);
#pragma unroll
          for (int e = 0; e < 8; ++e) RL[t * 64 + d0 + e] = a[e]; }
        float s[64];
        { const f32x4* sp = (const f32x4*)(SST + (size_t)u * 4096 + lane * 64);
#pragma unroll
          for (int k4 = 0; k4 < 16; ++k4) { const f32x4 v = sp[k4]; s[4 * k4] = v.x; s[4 * k4 + 1] = v.y; s[4 * k4 + 2] = v.z; s[4 * k4 + 3] = v.w; } }
        const float lnw = C.in[I_RW_LNW][l * 256 + hc], lnb = C.in[I_RW_LNB][l * 256 + hc];
        __syncthreads();
#pragma unroll 2
        for (int q = 0; q < 8; ++q) { const int t = wave * 8 + q; const size_t m = (size_t)(m0 + t);
            const LAS f32x4* rv = (const LAS f32x4*)(RL + t * 64);
            float y0 = 0.f, y1 = 0.f, y2 = 0.f, y3 = 0.f;
#pragma unroll
            for (int k4 = 0; k4 < 16; ++k4) { const f32x4 rq = rv[k4]; y0 += s[4 * k4] * rq.x; y1 += s[4 * k4 + 1] * rq.y; y2 += s[4 * k4 + 2] * rq.z; y3 += s[4 * k4 + 3] * rq.w; }
#ifndef RWDBG
#define RWDBG 0
#endif
            float y = ((RWDBG & 1) ? 0.f : (y0 + y1) + (y2 + y3)) + ((RWDBG & 2) ? 0.f : bf2f(Y0[m * 256 + hc]));
            const float mean = wave_sum(y, C.lane) * (1.f / 64.f); y -= mean;
            const float rstd = 1.0f / sqrtf(wave_sum(y * y, C.lane) * (1.f / 64.f) + 64e-5f);
            y = y * rstd * lnw + lnb;
            if (!(RWDBG & 4)) y += BON[m * 4 + h] * bf2f(RKVS[m * 768 + 512 + hc]);
            y *= bf2f(AG[m * 512 + 256 + hc]);
            if (RWDBG & 120) { y = 0.f; if (RWDBG & 8) y += ((const float*)(C.ws + WS_WDEC))[m * 256 + hc]; if (RWDBG & 16) y += bf2f(AG[m * 512 + hc]);
                if (RWDBG & 32) y += bf2f(RKVS[m * 768 + hc]) + bf2f(RKVS[m * 768 + 256 + hc]) + bf2f(RKVS[m * 768 + 512 + hc]); if (RWDBG & 64) y += BON[m * 4 + h]; }
            Y[m * 1024 + hc] = f2bf(y); }
        __syncthreads();
    }
}

constexpr int SB_VLD = 40;
__device__ __forceinline__ void ph_sb_attn_(const Ctx& C, int first_wg, int nwg, unsigned* qhead = nullptr) {
    const bf16* SB = (const bf16*)(C.ws + WS_SB); bf16* Y = (bf16*)(C.ws + WS_Y);
    const int lane = C.lane, j = lane & 31, hi = lane >> 5;
    LAS unsigned char* VR = C.lds + C.wave * (32 * 192);
    const int trq = (lane & 15) >> 2, trp = lane & 3, trg = (lane >> 4) & 1;
    for (int it = qhead ? q_next(C, qhead) : C.bid - first_wg; it < 512; it = qhead ? q_next(C, qhead) : it + nwg) {
        const int bh = it >> 6, b = bh >> 2, h = bh & 3, t0 = (it & 63) * 256 + C.wave * 32; const size_t mb = (size_t)b * SEQ;
        bf16x8 qf[4];
#pragma unroll
        for (int ks = 0; ks < 4; ++ks) qf[ks] = *(const bf16x8*)(SB + (mb + t0 + j) * 768 + h * 64 + 16 * ks + 8 * hi);
        f32x16 o0, o1;
#pragma unroll
        for (int i = 0; i < 16; ++i) { o0[i] = 0.f; o1[i] = 0.f; }
        float acc = 0.f;
#pragma unroll 1
        for (int kt = t0; kt >= 0; kt -= 32) {
            bf16x8 kf[4];
#pragma unroll
            for (int ks = 0; ks < 4; ++ks) kf[ks] = *(const bf16x8*)(SB + (mb + kt + j) * 768 + 256 + h * 64 + 16 * ks + 8 * hi);
            u32x4 vv[4];
#pragma unroll
            for (int i = 0; i < 4; ++i) { const int c = lane + 64 * i; vv[i] = *(const u32x4*)(SB + (mb + kt + (c >> 3)) * 768 + 512 + h * 64 + (c & 7) * 8); }
            f32x16 sc;
#pragma unroll
            for (int i = 0; i < 16; ++i) sc[i] = 0.f;
#pragma unroll
            for (int ks = 0; ks < 4; ++ks) sc = __builtin_amdgcn_mfma_f32_32x32x16_bf16(kf[ks], qf[ks], sc, 0, 0, 0);
#pragma unroll
            for (int i = 0; i < 4; ++i) { const int c = lane + 64 * i; *(LAS u32x4*)(VR + (c >> 3) * 192 + (c & 7) * 16) = vv[i]; }
            const bool diag = (kt == t0);
            float ls[16], g[4], og[4];
#pragma unroll
            for (int r = 0; r < 4; ++r) { g[r] = 0.f;
#pragma unroll
                for (int e = 0; e < 4; ++e) { const float z = sc[4 * r + e]; const bool valid = !diag || (8 * r + 4 * hi + e) < j;
                    const float l = (z > 40.f) ? -z : -__builtin_amdgcn_logf(1.f + __builtin_amdgcn_exp2f(z));
                    ls[4 * r + e] = valid ? l : 0.f; g[r] += ls[4 * r + e]; } }
#pragma unroll
            for (int r = 0; r < 4; ++r) og[r] = shx(g[r], 32, lane);
            float pw[16]; float run = acc;
#pragma unroll
            for (int r = 3; r >= 0; --r) { float cum = run + (hi == 0 ? og[r] : 0.f);
#pragma unroll
                for (int e = 3; e >= 0; --e) { cum += ls[4 * r + e]; const bool valid = !diag || (8 * r + 4 * hi + e) < j;
                    pw[4 * r + e] = valid ? __builtin_amdgcn_exp2f(sc[4 * r + e] + cum) : 0.f; }
                run += g[r] + og[r]; }
            acc = run;
            asm volatile("" ::: "memory");
#pragma unroll
            for (int ks = 0; ks < 2; ++ks) {
                u32x4 pk; pk.x = cvt_pk_bf16(pw[8 * ks], pw[8 * ks + 1]); pk.y = cvt_pk_bf16(pw[8 * ks + 2], pw[8 * ks + 3]); pk.z = cvt_pk_bf16(pw[8 * ks + 4], pw[8 * ks + 5]); pk.w = cvt_pk_bf16(pw[8 * ks + 6], pw[8 * ks + 7]);
                const bf16x8 pb = __builtin_bit_cast(bf16x8, pk);
                const LAS unsigned char* tb = VR + (16 * ks + 4 * hi + trq) * 192 + (16 * trg + 4 * trp) * 2;
                const s16x4 a0l = __builtin_amdgcn_ds_read_tr16_b64_v4i16((LAS s16x4*)(tb)), a0h = __builtin_amdgcn_ds_read_tr16_b64_v4i16((LAS s16x4*)(tb + 8 * 192));
                const s16x4 a1l = __builtin_amdgcn_ds_read_tr16_b64_v4i16((LAS s16x4*)(tb + 64)), a1h = __builtin_amdgcn_ds_read_tr16_b64_v4i16((LAS s16x4*)(tb + 8 * 192 + 64));
                const bf16x8 va0 = __builtin_shufflevector(a0l, a0h, 0, 1, 2, 3, 4, 5, 6, 7), va1 = __builtin_shufflevector(a1l, a1h, 0, 1, 2, 3, 4, 5, 6, 7);
                o0 = __builtin_amdgcn_mfma_f32_32x32x16_bf16(va0, pb, o0, 0, 0, 0);
                o1 = __builtin_amdgcn_mfma_f32_32x32x16_bf16(va1, pb, o1, 0, 0, 0);
            }
            asm volatile("" ::: "memory");
            if (__builtin_amdgcn_ballot_w64(acc > -140.f) == 0ull) break;
        }
        bf16* yp = Y + (mb + t0 + j) * 1024 + 256 + h * 64 + 4 * hi;
#pragma unroll
        for (int r = 0; r < 4; ++r) { u32x2 w0, w1; w0.x = cvt_pk_bf16(o0[4 * r], o0[4 * r + 1]); w0.y = cvt_pk_bf16(o0[4 * r + 2], o0[4 * r + 3]); w1.x = cvt_pk_bf16(o1[4 * r], o1[4 * r + 1]); w1.y = cvt_pk_bf16(o1[4 * r + 2], o1[4 * r + 3]);
            *(u32x2*)(yp + 8 * r) = w0; *(u32x2*)(yp + 32 + 8 * r) = w1; }
    }
}


__device__ __forceinline__ f32x16 mm_tile(const LAS bf16* X, const LAS bf16* Y, int ti, int tj, int lane) {
    const int j = lane & 31, hi = lane >> 5; f32x16 acc;
#pragma unroll
    for (int i = 0; i < 16; ++i) acc[i] = 0.f;
#pragma unroll
    for (int ks = 0; ks < 4; ++ks) { const bf16x8 a = *(const LAS bf16x8*)(X + (32 * ti + j) * MM_LP + 16 * ks + 8 * hi), b = *(const LAS bf16x8*)(Y + (32 * tj + j) * MM_LP + 16 * ks + 8 * hi);
        acc = __builtin_amdgcn_mfma_f32_32x32x16_bf16(a, b, acc, 0, 0, 0); }
    return acc;
}
__device__ __forceinline__ void ln_pair_stats(const f32x16& x, LAS float* XCH, int tr, int tt, int lane, float eps, float& mean, float& rstd) {
    const int j = lane & 31, hi = lane >> 5; float s1 = 0.f, s2 = 0.f;
#pragma unroll
    for (int i = 0; i < 16; ++i) { s1 += x[i]; s2 += x[i] * x[i]; }
    s1 += shx(s1, 32, lane); s2 += shx(s2, 32, lane);
    if (hi == 0) { XCH[(tr * 64 + 32 * tt + j) * 2] = s1; XCH[(tr * 64 + 32 * tt + j) * 2 + 1] = s2; }
    __syncthreads();
    const float a1 = XCH[(32 * tt + j) * 2] + XCH[(64 + 32 * tt + j) * 2], a2 = XCH[(32 * tt + j) * 2 + 1] + XCH[(64 + 32 * tt + j) * 2 + 1];
    mean = a1 * (1.f / 64.f); const float var = fmaxf(a2 * (1.f / 64.f) - mean * mean, 0.f); rstd = 1.0f / sqrtf(var + eps);
}
__device__ __forceinline__ void rot_store(const Ctx& C, const bf16* src  , int pos, int d0, float scale, LAS bf16* dstrow) {
    const float* cs = (const float*)(C.ws + WS_COS) + (size_t)pos * 32 + d0; const float* sn = (const float*)(C.ws + WS_SIN) + (size_t)pos * 32 + d0;
    float x1[8], x2[8]; unpack8(*(const u32x4*)(src + d0), x1); unpack8(*(const u32x4*)(src + 32 + d0), x2);
    const f32x4 c0 = *(const f32x4*)cs, c1 = *(const f32x4*)(cs + 4), s0 = *(const f32x4*)sn, s1 = *(const f32x4*)(sn + 4);
    const float cc[8] = {c0.x, c0.y, c0.z, c0.w, c1.x, c1.y, c1.z, c1.w}, ss[8] = {s0.x, s0.y, s0.z, s0.w, s1.x, s1.y, s1.z, s1.w};
    float o1[8], o2[8];
#pragma unroll
    for (int e = 0; e < 8; ++e) { o1[e] = (x1[e] * cc[e] - x2[e] * ss[e]) * scale; o2[e] = (x1[e] * ss[e] + x2[e] * cc[e]) * scale; }
    *(LAS u32x4*)(dstrow + d0) = pack8(o1); *(LAS u32x4*)(dstrow + 32 + d0) = pack8(o2);
}

__device__ __forceinline__ f32x16 mm_tile_tr(const LAS unsigned char* X, const LAS unsigned char* Y, int ti, int tj, int lane) {
    const int hi = lane >> 5, q = (lane & 15) >> 2, p = lane & 3, g = (lane >> 4) & 1;
    const LAS unsigned char* xb = X + (8 * hi + q) * 192 + (32 * ti + 16 * g + 4 * p) * 2; const LAS unsigned char* yb = Y + (8 * hi + q) * 192 + (32 * tj + 16 * g + 4 * p) * 2;
    f32x16 acc;
#pragma unroll
    for (int i = 0; i < 16; ++i) acc[i] = 0.f;
#pragma unroll
    for (int ks = 0; ks < 4; ++ks) {
        const s16x4 al = __builtin_amdgcn_ds_read_tr16_b64_v4i16((LAS s16x4*)(xb + 16 * ks * 192)), ah = __builtin_amdgcn_ds_read_tr16_b64_v4i16((LAS s16x4*)(xb + (16 * ks + 4) * 192));
        const s16x4 bl = __builtin_amdgcn_ds_read_tr16_b64_v4i16((LAS s16x4*)(yb + 16 * ks * 192)), bh = __builtin_amdgcn_ds_read_tr16_b64_v4i16((LAS s16x4*)(yb + (16 * ks + 4) * 192));
        acc = __builtin_amdgcn_mfma_f32_32x32x16_bf16(__builtin_shufflevector(al, ah, 0, 1, 2, 3, 4, 5, 6, 7), __builtin_shufflevector(bl, bh, 0, 1, 2, 3, 4, 5, 6, 7), acc, 0, 0, 0); }
    return acc;
}
__device__ __forceinline__ void ph_ret_kv2_(const Ctx& C) {
    const bf16* RET = (const bf16*)(C.ws + WS_RET); float* KV = (float*)(C.ws + WS_KV);
    const int half = C.wave >> 2, w4 = C.wave & 3, th = C.tid & 255, lane = C.lane;
    LAS unsigned char* KR = C.lds + half * 24576;
    LAS unsigned char* VR = KR + 64 * 192;
    const int srow = th >> 2, dq = th & 3;
    u32x4 kx1, kx2, vx0, vx1; f32x4 c0, c1, s0, s1;
#define KV_LOAD(itt) do { const int u_ = (itt) * 2 + half, bh_ = u_ >> 8; const size_t m_ = (size_t)((bh_ >> 2) * SEQ + (u_ & 255) * 64 + srow); const int h_ = bh_ & 3, pos_ = (int)(m_ & (SEQ - 1)); \
        const bf16* kp_ = RET + m_ * 1024 + 256 + h_ * 64 + dq * 8; kx1 = *(const u32x4*)kp_; kx2 = *(const u32x4*)(kp_ + 32); \
        const float* cs_ = (const float*)(C.ws + WS_COS) + (size_t)pos_ * 32 + dq * 8; const float* sn_ = (const float*)(C.ws + WS_SIN) + (size_t)pos_ * 32 + dq * 8; \
        c0 = *(const f32x4*)cs_; c1 = *(const f32x4*)(cs_ + 4); s0 = *(const f32x4*)sn_; s1 = *(const f32x4*)(sn_ + 4); \
        const bf16* vp_ = RET + m_ * 1024 + 512 + h_ * 64 + dq * 16; vx0 = *(const u32x4*)vp_; vx1 = *(const u32x4*)(vp_ + 8); } while (0)
    if (C.bid < 1024) KV_LOAD(C.bid);
    for (int it = C.bid; it < 1024; it += C.G) {
        const int u = it * 2 + half, bh = u >> 8, h = bh & 3;
        const float lg = ret_log2gamma(h);
        { float x1[8], x2[8], o1[8], o2[8]; unpack8(kx1, x1); unpack8(kx2, x2); const float scale = 0.125f * exp2f(lg * (float)(63 - srow));
          const float cc[8] = {c0.x, c0.y, c0.z, c0.w, c1.x, c1.y, c1.z, c1.w}, ss[8] = {s0.x, s0.y, s0.z, s0.w, s1.x, s1.y, s1.z, s1.w};
#pragma unroll
          for (int e = 0; e < 8; ++e) { o1[e] = (x1[e] * cc[e] - x2[e] * ss[e]) * scale; o2[e] = (x1[e] * ss[e] + x2[e] * cc[e]) * scale; }
          *(LAS u32x4*)(KR + srow * 192 + dq * 16) = pack8(o1); *(LAS u32x4*)(KR + srow * 192 + 64 + dq * 16) = pack8(o2);
          *(LAS u32x4*)(VR + srow * 192 + dq * 32) = vx0; *(LAS u32x4*)(VR + srow * 192 + dq * 32 + 16) = vx1; }
        if (it + C.G < 1024) KV_LOAD(it + C.G);
        __syncthreads();
        { const int ti = w4 >> 1, tj = w4 & 1, j = lane & 31, hi = lane >> 5;
          const f32x16 acc = mm_tile_tr(VR, KR, ti, tj, lane);
          float* o = KV + (size_t)u * 4096 + (size_t)(32 * ti + 4 * hi) * 64 + 32 * tj + j;
#pragma unroll
          for (int r = 0; r < 4; ++r)
#pragma unroll
              for (int e = 0; e < 4; ++e) o[(8 * r + e) * 64] = acc[4 * r + e]; }
        __syncthreads();
    }
#undef KV_LOAD
}
__device__ __forceinline__ void ph_ret_out2_(const Ctx& C, int l, int first_wg, int nwg, unsigned* qhead = nullptr) {
    const bf16* RET = (const bf16*)(C.ws + WS_RET); const float* KV = (const float*)(C.ws + WS_KV); bf16* Y = (bf16*)(C.ws + WS_Y);
    const int half = C.wave >> 2, w4 = C.wave & 3, th = C.tid & 255, lane = C.lane, j = lane & 31, hi = lane >> 5, te = w4 >> 1, tt = w4 & 1;
    LAS bf16* QL = (LAS bf16*)(C.lds + half * 40960);
    LAS bf16* KL = QL + 64 * MM_LP;
    LAS unsigned char* VR = C.lds + half * 40960 + 18432;
    LAS bf16* ST = (LAS bf16*)(C.lds + half * 40960 + 30720);
    LAS float* XCH = (LAS float*)(C.lds + half * 40960 + 39936);
    const int trq = (lane & 15) >> 2, trp = lane & 3, trg = (lane >> 4) & 1;
    const float* gn = C.in[I_RET_GN] + (size_t)l * 256;
    for (int it = qhead ? q_next(C, qhead) : C.bid - first_wg; it < 1024; it = qhead ? q_next(C, qhead) : it + nwg) {
        const int u = it * 2 + half, bh = u >> 8, ch = u & 255, b = bh >> 2, h = bh & 3, m0 = b * SEQ + ch * 64;
        const float lg = ret_log2gamma(h);
        u32x2 gtv2[4];
#pragma unroll
        for (int r = 0; r < 4; ++r) gtv2[r] = *(const u32x2*)(RET + (size_t)(m0 + 32 * tt + j) * 1024 + 768 + h * 64 + 32 * te + 4 * hi + 8 * r);
        { const int srow = th >> 2, dq = th & 3; const size_t m = (size_t)(m0 + srow); const int pos = (int)(m & (SEQ - 1));
          rot_store(C, RET + m * 1024 + h * 64, pos, dq * 8, 1.0f, QL + srow * MM_LP);
          rot_store(C, RET + m * 1024 + 256 + h * 64, pos, dq * 8, 0.125f, KL + srow * MM_LP);
#pragma unroll
          for (int q = 0; q < 2; ++q) { const int e0 = dq * 16 + q * 8; *(LAS u32x4*)(VR + srow * 192 + e0 * 2) = *(const u32x4*)(RET + m * 1024 + 512 + h * 64 + e0); }
          const float* sp = KV + (size_t)u * 4096 + srow * 64 + dq * 16;
          float sv[16];
#pragma unroll
          for (int q = 0; q < 4; ++q) { const f32x4 v4 = *(const f32x4*)(sp + 4 * q); sv[4 * q] = v4.x; sv[4 * q + 1] = v4.y; sv[4 * q + 2] = v4.z; sv[4 * q + 3] = v4.w; }
          *(LAS u32x4*)(ST + srow * MM_LP + dq * 16) = pack8(sv); *(LAS u32x4*)(ST + srow * MM_LP + dq * 16 + 8) = pack8(sv + 8); }
        __syncthreads();
        f32x16 acc = mm_tile(ST, QL, te, tt, lane);
        { const float qd = exp2f(lg * (float)(32 * tt + j + 1));
#pragma unroll
          for (int i = 0; i < 16; ++i) acc[i] *= qd; }
#pragma unroll
        for (int st = 0; st < 2; ++st) {
            if (st > tt) continue;
            const f32x16 sc = mm_tile(KL, QL, st, tt, lane);
            float pw[16];
#pragma unroll
            for (int r = 0; r < 4; ++r)
#pragma unroll
                for (int e = 0; e < 4; ++e) { const int sk = 32 * st + 8 * r + 4 * hi + e, tq = 32 * tt + j;
                    pw[4 * r + e] = (sk <= tq) ? sc[4 * r + e] * exp2f(lg * (float)(tq - sk)) : 0.f; }
#pragma unroll
            for (int ks = 0; ks < 2; ++ks) {
                u32x4 pk; pk.x = cvt_pk_bf16(pw[8 * ks], pw[8 * ks + 1]); pk.y = cvt_pk_bf16(pw[8 * ks + 2], pw[8 * ks + 3]); pk.z = cvt_pk_bf16(pw[8 * ks + 4], pw[8 * ks + 5]); pk.w = cvt_pk_bf16(pw[8 * ks + 6], pw[8 * ks + 7]);
                const bf16x8 pb = __builtin_bit_cast(bf16x8, pk);
                const LAS unsigned char* tb = VR + (32 * st + 16 * ks + 4 * hi + trq) * 192 + (32 * te + 16 * trg + 4 * trp) * 2;
                const s16x4 al = __builtin_amdgcn_ds_read_tr16_b64_v4i16((LAS s16x4*)tb), ah = __builtin_amdgcn_ds_read_tr16_b64_v4i16((LAS s16x4*)(tb + 8 * 192));
                const bf16x8 va = __builtin_shufflevector(al, ah, 0, 1, 2, 3, 4, 5, 6, 7);
                acc = __builtin_amdgcn_mfma_f32_32x32x16_bf16(va, pb, acc, 0, 0, 0);
            }
        }
        float mean, rstd; ln_pair_stats(acc, XCH, te, tt, lane, 1e-5f, mean, rstd);
        { const size_t m = (size_t)(m0 + 32 * tt + j); const bf16* gp = RET + m * 1024 + 768 + h * 64 + 32 * te + 4 * hi; bf16* yp = Y + m * 1024 + 512 + h * 64 + 32 * te + 4 * hi;
          const float* gw = gn + h * 64 + 32 * te + 4 * hi;
#pragma unroll
          for (int r = 0; r < 4; ++r) { const u32x2 gt2 = gtv2[r]; const float gtv[4] = {bflo(gt2.x), bfhi(gt2.x), bflo(gt2.y), bfhi(gt2.y)}; const f32x4 gwv = *(const f32x4*)(gw + 8 * r);
              float o[4];
#pragma unroll
              for (int e = 0; e < 4; ++e) o[e] = (acc[4 * r + e] - mean) * rstd * gwv[e] * (gtv[e] * sigm(gtv[e]));
              u32x2 w; w.x = cvt_pk_bf16(o[0], o[1]); w.y = cvt_pk_bf16(o[2], o[3]); *(u32x2*)(yp + 8 * r) = w; } }
        __syncthreads();
    }
}
__device__ __forceinline__ void ph_rw_out2_(const Ctx& C, int l, unsigned* qhead = nullptr) {
    const bf16* RWp = (const bf16*)(C.ws + WS_RW); const bf16* GP = (const bf16*)(C.ws + WS_GP); const bf16* Y0 = (const bf16*)(C.ws + WS_Y0); const bf16* RH = (const bf16*)(C.ws + WS_RHAT);
    const float* SST = (const float*)(C.ws + WS_SST); const float* BON = (const float*)(C.ws + WS_BON); bf16* Y = (bf16*)(C.ws + WS_Y);
    const int half = C.wave >> 2, w4 = C.wave & 3, th = C.tid & 255, lane = C.lane, j = lane & 31, hi = lane >> 5, tv = w4 >> 1, tt = w4 & 1;
    LAS bf16* SL = (LAS bf16*)(C.lds + half * 20480);
    LAS bf16* RL = SL + 64 * MM_LP;
    LAS float* XCH = (LAS float*)(C.lds + half * 20480 + 2 * 64 * MM_LP * 2);
    for (int it = qhead ? q_next(C, qhead) : C.bid; it < RW_NU / 2; it = qhead ? q_next(C, qhead) : it + C.G) {
        const int u = it * 2 + half, bh = u >> 8, ch = u & 255, b = bh >> 2, h = bh & 3, m0 = b * SEQ + ch * RWC;
        const size_t m = (size_t)(m0 + 32 * tt + j); const int vb = h * 64 + 32 * tv + 4 * hi;
        u32x2 y2v[4], v2v[4], vpv[4], g2v[4];
#pragma unroll
        for (int r = 0; r < 4; ++r) { const int vc = vb + 8 * r; y2v[r] = *(const u32x2*)(Y0 + m * 256 + vc); v2v[r] = *(const u32x2*)(RWp + m * 1024 + 512 + vc); g2v[r] = *(const u32x2*)(GP + m * 256 + vc);
            vpv[r] = (u32x2){0u, 0u}; if ((32 * tt + j) | (ch * RWC)) vpv[r] = *(const u32x2*)(RWp + (m - 1) * 1024 + 512 + vc); }
        const float bon = BON[m * 4 + h];
        { const int row = th >> 2, q4 = th & 3;
          const float* sp = SST + (size_t)(u >> 3) * 4096 + row * 64 + q4 * 16; float sv[16];
#pragma unroll
          for (int q = 0; q < 4; ++q) { const f32x4 v4 = *(const f32x4*)(sp + 4 * q); sv[4 * q] = v4.x; sv[4 * q + 1] = v4.y; sv[4 * q + 2] = v4.z; sv[4 * q + 3] = v4.w; }
          *(LAS u32x4*)(SL + row * MM_LP + q4 * 16) = pack8(sv); *(LAS u32x4*)(SL + row * MM_LP + q4 * 16 + 8) = pack8(sv + 8);
          const u32x4* rp = (const u32x4*)(RH + (size_t)(m0 + row) * 256 + h * 64 + q4 * 16);
          *(LAS u32x4*)(RL + row * MM_LP + q4 * 16) = rp[0]; *(LAS u32x4*)(RL + row * MM_LP + q4 * 16 + 8) = rp[1]; }
        __syncthreads();
        f32x16 acc = mm_tile(SL, RL, tv, tt, lane);
#pragma unroll
        for (int r = 0; r < 4; ++r) { const u32x2 y2 = y2v[r]; acc[4 * r] += bflo(y2.x); acc[4 * r + 1] += bfhi(y2.x); acc[4 * r + 2] += bflo(y2.y); acc[4 * r + 3] += bfhi(y2.y); }
        float mean, rstd; ln_pair_stats(acc, XCH, tv, tt, lane, 64e-5f, mean, rstd);
#pragma unroll
        for (int r = 0; r < 4; ++r) { const int vc = vb + 8 * r;
            const f32x4 lw = *(const f32x4*)(C.in[I_RW_LNW] + (size_t)l * 256 + vc), lb = *(const f32x4*)(C.in[I_RW_LNB] + (size_t)l * 256 + vc);
            const f32x4 mv = *(const f32x4*)(C.in[I_RW_MU] + (size_t)l * 1024 + 512 + vc);
            const u32x2 v2 = v2v[r], g2 = g2v[r], vp = vpv[r];
            const float vc4[4] = {bflo(v2.x), bfhi(v2.x), bflo(v2.y), bfhi(v2.y)}, vq4[4] = {bflo(vp.x), bfhi(vp.x), bflo(vp.y), bfhi(vp.y)};
            const float vv[4] = {vc4[0] + (vq4[0] - vc4[0]) * mv[0], vc4[1] + (vq4[1] - vc4[1]) * mv[1], vc4[2] + (vq4[2] - vc4[2]) * mv[2], vc4[3] + (vq4[3] - vc4[3]) * mv[3]}, gg[4] = {bflo(g2.x), bfhi(g2.x), bflo(g2.y), bfhi(g2.y)};
            float o[4];
#pragma unroll
            for (int e = 0; e < 4; ++e) o[e] = ((acc[4 * r + e] - mean) * rstd * lw[e] + lb[e] + bon * vv[e]) * gg[e];
            u32x2 w; w.x = cvt_pk_bf16(o[0], o[1]); w.y = cvt_pk_bf16(o[2], o[3]); *(u32x2*)(Y + m * 1024 + vc) = w; }
        __syncthreads();
    }
}

__device__ __forceinline__ void ph_moe_scatter_(const Ctx& C, int moe_idx) {
    unsigned* cw = (unsigned*)(C.ws + WS_CTL) + CW_MOE + moe_idx * 64;
    const int* eidx = (const int*)(C.ws + WS_EIDX); const float* gate = (const float*)(C.ws + WS_GATE);
    int* rowtok = (int*)(C.ws + WS_ROWTOK); float* rowgate = (float*)(C.ws + WS_ROWGATE); int* texp = (int*)(C.ws + WS_TEXP); int* segend = (int*)(C.ws + WS_SEGEND); int* ntp = (int*)(C.ws + WS_NT);
    bf16* XS = (bf16*)(C.ws + WS_XS);
    LAS unsigned* lcnt = (LAS unsigned*)(C.lds); LAS unsigned* lbase = lcnt + 8; LAS int* sl = (LAS int*)(C.lds + 256);
    int cnt[8], segb[8]; int tot = 0;
#pragma unroll
    for (int e = 0; e < 8; ++e) { cnt[e] = (int)__hip_atomic_load(&cw[e], __ATOMIC_RELAXED, __HIP_MEMORY_SCOPE_AGENT); segb[e] = tot; tot += (cnt[e] + 255) & ~255; }
    if (C.bid == 0) {
        if (C.tid < 8) { const int e = C.tid; int sb = 0, ce = 0;
#pragma unroll
            for (int q = 0; q < 8; ++q) if (q == e) { sb = segb[q]; ce = cnt[q]; }
            for (int pm = sb >> 8; pm < ((sb + ((ce + 255) & ~255)) >> 8); ++pm) { texp[pm] = e; segend[pm] = sb + ce; } }
        if (C.tid == 0) *ntp = tot >> 8;
    }
    for (int blk = C.bid; blk < T / 128; blk += C.G) {
        __syncthreads();
        if (C.tid < 8) lcnt[C.tid] = 0u;
        __syncthreads();
        const bool act = C.tid < 256;
        const int a = blk * 256 + (C.tid & 255), e = eidx[a];
        unsigned rank = 0u; if (act) rank = atomicAdd((unsigned*)&lcnt[e], 1u);
        __syncthreads();
        if (C.tid < 8) lbase[C.tid] = atomicAdd(&cw[16 + C.tid], lcnt[C.tid]);
        __syncthreads();
        if (act) { int sb = 0;
#pragma unroll
            for (int q = 0; q < 8; ++q) if (q == e) sb = segb[q];
            const int slot = sb + (int)lbase[e] + (int)rank;
            rowtok[slot] = a >> 1; rowgate[slot] = gate[a]; sl[C.tid] = slot; ((int*)(C.ws + WS_SLOTOF))[a] = slot; }
        __syncthreads();
#pragma unroll 1
        for (int i0 = C.wave; i0 < 256; i0 += 8 * NWAVES) { u32x4 rowv[8];
#pragma unroll
            for (int j = 0; j < 8; ++j) { const int i = i0 + j * NWAVES; rowv[j] = ((const u32x4*)(C.ws + WS_H8 + (size_t)(blk * 128 + (i >> 1)) * D))[C.lane]; }
#pragma unroll
            for (int j = 0; j < 8; ++j) { const int i = i0 + j * NWAVES; ((u32x4*)(C.ws + WS_XS + (size_t)sl[i] * D))[C.lane] = rowv[j]; } }
    }
}

__device__ __forceinline__ void grid_barrier(int wv) {
    const Ctx C = make_ctx(wv);
    XcdBarrier b; b.bar = (unsigned*)(C.ws + WS_CTL) + CW_BAR; b.x = xb_xcc_id(); b.st = (volatile LAS unsigned*)(C.lds + MISC_OFF) + 8;
    xcd_barrier(b, C.tid);
}
__device__ __forceinline__ void P_prologue(int wv) { const Ctx C = make_ctx(wv); ph_prologue_(C); }
__device__ __forceinline__ void P_weights_norm(int wv, int l) { const Ctx C = make_ctx(wv); ph_weights_(C, l, 0, 0, C.G); __syncthreads(); ph_norm_(C, C.in[I_NORM_MIX] + (size_t)l * D, false, nullptr, 0,  (l > 0) && ((l - 1) & 1), l == 0 ? C.in[I_X] : nullptr,  false, (float*)(C.ws + WS_SROW)); }
__device__ __forceinline__ void P_gemm_in(int wv, int l) { const Ctx C = make_ctx(wv); using namespace pg8; unsigned char* ws = C.ws;
    Gemm g{(const bf16*)(ws + WS_XB), (const bf16*)(ws + WS_WIN), D, D}; StaticOrder S; S.init(T, NIN, C.G, C.bid);
    EpiRoute E{(bf16*)(ws + WS_RW), (bf16*)(ws + WS_SB), (bf16*)(ws + WS_RET), (bf16*)(ws + WS_CV), C.in[I_SB_QN] + (size_t)l * 64, C.in[I_SB_KN] + (size_t)l * 64, (const float*)(ws + WS_SROW)};
    gemm_phase<EpiRoute, StaticOrder, true, 1>(C.lds, C.tid, g, S, E);
    { constexpr int nt_in = (T / 256) * (NIN / 256); const int rem = nt_in % C.G;
      if (C.G >= 192 && rem != 0 && C.bid >= rem) { __syncthreads(); ph_weights_(C, l, 1, 0, C.G, (unsigned*)(C.ws + WS_CTL) + CW_QUEUE + l * 64 + 32, 6, false); } } }
#define REP2(bit, stmt) do { stmt; if constexpr ((PROBE2 >> (bit)) & 1) { __syncthreads(); stmt; } } while (0)
__device__ __forceinline__ void P_mix1(int wv, int l) { REP2(2, { const Ctx C = make_ctx(wv); ph_rw_lora_(C, l); }); REP2(3, { const Ctx C = make_ctx(wv); ph_conv_(C, l); }); REP2(4, { const Ctx C = make_ctx(wv); ph_ret_kv2_(C); }); }
#ifndef MIX3_SEL
#define MIX3_SEL 3
#endif
__device__ __forceinline__ void P_mix3(int wv, int l) { REP2(0, { const Ctx C = make_ctx(wv); ph_rw_local_wy_(C, l); }); }
__device__ __forceinline__ void scan_done_post(const Ctx& C, unsigned* cnt) {
    asm volatile("s_waitcnt vmcnt(0)" ::: "memory"); __syncthreads();
    if (C.tid == 0) { __builtin_amdgcn_fence(__ATOMIC_RELEASE, "agent"); asm volatile("s_waitcnt vmcnt(0)" ::: "memory"); (void)xb_add(cnt, 1u); }
}
__device__ __forceinline__ void scan_done_wait(const Ctx& C, unsigned* cnt, unsigned need = 32u) {
    __syncthreads();
    if (C.tid == 0) { unsigned sp = 0u; while (xb_ld(cnt) < need) { __builtin_amdgcn_s_sleep(2); if (++sp > (1u << 24)) break; }
        __builtin_amdgcn_fence(__ATOMIC_ACQUIRE, "agent"); asm volatile("s_waitcnt vmcnt(0)" ::: "memory"); }
    __syncthreads();
}
__device__ __forceinline__ void P_mix4(int wv, int l) { const Ctx C = make_ctx(wv);
    unsigned* qh = (unsigned*)(C.ws + WS_CTL) + CW_QUEUE + l * 64;
    if (C.G >= 192) { if (C.bid < 32) { ph_rw_scan_(C, C.bid); scan_done_post(C, qh + 48); }
        else if (C.bid < 160) { ph_ret_scan_(C, 32, 128); scan_done_post(C, qh + 56); }
        ph_sb_attn_(C, 0, C.G, qh); scan_done_wait(C, qh + 56, 128u); ph_ret_out2_(C, l, 0, C.G, qh + 16); __syncthreads(); ph_weights_(C, l, 1, 0, C.G, qh + 32);
        scan_done_wait(C, qh + 48); ph_rw_out2_(C, l, qh + 40); }
    else { for (int w = C.bid; w < 32; w += C.G) { ph_rw_scan_(C, w); scan_done_post(C, qh + 48); } ph_ret_scan_(C, 0, C.G); scan_done_post(C, qh + 56);
        ph_sb_attn_(C, 0, C.G); scan_done_wait(C, qh + 56, (unsigned)C.G); ph_ret_out2_(C, l, 0, C.G); __syncthreads(); ph_weights_(C, l, 1, 0, C.G);
        scan_done_wait(C, qh + 48); ph_rw_out2_(C, l); } }
__device__ __forceinline__ void P_gemm_branch(int wv) { const Ctx C = make_ctx(wv); using namespace pg8; unsigned char* ws = C.ws;
    Gemm g{(const bf16*)(ws + WS_Y), (const bf16*)(ws + WS_WB), D, 256}; StaticOrder S; S.init(T, 4096, C.G, C.bid, 2, 512);
    EpiBall E{ws + WS_BALL};
    gemm_phase<EpiBall, StaticOrder, false>(C.lds, C.tid, g, S, E); }
__device__ __forceinline__ void P_gemm_gate(int wv) { const Ctx C = make_ctx(wv); using namespace pg8; unsigned char* ws = C.ws;
    Gemm g{(const bf16*)(ws + WS_H8), (const bf16*)(ws + WS_WG), D, D}; StaticOrder S; S.init(T, 4096, C.G, C.bid);
    EpiGateMerge E{(const bf16*)(ws + WS_BALL), (bf16*)(ws + WS_MERGED)};
    gemm_phase8<EpiGateMerge, StaticOrder, true>(C.lds, C.tid, g, S, E); }
__device__ __forceinline__ void P_gemm_out(int wv) { const Ctx C = make_ctx(wv); using namespace pg8; unsigned char* ws = C.ws;
    Gemm g{(const bf16*)(ws + WS_MERGED), (const bf16*)(ws + WS_WOUT), D, D}; StaticOrder S; S.init(T, D, C.G, C.bid);
    EpiResidual E{(bf16*)(ws + WS_XB), 1.0f};
    gemm_phase<EpiResidual, StaticOrder, true, 1>(C.lds, C.tid, g, S, E); }
__device__ __forceinline__ void P_norm_ffn(int wv, int l) { const Ctx C = make_ctx(wv); ph_norm_(C, C.in[I_NORM_FFN] + (size_t)l * D, (l & 1) != 0, C.in[I_ROUTER] + (size_t)(l >> 1) * D * NEXP, l >> 1, false, nullptr,  false); }
__device__ __forceinline__ void P_ffn_up(int wv) { const Ctx C = make_ctx(wv); using namespace pg8; unsigned char* ws = C.ws;
    Gemm g{(const bf16*)(ws + WS_H8), (const bf16*)(ws + WS_W13), D, D}; StaticOrder S; S.init(T, 2 * DFF, C.G, C.bid);
    EpiSwiglu E{ws + WS_HID, DFF, 1 << 20, false};
    gemm_phase8<EpiSwiglu, StaticOrder, true>(C.lds, C.tid, g, S, E); }
__device__ __forceinline__ void P_ffn_down(int wv) { const Ctx C = make_ctx(wv); using namespace pg8; unsigned char* ws = C.ws;
    Gemm g{(const bf16*)(ws + WS_HID), (const bf16*)(ws + WS_W2D), DFF, DFF}; StaticOrder S; S.init(T, D, C.G, C.bid);
    EpiResidual E{(bf16*)(ws + WS_XB), F8_DESCALE_DOWN};
    gemm_phase8<EpiResidual, StaticOrder, true, 1>(C.lds, C.tid, g, S, E); }
__device__ __forceinline__ void P_moe_scatter(int wv, int l2) { const Ctx C = make_ctx(wv); ph_moe_scatter_(C, l2); }
__device__ __forceinline__ void P_moe_up(int wv) { const Ctx C = make_ctx(wv); using namespace pg8; unsigned char* ws = C.ws;
    Gemm g{(const bf16*)(ws + WS_XS), (const bf16*)(ws + WS_W13), D, D};
    MoeOrder S{(const int*)(ws + WS_TEXP), __builtin_amdgcn_readfirstlane(*(const int*)(ws + WS_NT)), 2 * DFE / 256, C.G, C.bid};
    EpiSwiglu E{ws + WS_HIDM, DFE_PAD, 2 * DFE / 256, true};
    gemm_phase8<EpiSwiglu, MoeOrder, true>(C.lds, C.tid, g, S, E); }
__device__ __forceinline__ void P_moe_down(int wv) { const Ctx C = make_ctx(wv); using namespace pg8; unsigned char* ws = C.ws;
    Gemm g{(const bf16*)(ws + WS_HIDM), (const bf16*)(ws + WS_W2M), DFE_PAD, DFE_PAD};
    MoeOrder S{(const int*)(ws + WS_TEXP), __builtin_amdgcn_readfirstlane(*(const int*)(ws + WS_NT)), D / 256, C.G, C.bid};
    EpiBf16 E{(bf16*)(ws + WS_YS), D, 3, F8_DESCALE_DOWN};
    gemm_phase8<EpiBf16, MoeOrder, true, 1>(C.lds, C.tid, g, S, E); }
__device__ __forceinline__ void P_moe_combine(int wv) { const Ctx C = make_ctx(wv);
    const int gw = C.bid * NWAVES + C.wave, NGW = C.G * NWAVES, lane = C.lane;
    const int* slotof = (const int*)(C.ws + WS_SLOTOF); const float* gate = (const float*)(C.ws + WS_GATE); const bf16* YS = (const bf16*)(C.ws + WS_YS); const bf16* XB = (const bf16*)(C.ws + WS_XB);
    constexpr int NRC = 4;
    for (int mb = gw; mb < T; mb += NRC * NGW) {
        int s0[NRC], s1[NRC]; float g0[NRC], g1[NRC]; u32x4 x[NRC][2], ya[NRC][2], yb[NRC][2];
#pragma unroll
        for (int r = 0; r < NRC; ++r) { const int m = mb + r * NGW < T ? mb + r * NGW : T - 1; s0[r] = slotof[2 * m]; s1[r] = slotof[2 * m + 1]; g0[r] = gate[2 * m]; g1[r] = gate[2 * m + 1];
            const u32x4* xb = (const u32x4*)(XB + (size_t)m * D) + lane; x[r][0] = __builtin_nontemporal_load(xb); x[r][1] = __builtin_nontemporal_load(xb + 64); }
#pragma unroll
        for (int r = 0; r < NRC; ++r) { const u32x4* y0 = (const u32x4*)(YS + (size_t)s0[r] * D) + lane; const u32x4* y1 = (const u32x4*)(YS + (size_t)s1[r] * D) + lane;
            ya[r][0] = __builtin_nontemporal_load(y0); ya[r][1] = __builtin_nontemporal_load(y0 + 64); yb[r][0] = __builtin_nontemporal_load(y1); yb[r][1] = __builtin_nontemporal_load(y1 + 64); }
#pragma unroll
        for (int r = 0; r < NRC; ++r) { const int m = mb + r * NGW; if (m < T) { f32x4* xo = (f32x4*)(C.out + (size_t)m * D + 8 * lane); const float G0 = g0[r], G1 = g1[r];
#pragma unroll
            for (int j = 0; j < 2; ++j) { const u32x4 xx = x[r][j], a = ya[r][j], b = yb[r][j]; f32x4 v0, v1;
                v0.x = bflo(xx.x) + G0 * bflo(a.x) + G1 * bflo(b.x); v0.y = bfhi(xx.x) + G0 * bfhi(a.x) + G1 * bfhi(b.x); v0.z = bflo(xx.y) + G0 * bflo(a.y) + G1 * bflo(b.y); v0.w = bfhi(xx.y) + G0 * bfhi(a.y) + G1 * bfhi(b.y);
                v1.x = bflo(xx.z) + G0 * bflo(a.z) + G1 * bflo(b.z); v1.y = bfhi(xx.z) + G0 * bfhi(a.z) + G1 * bfhi(b.z); v1.z = bflo(xx.w) + G0 * bflo(a.w) + G1 * bflo(b.w); v1.w = bfhi(xx.w) + G0 * bfhi(a.w) + G1 * bfhi(b.w);
                __builtin_nontemporal_store(v0, xo + 128 * j); __builtin_nontemporal_store(v1, xo + 128 * j + 1); } } }
    }
}

#ifndef PROBE_MASK
#define PROBE_MASK 0u
#endif
#ifndef PH_MASK
#define PH_MASK 0xffffffffu
#endif
__global__ void __launch_bounds__(NTHR, 2) hybrid_fwd(Args args) {
    (void)args;
    const int wv = __builtin_amdgcn_readfirstlane(threadIdx.x >> 6);
    { LAS unsigned char* lds = (LAS unsigned char*)lds_raw;
      for (int u = threadIdx.x; u < (LDS_BYTES - RING_BYTES) / 4; u += NTHR) ((LAS unsigned*)(lds + RING_BYTES))[u] = 0u; }
    __syncthreads();
    { const CAS Args* ka = ka_ptr();
      if (ka->ph_hi - ka->ph_lo > 1) { (void)xcd_barrier_post((unsigned*)(ka->ws + WS_CTL) + CW_BAR, (volatile LAS unsigned*)((LAS unsigned char*)lds_raw + MISC_OFF) + 8); } }
    int gp = 0;
#define PHASE(k, call) { const CAS Args* ka_ = ka_ptr(); const int lo_ = ka_->ph_lo, hi_ = ka_->ph_hi; if (lo_ <= gp && gp < hi_) { if constexpr ((PH_MASK >> (k)) & 1u) { call; if constexpr ((PROBE_MASK >> (k)) & 1u) { __syncthreads(); call; } } if (hi_ - lo_ > 1 && gp + 1 < hi_) grid_barrier(wv); } ++gp; }
    PHASE(0, P_prologue(wv))
#pragma unroll 1
    for (int l = 0; l < NLAYER; ++l) {
        PHASE(1, P_weights_norm(wv, l))
        PHASE(2, P_gemm_in(wv, l))
        PHASE(3, P_mix1(wv, l))
        ++gp;
        PHASE(5, P_mix3(wv, l))
        PHASE(6, P_mix4(wv, l))
        ++gp;
        PHASE(8, P_gemm_branch(wv))
        PHASE(9, P_gemm_gate(wv))
        PHASE(10, P_gemm_out(wv))
        PHASE(11, P_norm_ffn(wv, l))
        if (!(l & 1)) {
            PHASE(12, P_ffn_up(wv))
            PHASE(13, P_ffn_down(wv))
            gp += 2;
        } else {
            PHASE(14, P_moe_scatter(wv, l >> 1))
            PHASE(15, P_moe_up(wv))
            PHASE(16, P_moe_down(wv))
            if (l == NLAYER - 1) { PHASE(17, P_moe_combine(wv)) } else { ++gp; }
        }
    }
#undef PHASE
}
constexpr int N_PHASES = 1 + NLAYER * 15;

#ifndef MK_MULTI
#define MK_MULTI 0
#endif
extern "C" void kernel_launch(void* const* d_in, const int* in_sizes, int n_in, void* d_out, int out_size, void* d_ws, size_t ws_size, hipStream_t stream) {
    static int grid = 0;
    if (grid == 0) {
        if (n_in != 32 || in_sizes[0] != T * D || out_size != T * D || ws_size < WS_END) { fprintf(stderr, "kernel_launch: unexpected problem shape / workspace (%d inputs, ws %zu)\n", n_in, ws_size); grid = -1; return; }
        int dev = 0, cus = 0, per_cu = 0;
        if (hipGetDevice(&dev) != hipSuccess || hipDeviceGetAttribute(&cus, hipDeviceAttributeMultiprocessorCount, dev) != hipSuccess) { grid = -1; return; }
        if (hipFuncSetAttribute((const void*)hybrid_fwd, hipFuncAttributeMaxDynamicSharedMemorySize, LDS_BYTES) != hipSuccess) { fprintf(stderr, "kernel_launch: hipFuncSetAttribute failed\n"); grid = -1; return; }
        if (hipOccupancyMaxActiveBlocksPerMultiprocessor(&per_cu, (const void*)hybrid_fwd, NTHR, LDS_BYTES) != hipSuccess || per_cu < 1) { fprintf(stderr, "kernel_launch: occupancy query says %d\n", per_cu); }
        (void)hipGetLastError();
        grid = cus;
    }
    if (grid < 0) return;
    (void)hipMemsetAsync((char*)d_ws + WS_CTL, 0, CTL_ZERO_BYTES, stream);
#ifdef DBG_ZERO_WS
    (void)hipMemsetAsync((char*)d_ws + CTL_ZERO_BYTES, 0, WS_END - CTL_ZERO_BYTES, stream);
#endif
    Args a{};
    for (int i = 0; i < 32; ++i) a.in[i] = (const float*)d_in[i];
    a.out = (float*)d_out; a.ws = (unsigned char*)d_ws;
#if MK_MULTI
    for (int p = 0; p < N_PHASES; ++p) { a.ph_lo = p; a.ph_hi = p + 1; hipLaunchKernelGGL(hybrid_fwd, dim3(grid), dim3(NTHR), LDS_BYTES, stream, a); }
#else
    a.ph_lo = 0; a.ph_hi = N_PHASES; hipLaunchKernelGGL(hybrid_fwd, dim3(grid), dim3(NTHR), LDS_BYTES, stream, a);
#endif
}
```
